# Optimizing an MI355X kernel written in HIP

```python
import math
import jax, jax.numpy as jnp
from jax import lax
import numpy as np

D_MODEL = 1024
BATCH = 2
SEQ = 8192
DEPTH = 2

GRID_W = 64
CTX_LEN = 256
HEAD_DIM = 64
ROPE_THETA = 10000.0
NORM_EPS = 1e-6
NEG_INF = -1e30

A_HEADS = 8
A_KV_HEADS = 2
A_WINDOW = 128
A_BLOCK = 128
B_HEADS = 8
NA_ROWS = 8
NA_COLS = 16
NA_COL_BLOCK = 16
NA_BAND = 32
C_HEADS = 4
C_VDIM = 2 * HEAD_DIM
C_BLOCK = 128
PEER_HEADS = 8
PEER_KEYS = 128
PEER_TOPK = 16
PEER_QDIM = 256
N_EXPERTS = PEER_KEYS * PEER_KEYS
PEER_CHUNK = 128

A_Q_W = A_HEADS * HEAD_DIM
A_KV_W = A_KV_HEADS * HEAD_DIM
B_W = B_HEADS * HEAD_DIM
C_QK_W = C_HEADS * 2 * HEAD_DIM
C_V_W = C_HEADS * C_VDIM
IN_SPLITS = (A_Q_W, A_KV_W, A_KV_W, B_W, B_W, B_W, C_QK_W, C_QK_W, C_V_W, D_MODEL, D_MODEL, D_MODEL)
IN_W = 6912

kernel_name = "hybrid_dit_gqa_natten_diffattn_peer"


def rms_norm(x, g):
    xf = x.astype(jnp.float32)
    y = xf * lax.rsqrt(jnp.mean(xf * xf, axis=-1, keepdims=True) + NORM_EPS)
    return (y * g.astype(jnp.float32)).astype(x.dtype)


def split_cols(p):
    idx = np.cumsum(np.array(IN_SPLITS))[:-1].tolist()
    return jnp.split(p, idx, axis=-1)


def axial_rope(n):
    t = jnp.arange(n, dtype=jnp.int32)
    row = (t // GRID_W).astype(jnp.float32)
    col = (t % GRID_W).astype(jnp.float32)
    n_freq = HEAD_DIM // 4
    inv = ROPE_THETA ** (-jnp.arange(n_freq, dtype=jnp.float32) / n_freq)
    ang = jnp.concatenate([row[:, None] * inv, col[:, None] * inv], axis=-1)
    return jnp.cos(ang), jnp.sin(ang)


def apply_rope(x, cos, sin):
    half = HEAD_DIM // 2
    xf = x.astype(jnp.float32)
    x1, x2 = xf[..., :half], xf[..., half:]
    cs, sn = cos[None, :, None, :], sin[None, :, None, :]
    return jnp.concatenate([x1 * cs - x2 * sn, x2 * cs + x1 * sn], axis=-1).astype(x.dtype)


def project_heads(h, w, rope):
    p = split_cols(h @ w)
    B, n = h.shape[:2]
    aq = p[0].reshape(B, n, A_HEADS, HEAD_DIM)
    ak = p[1].reshape(B, n, A_KV_HEADS, HEAD_DIM)
    av = p[2].reshape(B, n, A_KV_HEADS, HEAD_DIM)
    bq = p[3].reshape(B, n, B_HEADS, HEAD_DIM)
    bk = p[4].reshape(B, n, B_HEADS, HEAD_DIM)
    bv = p[5].reshape(B, n, B_HEADS, HEAD_DIM)
    cq = p[6].reshape(B, n, C_HEADS * 2, HEAD_DIM)
    ck = p[7].reshape(B, n, C_HEADS * 2, HEAD_DIM)
    cv = p[8].reshape(B, n, C_HEADS, C_VDIM)
    if rope is not None:
        cos, sin = rope
        aq, ak = apply_rope(aq, cos, sin), apply_rope(ak, cos, sin)
        cq, ck = apply_rope(cq, cos, sin), apply_rope(ck, cos, sin)
    cq = cq.reshape(B, n, C_HEADS, 2, HEAD_DIM)
    ck = ck.reshape(B, n, C_HEADS, 2, HEAD_DIM)
    return {"aq": aq, "ak": ak, "av": av, "bq": bq, "bk": bk, "bv": bv,
            "cq": cq, "ck": ck, "cv": cv, "ga": p[9], "gb": p[10], "gc": p[11]}


def context_attention(q, k, v, sink=None):
    B, L, H, D = q.shape
    G = k.shape[2]
    R = H // G
    qg = q.reshape(B, L, G, R, D)
    s = jnp.einsum('blgrd,bmgd->bgrlm', qg, k).astype(jnp.float32) * (D ** -0.5)
    if sink is not None:
        sk = jnp.broadcast_to(sink.reshape(G, R, 1, 1).astype(jnp.float32), s.shape[:-1] + (1,))
        s = jnp.concatenate([s, sk], axis=-1)
    p = jax.nn.softmax(s, axis=-1)[..., :L].astype(v.dtype)
    return jnp.einsum('bgrlm,bmgd->blgrd', p, v).reshape(B, L, H * D)


def window_gqa_latent(q, k, v, kc, vc, sink):
    B, N = q.shape[:2]
    L = kc.shape[1]
    nb = N // A_BLOCK
    G, R = A_KV_HEADS, A_HEADS // A_KV_HEADS
    scale = HEAD_DIM ** -0.5
    qb = q.reshape(B, nb, A_BLOCK, G, R, HEAD_DIM)

    def band(t):
        tp = jnp.pad(t, ((0, 0), (A_BLOCK, A_BLOCK), (0, 0), (0, 0))).reshape(B, nb + 2, A_BLOCK, G, HEAD_DIM)
        return jnp.concatenate([tp[:, :-2], tp[:, 1:-1], tp[:, 2:]], axis=2)

    kb, vb = band(k), band(v)
    nk = 3 * A_BLOCK
    qpos = jnp.arange(nb)[:, None] * A_BLOCK + jnp.arange(A_BLOCK)[None, :]
    kpos = jnp.arange(nb)[:, None] * A_BLOCK - A_BLOCK + jnp.arange(nk)[None, :]
    valid = ((jnp.abs(qpos[:, :, None] - kpos[:, None, :]) <= A_WINDOW)
             & (kpos[:, None, :] >= 0) & (kpos[:, None, :] < N))
    s_loc = jnp.einsum('bnqgrd,bnkgd->bgrnqk', qb, kb).astype(jnp.float32) * scale
    s_loc = jnp.where(valid, s_loc, NEG_INF)
    s_ctx = jnp.einsum('bnqgrd,blgd->bgrnql', qb, kc).astype(jnp.float32) * scale
    sk = jnp.broadcast_to(sink.reshape(G, R, 1, 1, 1).astype(jnp.float32), s_loc.shape[:-1] + (1,))
    p = jax.nn.softmax(jnp.concatenate([s_loc, s_ctx, sk], axis=-1), axis=-1).astype(v.dtype)
    o = (jnp.einsum('bgrnqk,bnkgd->bnqgrd', p[..., :nk], vb)
         + jnp.einsum('bgrnql,blgd->bnqgrd', p[..., nk:nk + L], vc))
    return o.reshape(B, N, A_HEADS * HEAD_DIM)


def na_column_tables():
    n_cb = GRID_W // NA_COL_BLOCK
    band0 = np.clip(np.arange(n_cb) * NA_COL_BLOCK - NA_COLS // 2, 0, GRID_W - NA_BAND)
    kcol = band0[:, None] + np.arange(NA_BAND)[None, :]
    qcol = np.arange(n_cb)[:, None] * NA_COL_BLOCK + np.arange(NA_COL_BLOCK)[None, :]
    cstart = np.clip(qcol - NA_COLS // 2, 0, GRID_W - NA_COLS)
    valid = (kcol[:, None, :] >= cstart[:, :, None]) & (kcol[:, None, :] < cstart[:, :, None] + NA_COLS)
    dc = np.clip(kcol[:, None, :] - qcol[:, :, None], -(NA_COLS - 1), NA_COLS - 1) + NA_COLS - 1
    return jnp.asarray(kcol), jnp.asarray(valid), jnp.asarray(dc)


def neighborhood_latent(q, k, v, kc, vc, rpb):
    B, N = q.shape[:2]
    rows = N // GRID_W
    kr = min(NA_ROWS, rows)
    n_cb = GRID_W // NA_COL_BLOCK
    H, D = B_HEADS, HEAD_DIM
    scale = D ** -0.5
    kcol, valid, dc = na_column_tables()
    qg = q.reshape(B, rows, GRID_W, H, D)
    kg = k.reshape(B, rows, GRID_W, H, D)
    vg = v.reshape(B, rows, GRID_W, H, D)
    nloc = kr * NA_BAND

    def row_step(r):
        rs = jnp.clip(r - kr // 2, 0, rows - kr)
        kw = lax.dynamic_slice_in_dim(kg, rs, kr, axis=1)[:, :, kcol]
        vw = lax.dynamic_slice_in_dim(vg, rs, kr, axis=1)[:, :, kcol]
        qr = lax.dynamic_index_in_dim(qg, r, axis=1, keepdims=False).reshape(B, n_cb, NA_COL_BLOCK, H, D)
        s = jnp.einsum('bnqhd,bknjhd->bhnqkj', qr, kw).astype(jnp.float32) * scale
        dr = rs + jnp.arange(kr) - r + NA_ROWS - 1
        bias = rpb[:, dr[None, None, :, None], dc[:, :, None, :]].astype(jnp.float32)
        s = jnp.where(valid[:, :, None, :], s + bias, NEG_INF)
        s_c = jnp.einsum('bnqhd,blhd->bhnql', qr, kc).astype(jnp.float32) * scale
        logits = jnp.concatenate([s.reshape(B, H, n_cb, NA_COL_BLOCK, nloc), s_c], axis=-1)
        p = jax.nn.softmax(logits, axis=-1).astype(v.dtype)
        p_loc = p[..., :nloc].reshape(B, H, n_cb, NA_COL_BLOCK, kr, NA_BAND)
        o = (jnp.einsum('bhnqkj,bknjhd->bnqhd', p_loc, vw)
             + jnp.einsum('bhnql,blhd->bnqhd', p[..., nloc:], vc))
        return o.reshape(B, GRID_W, H * D)

    o = lax.map(row_step, jnp.arange(rows, dtype=jnp.int32))
    return jnp.moveaxis(o, 0, 1).reshape(B, N, H * D)


def diff_lambda(lam, lam_init):
    lf = lam.astype(jnp.float32)
    return jnp.exp(jnp.sum(lf[0] * lf[1])) - jnp.exp(jnp.sum(lf[2] * lf[3])) + lam_init


def diff_attention_block(qb, k, v, lam):
    s = jnp.einsum('bqhmd,bkhmd->bhmqk', qb, k).astype(jnp.float32) * (HEAD_DIM ** -0.5)
    p = jax.nn.softmax(s, axis=-1)
    a = (p[:, :, 0] - lam * p[:, :, 1]).astype(v.dtype)
    return jnp.einsum('bhqk,bkhd->bqhd', a, v)


def diff_attention_latent(q, k, v, kc, vc, lam):
    B, N = q.shape[:2]
    nb = N // C_BLOCK
    kall = jnp.concatenate([k, kc], axis=1)
    vall = jnp.concatenate([v, vc], axis=1)
    qb = jnp.moveaxis(q.reshape(B, nb, C_BLOCK, C_HEADS, 2, HEAD_DIM), 1, 0)
    o = lax.map(lambda t: diff_attention_block(t, kall, vall, lam), qb)
    return jnp.moveaxis(o, 0, 1).reshape(B, N, C_HEADS, C_VDIM)


def diff_head_norm(o, g, lam_init):
    B, n = o.shape[:2]
    y = rms_norm(o, g.reshape(C_HEADS, C_VDIM)) * (1.0 - lam_init)
    return y.reshape(B, n, C_V_W)


def merge_branches(hd, ya, yb, yc, wa, wb, wc, wo):
    m = (jax.nn.sigmoid(hd["ga"]) * (ya @ wa) + jax.nn.sigmoid(hd["gb"]) * (yb @ wb)
         + jax.nn.sigmoid(hd["gc"]) * (yc @ wc))
    return m @ wo


def peer_ffn(h, wq, keys, u, v):
    shp = h.shape
    t = h.reshape(-1, PEER_CHUNK, shp[-1])

    def chunk(tc):
        q = (tc @ wq).reshape(PEER_CHUNK, PEER_HEADS, 2, PEER_QDIM // 2)
        s = jnp.einsum('thpd,hpkd->thpk', q, keys).astype(jnp.float32)
        sv, si = lax.top_k(s, PEER_TOPK)
        cand_s = (sv[:, :, 0, :, None] + sv[:, :, 1, None, :]).reshape(PEER_CHUNK, PEER_HEADS, PEER_TOPK * PEER_TOPK)
        cand_i = (si[:, :, 0, :, None] * PEER_KEYS + si[:, :, 1, None, :]).reshape(PEER_CHUNK, PEER_HEADS, PEER_TOPK * PEER_TOPK)
        top_s, pos = lax.top_k(cand_s, PEER_TOPK)
        e = jnp.take_along_axis(cand_i, pos, axis=-1)
        g = jax.nn.softmax(top_s, axis=-1)
        act = jax.nn.gelu(jnp.einsum('thkd,td->thk', u[e], tc).astype(jnp.float32), approximate=False)
        return jnp.einsum('thk,thkd->td', (g * act).astype(tc.dtype), v[e])

    return lax.map(chunk, t).reshape(shp)


def setup_inputs(seed: int = 0) -> dict:
    key = jax.random.key(seed)
    ks = jax.random.split(key, 24)
    D = D_MODEL

    def nrm(k, shape, s):
        return jax.random.normal(k, shape, jnp.float32) * s

    return {
        "x": nrm(ks[0], (BATCH, SEQ, D), 1.0),
        "c": nrm(ks[1], (BATCH, D), 1.0),
        "ctx": nrm(ks[2], (BATCH, CTX_LEN, D), 1.0),
        "c_ctx": nrm(ks[3], (D,), 1.0),
        "w_mod": nrm(ks[4], (DEPTH, D, 6 * D), 0.5 * D ** -0.5),
        "b_mod": nrm(ks[5], (DEPTH, 6 * D), 0.01),
        "g_norm1": 1.0 + nrm(ks[6], (DEPTH, D), 0.05),
        "g_norm2": 1.0 + nrm(ks[7], (DEPTH, D), 0.05),
        "w_in": nrm(ks[8], (DEPTH, D, IN_W), D ** -0.5),
        "a_sink": nrm(ks[9], (DEPTH, A_HEADS), 0.5),
        "b_rpb": nrm(ks[10], (DEPTH, B_HEADS, 2 * NA_ROWS - 1, 2 * NA_COLS - 1), 0.1),
        "c_lambda": nrm(ks[11], (DEPTH, 4, HEAD_DIM), 0.1),
        "c_subln": 1.0 + nrm(ks[12], (DEPTH, C_V_W), 0.05),
        "w_branch_a": nrm(ks[13], (DEPTH, A_Q_W, D), A_Q_W ** -0.5),
        "w_branch_b": nrm(ks[14], (DEPTH, B_W, D), B_W ** -0.5),
        "w_branch_c": nrm(ks[15], (DEPTH, C_V_W, D), C_V_W ** -0.5),
        "w_out": nrm(ks[16], (DEPTH, D, D), D ** -0.5),
        "peer_wq": nrm(ks[17], (DEPTH, D, PEER_HEADS * PEER_QDIM), D ** -0.5),
        "peer_keys": nrm(ks[18], (DEPTH, PEER_HEADS, 2, PEER_KEYS, PEER_QDIM // 2), (PEER_QDIM // 2) ** -0.5),
        "peer_u": nrm(ks[19], (DEPTH, N_EXPERTS, D), D ** -0.5),
        "peer_v": nrm(ks[20], (DEPTH, N_EXPERTS, D), PEER_HEADS ** -0.5),
        "g_final": 1.0 + nrm(ks[21], (D,), 0.05),
    }


def reference(x, c, ctx, c_ctx, w_mod, b_mod, g_norm1, g_norm2, w_in, a_sink, b_rpb, c_lambda,
              c_subln, w_branch_a, w_branch_b, w_branch_c, w_out, peer_wq, peer_keys, peer_u,
              peer_v, g_final):
    N = x.shape[1]
    rope = axial_rope(N)
    xc = ctx
    for l in range(DEPTH):
        last = l == DEPTH - 1
        lam_init = 0.8 - 0.6 * math.exp(-0.3 * l)
        lam = diff_lambda(c_lambda[l], lam_init)
        mod = (jax.nn.silu(c) @ w_mod[l] + b_mod[l])[:, None, :]
        mod_c = jax.nn.silu(c_ctx) @ w_mod[l] + b_mod[l]
        sh1, sc1, gt1, sh2, sc2, gt2 = jnp.split(mod, 6, axis=-1)
        sh1c, sc1c, gt1c, sh2c, sc2c, gt2c = jnp.split(mod_c, 6, axis=-1)

        h = rms_norm(x, g_norm1[l]) * (1.0 + sc1) + sh1
        hc = rms_norm(xc, g_norm1[l]) * (1.0 + sc1c) + sh1c
        lat = project_heads(h, w_in[l], rope)
        con = project_heads(hc, w_in[l], None)
        ya = window_gqa_latent(lat["aq"], lat["ak"], lat["av"], con["ak"], con["av"], a_sink[l])
        yb = neighborhood_latent(lat["bq"], lat["bk"], lat["bv"], con["bk"], con["bv"], b_rpb[l])
        yc = diff_head_norm(diff_attention_latent(lat["cq"], lat["ck"], lat["cv"], con["ck"], con["cv"], lam),
                            c_subln[l], lam_init)
        x = x + gt1 * merge_branches(lat, ya, yb, yc, w_branch_a[l], w_branch_b[l], w_branch_c[l], w_out[l])

        h2 = rms_norm(x, g_norm2[l]) * (1.0 + sc2) + sh2
        x = x + gt2 * peer_ffn(h2, peer_wq[l], peer_keys[l], peer_u[l], peer_v[l])

        if not last:
            ya_c = context_attention(con["aq"], con["ak"], con["av"], a_sink[l])
            yb_c = context_attention(con["bq"], con["bk"], con["bv"])
            yc_c = diff_head_norm(diff_attention_block(con["cq"], con["ck"], con["cv"], lam), c_subln[l], lam_init)
            xc = xc + gt1c * merge_branches(con, ya_c, yb_c, yc_c, w_branch_a[l], w_branch_b[l], w_branch_c[l], w_out[l])
            h2c = rms_norm(xc, g_norm2[l]) * (1.0 + sc2c) + sh2c
            xc = xc + gt2c * peer_ffn(h2c, peer_wq[l], peer_keys[l], peer_u[l], peer_v[l])
    return rms_norm(x, g_final)
```

```cpp
#include <hip/hip_runtime.h>
#include <cstdio>
#include <cstdint>

#define GAS __attribute__((address_space(1)))
#define LAS __attribute__((address_space(3)))
typedef unsigned short bf16;
typedef float f32x4 __attribute__((ext_vector_type(4)));
typedef short bf16x8 __attribute__((ext_vector_type(8)));
typedef unsigned v4u __attribute__((ext_vector_type(4)));
typedef unsigned v2u __attribute__((ext_vector_type(2)));
typedef GAS unsigned gu32;

constexpr int NWAVES = 8, NTHREADS = 512;
constexpr int D = 1024, BATCH = 2, SEQ = 8192, DEPTH = 2, GRID_W = 64, CTX = 256;
constexpr int T_LAT = BATCH * SEQ;
constexpr int T_ALL = T_LAT + BATCH * CTX;
constexpr int NTOK = SEQ + CTX;
constexpr int IN_W = 6912;
constexpr int PEER_HEADS = 8, PEER_KEYS = 128, PEER_TOPK = 16, NSEL = PEER_HEADS * PEER_TOPK;
constexpr float NORM_EPS = 1e-6f;
constexpr float LOG2E = 1.4426950408889634f;
constexpr float SCL2 = 0.125f * LOG2E;

constexpr size_t MiB = 1u << 20;
constexpr size_t WS_CTL = 0, CTL_ZERO_BYTES = 1 * MiB;
constexpr int CW_BAR = 4096;
constexpr size_t WS_MOD = 65536;
constexpr size_t WS_COS = 2 * MiB, WS_SIN = 3 * MiB;
constexpr size_t WS_WIN = 4 * MiB;
constexpr size_t WS_WB = 31 * MiB;
constexpr size_t WS_WO = 37 * MiB;
constexpr size_t WS_WQ = 41 * MiB;
constexpr size_t WS_KEYS = 49 * MiB;
constexpr size_t WS_X = 50 * MiB;
constexpr size_t WS_H = 116 * MiB;
constexpr size_t WS_Y = 149 * MiB;
constexpr size_t WS_MG = 199 * MiB;
constexpr size_t WS_EI = 232 * MiB;
constexpr size_t WS_EG = 241 * MiB;
constexpr size_t WS_P = 250 * MiB;
constexpr size_t SZ_R512 = (size_t)T_ALL * 512 * 2;
constexpr size_t SZ_R128 = (size_t)T_ALL * 128 * 2;
constexpr size_t WS_AQ = WS_P, WS_AK = WS_AQ + SZ_R512, WS_AVT = WS_AK + SZ_R128, WS_BQ = WS_AVT + SZ_R128, WS_BK = WS_BQ + SZ_R512,
                 WS_BVT = WS_BK + SZ_R512, WS_CQ = WS_BVT + SZ_R512, WS_CK = WS_CQ + SZ_R512, WS_CVT = WS_CK + SZ_R512, WS_SG = WS_CVT + SZ_R512;
constexpr size_t WS_Q2 = WS_P;
constexpr size_t WS_SC = WS_P + 66 * MiB;
constexpr size_t WS_END = WS_SG + (size_t)T_ALL * 3072 * 2;
static_assert(WS_SC + (size_t)T_ALL * 2048 * 4 <= WS_END, "alias map");
static_assert(WS_END <= 480 * MiB, "ws map");

constexpr int LDS_BYTES = 147456;
constexpr int MISC_OFF = 131072 + 320;

#define XB_TMO      128
#define XB_XCNT(j)  (256  + 64 * (j))
#define XB_XSUB(j)  (1280 + 64 * (j))
#define XB_XGEN(j)  (2304 + 64 * (j))
#define XB_TOP      3328
#define XB_TOPGEN   3392
#define XCD_BAR_WORDS 3456
#define XB_SPIN_CAP (1u << 24)

__device__ __forceinline__ unsigned xb_ld(unsigned* p)              { return __hip_atomic_load(p, __ATOMIC_RELAXED, __HIP_MEMORY_SCOPE_AGENT); }
__device__ __forceinline__ unsigned xb_add(unsigned* p, unsigned v) { return __hip_atomic_fetch_add(p, v, __ATOMIC_RELAXED, __HIP_MEMORY_SCOPE_AGENT); }
__device__ __forceinline__ unsigned xb_xcc_id() { return (unsigned)__builtin_amdgcn_s_getreg((3 << 11) | 20) & 0xFu; }
#define XB_SPIN(cond, bar) do { unsigned _sp = 0; while (cond) { __builtin_amdgcn_s_sleep(1); \
    if ((++_sp & 255u) == 0u) { if (xb_ld(&(bar)[XB_TMO])) break; if (_sp > XB_SPIN_CAP) { atomicAdd(&(bar)[XB_TMO], 1u); break; } } } } while (0)

struct XcdBarrier { unsigned* bar; unsigned x; volatile LAS unsigned* st; };

__device__ __forceinline__ XcdBarrier xcd_barrier_post(unsigned* bar, volatile LAS unsigned* st) {
    XcdBarrier b; b.bar = bar; b.x = xb_xcc_id(); b.st = st;
    if (threadIdx.x == 0) (void)xb_add(&bar[XB_XCNT(b.x)], 1u);
    return b;
}
__device__ __forceinline__ void xcd_barrier_complete(unsigned* bar, unsigned x, unsigned& nloc, unsigned& nx) {
    const unsigned G = gridDim.x * gridDim.y * gridDim.z;
    unsigned sum, cnt, mine, sp = 0u;
    for (;;) {
        sum = 0u; cnt = 0u; mine = 0u;
#pragma unroll
        for (unsigned j = 0; j < 16; ++j) { const unsigned c = xb_ld(&bar[XB_XCNT(j)]); sum += c; cnt += (c > 0u) ? 1u : 0u; mine = (j == x) ? c : mine; }
        if (sum == G) break;
        __builtin_amdgcn_s_sleep(1);
        if ((++sp & 255u) == 0u) { if (xb_ld(&bar[XB_TMO])) break; if (sp > XB_SPIN_CAP) { atomicAdd(&bar[XB_TMO], 1u); break; } }
    }
    nloc = mine > 0u ? mine : 1u; nx = cnt > 0u ? cnt : 1u;
}
__device__ __forceinline__ void xcd_barrier(const XcdBarrier& b) {
    asm volatile("s_waitcnt vmcnt(0)" ::: "memory");
    __syncthreads();
    if (threadIdx.x == 0) {
        unsigned* bar = b.bar;
        __builtin_amdgcn_s_waitcnt(0);
        unsigned nloc = b.st[0], nx = b.st[1];
        if (nloc == 0u) { xcd_barrier_complete(bar, b.x, nloc, nx); b.st[0] = nloc; b.st[1] = nx; }
        const unsigned old = xb_add(&bar[XB_XSUB(b.x)], 1u);
        const unsigned gen = old / nloc;
        if (old + 1u == (gen + 1u) * nloc) {
            __builtin_amdgcn_fence(__ATOMIC_RELEASE, "agent");
            asm volatile("s_waitcnt vmcnt(0)" ::: "memory");
            const unsigned og = xb_add(&bar[XB_TOP], 1u);
            const unsigned tg = og / nx;
            if (og + 1u == (tg + 1u) * nx) xb_add(&bar[XB_TOPGEN], 1u);
            else XB_SPIN(xb_ld(&bar[XB_TOPGEN]) == tg, bar);
            __builtin_amdgcn_fence(__ATOMIC_ACQUIRE, "agent");
            xb_add(&bar[XB_XGEN(b.x)], 1u);
            asm volatile("s_waitcnt vmcnt(0)" ::: "memory");
        } else {
            XB_SPIN(xb_ld(&bar[XB_XGEN(b.x)]) == gen, bar);
            __builtin_amdgcn_fence(__ATOMIC_ACQUIRE, "agent");
            asm volatile("s_waitcnt vmcnt(0)" ::: "memory");
        }
    }
    __syncthreads();
}

__device__ __forceinline__ unsigned f2bf(float f) { unsigned u = __builtin_bit_cast(unsigned, f); return (u + 0x7fffu + ((u >> 16) & 1u)) >> 16; }
__device__ __forceinline__ unsigned pk2(float lo, float hi) { return f2bf(lo) | (f2bf(hi) << 16); }
__device__ __forceinline__ float bf2f(unsigned h) { return __builtin_bit_cast(float, h << 16); }
__device__ __forceinline__ float wave_sum(float v) {
#pragma unroll
    for (int o = 1; o < 64; o <<= 1) v += __shfl_xor(v, o);
    return v;
}
__device__ __forceinline__ float grp16_sum(float v) { v += __shfl_xor(v, 1); v += __shfl_xor(v, 2); v += __shfl_xor(v, 4); v += __shfl_xor(v, 8); return v; }
__device__ __forceinline__ float grp16_max(float v) { v = fmaxf(v, __shfl_xor(v, 1)); v = fmaxf(v, __shfl_xor(v, 2)); v = fmaxf(v, __shfl_xor(v, 4)); v = fmaxf(v, __shfl_xor(v, 8)); return v; }
__device__ __forceinline__ float sigmoidf_(float x) { return 1.0f / (1.0f + __expf(-x)); }
__device__ __forceinline__ int row_modidx(int r) { return r < T_LAT ? (r >> 13) : 2; }
__device__ __forceinline__ int row_batch(int r) { return r < T_LAT ? (r >> 13) : ((r - T_LAT) >> 8); }
__device__ __forceinline__ int row_tok(int r) { return r < T_LAT ? (r & (SEQ - 1)) : SEQ + ((r - T_LAT) & (CTX - 1)); }

struct Args { const float* in[22]; float* out; unsigned char* ws; };
enum { I_X = 0, I_C, I_CTX, I_CCTX, I_WMOD, I_BMOD, I_G1, I_G2, I_WIN, I_SINK, I_RPB, I_LAMBDA, I_SUBLN, I_WBA, I_WBB, I_WBC, I_WOUT, I_PWQ, I_PKEYS, I_PU, I_PV, I_GFINAL };

__device__ __forceinline__ void p0_transpose_item(const float* W, int K, int N, bf16* WT, LAS float* scr, int item, int lane) {
    const int nblk = N / 32, kb = item / nblk, nb = item % nblk, k0 = 64 * kb, n0 = 32 * nb;
#pragma unroll 8
    for (int i = 0; i < 32; ++i) { const int kk = 2 * i + (lane >> 5); scr[kk * 33 + (lane & 31)] = W[(size_t)(k0 + kk) * N + n0 + (lane & 31)]; }
    asm volatile("s_waitcnt lgkmcnt(0)" ::: "memory");
    const int c = lane & 7;
#pragma unroll
    for (int j = 0; j < 4; ++j) { const int n = (lane >> 3) + 8 * j; const LAS float* s = scr + (8 * c) * 33 + n;
        v4u o; o.x = pk2(s[0 * 33], s[1 * 33]); o.y = pk2(s[2 * 33], s[3 * 33]); o.z = pk2(s[4 * 33], s[5 * 33]); o.w = pk2(s[6 * 33], s[7 * 33]);
        *(GAS v4u*)(WT + (size_t)(n0 + n) * K + k0 + 8 * c) = o; }
    asm volatile("s_waitcnt lgkmcnt(0)" ::: "memory");
}

template <int UNR = 2, int NN = 4>
__device__ __forceinline__ void sgemm_tile(f32x4 (&acc)[4][NN], const bf16* A, int lda, const bf16* Bt, int ldb, int K, int row0, int col0, int lane) {
    const int fr = lane & 15, fq = lane >> 4;
    const bf16* ap = A + (size_t)(row0 + fr) * lda + fq * 8;
    const bf16* bp = Bt + (size_t)(col0 + fr) * ldb + fq * 8;
#pragma unroll UNR
    for (int k = 0; k < K; k += 32) {
        bf16x8 a[4], b[NN];
#pragma unroll
        for (int m = 0; m < 4; ++m) a[m] = *(const GAS bf16x8*)(ap + (size_t)m * 16 * lda + k);
#pragma unroll
        for (int n = 0; n < NN; ++n) b[n] = *(const GAS bf16x8*)(bp + (size_t)n * 16 * ldb + k);
#pragma unroll
        for (int m = 0; m < 4; ++m)
#pragma unroll
            for (int n = 0; n < NN; ++n) acc[m][n] = __builtin_amdgcn_mfma_f32_16x16x32_bf16(a[m], b[n], acc[m][n], 0, 0, 0);
    }
}
template <int NN>
__device__ __forceinline__ void zero_acc(f32x4 (&acc)[4][NN]) {
#pragma unroll
    for (int m = 0; m < 4; ++m)
#pragma unroll
        for (int n = 0; n < NN; ++n) acc[m][n] = (f32x4){0.f, 0.f, 0.f, 0.f};
}

template <int NDT> struct AttnAcc { f32x4 o[NDT]; float m[4], l[4]; };

__device__ __forceinline__ f32x4 s_tile(const bf16x8 (&qf)[2], const bf16* Kb, int kpitch, int khoff, int krow, int fr, int fq) {
    const bf16* kp = Kb + (size_t)(krow + fr) * kpitch + khoff + fq * 8;
    const bf16x8 k0 = *(const GAS bf16x8*)kp, k1 = *(const GAS bf16x8*)(kp + 32);
    f32x4 s = (f32x4){0.f, 0.f, 0.f, 0.f};
    s = __builtin_amdgcn_mfma_f32_16x16x32_bf16(qf[0], k0, s, 0, 0, 0);
    s = __builtin_amdgcn_mfma_f32_16x16x32_bf16(qf[1], k1, s, 0, 0, 0);
    return s;
}
template <int NT, int NDT, int PSTR>
__device__ __forceinline__ void softmax_update(AttnAcc<NDT>& st, f32x4 (&s)[NT], LAS bf16* Pl, int fr, int fq) {
#pragma unroll
    for (int r = 0; r < 4; ++r) {
        float mx = s[0][r];
#pragma unroll
        for (int t = 1; t < NT; ++t) mx = fmaxf(mx, s[t][r]);
        mx = grp16_max(mx);
        const float mn = fmaxf(st.m[r], mx);
        const float alpha = __builtin_amdgcn_exp2f(st.m[r] - mn);
        st.m[r] = mn;
        float ls = st.l[r] * alpha;
#pragma unroll
        for (int dt = 0; dt < NDT; ++dt) st.o[dt][r] *= alpha;
#pragma unroll
        for (int t = 0; t < NT; ++t) {
            const float p = (s[t][r] > -1e29f) ? __builtin_amdgcn_exp2f(s[t][r] - mn) : 0.f;
            ls += p;
            Pl[(4 * fq + r) * PSTR + t * 16 + fr] = (bf16)f2bf(p);
        }
        st.l[r] = ls;
    }
}
template <int NKS, int NDT, int PSTR>
__device__ __forceinline__ void pv_update(AttnAcc<NDT>& st, const LAS bf16* Pl, const bf16* Vt, int tok0, int fr, int fq) {
    asm volatile("s_waitcnt lgkmcnt(0)" ::: "memory");
    __builtin_amdgcn_wave_barrier();
#pragma unroll
    for (int ks = 0; ks < NKS; ++ks) {
        const bf16x8 pf = *(const LAS bf16x8*)(Pl + fr * PSTR + ks * 32 + fq * 8);
#pragma unroll
        for (int dt = 0; dt < NDT; ++dt) {
            const bf16x8 vf = *(const GAS bf16x8*)(Vt + (size_t)(dt * 16 + fr) * NTOK + tok0 + ks * 32 + fq * 8);
            st.o[dt] = __builtin_amdgcn_mfma_f32_16x16x32_bf16(pf, vf, st.o[dt], 0, 0, 0);
        }
    }
    asm volatile("s_waitcnt lgkmcnt(0)" ::: "memory");
    __builtin_amdgcn_wave_barrier();
}

__device__ __forceinline__ int f2ord(float f) { const int b = __builtin_bit_cast(int, f); return b ^ ((b >> 31) & 0x7fffffff); }
__device__ __forceinline__ float ord2f(int o) { const int b = o ^ ((o >> 31) & 0x7fffffff); return __builtin_bit_cast(float, b); }
__device__ __forceinline__ void top16_insert(int (&top)[16], int key) {
#pragma unroll
    for (int i = 0; i < 16; ++i) { const int hi = max(top[i], key); key = min(top[i], key); top[i] = hi; }
}

__global__ void __launch_bounds__(NTHREADS, 2) mega_fwd(Args args) {
    extern __shared__ __attribute__((aligned(16))) unsigned char lds[];
    LAS unsigned char* L = (LAS unsigned char*)lds;
    volatile LAS unsigned* MISC = (volatile LAS unsigned*)(L + MISC_OFF);
    const int tid = threadIdx.x, lane = tid & 63, wave = __builtin_amdgcn_readfirstlane(tid >> 6);
    const int fr = lane & 15, fq = lane >> 4;
    const int G = gridDim.x;
    const int vcu = (G % 8 == 0) ? (int)(blockIdx.x % 8) * (G / 8) + (int)(blockIdx.x / 8) : (int)blockIdx.x;
    for (int u = tid; u < (LDS_BYTES - 131072) / 4; u += NTHREADS) ((LAS unsigned*)(L + 131072))[u] = 0u;
    __syncthreads();
    unsigned char* ws = args.ws;
    gu32* ctl = (gu32*)(ws + WS_CTL);
    XcdBarrier bar = xcd_barrier_post((unsigned*)(ctl + CW_BAR), MISC + 8);
    const int gw = vcu * NWAVES + wave, NGW = G * NWAVES;
    const int gt = vcu * NTHREADS + tid, NGT = G * NTHREADS;

    float* MODV = (float*)(ws + WS_MOD);
    float* COS = (float*)(ws + WS_COS); float* SIN = (float*)(ws + WS_SIN);
    bf16* WIN = (bf16*)(ws + WS_WIN); bf16* WB = (bf16*)(ws + WS_WB); bf16* WO = (bf16*)(ws + WS_WO); bf16* WQ = (bf16*)(ws + WS_WQ); bf16* KEYS = (bf16*)(ws + WS_KEYS);
    float* X = (float*)(ws + WS_X); bf16* H = (bf16*)(ws + WS_H); bf16* Y = (bf16*)(ws + WS_Y); bf16* MG = (bf16*)(ws + WS_MG);
    int* EI = (int*)(ws + WS_EI); float* EG = (float*)(ws + WS_EG);
    bf16* AQ = (bf16*)(ws + WS_AQ); bf16* AK = (bf16*)(ws + WS_AK); bf16* AVT = (bf16*)(ws + WS_AVT);
    bf16* BQ = (bf16*)(ws + WS_BQ); bf16* BK = (bf16*)(ws + WS_BK); bf16* BVT = (bf16*)(ws + WS_BVT);
    bf16* CQ = (bf16*)(ws + WS_CQ); bf16* CK = (bf16*)(ws + WS_CK); bf16* CVT = (bf16*)(ws + WS_CVT);
    bf16* SG = (bf16*)(ws + WS_SG); bf16* Q2 = (bf16*)(ws + WS_Q2); float* SC = (float*)(ws + WS_SC);

#ifndef SKIP_P0
    {
        LAS float* scr = (LAS float*)(L + wave * 16384);
        constexpr int I_IN = (D / 64) * (IN_W / 32), I_BR = (512 / 64) * (D / 32), I_O = (D / 64) * (D / 32), I_Q = (D / 64) * (2048 / 32);
        constexpr int PER_LAYER = I_IN + 3 * I_BR + I_O + I_Q;
        for (int it = gw; it < DEPTH * PER_LAYER; it += NGW) {
            const int l = it / PER_LAYER; int r = it % PER_LAYER;
            if (r < I_IN) { p0_transpose_item(args.in[I_WIN] + (size_t)l * D * IN_W, D, IN_W, WIN + (size_t)l * IN_W * D, scr, r, lane); continue; } r -= I_IN;
            if (r < I_BR) { p0_transpose_item(args.in[I_WBA] + (size_t)l * 512 * D, 512, D, WB + (size_t)(l * 3 + 0) * D * 512, scr, r, lane); continue; } r -= I_BR;
            if (r < I_BR) { p0_transpose_item(args.in[I_WBB] + (size_t)l * 512 * D, 512, D, WB + (size_t)(l * 3 + 1) * D * 512, scr, r, lane); continue; } r -= I_BR;
            if (r < I_BR) { p0_transpose_item(args.in[I_WBC] + (size_t)l * 512 * D, 512, D, WB + (size_t)(l * 3 + 2) * D * 512, scr, r, lane); continue; } r -= I_BR;
            if (r < I_O) { p0_transpose_item(args.in[I_WOUT] + (size_t)l * D * D, D, D, WO + (size_t)l * D * D, scr, r, lane); continue; } r -= I_O;
            p0_transpose_item(args.in[I_PWQ] + (size_t)l * D * 2048, D, 2048, WQ + (size_t)l * 2048 * D, scr, r, lane);
        }
        for (int i = gt; i < DEPTH * 16 * 128 * 128 / 4; i += NGT) {
            const f32x4 v = *((const GAS f32x4*)args.in[I_PKEYS] + i);
            v2u o; o.x = pk2(v.x, v.y); o.y = pk2(v.z, v.w); *((GAS v2u*)KEYS + i) = o;
        }
        for (int i = gt; i < T_ALL * D / 4; i += NGT) {
            const f32x4 v = (i < T_LAT * D / 4) ? *((const GAS f32x4*)args.in[I_X] + i) : *((const GAS f32x4*)args.in[I_CTX] + (i - T_LAT * D / 4));
            *((GAS f32x4*)X + i) = v;
        }
        {
            LAS float* red = (LAS float*)(L + 9216);
            for (int it = vcu; it < DEPTH * 96; it += G) {
                const int l = it / 96, nc = it % 96, n = nc * 64 + lane;
                const float* wm = args.in[I_WMOD] + (size_t)l * D * 6 * D + n;
                float a0 = 0.f, a1 = 0.f, a2 = 0.f;
#pragma unroll 8
                for (int k = wave * 128; k < wave * 128 + 128; ++k) {
                    const float c0 = args.in[I_C][k], c1 = args.in[I_C][D + k], c2 = args.in[I_CCTX][k];
                    const float w = wm[(size_t)k * 6 * D];
                    a0 += c0 * sigmoidf_(c0) * w; a1 += c1 * sigmoidf_(c1) * w; a2 += c2 * sigmoidf_(c2) * w;
                }
                red[(wave * 3 + 0) * 64 + lane] = a0; red[(wave * 3 + 1) * 64 + lane] = a1; red[(wave * 3 + 2) * 64 + lane] = a2;
                __syncthreads();
                if (wave < 3) {
                    float sum = args.in[I_BMOD][l * 6 * D + n];
#pragma unroll
                    for (int w = 0; w < 8; ++w) sum += red[(w * 3 + wave) * 64 + lane];
                    MODV[(size_t)(l * 3 + wave) * 6 * D + n] = sum;
                }
                __syncthreads();
            }
        }
        for (int i = gt; i < SEQ * 32; i += NGT) {
            const int t = i >> 5, f = i & 31;
            const double inv = pow(10000.0, -(double)(f & 15) / 16.0);
            const double pos = (f < 16) ? (double)(t / GRID_W) : (double)(t % GRID_W);
            const double ang = pos * inv;
            COS[i] = (float)cos(ang); SIN[i] = (float)sin(ang);
        }
    }
#endif
    xcd_barrier(bar);

    for (int layer = 0; layer < DEPTH; ++layer) {
        const bool last = (layer == DEPTH - 1);
        const int T_EFF = last ? T_LAT : T_ALL;
        const float* modl = MODV + (size_t)layer * 3 * 6 * D;
        const bf16* WINl = WIN + (size_t)layer * IN_W * D;

#ifndef SKIP_P1
        { int ln = lane; asm volatile("" : "+v"(ln));
        for (int r = gw; r < T_ALL; r += NGW) {
            const float* md = modl + (size_t)row_modidx(r) * 6 * D;
            const GAS f32x4* xr = (const GAS f32x4*)(X + (size_t)r * D) + ln;
            f32x4 v[4]; float ss = 0.f;
#pragma unroll
            for (int j = 0; j < 4; ++j) { v[j] = xr[64 * j]; ss += (v[j].x * v[j].x + v[j].y * v[j].y) + (v[j].z * v[j].z + v[j].w * v[j].w); }
            const float rs = 1.0f / sqrtf(wave_sum(ss) * (1.f / D) + NORM_EPS);
            GAS v2u* o8 = (GAS v2u*)(H + (size_t)r * D) + ln;
#pragma unroll
            for (int j = 0; j < 4; ++j) {
                const f32x4 g = *((const GAS f32x4*)(args.in[I_G1] + layer * D) + ln + 64 * j);
                const f32x4 sh = *((const GAS f32x4*)(md + 0) + ln + 64 * j), sc = *((const GAS f32x4*)(md + D) + ln + 64 * j);
                const f32x4 h = v[j] * rs * g * (sc + 1.0f) + sh;
                v2u o; o.x = pk2(h.x, h.y); o.y = pk2(h.z, h.w); o8[64 * j] = o;
            }
        }
        }
#endif
        xcd_barrier(bar);

#ifndef SKIP_P2
        {
            constexpr int NMT = T_ALL / 256, NNT = IN_W / 128;
            const int wr = wave >> 1, wc = wave & 1;
            for (int it = vcu; it < NMT * NNT; it += G) {
                const int pm = it / NNT, pn = it % NNT;
                const int row0 = pm * 256 + wr * 64, col0 = pn * 128 + wc * 64;
                f32x4 acc[4][4]; zero_acc<4>(acc);
                sgemm_tile(acc, H, D, WINl, D, D, row0, col0, lane);
                const bool latent = row0 < T_LAT;
                bf16* dst = nullptr; int pitch = 0, cbase = 0; bool rope = false; int tr = 0; bf16* vt = nullptr; int dv = 64, nh = 1, hd = 0;
                if (col0 < 512)       { dst = AQ; pitch = 512; cbase = col0; rope = true; }
                else if (col0 < 640)  { dst = AK; pitch = 128; cbase = col0 - 512; rope = true; }
                else if (col0 < 768)  { tr = 1; vt = AVT; dv = 64; nh = 2; hd = col0 - 640; }
                else if (col0 < 1280) { dst = BQ; pitch = 512; cbase = col0 - 768; }
                else if (col0 < 1792) { dst = BK; pitch = 512; cbase = col0 - 1280; }
                else if (col0 < 2304) { tr = 1; vt = BVT; dv = 64; nh = 8; hd = col0 - 1792; }
                else if (col0 < 2816) { dst = CQ; pitch = 512; cbase = col0 - 2304; rope = true; }
                else if (col0 < 3328) { dst = CK; pitch = 512; cbase = col0 - 2816; rope = true; }
                else if (col0 < 3840) { tr = 1; vt = CVT; dv = 128; nh = 4; hd = col0 - 3328; }
                else                  { tr = 2; dst = SG; pitch = 3072; cbase = col0 - 3840; }
                if (tr == 0) {
                    if (rope && latent) {
#pragma unroll
                        for (int m = 0; m < 4; ++m)
#pragma unroll
                            for (int r = 0; r < 4; ++r) {
                                const int t = (row0 + 16 * m + 4 * fq + r) & (SEQ - 1);
#pragma unroll
                                for (int n = 0; n < 2; ++n) {
                                    const int i = 16 * n + fr;
                                    const float cs = COS[t * 32 + i], sn = SIN[t * 32 + i];
                                    const float x1 = acc[m][n][r], x2 = acc[m][n + 2][r];
                                    acc[m][n][r] = x1 * cs - x2 * sn; acc[m][n + 2][r] = x2 * cs + x1 * sn;
                                }
                            }
                    }
#pragma unroll
                    for (int m = 0; m < 4; ++m)
#pragma unroll
                        for (int r = 0; r < 4; ++r) {
                            bf16* rowp = dst + (size_t)(row0 + 16 * m + 4 * fq + r) * pitch + cbase + fr;
#pragma unroll
                            for (int n = 0; n < 4; ++n) rowp[16 * n] = (bf16)f2bf(acc[m][n][r]);
                        }
                } else if (tr == 2) {
#pragma unroll
                    for (int m = 0; m < 4; ++m)
#pragma unroll
                        for (int r = 0; r < 4; ++r) {
                            bf16* rowp = dst + (size_t)(row0 + 16 * m + 4 * fq + r) * pitch + cbase + fr;
#pragma unroll
                            for (int n = 0; n < 4; ++n) rowp[16 * n] = (bf16)f2bf(sigmoidf_(acc[m][n][r]));
                        }
                } else {
                    const int head = hd / dv, d0 = hd % dv;
#pragma unroll
                    for (int m = 0; m < 4; ++m) {
                        const int rr = row0 + 16 * m + 4 * fq;
                        const int b = row_batch(rr), tok = row_tok(rr);
#pragma unroll
                        for (int n = 0; n < 4; ++n) {
                            const int d = d0 + 16 * n + fr;
                            v2u o; o.x = pk2(acc[m][n][0], acc[m][n][1]); o.y = pk2(acc[m][n][2], acc[m][n][3]);
                            *(GAS v2u*)(vt + ((size_t)(b * nh + head) * dv + d) * NTOK + tok) = o;
                        }
                    }
                }
            }
        }
#endif
        xcd_barrier(bar);

#ifndef SKIP_P3
        {
            LAS bf16* Pl = (LAS bf16*)(L + wave * 8192);
            const float lam_init = 0.8f - 0.6f * expf(-0.3f * (float)layer);
            float lam;
            {
                const float* cl = args.in[I_LAMBDA] + layer * 256;
                const float s1 = wave_sum(cl[lane] * cl[64 + lane]), s2 = wave_sum(cl[128 + lane] * cl[192 + lane]);
                lam = expf(s1) - expf(s2) + lam_init;
            }
            {
                const int n_lat = BATCH * 4 * (SEQ / 16), n_ctx = last ? 0 : BATCH * 4 * (CTX / 16);
                for (int it = gw; it < n_lat + n_ctx; it += NGW) {
                    int b, h, row0; bool isctx = it >= n_lat;
                    if (!isctx) { b = it / (4 * 512); h = (it / 512) % 4; row0 = b * SEQ + (it % 512) * 16; }
                    else { const int j = it - n_lat; b = j / (4 * 16); h = (j / 16) % 4; row0 = T_LAT + b * CTX + (j % 16) * 16; }
                    bf16x8 q1[2], q2[2];
                    { const bf16* qp = CQ + (size_t)(row0 + fr) * 512 + (h * 2) * 64 + fq * 8;
                      q1[0] = *(const GAS bf16x8*)qp; q1[1] = *(const GAS bf16x8*)(qp + 32); q2[0] = *(const GAS bf16x8*)(qp + 64); q2[1] = *(const GAS bf16x8*)(qp + 96); }
                    AttnAcc<8> s1, s2;
#pragma unroll
                    for (int r = 0; r < 4; ++r) { s1.m[r] = -1e30f; s1.l[r] = 0.f; s2.m[r] = -1e30f; s2.l[r] = 0.f; }
#pragma unroll
                    for (int dt = 0; dt < 8; ++dt) { s1.o[dt] = (f32x4){0.f, 0.f, 0.f, 0.f}; s2.o[dt] = (f32x4){0.f, 0.f, 0.f, 0.f}; }
                    const bf16* Vt = CVT + (size_t)(b * 4 + h) * 128 * NTOK;
                    const int nblk = isctx ? 4 : 132;
                    for (int jb = 0; jb < nblk; ++jb) {
                        const int j = isctx ? 128 + jb : jb;
                        const int krow = (j < 128) ? b * SEQ + 64 * j : T_LAT + b * CTX + 64 * (j - 128);
                        const int tok0 = 64 * j;
                        {
                            f32x4 sa[4];
#pragma unroll
                            for (int t = 0; t < 4; ++t) sa[t] = s_tile(q1, CK, 512, (h * 2) * 64, krow + 16 * t, fr, fq) * SCL2;
                            softmax_update<4, 8, 72>(s1, sa, Pl, fr, fq);
                        }
                        {
                            f32x4 sb[4];
#pragma unroll
                            for (int t = 0; t < 4; ++t) sb[t] = s_tile(q2, CK, 512, (h * 2 + 1) * 64, krow + 16 * t, fr, fq) * SCL2;
                            softmax_update<4, 8, 72>(s2, sb, Pl + 16 * 72, fr, fq);
                        }
                        asm volatile("s_waitcnt lgkmcnt(0)" ::: "memory");
                        __builtin_amdgcn_wave_barrier();
#pragma unroll
                        for (int ks = 0; ks < 2; ++ks) {
                            const bf16x8 pa = *(const LAS bf16x8*)(Pl + fr * 72 + ks * 32 + fq * 8);
                            const bf16x8 pb = *(const LAS bf16x8*)(Pl + 16 * 72 + fr * 72 + ks * 32 + fq * 8);
#pragma unroll
                            for (int dt = 0; dt < 8; ++dt) {
                                const bf16x8 vf = *(const GAS bf16x8*)(Vt + (size_t)(dt * 16 + fr) * NTOK + tok0 + ks * 32 + fq * 8);
                                s1.o[dt] = __builtin_amdgcn_mfma_f32_16x16x32_bf16(pa, vf, s1.o[dt], 0, 0, 0);
                                s2.o[dt] = __builtin_amdgcn_mfma_f32_16x16x32_bf16(pb, vf, s2.o[dt], 0, 0, 0);
                            }
                        }
                        asm volatile("s_waitcnt lgkmcnt(0)" ::: "memory");
                        __builtin_amdgcn_wave_barrier();
                    }
#pragma unroll
                    for (int r = 0; r < 4; ++r) {
                        const float i1 = 1.0f / grp16_sum(s1.l[r]), i2 = lam / grp16_sum(s2.l[r]);
                        float ss = 0.f; float ov[8];
#pragma unroll
                        for (int dt = 0; dt < 8; ++dt) { ov[dt] = s1.o[dt][r] * i1 - s2.o[dt][r] * i2; ss += ov[dt] * ov[dt]; }
                        ss = grp16_sum(ss);
                        const float rn = 1.0f / sqrtf(ss * (1.f / 128.f) + NORM_EPS) * (1.0f - lam_init);
                        bf16* yp = Y + (size_t)(row0 + 4 * fq + r) * 1536 + 1024 + h * 128 + fr;
#pragma unroll
                        for (int dt = 0; dt < 8; ++dt) yp[16 * dt] = (bf16)f2bf(ov[dt] * rn * args.in[I_SUBLN][layer * 512 + h * 128 + dt * 16 + fr]);
                    }
                }
            }
            {
                const int n_lat = BATCH * 8 * (SEQ / 16), n_ctx = last ? 0 : BATCH * 8 * (CTX / 16);
                for (int it = gw; it < n_lat + n_ctx; it += NGW) {
                    int b, hq, row0, qpos0 = 0; const bool isctx = it >= n_lat;
                    if (!isctx) { b = it / (8 * 512); hq = (it / 512) % 8; qpos0 = (it % 512) * 16; row0 = b * SEQ + qpos0; }
                    else { const int j = it - n_lat; b = j / (8 * 16); hq = (j / 16) % 8; row0 = T_LAT + b * CTX + (j % 16) * 16; }
                    const int g = hq >> 2;
                    bf16x8 qf[2];
                    { const bf16* qp = AQ + (size_t)(row0 + fr) * 512 + hq * 64 + fq * 8; qf[0] = *(const GAS bf16x8*)qp; qf[1] = *(const GAS bf16x8*)(qp + 32); }
                    AttnAcc<4> st;
                    const float sk = args.in[I_SINK][layer * 8 + hq] * LOG2E;
#pragma unroll
                    for (int r = 0; r < 4; ++r) { st.m[r] = sk; st.l[r] = (fr == 0) ? 1.0f : 0.0f; }
#pragma unroll
                    for (int dt = 0; dt < 4; ++dt) st.o[dt] = (f32x4){0.f, 0.f, 0.f, 0.f};
                    const bf16* Vt = AVT + (size_t)(b * 2 + g) * 64 * NTOK;
                    if (!isctx) {
                        const int al = ((qpos0 - 128) >> 5) << 5;
                        for (int ks = al; ks < qpos0 + 144; ks += 32) {
                            if (ks < 0 || ks >= SEQ) continue;
                            f32x4 s[2];
#pragma unroll
                            for (int t = 0; t < 2; ++t) {
                                s[t] = s_tile(qf, AK, 128, g * 64, b * SEQ + ks + 16 * t, fr, fq) * SCL2;
                                const int kpos = ks + 16 * t + fr;
#pragma unroll
                                for (int r = 0; r < 4; ++r) { const int dq = qpos0 + 4 * fq + r - kpos; if (dq > 128 || dq < -128) s[t][r] = -1e30f; }
                            }
                            softmax_update<2, 4, 40>(st, s, Pl, fr, fq);
                            pv_update<1, 4, 40>(st, Pl, Vt, ks, fr, fq);
                        }
                    }
                    for (int u = 0; u < 8; ++u) {
                        f32x4 s[2];
#pragma unroll
                        for (int t = 0; t < 2; ++t) s[t] = s_tile(qf, AK, 128, g * 64, T_LAT + b * CTX + 32 * u + 16 * t, fr, fq) * SCL2;
                        softmax_update<2, 4, 40>(st, s, Pl, fr, fq);
                        pv_update<1, 4, 40>(st, Pl, Vt, SEQ + 32 * u, fr, fq);
                    }
#pragma unroll
                    for (int r = 0; r < 4; ++r) {
                        const float il = 1.0f / grp16_sum(st.l[r]);
                        bf16* yp = Y + (size_t)(row0 + 4 * fq + r) * 1536 + hq * 64 + fr;
#pragma unroll
                        for (int dt = 0; dt < 4; ++dt) yp[16 * dt] = (bf16)f2bf(st.o[dt][r] * il);
                    }
                }
            }
            {
                const int n_lat = BATCH * 8 * 128 * 4, n_ctx = last ? 0 : BATCH * 8 * (CTX / 16);
                for (int it = gw; it < n_lat + n_ctx; it += NGW) {
                    int b, h, row0, gr = 0, nb = 0; const bool isctx = it >= n_lat;
                    if (!isctx) { b = it / (8 * 512); h = (it / 512) % 8; gr = (it % 512) / 4; nb = it % 4; row0 = b * SEQ + gr * GRID_W + nb * 16; }
                    else { const int j = it - n_lat; b = j / (8 * 16); h = (j / 16) % 8; row0 = T_LAT + b * CTX + (j % 16) * 16; }
                    bf16x8 qf[2];
                    { const bf16* qp = BQ + (size_t)(row0 + fr) * 512 + h * 64 + fq * 8; qf[0] = *(const GAS bf16x8*)qp; qf[1] = *(const GAS bf16x8*)(qp + 32); }
                    AttnAcc<4> st;
#pragma unroll
                    for (int r = 0; r < 4; ++r) { st.m[r] = -1e30f; st.l[r] = 0.f; }
#pragma unroll
                    for (int dt = 0; dt < 4; ++dt) st.o[dt] = (f32x4){0.f, 0.f, 0.f, 0.f};
                    const bf16* Vt = BVT + (size_t)(b * 8 + h) * 64 * NTOK;
                    if (!isctx) {
                        const int rs = min(max(gr - 4, 0), 120);
                        const int band0 = min(max(nb * 16 - 8, 0), 32);
                        const float* rpb = args.in[I_RPB] + (size_t)(layer * 8 + h) * 15 * 31;
                        for (int i = 0; i < 8; ++i) {
                            const int ktok0 = (rs + i) * GRID_W + band0;
                            const int dr = rs + i - gr + 7;
                            f32x4 s[2];
#pragma unroll
                            for (int t = 0; t < 2; ++t) {
                                s[t] = s_tile(qf, BK, 512, h * 64, b * SEQ + ktok0 + 16 * t, fr, fq) * SCL2;
                                const int kc = band0 + 16 * t + fr;
#pragma unroll
                                for (int r = 0; r < 4; ++r) {
                                    const int qc = nb * 16 + 4 * fq + r;
                                    const int cstart = min(max(qc - 8, 0), 48);
                                    const int dc = min(max(kc - qc, -15), 15) + 15;
                                    const bool valid = (kc >= cstart) && (kc < cstart + 16);
                                    s[t][r] = valid ? s[t][r] + rpb[dr * 31 + dc] * LOG2E : -1e30f;
                                }
                            }
                            softmax_update<2, 4, 40>(st, s, Pl, fr, fq);
                            pv_update<1, 4, 40>(st, Pl, Vt, ktok0, fr, fq);
                        }
                    }
                    for (int u = 0; u < 8; ++u) {
                        f32x4 s[2];
#pragma unroll
                        for (int t = 0; t < 2; ++t) s[t] = s_tile(qf, BK, 512, h * 64, T_LAT + b * CTX + 32 * u + 16 * t, fr, fq) * SCL2;
                        softmax_update<2, 4, 40>(st, s, Pl, fr, fq);
                        pv_update<1, 4, 40>(st, Pl, Vt, SEQ + 32 * u, fr, fq);
                    }
#pragma unroll
                    for (int r = 0; r < 4; ++r) {
                        const float il = 1.0f / grp16_sum(st.l[r]);
                        bf16* yp = Y + (size_t)(row0 + 4 * fq + r) * 1536 + 512 + h * 64 + fr;
#pragma unroll
                        for (int dt = 0; dt < 4; ++dt) yp[16 * dt] = (bf16)f2bf(st.o[dt][r] * il);
                    }
                }
            }
        }
#endif
        xcd_barrier(bar);

#ifndef SKIP_P4
        {
            const int NMT = T_EFF / 256; constexpr int NNT = D / 64;
            const int wr = wave >> 1, wc = wave & 1;
            for (int it = vcu; it < NMT * NNT; it += G) {
                const int pm = it / NNT, pn = it % NNT;
                const int row0 = pm * 256 + wr * 64, col0 = pn * 64 + wc * 32;
                f32x4 mg[4][2]; zero_acc<2>(mg);
#pragma unroll 1
                for (int seg = 0; seg < 3; ++seg) {
                    f32x4 acc[4][2]; zero_acc<2>(acc);
                    sgemm_tile<1, 2>(acc, Y + seg * 512, 1536, WB + (size_t)(layer * 3 + seg) * D * 512, 512, 512, row0, col0, lane);
#pragma unroll
                    for (int m = 0; m < 4; ++m)
#pragma unroll
                        for (int r = 0; r < 4; ++r) {
                            const bf16* gp = SG + (size_t)(row0 + 16 * m + 4 * fq + r) * 3072 + seg * 1024 + col0 + fr;
#pragma unroll
                            for (int n = 0; n < 2; ++n) mg[m][n][r] += bf2f(gp[16 * n]) * acc[m][n][r];
                        }
                }
#pragma unroll
                for (int m = 0; m < 4; ++m)
#pragma unroll
                    for (int r = 0; r < 4; ++r) {
                        bf16* rowp = MG + (size_t)(row0 + 16 * m + 4 * fq + r) * D + col0 + fr;
#pragma unroll
                        for (int n = 0; n < 2; ++n) rowp[16 * n] = (bf16)f2bf(mg[m][n][r]);
                    }
            }
        }
#endif
        xcd_barrier(bar);

#ifndef SKIP_P5
        {
            const int NMT = T_EFF / 256; constexpr int NNT = D / 128;
            const int wr = wave >> 1, wc = wave & 1;
            for (int it = vcu; it < NMT * NNT; it += G) {
                const int pm = it / NNT, pn = it % NNT;
                const int row0 = pm * 256 + wr * 64, col0 = pn * 128 + wc * 64;
                f32x4 acc[4][4]; zero_acc<4>(acc);
                sgemm_tile(acc, MG, D, WO + (size_t)layer * D * D, D, D, row0, col0, lane);
                const float* gt = modl + (size_t)row_modidx(row0) * 6 * D + 2 * D + col0 + fr;
#pragma unroll
                for (int m = 0; m < 4; ++m)
#pragma unroll
                    for (int r = 0; r < 4; ++r) {
                        float* rowp = X + (size_t)(row0 + 16 * m + 4 * fq + r) * D + col0 + fr;
#pragma unroll
                        for (int n = 0; n < 4; ++n) rowp[16 * n] += gt[16 * n] * acc[m][n][r];
                    }
            }
        }
#endif
        xcd_barrier(bar);

#ifndef SKIP_P6
        { int ln = lane; asm volatile("" : "+v"(ln));
        for (int r = gw; r < T_EFF; r += NGW) {
            const float* md = modl + (size_t)row_modidx(r) * 6 * D;
            const GAS f32x4* xr = (const GAS f32x4*)(X + (size_t)r * D) + ln;
            f32x4 v[4]; float ss = 0.f;
#pragma unroll
            for (int j = 0; j < 4; ++j) { v[j] = xr[64 * j]; ss += (v[j].x * v[j].x + v[j].y * v[j].y) + (v[j].z * v[j].z + v[j].w * v[j].w); }
            const float rs = 1.0f / sqrtf(wave_sum(ss) * (1.f / D) + NORM_EPS);
            GAS v2u* o8 = (GAS v2u*)(H + (size_t)r * D) + ln;
#pragma unroll
            for (int j = 0; j < 4; ++j) {
                const f32x4 g = *((const GAS f32x4*)(args.in[I_G2] + layer * D) + ln + 64 * j);
                const f32x4 sh = *((const GAS f32x4*)(md + 3 * D) + ln + 64 * j), sc = *((const GAS f32x4*)(md + 4 * D) + ln + 64 * j);
                const f32x4 h = v[j] * rs * g * (sc + 1.0f) + sh;
                v2u o; o.x = pk2(h.x, h.y); o.y = pk2(h.z, h.w); o8[64 * j] = o;
            }
        }
        }
#endif
        xcd_barrier(bar);

#ifndef SKIP_P7
        {
            const int NMT = T_EFF / 256; constexpr int NNT = 2048 / 128;
            const int wr = wave >> 1, wc = wave & 1;
            for (int it = vcu; it < NMT * NNT; it += G) {
                const int pm = it / NNT, pn = it % NNT;
                const int row0 = pm * 256 + wr * 64, col0 = pn * 128 + wc * 64;
                f32x4 acc[4][4]; zero_acc<4>(acc);
                sgemm_tile(acc, H, D, WQ + (size_t)layer * 2048 * D, D, D, row0, col0, lane);
#pragma unroll
                for (int m = 0; m < 4; ++m)
#pragma unroll
                    for (int r = 0; r < 4; ++r) {
                        bf16* rowp = Q2 + (size_t)(row0 + 16 * m + 4 * fq + r) * 2048 + col0 + fr;
#pragma unroll
                        for (int n = 0; n < 4; ++n) rowp[16 * n] = (bf16)f2bf(acc[m][n][r]);
                    }
            }
        }
#endif
        xcd_barrier(bar);

#ifndef SKIP_P8
        {
            const int NMT = T_EFF / 256; constexpr int NNT = 2048 / 128;
            const int wr = wave >> 1, wc = wave & 1;
            for (int it = vcu; it < NMT * NNT; it += G) {
                const int pm = it / NNT, grp = it % NNT;
                const int row0 = pm * 256 + wr * 64, c0 = wc * 64;
                f32x4 acc[4][4]; zero_acc<4>(acc);
                sgemm_tile(acc, Q2 + grp * 128, 2048, KEYS + (size_t)(layer * 16 + grp) * 128 * 128, 128, 128, row0, c0, lane);
#pragma unroll
                for (int m = 0; m < 4; ++m)
#pragma unroll
                    for (int r = 0; r < 4; ++r) {
                        float* rowp = SC + (size_t)(row0 + 16 * m + 4 * fq + r) * 2048 + grp * 128 + c0 + fr;
#pragma unroll
                        for (int n = 0; n < 4; ++n) rowp[16 * n] = acc[m][n][r];
                    }
            }
        }
#endif
        xcd_barrier(bar);

#ifndef SKIP_P9
        for (int it = gt; it < T_EFF * PEER_HEADS; it += NGT) {
            const int t = it >> 3, hh = it & 7;
            const float* sc = SC + (size_t)t * 2048 + hh * 256;
            int a0[16], a1[16];
#pragma unroll
            for (int i = 0; i < 16; ++i) { a0[i] = (int)0x80000000; a1[i] = (int)0x80000000; }
            for (int k = 0; k < 128; k += 4) {
                const f32x4 v = *(const GAS f32x4*)(sc + k);
                top16_insert(a0, (f2ord(v.x) & ~127) | (k + 0)); top16_insert(a0, (f2ord(v.y) & ~127) | (k + 1));
                top16_insert(a0, (f2ord(v.z) & ~127) | (k + 2)); top16_insert(a0, (f2ord(v.w) & ~127) | (k + 3));
            }
            for (int k = 0; k < 128; k += 4) {
                const f32x4 v = *(const GAS f32x4*)(sc + 128 + k);
                top16_insert(a1, (f2ord(v.x) & ~127) | (k + 0)); top16_insert(a1, (f2ord(v.y) & ~127) | (k + 1));
                top16_insert(a1, (f2ord(v.z) & ~127) | (k + 2)); top16_insert(a1, (f2ord(v.w) & ~127) | (k + 3));
            }
            int c[16];
#pragma unroll
            for (int i = 0; i < 16; ++i) c[i] = (int)0x80000000;
#pragma unroll
            for (int i = 0; i < 16; ++i) {
                const float vi = ord2f(a0[i] & ~127);
#pragma unroll
                for (int j = 0; j < 16; ++j) {
                    if ((i + 1) * (j + 1) <= 16) {
                        const float sj = vi + ord2f(a1[j] & ~127);
                        top16_insert(c, (f2ord(sj) & ~255) | (i * 16 + j));
                    }
                }
            }
            const float smax = ord2f(c[0] & ~255);
            float pe[16]; float psum = 0.f;
#pragma unroll
            for (int k = 0; k < 16; ++k) { pe[k] = __expf(ord2f(c[k] & ~255) - smax); psum += pe[k]; }
            const float ip = 1.0f / psum;
#pragma unroll
            for (int k = 0; k < 16; ++k) {
                const int ij = c[k] & 255, ii = ij >> 4, jj = ij & 15;
                int e0 = 0, e1 = 0;
#pragma unroll
                for (int q = 0; q < 16; ++q) { e0 = (ii == q) ? (a0[q] & 127) : e0; e1 = (jj == q) ? (a1[q] & 127) : e1; }
                EI[(size_t)t * NSEL + hh * 16 + k] = e0 * PEER_KEYS + e1;
                EG[(size_t)t * NSEL + hh * 16 + k] = pe[k] * ip;
            }
        }
#endif
        xcd_barrier(bar);

#ifndef SKIP_P10
        { int ln = lane; asm volatile("" : "+v"(ln));
        {
            const float* PU = args.in[I_PU] + (size_t)layer * 16384 * D;
            const float* PV = args.in[I_PV] + (size_t)layer * 16384 * D;
            for (int t = gw; t < T_EFF; t += NGW) {
                f32x4 hv[4];
                { const GAS v2u* hp = (const GAS v2u*)(H + (size_t)t * D) + ln;
#pragma unroll
                  for (int j = 0; j < 4; ++j) { const v2u w = hp[64 * j]; hv[j] = (f32x4){bf2f(w.x & 0xffffu), bf2f(w.x >> 16), bf2f(w.y & 0xffffu), bf2f(w.y >> 16)}; } }
                f32x4 o[4];
#pragma unroll
                for (int j = 0; j < 4; ++j) o[j] = (f32x4){0.f, 0.f, 0.f, 0.f};
                for (int s0 = 0; s0 < NSEL; s0 += 64) {
                    const int idx = EI[(size_t)t * NSEL + s0 + ln]; const float gate = EG[(size_t)t * NSEL + s0 + ln];
                    for (int s = 0; s < 64; s += 4) {
                        float dot[4]; int e[4];
#pragma unroll
                        for (int q = 0; q < 4; ++q) {
                            e[q] = __shfl(idx, s + q);
                            const GAS f32x4* up = (const GAS f32x4*)(PU + (size_t)e[q] * D) + ln;
                            float dd = 0.f;
#pragma unroll
                            for (int j = 0; j < 4; ++j) { const f32x4 u = up[64 * j]; dd += (u.x * hv[j].x + u.y * hv[j].y) + (u.z * hv[j].z + u.w * hv[j].w); }
                            dot[q] = dd;
                        }
#pragma unroll
                        for (int q = 0; q < 4; ++q) {
                            const float dd = wave_sum(dot[q]);
                            const float act = 0.5f * dd * (1.0f + erff(dd * 0.70710678118654752f));
                            const float w = __shfl(gate, s + q) * act;
                            const GAS f32x4* vp = (const GAS f32x4*)(PV + (size_t)e[q] * D) + ln;
#pragma unroll
                            for (int j = 0; j < 4; ++j) o[j] += vp[64 * j] * w;
                        }
                    }
                }
                const float* gt2 = modl + (size_t)row_modidx(t) * 6 * D + 5 * D;
                GAS f32x4* xr = (GAS f32x4*)(X + (size_t)t * D) + ln;
                f32x4 xn[4]; float ss = 0.f;
#pragma unroll
                for (int j = 0; j < 4; ++j) {
                    xn[j] = xr[64 * j] + *((const GAS f32x4*)gt2 + ln + 64 * j) * o[j];
                    ss += (xn[j].x * xn[j].x + xn[j].y * xn[j].y) + (xn[j].z * xn[j].z + xn[j].w * xn[j].w);
                }
                if (!last) {
#pragma unroll
                    for (int j = 0; j < 4; ++j) xr[64 * j] = xn[j];
                } else {
                    const float rs = 1.0f / sqrtf(wave_sum(ss) * (1.f / D) + NORM_EPS);
                    GAS f32x4* op = (GAS f32x4*)(args.out + (size_t)t * D) + ln;
#pragma unroll
                    for (int j = 0; j < 4; ++j) op[64 * j] = xn[j] * rs * *((const GAS f32x4*)args.in[I_GFINAL] + ln + 64 * j);
                }
            }
        }
        }
#endif
        if (!last) xcd_barrier(bar);
    }
}

extern "C" void kernel_launch(void* const* d_in, const int* in_sizes, int n_in, void* d_out, int out_size, void* d_ws, size_t ws_size, hipStream_t stream) {
    static int grid = 0;
    if (grid == 0) {
        if (n_in != 22 || out_size != T_LAT * D || ws_size < WS_END) { fprintf(stderr, "kernel_launch: unexpected shapes: n_in %d out %d ws %zu (need %zu)\n", n_in, out_size, ws_size, (size_t)WS_END); grid = -1; return; }
        int dev = 0, cus = 0, per_cu = 0;
        if (hipGetDevice(&dev) != hipSuccess || hipDeviceGetAttribute(&cus, hipDeviceAttributeMultiprocessorCount, dev) != hipSuccess) { fprintf(stderr, "device query failed\n"); grid = -1; return; }
        if (hipFuncSetAttribute((const void*)mega_fwd, hipFuncAttributeMaxDynamicSharedMemorySize, LDS_BYTES) != hipSuccess) { fprintf(stderr, "hipFuncSetAttribute failed\n"); grid = -1; return; }
        if (hipOccupancyMaxActiveBlocksPerMultiprocessor(&per_cu, (const void*)mega_fwd, NTHREADS, LDS_BYTES) != hipSuccess || per_cu < 1) { fprintf(stderr, "occupancy query: %d\n", per_cu); }
        (void)hipGetLastError();
        grid = cus;
    }
    if (grid < 0) return;
    if (hipMemsetAsync((char*)d_ws + WS_CTL, 0, CTL_ZERO_BYTES, stream) != hipSuccess) { fprintf(stderr, "memset failed\n"); return; }
    Args a{};
    for (int i = 0; i < 22; ++i) a.in[i] = (const float*)d_in[i];
    a.out = (float*)d_out; a.ws = (unsigned char*)d_ws;
    hipLaunchKernelGGL(mega_fwd, dim3(grid), dim3(NTHREADS), LDS_BYTES, stream, a);
}
```

```cpp
#include <hip/hip_runtime.h>
#include <cstdio>
#include <cstdint>

#ifndef REP_P3C
#define REP_P3C 1
#endif
#define GAS __attribute__((address_space(1)))
#define LAS __attribute__((address_space(3)))
typedef unsigned short bf16;
typedef float f32x4 __attribute__((ext_vector_type(4)));
typedef short bf16x8 __attribute__((ext_vector_type(8)));
typedef unsigned v4u __attribute__((ext_vector_type(4)));
typedef unsigned v2u __attribute__((ext_vector_type(2)));
typedef float f32x2 __attribute__((ext_vector_type(2)));
typedef GAS unsigned gu32;

constexpr int NWAVES = 8, NTHREADS = 512;
constexpr int D = 1024, BATCH = 2, SEQ = 8192, DEPTH = 2, GRID_W = 64, CTX = 256;
constexpr int T_LAT = BATCH * SEQ;
constexpr int T_ALL = T_LAT + BATCH * CTX;
constexpr int NTOK = SEQ + CTX;
constexpr int IN_W = 6912;
constexpr int PEER_HEADS = 8, PEER_KEYS = 128, PEER_TOPK = 16, NSEL = PEER_HEADS * PEER_TOPK;
constexpr float NORM_EPS = 1e-6f;
constexpr float LOG2E = 1.4426950408889634f;
constexpr float SCL2 = 0.125f * LOG2E;

constexpr size_t MiB = 1u << 20;
constexpr size_t WS_CTL = 0, CTL_ZERO_BYTES = 1 * MiB;
constexpr int CW_BAR = 4096;
constexpr size_t WS_MOD = 65536;
constexpr size_t WS_COS = 2 * MiB, WS_SIN = 3 * MiB;
constexpr size_t WS_WIN = 4 * MiB;
constexpr size_t WS_WB = 31 * MiB;
constexpr size_t WS_WO = 37 * MiB;
constexpr size_t WS_WQ = 41 * MiB;
constexpr size_t WS_KEYS = 49 * MiB;
constexpr size_t WS_X = 50 * MiB;
constexpr size_t WS_H = 116 * MiB;
constexpr size_t WS_Y = 149 * MiB;
constexpr size_t WS_MG = WS_H;
constexpr size_t WS_U8 = 199 * MiB;
constexpr size_t WS_SCU = 231 * MiB;
constexpr size_t WS_EI = 232 * MiB;
constexpr size_t WS_EG = 241 * MiB;
constexpr size_t WS_P = 250 * MiB;
constexpr size_t SZ_R512 = (size_t)T_ALL * 512 * 2;
constexpr size_t SZ_R128 = (size_t)T_ALL * 128 * 2;
constexpr size_t WS_AQ = WS_P, WS_AK = WS_AQ + SZ_R512, WS_AVT = WS_AK + SZ_R128, WS_BQ = WS_AVT + SZ_R128, WS_BK = WS_BQ + SZ_R512,
                 WS_BVT = WS_BK + SZ_R512, WS_CQ = WS_BVT + SZ_R512, WS_CK = WS_CQ + SZ_R512, WS_CVT = WS_CK + SZ_R512, WS_SG = WS_CVT + SZ_R512;
constexpr size_t WS_Q2 = WS_P;
constexpr size_t WS_SC = WS_P + 66 * MiB;
constexpr size_t WS_PEND = WS_SG + (size_t)T_ALL * 3072 * 2;
constexpr size_t WS_V8 = 473 * MiB;
constexpr size_t WS_END = WS_V8 + 32 * MiB;
static_assert(WS_SC + (size_t)T_ALL * 2048 * 4 <= WS_PEND && WS_PEND <= WS_V8, "alias map");
static_assert(WS_END <= 512 * MiB, "ws map");

constexpr int LDS_BYTES = 147456;
constexpr int MISC_OFF = 131072 + 320;

#define XB_TMO      128
#define XB_XCNT(j)  (256  + 64 * (j))
#define XB_XSUB(j)  (1280 + 64 * (j))
#define XB_XGEN(j)  (2304 + 64 * (j))
#define XB_TOP      3328
#define XB_TOPGEN   3392
#define XCD_BAR_WORDS 3456
#define XB_SPIN_CAP (1u << 24)

__device__ __forceinline__ unsigned xb_ld(unsigned* p)              { return __hip_atomic_load(p, __ATOMIC_RELAXED, __HIP_MEMORY_SCOPE_AGENT); }
__device__ __forceinline__ unsigned xb_add(unsigned* p, unsigned v) { return __hip_atomic_fetch_add(p, v, __ATOMIC_RELAXED, __HIP_MEMORY_SCOPE_AGENT); }
__device__ __forceinline__ unsigned xb_xcc_id() { return (unsigned)__builtin_amdgcn_s_getreg((3 << 11) | 20) & 0xFu; }
#define XB_SPIN(cond, bar) do { unsigned _sp = 0; while (cond) { __builtin_amdgcn_s_sleep(1); \
    if ((++_sp & 255u) == 0u) { if (xb_ld(&(bar)[XB_TMO])) break; if (_sp > XB_SPIN_CAP) { atomicAdd(&(bar)[XB_TMO], 1u); break; } } } } while (0)

struct XcdBarrier { unsigned* bar; unsigned x; volatile LAS unsigned* st; };

__device__ __forceinline__ XcdBarrier xcd_barrier_post(unsigned* bar, volatile LAS unsigned* st) {
    XcdBarrier b; b.bar = bar; b.x = xb_xcc_id(); b.st = st;
    if (threadIdx.x == 0) (void)xb_add(&bar[XB_XCNT(b.x)], 1u);
    return b;
}
__device__ __forceinline__ void xcd_barrier_complete(unsigned* bar, unsigned x, unsigned& nloc, unsigned& nx) {
    const unsigned G = gridDim.x * gridDim.y * gridDim.z;
    unsigned sum, cnt, mine, sp = 0u;
    for (;;) {
        sum = 0u; cnt = 0u; mine = 0u;
#pragma unroll
        for (unsigned j = 0; j < 16; ++j) { const unsigned c = xb_ld(&bar[XB_XCNT(j)]); sum += c; cnt += (c > 0u) ? 1u : 0u; mine = (j == x) ? c : mine; }
        if (sum == G) break;
        __builtin_amdgcn_s_sleep(1);
        if ((++sp & 255u) == 0u) { if (xb_ld(&bar[XB_TMO])) break; if (sp > XB_SPIN_CAP) { atomicAdd(&bar[XB_TMO], 1u); break; } }
    }
    nloc = mine > 0u ? mine : 1u; nx = cnt > 0u ? cnt : 1u;
}
__device__ __forceinline__ void xcd_barrier(const XcdBarrier& b) {
    asm volatile("s_waitcnt vmcnt(0)" ::: "memory");
    __syncthreads();
    if (threadIdx.x == 0) {
        unsigned* bar = b.bar;
        __builtin_amdgcn_s_waitcnt(0);
        unsigned nloc = b.st[0], nx = b.st[1];
        if (nloc == 0u) { xcd_barrier_complete(bar, b.x, nloc, nx); b.st[0] = nloc; b.st[1] = nx; }
        const unsigned old = xb_add(&bar[XB_XSUB(b.x)], 1u);
        const unsigned gen = old / nloc;
        if (old + 1u == (gen + 1u) * nloc) {
            __builtin_amdgcn_fence(__ATOMIC_RELEASE, "agent");
            asm volatile("s_waitcnt vmcnt(0)" ::: "memory");
            const unsigned og = xb_add(&bar[XB_TOP], 1u);
            const unsigned tg = og / nx;
            if (og + 1u == (tg + 1u) * nx) xb_add(&bar[XB_TOPGEN], 1u);
            else XB_SPIN(xb_ld(&bar[XB_TOPGEN]) == tg, bar);
            __builtin_amdgcn_fence(__ATOMIC_ACQUIRE, "agent");
            xb_add(&bar[XB_XGEN(b.x)], 1u);
            asm volatile("s_waitcnt vmcnt(0)" ::: "memory");
        } else {
            XB_SPIN(xb_ld(&bar[XB_XGEN(b.x)]) == gen, bar);
            __builtin_amdgcn_fence(__ATOMIC_ACQUIRE, "agent");
            asm volatile("s_waitcnt vmcnt(0)" ::: "memory");
        }
    }
    __syncthreads();
}

__device__ __forceinline__ unsigned f2bf(float f) { unsigned u = __builtin_bit_cast(unsigned, f); return (u + 0x7fffu + ((u >> 16) & 1u)) >> 16; }
__device__ __forceinline__ unsigned pk2(float lo, float hi) { return f2bf(lo) | (f2bf(hi) << 16); }
__device__ __forceinline__ float bf2f(unsigned h) { return __builtin_bit_cast(float, h << 16); }
__device__ __forceinline__ float wave_sum(float v) {
#pragma unroll
    for (int o = 1; o < 64; o <<= 1) v += __shfl_xor(v, o);
    return v;
}
__device__ __forceinline__ float grp16_sum(float v) { v += __shfl_xor(v, 1); v += __shfl_xor(v, 2); v += __shfl_xor(v, 4); v += __shfl_xor(v, 8); return v; }
__device__ __forceinline__ float grp16_max(float v) { v = fmaxf(v, __shfl_xor(v, 1)); v = fmaxf(v, __shfl_xor(v, 2)); v = fmaxf(v, __shfl_xor(v, 4)); v = fmaxf(v, __shfl_xor(v, 8)); return v; }
__device__ __forceinline__ float sigmoidf_(float x) { return 1.0f / (1.0f + __expf(-x)); }
__device__ __forceinline__ int row_modidx(int r) { return r < T_LAT ? (r >> 13) : 2; }
__device__ __forceinline__ int row_batch(int r) { return r < T_LAT ? (r >> 13) : ((r - T_LAT) >> 8); }
__device__ __forceinline__ int row_tok(int r) { return r < T_LAT ? (r & (SEQ - 1)) : SEQ + ((r - T_LAT) & (CTX - 1)); }

struct Args { const float* in[22]; float* out; unsigned char* ws; };
enum { I_X = 0, I_C, I_CTX, I_CCTX, I_WMOD, I_BMOD, I_G1, I_G2, I_WIN, I_SINK, I_RPB, I_LAMBDA, I_SUBLN, I_WBA, I_WBB, I_WBC, I_WOUT, I_PWQ, I_PKEYS, I_PU, I_PV, I_GFINAL };

__device__ __forceinline__ void p0_transpose_item(const float* W, int K, int N, bf16* WT, LAS float* scr, int item, int lane) {
    const int nblk = N / 32, kb = item / nblk, nb = item % nblk, k0 = 64 * kb, n0 = 32 * nb;
#pragma unroll 8
    for (int i = 0; i < 32; ++i) { const int kk = 2 * i + (lane >> 5); scr[kk * 33 + (lane & 31)] = W[(size_t)(k0 + kk) * N + n0 + (lane & 31)]; }
    asm volatile("s_waitcnt lgkmcnt(0)" ::: "memory");
    const int c = lane & 7;
#pragma unroll
    for (int j = 0; j < 4; ++j) { const int n = (lane >> 3) + 8 * j; const LAS float* s = scr + (8 * c) * 33 + n;
        v4u o; o.x = pk2(s[0 * 33], s[1 * 33]); o.y = pk2(s[2 * 33], s[3 * 33]); o.z = pk2(s[4 * 33], s[5 * 33]); o.w = pk2(s[6 * 33], s[7 * 33]);
        *(GAS v4u*)(WT + (size_t)(n0 + n) * K + k0 + 8 * c) = o; }
    asm volatile("s_waitcnt lgkmcnt(0)" ::: "memory");
}

template <int UNR = 2, int NN = 4>
__device__ __forceinline__ void sgemm_tile(f32x4 (&acc)[4][NN], const bf16* A, int lda, const bf16* Bt, int ldb, int K, int row0, int col0, int lane) {
    const int fr = lane & 15, fq = lane >> 4;
    const bf16* ap = A + (size_t)(row0 + fr) * lda + fq * 8;
    const bf16* bp = Bt + (size_t)(col0 + fr) * ldb + fq * 8;
#pragma unroll UNR
    for (int k = 0; k < K; k += 32) {
        bf16x8 a[4], b[NN];
#pragma unroll
        for (int m = 0; m < 4; ++m) a[m] = *(const GAS bf16x8*)(ap + (size_t)m * 16 * lda + k);
#pragma unroll
        for (int n = 0; n < NN; ++n) b[n] = *(const GAS bf16x8*)(bp + (size_t)n * 16 * ldb + k);
#pragma unroll
        for (int m = 0; m < 4; ++m)
#pragma unroll
            for (int n = 0; n < NN; ++n) acc[m][n] = __builtin_amdgcn_mfma_f32_16x16x32_bf16(a[m], b[n], acc[m][n], 0, 0, 0);
    }
}
template <int NN>
__device__ __forceinline__ void zero_acc(f32x4 (&acc)[4][NN]) {
#pragma unroll
    for (int m = 0; m < 4; ++m)
#pragma unroll
        for (int n = 0; n < NN; ++n) acc[m][n] = (f32x4){0.f, 0.f, 0.f, 0.f};
}

template <int NDT> struct AttnAcc { f32x4 o[NDT]; float m[4], l[4]; };

__device__ __forceinline__ f32x4 s_tile(const bf16x8 (&qf)[2], const bf16* Kb, int kpitch, int khoff, int krow, int fr, int fq) {
    const bf16* kp = Kb + (size_t)(krow + fr) * kpitch + khoff + fq * 8;
    const bf16x8 k0 = *(const GAS bf16x8*)kp, k1 = *(const GAS bf16x8*)(kp + 32);
    f32x4 s = (f32x4){0.f, 0.f, 0.f, 0.f};
    s = __builtin_amdgcn_mfma_f32_16x16x32_bf16(qf[0], k0, s, 0, 0, 0);
    s = __builtin_amdgcn_mfma_f32_16x16x32_bf16(qf[1], k1, s, 0, 0, 0);
    return s;
}
template <int NT, int NDT, int PSTR>
__device__ __forceinline__ void softmax_update(AttnAcc<NDT>& st, f32x4 (&s)[NT], LAS bf16* Pl, int fr, int fq) {
#pragma unroll
    for (int r = 0; r < 4; ++r) {
        float mx = s[0][r];
#pragma unroll
        for (int t = 1; t < NT; ++t) mx = fmaxf(mx, s[t][r]);
        mx = grp16_max(mx);
        const float mn = fmaxf(st.m[r], mx);
        const float alpha = __builtin_amdgcn_exp2f(st.m[r] - mn);
        st.m[r] = mn;
        float ls = st.l[r] * alpha;
#pragma unroll
        for (int dt = 0; dt < NDT; ++dt) st.o[dt][r] *= alpha;
#pragma unroll
        for (int t = 0; t < NT; ++t) {
            const float p = (s[t][r] > -1e29f) ? __builtin_amdgcn_exp2f(s[t][r] - mn) : 0.f;
            ls += p;
            Pl[(4 * fq + r) * PSTR + t * 16 + fr] = (bf16)f2bf(p);
        }
        st.l[r] = ls;
    }
}
template <int NKS, int NDT, int PSTR>
__device__ __forceinline__ void pv_update(AttnAcc<NDT>& st, const LAS bf16* Pl, const bf16* Vt, int tok0, int fr, int fq) {
    asm volatile("s_waitcnt lgkmcnt(0)" ::: "memory");
    __builtin_amdgcn_wave_barrier();
#pragma unroll
    for (int ks = 0; ks < NKS; ++ks) {
        const bf16x8 pf = *(const LAS bf16x8*)(Pl + fr * PSTR + ks * 32 + fq * 8);
#pragma unroll
        for (int dt = 0; dt < NDT; ++dt) {
            const bf16x8 vf = *(const GAS bf16x8*)(Vt + (size_t)(dt * 16 + fr) * NTOK + tok0 + ks * 32 + fq * 8);
            st.o[dt] = __builtin_amdgcn_mfma_f32_16x16x32_bf16(pf, vf, st.o[dt], 0, 0, 0);
        }
    }
    asm volatile("s_waitcnt lgkmcnt(0)" ::: "memory");
    __builtin_amdgcn_wave_barrier();
}

__device__ __forceinline__ int f2ord(float f) { const int b = __builtin_bit_cast(int, f); return b ^ ((b >> 31) & 0x7fffffff); }
__device__ __forceinline__ float ord2f(int o) { const int b = o ^ ((o >> 31) & 0x7fffffff); return __builtin_bit_cast(float, b); }
__device__ __forceinline__ void top16_insert(int (&top)[16], int key) {
#pragma unroll
    for (int i = 0; i < 16; ++i) { const int hi = max(top[i], key); key = min(top[i], key); top[i] = hi; }
}


typedef float f32x16 __attribute__((ext_vector_type(16)));
typedef short s16x4 __attribute__((ext_vector_type(4)));
typedef __bf16 bf16x2_t __attribute__((ext_vector_type(2)));
__device__ __forceinline__ unsigned cvtpk(float lo, float hi) { f32x2 v = {lo, hi}; bf16x2_t b = __builtin_convertvector(v, bf16x2_t); return __builtin_bit_cast(unsigned, b); }
constexpr int CK_PITCH = 144, CV_PITCH = 320;
constexpr int CK_SZ = 64 * CK_PITCH, CV_SZ = 64 * CV_PITCH;
constexpr float C_THR_RAW = 8.0f / SCL2;

__global__ void __launch_bounds__(NTHREADS, 2) mega_fwd(Args args) {
    extern __shared__ __attribute__((aligned(16))) unsigned char lds[];
    LAS unsigned char* L = (LAS unsigned char*)lds;
    volatile LAS unsigned* MISC = (volatile LAS unsigned*)(L + MISC_OFF);
    const int tid = threadIdx.x, lane = tid & 63, wave = __builtin_amdgcn_readfirstlane(tid >> 6);
    const int fr = lane & 15, fq = lane >> 4;
    const int G = gridDim.x;
    const int vcu = (G % 8 == 0) ? (int)(blockIdx.x % 8) * (G / 8) + (int)(blockIdx.x / 8) : (int)blockIdx.x;
    for (int u = tid; u < (LDS_BYTES - 131072) / 4; u += NTHREADS) ((LAS unsigned*)(L + 131072))[u] = 0u;
    __syncthreads();
    unsigned char* ws = args.ws;
    gu32* ctl = (gu32*)(ws + WS_CTL);
    XcdBarrier bar = xcd_barrier_post((unsigned*)(ctl + CW_BAR), MISC + 8);
    const int gw = vcu * NWAVES + wave, NGW = G * NWAVES;
    const int NGT = G * NTHREADS;

    float* MODV = (float*)(ws + WS_MOD);
    float* COS = (float*)(ws + WS_COS); float* SIN = (float*)(ws + WS_SIN);
    bf16* WIN = (bf16*)(ws + WS_WIN); bf16* WB = (bf16*)(ws + WS_WB); bf16* WO = (bf16*)(ws + WS_WO); bf16* WQ = (bf16*)(ws + WS_WQ); bf16* KEYS = (bf16*)(ws + WS_KEYS);
    float* X = (float*)(ws + WS_X); bf16* H = (bf16*)(ws + WS_H); bf16* Y = (bf16*)(ws + WS_Y); bf16* MG = (bf16*)(ws + WS_MG);
    unsigned* EI = (unsigned*)(ws + WS_EI); float* EG = (float*)(ws + WS_EG);
    unsigned char* U8 = ws + WS_U8; unsigned char* V8 = ws + WS_V8; float* SCU = (float*)(ws + WS_SCU); float* SCV = SCU + DEPTH * 16384;
    bf16* AQ = (bf16*)(ws + WS_AQ); bf16* AK = (bf16*)(ws + WS_AK); bf16* AVT = (bf16*)(ws + WS_AVT);
    bf16* BQ = (bf16*)(ws + WS_BQ); bf16* BK = (bf16*)(ws + WS_BK); bf16* BVT = (bf16*)(ws + WS_BVT);
    bf16* CQ = (bf16*)(ws + WS_CQ); bf16* CK = (bf16*)(ws + WS_CK); bf16* CVT = (bf16*)(ws + WS_CVT);
    bf16* SG = (bf16*)(ws + WS_SG); bf16* Q2 = (bf16*)(ws + WS_Q2); float* SC = (float*)(ws + WS_SC);

#ifndef SKIP_P0
    {
        LAS float* scr = (LAS float*)(L + wave * 16384);
        int gt = vcu * NTHREADS + tid; asm volatile("" : "+v"(gt));
        constexpr int I_IN = (D / 64) * (IN_W / 32), I_BR = (512 / 64) * (D / 32), I_O = (D / 64) * (D / 32), I_Q = (D / 64) * (2048 / 32);
        constexpr int PER_LAYER = I_IN + 3 * I_BR + I_O + I_Q;
        for (int it = gw; it < DEPTH * PER_LAYER; it += NGW) {
            const int l = it / PER_LAYER; int r = it % PER_LAYER;
            if (r < I_IN) { p0_transpose_item(args.in[I_WIN] + (size_t)l * D * IN_W, D, IN_W, WIN + (size_t)l * IN_W * D, scr, r, lane); continue; } r -= I_IN;
            if (r < I_BR) { p0_transpose_item(args.in[I_WBA] + (size_t)l * 512 * D, 512, D, WB + (size_t)(l * 3 + 0) * D * 512, scr, r, lane); continue; } r -= I_BR;
            if (r < I_BR) { p0_transpose_item(args.in[I_WBB] + (size_t)l * 512 * D, 512, D, WB + (size_t)(l * 3 + 1) * D * 512, scr, r, lane); continue; } r -= I_BR;
            if (r < I_BR) { p0_transpose_item(args.in[I_WBC] + (size_t)l * 512 * D, 512, D, WB + (size_t)(l * 3 + 2) * D * 512, scr, r, lane); continue; } r -= I_BR;
            if (r < I_O) { p0_transpose_item(args.in[I_WOUT] + (size_t)l * D * D, D, D, WO + (size_t)l * D * D, scr, r, lane); continue; } r -= I_O;
            p0_transpose_item(args.in[I_PWQ] + (size_t)l * D * 2048, D, 2048, WQ + (size_t)l * 2048 * D, scr, r, lane);
        }
        for (int i = gt; i < DEPTH * 16 * 128 * 128 / 4; i += NGT) {
            const f32x4 v = *((const GAS f32x4*)args.in[I_PKEYS] + i);
            v2u o; o.x = pk2(v.x, v.y); o.y = pk2(v.z, v.w); *((GAS v2u*)KEYS + i) = o;
        }
        for (int i = gt; i < T_ALL * D / 4; i += NGT) {
            const f32x4 v = (i < T_LAT * D / 4) ? *((const GAS f32x4*)args.in[I_X] + i) : *((const GAS f32x4*)args.in[I_CTX] + (i - T_LAT * D / 4));
            *((GAS f32x4*)X + i) = v;
        }
        {
            LAS float* red = (LAS float*)(L + 9216);
            for (int it = vcu; it < DEPTH * 96; it += G) {
                const int l = it / 96, nc = it % 96, n = nc * 64 + lane;
                const float* wm = args.in[I_WMOD] + (size_t)l * D * 6 * D + n;
                float a0 = 0.f, a1 = 0.f, a2 = 0.f;
#pragma unroll 8
                for (int k = wave * 128; k < wave * 128 + 128; ++k) {
                    const float c0 = args.in[I_C][k], c1 = args.in[I_C][D + k], c2 = args.in[I_CCTX][k];
                    const float w = wm[(size_t)k * 6 * D];
                    a0 += c0 * sigmoidf_(c0) * w; a1 += c1 * sigmoidf_(c1) * w; a2 += c2 * sigmoidf_(c2) * w;
                }
                red[(wave * 3 + 0) * 64 + lane] = a0; red[(wave * 3 + 1) * 64 + lane] = a1; red[(wave * 3 + 2) * 64 + lane] = a2;
                __syncthreads();
                if (wave < 3) {
                    float sum = args.in[I_BMOD][l * 6 * D + n];
#pragma unroll
                    for (int w = 0; w < 8; ++w) sum += red[(w * 3 + wave) * 64 + lane];
                    MODV[(size_t)(l * 3 + wave) * 6 * D + n] = sum;
                }
                __syncthreads();
            }
        }
        for (int i = gt; i < SEQ * 32; i += NGT) {
            const int t = i >> 5, f = i & 31;
            const double inv = pow(10000.0, -(double)(f & 15) / 16.0);
            const double pos = (f < 16) ? (double)(t / GRID_W) : (double)(t % GRID_W);
            const double ang = pos * inv;
            COS[i] = (float)cos(ang); SIN[i] = (float)sin(ang);
        }
    }
        for (int rr = gw; rr < 2 * DEPTH * 16384; rr += NGW) {
            const int tab = rr / (DEPTH * 16384), row = rr % (DEPTH * 16384);
            const float* src = (tab == 0 ? args.in[I_PU] : args.in[I_PV]) + (size_t)row * D;
            f32x4 v[4]; float am = 0.f;
#pragma unroll
            for (int j = 0; j < 4; ++j) { v[j] = *((const GAS f32x4*)src + lane + 64 * j); am = fmaxf(am, fmaxf(fmaxf(fabsf(v[j].x), fabsf(v[j].y)), fmaxf(fabsf(v[j].z), fabsf(v[j].w)))); }
#pragma unroll
            for (int o = 1; o < 64; o <<= 1) am = fmaxf(am, __shfl_xor(am, o));
            int ex = 0; float scale = 1.0f;
            if (am > 0.f) { (void)frexpf(am * (1.0f / 448.0f), &ex); scale = ldexpf(1.0f, ex); }
            const float inv = 1.0f / scale;
            v4u o;
#pragma unroll
            for (int j = 0; j < 4; ++j) {
                int p = __builtin_amdgcn_cvt_pk_fp8_f32(v[j].x * inv, v[j].y * inv, 0, false);
                p = __builtin_amdgcn_cvt_pk_fp8_f32(v[j].z * inv, v[j].w * inv, p, true);
                o[j] = (unsigned)p;
            }
            *((GAS v4u*)((tab == 0 ? U8 : V8) + (size_t)row * D) + lane) = o;
            if (lane == 0) (tab == 0 ? SCU : SCV)[row] = scale;
        }
#endif
    xcd_barrier(bar);

    for (int layer = 0; layer < DEPTH; ++layer) {
        const bool last = (layer == DEPTH - 1);
        const int T_EFF = last ? T_LAT : T_ALL;
        const float* modl = MODV + (size_t)layer * 3 * 6 * D;
        const bf16* WINl = WIN + (size_t)layer * IN_W * D;

#ifndef SKIP_P1
        { int ln = lane; asm volatile("" : "+v"(ln));
        for (int r = gw; r < T_ALL; r += NGW) {
            const float* md = modl + (size_t)row_modidx(r) * 6 * D;
            const GAS f32x4* xr = (const GAS f32x4*)(X + (size_t)r * D) + ln;
            f32x4 v[4]; float ss = 0.f;
#pragma unroll
            for (int j = 0; j < 4; ++j) { v[j] = xr[64 * j]; ss += (v[j].x * v[j].x + v[j].y * v[j].y) + (v[j].z * v[j].z + v[j].w * v[j].w); }
            const float rs = 1.0f / sqrtf(wave_sum(ss) * (1.f / D) + NORM_EPS);
            GAS v2u* o8 = (GAS v2u*)(H + (size_t)r * D) + ln;
#pragma unroll
            for (int j = 0; j < 4; ++j) {
                const f32x4 g = *((const GAS f32x4*)(args.in[I_G1] + layer * D) + ln + 64 * j);
                const f32x4 sh = *((const GAS f32x4*)(md + 0) + ln + 64 * j), sc = *((const GAS f32x4*)(md + D) + ln + 64 * j);
                const f32x4 h = v[j] * rs * g * (sc + 1.0f) + sh;
                v2u o; o.x = pk2(h.x, h.y); o.y = pk2(h.z, h.w); o8[64 * j] = o;
            }
        }
        }
#endif
        xcd_barrier(bar);

#ifndef SKIP_P2
{ int lo__ = lane; asm volatile("" : "+v"(lo__)); { const int lane = lo__; const int fr = lane & 15, fq = lane >> 4, tid = wave * 64 + lane; (void)fr; (void)fq; (void)tid;
        {
            constexpr int NMT = T_ALL / 256, NNT = IN_W / 128;
            const int wr = wave >> 1, wc = wave & 1;
            for (int it = vcu; it < NMT * NNT; it += G) {
                const int pm = it / NNT, pn = it % NNT;
                const int row0 = pm * 256 + wr * 64, col0 = pn * 128 + wc * 64;
                f32x4 acc[4][4]; zero_acc<4>(acc);
                sgemm_tile(acc, H, D, WINl, D, D, row0, col0, lane);
                const bool latent = row0 < T_LAT;
                bf16* dst = nullptr; int pitch = 0, cbase = 0; bool rope = false; int tr = 0; bf16* vt = nullptr; int dv = 64, nh = 1, hd = 0;
                if (col0 < 512)       { dst = AQ; pitch = 512; cbase = col0; rope = true; }
                else if (col0 < 640)  { dst = AK; pitch = 128; cbase = col0 - 512; rope = true; }
                else if (col0 < 768)  { tr = 1; vt = AVT; dv = 64; nh = 2; hd = col0 - 640; }
                else if (col0 < 1280) { dst = BQ; pitch = 512; cbase = col0 - 768; }
                else if (col0 < 1792) { dst = BK; pitch = 512; cbase = col0 - 1280; }
                else if (col0 < 2304) { tr = 1; vt = BVT; dv = 64; nh = 8; hd = col0 - 1792; }
                else if (col0 < 2816) { dst = CQ; pitch = 512; cbase = col0 - 2304; rope = true; }
                else if (col0 < 3328) { dst = CK; pitch = 512; cbase = col0 - 2816; rope = true; }
                else if (col0 < 3840) { dst = CVT; pitch = 512; cbase = col0 - 3328; }
                else                  { tr = 2; dst = SG; pitch = 3072; cbase = col0 - 3840; }
                if (tr == 0) {
                    if (rope && latent) {
#pragma unroll
                        for (int m = 0; m < 4; ++m)
#pragma unroll
                            for (int r = 0; r < 4; ++r) {
                                const int t = (row0 + 16 * m + 4 * fq + r) & (SEQ - 1);
#pragma unroll
                                for (int n = 0; n < 2; ++n) {
                                    const int i = 16 * n + fr;
                                    const float cs = COS[t * 32 + i], sn = SIN[t * 32 + i];
                                    const float x1 = acc[m][n][r], x2 = acc[m][n + 2][r];
                                    acc[m][n][r] = x1 * cs - x2 * sn; acc[m][n + 2][r] = x2 * cs + x1 * sn;
                                }
                            }
                    }
#pragma unroll
                    for (int m = 0; m < 4; ++m)
#pragma unroll
                        for (int r = 0; r < 4; ++r) {
                            bf16* rowp = dst + (size_t)(row0 + 16 * m + 4 * fq + r) * pitch + cbase + fr;
#pragma unroll
                            for (int n = 0; n < 4; ++n) rowp[16 * n] = (bf16)f2bf(acc[m][n][r]);
                        }
                } else if (tr == 2) {
#pragma unroll
                    for (int m = 0; m < 4; ++m)
#pragma unroll
                        for (int r = 0; r < 4; ++r) {
                            bf16* rowp = dst + (size_t)(row0 + 16 * m + 4 * fq + r) * pitch + cbase + fr;
#pragma unroll
                            for (int n = 0; n < 4; ++n) rowp[16 * n] = (bf16)f2bf(sigmoidf_(acc[m][n][r]));
                        }
                } else {
                    const int head = hd / dv, d0 = hd % dv;
#pragma unroll
                    for (int m = 0; m < 4; ++m) {
                        const int rr = row0 + 16 * m + 4 * fq;
                        const int b = row_batch(rr), tok = row_tok(rr);
#pragma unroll
                        for (int n = 0; n < 4; ++n) {
                            const int d = d0 + 16 * n + fr;
                            v2u o; o.x = pk2(acc[m][n][0], acc[m][n][1]); o.y = pk2(acc[m][n][2], acc[m][n][3]);
                            *(GAS v2u*)(vt + ((size_t)(b * nh + head) * dv + d) * NTOK + tok) = o;
                        }
                    }
                }
            }
        }
} }
#endif
        xcd_barrier(bar);

#ifndef SKIP_P3
        {
            LAS bf16* Pl = (LAS bf16*)(L + wave * 8192);
            const float lam_init = 0.8f - 0.6f * expf(-0.3f * (float)layer);
            float lam;
            {
                int ll = lane; asm volatile("" : "+v"(ll));
                const float* cl = args.in[I_LAMBDA] + layer * 256;
                const float s1 = wave_sum(cl[ll] * cl[64 + ll]), s2 = wave_sum(cl[128 + ll] * cl[192 + ll]);
                lam = expf(s1) - expf(s2) + lam_init;
            }
{ int lo__ = lane; asm volatile("" : "+v"(lo__)); { const int lane = lo__; const int fr = lane & 15, fq = lane >> 4, tid = wave * 64 + lane; (void)fr; (void)fq; (void)tid;
            {
                const int r32 = lane & 31, hi = lane >> 5;
                const int n_lat = BATCH * 4 * (SEQ / 256), n_ctx = last ? 0 : BATCH * 4;
                const int NU = (n_lat + G - 1) / G * G + n_ctx;
                for (int rep_ = 0; rep_ < REP_P3C; ++rep_)
                for (int u0 = vcu; u0 < NU; u0 += G) {
                    int b, h, row0, t_lo, t_hi;
                    if (u0 < n_lat) { const int bh = u0 >> 5; b = bh >> 2; h = bh & 3; row0 = b * SEQ + (u0 & 31) * 256; t_lo = 0; t_hi = 132; }
                    else { const int c = u0 - (n_lat + G - 1) / G * G; if (c < 0 || c >= n_ctx) continue; b = c >> 2; h = c & 3; row0 = T_LAT + b * CTX; t_lo = 128; t_hi = 132; }
                    const int qrow = row0 + wave * 32 + r32;
                    LAS unsigned* o1p = (LAS unsigned*)(L + 65536 + wave * 8192) + lane;
                    const int krow_s = tid >> 3, kch_s = tid & 7;
                    const int vrow_s0 = tid >> 4, vch_s = tid & 15;
                    LAS unsigned char* Kb0 = L; LAS unsigned char* Vb0 = L + 2 * CK_SZ;
#pragma unroll 1
                    for (int m = 0; m < 2; ++m) {
                        bf16x8 qf[4];
                        { const bf16* qp = CQ + (size_t)qrow * 512 + (h * 2 + m) * 64 + hi * 8;
#pragma unroll
                          for (int ks = 0; ks < 4; ++ks) qf[ks] = *(const GAS bf16x8*)(qp + ks * 16); }
                        f32x16 o[4];
#pragma unroll
                        for (int d = 0; d < 4; ++d)
#pragma unroll
                            for (int r = 0; r < 16; ++r) o[d][r] = 0.f;
                        float mrun = -1e30f, lpart = 0.f;
                        const bf16* kg = CK + (size_t)krow_s * 512 + (h * 2 + m) * 64 + kch_s * 8;
                        const bf16* vg = CVT + (size_t)vrow_s0 * 512 + h * 128 + vch_s * 8;
                        auto tile_row = [&](int j) { return (j < 128) ? b * SEQ + 64 * j : T_LAT + b * CTX + 64 * (j - 128); };
                        __syncthreads();
                        {
                            const size_t kb = (size_t)tile_row(t_lo) * 512;
                            const v4u kr = *(const GAS v4u*)(kg + kb), v0 = *(const GAS v4u*)(vg + kb), v1 = *(const GAS v4u*)(vg + kb + 32 * 512);
                            *(LAS v4u*)(Kb0 + krow_s * CK_PITCH + kch_s * 16) = kr;
                            *(LAS v4u*)(Vb0 + vrow_s0 * CV_PITCH + vch_s * 16) = v0; *(LAS v4u*)(Vb0 + (vrow_s0 + 32) * CV_PITCH + vch_s * 16) = v1;
                        }
                        __syncthreads();
#pragma unroll 1
                        for (int j = t_lo; j < t_hi; ++j) {
                            const int cur = (j - t_lo) & 1;
                            const LAS unsigned char* Kb = Kb0 + cur * CK_SZ; const LAS unsigned char* Vb = Vb0 + cur * CV_SZ;
                            v4u kr, v0, v1;
                            const bool more = (j + 1 < t_hi);
                            if (more) { const size_t kb = (size_t)tile_row(j + 1) * 512; kr = *(const GAS v4u*)(kg + kb); v0 = *(const GAS v4u*)(vg + kb); v1 = *(const GAS v4u*)(vg + kb + 32 * 512); }
                            f32x16 st[2];
#pragma unroll
                            for (int kb = 0; kb < 2; ++kb) {
#pragma unroll
                                for (int r = 0; r < 16; ++r) st[kb][r] = 0.f;
#pragma unroll
                                for (int ks = 0; ks < 4; ++ks) {
                                    const bf16x8 kf = *(const LAS bf16x8*)(Kb + (kb * 32 + r32) * CK_PITCH + ks * 32 + hi * 16);
                                    st[kb] = __builtin_amdgcn_mfma_f32_32x32x16_bf16(kf, qf[ks], st[kb], 0, 0, 0);
                                }
                            }
                            float mx = st[0][0];
#pragma unroll
                            for (int r = 1; r < 16; ++r) mx = fmaxf(mx, st[0][r]);
#pragma unroll
                            for (int r = 0; r < 16; ++r) mx = fmaxf(mx, st[1][r]);
                            mx = fmaxf(mx, __shfl_xor(mx, 32));
                            if (__builtin_amdgcn_ballot_w64(mx > mrun + C_THR_RAW) != 0ull) {
                                const float mn = fmaxf(mrun, mx);
                                const float alpha = __builtin_amdgcn_exp2f((mrun - mn) * SCL2);
#pragma unroll
                                for (int d = 0; d < 4; ++d)
#pragma unroll
                                    for (int r = 0; r < 16; ++r) o[d][r] *= alpha;
                                lpart *= alpha; mrun = mn;
                            }
                            const float nmc = -mrun * SCL2;
                            float ls = 0.f;
#pragma unroll
                            for (int kb = 0; kb < 2; ++kb)
#pragma unroll
                                for (int r = 0; r < 16; ++r) { const float p = __builtin_amdgcn_exp2f(fmaf(st[kb][r], SCL2, nmc)); st[kb][r] = p; ls += p; }
                            lpart += ls;
                            {
                                const int q4 = (lane & 15) >> 2, p4 = lane & 3, grp = (lane >> 4) & 1;
                                const LAS unsigned char* vbase = Vb + (4 * hi + q4) * CV_PITCH + (16 * grp + 4 * p4) * 2;
#pragma unroll
                                for (int kb = 0; kb < 2; ++kb)
#pragma unroll
                                    for (int ss = 0; ss < 2; ++ss) {
                                        v4u pw;
#pragma unroll
                                        for (int i2 = 0; i2 < 4; ++i2) pw[i2] = cvtpk(st[kb][8 * ss + 2 * i2], st[kb][8 * ss + 2 * i2 + 1]);
                                        const bf16x8 pb = __builtin_bit_cast(bf16x8, pw);
#pragma unroll
                                        for (int d = 0; d < 4; ++d) {
                                            const LAS unsigned char* va = vbase + (kb * 32 + 16 * ss) * CV_PITCH + d * 64;
                                            const s16x4 lo = __builtin_bit_cast(s16x4, __builtin_amdgcn_ds_read_tr16_b64_v4i16((LAS s16x4*)va));
                                            const s16x4 hh = __builtin_bit_cast(s16x4, __builtin_amdgcn_ds_read_tr16_b64_v4i16((LAS s16x4*)(va + 8 * CV_PITCH)));
                                            const bf16x8 vf = __builtin_shufflevector(lo, hh, 0, 1, 2, 3, 4, 5, 6, 7);
                                            o[d] = __builtin_amdgcn_mfma_f32_32x32x16_bf16(vf, pb, o[d], 0, 0, 0);
                                        }
                                        if (ss == 1) __builtin_amdgcn_sched_barrier(0);
                                    }
                            }
                            if (more) {
                                LAS unsigned char* Kn = Kb0 + (cur ^ 1) * CK_SZ; LAS unsigned char* Vn = Vb0 + (cur ^ 1) * CV_SZ;
                                *(LAS v4u*)(Kn + krow_s * CK_PITCH + kch_s * 16) = kr;
                                *(LAS v4u*)(Vn + vrow_s0 * CV_PITCH + vch_s * 16) = v0; *(LAS v4u*)(Vn + (vrow_s0 + 32) * CV_PITCH + vch_s * 16) = v1;
                            }
                            __syncthreads();
                        }
                        const float lt = lpart + __shfl_xor(lpart, 32);
                        if (m == 0) {
                            const float inv = 1.0f / lt;
#pragma unroll
                            for (int d = 0; d < 4; ++d)
#pragma unroll
                                for (int i2 = 0; i2 < 8; ++i2) o1p[64 * (d * 8 + i2)] = cvtpk(o[d][2 * i2] * inv, o[d][2 * i2 + 1] * inv);
                        } else {
                            const float inv2 = lam / lt;
                            float ssq = 0.f;
#pragma unroll
                            for (int d = 0; d < 4; ++d)
#pragma unroll
                                for (int i2 = 0; i2 < 8; ++i2) {
                                    const unsigned w1 = o1p[64 * (d * 8 + i2)];
                                    const float a0 = bf2f(w1 & 0xffffu) - o[d][2 * i2] * inv2, a1 = bf2f(w1 >> 16) - o[d][2 * i2 + 1] * inv2;
                                    o[d][2 * i2] = a0; o[d][2 * i2 + 1] = a1; ssq += a0 * a0 + a1 * a1;
                                }
                            ssq += __shfl_xor(ssq, 32);
                            const float rn = 1.0f / sqrtf(ssq * (1.f / 128.f) + NORM_EPS) * (1.0f - lam_init);
                            bf16* yp = Y + (size_t)qrow * 1536 + 1024 + h * 128 + 4 * hi;
                            const float* sl = args.in[I_SUBLN] + layer * 512 + h * 128 + 4 * hi;
#pragma unroll
                            for (int d = 0; d < 4; ++d)
#pragma unroll
                                for (int g4 = 0; g4 < 4; ++g4) {
                                    const f32x4 gsl = *(const GAS f32x4*)(sl + d * 32 + 8 * g4);
                                    v2u w; w.x = cvtpk(o[d][4 * g4] * rn * gsl.x, o[d][4 * g4 + 1] * rn * gsl.y); w.y = cvtpk(o[d][4 * g4 + 2] * rn * gsl.z, o[d][4 * g4 + 3] * rn * gsl.w);
                                    *(GAS v2u*)(yp + d * 32 + 8 * g4) = w;
                                }
                        }
                    }
                }
                __syncthreads();
            }
} }
{ int lo__ = lane; asm volatile("" : "+v"(lo__)); { const int lane = lo__; const int fr = lane & 15, fq = lane >> 4, tid = wave * 64 + lane; (void)fr; (void)fq; (void)tid;
            {
                const int n_lat = BATCH * 8 * (SEQ / 16), n_ctx = last ? 0 : BATCH * 8 * (CTX / 16);
                for (int it = gw; it < n_lat + n_ctx; it += NGW) {
                    int b, hq, row0, qpos0 = 0; const bool isctx = it >= n_lat;
                    if (!isctx) { b = it / (8 * 512); hq = (it / 512) % 8; qpos0 = (it % 512) * 16; row0 = b * SEQ + qpos0; }
                    else { const int j = it - n_lat; b = j / (8 * 16); hq = (j / 16) % 8; row0 = T_LAT + b * CTX + (j % 16) * 16; }
                    const int g = hq >> 2;
                    bf16x8 qf[2];
                    { const bf16* qp = AQ + (size_t)(row0 + fr) * 512 + hq * 64 + fq * 8; qf[0] = *(const GAS bf16x8*)qp; qf[1] = *(const GAS bf16x8*)(qp + 32); }
                    AttnAcc<4> st;
                    const float sk = args.in[I_SINK][layer * 8 + hq] * LOG2E;
#pragma unroll
                    for (int r = 0; r < 4; ++r) { st.m[r] = sk; st.l[r] = (fr == 0) ? 1.0f : 0.0f; }
#pragma unroll
                    for (int dt = 0; dt < 4; ++dt) st.o[dt] = (f32x4){0.f, 0.f, 0.f, 0.f};
                    const bf16* Vt = AVT + (size_t)(b * 2 + g) * 64 * NTOK;
                    if (!isctx) {
                        const int al = ((qpos0 - 128) >> 5) << 5;
                        for (int ks = al; ks < qpos0 + 144; ks += 32) {
                            if (ks < 0 || ks >= SEQ) continue;
                            f32x4 s[2];
#pragma unroll
                            for (int t = 0; t < 2; ++t) {
                                s[t] = s_tile(qf, AK, 128, g * 64, b * SEQ + ks + 16 * t, fr, fq) * SCL2;
                                const int kpos = ks + 16 * t + fr;
#pragma unroll
                                for (int r = 0; r < 4; ++r) { const int dq = qpos0 + 4 * fq + r - kpos; if (dq > 128 || dq < -128) s[t][r] = -1e30f; }
                            }
                            softmax_update<2, 4, 40>(st, s, Pl, fr, fq);
                            pv_update<1, 4, 40>(st, Pl, Vt, ks, fr, fq);
                        }
                    }
                    for (int u = 0; u < 8; ++u) {
                        f32x4 s[2];
#pragma unroll
                        for (int t = 0; t < 2; ++t) s[t] = s_tile(qf, AK, 128, g * 64, T_LAT + b * CTX + 32 * u + 16 * t, fr, fq) * SCL2;
                        softmax_update<2, 4, 40>(st, s, Pl, fr, fq);
                        pv_update<1, 4, 40>(st, Pl, Vt, SEQ + 32 * u, fr, fq);
                    }
#pragma unroll
                    for (int r = 0; r < 4; ++r) {
                        const float il = 1.0f / grp16_sum(st.l[r]);
                        bf16* yp = Y + (size_t)(row0 + 4 * fq + r) * 1536 + hq * 64 + fr;
#pragma unroll
                        for (int dt = 0; dt < 4; ++dt) yp[16 * dt] = (bf16)f2bf(st.o[dt][r] * il);
                    }
                }
            }
} }
{ int lo__ = lane; asm volatile("" : "+v"(lo__)); { const int lane = lo__; const int fr = lane & 15, fq = lane >> 4, tid = wave * 64 + lane; (void)fr; (void)fq; (void)tid;
            {
                const int n_lat = BATCH * 8 * 128 * 4, n_ctx = last ? 0 : BATCH * 8 * (CTX / 16);
                for (int it = gw; it < n_lat + n_ctx; it += NGW) {
                    int b, h, row0, gr = 0, nb = 0; const bool isctx = it >= n_lat;
                    if (!isctx) { b = it / (8 * 512); h = (it / 512) % 8; gr = (it % 512) / 4; nb = it % 4; row0 = b * SEQ + gr * GRID_W + nb * 16; }
                    else { const int j = it - n_lat; b = j / (8 * 16); h = (j / 16) % 8; row0 = T_LAT + b * CTX + (j % 16) * 16; }
                    bf16x8 qf[2];
                    { const bf16* qp = BQ + (size_t)(row0 + fr) * 512 + h * 64 + fq * 8; qf[0] = *(const GAS bf16x8*)qp; qf[1] = *(const GAS bf16x8*)(qp + 32); }
                    AttnAcc<4> st;
#pragma unroll
                    for (int r = 0; r < 4; ++r) { st.m[r] = -1e30f; st.l[r] = 0.f; }
#pragma unroll
                    for (int dt = 0; dt < 4; ++dt) st.o[dt] = (f32x4){0.f, 0.f, 0.f, 0.f};
                    const bf16* Vt = BVT + (size_t)(b * 8 + h) * 64 * NTOK;
                    if (!isctx) {
                        const int rs = min(max(gr - 4, 0), 120);
                        const int band0 = min(max(nb * 16 - 8, 0), 32);
                        const float* rpb = args.in[I_RPB] + (size_t)(layer * 8 + h) * 15 * 31;
                        for (int i = 0; i < 8; ++i) {
                            const int ktok0 = (rs + i) * GRID_W + band0;
                            const int dr = rs + i - gr + 7;
                            f32x4 s[2];
#pragma unroll
                            for (int t = 0; t < 2; ++t) {
                                s[t] = s_tile(qf, BK, 512, h * 64, b * SEQ + ktok0 + 16 * t, fr, fq) * SCL2;
                                const int kc = band0 + 16 * t + fr;
#pragma unroll
                                for (int r = 0; r < 4; ++r) {
                                    const int qc = nb * 16 + 4 * fq + r;
                                    const int cstart = min(max(qc - 8, 0), 48);
                                    const int dc = min(max(kc - qc, -15), 15) + 15;
                                    const bool valid = (kc >= cstart) && (kc < cstart + 16);
                                    s[t][r] = valid ? s[t][r] + rpb[dr * 31 + dc] * LOG2E : -1e30f;
                                }
                            }
                            softmax_update<2, 4, 40>(st, s, Pl, fr, fq);
                            pv_update<1, 4, 40>(st, Pl, Vt, ktok0, fr, fq);
                        }
                    }
                    for (int u = 0; u < 8; ++u) {
                        f32x4 s[2];
#pragma unroll
                        for (int t = 0; t < 2; ++t) s[t] = s_tile(qf, BK, 512, h * 64, T_LAT + b * CTX + 32 * u + 16 * t, fr, fq) * SCL2;
                        softmax_update<2, 4, 40>(st, s, Pl, fr, fq);
                        pv_update<1, 4, 40>(st, Pl, Vt, SEQ + 32 * u, fr, fq);
                    }
#pragma unroll
                    for (int r = 0; r < 4; ++r) {
                        const float il = 1.0f / grp16_sum(st.l[r]);
                        bf16* yp = Y + (size_t)(row0 + 4 * fq + r) * 1536 + 512 + h * 64 + fr;
#pragma unroll
                        for (int dt = 0; dt < 4; ++dt) yp[16 * dt] = (bf16)f2bf(st.o[dt][r] * il);
                    }
                }
            }
} }
        }
#endif
        xcd_barrier(bar);

#ifndef SKIP_P4
{ int lo__ = lane; asm volatile("" : "+v"(lo__)); { const int lane = lo__; const int fr = lane & 15, fq = lane >> 4, tid = wave * 64 + lane; (void)fr; (void)fq; (void)tid;
        {
            const int NMT = T_EFF / 256; constexpr int NNT = D / 64;
            const int wr = wave >> 1, wc = wave & 1;
            for (int it = vcu; it < NMT * NNT; it += G) {
                const int pm = it / NNT, pn = it % NNT;
                const int row0 = pm * 256 + wr * 64, col0 = pn * 64 + wc * 32;
                f32x4 mg[4][2]; zero_acc<2>(mg);
#pragma unroll 1
                for (int seg = 0; seg < 3; ++seg) {
                    f32x4 acc[4][2]; zero_acc<2>(acc);
                    sgemm_tile<1, 2>(acc, Y + seg * 512, 1536, WB + (size_t)(layer * 3 + seg) * D * 512, 512, 512, row0, col0, lane);
#pragma unroll
                    for (int m = 0; m < 4; ++m)
#pragma unroll
                        for (int r = 0; r < 4; ++r) {
                            const bf16* gp = SG + (size_t)(row0 + 16 * m + 4 * fq + r) * 3072 + seg * 1024 + col0 + fr;
#pragma unroll
                            for (int n = 0; n < 2; ++n) mg[m][n][r] += bf2f(gp[16 * n]) * acc[m][n][r];
                        }
                }
#pragma unroll
                for (int m = 0; m < 4; ++m)
#pragma unroll
                    for (int r = 0; r < 4; ++r) {
                        bf16* rowp = MG + (size_t)(row0 + 16 * m + 4 * fq + r) * D + col0 + fr;
#pragma unroll
                        for (int n = 0; n < 2; ++n) rowp[16 * n] = (bf16)f2bf(mg[m][n][r]);
                    }
            }
        }
} }
#endif
        xcd_barrier(bar);

#ifndef SKIP_P5
{ int lo__ = lane; asm volatile("" : "+v"(lo__)); { const int lane = lo__; const int fr = lane & 15, fq = lane >> 4, tid = wave * 64 + lane; (void)fr; (void)fq; (void)tid;
        {
            const int NMT = T_EFF / 256; constexpr int NNT = D / 128;
            const int wr = wave >> 1, wc = wave & 1;
            for (int it = vcu; it < NMT * NNT; it += G) {
                const int pm = it / NNT, pn = it % NNT;
                const int row0 = pm * 256 + wr * 64, col0 = pn * 128 + wc * 64;
                f32x4 acc[4][4]; zero_acc<4>(acc);
                sgemm_tile(acc, MG, D, WO + (size_t)layer * D * D, D, D, row0, col0, lane);
                const float* gt = modl + (size_t)row_modidx(row0) * 6 * D + 2 * D + col0 + fr;
#pragma unroll
                for (int m = 0; m < 4; ++m)
#pragma unroll
                    for (int r = 0; r < 4; ++r) {
                        float* rowp = X + (size_t)(row0 + 16 * m + 4 * fq + r) * D + col0 + fr;
#pragma unroll
                        for (int n = 0; n < 4; ++n) rowp[16 * n] += gt[16 * n] * acc[m][n][r];
                    }
            }
        }
} }
#endif
        xcd_barrier(bar);

#ifndef SKIP_P6
        { int ln = lane; asm volatile("" : "+v"(ln));
        for (int r = gw; r < T_EFF; r += NGW) {
            const float* md = modl + (size_t)row_modidx(r) * 6 * D;
            const GAS f32x4* xr = (const GAS f32x4*)(X + (size_t)r * D) + ln;
            f32x4 v[4]; float ss = 0.f;
#pragma unroll
            for (int j = 0; j < 4; ++j) { v[j] = xr[64 * j]; ss += (v[j].x * v[j].x + v[j].y * v[j].y) + (v[j].z * v[j].z + v[j].w * v[j].w); }
            const float rs = 1.0f / sqrtf(wave_sum(ss) * (1.f / D) + NORM_EPS);
            GAS v2u* o8 = (GAS v2u*)(H + (size_t)r * D) + ln;
#pragma unroll
            for (int j = 0; j < 4; ++j) {
                const f32x4 g = *((const GAS f32x4*)(args.in[I_G2] + layer * D) + ln + 64 * j);
                const f32x4 sh = *((const GAS f32x4*)(md + 3 * D) + ln + 64 * j), sc = *((const GAS f32x4*)(md + 4 * D) + ln + 64 * j);
                const f32x4 h = v[j] * rs * g * (sc + 1.0f) + sh;
                v2u o; o.x = pk2(h.x, h.y); o.y = pk2(h.z, h.w); o8[64 * j] = o;
            }
        }
        }
#endif
        xcd_barrier(bar);

#ifndef SKIP_P7
{ int lo__ = lane; asm volatile("" : "+v"(lo__)); { const int lane = lo__; const int fr = lane & 15, fq = lane >> 4, tid = wave * 64 + lane; (void)fr; (void)fq; (void)tid;
        {
            const int NMT = T_EFF / 256; constexpr int NNT = 2048 / 128;
            const int wr = wave >> 1, wc = wave & 1;
            for (int it = vcu; it < NMT * NNT; it += G) {
                const int pm = it / NNT, pn = it % NNT;
                const int row0 = pm * 256 + wr * 64, col0 = pn * 128 + wc * 64;
                f32x4 acc[4][4]; zero_acc<4>(acc);
                sgemm_tile(acc, H, D, WQ + (size_t)layer * 2048 * D, D, D, row0, col0, lane);
#pragma unroll
                for (int m = 0; m < 4; ++m)
#pragma unroll
                    for (int r = 0; r < 4; ++r) {
                        bf16* rowp = Q2 + (size_t)(row0 + 16 * m + 4 * fq + r) * 2048 + col0 + fr;
#pragma unroll
                        for (int n = 0; n < 4; ++n) rowp[16 * n] = (bf16)f2bf(acc[m][n][r]);
                    }
            }
        }
} }
#endif
        xcd_barrier(bar);

#ifndef SKIP_P8
{ int lo__ = lane; asm volatile("" : "+v"(lo__)); { const int lane = lo__; const int fr = lane & 15, fq = lane >> 4, tid = wave * 64 + lane; (void)fr; (void)fq; (void)tid;
        {
            const int NMT = T_EFF / 256; constexpr int NNT = 2048 / 128;
            const int wr = wave >> 1, wc = wave & 1;
            for (int it = vcu; it < NMT * NNT; it += G) {
                const int pm = it / NNT, grp = it % NNT;
                const int row0 = pm * 256 + wr * 64, c0 = wc * 64;
                f32x4 acc[4][4]; zero_acc<4>(acc);
                sgemm_tile(acc, Q2 + grp * 128, 2048, KEYS + (size_t)(layer * 16 + grp) * 128 * 128, 128, 128, row0, c0, lane);
#pragma unroll
                for (int m = 0; m < 4; ++m)
#pragma unroll
                    for (int r = 0; r < 4; ++r) {
                        float* rowp = SC + (size_t)(row0 + 16 * m + 4 * fq + r) * 2048 + grp * 128 + c0 + fr;
#pragma unroll
                        for (int n = 0; n < 4; ++n) rowp[16 * n] = acc[m][n][r];
                    }
            }
        }
} }
#endif
        xcd_barrier(bar);

#ifndef SKIP_P9
{ int lo__ = lane; asm volatile("" : "+v"(lo__)); { const int lane = lo__; const int fr = lane & 15, fq = lane >> 4, tid = wave * 64 + lane; (void)fr; (void)fq; (void)tid;
        for (int it = vcu * NTHREADS + tid; it < T_EFF * PEER_HEADS; it += NGT) {
            const int t = it >> 3, hh = it & 7;
            const float* sc = SC + (size_t)t * 2048 + hh * 256;
            int a0[16], a1[16];
#pragma unroll
            for (int i = 0; i < 16; ++i) { a0[i] = (int)0x80000000; a1[i] = (int)0x80000000; }
            for (int k = 0; k < 128; k += 4) {
                const f32x4 v = *(const GAS f32x4*)(sc + k);
                top16_insert(a0, (f2ord(v.x) & ~127) | (k + 0)); top16_insert(a0, (f2ord(v.y) & ~127) | (k + 1));
                top16_insert(a0, (f2ord(v.z) & ~127) | (k + 2)); top16_insert(a0, (f2ord(v.w) & ~127) | (k + 3));
            }
            for (int k = 0; k < 128; k += 4) {
                const f32x4 v = *(const GAS f32x4*)(sc + 128 + k);
                top16_insert(a1, (f2ord(v.x) & ~127) | (k + 0)); top16_insert(a1, (f2ord(v.y) & ~127) | (k + 1));
                top16_insert(a1, (f2ord(v.z) & ~127) | (k + 2)); top16_insert(a1, (f2ord(v.w) & ~127) | (k + 3));
            }
            int c[16];
#pragma unroll
            for (int i = 0; i < 16; ++i) c[i] = (int)0x80000000;
#pragma unroll
            for (int i = 0; i < 16; ++i) {
                const float vi = ord2f(a0[i] & ~127);
#pragma unroll
                for (int j = 0; j < 16; ++j) {
                    if ((i + 1) * (j + 1) <= 16) {
                        const float sj = vi + ord2f(a1[j] & ~127);
                        top16_insert(c, (f2ord(sj) & ~255) | (i * 16 + j));
                    }
                }
            }
            const float smax = ord2f(c[0] & ~255);
            float pe[16]; float psum = 0.f;
#pragma unroll
            for (int k = 0; k < 16; ++k) { pe[k] = __expf(ord2f(c[k] & ~255) - smax); psum += pe[k]; }
            const float ip = 1.0f / psum;
#pragma unroll
            for (int k = 0; k < 16; ++k) {
                const int ij = c[k] & 255, ii = ij >> 4, jj = ij & 15;
                int e0 = 0, e1 = 0;
#pragma unroll
                for (int q = 0; q < 16; ++q) { e0 = (ii == q) ? (a0[q] & 127) : e0; e1 = (jj == q) ? (a1[q] & 127) : e1; }
                const int e = e0 * PEER_KEYS + e1;
                const float su = SCU[layer * 16384 + e], sv = SCV[layer * 16384 + e];
                EI[(size_t)t * NSEL + hh * 16 + k] = (unsigned)e | (f2bf(su) << 16);
                EG[(size_t)t * NSEL + hh * 16 + k] = pe[k] * ip * sv;
            }
        }
} }
#endif
        xcd_barrier(bar);

#ifndef SKIP_P10
        { int ln = lane; asm volatile("" : "+v"(ln));
        {
            const unsigned char* U8l = U8 + (size_t)layer * 16384 * D;
            const unsigned char* V8l = V8 + (size_t)layer * 16384 * D;
            for (int t = gw; t < T_EFF; t += NGW) {
                f32x4 hv[4];
                { const GAS v2u* hp = (const GAS v2u*)(H + (size_t)t * D) + ln;
#pragma unroll
                  for (int j = 0; j < 4; ++j) { const v2u w = hp[64 * j]; hv[j] = (f32x4){bf2f(w.x & 0xffffu), bf2f(w.x >> 16), bf2f(w.y & 0xffffu), bf2f(w.y >> 16)}; } }
                f32x4 o[4];
#pragma unroll
                for (int j = 0; j < 4; ++j) o[j] = (f32x4){0.f, 0.f, 0.f, 0.f};
#pragma unroll 1
                for (int s0 = 0; s0 < NSEL; s0 += 32) {
                    const unsigned esu = EI[(size_t)t * NSEL + s0 + (ln & 31)]; const float gv = EG[(size_t)t * NSEL + s0 + (ln & 31)];
                    int eidx = (int)(esu & 0xffffu); const float su = bf2f(esu >> 16);
                    float p[32];
                    {
                        v4u rowa[8], rowb[8];
#pragma unroll
                        for (int q = 0; q < 8; ++q) { const int e = __builtin_amdgcn_readlane(eidx, q); rowa[q] = *((const GAS v4u*)(U8l + (size_t)e * D) + ln); }
#pragma unroll
                        for (int g = 0; g < 4; ++g) {
                            if (g < 3) {
#pragma unroll
                                for (int q = 0; q < 8; ++q) { const int e = __builtin_amdgcn_readlane(eidx, (g + 1) * 8 + q);
                                    if (g & 1) rowa[q] = *((const GAS v4u*)(U8l + (size_t)e * D) + ln); else rowb[q] = *((const GAS v4u*)(U8l + (size_t)e * D) + ln); }
                            }
                            __builtin_amdgcn_sched_barrier(0);
#pragma unroll
                            for (int q = 0; q < 8; ++q) {
                                const v4u rw = (g & 1) ? rowb[q] : rowa[q];
                                float dd = 0.f;
#pragma unroll
                                for (int j = 0; j < 4; ++j) {
                                    const f32x2 a = __builtin_amdgcn_cvt_pk_f32_fp8((int)rw[j], false), b = __builtin_amdgcn_cvt_pk_f32_fp8((int)rw[j], true);
                                    dd += (a.x * hv[j].x + a.y * hv[j].y) + (b.x * hv[j].z + b.y * hv[j].w);
                                }
                                asm volatile("" : "+v"(dd));
                                p[g * 8 + q] = dd;
                                __builtin_amdgcn_sched_barrier(0);
                            }
                        }
                    }
#pragma unroll
                    for (int w = 16; w >= 1; w >>= 1) {
                        const bool up = (ln & w) != 0;
#pragma unroll
                        for (int i = 0; i < w; ++i) {
                            const float send = up ? p[i] : p[i + w], keep = up ? p[i + w] : p[i];
                            p[i] = keep + __shfl_xor(send, w);
                        }
                    }
                    const float dot = (p[0] + __shfl_xor(p[0], 32)) * su;
                    float wgt = 0.5f * dot * (1.0f + erff(dot * 0.70710678118654752f)) * gv;
                    asm volatile("" : "+v"(eidx), "+v"(wgt));
                    {
                        v4u rowa[8], rowb[8];
#pragma unroll
                        for (int q = 0; q < 8; ++q) { const int e = __builtin_amdgcn_readlane(eidx, q); rowa[q] = *((const GAS v4u*)(V8l + (size_t)e * D) + ln); }
#pragma unroll
                        for (int g = 0; g < 4; ++g) {
                            if (g < 3) {
#pragma unroll
                                for (int q = 0; q < 8; ++q) { const int e = __builtin_amdgcn_readlane(eidx, (g + 1) * 8 + q);
                                    if (g & 1) rowa[q] = *((const GAS v4u*)(V8l + (size_t)e * D) + ln); else rowb[q] = *((const GAS v4u*)(V8l + (size_t)e * D) + ln); }
                            }
                            __builtin_amdgcn_sched_barrier(0);
#pragma unroll
                            for (int q = 0; q < 8; ++q) {
                                const v4u rw = (g & 1) ? rowb[q] : rowa[q];
                                const float wq = __builtin_bit_cast(float, __builtin_amdgcn_readlane(__builtin_bit_cast(int, wgt), g * 8 + q));
#pragma unroll
                                for (int j = 0; j < 4; ++j) {
                                    const f32x2 a = __builtin_amdgcn_cvt_pk_f32_fp8((int)rw[j], false), b = __builtin_amdgcn_cvt_pk_f32_fp8((int)rw[j], true);
                                    o[j].x += wq * a.x; o[j].y += wq * a.y; o[j].z += wq * b.x; o[j].w += wq * b.y;
                                }
                                asm volatile("" : "+v"(o[0]), "+v"(o[1]), "+v"(o[2]), "+v"(o[3]));
                                __builtin_amdgcn_sched_barrier(0);
                            }
                        }
                    }
                }
                const float* gt2 = modl + (size_t)row_modidx(t) * 6 * D + 5 * D;
                GAS f32x4* xr = (GAS f32x4*)(X + (size_t)t * D) + ln;
                f32x4 xn[4]; float ss = 0.f;
#pragma unroll
                for (int j = 0; j < 4; ++j) {
                    xn[j] = xr[64 * j] + *((const GAS f32x4*)gt2 + ln + 64 * j) * o[j];
                    ss += (xn[j].x * xn[j].x + xn[j].y * xn[j].y) + (xn[j].z * xn[j].z + xn[j].w * xn[j].w);
                }
                if (!last) {
#pragma unroll
                    for (int j = 0; j < 4; ++j) xr[64 * j] = xn[j];
                } else {
                    const float rs = 1.0f / sqrtf(wave_sum(ss) * (1.f / D) + NORM_EPS);
                    GAS f32x4* op = (GAS f32x4*)(args.out + (size_t)t * D) + ln;
#pragma unroll
                    for (int j = 0; j < 4; ++j) op[64 * j] = xn[j] * rs * *((const GAS f32x4*)args.in[I_GFINAL] + ln + 64 * j);
                }
            }
        }
        }
#endif
        if (!last) xcd_barrier(bar);
    }
}

extern "C" void kernel_launch(void* const* d_in, const int* in_sizes, int n_in, void* d_out, int out_size, void* d_ws, size_t ws_size, hipStream_t stream) {
    static int grid = 0;
    if (grid == 0) {
        if (n_in != 22 || out_size != T_LAT * D || ws_size < WS_END) { fprintf(stderr, "kernel_launch: unexpected shapes: n_in %d out %d ws %zu (need %zu)\n", n_in, out_size, ws_size, (size_t)WS_END); grid = -1; return; }
        int dev = 0, cus = 0, per_cu = 0;
        if (hipGetDevice(&dev) != hipSuccess || hipDeviceGetAttribute(&cus, hipDeviceAttributeMultiprocessorCount, dev) != hipSuccess) { fprintf(stderr, "device query failed\n"); grid = -1; return; }
        if (hipFuncSetAttribute((const void*)mega_fwd, hipFuncAttributeMaxDynamicSharedMemorySize, LDS_BYTES) != hipSuccess) { fprintf(stderr, "hipFuncSetAttribute failed\n"); grid = -1; return; }
        if (hipOccupancyMaxActiveBlocksPerMultiprocessor(&per_cu, (const void*)mega_fwd, NTHREADS, LDS_BYTES) != hipSuccess || per_cu < 1) { fprintf(stderr, "occupancy query: %d\n", per_cu); }
        (void)hipGetLastError();
        grid = cus;
    }
    if (grid < 0) return;
    if (hipMemsetAsync((char*)d_ws + WS_CTL, 0, CTL_ZERO_BYTES, stream) != hipSuccess) { fprintf(stderr, "memset failed\n"); return; }
    Args a{};
    for (int i = 0; i < 22; ++i) a.in[i] = (const float*)d_in[i];
    a.out = (float*)d_out; a.ws = (unsigned char*)d_ws;
    hipLaunchKernelGGL(mega_fwd, dim3(grid), dim3(NTHREADS), LDS_BYTES, stream, a);
}
```

```cpp
#include <hip/hip_runtime.h>
#include <cstdio>
#include <cstdint>

#ifndef REP_P3C
#define REP_P3C 1
#endif
#define GAS __attribute__((address_space(1)))
#define LAS __attribute__((address_space(3)))
typedef unsigned short bf16;
typedef float f32x4 __attribute__((ext_vector_type(4)));
typedef short bf16x8 __attribute__((ext_vector_type(8)));
typedef unsigned v4u __attribute__((ext_vector_type(4)));
typedef unsigned v2u __attribute__((ext_vector_type(2)));
typedef float f32x2 __attribute__((ext_vector_type(2)));
typedef GAS unsigned gu32;

constexpr int NWAVES = 8, NTHREADS = 512;
constexpr int D = 1024, BATCH = 2, SEQ = 8192, DEPTH = 2, GRID_W = 64, CTX = 256;
constexpr int T_LAT = BATCH * SEQ;
constexpr int T_ALL = T_LAT + BATCH * CTX;
constexpr int NTOK = SEQ + CTX;
constexpr int IN_W = 6912;
constexpr int PEER_HEADS = 8, PEER_KEYS = 128, PEER_TOPK = 16, NSEL = PEER_HEADS * PEER_TOPK;
constexpr float NORM_EPS = 1e-6f;
constexpr float LOG2E = 1.4426950408889634f;
constexpr float SCL2 = 0.125f * LOG2E;

constexpr size_t MiB = 1u << 20;
constexpr size_t WS_CTL = 0, CTL_ZERO_BYTES = 1 * MiB;
constexpr int CW_BAR = 4096;
constexpr size_t WS_MOD = 65536;
constexpr size_t WS_COS = 2 * MiB, WS_SIN = 3 * MiB;
constexpr size_t WS_WIN = 4 * MiB;
constexpr size_t WS_WB = 31 * MiB;
constexpr size_t WS_WO = 37 * MiB;
constexpr size_t WS_WQ = 41 * MiB;
constexpr size_t WS_KEYS = 49 * MiB;
constexpr size_t WS_X = 50 * MiB;
constexpr size_t WS_H = 116 * MiB;
constexpr size_t WS_Y = 149 * MiB;
constexpr size_t WS_MG = WS_H;
constexpr size_t WS_U8 = 199 * MiB;
constexpr size_t WS_SCU = 231 * MiB;
constexpr size_t WS_EI = 232 * MiB;
constexpr size_t WS_EG = 241 * MiB;
constexpr size_t WS_P = 250 * MiB;
constexpr size_t SZ_R512 = (size_t)T_ALL * 512 * 2;
constexpr size_t SZ_R128 = (size_t)T_ALL * 128 * 2;
constexpr size_t WS_AQ = WS_P, WS_AK = WS_AQ + SZ_R512, WS_AVT = WS_AK + SZ_R128, WS_BQ = WS_AVT + SZ_R128, WS_BK = WS_BQ + SZ_R512,
                 WS_BVT = WS_BK + SZ_R512, WS_CQ = WS_BVT + SZ_R512, WS_CK = WS_CQ + SZ_R512, WS_CVT = WS_CK + SZ_R512, WS_SG = WS_CVT + SZ_R512;
constexpr size_t WS_Q2 = WS_P;
constexpr size_t WS_SC = WS_P + 66 * MiB;
constexpr size_t WS_PEND = WS_SG + (size_t)T_ALL * 3072 * 2;
constexpr size_t WS_V8 = 473 * MiB;
constexpr size_t WS_END = WS_V8 + 32 * MiB;
static_assert(WS_SC + (size_t)T_ALL * 2048 * 4 <= WS_PEND && WS_PEND <= WS_V8, "alias map");
static_assert(WS_END <= 512 * MiB, "ws map");

constexpr int LDS_BYTES = 147456;
constexpr int MISC_OFF = 131072 + 320;

#define XB_TMO      128
#define XB_XCNT(j)  (256  + 64 * (j))
#define XB_XSUB(j)  (1280 + 64 * (j))
#define XB_XGEN(j)  (2304 + 64 * (j))
#define XB_TOP      3328
#define XB_TOPGEN   3392
#define XCD_BAR_WORDS 3456
#define XB_SPIN_CAP (1u << 24)

__device__ __forceinline__ unsigned xb_ld(unsigned* p)              { return __hip_atomic_load(p, __ATOMIC_RELAXED, __HIP_MEMORY_SCOPE_AGENT); }
__device__ __forceinline__ unsigned xb_add(unsigned* p, unsigned v) { return __hip_atomic_fetch_add(p, v, __ATOMIC_RELAXED, __HIP_MEMORY_SCOPE_AGENT); }
__device__ __forceinline__ unsigned xb_xcc_id() { return (unsigned)__builtin_amdgcn_s_getreg((3 << 11) | 20) & 0xFu; }
#define XB_SPIN(cond, bar) do { unsigned _sp = 0; while (cond) { __builtin_amdgcn_s_sleep(1); \
    if ((++_sp & 255u) == 0u) { if (xb_ld(&(bar)[XB_TMO])) break; if (_sp > XB_SPIN_CAP) { atomicAdd(&(bar)[XB_TMO], 1u); break; } } } } while (0)

struct XcdBarrier { unsigned* bar; unsigned x; volatile LAS unsigned* st; };

__device__ __forceinline__ XcdBarrier xcd_barrier_post(unsigned* bar, volatile LAS unsigned* st) {
    XcdBarrier b; b.bar = bar; b.x = xb_xcc_id(); b.st = st;
    if (threadIdx.x == 0) (void)xb_add(&bar[XB_XCNT(b.x)], 1u);
    return b;
}
__device__ __forceinline__ void xcd_barrier_complete(unsigned* bar, unsigned x, unsigned& nloc, unsigned& nx) {
    const unsigned G = gridDim.x * gridDim.y * gridDim.z;
    unsigned sum, cnt, mine, sp = 0u;
    for (;;) {
        sum = 0u; cnt = 0u; mine = 0u;
#pragma unroll
        for (unsigned j = 0; j < 16; ++j) { const unsigned c = xb_ld(&bar[XB_XCNT(j)]); sum += c; cnt += (c > 0u) ? 1u : 0u; mine = (j == x) ? c : mine; }
        if (sum == G) break;
        __builtin_amdgcn_s_sleep(1);
        if ((++sp & 255u) == 0u) { if (xb_ld(&bar[XB_TMO])) break; if (sp > XB_SPIN_CAP) { atomicAdd(&bar[XB_TMO], 1u); break; } }
    }
    nloc = mine > 0u ? mine : 1u; nx = cnt > 0u ? cnt : 1u;
}
__device__ __forceinline__ void xcd_barrier(const XcdBarrier& b) {
    asm volatile("s_waitcnt vmcnt(0)" ::: "memory");
    __syncthreads();
    if (threadIdx.x == 0) {
        unsigned* bar = b.bar;
        __builtin_amdgcn_s_waitcnt(0);
        unsigned nloc = b.st[0], nx = b.st[1];
        if (nloc == 0u) { xcd_barrier_complete(bar, b.x, nloc, nx); b.st[0] = nloc; b.st[1] = nx; }
        const unsigned old = xb_add(&bar[XB_XSUB(b.x)], 1u);
        const unsigned gen = old / nloc;
        if (old + 1u == (gen + 1u) * nloc) {
            __builtin_amdgcn_fence(__ATOMIC_RELEASE, "agent");
            asm volatile("s_waitcnt vmcnt(0)" ::: "memory");
            const unsigned og = xb_add(&bar[XB_TOP], 1u);
            const unsigned tg = og / nx;
            if (og + 1u == (tg + 1u) * nx) xb_add(&bar[XB_TOPGEN], 1u);
            else XB_SPIN(xb_ld(&bar[XB_TOPGEN]) == tg, bar);
            __builtin_amdgcn_fence(__ATOMIC_ACQUIRE, "agent");
            xb_add(&bar[XB_XGEN(b.x)], 1u);
            asm volatile("s_waitcnt vmcnt(0)" ::: "memory");
        } else {
            XB_SPIN(xb_ld(&bar[XB_XGEN(b.x)]) == gen, bar);
            __builtin_amdgcn_fence(__ATOMIC_ACQUIRE, "agent");
            asm volatile("s_waitcnt vmcnt(0)" ::: "memory");
        }
    }
    __syncthreads();
}

__device__ __forceinline__ unsigned f2bf(float f) { unsigned u = __builtin_bit_cast(unsigned, f); return (u + 0x7fffu + ((u >> 16) & 1u)) >> 16; }
__device__ __forceinline__ unsigned pk2(float lo, float hi) { return f2bf(lo) | (f2bf(hi) << 16); }
__device__ __forceinline__ float bf2f(unsigned h) { return __builtin_bit_cast(float, h << 16); }
__device__ __forceinline__ float wave_sum(float v) {
#pragma unroll
    for (int o = 1; o < 64; o <<= 1) v += __shfl_xor(v, o);
    return v;
}
__device__ __forceinline__ float grp16_sum(float v) { v += __shfl_xor(v, 1); v += __shfl_xor(v, 2); v += __shfl_xor(v, 4); v += __shfl_xor(v, 8); return v; }
__device__ __forceinline__ float grp16_max(float v) { v = fmaxf(v, __shfl_xor(v, 1)); v = fmaxf(v, __shfl_xor(v, 2)); v = fmaxf(v, __shfl_xor(v, 4)); v = fmaxf(v, __shfl_xor(v, 8)); return v; }
__device__ __forceinline__ float sigmoidf_(float x) { return 1.0f / (1.0f + __expf(-x)); }
__device__ __forceinline__ int row_modidx(int r) { return r < T_LAT ? (r >> 13) : 2; }
__device__ __forceinline__ int row_batch(int r) { return r < T_LAT ? (r >> 13) : ((r - T_LAT) >> 8); }
__device__ __forceinline__ int row_tok(int r) { return r < T_LAT ? (r & (SEQ - 1)) : SEQ + ((r - T_LAT) & (CTX - 1)); }

struct Args { const float* in[22]; float* out; unsigned char* ws; };
enum { I_X = 0, I_C, I_CTX, I_CCTX, I_WMOD, I_BMOD, I_G1, I_G2, I_WIN, I_SINK, I_RPB, I_LAMBDA, I_SUBLN, I_WBA, I_WBB, I_WBC, I_WOUT, I_PWQ, I_PKEYS, I_PU, I_PV, I_GFINAL };

__device__ __forceinline__ int rope_perm(int c) {
    if (c < 640 || (c >= 2304 && c < 3328)) { const int w = c & 63; return (c & ~63) + 2 * (w & 31) + (w >> 5); }
    return c;
}
template <bool PERM = false>
__device__ __forceinline__ void p0_transpose_item(const float* W, int K, int N, bf16* WT, LAS float* scr, int item, int lane) {
    const int nblk = N / 32, kb = item / nblk, nb = item % nblk, k0 = 64 * kb, n0 = 32 * nb;
#pragma unroll 8
    for (int i = 0; i < 32; ++i) { const int kk = 2 * i + (lane >> 5); scr[kk * 33 + (lane & 31)] = W[(size_t)(k0 + kk) * N + n0 + (lane & 31)]; }
    asm volatile("s_waitcnt lgkmcnt(0)" ::: "memory");
    const int c = lane & 7;
#pragma unroll
    for (int j = 0; j < 4; ++j) { const int n = (lane >> 3) + 8 * j; const LAS float* s = scr + (8 * c) * 33 + n;
        v4u o; o.x = pk2(s[0 * 33], s[1 * 33]); o.y = pk2(s[2 * 33], s[3 * 33]); o.z = pk2(s[4 * 33], s[5 * 33]); o.w = pk2(s[6 * 33], s[7 * 33]);
        const int nout = PERM ? rope_perm(n0 + n) : (n0 + n);
        *(GAS v4u*)(WT + (size_t)nout * K + k0 + 8 * c) = o; }
    asm volatile("s_waitcnt lgkmcnt(0)" ::: "memory");
}

template <int UNR = 2, int NN = 4>
__device__ __forceinline__ void sgemm_tile(f32x4 (&acc)[4][NN], const bf16* A, int lda, const bf16* Bt, int ldb, int K, int row0, int col0, int lane) {
    const int fr = lane & 15, fq = lane >> 4;
    const bf16* ap = A + (size_t)(row0 + fr) * lda + fq * 8;
    const bf16* bp = Bt + (size_t)(col0 + fr) * ldb + fq * 8;
#pragma unroll UNR
    for (int k = 0; k < K; k += 32) {
        bf16x8 a[4], b[NN];
#pragma unroll
        for (int m = 0; m < 4; ++m) a[m] = *(const GAS bf16x8*)(ap + (size_t)m * 16 * lda + k);
#pragma unroll
        for (int n = 0; n < NN; ++n) b[n] = *(const GAS bf16x8*)(bp + (size_t)n * 16 * ldb + k);
#pragma unroll
        for (int m = 0; m < 4; ++m)
#pragma unroll
            for (int n = 0; n < NN; ++n) acc[m][n] = __builtin_amdgcn_mfma_f32_16x16x32_bf16(a[m], b[n], acc[m][n], 0, 0, 0);
    }
}
template <int NN>
__device__ __forceinline__ void zero_acc(f32x4 (&acc)[4][NN]) {
#pragma unroll
    for (int m = 0; m < 4; ++m)
#pragma unroll
        for (int n = 0; n < NN; ++n) acc[m][n] = (f32x4){0.f, 0.f, 0.f, 0.f};
}

template <int NDT> struct AttnAcc { f32x4 o[NDT]; float m[4], l[4]; };

__device__ __forceinline__ f32x4 s_tile(const bf16x8 (&qf)[2], const bf16* Kb, int kpitch, int khoff, int krow, int fr, int fq) {
    const bf16* kp = Kb + (size_t)(krow + fr) * kpitch + khoff + fq * 8;
    const bf16x8 k0 = *(const GAS bf16x8*)kp, k1 = *(const GAS bf16x8*)(kp + 32);
    f32x4 s = (f32x4){0.f, 0.f, 0.f, 0.f};
    s = __builtin_amdgcn_mfma_f32_16x16x32_bf16(qf[0], k0, s, 0, 0, 0);
    s = __builtin_amdgcn_mfma_f32_16x16x32_bf16(qf[1], k1, s, 0, 0, 0);
    return s;
}
template <int NT, int NDT, int PSTR>
__device__ __forceinline__ void softmax_update(AttnAcc<NDT>& st, f32x4 (&s)[NT], LAS bf16* Pl, int fr, int fq) {
#pragma unroll
    for (int r = 0; r < 4; ++r) {
        float mx = s[0][r];
#pragma unroll
        for (int t = 1; t < NT; ++t) mx = fmaxf(mx, s[t][r]);
        mx = grp16_max(mx);
        const float mn = fmaxf(st.m[r], mx);
        const float alpha = __builtin_amdgcn_exp2f(st.m[r] - mn);
        st.m[r] = mn;
        float ls = st.l[r] * alpha;
#pragma unroll
        for (int dt = 0; dt < NDT; ++dt) st.o[dt][r] *= alpha;
#pragma unroll
        for (int t = 0; t < NT; ++t) {
            const float p = (s[t][r] > -1e29f) ? __builtin_amdgcn_exp2f(s[t][r] - mn) : 0.f;
            ls += p;
            Pl[(4 * fq + r) * PSTR + t * 16 + fr] = (bf16)f2bf(p);
        }
        st.l[r] = ls;
    }
}
template <int NKS, int NDT, int PSTR>
__device__ __forceinline__ void pv_update(AttnAcc<NDT>& st, const LAS bf16* Pl, const bf16* Vt, int tok0, int fr, int fq) {
    asm volatile("s_waitcnt lgkmcnt(0)" ::: "memory");
    __builtin_amdgcn_wave_barrier();
#pragma unroll
    for (int ks = 0; ks < NKS; ++ks) {
        const bf16x8 pf = *(const LAS bf16x8*)(Pl + fr * PSTR + ks * 32 + fq * 8);
#pragma unroll
        for (int dt = 0; dt < NDT; ++dt) {
            const bf16x8 vf = *(const GAS bf16x8*)(Vt + (size_t)(dt * 16 + fr) * NTOK + tok0 + ks * 32 + fq * 8);
            st.o[dt] = __builtin_amdgcn_mfma_f32_16x16x32_bf16(pf, vf, st.o[dt], 0, 0, 0);
        }
    }
    asm volatile("s_waitcnt lgkmcnt(0)" ::: "memory");
    __builtin_amdgcn_wave_barrier();
}

__device__ __forceinline__ int f2ord(float f) { const int b = __builtin_bit_cast(int, f); return b ^ ((b >> 31) & 0x7fffffff); }
__device__ __forceinline__ float ord2f(int o) { const int b = o ^ ((o >> 31) & 0x7fffffff); return __builtin_bit_cast(float, b); }
__device__ __forceinline__ void top16_insert(int (&top)[16], int key) {
#pragma unroll
    for (int i = 0; i < 16; ++i) { const int hi = max(top[i], key); key = min(top[i], key); top[i] = hi; }
}


typedef float f32x16 __attribute__((ext_vector_type(16)));
typedef short s16x4 __attribute__((ext_vector_type(4)));
typedef __bf16 bf16x2_t __attribute__((ext_vector_type(2)));
__device__ __forceinline__ unsigned cvtpk(float lo, float hi) { f32x2 v = {lo, hi}; bf16x2_t b = __builtin_convertvector(v, bf16x2_t); return __builtin_bit_cast(unsigned, b); }
constexpr int CK_PITCH = 144, CV_PITCH = 320;
constexpr int CK_SZ = 64 * CK_PITCH, CV_SZ = 64 * CV_PITCH;
constexpr float C_THR_RAW = 8.0f / SCL2;

namespace pg8 {
typedef unsigned short bf16_t;
constexpr int BM = 256, BK = 64, HALF = 128, HTB = HALF * BK * 2, STAGE_BYTES = 8 * HTB, NXCD = 8, WGM = 8;
__host__ __device__ __forceinline__ int lds_byte(int r, int c) { const int st = (r >> 4) * 2 + (c >> 5), rr = r & 15, cc = c & 31, ob = rr * 64 + cc * 2; return st * 1024 + (ob ^ (((ob >> 9) & 1) << 5)); }
__host__ __device__ __forceinline__ void stage_rc(int b, int& R, int& C) { const int st = b / 1024, sb = b % 1024, swz = sb ^ (((sb >> 9) & 1) << 5); R = (st >> 1) * 16 + swz / 64; C = (st & 1) * 32 + (swz % 64) / 2; }
__host__ __device__ __forceinline__ int perm32(int rho) { const int n = rho >> 4, i = rho & 15; return 8 * (i >> 2) + 4 * n + (i & 3); }
struct Unit { int pm, pn, seg; };
struct Gemm { const bf16_t* A; const bf16_t* Bt; int lda, ldb, K; size_t a_seg, b_seg; };
struct TileOrder {
    int nM, nN, nwg, G, c;
    __device__ void init(int M, int N, int G_, int c_) { nM = M / BM; nN = N / BM; nwg = nM * nN; G = G_; c = c_; }
    __device__ bool tile(int i, int& pm, int& pn) const {
        const long L = (long)i * G + c; if (L >= nwg) return false;
        int wgid = (int)L; { const int q = nwg / NXCD, r = nwg % NXCD, xcd = wgid % NXCD, off = wgid / NXCD; wgid = (xcd < r ? xcd * (q + 1) : r * (q + 1) + (xcd - r) * q) + off; }
        const int nig = WGM * nN, gid = wgid / nig, fm = gid * WGM, gsz = (nM - fm) < WGM ? (nM - fm) : WGM;
        pm = fm + ((wgid % nig) % gsz); pn = (wgid % nig) / gsz; return true;
    }
};
template <int NSEG> struct SegOrder {
    TileOrder T;
    __device__ bool next(int i, Unit& u) const { u.seg = i % NSEG; return T.tile(i / NSEG, u.pm, u.pn); }
};
template <class Epi, class Sched>
__device__ __forceinline__ void gemm_phase(LAS unsigned char* lds, const Gemm g, const Sched& S, const Epi& E) {
    int tid = threadIdx.x; asm volatile("" : "+v"(tid));
    const int wid = __builtin_amdgcn_readfirstlane(tid >> 6), lane = tid & 63, wr = wid >> 2, wc = wid & 3, fr = lane & 15, fq = lane >> 4;
    const int K = g.K, nt = K / BK;
    unsigned voffA[2], voffB[2];
#pragma unroll
    for (int i = 0; i < 2; ++i) { int R, C; stage_rc(tid * 16 + i * 8192, R, C); const int Rb = (R & ~31) + perm32(R & 31);
        voffA[i] = (unsigned)(R * g.lda + C) * 2u; voffB[i] = (unsigned)(Rb * g.ldb + C) * 2u; }
    const size_t kstep = (size_t)(BK * 2);
    const size_t hstepA = (size_t)HALF * g.lda * 2, hstepB = (size_t)HALF * g.ldb * 2;
    const unsigned ldsw = (unsigned)wid * 1024u;
    const int aoff = lds_byte(wr * 64 + fr, fq * 8), boff = lds_byte(wc * 32 + fr, fq * 8);
#define PG8_SA(b, h) (((b) * 2 + (h)) * HTB)
#define PG8_SB(b, h) ((4 + (b) * 2 + (h)) * HTB)
#define PG8_STAGE(bufoff, gbase, voff) do { _Pragma("unroll") for (int _i = 0; _i < 2; ++_i) \
        __builtin_amdgcn_global_load_lds((const unsigned*)((const char*)(gbase) + (voff)[_i]), (LAS unsigned*)(lds + (bufoff) + ldsw + _i * 8192), 16, 0, 0); } while (0)
#define PG8_LDA(dst, b, h) do { _Pragma("unroll") for (int m = 0; m < 4; ++m) _Pragma("unroll") for (int k = 0; k < 2; ++k) dst[m][k] = *(const LAS bf16x8*)(lds + PG8_SA(b, h) + aoff + m * 2048 + k * 1024); } while (0)
#define PG8_LDB(dst, b, h) do { _Pragma("unroll") for (int n = 0; n < 2; ++n) _Pragma("unroll") for (int k = 0; k < 2; ++k) dst[n][k] = *(const LAS bf16x8*)(lds + PG8_SB(b, h) + boff + n * 2048 + k * 1024); } while (0)
#define PG8_MMA(ai, bj, At, Bt) do { __builtin_amdgcn_s_setprio(1); _Pragma("unroll") for (int m = 0; m < 4; ++m) _Pragma("unroll") for (int n = 0; n < 2; ++n) _Pragma("unroll") for (int k = 0; k < 2; ++k) \
        acc[ai][bj][m][n] = __builtin_amdgcn_mfma_f32_16x16x32_bf16(Bt[n][k], At[m][k], acc[ai][bj][m][n], 0, 0, 0); __builtin_amdgcn_s_setprio(0); } while (0)
#define PG8_WAIT_V(n) asm volatile("s_waitcnt vmcnt(" #n ")" ::: "memory")
#define PG8_WAIT_L(n) asm volatile("s_waitcnt lgkmcnt(" #n ")" ::: "memory")
#define PG8_BAR __builtin_amdgcn_s_barrier()
#define PG8_SCHED __builtin_amdgcn_sched_barrier(0)
#define PG8_ABASE(u) ((const char*)g.A + ((size_t)(u).seg * g.a_seg + (size_t)(u).pm * BM * g.lda) * 2)
#define PG8_BBASE(u) ((const char*)g.Bt + ((size_t)(u).seg * g.b_seg + (size_t)(u).pn * BM * g.ldb) * 2)
    Unit cur, nxt; int ui = 0;
    if (!S.next(0, cur)) return;
    f32x4 acc[2][2][4][2];
#pragma unroll
    for (int a = 0; a < 2; ++a)
#pragma unroll
        for (int b = 0; b < 2; ++b)
#pragma unroll
            for (int m = 0; m < 4; ++m)
#pragma unroll
                for (int n = 0; n < 2; ++n) acc[a][b][m][n] = (f32x4){0.f, 0.f, 0.f, 0.f};
    bf16x8 At[4][2], B0[2][2], B1[2][2];
    const char* cA = PG8_ABASE(cur); const char* cB = PG8_BBASE(cur);
    PG8_STAGE(PG8_SB(0, 0), cB, voffB); PG8_STAGE(PG8_SB(0, 1), cB + hstepB, voffB); PG8_STAGE(PG8_SA(0, 0), cA, voffA); PG8_STAGE(PG8_SA(0, 1), cA + hstepA, voffA);
    if (wr == 1) PG8_BAR;
    PG8_WAIT_V(2); PG8_BAR;
    PG8_STAGE(PG8_SB(1, 0), cB + kstep, voffB); PG8_STAGE(PG8_SA(1, 0), cA + kstep, voffA); PG8_STAGE(PG8_SB(1, 1), cB + hstepB + kstep, voffB);
    PG8_WAIT_V(6); PG8_BAR;
    for (;;) {
        const bool has_next = S.next(ui + 1, nxt);
        const char* nA = has_next ? PG8_ABASE(nxt) : cA; const char* nB = has_next ? PG8_BBASE(nxt) : cB;
        for (int t = 0; t < nt; t += 2) {
            const bool lastk = (t == nt - 2);
            const char* a1 = cA + (size_t)(t + 1) * kstep;
            const char* a2 = lastk ? nA : cA + (size_t)(t + 2) * kstep; const char* b2 = lastk ? nB : cB + (size_t)(t + 2) * kstep;
            const char* a3 = a2 + kstep; const char* b3 = b2 + kstep;
            PG8_LDB(B0, 0, 0); PG8_LDB(B1, 0, 1); PG8_SCHED; PG8_LDA(At, 0, 0); PG8_STAGE(PG8_SA(1, 1), a1 + hstepA, voffA);
            PG8_WAIT_V(8); PG8_WAIT_L(0); PG8_BAR; PG8_MMA(0, 0, At, B0); PG8_MMA(0, 1, At, B1); PG8_BAR; PG8_SCHED;
            PG8_LDA(At, 0, 1); PG8_STAGE(PG8_SB(0, 0), b2, voffB); PG8_STAGE(PG8_SB(0, 1), b2 + hstepB, voffB); PG8_STAGE(PG8_SA(0, 0), a2, voffA);
            PG8_WAIT_V(8); PG8_WAIT_L(0); PG8_BAR; PG8_MMA(1, 0, At, B0); PG8_MMA(1, 1, At, B1); PG8_BAR; PG8_SCHED;
            PG8_LDB(B0, 1, 0); PG8_LDB(B1, 1, 1); PG8_SCHED; PG8_LDA(At, 1, 0); PG8_STAGE(PG8_SA(0, 1), a2 + hstepA, voffA);
            PG8_WAIT_V(8); PG8_WAIT_L(0); PG8_BAR; PG8_MMA(0, 0, At, B0); PG8_MMA(0, 1, At, B1); PG8_BAR; PG8_SCHED;
            PG8_LDA(At, 1, 1); PG8_STAGE(PG8_SB(1, 0), b3, voffB); PG8_STAGE(PG8_SB(1, 1), b3 + hstepB, voffB); PG8_STAGE(PG8_SA(1, 0), a3, voffA);
            PG8_WAIT_V(8); PG8_WAIT_L(0); PG8_BAR; PG8_MMA(1, 0, At, B0); PG8_MMA(1, 1, At, B1); PG8_BAR; PG8_SCHED;
        }
        if (wr == 0) PG8_BAR;
        E(acc, cur, wr, wc, fr, fq);
        if (!has_next) break;
#pragma unroll
        for (int a = 0; a < 2; ++a)
#pragma unroll
            for (int b = 0; b < 2; ++b)
#pragma unroll
                for (int m = 0; m < 4; ++m)
#pragma unroll
                    for (int n = 0; n < 2; ++n) acc[a][b][m][n] = (f32x4){0.f, 0.f, 0.f, 0.f};
        cur = nxt; cA = nA; cB = nB; ++ui;
        if (wr == 1) PG8_BAR;
    }
    PG8_WAIT_V(0);
    PG8_BAR;
#undef PG8_SA
#undef PG8_SB
#undef PG8_STAGE
#undef PG8_LDA
#undef PG8_LDB
#undef PG8_MMA
#undef PG8_WAIT_V
#undef PG8_WAIT_L
#undef PG8_BAR
#undef PG8_SCHED
#undef PG8_ABASE
#undef PG8_BBASE
}
}

__device__ __forceinline__ v4u pack8(const f32x4& a, const f32x4& b) { v4u w; w.x = cvtpk(a.x, a.y); w.y = cvtpk(a.z, a.w); w.z = cvtpk(b.x, b.y); w.w = cvtpk(b.z, b.w); return w; }
struct EpiInProj {
    bf16 *AQ, *AK, *AVT, *BQ, *BK, *BVT, *CQ, *CK, *CV, *SG; const float *COS, *SIN;
    __device__ __forceinline__ void operator()(const f32x4 (&acc)[2][2][4][2], const pg8::Unit& u, int wr, int wc, int fr, int fq) const {
        asm volatile("" : "+v"(fr), "+v"(fq));
#pragma unroll
        for (int bj = 0; bj < 2; ++bj) {
            const int cblk = u.pn * 256 + bj * 128;
            const int cw = wc * 32 + 8 * fq;
            bf16* dst; int pitch, cbase; int kind;
            int nh = 1, hd = 0;
            if (cblk < 512)       { dst = AQ; pitch = 512; cbase = cblk; kind = 1; }
            else if (cblk < 640)  { dst = AK; pitch = 128; cbase = cblk - 512; kind = 1; }
            else if (cblk < 768)  { dst = AVT; pitch = 0; cbase = 0; kind = 2; nh = 2; hd = cblk - 640; }
            else if (cblk < 1280) { dst = BQ; pitch = 512; cbase = cblk - 768; kind = 0; }
            else if (cblk < 1792) { dst = BK; pitch = 512; cbase = cblk - 1280; kind = 0; }
            else if (cblk < 2304) { dst = BVT; pitch = 0; cbase = 0; kind = 2; nh = 8; hd = cblk - 1792; }
            else if (cblk < 2816) { dst = CQ; pitch = 512; cbase = cblk - 2304; kind = 1; }
            else if (cblk < 3328) { dst = CK; pitch = 512; cbase = cblk - 2816; kind = 1; }
            else if (cblk < 3840) { dst = CV; pitch = 512; cbase = cblk - 3328; kind = 0; }
            else                  { dst = SG; pitch = 3072; cbase = cblk - 3840; kind = 3; }
#pragma unroll
            for (int ai = 0; ai < 2; ++ai)
#pragma unroll
                for (int m = 0; m < 4; ++m) {
                    const int row = u.pm * 256 + ai * 128 + wr * 64 + m * 16 + fr;
                    f32x4 v0 = acc[ai][bj][m][0], v1 = acc[ai][bj][m][1];
                    if (kind == 1) {
                        if (row < T_LAT) {
                            const int t = row & (SEQ - 1), i0 = (cw & 63) >> 1;
                            const f32x4 cs = *(const GAS f32x4*)(COS + t * 32 + i0), sn = *(const GAS f32x4*)(SIN + t * 32 + i0);
                            const f32x4 a = v0, b = v1;
                            v0.x = a.x * cs.x - a.y * sn.x; v0.y = a.y * cs.x + a.x * sn.x; v0.z = a.z * cs.y - a.w * sn.y; v0.w = a.w * cs.y + a.z * sn.y;
                            v1.x = b.x * cs.z - b.y * sn.z; v1.y = b.y * cs.z + b.x * sn.z; v1.z = b.z * cs.w - b.w * sn.w; v1.w = b.w * cs.w + b.z * sn.w;
                        }
                        *(GAS v4u*)(dst + (size_t)row * pitch + cbase + cw) = pack8(v0, v1);
                    } else if (kind == 0) {
                        *(GAS v4u*)(dst + (size_t)row * pitch + cbase + cw) = pack8(v0, v1);
                    } else if (kind == 3) {
                        v0.x = sigmoidf_(v0.x); v0.y = sigmoidf_(v0.y); v0.z = sigmoidf_(v0.z); v0.w = sigmoidf_(v0.w);
                        v1.x = sigmoidf_(v1.x); v1.y = sigmoidf_(v1.y); v1.z = sigmoidf_(v1.z); v1.w = sigmoidf_(v1.w);
                        *(GAS v4u*)(dst + (size_t)row * pitch + cbase + cw) = pack8(v0, v1);
                    } else {
                        const int hc = hd + cw, head = hc >> 6, d = hc & 63;
                        const int b = row_batch(row), tok = row_tok(row);
                        bf16* vp = dst + ((size_t)(b * nh + head) * 64 + d) * NTOK + tok;
                        vp[0 * NTOK] = (bf16)f2bf(v0.x); vp[1 * NTOK] = (bf16)f2bf(v0.y); vp[2 * NTOK] = (bf16)f2bf(v0.z); vp[3 * NTOK] = (bf16)f2bf(v0.w);
                        vp[4 * NTOK] = (bf16)f2bf(v1.x); vp[5 * NTOK] = (bf16)f2bf(v1.y); vp[6 * NTOK] = (bf16)f2bf(v1.z); vp[7 * NTOK] = (bf16)f2bf(v1.w);
                    }
                }
        }
    }
};
__device__ __forceinline__ void unpack8(const v4u& w, f32x4& a, f32x4& b) {
    a = (f32x4){bf2f(w.x & 0xffffu), bf2f(w.x >> 16), bf2f(w.y & 0xffffu), bf2f(w.y >> 16)}; b = (f32x4){bf2f(w.z & 0xffffu), bf2f(w.z >> 16), bf2f(w.w & 0xffffu), bf2f(w.w >> 16)};
}
struct EpiBranch {
    const bf16* SG; bf16* MG;
    __device__ __forceinline__ void operator()(const f32x4 (&acc)[2][2][4][2], const pg8::Unit& u, int wr, int wc, int fr, int fq) const {
        asm volatile("" : "+v"(fr), "+v"(fq));
#pragma unroll
        for (int ai = 0; ai < 2; ++ai)
#pragma unroll
            for (int m = 0; m < 4; ++m) {
                const int row = u.pm * 256 + ai * 128 + wr * 64 + m * 16 + fr;
#pragma unroll
                for (int bj = 0; bj < 2; ++bj) {
                    const int col = u.pn * 256 + bj * 128 + wc * 32 + 8 * fq;
                    f32x4 g0, g1; { const v4u wg = *(const GAS v4u*)(SG + (size_t)row * 3072 + u.seg * 1024 + col); unpack8(wg, g0, g1); }
                    f32x4 v0 = g0 * acc[ai][bj][m][0], v1 = g1 * acc[ai][bj][m][1];
                    bf16* mp = MG + (size_t)row * D + col;
                    if (u.seg > 0) { f32x4 p0, p1; const v4u wp = *(const GAS v4u*)mp; unpack8(wp, p0, p1); v0 += p0; v1 += p1; }
                    *(GAS v4u*)mp = pack8(v0, v1);
                }
            }
    }
};
struct EpiOut {
    float* X; const float* gtl;
    __device__ __forceinline__ void operator()(const f32x4 (&acc)[2][2][4][2], const pg8::Unit& u, int wr, int wc, int fr, int fq) const {
        asm volatile("" : "+v"(fr), "+v"(fq));
#pragma unroll
        for (int ai = 0; ai < 2; ++ai)
#pragma unroll
            for (int m = 0; m < 4; ++m) {
                const int row = u.pm * 256 + ai * 128 + wr * 64 + m * 16 + fr;
                const float* gt = gtl + (size_t)row_modidx(row) * 6 * D + 2 * D;
#pragma unroll
                for (int bj = 0; bj < 2; ++bj) {
                    const int col = u.pn * 256 + bj * 128 + wc * 32 + 8 * fq;
                    GAS f32x4* xp = (GAS f32x4*)(X + (size_t)row * D + col);
                    const f32x4 g0 = *(const GAS f32x4*)(gt + col), g1 = *(const GAS f32x4*)(gt + col + 4);
                    xp[0] = xp[0] + g0 * acc[ai][bj][m][0]; xp[1] = xp[1] + g1 * acc[ai][bj][m][1];
                }
            }
    }
};
struct EpiStore {
    bf16* O; int ldc;
    __device__ __forceinline__ void operator()(const f32x4 (&acc)[2][2][4][2], const pg8::Unit& u, int wr, int wc, int fr, int fq) const {
        asm volatile("" : "+v"(fr), "+v"(fq));
#pragma unroll
        for (int ai = 0; ai < 2; ++ai)
#pragma unroll
            for (int m = 0; m < 4; ++m) {
                const int row = u.pm * 256 + ai * 128 + wr * 64 + m * 16 + fr;
#pragma unroll
                for (int bj = 0; bj < 2; ++bj) {
                    const int col = u.pn * 256 + bj * 128 + wc * 32 + 8 * fq;
                    *(GAS v4u*)(O + (size_t)row * ldc + col) = pack8(acc[ai][bj][m][0], acc[ai][bj][m][1]);
                }
            }
    }
};

__global__ void __launch_bounds__(NTHREADS, 2) mega_fwd(Args args) {
    extern __shared__ __attribute__((aligned(16))) unsigned char lds[];
    LAS unsigned char* L = (LAS unsigned char*)lds;
    volatile LAS unsigned* MISC = (volatile LAS unsigned*)(L + MISC_OFF);
    const int tid = threadIdx.x, lane = tid & 63, wave = __builtin_amdgcn_readfirstlane(tid >> 6);
    const int fr = lane & 15, fq = lane >> 4;
    const int G = gridDim.x;
    const int vcu = (G % 8 == 0) ? (int)(blockIdx.x % 8) * (G / 8) + (int)(blockIdx.x / 8) : (int)blockIdx.x;
    for (int u = tid; u < (LDS_BYTES - 131072) / 4; u += NTHREADS) ((LAS unsigned*)(L + 131072))[u] = 0u;
    __syncthreads();
    unsigned char* ws = args.ws;
    gu32* ctl = (gu32*)(ws + WS_CTL);
    (void)xcd_barrier_post((unsigned*)(ctl + CW_BAR), MISC + 8);
#define GRID_BAR() do { unsigned* bp_ = (unsigned*)(ws + WS_CTL) + CW_BAR; asm volatile("" : "+s"(bp_)); XcdBarrier b_; b_.bar = bp_; b_.x = xb_xcc_id(); b_.st = MISC + 8; xcd_barrier(b_); } while (0)
    const int gw = vcu * NWAVES + wave, NGW = G * NWAVES;
    const int NGT = G * NTHREADS;

    float* MODV = (float*)(ws + WS_MOD);
    float* COS = (float*)(ws + WS_COS); float* SIN = (float*)(ws + WS_SIN);
    bf16* WIN = (bf16*)(ws + WS_WIN); bf16* WB = (bf16*)(ws + WS_WB); bf16* WO = (bf16*)(ws + WS_WO); bf16* WQ = (bf16*)(ws + WS_WQ); bf16* KEYS = (bf16*)(ws + WS_KEYS);
    float* X = (float*)(ws + WS_X); bf16* H = (bf16*)(ws + WS_H); bf16* Y = (bf16*)(ws + WS_Y); bf16* MG = (bf16*)(ws + WS_MG);
    unsigned* EI = (unsigned*)(ws + WS_EI); float* EG = (float*)(ws + WS_EG);
    unsigned char* U8 = ws + WS_U8; unsigned char* V8 = ws + WS_V8; float* SCU = (float*)(ws + WS_SCU); float* SCV = SCU + DEPTH * 16384;
    bf16* AQ = (bf16*)(ws + WS_AQ); bf16* AK = (bf16*)(ws + WS_AK); bf16* AVT = (bf16*)(ws + WS_AVT);
    bf16* BQ = (bf16*)(ws + WS_BQ); bf16* BK = (bf16*)(ws + WS_BK); bf16* BVT = (bf16*)(ws + WS_BVT);
    bf16* CQ = (bf16*)(ws + WS_CQ); bf16* CK = (bf16*)(ws + WS_CK); bf16* CVT = (bf16*)(ws + WS_CVT);
    bf16* SG = (bf16*)(ws + WS_SG); bf16* Q2 = (bf16*)(ws + WS_Q2); float* SC = (float*)(ws + WS_SC);

#ifndef SKIP_P0
    {
        LAS float* scr = (LAS float*)(L + wave * 16384);
        int gt = vcu * NTHREADS + tid; asm volatile("" : "+v"(gt));
        constexpr int I_IN = (D / 64) * (IN_W / 32), I_BR = (512 / 64) * (D / 32), I_O = (D / 64) * (D / 32), I_Q = (D / 64) * (2048 / 32);
        constexpr int PER_LAYER = I_IN + 3 * I_BR + I_O + I_Q;
        for (int it = gw; it < DEPTH * PER_LAYER; it += NGW) {
            const int l = it / PER_LAYER; int r = it % PER_LAYER;
            if (r < I_IN) { p0_transpose_item<true>(args.in[I_WIN] + (size_t)l * D * IN_W, D, IN_W, WIN + (size_t)l * IN_W * D, scr, r, lane); continue; } r -= I_IN;
            if (r < I_BR) { p0_transpose_item(args.in[I_WBA] + (size_t)l * 512 * D, 512, D, WB + (size_t)(l * 3 + 0) * D * 512, scr, r, lane); continue; } r -= I_BR;
            if (r < I_BR) { p0_transpose_item(args.in[I_WBB] + (size_t)l * 512 * D, 512, D, WB + (size_t)(l * 3 + 1) * D * 512, scr, r, lane); continue; } r -= I_BR;
            if (r < I_BR) { p0_transpose_item(args.in[I_WBC] + (size_t)l * 512 * D, 512, D, WB + (size_t)(l * 3 + 2) * D * 512, scr, r, lane); continue; } r -= I_BR;
            if (r < I_O) { p0_transpose_item(args.in[I_WOUT] + (size_t)l * D * D, D, D, WO + (size_t)l * D * D, scr, r, lane); continue; } r -= I_O;
            p0_transpose_item(args.in[I_PWQ] + (size_t)l * D * 2048, D, 2048, WQ + (size_t)l * 2048 * D, scr, r, lane);
        }
        for (int i = gt; i < DEPTH * 16 * 128 * 128 / 4; i += NGT) {
            const f32x4 v = *((const GAS f32x4*)args.in[I_PKEYS] + i);
            v2u o; o.x = pk2(v.x, v.y); o.y = pk2(v.z, v.w); *((GAS v2u*)KEYS + i) = o;
        }
        for (int i = gt; i < T_ALL * D / 4; i += NGT) {
            const f32x4 v = (i < T_LAT * D / 4) ? *((const GAS f32x4*)args.in[I_X] + i) : *((const GAS f32x4*)args.in[I_CTX] + (i - T_LAT * D / 4));
            *((GAS f32x4*)X + i) = v;
        }
        {
            LAS float* red = (LAS float*)(L + 9216);
            for (int it = vcu; it < DEPTH * 96; it += G) {
                const int l = it / 96, nc = it % 96, n = nc * 64 + lane;
                const float* wm = args.in[I_WMOD] + (size_t)l * D * 6 * D + n;
                float a0 = 0.f, a1 = 0.f, a2 = 0.f;
#pragma unroll 8
                for (int k = wave * 128; k < wave * 128 + 128; ++k) {
                    const float c0 = args.in[I_C][k], c1 = args.in[I_C][D + k], c2 = args.in[I_CCTX][k];
                    const float w = wm[(size_t)k * 6 * D];
                    a0 += c0 * sigmoidf_(c0) * w; a1 += c1 * sigmoidf_(c1) * w; a2 += c2 * sigmoidf_(c2) * w;
                }
                red[(wave * 3 + 0) * 64 + lane] = a0; red[(wave * 3 + 1) * 64 + lane] = a1; red[(wave * 3 + 2) * 64 + lane] = a2;
                __syncthreads();
                if (wave < 3) {
                    float sum = args.in[I_BMOD][l * 6 * D + n];
#pragma unroll
                    for (int w = 0; w < 8; ++w) sum += red[(w * 3 + wave) * 64 + lane];
                    MODV[(size_t)(l * 3 + wave) * 6 * D + n] = sum;
                }
                __syncthreads();
            }
        }
        for (int i = gt; i < SEQ * 32; i += NGT) {
            const int t = i >> 5, f = i & 31;
            const double inv = pow(10000.0, -(double)(f & 15) / 16.0);
            const double pos = (f < 16) ? (double)(t / GRID_W) : (double)(t % GRID_W);
            const double ang = pos * inv;
            COS[i] = (float)cos(ang); SIN[i] = (float)sin(ang);
        }
    }
        for (int rr = gw; rr < 2 * DEPTH * 16384; rr += NGW) {
            const int tab = rr / (DEPTH * 16384), row = rr % (DEPTH * 16384);
            const float* src = (tab == 0 ? args.in[I_PU] : args.in[I_PV]) + (size_t)row * D;
            f32x4 v[4]; float am = 0.f;
#pragma unroll
            for (int j = 0; j < 4; ++j) { v[j] = *((const GAS f32x4*)src + lane + 64 * j); am = fmaxf(am, fmaxf(fmaxf(fabsf(v[j].x), fabsf(v[j].y)), fmaxf(fabsf(v[j].z), fabsf(v[j].w)))); }
#pragma unroll
            for (int o = 1; o < 64; o <<= 1) am = fmaxf(am, __shfl_xor(am, o));
            int ex = 0; float scale = 1.0f;
            if (am > 0.f) { (void)frexpf(am * (1.0f / 448.0f), &ex); scale = ldexpf(1.0f, ex); }
            const float inv = 1.0f / scale;
            v4u o;
#pragma unroll
            for (int j = 0; j < 4; ++j) {
                int p = __builtin_amdgcn_cvt_pk_fp8_f32(v[j].x * inv, v[j].y * inv, 0, false);
                p = __builtin_amdgcn_cvt_pk_fp8_f32(v[j].z * inv, v[j].w * inv, p, true);
                o[j] = (unsigned)p;
            }
            *((GAS v4u*)((tab == 0 ? U8 : V8) + (size_t)row * D) + lane) = o;
            if (lane == 0) (tab == 0 ? SCU : SCV)[row] = scale;
        }
#endif
    GRID_BAR();

    for (int layer = 0; layer < DEPTH; ++layer) {
        const bool last = (layer == DEPTH - 1);
        const int T_EFF = last ? T_LAT : T_ALL;
        const float* modl = MODV + (size_t)layer * 3 * 6 * D;
        const bf16* WINl = WIN + (size_t)layer * IN_W * D;

#ifndef SKIP_P1
        { int ln = lane; asm volatile("" : "+v"(ln));
        for (int r = gw; r < T_ALL; r += NGW) {
            const float* md = modl + (size_t)row_modidx(r) * 6 * D;
            const GAS f32x4* xr = (const GAS f32x4*)(X + (size_t)r * D) + ln;
            f32x4 v[4]; float ss = 0.f;
#pragma unroll
            for (int j = 0; j < 4; ++j) { v[j] = xr[64 * j]; ss += (v[j].x * v[j].x + v[j].y * v[j].y) + (v[j].z * v[j].z + v[j].w * v[j].w); }
            const float rs = 1.0f / sqrtf(wave_sum(ss) * (1.f / D) + NORM_EPS);
            GAS v2u* o8 = (GAS v2u*)(H + (size_t)r * D) + ln;
#pragma unroll
            for (int j = 0; j < 4; ++j) {
                const f32x4 g = *((const GAS f32x4*)(args.in[I_G1] + layer * D) + ln + 64 * j);
                const f32x4 sh = *((const GAS f32x4*)(md + 0) + ln + 64 * j), sc = *((const GAS f32x4*)(md + D) + ln + 64 * j);
                const f32x4 h = v[j] * rs * g * (sc + 1.0f) + sh;
                v2u o; o.x = pk2(h.x, h.y); o.y = pk2(h.z, h.w); o8[64 * j] = o;
            }
        }
        }
#endif
        GRID_BAR();

#ifndef SKIP_P2
        {
            pg8::Gemm g{H, WINl, D, D, D, 0, 0};
            pg8::SegOrder<1> S; S.T.init(T_ALL, IN_W, G, (int)blockIdx.x);
            EpiInProj E{AQ, AK, AVT, BQ, BK, BVT, CQ, CK, CVT, SG, COS, SIN};
            pg8::gemm_phase(L, g, S, E);
        }
#endif
        GRID_BAR();

#ifndef SKIP_P3
        {
            LAS bf16* Pl = (LAS bf16*)(L + wave * 8192);
            const float lam_init = 0.8f - 0.6f * expf(-0.3f * (float)layer);
            float lam;
            {
                int ll = lane; asm volatile("" : "+v"(ll));
                const float* cl = args.in[I_LAMBDA] + layer * 256;
                const float s1 = wave_sum(cl[ll] * cl[64 + ll]), s2 = wave_sum(cl[128 + ll] * cl[192 + ll]);
                lam = expf(s1) - expf(s2) + lam_init;
            }
{ int lo__ = lane; asm volatile("" : "+v"(lo__)); { const int lane = lo__; const int fr = lane & 15, fq = lane >> 4, tid = wave * 64 + lane; (void)fr; (void)fq; (void)tid;
            {
                const int r32 = lane & 31, hi = lane >> 5;
                const int n_lat = BATCH * 4 * (SEQ / 256), n_ctx = last ? 0 : BATCH * 4;
                const int NU = (n_lat + G - 1) / G * G + n_ctx;
                for (int rep_ = 0; rep_ < REP_P3C; ++rep_)
                for (int u0 = vcu; u0 < NU; u0 += G) {
                    int b, h, row0, t_lo, t_hi;
                    if (u0 < n_lat) { const int bh = u0 >> 5; b = bh >> 2; h = bh & 3; row0 = b * SEQ + (u0 & 31) * 256; t_lo = 0; t_hi = 132; }
                    else { const int c = u0 - (n_lat + G - 1) / G * G; if (c < 0 || c >= n_ctx) continue; b = c >> 2; h = c & 3; row0 = T_LAT + b * CTX; t_lo = 128; t_hi = 132; }
                    const int qrow = row0 + wave * 32 + r32;
                    LAS unsigned* o1p = (LAS unsigned*)(L + 65536 + wave * 8192) + lane;
                    const int krow_s = tid >> 3, kch_s = tid & 7;
                    const int vrow_s0 = tid >> 4, vch_s = tid & 15;
                    LAS unsigned char* Kb0 = L; LAS unsigned char* Vb0 = L + 2 * CK_SZ;
#pragma unroll 1
                    for (int m = 0; m < 2; ++m) {
                        bf16x8 qf[4];
                        { const bf16* qp = CQ + (size_t)qrow * 512 + (h * 2 + m) * 64 + hi * 8;
#pragma unroll
                          for (int ks = 0; ks < 4; ++ks) qf[ks] = *(const GAS bf16x8*)(qp + ks * 16); }
                        f32x16 o[4];
#pragma unroll
                        for (int d = 0; d < 4; ++d)
#pragma unroll
                            for (int r = 0; r < 16; ++r) o[d][r] = 0.f;
                        float mrun = -1e30f, lpart = 0.f;
                        const bf16* kg = CK + (size_t)krow_s * 512 + (h * 2 + m) * 64 + kch_s * 8;
                        const bf16* vg = CVT + (size_t)vrow_s0 * 512 + h * 128 + vch_s * 8;
                        auto tile_row = [&](int j) { return (j < 128) ? b * SEQ + 64 * j : T_LAT + b * CTX + 64 * (j - 128); };
                        __syncthreads();
                        {
                            const size_t kb = (size_t)tile_row(t_lo) * 512;
                            const v4u kr = *(const GAS v4u*)(kg + kb), v0 = *(const GAS v4u*)(vg + kb), v1 = *(const GAS v4u*)(vg + kb + 32 * 512);
                            *(LAS v4u*)(Kb0 + krow_s * CK_PITCH + kch_s * 16) = kr;
                            *(LAS v4u*)(Vb0 + vrow_s0 * CV_PITCH + vch_s * 16) = v0; *(LAS v4u*)(Vb0 + (vrow_s0 + 32) * CV_PITCH + vch_s * 16) = v1;
                        }
                        __syncthreads();
#pragma unroll 1
                        for (int j = t_lo; j < t_hi; ++j) {
                            const int cur = (j - t_lo) & 1;
                            const LAS unsigned char* Kb = Kb0 + cur * CK_SZ; const LAS unsigned char* Vb = Vb0 + cur * CV_SZ;
                            v4u kr, v0, v1;
                            const bool more = (j + 1 < t_hi);
                            if (more) { const size_t kb = (size_t)tile_row(j + 1) * 512; kr = *(const GAS v4u*)(kg + kb); v0 = *(const GAS v4u*)(vg + kb); v1 = *(const GAS v4u*)(vg + kb + 32 * 512); }
                            f32x16 st[2];
#pragma unroll
                            for (int kb = 0; kb < 2; ++kb) {
#pragma unroll
                                for (int r = 0; r < 16; ++r) st[kb][r] = 0.f;
#pragma unroll
                                for (int ks = 0; ks < 4; ++ks) {
                                    const bf16x8 kf = *(const LAS bf16x8*)(Kb + (kb * 32 + r32) * CK_PITCH + ks * 32 + hi * 16);
                                    st[kb] = __builtin_amdgcn_mfma_f32_32x32x16_bf16(kf, qf[ks], st[kb], 0, 0, 0);
                                }
                            }
                            float mx = st[0][0];
#pragma unroll
                            for (int r = 1; r < 16; ++r) mx = fmaxf(mx, st[0][r]);
#pragma unroll
                            for (int r = 0; r < 16; ++r) mx = fmaxf(mx, st[1][r]);
                            mx = fmaxf(mx, __shfl_xor(mx, 32));
                            if (__builtin_amdgcn_ballot_w64(mx > mrun + C_THR_RAW) != 0ull) {
                                const float mn = fmaxf(mrun, mx);
                                const float alpha = __builtin_amdgcn_exp2f((mrun - mn) * SCL2);
#pragma unroll
                                for (int d = 0; d < 4; ++d)
#pragma unroll
                                    for (int r = 0; r < 16; ++r) o[d][r] *= alpha;
                                lpart *= alpha; mrun = mn;
                            }
                            const float nmc = -mrun * SCL2;
                            float ls = 0.f;
#pragma unroll
                            for (int kb = 0; kb < 2; ++kb)
#pragma unroll
                                for (int r = 0; r < 16; ++r) { const float p = __builtin_amdgcn_exp2f(fmaf(st[kb][r], SCL2, nmc)); st[kb][r] = p; ls += p; }
                            lpart += ls;
                            {
                                const int q4 = (lane & 15) >> 2, p4 = lane & 3, grp = (lane >> 4) & 1;
                                const LAS unsigned char* vbase = Vb + (4 * hi + q4) * CV_PITCH + (16 * grp + 4 * p4) * 2;
#pragma unroll
                                for (int kb = 0; kb < 2; ++kb)
#pragma unroll
                                    for (int ss = 0; ss < 2; ++ss) {
                                        v4u pw;
#pragma unroll
                                        for (int i2 = 0; i2 < 4; ++i2) pw[i2] = cvtpk(st[kb][8 * ss + 2 * i2], st[kb][8 * ss + 2 * i2 + 1]);
                                        const bf16x8 pb = __builtin_bit_cast(bf16x8, pw);
#pragma unroll
                                        for (int d = 0; d < 4; ++d) {
                                            const LAS unsigned char* va = vbase + (kb * 32 + 16 * ss) * CV_PITCH + d * 64;
                                            const s16x4 lo = __builtin_bit_cast(s16x4, __builtin_amdgcn_ds_read_tr16_b64_v4i16((LAS s16x4*)va));
                                            const s16x4 hh = __builtin_bit_cast(s16x4, __builtin_amdgcn_ds_read_tr16_b64_v4i16((LAS s16x4*)(va + 8 * CV_PITCH)));
                                            const bf16x8 vf = __builtin_shufflevector(lo, hh, 0, 1, 2, 3, 4, 5, 6, 7);
                                            o[d] = __builtin_amdgcn_mfma_f32_32x32x16_bf16(vf, pb, o[d], 0, 0, 0);
                                        }
                                        if (ss == 1) __builtin_amdgcn_sched_barrier(0);
                                    }
                            }
                            if (more) {
                                LAS unsigned char* Kn = Kb0 + (cur ^ 1) * CK_SZ; LAS unsigned char* Vn = Vb0 + (cur ^ 1) * CV_SZ;
                                *(LAS v4u*)(Kn + krow_s * CK_PITCH + kch_s * 16) = kr;
                                *(LAS v4u*)(Vn + vrow_s0 * CV_PITCH + vch_s * 16) = v0; *(LAS v4u*)(Vn + (vrow_s0 + 32) * CV_PITCH + vch_s * 16) = v1;
                            }
                            __syncthreads();
                        }
                        const float lt = lpart + __shfl_xor(lpart, 32);
                        if (m == 0) {
                            const float inv = 1.0f / lt;
#pragma unroll
                            for (int d = 0; d < 4; ++d)
#pragma unroll
                                for (int i2 = 0; i2 < 8; ++i2) o1p[64 * (d * 8 + i2)] = cvtpk(o[d][2 * i2] * inv, o[d][2 * i2 + 1] * inv);
                        } else {
                            const float inv2 = lam / lt;
                            float ssq = 0.f;
#pragma unroll
                            for (int d = 0; d < 4; ++d)
#pragma unroll
                                for (int i2 = 0; i2 < 8; ++i2) {
                                    const unsigned w1 = o1p[64 * (d * 8 + i2)];
                                    const float a0 = bf2f(w1 & 0xffffu) - o[d][2 * i2] * inv2, a1 = bf2f(w1 >> 16) - o[d][2 * i2 + 1] * inv2;
                                    o[d][2 * i2] = a0; o[d][2 * i2 + 1] = a1; ssq += a0 * a0 + a1 * a1;
                                }
                            ssq += __shfl_xor(ssq, 32);
                            const float rn = 1.0f / sqrtf(ssq * (1.f / 128.f) + NORM_EPS) * (1.0f - lam_init);
                            bf16* yp = Y + (size_t)qrow * 1536 + 1024 + h * 128 + 4 * hi;
                            const float* sl = args.in[I_SUBLN] + layer * 512 + h * 128 + 4 * hi;
#pragma unroll
                            for (int d = 0; d < 4; ++d)
#pragma unroll
                                for (int g4 = 0; g4 < 4; ++g4) {
                                    const f32x4 gsl = *(const GAS f32x4*)(sl + d * 32 + 8 * g4);
                                    v2u w; w.x = cvtpk(o[d][4 * g4] * rn * gsl.x, o[d][4 * g4 + 1] * rn * gsl.y); w.y = cvtpk(o[d][4 * g4 + 2] * rn * gsl.z, o[d][4 * g4 + 3] * rn * gsl.w);
                                    *(GAS v2u*)(yp + d * 32 + 8 * g4) = w;
                                }
                        }
                    }
                }
                __syncthreads();
            }
} }
{ int lo__ = lane; asm volatile("" : "+v"(lo__)); { const int lane = lo__; const int fr = lane & 15, fq = lane >> 4, tid = wave * 64 + lane; (void)fr; (void)fq; (void)tid;
            {
                const int n_lat = BATCH * 8 * (SEQ / 16), n_ctx = last ? 0 : BATCH * 8 * (CTX / 16);
                for (int it = gw; it < n_lat + n_ctx; it += NGW) {
                    int b, hq, row0, qpos0 = 0; const bool isctx = it >= n_lat;
                    if (!isctx) { b = it / (8 * 512); hq = (it / 512) % 8; qpos0 = (it % 512) * 16; row0 = b * SEQ + qpos0; }
                    else { const int j = it - n_lat; b = j / (8 * 16); hq = (j / 16) % 8; row0 = T_LAT + b * CTX + (j % 16) * 16; }
                    const int g = hq >> 2;
                    bf16x8 qf[2];
                    { const bf16* qp = AQ + (size_t)(row0 + fr) * 512 + hq * 64 + fq * 8; qf[0] = *(const GAS bf16x8*)qp; qf[1] = *(const GAS bf16x8*)(qp + 32); }
                    AttnAcc<4> st;
                    const float sk = args.in[I_SINK][layer * 8 + hq] * LOG2E;
#pragma unroll
                    for (int r = 0; r < 4; ++r) { st.m[r] = sk; st.l[r] = (fr == 0) ? 1.0f : 0.0f; }
#pragma unroll
                    for (int dt = 0; dt < 4; ++dt) st.o[dt] = (f32x4){0.f, 0.f, 0.f, 0.f};
                    const bf16* Vt = AVT + (size_t)(b * 2 + g) * 64 * NTOK;
                    if (!isctx) {
                        const int al = ((qpos0 - 128) >> 5) << 5;
                        for (int ks = al; ks < qpos0 + 144; ks += 32) {
                            if (ks < 0 || ks >= SEQ) continue;
                            f32x4 s[2];
#pragma unroll
                            for (int t = 0; t < 2; ++t) {
                                s[t] = s_tile(qf, AK, 128, g * 64, b * SEQ + ks + 16 * t, fr, fq) * SCL2;
                                const int kpos = ks + 16 * t + fr;
#pragma unroll
                                for (int r = 0; r < 4; ++r) { const int dq = qpos0 + 4 * fq + r - kpos; if (dq > 128 || dq < -128) s[t][r] = -1e30f; }
                            }
                            softmax_update<2, 4, 40>(st, s, Pl, fr, fq);
                            pv_update<1, 4, 40>(st, Pl, Vt, ks, fr, fq);
                        }
                    }
                    for (int u = 0; u < 8; ++u) {
                        f32x4 s[2];
#pragma unroll
                        for (int t = 0; t < 2; ++t) s[t] = s_tile(qf, AK, 128, g * 64, T_LAT + b * CTX + 32 * u + 16 * t, fr, fq) * SCL2;
                        softmax_update<2, 4, 40>(st, s, Pl, fr, fq);
                        pv_update<1, 4, 40>(st, Pl, Vt, SEQ + 32 * u, fr, fq);
                    }
#pragma unroll
                    for (int r = 0; r < 4; ++r) {
                        const float il = 1.0f / grp16_sum(st.l[r]);
                        bf16* yp = Y + (size_t)(row0 + 4 * fq + r) * 1536 + hq * 64 + fr;
#pragma unroll
                        for (int dt = 0; dt < 4; ++dt) yp[16 * dt] = (bf16)f2bf(st.o[dt][r] * il);
                    }
                }
            }
} }
{ int lo__ = lane; asm volatile("" : "+v"(lo__)); { const int lane = lo__; const int fr = lane & 15, fq = lane >> 4, tid = wave * 64 + lane; (void)fr; (void)fq; (void)tid;
            {
                const int n_lat = BATCH * 8 * 128 * 4, n_ctx = last ? 0 : BATCH * 8 * (CTX / 16);
                for (int it = gw; it < n_lat + n_ctx; it += NGW) {
                    int b, h, row0, gr = 0, nb = 0; const bool isctx = it >= n_lat;
                    if (!isctx) { b = it / (8 * 512); h = (it / 512) % 8; gr = (it % 512) / 4; nb = it % 4; row0 = b * SEQ + gr * GRID_W + nb * 16; }
                    else { const int j = it - n_lat; b = j / (8 * 16); h = (j / 16) % 8; row0 = T_LAT + b * CTX + (j % 16) * 16; }
                    bf16x8 qf[2];
                    { const bf16* qp = BQ + (size_t)(row0 + fr) * 512 + h * 64 + fq * 8; qf[0] = *(const GAS bf16x8*)qp; qf[1] = *(const GAS bf16x8*)(qp + 32); }
                    AttnAcc<4> st;
#pragma unroll
                    for (int r = 0; r < 4; ++r) { st.m[r] = -1e30f; st.l[r] = 0.f; }
#pragma unroll
                    for (int dt = 0; dt < 4; ++dt) st.o[dt] = (f32x4){0.f, 0.f, 0.f, 0.f};
                    const bf16* Vt = BVT + (size_t)(b * 8 + h) * 64 * NTOK;
                    if (!isctx) {
                        const int rs = min(max(gr - 4, 0), 120);
                        const int band0 = min(max(nb * 16 - 8, 0), 32);
                        const float* rpb = args.in[I_RPB] + (size_t)(layer * 8 + h) * 15 * 31;
                        for (int i = 0; i < 8; ++i) {
                            const int ktok0 = (rs + i) * GRID_W + band0;
                            const int dr = rs + i - gr + 7;
                            f32x4 s[2];
#pragma unroll
                            for (int t = 0; t < 2; ++t) {
                                s[t] = s_tile(qf, BK, 512, h * 64, b * SEQ + ktok0 + 16 * t, fr, fq) * SCL2;
                                const int kc = band0 + 16 * t + fr;
#pragma unroll
                                for (int r = 0; r < 4; ++r) {
                                    const int qc = nb * 16 + 4 * fq + r;
                                    const int cstart = min(max(qc - 8, 0), 48);
                                    const int dc = min(max(kc - qc, -15), 15) + 15;
                                    const bool valid = (kc >= cstart) && (kc < cstart + 16);
                                    s[t][r] = valid ? s[t][r] + rpb[dr * 31 + dc] * LOG2E : -1e30f;
                                }
                            }
                            softmax_update<2, 4, 40>(st, s, Pl, fr, fq);
                            pv_update<1, 4, 40>(st, Pl, Vt, ktok0, fr, fq);
                        }
                    }
                    for (int u = 0; u < 8; ++u) {
                        f32x4 s[2];
#pragma unroll
                        for (int t = 0; t < 2; ++t) s[t] = s_tile(qf, BK, 512, h * 64, T_LAT + b * CTX + 32 * u + 16 * t, fr, fq) * SCL2;
                        softmax_update<2, 4, 40>(st, s, Pl, fr, fq);
                        pv_update<1, 4, 40>(st, Pl, Vt, SEQ + 32 * u, fr, fq);
                    }
#pragma unroll
                    for (int r = 0; r < 4; ++r) {
                        const float il = 1.0f / grp16_sum(st.l[r]);
                        bf16* yp = Y + (size_t)(row0 + 4 * fq + r) * 1536 + 512 + h * 64 + fr;
#pragma unroll
                        for (int dt = 0; dt < 4; ++dt) yp[16 * dt] = (bf16)f2bf(st.o[dt][r] * il);
                    }
                }
            }
} }
        }
#endif
        GRID_BAR();

#ifndef SKIP_P4
        {
            pg8::Gemm g{Y, WB + (size_t)layer * 3 * D * 512, 1536, 512, 512, 512, (size_t)D * 512};
            pg8::SegOrder<3> S; S.T.init(T_LAT, D, G, (int)blockIdx.x);
            EpiBranch E{SG, MG};
            pg8::gemm_phase(L, g, S, E);
        }
        if (!last) { int lo__ = lane; asm volatile("" : "+v"(lo__)); { const int lane = lo__; const int fr = lane & 15, fq = lane >> 4; (void)fr; (void)fq;
            for (int it = gw; it < (T_ALL - T_LAT) / 64 * (D / 32); it += NGW) {
                const int row0 = T_LAT + (it / (D / 32)) * 64, col0 = (it % (D / 32)) * 32;
                f32x4 mg[4][2]; zero_acc<2>(mg);
#pragma unroll 1
                for (int seg = 0; seg < 3; ++seg) {
                    f32x4 acc[4][2]; zero_acc<2>(acc);
                    sgemm_tile<1, 2>(acc, Y + seg * 512, 1536, WB + (size_t)(layer * 3 + seg) * D * 512, 512, 512, row0, col0, lane);
#pragma unroll
                    for (int m = 0; m < 4; ++m)
#pragma unroll
                        for (int r = 0; r < 4; ++r) {
                            const bf16* gp = SG + (size_t)(row0 + 16 * m + 4 * fq + r) * 3072 + seg * 1024 + col0 + fr;
#pragma unroll
                            for (int n = 0; n < 2; ++n) mg[m][n][r] += bf2f(gp[16 * n]) * acc[m][n][r];
                        }
                }
#pragma unroll
                for (int m = 0; m < 4; ++m)
#pragma unroll
                    for (int r = 0; r < 4; ++r) {
                        bf16* rowp = MG + (size_t)(row0 + 16 * m + 4 * fq + r) * D + col0 + fr;
#pragma unroll
                        for (int n = 0; n < 2; ++n) rowp[16 * n] = (bf16)f2bf(mg[m][n][r]);
                    }
            }
} }
#endif
        GRID_BAR();

#ifndef SKIP_P5
        {
            pg8::Gemm g{MG, WO + (size_t)layer * D * D, D, D, D, 0, 0};
            pg8::SegOrder<1> S; S.T.init(T_LAT, D, G, (int)blockIdx.x);
            EpiOut E{X, modl};
            pg8::gemm_phase(L, g, S, E);
        }
        if (!last) { int lo__ = lane; asm volatile("" : "+v"(lo__)); { const int lane = lo__; const int fr = lane & 15, fq = lane >> 4; (void)fr; (void)fq;
            for (int it = gw; it < (T_ALL - T_LAT) / 64 * (D / 64); it += NGW) {
                const int row0 = T_LAT + (it / (D / 64)) * 64, col0 = (it % (D / 64)) * 64;
                f32x4 acc[4][4]; zero_acc<4>(acc);
                sgemm_tile(acc, MG, D, WO + (size_t)layer * D * D, D, D, row0, col0, lane);
                const float* gt = modl + (size_t)2 * 6 * D + 2 * D + col0 + fr;
#pragma unroll
                for (int m = 0; m < 4; ++m)
#pragma unroll
                    for (int r = 0; r < 4; ++r) {
                        float* rowp = X + (size_t)(row0 + 16 * m + 4 * fq + r) * D + col0 + fr;
#pragma unroll
                        for (int n = 0; n < 4; ++n) rowp[16 * n] += gt[16 * n] * acc[m][n][r];
                    }
            }
} }
#endif
        GRID_BAR();

#ifndef SKIP_P6
        { int ln = lane; asm volatile("" : "+v"(ln));
        for (int r = gw; r < T_EFF; r += NGW) {
            const float* md = modl + (size_t)row_modidx(r) * 6 * D;
            const GAS f32x4* xr = (const GAS f32x4*)(X + (size_t)r * D) + ln;
            f32x4 v[4]; float ss = 0.f;
#pragma unroll
            for (int j = 0; j < 4; ++j) { v[j] = xr[64 * j]; ss += (v[j].x * v[j].x + v[j].y * v[j].y) + (v[j].z * v[j].z + v[j].w * v[j].w); }
            const float rs = 1.0f / sqrtf(wave_sum(ss) * (1.f / D) + NORM_EPS);
            GAS v2u* o8 = (GAS v2u*)(H + (size_t)r * D) + ln;
#pragma unroll
            for (int j = 0; j < 4; ++j) {
                const f32x4 g = *((const GAS f32x4*)(args.in[I_G2] + layer * D) + ln + 64 * j);
                const f32x4 sh = *((const GAS f32x4*)(md + 3 * D) + ln + 64 * j), sc = *((const GAS f32x4*)(md + 4 * D) + ln + 64 * j);
                const f32x4 h = v[j] * rs * g * (sc + 1.0f) + sh;
                v2u o; o.x = pk2(h.x, h.y); o.y = pk2(h.z, h.w); o8[64 * j] = o;
            }
        }
        }
#endif
        GRID_BAR();

#ifndef SKIP_P7
        {
            pg8::Gemm g{H, WQ + (size_t)layer * 2048 * D, D, D, D, 0, 0};
            pg8::SegOrder<1> S; S.T.init(T_LAT, 2048, G, (int)blockIdx.x);
            EpiStore E{Q2, 2048};
            pg8::gemm_phase(L, g, S, E);
        }
        if (!last) { int lo__ = lane; asm volatile("" : "+v"(lo__)); { const int lane = lo__; const int fr = lane & 15, fq = lane >> 4; (void)fr; (void)fq;
            for (int it = gw; it < (T_ALL - T_LAT) / 64 * (2048 / 64); it += NGW) {
                const int row0 = T_LAT + (it / (2048 / 64)) * 64, col0 = (it % (2048 / 64)) * 64;
                f32x4 acc[4][4]; zero_acc<4>(acc);
                sgemm_tile(acc, H, D, WQ + (size_t)layer * 2048 * D, D, D, row0, col0, lane);
#pragma unroll
                for (int m = 0; m < 4; ++m)
#pragma unroll
                    for (int r = 0; r < 4; ++r) {
                        bf16* rowp = Q2 + (size_t)(row0 + 16 * m + 4 * fq + r) * 2048 + col0 + fr;
#pragma unroll
                        for (int n = 0; n < 4; ++n) rowp[16 * n] = (bf16)f2bf(acc[m][n][r]);
                    }
            }
} }
#endif
        GRID_BAR();

#ifndef SKIP_P8
{ int lo__ = lane; asm volatile("" : "+v"(lo__)); { const int lane = lo__; const int fr = lane & 15, fq = lane >> 4, tid = wave * 64 + lane; (void)fr; (void)fq; (void)tid;
        {
            const int NMT = T_EFF / 256; constexpr int NNT = 2048 / 128;
            const int wr = wave >> 1, wc = wave & 1;
            for (int it = vcu; it < NMT * NNT; it += G) {
                const int pm = it / NNT, grp = it % NNT;
                const int row0 = pm * 256 + wr * 64, c0 = wc * 64;
                f32x4 acc[4][4]; zero_acc<4>(acc);
                sgemm_tile(acc, Q2 + grp * 128, 2048, KEYS + (size_t)(layer * 16 + grp) * 128 * 128, 128, 128, row0, c0, lane);
#pragma unroll
                for (int m = 0; m < 4; ++m)
#pragma unroll
                    for (int r = 0; r < 4; ++r) {
                        float* rowp = SC + (size_t)(row0 + 16 * m + 4 * fq + r) * 2048 + grp * 128 + c0 + fr;
#pragma unroll
                        for (int n = 0; n < 4; ++n) rowp[16 * n] = acc[m][n][r];
                    }
            }
        }
} }
#endif
        GRID_BAR();

#ifndef SKIP_P9
{ int lo__ = lane; asm volatile("" : "+v"(lo__)); { const int lane = lo__; const int fr = lane & 15, fq = lane >> 4, tid = wave * 64 + lane; (void)fr; (void)fq; (void)tid;
        for (int it = vcu * NTHREADS + tid; it < T_EFF * PEER_HEADS; it += NGT) {
            const int t = it >> 3, hh = it & 7;
            const float* sc = SC + (size_t)t * 2048 + hh * 256;
            int a0[16], a1[16];
#pragma unroll
            for (int i = 0; i < 16; ++i) { a0[i] = (int)0x80000000; a1[i] = (int)0x80000000; }
            for (int k = 0; k < 128; k += 4) {
                const f32x4 v = *(const GAS f32x4*)(sc + k);
                top16_insert(a0, (f2ord(v.x) & ~127) | (k + 0)); top16_insert(a0, (f2ord(v.y) & ~127) | (k + 1));
                top16_insert(a0, (f2ord(v.z) & ~127) | (k + 2)); top16_insert(a0, (f2ord(v.w) & ~127) | (k + 3));
            }
            for (int k = 0; k < 128; k += 4) {
                const f32x4 v = *(const GAS f32x4*)(sc + 128 + k);
                top16_insert(a1, (f2ord(v.x) & ~127) | (k + 0)); top16_insert(a1, (f2ord(v.y) & ~127) | (k + 1));
                top16_insert(a1, (f2ord(v.z) & ~127) | (k + 2)); top16_insert(a1, (f2ord(v.w) & ~127) | (k + 3));
            }
            int c[16];
#pragma unroll
            for (int i = 0; i < 16; ++i) c[i] = (int)0x80000000;
#pragma unroll
            for (int i = 0; i < 16; ++i) {
                const float vi = ord2f(a0[i] & ~127);
#pragma unroll
                for (int j = 0; j < 16; ++j) {
                    if ((i + 1) * (j + 1) <= 16) {
                        const float sj = vi + ord2f(a1[j] & ~127);
                        top16_insert(c, (f2ord(sj) & ~255) | (i * 16 + j));
                    }
                }
            }
            const float smax = ord2f(c[0] & ~255);
            float pe[16]; float psum = 0.f;
#pragma unroll
            for (int k = 0; k < 16; ++k) { pe[k] = __expf(ord2f(c[k] & ~255) - smax); psum += pe[k]; }
            const float ip = 1.0f / psum;
#pragma unroll
            for (int k = 0; k < 16; ++k) {
                const int ij = c[k] & 255, ii = ij >> 4, jj = ij & 15;
                int e0 = 0, e1 = 0;
#pragma unroll
                for (int q = 0; q < 16; ++q) { e0 = (ii == q) ? (a0[q] & 127) : e0; e1 = (jj == q) ? (a1[q] & 127) : e1; }
                const int e = e0 * PEER_KEYS + e1;
                const float su = SCU[layer * 16384 + e], sv = SCV[layer * 16384 + e];
                EI[(size_t)t * NSEL + hh * 16 + k] = (unsigned)e | (f2bf(su) << 16);
                EG[(size_t)t * NSEL + hh * 16 + k] = pe[k] * ip * sv;
            }
        }
} }
#endif
        GRID_BAR();

#ifndef SKIP_P10
        { int ln = lane; asm volatile("" : "+v"(ln));
        {
            const unsigned char* U8l = U8 + (size_t)layer * 16384 * D;
            const unsigned char* V8l = V8 + (size_t)layer * 16384 * D;
            for (int t = gw; t < T_EFF; t += NGW) {
                f32x4 hv[4];
                { const GAS v2u* hp = (const GAS v2u*)(H + (size_t)t * D) + ln;
#pragma unroll
                  for (int j = 0; j < 4; ++j) { const v2u w = hp[64 * j]; hv[j] = (f32x4){bf2f(w.x & 0xffffu), bf2f(w.x >> 16), bf2f(w.y & 0xffffu), bf2f(w.y >> 16)}; } }
                f32x4 o[4];
#pragma unroll
                for (int j = 0; j < 4; ++j) o[j] = (f32x4){0.f, 0.f, 0.f, 0.f};
#pragma unroll 1
                for (int s0 = 0; s0 < NSEL; s0 += 32) {
                    const unsigned esu = EI[(size_t)t * NSEL + s0 + (ln & 31)]; const float gv = EG[(size_t)t * NSEL + s0 + (ln & 31)];
                    int eidx = (int)(esu & 0xffffu); const float su = bf2f(esu >> 16);
                    float p[32];
                    {
                        v4u rowa[8], rowb[8];
#pragma unroll
                        for (int q = 0; q < 8; ++q) { const int e = __builtin_amdgcn_readlane(eidx, q); rowa[q] = *((const GAS v4u*)(U8l + (size_t)e * D) + ln); }
#pragma unroll
                        for (int g = 0; g < 4; ++g) {
                            if (g < 3) {
#pragma unroll
                                for (int q = 0; q < 8; ++q) { const int e = __builtin_amdgcn_readlane(eidx, (g + 1) * 8 + q);
                                    if (g & 1) rowa[q] = *((const GAS v4u*)(U8l + (size_t)e * D) + ln); else rowb[q] = *((const GAS v4u*)(U8l + (size_t)e * D) + ln); }
                            }
                            __builtin_amdgcn_sched_barrier(0);
#pragma unroll
                            for (int q = 0; q < 8; ++q) {
                                const v4u rw = (g & 1) ? rowb[q] : rowa[q];
                                float dd = 0.f;
#pragma unroll
                                for (int j = 0; j < 4; ++j) {
                                    const f32x2 a = __builtin_amdgcn_cvt_pk_f32_fp8((int)rw[j], false), b = __builtin_amdgcn_cvt_pk_f32_fp8((int)rw[j], true);
                                    dd += (a.x * hv[j].x + a.y * hv[j].y) + (b.x * hv[j].z + b.y * hv[j].w);
                                }
                                asm volatile("" : "+v"(dd));
                                p[g * 8 + q] = dd;
                                __builtin_amdgcn_sched_barrier(0);
                            }
                        }
                    }
#pragma unroll
                    for (int w = 16; w >= 1; w >>= 1) {
                        const bool up = (ln & w) != 0;
#pragma unroll
                        for (int i = 0; i < w; ++i) {
                            const float send = up ? p[i] : p[i + w], keep = up ? p[i + w] : p[i];
                            p[i] = keep + __shfl_xor(send, w);
                        }
                    }
                    const float dot = (p[0] + __shfl_xor(p[0], 32)) * su;
                    float wgt = 0.5f * dot * (1.0f + erff(dot * 0.70710678118654752f)) * gv;
                    asm volatile("" : "+v"(eidx), "+v"(wgt));
                    {
                        v4u rowa[8], rowb[8];
#pragma unroll
                        for (int q = 0; q < 8; ++q) { const int e = __builtin_amdgcn_readlane(eidx, q); rowa[q] = *((const GAS v4u*)(V8l + (size_t)e * D) + ln); }
#pragma unroll
                        for (int g = 0; g < 4; ++g) {
                            if (g < 3) {
#pragma unroll
                                for (int q = 0; q < 8; ++q) { const int e = __builtin_amdgcn_readlane(eidx, (g + 1) * 8 + q);
                                    if (g & 1) rowa[q] = *((const GAS v4u*)(V8l + (size_t)e * D) + ln); else rowb[q] = *((const GAS v4u*)(V8l + (size_t)e * D) + ln); }
                            }
                            __builtin_amdgcn_sched_barrier(0);
#pragma unroll
                            for (int q = 0; q < 8; ++q) {
                                const v4u rw = (g & 1) ? rowb[q] : rowa[q];
                                const float wq = __builtin_bit_cast(float, __builtin_amdgcn_readlane(__builtin_bit_cast(int, wgt), g * 8 + q));
#pragma unroll
                                for (int j = 0; j < 4; ++j) {
                                    const f32x2 a = __builtin_amdgcn_cvt_pk_f32_fp8((int)rw[j], false), b = __builtin_amdgcn_cvt_pk_f32_fp8((int)rw[j], true);
                                    o[j].x += wq * a.x; o[j].y += wq * a.y; o[j].z += wq * b.x; o[j].w += wq * b.y;
                                }
                                asm volatile("" : "+v"(o[0]), "+v"(o[1]), "+v"(o[2]), "+v"(o[3]));
                                __builtin_amdgcn_sched_barrier(0);
                            }
                        }
                    }
                }
                const float* gt2 = modl + (size_t)row_modidx(t) * 6 * D + 5 * D;
                GAS f32x4* xr = (GAS f32x4*)(X + (size_t)t * D) + ln;
                f32x4 xn[4]; float ss = 0.f;
#pragma unroll
                for (int j = 0; j < 4; ++j) {
                    xn[j] = xr[64 * j] + *((const GAS f32x4*)gt2 + ln + 64 * j) * o[j];
                    ss += (xn[j].x * xn[j].x + xn[j].y * xn[j].y) + (xn[j].z * xn[j].z + xn[j].w * xn[j].w);
                }
                if (!last) {
#pragma unroll
                    for (int j = 0; j < 4; ++j) xr[64 * j] = xn[j];
                } else {
                    const float rs = 1.0f / sqrtf(wave_sum(ss) * (1.f / D) + NORM_EPS);
                    GAS f32x4* op = (GAS f32x4*)(args.out + (size_t)t * D) + ln;
#pragma unroll
                    for (int j = 0; j < 4; ++j) op[64 * j] = xn[j] * rs * *((const GAS f32x4*)args.in[I_GFINAL] + ln + 64 * j);
                }
            }
        }
        }
#endif
        if (!last) GRID_BAR();
    }
}

extern "C" void kernel_launch(void* const* d_in, const int* in_sizes, int n_in, void* d_out, int out_size, void* d_ws, size_t ws_size, hipStream_t stream) {
    static int grid = 0;
    if (grid == 0) {
        if (n_in != 22 || out_size != T_LAT * D || ws_size < WS_END) { fprintf(stderr, "kernel_launch: unexpected shapes: n_in %d out %d ws %zu (need %zu)\n", n_in, out_size, ws_size, (size_t)WS_END); grid = -1; return; }
        int dev = 0, cus = 0, per_cu = 0;
        if (hipGetDevice(&dev) != hipSuccess || hipDeviceGetAttribute(&cus, hipDeviceAttributeMultiprocessorCount, dev) != hipSuccess) { fprintf(stderr, "device query failed\n"); grid = -1; return; }
        if (hipFuncSetAttribute((const void*)mega_fwd, hipFuncAttributeMaxDynamicSharedMemorySize, LDS_BYTES) != hipSuccess) { fprintf(stderr, "hipFuncSetAttribute failed\n"); grid = -1; return; }
        if (hipOccupancyMaxActiveBlocksPerMultiprocessor(&per_cu, (const void*)mega_fwd, NTHREADS, LDS_BYTES) != hipSuccess || per_cu < 1) { fprintf(stderr, "occupancy query: %d\n", per_cu); }
        (void)hipGetLastError();
        grid = cus;
    }
    if (grid < 0) return;
    if (hipMemsetAsync((char*)d_ws + WS_CTL, 0, CTL_ZERO_BYTES, stream) != hipSuccess) { fprintf(stderr, "memset failed\n"); return; }
    Args a{};
    for (int i = 0; i < 22; ++i) a.in[i] = (const float*)d_in[i];
    a.out = (float*)d_out; a.ws = (unsigned char*)d_ws;
    hipLaunchKernelGGL(mega_fwd, dim3(grid), dim3(NTHREADS), LDS_BYTES, stream, a);
}
```

```cpp
#include <hip/hip_runtime.h>
#include <cstdio>
#include <cstdint>

#ifndef REP_P0
#define REP_P0 1
#endif
#ifndef REP_P1
#define REP_P1 1
#endif
#ifndef REP_P2
#define REP_P2 1
#endif
#ifndef REP_P3A
#define REP_P3A 1
#endif
#ifndef REP_P3B
#define REP_P3B 1
#endif
#ifndef REP_P4
#define REP_P4 1
#endif
#ifndef REP_P6
#define REP_P6 1
#endif
#ifndef REP_P7
#define REP_P7 1
#endif
#ifndef REP_P8
#define REP_P8 1
#endif
#ifndef REP_P9
#define REP_P9 1
#endif
#ifndef REP_P10
#define REP_P10 1
#endif
#ifndef REP_P3C
#define REP_P3C 1
#endif
#define GAS __attribute__((address_space(1)))
#define LAS __attribute__((address_space(3)))
typedef unsigned short bf16;
typedef float f32x4 __attribute__((ext_vector_type(4)));
typedef short bf16x8 __attribute__((ext_vector_type(8)));
typedef unsigned v4u __attribute__((ext_vector_type(4)));
typedef unsigned v2u __attribute__((ext_vector_type(2)));
typedef float f32x2 __attribute__((ext_vector_type(2)));
typedef GAS unsigned gu32;

constexpr int NWAVES = 8, NTHREADS = 512;
constexpr int D = 1024, BATCH = 2, SEQ = 8192, DEPTH = 2, GRID_W = 64, CTX = 256;
constexpr int T_LAT = BATCH * SEQ;
constexpr int T_ALL = T_LAT + BATCH * CTX;
constexpr int NTOK = SEQ + CTX;
constexpr int IN_W = 6912;
constexpr int PEER_HEADS = 8, PEER_KEYS = 128, PEER_TOPK = 16, NSEL = PEER_HEADS * PEER_TOPK;
constexpr float NORM_EPS = 1e-6f;
constexpr float LOG2E = 1.4426950408889634f;
constexpr float SCL2 = 0.125f * LOG2E;

constexpr size_t MiB = 1u << 20;
constexpr size_t WS_CTL = 0, CTL_ZERO_BYTES = 1 * MiB;
constexpr int CW_BAR = 4096;
constexpr size_t WS_MOD = 65536;
constexpr size_t WS_COS = 2 * MiB, WS_SIN = 3 * MiB;
constexpr size_t WS_WIN = 4 * MiB;
constexpr size_t WS_WB = 31 * MiB;
constexpr size_t WS_WO = 37 * MiB;
constexpr size_t WS_WQ = 41 * MiB;
constexpr size_t WS_KEYS = 49 * MiB;
constexpr size_t WS_X = 50 * MiB;
constexpr size_t WS_H = 116 * MiB;
constexpr size_t WS_Y = 149 * MiB;
constexpr size_t WS_MG = WS_H;
constexpr size_t WS_U8 = 199 * MiB;
constexpr size_t WS_SCU = 231 * MiB;
constexpr size_t WS_EI = 232 * MiB;
constexpr size_t WS_EG = 241 * MiB;
constexpr size_t WS_P = 250 * MiB;
constexpr size_t SZ_R512 = (size_t)T_ALL * 512 * 2;
constexpr size_t SZ_R128 = (size_t)T_ALL * 128 * 2;
constexpr size_t WS_AQ = WS_P, WS_AK = WS_AQ + SZ_R512, WS_AVT = WS_AK + SZ_R128, WS_BQ = WS_AVT + SZ_R128, WS_BK = WS_BQ + SZ_R512,
                 WS_BVT = WS_BK + SZ_R512, WS_CQ = WS_BVT + SZ_R512, WS_CK = WS_CQ + SZ_R512, WS_CVT = WS_CK + SZ_R512, WS_SG = WS_CVT + SZ_R512;
constexpr size_t WS_Q2 = WS_P;
constexpr size_t WS_SC = WS_P + 66 * MiB;
constexpr size_t WS_PEND = WS_SG + (size_t)T_ALL * 3072 * 2;
constexpr size_t WS_V8 = 473 * MiB;
constexpr size_t WS_END = WS_V8 + 32 * MiB;
static_assert(WS_SC + (size_t)T_ALL * 2048 * 4 <= WS_PEND && WS_PEND <= WS_V8, "alias map");
static_assert(WS_END <= 512 * MiB, "ws map");

constexpr int LDS_BYTES = 147456;
constexpr int MISC_OFF = 131072 + 320;

__device__ __forceinline__ int lane_id_v() { int l; asm volatile("v_mbcnt_lo_u32_b32 %0, -1, 0\n\tv_mbcnt_hi_u32_b32 %0, -1, %0" : "=v"(l)); return l; }
#define XB_TMO      128
#define XB_XCNT(j)  (256  + 64 * (j))
#define XB_XSUB(j)  (1280 + 64 * (j))
#define XB_XGEN(j)  (2304 + 64 * (j))
#define XB_TOP      3328
#define XB_TOPGEN   3392
#define XCD_BAR_WORDS 3456
#define XB_SPIN_CAP (1u << 24)

__device__ __forceinline__ unsigned xb_ld(unsigned* p)              { return __hip_atomic_load(p, __ATOMIC_RELAXED, __HIP_MEMORY_SCOPE_AGENT); }
__device__ __forceinline__ unsigned xb_add(unsigned* p, unsigned v) { return __hip_atomic_fetch_add(p, v, __ATOMIC_RELAXED, __HIP_MEMORY_SCOPE_AGENT); }
__device__ __forceinline__ unsigned xb_xcc_id() { return (unsigned)__builtin_amdgcn_s_getreg((3 << 11) | 20) & 0xFu; }
#define XB_SPIN(cond, bar) do { unsigned _sp = 0; while (cond) { __builtin_amdgcn_s_sleep(1); \
    if ((++_sp & 255u) == 0u) { if (xb_ld(&(bar)[XB_TMO])) break; if (_sp > XB_SPIN_CAP) { atomicAdd(&(bar)[XB_TMO], 1u); break; } } } } while (0)

struct XcdBarrier { unsigned* bar; unsigned x; volatile LAS unsigned* st; };

__device__ __forceinline__ XcdBarrier xcd_barrier_post(unsigned* bar, volatile LAS unsigned* st) {
    XcdBarrier b; b.bar = bar; b.x = xb_xcc_id(); b.st = st;
    if (threadIdx.x == 0) (void)xb_add(&bar[XB_XCNT(b.x)], 1u);
    return b;
}
__device__ __forceinline__ void xcd_barrier_complete(unsigned* bar, unsigned x, unsigned& nloc, unsigned& nx) {
    const unsigned G = gridDim.x * gridDim.y * gridDim.z;
    unsigned sum, cnt, mine, sp = 0u;
    for (;;) {
        sum = 0u; cnt = 0u; mine = 0u;
#pragma unroll
        for (unsigned j = 0; j < 16; ++j) { const unsigned c = xb_ld(&bar[XB_XCNT(j)]); sum += c; cnt += (c > 0u) ? 1u : 0u; mine = (j == x) ? c : mine; }
        if (sum == G) break;
        __builtin_amdgcn_s_sleep(1);
        if ((++sp & 255u) == 0u) { if (xb_ld(&bar[XB_TMO])) break; if (sp > XB_SPIN_CAP) { atomicAdd(&bar[XB_TMO], 1u); break; } }
    }
    nloc = mine > 0u ? mine : 1u; nx = cnt > 0u ? cnt : 1u;
}
__device__ __forceinline__ void xcd_barrier(const XcdBarrier& b, bool t0) {
    asm volatile("s_waitcnt vmcnt(0)" ::: "memory");
    __syncthreads();
    if (t0) {
        unsigned* bar = b.bar;
        __builtin_amdgcn_s_waitcnt(0);
        unsigned nloc = b.st[0], nx = b.st[1];
        if (nloc == 0u) { xcd_barrier_complete(bar, b.x, nloc, nx); b.st[0] = nloc; b.st[1] = nx; }
        const unsigned old = xb_add(&bar[XB_XSUB(b.x)], 1u);
        const unsigned gen = old / nloc;
        if (old + 1u == (gen + 1u) * nloc) {
            __builtin_amdgcn_fence(__ATOMIC_RELEASE, "agent");
            asm volatile("s_waitcnt vmcnt(0)" ::: "memory");
            const unsigned og = xb_add(&bar[XB_TOP], 1u);
            const unsigned tg = og / nx;
            if (og + 1u == (tg + 1u) * nx) xb_add(&bar[XB_TOPGEN], 1u);
            else XB_SPIN(xb_ld(&bar[XB_TOPGEN]) == tg, bar);
            __builtin_amdgcn_fence(__ATOMIC_ACQUIRE, "agent");
            xb_add(&bar[XB_XGEN(b.x)], 1u);
            asm volatile("s_waitcnt vmcnt(0)" ::: "memory");
        } else {
            XB_SPIN(xb_ld(&bar[XB_XGEN(b.x)]) == gen, bar);
            __builtin_amdgcn_fence(__ATOMIC_ACQUIRE, "agent");
            asm volatile("s_waitcnt vmcnt(0)" ::: "memory");
        }
    }
    __syncthreads();
}

__device__ __forceinline__ unsigned f2bf(float f) { unsigned u = __builtin_bit_cast(unsigned, f); return (u + 0x7fffu + ((u >> 16) & 1u)) >> 16; }
__device__ __forceinline__ unsigned pk2(float lo, float hi) { return f2bf(lo) | (f2bf(hi) << 16); }
__device__ __forceinline__ float bf2f(unsigned h) { return __builtin_bit_cast(float, h << 16); }
__device__ __forceinline__ float wave_sum(float v) {
#pragma unroll
    for (int o = 1; o < 64; o <<= 1) v += __shfl_xor(v, o);
    return v;
}
__device__ __forceinline__ float grp16_sum(float v) { v += __shfl_xor(v, 1); v += __shfl_xor(v, 2); v += __shfl_xor(v, 4); v += __shfl_xor(v, 8); return v; }
__device__ __forceinline__ float grp16_max(float v) { v = fmaxf(v, __shfl_xor(v, 1)); v = fmaxf(v, __shfl_xor(v, 2)); v = fmaxf(v, __shfl_xor(v, 4)); v = fmaxf(v, __shfl_xor(v, 8)); return v; }
__device__ __forceinline__ float sigmoidf_(float x) { return 1.0f / (1.0f + __expf(-x)); }
__device__ __forceinline__ int row_modidx(int r) { return r < T_LAT ? (r >> 13) : 2; }
__device__ __forceinline__ int row_batch(int r) { return r < T_LAT ? (r >> 13) : ((r - T_LAT) >> 8); }
__device__ __forceinline__ int row_tok(int r) { return r < T_LAT ? (r & (SEQ - 1)) : SEQ + ((r - T_LAT) & (CTX - 1)); }

__device__ __forceinline__ const float* xin_row(const float* x, const float* ctx, int r) { return r < T_LAT ? x + (size_t)r * D : ctx + (size_t)(r - T_LAT) * D; }
struct Args { const float* in[22]; float* out; unsigned char* ws; };
enum { I_X = 0, I_C, I_CTX, I_CCTX, I_WMOD, I_BMOD, I_G1, I_G2, I_WIN, I_SINK, I_RPB, I_LAMBDA, I_SUBLN, I_WBA, I_WBB, I_WBC, I_WOUT, I_PWQ, I_PKEYS, I_PU, I_PV, I_GFINAL };

__device__ __forceinline__ int rope_perm(int c) {
    if (c < 640 || (c >= 2304 && c < 3328)) { const int w = c & 63; return (c & ~63) + 2 * (w & 31) + (w >> 5); }
    return c;
}
template <bool PERM = false>
__device__ __forceinline__ void p0_transpose_item(const float* W, int K, int N, bf16* WT, LAS float* scr, int item, int lane) {
    const int nblk = N / 32, kb = item / nblk, nb = item % nblk, k0 = 64 * kb, n0 = 32 * nb;
#pragma unroll 8
    for (int i = 0; i < 32; ++i) { const int kk = 2 * i + (lane >> 5); scr[kk * 33 + (lane & 31)] = W[(size_t)(k0 + kk) * N + n0 + (lane & 31)]; }
    asm volatile("s_waitcnt lgkmcnt(0)" ::: "memory");
    const int c = lane & 7;
#pragma unroll
    for (int j = 0; j < 4; ++j) { const int n = (lane >> 3) + 8 * j; const LAS float* s = scr + (8 * c) * 33 + n;
        v4u o; o.x = pk2(s[0 * 33], s[1 * 33]); o.y = pk2(s[2 * 33], s[3 * 33]); o.z = pk2(s[4 * 33], s[5 * 33]); o.w = pk2(s[6 * 33], s[7 * 33]);
        const int nout = PERM ? rope_perm(n0 + n) : (n0 + n);
        *(GAS v4u*)(WT + (size_t)nout * K + k0 + 8 * c) = o; }
    asm volatile("s_waitcnt lgkmcnt(0)" ::: "memory");
}

template <int UNR = 2, int NN = 4>
__device__ __forceinline__ void sgemm_tile(f32x4 (&acc)[4][NN], const bf16* A, int lda, const bf16* Bt, int ldb, int K, int row0, int col0, int lane) {
    const int fr = lane & 15, fq = lane >> 4;
    const bf16* ap = A + (size_t)(row0 + fr) * lda + fq * 8;
    const bf16* bp = Bt + (size_t)(col0 + fr) * ldb + fq * 8;
#pragma unroll UNR
    for (int k = 0; k < K; k += 32) {
        bf16x8 a[4], b[NN];
#pragma unroll
        for (int m = 0; m < 4; ++m) a[m] = *(const GAS bf16x8*)(ap + (size_t)m * 16 * lda + k);
#pragma unroll
        for (int n = 0; n < NN; ++n) b[n] = *(const GAS bf16x8*)(bp + (size_t)n * 16 * ldb + k);
#pragma unroll
        for (int m = 0; m < 4; ++m)
#pragma unroll
            for (int n = 0; n < NN; ++n) acc[m][n] = __builtin_amdgcn_mfma_f32_16x16x32_bf16(a[m], b[n], acc[m][n], 0, 0, 0);
    }
}
template <int UNR>
__device__ __forceinline__ void sgemm32(f32x4 (&acc)[2][2], const bf16* A, int lda, const bf16* Bt, int ldb, int K, int row0, int col0, int lane) {
    const int fr = lane & 15, fq = lane >> 4;
    const bf16* ap = A + (size_t)(row0 + fr) * lda + fq * 8;
    const bf16* bp = Bt + (size_t)(col0 + fr) * ldb + fq * 8;
#pragma unroll 1
    for (int k0 = 0; k0 < K; k0 += 32 * UNR) {
        bf16x8 a[UNR][2], b[UNR][2];
#pragma unroll
        for (int u = 0; u < UNR; ++u)
#pragma unroll
            for (int m = 0; m < 2; ++m) { a[u][m] = *(const GAS bf16x8*)(ap + (size_t)m * 16 * lda + k0 + 32 * u); b[u][m] = *(const GAS bf16x8*)(bp + (size_t)m * 16 * ldb + k0 + 32 * u); }
#pragma unroll
        for (int u = 0; u < UNR; ++u)
#pragma unroll
            for (int m = 0; m < 2; ++m)
#pragma unroll
                for (int n = 0; n < 2; ++n) acc[m][n] = __builtin_amdgcn_mfma_f32_16x16x32_bf16(a[u][m], b[u][n], acc[m][n], 0, 0, 0);
    }
}
__device__ __forceinline__ void zero_acc22(f32x4 (&acc)[2][2]) { acc[0][0] = acc[0][1] = acc[1][0] = acc[1][1] = (f32x4){0.f, 0.f, 0.f, 0.f}; }
template <int NN>
__device__ __forceinline__ void zero_acc(f32x4 (&acc)[4][NN]) {
#pragma unroll
    for (int m = 0; m < 4; ++m)
#pragma unroll
        for (int n = 0; n < NN; ++n) acc[m][n] = (f32x4){0.f, 0.f, 0.f, 0.f};
}

template <int NDT> struct AttnAcc { f32x4 o[NDT]; float m[4], l[4]; };

__device__ __forceinline__ f32x4 s_tile(const bf16x8 (&qf)[2], const bf16* Kb, int kpitch, int khoff, int krow, int fr, int fq) {
    const bf16* kp = Kb + (size_t)(krow + fr) * kpitch + khoff + fq * 8;
    const bf16x8 k0 = *(const GAS bf16x8*)kp, k1 = *(const GAS bf16x8*)(kp + 32);
    f32x4 s = (f32x4){0.f, 0.f, 0.f, 0.f};
    s = __builtin_amdgcn_mfma_f32_16x16x32_bf16(qf[0], k0, s, 0, 0, 0);
    s = __builtin_amdgcn_mfma_f32_16x16x32_bf16(qf[1], k1, s, 0, 0, 0);
    return s;
}
template <int NT, int NDT, int PSTR>
__device__ __forceinline__ void softmax_update(AttnAcc<NDT>& st, f32x4 (&s)[NT], LAS bf16* Pl, int fr, int fq) {
#pragma unroll
    for (int r = 0; r < 4; ++r) {
        float mx = s[0][r];
#pragma unroll
        for (int t = 1; t < NT; ++t) mx = fmaxf(mx, s[t][r]);
        mx = grp16_max(mx);
        const float mn = fmaxf(st.m[r], mx);
        const float alpha = __builtin_amdgcn_exp2f(st.m[r] - mn);
        st.m[r] = mn;
        float ls = st.l[r] * alpha;
#pragma unroll
        for (int dt = 0; dt < NDT; ++dt) st.o[dt][r] *= alpha;
#pragma unroll
        for (int t = 0; t < NT; ++t) {
            const float p = (s[t][r] > -1e29f) ? __builtin_amdgcn_exp2f(s[t][r] - mn) : 0.f;
            ls += p;
            Pl[(4 * fq + r) * PSTR + t * 16 + fr] = (bf16)f2bf(p);
        }
        st.l[r] = ls;
    }
}
template <int NKS, int NDT, int PSTR>
__device__ __forceinline__ void pv_update(AttnAcc<NDT>& st, const LAS bf16* Pl, const bf16* Vt, int tok0, int fr, int fq) {
    asm volatile("s_waitcnt lgkmcnt(0)" ::: "memory");
    __builtin_amdgcn_wave_barrier();
#pragma unroll
    for (int ks = 0; ks < NKS; ++ks) {
        const bf16x8 pf = *(const LAS bf16x8*)(Pl + fr * PSTR + ks * 32 + fq * 8);
#pragma unroll
        for (int dt = 0; dt < NDT; ++dt) {
            const bf16x8 vf = *(const GAS bf16x8*)(Vt + (size_t)(dt * 16 + fr) * NTOK + tok0 + ks * 32 + fq * 8);
            st.o[dt] = __builtin_amdgcn_mfma_f32_16x16x32_bf16(pf, vf, st.o[dt], 0, 0, 0);
        }
    }
    asm volatile("s_waitcnt lgkmcnt(0)" ::: "memory");
    __builtin_amdgcn_wave_barrier();
}

__device__ __forceinline__ int f2ord(float f) { const int b = __builtin_bit_cast(int, f); return b ^ ((b >> 31) & 0x7fffffff); }
__device__ __forceinline__ float ord2f(int o) { const int b = o ^ ((o >> 31) & 0x7fffffff); return __builtin_bit_cast(float, b); }
__device__ __forceinline__ void top16_insert(int (&top)[16], int key) {
#pragma unroll
    for (int i = 0; i < 16; ++i) { const int hi = max(top[i], key); key = min(top[i], key); top[i] = hi; }
}


typedef float f32x16 __attribute__((ext_vector_type(16)));
typedef short s16x4 __attribute__((ext_vector_type(4)));
typedef __bf16 bf16x2_t __attribute__((ext_vector_type(2)));
__device__ __forceinline__ unsigned cvtpk(float lo, float hi) { f32x2 v = {lo, hi}; bf16x2_t b = __builtin_convertvector(v, bf16x2_t); return __builtin_bit_cast(unsigned, b); }
constexpr int CK_PITCH = 144, CV_PITCH = 320;
constexpr int CK_SZ = 64 * CK_PITCH, CV_SZ = 64 * CV_PITCH;
constexpr float C_THR_RAW = 8.0f / SCL2;

template <int NDV, class RowFn, class UseFn, class ElemFn>
__device__ __forceinline__ void attn64_pass(f32x16 (&o)[NDV], float& mrun, float& lpart, const bf16x8 (&qf)[4], const bf16* kg, int kpitch, const bf16* vg, int vpitch,
                                            int ntiles, RowFn tile_row, UseFn use_tile, ElemFn elem, LAS unsigned char* L, int lane, int tid) {
    constexpr int VP = NDV * 64 + 64, VSZ = 64 * VP, NVP = NDV / 2;
    const int r32 = lane & 31, hi = lane >> 5;
    const int krow_s = tid >> 3, kch_s = tid & 7;
    const int vrow_s = (NDV == 2) ? (tid >> 3) : (tid >> 4), vch_s = (NDV == 2) ? (tid & 7) : (tid & 15);
    LAS unsigned char* Kb0 = L; LAS unsigned char* Vb0 = L + 2 * CK_SZ;
    __syncthreads();
    {
        const int tr = tile_row(0);
        const v4u kr = *(const GAS v4u*)(kg + (size_t)tr * kpitch);
        *(LAS v4u*)(Kb0 + krow_s * CK_PITCH + kch_s * 16) = kr;
#pragma unroll
        for (int i = 0; i < NVP; ++i) { const v4u v = *(const GAS v4u*)(vg + (size_t)(tr + 32 * i) * vpitch); *(LAS v4u*)(Vb0 + (vrow_s + 32 * i) * VP + vch_s * 16) = v; }
    }
    __syncthreads();
#pragma unroll 1
    for (int j = 0; j < ntiles; ++j) {
        const int cur = j & 1;
        const LAS unsigned char* Kb = Kb0 + cur * CK_SZ; const LAS unsigned char* Vb = Vb0 + cur * VSZ;
        v4u kr, vr[NVP];
        const bool more = (j + 1 < ntiles);
        if (more) { const int tr = tile_row(j + 1); kr = *(const GAS v4u*)(kg + (size_t)tr * kpitch);
#pragma unroll
            for (int i = 0; i < NVP; ++i) vr[i] = *(const GAS v4u*)(vg + (size_t)(tr + 32 * i) * vpitch); }
        if (use_tile(j)) {
            f32x16 st[2];
#pragma unroll
            for (int kb = 0; kb < 2; ++kb) {
#pragma unroll
                for (int r = 0; r < 16; ++r) st[kb][r] = 0.f;
#pragma unroll
                for (int ks = 0; ks < 4; ++ks) {
                    const bf16x8 kf = *(const LAS bf16x8*)(Kb + (kb * 32 + r32) * CK_PITCH + ks * 32 + hi * 16);
                    st[kb] = __builtin_amdgcn_mfma_f32_32x32x16_bf16(kf, qf[ks], st[kb], 0, 0, 0);
                }
            }
            elem(st, j);
            float mx = st[0][0];
#pragma unroll
            for (int r = 1; r < 16; ++r) mx = fmaxf(mx, st[0][r]);
#pragma unroll
            for (int r = 0; r < 16; ++r) mx = fmaxf(mx, st[1][r]);
            mx = fmaxf(mx, __shfl_xor(mx, 32));
            if (__builtin_amdgcn_ballot_w64(mx > mrun + C_THR_RAW) != 0ull) {
                const float mn = fmaxf(mrun, mx);
                const float alpha = __builtin_amdgcn_exp2f((mrun - mn) * SCL2);
#pragma unroll
                for (int d = 0; d < NDV; ++d)
#pragma unroll
                    for (int r = 0; r < 16; ++r) o[d][r] *= alpha;
                lpart *= alpha; mrun = mn;
            }
            const float nmc = -mrun * SCL2;
            float ls = 0.f;
#pragma unroll
            for (int kb = 0; kb < 2; ++kb)
#pragma unroll
                for (int r = 0; r < 16; ++r) { const float p = __builtin_amdgcn_exp2f(fmaf(st[kb][r], SCL2, nmc)); st[kb][r] = p; ls += p; }
            lpart += ls;
            const int q4 = (lane & 15) >> 2, p4 = lane & 3, grp = (lane >> 4) & 1;
            const LAS unsigned char* vbase = Vb + (4 * hi + q4) * VP + (16 * grp + 4 * p4) * 2;
#pragma unroll
            for (int kb = 0; kb < 2; ++kb)
#pragma unroll
                for (int ss = 0; ss < 2; ++ss) {
                    v4u pw;
#pragma unroll
                    for (int i2 = 0; i2 < 4; ++i2) pw[i2] = cvtpk(st[kb][8 * ss + 2 * i2], st[kb][8 * ss + 2 * i2 + 1]);
                    const bf16x8 pb = __builtin_bit_cast(bf16x8, pw);
#pragma unroll
                    for (int d = 0; d < NDV; ++d) {
                        const LAS unsigned char* va = vbase + (kb * 32 + 16 * ss) * VP + d * 64;
                        const s16x4 lo = __builtin_bit_cast(s16x4, __builtin_amdgcn_ds_read_tr16_b64_v4i16((LAS s16x4*)va));
                        const s16x4 hh = __builtin_bit_cast(s16x4, __builtin_amdgcn_ds_read_tr16_b64_v4i16((LAS s16x4*)(va + 8 * VP)));
                        const bf16x8 vf = __builtin_shufflevector(lo, hh, 0, 1, 2, 3, 4, 5, 6, 7);
                        o[d] = __builtin_amdgcn_mfma_f32_32x32x16_bf16(vf, pb, o[d], 0, 0, 0);
                    }
                }
        }
        if (more) {
            LAS unsigned char* Kn = Kb0 + (cur ^ 1) * CK_SZ; LAS unsigned char* Vn = Vb0 + (cur ^ 1) * VSZ;
            *(LAS v4u*)(Kn + krow_s * CK_PITCH + kch_s * 16) = kr;
#pragma unroll
            for (int i = 0; i < NVP; ++i) *(LAS v4u*)(Vn + (vrow_s + 32 * i) * VP + vch_s * 16) = vr[i];
        }
        __syncthreads();
    }
}
__device__ __forceinline__ void attn64_store(const f32x16 (&o)[2], float inv, bf16* yrow, int hi) {
#pragma unroll
    for (int d = 0; d < 2; ++d)
#pragma unroll
        for (int g4 = 0; g4 < 4; ++g4) {
            v2u w; w.x = cvtpk(o[d][4 * g4] * inv, o[d][4 * g4 + 1] * inv); w.y = cvtpk(o[d][4 * g4 + 2] * inv, o[d][4 * g4 + 3] * inv);
            *(GAS v2u*)(yrow + d * 32 + 8 * g4 + 4 * hi) = w;
        }
}

namespace pg8 {
typedef unsigned short bf16_t;
constexpr int BM = 256, BK = 64, HALF = 128, HTB = HALF * BK * 2, STAGE_BYTES = 8 * HTB, NXCD = 8, WGM = 8;
__host__ __device__ __forceinline__ int lds_byte(int r, int c) { const int st = (r >> 4) * 2 + (c >> 5), rr = r & 15, cc = c & 31, ob = rr * 64 + cc * 2; return st * 1024 + (ob ^ (((ob >> 9) & 1) << 5)); }
__host__ __device__ __forceinline__ void stage_rc(int b, int& R, int& C) { const int st = b / 1024, sb = b % 1024, swz = sb ^ (((sb >> 9) & 1) << 5); R = (st >> 1) * 16 + swz / 64; C = (st & 1) * 32 + (swz % 64) / 2; }
__host__ __device__ __forceinline__ int perm32(int rho) { const int n = rho >> 4, i = rho & 15; return 8 * (i >> 2) + 4 * n + (i & 3); }
struct Unit { int pm, pn, seg; };
struct Gemm { const bf16_t* A; const bf16_t* Bt; int lda, ldb, K; size_t a_seg, b_seg; };
struct TileOrder {
    int nM, nN, nwg, G, c;
    __device__ void init(int M, int N, int G_, int c_) { nM = M / BM; nN = N / BM; nwg = nM * nN; G = G_; c = c_; }
    __device__ bool tile(int i, int& pm, int& pn) const {
        const long L = (long)i * G + c; if (L >= nwg) return false;
        int wgid = (int)L; { const int q = nwg / NXCD, r = nwg % NXCD, xcd = wgid % NXCD, off = wgid / NXCD; wgid = (xcd < r ? xcd * (q + 1) : r * (q + 1) + (xcd - r) * q) + off; }
        const int nig = WGM * nN, gid = wgid / nig, fm = gid * WGM, gsz = (nM - fm) < WGM ? (nM - fm) : WGM;
        pm = fm + ((wgid % nig) % gsz); pn = (wgid % nig) / gsz; return true;
    }
};
template <int NSEG> struct SegOrder {
    TileOrder T;
    __device__ bool next(int i, Unit& u) const { u.seg = i % NSEG; return T.tile(i / NSEG, u.pm, u.pn); }
};
template <class Epi, class Sched>
__device__ __forceinline__ void gemm_phase(LAS unsigned char* lds, const Gemm g, const Sched& S, const Epi& E, int wid) {
    const int lane = lane_id_v(), tid = wid * 64 + lane,
              wr = wid >> 2, wc = wid & 3, fr = lane & 15, fq = lane >> 4;
    const int K = g.K, nt = K / BK;
    unsigned voffA[2], voffB[2];
#pragma unroll
    for (int i = 0; i < 2; ++i) { int R, C; stage_rc(tid * 16 + i * 8192, R, C); const int Rb = (R & ~31) + perm32(R & 31);
        voffA[i] = (unsigned)(R * g.lda + C) * 2u; voffB[i] = (unsigned)(Rb * g.ldb + C) * 2u; }
    const size_t kstep = (size_t)(BK * 2);
    const size_t hstepA = (size_t)HALF * g.lda * 2, hstepB = (size_t)HALF * g.ldb * 2;
    const unsigned ldsw = (unsigned)wid * 1024u;
    const int aoff = lds_byte(wr * 64 + fr, fq * 8), boff = lds_byte(wc * 32 + fr, fq * 8);
#define PG8_SA(b, h) (((b) * 2 + (h)) * HTB)
#define PG8_SB(b, h) ((4 + (b) * 2 + (h)) * HTB)
#define PG8_STAGE(bufoff, gbase, voff) do { _Pragma("unroll") for (int _i = 0; _i < 2; ++_i) \
        __builtin_amdgcn_global_load_lds((const unsigned*)((const char*)(gbase) + (voff)[_i]), (LAS unsigned*)(lds + (bufoff) + ldsw + _i * 8192), 16, 0, 0); } while (0)
#define PG8_LDA(dst, b, h) do { _Pragma("unroll") for (int m = 0; m < 4; ++m) _Pragma("unroll") for (int k = 0; k < 2; ++k) dst[m][k] = *(const LAS bf16x8*)(lds + PG8_SA(b, h) + aoff + m * 2048 + k * 1024); } while (0)
#define PG8_LDB(dst, b, h) do { _Pragma("unroll") for (int n = 0; n < 2; ++n) _Pragma("unroll") for (int k = 0; k < 2; ++k) dst[n][k] = *(const LAS bf16x8*)(lds + PG8_SB(b, h) + boff + n * 2048 + k * 1024); } while (0)
#define PG8_MMA(ai, bj, At, Bt) do { __builtin_amdgcn_s_setprio(1); _Pragma("unroll") for (int m = 0; m < 4; ++m) _Pragma("unroll") for (int n = 0; n < 2; ++n) _Pragma("unroll") for (int k = 0; k < 2; ++k) \
        acc[ai][bj][m][n] = __builtin_amdgcn_mfma_f32_16x16x32_bf16(Bt[n][k], At[m][k], acc[ai][bj][m][n], 0, 0, 0); __builtin_amdgcn_s_setprio(0); } while (0)
#define PG8_WAIT_V(n) asm volatile("s_waitcnt vmcnt(" #n ")" ::: "memory")
#define PG8_WAIT_L(n) asm volatile("s_waitcnt lgkmcnt(" #n ")" ::: "memory")
#define PG8_BAR __builtin_amdgcn_s_barrier()
#define PG8_SCHED __builtin_amdgcn_sched_barrier(0)
#define PG8_ABASE(u) ((const char*)g.A + ((size_t)(u).seg * g.a_seg + (size_t)(u).pm * BM * g.lda) * 2)
#define PG8_BBASE(u) ((const char*)g.Bt + ((size_t)(u).seg * g.b_seg + (size_t)(u).pn * BM * g.ldb) * 2)
    Unit cur, nxt; int ui = 0;
    if (!S.next(0, cur)) return;
    f32x4 acc[2][2][4][2];
#pragma unroll
    for (int a = 0; a < 2; ++a)
#pragma unroll
        for (int b = 0; b < 2; ++b)
#pragma unroll
            for (int m = 0; m < 4; ++m)
#pragma unroll
                for (int n = 0; n < 2; ++n) acc[a][b][m][n] = (f32x4){0.f, 0.f, 0.f, 0.f};
    bf16x8 At[4][2], B0[2][2], B1[2][2];
    const char* cA = PG8_ABASE(cur); const char* cB = PG8_BBASE(cur);
    PG8_STAGE(PG8_SB(0, 0), cB, voffB); PG8_STAGE(PG8_SB(0, 1), cB + hstepB, voffB); PG8_STAGE(PG8_SA(0, 0), cA, voffA); PG8_STAGE(PG8_SA(0, 1), cA + hstepA, voffA);
    if (wr == 1) PG8_BAR;
    PG8_WAIT_V(2); PG8_BAR;
    PG8_STAGE(PG8_SB(1, 0), cB + kstep, voffB); PG8_STAGE(PG8_SA(1, 0), cA + kstep, voffA); PG8_STAGE(PG8_SB(1, 1), cB + hstepB + kstep, voffB);
    PG8_WAIT_V(6); PG8_BAR;
    for (;;) {
        const bool has_next = S.next(ui + 1, nxt);
        const char* nA = has_next ? PG8_ABASE(nxt) : cA; const char* nB = has_next ? PG8_BBASE(nxt) : cB;
        for (int t = 0; t < nt; t += 2) {
            const bool lastk = (t == nt - 2);
            const char* a1 = cA + (size_t)(t + 1) * kstep;
            const char* a2 = lastk ? nA : cA + (size_t)(t + 2) * kstep; const char* b2 = lastk ? nB : cB + (size_t)(t + 2) * kstep;
            const char* a3 = a2 + kstep; const char* b3 = b2 + kstep;
            PG8_LDB(B0, 0, 0); PG8_LDB(B1, 0, 1); PG8_SCHED; PG8_LDA(At, 0, 0); PG8_STAGE(PG8_SA(1, 1), a1 + hstepA, voffA);
            PG8_WAIT_V(8); PG8_WAIT_L(0); PG8_BAR; PG8_MMA(0, 0, At, B0); PG8_MMA(0, 1, At, B1); PG8_BAR; PG8_SCHED;
            PG8_LDA(At, 0, 1); PG8_STAGE(PG8_SB(0, 0), b2, voffB); PG8_STAGE(PG8_SB(0, 1), b2 + hstepB, voffB); PG8_STAGE(PG8_SA(0, 0), a2, voffA);
            PG8_WAIT_V(8); PG8_WAIT_L(0); PG8_BAR; PG8_MMA(1, 0, At, B0); PG8_MMA(1, 1, At, B1); PG8_BAR; PG8_SCHED;
            PG8_LDB(B0, 1, 0); PG8_LDB(B1, 1, 1); PG8_SCHED; PG8_LDA(At, 1, 0); PG8_STAGE(PG8_SA(0, 1), a2 + hstepA, voffA);
            PG8_WAIT_V(8); PG8_WAIT_L(0); PG8_BAR; PG8_MMA(0, 0, At, B0); PG8_MMA(0, 1, At, B1); PG8_BAR; PG8_SCHED;
            PG8_LDA(At, 1, 1); PG8_STAGE(PG8_SB(1, 0), b3, voffB); PG8_STAGE(PG8_SB(1, 1), b3 + hstepB, voffB); PG8_STAGE(PG8_SA(1, 0), a3, voffA);
            PG8_WAIT_V(8); PG8_WAIT_L(0); PG8_BAR; PG8_MMA(1, 0, At, B0); PG8_MMA(1, 1, At, B1); PG8_BAR; PG8_SCHED;
        }
        if (wr == 0) PG8_BAR;
        E(acc, cur, wr, wc, fr, fq);
        if (!has_next) break;
#pragma unroll
        for (int a = 0; a < 2; ++a)
#pragma unroll
            for (int b = 0; b < 2; ++b)
#pragma unroll
                for (int m = 0; m < 4; ++m)
#pragma unroll
                    for (int n = 0; n < 2; ++n) acc[a][b][m][n] = (f32x4){0.f, 0.f, 0.f, 0.f};
        cur = nxt; cA = nA; cB = nB; ++ui;
        if (wr == 1) PG8_BAR;
    }
    PG8_WAIT_V(0);
    PG8_BAR;
#undef PG8_SA
#undef PG8_SB
#undef PG8_STAGE
#undef PG8_LDA
#undef PG8_LDB
#undef PG8_MMA
#undef PG8_WAIT_V
#undef PG8_WAIT_L
#undef PG8_BAR
#undef PG8_SCHED
#undef PG8_ABASE
#undef PG8_BBASE
}
}

__device__ __forceinline__ v4u pack8(const f32x4& a, const f32x4& b) { v4u w; w.x = cvtpk(a.x, a.y); w.y = cvtpk(a.z, a.w); w.z = cvtpk(b.x, b.y); w.w = cvtpk(b.z, b.w); return w; }
struct EpiInProj {
    bf16 *AQ, *AK, *AVT, *BQ, *BK, *BVT, *CQ, *CK, *CV, *SG; const float *COS, *SIN;
    __device__ __forceinline__ void operator()(const f32x4 (&acc)[2][2][4][2], const pg8::Unit& u, int wr, int wc, int fr, int fq) const {
        asm volatile("" : "+v"(fr), "+v"(fq));
#pragma unroll
        for (int bj = 0; bj < 2; ++bj) {
            const int cblk = u.pn * 256 + bj * 128;
            const int cw = wc * 32 + 8 * fq;
            bf16* dst; int pitch, cbase; int kind;
            int nh = 1, hd = 0;
            if (cblk < 512)       { dst = AQ; pitch = 512; cbase = cblk; kind = 1; }
            else if (cblk < 640)  { dst = AK; pitch = 128; cbase = cblk - 512; kind = 1; }
            else if (cblk < 768)  { dst = AVT; pitch = 128; cbase = cblk - 640; kind = 0; }
            else if (cblk < 1280) { dst = BQ; pitch = 512; cbase = cblk - 768; kind = 0; }
            else if (cblk < 1792) { dst = BK; pitch = 512; cbase = cblk - 1280; kind = 0; }
            else if (cblk < 2304) { dst = BVT; pitch = 512; cbase = cblk - 1792; kind = 0; }
            else if (cblk < 2816) { dst = CQ; pitch = 512; cbase = cblk - 2304; kind = 1; }
            else if (cblk < 3328) { dst = CK; pitch = 512; cbase = cblk - 2816; kind = 1; }
            else if (cblk < 3840) { dst = CV; pitch = 512; cbase = cblk - 3328; kind = 0; }
            else                  { dst = SG; pitch = 3072; cbase = cblk - 3840; kind = 3; }
#pragma unroll
            for (int ai = 0; ai < 2; ++ai)
#pragma unroll
                for (int m = 0; m < 4; ++m) {
                    const int row = u.pm * 256 + ai * 128 + wr * 64 + m * 16 + fr;
                    f32x4 v0 = acc[ai][bj][m][0], v1 = acc[ai][bj][m][1];
                    if (kind == 1) {
                        if (row < T_LAT) {
                            const int t = row & (SEQ - 1), i0 = (cw & 63) >> 1;
                            const f32x4 cs = *(const GAS f32x4*)(COS + t * 32 + i0), sn = *(const GAS f32x4*)(SIN + t * 32 + i0);
                            const f32x4 a = v0, b = v1;
                            v0.x = a.x * cs.x - a.y * sn.x; v0.y = a.y * cs.x + a.x * sn.x; v0.z = a.z * cs.y - a.w * sn.y; v0.w = a.w * cs.y + a.z * sn.y;
                            v1.x = b.x * cs.z - b.y * sn.z; v1.y = b.y * cs.z + b.x * sn.z; v1.z = b.z * cs.w - b.w * sn.w; v1.w = b.w * cs.w + b.z * sn.w;
                        }
                        *(GAS v4u*)(dst + (size_t)row * pitch + cbase + cw) = pack8(v0, v1);
                    } else if (kind == 0) {
                        *(GAS v4u*)(dst + (size_t)row * pitch + cbase + cw) = pack8(v0, v1);
                    } else if (kind == 3) {
                        v0.x = sigmoidf_(v0.x); v0.y = sigmoidf_(v0.y); v0.z = sigmoidf_(v0.z); v0.w = sigmoidf_(v0.w);
                        v1.x = sigmoidf_(v1.x); v1.y = sigmoidf_(v1.y); v1.z = sigmoidf_(v1.z); v1.w = sigmoidf_(v1.w);
                        *(GAS v4u*)(dst + (size_t)row * pitch + cbase + cw) = pack8(v0, v1);
                    } else {
                        const int hc = hd + cw, head = hc >> 6, d = hc & 63;
                        const int b = row_batch(row), tok = row_tok(row);
                        bf16* vp = dst + ((size_t)(b * nh + head) * 64 + d) * NTOK + tok;
                        vp[0 * NTOK] = (bf16)f2bf(v0.x); vp[1 * NTOK] = (bf16)f2bf(v0.y); vp[2 * NTOK] = (bf16)f2bf(v0.z); vp[3 * NTOK] = (bf16)f2bf(v0.w);
                        vp[4 * NTOK] = (bf16)f2bf(v1.x); vp[5 * NTOK] = (bf16)f2bf(v1.y); vp[6 * NTOK] = (bf16)f2bf(v1.z); vp[7 * NTOK] = (bf16)f2bf(v1.w);
                    }
                }
        }
    }
};
__device__ __forceinline__ void unpack8(const v4u& w, f32x4& a, f32x4& b) {
    a = (f32x4){bf2f(w.x & 0xffffu), bf2f(w.x >> 16), bf2f(w.y & 0xffffu), bf2f(w.y >> 16)}; b = (f32x4){bf2f(w.z & 0xffffu), bf2f(w.z >> 16), bf2f(w.w & 0xffffu), bf2f(w.w >> 16)};
}
struct EpiBranch {
    const bf16* SG; bf16* MG;
    __device__ __forceinline__ void operator()(const f32x4 (&acc)[2][2][4][2], const pg8::Unit& u, int wr, int wc, int fr, int fq) const {
        asm volatile("" : "+v"(fr), "+v"(fq));
#pragma unroll
        for (int ai = 0; ai < 2; ++ai)
#pragma unroll
            for (int m = 0; m < 4; ++m) {
                const int row = u.pm * 256 + ai * 128 + wr * 64 + m * 16 + fr;
#pragma unroll
                for (int bj = 0; bj < 2; ++bj) {
                    const int col = u.pn * 256 + bj * 128 + wc * 32 + 8 * fq;
                    f32x4 g0, g1; { const v4u wg = *(const GAS v4u*)(SG + (size_t)row * 3072 + u.seg * 1024 + col); unpack8(wg, g0, g1); }
                    f32x4 v0 = g0 * acc[ai][bj][m][0], v1 = g1 * acc[ai][bj][m][1];
                    bf16* mp = MG + (size_t)row * D + col;
                    if (u.seg > 0) { f32x4 p0, p1; const v4u wp = *(const GAS v4u*)mp; unpack8(wp, p0, p1); v0 += p0; v1 += p1; }
                    *(GAS v4u*)mp = pack8(v0, v1);
                }
            }
    }
};
struct EpiOut {
    float* X; const float* gtl; const float* xin; const float* cin;
    __device__ __forceinline__ void operator()(const f32x4 (&acc)[2][2][4][2], const pg8::Unit& u, int wr, int wc, int fr, int fq) const {
        asm volatile("" : "+v"(fr), "+v"(fq));
#pragma unroll
        for (int ai = 0; ai < 2; ++ai)
#pragma unroll
            for (int m = 0; m < 4; ++m) {
                const int row = u.pm * 256 + ai * 128 + wr * 64 + m * 16 + fr;
                const float* gt = gtl + (size_t)row_modidx(row) * 6 * D + 2 * D;
#pragma unroll
                for (int bj = 0; bj < 2; ++bj) {
                    const int col = u.pn * 256 + bj * 128 + wc * 32 + 8 * fq;
                    GAS f32x4* xp = (GAS f32x4*)(X + (size_t)row * D + col);
                    const GAS f32x4* sp = xin ? (const GAS f32x4*)(xin_row(xin, cin, row) + col) : (const GAS f32x4*)xp;
                    const f32x4 g0 = *(const GAS f32x4*)(gt + col), g1 = *(const GAS f32x4*)(gt + col + 4);
                    xp[0] = sp[0] + g0 * acc[ai][bj][m][0]; xp[1] = sp[1] + g1 * acc[ai][bj][m][1];
                }
            }
    }
};
struct EpiStore {
    bf16* O; int ldc;
    __device__ __forceinline__ void operator()(const f32x4 (&acc)[2][2][4][2], const pg8::Unit& u, int wr, int wc, int fr, int fq) const {
        asm volatile("" : "+v"(fr), "+v"(fq));
#pragma unroll
        for (int ai = 0; ai < 2; ++ai)
#pragma unroll
            for (int m = 0; m < 4; ++m) {
                const int row = u.pm * 256 + ai * 128 + wr * 64 + m * 16 + fr;
#pragma unroll
                for (int bj = 0; bj < 2; ++bj) {
                    const int col = u.pn * 256 + bj * 128 + wc * 32 + 8 * fq;
                    *(GAS v4u*)(O + (size_t)row * ldc + col) = pack8(acc[ai][bj][m][0], acc[ai][bj][m][1]);
                }
            }
    }
};

__global__ void __launch_bounds__(NTHREADS, 2) mega_fwd(Args args) {
    extern __shared__ __attribute__((aligned(16))) unsigned char lds[];
    LAS unsigned char* L = (LAS unsigned char*)lds;
    volatile LAS unsigned* MISC = (volatile LAS unsigned*)(L + MISC_OFF);
    const int wave = __builtin_amdgcn_readfirstlane((int)threadIdx.x >> 6);
    const int lane = lane_id_v(), tid = wave * 64 + lane;
    const int fr = lane & 15, fq = lane >> 4;
    const int G = gridDim.x;
    const int vcu = (G % 8 == 0) ? (int)(blockIdx.x % 8) * (G / 8) + (int)(blockIdx.x / 8) : (int)blockIdx.x;
    for (int u = tid; u < (LDS_BYTES - 131072) / 4; u += NTHREADS) ((LAS unsigned*)(L + 131072))[u] = 0u;
    __syncthreads();
    unsigned char* ws = args.ws;
    gu32* ctl = (gu32*)(ws + WS_CTL);
    (void)xcd_barrier_post((unsigned*)(ctl + CW_BAR), MISC + 8);
#define GRID_BAR() do { unsigned* bp_ = (unsigned*)(ws + WS_CTL) + CW_BAR; asm volatile("" : "+s"(bp_)); XcdBarrier b_; b_.bar = bp_; b_.x = xb_xcc_id(); b_.st = MISC + 8; xcd_barrier(b_, wave == 0 && lane_id_v() == 0); } while (0)
    const int gw = vcu * NWAVES + wave, NGW = G * NWAVES;
    const int NGT = G * NTHREADS;

    float* MODV = (float*)(ws + WS_MOD);
    float* COS = (float*)(ws + WS_COS); float* SIN = (float*)(ws + WS_SIN);
    bf16* WIN = (bf16*)(ws + WS_WIN); bf16* WB = (bf16*)(ws + WS_WB); bf16* WO = (bf16*)(ws + WS_WO); bf16* WQ = (bf16*)(ws + WS_WQ); bf16* KEYS = (bf16*)(ws + WS_KEYS);
    float* X = (float*)(ws + WS_X); bf16* H = (bf16*)(ws + WS_H); bf16* Y = (bf16*)(ws + WS_Y); bf16* MG = (bf16*)(ws + WS_MG);
    unsigned* EI = (unsigned*)(ws + WS_EI); float* EG = (float*)(ws + WS_EG);
    unsigned char* U8 = ws + WS_U8; unsigned char* V8 = ws + WS_V8; float* SCU = (float*)(ws + WS_SCU); float* SCV = SCU + DEPTH * 16384;
    bf16* AQ = (bf16*)(ws + WS_AQ); bf16* AK = (bf16*)(ws + WS_AK); bf16* AVT = (bf16*)(ws + WS_AVT);
    bf16* BQ = (bf16*)(ws + WS_BQ); bf16* BK = (bf16*)(ws + WS_BK); bf16* BVT = (bf16*)(ws + WS_BVT);
    bf16* CQ = (bf16*)(ws + WS_CQ); bf16* CK = (bf16*)(ws + WS_CK); bf16* CVT = (bf16*)(ws + WS_CVT);
    bf16* SG = (bf16*)(ws + WS_SG); bf16* Q2 = (bf16*)(ws + WS_Q2); float* SC = (float*)(ws + WS_SC);

#ifndef SKIP_P0
        for (int rep_ = 0; rep_ < REP_P0; ++rep_) {
    {
        LAS float* scr = (LAS float*)(L + wave * 16384);
        int gt = vcu * NTHREADS + tid; asm volatile("" : "+v"(gt));
        constexpr int I_IN = (D / 64) * (IN_W / 32), I_BR = (512 / 64) * (D / 32), I_O = (D / 64) * (D / 32), I_Q = (D / 64) * (2048 / 32);
        constexpr int PER_LAYER = I_IN + 3 * I_BR + I_O + I_Q;
        for (int it = gw; it < DEPTH * PER_LAYER; it += NGW) {
            const int l = it / PER_LAYER; int r = it % PER_LAYER;
            if (r < I_IN) { p0_transpose_item<true>(args.in[I_WIN] + (size_t)l * D * IN_W, D, IN_W, WIN + (size_t)l * IN_W * D, scr, r, lane); continue; } r -= I_IN;
            if (r < I_BR) { p0_transpose_item(args.in[I_WBA] + (size_t)l * 512 * D, 512, D, WB + (size_t)(l * 3 + 0) * D * 512, scr, r, lane); continue; } r -= I_BR;
            if (r < I_BR) { p0_transpose_item(args.in[I_WBB] + (size_t)l * 512 * D, 512, D, WB + (size_t)(l * 3 + 1) * D * 512, scr, r, lane); continue; } r -= I_BR;
            if (r < I_BR) { p0_transpose_item(args.in[I_WBC] + (size_t)l * 512 * D, 512, D, WB + (size_t)(l * 3 + 2) * D * 512, scr, r, lane); continue; } r -= I_BR;
            if (r < I_O) { p0_transpose_item(args.in[I_WOUT] + (size_t)l * D * D, D, D, WO + (size_t)l * D * D, scr, r, lane); continue; } r -= I_O;
            p0_transpose_item(args.in[I_PWQ] + (size_t)l * D * 2048, D, 2048, WQ + (size_t)l * 2048 * D, scr, r, lane);
        }
        for (int i = gt; i < DEPTH * 16 * 128 * 128 / 4; i += NGT) {
            const f32x4 v = *((const GAS f32x4*)args.in[I_PKEYS] + i);
            v2u o; o.x = pk2(v.x, v.y); o.y = pk2(v.z, v.w); *((GAS v2u*)KEYS + i) = o;
        }
        {
            LAS float* red = (LAS float*)(L + 9216);
            for (int it = vcu; it < DEPTH * 96; it += G) {
                const int l = it / 96, nc = it % 96, n = nc * 64 + lane;
                const float* wm = args.in[I_WMOD] + (size_t)l * D * 6 * D + n;
                float a0 = 0.f, a1 = 0.f, a2 = 0.f;
#pragma unroll 8
                for (int k = wave * 128; k < wave * 128 + 128; ++k) {
                    const float c0 = args.in[I_C][k], c1 = args.in[I_C][D + k], c2 = args.in[I_CCTX][k];
                    const float w = wm[(size_t)k * 6 * D];
                    a0 += c0 * sigmoidf_(c0) * w; a1 += c1 * sigmoidf_(c1) * w; a2 += c2 * sigmoidf_(c2) * w;
                }
                red[(wave * 3 + 0) * 64 + lane] = a0; red[(wave * 3 + 1) * 64 + lane] = a1; red[(wave * 3 + 2) * 64 + lane] = a2;
                __syncthreads();
                if (wave < 3) {
                    float sum = args.in[I_BMOD][l * 6 * D + n];
#pragma unroll
                    for (int w = 0; w < 8; ++w) sum += red[(w * 3 + wave) * 64 + lane];
                    MODV[(size_t)(l * 3 + wave) * 6 * D + n] = sum;
                }
                __syncthreads();
            }
        }
        for (int i = gt; i < SEQ * 32; i += NGT) {
            const int t = i >> 5, f = i & 31;
            const double inv = pow(10000.0, -(double)(f & 15) / 16.0);
            const double pos = (f < 16) ? (double)(t / GRID_W) : (double)(t % GRID_W);
            const double ang = pos * inv;
            COS[i] = (float)cos(ang); SIN[i] = (float)sin(ang);
        }
    }
#pragma unroll 4
        for (int rr = gw; rr < 2 * DEPTH * 16384; rr += NGW) {
            const int tab = rr / (DEPTH * 16384), row = rr % (DEPTH * 16384);
            const float* src = (tab == 0 ? args.in[I_PU] : args.in[I_PV]) + (size_t)row * D;
            f32x4 v[4]; float am = 0.f;
#pragma unroll
            for (int j = 0; j < 4; ++j) { v[j] = *((const GAS f32x4*)src + lane + 64 * j); am = fmaxf(am, fmaxf(fmaxf(fabsf(v[j].x), fabsf(v[j].y)), fmaxf(fabsf(v[j].z), fabsf(v[j].w)))); }
#pragma unroll
            for (int o = 1; o < 64; o <<= 1) am = fmaxf(am, __shfl_xor(am, o));
            int ex = 0; float scale = 1.0f;
            if (am > 0.f) { (void)frexpf(am * (1.0f / 448.0f), &ex); scale = ldexpf(1.0f, ex); }
            const float inv = 1.0f / scale;
            v4u o;
#pragma unroll
            for (int j = 0; j < 4; ++j) {
                int p = __builtin_amdgcn_cvt_pk_fp8_f32(v[j].x * inv, v[j].y * inv, 0, false);
                p = __builtin_amdgcn_cvt_pk_fp8_f32(v[j].z * inv, v[j].w * inv, p, true);
                o[j] = (unsigned)p;
            }
            *((GAS v4u*)((tab == 0 ? U8 : V8) + (size_t)row * D) + lane) = o;
            if (lane == 0) (tab == 0 ? SCU : SCV)[row] = scale;
        }
        }
#endif
    GRID_BAR();

    for (int layer = 0; layer < DEPTH; ++layer) {
        const bool last = (layer == DEPTH - 1);
        const int T_EFF = last ? T_LAT : T_ALL;
        const float* modl = MODV + (size_t)layer * 3 * 6 * D;
        const bf16* WINl = WIN + (size_t)layer * IN_W * D;

#ifndef SKIP_P1
        for (int rep_ = 0; rep_ < REP_P1; ++rep_) {
        { const int ln = lane_id_v();
        if (layer == 0)
        for (int r = gw; r < T_ALL; r += NGW) {
            const float* md = modl + (size_t)row_modidx(r) * 6 * D;
            const GAS f32x4* xr = (const GAS f32x4*)xin_row(args.in[I_X], args.in[I_CTX], r) + ln;
            f32x4 v[4]; float ss = 0.f;
#pragma unroll
            for (int j = 0; j < 4; ++j) { v[j] = xr[64 * j]; ss += (v[j].x * v[j].x + v[j].y * v[j].y) + (v[j].z * v[j].z + v[j].w * v[j].w); }
            const float rs = 1.0f / sqrtf(wave_sum(ss) * (1.f / D) + NORM_EPS);
            GAS v2u* o8 = (GAS v2u*)(H + (size_t)r * D) + ln;
#pragma unroll
            for (int j = 0; j < 4; ++j) {
                const f32x4 g = *((const GAS f32x4*)(args.in[I_G1] + layer * D) + ln + 64 * j);
                const f32x4 sh = *((const GAS f32x4*)(md + 0) + ln + 64 * j), sc = *((const GAS f32x4*)(md + D) + ln + 64 * j);
                const f32x4 h = v[j] * rs * g * (sc + 1.0f) + sh;
                v2u o; o.x = pk2(h.x, h.y); o.y = pk2(h.z, h.w); o8[64 * j] = o;
            }
        }
        }
        }
#endif
        if (layer == 0) GRID_BAR();

#ifndef SKIP_P2
        for (int rep_ = 0; rep_ < REP_P2; ++rep_) {
        {
            pg8::Gemm g{H, WINl, D, D, D, 0, 0};
            pg8::SegOrder<1> S; S.T.init(T_ALL, IN_W, G, (int)blockIdx.x);
            EpiInProj E{AQ, AK, AVT, BQ, BK, BVT, CQ, CK, CVT, SG, COS, SIN};
            pg8::gemm_phase(L, g, S, E, wave);
        }
        }
#endif
        GRID_BAR();

#ifndef SKIP_P3
        {
            LAS bf16* Pl = (LAS bf16*)(L + wave * 8192);
            const float lam_init = 0.8f - 0.6f * expf(-0.3f * (float)layer);
            float lam;
            {
                const int ll = lane_id_v();
                const float* cl = args.in[I_LAMBDA] + layer * 256;
                const float s1 = wave_sum(cl[ll] * cl[64 + ll]), s2 = wave_sum(cl[128 + ll] * cl[192 + ll]);
                lam = expf(s1) - expf(s2) + lam_init;
            }
{ const int lo__ = lane_id_v(); { const int lane = lo__; const int fr = lane & 15, fq = lane >> 4, tid = wave * 64 + lane; (void)fr; (void)fq; (void)tid;
            {
                const int r32 = lane & 31, hi = lane >> 5;
                const int n_lat = BATCH * 4 * (SEQ / 256), n_ctx = last ? 0 : BATCH * 4;
                const int NU = (n_lat + G - 1) / G * G + n_ctx;
                for (int rep_ = 0; rep_ < REP_P3C; ++rep_)
                for (int u0 = vcu; u0 < NU; u0 += G) {
                    int b, h, row0, t_lo, t_hi;
                    if (u0 < n_lat) { const int bh = u0 >> 5; b = bh >> 2; h = bh & 3; row0 = b * SEQ + (u0 & 31) * 256; t_lo = 0; t_hi = 132; }
                    else { const int c = u0 - (n_lat + G - 1) / G * G; if (c < 0 || c >= n_ctx) continue; b = c >> 2; h = c & 3; row0 = T_LAT + b * CTX; t_lo = 128; t_hi = 132; }
                    const int qrow = row0 + wave * 32 + r32;
                    LAS unsigned* o1p = (LAS unsigned*)(L + 65536 + wave * 8192) + lane;
                    const int krow_s = tid >> 3, kch_s = tid & 7;
                    const int vrow_s0 = tid >> 4, vch_s = tid & 15;
                    LAS unsigned char* Kb0 = L; LAS unsigned char* Vb0 = L + 2 * CK_SZ;
#pragma unroll 1
                    for (int m = 0; m < 2; ++m) {
                        bf16x8 qf[4];
                        { const bf16* qp = CQ + (size_t)qrow * 512 + (h * 2 + m) * 64 + hi * 8;
#pragma unroll
                          for (int ks = 0; ks < 4; ++ks) qf[ks] = *(const GAS bf16x8*)(qp + ks * 16); }
                        f32x16 o[4];
#pragma unroll
                        for (int d = 0; d < 4; ++d)
#pragma unroll
                            for (int r = 0; r < 16; ++r) o[d][r] = 0.f;
                        float mrun = -1e30f, lpart = 0.f;
                        const bf16* kg = CK + (size_t)krow_s * 512 + (h * 2 + m) * 64 + kch_s * 8;
                        const bf16* vg = CVT + (size_t)vrow_s0 * 512 + h * 128 + vch_s * 8;
                        auto tile_row = [&](int j) { return (j < 128) ? b * SEQ + 64 * j : T_LAT + b * CTX + 64 * (j - 128); };
                        __syncthreads();
                        {
                            const size_t kb = (size_t)tile_row(t_lo) * 512;
                            const v4u kr = *(const GAS v4u*)(kg + kb), v0 = *(const GAS v4u*)(vg + kb), v1 = *(const GAS v4u*)(vg + kb + 32 * 512);
                            *(LAS v4u*)(Kb0 + krow_s * CK_PITCH + kch_s * 16) = kr;
                            *(LAS v4u*)(Vb0 + vrow_s0 * CV_PITCH + vch_s * 16) = v0; *(LAS v4u*)(Vb0 + (vrow_s0 + 32) * CV_PITCH + vch_s * 16) = v1;
                        }
                        __syncthreads();
#pragma unroll 1
                        for (int j = t_lo; j < t_hi; ++j) {
                            const int cur = (j - t_lo) & 1;
                            const LAS unsigned char* Kb = Kb0 + cur * CK_SZ; const LAS unsigned char* Vb = Vb0 + cur * CV_SZ;
                            v4u kr, v0, v1;
                            const bool more = (j + 1 < t_hi);
                            if (more) { const size_t kb = (size_t)tile_row(j + 1) * 512; kr = *(const GAS v4u*)(kg + kb); v0 = *(const GAS v4u*)(vg + kb); v1 = *(const GAS v4u*)(vg + kb + 32 * 512); }
                            f32x16 st[2];
#pragma unroll
                            for (int kb = 0; kb < 2; ++kb) {
#pragma unroll
                                for (int r = 0; r < 16; ++r) st[kb][r] = 0.f;
#pragma unroll
                                for (int ks = 0; ks < 4; ++ks) {
                                    const bf16x8 kf = *(const LAS bf16x8*)(Kb + (kb * 32 + r32) * CK_PITCH + ks * 32 + hi * 16);
                                    st[kb] = __builtin_amdgcn_mfma_f32_32x32x16_bf16(kf, qf[ks], st[kb], 0, 0, 0);
                                }
                            }
                            float mx = st[0][0];
#pragma unroll
                            for (int r = 1; r < 16; ++r) mx = fmaxf(mx, st[0][r]);
#pragma unroll
                            for (int r = 0; r < 16; ++r) mx = fmaxf(mx, st[1][r]);
                            mx = fmaxf(mx, __shfl_xor(mx, 32));
                            if (__builtin_amdgcn_ballot_w64(mx > mrun + C_THR_RAW) != 0ull) {
                                const float mn = fmaxf(mrun, mx);
                                const float alpha = __builtin_amdgcn_exp2f((mrun - mn) * SCL2);
#pragma unroll
                                for (int d = 0; d < 4; ++d)
#pragma unroll
                                    for (int r = 0; r < 16; ++r) o[d][r] *= alpha;
                                lpart *= alpha; mrun = mn;
                            }
                            const float nmc = -mrun * SCL2;
                            float ls = 0.f;
#pragma unroll
                            for (int kb = 0; kb < 2; ++kb)
#pragma unroll
                                for (int r = 0; r < 16; ++r) { const float p = __builtin_amdgcn_exp2f(fmaf(st[kb][r], SCL2, nmc)); st[kb][r] = p; ls += p; }
                            lpart += ls;
                            {
                                const int q4 = (lane & 15) >> 2, p4 = lane & 3, grp = (lane >> 4) & 1;
                                const LAS unsigned char* vbase = Vb + (4 * hi + q4) * CV_PITCH + (16 * grp + 4 * p4) * 2;
#pragma unroll
                                for (int kb = 0; kb < 2; ++kb)
#pragma unroll
                                    for (int ss = 0; ss < 2; ++ss) {
                                        v4u pw;
#pragma unroll
                                        for (int i2 = 0; i2 < 4; ++i2) pw[i2] = cvtpk(st[kb][8 * ss + 2 * i2], st[kb][8 * ss + 2 * i2 + 1]);
                                        const bf16x8 pb = __builtin_bit_cast(bf16x8, pw);
#pragma unroll
                                        for (int d = 0; d < 4; ++d) {
                                            const LAS unsigned char* va = vbase + (kb * 32 + 16 * ss) * CV_PITCH + d * 64;
                                            const s16x4 lo = __builtin_bit_cast(s16x4, __builtin_amdgcn_ds_read_tr16_b64_v4i16((LAS s16x4*)va));
                                            const s16x4 hh = __builtin_bit_cast(s16x4, __builtin_amdgcn_ds_read_tr16_b64_v4i16((LAS s16x4*)(va + 8 * CV_PITCH)));
                                            const bf16x8 vf = __builtin_shufflevector(lo, hh, 0, 1, 2, 3, 4, 5, 6, 7);
                                            o[d] = __builtin_amdgcn_mfma_f32_32x32x16_bf16(vf, pb, o[d], 0, 0, 0);
                                        }
                                        if (ss == 1) __builtin_amdgcn_sched_barrier(0);
                                    }
                            }
                            if (more) {
                                LAS unsigned char* Kn = Kb0 + (cur ^ 1) * CK_SZ; LAS unsigned char* Vn = Vb0 + (cur ^ 1) * CV_SZ;
                                *(LAS v4u*)(Kn + krow_s * CK_PITCH + kch_s * 16) = kr;
                                *(LAS v4u*)(Vn + vrow_s0 * CV_PITCH + vch_s * 16) = v0; *(LAS v4u*)(Vn + (vrow_s0 + 32) * CV_PITCH + vch_s * 16) = v1;
                            }
                            __syncthreads();
                        }
                        const float lt = lpart + __shfl_xor(lpart, 32);
                        if (m == 0) {
                            const float inv = 1.0f / lt;
#pragma unroll
                            for (int d = 0; d < 4; ++d)
#pragma unroll
                                for (int i2 = 0; i2 < 8; ++i2) o1p[64 * (d * 8 + i2)] = cvtpk(o[d][2 * i2] * inv, o[d][2 * i2 + 1] * inv);
                        } else {
                            const float inv2 = lam / lt;
                            float ssq = 0.f;
#pragma unroll
                            for (int d = 0; d < 4; ++d)
#pragma unroll
                                for (int i2 = 0; i2 < 8; ++i2) {
                                    const unsigned w1 = o1p[64 * (d * 8 + i2)];
                                    const float a0 = bf2f(w1 & 0xffffu) - o[d][2 * i2] * inv2, a1 = bf2f(w1 >> 16) - o[d][2 * i2 + 1] * inv2;
                                    o[d][2 * i2] = a0; o[d][2 * i2 + 1] = a1; ssq += a0 * a0 + a1 * a1;
                                }
                            ssq += __shfl_xor(ssq, 32);
                            const float rn = 1.0f / sqrtf(ssq * (1.f / 128.f) + NORM_EPS) * (1.0f - lam_init);
                            bf16* yp = Y + (size_t)qrow * 1536 + 1024 + h * 128 + 4 * hi;
                            const float* sl = args.in[I_SUBLN] + layer * 512 + h * 128 + 4 * hi;
#pragma unroll
                            for (int d = 0; d < 4; ++d)
#pragma unroll
                                for (int g4 = 0; g4 < 4; ++g4) {
                                    const f32x4 gsl = *(const GAS f32x4*)(sl + d * 32 + 8 * g4);
                                    v2u w; w.x = cvtpk(o[d][4 * g4] * rn * gsl.x, o[d][4 * g4 + 1] * rn * gsl.y); w.y = cvtpk(o[d][4 * g4 + 2] * rn * gsl.z, o[d][4 * g4 + 3] * rn * gsl.w);
                                    *(GAS v2u*)(yp + d * 32 + 8 * g4) = w;
                                }
                        }
                    }
                }
                __syncthreads();
            }
} }
{ const int lo__ = lane_id_v(); { const int lane = lo__; const int tid = wave * 64 + lane, r32 = lane & 31, hi = lane >> 5;
            {
                const int n_lat = BATCH * 2 * (SEQ / 64), n_ctx = last ? 0 : BATCH * 2 * (CTX / 64);
                for (int rep_ = 0; rep_ < REP_P3A; ++rep_)
                for (int u0 = vcu; u0 < n_lat + n_ctx; u0 += G) {
                    const bool isctx = u0 >= n_lat;
                    int b, g, p0, qrow, nl, klo;
                    if (!isctx) { b = u0 >> 8; g = (u0 >> 7) & 1; p0 = (u0 & 127) * 64; qrow = b * SEQ + p0 + (wave & 1) * 32 + r32;
                                  klo = p0 >= 128 ? 0 : (128 - p0) / 64; const int khi = min(4, (SEQ - 1 - (p0 - 128)) / 64); nl = khi - klo + 1; }
                    else { const int c = u0 - n_lat; b = c >> 3; g = (c >> 2) & 1; p0 = (c & 3) * 64; qrow = T_LAT + b * CTX + p0 + (wave & 1) * 32 + r32; nl = 0; klo = 0; }
                    const int hq = g * 4 + (wave >> 1);
                    const int qpos0 = p0 + (wave & 1) * 32;
                    bf16x8 qf[4];
                    { const bf16* qp = AQ + (size_t)qrow * 512 + hq * 64 + hi * 8;
#pragma unroll
                      for (int ks = 0; ks < 4; ++ks) qf[ks] = *(const GAS bf16x8*)(qp + ks * 16); }
                    f32x16 o[2];
#pragma unroll
                    for (int d = 0; d < 2; ++d)
#pragma unroll
                        for (int r = 0; r < 16; ++r) o[d][r] = 0.f;
                    float mrun = args.in[I_SINK][layer * 8 + hq] * 8.0f;
                    float lpart = (hi == 0) ? 1.0f : 0.0f;
                    const bf16* kg = AK + (size_t)(tid >> 3) * 128 + g * 64 + (tid & 7) * 8;
                    const bf16* vg = AVT + (size_t)(tid >> 3) * 128 + g * 64 + (tid & 7) * 8;
                    const int kp0 = p0 - 128 + 64 * klo;
                    auto tile_row = [&](int j) { return (j < nl) ? b * SEQ + kp0 + 64 * j : T_LAT + b * CTX + 64 * (j - nl); };
                    auto use_tile = [&](int j) { if (j >= nl) return true; const int kp = kp0 + 64 * j; return (kp + 63 >= qpos0 - 128) && (kp <= qpos0 + 31 + 128); };
                    auto elem = [&](f32x16 (&st)[2], int j) {
                        if (j < nl) {
                            const int dq0 = (qpos0 + r32) - (kp0 + 64 * j + 4 * hi);
#pragma unroll
                            for (int kb = 0; kb < 2; ++kb)
#pragma unroll
                                for (int r = 0; r < 16; ++r) { const int dq = dq0 - (kb * 32 + (r & 3) + 8 * (r >> 2)); if (dq > 128 || dq < -128) st[kb][r] = -1e30f; }
                        }
                    };
                    attn64_pass<2>(o, mrun, lpart, qf, kg, 128, vg, 128, nl + 4, tile_row, use_tile, elem, L, lane, tid);
                    const float lt = lpart + __shfl_xor(lpart, 32);
                    attn64_store(o, 1.0f / lt, Y + (size_t)qrow * 1536 + hq * 64, hi);
                }
            }
} }
{ const int lo__ = lane_id_v(); { const int lane = lo__; const int tid = wave * 64 + lane, r32 = lane & 31, hi = lane >> 5;
            {
                const int n_lat = BATCH * 8 * 32, n_ctx = last ? 0 : BATCH * 8;
                LAS float* rpbL = (LAS float*)(L + 49152);
                for (int rep_ = 0; rep_ < REP_P3B; ++rep_)
                for (int u0 = vcu; u0 < n_lat + n_ctx; u0 += G) {
                    const bool isctx = u0 >= n_lat;
                    int b, h, gr = 0, qc0 = 0, qrow, nl, krlo;
                    if (!isctx) { b = u0 >> 8; h = (u0 >> 5) & 7; const int r0 = (u0 & 31) * 4; gr = r0 + (wave >> 1); qc0 = (wave & 1) * 32; qrow = b * SEQ + gr * GRID_W + qc0 + r32;
                                  krlo = min(max(r0 - 4, 0), 120); nl = min(max(r0 - 1, 0), 120) + 8 - krlo; }
                    else { const int c = u0 - n_lat; b = c >> 3; h = c & 7; qrow = T_LAT + b * CTX + wave * 32 + r32; nl = 0; krlo = 0; }
                    __syncthreads();
                    if (tid < 465) rpbL[tid] = args.in[I_RPB][(size_t)(layer * 8 + h) * 465 + tid] * 8.0f;
                    bf16x8 qf[4];
                    { const bf16* qp = BQ + (size_t)qrow * 512 + h * 64 + hi * 8;
#pragma unroll
                      for (int ks = 0; ks < 4; ++ks) qf[ks] = *(const GAS bf16x8*)(qp + ks * 16); }
                    f32x16 o[2];
#pragma unroll
                    for (int d = 0; d < 2; ++d)
#pragma unroll
                        for (int r = 0; r < 16; ++r) o[d][r] = 0.f;
                    float mrun = -1e30f, lpart = 0.f;
                    const bf16* kg = BK + (size_t)(tid >> 3) * 512 + h * 64 + (tid & 7) * 8;
                    const bf16* vg = BVT + (size_t)(tid >> 3) * 512 + h * 64 + (tid & 7) * 8;
                    const int rs = min(max(gr - 4, 0), 120);
                    auto tile_row = [&](int j) { return (j < nl) ? b * SEQ + (krlo + j) * GRID_W : T_LAT + b * CTX + 64 * (j - nl); };
                    auto use_tile = [&](int j) { if (j >= nl) return true; const int kr = krlo + j; return kr >= rs && kr < rs + 8; };
                    auto elem = [&](f32x16 (&st)[2], int j) {
                        if (j < nl) {
                            const int qc = qc0 + r32, cstart = min(max(qc - 8, 0), 48);
                            const LAS float* brow = rpbL + (krlo + j - gr + 7) * 31 + 15;
#pragma unroll
                            for (int kb = 0; kb < 2; ++kb)
#pragma unroll
                                for (int r = 0; r < 16; ++r) {
                                    const int kc = kb * 32 + (r & 3) + 8 * (r >> 2) + 4 * hi;
                                    const bool valid = (kc >= cstart) && (kc < cstart + 16);
                                    const int dc = min(max(kc - qc, -15), 15);
                                    st[kb][r] = valid ? st[kb][r] + brow[dc] : -1e30f;
                                }
                        }
                    };
                    attn64_pass<2>(o, mrun, lpart, qf, kg, 512, vg, 512, nl + 4, tile_row, use_tile, elem, L, lane, tid);
                    const float lt = lpart + __shfl_xor(lpart, 32);
                    attn64_store(o, 1.0f / lt, Y + (size_t)qrow * 1536 + 512 + h * 64, hi);
                }
                __syncthreads();
            }
} }
        }
#endif
        GRID_BAR();

#ifndef SKIP_P4
        for (int rep_ = 0; rep_ < REP_P4; ++rep_) {
        {
            pg8::Gemm g{Y, WB + (size_t)layer * 3 * D * 512, 1536, 512, 512, 512, (size_t)D * 512};
            pg8::SegOrder<3> S; S.T.init(T_LAT, D, G, (int)blockIdx.x);
            EpiBranch E{SG, MG};
            pg8::gemm_phase(L, g, S, E, wave);
        }
        if (!last) { const int lo__ = lane_id_v(); { const int lane = lo__; const int fr = lane & 15, fq = lane >> 4; (void)fr; (void)fq;
            for (int it = gw; it < (T_ALL - T_LAT) / 32 * (D / 32); it += NGW) {
                const int row0 = T_LAT + (it / (D / 32)) * 32, col0 = (it % (D / 32)) * 32;
                f32x4 mg[2][2]; zero_acc22(mg);
#pragma unroll 1
                for (int seg = 0; seg < 3; ++seg) {
                    f32x4 acc[2][2]; zero_acc22(acc);
                    sgemm32<8>(acc, Y + seg * 512, 1536, WB + (size_t)(layer * 3 + seg) * D * 512, 512, 512, row0, col0, lane);
#pragma unroll
                    for (int m = 0; m < 2; ++m)
#pragma unroll
                        for (int r = 0; r < 4; ++r) {
                            const bf16* gp = SG + (size_t)(row0 + 16 * m + 4 * fq + r) * 3072 + seg * 1024 + col0 + fr;
#pragma unroll
                            for (int n = 0; n < 2; ++n) mg[m][n][r] += bf2f(gp[16 * n]) * acc[m][n][r];
                        }
                }
#pragma unroll
                for (int m = 0; m < 2; ++m)
#pragma unroll
                    for (int r = 0; r < 4; ++r) {
                        bf16* rowp = MG + (size_t)(row0 + 16 * m + 4 * fq + r) * D + col0 + fr;
#pragma unroll
                        for (int n = 0; n < 2; ++n) rowp[16 * n] = (bf16)f2bf(mg[m][n][r]);
                    }
            }
} }
        }
#endif
        GRID_BAR();

#ifndef SKIP_P5
        {
            pg8::Gemm g{MG, WO + (size_t)layer * D * D, D, D, D, 0, 0};
            pg8::SegOrder<1> S; S.T.init(T_LAT, D, G, (int)blockIdx.x);
            EpiOut E{X, modl, layer == 0 ? args.in[I_X] : nullptr, args.in[I_CTX]};
            pg8::gemm_phase(L, g, S, E, wave);
        }
        if (!last) { const int lo__ = lane_id_v(); { const int lane = lo__; const int fr = lane & 15, fq = lane >> 4; (void)fr; (void)fq;
            for (int it = gw; it < (T_ALL - T_LAT) / 32 * (D / 32); it += NGW) {
                const int row0 = T_LAT + (it / (D / 32)) * 32, col0 = (it % (D / 32)) * 32;
                f32x4 acc[2][2]; zero_acc22(acc);
                sgemm32<8>(acc, MG, D, WO + (size_t)layer * D * D, D, D, row0, col0, lane);
                const float* gt = modl + (size_t)2 * 6 * D + 2 * D + col0 + fr;
#pragma unroll
                for (int m = 0; m < 2; ++m)
#pragma unroll
                    for (int r = 0; r < 4; ++r) {
                        float* rowp = X + (size_t)(row0 + 16 * m + 4 * fq + r) * D + col0 + fr;
                        const float* srcp = (layer == 0) ? args.in[I_CTX] + (size_t)(row0 - T_LAT + 16 * m + 4 * fq + r) * D + col0 + fr : rowp;
#pragma unroll
                        for (int n = 0; n < 2; ++n) rowp[16 * n] = srcp[16 * n] + gt[16 * n] * acc[m][n][r];
                    }
            }
} }
#endif
        GRID_BAR();

#ifndef SKIP_P6
        for (int rep_ = 0; rep_ < REP_P6; ++rep_) {
        { const int ln = lane_id_v();
        for (int r = gw; r < T_EFF; r += NGW) {
            const float* md = modl + (size_t)row_modidx(r) * 6 * D;
            const GAS f32x4* xr = (const GAS f32x4*)(X + (size_t)r * D) + ln;
            f32x4 v[4]; float ss = 0.f;
#pragma unroll
            for (int j = 0; j < 4; ++j) { v[j] = xr[64 * j]; ss += (v[j].x * v[j].x + v[j].y * v[j].y) + (v[j].z * v[j].z + v[j].w * v[j].w); }
            const float rs = 1.0f / sqrtf(wave_sum(ss) * (1.f / D) + NORM_EPS);
            GAS v2u* o8 = (GAS v2u*)(H + (size_t)r * D) + ln;
#pragma unroll
            for (int j = 0; j < 4; ++j) {
                const f32x4 g = *((const GAS f32x4*)(args.in[I_G2] + layer * D) + ln + 64 * j);
                const f32x4 sh = *((const GAS f32x4*)(md + 3 * D) + ln + 64 * j), sc = *((const GAS f32x4*)(md + 4 * D) + ln + 64 * j);
                const f32x4 h = v[j] * rs * g * (sc + 1.0f) + sh;
                v2u o; o.x = pk2(h.x, h.y); o.y = pk2(h.z, h.w); o8[64 * j] = o;
            }
        }
        }
        }
#endif
        GRID_BAR();

#ifndef SKIP_P7
        for (int rep_ = 0; rep_ < REP_P7; ++rep_) {
        {
            pg8::Gemm g{H, WQ + (size_t)layer * 2048 * D, D, D, D, 0, 0};
            pg8::SegOrder<1> S; S.T.init(T_LAT, 2048, G, (int)blockIdx.x);
            EpiStore E{Q2, 2048};
            pg8::gemm_phase(L, g, S, E, wave);
        }
        if (!last) { const int lo__ = lane_id_v(); { const int lane = lo__; const int fr = lane & 15, fq = lane >> 4; (void)fr; (void)fq;
            for (int it = gw; it < (T_ALL - T_LAT) / 32 * (2048 / 32); it += NGW) {
                const int row0 = T_LAT + (it / (2048 / 32)) * 32, col0 = (it % (2048 / 32)) * 32;
                f32x4 acc[2][2]; zero_acc22(acc);
                sgemm32<8>(acc, H, D, WQ + (size_t)layer * 2048 * D, D, D, row0, col0, lane);
#pragma unroll
                for (int m = 0; m < 2; ++m)
#pragma unroll
                    for (int r = 0; r < 4; ++r) {
                        bf16* rowp = Q2 + (size_t)(row0 + 16 * m + 4 * fq + r) * 2048 + col0 + fr;
#pragma unroll
                        for (int n = 0; n < 2; ++n) rowp[16 * n] = (bf16)f2bf(acc[m][n][r]);
                    }
            }
} }
        }
#endif
        GRID_BAR();

#ifndef SKIP_P8
        for (int rep_ = 0; rep_ < REP_P8; ++rep_) {
{ const int lo__ = lane_id_v(); { const int lane = lo__; const int fr = lane & 15, fq = lane >> 4, tid = wave * 64 + lane; (void)fr; (void)fq; (void)tid;
        {
            const int NMT = T_EFF / 256; constexpr int NNT = 2048 / 128;
            const int wr = wave >> 1, wc = wave & 1;
            for (int it = vcu; it < NMT * NNT; it += G) {
                const int pm = it / NNT, grp = it % NNT;
                const int row0 = pm * 256 + wr * 64, c0 = wc * 64;
                f32x4 acc[4][4]; zero_acc<4>(acc);
                sgemm_tile(acc, Q2 + grp * 128, 2048, KEYS + (size_t)(layer * 16 + grp) * 128 * 128, 128, 128, row0, c0, lane);
#pragma unroll
                for (int m = 0; m < 4; ++m)
#pragma unroll
                    for (int r = 0; r < 4; ++r) {
                        float* rowp = SC + (size_t)(row0 + 16 * m + 4 * fq + r) * 2048 + grp * 128 + c0 + fr;
#pragma unroll
                        for (int n = 0; n < 4; ++n) rowp[16 * n] = acc[m][n][r];
                    }
            }
        }
} }
        }
#endif
        GRID_BAR();

#ifndef SKIP_P9
        for (int rep_ = 0; rep_ < REP_P9; ++rep_) {
{ const int lo__ = lane_id_v(); { const int lane = lo__; const int fr = lane & 15, fq = lane >> 4, tid = wave * 64 + lane; (void)fr; (void)fq; (void)tid;
        for (int it = vcu * NTHREADS + tid; it < T_EFF * PEER_HEADS; it += NGT) {
            const int t = it >> 3, hh = it & 7;
            const float* sc = SC + (size_t)t * 2048 + hh * 256;
            int a0[16], a1[16];
#pragma unroll
            for (int i = 0; i < 16; ++i) { a0[i] = (int)0x80000000; a1[i] = (int)0x80000000; }
            for (int k = 0; k < 128; k += 4) {
                const f32x4 v = *(const GAS f32x4*)(sc + k);
                top16_insert(a0, (f2ord(v.x) & ~127) | (k + 0)); top16_insert(a0, (f2ord(v.y) & ~127) | (k + 1));
                top16_insert(a0, (f2ord(v.z) & ~127) | (k + 2)); top16_insert(a0, (f2ord(v.w) & ~127) | (k + 3));
            }
            for (int k = 0; k < 128; k += 4) {
                const f32x4 v = *(const GAS f32x4*)(sc + 128 + k);
                top16_insert(a1, (f2ord(v.x) & ~127) | (k + 0)); top16_insert(a1, (f2ord(v.y) & ~127) | (k + 1));
                top16_insert(a1, (f2ord(v.z) & ~127) | (k + 2)); top16_insert(a1, (f2ord(v.w) & ~127) | (k + 3));
            }
            int c[16];
#pragma unroll
            for (int i = 0; i < 16; ++i) c[i] = (int)0x80000000;
#pragma unroll
            for (int i = 0; i < 16; ++i) {
                const float vi = ord2f(a0[i] & ~127);
#pragma unroll
                for (int j = 0; j < 16; ++j) {
                    if ((i + 1) * (j + 1) <= 16) {
                        const float sj = vi + ord2f(a1[j] & ~127);
                        top16_insert(c, (f2ord(sj) & ~255) | (i * 16 + j));
                    }
                }
            }
            const float smax = ord2f(c[0] & ~255);
            float pe[16]; float psum = 0.f;
#pragma unroll
            for (int k = 0; k < 16; ++k) { pe[k] = __expf(ord2f(c[k] & ~255) - smax); psum += pe[k]; }
            const float ip = 1.0f / psum;
#pragma unroll
            for (int k = 0; k < 16; ++k) {
                const int ij = c[k] & 255, ii = ij >> 4, jj = ij & 15;
                int e0 = 0, e1 = 0;
#pragma unroll
                for (int q = 0; q < 16; ++q) { e0 = (ii == q) ? (a0[q] & 127) : e0; e1 = (jj == q) ? (a1[q] & 127) : e1; }
                const int e = e0 * PEER_KEYS + e1;
                const float su = SCU[layer * 16384 + e], sv = SCV[layer * 16384 + e];
                EI[(size_t)t * NSEL + hh * 16 + k] = (unsigned)e | (f2bf(su) << 16);
                EG[(size_t)t * NSEL + hh * 16 + k] = pe[k] * ip * sv;
            }
        }
} }
        }
#endif
        GRID_BAR();

#ifndef SKIP_P10
        { const int ln = lane_id_v();
        {
            const unsigned char* U8l = U8 + (size_t)layer * 16384 * D;
            const unsigned char* V8l = V8 + (size_t)layer * 16384 * D;
            for (int rep_ = 0; rep_ < REP_P10; ++rep_)
            for (int t = gw; t < T_EFF; t += NGW) {
                f32x4 hv[4];
                { const GAS v2u* hp = (const GAS v2u*)(H + (size_t)t * D) + ln;
#pragma unroll
                  for (int j = 0; j < 4; ++j) { const v2u w = hp[64 * j]; hv[j] = (f32x4){bf2f(w.x & 0xffffu), bf2f(w.x >> 16), bf2f(w.y & 0xffffu), bf2f(w.y >> 16)}; } }
                f32x4 o[4];
#pragma unroll
                for (int j = 0; j < 4; ++j) o[j] = (f32x4){0.f, 0.f, 0.f, 0.f};
#pragma unroll 1
                for (int s0 = 0; s0 < NSEL; s0 += 32) {
                    const unsigned esu = EI[(size_t)t * NSEL + s0 + (ln & 31)]; const float gv = EG[(size_t)t * NSEL + s0 + (ln & 31)];
                    int eidx = (int)(esu & 0xffffu); const float su = bf2f(esu >> 16);
                    float p[32];
                    {
                        v4u rowa[8], rowb[8];
#pragma unroll
                        for (int q = 0; q < 8; ++q) { const int e = __builtin_amdgcn_readlane(eidx, q); rowa[q] = *((const GAS v4u*)(U8l + (size_t)e * D) + ln); }
#pragma unroll
                        for (int g = 0; g < 4; ++g) {
                            if (g < 3) {
#pragma unroll
                                for (int q = 0; q < 8; ++q) { const int e = __builtin_amdgcn_readlane(eidx, (g + 1) * 8 + q);
                                    if (g & 1) rowa[q] = *((const GAS v4u*)(U8l + (size_t)e * D) + ln); else rowb[q] = *((const GAS v4u*)(U8l + (size_t)e * D) + ln); }
                            }
                            __builtin_amdgcn_sched_barrier(0);
#pragma unroll
                            for (int q = 0; q < 8; ++q) {
                                const v4u rw = (g & 1) ? rowb[q] : rowa[q];
                                float dd = 0.f;
#pragma unroll
                                for (int j = 0; j < 4; ++j) {
                                    const f32x2 a = __builtin_amdgcn_cvt_pk_f32_fp8((int)rw[j], false), b = __builtin_amdgcn_cvt_pk_f32_fp8((int)rw[j], true);
                                    dd += (a.x * hv[j].x + a.y * hv[j].y) + (b.x * hv[j].z + b.y * hv[j].w);
                                }
                                asm volatile("" : "+v"(dd));
                                p[g * 8 + q] = dd;
                                __builtin_amdgcn_sched_barrier(0);
                            }
                        }
                    }
#pragma unroll
                    for (int w = 16; w >= 1; w >>= 1) {
                        const bool up = (ln & w) != 0;
#pragma unroll
                        for (int i = 0; i < w; ++i) {
                            const float send = up ? p[i] : p[i + w], keep = up ? p[i + w] : p[i];
                            p[i] = keep + __shfl_xor(send, w);
                        }
                    }
                    const float dot = (p[0] + __shfl_xor(p[0], 32)) * su;
                    float wgt = 0.5f * dot * (1.0f + erff(dot * 0.70710678118654752f)) * gv;
                    asm volatile("" : "+v"(eidx), "+v"(wgt));
                    {
                        v4u rowa[8], rowb[8];
#pragma unroll
                        for (int q = 0; q < 8; ++q) { const int e = __builtin_amdgcn_readlane(eidx, q); rowa[q] = *((const GAS v4u*)(V8l + (size_t)e * D) + ln); }
#pragma unroll
                        for (int g = 0; g < 4; ++g) {
                            if (g < 3) {
#pragma unroll
                                for (int q = 0; q < 8; ++q) { const int e = __builtin_amdgcn_readlane(eidx, (g + 1) * 8 + q);
                                    if (g & 1) rowa[q] = *((const GAS v4u*)(V8l + (size_t)e * D) + ln); else rowb[q] = *((const GAS v4u*)(V8l + (size_t)e * D) + ln); }
                            }
                            __builtin_amdgcn_sched_barrier(0);
#pragma unroll
                            for (int q = 0; q < 8; ++q) {
                                const v4u rw = (g & 1) ? rowb[q] : rowa[q];
                                const float wq = __builtin_bit_cast(float, __builtin_amdgcn_readlane(__builtin_bit_cast(int, wgt), g * 8 + q));
#pragma unroll
                                for (int j = 0; j < 4; ++j) {
                                    const f32x2 a = __builtin_amdgcn_cvt_pk_f32_fp8((int)rw[j], false), b = __builtin_amdgcn_cvt_pk_f32_fp8((int)rw[j], true);
                                    o[j].x += wq * a.x; o[j].y += wq * a.y; o[j].z += wq * b.x; o[j].w += wq * b.y;
                                }
                                asm volatile("" : "+v"(o[0]), "+v"(o[1]), "+v"(o[2]), "+v"(o[3]));
                                __builtin_amdgcn_sched_barrier(0);
                            }
                        }
                    }
                }
                const float* gt2 = modl + (size_t)row_modidx(t) * 6 * D + 5 * D;
                GAS f32x4* xr = (GAS f32x4*)(X + (size_t)t * D) + ln;
                f32x4 xn[4]; float ss = 0.f;
#pragma unroll
                for (int j = 0; j < 4; ++j) {
                    xn[j] = xr[64 * j] + *((const GAS f32x4*)gt2 + ln + 64 * j) * o[j];
                    ss += (xn[j].x * xn[j].x + xn[j].y * xn[j].y) + (xn[j].z * xn[j].z + xn[j].w * xn[j].w);
                }
                if (REP_P10 > 1 && rep_ + 1 < REP_P10 && ss != 1234.5678f) continue;
                if (!last) {
#pragma unroll
                    for (int j = 0; j < 4; ++j) xr[64 * j] = xn[j];
                    const float rs1 = 1.0f / sqrtf(wave_sum(ss) * (1.f / D) + NORM_EPS);
                    const float* md1 = modl + (size_t)(3 + row_modidx(t)) * 6 * D;
                    GAS v2u* o8 = (GAS v2u*)(H + (size_t)t * D) + ln;
#pragma unroll
                    for (int j = 0; j < 4; ++j) {
                        const f32x4 g = *((const GAS f32x4*)(args.in[I_G1] + (layer + 1) * D) + ln + 64 * j);
                        const f32x4 sh = *((const GAS f32x4*)(md1 + 0) + ln + 64 * j), sc = *((const GAS f32x4*)(md1 + D) + ln + 64 * j);
                        const f32x4 hh = xn[j] * rs1 * g * (sc + 1.0f) + sh;
                        v2u o; o.x = pk2(hh.x, hh.y); o.y = pk2(hh.z, hh.w); o8[64 * j] = o;
                    }
                } else {
                    const float rs = 1.0f / sqrtf(wave_sum(ss) * (1.f / D) + NORM_EPS);
                    GAS f32x4* op = (GAS f32x4*)(args.out + (size_t)t * D) + ln;
#pragma unroll
                    for (int j = 0; j < 4; ++j) op[64 * j] = xn[j] * rs * *((const GAS f32x4*)args.in[I_GFINAL] + ln + 64 * j);
                }
            }
        }
        }
#endif
        if (!last) GRID_BAR();
    }
}

extern "C" void kernel_launch(void* const* d_in, const int* in_sizes, int n_in, void* d_out, int out_size, void* d_ws, size_t ws_size, hipStream_t stream) {
    static int grid = 0;
    if (grid == 0) {
        if (n_in != 22 || out_size != T_LAT * D || ws_size < WS_END) { fprintf(stderr, "kernel_launch: unexpected shapes: n_in %d out %d ws %zu (need %zu)\n", n_in, out_size, ws_size, (size_t)WS_END); grid = -1; return; }
        int dev = 0, cus = 0, per_cu = 0;
        if (hipGetDevice(&dev) != hipSuccess || hipDeviceGetAttribute(&cus, hipDeviceAttributeMultiprocessorCount, dev) != hipSuccess) { fprintf(stderr, "device query failed\n"); grid = -1; return; }
        if (hipFuncSetAttribute((const void*)mega_fwd, hipFuncAttributeMaxDynamicSharedMemorySize, LDS_BYTES) != hipSuccess) { fprintf(stderr, "hipFuncSetAttribute failed\n"); grid = -1; return; }
        if (hipOccupancyMaxActiveBlocksPerMultiprocessor(&per_cu, (const void*)mega_fwd, NTHREADS, LDS_BYTES) != hipSuccess || per_cu < 1) { fprintf(stderr, "occupancy query: %d\n", per_cu); }
        (void)hipGetLastError();
        grid = cus;
    }
    if (grid < 0) return;
    if (hipMemsetAsync((char*)d_ws + WS_CTL, 0, CTL_ZERO_BYTES, stream) != hipSuccess) { fprintf(stderr, "memset failed\n"); return; }
    Args a{};
    for (int i = 0; i < 22; ++i) a.in[i] = (const float*)d_in[i];
    a.out = (float*)d_out; a.ws = (unsigned char*)d_ws;
    hipLaunchKernelGGL(mega_fwd, dim3(grid), dim3(NTHREADS), LDS_BYTES, stream, a);
}
```

```cpp
#include <hip/hip_runtime.h>
#include <cstdio>
#include <cstdint>

#ifndef REP_P0
#define REP_P0 1
#endif
#ifndef REP_P1
#define REP_P1 1
#endif
#ifndef REP_P2
#define REP_P2 1
#endif
#ifndef REP_P3A
#define REP_P3A 1
#endif
#ifndef REP_P3B
#define REP_P3B 1
#endif
#ifndef REP_P4
#define REP_P4 1
#endif
#ifndef REP_P6
#define REP_P6 1
#endif
#ifndef REP_P7
#define REP_P7 1
#endif
#ifndef REP_P8
#define REP_P8 1
#endif
#ifndef REP_P9
#define REP_P9 1
#endif
#ifndef REP_P10
#define REP_P10 1
#endif
#ifndef REP_P3C
#define REP_P3C 1
#endif
#define GAS __attribute__((address_space(1)))
#define LAS __attribute__((address_space(3)))
typedef unsigned short bf16;
typedef float f32x4 __attribute__((ext_vector_type(4)));
typedef short bf16x8 __attribute__((ext_vector_type(8)));
typedef unsigned v4u __attribute__((ext_vector_type(4)));
typedef unsigned v2u __attribute__((ext_vector_type(2)));
typedef float f32x2 __attribute__((ext_vector_type(2)));
typedef GAS unsigned gu32;

constexpr int NWAVES = 8, NTHREADS = 512;
constexpr int D = 1024, BATCH = 2, SEQ = 8192, DEPTH = 2, GRID_W = 64, CTX = 256;
constexpr int T_LAT = BATCH * SEQ;
constexpr int T_ALL = T_LAT + BATCH * CTX;
constexpr int NTOK = SEQ + CTX;
constexpr int IN_W = 6912;
constexpr int PEER_HEADS = 8, PEER_KEYS = 128, PEER_TOPK = 16, NSEL = PEER_HEADS * PEER_TOPK;
constexpr float NORM_EPS = 1e-6f;
constexpr float LOG2E = 1.4426950408889634f;
constexpr float SCL2 = 0.125f * LOG2E;

constexpr size_t MiB = 1u << 20;
constexpr size_t WS_CTL = 0, CTL_ZERO_BYTES = 1 * MiB;
constexpr int CW_BAR = 4096;
constexpr size_t WS_MOD = 65536;
constexpr size_t WS_COS = 2 * MiB, WS_SIN = 3 * MiB;
constexpr size_t WS_WIN = 4 * MiB;
constexpr size_t WS_WB = 31 * MiB;
constexpr size_t WS_WO = 37 * MiB;
constexpr size_t WS_WQ = 41 * MiB;
constexpr size_t WS_KEYS = 49 * MiB;
constexpr size_t WS_X = 50 * MiB;
constexpr size_t WS_H = 116 * MiB;
constexpr size_t WS_Y = 149 * MiB;
constexpr size_t WS_MG = WS_H;
constexpr size_t WS_U8 = 199 * MiB;
constexpr size_t WS_SCU = 231 * MiB;
constexpr size_t WS_EI = 232 * MiB;
constexpr size_t WS_EG = 241 * MiB;
constexpr size_t WS_P = 250 * MiB;
constexpr size_t SZ_R512 = (size_t)T_ALL * 512 * 2;
constexpr size_t SZ_R128 = (size_t)T_ALL * 128 * 2;
constexpr size_t WS_AQ = WS_P, WS_AK = WS_AQ + SZ_R512, WS_AVT = WS_AK + SZ_R128, WS_BQ = WS_AVT + SZ_R128, WS_BK = WS_BQ + SZ_R512,
                 WS_BVT = WS_BK + SZ_R512, WS_CQ = WS_BVT + SZ_R512, WS_CK = WS_CQ + SZ_R512, WS_CVT = WS_CK + SZ_R512, WS_SG = WS_CVT + SZ_R512;
constexpr size_t WS_Q2 = WS_P;
constexpr size_t WS_SC = WS_P + 66 * MiB;
constexpr size_t WS_PEND = WS_SG + (size_t)T_ALL * 3072 * 2;
constexpr size_t WS_V8 = 473 * MiB;
constexpr size_t WS_END = WS_V8 + 32 * MiB;
static_assert(WS_SC + (size_t)T_ALL * 2048 * 4 <= WS_PEND && WS_PEND <= WS_V8, "alias map");
static_assert(WS_END <= 512 * MiB, "ws map");

constexpr int LDS_BYTES = 147456;
constexpr int MISC_OFF = 131072 + 320;

__device__ __forceinline__ int lane_id_v() { int l; asm volatile("v_mbcnt_lo_u32_b32 %0, -1, 0\n\tv_mbcnt_hi_u32_b32 %0, -1, %0" : "=v"(l)); return l; }
#define XB_TMO      128
#define XB_XCNT(j)  (256  + 64 * (j))
#define XB_XSUB(j)  (1280 + 64 * (j))
#define XB_XGEN(j)  (2304 + 64 * (j))
#define XB_TOP      3328
#define XB_TOPGEN   3392
#define XCD_BAR_WORDS 3456
#define XB_SPIN_CAP (1u << 24)

__device__ __forceinline__ unsigned xb_ld(unsigned* p)              { return __hip_atomic_load(p, __ATOMIC_RELAXED, __HIP_MEMORY_SCOPE_AGENT); }
__device__ __forceinline__ unsigned xb_add(unsigned* p, unsigned v) { return __hip_atomic_fetch_add(p, v, __ATOMIC_RELAXED, __HIP_MEMORY_SCOPE_AGENT); }
__device__ __forceinline__ unsigned xb_xcc_id() { return (unsigned)__builtin_amdgcn_s_getreg((3 << 11) | 20) & 0xFu; }
#define XB_SPIN(cond, bar) do { unsigned _sp = 0; while (cond) { __builtin_amdgcn_s_sleep(1); \
    if ((++_sp & 255u) == 0u) { if (xb_ld(&(bar)[XB_TMO])) break; if (_sp > XB_SPIN_CAP) { atomicAdd(&(bar)[XB_TMO], 1u); break; } } } } while (0)

struct XcdBarrier { unsigned* bar; unsigned x; volatile LAS unsigned* st; };

__device__ __forceinline__ XcdBarrier xcd_barrier_post(unsigned* bar, volatile LAS unsigned* st) {
    XcdBarrier b; b.bar = bar; b.x = xb_xcc_id(); b.st = st;
    if (threadIdx.x == 0) (void)xb_add(&bar[XB_XCNT(b.x)], 1u);
    return b;
}
__device__ __forceinline__ void xcd_barrier_complete(unsigned* bar, unsigned x, unsigned& nloc, unsigned& nx) {
    const unsigned G = gridDim.x * gridDim.y * gridDim.z;
    unsigned sum, cnt, mine, sp = 0u;
    for (;;) {
        sum = 0u; cnt = 0u; mine = 0u;
#pragma unroll
        for (unsigned j = 0; j < 16; ++j) { const unsigned c = xb_ld(&bar[XB_XCNT(j)]); sum += c; cnt += (c > 0u) ? 1u : 0u; mine = (j == x) ? c : mine; }
        if (sum == G) break;
        __builtin_amdgcn_s_sleep(1);
        if ((++sp & 255u) == 0u) { if (xb_ld(&bar[XB_TMO])) break; if (sp > XB_SPIN_CAP) { atomicAdd(&bar[XB_TMO], 1u); break; } }
    }
    nloc = mine > 0u ? mine : 1u; nx = cnt > 0u ? cnt : 1u;
}
__device__ __forceinline__ void xcd_barrier(const XcdBarrier& b, bool t0) {
    asm volatile("s_waitcnt vmcnt(0)" ::: "memory");
    __syncthreads();
    if (t0) {
        unsigned* bar = b.bar;
        __builtin_amdgcn_s_waitcnt(0);
        unsigned nloc = b.st[0], nx = b.st[1];
        if (nloc == 0u) { xcd_barrier_complete(bar, b.x, nloc, nx); b.st[0] = nloc; b.st[1] = nx; }
        const unsigned old = xb_add(&bar[XB_XSUB(b.x)], 1u);
        const unsigned gen = old / nloc;
        if (old + 1u == (gen + 1u) * nloc) {
            __builtin_amdgcn_fence(__ATOMIC_RELEASE, "agent");
            asm volatile("s_waitcnt vmcnt(0)" ::: "memory");
            const unsigned og = xb_add(&bar[XB_TOP], 1u);
            const unsigned tg = og / nx;
            if (og + 1u == (tg + 1u) * nx) xb_add(&bar[XB_TOPGEN], 1u);
            else XB_SPIN(xb_ld(&bar[XB_TOPGEN]) == tg, bar);
            __builtin_amdgcn_fence(__ATOMIC_ACQUIRE, "agent");
            xb_add(&bar[XB_XGEN(b.x)], 1u);
            asm volatile("s_waitcnt vmcnt(0)" ::: "memory");
        } else {
            XB_SPIN(xb_ld(&bar[XB_XGEN(b.x)]) == gen, bar);
            __builtin_amdgcn_fence(__ATOMIC_ACQUIRE, "agent");
            asm volatile("s_waitcnt vmcnt(0)" ::: "memory");
        }
    }
    __syncthreads();
}

__device__ __forceinline__ unsigned f2bf(float f) { unsigned u = __builtin_bit_cast(unsigned, f); return (u + 0x7fffu + ((u >> 16) & 1u)) >> 16; }
__device__ __forceinline__ unsigned pk2(float lo, float hi) { return f2bf(lo) | (f2bf(hi) << 16); }
__device__ __forceinline__ float bf2f(unsigned h) { return __builtin_bit_cast(float, h << 16); }
template <int K> __device__ __forceinline__ float xshfl_l(float v, int lane) { return __builtin_bit_cast(float, __builtin_amdgcn_ds_bpermute((lane ^ K) << 2, __builtin_bit_cast(int, v))); }
template <int K> __device__ __forceinline__ float xshfl(float v) { return xshfl_l<K>(v, lane_id_v()); }
__device__ __forceinline__ float xadd32(float v) { return v + xshfl_l<32>(v, lane_id_v()); }
__device__ __forceinline__ float xmax32(float v) { return fmaxf(v, xshfl_l<32>(v, lane_id_v())); }
__device__ __forceinline__ float wave_sum(float v) { const int l = lane_id_v(); v += xshfl_l<1>(v, l); v += xshfl_l<2>(v, l); v += xshfl_l<4>(v, l); v += xshfl_l<8>(v, l); v += xshfl_l<16>(v, l); v += xshfl_l<32>(v, l); return v; }
__device__ __forceinline__ float wave_max(float v) { const int l = lane_id_v(); v = fmaxf(v, xshfl_l<1>(v, l)); v = fmaxf(v, xshfl_l<2>(v, l)); v = fmaxf(v, xshfl_l<4>(v, l)); v = fmaxf(v, xshfl_l<8>(v, l)); v = fmaxf(v, xshfl_l<16>(v, l)); v = fmaxf(v, xshfl_l<32>(v, l)); return v; }


__device__ __forceinline__ float sigmoidf_(float x) { return 1.0f / (1.0f + __expf(-x)); }
__device__ __forceinline__ float sigmoid_fast(float x) { return __builtin_amdgcn_rcpf(1.0f + __builtin_amdgcn_exp2f(-LOG2E * x)); }
__device__ __forceinline__ int row_modidx(int r) { return r < T_LAT ? (r >> 13) : 2; }
__device__ __forceinline__ int row_batch(int r) { return r < T_LAT ? (r >> 13) : ((r - T_LAT) >> 8); }
__device__ __forceinline__ int row_tok(int r) { return r < T_LAT ? (r & (SEQ - 1)) : SEQ + ((r - T_LAT) & (CTX - 1)); }

__device__ __forceinline__ const float* xin_row(const float* x, const float* ctx, int r) { return r < T_LAT ? x + (size_t)r * D : ctx + (size_t)(r - T_LAT) * D; }
struct Args { const float* in[22]; float* out; unsigned char* ws; };
enum { I_X = 0, I_C, I_CTX, I_CCTX, I_WMOD, I_BMOD, I_G1, I_G2, I_WIN, I_SINK, I_RPB, I_LAMBDA, I_SUBLN, I_WBA, I_WBB, I_WBC, I_WOUT, I_PWQ, I_PKEYS, I_PU, I_PV, I_GFINAL };

__device__ __forceinline__ int rope_perm(int c) {
    if (c < 640 || (c >= 2304 && c < 3328)) { const int w = c & 63; return (c & ~63) + 2 * (w & 31) + (w >> 5); }
    return c;
}
template <bool PERM = false>
__device__ __forceinline__ void p0_transpose_item(const float* W, int K, int N, bf16* WT, LAS float* scr, int item, int lane) {
    const int nblk = N / 32, kb = item / nblk, nb = item % nblk, k0 = 64 * kb, n0 = 32 * nb;
#pragma unroll 8
    for (int i = 0; i < 32; ++i) { const int kk = 2 * i + (lane >> 5); scr[kk * 33 + (lane & 31)] = W[(size_t)(k0 + kk) * N + n0 + (lane & 31)]; }
    asm volatile("s_waitcnt lgkmcnt(0)" ::: "memory");
    const int c = lane & 7;
#pragma unroll
    for (int j = 0; j < 4; ++j) { const int n = (lane >> 3) + 8 * j; const LAS float* s = scr + (8 * c) * 33 + n;
        v4u o; o.x = pk2(s[0 * 33], s[1 * 33]); o.y = pk2(s[2 * 33], s[3 * 33]); o.z = pk2(s[4 * 33], s[5 * 33]); o.w = pk2(s[6 * 33], s[7 * 33]);
        const int nout = PERM ? rope_perm(n0 + n) : (n0 + n);
        *(GAS v4u*)(WT + (size_t)nout * K + k0 + 8 * c) = o; }
    asm volatile("s_waitcnt lgkmcnt(0)" ::: "memory");
}

template <int UNR = 2, int NN = 4>
__device__ __forceinline__ void sgemm_tile(f32x4 (&acc)[4][NN], const bf16* A, int lda, const bf16* Bt, int ldb, int K, int row0, int col0, int lane) {
    const int fr = lane & 15, fq = lane >> 4;
    const bf16* ap = A + (size_t)(row0 + fr) * lda + fq * 8;
    const bf16* bp = Bt + (size_t)(col0 + fr) * ldb + fq * 8;
#pragma unroll UNR
    for (int k = 0; k < K; k += 32) {
        bf16x8 a[4], b[NN];
#pragma unroll
        for (int m = 0; m < 4; ++m) a[m] = *(const GAS bf16x8*)(ap + (size_t)m * 16 * lda + k);
#pragma unroll
        for (int n = 0; n < NN; ++n) b[n] = *(const GAS bf16x8*)(bp + (size_t)n * 16 * ldb + k);
#pragma unroll
        for (int m = 0; m < 4; ++m)
#pragma unroll
            for (int n = 0; n < NN; ++n) acc[m][n] = __builtin_amdgcn_mfma_f32_16x16x32_bf16(a[m], b[n], acc[m][n], 0, 0, 0);
    }
}
template <int UNR>
__device__ __forceinline__ void sgemm32(f32x4 (&acc)[2][2], const bf16* A, int lda, const bf16* Bt, int ldb, int K, int row0, int col0, int lane) {
    const int fr = lane & 15, fq = lane >> 4;
    const bf16* ap = A + (size_t)(row0 + fr) * lda + fq * 8;
    const bf16* bp = Bt + (size_t)(col0 + fr) * ldb + fq * 8;
#pragma unroll 1
    for (int k0 = 0; k0 < K; k0 += 32 * UNR) {
        bf16x8 a[UNR][2], b[UNR][2];
#pragma unroll
        for (int u = 0; u < UNR; ++u)
#pragma unroll
            for (int m = 0; m < 2; ++m) { a[u][m] = *(const GAS bf16x8*)(ap + (size_t)m * 16 * lda + k0 + 32 * u); b[u][m] = *(const GAS bf16x8*)(bp + (size_t)m * 16 * ldb + k0 + 32 * u); }
#pragma unroll
        for (int u = 0; u < UNR; ++u)
#pragma unroll
            for (int m = 0; m < 2; ++m)
#pragma unroll
                for (int n = 0; n < 2; ++n) acc[m][n] = __builtin_amdgcn_mfma_f32_16x16x32_bf16(a[u][m], b[u][n], acc[m][n], 0, 0, 0);
    }
}
__device__ __forceinline__ void zero_acc22(f32x4 (&acc)[2][2]) { acc[0][0] = acc[0][1] = acc[1][0] = acc[1][1] = (f32x4){0.f, 0.f, 0.f, 0.f}; }
template <int NN>
__device__ __forceinline__ void zero_acc(f32x4 (&acc)[4][NN]) {
#pragma unroll
    for (int m = 0; m < 4; ++m)
#pragma unroll
        for (int n = 0; n < NN; ++n) acc[m][n] = (f32x4){0.f, 0.f, 0.f, 0.f};
}

__device__ __forceinline__ int f2ord(float f) { const int b = __builtin_bit_cast(int, f); return b ^ ((b >> 31) & 0x7fffffff); }
__device__ __forceinline__ float ord2f(int o) { const int b = o ^ ((o >> 31) & 0x7fffffff); return __builtin_bit_cast(float, b); }
__device__ __forceinline__ void top16_insert(int (&top)[16], int key) {
#pragma unroll
    for (int i = 0; i < 16; ++i) { const int hi = max(top[i], key); key = min(top[i], key); top[i] = hi; }
}
#define CE(a, b) { const int t_ = max(a, b); b = min(a, b); a = t_; }
__device__ __forceinline__ void sort16_desc(int (&v)[16]) { CE(v[0], v[1]); CE(v[3], v[2]); CE(v[4], v[5]); CE(v[7], v[6]); CE(v[8], v[9]); CE(v[11], v[10]); CE(v[12], v[13]); CE(v[15], v[14]); CE(v[0], v[2]); CE(v[1], v[3]); CE(v[6], v[4]); CE(v[7], v[5]); CE(v[8], v[10]); CE(v[9], v[11]); CE(v[14], v[12]); CE(v[15], v[13]); CE(v[0], v[1]); CE(v[2], v[3]); CE(v[5], v[4]); CE(v[7], v[6]); CE(v[8], v[9]); CE(v[10], v[11]); CE(v[13], v[12]); CE(v[15], v[14]); CE(v[0], v[4]); CE(v[1], v[5]); CE(v[2], v[6]); CE(v[3], v[7]); CE(v[12], v[8]); CE(v[13], v[9]); CE(v[14], v[10]); CE(v[15], v[11]); CE(v[0], v[2]); CE(v[1], v[3]); CE(v[4], v[6]); CE(v[5], v[7]); CE(v[10], v[8]); CE(v[11], v[9]); CE(v[14], v[12]); CE(v[15], v[13]); CE(v[0], v[1]); CE(v[2], v[3]); CE(v[4], v[5]); CE(v[6], v[7]); CE(v[9], v[8]); CE(v[11], v[10]); CE(v[13], v[12]); CE(v[15], v[14]); CE(v[0], v[8]); CE(v[1], v[9]); CE(v[2], v[10]); CE(v[3], v[11]); CE(v[4], v[12]); CE(v[5], v[13]); CE(v[6], v[14]); CE(v[7], v[15]); CE(v[0], v[4]); CE(v[1], v[5]); CE(v[2], v[6]); CE(v[3], v[7]); CE(v[8], v[12]); CE(v[9], v[13]); CE(v[10], v[14]); CE(v[11], v[15]); CE(v[0], v[2]); CE(v[1], v[3]); CE(v[4], v[6]); CE(v[5], v[7]); CE(v[8], v[10]); CE(v[9], v[11]); CE(v[12], v[14]); CE(v[13], v[15]); CE(v[0], v[1]); CE(v[2], v[3]); CE(v[4], v[5]); CE(v[6], v[7]); CE(v[8], v[9]); CE(v[10], v[11]); CE(v[12], v[13]); CE(v[14], v[15]); }
__device__ __forceinline__ void merge16_desc(int (&a)[16], const int (&b)[16]) {
#pragma unroll
    for (int i = 0; i < 16; ++i) a[i] = max(a[i], b[15 - i]);
    CE(a[0], a[8]); CE(a[1], a[9]); CE(a[2], a[10]); CE(a[3], a[11]); CE(a[4], a[12]); CE(a[5], a[13]); CE(a[6], a[14]); CE(a[7], a[15]); CE(a[0], a[4]); CE(a[1], a[5]); CE(a[2], a[6]); CE(a[3], a[7]); CE(a[8], a[12]); CE(a[9], a[13]); CE(a[10], a[14]); CE(a[11], a[15]); CE(a[0], a[2]); CE(a[1], a[3]); CE(a[4], a[6]); CE(a[5], a[7]); CE(a[8], a[10]); CE(a[9], a[11]); CE(a[12], a[14]); CE(a[13], a[15]); CE(a[0], a[1]); CE(a[2], a[3]); CE(a[4], a[5]); CE(a[6], a[7]); CE(a[8], a[9]); CE(a[10], a[11]); CE(a[12], a[13]); CE(a[14], a[15]); }
#undef CE


typedef float f32x16 __attribute__((ext_vector_type(16)));
typedef short s16x4 __attribute__((ext_vector_type(4)));
typedef __bf16 bf16x2_t __attribute__((ext_vector_type(2)));
__device__ __forceinline__ unsigned cvtpk(float lo, float hi) { f32x2 v = {lo, hi}; bf16x2_t b = __builtin_convertvector(v, bf16x2_t); return __builtin_bit_cast(unsigned, b); }
constexpr int CK_PITCH = 144, CV_PITCH = 320;
constexpr int CK_SZ = 64 * CK_PITCH, CV_SZ = 64 * CV_PITCH;
constexpr float C_THR_RAW = 8.0f / SCL2;

template <int NDV, class RowFn, class UseFn, class ElemFn>
__device__ __forceinline__ void attn64_pass(f32x16 (&o)[NDV], float& mrun, float& lpart, const bf16x8 (&qf)[4], const bf16* kg, int kpitch, const bf16* vg, int vpitch,
                                            int ntiles, RowFn tile_row, UseFn use_tile, ElemFn elem, LAS unsigned char* L, int lane, int tid) {
    constexpr int VP = NDV * 64 + 64, VSZ = 64 * VP, NVP = NDV / 2;
    const int r32 = lane & 31, hi = lane >> 5;
    const int krow_s = tid >> 3, kch_s = tid & 7;
    const int vrow_s = (NDV == 2) ? (tid >> 3) : (tid >> 4), vch_s = (NDV == 2) ? (tid & 7) : (tid & 15);
    LAS unsigned char* Kb0 = L; LAS unsigned char* Vb0 = L + 2 * CK_SZ;
    __syncthreads();
    {
        const int tr = tile_row(0);
        const v4u kr = *(const GAS v4u*)(kg + (size_t)tr * kpitch);
        *(LAS v4u*)(Kb0 + krow_s * CK_PITCH + kch_s * 16) = kr;
#pragma unroll
        for (int i = 0; i < NVP; ++i) { const v4u v = *(const GAS v4u*)(vg + (size_t)(tr + 32 * i) * vpitch); *(LAS v4u*)(Vb0 + (vrow_s + 32 * i) * VP + vch_s * 16) = v; }
    }
    __syncthreads();
#pragma unroll 1
    for (int j = 0; j < ntiles; ++j) {
        const int cur = j & 1;
        const LAS unsigned char* Kb = Kb0 + cur * CK_SZ; const LAS unsigned char* Vb = Vb0 + cur * VSZ;
        v4u kr, vr[NVP];
        const bool more = (j + 1 < ntiles);
        { const int tr = tile_row(more ? j + 1 : j); kr = *(const GAS v4u*)(kg + (size_t)tr * kpitch);
#pragma unroll
            for (int i = 0; i < NVP; ++i) vr[i] = *(const GAS v4u*)(vg + (size_t)(tr + 32 * i) * vpitch); }
        if (use_tile(j)) {
            f32x16 st[2];
#pragma unroll
            for (int kb = 0; kb < 2; ++kb) {
#pragma unroll
                for (int r = 0; r < 16; ++r) st[kb][r] = 0.f;
#pragma unroll
                for (int ks = 0; ks < 4; ++ks) {
                    const bf16x8 kf = *(const LAS bf16x8*)(Kb + (kb * 32 + r32) * CK_PITCH + ks * 32 + hi * 16);
                    st[kb] = __builtin_amdgcn_mfma_f32_32x32x16_bf16(kf, qf[ks], st[kb], 0, 0, 0);
                }
            }
            elem(st, j);
            float mx = st[0][0];
#pragma unroll
            for (int r = 1; r < 16; ++r) mx = fmaxf(mx, st[0][r]);
#pragma unroll
            for (int r = 0; r < 16; ++r) mx = fmaxf(mx, st[1][r]);
            mx = xmax32(mx);
            if (__builtin_amdgcn_ballot_w64(mx > mrun + C_THR_RAW) != 0ull) {
                const float mn = fmaxf(mrun, mx);
                const float alpha = __builtin_amdgcn_exp2f((mrun - mn) * SCL2);
#pragma unroll
                for (int d = 0; d < NDV; ++d)
#pragma unroll
                    for (int r = 0; r < 16; ++r) o[d][r] *= alpha;
                lpart *= alpha; mrun = mn;
            }
            const float nmc = -mrun * SCL2;
            float ls = 0.f;
#pragma unroll
            for (int kb = 0; kb < 2; ++kb)
#pragma unroll
                for (int r = 0; r < 16; ++r) { const float p = __builtin_amdgcn_exp2f(fmaf(st[kb][r], SCL2, nmc)); st[kb][r] = p; ls += p; }
            lpart += ls;
            const int q4 = (lane & 15) >> 2, p4 = lane & 3, grp = (lane >> 4) & 1;
            const LAS unsigned char* vbase = Vb + (4 * hi + q4) * VP + (16 * grp + 4 * p4) * 2;
#pragma unroll
            for (int kb = 0; kb < 2; ++kb)
#pragma unroll
                for (int ss = 0; ss < 2; ++ss) {
                    v4u pw;
#pragma unroll
                    for (int i2 = 0; i2 < 4; ++i2) pw[i2] = cvtpk(st[kb][8 * ss + 2 * i2], st[kb][8 * ss + 2 * i2 + 1]);
                    const bf16x8 pb = __builtin_bit_cast(bf16x8, pw);
#pragma unroll
                    for (int d = 0; d < NDV; ++d) {
                        const LAS unsigned char* va = vbase + (kb * 32 + 16 * ss) * VP + d * 64;
                        const s16x4 lo = __builtin_bit_cast(s16x4, __builtin_amdgcn_ds_read_tr16_b64_v4i16((LAS s16x4*)va));
                        const s16x4 hh = __builtin_bit_cast(s16x4, __builtin_amdgcn_ds_read_tr16_b64_v4i16((LAS s16x4*)(va + 8 * VP)));
                        const bf16x8 vf = __builtin_shufflevector(lo, hh, 0, 1, 2, 3, 4, 5, 6, 7);
                        o[d] = __builtin_amdgcn_mfma_f32_32x32x16_bf16(vf, pb, o[d], 0, 0, 0);
                    }
                }
        }
        if (more) {
            LAS unsigned char* Kn = Kb0 + (cur ^ 1) * CK_SZ; LAS unsigned char* Vn = Vb0 + (cur ^ 1) * VSZ;
            *(LAS v4u*)(Kn + krow_s * CK_PITCH + kch_s * 16) = kr;
#pragma unroll
            for (int i = 0; i < NVP; ++i) *(LAS v4u*)(Vn + (vrow_s + 32 * i) * VP + vch_s * 16) = vr[i];
        }
        __syncthreads();
    }
}
__device__ __forceinline__ void attn64_store(const f32x16 (&o)[2], float inv, bf16* yrow, int hi) {
#pragma unroll
    for (int d = 0; d < 2; ++d)
#pragma unroll
        for (int g4 = 0; g4 < 4; ++g4) {
            v2u w; w.x = cvtpk(o[d][4 * g4] * inv, o[d][4 * g4 + 1] * inv); w.y = cvtpk(o[d][4 * g4 + 2] * inv, o[d][4 * g4 + 3] * inv);
            *(GAS v2u*)(yrow + d * 32 + 8 * g4 + 4 * hi) = w;
        }
}

namespace pg8 {
typedef unsigned short bf16_t;
constexpr int BM = 256, BK = 64, HALF = 128, HTB = HALF * BK * 2, STAGE_BYTES = 8 * HTB, NXCD = 8, WGM = 8;
__host__ __device__ __forceinline__ int lds_byte(int r, int c) { const int st = (r >> 4) * 2 + (c >> 5), rr = r & 15, cc = c & 31, ob = rr * 64 + cc * 2; return st * 1024 + (ob ^ (((ob >> 9) & 1) << 5)); }
__host__ __device__ __forceinline__ void stage_rc(int b, int& R, int& C) { const int st = b / 1024, sb = b % 1024, swz = sb ^ (((sb >> 9) & 1) << 5); R = (st >> 1) * 16 + swz / 64; C = (st & 1) * 32 + (swz % 64) / 2; }
__host__ __device__ __forceinline__ int perm32(int rho) { const int n = rho >> 4, i = rho & 15; return 8 * (i >> 2) + 4 * n + (i & 3); }
struct Unit { int pm, pn, seg; };
struct Gemm { const bf16_t* A; const bf16_t* Bt; int lda, ldb, K; size_t a_seg, b_seg; };
struct TileOrder {
    int nM, nN, nwg, G, c;
    __device__ void init(int M, int N, int G_, int c_) { nM = M / BM; nN = N / BM; nwg = nM * nN; G = G_; c = c_; }
    __device__ bool tile(int i, int& pm, int& pn) const {
        const long L = (long)i * G + c; if (L >= nwg) return false;
        int wgid = (int)L; { const int q = nwg / NXCD, r = nwg % NXCD, xcd = wgid % NXCD, off = wgid / NXCD; wgid = (xcd < r ? xcd * (q + 1) : r * (q + 1) + (xcd - r) * q) + off; }
        const int nig = WGM * nN, gid = wgid / nig, fm = gid * WGM, gsz = (nM - fm) < WGM ? (nM - fm) : WGM;
        pm = fm + ((wgid % nig) % gsz); pn = (wgid % nig) / gsz; return true;
    }
};
template <int NSEG> struct SegOrder {
    TileOrder T;
    __device__ bool next(int i, Unit& u) const { u.seg = i % NSEG; return T.tile(i / NSEG, u.pm, u.pn); }
};
template <class Epi, class Sched>
__device__ __forceinline__ void gemm_phase(LAS unsigned char* lds, const Gemm g, const Sched& S, const Epi& E, int wid) {
    const int lane = lane_id_v(), tid = wid * 64 + lane,
              wr = wid >> 2, wc = wid & 3, fr = lane & 15, fq = lane >> 4;
    const int K = g.K, nt = K / BK;
    unsigned voffA[2], voffB[2];
#pragma unroll
    for (int i = 0; i < 2; ++i) { int R, C; stage_rc(tid * 16 + i * 8192, R, C); const int Rb = (R & ~31) + perm32(R & 31);
        voffA[i] = (unsigned)(R * g.lda + C) * 2u; voffB[i] = (unsigned)(Rb * g.ldb + C) * 2u; }
    const size_t kstep = (size_t)(BK * 2);
    const size_t hstepA = (size_t)HALF * g.lda * 2, hstepB = (size_t)HALF * g.ldb * 2;
    const unsigned ldsw = (unsigned)wid * 1024u;
    const int aoff = lds_byte(wr * 64 + fr, fq * 8), boff = lds_byte(wc * 32 + fr, fq * 8);
#define PG8_SA(b, h) (((b) * 2 + (h)) * HTB)
#define PG8_SB(b, h) ((4 + (b) * 2 + (h)) * HTB)
#define PG8_STAGE(bufoff, gbase, voff) do { _Pragma("unroll") for (int _i = 0; _i < 2; ++_i) \
        __builtin_amdgcn_global_load_lds((const unsigned*)((const char*)(gbase) + (voff)[_i]), (LAS unsigned*)(lds + (bufoff) + ldsw + _i * 8192), 16, 0, 0); } while (0)
#define PG8_LDA(dst, b, h) do { _Pragma("unroll") for (int m = 0; m < 4; ++m) _Pragma("unroll") for (int k = 0; k < 2; ++k) dst[m][k] = *(const LAS bf16x8*)(lds + PG8_SA(b, h) + aoff + m * 2048 + k * 1024); } while (0)
#define PG8_LDB(dst, b, h) do { _Pragma("unroll") for (int n = 0; n < 2; ++n) _Pragma("unroll") for (int k = 0; k < 2; ++k) dst[n][k] = *(const LAS bf16x8*)(lds + PG8_SB(b, h) + boff + n * 2048 + k * 1024); } while (0)
#define PG8_MMA(ai, bj, At, Bt) do { __builtin_amdgcn_s_setprio(1); _Pragma("unroll") for (int m = 0; m < 4; ++m) _Pragma("unroll") for (int n = 0; n < 2; ++n) _Pragma("unroll") for (int k = 0; k < 2; ++k) \
        acc[ai][bj][m][n] = __builtin_amdgcn_mfma_f32_16x16x32_bf16(Bt[n][k], At[m][k], acc[ai][bj][m][n], 0, 0, 0); __builtin_amdgcn_s_setprio(0); } while (0)
#define PG8_WAIT_V(n) asm volatile("s_waitcnt vmcnt(" #n ")" ::: "memory")
#define PG8_WAIT_L(n) asm volatile("s_waitcnt lgkmcnt(" #n ")" ::: "memory")
#define PG8_BAR __builtin_amdgcn_s_barrier()
#define PG8_SCHED __builtin_amdgcn_sched_barrier(0)
#define PG8_ABASE(u) ((const char*)g.A + ((size_t)(u).seg * g.a_seg + (size_t)(u).pm * BM * g.lda) * 2)
#define PG8_BBASE(u) ((const char*)g.Bt + ((size_t)(u).seg * g.b_seg + (size_t)(u).pn * BM * g.ldb) * 2)
    Unit cur, nxt; int ui = 0;
    if (!S.next(0, cur)) return;
    f32x4 acc[2][2][4][2];
#pragma unroll
    for (int a = 0; a < 2; ++a)
#pragma unroll
        for (int b = 0; b < 2; ++b)
#pragma unroll
            for (int m = 0; m < 4; ++m)
#pragma unroll
                for (int n = 0; n < 2; ++n) acc[a][b][m][n] = (f32x4){0.f, 0.f, 0.f, 0.f};
    bf16x8 At[4][2], B0[2][2], B1[2][2];
    const char* cA = PG8_ABASE(cur); const char* cB = PG8_BBASE(cur);
    PG8_STAGE(PG8_SB(0, 0), cB, voffB); PG8_STAGE(PG8_SB(0, 1), cB + hstepB, voffB); PG8_STAGE(PG8_SA(0, 0), cA, voffA); PG8_STAGE(PG8_SA(0, 1), cA + hstepA, voffA);
    if (wr == 1) PG8_BAR;
    PG8_WAIT_V(2); PG8_BAR;
    PG8_STAGE(PG8_SB(1, 0), cB + kstep, voffB); PG8_STAGE(PG8_SA(1, 0), cA + kstep, voffA); PG8_STAGE(PG8_SB(1, 1), cB + hstepB + kstep, voffB);
    PG8_WAIT_V(6); PG8_BAR;
    for (;;) {
        const bool has_next = S.next(ui + 1, nxt);
        const char* nA = has_next ? PG8_ABASE(nxt) : cA; const char* nB = has_next ? PG8_BBASE(nxt) : cB;
        for (int t = 0; t < nt; t += 2) {
            const bool lastk = (t == nt - 2);
            const char* a1 = cA + (size_t)(t + 1) * kstep;
            const char* a2 = lastk ? nA : cA + (size_t)(t + 2) * kstep; const char* b2 = lastk ? nB : cB + (size_t)(t + 2) * kstep;
            const char* a3 = a2 + kstep; const char* b3 = b2 + kstep;
            PG8_LDB(B0, 0, 0); PG8_LDB(B1, 0, 1); PG8_SCHED; PG8_LDA(At, 0, 0); PG8_STAGE(PG8_SA(1, 1), a1 + hstepA, voffA);
            PG8_WAIT_V(8); PG8_WAIT_L(0); PG8_BAR; PG8_MMA(0, 0, At, B0); PG8_MMA(0, 1, At, B1); PG8_BAR; PG8_SCHED;
            PG8_LDA(At, 0, 1); PG8_STAGE(PG8_SB(0, 0), b2, voffB); PG8_STAGE(PG8_SB(0, 1), b2 + hstepB, voffB); PG8_STAGE(PG8_SA(0, 0), a2, voffA);
            PG8_WAIT_V(8); PG8_WAIT_L(0); PG8_BAR; PG8_MMA(1, 0, At, B0); PG8_MMA(1, 1, At, B1); PG8_BAR; PG8_SCHED;
            PG8_LDB(B0, 1, 0); PG8_LDB(B1, 1, 1); PG8_SCHED; PG8_LDA(At, 1, 0); PG8_STAGE(PG8_SA(0, 1), a2 + hstepA, voffA);
            PG8_WAIT_V(8); PG8_WAIT_L(0); PG8_BAR; PG8_MMA(0, 0, At, B0); PG8_MMA(0, 1, At, B1); PG8_BAR; PG8_SCHED;
            PG8_LDA(At, 1, 1); PG8_STAGE(PG8_SB(1, 0), b3, voffB); PG8_STAGE(PG8_SB(1, 1), b3 + hstepB, voffB); PG8_STAGE(PG8_SA(1, 0), a3, voffA);
            PG8_WAIT_V(8); PG8_WAIT_L(0); PG8_BAR; PG8_MMA(1, 0, At, B0); PG8_MMA(1, 1, At, B1); PG8_BAR; PG8_SCHED;
        }
        if (wr == 0) PG8_BAR;
        E(acc, cur, wr, wc, fr, fq);
        if (!has_next) break;
#pragma unroll
        for (int a = 0; a < 2; ++a)
#pragma unroll
            for (int b = 0; b < 2; ++b)
#pragma unroll
                for (int m = 0; m < 4; ++m)
#pragma unroll
                    for (int n = 0; n < 2; ++n) acc[a][b][m][n] = (f32x4){0.f, 0.f, 0.f, 0.f};
        cur = nxt; cA = nA; cB = nB; ++ui;
        if (wr == 1) PG8_BAR;
    }
    PG8_WAIT_V(0);
    PG8_BAR;
#undef PG8_SA
#undef PG8_SB
#undef PG8_STAGE
#undef PG8_LDA
#undef PG8_LDB
#undef PG8_MMA
#undef PG8_WAIT_V
#undef PG8_WAIT_L
#undef PG8_BAR
#undef PG8_SCHED
#undef PG8_ABASE
#undef PG8_BBASE
}
}

__device__ __forceinline__ v4u pack8(const f32x4& a, const f32x4& b) { v4u w; w.x = cvtpk(a.x, a.y); w.y = cvtpk(a.z, a.w); w.z = cvtpk(b.x, b.y); w.w = cvtpk(b.z, b.w); return w; }
struct EpiInProj {
    bf16 *AQ, *AK, *AVT, *BQ, *BK, *BVT, *CQ, *CK, *CV, *SG; const float *COS, *SIN;
    __device__ __forceinline__ void operator()(const f32x4 (&acc)[2][2][4][2], const pg8::Unit& u, int wr, int wc, int fr, int fq) const {
        asm volatile("" : "+v"(fr), "+v"(fq));
#pragma unroll
        for (int bj = 0; bj < 2; ++bj) {
            const int cblk = u.pn * 256 + bj * 128;
            const int cw = wc * 32 + 8 * fq;
            bf16* dst; int pitch, cbase; int kind;
            int nh = 1, hd = 0;
            if (cblk < 512)       { dst = AQ; pitch = 512; cbase = cblk; kind = 1; }
            else if (cblk < 640)  { dst = AK; pitch = 128; cbase = cblk - 512; kind = 1; }
            else if (cblk < 768)  { dst = AVT; pitch = 128; cbase = cblk - 640; kind = 0; }
            else if (cblk < 1280) { dst = BQ; pitch = 512; cbase = cblk - 768; kind = 0; }
            else if (cblk < 1792) { dst = BK; pitch = 512; cbase = cblk - 1280; kind = 0; }
            else if (cblk < 2304) { dst = BVT; pitch = 512; cbase = cblk - 1792; kind = 0; }
            else if (cblk < 2816) { dst = CQ; pitch = 512; cbase = cblk - 2304; kind = 1; }
            else if (cblk < 3328) { dst = CK; pitch = 512; cbase = cblk - 2816; kind = 1; }
            else if (cblk < 3840) { dst = CV; pitch = 512; cbase = cblk - 3328; kind = 0; }
            else                  { dst = SG; pitch = 3072; cbase = cblk - 3840; kind = 3; }
#pragma unroll
            for (int ai = 0; ai < 2; ++ai)
#pragma unroll
                for (int m = 0; m < 4; ++m) {
                    const int row = u.pm * 256 + ai * 128 + wr * 64 + m * 16 + fr;
                    f32x4 v0 = acc[ai][bj][m][0], v1 = acc[ai][bj][m][1];
                    if (kind == 1) {
                        if (row < T_LAT) {
                            const int t = row & (SEQ - 1), i0 = (cw & 63) >> 1;
                            const f32x4 cs = *(const GAS f32x4*)(COS + t * 32 + i0), sn = *(const GAS f32x4*)(SIN + t * 32 + i0);
                            const f32x4 a = v0, b = v1;
                            v0.x = a.x * cs.x - a.y * sn.x; v0.y = a.y * cs.x + a.x * sn.x; v0.z = a.z * cs.y - a.w * sn.y; v0.w = a.w * cs.y + a.z * sn.y;
                            v1.x = b.x * cs.z - b.y * sn.z; v1.y = b.y * cs.z + b.x * sn.z; v1.z = b.z * cs.w - b.w * sn.w; v1.w = b.w * cs.w + b.z * sn.w;
                        }
                        *(GAS v4u*)(dst + (size_t)row * pitch + cbase + cw) = pack8(v0, v1);
                    } else if (kind == 0) {
                        *(GAS v4u*)(dst + (size_t)row * pitch + cbase + cw) = pack8(v0, v1);
                    } else if (kind == 3) {
                        v0.x = sigmoid_fast(v0.x); v0.y = sigmoid_fast(v0.y); v0.z = sigmoid_fast(v0.z); v0.w = sigmoid_fast(v0.w);
                        v1.x = sigmoid_fast(v1.x); v1.y = sigmoid_fast(v1.y); v1.z = sigmoid_fast(v1.z); v1.w = sigmoid_fast(v1.w);
                        *(GAS v4u*)(dst + (size_t)row * pitch + cbase + cw) = pack8(v0, v1);
                    } else {
                        const int hc = hd + cw, head = hc >> 6, d = hc & 63;
                        const int b = row_batch(row), tok = row_tok(row);
                        bf16* vp = dst + ((size_t)(b * nh + head) * 64 + d) * NTOK + tok;
                        vp[0 * NTOK] = (bf16)f2bf(v0.x); vp[1 * NTOK] = (bf16)f2bf(v0.y); vp[2 * NTOK] = (bf16)f2bf(v0.z); vp[3 * NTOK] = (bf16)f2bf(v0.w);
                        vp[4 * NTOK] = (bf16)f2bf(v1.x); vp[5 * NTOK] = (bf16)f2bf(v1.y); vp[6 * NTOK] = (bf16)f2bf(v1.z); vp[7 * NTOK] = (bf16)f2bf(v1.w);
                    }
                }
        }
    }
};
__device__ __forceinline__ void unpack8(const v4u& w, f32x4& a, f32x4& b) {
    a = (f32x4){bf2f(w.x & 0xffffu), bf2f(w.x >> 16), bf2f(w.y & 0xffffu), bf2f(w.y >> 16)}; b = (f32x4){bf2f(w.z & 0xffffu), bf2f(w.z >> 16), bf2f(w.w & 0xffffu), bf2f(w.w >> 16)};
}
struct EpiBranch {
    const bf16* SG; bf16* MG;
    __device__ __forceinline__ void operator()(const f32x4 (&acc)[2][2][4][2], const pg8::Unit& u, int wr, int wc, int fr, int fq) const {
        asm volatile("" : "+v"(fr), "+v"(fq));
#pragma unroll
        for (int ai = 0; ai < 2; ++ai)
#pragma unroll
            for (int m = 0; m < 4; ++m) {
                const int row = u.pm * 256 + ai * 128 + wr * 64 + m * 16 + fr;
#pragma unroll
                for (int bj = 0; bj < 2; ++bj) {
                    const int col = u.pn * 256 + bj * 128 + wc * 32 + 8 * fq;
                    f32x4 g0, g1; { const v4u wg = *(const GAS v4u*)(SG + (size_t)row * 3072 + u.seg * 1024 + col); unpack8(wg, g0, g1); }
                    f32x4 v0 = g0 * acc[ai][bj][m][0], v1 = g1 * acc[ai][bj][m][1];
                    bf16* mp = MG + (size_t)row * D + col;
                    if (u.seg > 0) { f32x4 p0, p1; const v4u wp = *(const GAS v4u*)mp; unpack8(wp, p0, p1); v0 += p0; v1 += p1; }
                    *(GAS v4u*)mp = pack8(v0, v1);
                }
            }
    }
};
struct EpiOut {
    float* X; const float* gtl; const float* xin; const float* cin;
    __device__ __forceinline__ void operator()(const f32x4 (&acc)[2][2][4][2], const pg8::Unit& u, int wr, int wc, int fr, int fq) const {
        asm volatile("" : "+v"(fr), "+v"(fq));
#pragma unroll
        for (int ai = 0; ai < 2; ++ai)
#pragma unroll
            for (int m = 0; m < 4; ++m) {
                const int row = u.pm * 256 + ai * 128 + wr * 64 + m * 16 + fr;
                const float* gt = gtl + (size_t)row_modidx(row) * 6 * D + 2 * D;
#pragma unroll
                for (int bj = 0; bj < 2; ++bj) {
                    const int col = u.pn * 256 + bj * 128 + wc * 32 + 8 * fq;
                    GAS f32x4* xp = (GAS f32x4*)(X + (size_t)row * D + col);
                    const GAS f32x4* sp = xin ? (const GAS f32x4*)(xin_row(xin, cin, row) + col) : (const GAS f32x4*)xp;
                    const f32x4 g0 = *(const GAS f32x4*)(gt + col), g1 = *(const GAS f32x4*)(gt + col + 4);
                    xp[0] = sp[0] + g0 * acc[ai][bj][m][0]; xp[1] = sp[1] + g1 * acc[ai][bj][m][1];
                }
            }
    }
};
struct EpiStore {
    bf16* O; int ldc;
    __device__ __forceinline__ void operator()(const f32x4 (&acc)[2][2][4][2], const pg8::Unit& u, int wr, int wc, int fr, int fq) const {
        asm volatile("" : "+v"(fr), "+v"(fq));
#pragma unroll
        for (int ai = 0; ai < 2; ++ai)
#pragma unroll
            for (int m = 0; m < 4; ++m) {
                const int row = u.pm * 256 + ai * 128 + wr * 64 + m * 16 + fr;
#pragma unroll
                for (int bj = 0; bj < 2; ++bj) {
                    const int col = u.pn * 256 + bj * 128 + wc * 32 + 8 * fq;
                    *(GAS v4u*)(O + (size_t)row * ldc + col) = pack8(acc[ai][bj][m][0], acc[ai][bj][m][1]);
                }
            }
    }
};

__global__ void __launch_bounds__(NTHREADS, 2) mega_fwd(Args args) {
    extern __shared__ __attribute__((aligned(16))) unsigned char lds[];
    LAS unsigned char* L = (LAS unsigned char*)lds;
    volatile LAS unsigned* MISC = (volatile LAS unsigned*)(L + MISC_OFF);
    const int wave = __builtin_amdgcn_readfirstlane((int)threadIdx.x >> 6);
    const int lane = lane_id_v(), tid = wave * 64 + lane;
    const int fr = lane & 15, fq = lane >> 4;
    const int G = gridDim.x;
    const int vcu = (G % 8 == 0) ? (int)(blockIdx.x % 8) * (G / 8) + (int)(blockIdx.x / 8) : (int)blockIdx.x;
    for (int u = tid; u < (LDS_BYTES - 131072) / 4; u += NTHREADS) ((LAS unsigned*)(L + 131072))[u] = 0u;
    __syncthreads();
    unsigned char* ws = args.ws;
    gu32* ctl = (gu32*)(ws + WS_CTL);
    (void)xcd_barrier_post((unsigned*)(ctl + CW_BAR), MISC + 8);
#define GRID_BAR() do { unsigned* bp_ = (unsigned*)(args.ws + WS_CTL) + CW_BAR; asm volatile("" : "+s"(bp_)); XcdBarrier b_; b_.bar = bp_; b_.x = xb_xcc_id(); b_.st = MISC + 8; xcd_barrier(b_, wave == 0 && lane_id_v() == 0); } while (0)
    const int gw = vcu * NWAVES + wave, NGW = G * NWAVES;
    const int NGT = G * NTHREADS;

#define PHASE_PTRS \
    unsigned char* wsq = args.ws; asm volatile("" : "+s"(wsq)); \
    const float* const* IN_ = (const float* const*)__builtin_amdgcn_kernarg_segment_ptr(); asm volatile("" : "+s"(IN_)); \
    float* MODV = (float*)(wsq + WS_MOD); float* COS = (float*)(wsq + WS_COS); float* SIN = (float*)(wsq + WS_SIN); \
    bf16* WIN = (bf16*)(wsq + WS_WIN); bf16* WB = (bf16*)(wsq + WS_WB); bf16* WO = (bf16*)(wsq + WS_WO); bf16* WQ = (bf16*)(wsq + WS_WQ); bf16* KEYS = (bf16*)(wsq + WS_KEYS); \
    float* X = (float*)(wsq + WS_X); bf16* H = (bf16*)(wsq + WS_H); bf16* Y = (bf16*)(wsq + WS_Y); bf16* MG = (bf16*)(wsq + WS_MG); \
    unsigned* EI = (unsigned*)(wsq + WS_EI); float* EG = (float*)(wsq + WS_EG); \
    unsigned char* U8 = wsq + WS_U8; unsigned char* V8 = wsq + WS_V8; float* SCU = (float*)(wsq + WS_SCU); float* SCV = SCU + DEPTH * 16384; \
    bf16* AQ = (bf16*)(wsq + WS_AQ); bf16* AK = (bf16*)(wsq + WS_AK); bf16* AVT = (bf16*)(wsq + WS_AVT); \
    bf16* BQ = (bf16*)(wsq + WS_BQ); bf16* BK = (bf16*)(wsq + WS_BK); bf16* BVT = (bf16*)(wsq + WS_BVT); \
    bf16* CQ = (bf16*)(wsq + WS_CQ); bf16* CK = (bf16*)(wsq + WS_CK); bf16* CVT = (bf16*)(wsq + WS_CVT); \
    bf16* SG = (bf16*)(wsq + WS_SG); bf16* Q2 = (bf16*)(wsq + WS_Q2); float* SC = (float*)(wsq + WS_SC); \
    (void)MODV; (void)COS; (void)SIN; (void)WIN; (void)WB; (void)WO; (void)WQ; (void)KEYS; (void)X; (void)H; (void)Y; (void)MG; (void)EI; (void)EG; (void)U8; (void)V8; (void)SCU; (void)SCV; \
    (void)AQ; (void)AK; (void)AVT; (void)BQ; (void)BK; (void)BVT; (void)CQ; (void)CK; (void)CVT; (void)SG; (void)Q2; (void)SC; (void)IN_;
#define LAYER_PTRS const float* modl = MODV + (size_t)layer * 3 * 6 * D; const bf16* WINl = WIN + (size_t)layer * IN_W * D; (void)modl; (void)WINl;

#ifndef SKIP_P0
        { PHASE_PTRS
        for (int rep_ = 0; rep_ < REP_P0; ++rep_) {
    {
        LAS float* scr = (LAS float*)(L + wave * 16384);
        int gt = vcu * NTHREADS + tid; asm volatile("" : "+v"(gt));
        constexpr int I_IN = (D / 64) * (IN_W / 32), I_BR = (512 / 64) * (D / 32), I_O = (D / 64) * (D / 32), I_Q = (D / 64) * (2048 / 32);
        constexpr int PER_LAYER = I_IN + 3 * I_BR + I_O + I_Q;
        for (int it = gw; it < DEPTH * PER_LAYER; it += NGW) {
            const int l = it / PER_LAYER; int r = it % PER_LAYER;
            if (r < I_IN) { p0_transpose_item<true>(IN_[I_WIN] + (size_t)l * D * IN_W, D, IN_W, WIN + (size_t)l * IN_W * D, scr, r, lane); continue; } r -= I_IN;
            if (r < I_BR) { p0_transpose_item(IN_[I_WBA] + (size_t)l * 512 * D, 512, D, WB + (size_t)(l * 3 + 0) * D * 512, scr, r, lane); continue; } r -= I_BR;
            if (r < I_BR) { p0_transpose_item(IN_[I_WBB] + (size_t)l * 512 * D, 512, D, WB + (size_t)(l * 3 + 1) * D * 512, scr, r, lane); continue; } r -= I_BR;
            if (r < I_BR) { p0_transpose_item(IN_[I_WBC] + (size_t)l * 512 * D, 512, D, WB + (size_t)(l * 3 + 2) * D * 512, scr, r, lane); continue; } r -= I_BR;
            if (r < I_O) { p0_transpose_item(IN_[I_WOUT] + (size_t)l * D * D, D, D, WO + (size_t)l * D * D, scr, r, lane); continue; } r -= I_O;
            p0_transpose_item(IN_[I_PWQ] + (size_t)l * D * 2048, D, 2048, WQ + (size_t)l * 2048 * D, scr, r, lane);
        }
        for (int i = gt; i < DEPTH * 16 * 128 * 128 / 4; i += NGT) {
            const f32x4 v = *((const GAS f32x4*)IN_[I_PKEYS] + i);
            v2u o; o.x = pk2(v.x, v.y); o.y = pk2(v.z, v.w); *((GAS v2u*)KEYS + i) = o;
        }
        {
            LAS float* red = (LAS float*)(L + 9216);
            for (int it = vcu; it < DEPTH * 96; it += G) {
                const int l = it / 96, nc = it % 96, n = nc * 64 + lane;
                const float* wm = IN_[I_WMOD] + (size_t)l * D * 6 * D + n;
                float a0 = 0.f, a1 = 0.f, a2 = 0.f;
#pragma unroll 1
                for (int half = 0; half < 2; ++half) {
                    const int kb = wave * 128 + half * 64;
                    const float c0 = IN_[I_C][kb + lane], c1 = IN_[I_C][D + kb + lane], c2 = IN_[I_CCTX][kb + lane];
                    const int s0 = __builtin_bit_cast(int, c0 * sigmoidf_(c0)), s1 = __builtin_bit_cast(int, c1 * sigmoidf_(c1)), s2 = __builtin_bit_cast(int, c2 * sigmoidf_(c2));
#pragma unroll
                    for (int kk = 0; kk < 64; ++kk) {
                        const float w = wm[(size_t)(kb + kk) * 6 * D];
                        a0 += __builtin_bit_cast(float, __builtin_amdgcn_readlane(s0, kk)) * w;
                        a1 += __builtin_bit_cast(float, __builtin_amdgcn_readlane(s1, kk)) * w;
                        a2 += __builtin_bit_cast(float, __builtin_amdgcn_readlane(s2, kk)) * w;
                    }
                }
                red[(wave * 3 + 0) * 64 + lane] = a0; red[(wave * 3 + 1) * 64 + lane] = a1; red[(wave * 3 + 2) * 64 + lane] = a2;
                __syncthreads();
                if (wave < 3) {
                    float sum = IN_[I_BMOD][l * 6 * D + n];
#pragma unroll
                    for (int w = 0; w < 8; ++w) sum += red[(w * 3 + wave) * 64 + lane];
                    MODV[(size_t)(l * 3 + wave) * 6 * D + n] = sum;
                }
                __syncthreads();
            }
        }
        for (int i = gt; i < SEQ * 32; i += NGT) {
            const int t = i >> 5, f = i & 31;
            const double inv = pow(10000.0, -(double)(f & 15) / 16.0);
            const double pos = (f < 16) ? (double)(t / GRID_W) : (double)(t % GRID_W);
            const double ang = pos * inv;
            COS[i] = (float)cos(ang); SIN[i] = (float)sin(ang);
        }
    }
#pragma unroll 4
        for (int rr = gw; rr < 2 * DEPTH * 16384; rr += NGW) {
            const int tab = rr / (DEPTH * 16384), row = rr % (DEPTH * 16384);
            const float* src = (tab == 0 ? IN_[I_PU] : IN_[I_PV]) + (size_t)row * D;
            f32x4 v[4]; float am = 0.f;
#pragma unroll
            for (int j = 0; j < 4; ++j) { v[j] = *((const GAS f32x4*)src + lane + 64 * j); am = fmaxf(am, fmaxf(fmaxf(fabsf(v[j].x), fabsf(v[j].y)), fmaxf(fabsf(v[j].z), fabsf(v[j].w)))); }
            am = wave_max(am);
            int ex = 0; float scale = 1.0f;
            if (am > 0.f) { (void)frexpf(am * (1.0f / 448.0f), &ex); scale = ldexpf(1.0f, ex); }
            const float inv = 1.0f / scale;
            v4u o;
#pragma unroll
            for (int j = 0; j < 4; ++j) {
                int p = __builtin_amdgcn_cvt_pk_fp8_f32(v[j].x * inv, v[j].y * inv, 0, false);
                p = __builtin_amdgcn_cvt_pk_fp8_f32(v[j].z * inv, v[j].w * inv, p, true);
                o[j] = (unsigned)p;
            }
            *((GAS v4u*)((tab == 0 ? U8 : V8) + (size_t)row * D) + lane) = o;
            if (lane == 0) (tab == 0 ? SCU : SCV)[row] = scale;
        }
        }
        }
#endif
    GRID_BAR();

    for (int layer = 0; layer < DEPTH; ++layer) {
        const bool last = (layer == DEPTH - 1);
        const int T_EFF = last ? T_LAT : T_ALL;

#ifndef SKIP_P1
        { PHASE_PTRS LAYER_PTRS
        for (int rep_ = 0; rep_ < REP_P1; ++rep_) {
        { const int ln = lane_id_v();
        if (layer == 0)
        for (int r = gw; r < T_ALL; r += NGW) {
            const float* md = modl + (size_t)row_modidx(r) * 6 * D;
            const GAS f32x4* xr = (const GAS f32x4*)xin_row(IN_[I_X], IN_[I_CTX], r) + ln;
            f32x4 v[4]; float ss = 0.f;
#pragma unroll
            for (int j = 0; j < 4; ++j) { v[j] = xr[64 * j]; ss += (v[j].x * v[j].x + v[j].y * v[j].y) + (v[j].z * v[j].z + v[j].w * v[j].w); }
            const float rs = 1.0f / sqrtf(wave_sum(ss) * (1.f / D) + NORM_EPS);
            GAS v2u* o8 = (GAS v2u*)(H + (size_t)r * D) + ln;
#pragma unroll
            for (int j = 0; j < 4; ++j) {
                const f32x4 g = *((const GAS f32x4*)(IN_[I_G1] + layer * D) + ln + 64 * j);
                const f32x4 sh = *((const GAS f32x4*)(md + 0) + ln + 64 * j), sc = *((const GAS f32x4*)(md + D) + ln + 64 * j);
                const f32x4 h = v[j] * rs * g * (sc + 1.0f) + sh;
                v2u o; o.x = pk2(h.x, h.y); o.y = pk2(h.z, h.w); o8[64 * j] = o;
            }
        }
        }
        }
        }
#endif
        if (layer == 0) GRID_BAR();

#ifndef SKIP_P2
        { PHASE_PTRS LAYER_PTRS
        for (int rep_ = 0; rep_ < REP_P2; ++rep_) {
        {
            pg8::Gemm g{H, WINl, D, D, D, 0, 0};
            pg8::SegOrder<1> S; S.T.init(T_ALL, IN_W, G, (int)blockIdx.x);
            EpiInProj E{AQ, AK, AVT, BQ, BK, BVT, CQ, CK, CVT, SG, COS, SIN};
            pg8::gemm_phase(L, g, S, E, wave);
        }
        }
        }
#endif
        GRID_BAR();

#ifndef SKIP_P3
        { PHASE_PTRS LAYER_PTRS
        {
            LAS bf16* Pl = (LAS bf16*)(L + wave * 8192);
            const float lam_init = 0.8f - 0.6f * expf(-0.3f * (float)layer);
            float lam;
            {
                const int ll = lane_id_v();
                const float* cl = IN_[I_LAMBDA] + layer * 256;
                const float s1 = wave_sum(cl[ll] * cl[64 + ll]), s2 = wave_sum(cl[128 + ll] * cl[192 + ll]);
                lam = expf(s1) - expf(s2) + lam_init;
            }
{ const int lo__ = lane_id_v(); { const int lane = lo__; const int fr = lane & 15, fq = lane >> 4, tid = wave * 64 + lane; (void)fr; (void)fq; (void)tid;
            {
                const int r32 = lane & 31, hi = lane >> 5;
                const int n_lat = BATCH * 4 * (SEQ / 256), n_ctx = last ? 0 : BATCH * 4;
                const int NU = (n_lat + G - 1) / G * G + n_ctx;
                for (int rep_ = 0; rep_ < REP_P3C; ++rep_)
                for (int u0 = vcu; u0 < NU; u0 += G) {
                    int b, h, row0, t_lo, t_hi;
                    if (u0 < n_lat) { const int bh = u0 >> 5; b = bh >> 2; h = bh & 3; row0 = b * SEQ + (u0 & 31) * 256; t_lo = 0; t_hi = 132; }
                    else { const int c = u0 - (n_lat + G - 1) / G * G; if (c < 0 || c >= n_ctx) continue; b = c >> 2; h = c & 3; row0 = T_LAT + b * CTX; t_lo = 128; t_hi = 132; }
                    const int qrow = row0 + wave * 32 + r32;
                    LAS unsigned* o1p = (LAS unsigned*)(L + 65536 + wave * 8192) + lane;
                    const int krow_s = tid >> 3, kch_s = tid & 7;
                    const int vrow_s0 = tid >> 4, vch_s = tid & 15;
                    LAS unsigned char* Kb0 = L; LAS unsigned char* Vb0 = L + 2 * CK_SZ;
#pragma unroll 1
                    for (int m = 0; m < 2; ++m) {
                        bf16x8 qf[4];
                        { const bf16* qp = CQ + (size_t)qrow * 512 + (h * 2 + m) * 64 + hi * 8;
#pragma unroll
                          for (int ks = 0; ks < 4; ++ks) qf[ks] = *(const GAS bf16x8*)(qp + ks * 16); }
                        f32x16 o[4];
#pragma unroll
                        for (int d = 0; d < 4; ++d)
#pragma unroll
                            for (int r = 0; r < 16; ++r) o[d][r] = 0.f;
                        float mrun = -1e30f, lpart = 0.f;
                        const bf16* kg = CK + (size_t)krow_s * 512 + (h * 2 + m) * 64 + kch_s * 8;
                        const bf16* vg = CVT + (size_t)vrow_s0 * 512 + h * 128 + vch_s * 8;
                        auto tile_row = [&](int j) { return (j < 128) ? b * SEQ + 64 * j : T_LAT + b * CTX + 64 * (j - 128); };
                        __syncthreads();
                        {
                            const size_t kb = (size_t)tile_row(t_lo) * 512;
                            const v4u kr = *(const GAS v4u*)(kg + kb), v0 = *(const GAS v4u*)(vg + kb), v1 = *(const GAS v4u*)(vg + kb + 32 * 512);
                            *(LAS v4u*)(Kb0 + krow_s * CK_PITCH + kch_s * 16) = kr;
                            *(LAS v4u*)(Vb0 + vrow_s0 * CV_PITCH + vch_s * 16) = v0; *(LAS v4u*)(Vb0 + (vrow_s0 + 32) * CV_PITCH + vch_s * 16) = v1;
                        }
                        __syncthreads();
#pragma unroll 1
                        for (int j = t_lo; j < t_hi; ++j) {
                            const int cur = (j - t_lo) & 1;
                            const LAS unsigned char* Kb = Kb0 + cur * CK_SZ; const LAS unsigned char* Vb = Vb0 + cur * CV_SZ;
                            v4u kr, v0, v1;
                            const bool more = (j + 1 < t_hi);
                            { const size_t kb = (size_t)tile_row(more ? j + 1 : j) * 512; kr = *(const GAS v4u*)(kg + kb); v0 = *(const GAS v4u*)(vg + kb); v1 = *(const GAS v4u*)(vg + kb + 32 * 512); }
                            f32x16 st[2];
#pragma unroll
                            for (int kb = 0; kb < 2; ++kb) {
#pragma unroll
                                for (int r = 0; r < 16; ++r) st[kb][r] = 0.f;
#pragma unroll
                                for (int ks = 0; ks < 4; ++ks) {
                                    const bf16x8 kf = *(const LAS bf16x8*)(Kb + (kb * 32 + r32) * CK_PITCH + ks * 32 + hi * 16);
                                    st[kb] = __builtin_amdgcn_mfma_f32_32x32x16_bf16(kf, qf[ks], st[kb], 0, 0, 0);
                                }
                            }
                            float mx = st[0][0];
#pragma unroll
                            for (int r = 1; r < 16; ++r) mx = fmaxf(mx, st[0][r]);
#pragma unroll
                            for (int r = 0; r < 16; ++r) mx = fmaxf(mx, st[1][r]);
                            mx = xmax32(mx);
                            if (__builtin_amdgcn_ballot_w64(mx > mrun + C_THR_RAW) != 0ull) {
                                const float mn = fmaxf(mrun, mx);
                                const float alpha = __builtin_amdgcn_exp2f((mrun - mn) * SCL2);
#pragma unroll
                                for (int d = 0; d < 4; ++d)
#pragma unroll
                                    for (int r = 0; r < 16; ++r) o[d][r] *= alpha;
                                lpart *= alpha; mrun = mn;
                            }
                            const float nmc = -mrun * SCL2;
                            float ls = 0.f;
#pragma unroll
                            for (int kb = 0; kb < 2; ++kb)
#pragma unroll
                                for (int r = 0; r < 16; ++r) { const float p = __builtin_amdgcn_exp2f(fmaf(st[kb][r], SCL2, nmc)); st[kb][r] = p; ls += p; }
                            lpart += ls;
                            {
                                const int q4 = (lane & 15) >> 2, p4 = lane & 3, grp = (lane >> 4) & 1;
                                const LAS unsigned char* vbase = Vb + (4 * hi + q4) * CV_PITCH + (16 * grp + 4 * p4) * 2;
#pragma unroll
                                for (int kb = 0; kb < 2; ++kb)
#pragma unroll
                                    for (int ss = 0; ss < 2; ++ss) {
                                        v4u pw;
#pragma unroll
                                        for (int i2 = 0; i2 < 4; ++i2) pw[i2] = cvtpk(st[kb][8 * ss + 2 * i2], st[kb][8 * ss + 2 * i2 + 1]);
                                        const bf16x8 pb = __builtin_bit_cast(bf16x8, pw);
#pragma unroll
                                        for (int d = 0; d < 4; ++d) {
                                            const LAS unsigned char* va = vbase + (kb * 32 + 16 * ss) * CV_PITCH + d * 64;
                                            const s16x4 lo = __builtin_bit_cast(s16x4, __builtin_amdgcn_ds_read_tr16_b64_v4i16((LAS s16x4*)va));
                                            const s16x4 hh = __builtin_bit_cast(s16x4, __builtin_amdgcn_ds_read_tr16_b64_v4i16((LAS s16x4*)(va + 8 * CV_PITCH)));
                                            const bf16x8 vf = __builtin_shufflevector(lo, hh, 0, 1, 2, 3, 4, 5, 6, 7);
                                            o[d] = __builtin_amdgcn_mfma_f32_32x32x16_bf16(vf, pb, o[d], 0, 0, 0);
                                        }
                                        if (ss == 1) __builtin_amdgcn_sched_barrier(0);
                                    }
                            }
                            if (more) {
                                LAS unsigned char* Kn = Kb0 + (cur ^ 1) * CK_SZ; LAS unsigned char* Vn = Vb0 + (cur ^ 1) * CV_SZ;
                                *(LAS v4u*)(Kn + krow_s * CK_PITCH + kch_s * 16) = kr;
                                *(LAS v4u*)(Vn + vrow_s0 * CV_PITCH + vch_s * 16) = v0; *(LAS v4u*)(Vn + (vrow_s0 + 32) * CV_PITCH + vch_s * 16) = v1;
                            }
                            __syncthreads();
                        }
                        const float lt = xadd32(lpart);
                        if (m == 0) {
                            const float inv = 1.0f / lt;
#pragma unroll
                            for (int d = 0; d < 4; ++d)
#pragma unroll
                                for (int i2 = 0; i2 < 8; ++i2) o1p[64 * (d * 8 + i2)] = cvtpk(o[d][2 * i2] * inv, o[d][2 * i2 + 1] * inv);
                        } else {
                            const float inv2 = lam / lt;
                            float ssq = 0.f;
#pragma unroll
                            for (int d = 0; d < 4; ++d)
#pragma unroll
                                for (int i2 = 0; i2 < 8; ++i2) {
                                    const unsigned w1 = o1p[64 * (d * 8 + i2)];
                                    const float a0 = bf2f(w1 & 0xffffu) - o[d][2 * i2] * inv2, a1 = bf2f(w1 >> 16) - o[d][2 * i2 + 1] * inv2;
                                    o[d][2 * i2] = a0; o[d][2 * i2 + 1] = a1; ssq += a0 * a0 + a1 * a1;
                                }
                            ssq = xadd32(ssq);
                            const float rn = 1.0f / sqrtf(ssq * (1.f / 128.f) + NORM_EPS) * (1.0f - lam_init);
                            bf16* yp = Y + (size_t)qrow * 1536 + 1024 + h * 128 + 4 * hi;
                            const float* sl = IN_[I_SUBLN] + layer * 512 + h * 128 + 4 * hi;
#pragma unroll
                            for (int d = 0; d < 4; ++d)
#pragma unroll
                                for (int g4 = 0; g4 < 4; ++g4) {
                                    const f32x4 gsl = *(const GAS f32x4*)(sl + d * 32 + 8 * g4);
                                    v2u w; w.x = cvtpk(o[d][4 * g4] * rn * gsl.x, o[d][4 * g4 + 1] * rn * gsl.y); w.y = cvtpk(o[d][4 * g4 + 2] * rn * gsl.z, o[d][4 * g4 + 3] * rn * gsl.w);
                                    *(GAS v2u*)(yp + d * 32 + 8 * g4) = w;
                                }
                        }
                    }
                }
                __syncthreads();
            }
} }
{ const int lo__ = lane_id_v(); { const int lane = lo__; const int tid = wave * 64 + lane, r32 = lane & 31, hi = lane >> 5;
            {
                const int n_lat = BATCH * 2 * (SEQ / 64), n_ctx = last ? 0 : BATCH * 2 * (CTX / 64);
                for (int rep_ = 0; rep_ < REP_P3A; ++rep_)
                for (int u0 = vcu; u0 < n_lat + n_ctx; u0 += G) {
                    const bool isctx = u0 >= n_lat;
                    int b, g, p0, qrow, nl, klo;
                    if (!isctx) { b = u0 >> 8; g = (u0 >> 7) & 1; p0 = (u0 & 127) * 64; qrow = b * SEQ + p0 + (wave & 1) * 32 + r32;
                                  klo = p0 >= 128 ? 0 : (128 - p0) / 64; const int khi = min(4, (SEQ - 1 - (p0 - 128)) / 64); nl = khi - klo + 1; }
                    else { const int c = u0 - n_lat; b = c >> 3; g = (c >> 2) & 1; p0 = (c & 3) * 64; qrow = T_LAT + b * CTX + p0 + (wave & 1) * 32 + r32; nl = 0; klo = 0; }
                    const int hq = g * 4 + (wave >> 1);
                    const int qpos0 = p0 + (wave & 1) * 32;
                    bf16x8 qf[4];
                    { const bf16* qp = AQ + (size_t)qrow * 512 + hq * 64 + hi * 8;
#pragma unroll
                      for (int ks = 0; ks < 4; ++ks) qf[ks] = *(const GAS bf16x8*)(qp + ks * 16); }
                    f32x16 o[2];
#pragma unroll
                    for (int d = 0; d < 2; ++d)
#pragma unroll
                        for (int r = 0; r < 16; ++r) o[d][r] = 0.f;
                    float mrun = IN_[I_SINK][layer * 8 + hq] * 8.0f;
                    float lpart = (hi == 0) ? 1.0f : 0.0f;
                    const bf16* kg = AK + (size_t)(tid >> 3) * 128 + g * 64 + (tid & 7) * 8;
                    const bf16* vg = AVT + (size_t)(tid >> 3) * 128 + g * 64 + (tid & 7) * 8;
                    const int kp0 = p0 - 128 + 64 * klo;
                    auto tile_row = [&](int j) { return (j < nl) ? b * SEQ + kp0 + 64 * j : T_LAT + b * CTX + 64 * (j - nl); };
                    auto use_tile = [&](int j) { if (j >= nl) return true; const int kp = kp0 + 64 * j; return (kp + 63 >= qpos0 - 128) && (kp <= qpos0 + 31 + 128); };
                    auto elem = [&](f32x16 (&st)[2], int j) {
                        if (j < nl) {
                            const int dq0 = (qpos0 + r32) - (kp0 + 64 * j + 4 * hi);
#pragma unroll
                            for (int kb = 0; kb < 2; ++kb)
#pragma unroll
                                for (int r = 0; r < 16; ++r) { const int dq = dq0 - (kb * 32 + (r & 3) + 8 * (r >> 2)); if (dq > 128 || dq < -128) st[kb][r] = -1e30f; }
                        }
                    };
                    attn64_pass<2>(o, mrun, lpart, qf, kg, 128, vg, 128, nl + 4, tile_row, use_tile, elem, L, lane, tid);
                    const float lt = xadd32(lpart);
                    attn64_store(o, 1.0f / lt, Y + (size_t)qrow * 1536 + hq * 64, hi);
                }
            }
} }
{ const int lo__ = lane_id_v(); { const int lane = lo__; const int tid = wave * 64 + lane, r32 = lane & 31, hi = lane >> 5;
            {
                const int n_lat = BATCH * 8 * 32, n_ctx = last ? 0 : BATCH * 8;
                LAS float* rpbL = (LAS float*)(L + 49152);
                for (int rep_ = 0; rep_ < REP_P3B; ++rep_)
                for (int u0 = vcu; u0 < n_lat + n_ctx; u0 += G) {
                    const bool isctx = u0 >= n_lat;
                    int b, h, gr = 0, qc0 = 0, qrow, nl, krlo;
                    if (!isctx) { b = u0 >> 8; h = (u0 >> 5) & 7; const int r0 = (u0 & 31) * 4; gr = r0 + (wave >> 1); qc0 = (wave & 1) * 32; qrow = b * SEQ + gr * GRID_W + qc0 + r32;
                                  krlo = min(max(r0 - 4, 0), 120); nl = min(max(r0 - 1, 0), 120) + 8 - krlo; }
                    else { const int c = u0 - n_lat; b = c >> 3; h = c & 7; qrow = T_LAT + b * CTX + wave * 32 + r32; nl = 0; krlo = 0; }
                    __syncthreads();
                    if (tid < 465) rpbL[tid] = IN_[I_RPB][(size_t)(layer * 8 + h) * 465 + tid] * 8.0f;
                    bf16x8 qf[4];
                    { const bf16* qp = BQ + (size_t)qrow * 512 + h * 64 + hi * 8;
#pragma unroll
                      for (int ks = 0; ks < 4; ++ks) qf[ks] = *(const GAS bf16x8*)(qp + ks * 16); }
                    f32x16 o[2];
#pragma unroll
                    for (int d = 0; d < 2; ++d)
#pragma unroll
                        for (int r = 0; r < 16; ++r) o[d][r] = 0.f;
                    float mrun = -1e30f, lpart = 0.f;
                    const bf16* kg = BK + (size_t)(tid >> 3) * 512 + h * 64 + (tid & 7) * 8;
                    const bf16* vg = BVT + (size_t)(tid >> 3) * 512 + h * 64 + (tid & 7) * 8;
                    const int rs = min(max(gr - 4, 0), 120);
                    auto tile_row = [&](int j) { return (j < nl) ? b * SEQ + (krlo + j) * GRID_W : T_LAT + b * CTX + 64 * (j - nl); };
                    auto use_tile = [&](int j) { if (j >= nl) return true; const int kr = krlo + j; return kr >= rs && kr < rs + 8; };
                    auto elem = [&](f32x16 (&st)[2], int j) {
                        if (j < nl) {
                            const int qc = qc0 + r32, cstart = min(max(qc - 8, 0), 48);
                            const LAS float* brow = rpbL + (krlo + j - gr + 7) * 31 + 15;
#pragma unroll
                            for (int kb = 0; kb < 2; ++kb)
#pragma unroll
                                for (int r = 0; r < 16; ++r) {
                                    const int kc = kb * 32 + (r & 3) + 8 * (r >> 2) + 4 * hi;
                                    const bool valid = (kc >= cstart) && (kc < cstart + 16);
                                    const int dc = min(max(kc - qc, -15), 15);
                                    st[kb][r] = valid ? st[kb][r] + brow[dc] : -1e30f;
                                }
                        }
                    };
                    attn64_pass<2>(o, mrun, lpart, qf, kg, 512, vg, 512, nl + 4, tile_row, use_tile, elem, L, lane, tid);
                    const float lt = xadd32(lpart);
                    attn64_store(o, 1.0f / lt, Y + (size_t)qrow * 1536 + 512 + h * 64, hi);
                }
                __syncthreads();
            }
} }
        }
        }
#endif
        GRID_BAR();

#ifndef SKIP_P4
        { PHASE_PTRS LAYER_PTRS
        for (int rep_ = 0; rep_ < REP_P4; ++rep_) {
        {
            pg8::Gemm g{Y, WB + (size_t)layer * 3 * D * 512, 1536, 512, 512, 512, (size_t)D * 512};
            pg8::SegOrder<3> S; S.T.init(T_LAT, D, G, (int)blockIdx.x);
            EpiBranch E{SG, MG};
            pg8::gemm_phase(L, g, S, E, wave);
        }
        if (!last) { const int lo__ = lane_id_v(); { const int lane = lo__; const int fr = lane & 15, fq = lane >> 4; (void)fr; (void)fq;
            for (int it = gw; it < (T_ALL - T_LAT) / 32 * (D / 32); it += NGW) {
                const int row0 = T_LAT + (it / (D / 32)) * 32, col0 = (it % (D / 32)) * 32;
                f32x4 mg[2][2]; zero_acc22(mg);
#pragma unroll 1
                for (int seg = 0; seg < 3; ++seg) {
                    f32x4 acc[2][2]; zero_acc22(acc);
                    sgemm32<8>(acc, Y + seg * 512, 1536, WB + (size_t)(layer * 3 + seg) * D * 512, 512, 512, row0, col0, lane);
#pragma unroll
                    for (int m = 0; m < 2; ++m)
#pragma unroll
                        for (int r = 0; r < 4; ++r) {
                            const bf16* gp = SG + (size_t)(row0 + 16 * m + 4 * fq + r) * 3072 + seg * 1024 + col0 + fr;
#pragma unroll
                            for (int n = 0; n < 2; ++n) mg[m][n][r] += bf2f(gp[16 * n]) * acc[m][n][r];
                        }
                }
#pragma unroll
                for (int m = 0; m < 2; ++m)
#pragma unroll
                    for (int r = 0; r < 4; ++r) {
                        bf16* rowp = MG + (size_t)(row0 + 16 * m + 4 * fq + r) * D + col0 + fr;
#pragma unroll
                        for (int n = 0; n < 2; ++n) rowp[16 * n] = (bf16)f2bf(mg[m][n][r]);
                    }
            }
} }
        }
        }
#endif
        GRID_BAR();

#ifndef SKIP_P5
        { PHASE_PTRS LAYER_PTRS
        {
            pg8::Gemm g{MG, WO + (size_t)layer * D * D, D, D, D, 0, 0};
            pg8::SegOrder<1> S; S.T.init(T_LAT, D, G, (int)blockIdx.x);
            EpiOut E{X, modl, layer == 0 ? IN_[I_X] : nullptr, IN_[I_CTX]};
            pg8::gemm_phase(L, g, S, E, wave);
        }
        if (!last) { const int lo__ = lane_id_v(); { const int lane = lo__; const int fr = lane & 15, fq = lane >> 4; (void)fr; (void)fq;
            for (int it = gw; it < (T_ALL - T_LAT) / 32 * (D / 32); it += NGW) {
                const int row0 = T_LAT + (it / (D / 32)) * 32, col0 = (it % (D / 32)) * 32;
                f32x4 acc[2][2]; zero_acc22(acc);
                sgemm32<8>(acc, MG, D, WO + (size_t)layer * D * D, D, D, row0, col0, lane);
                const float* gt = modl + (size_t)2 * 6 * D + 2 * D + col0 + fr;
#pragma unroll
                for (int m = 0; m < 2; ++m)
#pragma unroll
                    for (int r = 0; r < 4; ++r) {
                        float* rowp = X + (size_t)(row0 + 16 * m + 4 * fq + r) * D + col0 + fr;
                        const float* srcp = (layer == 0) ? IN_[I_CTX] + (size_t)(row0 - T_LAT + 16 * m + 4 * fq + r) * D + col0 + fr : rowp;
#pragma unroll
                        for (int n = 0; n < 2; ++n) rowp[16 * n] = srcp[16 * n] + gt[16 * n] * acc[m][n][r];
                    }
            }
} }
        }
#endif
        GRID_BAR();

#ifndef SKIP_P6
        { PHASE_PTRS LAYER_PTRS
        for (int rep_ = 0; rep_ < REP_P6; ++rep_) {
        { const int ln = lane_id_v();
        for (int r = gw; r < T_EFF; r += NGW) {
            const float* md = modl + (size_t)row_modidx(r) * 6 * D;
            const GAS f32x4* xr = (const GAS f32x4*)(X + (size_t)r * D) + ln;
            f32x4 v[4]; float ss = 0.f;
#pragma unroll
            for (int j = 0; j < 4; ++j) { v[j] = xr[64 * j]; ss += (v[j].x * v[j].x + v[j].y * v[j].y) + (v[j].z * v[j].z + v[j].w * v[j].w); }
            const float rs = 1.0f / sqrtf(wave_sum(ss) * (1.f / D) + NORM_EPS);
            GAS v2u* o8 = (GAS v2u*)(H + (size_t)r * D) + ln;
#pragma unroll
            for (int j = 0; j < 4; ++j) {
                const f32x4 g = *((const GAS f32x4*)(IN_[I_G2] + layer * D) + ln + 64 * j);
                const f32x4 sh = *((const GAS f32x4*)(md + 3 * D) + ln + 64 * j), sc = *((const GAS f32x4*)(md + 4 * D) + ln + 64 * j);
                const f32x4 h = v[j] * rs * g * (sc + 1.0f) + sh;
                v2u o; o.x = pk2(h.x, h.y); o.y = pk2(h.z, h.w); o8[64 * j] = o;
            }
        }
        }
        }
        }
#endif
        GRID_BAR();

#ifndef SKIP_P7
        { PHASE_PTRS LAYER_PTRS
        for (int rep_ = 0; rep_ < REP_P7; ++rep_) {
        {
            pg8::Gemm g{H, WQ + (size_t)layer * 2048 * D, D, D, D, 0, 0};
            pg8::SegOrder<1> S; S.T.init(T_LAT, 2048, G, (int)blockIdx.x);
            EpiStore E{Q2, 2048};
            pg8::gemm_phase(L, g, S, E, wave);
        }
        if (!last) { const int lo__ = lane_id_v(); { const int lane = lo__; const int fr = lane & 15, fq = lane >> 4; (void)fr; (void)fq;
            for (int it = gw; it < (T_ALL - T_LAT) / 32 * (2048 / 32); it += NGW) {
                const int row0 = T_LAT + (it / (2048 / 32)) * 32, col0 = (it % (2048 / 32)) * 32;
                f32x4 acc[2][2]; zero_acc22(acc);
                sgemm32<8>(acc, H, D, WQ + (size_t)layer * 2048 * D, D, D, row0, col0, lane);
#pragma unroll
                for (int m = 0; m < 2; ++m)
#pragma unroll
                    for (int r = 0; r < 4; ++r) {
                        bf16* rowp = Q2 + (size_t)(row0 + 16 * m + 4 * fq + r) * 2048 + col0 + fr;
#pragma unroll
                        for (int n = 0; n < 2; ++n) rowp[16 * n] = (bf16)f2bf(acc[m][n][r]);
                    }
            }
} }
        }
        }
#endif
        GRID_BAR();

#ifndef SKIP_P8
        { PHASE_PTRS LAYER_PTRS
        for (int rep_ = 0; rep_ < REP_P8; ++rep_) {
{ const int lo__ = lane_id_v(); { const int lane = lo__; const int fr = lane & 15, fq = lane >> 4, tid = wave * 64 + lane; (void)fr; (void)fq; (void)tid;
        {
            const int NMT = T_EFF / 256; constexpr int NNT = 2048 / 128;
            const int wr = wave >> 1, wc = wave & 1;
            for (int it = vcu; it < NMT * NNT; it += G) {
                const int pm = it / NNT, grp = it % NNT;
                const int row0 = pm * 256 + wr * 64, c0 = wc * 64;
                f32x4 acc[4][4]; zero_acc<4>(acc);
                sgemm_tile(acc, Q2 + grp * 128, 2048, KEYS + (size_t)(layer * 16 + grp) * 128 * 128, 128, 128, row0, c0, lane);
#pragma unroll
                for (int m = 0; m < 4; ++m)
#pragma unroll
                    for (int r = 0; r < 4; ++r) {
                        float* rowp = SC + (size_t)(row0 + 16 * m + 4 * fq + r) * 2048 + grp * 128 + c0 + fr;
#pragma unroll
                        for (int n = 0; n < 4; ++n) rowp[16 * n] = acc[m][n][r];
                    }
            }
        }
} }
        }
        }
#endif
        GRID_BAR();

#ifndef SKIP_P9
        { PHASE_PTRS LAYER_PTRS
        for (int rep_ = 0; rep_ < REP_P9; ++rep_) {
{ const int lo__ = lane_id_v(); { const int lane = lo__; const int fr = lane & 15, fq = lane >> 4, tid = wave * 64 + lane; (void)fr; (void)fq; (void)tid;
        for (int it = vcu * NTHREADS + tid; it < T_EFF * PEER_HEADS; it += NGT) {
            const int t = it >> 3, hh = it & 7;
            const float* sc = SC + (size_t)t * 2048 + hh * 256;
            int a0[16], a1[16];
#define LOAD_CHUNK(v, base, ch) _Pragma("unroll") for (int q = 0; q < 4; ++q) { const f32x4 x = *(const GAS f32x4*)((base) + (ch) * 16 + 4 * q); \
                    v[4 * q + 0] = (f2ord(x.x) & ~127) | ((ch) * 16 + 4 * q + 0); v[4 * q + 1] = (f2ord(x.y) & ~127) | ((ch) * 16 + 4 * q + 1); \
                    v[4 * q + 2] = (f2ord(x.z) & ~127) | ((ch) * 16 + 4 * q + 2); v[4 * q + 3] = (f2ord(x.w) & ~127) | ((ch) * 16 + 4 * q + 3); }
            LOAD_CHUNK(a0, sc, 0) sort16_desc(a0);
#pragma unroll 1
            for (int ch = 1; ch < 8; ++ch) { int v[16]; LOAD_CHUNK(v, sc, ch) sort16_desc(v); merge16_desc(a0, v); }
            LOAD_CHUNK(a1, sc + 128, 0) sort16_desc(a1);
#pragma unroll 1
            for (int ch = 1; ch < 8; ++ch) { int v[16]; LOAD_CHUNK(v, sc + 128, ch) sort16_desc(v); merge16_desc(a1, v); }
#undef LOAD_CHUNK
            float va[16], vb[16];
#pragma unroll
            for (int i = 0; i < 16; ++i) { va[i] = ord2f(a0[i] & ~127); vb[i] = ord2f(a1[i] & ~127); }
            int c[16];
            {
                int v[16];
                v[0] = (f2ord(va[0] + vb[0]) & ~255) | 0;
                v[1] = (f2ord(va[0] + vb[1]) & ~255) | 1;
                v[2] = (f2ord(va[0] + vb[2]) & ~255) | 2;
                v[3] = (f2ord(va[0] + vb[3]) & ~255) | 3;
                v[4] = (f2ord(va[0] + vb[4]) & ~255) | 4;
                v[5] = (f2ord(va[0] + vb[5]) & ~255) | 5;
                v[6] = (f2ord(va[0] + vb[6]) & ~255) | 6;
                v[7] = (f2ord(va[0] + vb[7]) & ~255) | 7;
                v[8] = (f2ord(va[0] + vb[8]) & ~255) | 8;
                v[9] = (f2ord(va[0] + vb[9]) & ~255) | 9;
                v[10] = (f2ord(va[0] + vb[10]) & ~255) | 10;
                v[11] = (f2ord(va[0] + vb[11]) & ~255) | 11;
                v[12] = (f2ord(va[0] + vb[12]) & ~255) | 12;
                v[13] = (f2ord(va[0] + vb[13]) & ~255) | 13;
                v[14] = (f2ord(va[0] + vb[14]) & ~255) | 14;
                v[15] = (f2ord(va[0] + vb[15]) & ~255) | 15;
                sort16_desc(v);
#pragma unroll
                for (int i = 0; i < 16; ++i) c[i] = v[i];
            }
            {
                int v[16];
                v[0] = (f2ord(va[1] + vb[0]) & ~255) | 16;
                v[1] = (f2ord(va[1] + vb[1]) & ~255) | 17;
                v[2] = (f2ord(va[1] + vb[2]) & ~255) | 18;
                v[3] = (f2ord(va[1] + vb[3]) & ~255) | 19;
                v[4] = (f2ord(va[1] + vb[4]) & ~255) | 20;
                v[5] = (f2ord(va[1] + vb[5]) & ~255) | 21;
                v[6] = (f2ord(va[1] + vb[6]) & ~255) | 22;
                v[7] = (f2ord(va[1] + vb[7]) & ~255) | 23;
                v[8] = (f2ord(va[2] + vb[0]) & ~255) | 32;
                v[9] = (f2ord(va[2] + vb[1]) & ~255) | 33;
                v[10] = (f2ord(va[2] + vb[2]) & ~255) | 34;
                v[11] = (f2ord(va[2] + vb[3]) & ~255) | 35;
                v[12] = (f2ord(va[2] + vb[4]) & ~255) | 36;
                v[13] = (f2ord(va[3] + vb[0]) & ~255) | 48;
                v[14] = (f2ord(va[3] + vb[1]) & ~255) | 49;
                v[15] = (f2ord(va[3] + vb[2]) & ~255) | 50;
                sort16_desc(v);
                merge16_desc(c, v);
            }
            {
                int v[16];
                v[0] = (f2ord(va[3] + vb[3]) & ~255) | 51;
                v[1] = (f2ord(va[4] + vb[0]) & ~255) | 64;
                v[2] = (f2ord(va[4] + vb[1]) & ~255) | 65;
                v[3] = (f2ord(va[4] + vb[2]) & ~255) | 66;
                v[4] = (f2ord(va[5] + vb[0]) & ~255) | 80;
                v[5] = (f2ord(va[5] + vb[1]) & ~255) | 81;
                v[6] = (f2ord(va[6] + vb[0]) & ~255) | 96;
                v[7] = (f2ord(va[6] + vb[1]) & ~255) | 97;
                v[8] = (f2ord(va[7] + vb[0]) & ~255) | 112;
                v[9] = (f2ord(va[7] + vb[1]) & ~255) | 113;
                v[10] = (f2ord(va[8] + vb[0]) & ~255) | 128;
                v[11] = (f2ord(va[9] + vb[0]) & ~255) | 144;
                v[12] = (f2ord(va[10] + vb[0]) & ~255) | 160;
                v[13] = (f2ord(va[11] + vb[0]) & ~255) | 176;
                v[14] = (f2ord(va[12] + vb[0]) & ~255) | 192;
                v[15] = (f2ord(va[13] + vb[0]) & ~255) | 208;
                sort16_desc(v);
                merge16_desc(c, v);
            }
            {
                int v[16];
                v[0] = (f2ord(va[14] + vb[0]) & ~255) | 224;
                v[1] = (f2ord(va[15] + vb[0]) & ~255) | 240;
                v[2] = (int)0x80000000;
                v[3] = (int)0x80000000;
                v[4] = (int)0x80000000;
                v[5] = (int)0x80000000;
                v[6] = (int)0x80000000;
                v[7] = (int)0x80000000;
                v[8] = (int)0x80000000;
                v[9] = (int)0x80000000;
                v[10] = (int)0x80000000;
                v[11] = (int)0x80000000;
                v[12] = (int)0x80000000;
                v[13] = (int)0x80000000;
                v[14] = (int)0x80000000;
                v[15] = (int)0x80000000;
                sort16_desc(v);
                merge16_desc(c, v);
            }
            const float smax = ord2f(c[0] & ~255);
            float pe[16]; float psum = 0.f;
#pragma unroll
            for (int k = 0; k < 16; ++k) { pe[k] = __expf(ord2f(c[k] & ~255) - smax); psum += pe[k]; }
            const float ip = 1.0f / psum;
#pragma unroll
            for (int k = 0; k < 16; ++k) {
                const int ij = c[k] & 255, ii = ij >> 4, jj = ij & 15;
                int e0 = 0, e1 = 0;
#pragma unroll
                for (int q = 0; q < 16; ++q) { e0 = (ii == q) ? (a0[q] & 127) : e0; e1 = (jj == q) ? (a1[q] & 127) : e1; }
                const int e = e0 * PEER_KEYS + e1;
                const float su = SCU[layer * 16384 + e], sv = SCV[layer * 16384 + e];
                EI[(size_t)t * NSEL + hh * 16 + k] = (unsigned)e | (f2bf(su) << 16);
                EG[(size_t)t * NSEL + hh * 16 + k] = pe[k] * ip * sv;
                if ((k & 3) == 3) __builtin_amdgcn_sched_barrier(0);
            }
        }
} }
        }
        }
#endif
        GRID_BAR();

#ifndef SKIP_P10
        { PHASE_PTRS LAYER_PTRS
        { const int ln = lane_id_v();
        {
            const unsigned char* U8l = U8 + (size_t)layer * 16384 * D;
            const unsigned char* V8l = V8 + (size_t)layer * 16384 * D;
            for (int rep_ = 0; rep_ < REP_P10; ++rep_)
            for (int t = gw; t < T_EFF; t += NGW) {
                f32x4 hv[4];
                { const GAS v2u* hp = (const GAS v2u*)(H + (size_t)t * D) + ln;
#pragma unroll
                  for (int j = 0; j < 4; ++j) { const v2u w = hp[64 * j]; hv[j] = (f32x4){bf2f(w.x & 0xffffu), bf2f(w.x >> 16), bf2f(w.y & 0xffffu), bf2f(w.y >> 16)}; } }
                f32x4 o[4];
#pragma unroll
                for (int j = 0; j < 4; ++j) o[j] = (f32x4){0.f, 0.f, 0.f, 0.f};
#pragma unroll 1
                for (int s0 = 0; s0 < NSEL; s0 += 32) {
                    const unsigned esu = EI[(size_t)t * NSEL + s0 + (ln & 31)]; const float gv = EG[(size_t)t * NSEL + s0 + (ln & 31)];
                    int eidx = (int)(esu & 0xffffu); const float su = bf2f(esu >> 16);
                    float p[32];
                    {
                        v4u rowa[8], rowb[8];
#pragma unroll
                        for (int q = 0; q < 8; ++q) { const int e = __builtin_amdgcn_readlane(eidx, q); rowa[q] = *((const GAS v4u*)(U8l + (size_t)e * D) + ln); }
#pragma unroll
                        for (int g = 0; g < 4; ++g) {
                            if (g < 3) {
#pragma unroll
                                for (int q = 0; q < 8; ++q) { const int e = __builtin_amdgcn_readlane(eidx, (g + 1) * 8 + q);
                                    if (g & 1) rowa[q] = *((const GAS v4u*)(U8l + (size_t)e * D) + ln); else rowb[q] = *((const GAS v4u*)(U8l + (size_t)e * D) + ln); }
                            }
                            __builtin_amdgcn_sched_barrier(0);
#pragma unroll
                            for (int q = 0; q < 8; ++q) {
                                const v4u rw = (g & 1) ? rowb[q] : rowa[q];
                                float dd = 0.f;
#pragma unroll
                                for (int j = 0; j < 4; ++j) {
                                    const f32x2 a = __builtin_amdgcn_cvt_pk_f32_fp8((int)rw[j], false), b = __builtin_amdgcn_cvt_pk_f32_fp8((int)rw[j], true);
                                    dd += (a.x * hv[j].x + a.y * hv[j].y) + (b.x * hv[j].z + b.y * hv[j].w);
                                }
                                asm volatile("" : "+v"(dd));
                                p[g * 8 + q] = dd;
                                __builtin_amdgcn_sched_barrier(0);
                            }
                        }
                    }
#define TR_STEP(W) { const bool up = (ln & W) != 0; _Pragma("unroll") for (int i = 0; i < W; ++i) { const float send = up ? p[i] : p[i + W], keep = up ? p[i + W] : p[i]; p[i] = keep + xshfl_l<W>(send, ln); } }
                    TR_STEP(16) TR_STEP(8) TR_STEP(4) TR_STEP(2) TR_STEP(1)
#undef TR_STEP
                    const float dot = (p[0] + xshfl_l<32>(p[0], ln)) * su;
                    float wgt = 0.5f * dot * (1.0f + erff(dot * 0.70710678118654752f)) * gv;
                    asm volatile("" : "+v"(eidx), "+v"(wgt));
                    {
                        v4u rowa[8], rowb[8];
#pragma unroll
                        for (int q = 0; q < 8; ++q) { const int e = __builtin_amdgcn_readlane(eidx, q); rowa[q] = *((const GAS v4u*)(V8l + (size_t)e * D) + ln); }
#pragma unroll
                        for (int g = 0; g < 4; ++g) {
                            if (g < 3) {
#pragma unroll
                                for (int q = 0; q < 8; ++q) { const int e = __builtin_amdgcn_readlane(eidx, (g + 1) * 8 + q);
                                    if (g & 1) rowa[q] = *((const GAS v4u*)(V8l + (size_t)e * D) + ln); else rowb[q] = *((const GAS v4u*)(V8l + (size_t)e * D) + ln); }
                            }
                            __builtin_amdgcn_sched_barrier(0);
#pragma unroll
                            for (int q = 0; q < 8; ++q) {
                                const v4u rw = (g & 1) ? rowb[q] : rowa[q];
                                const float wq = __builtin_bit_cast(float, __builtin_amdgcn_readlane(__builtin_bit_cast(int, wgt), g * 8 + q));
#pragma unroll
                                for (int j = 0; j < 4; ++j) {
                                    const f32x2 a = __builtin_amdgcn_cvt_pk_f32_fp8((int)rw[j], false), b = __builtin_amdgcn_cvt_pk_f32_fp8((int)rw[j], true);
                                    o[j].x += wq * a.x; o[j].y += wq * a.y; o[j].z += wq * b.x; o[j].w += wq * b.y;
                                }
                                asm volatile("" : "+v"(o[0]), "+v"(o[1]), "+v"(o[2]), "+v"(o[3]));
                                __builtin_amdgcn_sched_barrier(0);
                            }
                        }
                    }
                }
                const float* gt2 = modl + (size_t)row_modidx(t) * 6 * D + 5 * D;
                GAS f32x4* xr = (GAS f32x4*)(X + (size_t)t * D) + ln;
                f32x4 xn[4]; float ss = 0.f;
#pragma unroll
                for (int j = 0; j < 4; ++j) {
                    xn[j] = xr[64 * j] + *((const GAS f32x4*)gt2 + ln + 64 * j) * o[j];
                    ss += (xn[j].x * xn[j].x + xn[j].y * xn[j].y) + (xn[j].z * xn[j].z + xn[j].w * xn[j].w);
                }
                if (REP_P10 > 1 && rep_ + 1 < REP_P10 && ss != 1234.5678f) continue;
                if (!last) {
#pragma unroll
                    for (int j = 0; j < 4; ++j) xr[64 * j] = xn[j];
                    const float rs1 = 1.0f / sqrtf(wave_sum(ss) * (1.f / D) + NORM_EPS);
                    const float* md1 = modl + (size_t)(3 + row_modidx(t)) * 6 * D;
                    GAS v2u* o8 = (GAS v2u*)(H + (size_t)t * D) + ln;
#pragma unroll
                    for (int j = 0; j < 4; ++j) {
                        const f32x4 g = *((const GAS f32x4*)(IN_[I_G1] + (layer + 1) * D) + ln + 64 * j);
                        const f32x4 sh = *((const GAS f32x4*)(md1 + 0) + ln + 64 * j), sc = *((const GAS f32x4*)(md1 + D) + ln + 64 * j);
                        const f32x4 hh = xn[j] * rs1 * g * (sc + 1.0f) + sh;
                        v2u o; o.x = pk2(hh.x, hh.y); o.y = pk2(hh.z, hh.w); o8[64 * j] = o;
                    }
                } else {
                    const float rs = 1.0f / sqrtf(wave_sum(ss) * (1.f / D) + NORM_EPS);
                    GAS f32x4* op = (GAS f32x4*)(((float*)IN_[22]) + (size_t)t * D) + ln;
#pragma unroll
                    for (int j = 0; j < 4; ++j) op[64 * j] = xn[j] * rs * *((const GAS f32x4*)IN_[I_GFINAL] + ln + 64 * j);
                }
            }
        }
        }
        }
#endif
        if (!last) GRID_BAR();
    }
}

extern "C" void kernel_launch(void* const* d_in, const int* in_sizes, int n_in, void* d_out, int out_size, void* d_ws, size_t ws_size, hipStream_t stream) {
    static int grid = 0;
    if (grid == 0) {
        if (n_in != 22 || out_size != T_LAT * D || ws_size < WS_END) { fprintf(stderr, "kernel_launch: unexpected shapes: n_in %d out %d ws %zu (need %zu)\n", n_in, out_size, ws_size, (size_t)WS_END); grid = -1; return; }
        int dev = 0, cus = 0, per_cu = 0;
        if (hipGetDevice(&dev) != hipSuccess || hipDeviceGetAttribute(&cus, hipDeviceAttributeMultiprocessorCount, dev) != hipSuccess) { fprintf(stderr, "device query failed\n"); grid = -1; return; }
        if (hipFuncSetAttribute((const void*)mega_fwd, hipFuncAttributeMaxDynamicSharedMemorySize, LDS_BYTES) != hipSuccess) { fprintf(stderr, "hipFuncSetAttribute failed\n"); grid = -1; return; }
        if (hipOccupancyMaxActiveBlocksPerMultiprocessor(&per_cu, (const void*)mega_fwd, NTHREADS, LDS_BYTES) != hipSuccess || per_cu < 1) { fprintf(stderr, "occupancy query: %d\n", per_cu); }
        (void)hipGetLastError();
        grid = cus;
    }
    if (grid < 0) return;
    if (hipMemsetAsync((char*)d_ws + WS_CTL, 0, CTL_ZERO_BYTES, stream) != hipSuccess) { fprintf(stderr, "memset failed\n"); return; }
    Args a{};
    for (int i = 0; i < 22; ++i) a.in[i] = (const float*)d_in[i];
    a.out = (float*)d_out; a.ws = (unsigned char*)d_ws;
    hipLaunchKernelGGL(mega_fwd, dim3(grid), dim3(NTHREADS), LDS_BYTES, stream, a);
}
```

```cpp
#include <hip/hip_runtime.h>
#include <cstdio>
#include <cstdint>

#ifndef REP_P0
#define REP_P0 1
#endif
#ifndef REP_P1
#define REP_P1 1
#endif
#ifndef REP_P2
#define REP_P2 1
#endif
#ifndef REP_P3A
#define REP_P3A 1
#endif
#ifndef REP_P3B
#define REP_P3B 1
#endif
#ifndef REP_P4
#define REP_P4 1
#endif
#ifndef REP_P6
#define REP_P6 1
#endif
#ifndef REP_P7
#define REP_P7 1
#endif
#ifndef REP_P8
#define REP_P8 1
#endif
#ifndef REP_P9
#define REP_P9 1
#endif
#ifndef REP_P10
#define REP_P10 1
#endif
#ifndef REP_P10A
#define REP_P10A 1
#endif
#ifndef REP_P10C
#define REP_P10C 1
#endif
#ifndef REP_P10B
#define REP_P10B 1
#endif
#ifndef REP_P0A
#define REP_P0A 1
#endif
#ifndef REP_P0D
#define REP_P0D 1
#endif
#ifndef REP_P0F
#define REP_P0F 1
#endif
#ifndef REP_P3C
#define REP_P3C 1
#endif
#define GAS __attribute__((address_space(1)))
#define LAS __attribute__((address_space(3)))
typedef unsigned short bf16;
typedef float f32x4 __attribute__((ext_vector_type(4)));
typedef short bf16x8 __attribute__((ext_vector_type(8)));
typedef unsigned v4u __attribute__((ext_vector_type(4)));
typedef unsigned v2u __attribute__((ext_vector_type(2)));
typedef float f32x2 __attribute__((ext_vector_type(2)));
typedef GAS unsigned gu32;

constexpr int NWAVES = 8, NTHREADS = 512;
constexpr int D = 1024, BATCH = 2, SEQ = 8192, DEPTH = 2, GRID_W = 64, CTX = 256;
constexpr int T_LAT = BATCH * SEQ;
constexpr int T_ALL = T_LAT + BATCH * CTX;
constexpr int NTOK = SEQ + CTX;
constexpr int IN_W = 6912;
constexpr int PEER_HEADS = 8, PEER_KEYS = 128, PEER_TOPK = 16, NSEL = PEER_HEADS * PEER_TOPK;
constexpr float NORM_EPS = 1e-6f;
constexpr float LOG2E = 1.4426950408889634f;
constexpr float SCL2 = 0.125f * LOG2E;

constexpr size_t MiB = 1u << 20;
constexpr size_t WS_CTL = 0, CTL_ZERO_BYTES = 1 * MiB;
constexpr int CW_BAR = 4096;
constexpr int CW_RANK = 8192;
#ifndef P10_SLICED
#define P10_SLICED 1
#endif
constexpr size_t WS_MOD = 65536;
constexpr size_t WS_COS = 2 * MiB, WS_SIN = 3 * MiB;
constexpr size_t WS_WIN = 4 * MiB;
constexpr size_t WS_WB = 31 * MiB;
constexpr size_t WS_WO = 37 * MiB;
constexpr size_t WS_WQ = 41 * MiB;
constexpr size_t WS_KEYS = 49 * MiB;
constexpr size_t WS_X = 50 * MiB;
constexpr size_t WS_H = 116 * MiB;
constexpr size_t WS_Y = 149 * MiB;
constexpr size_t WS_MG = WS_H;
constexpr size_t WS_U8 = 199 * MiB;
constexpr size_t WS_SCU = 231 * MiB;
constexpr size_t WS_EI = 232 * MiB;
constexpr size_t WS_EG = 241 * MiB;
constexpr size_t WS_P = 250 * MiB;
constexpr size_t SZ_R512 = (size_t)T_ALL * 512 * 2;
constexpr size_t SZ_R128 = (size_t)T_ALL * 128 * 2;
constexpr size_t WS_AQ = WS_P, WS_AK = WS_AQ + SZ_R512, WS_AVT = WS_AK + SZ_R128, WS_BQ = WS_AVT + SZ_R128, WS_BK = WS_BQ + SZ_R512,
                 WS_BVT = WS_BK + SZ_R512, WS_CQ = WS_BVT + SZ_R512, WS_CK = WS_CQ + SZ_R512, WS_CVT = WS_CK + SZ_R512, WS_SG = WS_CVT + SZ_R512;
constexpr size_t WS_Q2 = WS_P;
constexpr size_t WS_SC = WS_P + 66 * MiB;
constexpr size_t WS_PART = WS_P, WS_XO = WS_P + 66 * MiB, WS_WGT = WS_P + 132 * MiB;
constexpr size_t WS_PEND = WS_SG + (size_t)T_ALL * 3072 * 2;
constexpr size_t WS_V8 = 473 * MiB;
constexpr size_t WS_END = WS_V8 + 32 * MiB;
static_assert(WS_SC + (size_t)T_ALL * 2048 * 4 <= WS_PEND && WS_PEND <= WS_V8, "alias map");
static_assert(WS_END <= 512 * MiB, "ws map");

constexpr int LDS_BYTES = 147456;
constexpr int MISC_OFF = 131072 + 320;

__device__ __forceinline__ int lane_id_v() { int l; asm volatile("v_mbcnt_lo_u32_b32 %0, -1, 0\n\tv_mbcnt_hi_u32_b32 %0, -1, %0" : "=v"(l)); return l; }
#define XB_TMO      128
#define XB_XCNT(j)  (256  + 64 * (j))
#define XB_XSUB(j)  (1280 + 64 * (j))
#define XB_XGEN(j)  (2304 + 64 * (j))
#define XB_TOP      3328
#define XB_TOPGEN   3392
#define XCD_BAR_WORDS 3456
#define XB_SPIN_CAP (1u << 24)

__device__ __forceinline__ unsigned xb_ld(unsigned* p)              { return __hip_atomic_load(p, __ATOMIC_RELAXED, __HIP_MEMORY_SCOPE_AGENT); }
__device__ __forceinline__ unsigned xb_add(unsigned* p, unsigned v) { return __hip_atomic_fetch_add(p, v, __ATOMIC_RELAXED, __HIP_MEMORY_SCOPE_AGENT); }
__device__ __forceinline__ unsigned xb_xcc_id() { return (unsigned)__builtin_amdgcn_s_getreg((3 << 11) | 20) & 0xFu; }
#define XB_SPIN(cond, bar) do { unsigned _sp = 0; while (cond) { __builtin_amdgcn_s_sleep(1); \
    if ((++_sp & 255u) == 0u) { if (xb_ld(&(bar)[XB_TMO])) break; if (_sp > XB_SPIN_CAP) { atomicAdd(&(bar)[XB_TMO], 1u); break; } } } } while (0)

struct XcdBarrier { unsigned* bar; unsigned x; volatile LAS unsigned* st; };

__device__ __forceinline__ XcdBarrier xcd_barrier_post(unsigned* bar, volatile LAS unsigned* st) {
    XcdBarrier b; b.bar = bar; b.x = xb_xcc_id(); b.st = st;
    if (threadIdx.x == 0) (void)xb_add(&bar[XB_XCNT(b.x)], 1u);
    return b;
}
__device__ __forceinline__ void xcd_barrier_complete(unsigned* bar, unsigned x, unsigned& nloc, unsigned& nx) {
    const unsigned G = gridDim.x * gridDim.y * gridDim.z;
    unsigned sum, cnt, mine, sp = 0u;
    for (;;) {
        sum = 0u; cnt = 0u; mine = 0u;
#pragma unroll
        for (unsigned j = 0; j < 16; ++j) { const unsigned c = xb_ld(&bar[XB_XCNT(j)]); sum += c; cnt += (c > 0u) ? 1u : 0u; mine = (j == x) ? c : mine; }
        if (sum == G) break;
        __builtin_amdgcn_s_sleep(1);
        if ((++sp & 255u) == 0u) { if (xb_ld(&bar[XB_TMO])) break; if (sp > XB_SPIN_CAP) { atomicAdd(&bar[XB_TMO], 1u); break; } }
    }
    nloc = mine > 0u ? mine : 1u; nx = cnt > 0u ? cnt : 1u;
}
__device__ __forceinline__ void xcd_barrier(const XcdBarrier& b, bool t0) {
    asm volatile("s_waitcnt vmcnt(0)" ::: "memory");
    __syncthreads();
    if (t0) {
        unsigned* bar = b.bar;
        __builtin_amdgcn_s_waitcnt(0);
        unsigned nloc = b.st[0], nx = b.st[1];
        if (nloc == 0u) { xcd_barrier_complete(bar, b.x, nloc, nx); b.st[0] = nloc; b.st[1] = nx; }
        const unsigned old = xb_add(&bar[XB_XSUB(b.x)], 1u);
        const unsigned gen = old / nloc;
        if (old + 1u == (gen + 1u) * nloc) {
            __builtin_amdgcn_fence(__ATOMIC_RELEASE, "agent");
            asm volatile("s_waitcnt vmcnt(0)" ::: "memory");
            const unsigned og = xb_add(&bar[XB_TOP], 1u);
            const unsigned tg = og / nx;
            if (og + 1u == (tg + 1u) * nx) xb_add(&bar[XB_TOPGEN], 1u);
            else XB_SPIN(xb_ld(&bar[XB_TOPGEN]) == tg, bar);
            __builtin_amdgcn_fence(__ATOMIC_ACQUIRE, "agent");
            xb_add(&bar[XB_XGEN(b.x)], 1u);
            asm volatile("s_waitcnt vmcnt(0)" ::: "memory");
        } else {
            XB_SPIN(xb_ld(&bar[XB_XGEN(b.x)]) == gen, bar);
            __builtin_amdgcn_fence(__ATOMIC_ACQUIRE, "agent");
            asm volatile("s_waitcnt vmcnt(0)" ::: "memory");
        }
    }
    __syncthreads();
}

__device__ __forceinline__ unsigned f2bf(float f) { unsigned u = __builtin_bit_cast(unsigned, f); return (u + 0x7fffu + ((u >> 16) & 1u)) >> 16; }
__device__ __forceinline__ unsigned pk2(float lo, float hi) { return f2bf(lo) | (f2bf(hi) << 16); }
__device__ __forceinline__ float bf2f(unsigned h) { return __builtin_bit_cast(float, h << 16); }
template <int CTRL> __device__ __forceinline__ float dpp_mov(float v) { return __builtin_bit_cast(float, __builtin_amdgcn_update_dpp(0, __builtin_bit_cast(int, v), CTRL, 0xF, 0xF, true)); }
__device__ __forceinline__ float sum8_dpp(float v) { v += dpp_mov<0xB1>(v); v += dpp_mov<0x4E>(v); v += dpp_mov<0x141>(v); return v; }
template <int K> __device__ __forceinline__ float xshfl_l(float v, int lane) { return __builtin_bit_cast(float, __builtin_amdgcn_ds_bpermute((lane ^ K) << 2, __builtin_bit_cast(int, v))); }
template <int K> __device__ __forceinline__ float xshfl(float v) { return xshfl_l<K>(v, lane_id_v()); }
__device__ __forceinline__ float xadd32(float v) { return v + xshfl_l<32>(v, lane_id_v()); }
__device__ __forceinline__ float xmax32(float v) { return fmaxf(v, xshfl_l<32>(v, lane_id_v())); }
__device__ __forceinline__ float wave_sum(float v) { const int l = lane_id_v(); v += xshfl_l<1>(v, l); v += xshfl_l<2>(v, l); v += xshfl_l<4>(v, l); v += xshfl_l<8>(v, l); v += xshfl_l<16>(v, l); v += xshfl_l<32>(v, l); return v; }
__device__ __forceinline__ float wave_max(float v) { const int l = lane_id_v(); v = fmaxf(v, xshfl_l<1>(v, l)); v = fmaxf(v, xshfl_l<2>(v, l)); v = fmaxf(v, xshfl_l<4>(v, l)); v = fmaxf(v, xshfl_l<8>(v, l)); v = fmaxf(v, xshfl_l<16>(v, l)); v = fmaxf(v, xshfl_l<32>(v, l)); return v; }


__device__ __forceinline__ float sigmoidf_(float x) { return 1.0f / (1.0f + __expf(-x)); }
__device__ __forceinline__ float sigmoid_fast(float x) { return __builtin_amdgcn_rcpf(1.0f + __builtin_amdgcn_exp2f(-LOG2E * x)); }
__device__ __forceinline__ int row_modidx(int r) { return r < T_LAT ? (r >> 13) : 2; }
__device__ __forceinline__ int row_batch(int r) { return r < T_LAT ? (r >> 13) : ((r - T_LAT) >> 8); }
__device__ __forceinline__ int row_tok(int r) { return r < T_LAT ? (r & (SEQ - 1)) : SEQ + ((r - T_LAT) & (CTX - 1)); }

__device__ __forceinline__ const float* xin_row(const float* x, const float* ctx, int r) { return r < T_LAT ? x + (size_t)r * D : ctx + (size_t)(r - T_LAT) * D; }
struct Args { const float* in[22]; float* out; unsigned char* ws; };
enum { I_X = 0, I_C, I_CTX, I_CCTX, I_WMOD, I_BMOD, I_G1, I_G2, I_WIN, I_SINK, I_RPB, I_LAMBDA, I_SUBLN, I_WBA, I_WBB, I_WBC, I_WOUT, I_PWQ, I_PKEYS, I_PU, I_PV, I_GFINAL };

__device__ __forceinline__ int rope_perm(int c) {
    if (c < 640 || (c >= 2304 && c < 3328)) { const int w = c & 63; return (c & ~63) + 2 * (w & 31) + (w >> 5); }
    return c;
}
template <bool PERM = false>
__device__ __forceinline__ void p0_transpose_item(const float* W, int K, int N, bf16* WT, LAS float* scr, int item, int lane) {
    const int nblk = N / 32, kb = item / nblk, nb = item % nblk, k0 = 64 * kb, n0 = 32 * nb;
#pragma unroll 8
    for (int i = 0; i < 32; ++i) { const int kk = 2 * i + (lane >> 5); scr[kk * 33 + (lane & 31)] = W[(size_t)(k0 + kk) * N + n0 + (lane & 31)]; }
    asm volatile("s_waitcnt lgkmcnt(0)" ::: "memory");
    const int c = lane & 7;
#pragma unroll
    for (int j = 0; j < 4; ++j) { const int n = (lane >> 3) + 8 * j; const LAS float* s = scr + (8 * c) * 33 + n;
        v4u o; o.x = pk2(s[0 * 33], s[1 * 33]); o.y = pk2(s[2 * 33], s[3 * 33]); o.z = pk2(s[4 * 33], s[5 * 33]); o.w = pk2(s[6 * 33], s[7 * 33]);
        const int nout = PERM ? rope_perm(n0 + n) : (n0 + n);
        *(GAS v4u*)(WT + (size_t)nout * K + k0 + 8 * c) = o; }
    asm volatile("s_waitcnt lgkmcnt(0)" ::: "memory");
}

template <int UNR = 2, int NN = 4>
__device__ __forceinline__ void sgemm_tile(f32x4 (&acc)[4][NN], const bf16* A, int lda, const bf16* Bt, int ldb, int K, int row0, int col0, int lane) {
    const int fr = lane & 15, fq = lane >> 4;
    const bf16* ap = A + (size_t)(row0 + fr) * lda + fq * 8;
    const bf16* bp = Bt + (size_t)(col0 + fr) * ldb + fq * 8;
#pragma unroll UNR
    for (int k = 0; k < K; k += 32) {
        bf16x8 a[4], b[NN];
#pragma unroll
        for (int m = 0; m < 4; ++m) a[m] = *(const GAS bf16x8*)(ap + (size_t)m * 16 * lda + k);
#pragma unroll
        for (int n = 0; n < NN; ++n) b[n] = *(const GAS bf16x8*)(bp + (size_t)n * 16 * ldb + k);
#pragma unroll
        for (int m = 0; m < 4; ++m)
#pragma unroll
            for (int n = 0; n < NN; ++n) acc[m][n] = __builtin_amdgcn_mfma_f32_16x16x32_bf16(a[m], b[n], acc[m][n], 0, 0, 0);
    }
}
template <int UNR>
__device__ __forceinline__ void sgemm32(f32x4 (&acc)[2][2], const bf16* A, int lda, const bf16* Bt, int ldb, int K, int row0, int col0, int lane) {
    const int fr = lane & 15, fq = lane >> 4;
    const bf16* ap = A + (size_t)(row0 + fr) * lda + fq * 8;
    const bf16* bp = Bt + (size_t)(col0 + fr) * ldb + fq * 8;
#pragma unroll 1
    for (int k0 = 0; k0 < K; k0 += 32 * UNR) {
        bf16x8 a[UNR][2], b[UNR][2];
#pragma unroll
        for (int u = 0; u < UNR; ++u)
#pragma unroll
            for (int m = 0; m < 2; ++m) { a[u][m] = *(const GAS bf16x8*)(ap + (size_t)m * 16 * lda + k0 + 32 * u); b[u][m] = *(const GAS bf16x8*)(bp + (size_t)m * 16 * ldb + k0 + 32 * u); }
#pragma unroll
        for (int u = 0; u < UNR; ++u)
#pragma unroll
            for (int m = 0; m < 2; ++m)
#pragma unroll
                for (int n = 0; n < 2; ++n) acc[m][n] = __builtin_amdgcn_mfma_f32_16x16x32_bf16(a[u][m], b[u][n], acc[m][n], 0, 0, 0);
    }
}
__device__ __forceinline__ void zero_acc22(f32x4 (&acc)[2][2]) { acc[0][0] = acc[0][1] = acc[1][0] = acc[1][1] = (f32x4){0.f, 0.f, 0.f, 0.f}; }
template <int NN>
__device__ __forceinline__ void zero_acc(f32x4 (&acc)[4][NN]) {
#pragma unroll
    for (int m = 0; m < 4; ++m)
#pragma unroll
        for (int n = 0; n < NN; ++n) acc[m][n] = (f32x4){0.f, 0.f, 0.f, 0.f};
}

__device__ __forceinline__ int f2ord(float f) { const int b = __builtin_bit_cast(int, f); return b ^ ((b >> 31) & 0x7fffffff); }
__device__ __forceinline__ float ord2f(int o) { const int b = o ^ ((o >> 31) & 0x7fffffff); return __builtin_bit_cast(float, b); }
__device__ __forceinline__ void top16_insert(int (&top)[16], int key) {
#pragma unroll
    for (int i = 0; i < 16; ++i) { const int hi = max(top[i], key); key = min(top[i], key); top[i] = hi; }
}
#define CE(a, b) { const int t_ = max(a, b); b = min(a, b); a = t_; }
__device__ __forceinline__ void sort16_desc(int (&v)[16]) { CE(v[0], v[1]); CE(v[3], v[2]); CE(v[4], v[5]); CE(v[7], v[6]); CE(v[8], v[9]); CE(v[11], v[10]); CE(v[12], v[13]); CE(v[15], v[14]); CE(v[0], v[2]); CE(v[1], v[3]); CE(v[6], v[4]); CE(v[7], v[5]); CE(v[8], v[10]); CE(v[9], v[11]); CE(v[14], v[12]); CE(v[15], v[13]); CE(v[0], v[1]); CE(v[2], v[3]); CE(v[5], v[4]); CE(v[7], v[6]); CE(v[8], v[9]); CE(v[10], v[11]); CE(v[13], v[12]); CE(v[15], v[14]); CE(v[0], v[4]); CE(v[1], v[5]); CE(v[2], v[6]); CE(v[3], v[7]); CE(v[12], v[8]); CE(v[13], v[9]); CE(v[14], v[10]); CE(v[15], v[11]); CE(v[0], v[2]); CE(v[1], v[3]); CE(v[4], v[6]); CE(v[5], v[7]); CE(v[10], v[8]); CE(v[11], v[9]); CE(v[14], v[12]); CE(v[15], v[13]); CE(v[0], v[1]); CE(v[2], v[3]); CE(v[4], v[5]); CE(v[6], v[7]); CE(v[9], v[8]); CE(v[11], v[10]); CE(v[13], v[12]); CE(v[15], v[14]); CE(v[0], v[8]); CE(v[1], v[9]); CE(v[2], v[10]); CE(v[3], v[11]); CE(v[4], v[12]); CE(v[5], v[13]); CE(v[6], v[14]); CE(v[7], v[15]); CE(v[0], v[4]); CE(v[1], v[5]); CE(v[2], v[6]); CE(v[3], v[7]); CE(v[8], v[12]); CE(v[9], v[13]); CE(v[10], v[14]); CE(v[11], v[15]); CE(v[0], v[2]); CE(v[1], v[3]); CE(v[4], v[6]); CE(v[5], v[7]); CE(v[8], v[10]); CE(v[9], v[11]); CE(v[12], v[14]); CE(v[13], v[15]); CE(v[0], v[1]); CE(v[2], v[3]); CE(v[4], v[5]); CE(v[6], v[7]); CE(v[8], v[9]); CE(v[10], v[11]); CE(v[12], v[13]); CE(v[14], v[15]); }
__device__ __forceinline__ void merge16_desc(int (&a)[16], const int (&b)[16]) {
#pragma unroll
    for (int i = 0; i < 16; ++i) a[i] = max(a[i], b[15 - i]);
    CE(a[0], a[8]); CE(a[1], a[9]); CE(a[2], a[10]); CE(a[3], a[11]); CE(a[4], a[12]); CE(a[5], a[13]); CE(a[6], a[14]); CE(a[7], a[15]); CE(a[0], a[4]); CE(a[1], a[5]); CE(a[2], a[6]); CE(a[3], a[7]); CE(a[8], a[12]); CE(a[9], a[13]); CE(a[10], a[14]); CE(a[11], a[15]); CE(a[0], a[2]); CE(a[1], a[3]); CE(a[4], a[6]); CE(a[5], a[7]); CE(a[8], a[10]); CE(a[9], a[11]); CE(a[12], a[14]); CE(a[13], a[15]); CE(a[0], a[1]); CE(a[2], a[3]); CE(a[4], a[5]); CE(a[6], a[7]); CE(a[8], a[9]); CE(a[10], a[11]); CE(a[12], a[13]); CE(a[14], a[15]); }
#undef CE


typedef float f32x16 __attribute__((ext_vector_type(16)));
typedef short s16x4 __attribute__((ext_vector_type(4)));
typedef __bf16 bf16x2_t __attribute__((ext_vector_type(2)));
__device__ __forceinline__ unsigned cvtpk(float lo, float hi) { f32x2 v = {lo, hi}; bf16x2_t b = __builtin_convertvector(v, bf16x2_t); return __builtin_bit_cast(unsigned, b); }
constexpr int CK_PITCH = 144, CV_PITCH = 320;
constexpr int CK_SZ = 64 * CK_PITCH, CV_SZ = 64 * CV_PITCH;
constexpr float C_THR_RAW = 8.0f / SCL2;

template <int NDV, class RowFn, class UseFn, class ElemFn>
__device__ __forceinline__ void attn64_pass(f32x16 (&o)[NDV], float& mrun, float& lpart, const bf16x8 (&qf)[4], const bf16* kg, int kpitch, const bf16* vg, int vpitch,
                                            int ntiles, RowFn tile_row, UseFn use_tile, ElemFn elem, LAS unsigned char* L, int lane, int tid) {
    constexpr int VP = NDV * 64 + 64, VSZ = 64 * VP, NVP = NDV / 2;
    const int r32 = lane & 31, hi = lane >> 5;
    const int krow_s = tid >> 3, kch_s = tid & 7;
    const int vrow_s = (NDV == 2) ? (tid >> 3) : (tid >> 4), vch_s = (NDV == 2) ? (tid & 7) : (tid & 15);
    LAS unsigned char* Kb0 = L; LAS unsigned char* Vb0 = L + 2 * CK_SZ;
    __syncthreads();
    {
        const int tr = tile_row(0);
        const v4u kr = *(const GAS v4u*)(kg + (size_t)tr * kpitch);
        *(LAS v4u*)(Kb0 + krow_s * CK_PITCH + kch_s * 16) = kr;
#pragma unroll
        for (int i = 0; i < NVP; ++i) { const v4u v = *(const GAS v4u*)(vg + (size_t)(tr + 32 * i) * vpitch); *(LAS v4u*)(Vb0 + (vrow_s + 32 * i) * VP + vch_s * 16) = v; }
    }
    v4u kr, vr[NVP];
    { const int tr = tile_row(ntiles > 1 ? 1 : 0); kr = *(const GAS v4u*)(kg + (size_t)tr * kpitch);
#pragma unroll
      for (int i = 0; i < NVP; ++i) vr[i] = *(const GAS v4u*)(vg + (size_t)(tr + 32 * i) * vpitch); }
    __syncthreads();
#pragma unroll 1
    for (int j = 0; j < ntiles; ++j) {
        const int cur = j & 1;
        const LAS unsigned char* Kb = Kb0 + cur * CK_SZ; const LAS unsigned char* Vb = Vb0 + cur * VSZ;
        const bool more = (j + 1 < ntiles);
        v4u kr2, vr2[NVP];
        { const int tr = tile_row(j + 2 < ntiles ? j + 2 : ntiles - 1); kr2 = *(const GAS v4u*)(kg + (size_t)tr * kpitch);
#pragma unroll
            for (int i = 0; i < NVP; ++i) vr2[i] = *(const GAS v4u*)(vg + (size_t)(tr + 32 * i) * vpitch); }
        if (use_tile(j)) {
            f32x16 st[2];
#pragma unroll
            for (int kb = 0; kb < 2; ++kb) {
#pragma unroll
                for (int r = 0; r < 16; ++r) st[kb][r] = 0.f;
#pragma unroll
                for (int ks = 0; ks < 4; ++ks) {
                    const bf16x8 kf = *(const LAS bf16x8*)(Kb + (kb * 32 + r32) * CK_PITCH + ks * 32 + hi * 16);
                    st[kb] = __builtin_amdgcn_mfma_f32_32x32x16_bf16(kf, qf[ks], st[kb], 0, 0, 0);
                }
            }
            elem(st, j);
            float mx = st[0][0];
#pragma unroll
            for (int r = 1; r < 16; ++r) mx = fmaxf(mx, st[0][r]);
#pragma unroll
            for (int r = 0; r < 16; ++r) mx = fmaxf(mx, st[1][r]);
            mx = xmax32(mx);
            if (__builtin_amdgcn_ballot_w64(mx > mrun + C_THR_RAW) != 0ull) {
                const float mn = fmaxf(mrun, mx);
                const float alpha = __builtin_amdgcn_exp2f((mrun - mn) * SCL2);
#pragma unroll
                for (int d = 0; d < NDV; ++d)
#pragma unroll
                    for (int r = 0; r < 16; ++r) o[d][r] *= alpha;
                lpart *= alpha; mrun = mn;
            }
            const float nmc = -mrun * SCL2;
            float ls = 0.f;
#pragma unroll
            for (int kb = 0; kb < 2; ++kb)
#pragma unroll
                for (int r = 0; r < 16; ++r) { const float p = __builtin_amdgcn_exp2f(fmaf(st[kb][r], SCL2, nmc)); st[kb][r] = p; ls += p; }
            lpart += ls;
            const int q4 = (lane & 15) >> 2, p4 = lane & 3, grp = (lane >> 4) & 1;
            const LAS unsigned char* vbase = Vb + (4 * hi + q4) * VP + (16 * grp + 4 * p4) * 2;
#pragma unroll
            for (int kb = 0; kb < 2; ++kb)
#pragma unroll
                for (int ss = 0; ss < 2; ++ss) {
                    v4u pw;
#pragma unroll
                    for (int i2 = 0; i2 < 4; ++i2) pw[i2] = cvtpk(st[kb][8 * ss + 2 * i2], st[kb][8 * ss + 2 * i2 + 1]);
                    const bf16x8 pb = __builtin_bit_cast(bf16x8, pw);
#pragma unroll
                    for (int d = 0; d < NDV; ++d) {
                        const LAS unsigned char* va = vbase + (kb * 32 + 16 * ss) * VP + d * 64;
                        const s16x4 lo = __builtin_bit_cast(s16x4, __builtin_amdgcn_ds_read_tr16_b64_v4i16((LAS s16x4*)va));
                        const s16x4 hh = __builtin_bit_cast(s16x4, __builtin_amdgcn_ds_read_tr16_b64_v4i16((LAS s16x4*)(va + 8 * VP)));
                        const bf16x8 vf = __builtin_shufflevector(lo, hh, 0, 1, 2, 3, 4, 5, 6, 7);
                        o[d] = __builtin_amdgcn_mfma_f32_32x32x16_bf16(vf, pb, o[d], 0, 0, 0);
                    }
                }
        }
        if (more) {
            LAS unsigned char* Kn = Kb0 + (cur ^ 1) * CK_SZ; LAS unsigned char* Vn = Vb0 + (cur ^ 1) * VSZ;
            *(LAS v4u*)(Kn + krow_s * CK_PITCH + kch_s * 16) = kr;
#pragma unroll
            for (int i = 0; i < NVP; ++i) *(LAS v4u*)(Vn + (vrow_s + 32 * i) * VP + vch_s * 16) = vr[i];
        }
        kr = kr2;
#pragma unroll
        for (int i = 0; i < NVP; ++i) vr[i] = vr2[i];
        __syncthreads();
    }
}
__device__ __forceinline__ void attn64_store(const f32x16 (&o)[2], float inv, bf16* yrow, int hi) {
#pragma unroll
    for (int d = 0; d < 2; ++d)
#pragma unroll
        for (int g4 = 0; g4 < 4; ++g4) {
            v2u w; w.x = cvtpk(o[d][4 * g4] * inv, o[d][4 * g4 + 1] * inv); w.y = cvtpk(o[d][4 * g4 + 2] * inv, o[d][4 * g4 + 3] * inv);
            *(GAS v2u*)(yrow + d * 32 + 8 * g4 + 4 * hi) = w;
        }
}

namespace pg8 {
typedef unsigned short bf16_t;
constexpr int BM = 256, BK = 64, HALF = 128, HTB = HALF * BK * 2, STAGE_BYTES = 8 * HTB, NXCD = 8, WGM = 8;
__host__ __device__ __forceinline__ int lds_byte(int r, int c) { const int st = (r >> 4) * 2 + (c >> 5), rr = r & 15, cc = c & 31, ob = rr * 64 + cc * 2; return st * 1024 + (ob ^ (((ob >> 9) & 1) << 5)); }
__host__ __device__ __forceinline__ void stage_rc(int b, int& R, int& C) { const int st = b / 1024, sb = b % 1024, swz = sb ^ (((sb >> 9) & 1) << 5); R = (st >> 1) * 16 + swz / 64; C = (st & 1) * 32 + (swz % 64) / 2; }
__host__ __device__ __forceinline__ int perm32(int rho) { const int n = rho >> 4, i = rho & 15; return 8 * (i >> 2) + 4 * n + (i & 3); }
struct Unit { int pm, pn, seg; };
struct Gemm { const bf16_t* A; const bf16_t* Bt; int lda, ldb, K; size_t a_seg, b_seg; };
struct TileOrder {
    int nM, nN, nwg, G, c;
    __device__ void init(int M, int N, int G_, int c_) { nM = M / BM; nN = N / BM; nwg = nM * nN; G = G_; c = c_; }
    __device__ bool tile(int i, int& pm, int& pn) const {
        const long L = (long)i * G + c; if (L >= nwg) return false;
        int wgid = (int)L; { const int q = nwg / NXCD, r = nwg % NXCD, xcd = wgid % NXCD, off = wgid / NXCD; wgid = (xcd < r ? xcd * (q + 1) : r * (q + 1) + (xcd - r) * q) + off; }
        const int nig = WGM * nN, gid = wgid / nig, fm = gid * WGM, gsz = (nM - fm) < WGM ? (nM - fm) : WGM;
        pm = fm + ((wgid % nig) % gsz); pn = (wgid % nig) / gsz; return true;
    }
};
template <int NSEG> struct SegOrder {
    TileOrder T;
    __device__ bool next(int i, Unit& u) const { u.seg = i % NSEG; return T.tile(i / NSEG, u.pm, u.pn); }
};
template <class Epi, class Sched>
__device__ __forceinline__ void gemm_phase(LAS unsigned char* lds, const Gemm g, const Sched& S, const Epi& E, int wid) {
    const int lane = lane_id_v(), tid = wid * 64 + lane,
              wr = wid >> 2, wc = wid & 3, fr = lane & 15, fq = lane >> 4;
    const int K = g.K, nt = K / BK;
    unsigned voffA[2], voffB[2];
#pragma unroll
    for (int i = 0; i < 2; ++i) { int R, C; stage_rc(tid * 16 + i * 8192, R, C); const int Rb = (R & ~31) + perm32(R & 31);
        voffA[i] = (unsigned)(R * g.lda + C) * 2u; voffB[i] = (unsigned)(Rb * g.ldb + C) * 2u; }
    const size_t kstep = (size_t)(BK * 2);
    const size_t hstepA = (size_t)HALF * g.lda * 2, hstepB = (size_t)HALF * g.ldb * 2;
    const unsigned ldsw = (unsigned)wid * 1024u;
    const int aoff = lds_byte(wr * 64 + fr, fq * 8), boff = lds_byte(wc * 32 + fr, fq * 8);
#define PG8_SA(b, h) (((b) * 2 + (h)) * HTB)
#define PG8_SB(b, h) ((4 + (b) * 2 + (h)) * HTB)
#define PG8_STAGE(bufoff, gbase, voff) do { _Pragma("unroll") for (int _i = 0; _i < 2; ++_i) \
        __builtin_amdgcn_global_load_lds((const unsigned*)((const char*)(gbase) + (voff)[_i]), (LAS unsigned*)(lds + (bufoff) + ldsw + _i * 8192), 16, 0, 0); } while (0)
#define PG8_LDA(dst, b, h) do { _Pragma("unroll") for (int m = 0; m < 4; ++m) _Pragma("unroll") for (int k = 0; k < 2; ++k) dst[m][k] = *(const LAS bf16x8*)(lds + PG8_SA(b, h) + aoff + m * 2048 + k * 1024); } while (0)
#define PG8_LDB(dst, b, h) do { _Pragma("unroll") for (int n = 0; n < 2; ++n) _Pragma("unroll") for (int k = 0; k < 2; ++k) dst[n][k] = *(const LAS bf16x8*)(lds + PG8_SB(b, h) + boff + n * 2048 + k * 1024); } while (0)
#define PG8_MMA(ai, bj, At, Bt) do { __builtin_amdgcn_s_setprio(1); _Pragma("unroll") for (int m = 0; m < 4; ++m) _Pragma("unroll") for (int n = 0; n < 2; ++n) _Pragma("unroll") for (int k = 0; k < 2; ++k) \
        acc[ai][bj][m][n] = __builtin_amdgcn_mfma_f32_16x16x32_bf16(Bt[n][k], At[m][k], acc[ai][bj][m][n], 0, 0, 0); __builtin_amdgcn_s_setprio(0); } while (0)
#define PG8_WAIT_V(n) asm volatile("s_waitcnt vmcnt(" #n ")" ::: "memory")
#define PG8_WAIT_L(n) asm volatile("s_waitcnt lgkmcnt(" #n ")" ::: "memory")
#define PG8_BAR __builtin_amdgcn_s_barrier()
#define PG8_SCHED __builtin_amdgcn_sched_barrier(0)
#define PG8_ABASE(u) ((const char*)g.A + ((size_t)(u).seg * g.a_seg + (size_t)(u).pm * BM * g.lda) * 2)
#define PG8_BBASE(u) ((const char*)g.Bt + ((size_t)(u).seg * g.b_seg + (size_t)(u).pn * BM * g.ldb) * 2)
    Unit cur, nxt; int ui = 0;
    if (!S.next(0, cur)) return;
    f32x4 acc[2][2][4][2];
#pragma unroll
    for (int a = 0; a < 2; ++a)
#pragma unroll
        for (int b = 0; b < 2; ++b)
#pragma unroll
            for (int m = 0; m < 4; ++m)
#pragma unroll
                for (int n = 0; n < 2; ++n) acc[a][b][m][n] = (f32x4){0.f, 0.f, 0.f, 0.f};
    bf16x8 At[4][2], B0[2][2], B1[2][2];
    const char* cA = PG8_ABASE(cur); const char* cB = PG8_BBASE(cur);
    PG8_STAGE(PG8_SB(0, 0), cB, voffB); PG8_STAGE(PG8_SB(0, 1), cB + hstepB, voffB); PG8_STAGE(PG8_SA(0, 0), cA, voffA); PG8_STAGE(PG8_SA(0, 1), cA + hstepA, voffA);
    if (wr == 1) PG8_BAR;
    PG8_WAIT_V(2); PG8_BAR;
    PG8_STAGE(PG8_SB(1, 0), cB + kstep, voffB); PG8_STAGE(PG8_SA(1, 0), cA + kstep, voffA); PG8_STAGE(PG8_SB(1, 1), cB + hstepB + kstep, voffB);
    PG8_WAIT_V(6); PG8_BAR;
    for (;;) {
        const bool has_next = S.next(ui + 1, nxt);
        const char* nA = has_next ? PG8_ABASE(nxt) : cA; const char* nB = has_next ? PG8_BBASE(nxt) : cB;
        for (int t = 0; t < nt; t += 2) {
            const bool lastk = (t == nt - 2);
            const char* a1 = cA + (size_t)(t + 1) * kstep;
            const char* a2 = lastk ? nA : cA + (size_t)(t + 2) * kstep; const char* b2 = lastk ? nB : cB + (size_t)(t + 2) * kstep;
            const char* a3 = a2 + kstep; const char* b3 = b2 + kstep;
            PG8_LDB(B0, 0, 0); PG8_LDB(B1, 0, 1); PG8_SCHED; PG8_LDA(At, 0, 0); PG8_STAGE(PG8_SA(1, 1), a1 + hstepA, voffA);
            PG8_WAIT_V(8); PG8_WAIT_L(0); PG8_BAR; PG8_MMA(0, 0, At, B0); PG8_MMA(0, 1, At, B1); PG8_BAR; PG8_SCHED;
            PG8_LDA(At, 0, 1); PG8_STAGE(PG8_SB(0, 0), b2, voffB); PG8_STAGE(PG8_SB(0, 1), b2 + hstepB, voffB); PG8_STAGE(PG8_SA(0, 0), a2, voffA);
            PG8_WAIT_V(8); PG8_WAIT_L(0); PG8_BAR; PG8_MMA(1, 0, At, B0); PG8_MMA(1, 1, At, B1); PG8_BAR; PG8_SCHED;
            PG8_LDB(B0, 1, 0); PG8_LDB(B1, 1, 1); PG8_SCHED; PG8_LDA(At, 1, 0); PG8_STAGE(PG8_SA(0, 1), a2 + hstepA, voffA);
            PG8_WAIT_V(8); PG8_WAIT_L(0); PG8_BAR; PG8_MMA(0, 0, At, B0); PG8_MMA(0, 1, At, B1); PG8_BAR; PG8_SCHED;
            PG8_LDA(At, 1, 1); PG8_STAGE(PG8_SB(1, 0), b3, voffB); PG8_STAGE(PG8_SB(1, 1), b3 + hstepB, voffB); PG8_STAGE(PG8_SA(1, 0), a3, voffA);
            PG8_WAIT_V(8); PG8_WAIT_L(0); PG8_BAR; PG8_MMA(1, 0, At, B0); PG8_MMA(1, 1, At, B1); PG8_BAR; PG8_SCHED;
        }
        if (wr == 0) PG8_BAR;
        E(acc, cur, wr, wc, fr, fq);
        if (!has_next) break;
#pragma unroll
        for (int a = 0; a < 2; ++a)
#pragma unroll
            for (int b = 0; b < 2; ++b)
#pragma unroll
                for (int m = 0; m < 4; ++m)
#pragma unroll
                    for (int n = 0; n < 2; ++n) acc[a][b][m][n] = (f32x4){0.f, 0.f, 0.f, 0.f};
        cur = nxt; cA = nA; cB = nB; ++ui;
        if (wr == 1) PG8_BAR;
    }
    PG8_WAIT_V(0);
    PG8_BAR;
#undef PG8_SA
#undef PG8_SB
#undef PG8_STAGE
#undef PG8_LDA
#undef PG8_LDB
#undef PG8_MMA
#undef PG8_WAIT_V
#undef PG8_WAIT_L
#undef PG8_BAR
#undef PG8_SCHED
#undef PG8_ABASE
#undef PG8_BBASE
}
}

__device__ __forceinline__ v4u pack8(const f32x4& a, const f32x4& b) { v4u w; w.x = cvtpk(a.x, a.y); w.y = cvtpk(a.z, a.w); w.z = cvtpk(b.x, b.y); w.w = cvtpk(b.z, b.w); return w; }
struct EpiInProj {
    bf16 *AQ, *AK, *AVT, *BQ, *BK, *BVT, *CQ, *CK, *CV, *SG; const float *COS, *SIN;
    __device__ __forceinline__ void operator()(const f32x4 (&acc)[2][2][4][2], const pg8::Unit& u, int wr, int wc, int fr, int fq) const {
        asm volatile("" : "+v"(fr), "+v"(fq));
#pragma unroll
        for (int bj = 0; bj < 2; ++bj) {
            const int cblk = u.pn * 256 + bj * 128;
            const int cw = wc * 32 + 8 * fq;
            bf16* dst; int pitch, cbase; int kind;
            int nh = 1, hd = 0;
            if (cblk < 512)       { dst = AQ; pitch = 512; cbase = cblk; kind = 1; }
            else if (cblk < 640)  { dst = AK; pitch = 128; cbase = cblk - 512; kind = 1; }
            else if (cblk < 768)  { dst = AVT; pitch = 128; cbase = cblk - 640; kind = 0; }
            else if (cblk < 1280) { dst = BQ; pitch = 512; cbase = cblk - 768; kind = 0; }
            else if (cblk < 1792) { dst = BK; pitch = 512; cbase = cblk - 1280; kind = 0; }
            else if (cblk < 2304) { dst = BVT; pitch = 512; cbase = cblk - 1792; kind = 0; }
            else if (cblk < 2816) { dst = CQ; pitch = 512; cbase = cblk - 2304; kind = 1; }
            else if (cblk < 3328) { dst = CK; pitch = 512; cbase = cblk - 2816; kind = 1; }
            else if (cblk < 3840) { dst = CV; pitch = 512; cbase = cblk - 3328; kind = 0; }
            else                  { dst = SG; pitch = 3072; cbase = cblk - 3840; kind = 3; }
#pragma unroll
            for (int ai = 0; ai < 2; ++ai)
#pragma unroll
                for (int m = 0; m < 4; ++m) {
                    const int row = u.pm * 256 + ai * 128 + wr * 64 + m * 16 + fr;
                    f32x4 v0 = acc[ai][bj][m][0], v1 = acc[ai][bj][m][1];
                    if (kind == 1) {
                        if (row < T_LAT) {
                            const int t = row & (SEQ - 1), i0 = (cw & 63) >> 1;
                            const f32x4 cs = *(const GAS f32x4*)(COS + t * 32 + i0), sn = *(const GAS f32x4*)(SIN + t * 32 + i0);
                            const f32x4 a = v0, b = v1;
                            v0.x = a.x * cs.x - a.y * sn.x; v0.y = a.y * cs.x + a.x * sn.x; v0.z = a.z * cs.y - a.w * sn.y; v0.w = a.w * cs.y + a.z * sn.y;
                            v1.x = b.x * cs.z - b.y * sn.z; v1.y = b.y * cs.z + b.x * sn.z; v1.z = b.z * cs.w - b.w * sn.w; v1.w = b.w * cs.w + b.z * sn.w;
                        }
                        *(GAS v4u*)(dst + (size_t)row * pitch + cbase + cw) = pack8(v0, v1);
                    } else if (kind == 0) {
                        *(GAS v4u*)(dst + (size_t)row * pitch + cbase + cw) = pack8(v0, v1);
                    } else if (kind == 3) {
                        v0.x = sigmoid_fast(v0.x); v0.y = sigmoid_fast(v0.y); v0.z = sigmoid_fast(v0.z); v0.w = sigmoid_fast(v0.w);
                        v1.x = sigmoid_fast(v1.x); v1.y = sigmoid_fast(v1.y); v1.z = sigmoid_fast(v1.z); v1.w = sigmoid_fast(v1.w);
                        *(GAS v4u*)(dst + (size_t)row * pitch + cbase + cw) = pack8(v0, v1);
                    } else {
                        const int hc = hd + cw, head = hc >> 6, d = hc & 63;
                        const int b = row_batch(row), tok = row_tok(row);
                        bf16* vp = dst + ((size_t)(b * nh + head) * 64 + d) * NTOK + tok;
                        vp[0 * NTOK] = (bf16)f2bf(v0.x); vp[1 * NTOK] = (bf16)f2bf(v0.y); vp[2 * NTOK] = (bf16)f2bf(v0.z); vp[3 * NTOK] = (bf16)f2bf(v0.w);
                        vp[4 * NTOK] = (bf16)f2bf(v1.x); vp[5 * NTOK] = (bf16)f2bf(v1.y); vp[6 * NTOK] = (bf16)f2bf(v1.z); vp[7 * NTOK] = (bf16)f2bf(v1.w);
                    }
                }
        }
    }
};
__device__ __forceinline__ void unpack8(const v4u& w, f32x4& a, f32x4& b) {
    a = (f32x4){bf2f(w.x & 0xffffu), bf2f(w.x >> 16), bf2f(w.y & 0xffffu), bf2f(w.y >> 16)}; b = (f32x4){bf2f(w.z & 0xffffu), bf2f(w.z >> 16), bf2f(w.w & 0xffffu), bf2f(w.w >> 16)};
}
struct EpiBranch {
    const bf16* SG; bf16* MG;
    __device__ __forceinline__ void operator()(const f32x4 (&acc)[2][2][4][2], const pg8::Unit& u, int wr, int wc, int fr, int fq) const {
        asm volatile("" : "+v"(fr), "+v"(fq));
#pragma unroll
        for (int ai = 0; ai < 2; ++ai)
#pragma unroll
            for (int m = 0; m < 4; ++m) {
                const int row = u.pm * 256 + ai * 128 + wr * 64 + m * 16 + fr;
#pragma unroll
                for (int bj = 0; bj < 2; ++bj) {
                    const int col = u.pn * 256 + bj * 128 + wc * 32 + 8 * fq;
                    f32x4 g0, g1; { const v4u wg = *(const GAS v4u*)(SG + (size_t)row * 3072 + u.seg * 1024 + col); unpack8(wg, g0, g1); }
                    f32x4 v0 = g0 * acc[ai][bj][m][0], v1 = g1 * acc[ai][bj][m][1];
                    bf16* mp = MG + (size_t)row * D + col;
                    if (u.seg > 0) { f32x4 p0, p1; const v4u wp = *(const GAS v4u*)mp; unpack8(wp, p0, p1); v0 += p0; v1 += p1; }
                    *(GAS v4u*)mp = pack8(v0, v1);
                }
            }
    }
};
struct EpiOut {
    float* X; const float* gtl; const float* xin; const float* cin;
    __device__ __forceinline__ void operator()(const f32x4 (&acc)[2][2][4][2], const pg8::Unit& u, int wr, int wc, int fr, int fq) const {
        asm volatile("" : "+v"(fr), "+v"(fq));
#pragma unroll
        for (int ai = 0; ai < 2; ++ai)
#pragma unroll
            for (int m = 0; m < 4; ++m) {
                const int row = u.pm * 256 + ai * 128 + wr * 64 + m * 16 + fr;
                const float* gt = gtl + (size_t)row_modidx(row) * 6 * D + 2 * D;
#pragma unroll
                for (int bj = 0; bj < 2; ++bj) {
                    const int col = u.pn * 256 + bj * 128 + wc * 32 + 8 * fq;
                    GAS f32x4* xp = (GAS f32x4*)(X + (size_t)row * D + col);
                    const GAS f32x4* sp = xin ? (const GAS f32x4*)(xin_row(xin, cin, row) + col) : (const GAS f32x4*)xp;
                    const f32x4 g0 = *(const GAS f32x4*)(gt + col), g1 = *(const GAS f32x4*)(gt + col + 4);
                    xp[0] = sp[0] + g0 * acc[ai][bj][m][0]; xp[1] = sp[1] + g1 * acc[ai][bj][m][1];
                }
            }
    }
};
struct EpiStore {
    bf16* O; int ldc;
    __device__ __forceinline__ void operator()(const f32x4 (&acc)[2][2][4][2], const pg8::Unit& u, int wr, int wc, int fr, int fq) const {
        asm volatile("" : "+v"(fr), "+v"(fq));
#pragma unroll
        for (int ai = 0; ai < 2; ++ai)
#pragma unroll
            for (int m = 0; m < 4; ++m) {
                const int row = u.pm * 256 + ai * 128 + wr * 64 + m * 16 + fr;
#pragma unroll
                for (int bj = 0; bj < 2; ++bj) {
                    const int col = u.pn * 256 + bj * 128 + wc * 32 + 8 * fq;
                    *(GAS v4u*)(O + (size_t)row * ldc + col) = pack8(acc[ai][bj][m][0], acc[ai][bj][m][1]);
                }
            }
    }
};

__global__ void __launch_bounds__(NTHREADS, 2) mega_fwd(Args args) {
    extern __shared__ __attribute__((aligned(16))) unsigned char lds[];
    LAS unsigned char* L = (LAS unsigned char*)lds;
    volatile LAS unsigned* MISC = (volatile LAS unsigned*)(L + MISC_OFF);
    const int wave = __builtin_amdgcn_readfirstlane((int)threadIdx.x >> 6);
    const int lane = lane_id_v(), tid = wave * 64 + lane;
    const int fr = lane & 15, fq = lane >> 4;
    const int G = gridDim.x;
    const int vcu = (G % 8 == 0) ? (int)(blockIdx.x % 8) * (G / 8) + (int)(blockIdx.x / 8) : (int)blockIdx.x;
    for (int u = tid; u < (LDS_BYTES - 131072) / 4; u += NTHREADS) ((LAS unsigned*)(L + 131072))[u] = 0u;
    __syncthreads();
    unsigned char* ws = args.ws;
    gu32* ctl = (gu32*)(ws + WS_CTL);
    (void)xcd_barrier_post((unsigned*)(ctl + CW_BAR), MISC + 8);
    if (tid == 0) MISC[12] = xb_add((unsigned*)(ctl + CW_RANK) + 64 * xb_xcc_id(), 1u);
    __syncthreads();
#define GRID_BAR() do { unsigned* bp_ = (unsigned*)(args.ws + WS_CTL) + CW_BAR; asm volatile("" : "+s"(bp_)); XcdBarrier b_; b_.bar = bp_; b_.x = xb_xcc_id(); b_.st = MISC + 8; xcd_barrier(b_, wave == 0 && lane_id_v() == 0); } while (0)
    const int gw = vcu * NWAVES + wave, NGW = G * NWAVES;
    const int NGT = G * NTHREADS;

#define PHASE_PTRS \
    unsigned char* wsq = args.ws; asm volatile("" : "+s"(wsq)); \
    const float* const* IN_ = (const float* const*)__builtin_amdgcn_kernarg_segment_ptr(); asm volatile("" : "+s"(IN_)); \
    float* MODV = (float*)(wsq + WS_MOD); float* COS = (float*)(wsq + WS_COS); float* SIN = (float*)(wsq + WS_SIN); \
    bf16* WIN = (bf16*)(wsq + WS_WIN); bf16* WB = (bf16*)(wsq + WS_WB); bf16* WO = (bf16*)(wsq + WS_WO); bf16* WQ = (bf16*)(wsq + WS_WQ); bf16* KEYS = (bf16*)(wsq + WS_KEYS); \
    float* X = (float*)(wsq + WS_X); bf16* H = (bf16*)(wsq + WS_H); bf16* Y = (bf16*)(wsq + WS_Y); bf16* MG = (bf16*)(wsq + WS_MG); \
    unsigned* EI = (unsigned*)(wsq + WS_EI); float* EG = (float*)(wsq + WS_EG); \
    unsigned char* U8 = wsq + WS_U8; unsigned char* V8 = wsq + WS_V8; float* SCU = (float*)(wsq + WS_SCU); float* SCV = SCU + DEPTH * 16384; \
    bf16* AQ = (bf16*)(wsq + WS_AQ); bf16* AK = (bf16*)(wsq + WS_AK); bf16* AVT = (bf16*)(wsq + WS_AVT); \
    bf16* BQ = (bf16*)(wsq + WS_BQ); bf16* BK = (bf16*)(wsq + WS_BK); bf16* BVT = (bf16*)(wsq + WS_BVT); \
    bf16* CQ = (bf16*)(wsq + WS_CQ); bf16* CK = (bf16*)(wsq + WS_CK); bf16* CVT = (bf16*)(wsq + WS_CVT); \
    bf16* SG = (bf16*)(wsq + WS_SG); bf16* Q2 = (bf16*)(wsq + WS_Q2); float* SC = (float*)(wsq + WS_SC); \
    (void)MODV; (void)COS; (void)SIN; (void)WIN; (void)WB; (void)WO; (void)WQ; (void)KEYS; (void)X; (void)H; (void)Y; (void)MG; (void)EI; (void)EG; (void)U8; (void)V8; (void)SCU; (void)SCV; \
    (void)AQ; (void)AK; (void)AVT; (void)BQ; (void)BK; (void)BVT; (void)CQ; (void)CK; (void)CVT; (void)SG; (void)Q2; (void)SC; (void)IN_;
#define LAYER_PTRS const float* modl = MODV + (size_t)layer * 3 * 6 * D; const bf16* WINl = WIN + (size_t)layer * IN_W * D; (void)modl; (void)WINl;

#ifndef SKIP_P0
        { PHASE_PTRS
        for (int rep_ = 0; rep_ < REP_P0; ++rep_) {
    {
        LAS float* scr = (LAS float*)(L + wave * 16384);
        int gt = vcu * NTHREADS + tid; asm volatile("" : "+v"(gt));
        constexpr int I_IN = (D / 64) * (IN_W / 32), I_BR = (512 / 64) * (D / 32), I_O = (D / 64) * (D / 32), I_Q = (D / 64) * (2048 / 32);
        constexpr int PER_LAYER = I_IN + 3 * I_BR + I_O + I_Q;
        for (int rp_ = 0; rp_ < REP_P0A; ++rp_)
        for (int it = gw; it < DEPTH * PER_LAYER; it += NGW) {
            const int l = it / PER_LAYER; int r = it % PER_LAYER;
            if (r < I_IN) { p0_transpose_item<true>(IN_[I_WIN] + (size_t)l * D * IN_W, D, IN_W, WIN + (size_t)l * IN_W * D, scr, r, lane); continue; } r -= I_IN;
            if (r < I_BR) { p0_transpose_item(IN_[I_WBA] + (size_t)l * 512 * D, 512, D, WB + (size_t)(l * 3 + 0) * D * 512, scr, r, lane); continue; } r -= I_BR;
            if (r < I_BR) { p0_transpose_item(IN_[I_WBB] + (size_t)l * 512 * D, 512, D, WB + (size_t)(l * 3 + 1) * D * 512, scr, r, lane); continue; } r -= I_BR;
            if (r < I_BR) { p0_transpose_item(IN_[I_WBC] + (size_t)l * 512 * D, 512, D, WB + (size_t)(l * 3 + 2) * D * 512, scr, r, lane); continue; } r -= I_BR;
            if (r < I_O) { p0_transpose_item(IN_[I_WOUT] + (size_t)l * D * D, D, D, WO + (size_t)l * D * D, scr, r, lane); continue; } r -= I_O;
            p0_transpose_item(IN_[I_PWQ] + (size_t)l * D * 2048, D, 2048, WQ + (size_t)l * 2048 * D, scr, r, lane);
        }
        for (int i = gt; i < DEPTH * 16 * 128 * 128 / 4; i += NGT) {
            const f32x4 v = *((const GAS f32x4*)IN_[I_PKEYS] + i);
            v2u o; o.x = pk2(v.x, v.y); o.y = pk2(v.z, v.w); *((GAS v2u*)KEYS + i) = o;
        }
        {
            LAS float* red = (LAS float*)(L + 9216);
            for (int rp_ = 0; rp_ < REP_P0D; ++rp_)
            for (int it = vcu; it < DEPTH * 96; it += G) {
                const int l = it / 96, nc = it % 96, n = nc * 64 + lane;
                const float* wm = IN_[I_WMOD] + (size_t)l * D * 6 * D + n;
                float a0 = 0.f, a1 = 0.f, a2 = 0.f;
#pragma unroll 1
                for (int half = 0; half < 2; ++half) {
                    const int kb = wave * 128 + half * 64;
                    const float c0 = IN_[I_C][kb + lane], c1 = IN_[I_C][D + kb + lane], c2 = IN_[I_CCTX][kb + lane];
                    const int s0 = __builtin_bit_cast(int, c0 * sigmoidf_(c0)), s1 = __builtin_bit_cast(int, c1 * sigmoidf_(c1)), s2 = __builtin_bit_cast(int, c2 * sigmoidf_(c2));
#pragma unroll
                    for (int kk = 0; kk < 64; ++kk) {
                        const float w = wm[(size_t)(kb + kk) * 6 * D];
                        a0 += __builtin_bit_cast(float, __builtin_amdgcn_readlane(s0, kk)) * w;
                        a1 += __builtin_bit_cast(float, __builtin_amdgcn_readlane(s1, kk)) * w;
                        a2 += __builtin_bit_cast(float, __builtin_amdgcn_readlane(s2, kk)) * w;
                    }
                }
                red[(wave * 3 + 0) * 64 + lane] = a0; red[(wave * 3 + 1) * 64 + lane] = a1; red[(wave * 3 + 2) * 64 + lane] = a2;
                __syncthreads();
                if (wave < 3) {
                    float sum = IN_[I_BMOD][l * 6 * D + n];
#pragma unroll
                    for (int w = 0; w < 8; ++w) sum += red[(w * 3 + wave) * 64 + lane];
                    MODV[(size_t)(l * 3 + wave) * 6 * D + n] = sum;
                }
                __syncthreads();
            }
        }
        for (int i = gt; i < SEQ * 32; i += NGT) {
            const int t = i >> 5, f = i & 31;
            const float inv = exp2f(-(float)(f & 15) * (13.287712379549449f / 16.0f));
            const float pos = (f < 16) ? (float)(t / GRID_W) : (float)(t % GRID_W);
            float sn, cs; sincosf(pos * inv, &sn, &cs);
            COS[i] = cs; SIN[i] = sn;
        }
    }
        for (int rp_ = 0; rp_ < REP_P0F; ++rp_)
#pragma unroll 4
        for (int rr = gw; rr < 2 * DEPTH * 16384; rr += NGW) {
            const int tab = rr / (DEPTH * 16384), row = rr % (DEPTH * 16384);
            const float* src = (tab == 0 ? IN_[I_PU] : IN_[I_PV]) + (size_t)row * D;
            f32x4 v[4]; float am = 0.f;
#pragma unroll
            for (int j = 0; j < 4; ++j) { v[j] = *((const GAS f32x4*)src + lane + 64 * j); am = fmaxf(am, fmaxf(fmaxf(fabsf(v[j].x), fabsf(v[j].y)), fmaxf(fabsf(v[j].z), fabsf(v[j].w)))); }
            am = wave_max(am);
            int ex = 0; float scale = 1.0f;
            if (am > 0.f) { (void)frexpf(am * (1.0f / 448.0f), &ex); scale = ldexpf(1.0f, ex); }
            const float inv = 1.0f / scale;
            v4u o;
#pragma unroll
            for (int j = 0; j < 4; ++j) {
                int p = __builtin_amdgcn_cvt_pk_fp8_f32(v[j].x * inv, v[j].y * inv, 0, false);
                p = __builtin_amdgcn_cvt_pk_fp8_f32(v[j].z * inv, v[j].w * inv, p, true);
                o[j] = (unsigned)p;
            }
            *((GAS v4u*)((tab == 0 ? U8 : V8) + (size_t)row * D) + lane) = o;
            if (lane == 0) (tab == 0 ? SCU : SCV)[row] = scale;
        }
        }
        }
#endif
    GRID_BAR();

    for (int layer = 0; layer < DEPTH; ++layer) {
        const bool last = (layer == DEPTH - 1);
        const int T_EFF = last ? T_LAT : T_ALL;

#ifndef SKIP_P1
        { PHASE_PTRS LAYER_PTRS
        for (int rep_ = 0; rep_ < REP_P1; ++rep_) {
        { const int ln = lane_id_v();
        if (layer == 0)
        for (int r = gw; r < T_ALL; r += NGW) {
            const float* md = modl + (size_t)row_modidx(r) * 6 * D;
            const GAS f32x4* xr = (const GAS f32x4*)xin_row(IN_[I_X], IN_[I_CTX], r) + ln;
            f32x4 v[4]; float ss = 0.f;
#pragma unroll
            for (int j = 0; j < 4; ++j) { v[j] = xr[64 * j]; ss += (v[j].x * v[j].x + v[j].y * v[j].y) + (v[j].z * v[j].z + v[j].w * v[j].w); }
            const float rs = 1.0f / sqrtf(wave_sum(ss) * (1.f / D) + NORM_EPS);
            GAS v2u* o8 = (GAS v2u*)(H + (size_t)r * D) + ln;
#pragma unroll
            for (int j = 0; j < 4; ++j) {
                const f32x4 g = *((const GAS f32x4*)(IN_[I_G1] + layer * D) + ln + 64 * j);
                const f32x4 sh = *((const GAS f32x4*)(md + 0) + ln + 64 * j), sc = *((const GAS f32x4*)(md + D) + ln + 64 * j);
                const f32x4 h = v[j] * rs * g * (sc + 1.0f) + sh;
                v2u o; o.x = pk2(h.x, h.y); o.y = pk2(h.z, h.w); o8[64 * j] = o;
            }
        }
        }
        }
        }
#endif
        if (layer == 0) GRID_BAR();

#ifndef SKIP_P2
        { PHASE_PTRS LAYER_PTRS
        for (int rep_ = 0; rep_ < REP_P2; ++rep_) {
        {
            pg8::Gemm g{H, WINl, D, D, D, 0, 0};
            pg8::SegOrder<1> S; S.T.init(T_ALL, IN_W, G, (int)blockIdx.x);
            EpiInProj E{AQ, AK, AVT, BQ, BK, BVT, CQ, CK, CVT, SG, COS, SIN};
            pg8::gemm_phase(L, g, S, E, wave);
        }
        }
        }
#endif
        GRID_BAR();

#ifndef SKIP_P3
        { PHASE_PTRS LAYER_PTRS
        {
            LAS bf16* Pl = (LAS bf16*)(L + wave * 8192);
            const float lam_init = 0.8f - 0.6f * expf(-0.3f * (float)layer);
            float lam;
            {
                const int ll = lane_id_v();
                const float* cl = IN_[I_LAMBDA] + layer * 256;
                const float s1 = wave_sum(cl[ll] * cl[64 + ll]), s2 = wave_sum(cl[128 + ll] * cl[192 + ll]);
                lam = expf(s1) - expf(s2) + lam_init;
            }
{ const int lo__ = lane_id_v(); { const int lane = lo__; const int fr = lane & 15, fq = lane >> 4, tid = wave * 64 + lane; (void)fr; (void)fq; (void)tid;
            {
                const int r32 = lane & 31, hi = lane >> 5;
                const int n_lat = BATCH * 4 * (SEQ / 256), n_ctx = last ? 0 : BATCH * 4;
                const int NU = (n_lat + G - 1) / G * G + n_ctx;
                for (int rep_ = 0; rep_ < REP_P3C; ++rep_)
                for (int u0 = vcu; u0 < NU; u0 += G) {
                    int b, h, row0, t_lo, t_hi;
                    if (u0 < n_lat) { const int bh = u0 >> 5; b = bh >> 2; h = bh & 3; row0 = b * SEQ + (u0 & 31) * 256; t_lo = 0; t_hi = 132; }
                    else { const int c = u0 - (n_lat + G - 1) / G * G; if (c < 0 || c >= n_ctx) continue; b = c >> 2; h = c & 3; row0 = T_LAT + b * CTX; t_lo = 128; t_hi = 132; }
                    const int qrow = row0 + wave * 32 + r32;
                    LAS unsigned* o1p = (LAS unsigned*)(L + 65536 + wave * 8192) + lane;
                    const int krow_s = tid >> 3, kch_s = tid & 7;
                    const int vrow_s0 = tid >> 4, vch_s = tid & 15;
                    LAS unsigned char* Kb0 = L; LAS unsigned char* Vb0 = L + 2 * CK_SZ;
#pragma unroll 1
                    for (int m = 0; m < 2; ++m) {
                        bf16x8 qf[4];
                        { const bf16* qp = CQ + (size_t)qrow * 512 + (h * 2 + m) * 64 + hi * 8;
#pragma unroll
                          for (int ks = 0; ks < 4; ++ks) qf[ks] = *(const GAS bf16x8*)(qp + ks * 16); }
                        f32x16 o[4];
#pragma unroll
                        for (int d = 0; d < 4; ++d)
#pragma unroll
                            for (int r = 0; r < 16; ++r) o[d][r] = 0.f;
                        float mrun = -1e30f, lpart = 0.f;
                        const bf16* kg = CK + (size_t)krow_s * 512 + (h * 2 + m) * 64 + kch_s * 8;
                        const bf16* vg = CVT + (size_t)vrow_s0 * 512 + h * 128 + vch_s * 8;
                        auto tile_row = [&](int j) { return (j < 128) ? b * SEQ + 64 * j : T_LAT + b * CTX + 64 * (j - 128); };
                        __syncthreads();
                        {
                            const size_t kb = (size_t)tile_row(t_lo) * 512;
                            const v4u kr = *(const GAS v4u*)(kg + kb), v0 = *(const GAS v4u*)(vg + kb), v1 = *(const GAS v4u*)(vg + kb + 32 * 512);
                            *(LAS v4u*)(Kb0 + krow_s * CK_PITCH + kch_s * 16) = kr;
                            *(LAS v4u*)(Vb0 + vrow_s0 * CV_PITCH + vch_s * 16) = v0; *(LAS v4u*)(Vb0 + (vrow_s0 + 32) * CV_PITCH + vch_s * 16) = v1;
                        }
                        __syncthreads();
#pragma unroll 1
                        for (int j = t_lo; j < t_hi; ++j) {
                            const int cur = (j - t_lo) & 1;
                            const LAS unsigned char* Kb = Kb0 + cur * CK_SZ; const LAS unsigned char* Vb = Vb0 + cur * CV_SZ;
                            v4u kr, v0, v1;
                            const bool more = (j + 1 < t_hi);
                            { const size_t kb = (size_t)tile_row(more ? j + 1 : j) * 512; kr = *(const GAS v4u*)(kg + kb); v0 = *(const GAS v4u*)(vg + kb); v1 = *(const GAS v4u*)(vg + kb + 32 * 512); }
                            f32x16 st[2];
#pragma unroll
                            for (int kb = 0; kb < 2; ++kb) {
#pragma unroll
                                for (int r = 0; r < 16; ++r) st[kb][r] = 0.f;
#pragma unroll
                                for (int ks = 0; ks < 4; ++ks) {
                                    const bf16x8 kf = *(const LAS bf16x8*)(Kb + (kb * 32 + r32) * CK_PITCH + ks * 32 + hi * 16);
                                    st[kb] = __builtin_amdgcn_mfma_f32_32x32x16_bf16(kf, qf[ks], st[kb], 0, 0, 0);
                                }
                            }
                            float mx = st[0][0];
#pragma unroll
                            for (int r = 1; r < 16; ++r) mx = fmaxf(mx, st[0][r]);
#pragma unroll
                            for (int r = 0; r < 16; ++r) mx = fmaxf(mx, st[1][r]);
                            mx = xmax32(mx);
                            if (__builtin_amdgcn_ballot_w64(mx > mrun + C_THR_RAW) != 0ull) {
                                const float mn = fmaxf(mrun, mx);
                                const float alpha = __builtin_amdgcn_exp2f((mrun - mn) * SCL2);
#pragma unroll
                                for (int d = 0; d < 4; ++d)
#pragma unroll
                                    for (int r = 0; r < 16; ++r) o[d][r] *= alpha;
                                lpart *= alpha; mrun = mn;
                            }
                            const float nmc = -mrun * SCL2;
                            float ls = 0.f;
#pragma unroll
                            for (int kb = 0; kb < 2; ++kb)
#pragma unroll
                                for (int r = 0; r < 16; ++r) { const float p = __builtin_amdgcn_exp2f(fmaf(st[kb][r], SCL2, nmc)); st[kb][r] = p; ls += p; }
                            lpart += ls;
                            {
                                const int q4 = (lane & 15) >> 2, p4 = lane & 3, grp = (lane >> 4) & 1;
                                const LAS unsigned char* vbase = Vb + (4 * hi + q4) * CV_PITCH + (16 * grp + 4 * p4) * 2;
#pragma unroll
                                for (int kb = 0; kb < 2; ++kb)
#pragma unroll
                                    for (int ss = 0; ss < 2; ++ss) {
                                        v4u pw;
#pragma unroll
                                        for (int i2 = 0; i2 < 4; ++i2) pw[i2] = cvtpk(st[kb][8 * ss + 2 * i2], st[kb][8 * ss + 2 * i2 + 1]);
                                        const bf16x8 pb = __builtin_bit_cast(bf16x8, pw);
#pragma unroll
                                        for (int d = 0; d < 4; ++d) {
                                            const LAS unsigned char* va = vbase + (kb * 32 + 16 * ss) * CV_PITCH + d * 64;
                                            const s16x4 lo = __builtin_bit_cast(s16x4, __builtin_amdgcn_ds_read_tr16_b64_v4i16((LAS s16x4*)va));
                                            const s16x4 hh = __builtin_bit_cast(s16x4, __builtin_amdgcn_ds_read_tr16_b64_v4i16((LAS s16x4*)(va + 8 * CV_PITCH)));
                                            const bf16x8 vf = __builtin_shufflevector(lo, hh, 0, 1, 2, 3, 4, 5, 6, 7);
                                            o[d] = __builtin_amdgcn_mfma_f32_32x32x16_bf16(vf, pb, o[d], 0, 0, 0);
                                        }
                                        if (ss == 1) __builtin_amdgcn_sched_barrier(0);
                                    }
                            }
                            if (more) {
                                LAS unsigned char* Kn = Kb0 + (cur ^ 1) * CK_SZ; LAS unsigned char* Vn = Vb0 + (cur ^ 1) * CV_SZ;
                                *(LAS v4u*)(Kn + krow_s * CK_PITCH + kch_s * 16) = kr;
                                *(LAS v4u*)(Vn + vrow_s0 * CV_PITCH + vch_s * 16) = v0; *(LAS v4u*)(Vn + (vrow_s0 + 32) * CV_PITCH + vch_s * 16) = v1;
                            }
                            __syncthreads();
                        }
                        const float lt = xadd32(lpart);
                        if (m == 0) {
                            const float inv = 1.0f / lt;
#pragma unroll
                            for (int d = 0; d < 4; ++d)
#pragma unroll
                                for (int i2 = 0; i2 < 8; ++i2) o1p[64 * (d * 8 + i2)] = cvtpk(o[d][2 * i2] * inv, o[d][2 * i2 + 1] * inv);
                        } else {
                            const float inv2 = lam / lt;
                            float ssq = 0.f;
#pragma unroll
                            for (int d = 0; d < 4; ++d)
#pragma unroll
                                for (int i2 = 0; i2 < 8; ++i2) {
                                    const unsigned w1 = o1p[64 * (d * 8 + i2)];
                                    const float a0 = bf2f(w1 & 0xffffu) - o[d][2 * i2] * inv2, a1 = bf2f(w1 >> 16) - o[d][2 * i2 + 1] * inv2;
                                    o[d][2 * i2] = a0; o[d][2 * i2 + 1] = a1; ssq += a0 * a0 + a1 * a1;
                                }
                            ssq = xadd32(ssq);
                            const float rn = 1.0f / sqrtf(ssq * (1.f / 128.f) + NORM_EPS) * (1.0f - lam_init);
                            bf16* yp = Y + (size_t)qrow * 1536 + 1024 + h * 128 + 4 * hi;
                            const float* sl = IN_[I_SUBLN] + layer * 512 + h * 128 + 4 * hi;
#pragma unroll
                            for (int d = 0; d < 4; ++d)
#pragma unroll
                                for (int g4 = 0; g4 < 4; ++g4) {
                                    const f32x4 gsl = *(const GAS f32x4*)(sl + d * 32 + 8 * g4);
                                    v2u w; w.x = cvtpk(o[d][4 * g4] * rn * gsl.x, o[d][4 * g4 + 1] * rn * gsl.y); w.y = cvtpk(o[d][4 * g4 + 2] * rn * gsl.z, o[d][4 * g4 + 3] * rn * gsl.w);
                                    *(GAS v2u*)(yp + d * 32 + 8 * g4) = w;
                                }
                        }
                    }
                }
                __syncthreads();
            }
} }
{ const int lo__ = lane_id_v(); { const int lane = lo__; const int tid = wave * 64 + lane, r32 = lane & 31, hi = lane >> 5;
            {
                const int n_lat = BATCH * 2 * (SEQ / 64), n_ctx = last ? 0 : BATCH * 2 * (CTX / 64);
                for (int rep_ = 0; rep_ < REP_P3A; ++rep_)
                for (int u0 = vcu; u0 < n_lat + n_ctx; u0 += G) {
                    const bool isctx = u0 >= n_lat;
                    int b, g, p0, qrow, nl, klo;
                    if (!isctx) { b = u0 >> 8; g = (u0 >> 7) & 1; p0 = (u0 & 127) * 64; qrow = b * SEQ + p0 + (wave & 1) * 32 + r32;
                                  klo = p0 >= 128 ? 0 : (128 - p0) / 64; const int khi = min(4, (SEQ - 1 - (p0 - 128)) / 64); nl = khi - klo + 1; }
                    else { const int c = u0 - n_lat; b = c >> 3; g = (c >> 2) & 1; p0 = (c & 3) * 64; qrow = T_LAT + b * CTX + p0 + (wave & 1) * 32 + r32; nl = 0; klo = 0; }
                    const int hq = g * 4 + (wave >> 1);
                    const int qpos0 = p0 + (wave & 1) * 32;
                    bf16x8 qf[4];
                    { const bf16* qp = AQ + (size_t)qrow * 512 + hq * 64 + hi * 8;
#pragma unroll
                      for (int ks = 0; ks < 4; ++ks) qf[ks] = *(const GAS bf16x8*)(qp + ks * 16); }
                    f32x16 o[2];
#pragma unroll
                    for (int d = 0; d < 2; ++d)
#pragma unroll
                        for (int r = 0; r < 16; ++r) o[d][r] = 0.f;
                    float mrun = IN_[I_SINK][layer * 8 + hq] * 8.0f;
                    float lpart = (hi == 0) ? 1.0f : 0.0f;
                    const bf16* kg = AK + (size_t)(tid >> 3) * 128 + g * 64 + (tid & 7) * 8;
                    const bf16* vg = AVT + (size_t)(tid >> 3) * 128 + g * 64 + (tid & 7) * 8;
                    const int kp0 = p0 - 128 + 64 * klo;
                    auto tile_row = [&](int j) { return (j < nl) ? b * SEQ + kp0 + 64 * j : T_LAT + b * CTX + 64 * (j - nl); };
                    auto use_tile = [&](int j) { if (j >= nl) return true; const int kp = kp0 + 64 * j; return (kp + 63 >= qpos0 - 128) && (kp <= qpos0 + 31 + 128); };
                    auto elem = [&](f32x16 (&st)[2], int j) {
                        if (j < nl) {
                            const int dq0 = (qpos0 + r32) - (kp0 + 64 * j + 4 * hi);
#pragma unroll
                            for (int kb = 0; kb < 2; ++kb)
#pragma unroll
                                for (int r = 0; r < 16; ++r) { const int dq = dq0 - (kb * 32 + (r & 3) + 8 * (r >> 2)); if (dq > 128 || dq < -128) st[kb][r] = -1e30f; }
                        }
                    };
                    attn64_pass<2>(o, mrun, lpart, qf, kg, 128, vg, 128, nl + 4, tile_row, use_tile, elem, L, lane, tid);
                    const float lt = xadd32(lpart);
                    attn64_store(o, 1.0f / lt, Y + (size_t)qrow * 1536 + hq * 64, hi);
                }
            }
} }
{ const int lo__ = lane_id_v(); { const int lane = lo__; const int tid = wave * 64 + lane, r32 = lane & 31, hi = lane >> 5;
            {
                const int n_lat = BATCH * 8 * 32, n_ctx = last ? 0 : BATCH * 8;
                LAS float* rpbL = (LAS float*)(L + 49152);
                for (int rep_ = 0; rep_ < REP_P3B; ++rep_)
                for (int u0 = vcu; u0 < n_lat + n_ctx; u0 += G) {
                    const bool isctx = u0 >= n_lat;
                    int b, h, gr = 0, qc0 = 0, qrow, nl, krlo;
                    if (!isctx) { b = u0 >> 8; h = (u0 >> 5) & 7; const int r0 = (u0 & 31) * 4; gr = r0 + (wave >> 1); qc0 = (wave & 1) * 32; qrow = b * SEQ + gr * GRID_W + qc0 + r32;
                                  krlo = min(max(r0 - 4, 0), 120); nl = min(max(r0 - 1, 0), 120) + 8 - krlo; }
                    else { const int c = u0 - n_lat; b = c >> 3; h = c & 7; qrow = T_LAT + b * CTX + wave * 32 + r32; nl = 0; krlo = 0; }
                    __syncthreads();
                    if (tid < 465) rpbL[tid] = IN_[I_RPB][(size_t)(layer * 8 + h) * 465 + tid] * 8.0f;
                    bf16x8 qf[4];
                    { const bf16* qp = BQ + (size_t)qrow * 512 + h * 64 + hi * 8;
#pragma unroll
                      for (int ks = 0; ks < 4; ++ks) qf[ks] = *(const GAS bf16x8*)(qp + ks * 16); }
                    f32x16 o[2];
#pragma unroll
                    for (int d = 0; d < 2; ++d)
#pragma unroll
                        for (int r = 0; r < 16; ++r) o[d][r] = 0.f;
                    float mrun = -1e30f, lpart = 0.f;
                    const bf16* kg = BK + (size_t)(tid >> 3) * 512 + h * 64 + (tid & 7) * 8;
                    const bf16* vg = BVT + (size_t)(tid >> 3) * 512 + h * 64 + (tid & 7) * 8;
                    const int rs = min(max(gr - 4, 0), 120);
                    auto tile_row = [&](int j) { return (j < nl) ? b * SEQ + (krlo + j) * GRID_W : T_LAT + b * CTX + 64 * (j - nl); };
                    auto use_tile = [&](int j) { if (j >= nl) return true; const int kr = krlo + j; return kr >= rs && kr < rs + 8; };
                    auto elem = [&](f32x16 (&st)[2], int j) {
                        if (j < nl) {
                            const int qc = qc0 + r32, cstart = min(max(qc - 8, 0), 48);
                            const LAS float* brow = rpbL + (krlo + j - gr + 7) * 31 + 15;
#pragma unroll
                            for (int kb = 0; kb < 2; ++kb)
#pragma unroll
                                for (int r = 0; r < 16; ++r) {
                                    const int kc = kb * 32 + (r & 3) + 8 * (r >> 2) + 4 * hi;
                                    const bool valid = (kc >= cstart) && (kc < cstart + 16);
                                    const int dc = min(max(kc - qc, -15), 15);
                                    st[kb][r] = valid ? st[kb][r] + brow[dc] : -1e30f;
                                }
                        }
                    };
                    attn64_pass<2>(o, mrun, lpart, qf, kg, 512, vg, 512, nl + 4, tile_row, use_tile, elem, L, lane, tid);
                    const float lt = xadd32(lpart);
                    attn64_store(o, 1.0f / lt, Y + (size_t)qrow * 1536 + 512 + h * 64, hi);
                }
                __syncthreads();
            }
} }
        }
        }
#endif
        GRID_BAR();

#ifndef SKIP_P4
        { PHASE_PTRS LAYER_PTRS
        for (int rep_ = 0; rep_ < REP_P4; ++rep_) {
        {
            pg8::Gemm g{Y, WB + (size_t)layer * 3 * D * 512, 1536, 512, 512, 512, (size_t)D * 512};
            pg8::SegOrder<3> S; S.T.init(T_LAT, D, G, (int)blockIdx.x);
            EpiBranch E{SG, MG};
            pg8::gemm_phase(L, g, S, E, wave);
        }
        if (!last) { const int lo__ = lane_id_v(); { const int lane = lo__; const int fr = lane & 15, fq = lane >> 4; (void)fr; (void)fq;
            for (int it = gw; it < (T_ALL - T_LAT) / 32 * (D / 32); it += NGW) {
                const int row0 = T_LAT + (it / (D / 32)) * 32, col0 = (it % (D / 32)) * 32;
                f32x4 mg[2][2]; zero_acc22(mg);
#pragma unroll 1
                for (int seg = 0; seg < 3; ++seg) {
                    f32x4 acc[2][2]; zero_acc22(acc);
                    sgemm32<8>(acc, Y + seg * 512, 1536, WB + (size_t)(layer * 3 + seg) * D * 512, 512, 512, row0, col0, lane);
#pragma unroll
                    for (int m = 0; m < 2; ++m)
#pragma unroll
                        for (int r = 0; r < 4; ++r) {
                            const bf16* gp = SG + (size_t)(row0 + 16 * m + 4 * fq + r) * 3072 + seg * 1024 + col0 + fr;
#pragma unroll
                            for (int n = 0; n < 2; ++n) mg[m][n][r] += bf2f(gp[16 * n]) * acc[m][n][r];
                        }
                }
#pragma unroll
                for (int m = 0; m < 2; ++m)
#pragma unroll
                    for (int r = 0; r < 4; ++r) {
                        bf16* rowp = MG + (size_t)(row0 + 16 * m + 4 * fq + r) * D + col0 + fr;
#pragma unroll
                        for (int n = 0; n < 2; ++n) rowp[16 * n] = (bf16)f2bf(mg[m][n][r]);
                    }
            }
} }
        }
        }
#endif
        GRID_BAR();

#ifndef SKIP_P5
        { PHASE_PTRS LAYER_PTRS
        {
            pg8::Gemm g{MG, WO + (size_t)layer * D * D, D, D, D, 0, 0};
            pg8::SegOrder<1> S; S.T.init(T_LAT, D, G, (int)blockIdx.x);
            EpiOut E{X, modl, layer == 0 ? IN_[I_X] : nullptr, IN_[I_CTX]};
            pg8::gemm_phase(L, g, S, E, wave);
        }
        if (!last) { const int lo__ = lane_id_v(); { const int lane = lo__; const int fr = lane & 15, fq = lane >> 4; (void)fr; (void)fq;
            for (int it = gw; it < (T_ALL - T_LAT) / 32 * (D / 32); it += NGW) {
                const int row0 = T_LAT + (it / (D / 32)) * 32, col0 = (it % (D / 32)) * 32;
                f32x4 acc[2][2]; zero_acc22(acc);
                sgemm32<8>(acc, MG, D, WO + (size_t)layer * D * D, D, D, row0, col0, lane);
                const float* gt = modl + (size_t)2 * 6 * D + 2 * D + col0 + fr;
#pragma unroll
                for (int m = 0; m < 2; ++m)
#pragma unroll
                    for (int r = 0; r < 4; ++r) {
                        float* rowp = X + (size_t)(row0 + 16 * m + 4 * fq + r) * D + col0 + fr;
                        const float* srcp = (layer == 0) ? IN_[I_CTX] + (size_t)(row0 - T_LAT + 16 * m + 4 * fq + r) * D + col0 + fr : rowp;
#pragma unroll
                        for (int n = 0; n < 2; ++n) rowp[16 * n] = srcp[16 * n] + gt[16 * n] * acc[m][n][r];
                    }
            }
} }
        }
#endif
        GRID_BAR();

#ifndef SKIP_P6
        { PHASE_PTRS LAYER_PTRS
        for (int rep_ = 0; rep_ < REP_P6; ++rep_) {
        { const int ln = lane_id_v();
        for (int r = gw; r < T_EFF; r += NGW) {
            const float* md = modl + (size_t)row_modidx(r) * 6 * D;
            const GAS f32x4* xr = (const GAS f32x4*)(X + (size_t)r * D) + ln;
            f32x4 v[4]; float ss = 0.f;
#pragma unroll
            for (int j = 0; j < 4; ++j) { v[j] = xr[64 * j]; ss += (v[j].x * v[j].x + v[j].y * v[j].y) + (v[j].z * v[j].z + v[j].w * v[j].w); }
            const float rs = 1.0f / sqrtf(wave_sum(ss) * (1.f / D) + NORM_EPS);
            GAS v2u* o8 = (GAS v2u*)(H + (size_t)r * D) + ln;
#pragma unroll
            for (int j = 0; j < 4; ++j) {
                const f32x4 g = *((const GAS f32x4*)(IN_[I_G2] + layer * D) + ln + 64 * j);
                const f32x4 sh = *((const GAS f32x4*)(md + 3 * D) + ln + 64 * j), sc = *((const GAS f32x4*)(md + 4 * D) + ln + 64 * j);
                const f32x4 h = v[j] * rs * g * (sc + 1.0f) + sh;
                v2u o; o.x = pk2(h.x, h.y); o.y = pk2(h.z, h.w); o8[64 * j] = o;
            }
        }
        }
        }
        }
#endif
        GRID_BAR();

#ifndef SKIP_P7
        { PHASE_PTRS LAYER_PTRS
        for (int rep_ = 0; rep_ < REP_P7; ++rep_) {
        {
            pg8::Gemm g{H, WQ + (size_t)layer * 2048 * D, D, D, D, 0, 0};
            pg8::SegOrder<1> S; S.T.init(T_LAT, 2048, G, (int)blockIdx.x);
            EpiStore E{Q2, 2048};
            pg8::gemm_phase(L, g, S, E, wave);
        }
        if (!last) { const int lo__ = lane_id_v(); { const int lane = lo__; const int fr = lane & 15, fq = lane >> 4; (void)fr; (void)fq;
            for (int it = gw; it < (T_ALL - T_LAT) / 32 * (2048 / 32); it += NGW) {
                const int row0 = T_LAT + (it / (2048 / 32)) * 32, col0 = (it % (2048 / 32)) * 32;
                f32x4 acc[2][2]; zero_acc22(acc);
                sgemm32<8>(acc, H, D, WQ + (size_t)layer * 2048 * D, D, D, row0, col0, lane);
#pragma unroll
                for (int m = 0; m < 2; ++m)
#pragma unroll
                    for (int r = 0; r < 4; ++r) {
                        bf16* rowp = Q2 + (size_t)(row0 + 16 * m + 4 * fq + r) * 2048 + col0 + fr;
#pragma unroll
                        for (int n = 0; n < 2; ++n) rowp[16 * n] = (bf16)f2bf(acc[m][n][r]);
                    }
            }
} }
        }
        }
#endif
        GRID_BAR();

#ifndef SKIP_P8
        { PHASE_PTRS LAYER_PTRS
        for (int rep_ = 0; rep_ < REP_P8; ++rep_) {
{ const int lo__ = lane_id_v(); { const int lane = lo__; const int fr = lane & 15, fq = lane >> 4, tid = wave * 64 + lane; (void)fr; (void)fq; (void)tid;
        {
            const int NMT = T_EFF / 256; constexpr int NNT = 2048 / 128;
            const int wr = wave >> 1, wc = wave & 1;
            for (int it = vcu; it < NMT * NNT; it += G) {
                const int pm = it / NNT, grp = it % NNT;
                const int row0 = pm * 256 + wr * 64, c0 = wc * 64;
                f32x4 acc[4][4]; zero_acc<4>(acc);
                sgemm_tile(acc, Q2 + grp * 128, 2048, KEYS + (size_t)(layer * 16 + grp) * 128 * 128, 128, 128, row0, c0, lane);
#pragma unroll
                for (int m = 0; m < 4; ++m)
#pragma unroll
                    for (int r = 0; r < 4; ++r) {
                        float* rowp = SC + (size_t)(row0 + 16 * m + 4 * fq + r) * 2048 + grp * 128 + c0 + fr;
#pragma unroll
                        for (int n = 0; n < 4; ++n) rowp[16 * n] = acc[m][n][r];
                    }
            }
        }
} }
        }
        }
#endif
        GRID_BAR();

#ifndef SKIP_P9
        { PHASE_PTRS LAYER_PTRS
        for (int rep_ = 0; rep_ < REP_P9; ++rep_) {
{ const int lo__ = lane_id_v(); { const int lane = lo__; const int fr = lane & 15, fq = lane >> 4, tid = wave * 64 + lane; (void)fr; (void)fq; (void)tid;
        for (int it = vcu * NTHREADS + tid; it < T_EFF * PEER_HEADS; it += NGT) {
            const int t = it >> 3, hh = it & 7;
            const float* sc = SC + (size_t)t * 2048 + hh * 256;
            int a0[16], a1[16];
#define LOAD_CHUNK(v, base, ch) _Pragma("unroll") for (int q = 0; q < 4; ++q) { const f32x4 x = *(const GAS f32x4*)((base) + (ch) * 16 + 4 * q); \
                    v[4 * q + 0] = (f2ord(x.x) & ~127) | ((ch) * 16 + 4 * q + 0); v[4 * q + 1] = (f2ord(x.y) & ~127) | ((ch) * 16 + 4 * q + 1); \
                    v[4 * q + 2] = (f2ord(x.z) & ~127) | ((ch) * 16 + 4 * q + 2); v[4 * q + 3] = (f2ord(x.w) & ~127) | ((ch) * 16 + 4 * q + 3); }
            LOAD_CHUNK(a0, sc, 0) sort16_desc(a0);
#pragma unroll 1
            for (int ch = 1; ch < 8; ++ch) { int v[16]; LOAD_CHUNK(v, sc, ch) sort16_desc(v); merge16_desc(a0, v); }
            LOAD_CHUNK(a1, sc + 128, 0) sort16_desc(a1);
#pragma unroll 1
            for (int ch = 1; ch < 8; ++ch) { int v[16]; LOAD_CHUNK(v, sc + 128, ch) sort16_desc(v); merge16_desc(a1, v); }
#undef LOAD_CHUNK
            float va[16], vb[16];
#pragma unroll
            for (int i = 0; i < 16; ++i) { va[i] = ord2f(a0[i] & ~127); vb[i] = ord2f(a1[i] & ~127); }
            int c[16];
            {
                int v[16];
                v[0] = (f2ord(va[0] + vb[0]) & ~255) | 0;
                v[1] = (f2ord(va[0] + vb[1]) & ~255) | 1;
                v[2] = (f2ord(va[0] + vb[2]) & ~255) | 2;
                v[3] = (f2ord(va[0] + vb[3]) & ~255) | 3;
                v[4] = (f2ord(va[0] + vb[4]) & ~255) | 4;
                v[5] = (f2ord(va[0] + vb[5]) & ~255) | 5;
                v[6] = (f2ord(va[0] + vb[6]) & ~255) | 6;
                v[7] = (f2ord(va[0] + vb[7]) & ~255) | 7;
                v[8] = (f2ord(va[0] + vb[8]) & ~255) | 8;
                v[9] = (f2ord(va[0] + vb[9]) & ~255) | 9;
                v[10] = (f2ord(va[0] + vb[10]) & ~255) | 10;
                v[11] = (f2ord(va[0] + vb[11]) & ~255) | 11;
                v[12] = (f2ord(va[0] + vb[12]) & ~255) | 12;
                v[13] = (f2ord(va[0] + vb[13]) & ~255) | 13;
                v[14] = (f2ord(va[0] + vb[14]) & ~255) | 14;
                v[15] = (f2ord(va[0] + vb[15]) & ~255) | 15;
                sort16_desc(v);
#pragma unroll
                for (int i = 0; i < 16; ++i) c[i] = v[i];
            }
            {
                int v[16];
                v[0] = (f2ord(va[1] + vb[0]) & ~255) | 16;
                v[1] = (f2ord(va[1] + vb[1]) & ~255) | 17;
                v[2] = (f2ord(va[1] + vb[2]) & ~255) | 18;
                v[3] = (f2ord(va[1] + vb[3]) & ~255) | 19;
                v[4] = (f2ord(va[1] + vb[4]) & ~255) | 20;
                v[5] = (f2ord(va[1] + vb[5]) & ~255) | 21;
                v[6] = (f2ord(va[1] + vb[6]) & ~255) | 22;
                v[7] = (f2ord(va[1] + vb[7]) & ~255) | 23;
                v[8] = (f2ord(va[2] + vb[0]) & ~255) | 32;
                v[9] = (f2ord(va[2] + vb[1]) & ~255) | 33;
                v[10] = (f2ord(va[2] + vb[2]) & ~255) | 34;
                v[11] = (f2ord(va[2] + vb[3]) & ~255) | 35;
                v[12] = (f2ord(va[2] + vb[4]) & ~255) | 36;
                v[13] = (f2ord(va[3] + vb[0]) & ~255) | 48;
                v[14] = (f2ord(va[3] + vb[1]) & ~255) | 49;
                v[15] = (f2ord(va[3] + vb[2]) & ~255) | 50;
                sort16_desc(v);
                merge16_desc(c, v);
            }
            {
                int v[16];
                v[0] = (f2ord(va[3] + vb[3]) & ~255) | 51;
                v[1] = (f2ord(va[4] + vb[0]) & ~255) | 64;
                v[2] = (f2ord(va[4] + vb[1]) & ~255) | 65;
                v[3] = (f2ord(va[4] + vb[2]) & ~255) | 66;
                v[4] = (f2ord(va[5] + vb[0]) & ~255) | 80;
                v[5] = (f2ord(va[5] + vb[1]) & ~255) | 81;
                v[6] = (f2ord(va[6] + vb[0]) & ~255) | 96;
                v[7] = (f2ord(va[6] + vb[1]) & ~255) | 97;
                v[8] = (f2ord(va[7] + vb[0]) & ~255) | 112;
                v[9] = (f2ord(va[7] + vb[1]) & ~255) | 113;
                v[10] = (f2ord(va[8] + vb[0]) & ~255) | 128;
                v[11] = (f2ord(va[9] + vb[0]) & ~255) | 144;
                v[12] = (f2ord(va[10] + vb[0]) & ~255) | 160;
                v[13] = (f2ord(va[11] + vb[0]) & ~255) | 176;
                v[14] = (f2ord(va[12] + vb[0]) & ~255) | 192;
                v[15] = (f2ord(va[13] + vb[0]) & ~255) | 208;
                sort16_desc(v);
                merge16_desc(c, v);
            }
            {
                int v[16];
                v[0] = (f2ord(va[14] + vb[0]) & ~255) | 224;
                v[1] = (f2ord(va[15] + vb[0]) & ~255) | 240;
                v[2] = (int)0x80000000;
                v[3] = (int)0x80000000;
                v[4] = (int)0x80000000;
                v[5] = (int)0x80000000;
                v[6] = (int)0x80000000;
                v[7] = (int)0x80000000;
                v[8] = (int)0x80000000;
                v[9] = (int)0x80000000;
                v[10] = (int)0x80000000;
                v[11] = (int)0x80000000;
                v[12] = (int)0x80000000;
                v[13] = (int)0x80000000;
                v[14] = (int)0x80000000;
                v[15] = (int)0x80000000;
                sort16_desc(v);
                merge16_desc(c, v);
            }
            const float smax = ord2f(c[0] & ~255);
            float pe[16]; float psum = 0.f;
#pragma unroll
            for (int k = 0; k < 16; ++k) { pe[k] = __expf(ord2f(c[k] & ~255) - smax); psum += pe[k]; }
            const float ip = 1.0f / psum;
#pragma unroll
            for (int k = 0; k < 16; ++k) {
                const int ij = c[k] & 255, ii = ij >> 4, jj = ij & 15;
                int e0 = 0, e1 = 0;
#pragma unroll
                for (int q = 0; q < 16; ++q) { e0 = (ii == q) ? (a0[q] & 127) : e0; e1 = (jj == q) ? (a1[q] & 127) : e1; }
                const int e = e0 * PEER_KEYS + e1;
                const float su = SCU[layer * 16384 + e], sv = SCV[layer * 16384 + e];
                EI[(size_t)t * NSEL + hh * 16 + k] = (unsigned)e | (f2bf(su) << 16);
                EG[(size_t)t * NSEL + hh * 16 + k] = pe[k] * ip * sv;
                if ((k & 3) == 3) __builtin_amdgcn_sched_barrier(0);
            }
        }
} }
        }
        }
#endif
        GRID_BAR();

#ifndef SKIP_P10
#if P10_SLICED
#define P10_CENSUS \
        unsigned myx_, nx_ = 1u, smask_ = 0u; { unsigned cnt_[16]; unsigned* bw_ = (unsigned*)(args.ws + WS_CTL) + CW_BAR; \
            _Pragma("unroll") for (int j = 0; j < 16; ++j) cnt_[j] = (unsigned)__builtin_amdgcn_readfirstlane((int)xb_ld(&bw_[XB_XCNT(j)])); \
            myx_ = xb_xcc_id(); unsigned np_ = 0u; \
            _Pragma("unroll") for (int j = 0; j < 16; ++j) { np_ += (cnt_[j] > 0u) ? 1u : 0u; nx_ = ((unsigned)j == myx_) ? cnt_[j] : nx_; } \
            if (np_ == 0u) np_ = 1u; if (nx_ == 0u) nx_ = 1u; \
            _Pragma("unroll") for (int sl = 0; sl < 8; ++sl) { const unsigned k_ = (unsigned)sl % np_; unsigned seen_ = 0u, srv_ = 0xffu; \
                _Pragma("unroll") for (int j = 0; j < 16; ++j) { if (cnt_[j] > 0u) { srv_ = (seen_ == k_) ? (unsigned)j : srv_; ++seen_; } } \
                smask_ |= (srv_ == myx_) ? (1u << sl) : 0u; } } \
        const int rank_ = (int)__builtin_amdgcn_readfirstlane((int)MISC[12]); const int wstride_ = (int)nx_ * NWAVES; (void)rank_; (void)wstride_;
        { PHASE_PTRS LAYER_PTRS
        { const int ln = lane_id_v(); const int c = ln & 7, sg = ln >> 3;
          P10_CENSUS
          float* PART = (float*)(wsq + WS_PART);
          const unsigned char* U8l = U8 + (size_t)layer * 16384 * D;
          for (int rep_ = 0; rep_ < REP_P10A; ++rep_)
#pragma unroll 1
          for (int sl = 0; sl < 8; ++sl) {
            if (!((smask_ >> sl) & 1u)) continue;
            const int t0 = rank_ * NWAVES + wave;
            if (t0 >= T_EFF) continue;
            const int tlast = t0 + ((T_EFF - 1 - t0) / wstride_) * wstride_;
#define A_LOAD_E(ev, tt) { const int tq_ = min((tt), tlast); _Pragma("unroll") for (int g = 0; g < 16; ++g) ev[g] = EI[(size_t)tq_ * NSEL + 8 * g + sg] & 0xffffu; }
#define A_ISSUE(rowv, hvv, ev, tt) { const int tq_ = min((tt), tlast); \
                _Pragma("unroll") for (int g = 0; g < 16; ++g) rowv[g] = *(const GAS v4u*)(U8l + (size_t)ev[g] * D + 128 * sl + 16 * c); \
                _Pragma("unroll") for (int j = 0; j < 4; ++j) hvv[j] = *(const GAS v2u*)(H + (size_t)tq_ * D + 256 * j + 32 * sl + 4 * c); }
#define A_COMPUTE(rowv, hvv, tt) if ((tt) <= tlast) { f32x2 hlo[4], hhi[4]; \
                _Pragma("unroll") for (int j = 0; j < 4; ++j) { hlo[j] = (f32x2){bf2f(hvv[j].x & 0xffffu), bf2f(hvv[j].x >> 16)}; hhi[j] = (f32x2){bf2f(hvv[j].y & 0xffffu), bf2f(hvv[j].y >> 16)}; } \
                _Pragma("unroll") for (int g = 0; g < 16; ++g) { f32x2 d2 = (f32x2){0.f, 0.f}; \
                    _Pragma("unroll") for (int j = 0; j < 4; ++j) { const f32x2 a = __builtin_amdgcn_cvt_pk_f32_fp8((int)rowv[g][j], false), b = __builtin_amdgcn_cvt_pk_f32_fp8((int)rowv[g][j], true); \
                        d2 = __builtin_elementwise_fma(a, hlo[j], d2); d2 = __builtin_elementwise_fma(b, hhi[j], d2); } \
                    float dd = d2.x + d2.y; asm volatile("" : "+v"(dd)); dd = sum8_dpp(dd); \
                    if (c == 0) PART[((size_t)sl * T_ALL + (tt)) * NSEL + 8 * g + sg] = dd; } }
            unsigned eA[16], eB[16]; v4u rowA[16], rowB[16]; v2u hA[4], hB[4];
            A_LOAD_E(eA, t0) A_LOAD_E(eB, t0 + wstride_)
            A_ISSUE(rowA, hA, eA, t0)
#pragma unroll 1
            for (int ta = t0; ta <= tlast; ta += 2 * wstride_) {
                A_ISSUE(rowB, hB, eB, ta + wstride_) A_LOAD_E(eA, ta + 2 * wstride_)
                __builtin_amdgcn_sched_barrier(0);
                A_COMPUTE(rowA, hA, ta)
                __builtin_amdgcn_sched_barrier(0);
                A_ISSUE(rowA, hA, eA, ta + 2 * wstride_) A_LOAD_E(eB, ta + 3 * wstride_)
                __builtin_amdgcn_sched_barrier(0);
                A_COMPUTE(rowB, hB, ta + wstride_)
                __builtin_amdgcn_sched_barrier(0);
            }
#undef A_LOAD_E
#undef A_ISSUE
#undef A_COMPUTE
          }
        } }
        GRID_BAR();
        { PHASE_PTRS LAYER_PTRS
        { const int ln = lane_id_v();
          const float* PART = (const float*)(wsq + WS_PART); float* WGT = (float*)(wsq + WS_WGT);
          for (int rep_ = 0; rep_ < REP_P10B; ++rep_)
          for (int i = vcu * NTHREADS + wave * 64 + ln; i < T_EFF * NSEL; i += NGT) {
              float dsum = 0.f;
#pragma unroll
              for (int sl = 0; sl < 8; ++sl) dsum += PART[(size_t)sl * T_ALL * NSEL + i];
              const unsigned esu = EI[i];
              const float dot = dsum * bf2f(esu >> 16);
              ((unsigned*)WGT)[i] = (esu & 0xffffu) | (f2bf(0.5f * dot * (1.0f + erff(dot * 0.70710678118654752f)) * EG[i]) << 16);
          }
        } }
        GRID_BAR();
        { PHASE_PTRS LAYER_PTRS
        { const int ln = lane_id_v(); const int c = ln & 7, sg = ln >> 3;
          P10_CENSUS
          const float* WGT = (const float*)(wsq + WS_WGT); float* XO = (float*)(wsq + WS_XO);
          const unsigned char* V8l = V8 + (size_t)layer * 16384 * D;
          for (int rep_ = 0; rep_ < REP_P10C; ++rep_)
#pragma unroll 1
          for (int sl = 0; sl < 8; ++sl) {
            if (!((smask_ >> sl) & 1u)) continue;
            const int t0 = rank_ * NWAVES + wave;
            if (t0 >= T_EFF) continue;
            const int tlast = t0 + ((T_EFF - 1 - t0) / wstride_) * wstride_;
#define C_LOAD_E(ev, tt) { const int tq_ = min((tt), tlast); _Pragma("unroll") for (int g = 0; g < 16; ++g) ev[g] = ((const unsigned*)WGT)[(size_t)tq_ * NSEL + 8 * g + sg]; }
#define C_ISSUE(rowv, wv, ev) { _Pragma("unroll") for (int g = 0; g < 16; ++g) { rowv[g] = *(const GAS v4u*)(V8l + (size_t)(ev[g] & 0xffffu) * D + 128 * sl + 16 * c); wv[g] = ev[g] >> 16; } }
#define C_COMPUTE(rowv, wv, tt) if ((tt) <= tlast) { f32x4 o[4]; \
                _Pragma("unroll") for (int j = 0; j < 4; ++j) o[j] = (f32x4){0.f, 0.f, 0.f, 0.f}; \
                _Pragma("unroll") for (int g = 0; g < 16; ++g) { const float wq_ = bf2f(wv[g]); const f32x2 w2_ = (f32x2){wq_, wq_}; _Pragma("unroll") for (int j = 0; j < 4; ++j) { \
                    const f32x2 a = __builtin_amdgcn_cvt_pk_f32_fp8((int)rowv[g][j], false), b = __builtin_amdgcn_cvt_pk_f32_fp8((int)rowv[g][j], true); \
                    f32x2 lo_ = (f32x2){o[j].x, o[j].y}, hi_ = (f32x2){o[j].z, o[j].w}; lo_ = __builtin_elementwise_fma(a, w2_, lo_); hi_ = __builtin_elementwise_fma(b, w2_, hi_); \
                    o[j].x = lo_.x; o[j].y = lo_.y; o[j].z = hi_.x; o[j].w = hi_.y; } \
                    asm volatile("" : "+v"(o[0]), "+v"(o[1]), "+v"(o[2]), "+v"(o[3])); } \
                _Pragma("unroll") for (int j = 0; j < 4; ++j) { \
                    o[j].x += dpp_mov<0x128>(o[j].x); o[j].y += dpp_mov<0x128>(o[j].y); o[j].z += dpp_mov<0x128>(o[j].z); o[j].w += dpp_mov<0x128>(o[j].w); \
                    o[j].x += xshfl_l<16>(o[j].x, ln); o[j].y += xshfl_l<16>(o[j].y, ln); o[j].z += xshfl_l<16>(o[j].z, ln); o[j].w += xshfl_l<16>(o[j].w, ln); \
                    o[j].x += xshfl_l<32>(o[j].x, ln); o[j].y += xshfl_l<32>(o[j].y, ln); o[j].z += xshfl_l<32>(o[j].z, ln); o[j].w += xshfl_l<32>(o[j].w, ln); } \
                if (sg == 0) { _Pragma("unroll") for (int j = 0; j < 4; ++j) *(GAS f32x4*)(XO + (size_t)(tt) * D + 256 * j + 32 * sl + 4 * c) = o[j]; } }
            unsigned eA[16], eB[16], wA[16], wB[16]; v4u rowA[16], rowB[16];
            C_LOAD_E(eA, t0) C_LOAD_E(eB, t0 + wstride_)
            C_ISSUE(rowA, wA, eA)
#pragma unroll 1
            for (int ta = t0; ta <= tlast; ta += 2 * wstride_) {
                C_ISSUE(rowB, wB, eB) C_LOAD_E(eA, ta + 2 * wstride_)
                __builtin_amdgcn_sched_barrier(0);
                C_COMPUTE(rowA, wA, ta)
                __builtin_amdgcn_sched_barrier(0);
                C_ISSUE(rowA, wA, eA) C_LOAD_E(eB, ta + 3 * wstride_)
                __builtin_amdgcn_sched_barrier(0);
                C_COMPUTE(rowB, wB, ta + wstride_)
                __builtin_amdgcn_sched_barrier(0);
            }
#undef C_LOAD_E
#undef C_ISSUE
#undef C_COMPUTE
          }
        } }
        GRID_BAR();
#undef P10_CENSUS
#endif
        { PHASE_PTRS LAYER_PTRS
        { const int ln = lane_id_v();
        {
            const unsigned char* U8l = U8 + (size_t)layer * 16384 * D;
            const unsigned char* V8l = V8 + (size_t)layer * 16384 * D;
            for (int rep_ = 0; rep_ < REP_P10; ++rep_)
            for (int t = gw; t < T_EFF; t += NGW) {
#if !P10_SLICED
                f32x4 hv[4];
                { const GAS v2u* hp = (const GAS v2u*)(H + (size_t)t * D) + ln;
#pragma unroll
                  for (int j = 0; j < 4; ++j) { const v2u w = hp[64 * j]; hv[j] = (f32x4){bf2f(w.x & 0xffffu), bf2f(w.x >> 16), bf2f(w.y & 0xffffu), bf2f(w.y >> 16)}; } }
#endif
#if P10_SLICED
                f32x4 o[4];
#pragma unroll
                for (int j = 0; j < 4; ++j) o[j] = *((const GAS f32x4*)((const float*)(wsq + WS_XO) + (size_t)t * D) + ln + 64 * j);
#else
                f32x4 o[4];
#pragma unroll
                for (int j = 0; j < 4; ++j) o[j] = (f32x4){0.f, 0.f, 0.f, 0.f};
#pragma unroll 1
                for (int s0 = 0; s0 < NSEL; s0 += 32) {
                    const unsigned esu = EI[(size_t)t * NSEL + s0 + (ln & 31)]; const float gv = EG[(size_t)t * NSEL + s0 + (ln & 31)];
                    int eidx = (int)(esu & 0xffffu); const float su = bf2f(esu >> 16);
                    float p[32];
                    {
                        v4u rowa[8], rowb[8];
#pragma unroll
                        for (int q = 0; q < 8; ++q) { const int e = __builtin_amdgcn_readlane(eidx, q); rowa[q] = *((const GAS v4u*)(U8l + (size_t)e * D) + ln); }
#pragma unroll
                        for (int g = 0; g < 4; ++g) {
                            if (g < 3) {
#pragma unroll
                                for (int q = 0; q < 8; ++q) { const int e = __builtin_amdgcn_readlane(eidx, (g + 1) * 8 + q);
                                    if (g & 1) rowa[q] = *((const GAS v4u*)(U8l + (size_t)e * D) + ln); else rowb[q] = *((const GAS v4u*)(U8l + (size_t)e * D) + ln); }
                            }
                            __builtin_amdgcn_sched_barrier(0);
#pragma unroll
                            for (int q = 0; q < 8; ++q) {
                                const v4u rw = (g & 1) ? rowb[q] : rowa[q];
                                float dd = 0.f;
#pragma unroll
                                for (int j = 0; j < 4; ++j) {
                                    const f32x2 a = __builtin_amdgcn_cvt_pk_f32_fp8((int)rw[j], false), b = __builtin_amdgcn_cvt_pk_f32_fp8((int)rw[j], true);
                                    dd += (a.x * hv[j].x + a.y * hv[j].y) + (b.x * hv[j].z + b.y * hv[j].w);
                                }
                                asm volatile("" : "+v"(dd));
                                p[g * 8 + q] = dd;
                                __builtin_amdgcn_sched_barrier(0);
                            }
                        }
                    }
#define TR_STEP(W) { const bool up = (ln & W) != 0; _Pragma("unroll") for (int i = 0; i < W; ++i) { const float send = up ? p[i] : p[i + W], keep = up ? p[i + W] : p[i]; p[i] = keep + xshfl_l<W>(send, ln); } }
                    TR_STEP(16) TR_STEP(8) TR_STEP(4) TR_STEP(2) TR_STEP(1)
#undef TR_STEP
                    const float dot = (p[0] + xshfl_l<32>(p[0], ln)) * su;
                    float wgt = 0.5f * dot * (1.0f + erff(dot * 0.70710678118654752f)) * gv;
                    asm volatile("" : "+v"(eidx), "+v"(wgt));
                    {
                        v4u rowa[8], rowb[8];
#pragma unroll
                        for (int q = 0; q < 8; ++q) { const int e = __builtin_amdgcn_readlane(eidx, q); rowa[q] = *((const GAS v4u*)(V8l + (size_t)e * D) + ln); }
#pragma unroll
                        for (int g = 0; g < 4; ++g) {
                            if (g < 3) {
#pragma unroll
                                for (int q = 0; q < 8; ++q) { const int e = __builtin_amdgcn_readlane(eidx, (g + 1) * 8 + q);
                                    if (g & 1) rowa[q] = *((const GAS v4u*)(V8l + (size_t)e * D) + ln); else rowb[q] = *((const GAS v4u*)(V8l + (size_t)e * D) + ln); }
                            }
                            __builtin_amdgcn_sched_barrier(0);
#pragma unroll
                            for (int q = 0; q < 8; ++q) {
                                const v4u rw = (g & 1) ? rowb[q] : rowa[q];
                                const float wq = __builtin_bit_cast(float, __builtin_amdgcn_readlane(__builtin_bit_cast(int, wgt), g * 8 + q));
#pragma unroll
                                for (int j = 0; j < 4; ++j) {
                                    const f32x2 a = __builtin_amdgcn_cvt_pk_f32_fp8((int)rw[j], false), b = __builtin_amdgcn_cvt_pk_f32_fp8((int)rw[j], true);
                                    o[j].x += wq * a.x; o[j].y += wq * a.y; o[j].z += wq * b.x; o[j].w += wq * b.y;
                                }
                                asm volatile("" : "+v"(o[0]), "+v"(o[1]), "+v"(o[2]), "+v"(o[3]));
                                __builtin_amdgcn_sched_barrier(0);
                            }
                        }
                    }
                }
#endif
                const float* gt2 = modl + (size_t)row_modidx(t) * 6 * D + 5 * D;
                GAS f32x4* xr = (GAS f32x4*)(X + (size_t)t * D) + ln;
                f32x4 xn[4]; float ss = 0.f;
#pragma unroll
                for (int j = 0; j < 4; ++j) {
                    xn[j] = xr[64 * j] + *((const GAS f32x4*)gt2 + ln + 64 * j) * o[j];
                    ss += (xn[j].x * xn[j].x + xn[j].y * xn[j].y) + (xn[j].z * xn[j].z + xn[j].w * xn[j].w);
                }
                if (REP_P10 > 1 && rep_ + 1 < REP_P10 && ss != 1234.5678f) continue;
                if (!last) {
#pragma unroll
                    for (int j = 0; j < 4; ++j) xr[64 * j] = xn[j];
                    const float rs1 = 1.0f / sqrtf(wave_sum(ss) * (1.f / D) + NORM_EPS);
                    const float* md1 = modl + (size_t)(3 + row_modidx(t)) * 6 * D;
                    GAS v2u* o8 = (GAS v2u*)(H + (size_t)t * D) + ln;
#pragma unroll
                    for (int j = 0; j < 4; ++j) {
                        const f32x4 g = *((const GAS f32x4*)(IN_[I_G1] + (layer + 1) * D) + ln + 64 * j);
                        const f32x4 sh = *((const GAS f32x4*)(md1 + 0) + ln + 64 * j), sc = *((const GAS f32x4*)(md1 + D) + ln + 64 * j);
                        const f32x4 hh = xn[j] * rs1 * g * (sc + 1.0f) + sh;
                        v2u o; o.x = pk2(hh.x, hh.y); o.y = pk2(hh.z, hh.w); o8[64 * j] = o;
                    }
                } else {
                    const float rs = 1.0f / sqrtf(wave_sum(ss) * (1.f / D) + NORM_EPS);
                    GAS f32x4* op = (GAS f32x4*)(((float*)IN_[22]) + (size_t)t * D) + ln;
#pragma unroll
                    for (int j = 0; j < 4; ++j) op[64 * j] = xn[j] * rs * *((const GAS f32x4*)IN_[I_GFINAL] + ln + 64 * j);
                }
            }
        }
        }
        }
#endif
        if (!last) GRID_BAR();
    }
}

extern "C" void kernel_launch(void* const* d_in, const int* in_sizes, int n_in, void* d_out, int out_size, void* d_ws, size_t ws_size, hipStream_t stream) {
    static int grid = 0;
    if (grid == 0) {
        if (n_in != 22 || out_size != T_LAT * D || ws_size < WS_END) { fprintf(stderr, "kernel_launch: unexpected shapes: n_in %d out %d ws %zu (need %zu)\n", n_in, out_size, ws_size, (size_t)WS_END); grid = -1; return; }
        int dev = 0, cus = 0, per_cu = 0;
        if (hipGetDevice(&dev) != hipSuccess || hipDeviceGetAttribute(&cus, hipDeviceAttributeMultiprocessorCount, dev) != hipSuccess) { fprintf(stderr, "device query failed\n"); grid = -1; return; }
        if (hipFuncSetAttribute((const void*)mega_fwd, hipFuncAttributeMaxDynamicSharedMemorySize, LDS_BYTES) != hipSuccess) { fprintf(stderr, "hipFuncSetAttribute failed\n"); grid = -1; return; }
        if (hipOccupancyMaxActiveBlocksPerMultiprocessor(&per_cu, (const void*)mega_fwd, NTHREADS, LDS_BYTES) != hipSuccess || per_cu < 1) { fprintf(stderr, "occupancy query: %d\n", per_cu); }
        (void)hipGetLastError();
        grid = cus;
    }
    if (grid < 0) return;
    if (hipMemsetAsync((char*)d_ws + WS_CTL, 0, CTL_ZERO_BYTES, stream) != hipSuccess) { fprintf(stderr, "memset failed\n"); return; }
    Args a{};
    for (int i = 0; i < 22; ++i) a.in[i] = (const float*)d_in[i];
    a.out = (float*)d_out; a.ws = (unsigned char*)d_ws;
    hipLaunchKernelGGL(mega_fwd, dim3(grid), dim3(NTHREADS), LDS_BYTES, stream, a);
}
```

```cpp
#include <hip/hip_runtime.h>
#include <cstdio>
#include <cstdint>

#ifndef REP_P0
#define REP_P0 1
#endif
#ifndef REP_P1
#define REP_P1 1
#endif
#ifndef REP_P2
#define REP_P2 1
#endif
#ifndef REP_P3A
#define REP_P3A 1
#endif
#ifndef REP_P3B
#define REP_P3B 1
#endif
#ifndef REP_P4
#define REP_P4 1
#endif
#ifndef REP_P6
#define REP_P6 1
#endif
#ifndef REP_P7
#define REP_P7 1
#endif
#ifndef REP_P8
#define REP_P8 1
#endif
#ifndef REP_P9
#define REP_P9 1
#endif
#ifndef REP_P10
#define REP_P10 1
#endif
#ifndef REP_P10A
#define REP_P10A 1
#endif
#ifndef REP_P10C
#define REP_P10C 1
#endif
#ifndef REP_P10B
#define REP_P10B 1
#endif
#ifndef REP_P0A
#define REP_P0A 1
#endif
#ifndef REP_P0D
#define REP_P0D 1
#endif
#ifndef REP_P0F
#define REP_P0F 1
#endif
#ifndef REP_P3C
#define REP_P3C 1
#endif
#define GAS __attribute__((address_space(1)))
#define LAS __attribute__((address_space(3)))
typedef unsigned short bf16;
typedef float f32x4 __attribute__((ext_vector_type(4)));
typedef short bf16x8 __attribute__((ext_vector_type(8)));
typedef unsigned v4u __attribute__((ext_vector_type(4)));
typedef unsigned v2u __attribute__((ext_vector_type(2)));
typedef float f32x2 __attribute__((ext_vector_type(2)));
typedef GAS unsigned gu32;

constexpr int NWAVES = 8, NTHREADS = 512;
constexpr int D = 1024, BATCH = 2, SEQ = 8192, DEPTH = 2, GRID_W = 64, CTX = 256;
constexpr int T_LAT = BATCH * SEQ;
constexpr int T_ALL = T_LAT + BATCH * CTX;
constexpr int NTOK = SEQ + CTX;
constexpr int IN_W = 6912;
constexpr int PEER_HEADS = 8, PEER_KEYS = 128, PEER_TOPK = 16, NSEL = PEER_HEADS * PEER_TOPK;
constexpr float NORM_EPS = 1e-6f;
constexpr float LOG2E = 1.4426950408889634f;
constexpr float SCL2 = 0.125f * LOG2E;

constexpr size_t MiB = 1u << 20;
constexpr size_t WS_CTL = 0, CTL_ZERO_BYTES = 1 * MiB;
constexpr int CW_BAR = 4096;
constexpr int CW_RANK = 8192;
#ifndef P10_SLICED
#define P10_SLICED 1
#endif
constexpr size_t WS_MOD = 65536;
constexpr size_t WS_COS = 2 * MiB, WS_SIN = 3 * MiB;
constexpr size_t WS_WIN = 4 * MiB;
constexpr size_t WS_WB = 31 * MiB;
constexpr size_t WS_WO = 37 * MiB;
constexpr size_t WS_WQ = 41 * MiB;
constexpr size_t WS_KEYS = 49 * MiB;
constexpr size_t WS_X = 50 * MiB;
constexpr size_t WS_H = 116 * MiB;
constexpr size_t WS_Y = 149 * MiB;
constexpr size_t WS_MG = WS_H;
constexpr size_t WS_U8 = 199 * MiB;
constexpr size_t WS_SCU = 231 * MiB;
constexpr size_t WS_EI = 232 * MiB;
constexpr size_t WS_EG = 241 * MiB;
constexpr size_t WS_P = 250 * MiB;
constexpr size_t SZ_R512 = (size_t)T_ALL * 512 * 2;
constexpr size_t SZ_R128 = (size_t)T_ALL * 128 * 2;
constexpr size_t WS_AQ = WS_P, WS_AK = WS_AQ + SZ_R512, WS_AVT = WS_AK + SZ_R128, WS_BQ = WS_AVT + SZ_R128, WS_BK = WS_BQ + SZ_R512,
                 WS_BVT = WS_BK + SZ_R512, WS_CQ = WS_BVT + SZ_R512, WS_CK = WS_CQ + SZ_R512, WS_CVT = WS_CK + SZ_R512, WS_SG = WS_CVT + SZ_R512;
constexpr size_t WS_Q2 = WS_P;
constexpr size_t WS_SC = WS_P + 66 * MiB;
constexpr size_t WS_PART = WS_P, WS_XO = WS_P + 66 * MiB, WS_WGT = WS_P + 132 * MiB;
constexpr size_t WS_PEND = WS_SG + (size_t)T_ALL * 3072 * 2;
constexpr size_t WS_V8 = 473 * MiB;
constexpr size_t WS_END = WS_V8 + 32 * MiB;
static_assert(WS_SC + (size_t)T_ALL * 2048 * 4 <= WS_PEND && WS_PEND <= WS_V8, "alias map");
static_assert(WS_END <= 512 * MiB, "ws map");

constexpr int LDS_BYTES = 147456;
constexpr int MISC_OFF = 131072 + 320;

__device__ __forceinline__ int lane_id_v() { int l; asm volatile("v_mbcnt_lo_u32_b32 %0, -1, 0\n\tv_mbcnt_hi_u32_b32 %0, -1, %0" : "=v"(l)); return l; }
#define XB_TMO      128
#define XB_XCNT(j)  (256  + 64 * (j))
#define XB_XSUB(j)  (1280 + 64 * (j))
#define XB_XGEN(j)  (2304 + 64 * (j))
#define XB_TOP      3328
#define XB_TOPGEN   3392
#define XCD_BAR_WORDS 3456
#define XB_SPIN_CAP (1u << 24)

__device__ __forceinline__ unsigned xb_ld(unsigned* p)              { return __hip_atomic_load(p, __ATOMIC_RELAXED, __HIP_MEMORY_SCOPE_AGENT); }
__device__ __forceinline__ unsigned xb_add(unsigned* p, unsigned v) { return __hip_atomic_fetch_add(p, v, __ATOMIC_RELAXED, __HIP_MEMORY_SCOPE_AGENT); }
__device__ __forceinline__ unsigned xb_xcc_id() { return (unsigned)__builtin_amdgcn_s_getreg((3 << 11) | 20) & 0xFu; }
#define XB_SPIN(cond, bar) do { unsigned _sp = 0; while (cond) { __builtin_amdgcn_s_sleep(1); \
    if ((++_sp & 255u) == 0u) { if (xb_ld(&(bar)[XB_TMO])) break; if (_sp > XB_SPIN_CAP) { atomicAdd(&(bar)[XB_TMO], 1u); break; } } } } while (0)

struct XcdBarrier { unsigned* bar; unsigned x; volatile LAS unsigned* st; };

__device__ __forceinline__ XcdBarrier xcd_barrier_post(unsigned* bar, volatile LAS unsigned* st) {
    XcdBarrier b; b.bar = bar; b.x = xb_xcc_id(); b.st = st;
    if (threadIdx.x == 0) (void)xb_add(&bar[XB_XCNT(b.x)], 1u);
    return b;
}
__device__ __forceinline__ void xcd_barrier_complete(unsigned* bar, unsigned x, unsigned& nloc, unsigned& nx) {
    const unsigned G = gridDim.x * gridDim.y * gridDim.z;
    unsigned sum, cnt, mine, sp = 0u;
    for (;;) {
        sum = 0u; cnt = 0u; mine = 0u;
#pragma unroll
        for (unsigned j = 0; j < 16; ++j) { const unsigned c = xb_ld(&bar[XB_XCNT(j)]); sum += c; cnt += (c > 0u) ? 1u : 0u; mine = (j == x) ? c : mine; }
        if (sum == G) break;
        __builtin_amdgcn_s_sleep(1);
        if ((++sp & 255u) == 0u) { if (xb_ld(&bar[XB_TMO])) break; if (sp > XB_SPIN_CAP) { atomicAdd(&bar[XB_TMO], 1u); break; } }
    }
    nloc = mine > 0u ? mine : 1u; nx = cnt > 0u ? cnt : 1u;
}
__device__ __forceinline__ void xcd_barrier(const XcdBarrier& b, bool t0) {
    asm volatile("s_waitcnt vmcnt(0)" ::: "memory");
    __syncthreads();
    if (t0) {
        unsigned* bar = b.bar;
        __builtin_amdgcn_s_waitcnt(0);
        unsigned nloc = b.st[0], nx = b.st[1];
        if (nloc == 0u) { xcd_barrier_complete(bar, b.x, nloc, nx); b.st[0] = nloc; b.st[1] = nx; }
        const unsigned old = xb_add(&bar[XB_XSUB(b.x)], 1u);
        const unsigned gen = old / nloc;
        if (old + 1u == (gen + 1u) * nloc) {
            __builtin_amdgcn_fence(__ATOMIC_RELEASE, "agent");
            asm volatile("s_waitcnt vmcnt(0)" ::: "memory");
            const unsigned og = xb_add(&bar[XB_TOP], 1u);
            const unsigned tg = og / nx;
            if (og + 1u == (tg + 1u) * nx) xb_add(&bar[XB_TOPGEN], 1u);
            else XB_SPIN(xb_ld(&bar[XB_TOPGEN]) == tg, bar);
            __builtin_amdgcn_fence(__ATOMIC_ACQUIRE, "agent");
            xb_add(&bar[XB_XGEN(b.x)], 1u);
            asm volatile("s_waitcnt vmcnt(0)" ::: "memory");
        } else {
            XB_SPIN(xb_ld(&bar[XB_XGEN(b.x)]) == gen, bar);
            __builtin_amdgcn_fence(__ATOMIC_ACQUIRE, "agent");
            asm volatile("s_waitcnt vmcnt(0)" ::: "memory");
        }
    }
    __syncthreads();
}

__device__ __forceinline__ unsigned f2bf(float f) { unsigned u = __builtin_bit_cast(unsigned, f); return (u + 0x7fffu + ((u >> 16) & 1u)) >> 16; }
__device__ __forceinline__ unsigned pk2(float lo, float hi) { return f2bf(lo) | (f2bf(hi) << 16); }
__device__ __forceinline__ float bf2f(unsigned h) { return __builtin_bit_cast(float, h << 16); }
template <int CTRL> __device__ __forceinline__ float dpp_mov(float v) { return __builtin_bit_cast(float, __builtin_amdgcn_update_dpp(0, __builtin_bit_cast(int, v), CTRL, 0xF, 0xF, true)); }
__device__ __forceinline__ float sum8_dpp(float v) { v += dpp_mov<0xB1>(v); v += dpp_mov<0x4E>(v); v += dpp_mov<0x141>(v); return v; }
template <int K> __device__ __forceinline__ float xshfl_l(float v, int lane) { return __builtin_bit_cast(float, __builtin_amdgcn_ds_bpermute((lane ^ K) << 2, __builtin_bit_cast(int, v))); }
template <int K> __device__ __forceinline__ float xshfl(float v) { return xshfl_l<K>(v, lane_id_v()); }
__device__ __forceinline__ float xadd32(float v) { return v + xshfl_l<32>(v, lane_id_v()); }
__device__ __forceinline__ float xmax32(float v) { return fmaxf(v, xshfl_l<32>(v, lane_id_v())); }
__device__ __forceinline__ float wave_sum(float v) { const int l = lane_id_v(); v += xshfl_l<1>(v, l); v += xshfl_l<2>(v, l); v += xshfl_l<4>(v, l); v += xshfl_l<8>(v, l); v += xshfl_l<16>(v, l); v += xshfl_l<32>(v, l); return v; }
__device__ __forceinline__ float wave_max(float v) { const int l = lane_id_v(); v = fmaxf(v, xshfl_l<1>(v, l)); v = fmaxf(v, xshfl_l<2>(v, l)); v = fmaxf(v, xshfl_l<4>(v, l)); v = fmaxf(v, xshfl_l<8>(v, l)); v = fmaxf(v, xshfl_l<16>(v, l)); v = fmaxf(v, xshfl_l<32>(v, l)); return v; }


__device__ __forceinline__ float sigmoidf_(float x) { return 1.0f / (1.0f + __expf(-x)); }
__device__ __forceinline__ float sigmoid_fast(float x) { return __builtin_amdgcn_rcpf(1.0f + __builtin_amdgcn_exp2f(-LOG2E * x)); }
__device__ __forceinline__ int row_modidx(int r) { return r < T_LAT ? (r >> 13) : 2; }
__device__ __forceinline__ int row_batch(int r) { return r < T_LAT ? (r >> 13) : ((r - T_LAT) >> 8); }
__device__ __forceinline__ int row_tok(int r) { return r < T_LAT ? (r & (SEQ - 1)) : SEQ + ((r - T_LAT) & (CTX - 1)); }

__device__ __forceinline__ const float* xin_row(const float* x, const float* ctx, int r) { return r < T_LAT ? x + (size_t)r * D : ctx + (size_t)(r - T_LAT) * D; }
struct Args { const float* in[22]; float* out; unsigned char* ws; };
enum { I_X = 0, I_C, I_CTX, I_CCTX, I_WMOD, I_BMOD, I_G1, I_G2, I_WIN, I_SINK, I_RPB, I_LAMBDA, I_SUBLN, I_WBA, I_WBB, I_WBC, I_WOUT, I_PWQ, I_PKEYS, I_PU, I_PV, I_GFINAL };

__device__ __forceinline__ int rope_perm(int c) {
    if (c < 640 || (c >= 2304 && c < 3328)) { const int w = c & 63; return (c & ~63) + 2 * (w & 31) + (w >> 5); }
    return c;
}
template <bool PERM = false>
__device__ __forceinline__ void p0_transpose_item(const float* W, int K, int N, bf16* WT, LAS float* scr, int item, int lane) {
    const int nblk = N / 32, kb = item / nblk, nb = item % nblk, k0 = 64 * kb, n0 = 32 * nb;
#pragma unroll 8
    for (int i = 0; i < 32; ++i) { const int kk = 2 * i + (lane >> 5); scr[kk * 33 + (lane & 31)] = W[(size_t)(k0 + kk) * N + n0 + (lane & 31)]; }
    asm volatile("s_waitcnt lgkmcnt(0)" ::: "memory");
    const int c = lane & 7;
#pragma unroll
    for (int j = 0; j < 4; ++j) { const int n = (lane >> 3) + 8 * j; const LAS float* s = scr + (8 * c) * 33 + n;
        v4u o; o.x = pk2(s[0 * 33], s[1 * 33]); o.y = pk2(s[2 * 33], s[3 * 33]); o.z = pk2(s[4 * 33], s[5 * 33]); o.w = pk2(s[6 * 33], s[7 * 33]);
        const int nout = PERM ? rope_perm(n0 + n) : (n0 + n);
        *(GAS v4u*)(WT + (size_t)nout * K + k0 + 8 * c) = o; }
    asm volatile("s_waitcnt lgkmcnt(0)" ::: "memory");
}

template <int UNR = 2, int NN = 4>
__device__ __forceinline__ void sgemm_tile(f32x4 (&acc)[4][NN], const bf16* A, int lda, const bf16* Bt, int ldb, int K, int row0, int col0, int lane) {
    const int fr = lane & 15, fq = lane >> 4;
    const bf16* ap = A + (size_t)(row0 + fr) * lda + fq * 8;
    const bf16* bp = Bt + (size_t)(col0 + fr) * ldb + fq * 8;
#pragma unroll UNR
    for (int k = 0; k < K; k += 32) {
        bf16x8 a[4], b[NN];
#pragma unroll
        for (int m = 0; m < 4; ++m) a[m] = *(const GAS bf16x8*)(ap + (size_t)m * 16 * lda + k);
#pragma unroll
        for (int n = 0; n < NN; ++n) b[n] = *(const GAS bf16x8*)(bp + (size_t)n * 16 * ldb + k);
#pragma unroll
        for (int m = 0; m < 4; ++m)
#pragma unroll
            for (int n = 0; n < NN; ++n) acc[m][n] = __builtin_amdgcn_mfma_f32_16x16x32_bf16(a[m], b[n], acc[m][n], 0, 0, 0);
    }
}
template <int UNR>
__device__ __forceinline__ void sgemm32(f32x4 (&acc)[2][2], const bf16* A, int lda, const bf16* Bt, int ldb, int K, int row0, int col0, int lane) {
    const int fr = lane & 15, fq = lane >> 4;
    const bf16* ap = A + (size_t)(row0 + fr) * lda + fq * 8;
    const bf16* bp = Bt + (size_t)(col0 + fr) * ldb + fq * 8;
#pragma unroll 1
    for (int k0 = 0; k0 < K; k0 += 32 * UNR) {
        bf16x8 a[UNR][2], b[UNR][2];
#pragma unroll
        for (int u = 0; u < UNR; ++u)
#pragma unroll
            for (int m = 0; m < 2; ++m) { a[u][m] = *(const GAS bf16x8*)(ap + (size_t)m * 16 * lda + k0 + 32 * u); b[u][m] = *(const GAS bf16x8*)(bp + (size_t)m * 16 * ldb + k0 + 32 * u); }
#pragma unroll
        for (int u = 0; u < UNR; ++u)
#pragma unroll
            for (int m = 0; m < 2; ++m)
#pragma unroll
                for (int n = 0; n < 2; ++n) acc[m][n] = __builtin_amdgcn_mfma_f32_16x16x32_bf16(a[u][m], b[u][n], acc[m][n], 0, 0, 0);
    }
}
__device__ __forceinline__ void zero_acc22(f32x4 (&acc)[2][2]) { acc[0][0] = acc[0][1] = acc[1][0] = acc[1][1] = (f32x4){0.f, 0.f, 0.f, 0.f}; }
template <int NN>
__device__ __forceinline__ void zero_acc(f32x4 (&acc)[4][NN]) {
#pragma unroll
    for (int m = 0; m < 4; ++m)
#pragma unroll
        for (int n = 0; n < NN; ++n) acc[m][n] = (f32x4){0.f, 0.f, 0.f, 0.f};
}

__device__ __forceinline__ int f2ord(float f) { const int b = __builtin_bit_cast(int, f); return b ^ ((b >> 31) & 0x7fffffff); }
__device__ __forceinline__ float ord2f(int o) { const int b = o ^ ((o >> 31) & 0x7fffffff); return __builtin_bit_cast(float, b); }
__device__ __forceinline__ void top16_insert(int (&top)[16], int key) {
#pragma unroll
    for (int i = 0; i < 16; ++i) { const int hi = max(top[i], key); key = min(top[i], key); top[i] = hi; }
}
#define CE(a, b) { const int t_ = max(a, b); b = min(a, b); a = t_; }
__device__ __forceinline__ void sort16_desc(int (&v)[16]) { CE(v[0], v[1]); CE(v[3], v[2]); CE(v[4], v[5]); CE(v[7], v[6]); CE(v[8], v[9]); CE(v[11], v[10]); CE(v[12], v[13]); CE(v[15], v[14]); CE(v[0], v[2]); CE(v[1], v[3]); CE(v[6], v[4]); CE(v[7], v[5]); CE(v[8], v[10]); CE(v[9], v[11]); CE(v[14], v[12]); CE(v[15], v[13]); CE(v[0], v[1]); CE(v[2], v[3]); CE(v[5], v[4]); CE(v[7], v[6]); CE(v[8], v[9]); CE(v[10], v[11]); CE(v[13], v[12]); CE(v[15], v[14]); CE(v[0], v[4]); CE(v[1], v[5]); CE(v[2], v[6]); CE(v[3], v[7]); CE(v[12], v[8]); CE(v[13], v[9]); CE(v[14], v[10]); CE(v[15], v[11]); CE(v[0], v[2]); CE(v[1], v[3]); CE(v[4], v[6]); CE(v[5], v[7]); CE(v[10], v[8]); CE(v[11], v[9]); CE(v[14], v[12]); CE(v[15], v[13]); CE(v[0], v[1]); CE(v[2], v[3]); CE(v[4], v[5]); CE(v[6], v[7]); CE(v[9], v[8]); CE(v[11], v[10]); CE(v[13], v[12]); CE(v[15], v[14]); CE(v[0], v[8]); CE(v[1], v[9]); CE(v[2], v[10]); CE(v[3], v[11]); CE(v[4], v[12]); CE(v[5], v[13]); CE(v[6], v[14]); CE(v[7], v[15]); CE(v[0], v[4]); CE(v[1], v[5]); CE(v[2], v[6]); CE(v[3], v[7]); CE(v[8], v[12]); CE(v[9], v[13]); CE(v[10], v[14]); CE(v[11], v[15]); CE(v[0], v[2]); CE(v[1], v[3]); CE(v[4], v[6]); CE(v[5], v[7]); CE(v[8], v[10]); CE(v[9], v[11]); CE(v[12], v[14]); CE(v[13], v[15]); CE(v[0], v[1]); CE(v[2], v[3]); CE(v[4], v[5]); CE(v[6], v[7]); CE(v[8], v[9]); CE(v[10], v[11]); CE(v[12], v[13]); CE(v[14], v[15]); }
__device__ __forceinline__ void merge16_desc(int (&a)[16], const int (&b)[16]) {
#pragma unroll
    for (int i = 0; i < 16; ++i) a[i] = max(a[i], b[15 - i]);
    CE(a[0], a[8]); CE(a[1], a[9]); CE(a[2], a[10]); CE(a[3], a[11]); CE(a[4], a[12]); CE(a[5], a[13]); CE(a[6], a[14]); CE(a[7], a[15]); CE(a[0], a[4]); CE(a[1], a[5]); CE(a[2], a[6]); CE(a[3], a[7]); CE(a[8], a[12]); CE(a[9], a[13]); CE(a[10], a[14]); CE(a[11], a[15]); CE(a[0], a[2]); CE(a[1], a[3]); CE(a[4], a[6]); CE(a[5], a[7]); CE(a[8], a[10]); CE(a[9], a[11]); CE(a[12], a[14]); CE(a[13], a[15]); CE(a[0], a[1]); CE(a[2], a[3]); CE(a[4], a[5]); CE(a[6], a[7]); CE(a[8], a[9]); CE(a[10], a[11]); CE(a[12], a[13]); CE(a[14], a[15]); }
#undef CE


typedef float f32x16 __attribute__((ext_vector_type(16)));
typedef short s16x4 __attribute__((ext_vector_type(4)));
typedef __bf16 bf16x2_t __attribute__((ext_vector_type(2)));
__device__ __forceinline__ unsigned cvtpk(float lo, float hi) { f32x2 v = {lo, hi}; bf16x2_t b = __builtin_convertvector(v, bf16x2_t); return __builtin_bit_cast(unsigned, b); }
constexpr int CK_PITCH = 144, CV_PITCH = 320;
constexpr int CK_SZ = 64 * CK_PITCH, CV_SZ = 64 * CV_PITCH;
constexpr float C_THR_RAW = 8.0f / SCL2;

template <int NDV, class RowFn, class UseFn, class ElemFn>
__device__ __forceinline__ void attn64_pass(f32x16 (&o)[NDV], float& mrun, float& lpart, const bf16x8 (&qf)[4], const bf16* kg, int kpitch, const bf16* vg, int vpitch,
                                            int ntiles, RowFn tile_row, UseFn use_tile, ElemFn elem, LAS unsigned char* L, int lane, int tid) {
    constexpr int VP = NDV * 64 + 64, VSZ = 64 * VP, NVP = NDV / 2;
    const int r32 = lane & 31, hi = lane >> 5;
    const int krow_s = tid >> 3, kch_s = tid & 7;
    const int vrow_s = (NDV == 2) ? (tid >> 3) : (tid >> 4), vch_s = (NDV == 2) ? (tid & 7) : (tid & 15);
    LAS unsigned char* Kb0 = L; LAS unsigned char* Vb0 = L + 2 * CK_SZ;
    __syncthreads();
    {
        const int tr = tile_row(0);
        const v4u kr = *(const GAS v4u*)(kg + (size_t)tr * kpitch);
        *(LAS v4u*)(Kb0 + krow_s * CK_PITCH + kch_s * 16) = kr;
#pragma unroll
        for (int i = 0; i < NVP; ++i) { const v4u v = *(const GAS v4u*)(vg + (size_t)(tr + 32 * i) * vpitch); *(LAS v4u*)(Vb0 + (vrow_s + 32 * i) * VP + vch_s * 16) = v; }
    }
    v4u kr, vr[NVP];
    { const int tr = tile_row(ntiles > 1 ? 1 : 0); kr = *(const GAS v4u*)(kg + (size_t)tr * kpitch);
#pragma unroll
      for (int i = 0; i < NVP; ++i) vr[i] = *(const GAS v4u*)(vg + (size_t)(tr + 32 * i) * vpitch); }
    __syncthreads();
#pragma unroll 1
    for (int j = 0; j < ntiles; ++j) {
        const int cur = j & 1;
        const LAS unsigned char* Kb = Kb0 + cur * CK_SZ; const LAS unsigned char* Vb = Vb0 + cur * VSZ;
        const bool more = (j + 1 < ntiles);
        v4u kr2, vr2[NVP];
        { const int tr = tile_row(j + 2 < ntiles ? j + 2 : ntiles - 1); kr2 = *(const GAS v4u*)(kg + (size_t)tr * kpitch);
#pragma unroll
            for (int i = 0; i < NVP; ++i) vr2[i] = *(const GAS v4u*)(vg + (size_t)(tr + 32 * i) * vpitch); }
        if (use_tile(j)) {
            f32x16 st[2];
#pragma unroll
            for (int kb = 0; kb < 2; ++kb) {
#pragma unroll
                for (int r = 0; r < 16; ++r) st[kb][r] = 0.f;
#pragma unroll
                for (int ks = 0; ks < 4; ++ks) {
                    const bf16x8 kf = *(const LAS bf16x8*)(Kb + (kb * 32 + r32) * CK_PITCH + ks * 32 + hi * 16);
                    st[kb] = __builtin_amdgcn_mfma_f32_32x32x16_bf16(kf, qf[ks], st[kb], 0, 0, 0);
                }
            }
            elem(st, j);
            float mx = st[0][0];
#pragma unroll
            for (int r = 1; r < 16; ++r) mx = fmaxf(mx, st[0][r]);
#pragma unroll
            for (int r = 0; r < 16; ++r) mx = fmaxf(mx, st[1][r]);
            mx = xmax32(mx);
            if (__builtin_amdgcn_ballot_w64(mx > mrun + C_THR_RAW) != 0ull) {
                const float mn = fmaxf(mrun, mx);
                const float alpha = __builtin_amdgcn_exp2f((mrun - mn) * SCL2);
#pragma unroll
                for (int d = 0; d < NDV; ++d)
#pragma unroll
                    for (int r = 0; r < 16; ++r) o[d][r] *= alpha;
                lpart *= alpha; mrun = mn;
            }
            const float nmc = -mrun * SCL2;
            float ls = 0.f;
#pragma unroll
            for (int kb = 0; kb < 2; ++kb)
#pragma unroll
                for (int r = 0; r < 16; ++r) { const float p = __builtin_amdgcn_exp2f(fmaf(st[kb][r], SCL2, nmc)); st[kb][r] = p; ls += p; }
            lpart += ls;
            const int q4 = (lane & 15) >> 2, p4 = lane & 3, grp = (lane >> 4) & 1;
            const LAS unsigned char* vbase = Vb + (4 * hi + q4) * VP + (16 * grp + 4 * p4) * 2;
#pragma unroll
            for (int kb = 0; kb < 2; ++kb)
#pragma unroll
                for (int ss = 0; ss < 2; ++ss) {
                    v4u pw;
#pragma unroll
                    for (int i2 = 0; i2 < 4; ++i2) pw[i2] = cvtpk(st[kb][8 * ss + 2 * i2], st[kb][8 * ss + 2 * i2 + 1]);
                    const bf16x8 pb = __builtin_bit_cast(bf16x8, pw);
#pragma unroll
                    for (int d = 0; d < NDV; ++d) {
                        const LAS unsigned char* va = vbase + (kb * 32 + 16 * ss) * VP + d * 64;
                        const s16x4 lo = __builtin_bit_cast(s16x4, __builtin_amdgcn_ds_read_tr16_b64_v4i16((LAS s16x4*)va));
                        const s16x4 hh = __builtin_bit_cast(s16x4, __builtin_amdgcn_ds_read_tr16_b64_v4i16((LAS s16x4*)(va + 8 * VP)));
                        const bf16x8 vf = __builtin_shufflevector(lo, hh, 0, 1, 2, 3, 4, 5, 6, 7);
                        o[d] = __builtin_amdgcn_mfma_f32_32x32x16_bf16(vf, pb, o[d], 0, 0, 0);
                    }
                }
        }
        if (more) {
            LAS unsigned char* Kn = Kb0 + (cur ^ 1) * CK_SZ; LAS unsigned char* Vn = Vb0 + (cur ^ 1) * VSZ;
            *(LAS v4u*)(Kn + krow_s * CK_PITCH + kch_s * 16) = kr;
#pragma unroll
            for (int i = 0; i < NVP; ++i) *(LAS v4u*)(Vn + (vrow_s + 32 * i) * VP + vch_s * 16) = vr[i];
        }
        kr = kr2;
#pragma unroll
        for (int i = 0; i < NVP; ++i) vr[i] = vr2[i];
        __syncthreads();
    }
}
__device__ __forceinline__ void attn64_store(const f32x16 (&o)[2], float inv, bf16* yrow, int hi) {
#pragma unroll
    for (int d = 0; d < 2; ++d)
#pragma unroll
        for (int g4 = 0; g4 < 4; ++g4) {
            v2u w; w.x = cvtpk(o[d][4 * g4] * inv, o[d][4 * g4 + 1] * inv); w.y = cvtpk(o[d][4 * g4 + 2] * inv, o[d][4 * g4 + 3] * inv);
            *(GAS v2u*)(yrow + d * 32 + 8 * g4 + 4 * hi) = w;
        }
}

namespace pg8 {
typedef unsigned short bf16_t;
constexpr int BM = 256, BK = 64, HALF = 128, HTB = HALF * BK * 2, STAGE_BYTES = 8 * HTB, NXCD = 8, WGM = 8;
__host__ __device__ __forceinline__ int lds_byte(int r, int c) { const int st = (r >> 4) * 2 + (c >> 5), rr = r & 15, cc = c & 31, ob = rr * 64 + cc * 2; return st * 1024 + (ob ^ (((ob >> 9) & 1) << 5)); }
__host__ __device__ __forceinline__ void stage_rc(int b, int& R, int& C) { const int st = b / 1024, sb = b % 1024, swz = sb ^ (((sb >> 9) & 1) << 5); R = (st >> 1) * 16 + swz / 64; C = (st & 1) * 32 + (swz % 64) / 2; }
__host__ __device__ __forceinline__ int perm32(int rho) { const int n = rho >> 4, i = rho & 15; return 8 * (i >> 2) + 4 * n + (i & 3); }
struct Unit { int pm, pn, seg; };
struct Gemm { const bf16_t* A; const bf16_t* Bt; int lda, ldb, K; size_t a_seg, b_seg; };
struct TileOrder {
    int nM, nN, nwg, G, c;
    __device__ void init(int M, int N, int G_, int c_) { nM = M / BM; nN = N / BM; nwg = nM * nN; G = G_; c = c_; }
    __device__ bool tile(int i, int& pm, int& pn) const {
        const long L = (long)i * G + c; if (L >= nwg) return false;
        int wgid = (int)L; { const int q = nwg / NXCD, r = nwg % NXCD, xcd = wgid % NXCD, off = wgid / NXCD; wgid = (xcd < r ? xcd * (q + 1) : r * (q + 1) + (xcd - r) * q) + off; }
        const int nig = WGM * nN, gid = wgid / nig, fm = gid * WGM, gsz = (nM - fm) < WGM ? (nM - fm) : WGM;
        pm = fm + ((wgid % nig) % gsz); pn = (wgid % nig) / gsz; return true;
    }
};
template <int NSEG> struct SegOrder {
    TileOrder T;
    __device__ bool next(int i, Unit& u) const { u.seg = i % NSEG; return T.tile(i / NSEG, u.pm, u.pn); }
};
template <class Epi, class Sched>
__device__ __forceinline__ void gemm_phase(LAS unsigned char* lds, const Gemm g, const Sched& S, const Epi& E, int wid) {
    const int lane = lane_id_v(), tid = wid * 64 + lane,
              wr = wid >> 2, wc = wid & 3, fr = lane & 15, fq = lane >> 4;
    const int K = g.K, nt = K / BK;
    unsigned voffA[2], voffB[2];
#pragma unroll
    for (int i = 0; i < 2; ++i) { int R, C; stage_rc(tid * 16 + i * 8192, R, C); const int Rb = (R & ~31) + perm32(R & 31);
        voffA[i] = (unsigned)(R * g.lda + C) * 2u; voffB[i] = (unsigned)(Rb * g.ldb + C) * 2u; }
    const size_t kstep = (size_t)(BK * 2);
    const size_t hstepA = (size_t)HALF * g.lda * 2, hstepB = (size_t)HALF * g.ldb * 2;
    const unsigned ldsw = (unsigned)wid * 1024u;
    const int aoff = lds_byte(wr * 64 + fr, fq * 8), boff = lds_byte(wc * 32 + fr, fq * 8);
#define PG8_SA(b, h) (((b) * 2 + (h)) * HTB)
#define PG8_SB(b, h) ((4 + (b) * 2 + (h)) * HTB)
#define PG8_STAGE(bufoff, gbase, voff) do { _Pragma("unroll") for (int _i = 0; _i < 2; ++_i) \
        __builtin_amdgcn_global_load_lds((const unsigned*)((const char*)(gbase) + (voff)[_i]), (LAS unsigned*)(lds + (bufoff) + ldsw + _i * 8192), 16, 0, 0); } while (0)
#define PG8_LDA(dst, b, h) do { _Pragma("unroll") for (int m = 0; m < 4; ++m) _Pragma("unroll") for (int k = 0; k < 2; ++k) dst[m][k] = *(const LAS bf16x8*)(lds + PG8_SA(b, h) + aoff + m * 2048 + k * 1024); } while (0)
#define PG8_LDB(dst, b, h) do { _Pragma("unroll") for (int n = 0; n < 2; ++n) _Pragma("unroll") for (int k = 0; k < 2; ++k) dst[n][k] = *(const LAS bf16x8*)(lds + PG8_SB(b, h) + boff + n * 2048 + k * 1024); } while (0)
#define PG8_MMA(ai, bj, At, Bt) do { __builtin_amdgcn_s_setprio(1); _Pragma("unroll") for (int m = 0; m < 4; ++m) _Pragma("unroll") for (int n = 0; n < 2; ++n) _Pragma("unroll") for (int k = 0; k < 2; ++k) \
        acc[ai][bj][m][n] = __builtin_amdgcn_mfma_f32_16x16x32_bf16(Bt[n][k], At[m][k], acc[ai][bj][m][n], 0, 0, 0); __builtin_amdgcn_s_setprio(0); } while (0)
#define PG8_WAIT_V(n) asm volatile("s_waitcnt vmcnt(" #n ")" ::: "memory")
#define PG8_WAIT_L(n) asm volatile("s_waitcnt lgkmcnt(" #n ")" ::: "memory")
#define PG8_BAR __builtin_amdgcn_s_barrier()
#define PG8_SCHED __builtin_amdgcn_sched_barrier(0)
#define PG8_ABASE(u) ((const char*)g.A + ((size_t)(u).seg * g.a_seg + (size_t)(u).pm * BM * g.lda) * 2)
#define PG8_BBASE(u) ((const char*)g.Bt + ((size_t)(u).seg * g.b_seg + (size_t)(u).pn * BM * g.ldb) * 2)
    Unit cur, nxt; int ui = 0;
    if (!S.next(0, cur)) return;
    f32x4 acc[2][2][4][2];
#pragma unroll
    for (int a = 0; a < 2; ++a)
#pragma unroll
        for (int b = 0; b < 2; ++b)
#pragma unroll
            for (int m = 0; m < 4; ++m)
#pragma unroll
                for (int n = 0; n < 2; ++n) acc[a][b][m][n] = (f32x4){0.f, 0.f, 0.f, 0.f};
    bf16x8 At[4][2], B0[2][2], B1[2][2];
    const char* cA = PG8_ABASE(cur); const char* cB = PG8_BBASE(cur);
    PG8_STAGE(PG8_SB(0, 0), cB, voffB); PG8_STAGE(PG8_SB(0, 1), cB + hstepB, voffB); PG8_STAGE(PG8_SA(0, 0), cA, voffA); PG8_STAGE(PG8_SA(0, 1), cA + hstepA, voffA);
    if (wr == 1) PG8_BAR;
    PG8_WAIT_V(2); PG8_BAR;
    PG8_STAGE(PG8_SB(1, 0), cB + kstep, voffB); PG8_STAGE(PG8_SA(1, 0), cA + kstep, voffA); PG8_STAGE(PG8_SB(1, 1), cB + hstepB + kstep, voffB);
    PG8_WAIT_V(6); PG8_BAR;
    for (;;) {
        const bool has_next = S.next(ui + 1, nxt);
        const char* nA = has_next ? PG8_ABASE(nxt) : cA; const char* nB = has_next ? PG8_BBASE(nxt) : cB;
        for (int t = 0; t < nt; t += 2) {
            const bool lastk = (t == nt - 2);
            const char* a1 = cA + (size_t)(t + 1) * kstep;
            const char* a2 = lastk ? nA : cA + (size_t)(t + 2) * kstep; const char* b2 = lastk ? nB : cB + (size_t)(t + 2) * kstep;
            const char* a3 = a2 + kstep; const char* b3 = b2 + kstep;
            PG8_LDB(B0, 0, 0); PG8_LDB(B1, 0, 1); PG8_SCHED; PG8_LDA(At, 0, 0); PG8_STAGE(PG8_SA(1, 1), a1 + hstepA, voffA);
            PG8_WAIT_V(8); PG8_WAIT_L(0); PG8_BAR; PG8_MMA(0, 0, At, B0); PG8_MMA(0, 1, At, B1); PG8_BAR; PG8_SCHED;
            PG8_LDA(At, 0, 1); PG8_STAGE(PG8_SB(0, 0), b2, voffB); PG8_STAGE(PG8_SB(0, 1), b2 + hstepB, voffB); PG8_STAGE(PG8_SA(0, 0), a2, voffA);
            PG8_WAIT_V(8); PG8_WAIT_L(0); PG8_BAR; PG8_MMA(1, 0, At, B0); PG8_MMA(1, 1, At, B1); PG8_BAR; PG8_SCHED;
            PG8_LDB(B0, 1, 0); PG8_LDB(B1, 1, 1); PG8_SCHED; PG8_LDA(At, 1, 0); PG8_STAGE(PG8_SA(0, 1), a2 + hstepA, voffA);
            PG8_WAIT_V(8); PG8_WAIT_L(0); PG8_BAR; PG8_MMA(0, 0, At, B0); PG8_MMA(0, 1, At, B1); PG8_BAR; PG8_SCHED;
            PG8_LDA(At, 1, 1); PG8_STAGE(PG8_SB(1, 0), b3, voffB); PG8_STAGE(PG8_SB(1, 1), b3 + hstepB, voffB); PG8_STAGE(PG8_SA(1, 0), a3, voffA);
            PG8_WAIT_V(8); PG8_WAIT_L(0); PG8_BAR; PG8_MMA(1, 0, At, B0); PG8_MMA(1, 1, At, B1); PG8_BAR; PG8_SCHED;
        }
        if (wr == 0) PG8_BAR;
        E(acc, cur, wr, wc, fr, fq);
        if (!has_next) break;
#pragma unroll
        for (int a = 0; a < 2; ++a)
#pragma unroll
            for (int b = 0; b < 2; ++b)
#pragma unroll
                for (int m = 0; m < 4; ++m)
#pragma unroll
                    for (int n = 0; n < 2; ++n) acc[a][b][m][n] = (f32x4){0.f, 0.f, 0.f, 0.f};
        cur = nxt; cA = nA; cB = nB; ++ui;
        if (wr == 1) PG8_BAR;
    }
    PG8_WAIT_V(0);
    PG8_BAR;
#undef PG8_SA
#undef PG8_SB
#undef PG8_STAGE
#undef PG8_LDA
#undef PG8_LDB
#undef PG8_MMA
#undef PG8_WAIT_V
#undef PG8_WAIT_L
#undef PG8_BAR
#undef PG8_SCHED
#undef PG8_ABASE
#undef PG8_BBASE
}
}

__device__ __forceinline__ v4u pack8(const f32x4& a, const f32x4& b) { v4u w; w.x = cvtpk(a.x, a.y); w.y = cvtpk(a.z, a.w); w.z = cvtpk(b.x, b.y); w.w = cvtpk(b.z, b.w); return w; }
struct EpiInProj {
    bf16 *AQ, *AK, *AVT, *BQ, *BK, *BVT, *CQ, *CK, *CV, *SG; const float *COS, *SIN;
    __device__ __forceinline__ void operator()(const f32x4 (&acc)[2][2][4][2], const pg8::Unit& u, int wr, int wc, int fr, int fq) const {
        asm volatile("" : "+v"(fr), "+v"(fq));
#pragma unroll
        for (int bj = 0; bj < 2; ++bj) {
            const int cblk = u.pn * 256 + bj * 128;
            const int cw = wc * 32 + 8 * fq;
            bf16* dst; int pitch, cbase; int kind;
            int nh = 1, hd = 0;
            if (cblk < 512)       { dst = AQ; pitch = 512; cbase = cblk; kind = 1; }
            else if (cblk < 640)  { dst = AK; pitch = 128; cbase = cblk - 512; kind = 1; }
            else if (cblk < 768)  { dst = AVT; pitch = 128; cbase = cblk - 640; kind = 0; }
            else if (cblk < 1280) { dst = BQ; pitch = 512; cbase = cblk - 768; kind = 0; }
            else if (cblk < 1792) { dst = BK; pitch = 512; cbase = cblk - 1280; kind = 0; }
            else if (cblk < 2304) { dst = BVT; pitch = 512; cbase = cblk - 1792; kind = 0; }
            else if (cblk < 2816) { dst = CQ; pitch = 512; cbase = cblk - 2304; kind = 1; }
            else if (cblk < 3328) { dst = CK; pitch = 512; cbase = cblk - 2816; kind = 1; }
            else if (cblk < 3840) { dst = CV; pitch = 512; cbase = cblk - 3328; kind = 0; }
            else                  { dst = SG; pitch = 3072; cbase = cblk - 3840; kind = 3; }
#pragma unroll
            for (int ai = 0; ai < 2; ++ai)
#pragma unroll
                for (int m = 0; m < 4; ++m) {
                    const int row = u.pm * 256 + ai * 128 + wr * 64 + m * 16 + fr;
                    f32x4 v0 = acc[ai][bj][m][0], v1 = acc[ai][bj][m][1];
                    if (kind == 1) {
                        if (row < T_LAT) {
                            const int t = row & (SEQ - 1), i0 = (cw & 63) >> 1;
                            const f32x4 cs = *(const GAS f32x4*)(COS + t * 32 + i0), sn = *(const GAS f32x4*)(SIN + t * 32 + i0);
                            const f32x4 a = v0, b = v1;
                            v0.x = a.x * cs.x - a.y * sn.x; v0.y = a.y * cs.x + a.x * sn.x; v0.z = a.z * cs.y - a.w * sn.y; v0.w = a.w * cs.y + a.z * sn.y;
                            v1.x = b.x * cs.z - b.y * sn.z; v1.y = b.y * cs.z + b.x * sn.z; v1.z = b.z * cs.w - b.w * sn.w; v1.w = b.w * cs.w + b.z * sn.w;
                        }
                        *(GAS v4u*)(dst + (size_t)row * pitch + cbase + cw) = pack8(v0, v1);
                    } else if (kind == 0) {
                        *(GAS v4u*)(dst + (size_t)row * pitch + cbase + cw) = pack8(v0, v1);
                    } else if (kind == 3) {
                        v0.x = sigmoid_fast(v0.x); v0.y = sigmoid_fast(v0.y); v0.z = sigmoid_fast(v0.z); v0.w = sigmoid_fast(v0.w);
                        v1.x = sigmoid_fast(v1.x); v1.y = sigmoid_fast(v1.y); v1.z = sigmoid_fast(v1.z); v1.w = sigmoid_fast(v1.w);
                        *(GAS v4u*)(dst + (size_t)row * pitch + cbase + cw) = pack8(v0, v1);
                    } else {
                        const int hc = hd + cw, head = hc >> 6, d = hc & 63;
                        const int b = row_batch(row), tok = row_tok(row);
                        bf16* vp = dst + ((size_t)(b * nh + head) * 64 + d) * NTOK + tok;
                        vp[0 * NTOK] = (bf16)f2bf(v0.x); vp[1 * NTOK] = (bf16)f2bf(v0.y); vp[2 * NTOK] = (bf16)f2bf(v0.z); vp[3 * NTOK] = (bf16)f2bf(v0.w);
                        vp[4 * NTOK] = (bf16)f2bf(v1.x); vp[5 * NTOK] = (bf16)f2bf(v1.y); vp[6 * NTOK] = (bf16)f2bf(v1.z); vp[7 * NTOK] = (bf16)f2bf(v1.w);
                    }
                }
        }
    }
};
__device__ __forceinline__ void unpack8(const v4u& w, f32x4& a, f32x4& b) {
    a = (f32x4){bf2f(w.x & 0xffffu), bf2f(w.x >> 16), bf2f(w.y & 0xffffu), bf2f(w.y >> 16)}; b = (f32x4){bf2f(w.z & 0xffffu), bf2f(w.z >> 16), bf2f(w.w & 0xffffu), bf2f(w.w >> 16)};
}
struct EpiBranch {
    const bf16* SG; bf16* MG;
    __device__ __forceinline__ void operator()(const f32x4 (&acc)[2][2][4][2], const pg8::Unit& u, int wr, int wc, int fr, int fq) const {
        asm volatile("" : "+v"(fr), "+v"(fq));
#pragma unroll
        for (int ai = 0; ai < 2; ++ai)
#pragma unroll
            for (int m = 0; m < 4; ++m) {
                const int row = u.pm * 256 + ai * 128 + wr * 64 + m * 16 + fr;
#pragma unroll
                for (int bj = 0; bj < 2; ++bj) {
                    const int col = u.pn * 256 + bj * 128 + wc * 32 + 8 * fq;
                    f32x4 g0, g1; { const v4u wg = *(const GAS v4u*)(SG + (size_t)row * 3072 + u.seg * 1024 + col); unpack8(wg, g0, g1); }
                    f32x4 v0 = g0 * acc[ai][bj][m][0], v1 = g1 * acc[ai][bj][m][1];
                    bf16* mp = MG + (size_t)row * D + col;
                    if (u.seg > 0) { f32x4 p0, p1; const v4u wp = *(const GAS v4u*)mp; unpack8(wp, p0, p1); v0 += p0; v1 += p1; }
                    *(GAS v4u*)mp = pack8(v0, v1);
                }
            }
    }
};
struct EpiOut {
    float* X; const float* gtl; const float* xin; const float* cin;
    __device__ __forceinline__ void operator()(const f32x4 (&acc)[2][2][4][2], const pg8::Unit& u, int wr, int wc, int fr, int fq) const {
        asm volatile("" : "+v"(fr), "+v"(fq));
#pragma unroll
        for (int ai = 0; ai < 2; ++ai)
#pragma unroll
            for (int m = 0; m < 4; ++m) {
                const int row = u.pm * 256 + ai * 128 + wr * 64 + m * 16 + fr;
                const float* gt = gtl + (size_t)row_modidx(row) * 6 * D + 2 * D;
#pragma unroll
                for (int bj = 0; bj < 2; ++bj) {
                    const int col = u.pn * 256 + bj * 128 + wc * 32 + 8 * fq;
                    GAS f32x4* xp = (GAS f32x4*)(X + (size_t)row * D + col);
                    const GAS f32x4* sp = xin ? (const GAS f32x4*)(xin_row(xin, cin, row) + col) : (const GAS f32x4*)xp;
                    const f32x4 g0 = *(const GAS f32x4*)(gt + col), g1 = *(const GAS f32x4*)(gt + col + 4);
                    xp[0] = sp[0] + g0 * acc[ai][bj][m][0]; xp[1] = sp[1] + g1 * acc[ai][bj][m][1];
                }
            }
    }
};
struct EpiStore {
    bf16* O; int ldc;
    __device__ __forceinline__ void operator()(const f32x4 (&acc)[2][2][4][2], const pg8::Unit& u, int wr, int wc, int fr, int fq) const {
        asm volatile("" : "+v"(fr), "+v"(fq));
#pragma unroll
        for (int ai = 0; ai < 2; ++ai)
#pragma unroll
            for (int m = 0; m < 4; ++m) {
                const int row = u.pm * 256 + ai * 128 + wr * 64 + m * 16 + fr;
#pragma unroll
                for (int bj = 0; bj < 2; ++bj) {
                    const int col = u.pn * 256 + bj * 128 + wc * 32 + 8 * fq;
                    *(GAS v4u*)(O + (size_t)row * ldc + col) = pack8(acc[ai][bj][m][0], acc[ai][bj][m][1]);
                }
            }
    }
};

__global__ void __launch_bounds__(NTHREADS, 2) mega_fwd(Args args) {
    extern __shared__ __attribute__((aligned(16))) unsigned char lds[];
    LAS unsigned char* L = (LAS unsigned char*)lds;
    volatile LAS unsigned* MISC = (volatile LAS unsigned*)(L + MISC_OFF);
    const int wave = __builtin_amdgcn_readfirstlane((int)threadIdx.x >> 6);
    const int lane = lane_id_v(), tid = wave * 64 + lane;
    const int fr = lane & 15, fq = lane >> 4;
    const int G = gridDim.x;
    const int vcu = (G % 8 == 0) ? (int)(blockIdx.x % 8) * (G / 8) + (int)(blockIdx.x / 8) : (int)blockIdx.x;
    for (int u = tid; u < (LDS_BYTES - 131072) / 4; u += NTHREADS) ((LAS unsigned*)(L + 131072))[u] = 0u;
    __syncthreads();
    unsigned char* ws = args.ws;
    gu32* ctl = (gu32*)(ws + WS_CTL);
    (void)xcd_barrier_post((unsigned*)(ctl + CW_BAR), MISC + 8);
    if (tid == 0) MISC[12] = xb_add((unsigned*)(ctl + CW_RANK) + 64 * xb_xcc_id(), 1u);
    __syncthreads();
#define GRID_BAR() do { unsigned* bp_ = (unsigned*)(args.ws + WS_CTL) + CW_BAR; asm volatile("" : "+s"(bp_)); XcdBarrier b_; b_.bar = bp_; b_.x = xb_xcc_id(); b_.st = MISC + 8; xcd_barrier(b_, wave == 0 && lane_id_v() == 0); } while (0)
    const int gw = vcu * NWAVES + wave, NGW = G * NWAVES;
    const int NGT = G * NTHREADS;

#define PHASE_PTRS \
    unsigned char* wsq = args.ws; asm volatile("" : "+s"(wsq)); \
    const float* const* IN_ = (const float* const*)__builtin_amdgcn_kernarg_segment_ptr(); asm volatile("" : "+s"(IN_)); \
    float* MODV = (float*)(wsq + WS_MOD); float* COS = (float*)(wsq + WS_COS); float* SIN = (float*)(wsq + WS_SIN); \
    bf16* WIN = (bf16*)(wsq + WS_WIN); bf16* WB = (bf16*)(wsq + WS_WB); bf16* WO = (bf16*)(wsq + WS_WO); bf16* WQ = (bf16*)(wsq + WS_WQ); bf16* KEYS = (bf16*)(wsq + WS_KEYS); \
    float* X = (float*)(wsq + WS_X); bf16* H = (bf16*)(wsq + WS_H); bf16* Y = (bf16*)(wsq + WS_Y); bf16* MG = (bf16*)(wsq + WS_MG); \
    unsigned* EI = (unsigned*)(wsq + WS_EI); float* EG = (float*)(wsq + WS_EG); \
    unsigned char* U8 = wsq + WS_U8; unsigned char* V8 = wsq + WS_V8; float* SCU = (float*)(wsq + WS_SCU); float* SCV = SCU + DEPTH * 16384; \
    bf16* AQ = (bf16*)(wsq + WS_AQ); bf16* AK = (bf16*)(wsq + WS_AK); bf16* AVT = (bf16*)(wsq + WS_AVT); \
    bf16* BQ = (bf16*)(wsq + WS_BQ); bf16* BK = (bf16*)(wsq + WS_BK); bf16* BVT = (bf16*)(wsq + WS_BVT); \
    bf16* CQ = (bf16*)(wsq + WS_CQ); bf16* CK = (bf16*)(wsq + WS_CK); bf16* CVT = (bf16*)(wsq + WS_CVT); \
    bf16* SG = (bf16*)(wsq + WS_SG); bf16* Q2 = (bf16*)(wsq + WS_Q2); float* SC = (float*)(wsq + WS_SC); \
    (void)MODV; (void)COS; (void)SIN; (void)WIN; (void)WB; (void)WO; (void)WQ; (void)KEYS; (void)X; (void)H; (void)Y; (void)MG; (void)EI; (void)EG; (void)U8; (void)V8; (void)SCU; (void)SCV; \
    (void)AQ; (void)AK; (void)AVT; (void)BQ; (void)BK; (void)BVT; (void)CQ; (void)CK; (void)CVT; (void)SG; (void)Q2; (void)SC; (void)IN_;
#define LAYER_PTRS const float* modl = MODV + (size_t)layer * 3 * 6 * D; const bf16* WINl = WIN + (size_t)layer * IN_W * D; (void)modl; (void)WINl;

#ifndef SKIP_P0
        { PHASE_PTRS
        for (int rep_ = 0; rep_ < REP_P0; ++rep_) {
    {
        LAS float* scr = (LAS float*)(L + wave * 16384);
        int gt = vcu * NTHREADS + tid; asm volatile("" : "+v"(gt));
        constexpr int I_IN = (D / 64) * (IN_W / 32), I_BR = (512 / 64) * (D / 32), I_O = (D / 64) * (D / 32), I_Q = (D / 64) * (2048 / 32);
        constexpr int PER_LAYER = I_IN + 3 * I_BR + I_O + I_Q;
        for (int rp_ = 0; rp_ < REP_P0A; ++rp_)
        for (int it = gw; it < DEPTH * PER_LAYER; it += NGW) {
            const int l = it / PER_LAYER; int r = it % PER_LAYER;
            if (r < I_IN) { p0_transpose_item<true>(IN_[I_WIN] + (size_t)l * D * IN_W, D, IN_W, WIN + (size_t)l * IN_W * D, scr, r, lane); continue; } r -= I_IN;
            if (r < I_BR) { p0_transpose_item(IN_[I_WBA] + (size_t)l * 512 * D, 512, D, WB + (size_t)(l * 3 + 0) * D * 512, scr, r, lane); continue; } r -= I_BR;
            if (r < I_BR) { p0_transpose_item(IN_[I_WBB] + (size_t)l * 512 * D, 512, D, WB + (size_t)(l * 3 + 1) * D * 512, scr, r, lane); continue; } r -= I_BR;
            if (r < I_BR) { p0_transpose_item(IN_[I_WBC] + (size_t)l * 512 * D, 512, D, WB + (size_t)(l * 3 + 2) * D * 512, scr, r, lane); continue; } r -= I_BR;
            if (r < I_O) { p0_transpose_item(IN_[I_WOUT] + (size_t)l * D * D, D, D, WO + (size_t)l * D * D, scr, r, lane); continue; } r -= I_O;
            p0_transpose_item(IN_[I_PWQ] + (size_t)l * D * 2048, D, 2048, WQ + (size_t)l * 2048 * D, scr, r, lane);
        }
        for (int i = gt; i < DEPTH * 16 * 128 * 128 / 4; i += NGT) {
            const f32x4 v = *((const GAS f32x4*)IN_[I_PKEYS] + i);
            v2u o; o.x = pk2(v.x, v.y); o.y = pk2(v.z, v.w); *((GAS v2u*)KEYS + i) = o;
        }
        {
            LAS float* red = (LAS float*)(L + 9216);
            for (int rp_ = 0; rp_ < REP_P0D; ++rp_)
            for (int it = vcu; it < DEPTH * 96; it += G) {
                const int l = it / 96, nc = it % 96, n = nc * 64 + lane;
                const float* wm = IN_[I_WMOD] + (size_t)l * D * 6 * D + n;
                float a0 = 0.f, a1 = 0.f, a2 = 0.f;
#pragma unroll 1
                for (int half = 0; half < 2; ++half) {
                    const int kb = wave * 128 + half * 64;
                    const float c0 = IN_[I_C][kb + lane], c1 = IN_[I_C][D + kb + lane], c2 = IN_[I_CCTX][kb + lane];
                    const int s0 = __builtin_bit_cast(int, c0 * sigmoidf_(c0)), s1 = __builtin_bit_cast(int, c1 * sigmoidf_(c1)), s2 = __builtin_bit_cast(int, c2 * sigmoidf_(c2));
#pragma unroll
                    for (int kk = 0; kk < 64; ++kk) {
                        const float w = wm[(size_t)(kb + kk) * 6 * D];
                        a0 += __builtin_bit_cast(float, __builtin_amdgcn_readlane(s0, kk)) * w;
                        a1 += __builtin_bit_cast(float, __builtin_amdgcn_readlane(s1, kk)) * w;
                        a2 += __builtin_bit_cast(float, __builtin_amdgcn_readlane(s2, kk)) * w;
                    }
                }
                red[(wave * 3 + 0) * 64 + lane] = a0; red[(wave * 3 + 1) * 64 + lane] = a1; red[(wave * 3 + 2) * 64 + lane] = a2;
                __syncthreads();
                if (wave < 3) {
                    float sum = IN_[I_BMOD][l * 6 * D + n];
#pragma unroll
                    for (int w = 0; w < 8; ++w) sum += red[(w * 3 + wave) * 64 + lane];
                    MODV[(size_t)(l * 3 + wave) * 6 * D + n] = sum;
                }
                __syncthreads();
            }
        }
        for (int i = gt; i < SEQ * 32; i += NGT) {
            const int t = i >> 5, f = i & 31;
            const float inv = exp2f(-(float)(f & 15) * (13.287712379549449f / 16.0f));
            const float pos = (f < 16) ? (float)(t / GRID_W) : (float)(t % GRID_W);
            float sn, cs; sincosf(pos * inv, &sn, &cs);
            COS[i] = cs; SIN[i] = sn;
        }
    }
        for (int rp_ = 0; rp_ < REP_P0F; ++rp_)
#pragma unroll 4
        for (int rr = gw; rr < 2 * DEPTH * 16384; rr += NGW) {
            const int tab = rr / (DEPTH * 16384), row = rr % (DEPTH * 16384);
            const float* src = (tab == 0 ? IN_[I_PU] : IN_[I_PV]) + (size_t)row * D;
            f32x4 v[4]; float am = 0.f;
#pragma unroll
            for (int j = 0; j < 4; ++j) { v[j] = *((const GAS f32x4*)src + lane + 64 * j); am = fmaxf(am, fmaxf(fmaxf(fabsf(v[j].x), fabsf(v[j].y)), fmaxf(fabsf(v[j].z), fabsf(v[j].w)))); }
            am = wave_max(am);
            const bool as_i8 = (P10_SLICED != 0) && (tab == 0);
            int ex = 0; float scale = 1.0f;
            if (am > 0.f) { (void)frexpf(am * (as_i8 ? (1.0f / 127.0f) : (1.0f / 448.0f)), &ex); scale = ldexpf(1.0f, ex); }
            const float inv = 1.0f / scale;
            v4u o;
#pragma unroll
            for (int j = 0; j < 4; ++j) {
                if (as_i8) {
                    const int q0 = __float2int_rn(v[j].x * inv), q1 = __float2int_rn(v[j].y * inv), q2 = __float2int_rn(v[j].z * inv), q3 = __float2int_rn(v[j].w * inv);
                    o[j] = (unsigned)(q0 & 255) | ((unsigned)(q1 & 255) << 8) | ((unsigned)(q2 & 255) << 16) | ((unsigned)q3 << 24);
                } else {
                    int p = __builtin_amdgcn_cvt_pk_fp8_f32(v[j].x * inv, v[j].y * inv, 0, false);
                    p = __builtin_amdgcn_cvt_pk_fp8_f32(v[j].z * inv, v[j].w * inv, p, true);
                    o[j] = (unsigned)p;
                }
            }
            *((GAS v4u*)((tab == 0 ? U8 : V8) + (size_t)row * D) + lane) = o;
            if (lane == 0) (tab == 0 ? SCU : SCV)[row] = scale;
        }
        }
        }
#endif
    GRID_BAR();

    for (int layer = 0; layer < DEPTH; ++layer) {
        const bool last = (layer == DEPTH - 1);
        const int T_EFF = last ? T_LAT : T_ALL;

#ifndef SKIP_P1
        { PHASE_PTRS LAYER_PTRS
        for (int rep_ = 0; rep_ < REP_P1; ++rep_) {
        { const int ln = lane_id_v();
        if (layer == 0)
        for (int r = gw; r < T_ALL; r += NGW) {
            const float* md = modl + (size_t)row_modidx(r) * 6 * D;
            const GAS f32x4* xr = (const GAS f32x4*)xin_row(IN_[I_X], IN_[I_CTX], r) + ln;
            f32x4 v[4]; float ss = 0.f;
#pragma unroll
            for (int j = 0; j < 4; ++j) { v[j] = xr[64 * j]; ss += (v[j].x * v[j].x + v[j].y * v[j].y) + (v[j].z * v[j].z + v[j].w * v[j].w); }
            const float rs = 1.0f / sqrtf(wave_sum(ss) * (1.f / D) + NORM_EPS);
            GAS v2u* o8 = (GAS v2u*)(H + (size_t)r * D) + ln;
#pragma unroll
            for (int j = 0; j < 4; ++j) {
                const f32x4 g = *((const GAS f32x4*)(IN_[I_G1] + layer * D) + ln + 64 * j);
                const f32x4 sh = *((const GAS f32x4*)(md + 0) + ln + 64 * j), sc = *((const GAS f32x4*)(md + D) + ln + 64 * j);
                const f32x4 h = v[j] * rs * g * (sc + 1.0f) + sh;
                v2u o; o.x = pk2(h.x, h.y); o.y = pk2(h.z, h.w); o8[64 * j] = o;
            }
        }
        }
        }
        }
#endif
        if (layer == 0) GRID_BAR();

#ifndef SKIP_P2
        { PHASE_PTRS LAYER_PTRS
        for (int rep_ = 0; rep_ < REP_P2; ++rep_) {
        {
            pg8::Gemm g{H, WINl, D, D, D, 0, 0};
            pg8::SegOrder<1> S; S.T.init(T_ALL, IN_W, G, (int)blockIdx.x);
            EpiInProj E{AQ, AK, AVT, BQ, BK, BVT, CQ, CK, CVT, SG, COS, SIN};
            pg8::gemm_phase(L, g, S, E, wave);
        }
        }
        }
#endif
        GRID_BAR();

#ifndef SKIP_P3
        { PHASE_PTRS LAYER_PTRS
        {
            LAS bf16* Pl = (LAS bf16*)(L + wave * 8192);
            const float lam_init = 0.8f - 0.6f * expf(-0.3f * (float)layer);
            float lam;
            {
                const int ll = lane_id_v();
                const float* cl = IN_[I_LAMBDA] + layer * 256;
                const float s1 = wave_sum(cl[ll] * cl[64 + ll]), s2 = wave_sum(cl[128 + ll] * cl[192 + ll]);
                lam = expf(s1) - expf(s2) + lam_init;
            }
{ const int lo__ = lane_id_v(); { const int lane = lo__; const int fr = lane & 15, fq = lane >> 4, tid = wave * 64 + lane; (void)fr; (void)fq; (void)tid;
            {
                const int r32 = lane & 31, hi = lane >> 5;
                const int n_lat = BATCH * 4 * (SEQ / 256), n_ctx = last ? 0 : BATCH * 4;
                const int NU = (n_lat + G - 1) / G * G + n_ctx;
                for (int rep_ = 0; rep_ < REP_P3C; ++rep_)
                for (int u0 = vcu; u0 < NU; u0 += G) {
                    int b, h, row0, t_lo, t_hi;
                    if (u0 < n_lat) { const int bh = u0 >> 5; b = bh >> 2; h = bh & 3; row0 = b * SEQ + (u0 & 31) * 256; t_lo = 0; t_hi = 132; }
                    else { const int c = u0 - (n_lat + G - 1) / G * G; if (c < 0 || c >= n_ctx) continue; b = c >> 2; h = c & 3; row0 = T_LAT + b * CTX; t_lo = 128; t_hi = 132; }
                    const int qrow = row0 + wave * 32 + r32;
                    LAS unsigned* o1p = (LAS unsigned*)(L + 65536 + wave * 8192) + lane;
                    const int krow_s = tid >> 3, kch_s = tid & 7;
                    const int vrow_s0 = tid >> 4, vch_s = tid & 15;
                    LAS unsigned char* Kb0 = L; LAS unsigned char* Vb0 = L + 2 * CK_SZ;
#pragma unroll 1
                    for (int m = 0; m < 2; ++m) {
                        bf16x8 qf[4];
                        { const bf16* qp = CQ + (size_t)qrow * 512 + (h * 2 + m) * 64 + hi * 8;
#pragma unroll
                          for (int ks = 0; ks < 4; ++ks) qf[ks] = *(const GAS bf16x8*)(qp + ks * 16); }
                        f32x16 o[4];
#pragma unroll
                        for (int d = 0; d < 4; ++d)
#pragma unroll
                            for (int r = 0; r < 16; ++r) o[d][r] = 0.f;
                        float mrun = -1e30f, lpart = 0.f;
                        const bf16* kg = CK + (size_t)krow_s * 512 + (h * 2 + m) * 64 + kch_s * 8;
                        const bf16* vg = CVT + (size_t)vrow_s0 * 512 + h * 128 + vch_s * 8;
                        auto tile_row = [&](int j) { return (j < 128) ? b * SEQ + 64 * j : T_LAT + b * CTX + 64 * (j - 128); };
                        __syncthreads();
                        {
                            const size_t kb = (size_t)tile_row(t_lo) * 512;
                            const v4u kr = *(const GAS v4u*)(kg + kb), v0 = *(const GAS v4u*)(vg + kb), v1 = *(const GAS v4u*)(vg + kb + 32 * 512);
                            *(LAS v4u*)(Kb0 + krow_s * CK_PITCH + kch_s * 16) = kr;
                            *(LAS v4u*)(Vb0 + vrow_s0 * CV_PITCH + vch_s * 16) = v0; *(LAS v4u*)(Vb0 + (vrow_s0 + 32) * CV_PITCH + vch_s * 16) = v1;
                        }
                        __syncthreads();
#pragma unroll 1
                        for (int j = t_lo; j < t_hi; ++j) {
                            const int cur = (j - t_lo) & 1;
                            const LAS unsigned char* Kb = Kb0 + cur * CK_SZ; const LAS unsigned char* Vb = Vb0 + cur * CV_SZ;
                            v4u kr, v0, v1;
                            const bool more = (j + 1 < t_hi);
                            { const size_t kb = (size_t)tile_row(more ? j + 1 : j) * 512; kr = *(const GAS v4u*)(kg + kb); v0 = *(const GAS v4u*)(vg + kb); v1 = *(const GAS v4u*)(vg + kb + 32 * 512); }
                            f32x16 st[2];
#pragma unroll
                            for (int kb = 0; kb < 2; ++kb) {
#pragma unroll
                                for (int r = 0; r < 16; ++r) st[kb][r] = 0.f;
#pragma unroll
                                for (int ks = 0; ks < 4; ++ks) {
                                    const bf16x8 kf = *(const LAS bf16x8*)(Kb + (kb * 32 + r32) * CK_PITCH + ks * 32 + hi * 16);
                                    st[kb] = __builtin_amdgcn_mfma_f32_32x32x16_bf16(kf, qf[ks], st[kb], 0, 0, 0);
                                }
                            }
                            float mx = st[0][0];
#pragma unroll
                            for (int r = 1; r < 16; ++r) mx = fmaxf(mx, st[0][r]);
#pragma unroll
                            for (int r = 0; r < 16; ++r) mx = fmaxf(mx, st[1][r]);
                            mx = xmax32(mx);
                            if (__builtin_amdgcn_ballot_w64(mx > mrun + C_THR_RAW) != 0ull) {
                                const float mn = fmaxf(mrun, mx);
                                const float alpha = __builtin_amdgcn_exp2f((mrun - mn) * SCL2);
#pragma unroll
                                for (int d = 0; d < 4; ++d)
#pragma unroll
                                    for (int r = 0; r < 16; ++r) o[d][r] *= alpha;
                                lpart *= alpha; mrun = mn;
                            }
                            const float nmc = -mrun * SCL2;
                            float ls = 0.f;
#pragma unroll
                            for (int kb = 0; kb < 2; ++kb)
#pragma unroll
                                for (int r = 0; r < 16; ++r) { const float p = __builtin_amdgcn_exp2f(fmaf(st[kb][r], SCL2, nmc)); st[kb][r] = p; ls += p; }
                            lpart += ls;
                            {
                                const int q4 = (lane & 15) >> 2, p4 = lane & 3, grp = (lane >> 4) & 1;
                                const LAS unsigned char* vbase = Vb + (4 * hi + q4) * CV_PITCH + (16 * grp + 4 * p4) * 2;
#pragma unroll
                                for (int kb = 0; kb < 2; ++kb)
#pragma unroll
                                    for (int ss = 0; ss < 2; ++ss) {
                                        v4u pw;
#pragma unroll
                                        for (int i2 = 0; i2 < 4; ++i2) pw[i2] = cvtpk(st[kb][8 * ss + 2 * i2], st[kb][8 * ss + 2 * i2 + 1]);
                                        const bf16x8 pb = __builtin_bit_cast(bf16x8, pw);
#pragma unroll
                                        for (int d = 0; d < 4; ++d) {
                                            const LAS unsigned char* va = vbase + (kb * 32 + 16 * ss) * CV_PITCH + d * 64;
                                            const s16x4 lo = __builtin_bit_cast(s16x4, __builtin_amdgcn_ds_read_tr16_b64_v4i16((LAS s16x4*)va));
                                            const s16x4 hh = __builtin_bit_cast(s16x4, __builtin_amdgcn_ds_read_tr16_b64_v4i16((LAS s16x4*)(va + 8 * CV_PITCH)));
                                            const bf16x8 vf = __builtin_shufflevector(lo, hh, 0, 1, 2, 3, 4, 5, 6, 7);
                                            o[d] = __builtin_amdgcn_mfma_f32_32x32x16_bf16(vf, pb, o[d], 0, 0, 0);
                                        }
                                        if (ss == 1) __builtin_amdgcn_sched_barrier(0);
                                    }
                            }
                            if (more) {
                                LAS unsigned char* Kn = Kb0 + (cur ^ 1) * CK_SZ; LAS unsigned char* Vn = Vb0 + (cur ^ 1) * CV_SZ;
                                *(LAS v4u*)(Kn + krow_s * CK_PITCH + kch_s * 16) = kr;
                                *(LAS v4u*)(Vn + vrow_s0 * CV_PITCH + vch_s * 16) = v0; *(LAS v4u*)(Vn + (vrow_s0 + 32) * CV_PITCH + vch_s * 16) = v1;
                            }
                            __syncthreads();
                        }
                        const float lt = xadd32(lpart);
                        if (m == 0) {
                            const float inv = 1.0f / lt;
#pragma unroll
                            for (int d = 0; d < 4; ++d)
#pragma unroll
                                for (int i2 = 0; i2 < 8; ++i2) o1p[64 * (d * 8 + i2)] = cvtpk(o[d][2 * i2] * inv, o[d][2 * i2 + 1] * inv);
                        } else {
                            const float inv2 = lam / lt;
                            float ssq = 0.f;
#pragma unroll
                            for (int d = 0; d < 4; ++d)
#pragma unroll
                                for (int i2 = 0; i2 < 8; ++i2) {
                                    const unsigned w1 = o1p[64 * (d * 8 + i2)];
                                    const float a0 = bf2f(w1 & 0xffffu) - o[d][2 * i2] * inv2, a1 = bf2f(w1 >> 16) - o[d][2 * i2 + 1] * inv2;
                                    o[d][2 * i2] = a0; o[d][2 * i2 + 1] = a1; ssq += a0 * a0 + a1 * a1;
                                }
                            ssq = xadd32(ssq);
                            const float rn = 1.0f / sqrtf(ssq * (1.f / 128.f) + NORM_EPS) * (1.0f - lam_init);
                            bf16* yp = Y + (size_t)qrow * 1536 + 1024 + h * 128 + 4 * hi;
                            const float* sl = IN_[I_SUBLN] + layer * 512 + h * 128 + 4 * hi;
#pragma unroll
                            for (int d = 0; d < 4; ++d)
#pragma unroll
                                for (int g4 = 0; g4 < 4; ++g4) {
                                    const f32x4 gsl = *(const GAS f32x4*)(sl + d * 32 + 8 * g4);
                                    v2u w; w.x = cvtpk(o[d][4 * g4] * rn * gsl.x, o[d][4 * g4 + 1] * rn * gsl.y); w.y = cvtpk(o[d][4 * g4 + 2] * rn * gsl.z, o[d][4 * g4 + 3] * rn * gsl.w);
                                    *(GAS v2u*)(yp + d * 32 + 8 * g4) = w;
                                }
                        }
                    }
                }
                __syncthreads();
            }
} }
{ const int lo__ = lane_id_v(); { const int lane = lo__; const int tid = wave * 64 + lane, r32 = lane & 31, hi = lane >> 5;
            {
                const int n_lat = BATCH * 2 * (SEQ / 64), n_ctx = last ? 0 : BATCH * 2 * (CTX / 64);
                for (int rep_ = 0; rep_ < REP_P3A; ++rep_)
                for (int u0 = vcu; u0 < n_lat + n_ctx; u0 += G) {
                    const bool isctx = u0 >= n_lat;
                    int b, g, p0, qrow, nl, klo;
                    if (!isctx) { b = u0 >> 8; g = (u0 >> 7) & 1; p0 = (u0 & 127) * 64; qrow = b * SEQ + p0 + (wave & 1) * 32 + r32;
                                  klo = p0 >= 128 ? 0 : (128 - p0) / 64; const int khi = min(4, (SEQ - 1 - (p0 - 128)) / 64); nl = khi - klo + 1; }
                    else { const int c = u0 - n_lat; b = c >> 3; g = (c >> 2) & 1; p0 = (c & 3) * 64; qrow = T_LAT + b * CTX + p0 + (wave & 1) * 32 + r32; nl = 0; klo = 0; }
                    const int hq = g * 4 + (wave >> 1);
                    const int qpos0 = p0 + (wave & 1) * 32;
                    bf16x8 qf[4];
                    { const bf16* qp = AQ + (size_t)qrow * 512 + hq * 64 + hi * 8;
#pragma unroll
                      for (int ks = 0; ks < 4; ++ks) qf[ks] = *(const GAS bf16x8*)(qp + ks * 16); }
                    f32x16 o[2];
#pragma unroll
                    for (int d = 0; d < 2; ++d)
#pragma unroll
                        for (int r = 0; r < 16; ++r) o[d][r] = 0.f;
                    float mrun = IN_[I_SINK][layer * 8 + hq] * 8.0f;
                    float lpart = (hi == 0) ? 1.0f : 0.0f;
                    const bf16* kg = AK + (size_t)(tid >> 3) * 128 + g * 64 + (tid & 7) * 8;
                    const bf16* vg = AVT + (size_t)(tid >> 3) * 128 + g * 64 + (tid & 7) * 8;
                    const int kp0 = p0 - 128 + 64 * klo;
                    auto tile_row = [&](int j) { return (j < nl) ? b * SEQ + kp0 + 64 * j : T_LAT + b * CTX + 64 * (j - nl); };
                    auto use_tile = [&](int j) { if (j >= nl) return true; const int kp = kp0 + 64 * j; return (kp + 63 >= qpos0 - 128) && (kp <= qpos0 + 31 + 128); };
                    auto elem = [&](f32x16 (&st)[2], int j) {
                        if (j < nl) {
                            const int dq0 = (qpos0 + r32) - (kp0 + 64 * j + 4 * hi);
#pragma unroll
                            for (int kb = 0; kb < 2; ++kb)
#pragma unroll
                                for (int r = 0; r < 16; ++r) { const int dq = dq0 - (kb * 32 + (r & 3) + 8 * (r >> 2)); if (dq > 128 || dq < -128) st[kb][r] = -1e30f; }
                        }
                    };
                    attn64_pass<2>(o, mrun, lpart, qf, kg, 128, vg, 128, nl + 4, tile_row, use_tile, elem, L, lane, tid);
                    const float lt = xadd32(lpart);
                    attn64_store(o, 1.0f / lt, Y + (size_t)qrow * 1536 + hq * 64, hi);
                }
            }
} }
{ const int lo__ = lane_id_v(); { const int lane = lo__; const int tid = wave * 64 + lane, r32 = lane & 31, hi = lane >> 5;
            {
                const int n_lat = BATCH * 8 * 32, n_ctx = last ? 0 : BATCH * 8;
                LAS float* rpbL = (LAS float*)(L + 49152);
                for (int rep_ = 0; rep_ < REP_P3B; ++rep_)
                for (int u0 = vcu; u0 < n_lat + n_ctx; u0 += G) {
                    const bool isctx = u0 >= n_lat;
                    int b, h, gr = 0, qc0 = 0, qrow, nl, krlo;
                    if (!isctx) { b = u0 >> 8; h = (u0 >> 5) & 7; const int r0 = (u0 & 31) * 4; gr = r0 + (wave >> 1); qc0 = (wave & 1) * 32; qrow = b * SEQ + gr * GRID_W + qc0 + r32;
                                  krlo = min(max(r0 - 4, 0), 120); nl = min(max(r0 - 1, 0), 120) + 8 - krlo; }
                    else { const int c = u0 - n_lat; b = c >> 3; h = c & 7; qrow = T_LAT + b * CTX + wave * 32 + r32; nl = 0; krlo = 0; }
                    __syncthreads();
                    if (tid < 465) rpbL[tid] = IN_[I_RPB][(size_t)(layer * 8 + h) * 465 + tid] * 8.0f;
                    bf16x8 qf[4];
                    { const bf16* qp = BQ + (size_t)qrow * 512 + h * 64 + hi * 8;
#pragma unroll
                      for (int ks = 0; ks < 4; ++ks) qf[ks] = *(const GAS bf16x8*)(qp + ks * 16); }
                    f32x16 o[2];
#pragma unroll
                    for (int d = 0; d < 2; ++d)
#pragma unroll
                        for (int r = 0; r < 16; ++r) o[d][r] = 0.f;
                    float mrun = -1e30f, lpart = 0.f;
                    const bf16* kg = BK + (size_t)(tid >> 3) * 512 + h * 64 + (tid & 7) * 8;
                    const bf16* vg = BVT + (size_t)(tid >> 3) * 512 + h * 64 + (tid & 7) * 8;
                    const int rs = min(max(gr - 4, 0), 120);
                    auto tile_row = [&](int j) { return (j < nl) ? b * SEQ + (krlo + j) * GRID_W : T_LAT + b * CTX + 64 * (j - nl); };
                    auto use_tile = [&](int j) { if (j >= nl) return true; const int kr = krlo + j; return kr >= rs && kr < rs + 8; };
                    auto elem = [&](f32x16 (&st)[2], int j) {
                        if (j < nl) {
                            const int qc = qc0 + r32, cstart = min(max(qc - 8, 0), 48);
                            const LAS float* brow = rpbL + (krlo + j - gr + 7) * 31 + 15;
#pragma unroll
                            for (int kb = 0; kb < 2; ++kb)
#pragma unroll
                                for (int r = 0; r < 16; ++r) {
                                    const int kc = kb * 32 + (r & 3) + 8 * (r >> 2) + 4 * hi;
                                    const bool valid = (kc >= cstart) && (kc < cstart + 16);
                                    const int dc = min(max(kc - qc, -15), 15);
                                    st[kb][r] = valid ? st[kb][r] + brow[dc] : -1e30f;
                                }
                        }
                    };
                    attn64_pass<2>(o, mrun, lpart, qf, kg, 512, vg, 512, nl + 4, tile_row, use_tile, elem, L, lane, tid);
                    const float lt = xadd32(lpart);
                    attn64_store(o, 1.0f / lt, Y + (size_t)qrow * 1536 + 512 + h * 64, hi);
                }
                __syncthreads();
            }
} }
        }
        }
#endif
        GRID_BAR();

#ifndef SKIP_P4
        { PHASE_PTRS LAYER_PTRS
        for (int rep_ = 0; rep_ < REP_P4; ++rep_) {
        {
            pg8::Gemm g{Y, WB + (size_t)layer * 3 * D * 512, 1536, 512, 512, 512, (size_t)D * 512};
            pg8::SegOrder<3> S; S.T.init(T_LAT, D, G, (int)blockIdx.x);
            EpiBranch E{SG, MG};
            pg8::gemm_phase(L, g, S, E, wave);
        }
        if (!last) { const int lo__ = lane_id_v(); { const int lane = lo__; const int fr = lane & 15, fq = lane >> 4; (void)fr; (void)fq;
            for (int it = gw; it < (T_ALL - T_LAT) / 32 * (D / 32); it += NGW) {
                const int row0 = T_LAT + (it / (D / 32)) * 32, col0 = (it % (D / 32)) * 32;
                f32x4 mg[2][2]; zero_acc22(mg);
#pragma unroll 1
                for (int seg = 0; seg < 3; ++seg) {
                    f32x4 acc[2][2]; zero_acc22(acc);
                    sgemm32<8>(acc, Y + seg * 512, 1536, WB + (size_t)(layer * 3 + seg) * D * 512, 512, 512, row0, col0, lane);
#pragma unroll
                    for (int m = 0; m < 2; ++m)
#pragma unroll
                        for (int r = 0; r < 4; ++r) {
                            const bf16* gp = SG + (size_t)(row0 + 16 * m + 4 * fq + r) * 3072 + seg * 1024 + col0 + fr;
#pragma unroll
                            for (int n = 0; n < 2; ++n) mg[m][n][r] += bf2f(gp[16 * n]) * acc[m][n][r];
                        }
                }
#pragma unroll
                for (int m = 0; m < 2; ++m)
#pragma unroll
                    for (int r = 0; r < 4; ++r) {
                        bf16* rowp = MG + (size_t)(row0 + 16 * m + 4 * fq + r) * D + col0 + fr;
#pragma unroll
                        for (int n = 0; n < 2; ++n) rowp[16 * n] = (bf16)f2bf(mg[m][n][r]);
                    }
            }
} }
        }
        }
#endif
        GRID_BAR();

#ifndef SKIP_P5
        { PHASE_PTRS LAYER_PTRS
        {
            pg8::Gemm g{MG, WO + (size_t)layer * D * D, D, D, D, 0, 0};
            pg8::SegOrder<1> S; S.T.init(T_LAT, D, G, (int)blockIdx.x);
            EpiOut E{X, modl, layer == 0 ? IN_[I_X] : nullptr, IN_[I_CTX]};
            pg8::gemm_phase(L, g, S, E, wave);
        }
        if (!last) { const int lo__ = lane_id_v(); { const int lane = lo__; const int fr = lane & 15, fq = lane >> 4; (void)fr; (void)fq;
            for (int it = gw; it < (T_ALL - T_LAT) / 32 * (D / 32); it += NGW) {
                const int row0 = T_LAT + (it / (D / 32)) * 32, col0 = (it % (D / 32)) * 32;
                f32x4 acc[2][2]; zero_acc22(acc);
                sgemm32<8>(acc, MG, D, WO + (size_t)layer * D * D, D, D, row0, col0, lane);
                const float* gt = modl + (size_t)2 * 6 * D + 2 * D + col0 + fr;
#pragma unroll
                for (int m = 0; m < 2; ++m)
#pragma unroll
                    for (int r = 0; r < 4; ++r) {
                        float* rowp = X + (size_t)(row0 + 16 * m + 4 * fq + r) * D + col0 + fr;
                        const float* srcp = (layer == 0) ? IN_[I_CTX] + (size_t)(row0 - T_LAT + 16 * m + 4 * fq + r) * D + col0 + fr : rowp;
#pragma unroll
                        for (int n = 0; n < 2; ++n) rowp[16 * n] = srcp[16 * n] + gt[16 * n] * acc[m][n][r];
                    }
            }
} }
        }
#endif
        GRID_BAR();

#ifndef SKIP_P6
        { PHASE_PTRS LAYER_PTRS
        for (int rep_ = 0; rep_ < REP_P6; ++rep_) {
        { const int ln = lane_id_v();
        for (int r = gw; r < T_EFF; r += NGW) {
            const float* md = modl + (size_t)row_modidx(r) * 6 * D;
            const GAS f32x4* xr = (const GAS f32x4*)(X + (size_t)r * D) + ln;
            f32x4 v[4]; float ss = 0.f;
#pragma unroll
            for (int j = 0; j < 4; ++j) { v[j] = xr[64 * j]; ss += (v[j].x * v[j].x + v[j].y * v[j].y) + (v[j].z * v[j].z + v[j].w * v[j].w); }
            const float rs = 1.0f / sqrtf(wave_sum(ss) * (1.f / D) + NORM_EPS);
            GAS v2u* o8 = (GAS v2u*)(H + (size_t)r * D) + ln;
#pragma unroll
            for (int j = 0; j < 4; ++j) {
                const f32x4 g = *((const GAS f32x4*)(IN_[I_G2] + layer * D) + ln + 64 * j);
                const f32x4 sh = *((const GAS f32x4*)(md + 3 * D) + ln + 64 * j), sc = *((const GAS f32x4*)(md + 4 * D) + ln + 64 * j);
                const f32x4 h = v[j] * rs * g * (sc + 1.0f) + sh;
                v2u o; o.x = pk2(h.x, h.y); o.y = pk2(h.z, h.w); o8[64 * j] = o;
            }
        }
        }
        }
        }
#endif
        GRID_BAR();

#ifndef SKIP_P7
        { PHASE_PTRS LAYER_PTRS
        for (int rep_ = 0; rep_ < REP_P7; ++rep_) {
        {
            pg8::Gemm g{H, WQ + (size_t)layer * 2048 * D, D, D, D, 0, 0};
            pg8::SegOrder<1> S; S.T.init(T_LAT, 2048, G, (int)blockIdx.x);
            EpiStore E{Q2, 2048};
            pg8::gemm_phase(L, g, S, E, wave);
        }
        if (!last) { const int lo__ = lane_id_v(); { const int lane = lo__; const int fr = lane & 15, fq = lane >> 4; (void)fr; (void)fq;
            for (int it = gw; it < (T_ALL - T_LAT) / 32 * (2048 / 32); it += NGW) {
                const int row0 = T_LAT + (it / (2048 / 32)) * 32, col0 = (it % (2048 / 32)) * 32;
                f32x4 acc[2][2]; zero_acc22(acc);
                sgemm32<8>(acc, H, D, WQ + (size_t)layer * 2048 * D, D, D, row0, col0, lane);
#pragma unroll
                for (int m = 0; m < 2; ++m)
#pragma unroll
                    for (int r = 0; r < 4; ++r) {
                        bf16* rowp = Q2 + (size_t)(row0 + 16 * m + 4 * fq + r) * 2048 + col0 + fr;
#pragma unroll
                        for (int n = 0; n < 2; ++n) rowp[16 * n] = (bf16)f2bf(acc[m][n][r]);
                    }
            }
} }
        }
        }
#endif
        GRID_BAR();

#ifndef SKIP_P8
        { PHASE_PTRS LAYER_PTRS
        for (int rep_ = 0; rep_ < REP_P8; ++rep_) {
{ const int lo__ = lane_id_v(); { const int lane = lo__; const int fr = lane & 15, fq = lane >> 4, tid = wave * 64 + lane;
        {
            LAS float* S = (LAS float*)L;
            const int wr = wave >> 1, wc = wave & 1;
            const int tl = tid >> 2, qd = tid & 3, ph = qd >> 1, hq = qd & 1;
            for (int it = vcu; it < (T_EFF / 128) * PEER_HEADS; it += G) {
                const int tile = it >> 3, h = it & 7;
                {
                    f32x4 acc[2][8];
#pragma unroll
                    for (int m = 0; m < 2; ++m)
#pragma unroll
                        for (int n = 0; n < 8; ++n) acc[m][n] = (f32x4){0.f, 0.f, 0.f, 0.f};
                    const bf16* ap = Q2 + (size_t)(tile * 128 + wr * 32 + fr) * 2048 + h * 256 + wc * 128 + fq * 8;
                    const bf16* bp = KEYS + ((size_t)(layer * 16 + h * 2 + wc) * 128 + fr) * 128 + fq * 8;
                    bf16x8 af[2][4];
#pragma unroll
                    for (int m = 0; m < 2; ++m)
#pragma unroll
                        for (int ks = 0; ks < 4; ++ks) af[m][ks] = *(const GAS bf16x8*)(ap + (size_t)m * 16 * 2048 + ks * 32);
#pragma unroll
                    for (int n = 0; n < 8; ++n) {
                        bf16x8 bfr[4];
#pragma unroll
                        for (int ks = 0; ks < 4; ++ks) bfr[ks] = *(const GAS bf16x8*)(bp + (size_t)n * 16 * 128 + ks * 32);
#pragma unroll
                        for (int ks = 0; ks < 4; ++ks)
#pragma unroll
                            for (int m = 0; m < 2; ++m) acc[m][n] = __builtin_amdgcn_mfma_f32_16x16x32_bf16(af[m][ks], bfr[ks], acc[m][n], 0, 0, 0);
                    }
#pragma unroll
                    for (int m = 0; m < 2; ++m)
#pragma unroll
                        for (int r = 0; r < 4; ++r) {
                            const int row_ = wr * 32 + 16 * m + 4 * fq + r;
#pragma unroll
                            for (int n = 0; n < 8; ++n) { const int key_ = wc * 128 + 16 * n + fr, c_ = key_ >> 2, pc_ = (c_ & 0x30) | ((c_ & 15) ^ (((row_ & 3) << 2) | (c_ >> 4)));
                                S[row_ * 256 + pc_ * 4 + (key_ & 3)] = acc[m][n][r]; }
                        }
                }
                __syncthreads();
                {
                    const int t = tile * 128 + tl;
                    int a[16];
#define LOAD_CHUNK_L(v, ch) _Pragma("unroll") for (int q = 0; q < 4; ++q) { const int c_ = qd * 16 + (ch) * 4 + q, pc_ = (c_ & 0x30) | ((c_ & 15) ^ (((tl & 3) << 2) | qd)); \
                        const f32x4 x = *(const LAS f32x4*)(S + tl * 256 + pc_ * 4); const int kb_ = hq * 64 + (ch) * 16 + 4 * q; \
                        v[4 * q + 0] = (f2ord(x.x) & ~127) | (kb_ + 0); v[4 * q + 1] = (f2ord(x.y) & ~127) | (kb_ + 1); v[4 * q + 2] = (f2ord(x.z) & ~127) | (kb_ + 2); v[4 * q + 3] = (f2ord(x.w) & ~127) | (kb_ + 3); }
                    LOAD_CHUNK_L(a, 0) sort16_desc(a);
#pragma unroll
                    for (int ch = 1; ch < 4; ++ch) { int v[16]; LOAD_CHUNK_L(v, ch) sort16_desc(v); merge16_desc(a, v); }
#undef LOAD_CHUNK_L
                    { int b[16];
#pragma unroll
                      for (int i = 0; i < 16; ++i) b[i] = __builtin_amdgcn_update_dpp(0, a[i], 0xB1, 0xF, 0xF, true);
                      merge16_desc(a, b); }
                    int a0[16], a1[16];
#pragma unroll
                    for (int i = 0; i < 16; ++i) { const int o2 = __builtin_amdgcn_update_dpp(0, a[i], 0x4E, 0xF, 0xF, true); a0[i] = ph ? o2 : a[i]; a1[i] = ph ? a[i] : o2; }
                    {
            float va[16], vb[16];
#pragma unroll
            for (int i = 0; i < 16; ++i) { va[i] = ord2f(a0[i] & ~127); vb[i] = ord2f(a1[i] & ~127); }
            int c[16];
            {
                int v[16];
                v[0] = (f2ord(va[0] + vb[0]) & ~255) | 0;
                v[1] = (f2ord(va[0] + vb[1]) & ~255) | 1;
                v[2] = (f2ord(va[0] + vb[2]) & ~255) | 2;
                v[3] = (f2ord(va[0] + vb[3]) & ~255) | 3;
                v[4] = (f2ord(va[0] + vb[4]) & ~255) | 4;
                v[5] = (f2ord(va[0] + vb[5]) & ~255) | 5;
                v[6] = (f2ord(va[0] + vb[6]) & ~255) | 6;
                v[7] = (f2ord(va[0] + vb[7]) & ~255) | 7;
                v[8] = (f2ord(va[0] + vb[8]) & ~255) | 8;
                v[9] = (f2ord(va[0] + vb[9]) & ~255) | 9;
                v[10] = (f2ord(va[0] + vb[10]) & ~255) | 10;
                v[11] = (f2ord(va[0] + vb[11]) & ~255) | 11;
                v[12] = (f2ord(va[0] + vb[12]) & ~255) | 12;
                v[13] = (f2ord(va[0] + vb[13]) & ~255) | 13;
                v[14] = (f2ord(va[0] + vb[14]) & ~255) | 14;
                v[15] = (f2ord(va[0] + vb[15]) & ~255) | 15;
                sort16_desc(v);
#pragma unroll
                for (int i = 0; i < 16; ++i) c[i] = v[i];
            }
            {
                int v[16];
                v[0] = (f2ord(va[1] + vb[0]) & ~255) | 16;
                v[1] = (f2ord(va[1] + vb[1]) & ~255) | 17;
                v[2] = (f2ord(va[1] + vb[2]) & ~255) | 18;
                v[3] = (f2ord(va[1] + vb[3]) & ~255) | 19;
                v[4] = (f2ord(va[1] + vb[4]) & ~255) | 20;
                v[5] = (f2ord(va[1] + vb[5]) & ~255) | 21;
                v[6] = (f2ord(va[1] + vb[6]) & ~255) | 22;
                v[7] = (f2ord(va[1] + vb[7]) & ~255) | 23;
                v[8] = (f2ord(va[2] + vb[0]) & ~255) | 32;
                v[9] = (f2ord(va[2] + vb[1]) & ~255) | 33;
                v[10] = (f2ord(va[2] + vb[2]) & ~255) | 34;
                v[11] = (f2ord(va[2] + vb[3]) & ~255) | 35;
                v[12] = (f2ord(va[2] + vb[4]) & ~255) | 36;
                v[13] = (f2ord(va[3] + vb[0]) & ~255) | 48;
                v[14] = (f2ord(va[3] + vb[1]) & ~255) | 49;
                v[15] = (f2ord(va[3] + vb[2]) & ~255) | 50;
                sort16_desc(v);
                merge16_desc(c, v);
            }
            {
                int v[16];
                v[0] = (f2ord(va[3] + vb[3]) & ~255) | 51;
                v[1] = (f2ord(va[4] + vb[0]) & ~255) | 64;
                v[2] = (f2ord(va[4] + vb[1]) & ~255) | 65;
                v[3] = (f2ord(va[4] + vb[2]) & ~255) | 66;
                v[4] = (f2ord(va[5] + vb[0]) & ~255) | 80;
                v[5] = (f2ord(va[5] + vb[1]) & ~255) | 81;
                v[6] = (f2ord(va[6] + vb[0]) & ~255) | 96;
                v[7] = (f2ord(va[6] + vb[1]) & ~255) | 97;
                v[8] = (f2ord(va[7] + vb[0]) & ~255) | 112;
                v[9] = (f2ord(va[7] + vb[1]) & ~255) | 113;
                v[10] = (f2ord(va[8] + vb[0]) & ~255) | 128;
                v[11] = (f2ord(va[9] + vb[0]) & ~255) | 144;
                v[12] = (f2ord(va[10] + vb[0]) & ~255) | 160;
                v[13] = (f2ord(va[11] + vb[0]) & ~255) | 176;
                v[14] = (f2ord(va[12] + vb[0]) & ~255) | 192;
                v[15] = (f2ord(va[13] + vb[0]) & ~255) | 208;
                sort16_desc(v);
                merge16_desc(c, v);
            }
            {
                int v[16];
                v[0] = (f2ord(va[14] + vb[0]) & ~255) | 224;
                v[1] = (f2ord(va[15] + vb[0]) & ~255) | 240;
                v[2] = (int)0x80000000;
                v[3] = (int)0x80000000;
                v[4] = (int)0x80000000;
                v[5] = (int)0x80000000;
                v[6] = (int)0x80000000;
                v[7] = (int)0x80000000;
                v[8] = (int)0x80000000;
                v[9] = (int)0x80000000;
                v[10] = (int)0x80000000;
                v[11] = (int)0x80000000;
                v[12] = (int)0x80000000;
                v[13] = (int)0x80000000;
                v[14] = (int)0x80000000;
                v[15] = (int)0x80000000;
                sort16_desc(v);
                merge16_desc(c, v);
            }
            const float smax = ord2f(c[0] & ~255);
            float pe[16]; float psum = 0.f;
#pragma unroll
            for (int k = 0; k < 16; ++k) { pe[k] = __expf(ord2f(c[k] & ~255) - smax); psum += pe[k]; }
            const float ip = 1.0f / psum;
#pragma unroll
            for (int kk = 0; kk < 4; ++kk) {
                const int ck = (qd == 0) ? c[kk] : (qd == 1) ? c[4 + kk] : (qd == 2) ? c[8 + kk] : c[12 + kk];
                const float pk_ = (qd == 0) ? pe[kk] : (qd == 1) ? pe[4 + kk] : (qd == 2) ? pe[8 + kk] : pe[12 + kk];
                const int ij = ck & 255, ii = ij >> 4, jj = ij & 15;
                int e0 = 0, e1 = 0;
#pragma unroll
                for (int q = 0; q < 16; ++q) { e0 = (ii == q) ? (a0[q] & 127) : e0; e1 = (jj == q) ? (a1[q] & 127) : e1; }
                const int e = e0 * PEER_KEYS + e1;
                const float su = SCU[layer * 16384 + e], sv = SCV[layer * 16384 + e];
                const int k = 4 * qd + kk;
                EI[(size_t)t * NSEL + h * 16 + k] = (unsigned)e | (f2bf(su) << 16);
                EG[(size_t)t * NSEL + h * 16 + k] = pk_ * ip * sv;
            }
                    }
                }
                __syncthreads();
            }
        }
} }
        }
        }
#endif
        GRID_BAR();

#ifndef SKIP_P10
#if P10_SLICED
#define P10_CENSUS \
        unsigned myx_, nx_ = 1u, smask_ = 0u; { unsigned cnt_[16]; unsigned* bw_ = (unsigned*)(args.ws + WS_CTL) + CW_BAR; \
            _Pragma("unroll") for (int j = 0; j < 16; ++j) cnt_[j] = (unsigned)__builtin_amdgcn_readfirstlane((int)xb_ld(&bw_[XB_XCNT(j)])); \
            myx_ = xb_xcc_id(); unsigned np_ = 0u; \
            _Pragma("unroll") for (int j = 0; j < 16; ++j) { np_ += (cnt_[j] > 0u) ? 1u : 0u; nx_ = ((unsigned)j == myx_) ? cnt_[j] : nx_; } \
            if (np_ == 0u) np_ = 1u; if (nx_ == 0u) nx_ = 1u; \
            _Pragma("unroll") for (int sl = 0; sl < 8; ++sl) { const unsigned k_ = (unsigned)sl % np_; unsigned seen_ = 0u, srv_ = 0xffu; \
                _Pragma("unroll") for (int j = 0; j < 16; ++j) { if (cnt_[j] > 0u) { srv_ = (seen_ == k_) ? (unsigned)j : srv_; ++seen_; } } \
                smask_ |= (srv_ == myx_) ? (1u << sl) : 0u; } } \
        const int rank_ = (int)__builtin_amdgcn_readfirstlane((int)MISC[12]); const int wstride_ = (int)nx_ * NWAVES; (void)rank_; (void)wstride_;
        { PHASE_PTRS LAYER_PTRS
        { const int ln = lane_id_v(); const int c = ln & 7, sg = ln >> 3;
          P10_CENSUS
          float* PART = (float*)(wsq + WS_PART);
          const unsigned char* U8l = U8 + (size_t)layer * 16384 * D;
          for (int rep_ = 0; rep_ < REP_P10A; ++rep_)
#pragma unroll 1
          for (int sl = 0; sl < 8; ++sl) {
            if (!((smask_ >> sl) & 1u)) continue;
            const int t0 = rank_ * NWAVES + wave;
            if (t0 >= T_EFF) continue;
            const int tlast = t0 + ((T_EFF - 1 - t0) / wstride_) * wstride_;
#define A_LOAD_E(ev, tt) { const int tq_ = min((tt), tlast); _Pragma("unroll") for (int g = 0; g < 16; ++g) ev[g] = EI[(size_t)tq_ * NSEL + 8 * g + sg] & 0xffffu; }
#define A_ISSUE(rowv, hvv, ev, tt) { const int tq_ = min((tt), tlast); \
                _Pragma("unroll") for (int g = 0; g < 16; ++g) rowv[g] = *(const GAS v4u*)(U8l + (size_t)ev[g] * D + 128 * sl + 16 * c); \
                _Pragma("unroll") for (int j = 0; j < 4; ++j) hvv[j] = *(const GAS v2u*)(H + (size_t)tq_ * D + 256 * j + 32 * sl + 4 * c); }
#define A_COMPUTE(rowv, hvv, tt) if ((tt) <= tlast) { float hf[16]; float am_ = 0.f; \
                _Pragma("unroll") for (int j = 0; j < 4; ++j) { hf[4 * j] = bf2f(hvv[j].x & 0xffffu); hf[4 * j + 1] = bf2f(hvv[j].x >> 16); hf[4 * j + 2] = bf2f(hvv[j].y & 0xffffu); hf[4 * j + 3] = bf2f(hvv[j].y >> 16); } \
                _Pragma("unroll") for (int i = 0; i < 16; ++i) am_ = fmaxf(am_, fabsf(hf[i])); \
                am_ = fmaxf(am_, dpp_mov<0xB1>(am_)); am_ = fmaxf(am_, dpp_mov<0x4E>(am_)); am_ = fmaxf(am_, dpp_mov<0x141>(am_)); am_ = fmaxf(am_, 1e-20f); \
                const float sh_ = am_ * (1.0f / 127.0f), ih_ = 127.0f / am_; int hq_[4]; \
                _Pragma("unroll") for (int j = 0; j < 4; ++j) { const int q0 = __float2int_rn(hf[4 * j] * ih_), q1 = __float2int_rn(hf[4 * j + 1] * ih_), q2 = __float2int_rn(hf[4 * j + 2] * ih_), q3 = __float2int_rn(hf[4 * j + 3] * ih_); \
                    hq_[j] = (int)((unsigned)(q0 & 255) | ((unsigned)(q1 & 255) << 8) | ((unsigned)(q2 & 255) << 16) | ((unsigned)q3 << 24)); } \
                _Pragma("unroll") for (int g = 0; g < 16; ++g) { int ia = 0; \
                    _Pragma("unroll") for (int j = 0; j < 4; ++j) ia = __builtin_amdgcn_sdot4((int)rowv[g][j], hq_[j], ia, false); \
                    ia += __builtin_amdgcn_update_dpp(0, ia, 0xB1, 0xF, 0xF, true); ia += __builtin_amdgcn_update_dpp(0, ia, 0x4E, 0xF, 0xF, true); ia += __builtin_amdgcn_update_dpp(0, ia, 0x141, 0xF, 0xF, true); \
                    if (c == 0) PART[((size_t)sl * T_ALL + (tt)) * NSEL + 8 * g + sg] = (float)ia * sh_; } }
            unsigned eA[16], eB[16]; v4u rowA[16], rowB[16]; v2u hA[4], hB[4];
            A_LOAD_E(eA, t0) A_LOAD_E(eB, t0 + wstride_)
            A_ISSUE(rowA, hA, eA, t0)
#pragma unroll 1
            for (int ta = t0; ta <= tlast; ta += 2 * wstride_) {
                A_ISSUE(rowB, hB, eB, ta + wstride_) A_LOAD_E(eA, ta + 2 * wstride_)
                __builtin_amdgcn_sched_barrier(0);
                A_COMPUTE(rowA, hA, ta)
                __builtin_amdgcn_sched_barrier(0);
                A_ISSUE(rowA, hA, eA, ta + 2 * wstride_) A_LOAD_E(eB, ta + 3 * wstride_)
                __builtin_amdgcn_sched_barrier(0);
                A_COMPUTE(rowB, hB, ta + wstride_)
                __builtin_amdgcn_sched_barrier(0);
            }
#undef A_LOAD_E
#undef A_ISSUE
#undef A_COMPUTE
          }
        } }
        GRID_BAR();
        { PHASE_PTRS LAYER_PTRS
        { const int ln = lane_id_v();
          const float* PART = (const float*)(wsq + WS_PART); float* WGT = (float*)(wsq + WS_WGT);
          for (int rep_ = 0; rep_ < REP_P10B; ++rep_)
          for (int i = vcu * NTHREADS + wave * 64 + ln; i < T_EFF * NSEL; i += NGT) {
              float dsum = 0.f;
#pragma unroll
              for (int sl = 0; sl < 8; ++sl) dsum += PART[(size_t)sl * T_ALL * NSEL + i];
              const unsigned esu = EI[i];
              const float dot = dsum * bf2f(esu >> 16);
              ((unsigned*)WGT)[i] = (esu & 0xffffu) | (f2bf(0.5f * dot * (1.0f + erff(dot * 0.70710678118654752f)) * EG[i]) << 16);
          }
        } }
        GRID_BAR();
        { PHASE_PTRS LAYER_PTRS
        { const int ln = lane_id_v(); const int c = ln & 7, sg = ln >> 3;
          P10_CENSUS
          const float* WGT = (const float*)(wsq + WS_WGT); float* XO = (float*)(wsq + WS_XO);
          const unsigned char* V8l = V8 + (size_t)layer * 16384 * D;
          for (int rep_ = 0; rep_ < REP_P10C; ++rep_)
#pragma unroll 1
          for (int sl = 0; sl < 8; ++sl) {
            if (!((smask_ >> sl) & 1u)) continue;
            const int t0 = rank_ * NWAVES + wave;
            if (t0 >= T_EFF) continue;
            const int tlast = t0 + ((T_EFF - 1 - t0) / wstride_) * wstride_;
#define C_LOAD_E(ev, tt) { const int tq_ = min((tt), tlast); _Pragma("unroll") for (int g = 0; g < 16; ++g) ev[g] = ((const unsigned*)WGT)[(size_t)tq_ * NSEL + 8 * g + sg]; }
#define C_ISSUE(rowv, wv, ev) { _Pragma("unroll") for (int g = 0; g < 16; ++g) { rowv[g] = *(const GAS v4u*)(V8l + (size_t)(ev[g] & 0xffffu) * D + 128 * sl + 16 * c); wv[g] = ev[g] >> 16; } }
#define C_COMPUTE(rowv, wv, tt) if ((tt) <= tlast) { f32x4 o[4]; \
                _Pragma("unroll") for (int j = 0; j < 4; ++j) o[j] = (f32x4){0.f, 0.f, 0.f, 0.f}; \
                _Pragma("unroll") for (int g = 0; g < 16; ++g) { const float wq_ = bf2f(wv[g]); const f32x2 w2_ = (f32x2){wq_, wq_}; _Pragma("unroll") for (int j = 0; j < 4; ++j) { \
                    const f32x2 a = __builtin_amdgcn_cvt_pk_f32_fp8((int)rowv[g][j], false), b = __builtin_amdgcn_cvt_pk_f32_fp8((int)rowv[g][j], true); \
                    f32x2 lo_ = (f32x2){o[j].x, o[j].y}, hi_ = (f32x2){o[j].z, o[j].w}; lo_ = __builtin_elementwise_fma(a, w2_, lo_); hi_ = __builtin_elementwise_fma(b, w2_, hi_); \
                    o[j].x = lo_.x; o[j].y = lo_.y; o[j].z = hi_.x; o[j].w = hi_.y; } \
                    asm volatile("" : "+v"(o[0]), "+v"(o[1]), "+v"(o[2]), "+v"(o[3])); } \
                _Pragma("unroll") for (int j = 0; j < 4; ++j) { \
                    o[j].x += dpp_mov<0x128>(o[j].x); o[j].y += dpp_mov<0x128>(o[j].y); o[j].z += dpp_mov<0x128>(o[j].z); o[j].w += dpp_mov<0x128>(o[j].w); \
                    o[j].x += xshfl_l<16>(o[j].x, ln); o[j].y += xshfl_l<16>(o[j].y, ln); o[j].z += xshfl_l<16>(o[j].z, ln); o[j].w += xshfl_l<16>(o[j].w, ln); \
                    o[j].x += xshfl_l<32>(o[j].x, ln); o[j].y += xshfl_l<32>(o[j].y, ln); o[j].z += xshfl_l<32>(o[j].z, ln); o[j].w += xshfl_l<32>(o[j].w, ln); } \
                if (sg == 0) { _Pragma("unroll") for (int j = 0; j < 4; ++j) *(GAS f32x4*)(XO + (size_t)(tt) * D + 256 * j + 32 * sl + 4 * c) = o[j]; } }
            unsigned eA[16], eB[16], wA[16], wB[16]; v4u rowA[16], rowB[16];
            C_LOAD_E(eA, t0) C_LOAD_E(eB, t0 + wstride_)
            C_ISSUE(rowA, wA, eA)
#pragma unroll 1
            for (int ta = t0; ta <= tlast; ta += 2 * wstride_) {
                C_ISSUE(rowB, wB, eB) C_LOAD_E(eA, ta + 2 * wstride_)
                __builtin_amdgcn_sched_barrier(0);
                C_COMPUTE(rowA, wA, ta)
                __builtin_amdgcn_sched_barrier(0);
                C_ISSUE(rowA, wA, eA) C_LOAD_E(eB, ta + 3 * wstride_)
                __builtin_amdgcn_sched_barrier(0);
                C_COMPUTE(rowB, wB, ta + wstride_)
                __builtin_amdgcn_sched_barrier(0);
            }
#undef C_LOAD_E
#undef C_ISSUE
#undef C_COMPUTE
          }
        } }
        GRID_BAR();
#undef P10_CENSUS
#endif
        { PHASE_PTRS LAYER_PTRS
        { const int ln = lane_id_v();
        {
            const unsigned char* U8l = U8 + (size_t)layer * 16384 * D;
            const unsigned char* V8l = V8 + (size_t)layer * 16384 * D;
            for (int rep_ = 0; rep_ < REP_P10; ++rep_)
            for (int t = gw; t < T_EFF; t += NGW) {
#if !P10_SLICED
                f32x4 hv[4];
                { const GAS v2u* hp = (const GAS v2u*)(H + (size_t)t * D) + ln;
#pragma unroll
                  for (int j = 0; j < 4; ++j) { const v2u w = hp[64 * j]; hv[j] = (f32x4){bf2f(w.x & 0xffffu), bf2f(w.x >> 16), bf2f(w.y & 0xffffu), bf2f(w.y >> 16)}; } }
#endif
#if P10_SLICED
                f32x4 o[4];
#pragma unroll
                for (int j = 0; j < 4; ++j) o[j] = *((const GAS f32x4*)((const float*)(wsq + WS_XO) + (size_t)t * D) + ln + 64 * j);
#else
                f32x4 o[4];
#pragma unroll
                for (int j = 0; j < 4; ++j) o[j] = (f32x4){0.f, 0.f, 0.f, 0.f};
#pragma unroll 1
                for (int s0 = 0; s0 < NSEL; s0 += 32) {
                    const unsigned esu = EI[(size_t)t * NSEL + s0 + (ln & 31)]; const float gv = EG[(size_t)t * NSEL + s0 + (ln & 31)];
                    int eidx = (int)(esu & 0xffffu); const float su = bf2f(esu >> 16);
                    float p[32];
                    {
                        v4u rowa[8], rowb[8];
#pragma unroll
                        for (int q = 0; q < 8; ++q) { const int e = __builtin_amdgcn_readlane(eidx, q); rowa[q] = *((const GAS v4u*)(U8l + (size_t)e * D) + ln); }
#pragma unroll
                        for (int g = 0; g < 4; ++g) {
                            if (g < 3) {
#pragma unroll
                                for (int q = 0; q < 8; ++q) { const int e = __builtin_amdgcn_readlane(eidx, (g + 1) * 8 + q);
                                    if (g & 1) rowa[q] = *((const GAS v4u*)(U8l + (size_t)e * D) + ln); else rowb[q] = *((const GAS v4u*)(U8l + (size_t)e * D) + ln); }
                            }
                            __builtin_amdgcn_sched_barrier(0);
#pragma unroll
                            for (int q = 0; q < 8; ++q) {
                                const v4u rw = (g & 1) ? rowb[q] : rowa[q];
                                float dd = 0.f;
#pragma unroll
                                for (int j = 0; j < 4; ++j) {
                                    const f32x2 a = __builtin_amdgcn_cvt_pk_f32_fp8((int)rw[j], false), b = __builtin_amdgcn_cvt_pk_f32_fp8((int)rw[j], true);
                                    dd += (a.x * hv[j].x + a.y * hv[j].y) + (b.x * hv[j].z + b.y * hv[j].w);
                                }
                                asm volatile("" : "+v"(dd));
                                p[g * 8 + q] = dd;
                                __builtin_amdgcn_sched_barrier(0);
                            }
                        }
                    }
#define TR_STEP(W) { const bool up = (ln & W) != 0; _Pragma("unroll") for (int i = 0; i < W; ++i) { const float send = up ? p[i] : p[i + W], keep = up ? p[i + W] : p[i]; p[i] = keep + xshfl_l<W>(send, ln); } }
                    TR_STEP(16) TR_STEP(8) TR_STEP(4) TR_STEP(2) TR_STEP(1)
#undef TR_STEP
                    const float dot = (p[0] + xshfl_l<32>(p[0], ln)) * su;
                    float wgt = 0.5f * dot * (1.0f + erff(dot * 0.70710678118654752f)) * gv;
                    asm volatile("" : "+v"(eidx), "+v"(wgt));
                    {
                        v4u rowa[8], rowb[8];
#pragma unroll
                        for (int q = 0; q < 8; ++q) { const int e = __builtin_amdgcn_readlane(eidx, q); rowa[q] = *((const GAS v4u*)(V8l + (size_t)e * D) + ln); }
#pragma unroll
                        for (int g = 0; g < 4; ++g) {
                            if (g < 3) {
#pragma unroll
                                for (int q = 0; q < 8; ++q) { const int e = __builtin_amdgcn_readlane(eidx, (g + 1) * 8 + q);
                                    if (g & 1) rowa[q] = *((const GAS v4u*)(V8l + (size_t)e * D) + ln); else rowb[q] = *((const GAS v4u*)(V8l + (size_t)e * D) + ln); }
                            }
                            __builtin_amdgcn_sched_barrier(0);
#pragma unroll
                            for (int q = 0; q < 8; ++q) {
                                const v4u rw = (g & 1) ? rowb[q] : rowa[q];
                                const float wq = __builtin_bit_cast(float, __builtin_amdgcn_readlane(__builtin_bit_cast(int, wgt), g * 8 + q));
#pragma unroll
                                for (int j = 0; j < 4; ++j) {
                                    const f32x2 a = __builtin_amdgcn_cvt_pk_f32_fp8((int)rw[j], false), b = __builtin_amdgcn_cvt_pk_f32_fp8((int)rw[j], true);
                                    o[j].x += wq * a.x; o[j].y += wq * a.y; o[j].z += wq * b.x; o[j].w += wq * b.y;
                                }
                                asm volatile("" : "+v"(o[0]), "+v"(o[1]), "+v"(o[2]), "+v"(o[3]));
                                __builtin_amdgcn_sched_barrier(0);
                            }
                        }
                    }
                }
#endif
                const float* gt2 = modl + (size_t)row_modidx(t) * 6 * D + 5 * D;
                GAS f32x4* xr = (GAS f32x4*)(X + (size_t)t * D) + ln;
                f32x4 xn[4]; float ss = 0.f;
#pragma unroll
                for (int j = 0; j < 4; ++j) {
                    xn[j] = xr[64 * j] + *((const GAS f32x4*)gt2 + ln + 64 * j) * o[j];
                    ss += (xn[j].x * xn[j].x + xn[j].y * xn[j].y) + (xn[j].z * xn[j].z + xn[j].w * xn[j].w);
                }
                if (REP_P10 > 1 && rep_ + 1 < REP_P10 && ss != 1234.5678f) continue;
                if (!last) {
#pragma unroll
                    for (int j = 0; j < 4; ++j) xr[64 * j] = xn[j];
                    const float rs1 = 1.0f / sqrtf(wave_sum(ss) * (1.f / D) + NORM_EPS);
                    const float* md1 = modl + (size_t)(3 + row_modidx(t)) * 6 * D;
                    GAS v2u* o8 = (GAS v2u*)(H + (size_t)t * D) + ln;
#pragma unroll
                    for (int j = 0; j < 4; ++j) {
                        const f32x4 g = *((const GAS f32x4*)(IN_[I_G1] + (layer + 1) * D) + ln + 64 * j);
                        const f32x4 sh = *((const GAS f32x4*)(md1 + 0) + ln + 64 * j), sc = *((const GAS f32x4*)(md1 + D) + ln + 64 * j);
                        const f32x4 hh = xn[j] * rs1 * g * (sc + 1.0f) + sh;
                        v2u o; o.x = pk2(hh.x, hh.y); o.y = pk2(hh.z, hh.w); o8[64 * j] = o;
                    }
                } else {
                    const float rs = 1.0f / sqrtf(wave_sum(ss) * (1.f / D) + NORM_EPS);
                    GAS f32x4* op = (GAS f32x4*)(((float*)IN_[22]) + (size_t)t * D) + ln;
#pragma unroll
                    for (int j = 0; j < 4; ++j) op[64 * j] = xn[j] * rs * *((const GAS f32x4*)IN_[I_GFINAL] + ln + 64 * j);
                }
            }
        }
        }
        }
#endif
        if (!last) GRID_BAR();
    }
}

extern "C" void kernel_launch(void* const* d_in, const int* in_sizes, int n_in, void* d_out, int out_size, void* d_ws, size_t ws_size, hipStream_t stream) {
    static int grid = 0;
    if (grid == 0) {
        if (n_in != 22 || out_size != T_LAT * D || ws_size < WS_END) { fprintf(stderr, "kernel_launch: unexpected shapes: n_in %d out %d ws %zu (need %zu)\n", n_in, out_size, ws_size, (size_t)WS_END); grid = -1; return; }
        int dev = 0, cus = 0, per_cu = 0;
        if (hipGetDevice(&dev) != hipSuccess || hipDeviceGetAttribute(&cus, hipDeviceAttributeMultiprocessorCount, dev) != hipSuccess) { fprintf(stderr, "device query failed\n"); grid = -1; return; }
        if (hipFuncSetAttribute((const void*)mega_fwd, hipFuncAttributeMaxDynamicSharedMemorySize, LDS_BYTES) != hipSuccess) { fprintf(stderr, "hipFuncSetAttribute failed\n"); grid = -1; return; }
        if (hipOccupancyMaxActiveBlocksPerMultiprocessor(&per_cu, (const void*)mega_fwd, NTHREADS, LDS_BYTES) != hipSuccess || per_cu < 1) { fprintf(stderr, "occupancy query: %d\n", per_cu); }
        (void)hipGetLastError();
        grid = cus;
    }
    if (grid < 0) return;
    if (hipMemsetAsync((char*)d_ws + WS_CTL, 0, CTL_ZERO_BYTES, stream) != hipSuccess) { fprintf(stderr, "memset failed\n"); return; }
    Args a{};
    for (int i = 0; i < 22; ++i) a.in[i] = (const float*)d_in[i];
    a.out = (float*)d_out; a.ws = (unsigned char*)d_ws;
    hipLaunchKernelGGL(mega_fwd, dim3(grid), dim3(NTHREADS), LDS_BYTES, stream, a);
}
```

```cpp
#include <hip/hip_runtime.h>
#include <cstdio>
#include <cstdint>

#ifndef REP_P0
#define REP_P0 1
#endif
#ifndef REP_P1
#define REP_P1 1
#endif
#ifndef REP_P2
#define REP_P2 1
#endif
#ifndef REP_P3A
#define REP_P3A 1
#endif
#ifndef REP_P3B
#define REP_P3B 1
#endif
#ifndef REP_P4
#define REP_P4 1
#endif
#ifndef REP_P6
#define REP_P6 1
#endif
#ifndef REP_P7
#define REP_P7 1
#endif
#ifndef REP_P8
#define REP_P8 1
#endif
#ifndef REP_P9
#define REP_P9 1
#endif
#ifndef REP_P10
#define REP_P10 1
#endif
#ifndef REP_P10A
#define REP_P10A 1
#endif
#ifndef REP_P10C
#define REP_P10C 1
#endif
#ifndef REP_P10B
#define REP_P10B 1
#endif
#ifndef REP_P0A
#define REP_P0A 1
#endif
#ifndef REP_P0D
#define REP_P0D 1
#endif
#ifndef REP_P0F
#define REP_P0F 1
#endif
#ifndef REP_P3C
#define REP_P3C 1
#endif
#define GAS __attribute__((address_space(1)))
#define LAS __attribute__((address_space(3)))
typedef unsigned short bf16;
typedef float f32x4 __attribute__((ext_vector_type(4)));
typedef short bf16x8 __attribute__((ext_vector_type(8)));
typedef unsigned v4u __attribute__((ext_vector_type(4)));
typedef unsigned v2u __attribute__((ext_vector_type(2)));
typedef float f32x2 __attribute__((ext_vector_type(2)));
typedef GAS unsigned gu32;

constexpr int NWAVES = 8, NTHREADS = 512;
constexpr int D = 1024, BATCH = 2, SEQ = 8192, DEPTH = 2, GRID_W = 64, CTX = 256;
constexpr int T_LAT = BATCH * SEQ;
constexpr int T_ALL = T_LAT + BATCH * CTX;
constexpr int NTOK = SEQ + CTX;
constexpr int IN_W = 6912;
constexpr int PEER_HEADS = 8, PEER_KEYS = 128, PEER_TOPK = 16, NSEL = PEER_HEADS * PEER_TOPK;
constexpr float NORM_EPS = 1e-6f;
constexpr float LOG2E = 1.4426950408889634f;
constexpr float SCL2 = 0.125f * LOG2E;

constexpr size_t MiB = 1u << 20;
constexpr size_t WS_CTL = 0, CTL_ZERO_BYTES = 1 * MiB;
constexpr int CW_BAR = 4096;
constexpr int CW_RANK = 8192;
#ifndef P10_SLICED
#define P10_SLICED 1
#endif
constexpr size_t WS_MOD = 65536;
constexpr size_t WS_COS = 2 * MiB, WS_SIN = 3 * MiB;
constexpr size_t WS_WIN = 4 * MiB;
constexpr size_t WS_WB = 31 * MiB;
constexpr size_t WS_WO = 37 * MiB;
constexpr size_t WS_WQ = 41 * MiB;
constexpr size_t WS_KEYS = 49 * MiB;
constexpr size_t WS_X = 50 * MiB;
constexpr size_t WS_H = 116 * MiB;
constexpr size_t WS_Y = 149 * MiB;
constexpr size_t WS_MG = WS_H;
constexpr size_t WS_U8 = 199 * MiB;
constexpr size_t WS_SCU = 231 * MiB;
constexpr size_t WS_EI = 232 * MiB;
constexpr size_t WS_EG = 241 * MiB;
constexpr size_t WS_P = 250 * MiB;
constexpr size_t SZ_R512 = (size_t)T_ALL * 512 * 2;
constexpr size_t SZ_R128 = (size_t)T_ALL * 128 * 2;
constexpr size_t WS_AQ = WS_P, WS_AK = WS_AQ + SZ_R512, WS_AVT = WS_AK + SZ_R128, WS_BQ = WS_AVT + SZ_R128, WS_BK = WS_BQ + SZ_R512,
                 WS_BVT = WS_BK + SZ_R512, WS_CQ = WS_BVT + SZ_R512, WS_CK = WS_CQ + SZ_R512, WS_CVT = WS_CK + SZ_R512, WS_SG = WS_CVT + SZ_R512;
constexpr size_t WS_Q2 = WS_P;
constexpr size_t WS_SC = WS_P + 66 * MiB;
constexpr size_t WS_PART = WS_P, WS_XO = WS_P + 66 * MiB, WS_WGT = WS_P + 132 * MiB;
constexpr size_t WS_PEND = WS_SG + (size_t)T_ALL * 3072 * 2;
constexpr size_t WS_V8 = 473 * MiB;
constexpr size_t WS_END = WS_V8 + 32 * MiB;
static_assert(WS_SC + (size_t)T_ALL * 2048 * 4 <= WS_PEND && WS_PEND <= WS_V8, "alias map");
static_assert(WS_END <= 512 * MiB, "ws map");

constexpr int LDS_BYTES = 147456;
constexpr int MISC_OFF = 131072 + 320;

__device__ __forceinline__ int lane_id_v() { int l; asm volatile("v_mbcnt_lo_u32_b32 %0, -1, 0\n\tv_mbcnt_hi_u32_b32 %0, -1, %0" : "=v"(l)); return l; }
#define XB_TMO      128
#define XB_XCNT(j)  (256  + 64 * (j))
#define XB_XSUB(j)  (1280 + 64 * (j))
#define XB_XGEN(j)  (2304 + 64 * (j))
#define XB_TOP      3328
#define XB_TOPGEN   3392
#define XCD_BAR_WORDS 3456
#define XB_SPIN_CAP (1u << 24)

__device__ __forceinline__ unsigned xb_ld(unsigned* p)              { return __hip_atomic_load(p, __ATOMIC_RELAXED, __HIP_MEMORY_SCOPE_AGENT); }
__device__ __forceinline__ unsigned xb_add(unsigned* p, unsigned v) { return __hip_atomic_fetch_add(p, v, __ATOMIC_RELAXED, __HIP_MEMORY_SCOPE_AGENT); }
__device__ __forceinline__ unsigned xb_xcc_id() { return (unsigned)__builtin_amdgcn_s_getreg((3 << 11) | 20) & 0xFu; }
#define XB_SPIN(cond, bar) do { unsigned _sp = 0; while (cond) { __builtin_amdgcn_s_sleep(1); \
    if ((++_sp & 255u) == 0u) { if (xb_ld(&(bar)[XB_TMO])) break; if (_sp > XB_SPIN_CAP) { atomicAdd(&(bar)[XB_TMO], 1u); break; } } } } while (0)

struct XcdBarrier { unsigned* bar; unsigned x; volatile LAS unsigned* st; };

__device__ __forceinline__ XcdBarrier xcd_barrier_post(unsigned* bar, volatile LAS unsigned* st) {
    XcdBarrier b; b.bar = bar; b.x = xb_xcc_id(); b.st = st;
    if (threadIdx.x == 0) (void)xb_add(&bar[XB_XCNT(b.x)], 1u);
    return b;
}
__device__ __forceinline__ void xcd_barrier_complete(unsigned* bar, unsigned x, unsigned& nloc, unsigned& nx) {
    const unsigned G = gridDim.x * gridDim.y * gridDim.z;
    unsigned sum, cnt, mine, sp = 0u;
    for (;;) {
        sum = 0u; cnt = 0u; mine = 0u;
#pragma unroll
        for (unsigned j = 0; j < 16; ++j) { const unsigned c = xb_ld(&bar[XB_XCNT(j)]); sum += c; cnt += (c > 0u) ? 1u : 0u; mine = (j == x) ? c : mine; }
        if (sum == G) break;
        __builtin_amdgcn_s_sleep(1);
        if ((++sp & 255u) == 0u) { if (xb_ld(&bar[XB_TMO])) break; if (sp > XB_SPIN_CAP) { atomicAdd(&bar[XB_TMO], 1u); break; } }
    }
    nloc = mine > 0u ? mine : 1u; nx = cnt > 0u ? cnt : 1u;
}
__device__ __forceinline__ void xcd_barrier(const XcdBarrier& b, bool t0) {
    asm volatile("s_waitcnt vmcnt(0)" ::: "memory");
    __syncthreads();
    if (t0) {
        unsigned* bar = b.bar;
        __builtin_amdgcn_s_waitcnt(0);
        unsigned nloc = b.st[0], nx = b.st[1];
        if (nloc == 0u) { xcd_barrier_complete(bar, b.x, nloc, nx); b.st[0] = nloc; b.st[1] = nx; }
        const unsigned old = xb_add(&bar[XB_XSUB(b.x)], 1u);
        const unsigned gen = old / nloc;
        if (old + 1u == (gen + 1u) * nloc) {
            __builtin_amdgcn_fence(__ATOMIC_RELEASE, "agent");
            asm volatile("s_waitcnt vmcnt(0)" ::: "memory");
            const unsigned og = xb_add(&bar[XB_TOP], 1u);
            const unsigned tg = og / nx;
            if (og + 1u == (tg + 1u) * nx) xb_add(&bar[XB_TOPGEN], 1u);
            else XB_SPIN(xb_ld(&bar[XB_TOPGEN]) == tg, bar);
            __builtin_amdgcn_fence(__ATOMIC_ACQUIRE, "agent");
            xb_add(&bar[XB_XGEN(b.x)], 1u);
            asm volatile("s_waitcnt vmcnt(0)" ::: "memory");
        } else {
            XB_SPIN(xb_ld(&bar[XB_XGEN(b.x)]) == gen, bar);
            __builtin_amdgcn_fence(__ATOMIC_ACQUIRE, "agent");
            asm volatile("s_waitcnt vmcnt(0)" ::: "memory");
        }
    }
    __syncthreads();
}

__device__ __forceinline__ unsigned f2bf(float f) { unsigned u = __builtin_bit_cast(unsigned, f); return (u + 0x7fffu + ((u >> 16) & 1u)) >> 16; }
__device__ __forceinline__ unsigned pk2(float lo, float hi) { return f2bf(lo) | (f2bf(hi) << 16); }
__device__ __forceinline__ float bf2f(unsigned h) { return __builtin_bit_cast(float, h << 16); }
template <int CTRL> __device__ __forceinline__ float dpp_mov(float v) { return __builtin_bit_cast(float, __builtin_amdgcn_update_dpp(0, __builtin_bit_cast(int, v), CTRL, 0xF, 0xF, true)); }
__device__ __forceinline__ float sum8_dpp(float v) { v += dpp_mov<0xB1>(v); v += dpp_mov<0x4E>(v); v += dpp_mov<0x141>(v); return v; }
template <int K> __device__ __forceinline__ float xshfl_l(float v, int lane) { return __builtin_bit_cast(float, __builtin_amdgcn_ds_bpermute((lane ^ K) << 2, __builtin_bit_cast(int, v))); }
template <int K> __device__ __forceinline__ float xshfl(float v) { return xshfl_l<K>(v, lane_id_v()); }
__device__ __forceinline__ float xadd32(float v) { return v + xshfl_l<32>(v, lane_id_v()); }
__device__ __forceinline__ float xmax32(float v) { return fmaxf(v, xshfl_l<32>(v, lane_id_v())); }
__device__ __forceinline__ float wave_sum(float v) { const int l = lane_id_v(); v += xshfl_l<1>(v, l); v += xshfl_l<2>(v, l); v += xshfl_l<4>(v, l); v += xshfl_l<8>(v, l); v += xshfl_l<16>(v, l); v += xshfl_l<32>(v, l); return v; }
__device__ __forceinline__ float wave_max(float v) { const int l = lane_id_v(); v = fmaxf(v, xshfl_l<1>(v, l)); v = fmaxf(v, xshfl_l<2>(v, l)); v = fmaxf(v, xshfl_l<4>(v, l)); v = fmaxf(v, xshfl_l<8>(v, l)); v = fmaxf(v, xshfl_l<16>(v, l)); v = fmaxf(v, xshfl_l<32>(v, l)); return v; }


__device__ __forceinline__ float sigmoidf_(float x) { return 1.0f / (1.0f + __expf(-x)); }
__device__ __forceinline__ float sigmoid_fast(float x) { return __builtin_amdgcn_rcpf(1.0f + __builtin_amdgcn_exp2f(-LOG2E * x)); }
__device__ __forceinline__ int row_modidx(int r) { return r < T_LAT ? (r >> 13) : 2; }
__device__ __forceinline__ int row_batch(int r) { return r < T_LAT ? (r >> 13) : ((r - T_LAT) >> 8); }
__device__ __forceinline__ int row_tok(int r) { return r < T_LAT ? (r & (SEQ - 1)) : SEQ + ((r - T_LAT) & (CTX - 1)); }

__device__ __forceinline__ const float* xin_row(const float* x, const float* ctx, int r) { return r < T_LAT ? x + (size_t)r * D : ctx + (size_t)(r - T_LAT) * D; }
struct Args { const float* in[22]; float* out; unsigned char* ws; };
enum { I_X = 0, I_C, I_CTX, I_CCTX, I_WMOD, I_BMOD, I_G1, I_G2, I_WIN, I_SINK, I_RPB, I_LAMBDA, I_SUBLN, I_WBA, I_WBB, I_WBC, I_WOUT, I_PWQ, I_PKEYS, I_PU, I_PV, I_GFINAL };

__device__ __forceinline__ int rope_perm(int c) {
    if (c < 640 || (c >= 2304 && c < 3328)) { const int w = c & 63; return (c & ~63) + 2 * (w & 31) + (w >> 5); }
    return c;
}
template <bool PERM = false>
__device__ __forceinline__ void p0_transpose_item(const float* W, int K, int N, bf16* WT, LAS float* scr, int item, int lane) {
    const int nblk = N / 32, kb = item / nblk, nb = item % nblk, k0 = 64 * kb, n0 = 32 * nb;
#pragma unroll 8
    for (int i = 0; i < 32; ++i) { const int kk = 2 * i + (lane >> 5); scr[kk * 33 + (lane & 31)] = W[(size_t)(k0 + kk) * N + n0 + (lane & 31)]; }
    asm volatile("s_waitcnt lgkmcnt(0)" ::: "memory");
    const int c = lane & 7;
#pragma unroll
    for (int j = 0; j < 4; ++j) { const int n = (lane >> 3) + 8 * j; const LAS float* s = scr + (8 * c) * 33 + n;
        v4u o; o.x = pk2(s[0 * 33], s[1 * 33]); o.y = pk2(s[2 * 33], s[3 * 33]); o.z = pk2(s[4 * 33], s[5 * 33]); o.w = pk2(s[6 * 33], s[7 * 33]);
        const int nout = PERM ? rope_perm(n0 + n) : (n0 + n);
        *(GAS v4u*)(WT + (size_t)nout * K + k0 + 8 * c) = o; }
    asm volatile("s_waitcnt lgkmcnt(0)" ::: "memory");
}

template <int UNR = 2, int NN = 4>
__device__ __forceinline__ void sgemm_tile(f32x4 (&acc)[4][NN], const bf16* A, int lda, const bf16* Bt, int ldb, int K, int row0, int col0, int lane) {
    const int fr = lane & 15, fq = lane >> 4;
    const bf16* ap = A + (size_t)(row0 + fr) * lda + fq * 8;
    const bf16* bp = Bt + (size_t)(col0 + fr) * ldb + fq * 8;
#pragma unroll UNR
    for (int k = 0; k < K; k += 32) {
        bf16x8 a[4], b[NN];
#pragma unroll
        for (int m = 0; m < 4; ++m) a[m] = *(const GAS bf16x8*)(ap + (size_t)m * 16 * lda + k);
#pragma unroll
        for (int n = 0; n < NN; ++n) b[n] = *(const GAS bf16x8*)(bp + (size_t)n * 16 * ldb + k);
#pragma unroll
        for (int m = 0; m < 4; ++m)
#pragma unroll
            for (int n = 0; n < NN; ++n) acc[m][n] = __builtin_amdgcn_mfma_f32_16x16x32_bf16(a[m], b[n], acc[m][n], 0, 0, 0);
    }
}
template <int UNR>
__device__ __forceinline__ void sgemm32(f32x4 (&acc)[2][2], const bf16* A, int lda, const bf16* Bt, int ldb, int K, int row0, int col0, int lane) {
    const int fr = lane & 15, fq = lane >> 4;
    const bf16* ap = A + (size_t)(row0 + fr) * lda + fq * 8;
    const bf16* bp = Bt + (size_t)(col0 + fr) * ldb + fq * 8;
#pragma unroll 1
    for (int k0 = 0; k0 < K; k0 += 32 * UNR) {
        bf16x8 a[UNR][2], b[UNR][2];
#pragma unroll
        for (int u = 0; u < UNR; ++u)
#pragma unroll
            for (int m = 0; m < 2; ++m) { a[u][m] = *(const GAS bf16x8*)(ap + (size_t)m * 16 * lda + k0 + 32 * u); b[u][m] = *(const GAS bf16x8*)(bp + (size_t)m * 16 * ldb + k0 + 32 * u); }
#pragma unroll
        for (int u = 0; u < UNR; ++u)
#pragma unroll
            for (int m = 0; m < 2; ++m)
#pragma unroll
                for (int n = 0; n < 2; ++n) acc[m][n] = __builtin_amdgcn_mfma_f32_16x16x32_bf16(a[u][m], b[u][n], acc[m][n], 0, 0, 0);
    }
}
__device__ __forceinline__ void zero_acc22(f32x4 (&acc)[2][2]) { acc[0][0] = acc[0][1] = acc[1][0] = acc[1][1] = (f32x4){0.f, 0.f, 0.f, 0.f}; }
template <int NN>
__device__ __forceinline__ void zero_acc(f32x4 (&acc)[4][NN]) {
#pragma unroll
    for (int m = 0; m < 4; ++m)
#pragma unroll
        for (int n = 0; n < NN; ++n) acc[m][n] = (f32x4){0.f, 0.f, 0.f, 0.f};
}

__device__ __forceinline__ int f2ord(float f) { const int b = __builtin_bit_cast(int, f); return b ^ ((b >> 31) & 0x7fffffff); }
__device__ __forceinline__ float ord2f(int o) { const int b = o ^ ((o >> 31) & 0x7fffffff); return __builtin_bit_cast(float, b); }
__device__ __forceinline__ void top16_insert(int (&top)[16], int key) {
#pragma unroll
    for (int i = 0; i < 16; ++i) { const int hi = max(top[i], key); key = min(top[i], key); top[i] = hi; }
}
#define CE(a, b) { const int t_ = max(a, b); b = min(a, b); a = t_; }
__device__ __forceinline__ void sort16_desc(int (&v)[16]) { CE(v[0], v[1]); CE(v[3], v[2]); CE(v[4], v[5]); CE(v[7], v[6]); CE(v[8], v[9]); CE(v[11], v[10]); CE(v[12], v[13]); CE(v[15], v[14]); CE(v[0], v[2]); CE(v[1], v[3]); CE(v[6], v[4]); CE(v[7], v[5]); CE(v[8], v[10]); CE(v[9], v[11]); CE(v[14], v[12]); CE(v[15], v[13]); CE(v[0], v[1]); CE(v[2], v[3]); CE(v[5], v[4]); CE(v[7], v[6]); CE(v[8], v[9]); CE(v[10], v[11]); CE(v[13], v[12]); CE(v[15], v[14]); CE(v[0], v[4]); CE(v[1], v[5]); CE(v[2], v[6]); CE(v[3], v[7]); CE(v[12], v[8]); CE(v[13], v[9]); CE(v[14], v[10]); CE(v[15], v[11]); CE(v[0], v[2]); CE(v[1], v[3]); CE(v[4], v[6]); CE(v[5], v[7]); CE(v[10], v[8]); CE(v[11], v[9]); CE(v[14], v[12]); CE(v[15], v[13]); CE(v[0], v[1]); CE(v[2], v[3]); CE(v[4], v[5]); CE(v[6], v[7]); CE(v[9], v[8]); CE(v[11], v[10]); CE(v[13], v[12]); CE(v[15], v[14]); CE(v[0], v[8]); CE(v[1], v[9]); CE(v[2], v[10]); CE(v[3], v[11]); CE(v[4], v[12]); CE(v[5], v[13]); CE(v[6], v[14]); CE(v[7], v[15]); CE(v[0], v[4]); CE(v[1], v[5]); CE(v[2], v[6]); CE(v[3], v[7]); CE(v[8], v[12]); CE(v[9], v[13]); CE(v[10], v[14]); CE(v[11], v[15]); CE(v[0], v[2]); CE(v[1], v[3]); CE(v[4], v[6]); CE(v[5], v[7]); CE(v[8], v[10]); CE(v[9], v[11]); CE(v[12], v[14]); CE(v[13], v[15]); CE(v[0], v[1]); CE(v[2], v[3]); CE(v[4], v[5]); CE(v[6], v[7]); CE(v[8], v[9]); CE(v[10], v[11]); CE(v[12], v[13]); CE(v[14], v[15]); }
__device__ __forceinline__ void merge16_desc(int (&a)[16], const int (&b)[16]) {
#pragma unroll
    for (int i = 0; i < 16; ++i) a[i] = max(a[i], b[15 - i]);
    CE(a[0], a[8]); CE(a[1], a[9]); CE(a[2], a[10]); CE(a[3], a[11]); CE(a[4], a[12]); CE(a[5], a[13]); CE(a[6], a[14]); CE(a[7], a[15]); CE(a[0], a[4]); CE(a[1], a[5]); CE(a[2], a[6]); CE(a[3], a[7]); CE(a[8], a[12]); CE(a[9], a[13]); CE(a[10], a[14]); CE(a[11], a[15]); CE(a[0], a[2]); CE(a[1], a[3]); CE(a[4], a[6]); CE(a[5], a[7]); CE(a[8], a[10]); CE(a[9], a[11]); CE(a[12], a[14]); CE(a[13], a[15]); CE(a[0], a[1]); CE(a[2], a[3]); CE(a[4], a[5]); CE(a[6], a[7]); CE(a[8], a[9]); CE(a[10], a[11]); CE(a[12], a[13]); CE(a[14], a[15]); }
#undef CE


typedef float f32x16 __attribute__((ext_vector_type(16)));
typedef short s16x4 __attribute__((ext_vector_type(4)));
typedef __bf16 bf16x2_t __attribute__((ext_vector_type(2)));
__device__ __forceinline__ unsigned cvtpk(float lo, float hi) { f32x2 v = {lo, hi}; bf16x2_t b = __builtin_convertvector(v, bf16x2_t); return __builtin_bit_cast(unsigned, b); }
constexpr int CK_PITCH = 144, CV_PITCH = 320;
constexpr int CK_SZ = 64 * CK_PITCH, CV_SZ = 64 * CV_PITCH;
constexpr float C_THR_RAW = 8.0f / SCL2;

template <int NDV, class RowFn, class UseFn, class ElemFn>
__device__ __forceinline__ void attn64_pass(f32x16 (&o)[NDV], float& mrun, float& lpart, const bf16x8 (&qf)[4], const bf16* kg, int kpitch, const bf16* vg, int vpitch,
                                            int ntiles, RowFn tile_row, UseFn use_tile, ElemFn elem, LAS unsigned char* L, int lane, int tid) {
    constexpr int VP = NDV * 64 + 64, VSZ = 64 * VP, NVP = NDV / 2;
    const int r32 = lane & 31, hi = lane >> 5;
    const int krow_s = tid >> 3, kch_s = tid & 7;
    const int vrow_s = (NDV == 2) ? (tid >> 3) : (tid >> 4), vch_s = (NDV == 2) ? (tid & 7) : (tid & 15);
    LAS unsigned char* Kb0 = L; LAS unsigned char* Vb0 = L + 2 * CK_SZ;
    __syncthreads();
    {
        const int tr = tile_row(0);
        const v4u kr = *(const GAS v4u*)(kg + (size_t)tr * kpitch);
        *(LAS v4u*)(Kb0 + krow_s * CK_PITCH + kch_s * 16) = kr;
#pragma unroll
        for (int i = 0; i < NVP; ++i) { const v4u v = *(const GAS v4u*)(vg + (size_t)(tr + 32 * i) * vpitch); *(LAS v4u*)(Vb0 + (vrow_s + 32 * i) * VP + vch_s * 16) = v; }
    }
    v4u kr, vr[NVP];
    { const int tr = tile_row(ntiles > 1 ? 1 : 0); kr = *(const GAS v4u*)(kg + (size_t)tr * kpitch);
#pragma unroll
      for (int i = 0; i < NVP; ++i) vr[i] = *(const GAS v4u*)(vg + (size_t)(tr + 32 * i) * vpitch); }
    __syncthreads();
#pragma unroll 1
    for (int j = 0; j < ntiles; ++j) {
        const int cur = j & 1;
        const LAS unsigned char* Kb = Kb0 + cur * CK_SZ; const LAS unsigned char* Vb = Vb0 + cur * VSZ;
        const bool more = (j + 1 < ntiles);
        v4u kr2, vr2[NVP];
        { const int tr = tile_row(j + 2 < ntiles ? j + 2 : ntiles - 1); kr2 = *(const GAS v4u*)(kg + (size_t)tr * kpitch);
#pragma unroll
            for (int i = 0; i < NVP; ++i) vr2[i] = *(const GAS v4u*)(vg + (size_t)(tr + 32 * i) * vpitch); }
        if (use_tile(j)) {
            f32x16 st[2];
#pragma unroll
            for (int kb = 0; kb < 2; ++kb) {
#pragma unroll
                for (int r = 0; r < 16; ++r) st[kb][r] = 0.f;
#pragma unroll
                for (int ks = 0; ks < 4; ++ks) {
                    const bf16x8 kf = *(const LAS bf16x8*)(Kb + (kb * 32 + r32) * CK_PITCH + ks * 32 + hi * 16);
                    st[kb] = __builtin_amdgcn_mfma_f32_32x32x16_bf16(kf, qf[ks], st[kb], 0, 0, 0);
                }
            }
            elem(st, j);
            float mx = st[0][0];
#pragma unroll
            for (int r = 1; r < 16; ++r) mx = fmaxf(mx, st[0][r]);
#pragma unroll
            for (int r = 0; r < 16; ++r) mx = fmaxf(mx, st[1][r]);
            mx = xmax32(mx);
            if (__builtin_amdgcn_ballot_w64(mx > mrun + C_THR_RAW) != 0ull) {
                const float mn = fmaxf(mrun, mx);
                const float alpha = __builtin_amdgcn_exp2f((mrun - mn) * SCL2);
#pragma unroll
                for (int d = 0; d < NDV; ++d)
#pragma unroll
                    for (int r = 0; r < 16; ++r) o[d][r] *= alpha;
                lpart *= alpha; mrun = mn;
            }
            const float nmc = -mrun * SCL2;
            float ls = 0.f;
#pragma unroll
            for (int kb = 0; kb < 2; ++kb)
#pragma unroll
                for (int r = 0; r < 16; ++r) { const float p = __builtin_amdgcn_exp2f(fmaf(st[kb][r], SCL2, nmc)); st[kb][r] = p; ls += p; }
            lpart += ls;
            const int q4 = (lane & 15) >> 2, p4 = lane & 3, grp = (lane >> 4) & 1;
            const LAS unsigned char* vbase = Vb + (4 * hi + q4) * VP + (16 * grp + 4 * p4) * 2;
#pragma unroll
            for (int kb = 0; kb < 2; ++kb)
#pragma unroll
                for (int ss = 0; ss < 2; ++ss) {
                    v4u pw;
#pragma unroll
                    for (int i2 = 0; i2 < 4; ++i2) pw[i2] = cvtpk(st[kb][8 * ss + 2 * i2], st[kb][8 * ss + 2 * i2 + 1]);
                    const bf16x8 pb = __builtin_bit_cast(bf16x8, pw);
#pragma unroll
                    for (int d = 0; d < NDV; ++d) {
                        const LAS unsigned char* va = vbase + (kb * 32 + 16 * ss) * VP + d * 64;
                        const s16x4 lo = __builtin_bit_cast(s16x4, __builtin_amdgcn_ds_read_tr16_b64_v4i16((LAS s16x4*)va));
                        const s16x4 hh = __builtin_bit_cast(s16x4, __builtin_amdgcn_ds_read_tr16_b64_v4i16((LAS s16x4*)(va + 8 * VP)));
                        const bf16x8 vf = __builtin_shufflevector(lo, hh, 0, 1, 2, 3, 4, 5, 6, 7);
                        o[d] = __builtin_amdgcn_mfma_f32_32x32x16_bf16(vf, pb, o[d], 0, 0, 0);
                    }
                }
        }
        if (more) {
            LAS unsigned char* Kn = Kb0 + (cur ^ 1) * CK_SZ; LAS unsigned char* Vn = Vb0 + (cur ^ 1) * VSZ;
            *(LAS v4u*)(Kn + krow_s * CK_PITCH + kch_s * 16) = kr;
#pragma unroll
            for (int i = 0; i < NVP; ++i) *(LAS v4u*)(Vn + (vrow_s + 32 * i) * VP + vch_s * 16) = vr[i];
        }
        kr = kr2;
#pragma unroll
        for (int i = 0; i < NVP; ++i) vr[i] = vr2[i];
        __syncthreads();
    }
}
__device__ __forceinline__ void attn64_store(const f32x16 (&o)[2], float inv, bf16* yrow, int hi) {
#pragma unroll
    for (int d = 0; d < 2; ++d)
#pragma unroll
        for (int g4 = 0; g4 < 4; ++g4) {
            v2u w; w.x = cvtpk(o[d][4 * g4] * inv, o[d][4 * g4 + 1] * inv); w.y = cvtpk(o[d][4 * g4 + 2] * inv, o[d][4 * g4 + 3] * inv);
            *(GAS v2u*)(yrow + d * 32 + 8 * g4 + 4 * hi) = w;
        }
}

namespace pg8 {
typedef unsigned short bf16_t;
constexpr int BM = 256, BK = 64, HALF = 128, HTB = HALF * BK * 2, STAGE_BYTES = 8 * HTB, NXCD = 8, WGM = 8;
__host__ __device__ __forceinline__ int lds_byte(int r, int c) { const int st = (r >> 4) * 2 + (c >> 5), rr = r & 15, cc = c & 31, ob = rr * 64 + cc * 2; return st * 1024 + (ob ^ (((ob >> 9) & 1) << 5)); }
__host__ __device__ __forceinline__ void stage_rc(int b, int& R, int& C) { const int st = b / 1024, sb = b % 1024, swz = sb ^ (((sb >> 9) & 1) << 5); R = (st >> 1) * 16 + swz / 64; C = (st & 1) * 32 + (swz % 64) / 2; }
__host__ __device__ __forceinline__ int perm32(int rho) { const int n = rho >> 4, i = rho & 15; return 8 * (i >> 2) + 4 * n + (i & 3); }
struct Unit { int pm, pn, seg; };
struct Gemm { const bf16_t* A; const bf16_t* Bt; int lda, ldb, K; size_t a_seg, b_seg; };
struct TileOrder {
    int nM, nN, nwg, G, c;
    __device__ void init(int M, int N, int G_, int c_) { nM = M / BM; nN = N / BM; nwg = nM * nN; G = G_; c = c_; }
    __device__ bool tile(int i, int& pm, int& pn) const {
        const long L = (long)i * G + c; if (L >= nwg) return false;
        int wgid = (int)L; { const int q = nwg / NXCD, r = nwg % NXCD, xcd = wgid % NXCD, off = wgid / NXCD; wgid = (xcd < r ? xcd * (q + 1) : r * (q + 1) + (xcd - r) * q) + off; }
        const int nig = WGM * nN, gid = wgid / nig, fm = gid * WGM, gsz = (nM - fm) < WGM ? (nM - fm) : WGM;
        pm = fm + ((wgid % nig) % gsz); pn = (wgid % nig) / gsz; return true;
    }
};
template <int NSEG> struct SegOrder {
    TileOrder T;
    __device__ bool next(int i, Unit& u) const { u.seg = i % NSEG; return T.tile(i / NSEG, u.pm, u.pn); }
};
template <class Epi, class Sched>
__device__ __forceinline__ void gemm_phase(LAS unsigned char* lds, const Gemm g, const Sched& S, const Epi& E, int wid) {
    const int lane = lane_id_v(), tid = wid * 64 + lane,
              wr = wid >> 2, wc = wid & 3, fr = lane & 15, fq = lane >> 4;
    const int K = g.K, nt = K / BK;
    unsigned voffA[2], voffB[2];
#pragma unroll
    for (int i = 0; i < 2; ++i) { int R, C; stage_rc(tid * 16 + i * 8192, R, C); const int Rb = (R & ~31) + perm32(R & 31);
        voffA[i] = (unsigned)(R * g.lda + C) * 2u; voffB[i] = (unsigned)(Rb * g.ldb + C) * 2u; }
    const size_t kstep = (size_t)(BK * 2);
    const size_t hstepA = (size_t)HALF * g.lda * 2, hstepB = (size_t)HALF * g.ldb * 2;
    const unsigned ldsw = (unsigned)wid * 1024u;
    const int aoff = lds_byte(wr * 64 + fr, fq * 8), boff = lds_byte(wc * 32 + fr, fq * 8);
#define PG8_SA(b, h) (((b) * 2 + (h)) * HTB)
#define PG8_SB(b, h) ((4 + (b) * 2 + (h)) * HTB)
#define PG8_STAGE(bufoff, gbase, voff) do { _Pragma("unroll") for (int _i = 0; _i < 2; ++_i) \
        __builtin_amdgcn_global_load_lds((const unsigned*)((const char*)(gbase) + (voff)[_i]), (LAS unsigned*)(lds + (bufoff) + ldsw + _i * 8192), 16, 0, 0); } while (0)
#define PG8_LDA(dst, b, h) do { _Pragma("unroll") for (int m = 0; m < 4; ++m) _Pragma("unroll") for (int k = 0; k < 2; ++k) dst[m][k] = *(const LAS bf16x8*)(lds + PG8_SA(b, h) + aoff + m * 2048 + k * 1024); } while (0)
#define PG8_LDB(dst, b, h) do { _Pragma("unroll") for (int n = 0; n < 2; ++n) _Pragma("unroll") for (int k = 0; k < 2; ++k) dst[n][k] = *(const LAS bf16x8*)(lds + PG8_SB(b, h) + boff + n * 2048 + k * 1024); } while (0)
#define PG8_MMA(ai, bj, At, Bt) do { __builtin_amdgcn_s_setprio(1); _Pragma("unroll") for (int m = 0; m < 4; ++m) _Pragma("unroll") for (int n = 0; n < 2; ++n) _Pragma("unroll") for (int k = 0; k < 2; ++k) \
        acc[ai][bj][m][n] = __builtin_amdgcn_mfma_f32_16x16x32_bf16(Bt[n][k], At[m][k], acc[ai][bj][m][n], 0, 0, 0); __builtin_amdgcn_s_setprio(0); } while (0)
#define PG8_WAIT_V(n) asm volatile("s_waitcnt vmcnt(" #n ")" ::: "memory")
#define PG8_WAIT_L(n) asm volatile("s_waitcnt lgkmcnt(" #n ")" ::: "memory")
#define PG8_BAR __builtin_amdgcn_s_barrier()
#define PG8_SCHED __builtin_amdgcn_sched_barrier(0)
#define PG8_ABASE(u) ((const char*)g.A + ((size_t)(u).seg * g.a_seg + (size_t)(u).pm * BM * g.lda) * 2)
#define PG8_BBASE(u) ((const char*)g.Bt + ((size_t)(u).seg * g.b_seg + (size_t)(u).pn * BM * g.ldb) * 2)
    Unit cur, nxt; int ui = 0;
    if (!S.next(0, cur)) return;
    f32x4 acc[2][2][4][2];
#pragma unroll
    for (int a = 0; a < 2; ++a)
#pragma unroll
        for (int b = 0; b < 2; ++b)
#pragma unroll
            for (int m = 0; m < 4; ++m)
#pragma unroll
                for (int n = 0; n < 2; ++n) acc[a][b][m][n] = (f32x4){0.f, 0.f, 0.f, 0.f};
    bf16x8 At[4][2], B0[2][2], B1[2][2];
    const char* cA = PG8_ABASE(cur); const char* cB = PG8_BBASE(cur);
    PG8_STAGE(PG8_SB(0, 0), cB, voffB); PG8_STAGE(PG8_SB(0, 1), cB + hstepB, voffB); PG8_STAGE(PG8_SA(0, 0), cA, voffA); PG8_STAGE(PG8_SA(0, 1), cA + hstepA, voffA);
    if (wr == 1) PG8_BAR;
    PG8_WAIT_V(2); PG8_BAR;
    PG8_STAGE(PG8_SB(1, 0), cB + kstep, voffB); PG8_STAGE(PG8_SA(1, 0), cA + kstep, voffA); PG8_STAGE(PG8_SB(1, 1), cB + hstepB + kstep, voffB);
    PG8_WAIT_V(6); PG8_BAR;
    for (;;) {
        const bool has_next = S.next(ui + 1, nxt);
        const char* nA = has_next ? PG8_ABASE(nxt) : cA; const char* nB = has_next ? PG8_BBASE(nxt) : cB;
        for (int t = 0; t < nt; t += 2) {
            const bool lastk = (t == nt - 2);
            const char* a1 = cA + (size_t)(t + 1) * kstep;
            const char* a2 = lastk ? nA : cA + (size_t)(t + 2) * kstep; const char* b2 = lastk ? nB : cB + (size_t)(t + 2) * kstep;
            const char* a3 = a2 + kstep; const char* b3 = b2 + kstep;
            PG8_LDB(B0, 0, 0); PG8_LDB(B1, 0, 1); PG8_SCHED; PG8_LDA(At, 0, 0); PG8_STAGE(PG8_SA(1, 1), a1 + hstepA, voffA);
            PG8_WAIT_V(8); PG8_WAIT_L(0); PG8_BAR; PG8_MMA(0, 0, At, B0); PG8_MMA(0, 1, At, B1); PG8_BAR; PG8_SCHED;
            PG8_LDA(At, 0, 1); PG8_STAGE(PG8_SB(0, 0), b2, voffB); PG8_STAGE(PG8_SB(0, 1), b2 + hstepB, voffB); PG8_STAGE(PG8_SA(0, 0), a2, voffA);
            PG8_WAIT_V(8); PG8_WAIT_L(0); PG8_BAR; PG8_MMA(1, 0, At, B0); PG8_MMA(1, 1, At, B1); PG8_BAR; PG8_SCHED;
            PG8_LDB(B0, 1, 0); PG8_LDB(B1, 1, 1); PG8_SCHED; PG8_LDA(At, 1, 0); PG8_STAGE(PG8_SA(0, 1), a2 + hstepA, voffA);
            PG8_WAIT_V(8); PG8_WAIT_L(0); PG8_BAR; PG8_MMA(0, 0, At, B0); PG8_MMA(0, 1, At, B1); PG8_BAR; PG8_SCHED;
            PG8_LDA(At, 1, 1); PG8_STAGE(PG8_SB(1, 0), b3, voffB); PG8_STAGE(PG8_SB(1, 1), b3 + hstepB, voffB); PG8_STAGE(PG8_SA(1, 0), a3, voffA);
            PG8_WAIT_V(8); PG8_WAIT_L(0); PG8_BAR; PG8_MMA(1, 0, At, B0); PG8_MMA(1, 1, At, B1); PG8_BAR; PG8_SCHED;
        }
        if (wr == 0) PG8_BAR;
        E(acc, cur, wr, wc, fr, fq);
        if (!has_next) break;
#pragma unroll
        for (int a = 0; a < 2; ++a)
#pragma unroll
            for (int b = 0; b < 2; ++b)
#pragma unroll
                for (int m = 0; m < 4; ++m)
#pragma unroll
                    for (int n = 0; n < 2; ++n) acc[a][b][m][n] = (f32x4){0.f, 0.f, 0.f, 0.f};
        cur = nxt; cA = nA; cB = nB; ++ui;
        if (wr == 1) PG8_BAR;
    }
    PG8_WAIT_V(0);
    PG8_BAR;
#undef PG8_SA
#undef PG8_SB
#undef PG8_STAGE
#undef PG8_LDA
#undef PG8_LDB
#undef PG8_MMA
#undef PG8_WAIT_V
#undef PG8_WAIT_L
#undef PG8_BAR
#undef PG8_SCHED
#undef PG8_ABASE
#undef PG8_BBASE
}
}

__device__ __forceinline__ v4u pack8(const f32x4& a, const f32x4& b) { v4u w; w.x = cvtpk(a.x, a.y); w.y = cvtpk(a.z, a.w); w.z = cvtpk(b.x, b.y); w.w = cvtpk(b.z, b.w); return w; }
struct EpiInProj {
    bf16 *AQ, *AK, *AVT, *BQ, *BK, *BVT, *CQ, *CK, *CV, *SG; const float *COS, *SIN;
    __device__ __forceinline__ void operator()(const f32x4 (&acc)[2][2][4][2], const pg8::Unit& u, int wr, int wc, int fr, int fq) const {
        asm volatile("" : "+v"(fr), "+v"(fq));
#pragma unroll
        for (int bj = 0; bj < 2; ++bj) {
            const int cblk = u.pn * 256 + bj * 128;
            const int cw = wc * 32 + 8 * fq;
            bf16* dst; int pitch, cbase; int kind;
            int nh = 1, hd = 0;
            if (cblk < 512)       { dst = AQ; pitch = 512; cbase = cblk; kind = 1; }
            else if (cblk < 640)  { dst = AK; pitch = 128; cbase = cblk - 512; kind = 1; }
            else if (cblk < 768)  { dst = AVT; pitch = 128; cbase = cblk - 640; kind = 0; }
            else if (cblk < 1280) { dst = BQ; pitch = 512; cbase = cblk - 768; kind = 0; }
            else if (cblk < 1792) { dst = BK; pitch = 512; cbase = cblk - 1280; kind = 0; }
            else if (cblk < 2304) { dst = BVT; pitch = 512; cbase = cblk - 1792; kind = 0; }
            else if (cblk < 2816) { dst = CQ; pitch = 512; cbase = cblk - 2304; kind = 1; }
            else if (cblk < 3328) { dst = CK; pitch = 512; cbase = cblk - 2816; kind = 1; }
            else if (cblk < 3840) { dst = CV; pitch = 512; cbase = cblk - 3328; kind = 0; }
            else                  { dst = SG; pitch = 3072; cbase = cblk - 3840; kind = 3; }
#pragma unroll
            for (int ai = 0; ai < 2; ++ai)
#pragma unroll
                for (int m = 0; m < 4; ++m) {
                    const int row = u.pm * 256 + ai * 128 + wr * 64 + m * 16 + fr;
                    f32x4 v0 = acc[ai][bj][m][0], v1 = acc[ai][bj][m][1];
                    if (kind == 1) {
                        if (row < T_LAT) {
                            const int t = row & (SEQ - 1), i0 = (cw & 63) >> 1;
                            const f32x4 cs = *(const GAS f32x4*)(COS + t * 32 + i0), sn = *(const GAS f32x4*)(SIN + t * 32 + i0);
                            const f32x4 a = v0, b = v1;
                            v0.x = a.x * cs.x - a.y * sn.x; v0.y = a.y * cs.x + a.x * sn.x; v0.z = a.z * cs.y - a.w * sn.y; v0.w = a.w * cs.y + a.z * sn.y;
                            v1.x = b.x * cs.z - b.y * sn.z; v1.y = b.y * cs.z + b.x * sn.z; v1.z = b.z * cs.w - b.w * sn.w; v1.w = b.w * cs.w + b.z * sn.w;
                        }
                        *(GAS v4u*)(dst + (size_t)row * pitch + cbase + cw) = pack8(v0, v1);
                    } else if (kind == 0) {
                        *(GAS v4u*)(dst + (size_t)row * pitch + cbase + cw) = pack8(v0, v1);
                    } else if (kind == 3) {
                        v0.x = sigmoid_fast(v0.x); v0.y = sigmoid_fast(v0.y); v0.z = sigmoid_fast(v0.z); v0.w = sigmoid_fast(v0.w);
                        v1.x = sigmoid_fast(v1.x); v1.y = sigmoid_fast(v1.y); v1.z = sigmoid_fast(v1.z); v1.w = sigmoid_fast(v1.w);
                        *(GAS v4u*)(dst + (size_t)row * pitch + cbase + cw) = pack8(v0, v1);
                    } else {
                        const int hc = hd + cw, head = hc >> 6, d = hc & 63;
                        const int b = row_batch(row), tok = row_tok(row);
                        bf16* vp = dst + ((size_t)(b * nh + head) * 64 + d) * NTOK + tok;
                        vp[0 * NTOK] = (bf16)f2bf(v0.x); vp[1 * NTOK] = (bf16)f2bf(v0.y); vp[2 * NTOK] = (bf16)f2bf(v0.z); vp[3 * NTOK] = (bf16)f2bf(v0.w);
                        vp[4 * NTOK] = (bf16)f2bf(v1.x); vp[5 * NTOK] = (bf16)f2bf(v1.y); vp[6 * NTOK] = (bf16)f2bf(v1.z); vp[7 * NTOK] = (bf16)f2bf(v1.w);
                    }
                }
        }
    }
};
__device__ __forceinline__ void unpack8(const v4u& w, f32x4& a, f32x4& b) {
    a = (f32x4){bf2f(w.x & 0xffffu), bf2f(w.x >> 16), bf2f(w.y & 0xffffu), bf2f(w.y >> 16)}; b = (f32x4){bf2f(w.z & 0xffffu), bf2f(w.z >> 16), bf2f(w.w & 0xffffu), bf2f(w.w >> 16)};
}
struct EpiBranch {
    const bf16* SG; bf16* MG;
    __device__ __forceinline__ void operator()(const f32x4 (&acc)[2][2][4][2], const pg8::Unit& u, int wr, int wc, int fr, int fq) const {
        asm volatile("" : "+v"(fr), "+v"(fq));
#pragma unroll
        for (int ai = 0; ai < 2; ++ai)
#pragma unroll
            for (int m = 0; m < 4; ++m) {
                const int row = u.pm * 256 + ai * 128 + wr * 64 + m * 16 + fr;
#pragma unroll
                for (int bj = 0; bj < 2; ++bj) {
                    const int col = u.pn * 256 + bj * 128 + wc * 32 + 8 * fq;
                    f32x4 g0, g1; { const v4u wg = *(const GAS v4u*)(SG + (size_t)row * 3072 + u.seg * 1024 + col); unpack8(wg, g0, g1); }
                    f32x4 v0 = g0 * acc[ai][bj][m][0], v1 = g1 * acc[ai][bj][m][1];
                    bf16* mp = MG + (size_t)row * D + col;
                    if (u.seg > 0) { f32x4 p0, p1; const v4u wp = *(const GAS v4u*)mp; unpack8(wp, p0, p1); v0 += p0; v1 += p1; }
                    *(GAS v4u*)mp = pack8(v0, v1);
                }
            }
    }
};
struct EpiOut {
    float* X; const float* gtl; const float* xin; const float* cin;
    __device__ __forceinline__ void operator()(const f32x4 (&acc)[2][2][4][2], const pg8::Unit& u, int wr, int wc, int fr, int fq) const {
        asm volatile("" : "+v"(fr), "+v"(fq));
#pragma unroll
        for (int ai = 0; ai < 2; ++ai)
#pragma unroll
            for (int m = 0; m < 4; ++m) {
                const int row = u.pm * 256 + ai * 128 + wr * 64 + m * 16 + fr;
                const float* gt = gtl + (size_t)row_modidx(row) * 6 * D + 2 * D;
#pragma unroll
                for (int bj = 0; bj < 2; ++bj) {
                    const int col = u.pn * 256 + bj * 128 + wc * 32 + 8 * fq;
                    GAS f32x4* xp = (GAS f32x4*)(X + (size_t)row * D + col);
                    const GAS f32x4* sp = xin ? (const GAS f32x4*)(xin_row(xin, cin, row) + col) : (const GAS f32x4*)xp;
                    const f32x4 g0 = *(const GAS f32x4*)(gt + col), g1 = *(const GAS f32x4*)(gt + col + 4);
                    xp[0] = sp[0] + g0 * acc[ai][bj][m][0]; xp[1] = sp[1] + g1 * acc[ai][bj][m][1];
                }
            }
    }
};
struct EpiStore {
    bf16* O; int ldc;
    __device__ __forceinline__ void operator()(const f32x4 (&acc)[2][2][4][2], const pg8::Unit& u, int wr, int wc, int fr, int fq) const {
        asm volatile("" : "+v"(fr), "+v"(fq));
#pragma unroll
        for (int ai = 0; ai < 2; ++ai)
#pragma unroll
            for (int m = 0; m < 4; ++m) {
                const int row = u.pm * 256 + ai * 128 + wr * 64 + m * 16 + fr;
#pragma unroll
                for (int bj = 0; bj < 2; ++bj) {
                    const int col = u.pn * 256 + bj * 128 + wc * 32 + 8 * fq;
                    *(GAS v4u*)(O + (size_t)row * ldc + col) = pack8(acc[ai][bj][m][0], acc[ai][bj][m][1]);
                }
            }
    }
};

__global__ void __launch_bounds__(NTHREADS, 2) mega_fwd(Args args) {
    extern __shared__ __attribute__((aligned(16))) unsigned char lds[];
    LAS unsigned char* L = (LAS unsigned char*)lds;
    volatile LAS unsigned* MISC = (volatile LAS unsigned*)(L + MISC_OFF);
    const int wave = __builtin_amdgcn_readfirstlane((int)threadIdx.x >> 6);
    const int lane = lane_id_v(), tid = wave * 64 + lane;
    const int fr = lane & 15, fq = lane >> 4;
    const int G = gridDim.x;
    const int vcu = (G % 8 == 0) ? (int)(blockIdx.x % 8) * (G / 8) + (int)(blockIdx.x / 8) : (int)blockIdx.x;
    for (int u = tid; u < (LDS_BYTES - 131072) / 4; u += NTHREADS) ((LAS unsigned*)(L + 131072))[u] = 0u;
    __syncthreads();
    unsigned char* ws = args.ws;
    gu32* ctl = (gu32*)(ws + WS_CTL);
    (void)xcd_barrier_post((unsigned*)(ctl + CW_BAR), MISC + 8);
    if (tid == 0) MISC[12] = xb_add((unsigned*)(ctl + CW_RANK) + 64 * xb_xcc_id(), 1u);
    __syncthreads();
#define GRID_BAR() do { unsigned* bp_ = (unsigned*)(args.ws + WS_CTL) + CW_BAR; asm volatile("" : "+s"(bp_)); XcdBarrier b_; b_.bar = bp_; b_.x = xb_xcc_id(); b_.st = MISC + 8; xcd_barrier(b_, wave == 0 && lane_id_v() == 0); } while (0)
    const int gw = vcu * NWAVES + wave, NGW = G * NWAVES;
    const int NGT = G * NTHREADS;

#define PHASE_PTRS \
    unsigned char* wsq = args.ws; asm volatile("" : "+s"(wsq)); \
    const float* const* IN_ = (const float* const*)__builtin_amdgcn_kernarg_segment_ptr(); asm volatile("" : "+s"(IN_)); \
    float* MODV = (float*)(wsq + WS_MOD); float* COS = (float*)(wsq + WS_COS); float* SIN = (float*)(wsq + WS_SIN); \
    bf16* WIN = (bf16*)(wsq + WS_WIN); bf16* WB = (bf16*)(wsq + WS_WB); bf16* WO = (bf16*)(wsq + WS_WO); bf16* WQ = (bf16*)(wsq + WS_WQ); bf16* KEYS = (bf16*)(wsq + WS_KEYS); \
    float* X = (float*)(wsq + WS_X); bf16* H = (bf16*)(wsq + WS_H); bf16* Y = (bf16*)(wsq + WS_Y); bf16* MG = (bf16*)(wsq + WS_MG); \
    unsigned* EI = (unsigned*)(wsq + WS_EI); float* EG = (float*)(wsq + WS_EG); \
    unsigned char* U8 = wsq + WS_U8; unsigned char* V8 = wsq + WS_V8; float* SCU = (float*)(wsq + WS_SCU); float* SCV = SCU + DEPTH * 16384; \
    bf16* AQ = (bf16*)(wsq + WS_AQ); bf16* AK = (bf16*)(wsq + WS_AK); bf16* AVT = (bf16*)(wsq + WS_AVT); \
    bf16* BQ = (bf16*)(wsq + WS_BQ); bf16* BK = (bf16*)(wsq + WS_BK); bf16* BVT = (bf16*)(wsq + WS_BVT); \
    bf16* CQ = (bf16*)(wsq + WS_CQ); bf16* CK = (bf16*)(wsq + WS_CK); bf16* CVT = (bf16*)(wsq + WS_CVT); \
    bf16* SG = (bf16*)(wsq + WS_SG); bf16* Q2 = (bf16*)(wsq + WS_Q2); float* SC = (float*)(wsq + WS_SC); \
    (void)MODV; (void)COS; (void)SIN; (void)WIN; (void)WB; (void)WO; (void)WQ; (void)KEYS; (void)X; (void)H; (void)Y; (void)MG; (void)EI; (void)EG; (void)U8; (void)V8; (void)SCU; (void)SCV; \
    (void)AQ; (void)AK; (void)AVT; (void)BQ; (void)BK; (void)BVT; (void)CQ; (void)CK; (void)CVT; (void)SG; (void)Q2; (void)SC; (void)IN_;
#define LAYER_PTRS const float* modl = MODV + (size_t)layer * 3 * 6 * D; const bf16* WINl = WIN + (size_t)layer * IN_W * D; (void)modl; (void)WINl;

#ifndef SKIP_P0
        { PHASE_PTRS
        for (int rep_ = 0; rep_ < REP_P0; ++rep_) {
    {
        LAS float* scr = (LAS float*)(L + wave * 16384);
        int gt = vcu * NTHREADS + tid; asm volatile("" : "+v"(gt));
        constexpr int I_IN = (D / 64) * (IN_W / 32), I_BR = (512 / 64) * (D / 32), I_O = (D / 64) * (D / 32), I_Q = (D / 64) * (2048 / 32);
        constexpr int PER_LAYER = I_IN + 3 * I_BR + I_O + I_Q;
        for (int rp_ = 0; rp_ < REP_P0A; ++rp_)
        for (int it = gw; it < DEPTH * PER_LAYER; it += NGW) {
            const int l = it / PER_LAYER; int r = it % PER_LAYER;
            if (r < I_IN) { p0_transpose_item<true>(IN_[I_WIN] + (size_t)l * D * IN_W, D, IN_W, WIN + (size_t)l * IN_W * D, scr, r, lane); continue; } r -= I_IN;
            if (r < I_BR) { p0_transpose_item(IN_[I_WBA] + (size_t)l * 512 * D, 512, D, WB + (size_t)(l * 3 + 0) * D * 512, scr, r, lane); continue; } r -= I_BR;
            if (r < I_BR) { p0_transpose_item(IN_[I_WBB] + (size_t)l * 512 * D, 512, D, WB + (size_t)(l * 3 + 1) * D * 512, scr, r, lane); continue; } r -= I_BR;
            if (r < I_BR) { p0_transpose_item(IN_[I_WBC] + (size_t)l * 512 * D, 512, D, WB + (size_t)(l * 3 + 2) * D * 512, scr, r, lane); continue; } r -= I_BR;
            if (r < I_O) { p0_transpose_item(IN_[I_WOUT] + (size_t)l * D * D, D, D, WO + (size_t)l * D * D, scr, r, lane); continue; } r -= I_O;
            p0_transpose_item(IN_[I_PWQ] + (size_t)l * D * 2048, D, 2048, WQ + (size_t)l * 2048 * D, scr, r, lane);
        }
        for (int i = gt; i < DEPTH * 16 * 128 * 128 / 4; i += NGT) {
            const f32x4 v = *((const GAS f32x4*)IN_[I_PKEYS] + i);
            v2u o; o.x = pk2(v.x, v.y); o.y = pk2(v.z, v.w); *((GAS v2u*)KEYS + i) = o;
        }
        {
            LAS float* red = (LAS float*)(L + 9216);
            for (int rp_ = 0; rp_ < REP_P0D; ++rp_)
            for (int it = vcu; it < DEPTH * 96; it += G) {
                const int l = it / 96, nc = it % 96, n = nc * 64 + lane;
                const float* wm = IN_[I_WMOD] + (size_t)l * D * 6 * D + n;
                float a0 = 0.f, a1 = 0.f, a2 = 0.f;
#pragma unroll 1
                for (int half = 0; half < 2; ++half) {
                    const int kb = wave * 128 + half * 64;
                    const float c0 = IN_[I_C][kb + lane], c1 = IN_[I_C][D + kb + lane], c2 = IN_[I_CCTX][kb + lane];
                    const int s0 = __builtin_bit_cast(int, c0 * sigmoidf_(c0)), s1 = __builtin_bit_cast(int, c1 * sigmoidf_(c1)), s2 = __builtin_bit_cast(int, c2 * sigmoidf_(c2));
#pragma unroll
                    for (int kk = 0; kk < 64; ++kk) {
                        const float w = wm[(size_t)(kb + kk) * 6 * D];
                        a0 += __builtin_bit_cast(float, __builtin_amdgcn_readlane(s0, kk)) * w;
                        a1 += __builtin_bit_cast(float, __builtin_amdgcn_readlane(s1, kk)) * w;
                        a2 += __builtin_bit_cast(float, __builtin_amdgcn_readlane(s2, kk)) * w;
                    }
                }
                red[(wave * 3 + 0) * 64 + lane] = a0; red[(wave * 3 + 1) * 64 + lane] = a1; red[(wave * 3 + 2) * 64 + lane] = a2;
                __syncthreads();
                if (wave < 3) {
                    float sum = IN_[I_BMOD][l * 6 * D + n];
#pragma unroll
                    for (int w = 0; w < 8; ++w) sum += red[(w * 3 + wave) * 64 + lane];
                    MODV[(size_t)(l * 3 + wave) * 6 * D + n] = sum;
                }
                __syncthreads();
            }
        }
        for (int i = gt; i < SEQ * 32; i += NGT) {
            const int t = i >> 5, f = i & 31;
            const float inv = exp2f(-(float)(f & 15) * (13.287712379549449f / 16.0f));
            const float pos = (f < 16) ? (float)(t / GRID_W) : (float)(t % GRID_W);
            float sn, cs; sincosf(pos * inv, &sn, &cs);
            COS[i] = cs; SIN[i] = sn;
        }
    }
        for (int rp_ = 0; rp_ < REP_P0F; ++rp_)
#pragma unroll 4
        for (int rr = gw; rr < 2 * DEPTH * 16384; rr += NGW) {
            const int tab = rr / (DEPTH * 16384), row = rr % (DEPTH * 16384);
            const float* src = (tab == 0 ? IN_[I_PU] : IN_[I_PV]) + (size_t)row * D;
            f32x4 v[4]; float am = 0.f;
#pragma unroll
            for (int j = 0; j < 4; ++j) { v[j] = *((const GAS f32x4*)src + lane + 64 * j); am = fmaxf(am, fmaxf(fmaxf(fabsf(v[j].x), fabsf(v[j].y)), fmaxf(fabsf(v[j].z), fabsf(v[j].w)))); }
            am = wave_max(am);
            const bool as_i8 = (P10_SLICED != 0) && (tab == 0);
            int ex = 0; float scale = 1.0f;
            if (am > 0.f) { (void)frexpf(am * (as_i8 ? (1.0f / 127.0f) : (1.0f / 448.0f)), &ex); scale = ldexpf(1.0f, ex); }
            const float inv = 1.0f / scale;
            v4u o;
#pragma unroll
            for (int j = 0; j < 4; ++j) {
                if (as_i8) {
                    const int q0 = __float2int_rn(v[j].x * inv), q1 = __float2int_rn(v[j].y * inv), q2 = __float2int_rn(v[j].z * inv), q3 = __float2int_rn(v[j].w * inv);
                    o[j] = (unsigned)(q0 & 255) | ((unsigned)(q1 & 255) << 8) | ((unsigned)(q2 & 255) << 16) | ((unsigned)q3 << 24);
                } else {
                    int p = __builtin_amdgcn_cvt_pk_fp8_f32(v[j].x * inv, v[j].y * inv, 0, false);
                    p = __builtin_amdgcn_cvt_pk_fp8_f32(v[j].z * inv, v[j].w * inv, p, true);
                    o[j] = (unsigned)p;
                }
            }
            *((GAS v4u*)((tab == 0 ? U8 : V8) + (size_t)row * D) + lane) = o;
            if (lane == 0) (tab == 0 ? SCU : SCV)[row] = scale;
        }
        }
        }
#endif
    GRID_BAR();

    for (int layer = 0; layer < DEPTH; ++layer) {
        const bool last = (layer == DEPTH - 1);
        const int T_EFF = last ? T_LAT : T_ALL;

#ifndef SKIP_P1
        { PHASE_PTRS LAYER_PTRS
        for (int rep_ = 0; rep_ < REP_P1; ++rep_) {
        { const int ln = lane_id_v();
        if (layer == 0)
        for (int r = gw; r < T_ALL; r += NGW) {
            const float* md = modl + (size_t)row_modidx(r) * 6 * D;
            const GAS f32x4* xr = (const GAS f32x4*)xin_row(IN_[I_X], IN_[I_CTX], r) + ln;
            f32x4 v[4]; float ss = 0.f;
#pragma unroll
            for (int j = 0; j < 4; ++j) { v[j] = xr[64 * j]; ss += (v[j].x * v[j].x + v[j].y * v[j].y) + (v[j].z * v[j].z + v[j].w * v[j].w); }
            const float rs = 1.0f / sqrtf(wave_sum(ss) * (1.f / D) + NORM_EPS);
            GAS v2u* o8 = (GAS v2u*)(H + (size_t)r * D) + ln;
#pragma unroll
            for (int j = 0; j < 4; ++j) {
                const f32x4 g = *((const GAS f32x4*)(IN_[I_G1] + layer * D) + ln + 64 * j);
                const f32x4 sh = *((const GAS f32x4*)(md + 0) + ln + 64 * j), sc = *((const GAS f32x4*)(md + D) + ln + 64 * j);
                const f32x4 h = v[j] * rs * g * (sc + 1.0f) + sh;
                v2u o; o.x = pk2(h.x, h.y); o.y = pk2(h.z, h.w); o8[64 * j] = o;
            }
        }
        }
        }
        }
#endif
        if (layer == 0) GRID_BAR();

#ifndef SKIP_P2
        { PHASE_PTRS LAYER_PTRS
        for (int rep_ = 0; rep_ < REP_P2; ++rep_) {
        {
            pg8::Gemm g{H, WINl, D, D, D, 0, 0};
            pg8::SegOrder<1> S; S.T.init(T_ALL, IN_W, G, (int)blockIdx.x);
            EpiInProj E{AQ, AK, AVT, BQ, BK, BVT, CQ, CK, CVT, SG, COS, SIN};
            pg8::gemm_phase(L, g, S, E, wave);
        }
        }
        }
#endif
        GRID_BAR();

#ifndef SKIP_P3
        { PHASE_PTRS LAYER_PTRS
        {
            LAS bf16* Pl = (LAS bf16*)(L + wave * 8192);
            const float lam_init = 0.8f - 0.6f * expf(-0.3f * (float)layer);
            float lam;
            {
                const int ll = lane_id_v();
                const float* cl = IN_[I_LAMBDA] + layer * 256;
                const float s1 = wave_sum(cl[ll] * cl[64 + ll]), s2 = wave_sum(cl[128 + ll] * cl[192 + ll]);
                lam = expf(s1) - expf(s2) + lam_init;
            }
{ const int lo__ = lane_id_v(); { const int lane = lo__; const int fr = lane & 15, fq = lane >> 4, tid = wave * 64 + lane; (void)fr; (void)fq; (void)tid;
            {
                const int r32 = lane & 31, hi = lane >> 5;
                const int n_lat = BATCH * 4 * (SEQ / 256), n_ctx = last ? 0 : BATCH * 4;
                const int NU = (n_lat + G - 1) / G * G + n_ctx;
                for (int rep_ = 0; rep_ < REP_P3C; ++rep_)
                for (int u0 = vcu; u0 < NU; u0 += G) {
                    int b, h, row0, t_lo, t_hi;
                    if (u0 < n_lat) { const int bh = u0 >> 5; b = bh >> 2; h = bh & 3; row0 = b * SEQ + (u0 & 31) * 256; t_lo = 0; t_hi = 132; }
                    else { const int c = u0 - (n_lat + G - 1) / G * G; if (c < 0 || c >= n_ctx) continue; b = c >> 2; h = c & 3; row0 = T_LAT + b * CTX; t_lo = 128; t_hi = 132; }
                    const int qrow = row0 + wave * 32 + r32;
                    LAS unsigned* o1p = (LAS unsigned*)(L + 65536 + wave * 8192) + lane;
                    const int krow_s = tid >> 3, kch_s = tid & 7;
                    const int vrow_s0 = tid >> 4, vch_s = tid & 15;
                    LAS unsigned char* Kb0 = L; LAS unsigned char* Vb0 = L + 2 * CK_SZ;
#pragma unroll 1
                    for (int m = 0; m < 2; ++m) {
                        bf16x8 qf[4];
                        { const bf16* qp = CQ + (size_t)qrow * 512 + (h * 2 + m) * 64 + hi * 8;
#pragma unroll
                          for (int ks = 0; ks < 4; ++ks) qf[ks] = *(const GAS bf16x8*)(qp + ks * 16); }
                        f32x16 o[4];
#pragma unroll
                        for (int d = 0; d < 4; ++d)
#pragma unroll
                            for (int r = 0; r < 16; ++r) o[d][r] = 0.f;
                        float mrun = -1e30f, lpart = 0.f;
                        const bf16* kg = CK + (size_t)krow_s * 512 + (h * 2 + m) * 64 + kch_s * 8;
                        const bf16* vg = CVT + (size_t)vrow_s0 * 512 + h * 128 + vch_s * 8;
                        auto tile_row = [&](int j) { return (j < 128) ? b * SEQ + 64 * j : T_LAT + b * CTX + 64 * (j - 128); };
                        __syncthreads();
                        {
                            const size_t kb = (size_t)tile_row(t_lo) * 512;
                            const v4u kr = *(const GAS v4u*)(kg + kb), v0 = *(const GAS v4u*)(vg + kb), v1 = *(const GAS v4u*)(vg + kb + 32 * 512);
                            *(LAS v4u*)(Kb0 + krow_s * CK_PITCH + kch_s * 16) = kr;
                            *(LAS v4u*)(Vb0 + vrow_s0 * CV_PITCH + vch_s * 16) = v0; *(LAS v4u*)(Vb0 + (vrow_s0 + 32) * CV_PITCH + vch_s * 16) = v1;
                        }
                        __syncthreads();
#pragma unroll 1
                        for (int j = t_lo; j < t_hi; ++j) {
                            const int cur = (j - t_lo) & 1;
                            const LAS unsigned char* Kb = Kb0 + cur * CK_SZ; const LAS unsigned char* Vb = Vb0 + cur * CV_SZ;
                            v4u kr, v0, v1;
                            const bool more = (j + 1 < t_hi);
                            { const size_t kb = (size_t)tile_row(more ? j + 1 : j) * 512; kr = *(const GAS v4u*)(kg + kb); v0 = *(const GAS v4u*)(vg + kb); v1 = *(const GAS v4u*)(vg + kb + 32 * 512); }
                            f32x16 st[2];
#pragma unroll
                            for (int kb = 0; kb < 2; ++kb) {
#pragma unroll
                                for (int r = 0; r < 16; ++r) st[kb][r] = 0.f;
#pragma unroll
                                for (int ks = 0; ks < 4; ++ks) {
                                    const bf16x8 kf = *(const LAS bf16x8*)(Kb + (kb * 32 + r32) * CK_PITCH + ks * 32 + hi * 16);
                                    st[kb] = __builtin_amdgcn_mfma_f32_32x32x16_bf16(kf, qf[ks], st[kb], 0, 0, 0);
                                }
                            }
                            float mx = st[0][0];
#pragma unroll
                            for (int r = 1; r < 16; ++r) mx = fmaxf(mx, st[0][r]);
#pragma unroll
                            for (int r = 0; r < 16; ++r) mx = fmaxf(mx, st[1][r]);
                            mx = xmax32(mx);
                            if (__builtin_amdgcn_ballot_w64(mx > mrun + C_THR_RAW) != 0ull) {
                                const float mn = fmaxf(mrun, mx);
                                const float alpha = __builtin_amdgcn_exp2f((mrun - mn) * SCL2);
#pragma unroll
                                for (int d = 0; d < 4; ++d)
#pragma unroll
                                    for (int r = 0; r < 16; ++r) o[d][r] *= alpha;
                                lpart *= alpha; mrun = mn;
                            }
                            const float nmc = -mrun * SCL2;
                            float ls = 0.f;
#pragma unroll
                            for (int kb = 0; kb < 2; ++kb)
#pragma unroll
                                for (int r = 0; r < 16; ++r) { const float p = __builtin_amdgcn_exp2f(fmaf(st[kb][r], SCL2, nmc)); st[kb][r] = p; ls += p; }
                            lpart += ls;
                            {
                                const int q4 = (lane & 15) >> 2, p4 = lane & 3, grp = (lane >> 4) & 1;
                                const LAS unsigned char* vbase = Vb + (4 * hi + q4) * CV_PITCH + (16 * grp + 4 * p4) * 2;
#pragma unroll
                                for (int kb = 0; kb < 2; ++kb)
#pragma unroll
                                    for (int ss = 0; ss < 2; ++ss) {
                                        v4u pw;
#pragma unroll
                                        for (int i2 = 0; i2 < 4; ++i2) pw[i2] = cvtpk(st[kb][8 * ss + 2 * i2], st[kb][8 * ss + 2 * i2 + 1]);
                                        const bf16x8 pb = __builtin_bit_cast(bf16x8, pw);
#pragma unroll
                                        for (int d = 0; d < 4; ++d) {
                                            const LAS unsigned char* va = vbase + (kb * 32 + 16 * ss) * CV_PITCH + d * 64;
                                            const s16x4 lo = __builtin_bit_cast(s16x4, __builtin_amdgcn_ds_read_tr16_b64_v4i16((LAS s16x4*)va));
                                            const s16x4 hh = __builtin_bit_cast(s16x4, __builtin_amdgcn_ds_read_tr16_b64_v4i16((LAS s16x4*)(va + 8 * CV_PITCH)));
                                            const bf16x8 vf = __builtin_shufflevector(lo, hh, 0, 1, 2, 3, 4, 5, 6, 7);
                                            o[d] = __builtin_amdgcn_mfma_f32_32x32x16_bf16(vf, pb, o[d], 0, 0, 0);
                                        }
                                        if (ss == 1) __builtin_amdgcn_sched_barrier(0);
                                    }
                            }
                            if (more) {
                                LAS unsigned char* Kn = Kb0 + (cur ^ 1) * CK_SZ; LAS unsigned char* Vn = Vb0 + (cur ^ 1) * CV_SZ;
                                *(LAS v4u*)(Kn + krow_s * CK_PITCH + kch_s * 16) = kr;
                                *(LAS v4u*)(Vn + vrow_s0 * CV_PITCH + vch_s * 16) = v0; *(LAS v4u*)(Vn + (vrow_s0 + 32) * CV_PITCH + vch_s * 16) = v1;
                            }
                            __syncthreads();
                        }
                        const float lt = xadd32(lpart);
                        if (m == 0) {
                            const float inv = 1.0f / lt;
#pragma unroll
                            for (int d = 0; d < 4; ++d)
#pragma unroll
                                for (int i2 = 0; i2 < 8; ++i2) o1p[64 * (d * 8 + i2)] = cvtpk(o[d][2 * i2] * inv, o[d][2 * i2 + 1] * inv);
                        } else {
                            const float inv2 = lam / lt;
                            float ssq = 0.f;
#pragma unroll
                            for (int d = 0; d < 4; ++d)
#pragma unroll
                                for (int i2 = 0; i2 < 8; ++i2) {
                                    const unsigned w1 = o1p[64 * (d * 8 + i2)];
                                    const float a0 = bf2f(w1 & 0xffffu) - o[d][2 * i2] * inv2, a1 = bf2f(w1 >> 16) - o[d][2 * i2 + 1] * inv2;
                                    o[d][2 * i2] = a0; o[d][2 * i2 + 1] = a1; ssq += a0 * a0 + a1 * a1;
                                }
                            ssq = xadd32(ssq);
                            const float rn = 1.0f / sqrtf(ssq * (1.f / 128.f) + NORM_EPS) * (1.0f - lam_init);
                            bf16* yp = Y + (size_t)qrow * 1536 + 1024 + h * 128 + 4 * hi;
                            const float* sl = IN_[I_SUBLN] + layer * 512 + h * 128 + 4 * hi;
#pragma unroll
                            for (int d = 0; d < 4; ++d)
#pragma unroll
                                for (int g4 = 0; g4 < 4; ++g4) {
                                    const f32x4 gsl = *(const GAS f32x4*)(sl + d * 32 + 8 * g4);
                                    v2u w; w.x = cvtpk(o[d][4 * g4] * rn * gsl.x, o[d][4 * g4 + 1] * rn * gsl.y); w.y = cvtpk(o[d][4 * g4 + 2] * rn * gsl.z, o[d][4 * g4 + 3] * rn * gsl.w);
                                    *(GAS v2u*)(yp + d * 32 + 8 * g4) = w;
                                }
                        }
                    }
                }
                __syncthreads();
            }
} }
{ const int lo__ = lane_id_v(); { const int lane = lo__; const int tid = wave * 64 + lane, r32 = lane & 31, hi = lane >> 5;
            {
                const int n_lat = BATCH * 2 * (SEQ / 64), n_ctx = last ? 0 : BATCH * 2 * (CTX / 64);
                for (int rep_ = 0; rep_ < REP_P3A; ++rep_)
                for (int u0 = vcu; u0 < n_lat + n_ctx; u0 += G) {
                    const bool isctx = u0 >= n_lat;
                    int b, g, p0, qrow, nl, klo;
                    if (!isctx) { b = u0 >> 8; g = (u0 >> 7) & 1; p0 = (u0 & 127) * 64; qrow = b * SEQ + p0 + (wave & 1) * 32 + r32;
                                  klo = p0 >= 128 ? 0 : (128 - p0) / 64; const int khi = min(4, (SEQ - 1 - (p0 - 128)) / 64); nl = khi - klo + 1; }
                    else { const int c = u0 - n_lat; b = c >> 3; g = (c >> 2) & 1; p0 = (c & 3) * 64; qrow = T_LAT + b * CTX + p0 + (wave & 1) * 32 + r32; nl = 0; klo = 0; }
                    const int hq = g * 4 + (wave >> 1);
                    const int qpos0 = p0 + (wave & 1) * 32;
                    bf16x8 qf[4];
                    { const bf16* qp = AQ + (size_t)qrow * 512 + hq * 64 + hi * 8;
#pragma unroll
                      for (int ks = 0; ks < 4; ++ks) qf[ks] = *(const GAS bf16x8*)(qp + ks * 16); }
                    f32x16 o[2];
#pragma unroll
                    for (int d = 0; d < 2; ++d)
#pragma unroll
                        for (int r = 0; r < 16; ++r) o[d][r] = 0.f;
                    float mrun = IN_[I_SINK][layer * 8 + hq] * 8.0f;
                    float lpart = (hi == 0) ? 1.0f : 0.0f;
                    const bf16* kg = AK + (size_t)(tid >> 3) * 128 + g * 64 + (tid & 7) * 8;
                    const bf16* vg = AVT + (size_t)(tid >> 3) * 128 + g * 64 + (tid & 7) * 8;
                    const int kp0 = p0 - 128 + 64 * klo;
                    auto tile_row = [&](int j) { return (j < nl) ? b * SEQ + kp0 + 64 * j : T_LAT + b * CTX + 64 * (j - nl); };
                    auto use_tile = [&](int j) { if (j >= nl) return true; const int kp = kp0 + 64 * j; return (kp + 63 >= qpos0 - 128) && (kp <= qpos0 + 31 + 128); };
                    auto elem = [&](f32x16 (&st)[2], int j) {
                        if (j < nl) {
                            const int dq0 = (qpos0 + r32) - (kp0 + 64 * j + 4 * hi);
#pragma unroll
                            for (int kb = 0; kb < 2; ++kb)
#pragma unroll
                                for (int r = 0; r < 16; ++r) { const int dq = dq0 - (kb * 32 + (r & 3) + 8 * (r >> 2)); if (dq > 128 || dq < -128) st[kb][r] = -1e30f; }
                        }
                    };
                    attn64_pass<2>(o, mrun, lpart, qf, kg, 128, vg, 128, nl + 4, tile_row, use_tile, elem, L, lane, tid);
                    const float lt = xadd32(lpart);
                    attn64_store(o, 1.0f / lt, Y + (size_t)qrow * 1536 + hq * 64, hi);
                }
            }
} }
{ const int lo__ = lane_id_v(); { const int lane = lo__; const int tid = wave * 64 + lane, r32 = lane & 31, hi = lane >> 5;
            {
                const int n_lat = BATCH * 8 * 32, n_ctx = last ? 0 : BATCH * 8;
                LAS float* rpbL = (LAS float*)(L + 49152);
                for (int rep_ = 0; rep_ < REP_P3B; ++rep_)
                for (int u0 = vcu; u0 < n_lat + n_ctx; u0 += G) {
                    const bool isctx = u0 >= n_lat;
                    int b, h, gr = 0, qc0 = 0, qrow, nl, krlo;
                    if (!isctx) { b = u0 >> 8; h = (u0 >> 5) & 7; const int r0 = (u0 & 31) * 4; gr = r0 + (wave >> 1); qc0 = (wave & 1) * 32; qrow = b * SEQ + gr * GRID_W + qc0 + r32;
                                  krlo = min(max(r0 - 4, 0), 120); nl = min(max(r0 - 1, 0), 120) + 8 - krlo; }
                    else { const int c = u0 - n_lat; b = c >> 3; h = c & 7; qrow = T_LAT + b * CTX + wave * 32 + r32; nl = 0; krlo = 0; }
                    __syncthreads();
                    if (tid < 465) rpbL[tid] = IN_[I_RPB][(size_t)(layer * 8 + h) * 465 + tid] * 8.0f;
                    bf16x8 qf[4];
                    { const bf16* qp = BQ + (size_t)qrow * 512 + h * 64 + hi * 8;
#pragma unroll
                      for (int ks = 0; ks < 4; ++ks) qf[ks] = *(const GAS bf16x8*)(qp + ks * 16); }
                    f32x16 o[2];
#pragma unroll
                    for (int d = 0; d < 2; ++d)
#pragma unroll
                        for (int r = 0; r < 16; ++r) o[d][r] = 0.f;
                    float mrun = -1e30f, lpart = 0.f;
                    const bf16* kg = BK + (size_t)(tid >> 3) * 512 + h * 64 + (tid & 7) * 8;
                    const bf16* vg = BVT + (size_t)(tid >> 3) * 512 + h * 64 + (tid & 7) * 8;
                    const int rs = min(max(gr - 4, 0), 120);
                    auto tile_row = [&](int j) { return (j < nl) ? b * SEQ + (krlo + j) * GRID_W : T_LAT + b * CTX + 64 * (j - nl); };
                    auto use_tile = [&](int j) { if (j >= nl) return true; const int kr = krlo + j; return kr >= rs && kr < rs + 8; };
                    auto elem = [&](f32x16 (&st)[2], int j) {
                        if (j < nl) {
                            const int qc = qc0 + r32, cstart = min(max(qc - 8, 0), 48);
                            const LAS float* brow = rpbL + (krlo + j - gr + 7) * 31 + 15;
#pragma unroll
                            for (int kb = 0; kb < 2; ++kb)
#pragma unroll
                                for (int r = 0; r < 16; ++r) {
                                    const int kc = kb * 32 + (r & 3) + 8 * (r >> 2) + 4 * hi;
                                    const bool valid = (kc >= cstart) && (kc < cstart + 16);
                                    const int dc = min(max(kc - qc, -15), 15);
                                    st[kb][r] = valid ? st[kb][r] + brow[dc] : -1e30f;
                                }
                        }
                    };
                    attn64_pass<2>(o, mrun, lpart, qf, kg, 512, vg, 512, nl + 4, tile_row, use_tile, elem, L, lane, tid);
                    const float lt = xadd32(lpart);
                    attn64_store(o, 1.0f / lt, Y + (size_t)qrow * 1536 + 512 + h * 64, hi);
                }
                __syncthreads();
            }
} }
        }
        }
#endif
        GRID_BAR();

#ifndef SKIP_P4
        { PHASE_PTRS LAYER_PTRS
        for (int rep_ = 0; rep_ < REP_P4; ++rep_) {
        {
            pg8::Gemm g{Y, WB + (size_t)layer * 3 * D * 512, 1536, 512, 512, 512, (size_t)D * 512};
            pg8::SegOrder<3> S; S.T.init(T_LAT, D, G, (int)blockIdx.x);
            EpiBranch E{SG, MG};
            pg8::gemm_phase(L, g, S, E, wave);
        }
        if (!last) { const int lo__ = lane_id_v(); { const int lane = lo__; const int fr = lane & 15, fq = lane >> 4; (void)fr; (void)fq;
            for (int it = gw; it < (T_ALL - T_LAT) / 32 * (D / 32); it += NGW) {
                const int row0 = T_LAT + (it / (D / 32)) * 32, col0 = (it % (D / 32)) * 32;
                f32x4 mg[2][2]; zero_acc22(mg);
#pragma unroll 1
                for (int seg = 0; seg < 3; ++seg) {
                    f32x4 acc[2][2]; zero_acc22(acc);
                    sgemm32<8>(acc, Y + seg * 512, 1536, WB + (size_t)(layer * 3 + seg) * D * 512, 512, 512, row0, col0, lane);
#pragma unroll
                    for (int m = 0; m < 2; ++m)
#pragma unroll
                        for (int r = 0; r < 4; ++r) {
                            const bf16* gp = SG + (size_t)(row0 + 16 * m + 4 * fq + r) * 3072 + seg * 1024 + col0 + fr;
#pragma unroll
                            for (int n = 0; n < 2; ++n) mg[m][n][r] += bf2f(gp[16 * n]) * acc[m][n][r];
                        }
                }
#pragma unroll
                for (int m = 0; m < 2; ++m)
#pragma unroll
                    for (int r = 0; r < 4; ++r) {
                        bf16* rowp = MG + (size_t)(row0 + 16 * m + 4 * fq + r) * D + col0 + fr;
#pragma unroll
                        for (int n = 0; n < 2; ++n) rowp[16 * n] = (bf16)f2bf(mg[m][n][r]);
                    }
            }
} }
        }
        }
#endif
        GRID_BAR();

#ifndef SKIP_P5
        { PHASE_PTRS LAYER_PTRS
        {
            pg8::Gemm g{MG, WO + (size_t)layer * D * D, D, D, D, 0, 0};
            pg8::SegOrder<1> S; S.T.init(T_LAT, D, G, (int)blockIdx.x);
            EpiOut E{X, modl, layer == 0 ? IN_[I_X] : nullptr, IN_[I_CTX]};
            pg8::gemm_phase(L, g, S, E, wave);
        }
        if (!last) { const int lo__ = lane_id_v(); { const int lane = lo__; const int fr = lane & 15, fq = lane >> 4; (void)fr; (void)fq;
            for (int it = gw; it < (T_ALL - T_LAT) / 32 * (D / 32); it += NGW) {
                const int row0 = T_LAT + (it / (D / 32)) * 32, col0 = (it % (D / 32)) * 32;
                f32x4 acc[2][2]; zero_acc22(acc);
                sgemm32<8>(acc, MG, D, WO + (size_t)layer * D * D, D, D, row0, col0, lane);
                const float* gt = modl + (size_t)2 * 6 * D + 2 * D + col0 + fr;
#pragma unroll
                for (int m = 0; m < 2; ++m)
#pragma unroll
                    for (int r = 0; r < 4; ++r) {
                        float* rowp = X + (size_t)(row0 + 16 * m + 4 * fq + r) * D + col0 + fr;
                        const float* srcp = (layer == 0) ? IN_[I_CTX] + (size_t)(row0 - T_LAT + 16 * m + 4 * fq + r) * D + col0 + fr : rowp;
#pragma unroll
                        for (int n = 0; n < 2; ++n) rowp[16 * n] = srcp[16 * n] + gt[16 * n] * acc[m][n][r];
                    }
            }
} }
        }
#endif
        GRID_BAR();

#ifndef SKIP_P6
        { PHASE_PTRS LAYER_PTRS
        for (int rep_ = 0; rep_ < REP_P6; ++rep_) {
        { const int ln = lane_id_v();
        for (int r = gw; r < T_EFF; r += NGW) {
            const float* md = modl + (size_t)row_modidx(r) * 6 * D;
            const GAS f32x4* xr = (const GAS f32x4*)(X + (size_t)r * D) + ln;
            f32x4 v[4]; float ss = 0.f;
#pragma unroll
            for (int j = 0; j < 4; ++j) { v[j] = xr[64 * j]; ss += (v[j].x * v[j].x + v[j].y * v[j].y) + (v[j].z * v[j].z + v[j].w * v[j].w); }
            const float rs = 1.0f / sqrtf(wave_sum(ss) * (1.f / D) + NORM_EPS);
            GAS v2u* o8 = (GAS v2u*)(H + (size_t)r * D) + ln;
#pragma unroll
            for (int j = 0; j < 4; ++j) {
                const f32x4 g = *((const GAS f32x4*)(IN_[I_G2] + layer * D) + ln + 64 * j);
                const f32x4 sh = *((const GAS f32x4*)(md + 3 * D) + ln + 64 * j), sc = *((const GAS f32x4*)(md + 4 * D) + ln + 64 * j);
                const f32x4 h = v[j] * rs * g * (sc + 1.0f) + sh;
                v2u o; o.x = pk2(h.x, h.y); o.y = pk2(h.z, h.w); o8[64 * j] = o;
            }
        }
        }
        }
        }
#endif
        GRID_BAR();

#ifndef SKIP_P7
        { PHASE_PTRS LAYER_PTRS
        for (int rep_ = 0; rep_ < REP_P7; ++rep_) {
        {
            pg8::Gemm g{H, WQ + (size_t)layer * 2048 * D, D, D, D, 0, 0};
            pg8::SegOrder<1> S; S.T.init(T_LAT, 2048, G, (int)blockIdx.x);
            EpiStore E{Q2, 2048};
            pg8::gemm_phase(L, g, S, E, wave);
        }
        if (!last) { const int lo__ = lane_id_v(); { const int lane = lo__; const int fr = lane & 15, fq = lane >> 4; (void)fr; (void)fq;
            for (int it = gw; it < (T_ALL - T_LAT) / 32 * (2048 / 32); it += NGW) {
                const int row0 = T_LAT + (it / (2048 / 32)) * 32, col0 = (it % (2048 / 32)) * 32;
                f32x4 acc[2][2]; zero_acc22(acc);
                sgemm32<8>(acc, H, D, WQ + (size_t)layer * 2048 * D, D, D, row0, col0, lane);
#pragma unroll
                for (int m = 0; m < 2; ++m)
#pragma unroll
                    for (int r = 0; r < 4; ++r) {
                        bf16* rowp = Q2 + (size_t)(row0 + 16 * m + 4 * fq + r) * 2048 + col0 + fr;
#pragma unroll
                        for (int n = 0; n < 2; ++n) rowp[16 * n] = (bf16)f2bf(acc[m][n][r]);
                    }
            }
} }
        }
        }
#endif
        GRID_BAR();

#ifndef SKIP_P8
        { PHASE_PTRS LAYER_PTRS
        for (int rep_ = 0; rep_ < REP_P8; ++rep_) {
{ const int lo__ = lane_id_v(); { const int lane = lo__; const int fr = lane & 15, fq = lane >> 4, tid = wave * 64 + lane;
        {
            LAS float* S = (LAS float*)L;
            const int wr = wave >> 1, wc = wave & 1;
            const int tl = tid >> 2, qd = tid & 3, ph = qd >> 1, hq = qd & 1;
            for (int it = vcu; it < (T_EFF / 128) * PEER_HEADS; it += G) {
                const int tile = it >> 3, h = it & 7;
                {
                    f32x4 acc[2][8];
#pragma unroll
                    for (int m = 0; m < 2; ++m)
#pragma unroll
                        for (int n = 0; n < 8; ++n) acc[m][n] = (f32x4){0.f, 0.f, 0.f, 0.f};
                    const bf16* ap = Q2 + (size_t)(tile * 128 + wr * 32 + fr) * 2048 + h * 256 + wc * 128 + fq * 8;
                    const bf16* bp = KEYS + ((size_t)(layer * 16 + h * 2 + wc) * 128 + fr) * 128 + fq * 8;
                    bf16x8 af[2][4];
#pragma unroll
                    for (int m = 0; m < 2; ++m)
#pragma unroll
                        for (int ks = 0; ks < 4; ++ks) af[m][ks] = *(const GAS bf16x8*)(ap + (size_t)m * 16 * 2048 + ks * 32);
#pragma unroll
                    for (int n = 0; n < 8; ++n) {
                        bf16x8 bfr[4];
#pragma unroll
                        for (int ks = 0; ks < 4; ++ks) bfr[ks] = *(const GAS bf16x8*)(bp + (size_t)n * 16 * 128 + ks * 32);
#pragma unroll
                        for (int ks = 0; ks < 4; ++ks)
#pragma unroll
                            for (int m = 0; m < 2; ++m) acc[m][n] = __builtin_amdgcn_mfma_f32_16x16x32_bf16(af[m][ks], bfr[ks], acc[m][n], 0, 0, 0);
                    }
#pragma unroll
                    for (int m = 0; m < 2; ++m)
#pragma unroll
                        for (int r = 0; r < 4; ++r) {
                            const int row_ = wr * 32 + 16 * m + 4 * fq + r;
#pragma unroll
                            for (int n = 0; n < 8; ++n) { const int key_ = wc * 128 + 16 * n + fr, c_ = key_ >> 2, pc_ = (c_ & 0x30) | ((c_ & 15) ^ (((row_ & 3) << 2) | (c_ >> 4)));
                                S[row_ * 256 + pc_ * 4 + (key_ & 3)] = acc[m][n][r]; }
                        }
                }
                __syncthreads();
                {
                    const int t = tile * 128 + tl;
                    int a[16];
#define LOAD_CHUNK_L(v, ch) _Pragma("unroll") for (int q = 0; q < 4; ++q) { const int c_ = qd * 16 + (ch) * 4 + q, pc_ = (c_ & 0x30) | ((c_ & 15) ^ (((tl & 3) << 2) | qd)); \
                        const f32x4 x = *(const LAS f32x4*)(S + tl * 256 + pc_ * 4); const int kb_ = hq * 64 + (ch) * 16 + 4 * q; \
                        v[4 * q + 0] = (f2ord(x.x) & ~127) | (kb_ + 0); v[4 * q + 1] = (f2ord(x.y) & ~127) | (kb_ + 1); v[4 * q + 2] = (f2ord(x.z) & ~127) | (kb_ + 2); v[4 * q + 3] = (f2ord(x.w) & ~127) | (kb_ + 3); }
                    LOAD_CHUNK_L(a, 0) sort16_desc(a);
#pragma unroll
                    for (int ch = 1; ch < 4; ++ch) { int v[16]; LOAD_CHUNK_L(v, ch) sort16_desc(v); merge16_desc(a, v); }
#undef LOAD_CHUNK_L
                    { int b[16];
#pragma unroll
                      for (int i = 0; i < 16; ++i) b[i] = __builtin_amdgcn_update_dpp(0, a[i], 0xB1, 0xF, 0xF, true);
                      merge16_desc(a, b); }
                    int a0[16], a1[16];
#pragma unroll
                    for (int i = 0; i < 16; ++i) { const int o2 = __builtin_amdgcn_update_dpp(0, a[i], 0x4E, 0xF, 0xF, true); a0[i] = ph ? o2 : a[i]; a1[i] = ph ? a[i] : o2; }
                    {
            float va[16], vb[16];
#pragma unroll
            for (int i = 0; i < 16; ++i) { va[i] = ord2f(a0[i] & ~127); vb[i] = ord2f(a1[i] & ~127); }
            int c[16];
            {
                int v[16];
                v[0] = (f2ord(va[0] + vb[0]) & ~255) | 0;
                v[1] = (f2ord(va[0] + vb[1]) & ~255) | 1;
                v[2] = (f2ord(va[0] + vb[2]) & ~255) | 2;
                v[3] = (f2ord(va[0] + vb[3]) & ~255) | 3;
                v[4] = (f2ord(va[0] + vb[4]) & ~255) | 4;
                v[5] = (f2ord(va[0] + vb[5]) & ~255) | 5;
                v[6] = (f2ord(va[0] + vb[6]) & ~255) | 6;
                v[7] = (f2ord(va[0] + vb[7]) & ~255) | 7;
                v[8] = (f2ord(va[0] + vb[8]) & ~255) | 8;
                v[9] = (f2ord(va[0] + vb[9]) & ~255) | 9;
                v[10] = (f2ord(va[0] + vb[10]) & ~255) | 10;
                v[11] = (f2ord(va[0] + vb[11]) & ~255) | 11;
                v[12] = (f2ord(va[0] + vb[12]) & ~255) | 12;
                v[13] = (f2ord(va[0] + vb[13]) & ~255) | 13;
                v[14] = (f2ord(va[0] + vb[14]) & ~255) | 14;
                v[15] = (f2ord(va[0] + vb[15]) & ~255) | 15;
                sort16_desc(v);
#pragma unroll
                for (int i = 0; i < 16; ++i) c[i] = v[i];
            }
            {
                int v[16];
                v[0] = (f2ord(va[1] + vb[0]) & ~255) | 16;
                v[1] = (f2ord(va[1] + vb[1]) & ~255) | 17;
                v[2] = (f2ord(va[1] + vb[2]) & ~255) | 18;
                v[3] = (f2ord(va[1] + vb[3]) & ~255) | 19;
                v[4] = (f2ord(va[1] + vb[4]) & ~255) | 20;
                v[5] = (f2ord(va[1] + vb[5]) & ~255) | 21;
                v[6] = (f2ord(va[1] + vb[6]) & ~255) | 22;
                v[7] = (f2ord(va[1] + vb[7]) & ~255) | 23;
                v[8] = (f2ord(va[2] + vb[0]) & ~255) | 32;
                v[9] = (f2ord(va[2] + vb[1]) & ~255) | 33;
                v[10] = (f2ord(va[2] + vb[2]) & ~255) | 34;
                v[11] = (f2ord(va[2] + vb[3]) & ~255) | 35;
                v[12] = (f2ord(va[2] + vb[4]) & ~255) | 36;
                v[13] = (f2ord(va[3] + vb[0]) & ~255) | 48;
                v[14] = (f2ord(va[3] + vb[1]) & ~255) | 49;
                v[15] = (f2ord(va[3] + vb[2]) & ~255) | 50;
                sort16_desc(v);
                merge16_desc(c, v);
            }
            {
                int v[16];
                v[0] = (f2ord(va[3] + vb[3]) & ~255) | 51;
                v[1] = (f2ord(va[4] + vb[0]) & ~255) | 64;
                v[2] = (f2ord(va[4] + vb[1]) & ~255) | 65;
                v[3] = (f2ord(va[4] + vb[2]) & ~255) | 66;
                v[4] = (f2ord(va[5] + vb[0]) & ~255) | 80;
                v[5] = (f2ord(va[5] + vb[1]) & ~255) | 81;
                v[6] = (f2ord(va[6] + vb[0]) & ~255) | 96;
                v[7] = (f2ord(va[6] + vb[1]) & ~255) | 97;
                v[8] = (f2ord(va[7] + vb[0]) & ~255) | 112;
                v[9] = (f2ord(va[7] + vb[1]) & ~255) | 113;
                v[10] = (f2ord(va[8] + vb[0]) & ~255) | 128;
                v[11] = (f2ord(va[9] + vb[0]) & ~255) | 144;
                v[12] = (f2ord(va[10] + vb[0]) & ~255) | 160;
                v[13] = (f2ord(va[11] + vb[0]) & ~255) | 176;
                v[14] = (f2ord(va[12] + vb[0]) & ~255) | 192;
                v[15] = (f2ord(va[13] + vb[0]) & ~255) | 208;
                sort16_desc(v);
                merge16_desc(c, v);
            }
            {
                int v[16];
                v[0] = (f2ord(va[14] + vb[0]) & ~255) | 224;
                v[1] = (f2ord(va[15] + vb[0]) & ~255) | 240;
                v[2] = (int)0x80000000;
                v[3] = (int)0x80000000;
                v[4] = (int)0x80000000;
                v[5] = (int)0x80000000;
                v[6] = (int)0x80000000;
                v[7] = (int)0x80000000;
                v[8] = (int)0x80000000;
                v[9] = (int)0x80000000;
                v[10] = (int)0x80000000;
                v[11] = (int)0x80000000;
                v[12] = (int)0x80000000;
                v[13] = (int)0x80000000;
                v[14] = (int)0x80000000;
                v[15] = (int)0x80000000;
                sort16_desc(v);
                merge16_desc(c, v);
            }
            const float smax = ord2f(c[0] & ~255);
            float pe[16]; float psum = 0.f;
#pragma unroll
            for (int k = 0; k < 16; ++k) { pe[k] = __expf(ord2f(c[k] & ~255) - smax); psum += pe[k]; }
            const float ip = 1.0f / psum;
#pragma unroll
            for (int kk = 0; kk < 4; ++kk) {
                const int ck = (qd == 0) ? c[kk] : (qd == 1) ? c[4 + kk] : (qd == 2) ? c[8 + kk] : c[12 + kk];
                const float pk_ = (qd == 0) ? pe[kk] : (qd == 1) ? pe[4 + kk] : (qd == 2) ? pe[8 + kk] : pe[12 + kk];
                const int ij = ck & 255, ii = ij >> 4, jj = ij & 15;
                int e0 = 0, e1 = 0;
#pragma unroll
                for (int q = 0; q < 16; ++q) { e0 = (ii == q) ? (a0[q] & 127) : e0; e1 = (jj == q) ? (a1[q] & 127) : e1; }
                const int e = e0 * PEER_KEYS + e1;
                const float su = SCU[layer * 16384 + e], sv = SCV[layer * 16384 + e];
                const int k = 4 * qd + kk;
                EI[(size_t)t * NSEL + h * 16 + k] = (unsigned)e | (f2bf(su) << 16);
                EG[(size_t)t * NSEL + h * 16 + k] = pk_ * ip * sv;
            }
                    }
                }
                __syncthreads();
            }
        }
} }
        }
        }
#endif
        GRID_BAR();

#ifndef SKIP_P10
#if P10_SLICED
#define P10_CENSUS \
        unsigned myx_, nx_ = 1u, smask_ = 0u; { unsigned cnt_[16]; unsigned* bw_ = (unsigned*)(args.ws + WS_CTL) + CW_BAR; \
            _Pragma("unroll") for (int j = 0; j < 16; ++j) cnt_[j] = (unsigned)__builtin_amdgcn_readfirstlane((int)xb_ld(&bw_[XB_XCNT(j)])); \
            myx_ = xb_xcc_id(); unsigned np_ = 0u; \
            _Pragma("unroll") for (int j = 0; j < 16; ++j) { np_ += (cnt_[j] > 0u) ? 1u : 0u; nx_ = ((unsigned)j == myx_) ? cnt_[j] : nx_; } \
            if (np_ == 0u) np_ = 1u; if (nx_ == 0u) nx_ = 1u; \
            _Pragma("unroll") for (int sl = 0; sl < 8; ++sl) { const unsigned k_ = (unsigned)sl % np_; unsigned seen_ = 0u, srv_ = 0xffu; \
                _Pragma("unroll") for (int j = 0; j < 16; ++j) { if (cnt_[j] > 0u) { srv_ = (seen_ == k_) ? (unsigned)j : srv_; ++seen_; } } \
                smask_ |= (srv_ == myx_) ? (1u << sl) : 0u; } } \
        const int rank_ = (int)__builtin_amdgcn_readfirstlane((int)MISC[12]); const int wstride_ = (int)nx_ * NWAVES; (void)rank_; (void)wstride_;
        { PHASE_PTRS LAYER_PTRS
        { const int ln = lane_id_v(); const int c = ln & 7, tg = ln >> 3;
          P10_CENSUS
          float* PART = (float*)(wsq + WS_PART);
          const unsigned char* U8l = U8 + (size_t)layer * 16384 * D;
          for (int rep_ = 0; rep_ < REP_P10A; ++rep_)
#pragma unroll 1
          for (int sl = 0; sl < 8; ++sl) {
            if (!((smask_ >> sl) & 1u)) continue;
            const int ws0 = (rank_ * NWAVES + wave) * 8, nslot = wstride_ * 8;
            if (ws0 >= T_EFF) continue;
            const int niter = (T_EFF - ws0 + nslot - 1) / nslot, nb = niter * 8;
#define A_TOK(bi) (ws0 + tg + (min((bi), nb - 1) >> 3) * nslot)
#define A_LOAD_PK(pkv, bi) { const GAS v4u* wp_ = (const GAS v4u*)(EI + (size_t)A_TOK(bi) * NSEL + 16 * (min((bi), nb - 1) & 7)); _Pragma("unroll") for (int q = 0; q < 4; ++q) pkv[q] = wp_[q]; }
#define A_ISSUE(rowv, pkv) { _Pragma("unroll") for (int q = 0; q < 16; ++q) rowv[q] = *(const GAS v4u*)(U8l + (size_t)(pkv[q >> 2][q & 3] & 0xffffu) * D + 128 * sl + 16 * c); }
#define A_LOAD_H(hvv, bi) { const int tq_ = A_TOK(bi); _Pragma("unroll") for (int j = 0; j < 4; ++j) hvv[j] = *(const GAS v2u*)(H + (size_t)tq_ * D + 256 * j + 32 * sl + 4 * c); }
#define A_QUANT(hvv) { float hf[16]; float am_ = 0.f; \
                _Pragma("unroll") for (int j = 0; j < 4; ++j) { hf[4 * j] = bf2f(hvv[j].x & 0xffffu); hf[4 * j + 1] = bf2f(hvv[j].x >> 16); hf[4 * j + 2] = bf2f(hvv[j].y & 0xffffu); hf[4 * j + 3] = bf2f(hvv[j].y >> 16); } \
                _Pragma("unroll") for (int i = 0; i < 16; ++i) am_ = fmaxf(am_, fabsf(hf[i])); \
                am_ = fmaxf(am_, dpp_mov<0xB1>(am_)); am_ = fmaxf(am_, dpp_mov<0x4E>(am_)); am_ = fmaxf(am_, dpp_mov<0x141>(am_)); am_ = fmaxf(am_, 1e-20f); \
                sh_ = am_ * (1.0f / 127.0f); const float ih_ = 127.0f / am_; \
                _Pragma("unroll") for (int j = 0; j < 4; ++j) { const int q0 = __float2int_rn(hf[4 * j] * ih_), q1 = __float2int_rn(hf[4 * j + 1] * ih_), q2 = __float2int_rn(hf[4 * j + 2] * ih_), q3 = __float2int_rn(hf[4 * j + 3] * ih_); \
                    hq_[j] = (int)((unsigned)(q0 & 255) | ((unsigned)(q1 & 255) << 8) | ((unsigned)(q2 & 255) << 16) | ((unsigned)q3 << 24)); } }
#define A_COMPUTE(rowv, bi) { int p_[16]; \
                _Pragma("unroll") for (int q = 0; q < 16; ++q) { int ia = 0; _Pragma("unroll") for (int j = 0; j < 4; ++j) ia = __builtin_amdgcn_sdot4((int)rowv[q][j], hq_[j], ia, false); p_[q] = ia; } \
                { const bool up = (c & 4) != 0; _Pragma("unroll") for (int i = 0; i < 8; ++i) { const int send = up ? p_[i] : p_[8 + i], keep = up ? p_[8 + i] : p_[i]; p_[i] = keep + __builtin_amdgcn_update_dpp(0, send, 0x141, 0xF, 0xF, true); } } \
                { const bool up = (c & 2) != 0; _Pragma("unroll") for (int i = 0; i < 4; ++i) { const int send = up ? p_[i] : p_[4 + i], keep = up ? p_[4 + i] : p_[i]; p_[i] = keep + __builtin_amdgcn_update_dpp(0, send, 0x4E, 0xF, 0xF, true); } } \
                { const bool up = (c & 1) != 0; _Pragma("unroll") for (int i = 0; i < 2; ++i) { const int send = up ? p_[i] : p_[2 + i], keep = up ? p_[2 + i] : p_[i]; p_[i] = keep + __builtin_amdgcn_update_dpp(0, send, 0xB1, 0xF, 0xF, true); } } \
                f32x2 r2_; r2_.x = (float)p_[0] * sh_; r2_.y = (float)p_[1] * sh_; \
                *(GAS f32x2*)(PART + ((size_t)sl * T_ALL + (ws0 + tg + ((bi) >> 3) * nslot)) * NSEL + 16 * ((bi) & 7) + 2 * c) = r2_; }
            v4u pkA[4], pkB[4]; v4u rowA[16], rowB[16]; v2u hN[4]; int hq_[4] = {0, 0, 0, 0}; float sh_ = 0.f;
            A_LOAD_PK(pkA, 0) A_LOAD_PK(pkB, 1) A_LOAD_H(hN, 0)
            A_ISSUE(rowA, pkA)
#pragma unroll 1
            for (int bi = 0; bi < nb; bi += 2) {
                if ((bi & 7) == 0) { A_QUANT(hN) A_LOAD_H(hN, bi + 8) }
                A_ISSUE(rowB, pkB) A_LOAD_PK(pkA, bi + 2)
                __builtin_amdgcn_sched_barrier(0);
                A_COMPUTE(rowA, bi)
                __builtin_amdgcn_sched_barrier(0);
                A_ISSUE(rowA, pkA) A_LOAD_PK(pkB, bi + 3)
                __builtin_amdgcn_sched_barrier(0);
                A_COMPUTE(rowB, bi + 1)
                __builtin_amdgcn_sched_barrier(0);
            }
#undef A_TOK
#undef A_LOAD_PK
#undef A_ISSUE
#undef A_LOAD_H
#undef A_QUANT
#undef A_COMPUTE
          }
        } }
        GRID_BAR();
        { PHASE_PTRS LAYER_PTRS
        { const int ln = lane_id_v();
          const float* PART = (const float*)(wsq + WS_PART); float* WGT = (float*)(wsq + WS_WGT);
          for (int rep_ = 0; rep_ < REP_P10B; ++rep_)
          for (int i = vcu * NTHREADS + wave * 64 + ln; i < T_EFF * NSEL; i += NGT) {
              float dsum = 0.f;
#pragma unroll
              for (int sl = 0; sl < 8; ++sl) dsum += PART[(size_t)sl * T_ALL * NSEL + i];
              const unsigned esu = EI[i];
              const float dot = dsum * bf2f(esu >> 16);
              ((unsigned*)WGT)[i] = (esu & 0xffffu) | (f2bf(0.5f * dot * (1.0f + erff(dot * 0.70710678118654752f)) * EG[i]) << 16);
          }
        } }
        GRID_BAR();
        { PHASE_PTRS LAYER_PTRS
        { const int ln = lane_id_v(); const int c = ln & 7, tg = ln >> 3;
          P10_CENSUS
          const unsigned* WGT = (const unsigned*)(wsq + WS_WGT); float* XO = (float*)(wsq + WS_XO);
          const unsigned char* V8l = V8 + (size_t)layer * 16384 * D;
          for (int rep_ = 0; rep_ < REP_P10C; ++rep_)
#pragma unroll 1
          for (int sl = 0; sl < 8; ++sl) {
            if (!((smask_ >> sl) & 1u)) continue;
            const int ws0 = (rank_ * NWAVES + wave) * 8, nslot = wstride_ * 8;
            if (ws0 >= T_EFF) continue;
            const int niter = (T_EFF - ws0 + nslot - 1) / nslot, nb = niter * 8;
#define C_TOK(bi) (ws0 + tg + (min((bi), nb - 1) >> 3) * nslot)
#define C_LOAD_PK(pkv, bi) { const GAS v4u* wp_ = (const GAS v4u*)(WGT + (size_t)C_TOK(bi) * NSEL + 16 * (min((bi), nb - 1) & 7)); _Pragma("unroll") for (int q = 0; q < 4; ++q) pkv[q] = wp_[q]; }
#define C_ISSUE(rowv, wv, pkv) { _Pragma("unroll") for (int q = 0; q < 16; ++q) { const unsigned w_ = pkv[q >> 2][q & 3]; rowv[q] = *(const GAS v4u*)(V8l + (size_t)(w_ & 0xffffu) * D + 128 * sl + 16 * c); } \
                _Pragma("unroll") for (int q = 0; q < 8; ++q) wv[q] = (pkv[q >> 1][(2 * q) & 3] >> 16) | (pkv[q >> 1][(2 * q + 1) & 3] & 0xffff0000u); }
#define C_COMPUTE(rowv, wv) { _Pragma("unroll") for (int q = 0; q < 16; ++q) { const float wq_ = (q & 1) ? __builtin_bit_cast(float, wv[q >> 1] & 0xffff0000u) : bf2f(wv[q >> 1] & 0xffffu); const f32x2 w2_ = (f32x2){wq_, wq_}; _Pragma("unroll") for (int j = 0; j < 4; ++j) { \
                    const f32x2 a = __builtin_amdgcn_cvt_pk_f32_fp8((int)rowv[q][j], false), b = __builtin_amdgcn_cvt_pk_f32_fp8((int)rowv[q][j], true); \
                    f32x2 lo_ = (f32x2){o[j].x, o[j].y}, hi_ = (f32x2){o[j].z, o[j].w}; lo_ = __builtin_elementwise_fma(a, w2_, lo_); hi_ = __builtin_elementwise_fma(b, w2_, hi_); \
                    o[j].x = lo_.x; o[j].y = lo_.y; o[j].z = hi_.x; o[j].w = hi_.y; } \
                    asm volatile("" : "+v"(o[0]), "+v"(o[1]), "+v"(o[2]), "+v"(o[3])); } }
            v4u pkA[4], pkB[4]; unsigned wA[8], wB[8]; v4u rowA[16], rowB[16];
            f32x4 o[4];
#pragma unroll
            for (int j = 0; j < 4; ++j) o[j] = (f32x4){0.f, 0.f, 0.f, 0.f};
            C_LOAD_PK(pkA, 0) C_LOAD_PK(pkB, 1)
            C_ISSUE(rowA, wA, pkA)
#pragma unroll 1
            for (int bi = 0; bi < nb; bi += 2) {
                C_ISSUE(rowB, wB, pkB) C_LOAD_PK(pkA, bi + 2)
                __builtin_amdgcn_sched_barrier(0);
                C_COMPUTE(rowA, wA)
                __builtin_amdgcn_sched_barrier(0);
                C_ISSUE(rowA, wA, pkA) C_LOAD_PK(pkB, bi + 3)
                __builtin_amdgcn_sched_barrier(0);
                C_COMPUTE(rowB, wB)
                __builtin_amdgcn_sched_barrier(0);
                if ((bi & 7) == 6) {
                    const int t = ws0 + tg + (bi >> 3) * nslot;
#pragma unroll
                    for (int j = 0; j < 4; ++j) { *(GAS f32x4*)(XO + (size_t)t * D + 256 * j + 32 * sl + 4 * c) = o[j]; o[j] = (f32x4){0.f, 0.f, 0.f, 0.f}; }
                }
            }
#undef C_TOK
#undef C_LOAD_PK
#undef C_ISSUE
#undef C_COMPUTE
          }
        } }
        GRID_BAR();
#undef P10_CENSUS
#endif
        { PHASE_PTRS LAYER_PTRS
        { const int ln = lane_id_v();
        {
            const unsigned char* U8l = U8 + (size_t)layer * 16384 * D;
            const unsigned char* V8l = V8 + (size_t)layer * 16384 * D;
            for (int rep_ = 0; rep_ < REP_P10; ++rep_)
            for (int t = gw; t < T_EFF; t += NGW) {
#if !P10_SLICED
                f32x4 hv[4];
                { const GAS v2u* hp = (const GAS v2u*)(H + (size_t)t * D) + ln;
#pragma unroll
                  for (int j = 0; j < 4; ++j) { const v2u w = hp[64 * j]; hv[j] = (f32x4){bf2f(w.x & 0xffffu), bf2f(w.x >> 16), bf2f(w.y & 0xffffu), bf2f(w.y >> 16)}; } }
#endif
#if P10_SLICED
                f32x4 o[4];
#pragma unroll
                for (int j = 0; j < 4; ++j) o[j] = *((const GAS f32x4*)((const float*)(wsq + WS_XO) + (size_t)t * D) + ln + 64 * j);
#else
                f32x4 o[4];
#pragma unroll
                for (int j = 0; j < 4; ++j) o[j] = (f32x4){0.f, 0.f, 0.f, 0.f};
#pragma unroll 1
                for (int s0 = 0; s0 < NSEL; s0 += 32) {
                    const unsigned esu = EI[(size_t)t * NSEL + s0 + (ln & 31)]; const float gv = EG[(size_t)t * NSEL + s0 + (ln & 31)];
                    int eidx = (int)(esu & 0xffffu); const float su = bf2f(esu >> 16);
                    float p[32];
                    {
                        v4u rowa[8], rowb[8];
#pragma unroll
                        for (int q = 0; q < 8; ++q) { const int e = __builtin_amdgcn_readlane(eidx, q); rowa[q] = *((const GAS v4u*)(U8l + (size_t)e * D) + ln); }
#pragma unroll
                        for (int g = 0; g < 4; ++g) {
                            if (g < 3) {
#pragma unroll
                                for (int q = 0; q < 8; ++q) { const int e = __builtin_amdgcn_readlane(eidx, (g + 1) * 8 + q);
                                    if (g & 1) rowa[q] = *((const GAS v4u*)(U8l + (size_t)e * D) + ln); else rowb[q] = *((const GAS v4u*)(U8l + (size_t)e * D) + ln); }
                            }
                            __builtin_amdgcn_sched_barrier(0);
#pragma unroll
                            for (int q = 0; q < 8; ++q) {
                                const v4u rw = (g & 1) ? rowb[q] : rowa[q];
                                float dd = 0.f;
#pragma unroll
                                for (int j = 0; j < 4; ++j) {
                                    const f32x2 a = __builtin_amdgcn_cvt_pk_f32_fp8((int)rw[j], false), b = __builtin_amdgcn_cvt_pk_f32_fp8((int)rw[j], true);
                                    dd += (a.x * hv[j].x + a.y * hv[j].y) + (b.x * hv[j].z + b.y * hv[j].w);
                                }
                                asm volatile("" : "+v"(dd));
                                p[g * 8 + q] = dd;
                                __builtin_amdgcn_sched_barrier(0);
                            }
                        }
                    }
#define TR_STEP(W) { const bool up = (ln & W) != 0; _Pragma("unroll") for (int i = 0; i < W; ++i) { const float send = up ? p[i] : p[i + W], keep = up ? p[i + W] : p[i]; p[i] = keep + xshfl_l<W>(send, ln); } }
                    TR_STEP(16) TR_STEP(8) TR_STEP(4) TR_STEP(2) TR_STEP(1)
#undef TR_STEP
                    const float dot = (p[0] + xshfl_l<32>(p[0], ln)) * su;
                    float wgt = 0.5f * dot * (1.0f + erff(dot * 0.70710678118654752f)) * gv;
                    asm volatile("" : "+v"(eidx), "+v"(wgt));
                    {
                        v4u rowa[8], rowb[8];
#pragma unroll
                        for (int q = 0; q < 8; ++q) { const int e = __builtin_amdgcn_readlane(eidx, q); rowa[q] = *((const GAS v4u*)(V8l + (size_t)e * D) + ln); }
#pragma unroll
                        for (int g = 0; g < 4; ++g) {
                            if (g < 3) {
#pragma unroll
                                for (int q = 0; q < 8; ++q) { const int e = __builtin_amdgcn_readlane(eidx, (g + 1) * 8 + q);
                                    if (g & 1) rowa[q] = *((const GAS v4u*)(V8l + (size_t)e * D) + ln); else rowb[q] = *((const GAS v4u*)(V8l + (size_t)e * D) + ln); }
                            }
                            __builtin_amdgcn_sched_barrier(0);
#pragma unroll
                            for (int q = 0; q < 8; ++q) {
                                const v4u rw = (g & 1) ? rowb[q] : rowa[q];
                                const float wq = __builtin_bit_cast(float, __builtin_amdgcn_readlane(__builtin_bit_cast(int, wgt), g * 8 + q));
#pragma unroll
                                for (int j = 0; j < 4; ++j) {
                                    const f32x2 a = __builtin_amdgcn_cvt_pk_f32_fp8((int)rw[j], false), b = __builtin_amdgcn_cvt_pk_f32_fp8((int)rw[j], true);
                                    o[j].x += wq * a.x; o[j].y += wq * a.y; o[j].z += wq * b.x; o[j].w += wq * b.y;
                                }
                                asm volatile("" : "+v"(o[0]), "+v"(o[1]), "+v"(o[2]), "+v"(o[3]));
                                __builtin_amdgcn_sched_barrier(0);
                            }
                        }
                    }
                }
#endif
                const float* gt2 = modl + (size_t)row_modidx(t) * 6 * D + 5 * D;
                GAS f32x4* xr = (GAS f32x4*)(X + (size_t)t * D) + ln;
                f32x4 xn[4]; float ss = 0.f;
#pragma unroll
                for (int j = 0; j < 4; ++j) {
                    xn[j] = xr[64 * j] + *((const GAS f32x4*)gt2 + ln + 64 * j) * o[j];
                    ss += (xn[j].x * xn[j].x + xn[j].y * xn[j].y) + (xn[j].z * xn[j].z + xn[j].w * xn[j].w);
                }
                if (REP_P10 > 1 && rep_ + 1 < REP_P10 && ss != 1234.5678f) continue;
                if (!last) {
#pragma unroll
                    for (int j = 0; j < 4; ++j) xr[64 * j] = xn[j];
                    const float rs1 = 1.0f / sqrtf(wave_sum(ss) * (1.f / D) + NORM_EPS);
                    const float* md1 = modl + (size_t)(3 + row_modidx(t)) * 6 * D;
                    GAS v2u* o8 = (GAS v2u*)(H + (size_t)t * D) + ln;
#pragma unroll
                    for (int j = 0; j < 4; ++j) {
                        const f32x4 g = *((const GAS f32x4*)(IN_[I_G1] + (layer + 1) * D) + ln + 64 * j);
                        const f32x4 sh = *((const GAS f32x4*)(md1 + 0) + ln + 64 * j), sc = *((const GAS f32x4*)(md1 + D) + ln + 64 * j);
                        const f32x4 hh = xn[j] * rs1 * g * (sc + 1.0f) + sh;
                        v2u o; o.x = pk2(hh.x, hh.y); o.y = pk2(hh.z, hh.w); o8[64 * j] = o;
                    }
                } else {
                    const float rs = 1.0f / sqrtf(wave_sum(ss) * (1.f / D) + NORM_EPS);
                    GAS f32x4* op = (GAS f32x4*)(((float*)IN_[22]) + (size_t)t * D) + ln;
#pragma unroll
                    for (int j = 0; j < 4; ++j) op[64 * j] = xn[j] * rs * *((const GAS f32x4*)IN_[I_GFINAL] + ln + 64 * j);
                }
            }
        }
        }
        }
#endif
        if (!last) GRID_BAR();
    }
}

extern "C" void kernel_launch(void* const* d_in, const int* in_sizes, int n_in, void* d_out, int out_size, void* d_ws, size_t ws_size, hipStream_t stream) {
    static int grid = 0;
    if (grid == 0) {
        if (n_in != 22 || out_size != T_LAT * D || ws_size < WS_END) { fprintf(stderr, "kernel_launch: unexpected shapes: n_in %d out %d ws %zu (need %zu)\n", n_in, out_size, ws_size, (size_t)WS_END); grid = -1; return; }
        int dev = 0, cus = 0, per_cu = 0;
        if (hipGetDevice(&dev) != hipSuccess || hipDeviceGetAttribute(&cus, hipDeviceAttributeMultiprocessorCount, dev) != hipSuccess) { fprintf(stderr, "device query failed\n"); grid = -1; return; }
        if (hipFuncSetAttribute((const void*)mega_fwd, hipFuncAttributeMaxDynamicSharedMemorySize, LDS_BYTES) != hipSuccess) { fprintf(stderr, "hipFuncSetAttribute failed\n"); grid = -1; return; }
        if (hipOccupancyMaxActiveBlocksPerMultiprocessor(&per_cu, (const void*)mega_fwd, NTHREADS, LDS_BYTES) != hipSuccess || per_cu < 1) { fprintf(stderr, "occupancy query: %d\n", per_cu); }
        (void)hipGetLastError();
        grid = cus;
    }
    if (grid < 0) return;
    if (hipMemsetAsync((char*)d_ws + WS_CTL, 0, CTL_ZERO_BYTES, stream) != hipSuccess) { fprintf(stderr, "memset failed\n"); return; }
    Args a{};
    for (int i = 0; i < 22; ++i) a.in[i] = (const float*)d_in[i];
    a.out = (float*)d_out; a.ws = (unsigned char*)d_ws;
    hipLaunchKernelGGL(mega_fwd, dim3(grid), dim3(NTHREADS), LDS_BYTES, stream, a);
}
```

```cpp
#include <hip/hip_runtime.h>
#include <cstdio>
#include <cstdint>

#ifndef REP_P0
#define REP_P0 1
#endif
#ifndef REP_P1
#define REP_P1 1
#endif
#ifndef REP_P2
#define REP_P2 1
#endif
#ifndef REP_P3A
#define REP_P3A 1
#endif
#ifndef REP_P3B
#define REP_P3B 1
#endif
#ifndef REP_P4
#define REP_P4 1
#endif
#ifndef REP_P6
#define REP_P6 1
#endif
#ifndef REP_P7
#define REP_P7 1
#endif
#ifndef REP_P8
#define REP_P8 1
#endif
#ifndef REP_P9
#define REP_P9 1
#endif
#ifndef REP_P10
#define REP_P10 1
#endif
#ifndef REP_P10A
#define REP_P10A 1
#endif
#ifndef REP_P10C
#define REP_P10C 1
#endif
#ifndef REP_P10B
#define REP_P10B 1
#endif
#ifndef REP_P0A
#define REP_P0A 1
#endif
#ifndef REP_P0D
#define REP_P0D 1
#endif
#ifndef REP_P0F
#define REP_P0F 1
#endif
#ifndef REP_P3C
#define REP_P3C 1
#endif
#define GAS __attribute__((address_space(1)))
#define LAS __attribute__((address_space(3)))
typedef unsigned short bf16;
typedef float f32x4 __attribute__((ext_vector_type(4)));
typedef short bf16x8 __attribute__((ext_vector_type(8)));
typedef unsigned v4u __attribute__((ext_vector_type(4)));
typedef unsigned v2u __attribute__((ext_vector_type(2)));
typedef float f32x2 __attribute__((ext_vector_type(2)));
typedef GAS unsigned gu32;

constexpr int NWAVES = 8, NTHREADS = 512;
constexpr int D = 1024, BATCH = 2, SEQ = 8192, DEPTH = 2, GRID_W = 64, CTX = 256;
constexpr int T_LAT = BATCH * SEQ;
constexpr int T_ALL = T_LAT + BATCH * CTX;
constexpr int NTOK = SEQ + CTX;
constexpr int IN_W = 6912;
constexpr int PEER_HEADS = 8, PEER_KEYS = 128, PEER_TOPK = 16, NSEL = PEER_HEADS * PEER_TOPK;
constexpr float NORM_EPS = 1e-6f;
constexpr float LOG2E = 1.4426950408889634f;
constexpr float SCL2 = 0.125f * LOG2E;

constexpr size_t MiB = 1u << 20;
constexpr size_t WS_CTL = 0, CTL_ZERO_BYTES = 1 * MiB;
constexpr int CW_BAR = 4096;
constexpr int CW_RANK = 8192;
#ifndef P10_SLICED
#define P10_SLICED 1
#endif
constexpr size_t WS_MOD = 65536;
constexpr size_t WS_COS = 2 * MiB, WS_SIN = 3 * MiB;
constexpr size_t WS_WIN = 4 * MiB;
constexpr size_t WS_WB = 31 * MiB;
constexpr size_t WS_WO = 37 * MiB;
constexpr size_t WS_WQ = 41 * MiB;
constexpr size_t WS_KEYS = 49 * MiB;
constexpr size_t WS_X = 50 * MiB;
constexpr size_t WS_H = 116 * MiB;
constexpr size_t WS_Y = 149 * MiB;
constexpr size_t WS_MG = WS_H;
constexpr size_t WS_U8 = 199 * MiB;
constexpr size_t WS_SCU = 231 * MiB;
constexpr size_t WS_EI = 232 * MiB;
constexpr size_t WS_EG = 241 * MiB;
constexpr size_t WS_P = 250 * MiB;
constexpr size_t SZ_R512 = (size_t)T_ALL * 512 * 2;
constexpr size_t SZ_R128 = (size_t)T_ALL * 128 * 2;
constexpr size_t WS_AQ = WS_P, WS_AK = WS_AQ + SZ_R512, WS_AVT = WS_AK + SZ_R128, WS_BQ = WS_AVT + SZ_R128, WS_BK = WS_BQ + SZ_R512,
                 WS_BVT = WS_BK + SZ_R512, WS_CQ = WS_BVT + SZ_R512, WS_CK = WS_CQ + SZ_R512, WS_CVT = WS_CK + SZ_R512, WS_SG = WS_CVT + SZ_R512;
constexpr size_t WS_Q2 = WS_P;
constexpr size_t WS_SC = WS_P + 66 * MiB;
constexpr size_t WS_PART = WS_P, WS_XO = WS_P + 66 * MiB, WS_WGT = WS_P + 132 * MiB;
constexpr size_t WS_PEND = WS_SG + (size_t)T_ALL * 3072 * 2;
constexpr size_t WS_V8 = 473 * MiB;
constexpr size_t WS_END = WS_V8 + 32 * MiB;
static_assert(WS_SC + (size_t)T_ALL * 2048 * 4 <= WS_PEND && WS_PEND <= WS_V8, "alias map");
static_assert(WS_END <= 512 * MiB, "ws map");

constexpr int LDS_BYTES = 147456;
constexpr int MISC_OFF = 131072 + 320;

__device__ __forceinline__ int lane_id_v() { int l; asm volatile("v_mbcnt_lo_u32_b32 %0, -1, 0\n\tv_mbcnt_hi_u32_b32 %0, -1, %0" : "=v"(l)); return l; }
#define XB_TMO      128
#define XB_XCNT(j)  (256  + 64 * (j))
#define XB_XSUB(j)  (1280 + 64 * (j))
#define XB_XGEN(j)  (2304 + 64 * (j))
#define XB_TOP      3328
#define XB_TOPGEN   3392
#define XCD_BAR_WORDS 3456
#define XB_SPIN_CAP (1u << 24)

__device__ __forceinline__ unsigned xb_ld(unsigned* p)              { return __hip_atomic_load(p, __ATOMIC_RELAXED, __HIP_MEMORY_SCOPE_AGENT); }
__device__ __forceinline__ unsigned xb_add(unsigned* p, unsigned v) { return __hip_atomic_fetch_add(p, v, __ATOMIC_RELAXED, __HIP_MEMORY_SCOPE_AGENT); }
__device__ __forceinline__ unsigned xb_xcc_id() { return (unsigned)__builtin_amdgcn_s_getreg((3 << 11) | 20) & 0xFu; }
#define XB_SPIN(cond, bar) do { unsigned _sp = 0; while (cond) { __builtin_amdgcn_s_sleep(1); \
    if ((++_sp & 255u) == 0u) { if (xb_ld(&(bar)[XB_TMO])) break; if (_sp > XB_SPIN_CAP) { atomicAdd(&(bar)[XB_TMO], 1u); break; } } } } while (0)

struct XcdBarrier { unsigned* bar; unsigned x; volatile LAS unsigned* st; };

__device__ __forceinline__ XcdBarrier xcd_barrier_post(unsigned* bar, volatile LAS unsigned* st) {
    XcdBarrier b; b.bar = bar; b.x = xb_xcc_id(); b.st = st;
    if (threadIdx.x == 0) (void)xb_add(&bar[XB_XCNT(b.x)], 1u);
    return b;
}
__device__ __forceinline__ void xcd_barrier_complete(unsigned* bar, unsigned x, unsigned& nloc, unsigned& nx) {
    const unsigned G = gridDim.x * gridDim.y * gridDim.z;
    unsigned sum, cnt, mine, sp = 0u;
    for (;;) {
        sum = 0u; cnt = 0u; mine = 0u;
#pragma unroll
        for (unsigned j = 0; j < 16; ++j) { const unsigned c = xb_ld(&bar[XB_XCNT(j)]); sum += c; cnt += (c > 0u) ? 1u : 0u; mine = (j == x) ? c : mine; }
        if (sum == G) break;
        __builtin_amdgcn_s_sleep(1);
        if ((++sp & 255u) == 0u) { if (xb_ld(&bar[XB_TMO])) break; if (sp > XB_SPIN_CAP) { atomicAdd(&bar[XB_TMO], 1u); break; } }
    }
    nloc = mine > 0u ? mine : 1u; nx = cnt > 0u ? cnt : 1u;
}
__device__ __forceinline__ void xcd_barrier(const XcdBarrier& b, bool t0) {
    asm volatile("s_waitcnt vmcnt(0)" ::: "memory");
    __syncthreads();
    if (t0) {
        unsigned* bar = b.bar;
        __builtin_amdgcn_s_waitcnt(0);
        unsigned nloc = b.st[0], nx = b.st[1];
        if (nloc == 0u) { xcd_barrier_complete(bar, b.x, nloc, nx); b.st[0] = nloc; b.st[1] = nx; }
        const unsigned old = xb_add(&bar[XB_XSUB(b.x)], 1u);
        const unsigned gen = old / nloc;
        if (old + 1u == (gen + 1u) * nloc) {
            __builtin_amdgcn_fence(__ATOMIC_RELEASE, "agent");
            asm volatile("s_waitcnt vmcnt(0)" ::: "memory");
            const unsigned og = xb_add(&bar[XB_TOP], 1u);
            const unsigned tg = og / nx;
            if (og + 1u == (tg + 1u) * nx) xb_add(&bar[XB_TOPGEN], 1u);
            else XB_SPIN(xb_ld(&bar[XB_TOPGEN]) == tg, bar);
            __builtin_amdgcn_fence(__ATOMIC_ACQUIRE, "agent");
            xb_add(&bar[XB_XGEN(b.x)], 1u);
            asm volatile("s_waitcnt vmcnt(0)" ::: "memory");
        } else {
            XB_SPIN(xb_ld(&bar[XB_XGEN(b.x)]) == gen, bar);
            __builtin_amdgcn_fence(__ATOMIC_ACQUIRE, "agent");
            asm volatile("s_waitcnt vmcnt(0)" ::: "memory");
        }
    }
    __syncthreads();
}

__device__ __forceinline__ unsigned f2bf(float f) { unsigned u = __builtin_bit_cast(unsigned, f); return (u + 0x7fffu + ((u >> 16) & 1u)) >> 16; }
__device__ __forceinline__ unsigned pk2(float lo, float hi) { return f2bf(lo) | (f2bf(hi) << 16); }
__device__ __forceinline__ float bf2f(unsigned h) { return __builtin_bit_cast(float, h << 16); }
template <int CTRL> __device__ __forceinline__ float dpp_mov(float v) { return __builtin_bit_cast(float, __builtin_amdgcn_update_dpp(0, __builtin_bit_cast(int, v), CTRL, 0xF, 0xF, true)); }
__device__ __forceinline__ float sum8_dpp(float v) { v += dpp_mov<0xB1>(v); v += dpp_mov<0x4E>(v); v += dpp_mov<0x141>(v); return v; }
template <int K> __device__ __forceinline__ float xshfl_l(float v, int lane) { return __builtin_bit_cast(float, __builtin_amdgcn_ds_bpermute((lane ^ K) << 2, __builtin_bit_cast(int, v))); }
template <int K> __device__ __forceinline__ float xshfl(float v) { return xshfl_l<K>(v, lane_id_v()); }
__device__ __forceinline__ float xadd32(float v) { return v + xshfl_l<32>(v, lane_id_v()); }
__device__ __forceinline__ float xmax32(float v) { return fmaxf(v, xshfl_l<32>(v, lane_id_v())); }
__device__ __forceinline__ float wave_sum(float v) { const int l = lane_id_v(); v += xshfl_l<1>(v, l); v += xshfl_l<2>(v, l); v += xshfl_l<4>(v, l); v += xshfl_l<8>(v, l); v += xshfl_l<16>(v, l); v += xshfl_l<32>(v, l); return v; }
__device__ __forceinline__ float wave_max(float v) { const int l = lane_id_v(); v = fmaxf(v, xshfl_l<1>(v, l)); v = fmaxf(v, xshfl_l<2>(v, l)); v = fmaxf(v, xshfl_l<4>(v, l)); v = fmaxf(v, xshfl_l<8>(v, l)); v = fmaxf(v, xshfl_l<16>(v, l)); v = fmaxf(v, xshfl_l<32>(v, l)); return v; }


__device__ __forceinline__ float sigmoidf_(float x) { return 1.0f / (1.0f + __expf(-x)); }
__device__ __forceinline__ float sigmoid_fast(float x) { return __builtin_amdgcn_rcpf(1.0f + __builtin_amdgcn_exp2f(-LOG2E * x)); }
__device__ __forceinline__ int row_modidx(int r) { return r < T_LAT ? (r >> 13) : 2; }
__device__ __forceinline__ int row_batch(int r) { return r < T_LAT ? (r >> 13) : ((r - T_LAT) >> 8); }
__device__ __forceinline__ int row_tok(int r) { return r < T_LAT ? (r & (SEQ - 1)) : SEQ + ((r - T_LAT) & (CTX - 1)); }

__device__ __forceinline__ const float* xin_row(const float* x, const float* ctx, int r) { return r < T_LAT ? x + (size_t)r * D : ctx + (size_t)(r - T_LAT) * D; }
template <class Prep, class Row>
__device__ __forceinline__ void wave_row_blocks(int T_rows, int gw, int NGW, Prep prep, Row row) {
    for (int r0 = gw * 8; r0 < T_LAT; r0 += NGW * 8) {
        prep(r0 >> 13);
#pragma unroll 2
        for (int k = 0; k < 8; ++k) row(r0 + k);
    }
    if (T_rows > T_LAT) for (int r = T_LAT + gw; r < T_rows; r += NGW) { prep(2); row(r); }
}
struct Args { const float* in[22]; float* out; unsigned char* ws; };
enum { I_X = 0, I_C, I_CTX, I_CCTX, I_WMOD, I_BMOD, I_G1, I_G2, I_WIN, I_SINK, I_RPB, I_LAMBDA, I_SUBLN, I_WBA, I_WBB, I_WBC, I_WOUT, I_PWQ, I_PKEYS, I_PU, I_PV, I_GFINAL };

__device__ __forceinline__ int rope_perm(int c) {
    if (c < 640 || (c >= 2304 && c < 3328)) { const int w = c & 63; return (c & ~63) + 2 * (w & 31) + (w >> 5); }
    return c;
}
template <bool PERM = false>
__device__ __forceinline__ void p0_transpose_item(const float* W, int K, int N, bf16* WT, LAS float* scr, int item, int lane) {
    const int nblk = N / 32, kb = item / nblk, nb = item % nblk, k0 = 64 * kb, n0 = 32 * nb;
#pragma unroll 8
    for (int i = 0; i < 32; ++i) { const int kk = 2 * i + (lane >> 5); scr[kk * 33 + (lane & 31)] = W[(size_t)(k0 + kk) * N + n0 + (lane & 31)]; }
    asm volatile("s_waitcnt lgkmcnt(0)" ::: "memory");
    const int c = lane & 7;
#pragma unroll
    for (int j = 0; j < 4; ++j) { const int n = (lane >> 3) + 8 * j; const LAS float* s = scr + (8 * c) * 33 + n;
        v4u o; o.x = pk2(s[0 * 33], s[1 * 33]); o.y = pk2(s[2 * 33], s[3 * 33]); o.z = pk2(s[4 * 33], s[5 * 33]); o.w = pk2(s[6 * 33], s[7 * 33]);
        const int nout = PERM ? rope_perm(n0 + n) : (n0 + n);
        *(GAS v4u*)(WT + (size_t)nout * K + k0 + 8 * c) = o; }
    asm volatile("s_waitcnt lgkmcnt(0)" ::: "memory");
}

template <int UNR = 2, int NN = 4>
__device__ __forceinline__ void sgemm_tile(f32x4 (&acc)[4][NN], const bf16* A, int lda, const bf16* Bt, int ldb, int K, int row0, int col0, int lane) {
    const int fr = lane & 15, fq = lane >> 4;
    const bf16* ap = A + (size_t)(row0 + fr) * lda + fq * 8;
    const bf16* bp = Bt + (size_t)(col0 + fr) * ldb + fq * 8;
#pragma unroll UNR
    for (int k = 0; k < K; k += 32) {
        bf16x8 a[4], b[NN];
#pragma unroll
        for (int m = 0; m < 4; ++m) a[m] = *(const GAS bf16x8*)(ap + (size_t)m * 16 * lda + k);
#pragma unroll
        for (int n = 0; n < NN; ++n) b[n] = *(const GAS bf16x8*)(bp + (size_t)n * 16 * ldb + k);
#pragma unroll
        for (int m = 0; m < 4; ++m)
#pragma unroll
            for (int n = 0; n < NN; ++n) acc[m][n] = __builtin_amdgcn_mfma_f32_16x16x32_bf16(a[m], b[n], acc[m][n], 0, 0, 0);
    }
}
template <int UNR>
__device__ __forceinline__ void sgemm32(f32x4 (&acc)[2][2], const bf16* A, int lda, const bf16* Bt, int ldb, int K, int row0, int col0, int lane) {
    const int fr = lane & 15, fq = lane >> 4;
    const bf16* ap = A + (size_t)(row0 + fr) * lda + fq * 8;
    const bf16* bp = Bt + (size_t)(col0 + fr) * ldb + fq * 8;
#pragma unroll 1
    for (int k0 = 0; k0 < K; k0 += 32 * UNR) {
        bf16x8 a[UNR][2], b[UNR][2];
#pragma unroll
        for (int u = 0; u < UNR; ++u)
#pragma unroll
            for (int m = 0; m < 2; ++m) { a[u][m] = *(const GAS bf16x8*)(ap + (size_t)m * 16 * lda + k0 + 32 * u); b[u][m] = *(const GAS bf16x8*)(bp + (size_t)m * 16 * ldb + k0 + 32 * u); }
#pragma unroll
        for (int u = 0; u < UNR; ++u)
#pragma unroll
            for (int m = 0; m < 2; ++m)
#pragma unroll
                for (int n = 0; n < 2; ++n) acc[m][n] = __builtin_amdgcn_mfma_f32_16x16x32_bf16(a[u][m], b[u][n], acc[m][n], 0, 0, 0);
    }
}
__device__ __forceinline__ void zero_acc22(f32x4 (&acc)[2][2]) { acc[0][0] = acc[0][1] = acc[1][0] = acc[1][1] = (f32x4){0.f, 0.f, 0.f, 0.f}; }
template <int NN>
__device__ __forceinline__ void zero_acc(f32x4 (&acc)[4][NN]) {
#pragma unroll
    for (int m = 0; m < 4; ++m)
#pragma unroll
        for (int n = 0; n < NN; ++n) acc[m][n] = (f32x4){0.f, 0.f, 0.f, 0.f};
}

__device__ __forceinline__ int f2ord(float f) { const int b = __builtin_bit_cast(int, f); return b ^ ((b >> 31) & 0x7fffffff); }
__device__ __forceinline__ float ord2f(int o) { const int b = o ^ ((o >> 31) & 0x7fffffff); return __builtin_bit_cast(float, b); }
__device__ __forceinline__ void top16_insert(int (&top)[16], int key) {
#pragma unroll
    for (int i = 0; i < 16; ++i) { const int hi = max(top[i], key); key = min(top[i], key); top[i] = hi; }
}
#define CE(a, b) { const int t_ = max(a, b); b = min(a, b); a = t_; }
__device__ __forceinline__ void sort16_desc(int (&v)[16]) { CE(v[0], v[1]); CE(v[3], v[2]); CE(v[4], v[5]); CE(v[7], v[6]); CE(v[8], v[9]); CE(v[11], v[10]); CE(v[12], v[13]); CE(v[15], v[14]); CE(v[0], v[2]); CE(v[1], v[3]); CE(v[6], v[4]); CE(v[7], v[5]); CE(v[8], v[10]); CE(v[9], v[11]); CE(v[14], v[12]); CE(v[15], v[13]); CE(v[0], v[1]); CE(v[2], v[3]); CE(v[5], v[4]); CE(v[7], v[6]); CE(v[8], v[9]); CE(v[10], v[11]); CE(v[13], v[12]); CE(v[15], v[14]); CE(v[0], v[4]); CE(v[1], v[5]); CE(v[2], v[6]); CE(v[3], v[7]); CE(v[12], v[8]); CE(v[13], v[9]); CE(v[14], v[10]); CE(v[15], v[11]); CE(v[0], v[2]); CE(v[1], v[3]); CE(v[4], v[6]); CE(v[5], v[7]); CE(v[10], v[8]); CE(v[11], v[9]); CE(v[14], v[12]); CE(v[15], v[13]); CE(v[0], v[1]); CE(v[2], v[3]); CE(v[4], v[5]); CE(v[6], v[7]); CE(v[9], v[8]); CE(v[11], v[10]); CE(v[13], v[12]); CE(v[15], v[14]); CE(v[0], v[8]); CE(v[1], v[9]); CE(v[2], v[10]); CE(v[3], v[11]); CE(v[4], v[12]); CE(v[5], v[13]); CE(v[6], v[14]); CE(v[7], v[15]); CE(v[0], v[4]); CE(v[1], v[5]); CE(v[2], v[6]); CE(v[3], v[7]); CE(v[8], v[12]); CE(v[9], v[13]); CE(v[10], v[14]); CE(v[11], v[15]); CE(v[0], v[2]); CE(v[1], v[3]); CE(v[4], v[6]); CE(v[5], v[7]); CE(v[8], v[10]); CE(v[9], v[11]); CE(v[12], v[14]); CE(v[13], v[15]); CE(v[0], v[1]); CE(v[2], v[3]); CE(v[4], v[5]); CE(v[6], v[7]); CE(v[8], v[9]); CE(v[10], v[11]); CE(v[12], v[13]); CE(v[14], v[15]); }
__device__ __forceinline__ void merge16_desc(int (&a)[16], const int (&b)[16]) {
#pragma unroll
    for (int i = 0; i < 16; ++i) a[i] = max(a[i], b[15 - i]);
    CE(a[0], a[8]); CE(a[1], a[9]); CE(a[2], a[10]); CE(a[3], a[11]); CE(a[4], a[12]); CE(a[5], a[13]); CE(a[6], a[14]); CE(a[7], a[15]); CE(a[0], a[4]); CE(a[1], a[5]); CE(a[2], a[6]); CE(a[3], a[7]); CE(a[8], a[12]); CE(a[9], a[13]); CE(a[10], a[14]); CE(a[11], a[15]); CE(a[0], a[2]); CE(a[1], a[3]); CE(a[4], a[6]); CE(a[5], a[7]); CE(a[8], a[10]); CE(a[9], a[11]); CE(a[12], a[14]); CE(a[13], a[15]); CE(a[0], a[1]); CE(a[2], a[3]); CE(a[4], a[5]); CE(a[6], a[7]); CE(a[8], a[9]); CE(a[10], a[11]); CE(a[12], a[13]); CE(a[14], a[15]); }
#undef CE


typedef float f32x16 __attribute__((ext_vector_type(16)));
typedef short s16x4 __attribute__((ext_vector_type(4)));
typedef __bf16 bf16x2_t __attribute__((ext_vector_type(2)));
__device__ __forceinline__ unsigned cvtpk(float lo, float hi) { f32x2 v = {lo, hi}; bf16x2_t b = __builtin_convertvector(v, bf16x2_t); return __builtin_bit_cast(unsigned, b); }
constexpr int CK_PITCH = 144, CV_PITCH = 320;
constexpr int CK_SZ = 64 * CK_PITCH, CV_SZ = 64 * CV_PITCH;
constexpr float C_THR_RAW = 8.0f / SCL2;

template <int NDV, class RowFn, class UseFn, class ElemFn>
__device__ __forceinline__ void attn64_pass(f32x16 (&o)[NDV], float& mrun, float& lpart, const bf16x8 (&qf)[4], const bf16* kg, int kpitch, const bf16* vg, int vpitch,
                                            int ntiles, RowFn tile_row, UseFn use_tile, ElemFn elem, LAS unsigned char* L, int lane, int tid) {
    constexpr int VP = NDV * 64 + 64, VSZ = 64 * VP, NVP = NDV / 2;
    const int r32 = lane & 31, hi = lane >> 5;
    const int krow_s = tid >> 3, kch_s = tid & 7;
    const int vrow_s = (NDV == 2) ? (tid >> 3) : (tid >> 4), vch_s = (NDV == 2) ? (tid & 7) : (tid & 15);
    LAS unsigned char* Kb0 = L; LAS unsigned char* Vb0 = L + 2 * CK_SZ;
    __syncthreads();
    {
        const int tr = tile_row(0);
        const v4u kr = *(const GAS v4u*)(kg + (size_t)tr * kpitch);
        *(LAS v4u*)(Kb0 + krow_s * CK_PITCH + kch_s * 16) = kr;
#pragma unroll
        for (int i = 0; i < NVP; ++i) { const v4u v = *(const GAS v4u*)(vg + (size_t)(tr + 32 * i) * vpitch); *(LAS v4u*)(Vb0 + (vrow_s + 32 * i) * VP + vch_s * 16) = v; }
    }
    v4u kr, vr[NVP];
    { const int tr = tile_row(ntiles > 1 ? 1 : 0); kr = *(const GAS v4u*)(kg + (size_t)tr * kpitch);
#pragma unroll
      for (int i = 0; i < NVP; ++i) vr[i] = *(const GAS v4u*)(vg + (size_t)(tr + 32 * i) * vpitch); }
    __syncthreads();
#pragma unroll 1
    for (int j = 0; j < ntiles; ++j) {
        const int cur = j & 1;
        const LAS unsigned char* Kb = Kb0 + cur * CK_SZ; const LAS unsigned char* Vb = Vb0 + cur * VSZ;
        const bool more = (j + 1 < ntiles);
        v4u kr2, vr2[NVP];
        { const int tr = tile_row(j + 2 < ntiles ? j + 2 : ntiles - 1); kr2 = *(const GAS v4u*)(kg + (size_t)tr * kpitch);
#pragma unroll
            for (int i = 0; i < NVP; ++i) vr2[i] = *(const GAS v4u*)(vg + (size_t)(tr + 32 * i) * vpitch); }
        if (use_tile(j)) {
            f32x16 st[2];
#pragma unroll
            for (int kb = 0; kb < 2; ++kb) {
#pragma unroll
                for (int r = 0; r < 16; ++r) st[kb][r] = 0.f;
#pragma unroll
                for (int ks = 0; ks < 4; ++ks) {
                    const bf16x8 kf = *(const LAS bf16x8*)(Kb + (kb * 32 + r32) * CK_PITCH + ks * 32 + hi * 16);
                    st[kb] = __builtin_amdgcn_mfma_f32_32x32x16_bf16(kf, qf[ks], st[kb], 0, 0, 0);
                }
            }
            elem(st, j);
            float mx = st[0][0];
#pragma unroll
            for (int r = 1; r < 16; ++r) mx = fmaxf(mx, st[0][r]);
#pragma unroll
            for (int r = 0; r < 16; ++r) mx = fmaxf(mx, st[1][r]);
            mx = xmax32(mx);
            if (__builtin_amdgcn_ballot_w64(mx > mrun + C_THR_RAW) != 0ull) {
                const float mn = fmaxf(mrun, mx);
                const float alpha = __builtin_amdgcn_exp2f((mrun - mn) * SCL2);
#pragma unroll
                for (int d = 0; d < NDV; ++d)
#pragma unroll
                    for (int r = 0; r < 16; ++r) o[d][r] *= alpha;
                lpart *= alpha; mrun = mn;
            }
            const float nmc = -mrun * SCL2;
            float ls = 0.f;
#pragma unroll
            for (int kb = 0; kb < 2; ++kb)
#pragma unroll
                for (int r = 0; r < 16; ++r) { const float p = __builtin_amdgcn_exp2f(fmaf(st[kb][r], SCL2, nmc)); st[kb][r] = p; ls += p; }
            lpart += ls;
            const int q4 = (lane & 15) >> 2, p4 = lane & 3, grp = (lane >> 4) & 1;
            const LAS unsigned char* vbase = Vb + (4 * hi + q4) * VP + (16 * grp + 4 * p4) * 2;
#pragma unroll
            for (int kb = 0; kb < 2; ++kb)
#pragma unroll
                for (int ss = 0; ss < 2; ++ss) {
                    v4u pw;
#pragma unroll
                    for (int i2 = 0; i2 < 4; ++i2) pw[i2] = cvtpk(st[kb][8 * ss + 2 * i2], st[kb][8 * ss + 2 * i2 + 1]);
                    const bf16x8 pb = __builtin_bit_cast(bf16x8, pw);
#pragma unroll
                    for (int d = 0; d < NDV; ++d) {
                        const LAS unsigned char* va = vbase + (kb * 32 + 16 * ss) * VP + d * 64;
                        const s16x4 lo = __builtin_bit_cast(s16x4, __builtin_amdgcn_ds_read_tr16_b64_v4i16((LAS s16x4*)va));
                        const s16x4 hh = __builtin_bit_cast(s16x4, __builtin_amdgcn_ds_read_tr16_b64_v4i16((LAS s16x4*)(va + 8 * VP)));
                        const bf16x8 vf = __builtin_shufflevector(lo, hh, 0, 1, 2, 3, 4, 5, 6, 7);
                        o[d] = __builtin_amdgcn_mfma_f32_32x32x16_bf16(vf, pb, o[d], 0, 0, 0);
                    }
                }
        }
        if (more) {
            LAS unsigned char* Kn = Kb0 + (cur ^ 1) * CK_SZ; LAS unsigned char* Vn = Vb0 + (cur ^ 1) * VSZ;
            *(LAS v4u*)(Kn + krow_s * CK_PITCH + kch_s * 16) = kr;
#pragma unroll
            for (int i = 0; i < NVP; ++i) *(LAS v4u*)(Vn + (vrow_s + 32 * i) * VP + vch_s * 16) = vr[i];
        }
        kr = kr2;
#pragma unroll
        for (int i = 0; i < NVP; ++i) vr[i] = vr2[i];
        __syncthreads();
    }
}
__device__ __forceinline__ void attn64_store(const f32x16 (&o)[2], float inv, bf16* yrow, int hi) {
#pragma unroll
    for (int d = 0; d < 2; ++d)
#pragma unroll
        for (int g4 = 0; g4 < 4; ++g4) {
            v2u w; w.x = cvtpk(o[d][4 * g4] * inv, o[d][4 * g4 + 1] * inv); w.y = cvtpk(o[d][4 * g4 + 2] * inv, o[d][4 * g4 + 3] * inv);
            *(GAS v2u*)(yrow + d * 32 + 8 * g4 + 4 * hi) = w;
        }
}

namespace pg8 {
typedef unsigned short bf16_t;
constexpr int BM = 256, BK = 64, HALF = 128, HTB = HALF * BK * 2, STAGE_BYTES = 8 * HTB, NXCD = 8, WGM = 8;
__host__ __device__ __forceinline__ int lds_byte(int r, int c) { const int st = (r >> 4) * 2 + (c >> 5), rr = r & 15, cc = c & 31, ob = rr * 64 + cc * 2; return st * 1024 + (ob ^ (((ob >> 9) & 1) << 5)); }
__host__ __device__ __forceinline__ void stage_rc(int b, int& R, int& C) { const int st = b / 1024, sb = b % 1024, swz = sb ^ (((sb >> 9) & 1) << 5); R = (st >> 1) * 16 + swz / 64; C = (st & 1) * 32 + (swz % 64) / 2; }
__host__ __device__ __forceinline__ int perm32(int rho) { const int n = rho >> 4, i = rho & 15; return 8 * (i >> 2) + 4 * n + (i & 3); }
struct Unit { int pm, pn, seg; };
struct Gemm { const bf16_t* A; const bf16_t* Bt; int lda, ldb, K; size_t a_seg, b_seg; };
struct TileOrder {
    int nM, nN, nwg, G, c;
    __device__ void init(int M, int N, int G_, int c_) { nM = M / BM; nN = N / BM; nwg = nM * nN; G = G_; c = c_; }
    __device__ bool tile(int i, int& pm, int& pn) const {
        const long L = (long)i * G + c; if (L >= nwg) return false;
        int wgid = (int)L; { const int q = nwg / NXCD, r = nwg % NXCD, xcd = wgid % NXCD, off = wgid / NXCD; wgid = (xcd < r ? xcd * (q + 1) : r * (q + 1) + (xcd - r) * q) + off; }
        const int nig = WGM * nN, gid = wgid / nig, fm = gid * WGM, gsz = (nM - fm) < WGM ? (nM - fm) : WGM;
        pm = fm + ((wgid % nig) % gsz); pn = (wgid % nig) / gsz; return true;
    }
};
template <int NSEG> struct SegOrder {
    TileOrder T;
    __device__ bool next(int i, Unit& u) const { u.seg = i % NSEG; return T.tile(i / NSEG, u.pm, u.pn); }
};
template <class Epi, class Sched>
__device__ __forceinline__ void gemm_phase(LAS unsigned char* lds, const Gemm g, const Sched& S, const Epi& E, int wid) {
    const int lane = lane_id_v(), tid = wid * 64 + lane,
              wr = wid >> 2, wc = wid & 3, fr = lane & 15, fq = lane >> 4;
    const int K = g.K, nt = K / BK;
    unsigned voffA[2], voffB[2];
#pragma unroll
    for (int i = 0; i < 2; ++i) { int R, C; stage_rc(tid * 16 + i * 8192, R, C); const int Rb = (R & ~31) + perm32(R & 31);
        voffA[i] = (unsigned)(R * g.lda + C) * 2u; voffB[i] = (unsigned)(Rb * g.ldb + C) * 2u; }
    const size_t kstep = (size_t)(BK * 2);
    const size_t hstepA = (size_t)HALF * g.lda * 2, hstepB = (size_t)HALF * g.ldb * 2;
    const unsigned ldsw = (unsigned)wid * 1024u;
    const int aoff = lds_byte(wr * 64 + fr, fq * 8), boff = lds_byte(wc * 32 + fr, fq * 8);
#define PG8_SA(b, h) (((b) * 2 + (h)) * HTB)
#define PG8_SB(b, h) ((4 + (b) * 2 + (h)) * HTB)
#define PG8_STAGE(bufoff, gbase, voff) do { _Pragma("unroll") for (int _i = 0; _i < 2; ++_i) \
        __builtin_amdgcn_global_load_lds((const unsigned*)((const char*)(gbase) + (voff)[_i]), (LAS unsigned*)(lds + (bufoff) + ldsw + _i * 8192), 16, 0, 0); } while (0)
#define PG8_LDA(dst, b, h) do { _Pragma("unroll") for (int m = 0; m < 4; ++m) _Pragma("unroll") for (int k = 0; k < 2; ++k) dst[m][k] = *(const LAS bf16x8*)(lds + PG8_SA(b, h) + aoff + m * 2048 + k * 1024); } while (0)
#define PG8_LDB(dst, b, h) do { _Pragma("unroll") for (int n = 0; n < 2; ++n) _Pragma("unroll") for (int k = 0; k < 2; ++k) dst[n][k] = *(const LAS bf16x8*)(lds + PG8_SB(b, h) + boff + n * 2048 + k * 1024); } while (0)
#define PG8_MMA(ai, bj, At, Bt) do { __builtin_amdgcn_s_setprio(1); _Pragma("unroll") for (int m = 0; m < 4; ++m) _Pragma("unroll") for (int n = 0; n < 2; ++n) _Pragma("unroll") for (int k = 0; k < 2; ++k) \
        acc[ai][bj][m][n] = __builtin_amdgcn_mfma_f32_16x16x32_bf16(Bt[n][k], At[m][k], acc[ai][bj][m][n], 0, 0, 0); __builtin_amdgcn_s_setprio(0); } while (0)
#define PG8_WAIT_V(n) asm volatile("s_waitcnt vmcnt(" #n ")" ::: "memory")
#define PG8_WAIT_L(n) asm volatile("s_waitcnt lgkmcnt(" #n ")" ::: "memory")
#define PG8_BAR __builtin_amdgcn_s_barrier()
#define PG8_SCHED __builtin_amdgcn_sched_barrier(0)
#define PG8_ABASE(u) ((const char*)g.A + ((size_t)(u).seg * g.a_seg + (size_t)(u).pm * BM * g.lda) * 2)
#define PG8_BBASE(u) ((const char*)g.Bt + ((size_t)(u).seg * g.b_seg + (size_t)(u).pn * BM * g.ldb) * 2)
    Unit cur, nxt; int ui = 0;
    if (!S.next(0, cur)) return;
    f32x4 acc[2][2][4][2];
#pragma unroll
    for (int a = 0; a < 2; ++a)
#pragma unroll
        for (int b = 0; b < 2; ++b)
#pragma unroll
            for (int m = 0; m < 4; ++m)
#pragma unroll
                for (int n = 0; n < 2; ++n) acc[a][b][m][n] = (f32x4){0.f, 0.f, 0.f, 0.f};
    bf16x8 At[4][2], B0[2][2], B1[2][2];
    const char* cA = PG8_ABASE(cur); const char* cB = PG8_BBASE(cur);
    PG8_STAGE(PG8_SB(0, 0), cB, voffB); PG8_STAGE(PG8_SB(0, 1), cB + hstepB, voffB); PG8_STAGE(PG8_SA(0, 0), cA, voffA); PG8_STAGE(PG8_SA(0, 1), cA + hstepA, voffA);
    if (wr == 1) PG8_BAR;
    PG8_WAIT_V(2); PG8_BAR;
    PG8_STAGE(PG8_SB(1, 0), cB + kstep, voffB); PG8_STAGE(PG8_SA(1, 0), cA + kstep, voffA); PG8_STAGE(PG8_SB(1, 1), cB + hstepB + kstep, voffB);
    PG8_WAIT_V(6); PG8_BAR;
    for (;;) {
        const bool has_next = S.next(ui + 1, nxt);
        const char* nA = has_next ? PG8_ABASE(nxt) : cA; const char* nB = has_next ? PG8_BBASE(nxt) : cB;
        for (int t = 0; t < nt; t += 2) {
            const bool lastk = (t == nt - 2);
            const char* a1 = cA + (size_t)(t + 1) * kstep;
            const char* a2 = lastk ? nA : cA + (size_t)(t + 2) * kstep; const char* b2 = lastk ? nB : cB + (size_t)(t + 2) * kstep;
            const char* a3 = a2 + kstep; const char* b3 = b2 + kstep;
            PG8_LDB(B0, 0, 0); PG8_LDB(B1, 0, 1); PG8_SCHED; PG8_LDA(At, 0, 0); PG8_STAGE(PG8_SA(1, 1), a1 + hstepA, voffA);
            PG8_WAIT_V(8); PG8_WAIT_L(0); PG8_BAR; PG8_MMA(0, 0, At, B0); PG8_MMA(0, 1, At, B1); PG8_BAR; PG8_SCHED;
            PG8_LDA(At, 0, 1); PG8_STAGE(PG8_SB(0, 0), b2, voffB); PG8_STAGE(PG8_SB(0, 1), b2 + hstepB, voffB); PG8_STAGE(PG8_SA(0, 0), a2, voffA);
            PG8_WAIT_V(8); PG8_WAIT_L(0); PG8_BAR; PG8_MMA(1, 0, At, B0); PG8_MMA(1, 1, At, B1); PG8_BAR; PG8_SCHED;
            PG8_LDB(B0, 1, 0); PG8_LDB(B1, 1, 1); PG8_SCHED; PG8_LDA(At, 1, 0); PG8_STAGE(PG8_SA(0, 1), a2 + hstepA, voffA);
            PG8_WAIT_V(8); PG8_WAIT_L(0); PG8_BAR; PG8_MMA(0, 0, At, B0); PG8_MMA(0, 1, At, B1); PG8_BAR; PG8_SCHED;
            PG8_LDA(At, 1, 1); PG8_STAGE(PG8_SB(1, 0), b3, voffB); PG8_STAGE(PG8_SB(1, 1), b3 + hstepB, voffB); PG8_STAGE(PG8_SA(1, 0), a3, voffA);
            PG8_WAIT_V(8); PG8_WAIT_L(0); PG8_BAR; PG8_MMA(1, 0, At, B0); PG8_MMA(1, 1, At, B1); PG8_BAR; PG8_SCHED;
        }
        if (wr == 0) PG8_BAR;
        E(acc, cur, wr, wc, fr, fq);
        if (!has_next) break;
#pragma unroll
        for (int a = 0; a < 2; ++a)
#pragma unroll
            for (int b = 0; b < 2; ++b)
#pragma unroll
                for (int m = 0; m < 4; ++m)
#pragma unroll
                    for (int n = 0; n < 2; ++n) acc[a][b][m][n] = (f32x4){0.f, 0.f, 0.f, 0.f};
        cur = nxt; cA = nA; cB = nB; ++ui;
        if (wr == 1) PG8_BAR;
    }
    PG8_WAIT_V(0);
    PG8_BAR;
#undef PG8_SA
#undef PG8_SB
#undef PG8_STAGE
#undef PG8_LDA
#undef PG8_LDB
#undef PG8_MMA
#undef PG8_WAIT_V
#undef PG8_WAIT_L
#undef PG8_BAR
#undef PG8_SCHED
#undef PG8_ABASE
#undef PG8_BBASE
}
}

__device__ __forceinline__ v4u pack8(const f32x4& a, const f32x4& b) { v4u w; w.x = cvtpk(a.x, a.y); w.y = cvtpk(a.z, a.w); w.z = cvtpk(b.x, b.y); w.w = cvtpk(b.z, b.w); return w; }
struct EpiInProj {
    bf16 *AQ, *AK, *AVT, *BQ, *BK, *BVT, *CQ, *CK, *CV, *SG; const float *COS, *SIN;
    __device__ __forceinline__ void operator()(const f32x4 (&acc)[2][2][4][2], const pg8::Unit& u, int wr, int wc, int fr, int fq) const {
        asm volatile("" : "+v"(fr), "+v"(fq));
#pragma unroll
        for (int bj = 0; bj < 2; ++bj) {
            const int cblk = u.pn * 256 + bj * 128;
            const int cw = wc * 32 + 8 * fq;
            bf16* dst; int pitch, cbase; int kind;
            int nh = 1, hd = 0;
            if (cblk < 512)       { dst = AQ; pitch = 512; cbase = cblk; kind = 1; }
            else if (cblk < 640)  { dst = AK; pitch = 128; cbase = cblk - 512; kind = 1; }
            else if (cblk < 768)  { dst = AVT; pitch = 128; cbase = cblk - 640; kind = 0; }
            else if (cblk < 1280) { dst = BQ; pitch = 512; cbase = cblk - 768; kind = 0; }
            else if (cblk < 1792) { dst = BK; pitch = 512; cbase = cblk - 1280; kind = 0; }
            else if (cblk < 2304) { dst = BVT; pitch = 512; cbase = cblk - 1792; kind = 0; }
            else if (cblk < 2816) { dst = CQ; pitch = 512; cbase = cblk - 2304; kind = 1; }
            else if (cblk < 3328) { dst = CK; pitch = 512; cbase = cblk - 2816; kind = 1; }
            else if (cblk < 3840) { dst = CV; pitch = 512; cbase = cblk - 3328; kind = 0; }
            else                  { dst = SG; pitch = 3072; cbase = cblk - 3840; kind = 3; }
#pragma unroll
            for (int ai = 0; ai < 2; ++ai)
#pragma unroll
                for (int m = 0; m < 4; ++m) {
                    const int row = u.pm * 256 + ai * 128 + wr * 64 + m * 16 + fr;
                    f32x4 v0 = acc[ai][bj][m][0], v1 = acc[ai][bj][m][1];
                    if (kind == 1) {
                        if (row < T_LAT) {
                            const int t = row & (SEQ - 1), i0 = (cw & 63) >> 1;
                            const f32x4 cs = *(const GAS f32x4*)(COS + t * 32 + i0), sn = *(const GAS f32x4*)(SIN + t * 32 + i0);
                            const f32x4 a = v0, b = v1;
                            v0.x = a.x * cs.x - a.y * sn.x; v0.y = a.y * cs.x + a.x * sn.x; v0.z = a.z * cs.y - a.w * sn.y; v0.w = a.w * cs.y + a.z * sn.y;
                            v1.x = b.x * cs.z - b.y * sn.z; v1.y = b.y * cs.z + b.x * sn.z; v1.z = b.z * cs.w - b.w * sn.w; v1.w = b.w * cs.w + b.z * sn.w;
                        }
                        *(GAS v4u*)(dst + (size_t)row * pitch + cbase + cw) = pack8(v0, v1);
                    } else if (kind == 0) {
                        *(GAS v4u*)(dst + (size_t)row * pitch + cbase + cw) = pack8(v0, v1);
                    } else if (kind == 3) {
                        v0.x = sigmoid_fast(v0.x); v0.y = sigmoid_fast(v0.y); v0.z = sigmoid_fast(v0.z); v0.w = sigmoid_fast(v0.w);
                        v1.x = sigmoid_fast(v1.x); v1.y = sigmoid_fast(v1.y); v1.z = sigmoid_fast(v1.z); v1.w = sigmoid_fast(v1.w);
                        *(GAS v4u*)(dst + (size_t)row * pitch + cbase + cw) = pack8(v0, v1);
                    } else {
                        const int hc = hd + cw, head = hc >> 6, d = hc & 63;
                        const int b = row_batch(row), tok = row_tok(row);
                        bf16* vp = dst + ((size_t)(b * nh + head) * 64 + d) * NTOK + tok;
                        vp[0 * NTOK] = (bf16)f2bf(v0.x); vp[1 * NTOK] = (bf16)f2bf(v0.y); vp[2 * NTOK] = (bf16)f2bf(v0.z); vp[3 * NTOK] = (bf16)f2bf(v0.w);
                        vp[4 * NTOK] = (bf16)f2bf(v1.x); vp[5 * NTOK] = (bf16)f2bf(v1.y); vp[6 * NTOK] = (bf16)f2bf(v1.z); vp[7 * NTOK] = (bf16)f2bf(v1.w);
                    }
                }
        }
    }
};
__device__ __forceinline__ void unpack8(const v4u& w, f32x4& a, f32x4& b) {
    a = (f32x4){bf2f(w.x & 0xffffu), bf2f(w.x >> 16), bf2f(w.y & 0xffffu), bf2f(w.y >> 16)}; b = (f32x4){bf2f(w.z & 0xffffu), bf2f(w.z >> 16), bf2f(w.w & 0xffffu), bf2f(w.w >> 16)};
}
struct EpiBranch {
    const bf16* SG; bf16* MG;
    __device__ __forceinline__ void operator()(const f32x4 (&acc)[2][2][4][2], const pg8::Unit& u, int wr, int wc, int fr, int fq) const {
        asm volatile("" : "+v"(fr), "+v"(fq));
#pragma unroll
        for (int ai = 0; ai < 2; ++ai)
#pragma unroll
            for (int m = 0; m < 4; ++m) {
                const int row = u.pm * 256 + ai * 128 + wr * 64 + m * 16 + fr;
#pragma unroll
                for (int bj = 0; bj < 2; ++bj) {
                    const int col = u.pn * 256 + bj * 128 + wc * 32 + 8 * fq;
                    f32x4 g0, g1; { const v4u wg = *(const GAS v4u*)(SG + (size_t)row * 3072 + u.seg * 1024 + col); unpack8(wg, g0, g1); }
                    f32x4 v0 = g0 * acc[ai][bj][m][0], v1 = g1 * acc[ai][bj][m][1];
                    bf16* mp = MG + (size_t)row * D + col;
                    if (u.seg > 0) { f32x4 p0, p1; const v4u wp = *(const GAS v4u*)mp; unpack8(wp, p0, p1); v0 += p0; v1 += p1; }
                    *(GAS v4u*)mp = pack8(v0, v1);
                }
            }
    }
};
struct EpiOut {
    float* X; const float* gtl; const float* xin; const float* cin;
    __device__ __forceinline__ void operator()(const f32x4 (&acc)[2][2][4][2], const pg8::Unit& u, int wr, int wc, int fr, int fq) const {
        asm volatile("" : "+v"(fr), "+v"(fq));
#pragma unroll
        for (int ai = 0; ai < 2; ++ai)
#pragma unroll
            for (int m = 0; m < 4; ++m) {
                const int row = u.pm * 256 + ai * 128 + wr * 64 + m * 16 + fr;
                const float* gt = gtl + (size_t)row_modidx(row) * 6 * D + 2 * D;
#pragma unroll
                for (int bj = 0; bj < 2; ++bj) {
                    const int col = u.pn * 256 + bj * 128 + wc * 32 + 8 * fq;
                    GAS f32x4* xp = (GAS f32x4*)(X + (size_t)row * D + col);
                    const GAS f32x4* sp = xin ? (const GAS f32x4*)(xin_row(xin, cin, row) + col) : (const GAS f32x4*)xp;
                    const f32x4 g0 = *(const GAS f32x4*)(gt + col), g1 = *(const GAS f32x4*)(gt + col + 4);
                    xp[0] = sp[0] + g0 * acc[ai][bj][m][0]; xp[1] = sp[1] + g1 * acc[ai][bj][m][1];
                }
            }
    }
};
struct EpiStore {
    bf16* O; int ldc;
    __device__ __forceinline__ void operator()(const f32x4 (&acc)[2][2][4][2], const pg8::Unit& u, int wr, int wc, int fr, int fq) const {
        asm volatile("" : "+v"(fr), "+v"(fq));
#pragma unroll
        for (int ai = 0; ai < 2; ++ai)
#pragma unroll
            for (int m = 0; m < 4; ++m) {
                const int row = u.pm * 256 + ai * 128 + wr * 64 + m * 16 + fr;
#pragma unroll
                for (int bj = 0; bj < 2; ++bj) {
                    const int col = u.pn * 256 + bj * 128 + wc * 32 + 8 * fq;
                    *(GAS v4u*)(O + (size_t)row * ldc + col) = pack8(acc[ai][bj][m][0], acc[ai][bj][m][1]);
                }
            }
    }
};

__global__ void __launch_bounds__(NTHREADS, 2) mega_fwd(Args args) {
    extern __shared__ __attribute__((aligned(16))) unsigned char lds[];
    LAS unsigned char* L = (LAS unsigned char*)lds;
    volatile LAS unsigned* MISC = (volatile LAS unsigned*)(L + MISC_OFF);
    const int wave = __builtin_amdgcn_readfirstlane((int)threadIdx.x >> 6);
    const int lane = lane_id_v(), tid = wave * 64 + lane;
    const int fr = lane & 15, fq = lane >> 4;
    const int G = gridDim.x;
    const int vcu = (G % 8 == 0) ? (int)(blockIdx.x % 8) * (G / 8) + (int)(blockIdx.x / 8) : (int)blockIdx.x;
    for (int u = tid; u < (LDS_BYTES - 131072) / 4; u += NTHREADS) ((LAS unsigned*)(L + 131072))[u] = 0u;
    __syncthreads();
    unsigned char* ws = args.ws;
    gu32* ctl = (gu32*)(ws + WS_CTL);
    (void)xcd_barrier_post((unsigned*)(ctl + CW_BAR), MISC + 8);
    if (tid == 0) MISC[12] = xb_add((unsigned*)(ctl + CW_RANK) + 64 * xb_xcc_id(), 1u);
    __syncthreads();
#define GRID_BAR() do { unsigned* bp_ = (unsigned*)(args.ws + WS_CTL) + CW_BAR; asm volatile("" : "+s"(bp_)); XcdBarrier b_; b_.bar = bp_; b_.x = xb_xcc_id(); b_.st = MISC + 8; xcd_barrier(b_, wave == 0 && lane_id_v() == 0); } while (0)
    const int gw = vcu * NWAVES + wave, NGW = G * NWAVES;
    const int NGT = G * NTHREADS;

#define PHASE_PTRS \
    unsigned char* wsq = args.ws; asm volatile("" : "+s"(wsq)); \
    const float* const* IN_ = (const float* const*)__builtin_amdgcn_kernarg_segment_ptr(); asm volatile("" : "+s"(IN_)); \
    float* MODV = (float*)(wsq + WS_MOD); float* COS = (float*)(wsq + WS_COS); float* SIN = (float*)(wsq + WS_SIN); \
    bf16* WIN = (bf16*)(wsq + WS_WIN); bf16* WB = (bf16*)(wsq + WS_WB); bf16* WO = (bf16*)(wsq + WS_WO); bf16* WQ = (bf16*)(wsq + WS_WQ); bf16* KEYS = (bf16*)(wsq + WS_KEYS); \
    float* X = (float*)(wsq + WS_X); bf16* H = (bf16*)(wsq + WS_H); bf16* Y = (bf16*)(wsq + WS_Y); bf16* MG = (bf16*)(wsq + WS_MG); \
    unsigned* EI = (unsigned*)(wsq + WS_EI); float* EG = (float*)(wsq + WS_EG); \
    unsigned char* U8 = wsq + WS_U8; unsigned char* V8 = wsq + WS_V8; float* SCU = (float*)(wsq + WS_SCU); float* SCV = SCU + DEPTH * 16384; \
    bf16* AQ = (bf16*)(wsq + WS_AQ); bf16* AK = (bf16*)(wsq + WS_AK); bf16* AVT = (bf16*)(wsq + WS_AVT); \
    bf16* BQ = (bf16*)(wsq + WS_BQ); bf16* BK = (bf16*)(wsq + WS_BK); bf16* BVT = (bf16*)(wsq + WS_BVT); \
    bf16* CQ = (bf16*)(wsq + WS_CQ); bf16* CK = (bf16*)(wsq + WS_CK); bf16* CVT = (bf16*)(wsq + WS_CVT); \
    bf16* SG = (bf16*)(wsq + WS_SG); bf16* Q2 = (bf16*)(wsq + WS_Q2); float* SC = (float*)(wsq + WS_SC); \
    (void)MODV; (void)COS; (void)SIN; (void)WIN; (void)WB; (void)WO; (void)WQ; (void)KEYS; (void)X; (void)H; (void)Y; (void)MG; (void)EI; (void)EG; (void)U8; (void)V8; (void)SCU; (void)SCV; \
    (void)AQ; (void)AK; (void)AVT; (void)BQ; (void)BK; (void)BVT; (void)CQ; (void)CK; (void)CVT; (void)SG; (void)Q2; (void)SC; (void)IN_;
#define LAYER_PTRS const float* modl = MODV + (size_t)layer * 3 * 6 * D; const bf16* WINl = WIN + (size_t)layer * IN_W * D; (void)modl; (void)WINl;

#ifndef SKIP_P0
        { PHASE_PTRS
        for (int rep_ = 0; rep_ < REP_P0; ++rep_) {
    {
        LAS float* scr = (LAS float*)(L + wave * 16384);
        int gt = vcu * NTHREADS + tid; asm volatile("" : "+v"(gt));
        constexpr int I_IN = (D / 64) * (IN_W / 32), I_BR = (512 / 64) * (D / 32), I_O = (D / 64) * (D / 32), I_Q = (D / 64) * (2048 / 32);
        constexpr int PER_LAYER = I_IN + 3 * I_BR + I_O + I_Q;
        for (int rp_ = 0; rp_ < REP_P0A; ++rp_)
        for (int it = gw; it < DEPTH * PER_LAYER; it += NGW) {
            const int l = it / PER_LAYER; int r = it % PER_LAYER;
            if (r < I_IN) { p0_transpose_item<true>(IN_[I_WIN] + (size_t)l * D * IN_W, D, IN_W, WIN + (size_t)l * IN_W * D, scr, r, lane); continue; } r -= I_IN;
            if (r < I_BR) { p0_transpose_item(IN_[I_WBA] + (size_t)l * 512 * D, 512, D, WB + (size_t)(l * 3 + 0) * D * 512, scr, r, lane); continue; } r -= I_BR;
            if (r < I_BR) { p0_transpose_item(IN_[I_WBB] + (size_t)l * 512 * D, 512, D, WB + (size_t)(l * 3 + 1) * D * 512, scr, r, lane); continue; } r -= I_BR;
            if (r < I_BR) { p0_transpose_item(IN_[I_WBC] + (size_t)l * 512 * D, 512, D, WB + (size_t)(l * 3 + 2) * D * 512, scr, r, lane); continue; } r -= I_BR;
            if (r < I_O) { p0_transpose_item(IN_[I_WOUT] + (size_t)l * D * D, D, D, WO + (size_t)l * D * D, scr, r, lane); continue; } r -= I_O;
            p0_transpose_item(IN_[I_PWQ] + (size_t)l * D * 2048, D, 2048, WQ + (size_t)l * 2048 * D, scr, r, lane);
        }
        for (int i = gt; i < DEPTH * 16 * 128 * 128 / 4; i += NGT) {
            const f32x4 v = *((const GAS f32x4*)IN_[I_PKEYS] + i);
            v2u o; o.x = pk2(v.x, v.y); o.y = pk2(v.z, v.w); *((GAS v2u*)KEYS + i) = o;
        }
        {
            LAS float* red = (LAS float*)(L + 9216);
            for (int rp_ = 0; rp_ < REP_P0D; ++rp_)
            for (int it = vcu; it < DEPTH * 96; it += G) {
                const int l = it / 96, nc = it % 96, n = nc * 64 + lane;
                const float* wm = IN_[I_WMOD] + (size_t)l * D * 6 * D + n;
                float a0 = 0.f, a1 = 0.f, a2 = 0.f;
#pragma unroll 1
                for (int half = 0; half < 2; ++half) {
                    const int kb = wave * 128 + half * 64;
                    const float c0 = IN_[I_C][kb + lane], c1 = IN_[I_C][D + kb + lane], c2 = IN_[I_CCTX][kb + lane];
                    const int s0 = __builtin_bit_cast(int, c0 * sigmoidf_(c0)), s1 = __builtin_bit_cast(int, c1 * sigmoidf_(c1)), s2 = __builtin_bit_cast(int, c2 * sigmoidf_(c2));
#pragma unroll
                    for (int kk = 0; kk < 64; ++kk) {
                        const float w = wm[(size_t)(kb + kk) * 6 * D];
                        a0 += __builtin_bit_cast(float, __builtin_amdgcn_readlane(s0, kk)) * w;
                        a1 += __builtin_bit_cast(float, __builtin_amdgcn_readlane(s1, kk)) * w;
                        a2 += __builtin_bit_cast(float, __builtin_amdgcn_readlane(s2, kk)) * w;
                    }
                }
                red[(wave * 3 + 0) * 64 + lane] = a0; red[(wave * 3 + 1) * 64 + lane] = a1; red[(wave * 3 + 2) * 64 + lane] = a2;
                __syncthreads();
                if (wave < 3) {
                    float sum = IN_[I_BMOD][l * 6 * D + n];
#pragma unroll
                    for (int w = 0; w < 8; ++w) sum += red[(w * 3 + wave) * 64 + lane];
                    MODV[(size_t)(l * 3 + wave) * 6 * D + n] = sum;
                }
                __syncthreads();
            }
        }
        for (int i = gt; i < SEQ * 32; i += NGT) {
            const int t = i >> 5, f = i & 31;
            const float inv = exp2f(-(float)(f & 15) * (13.287712379549449f / 16.0f));
            const float pos = (f < 16) ? (float)(t / GRID_W) : (float)(t % GRID_W);
            float sn, cs; sincosf(pos * inv, &sn, &cs);
            COS[i] = cs; SIN[i] = sn;
        }
    }
        for (int rp_ = 0; rp_ < REP_P0F; ++rp_)
#pragma unroll 4
        for (int rr = gw; rr < 2 * DEPTH * 16384; rr += NGW) {
            const int tab = rr / (DEPTH * 16384), row = rr % (DEPTH * 16384);
            const float* src = (tab == 0 ? IN_[I_PU] : IN_[I_PV]) + (size_t)row * D;
            f32x4 v[4]; float am = 0.f;
#pragma unroll
            for (int j = 0; j < 4; ++j) { v[j] = *((const GAS f32x4*)src + lane + 64 * j); am = fmaxf(am, fmaxf(fmaxf(fabsf(v[j].x), fabsf(v[j].y)), fmaxf(fabsf(v[j].z), fabsf(v[j].w)))); }
            am = wave_max(am);
            const bool as_i8 = (P10_SLICED != 0) && (tab == 0);
            int ex = 0; float scale = 1.0f;
            if (am > 0.f) { (void)frexpf(am * (as_i8 ? (1.0f / 127.0f) : (1.0f / 448.0f)), &ex); scale = ldexpf(1.0f, ex); }
            const float inv = 1.0f / scale;
            v4u o;
#pragma unroll
            for (int j = 0; j < 4; ++j) {
                if (as_i8) {
                    const int q0 = __float2int_rn(v[j].x * inv), q1 = __float2int_rn(v[j].y * inv), q2 = __float2int_rn(v[j].z * inv), q3 = __float2int_rn(v[j].w * inv);
                    o[j] = (unsigned)(q0 & 255) | ((unsigned)(q1 & 255) << 8) | ((unsigned)(q2 & 255) << 16) | ((unsigned)q3 << 24);
                } else {
                    int p = __builtin_amdgcn_cvt_pk_fp8_f32(v[j].x * inv, v[j].y * inv, 0, false);
                    p = __builtin_amdgcn_cvt_pk_fp8_f32(v[j].z * inv, v[j].w * inv, p, true);
                    o[j] = (unsigned)p;
                }
            }
            *((GAS v4u*)((tab == 0 ? U8 : V8) + (size_t)row * D) + lane) = o;
            if (lane == 0) (tab == 0 ? SCU : SCV)[row] = scale;
        }
        }
        }
#endif
    GRID_BAR();

    for (int layer = 0; layer < DEPTH; ++layer) {
        const bool last = (layer == DEPTH - 1);
        const int T_EFF = last ? T_LAT : T_ALL;

#ifndef SKIP_P1
        { PHASE_PTRS LAYER_PTRS
        for (int rep_ = 0; rep_ < REP_P1; ++rep_) {
        { const int ln = lane_id_v();
        if (layer == 0) {
            f32x4 gm[4], shv[4];
            auto prep = [&](int midx) { const float* md = modl + (size_t)midx * 6 * D;
#pragma unroll
                for (int j = 0; j < 4; ++j) { const f32x4 g = *((const GAS f32x4*)(IN_[I_G1] + layer * D) + ln + 64 * j); const f32x4 sc = *((const GAS f32x4*)(md + D) + ln + 64 * j);
                    gm[j] = g * (sc + 1.0f); shv[j] = *((const GAS f32x4*)(md + 0) + ln + 64 * j); } };
            auto row = [&](int r) {
                const GAS f32x4* xr = (const GAS f32x4*)xin_row(IN_[I_X], IN_[I_CTX], r) + ln;
                f32x4 v[4]; float ss = 0.f;
#pragma unroll
                for (int j = 0; j < 4; ++j) { v[j] = xr[64 * j]; ss += (v[j].x * v[j].x + v[j].y * v[j].y) + (v[j].z * v[j].z + v[j].w * v[j].w); }
                const float rs = 1.0f / sqrtf(wave_sum(ss) * (1.f / D) + NORM_EPS);
                GAS v2u* o8 = (GAS v2u*)(H + (size_t)r * D) + ln;
#pragma unroll
                for (int j = 0; j < 4; ++j) { const f32x4 h = v[j] * rs * gm[j] + shv[j]; v2u o; o.x = pk2(h.x, h.y); o.y = pk2(h.z, h.w); o8[64 * j] = o; } };
            wave_row_blocks(T_ALL, gw, NGW, prep, row);
        }
        }
        }
        }
#endif
        if (layer == 0) GRID_BAR();

#ifndef SKIP_P2
        { PHASE_PTRS LAYER_PTRS
        for (int rep_ = 0; rep_ < REP_P2; ++rep_) {
        {
            pg8::Gemm g{H, WINl, D, D, D, 0, 0};
            pg8::SegOrder<1> S; S.T.init(T_ALL, IN_W, G, (int)blockIdx.x);
            EpiInProj E{AQ, AK, AVT, BQ, BK, BVT, CQ, CK, CVT, SG, COS, SIN};
            pg8::gemm_phase(L, g, S, E, wave);
        }
        }
        }
#endif
        GRID_BAR();

#ifndef SKIP_P3
        { PHASE_PTRS LAYER_PTRS
        {
            LAS bf16* Pl = (LAS bf16*)(L + wave * 8192);
            const float lam_init = 0.8f - 0.6f * expf(-0.3f * (float)layer);
            float lam;
            {
                const int ll = lane_id_v();
                const float* cl = IN_[I_LAMBDA] + layer * 256;
                const float s1 = wave_sum(cl[ll] * cl[64 + ll]), s2 = wave_sum(cl[128 + ll] * cl[192 + ll]);
                lam = expf(s1) - expf(s2) + lam_init;
            }
{ const int lo__ = lane_id_v(); { const int lane = lo__; const int fr = lane & 15, fq = lane >> 4, tid = wave * 64 + lane; (void)fr; (void)fq; (void)tid;
            {
                const int r32 = lane & 31, hi = lane >> 5;
                const int n_lat = BATCH * 4 * (SEQ / 256), n_ctx = last ? 0 : BATCH * 4;
                const int NU = (n_lat + G - 1) / G * G + n_ctx;
                for (int rep_ = 0; rep_ < REP_P3C; ++rep_)
                for (int u0 = vcu; u0 < NU; u0 += G) {
                    int b, h, row0, t_lo, t_hi;
                    if (u0 < n_lat) { const int bh = u0 >> 5; b = bh >> 2; h = bh & 3; row0 = b * SEQ + (u0 & 31) * 256; t_lo = 0; t_hi = 132; }
                    else { const int c = u0 - (n_lat + G - 1) / G * G; if (c < 0 || c >= n_ctx) continue; b = c >> 2; h = c & 3; row0 = T_LAT + b * CTX; t_lo = 128; t_hi = 132; }
                    const int qrow = row0 + wave * 32 + r32;
                    LAS unsigned* o1p = (LAS unsigned*)(L + 65536 + wave * 8192) + lane;
                    const int krow_s = tid >> 3, kch_s = tid & 7;
                    const int vrow_s0 = tid >> 4, vch_s = tid & 15;
                    LAS unsigned char* Kb0 = L; LAS unsigned char* Vb0 = L + 2 * CK_SZ;
#pragma unroll 1
                    for (int m = 0; m < 2; ++m) {
                        bf16x8 qf[4];
                        { const bf16* qp = CQ + (size_t)qrow * 512 + (h * 2 + m) * 64 + hi * 8;
#pragma unroll
                          for (int ks = 0; ks < 4; ++ks) qf[ks] = *(const GAS bf16x8*)(qp + ks * 16); }
                        f32x16 o[4];
#pragma unroll
                        for (int d = 0; d < 4; ++d)
#pragma unroll
                            for (int r = 0; r < 16; ++r) o[d][r] = 0.f;
                        float mrun = -1e30f, lpart = 0.f;
                        const bf16* kg = CK + (size_t)krow_s * 512 + (h * 2 + m) * 64 + kch_s * 8;
                        const bf16* vg = CVT + (size_t)vrow_s0 * 512 + h * 128 + vch_s * 8;
                        auto tile_row = [&](int j) { return (j < 128) ? b * SEQ + 64 * j : T_LAT + b * CTX + 64 * (j - 128); };
                        __syncthreads();
                        {
                            const size_t kb = (size_t)tile_row(t_lo) * 512;
                            const v4u kr = *(const GAS v4u*)(kg + kb), v0 = *(const GAS v4u*)(vg + kb), v1 = *(const GAS v4u*)(vg + kb + 32 * 512);
                            *(LAS v4u*)(Kb0 + krow_s * CK_PITCH + kch_s * 16) = kr;
                            *(LAS v4u*)(Vb0 + vrow_s0 * CV_PITCH + vch_s * 16) = v0; *(LAS v4u*)(Vb0 + (vrow_s0 + 32) * CV_PITCH + vch_s * 16) = v1;
                        }
                        __syncthreads();
#pragma unroll 1
                        for (int j = t_lo; j < t_hi; ++j) {
                            const int cur = (j - t_lo) & 1;
                            const LAS unsigned char* Kb = Kb0 + cur * CK_SZ; const LAS unsigned char* Vb = Vb0 + cur * CV_SZ;
                            v4u kr, v0, v1;
                            const bool more = (j + 1 < t_hi);
                            { const size_t kb = (size_t)tile_row(more ? j + 1 : j) * 512; kr = *(const GAS v4u*)(kg + kb); v0 = *(const GAS v4u*)(vg + kb); v1 = *(const GAS v4u*)(vg + kb + 32 * 512); }
                            f32x16 st[2];
#pragma unroll
                            for (int kb = 0; kb < 2; ++kb) {
#pragma unroll
                                for (int r = 0; r < 16; ++r) st[kb][r] = 0.f;
#pragma unroll
                                for (int ks = 0; ks < 4; ++ks) {
                                    const bf16x8 kf = *(const LAS bf16x8*)(Kb + (kb * 32 + r32) * CK_PITCH + ks * 32 + hi * 16);
                                    st[kb] = __builtin_amdgcn_mfma_f32_32x32x16_bf16(kf, qf[ks], st[kb], 0, 0, 0);
                                }
                            }
                            float mx = st[0][0];
#pragma unroll
                            for (int r = 1; r < 16; ++r) mx = fmaxf(mx, st[0][r]);
#pragma unroll
                            for (int r = 0; r < 16; ++r) mx = fmaxf(mx, st[1][r]);
                            mx = xmax32(mx);
                            if (__builtin_amdgcn_ballot_w64(mx > mrun + C_THR_RAW) != 0ull) {
                                const float mn = fmaxf(mrun, mx);
                                const float alpha = __builtin_amdgcn_exp2f((mrun - mn) * SCL2);
#pragma unroll
                                for (int d = 0; d < 4; ++d)
#pragma unroll
                                    for (int r = 0; r < 16; ++r) o[d][r] *= alpha;
                                lpart *= alpha; mrun = mn;
                            }
                            const float nmc = -mrun * SCL2;
                            float ls = 0.f;
#pragma unroll
                            for (int kb = 0; kb < 2; ++kb)
#pragma unroll
                                for (int r = 0; r < 16; ++r) { const float p = __builtin_amdgcn_exp2f(fmaf(st[kb][r], SCL2, nmc)); st[kb][r] = p; ls += p; }
                            lpart += ls;
                            {
                                const int q4 = (lane & 15) >> 2, p4 = lane & 3, grp = (lane >> 4) & 1;
                                const LAS unsigned char* vbase = Vb + (4 * hi + q4) * CV_PITCH + (16 * grp + 4 * p4) * 2;
#pragma unroll
                                for (int kb = 0; kb < 2; ++kb)
#pragma unroll
                                    for (int ss = 0; ss < 2; ++ss) {
                                        v4u pw;
#pragma unroll
                                        for (int i2 = 0; i2 < 4; ++i2) pw[i2] = cvtpk(st[kb][8 * ss + 2 * i2], st[kb][8 * ss + 2 * i2 + 1]);
                                        const bf16x8 pb = __builtin_bit_cast(bf16x8, pw);
#pragma unroll
                                        for (int d = 0; d < 4; ++d) {
                                            const LAS unsigned char* va = vbase + (kb * 32 + 16 * ss) * CV_PITCH + d * 64;
                                            const s16x4 lo = __builtin_bit_cast(s16x4, __builtin_amdgcn_ds_read_tr16_b64_v4i16((LAS s16x4*)va));
                                            const s16x4 hh = __builtin_bit_cast(s16x4, __builtin_amdgcn_ds_read_tr16_b64_v4i16((LAS s16x4*)(va + 8 * CV_PITCH)));
                                            const bf16x8 vf = __builtin_shufflevector(lo, hh, 0, 1, 2, 3, 4, 5, 6, 7);
                                            o[d] = __builtin_amdgcn_mfma_f32_32x32x16_bf16(vf, pb, o[d], 0, 0, 0);
                                        }
                                        if (ss == 1) __builtin_amdgcn_sched_barrier(0);
                                    }
                            }
                            if (more) {
                                LAS unsigned char* Kn = Kb0 + (cur ^ 1) * CK_SZ; LAS unsigned char* Vn = Vb0 + (cur ^ 1) * CV_SZ;
                                *(LAS v4u*)(Kn + krow_s * CK_PITCH + kch_s * 16) = kr;
                                *(LAS v4u*)(Vn + vrow_s0 * CV_PITCH + vch_s * 16) = v0; *(LAS v4u*)(Vn + (vrow_s0 + 32) * CV_PITCH + vch_s * 16) = v1;
                            }
                            __syncthreads();
                        }
                        const float lt = xadd32(lpart);
                        if (m == 0) {
                            const float inv = 1.0f / lt;
#pragma unroll
                            for (int d = 0; d < 4; ++d)
#pragma unroll
                                for (int i2 = 0; i2 < 8; ++i2) o1p[64 * (d * 8 + i2)] = cvtpk(o[d][2 * i2] * inv, o[d][2 * i2 + 1] * inv);
                        } else {
                            const float inv2 = lam / lt;
                            float ssq = 0.f;
#pragma unroll
                            for (int d = 0; d < 4; ++d)
#pragma unroll
                                for (int i2 = 0; i2 < 8; ++i2) {
                                    const unsigned w1 = o1p[64 * (d * 8 + i2)];
                                    const float a0 = bf2f(w1 & 0xffffu) - o[d][2 * i2] * inv2, a1 = bf2f(w1 >> 16) - o[d][2 * i2 + 1] * inv2;
                                    o[d][2 * i2] = a0; o[d][2 * i2 + 1] = a1; ssq += a0 * a0 + a1 * a1;
                                }
                            ssq = xadd32(ssq);
                            const float rn = 1.0f / sqrtf(ssq * (1.f / 128.f) + NORM_EPS) * (1.0f - lam_init);
                            bf16* yp = Y + (size_t)qrow * 1536 + 1024 + h * 128 + 4 * hi;
                            const float* sl = IN_[I_SUBLN] + layer * 512 + h * 128 + 4 * hi;
#pragma unroll
                            for (int d = 0; d < 4; ++d)
#pragma unroll
                                for (int g4 = 0; g4 < 4; ++g4) {
                                    const f32x4 gsl = *(const GAS f32x4*)(sl + d * 32 + 8 * g4);
                                    v2u w; w.x = cvtpk(o[d][4 * g4] * rn * gsl.x, o[d][4 * g4 + 1] * rn * gsl.y); w.y = cvtpk(o[d][4 * g4 + 2] * rn * gsl.z, o[d][4 * g4 + 3] * rn * gsl.w);
                                    *(GAS v2u*)(yp + d * 32 + 8 * g4) = w;
                                }
                        }
                    }
                }
                __syncthreads();
            }
} }
{ const int lo__ = lane_id_v(); { const int lane = lo__; const int tid = wave * 64 + lane, r32 = lane & 31, hi = lane >> 5;
            {
                const int n_lat = BATCH * 2 * (SEQ / 64), n_ctx = last ? 0 : BATCH * 2 * (CTX / 64);
                for (int rep_ = 0; rep_ < REP_P3A; ++rep_)
                for (int u0 = vcu; u0 < n_lat + n_ctx; u0 += G) {
                    const bool isctx = u0 >= n_lat;
                    int b, g, p0, qrow, nl, klo;
                    if (!isctx) { b = u0 >> 8; g = (u0 >> 7) & 1; p0 = (u0 & 127) * 64; qrow = b * SEQ + p0 + (wave & 1) * 32 + r32;
                                  klo = p0 >= 128 ? 0 : (128 - p0) / 64; const int khi = min(4, (SEQ - 1 - (p0 - 128)) / 64); nl = khi - klo + 1; }
                    else { const int c = u0 - n_lat; b = c >> 3; g = (c >> 2) & 1; p0 = (c & 3) * 64; qrow = T_LAT + b * CTX + p0 + (wave & 1) * 32 + r32; nl = 0; klo = 0; }
                    const int hq = g * 4 + (wave >> 1);
                    const int qpos0 = p0 + (wave & 1) * 32;
                    bf16x8 qf[4];
                    { const bf16* qp = AQ + (size_t)qrow * 512 + hq * 64 + hi * 8;
#pragma unroll
                      for (int ks = 0; ks < 4; ++ks) qf[ks] = *(const GAS bf16x8*)(qp + ks * 16); }
                    f32x16 o[2];
#pragma unroll
                    for (int d = 0; d < 2; ++d)
#pragma unroll
                        for (int r = 0; r < 16; ++r) o[d][r] = 0.f;
                    float mrun = IN_[I_SINK][layer * 8 + hq] * 8.0f;
                    float lpart = (hi == 0) ? 1.0f : 0.0f;
                    const bf16* kg = AK + (size_t)(tid >> 3) * 128 + g * 64 + (tid & 7) * 8;
                    const bf16* vg = AVT + (size_t)(tid >> 3) * 128 + g * 64 + (tid & 7) * 8;
                    const int kp0 = p0 - 128 + 64 * klo;
                    auto tile_row = [&](int j) { return (j < nl) ? b * SEQ + kp0 + 64 * j : T_LAT + b * CTX + 64 * (j - nl); };
                    auto use_tile = [&](int j) { if (j >= nl) return true; const int kp = kp0 + 64 * j; return (kp + 63 >= qpos0 - 128) && (kp <= qpos0 + 31 + 128); };
                    auto elem = [&](f32x16 (&st)[2], int j) {
                        if (j < nl) {
                            const int dq0 = (qpos0 + r32) - (kp0 + 64 * j + 4 * hi);
#pragma unroll
                            for (int kb = 0; kb < 2; ++kb)
#pragma unroll
                                for (int r = 0; r < 16; ++r) { const int dq = dq0 - (kb * 32 + (r & 3) + 8 * (r >> 2)); if (dq > 128 || dq < -128) st[kb][r] = -1e30f; }
                        }
                    };
                    attn64_pass<2>(o, mrun, lpart, qf, kg, 128, vg, 128, nl + 4, tile_row, use_tile, elem, L, lane, tid);
                    const float lt = xadd32(lpart);
                    attn64_store(o, 1.0f / lt, Y + (size_t)qrow * 1536 + hq * 64, hi);
                }
            }
} }
{ const int lo__ = lane_id_v(); { const int lane = lo__; const int tid = wave * 64 + lane, r32 = lane & 31, hi = lane >> 5;
            {
                const int n_lat = BATCH * 8 * 32, n_ctx = last ? 0 : BATCH * 8;
                LAS float* rpbL = (LAS float*)(L + 49152);
                for (int rep_ = 0; rep_ < REP_P3B; ++rep_)
                for (int u0 = vcu; u0 < n_lat + n_ctx; u0 += G) {
                    const bool isctx = u0 >= n_lat;
                    int b, h, gr = 0, qc0 = 0, qrow, nl, krlo;
                    if (!isctx) { b = u0 >> 8; h = (u0 >> 5) & 7; const int r0 = (u0 & 31) * 4; gr = r0 + (wave >> 1); qc0 = (wave & 1) * 32; qrow = b * SEQ + gr * GRID_W + qc0 + r32;
                                  krlo = min(max(r0 - 4, 0), 120); nl = min(max(r0 - 1, 0), 120) + 8 - krlo; }
                    else { const int c = u0 - n_lat; b = c >> 3; h = c & 7; qrow = T_LAT + b * CTX + wave * 32 + r32; nl = 0; krlo = 0; }
                    __syncthreads();
                    if (tid < 465) rpbL[tid] = IN_[I_RPB][(size_t)(layer * 8 + h) * 465 + tid] * 8.0f;
                    bf16x8 qf[4];
                    { const bf16* qp = BQ + (size_t)qrow * 512 + h * 64 + hi * 8;
#pragma unroll
                      for (int ks = 0; ks < 4; ++ks) qf[ks] = *(const GAS bf16x8*)(qp + ks * 16); }
                    f32x16 o[2];
#pragma unroll
                    for (int d = 0; d < 2; ++d)
#pragma unroll
                        for (int r = 0; r < 16; ++r) o[d][r] = 0.f;
                    float mrun = -1e30f, lpart = 0.f;
                    const bf16* kg = BK + (size_t)(tid >> 3) * 512 + h * 64 + (tid & 7) * 8;
                    const bf16* vg = BVT + (size_t)(tid >> 3) * 512 + h * 64 + (tid & 7) * 8;
                    const int rs = min(max(gr - 4, 0), 120);
                    auto tile_row = [&](int j) { return (j < nl) ? b * SEQ + (krlo + j) * GRID_W : T_LAT + b * CTX + 64 * (j - nl); };
                    auto use_tile = [&](int j) { if (j >= nl) return true; const int kr = krlo + j; return kr >= rs && kr < rs + 8; };
                    auto elem = [&](f32x16 (&st)[2], int j) {
                        if (j < nl) {
                            const int qc = qc0 + r32, cstart = min(max(qc - 8, 0), 48);
                            const LAS float* brow = rpbL + (krlo + j - gr + 7) * 31 + 15;
#pragma unroll
                            for (int kb = 0; kb < 2; ++kb)
#pragma unroll
                                for (int r = 0; r < 16; ++r) {
                                    const int kc = kb * 32 + (r & 3) + 8 * (r >> 2) + 4 * hi;
                                    const bool valid = (kc >= cstart) && (kc < cstart + 16);
                                    const int dc = min(max(kc - qc, -15), 15);
                                    st[kb][r] = valid ? st[kb][r] + brow[dc] : -1e30f;
                                }
                        }
                    };
                    attn64_pass<2>(o, mrun, lpart, qf, kg, 512, vg, 512, nl + 4, tile_row, use_tile, elem, L, lane, tid);
                    const float lt = xadd32(lpart);
                    attn64_store(o, 1.0f / lt, Y + (size_t)qrow * 1536 + 512 + h * 64, hi);
                }
                __syncthreads();
            }
} }
        }
        }
#endif
        GRID_BAR();

#ifndef SKIP_P4
        { PHASE_PTRS LAYER_PTRS
        for (int rep_ = 0; rep_ < REP_P4; ++rep_) {
        {
            pg8::Gemm g{Y, WB + (size_t)layer * 3 * D * 512, 1536, 512, 512, 512, (size_t)D * 512};
            pg8::SegOrder<3> S; S.T.init(T_LAT, D, G, (int)blockIdx.x);
            EpiBranch E{SG, MG};
            pg8::gemm_phase(L, g, S, E, wave);
        }
        if (!last) { const int lo__ = lane_id_v(); { const int lane = lo__; const int fr = lane & 15, fq = lane >> 4; (void)fr; (void)fq;
            for (int it = gw; it < (T_ALL - T_LAT) / 32 * (D / 32); it += NGW) {
                const int row0 = T_LAT + (it / (D / 32)) * 32, col0 = (it % (D / 32)) * 32;
                f32x4 mg[2][2]; zero_acc22(mg);
#pragma unroll 1
                for (int seg = 0; seg < 3; ++seg) {
                    f32x4 acc[2][2]; zero_acc22(acc);
                    sgemm32<8>(acc, Y + seg * 512, 1536, WB + (size_t)(layer * 3 + seg) * D * 512, 512, 512, row0, col0, lane);
#pragma unroll
                    for (int m = 0; m < 2; ++m)
#pragma unroll
                        for (int r = 0; r < 4; ++r) {
                            const bf16* gp = SG + (size_t)(row0 + 16 * m + 4 * fq + r) * 3072 + seg * 1024 + col0 + fr;
#pragma unroll
                            for (int n = 0; n < 2; ++n) mg[m][n][r] += bf2f(gp[16 * n]) * acc[m][n][r];
                        }
                }
#pragma unroll
                for (int m = 0; m < 2; ++m)
#pragma unroll
                    for (int r = 0; r < 4; ++r) {
                        bf16* rowp = MG + (size_t)(row0 + 16 * m + 4 * fq + r) * D + col0 + fr;
#pragma unroll
                        for (int n = 0; n < 2; ++n) rowp[16 * n] = (bf16)f2bf(mg[m][n][r]);
                    }
            }
} }
        }
        }
#endif
        GRID_BAR();

#ifndef SKIP_P5
        { PHASE_PTRS LAYER_PTRS
        {
            pg8::Gemm g{MG, WO + (size_t)layer * D * D, D, D, D, 0, 0};
            pg8::SegOrder<1> S; S.T.init(T_LAT, D, G, (int)blockIdx.x);
            EpiOut E{X, modl, layer == 0 ? IN_[I_X] : nullptr, IN_[I_CTX]};
            pg8::gemm_phase(L, g, S, E, wave);
        }
        if (!last) { const int lo__ = lane_id_v(); { const int lane = lo__; const int fr = lane & 15, fq = lane >> 4; (void)fr; (void)fq;
            for (int it = gw; it < (T_ALL - T_LAT) / 32 * (D / 32); it += NGW) {
                const int row0 = T_LAT + (it / (D / 32)) * 32, col0 = (it % (D / 32)) * 32;
                f32x4 acc[2][2]; zero_acc22(acc);
                sgemm32<8>(acc, MG, D, WO + (size_t)layer * D * D, D, D, row0, col0, lane);
                const float* gt = modl + (size_t)2 * 6 * D + 2 * D + col0 + fr;
#pragma unroll
                for (int m = 0; m < 2; ++m)
#pragma unroll
                    for (int r = 0; r < 4; ++r) {
                        float* rowp = X + (size_t)(row0 + 16 * m + 4 * fq + r) * D + col0 + fr;
                        const float* srcp = (layer == 0) ? IN_[I_CTX] + (size_t)(row0 - T_LAT + 16 * m + 4 * fq + r) * D + col0 + fr : rowp;
#pragma unroll
                        for (int n = 0; n < 2; ++n) rowp[16 * n] = srcp[16 * n] + gt[16 * n] * acc[m][n][r];
                    }
            }
} }
        }
#endif
        GRID_BAR();

#ifndef SKIP_P6
        { PHASE_PTRS LAYER_PTRS
        for (int rep_ = 0; rep_ < REP_P6; ++rep_) {
        { const int ln = lane_id_v();
        {
            f32x4 gm[4], shv[4];
            auto prep = [&](int midx) { const float* md = modl + (size_t)midx * 6 * D;
#pragma unroll
                for (int j = 0; j < 4; ++j) { const f32x4 g = *((const GAS f32x4*)(IN_[I_G2] + layer * D) + ln + 64 * j); const f32x4 sc = *((const GAS f32x4*)(md + 4 * D) + ln + 64 * j);
                    gm[j] = g * (sc + 1.0f); shv[j] = *((const GAS f32x4*)(md + 3 * D) + ln + 64 * j); } };
            auto row = [&](int r) {
                const GAS f32x4* xr = (const GAS f32x4*)(X + (size_t)r * D) + ln;
                f32x4 v[4]; float ss = 0.f;
#pragma unroll
                for (int j = 0; j < 4; ++j) { v[j] = xr[64 * j]; ss += (v[j].x * v[j].x + v[j].y * v[j].y) + (v[j].z * v[j].z + v[j].w * v[j].w); }
                const float rs = 1.0f / sqrtf(wave_sum(ss) * (1.f / D) + NORM_EPS);
                GAS v2u* o8 = (GAS v2u*)(H + (size_t)r * D) + ln;
#pragma unroll
                for (int j = 0; j < 4; ++j) { const f32x4 h = v[j] * rs * gm[j] + shv[j]; v2u o; o.x = pk2(h.x, h.y); o.y = pk2(h.z, h.w); o8[64 * j] = o; } };
            wave_row_blocks(T_EFF, gw, NGW, prep, row);
        }
        }
        }
        }
#endif
        GRID_BAR();

#ifndef SKIP_P7
        { PHASE_PTRS LAYER_PTRS
        for (int rep_ = 0; rep_ < REP_P7; ++rep_) {
        {
            pg8::Gemm g{H, WQ + (size_t)layer * 2048 * D, D, D, D, 0, 0};
            pg8::SegOrder<1> S; S.T.init(T_LAT, 2048, G, (int)blockIdx.x);
            EpiStore E{Q2, 2048};
            pg8::gemm_phase(L, g, S, E, wave);
        }
        if (!last) { const int lo__ = lane_id_v(); { const int lane = lo__; const int fr = lane & 15, fq = lane >> 4; (void)fr; (void)fq;
            for (int it = gw; it < (T_ALL - T_LAT) / 32 * (2048 / 32); it += NGW) {
                const int row0 = T_LAT + (it / (2048 / 32)) * 32, col0 = (it % (2048 / 32)) * 32;
                f32x4 acc[2][2]; zero_acc22(acc);
                sgemm32<8>(acc, H, D, WQ + (size_t)layer * 2048 * D, D, D, row0, col0, lane);
#pragma unroll
                for (int m = 0; m < 2; ++m)
#pragma unroll
                    for (int r = 0; r < 4; ++r) {
                        bf16* rowp = Q2 + (size_t)(row0 + 16 * m + 4 * fq + r) * 2048 + col0 + fr;
#pragma unroll
                        for (int n = 0; n < 2; ++n) rowp[16 * n] = (bf16)f2bf(acc[m][n][r]);
                    }
            }
} }
        }
        }
#endif
        GRID_BAR();

#ifndef SKIP_P8
        { PHASE_PTRS LAYER_PTRS
        for (int rep_ = 0; rep_ < REP_P8; ++rep_) {
{ const int lo__ = lane_id_v(); { const int lane = lo__; const int fr = lane & 15, fq = lane >> 4, tid = wave * 64 + lane;
        {
            LAS float* S = (LAS float*)L;
            const int wr = wave >> 1, wc = wave & 1;
            const int tl = tid >> 2, qd = tid & 3, ph = qd >> 1, hq = qd & 1;
            for (int it = vcu; it < (T_EFF / 128) * PEER_HEADS; it += G) {
                const int tile = it >> 3, h = it & 7;
                {
                    f32x4 acc[2][8];
#pragma unroll
                    for (int m = 0; m < 2; ++m)
#pragma unroll
                        for (int n = 0; n < 8; ++n) acc[m][n] = (f32x4){0.f, 0.f, 0.f, 0.f};
                    const bf16* ap = Q2 + (size_t)(tile * 128 + wr * 32 + fr) * 2048 + h * 256 + wc * 128 + fq * 8;
                    const bf16* bp = KEYS + ((size_t)(layer * 16 + h * 2 + wc) * 128 + fr) * 128 + fq * 8;
                    bf16x8 af[2][4];
#pragma unroll
                    for (int m = 0; m < 2; ++m)
#pragma unroll
                        for (int ks = 0; ks < 4; ++ks) af[m][ks] = *(const GAS bf16x8*)(ap + (size_t)m * 16 * 2048 + ks * 32);
#pragma unroll
                    for (int n = 0; n < 8; ++n) {
                        bf16x8 bfr[4];
#pragma unroll
                        for (int ks = 0; ks < 4; ++ks) bfr[ks] = *(const GAS bf16x8*)(bp + (size_t)n * 16 * 128 + ks * 32);
#pragma unroll
                        for (int ks = 0; ks < 4; ++ks)
#pragma unroll
                            for (int m = 0; m < 2; ++m) acc[m][n] = __builtin_amdgcn_mfma_f32_16x16x32_bf16(af[m][ks], bfr[ks], acc[m][n], 0, 0, 0);
                    }
#pragma unroll
                    for (int m = 0; m < 2; ++m)
#pragma unroll
                        for (int r = 0; r < 4; ++r) {
                            const int row_ = wr * 32 + 16 * m + 4 * fq + r;
#pragma unroll
                            for (int n = 0; n < 8; ++n) { const int key_ = wc * 128 + 16 * n + fr, c_ = key_ >> 2, pc_ = (c_ & 0x30) | ((c_ & 15) ^ (((row_ & 3) << 2) | (c_ >> 4)));
                                S[row_ * 256 + pc_ * 4 + (key_ & 3)] = acc[m][n][r]; }
                        }
                }
                __syncthreads();
                {
                    const int t = tile * 128 + tl;
                    int a[16];
#define LOAD_CHUNK_L(v, ch) _Pragma("unroll") for (int q = 0; q < 4; ++q) { const int c_ = qd * 16 + (ch) * 4 + q, pc_ = (c_ & 0x30) | ((c_ & 15) ^ (((tl & 3) << 2) | qd)); \
                        const f32x4 x = *(const LAS f32x4*)(S + tl * 256 + pc_ * 4); const int kb_ = hq * 64 + (ch) * 16 + 4 * q; \
                        v[4 * q + 0] = (f2ord(x.x) & ~127) | (kb_ + 0); v[4 * q + 1] = (f2ord(x.y) & ~127) | (kb_ + 1); v[4 * q + 2] = (f2ord(x.z) & ~127) | (kb_ + 2); v[4 * q + 3] = (f2ord(x.w) & ~127) | (kb_ + 3); }
                    LOAD_CHUNK_L(a, 0) sort16_desc(a);
#pragma unroll
                    for (int ch = 1; ch < 4; ++ch) { int v[16]; LOAD_CHUNK_L(v, ch) sort16_desc(v); merge16_desc(a, v); }
#undef LOAD_CHUNK_L
                    { int b[16];
#pragma unroll
                      for (int i = 0; i < 16; ++i) b[i] = __builtin_amdgcn_update_dpp(0, a[i], 0xB1, 0xF, 0xF, true);
                      merge16_desc(a, b); }
                    int a0[16], a1[16];
#pragma unroll
                    for (int i = 0; i < 16; ++i) { const int o2 = __builtin_amdgcn_update_dpp(0, a[i], 0x4E, 0xF, 0xF, true); a0[i] = ph ? o2 : a[i]; a1[i] = ph ? a[i] : o2; }
                    {
            float va[16], vb[16];
#pragma unroll
            for (int i = 0; i < 16; ++i) { va[i] = ord2f(a0[i] & ~127); vb[i] = ord2f(a1[i] & ~127); }
            int c[16];
            {
                int v[16];
                v[0] = (f2ord(va[0] + vb[0]) & ~255) | 0;
                v[1] = (f2ord(va[0] + vb[1]) & ~255) | 1;
                v[2] = (f2ord(va[0] + vb[2]) & ~255) | 2;
                v[3] = (f2ord(va[0] + vb[3]) & ~255) | 3;
                v[4] = (f2ord(va[0] + vb[4]) & ~255) | 4;
                v[5] = (f2ord(va[0] + vb[5]) & ~255) | 5;
                v[6] = (f2ord(va[0] + vb[6]) & ~255) | 6;
                v[7] = (f2ord(va[0] + vb[7]) & ~255) | 7;
                v[8] = (f2ord(va[0] + vb[8]) & ~255) | 8;
                v[9] = (f2ord(va[0] + vb[9]) & ~255) | 9;
                v[10] = (f2ord(va[0] + vb[10]) & ~255) | 10;
                v[11] = (f2ord(va[0] + vb[11]) & ~255) | 11;
                v[12] = (f2ord(va[0] + vb[12]) & ~255) | 12;
                v[13] = (f2ord(va[0] + vb[13]) & ~255) | 13;
                v[14] = (f2ord(va[0] + vb[14]) & ~255) | 14;
                v[15] = (f2ord(va[0] + vb[15]) & ~255) | 15;
                sort16_desc(v);
#pragma unroll
                for (int i = 0; i < 16; ++i) c[i] = v[i];
            }
            {
                int v[16];
                v[0] = (f2ord(va[1] + vb[0]) & ~255) | 16;
                v[1] = (f2ord(va[1] + vb[1]) & ~255) | 17;
                v[2] = (f2ord(va[1] + vb[2]) & ~255) | 18;
                v[3] = (f2ord(va[1] + vb[3]) & ~255) | 19;
                v[4] = (f2ord(va[1] + vb[4]) & ~255) | 20;
                v[5] = (f2ord(va[1] + vb[5]) & ~255) | 21;
                v[6] = (f2ord(va[1] + vb[6]) & ~255) | 22;
                v[7] = (f2ord(va[1] + vb[7]) & ~255) | 23;
                v[8] = (f2ord(va[2] + vb[0]) & ~255) | 32;
                v[9] = (f2ord(va[2] + vb[1]) & ~255) | 33;
                v[10] = (f2ord(va[2] + vb[2]) & ~255) | 34;
                v[11] = (f2ord(va[2] + vb[3]) & ~255) | 35;
                v[12] = (f2ord(va[2] + vb[4]) & ~255) | 36;
                v[13] = (f2ord(va[3] + vb[0]) & ~255) | 48;
                v[14] = (f2ord(va[3] + vb[1]) & ~255) | 49;
                v[15] = (f2ord(va[3] + vb[2]) & ~255) | 50;
                sort16_desc(v);
                merge16_desc(c, v);
            }
            {
                int v[16];
                v[0] = (f2ord(va[3] + vb[3]) & ~255) | 51;
                v[1] = (f2ord(va[4] + vb[0]) & ~255) | 64;
                v[2] = (f2ord(va[4] + vb[1]) & ~255) | 65;
                v[3] = (f2ord(va[4] + vb[2]) & ~255) | 66;
                v[4] = (f2ord(va[5] + vb[0]) & ~255) | 80;
                v[5] = (f2ord(va[5] + vb[1]) & ~255) | 81;
                v[6] = (f2ord(va[6] + vb[0]) & ~255) | 96;
                v[7] = (f2ord(va[6] + vb[1]) & ~255) | 97;
                v[8] = (f2ord(va[7] + vb[0]) & ~255) | 112;
                v[9] = (f2ord(va[7] + vb[1]) & ~255) | 113;
                v[10] = (f2ord(va[8] + vb[0]) & ~255) | 128;
                v[11] = (f2ord(va[9] + vb[0]) & ~255) | 144;
                v[12] = (f2ord(va[10] + vb[0]) & ~255) | 160;
                v[13] = (f2ord(va[11] + vb[0]) & ~255) | 176;
                v[14] = (f2ord(va[12] + vb[0]) & ~255) | 192;
                v[15] = (f2ord(va[13] + vb[0]) & ~255) | 208;
                sort16_desc(v);
                merge16_desc(c, v);
            }
            {
                int v[16];
                v[0] = (f2ord(va[14] + vb[0]) & ~255) | 224;
                v[1] = (f2ord(va[15] + vb[0]) & ~255) | 240;
                v[2] = (int)0x80000000;
                v[3] = (int)0x80000000;
                v[4] = (int)0x80000000;
                v[5] = (int)0x80000000;
                v[6] = (int)0x80000000;
                v[7] = (int)0x80000000;
                v[8] = (int)0x80000000;
                v[9] = (int)0x80000000;
                v[10] = (int)0x80000000;
                v[11] = (int)0x80000000;
                v[12] = (int)0x80000000;
                v[13] = (int)0x80000000;
                v[14] = (int)0x80000000;
                v[15] = (int)0x80000000;
                sort16_desc(v);
                merge16_desc(c, v);
            }
            const float smax = ord2f(c[0] & ~255);
            float pe[16]; float psum = 0.f;
#pragma unroll
            for (int k = 0; k < 16; ++k) { pe[k] = __expf(ord2f(c[k] & ~255) - smax); psum += pe[k]; }
            const float ip = 1.0f / psum;
#pragma unroll
            for (int kk = 0; kk < 4; ++kk) {
                const int ck = (qd == 0) ? c[kk] : (qd == 1) ? c[4 + kk] : (qd == 2) ? c[8 + kk] : c[12 + kk];
                const float pk_ = (qd == 0) ? pe[kk] : (qd == 1) ? pe[4 + kk] : (qd == 2) ? pe[8 + kk] : pe[12 + kk];
                const int ij = ck & 255, ii = ij >> 4, jj = ij & 15;
                int e0 = 0, e1 = 0;
#pragma unroll
                for (int q = 0; q < 16; ++q) { e0 = (ii == q) ? (a0[q] & 127) : e0; e1 = (jj == q) ? (a1[q] & 127) : e1; }
                const int e = e0 * PEER_KEYS + e1;
                const float su = SCU[layer * 16384 + e], sv = SCV[layer * 16384 + e];
                const int k = 4 * qd + kk;
                EI[(size_t)t * NSEL + h * 16 + k] = (unsigned)e | (f2bf(su) << 16);
                EG[(size_t)t * NSEL + h * 16 + k] = pk_ * ip * sv;
            }
                    }
                }
                __syncthreads();
            }
        }
} }
        }
        }
#endif
        GRID_BAR();

#ifndef SKIP_P10
#define P10_CENSUS \
        unsigned myx_, nx_ = 1u, smask_ = 0u; { unsigned cnt_[16]; unsigned* bw_ = (unsigned*)(args.ws + WS_CTL) + CW_BAR; \
            _Pragma("unroll") for (int j = 0; j < 16; ++j) cnt_[j] = (unsigned)__builtin_amdgcn_readfirstlane((int)xb_ld(&bw_[XB_XCNT(j)])); \
            myx_ = xb_xcc_id(); unsigned np_ = 0u; \
            _Pragma("unroll") for (int j = 0; j < 16; ++j) { np_ += (cnt_[j] > 0u) ? 1u : 0u; nx_ = ((unsigned)j == myx_) ? cnt_[j] : nx_; } \
            if (np_ == 0u) np_ = 1u; if (nx_ == 0u) nx_ = 1u; \
            _Pragma("unroll") for (int sl = 0; sl < 8; ++sl) { const unsigned k_ = (unsigned)sl % np_; unsigned seen_ = 0u, srv_ = 0xffu; \
                _Pragma("unroll") for (int j = 0; j < 16; ++j) { if (cnt_[j] > 0u) { srv_ = (seen_ == k_) ? (unsigned)j : srv_; ++seen_; } } \
                smask_ |= (srv_ == myx_) ? (1u << sl) : 0u; } } \
        const int rank_ = (int)__builtin_amdgcn_readfirstlane((int)MISC[12]); const int wstride_ = (int)nx_ * NWAVES; (void)rank_; (void)wstride_;
        { PHASE_PTRS LAYER_PTRS
        { const int ln = lane_id_v(); const int c = ln & 7, tg = ln >> 3;
          P10_CENSUS
          float* PART = (float*)(wsq + WS_PART);
          const unsigned char* U8l = U8 + (size_t)layer * 16384 * D;
          for (int rep_ = 0; rep_ < REP_P10A; ++rep_)
#pragma unroll 1
          for (int sl = 0; sl < 8; ++sl) {
            if (!((smask_ >> sl) & 1u)) continue;
            const int ws0 = (rank_ * NWAVES + wave) * 8, nslot = wstride_ * 8;
            if (ws0 >= T_EFF) continue;
            const int niter = (T_EFF - ws0 + nslot - 1) / nslot, nb = niter * 8;
#define A_TOK(bi) (ws0 + tg + (min((bi), nb - 1) >> 3) * nslot)
#define A_LOAD_PK(pkv, bi) { const GAS v4u* wp_ = (const GAS v4u*)(EI + (size_t)A_TOK(bi) * NSEL + 16 * (min((bi), nb - 1) & 7)); _Pragma("unroll") for (int q = 0; q < 4; ++q) pkv[q] = wp_[q]; }
#define A_ISSUE(rowv, pkv) { _Pragma("unroll") for (int q = 0; q < 16; ++q) rowv[q] = *(const GAS v4u*)(U8l + (size_t)(pkv[q >> 2][q & 3] & 0xffffu) * D + 128 * sl + 16 * c); }
#define A_LOAD_H(hvv, bi) { const int tq_ = A_TOK(bi); _Pragma("unroll") for (int j = 0; j < 4; ++j) hvv[j] = *(const GAS v2u*)(H + (size_t)tq_ * D + 256 * j + 32 * sl + 4 * c); }
#define A_QUANT(hvv) { float hf[16]; float am_ = 0.f; \
                _Pragma("unroll") for (int j = 0; j < 4; ++j) { hf[4 * j] = bf2f(hvv[j].x & 0xffffu); hf[4 * j + 1] = bf2f(hvv[j].x >> 16); hf[4 * j + 2] = bf2f(hvv[j].y & 0xffffu); hf[4 * j + 3] = bf2f(hvv[j].y >> 16); } \
                _Pragma("unroll") for (int i = 0; i < 16; ++i) am_ = fmaxf(am_, fabsf(hf[i])); \
                am_ = fmaxf(am_, dpp_mov<0xB1>(am_)); am_ = fmaxf(am_, dpp_mov<0x4E>(am_)); am_ = fmaxf(am_, dpp_mov<0x141>(am_)); am_ = fmaxf(am_, 1e-20f); \
                sh_ = am_ * (1.0f / 127.0f); const float ih_ = 127.0f / am_; \
                _Pragma("unroll") for (int j = 0; j < 4; ++j) { const int q0 = __float2int_rn(hf[4 * j] * ih_), q1 = __float2int_rn(hf[4 * j + 1] * ih_), q2 = __float2int_rn(hf[4 * j + 2] * ih_), q3 = __float2int_rn(hf[4 * j + 3] * ih_); \
                    hq_[j] = (int)((unsigned)(q0 & 255) | ((unsigned)(q1 & 255) << 8) | ((unsigned)(q2 & 255) << 16) | ((unsigned)q3 << 24)); } }
#define A_COMPUTE(rowv, bi) { int p_[16]; \
                _Pragma("unroll") for (int q = 0; q < 16; ++q) { int ia = 0; _Pragma("unroll") for (int j = 0; j < 4; ++j) ia = __builtin_amdgcn_sdot4((int)rowv[q][j], hq_[j], ia, false); p_[q] = ia; } \
                { const bool up = (c & 4) != 0; _Pragma("unroll") for (int i = 0; i < 8; ++i) { const int send = up ? p_[i] : p_[8 + i], keep = up ? p_[8 + i] : p_[i]; p_[i] = keep + __builtin_amdgcn_update_dpp(0, send, 0x141, 0xF, 0xF, true); } } \
                { const bool up = (c & 2) != 0; _Pragma("unroll") for (int i = 0; i < 4; ++i) { const int send = up ? p_[i] : p_[4 + i], keep = up ? p_[4 + i] : p_[i]; p_[i] = keep + __builtin_amdgcn_update_dpp(0, send, 0x4E, 0xF, 0xF, true); } } \
                { const bool up = (c & 1) != 0; _Pragma("unroll") for (int i = 0; i < 2; ++i) { const int send = up ? p_[i] : p_[2 + i], keep = up ? p_[2 + i] : p_[i]; p_[i] = keep + __builtin_amdgcn_update_dpp(0, send, 0xB1, 0xF, 0xF, true); } } \
                f32x2 r2_; r2_.x = (float)p_[0] * sh_; r2_.y = (float)p_[1] * sh_; \
                *(GAS f32x2*)(PART + ((size_t)sl * T_ALL + (ws0 + tg + ((bi) >> 3) * nslot)) * NSEL + 16 * ((bi) & 7) + 2 * c) = r2_; }
            v4u pkA[4], pkB[4]; v4u rowA[16], rowB[16]; v2u hN[4]; int hq_[4] = {0, 0, 0, 0}; float sh_ = 0.f;
            A_LOAD_PK(pkA, 0) A_LOAD_PK(pkB, 1) A_LOAD_H(hN, 0)
            A_ISSUE(rowA, pkA)
#pragma unroll 1
            for (int bi = 0; bi < nb; bi += 2) {
                if ((bi & 7) == 0) { A_QUANT(hN) A_LOAD_H(hN, bi + 8) }
                A_ISSUE(rowB, pkB) A_LOAD_PK(pkA, bi + 2)
                __builtin_amdgcn_sched_barrier(0);
                A_COMPUTE(rowA, bi)
                __builtin_amdgcn_sched_barrier(0);
                A_ISSUE(rowA, pkA) A_LOAD_PK(pkB, bi + 3)
                __builtin_amdgcn_sched_barrier(0);
                A_COMPUTE(rowB, bi + 1)
                __builtin_amdgcn_sched_barrier(0);
            }
#undef A_TOK
#undef A_LOAD_PK
#undef A_ISSUE
#undef A_LOAD_H
#undef A_QUANT
#undef A_COMPUTE
          }
        } }
        GRID_BAR();
        { PHASE_PTRS LAYER_PTRS
        { const int ln = lane_id_v();
          const float* PART = (const float*)(wsq + WS_PART); float* WGT = (float*)(wsq + WS_WGT);
          for (int rep_ = 0; rep_ < REP_P10B; ++rep_)
          for (int i = vcu * NTHREADS + wave * 64 + ln; i < T_EFF * NSEL; i += NGT) {
              float dsum = 0.f;
#pragma unroll
              for (int sl = 0; sl < 8; ++sl) dsum += PART[(size_t)sl * T_ALL * NSEL + i];
              const unsigned esu = EI[i];
              const float dot = dsum * bf2f(esu >> 16);
              ((unsigned*)WGT)[i] = (esu & 0xffffu) | (f2bf(0.5f * dot * (1.0f + erff(dot * 0.70710678118654752f)) * EG[i]) << 16);
          }
        } }
        GRID_BAR();
        { PHASE_PTRS LAYER_PTRS
        { const int ln = lane_id_v(); const int c = ln & 7, tg = ln >> 3;
          P10_CENSUS
          const unsigned* WGT = (const unsigned*)(wsq + WS_WGT); float* XO = (float*)(wsq + WS_XO);
          const unsigned char* V8l = V8 + (size_t)layer * 16384 * D;
          for (int rep_ = 0; rep_ < REP_P10C; ++rep_)
#pragma unroll 1
          for (int sl = 0; sl < 8; ++sl) {
            if (!((smask_ >> sl) & 1u)) continue;
            const int ws0 = (rank_ * NWAVES + wave) * 8, nslot = wstride_ * 8;
            if (ws0 >= T_EFF) continue;
            const int niter = (T_EFF - ws0 + nslot - 1) / nslot, nb = niter * 8;
#define C_TOK(bi) (ws0 + tg + (min((bi), nb - 1) >> 3) * nslot)
#define C_LOAD_PK(pkv, bi) { const GAS v4u* wp_ = (const GAS v4u*)(WGT + (size_t)C_TOK(bi) * NSEL + 16 * (min((bi), nb - 1) & 7)); _Pragma("unroll") for (int q = 0; q < 4; ++q) pkv[q] = wp_[q]; }
#define C_ISSUE(rowv, wv, pkv) { _Pragma("unroll") for (int q = 0; q < 16; ++q) { const unsigned w_ = pkv[q >> 2][q & 3]; rowv[q] = *(const GAS v4u*)(V8l + (size_t)(w_ & 0xffffu) * D + 128 * sl + 16 * c); } \
                _Pragma("unroll") for (int q = 0; q < 8; ++q) wv[q] = (pkv[q >> 1][(2 * q) & 3] >> 16) | (pkv[q >> 1][(2 * q + 1) & 3] & 0xffff0000u); }
#define C_COMPUTE(rowv, wv) { _Pragma("unroll") for (int q = 0; q < 16; ++q) { const float wq_ = (q & 1) ? __builtin_bit_cast(float, wv[q >> 1] & 0xffff0000u) : bf2f(wv[q >> 1] & 0xffffu); const f32x2 w2_ = (f32x2){wq_, wq_}; _Pragma("unroll") for (int j = 0; j < 4; ++j) { \
                    const f32x2 a = __builtin_amdgcn_cvt_pk_f32_fp8((int)rowv[q][j], false), b = __builtin_amdgcn_cvt_pk_f32_fp8((int)rowv[q][j], true); \
                    f32x2 lo_ = (f32x2){o[j].x, o[j].y}, hi_ = (f32x2){o[j].z, o[j].w}; lo_ = __builtin_elementwise_fma(a, w2_, lo_); hi_ = __builtin_elementwise_fma(b, w2_, hi_); \
                    o[j].x = lo_.x; o[j].y = lo_.y; o[j].z = hi_.x; o[j].w = hi_.y; } \
                    asm volatile("" : "+v"(o[0]), "+v"(o[1]), "+v"(o[2]), "+v"(o[3])); } }
            v4u pkA[4], pkB[4]; unsigned wA[8], wB[8]; v4u rowA[16], rowB[16];
            f32x4 o[4];
#pragma unroll
            for (int j = 0; j < 4; ++j) o[j] = (f32x4){0.f, 0.f, 0.f, 0.f};
            C_LOAD_PK(pkA, 0) C_LOAD_PK(pkB, 1)
            C_ISSUE(rowA, wA, pkA)
#pragma unroll 1
            for (int bi = 0; bi < nb; bi += 2) {
                C_ISSUE(rowB, wB, pkB) C_LOAD_PK(pkA, bi + 2)
                __builtin_amdgcn_sched_barrier(0);
                C_COMPUTE(rowA, wA)
                __builtin_amdgcn_sched_barrier(0);
                C_ISSUE(rowA, wA, pkA) C_LOAD_PK(pkB, bi + 3)
                __builtin_amdgcn_sched_barrier(0);
                C_COMPUTE(rowB, wB)
                __builtin_amdgcn_sched_barrier(0);
                if ((bi & 7) == 6) {
                    const int t = ws0 + tg + (bi >> 3) * nslot;
#pragma unroll
                    for (int j = 0; j < 4; ++j) { *(GAS f32x4*)(XO + (size_t)t * D + 256 * j + 32 * sl + 4 * c) = o[j]; o[j] = (f32x4){0.f, 0.f, 0.f, 0.f}; }
                }
            }
#undef C_TOK
#undef C_LOAD_PK
#undef C_ISSUE
#undef C_COMPUTE
          }
        } }
        GRID_BAR();
#undef P10_CENSUS
        { PHASE_PTRS LAYER_PTRS
        { const int ln = lane_id_v();
          const float* XO = (const float*)(wsq + WS_XO);
          f32x4 gt2v[4], gm[4], shv[4];
          auto prep = [&](int midx) {
              const float* md = modl + (size_t)midx * 6 * D; const float* md1 = modl + (size_t)(3 + midx) * 6 * D;
#pragma unroll
              for (int j = 0; j < 4; ++j) {
                  gt2v[j] = *((const GAS f32x4*)(md + 5 * D) + ln + 64 * j);
                  if (!last) { const f32x4 g = *((const GAS f32x4*)(IN_[I_G1] + (layer + 1) * D) + ln + 64 * j); const f32x4 sc = *((const GAS f32x4*)(md1 + D) + ln + 64 * j);
                               gm[j] = g * (sc + 1.0f); shv[j] = *((const GAS f32x4*)(md1 + 0) + ln + 64 * j); }
                  else { gm[j] = *((const GAS f32x4*)IN_[I_GFINAL] + ln + 64 * j); shv[j] = (f32x4){0.f, 0.f, 0.f, 0.f}; }
              } };
          auto row = [&](int t) {
              GAS f32x4* xr = (GAS f32x4*)(X + (size_t)t * D) + ln;
              const GAS f32x4* xo = (const GAS f32x4*)(XO + (size_t)t * D) + ln;
              f32x4 xn[4]; float ss = 0.f;
#pragma unroll
              for (int j = 0; j < 4; ++j) { xn[j] = xr[64 * j] + gt2v[j] * xo[64 * j]; ss += (xn[j].x * xn[j].x + xn[j].y * xn[j].y) + (xn[j].z * xn[j].z + xn[j].w * xn[j].w); }
              const float rs = 1.0f / sqrtf(wave_sum(ss) * (1.f / D) + NORM_EPS);
              if (!last) {
                  GAS v2u* o8 = (GAS v2u*)(H + (size_t)t * D) + ln;
#pragma unroll
                  for (int j = 0; j < 4; ++j) { xr[64 * j] = xn[j]; const f32x4 hh = xn[j] * rs * gm[j] + shv[j]; v2u o; o.x = pk2(hh.x, hh.y); o.y = pk2(hh.z, hh.w); o8[64 * j] = o; }
              } else {
                  GAS f32x4* op = (GAS f32x4*)(((float*)IN_[22]) + (size_t)t * D) + ln;
#pragma unroll
                  for (int j = 0; j < 4; ++j) op[64 * j] = xn[j] * rs * gm[j];
              } };
          wave_row_blocks(T_EFF, gw, NGW, prep, row);
        } }
#endif
        if (!last) GRID_BAR();
    }
}

extern "C" void kernel_launch(void* const* d_in, const int* in_sizes, int n_in, void* d_out, int out_size, void* d_ws, size_t ws_size, hipStream_t stream) {
    static int grid = 0;
    if (grid == 0) {
        if (n_in != 22 || out_size != T_LAT * D || ws_size < WS_END) { fprintf(stderr, "kernel_launch: unexpected shapes: n_in %d out %d ws %zu (need %zu)\n", n_in, out_size, ws_size, (size_t)WS_END); grid = -1; return; }
        int dev = 0, cus = 0, per_cu = 0;
        if (hipGetDevice(&dev) != hipSuccess || hipDeviceGetAttribute(&cus, hipDeviceAttributeMultiprocessorCount, dev) != hipSuccess) { fprintf(stderr, "device query failed\n"); grid = -1; return; }
        if (hipFuncSetAttribute((const void*)mega_fwd, hipFuncAttributeMaxDynamicSharedMemorySize, LDS_BYTES) != hipSuccess) { fprintf(stderr, "hipFuncSetAttribute failed\n"); grid = -1; return; }
        if (hipOccupancyMaxActiveBlocksPerMultiprocessor(&per_cu, (const void*)mega_fwd, NTHREADS, LDS_BYTES) != hipSuccess || per_cu < 1) { fprintf(stderr, "occupancy query: %d\n", per_cu); }
        (void)hipGetLastError();
        grid = cus;
    }
    if (grid < 0) return;
    if (hipMemsetAsync((char*)d_ws + WS_CTL, 0, CTL_ZERO_BYTES, stream) != hipSuccess) { fprintf(stderr, "memset failed\n"); return; }
    Args a{};
    for (int i = 0; i < 22; ++i) a.in[i] = (const float*)d_in[i];
    a.out = (float*)d_out; a.ws = (unsigned char*)d_ws;
    hipLaunchKernelGGL(mega_fwd, dim3(grid), dim3(NTHREADS), LDS_BYTES, stream, a);
}
```

```cpp
#include <hip/hip_runtime.h>
#include <cstdio>
#include <cstdint>

#ifndef REP_P0
#define REP_P0 1
#endif
#ifndef REP_P1
#define REP_P1 1
#endif
#ifndef REP_P2
#define REP_P2 1
#endif
#ifndef REP_P3A
#define REP_P3A 1
#endif
#ifndef REP_P3B
#define REP_P3B 1
#endif
#ifndef REP_P4
#define REP_P4 1
#endif
#ifndef REP_P6
#define REP_P6 1
#endif
#ifndef REP_P7
#define REP_P7 1
#endif
#ifndef REP_P8
#define REP_P8 1
#endif
#ifndef REP_P9
#define REP_P9 1
#endif
#ifndef REP_P10
#define REP_P10 1
#endif
#ifndef REP_P10A
#define REP_P10A 1
#endif
#ifndef REP_P10C
#define REP_P10C 1
#endif
#ifndef REP_P10B
#define REP_P10B 1
#endif
#ifndef REP_P0A
#define REP_P0A 1
#endif
#ifndef REP_P0D
#define REP_P0D 1
#endif
#ifndef REP_P0F
#define REP_P0F 1
#endif
#ifndef REP_P3C
#define REP_P3C 1
#endif
#define GAS __attribute__((address_space(1)))
#define LAS __attribute__((address_space(3)))
typedef unsigned short bf16;
typedef float f32x4 __attribute__((ext_vector_type(4)));
typedef short bf16x8 __attribute__((ext_vector_type(8)));
typedef unsigned v4u __attribute__((ext_vector_type(4)));
typedef unsigned v2u __attribute__((ext_vector_type(2)));
typedef float f32x2 __attribute__((ext_vector_type(2)));
typedef GAS unsigned gu32;

constexpr int NWAVES = 8, NTHREADS = 512;
constexpr int D = 1024, BATCH = 2, SEQ = 8192, DEPTH = 2, GRID_W = 64, CTX = 256;
constexpr int T_LAT = BATCH * SEQ;
constexpr int T_ALL = T_LAT + BATCH * CTX;
constexpr int NTOK = SEQ + CTX;
constexpr int IN_W = 6912;
constexpr int PEER_HEADS = 8, PEER_KEYS = 128, PEER_TOPK = 16, NSEL = PEER_HEADS * PEER_TOPK;
constexpr float NORM_EPS = 1e-6f;
constexpr float LOG2E = 1.4426950408889634f;
constexpr float SCL2 = 0.125f * LOG2E;

constexpr size_t MiB = 1u << 20;
constexpr size_t WS_CTL = 0, CTL_ZERO_BYTES = 1 * MiB;
constexpr int CW_BAR = 4096;
constexpr int CW_RANK = 8192;
#ifndef P10_SLICED
#define P10_SLICED 1
#endif
constexpr size_t WS_MOD = 65536;
constexpr size_t WS_COS = 2 * MiB, WS_SIN = 3 * MiB;
constexpr size_t WS_WIN = 4 * MiB;
constexpr size_t WS_WB = 31 * MiB;
constexpr size_t WS_WO = 37 * MiB;
constexpr size_t WS_WQ = 41 * MiB;
constexpr size_t WS_KEYS = 49 * MiB;
constexpr size_t WS_X = 50 * MiB;
constexpr size_t WS_H = 116 * MiB;
constexpr size_t WS_Y = 149 * MiB;
constexpr size_t WS_MG = WS_H;
constexpr size_t WS_U8 = 199 * MiB;
constexpr size_t WS_SCU = 231 * MiB;
constexpr size_t WS_EI = 232 * MiB;
constexpr size_t WS_EG = 241 * MiB;
constexpr size_t WS_P = 250 * MiB;
constexpr size_t SZ_R512 = (size_t)T_ALL * 512 * 2;
constexpr size_t SZ_R128 = (size_t)T_ALL * 128 * 2;
constexpr size_t WS_AQ = WS_P, WS_AK = WS_AQ + SZ_R512, WS_AVT = WS_AK + SZ_R128, WS_BQ = WS_AVT + SZ_R128, WS_BK = WS_BQ + SZ_R512,
                 WS_BVT = WS_BK + SZ_R512, WS_CQ = WS_BVT + SZ_R512, WS_CK = WS_CQ + SZ_R512, WS_CVT = WS_CK + SZ_R512, WS_SG = WS_CVT + SZ_R512;
constexpr size_t WS_Q2 = WS_P;
constexpr size_t WS_SC = WS_P + 66 * MiB;
constexpr size_t WS_PART = WS_P, WS_XO = WS_P + 66 * MiB, WS_WGT = WS_P + 132 * MiB;
constexpr size_t WS_PEND = WS_SG + (size_t)T_ALL * 3072 * 2;
constexpr size_t WS_V8 = 473 * MiB;
constexpr size_t WS_END = WS_V8 + 32 * MiB;
static_assert(WS_SC + (size_t)T_ALL * 2048 * 4 <= WS_PEND && WS_PEND <= WS_V8, "alias map");
static_assert(WS_END <= 512 * MiB, "ws map");

constexpr int LDS_BYTES = 147456;
constexpr int MISC_OFF = 131072 + 320;

__device__ __forceinline__ int lane_id_v() { int l; asm volatile("v_mbcnt_lo_u32_b32 %0, -1, 0\n\tv_mbcnt_hi_u32_b32 %0, -1, %0" : "=v"(l)); return l; }
#define XB_TMO      128
#define XB_XCNT(j)  (256  + 64 * (j))
#define XB_XSUB(j)  (1280 + 64 * (j))
#define XB_XGEN(j)  (2304 + 64 * (j))
#define XB_TOP      3328
#define XB_TOPGEN   3392
#define XCD_BAR_WORDS 3456
#define XB_SPIN_CAP (1u << 24)

__device__ __forceinline__ unsigned xb_ld(unsigned* p)              { return __hip_atomic_load(p, __ATOMIC_RELAXED, __HIP_MEMORY_SCOPE_AGENT); }
__device__ __forceinline__ unsigned xb_add(unsigned* p, unsigned v) { return __hip_atomic_fetch_add(p, v, __ATOMIC_RELAXED, __HIP_MEMORY_SCOPE_AGENT); }
__device__ __forceinline__ unsigned xb_xcc_id() { return (unsigned)__builtin_amdgcn_s_getreg((3 << 11) | 20) & 0xFu; }
#define XB_SPIN(cond, bar) do { unsigned _sp = 0; while (cond) { __builtin_amdgcn_s_sleep(1); \
    if ((++_sp & 255u) == 0u) { if (xb_ld(&(bar)[XB_TMO])) break; if (_sp > XB_SPIN_CAP) { atomicAdd(&(bar)[XB_TMO], 1u); break; } } } } while (0)

struct XcdBarrier { unsigned* bar; unsigned x; volatile LAS unsigned* st; };

__device__ __forceinline__ XcdBarrier xcd_barrier_post(unsigned* bar, volatile LAS unsigned* st) {
    XcdBarrier b; b.bar = bar; b.x = xb_xcc_id(); b.st = st;
    if (threadIdx.x == 0) (void)xb_add(&bar[XB_XCNT(b.x)], 1u);
    return b;
}
__device__ __forceinline__ void xcd_barrier_complete(unsigned* bar, unsigned x, unsigned& nloc, unsigned& nx) {
    const unsigned G = gridDim.x * gridDim.y * gridDim.z;
    unsigned sum, cnt, mine, sp = 0u;
    for (;;) {
        sum = 0u; cnt = 0u; mine = 0u;
#pragma unroll
        for (unsigned j = 0; j < 16; ++j) { const unsigned c = xb_ld(&bar[XB_XCNT(j)]); sum += c; cnt += (c > 0u) ? 1u : 0u; mine = (j == x) ? c : mine; }
        if (sum == G) break;
        __builtin_amdgcn_s_sleep(1);
        if ((++sp & 255u) == 0u) { if (xb_ld(&bar[XB_TMO])) break; if (sp > XB_SPIN_CAP) { atomicAdd(&bar[XB_TMO], 1u); break; } }
    }
    nloc = mine > 0u ? mine : 1u; nx = cnt > 0u ? cnt : 1u;
}
__device__ __forceinline__ void xcd_barrier(const XcdBarrier& b, bool t0) {
    asm volatile("s_waitcnt vmcnt(0)" ::: "memory");
    __syncthreads();
    if (t0) {
        unsigned* bar = b.bar;
        __builtin_amdgcn_s_waitcnt(0);
        unsigned nloc = b.st[0], nx = b.st[1];
        if (nloc == 0u) { xcd_barrier_complete(bar, b.x, nloc, nx); b.st[0] = nloc; b.st[1] = nx; }
        const unsigned old = xb_add(&bar[XB_XSUB(b.x)], 1u);
        const unsigned gen = old / nloc;
        if (old + 1u == (gen + 1u) * nloc) {
            __builtin_amdgcn_fence(__ATOMIC_RELEASE, "agent");
            asm volatile("s_waitcnt vmcnt(0)" ::: "memory");
            const unsigned og = xb_add(&bar[XB_TOP], 1u);
            const unsigned tg = og / nx;
            if (og + 1u == (tg + 1u) * nx) xb_add(&bar[XB_TOPGEN], 1u);
            else XB_SPIN(xb_ld(&bar[XB_TOPGEN]) == tg, bar);
            __builtin_amdgcn_fence(__ATOMIC_ACQUIRE, "agent");
            xb_add(&bar[XB_XGEN(b.x)], 1u);
            asm volatile("s_waitcnt vmcnt(0)" ::: "memory");
        } else {
            XB_SPIN(xb_ld(&bar[XB_XGEN(b.x)]) == gen, bar);
            __builtin_amdgcn_fence(__ATOMIC_ACQUIRE, "agent");
            asm volatile("s_waitcnt vmcnt(0)" ::: "memory");
        }
    }
    __syncthreads();
}

__device__ __forceinline__ unsigned f2bf(float f) { unsigned u = __builtin_bit_cast(unsigned, f); return (u + 0x7fffu + ((u >> 16) & 1u)) >> 16; }
__device__ __forceinline__ unsigned pk2(float lo, float hi) { return f2bf(lo) | (f2bf(hi) << 16); }
__device__ __forceinline__ float bf2f(unsigned h) { return __builtin_bit_cast(float, h << 16); }
template <int CTRL> __device__ __forceinline__ float dpp_mov(float v) { return __builtin_bit_cast(float, __builtin_amdgcn_update_dpp(0, __builtin_bit_cast(int, v), CTRL, 0xF, 0xF, true)); }
__device__ __forceinline__ float sum8_dpp(float v) { v += dpp_mov<0xB1>(v); v += dpp_mov<0x4E>(v); v += dpp_mov<0x141>(v); return v; }
template <int K> __device__ __forceinline__ float xshfl_l(float v, int lane) { return __builtin_bit_cast(float, __builtin_amdgcn_ds_bpermute((lane ^ K) << 2, __builtin_bit_cast(int, v))); }
template <int K> __device__ __forceinline__ float xshfl(float v) { return xshfl_l<K>(v, lane_id_v()); }
__device__ __forceinline__ float xadd32(float v) { return v + xshfl_l<32>(v, lane_id_v()); }
__device__ __forceinline__ float xmax32(float v) { return fmaxf(v, xshfl_l<32>(v, lane_id_v())); }
__device__ __forceinline__ float wave_sum(float v) { const int l = lane_id_v(); v += xshfl_l<1>(v, l); v += xshfl_l<2>(v, l); v += xshfl_l<4>(v, l); v += xshfl_l<8>(v, l); v += xshfl_l<16>(v, l); v += xshfl_l<32>(v, l); return v; }
__device__ __forceinline__ float wave_max(float v) { const int l = lane_id_v(); v = fmaxf(v, xshfl_l<1>(v, l)); v = fmaxf(v, xshfl_l<2>(v, l)); v = fmaxf(v, xshfl_l<4>(v, l)); v = fmaxf(v, xshfl_l<8>(v, l)); v = fmaxf(v, xshfl_l<16>(v, l)); v = fmaxf(v, xshfl_l<32>(v, l)); return v; }


__device__ __forceinline__ float sigmoidf_(float x) { return 1.0f / (1.0f + __expf(-x)); }
__device__ __forceinline__ float sigmoid_fast(float x) { return __builtin_amdgcn_rcpf(1.0f + __builtin_amdgcn_exp2f(-LOG2E * x)); }
__device__ __forceinline__ int row_modidx(int r) { return r < T_LAT ? (r >> 13) : 2; }
__device__ __forceinline__ int row_batch(int r) { return r < T_LAT ? (r >> 13) : ((r - T_LAT) >> 8); }
__device__ __forceinline__ int row_tok(int r) { return r < T_LAT ? (r & (SEQ - 1)) : SEQ + ((r - T_LAT) & (CTX - 1)); }

__device__ __forceinline__ const float* xin_row(const float* x, const float* ctx, int r) { return r < T_LAT ? x + (size_t)r * D : ctx + (size_t)(r - T_LAT) * D; }
template <class Prep, class Row>
__device__ __forceinline__ void wave_row_blocks(int T_rows, int gw, int NGW, Prep prep, Row row) {
    for (int r0 = gw * 8; r0 < T_LAT; r0 += NGW * 8) {
        prep(r0 >> 13);
#pragma unroll 2
        for (int k = 0; k < 8; ++k) row(r0 + k);
    }
    if (T_rows > T_LAT) for (int r = T_LAT + gw; r < T_rows; r += NGW) { prep(2); row(r); }
}
struct Args { const float* in[22]; float* out; unsigned char* ws; };
enum { I_X = 0, I_C, I_CTX, I_CCTX, I_WMOD, I_BMOD, I_G1, I_G2, I_WIN, I_SINK, I_RPB, I_LAMBDA, I_SUBLN, I_WBA, I_WBB, I_WBC, I_WOUT, I_PWQ, I_PKEYS, I_PU, I_PV, I_GFINAL };

__device__ __forceinline__ int rope_perm(int c) {
    if (c < 640 || (c >= 2304 && c < 3328)) { const int w = c & 63; return (c & ~63) + 2 * (w & 31) + (w >> 5); }
    return c;
}
template <bool PERM = false>
__device__ __forceinline__ void p0_transpose_item(const float* W, int K, int N, bf16* WT, LAS float* scr, int item, int lane) {
    const int nblk = N / 32, kb = item / nblk, nb = item % nblk, k0 = 64 * kb, n0 = 32 * nb;
#pragma unroll 8
    for (int i = 0; i < 32; ++i) { const int kk = 2 * i + (lane >> 5); scr[kk * 33 + (lane & 31)] = W[(size_t)(k0 + kk) * N + n0 + (lane & 31)]; }
    asm volatile("s_waitcnt lgkmcnt(0)" ::: "memory");
    const int c = lane & 7;
#pragma unroll
    for (int j = 0; j < 4; ++j) { const int n = (lane >> 3) + 8 * j; const LAS float* s = scr + (8 * c) * 33 + n;
        v4u o; o.x = pk2(s[0 * 33], s[1 * 33]); o.y = pk2(s[2 * 33], s[3 * 33]); o.z = pk2(s[4 * 33], s[5 * 33]); o.w = pk2(s[6 * 33], s[7 * 33]);
        const int nout = PERM ? rope_perm(n0 + n) : (n0 + n);
        *(GAS v4u*)(WT + (size_t)nout * K + k0 + 8 * c) = o; }
    asm volatile("s_waitcnt lgkmcnt(0)" ::: "memory");
}

template <int UNR = 2, int NN = 4>
__device__ __forceinline__ void sgemm_tile(f32x4 (&acc)[4][NN], const bf16* A, int lda, const bf16* Bt, int ldb, int K, int row0, int col0, int lane) {
    const int fr = lane & 15, fq = lane >> 4;
    const bf16* ap = A + (size_t)(row0 + fr) * lda + fq * 8;
    const bf16* bp = Bt + (size_t)(col0 + fr) * ldb + fq * 8;
#pragma unroll UNR
    for (int k = 0; k < K; k += 32) {
        bf16x8 a[4], b[NN];
#pragma unroll
        for (int m = 0; m < 4; ++m) a[m] = *(const GAS bf16x8*)(ap + (size_t)m * 16 * lda + k);
#pragma unroll
        for (int n = 0; n < NN; ++n) b[n] = *(const GAS bf16x8*)(bp + (size_t)n * 16 * ldb + k);
#pragma unroll
        for (int m = 0; m < 4; ++m)
#pragma unroll
            for (int n = 0; n < NN; ++n) acc[m][n] = __builtin_amdgcn_mfma_f32_16x16x32_bf16(a[m], b[n], acc[m][n], 0, 0, 0);
    }
}
template <int UNR>
__device__ __forceinline__ void sgemm32(f32x4 (&acc)[2][2], const bf16* A, int lda, const bf16* Bt, int ldb, int K, int row0, int col0, int lane) {
    const int fr = lane & 15, fq = lane >> 4;
    const bf16* ap = A + (size_t)(row0 + fr) * lda + fq * 8;
    const bf16* bp = Bt + (size_t)(col0 + fr) * ldb + fq * 8;
#pragma unroll 1
    for (int k0 = 0; k0 < K; k0 += 32 * UNR) {
        bf16x8 a[UNR][2], b[UNR][2];
#pragma unroll
        for (int u = 0; u < UNR; ++u)
#pragma unroll
            for (int m = 0; m < 2; ++m) { a[u][m] = *(const GAS bf16x8*)(ap + (size_t)m * 16 * lda + k0 + 32 * u); b[u][m] = *(const GAS bf16x8*)(bp + (size_t)m * 16 * ldb + k0 + 32 * u); }
#pragma unroll
        for (int u = 0; u < UNR; ++u)
#pragma unroll
            for (int m = 0; m < 2; ++m)
#pragma unroll
                for (int n = 0; n < 2; ++n) acc[m][n] = __builtin_amdgcn_mfma_f32_16x16x32_bf16(a[u][m], b[u][n], acc[m][n], 0, 0, 0);
    }
}
__device__ __forceinline__ void zero_acc22(f32x4 (&acc)[2][2]) { acc[0][0] = acc[0][1] = acc[1][0] = acc[1][1] = (f32x4){0.f, 0.f, 0.f, 0.f}; }
template <int NN>
__device__ __forceinline__ void zero_acc(f32x4 (&acc)[4][NN]) {
#pragma unroll
    for (int m = 0; m < 4; ++m)
#pragma unroll
        for (int n = 0; n < NN; ++n) acc[m][n] = (f32x4){0.f, 0.f, 0.f, 0.f};
}

__device__ __forceinline__ int f2ord(float f) { const int b = __builtin_bit_cast(int, f); return b ^ ((b >> 31) & 0x7fffffff); }
__device__ __forceinline__ float ord2f(int o) { const int b = o ^ ((o >> 31) & 0x7fffffff); return __builtin_bit_cast(float, b); }
__device__ __forceinline__ void top16_insert(int (&top)[16], int key) {
#pragma unroll
    for (int i = 0; i < 16; ++i) { const int hi = max(top[i], key); key = min(top[i], key); top[i] = hi; }
}
#define CE(a, b) { const int t_ = max(a, b); b = min(a, b); a = t_; }
__device__ __forceinline__ void sort16_desc(int (&v)[16]) { CE(v[0], v[1]); CE(v[3], v[2]); CE(v[4], v[5]); CE(v[7], v[6]); CE(v[8], v[9]); CE(v[11], v[10]); CE(v[12], v[13]); CE(v[15], v[14]); CE(v[0], v[2]); CE(v[1], v[3]); CE(v[6], v[4]); CE(v[7], v[5]); CE(v[8], v[10]); CE(v[9], v[11]); CE(v[14], v[12]); CE(v[15], v[13]); CE(v[0], v[1]); CE(v[2], v[3]); CE(v[5], v[4]); CE(v[7], v[6]); CE(v[8], v[9]); CE(v[10], v[11]); CE(v[13], v[12]); CE(v[15], v[14]); CE(v[0], v[4]); CE(v[1], v[5]); CE(v[2], v[6]); CE(v[3], v[7]); CE(v[12], v[8]); CE(v[13], v[9]); CE(v[14], v[10]); CE(v[15], v[11]); CE(v[0], v[2]); CE(v[1], v[3]); CE(v[4], v[6]); CE(v[5], v[7]); CE(v[10], v[8]); CE(v[11], v[9]); CE(v[14], v[12]); CE(v[15], v[13]); CE(v[0], v[1]); CE(v[2], v[3]); CE(v[4], v[5]); CE(v[6], v[7]); CE(v[9], v[8]); CE(v[11], v[10]); CE(v[13], v[12]); CE(v[15], v[14]); CE(v[0], v[8]); CE(v[1], v[9]); CE(v[2], v[10]); CE(v[3], v[11]); CE(v[4], v[12]); CE(v[5], v[13]); CE(v[6], v[14]); CE(v[7], v[15]); CE(v[0], v[4]); CE(v[1], v[5]); CE(v[2], v[6]); CE(v[3], v[7]); CE(v[8], v[12]); CE(v[9], v[13]); CE(v[10], v[14]); CE(v[11], v[15]); CE(v[0], v[2]); CE(v[1], v[3]); CE(v[4], v[6]); CE(v[5], v[7]); CE(v[8], v[10]); CE(v[9], v[11]); CE(v[12], v[14]); CE(v[13], v[15]); CE(v[0], v[1]); CE(v[2], v[3]); CE(v[4], v[5]); CE(v[6], v[7]); CE(v[8], v[9]); CE(v[10], v[11]); CE(v[12], v[13]); CE(v[14], v[15]); }
__device__ __forceinline__ void merge16_desc(int (&a)[16], const int (&b)[16]) {
#pragma unroll
    for (int i = 0; i < 16; ++i) a[i] = max(a[i], b[15 - i]);
    CE(a[0], a[8]); CE(a[1], a[9]); CE(a[2], a[10]); CE(a[3], a[11]); CE(a[4], a[12]); CE(a[5], a[13]); CE(a[6], a[14]); CE(a[7], a[15]); CE(a[0], a[4]); CE(a[1], a[5]); CE(a[2], a[6]); CE(a[3], a[7]); CE(a[8], a[12]); CE(a[9], a[13]); CE(a[10], a[14]); CE(a[11], a[15]); CE(a[0], a[2]); CE(a[1], a[3]); CE(a[4], a[6]); CE(a[5], a[7]); CE(a[8], a[10]); CE(a[9], a[11]); CE(a[12], a[14]); CE(a[13], a[15]); CE(a[0], a[1]); CE(a[2], a[3]); CE(a[4], a[5]); CE(a[6], a[7]); CE(a[8], a[9]); CE(a[10], a[11]); CE(a[12], a[13]); CE(a[14], a[15]); }
#undef CE


typedef float f32x16 __attribute__((ext_vector_type(16)));
typedef short s16x4 __attribute__((ext_vector_type(4)));
typedef __bf16 bf16x2_t __attribute__((ext_vector_type(2)));
__device__ __forceinline__ unsigned cvtpk(float lo, float hi) { f32x2 v = {lo, hi}; bf16x2_t b = __builtin_convertvector(v, bf16x2_t); return __builtin_bit_cast(unsigned, b); }
constexpr int CK_PITCH = 144, CV_PITCH = 320;
constexpr int CK_SZ = 64 * CK_PITCH, CV_SZ = 64 * CV_PITCH;
constexpr float C_THR_RAW = 8.0f / SCL2;

template <int NDV, class RowFn, class UseFn, class ElemFn>
__device__ __forceinline__ void attn64_pass(f32x16 (&o)[NDV], float& mrun, float& lpart, const bf16x8 (&qf)[4], const bf16* kg, int kpitch, const bf16* vg, int vpitch,
                                            int ntiles, RowFn tile_row, UseFn use_tile, ElemFn elem, LAS unsigned char* L, int lane, int tid) {
    constexpr int VP = NDV * 64 + 64, VSZ = 64 * VP, NVP = NDV / 2;
    const int r32 = lane & 31, hi = lane >> 5;
    const int krow_s = tid >> 3, kch_s = tid & 7;
    const int vrow_s = (NDV == 2) ? (tid >> 3) : (tid >> 4), vch_s = (NDV == 2) ? (tid & 7) : (tid & 15);
    LAS unsigned char* Kb0 = L; LAS unsigned char* Vb0 = L + 2 * CK_SZ;
    __syncthreads();
    {
        const int tr = tile_row(0);
        const v4u kr = *(const GAS v4u*)(kg + (size_t)tr * kpitch);
        *(LAS v4u*)(Kb0 + krow_s * CK_PITCH + kch_s * 16) = kr;
#pragma unroll
        for (int i = 0; i < NVP; ++i) { const v4u v = *(const GAS v4u*)(vg + (size_t)(tr + 32 * i) * vpitch); *(LAS v4u*)(Vb0 + (vrow_s + 32 * i) * VP + vch_s * 16) = v; }
    }
    v4u kr, vr[NVP];
    { const int tr = tile_row(ntiles > 1 ? 1 : 0); kr = *(const GAS v4u*)(kg + (size_t)tr * kpitch);
#pragma unroll
      for (int i = 0; i < NVP; ++i) vr[i] = *(const GAS v4u*)(vg + (size_t)(tr + 32 * i) * vpitch); }
    __syncthreads();
#pragma unroll 1
    for (int j = 0; j < ntiles; ++j) {
        const int cur = j & 1;
        const LAS unsigned char* Kb = Kb0 + cur * CK_SZ; const LAS unsigned char* Vb = Vb0 + cur * VSZ;
        const bool more = (j + 1 < ntiles);
        v4u kr2, vr2[NVP];
        { const int tr = tile_row(j + 2 < ntiles ? j + 2 : ntiles - 1); kr2 = *(const GAS v4u*)(kg + (size_t)tr * kpitch);
#pragma unroll
            for (int i = 0; i < NVP; ++i) vr2[i] = *(const GAS v4u*)(vg + (size_t)(tr + 32 * i) * vpitch); }
        if (use_tile(j)) {
            f32x16 st[2];
#pragma unroll
            for (int kb = 0; kb < 2; ++kb) {
#pragma unroll
                for (int r = 0; r < 16; ++r) st[kb][r] = 0.f;
#pragma unroll
                for (int ks = 0; ks < 4; ++ks) {
                    const bf16x8 kf = *(const LAS bf16x8*)(Kb + (kb * 32 + r32) * CK_PITCH + ks * 32 + hi * 16);
                    st[kb] = __builtin_amdgcn_mfma_f32_32x32x16_bf16(kf, qf[ks], st[kb], 0, 0, 0);
                }
            }
            elem(st, j);
            float mx = st[0][0];
#pragma unroll
            for (int r = 1; r < 16; ++r) mx = fmaxf(mx, st[0][r]);
#pragma unroll
            for (int r = 0; r < 16; ++r) mx = fmaxf(mx, st[1][r]);
            mx = xmax32(mx);
            if (__builtin_amdgcn_ballot_w64(mx > mrun + C_THR_RAW) != 0ull) {
                const float mn = fmaxf(mrun, mx);
                const float alpha = __builtin_amdgcn_exp2f((mrun - mn) * SCL2);
#pragma unroll
                for (int d = 0; d < NDV; ++d)
#pragma unroll
                    for (int r = 0; r < 16; ++r) o[d][r] *= alpha;
                lpart *= alpha; mrun = mn;
            }
            const float nmc = -mrun * SCL2;
            float ls = 0.f;
#pragma unroll
            for (int kb = 0; kb < 2; ++kb)
#pragma unroll
                for (int r = 0; r < 16; ++r) { const float p = __builtin_amdgcn_exp2f(fmaf(st[kb][r], SCL2, nmc)); st[kb][r] = p; ls += p; }
            lpart += ls;
            const int q4 = (lane & 15) >> 2, p4 = lane & 3, grp = (lane >> 4) & 1;
            const LAS unsigned char* vbase = Vb + (4 * hi + q4) * VP + (16 * grp + 4 * p4) * 2;
#pragma unroll
            for (int kb = 0; kb < 2; ++kb)
#pragma unroll
                for (int ss = 0; ss < 2; ++ss) {
                    v4u pw;
#pragma unroll
                    for (int i2 = 0; i2 < 4; ++i2) pw[i2] = cvtpk(st[kb][8 * ss + 2 * i2], st[kb][8 * ss + 2 * i2 + 1]);
                    const bf16x8 pb = __builtin_bit_cast(bf16x8, pw);
#pragma unroll
                    for (int d = 0; d < NDV; ++d) {
                        const LAS unsigned char* va = vbase + (kb * 32 + 16 * ss) * VP + d * 64;
                        const s16x4 lo = __builtin_bit_cast(s16x4, __builtin_amdgcn_ds_read_tr16_b64_v4i16((LAS s16x4*)va));
                        const s16x4 hh = __builtin_bit_cast(s16x4, __builtin_amdgcn_ds_read_tr16_b64_v4i16((LAS s16x4*)(va + 8 * VP)));
                        const bf16x8 vf = __builtin_shufflevector(lo, hh, 0, 1, 2, 3, 4, 5, 6, 7);
                        o[d] = __builtin_amdgcn_mfma_f32_32x32x16_bf16(vf, pb, o[d], 0, 0, 0);
                    }
                }
        }
        if (more) {
            LAS unsigned char* Kn = Kb0 + (cur ^ 1) * CK_SZ; LAS unsigned char* Vn = Vb0 + (cur ^ 1) * VSZ;
            *(LAS v4u*)(Kn + krow_s * CK_PITCH + kch_s * 16) = kr;
#pragma unroll
            for (int i = 0; i < NVP; ++i) *(LAS v4u*)(Vn + (vrow_s + 32 * i) * VP + vch_s * 16) = vr[i];
        }
        kr = kr2;
#pragma unroll
        for (int i = 0; i < NVP; ++i) vr[i] = vr2[i];
        __syncthreads();
    }
}
__device__ __forceinline__ void attn64_store(const f32x16 (&o)[2], float inv, bf16* yrow, int hi) {
#pragma unroll
    for (int d = 0; d < 2; ++d)
#pragma unroll
        for (int g4 = 0; g4 < 4; ++g4) {
            v2u w; w.x = cvtpk(o[d][4 * g4] * inv, o[d][4 * g4 + 1] * inv); w.y = cvtpk(o[d][4 * g4 + 2] * inv, o[d][4 * g4 + 3] * inv);
            *(GAS v2u*)(yrow + d * 32 + 8 * g4 + 4 * hi) = w;
        }
}

namespace pg8 {
typedef unsigned short bf16_t;
constexpr int BM = 256, BK = 64, HALF = 128, HTB = HALF * BK * 2, STAGE_BYTES = 8 * HTB, NXCD = 8, WGM = 8;
__host__ __device__ __forceinline__ int lds_byte(int r, int c) { const int st = (r >> 4) * 2 + (c >> 5), rr = r & 15, cc = c & 31, ob = rr * 64 + cc * 2; return st * 1024 + (ob ^ (((ob >> 9) & 1) << 5)); }
__host__ __device__ __forceinline__ void stage_rc(int b, int& R, int& C) { const int st = b / 1024, sb = b % 1024, swz = sb ^ (((sb >> 9) & 1) << 5); R = (st >> 1) * 16 + swz / 64; C = (st & 1) * 32 + (swz % 64) / 2; }
__host__ __device__ __forceinline__ int perm32(int rho) { const int n = rho >> 4, i = rho & 15; return 8 * (i >> 2) + 4 * n + (i & 3); }
struct Unit { int pm, pn, seg; };
struct Gemm { const bf16_t* A; const bf16_t* Bt; int lda, ldb, K; size_t a_seg, b_seg; };
struct TileOrder {
    int nM, nN, nwg, G, c;
    __device__ void init(int M, int N, int G_, int c_) { nM = M / BM; nN = N / BM; nwg = nM * nN; G = G_; c = c_; }
    __device__ bool tile(int i, int& pm, int& pn) const {
        const long L = (long)i * G + c; if (L >= nwg) return false;
        int wgid = (int)L; { const int q = nwg / NXCD, r = nwg % NXCD, xcd = wgid % NXCD, off = wgid / NXCD; wgid = (xcd < r ? xcd * (q + 1) : r * (q + 1) + (xcd - r) * q) + off; }
        const int nig = WGM * nN, gid = wgid / nig, fm = gid * WGM, gsz = (nM - fm) < WGM ? (nM - fm) : WGM;
        pm = fm + ((wgid % nig) % gsz); pn = (wgid % nig) / gsz; return true;
    }
};
template <int NSEG> struct SegOrder {
    TileOrder T;
    __device__ bool next(int i, Unit& u) const { u.seg = i % NSEG; return T.tile(i / NSEG, u.pm, u.pn); }
};
template <class Epi, class Sched>
__device__ __forceinline__ void gemm_phase(LAS unsigned char* lds, const Gemm g, const Sched& S, const Epi& E, int wid) {
    const int lane = lane_id_v(), tid = wid * 64 + lane,
              wr = wid >> 2, wc = wid & 3, fr = lane & 15, fq = lane >> 4;
    const int K = g.K, nt = K / BK;
    unsigned voffA[2], voffB[2];
#pragma unroll
    for (int i = 0; i < 2; ++i) { int R, C; stage_rc(tid * 16 + i * 8192, R, C); const int Rb = (R & ~31) + perm32(R & 31);
        voffA[i] = (unsigned)(R * g.lda + C) * 2u; voffB[i] = (unsigned)(Rb * g.ldb + C) * 2u; }
    const size_t kstep = (size_t)(BK * 2);
    const size_t hstepA = (size_t)HALF * g.lda * 2, hstepB = (size_t)HALF * g.ldb * 2;
    const unsigned ldsw = (unsigned)wid * 1024u;
    const int aoff = lds_byte(wr * 64 + fr, fq * 8), boff = lds_byte(wc * 32 + fr, fq * 8);
#define PG8_SA(b, h) (((b) * 2 + (h)) * HTB)
#define PG8_SB(b, h) ((4 + (b) * 2 + (h)) * HTB)
#define PG8_STAGE(bufoff, gbase, voff) do { _Pragma("unroll") for (int _i = 0; _i < 2; ++_i) \
        __builtin_amdgcn_global_load_lds((const unsigned*)((const char*)(gbase) + (voff)[_i]), (LAS unsigned*)(lds + (bufoff) + ldsw + _i * 8192), 16, 0, 0); } while (0)
#define PG8_LDA(dst, b, h) do { _Pragma("unroll") for (int m = 0; m < 4; ++m) _Pragma("unroll") for (int k = 0; k < 2; ++k) dst[m][k] = *(const LAS bf16x8*)(lds + PG8_SA(b, h) + aoff + m * 2048 + k * 1024); } while (0)
#define PG8_LDB(dst, b, h) do { _Pragma("unroll") for (int n = 0; n < 2; ++n) _Pragma("unroll") for (int k = 0; k < 2; ++k) dst[n][k] = *(const LAS bf16x8*)(lds + PG8_SB(b, h) + boff + n * 2048 + k * 1024); } while (0)
#define PG8_MMA(ai, bj, At, Bt) do { __builtin_amdgcn_s_setprio(1); _Pragma("unroll") for (int m = 0; m < 4; ++m) _Pragma("unroll") for (int n = 0; n < 2; ++n) _Pragma("unroll") for (int k = 0; k < 2; ++k) \
        acc[ai][bj][m][n] = __builtin_amdgcn_mfma_f32_16x16x32_bf16(Bt[n][k], At[m][k], acc[ai][bj][m][n], 0, 0, 0); __builtin_amdgcn_s_setprio(0); } while (0)
#define PG8_WAIT_V(n) asm volatile("s_waitcnt vmcnt(" #n ")" ::: "memory")
#define PG8_WAIT_L(n) asm volatile("s_waitcnt lgkmcnt(" #n ")" ::: "memory")
#define PG8_BAR __builtin_amdgcn_s_barrier()
#define PG8_SCHED __builtin_amdgcn_sched_barrier(0)
#define PG8_ABASE(u) ((const char*)g.A + ((size_t)(u).seg * g.a_seg + (size_t)(u).pm * BM * g.lda) * 2)
#define PG8_BBASE(u) ((const char*)g.Bt + ((size_t)(u).seg * g.b_seg + (size_t)(u).pn * BM * g.ldb) * 2)
    Unit cur, nxt; int ui = 0;
    if (!S.next(0, cur)) return;
    f32x4 acc[2][2][4][2];
#pragma unroll
    for (int a = 0; a < 2; ++a)
#pragma unroll
        for (int b = 0; b < 2; ++b)
#pragma unroll
            for (int m = 0; m < 4; ++m)
#pragma unroll
                for (int n = 0; n < 2; ++n) acc[a][b][m][n] = (f32x4){0.f, 0.f, 0.f, 0.f};
    bf16x8 At[4][2], B0[2][2], B1[2][2];
    const char* cA = PG8_ABASE(cur); const char* cB = PG8_BBASE(cur);
    PG8_STAGE(PG8_SB(0, 0), cB, voffB); PG8_STAGE(PG8_SB(0, 1), cB + hstepB, voffB); PG8_STAGE(PG8_SA(0, 0), cA, voffA); PG8_STAGE(PG8_SA(0, 1), cA + hstepA, voffA);
    if (wr == 1) PG8_BAR;
    PG8_WAIT_V(2); PG8_BAR;
    PG8_STAGE(PG8_SB(1, 0), cB + kstep, voffB); PG8_STAGE(PG8_SA(1, 0), cA + kstep, voffA); PG8_STAGE(PG8_SB(1, 1), cB + hstepB + kstep, voffB);
    PG8_WAIT_V(6); PG8_BAR;
    for (;;) {
        const bool has_next = S.next(ui + 1, nxt);
        const char* nA = has_next ? PG8_ABASE(nxt) : cA; const char* nB = has_next ? PG8_BBASE(nxt) : cB;
        for (int t = 0; t < nt; t += 2) {
            const bool lastk = (t == nt - 2);
            const char* a1 = cA + (size_t)(t + 1) * kstep;
            const char* a2 = lastk ? nA : cA + (size_t)(t + 2) * kstep; const char* b2 = lastk ? nB : cB + (size_t)(t + 2) * kstep;
            const char* a3 = a2 + kstep; const char* b3 = b2 + kstep;
            PG8_LDB(B0, 0, 0); PG8_LDB(B1, 0, 1); PG8_SCHED; PG8_LDA(At, 0, 0); PG8_STAGE(PG8_SA(1, 1), a1 + hstepA, voffA);
            PG8_WAIT_V(8); PG8_WAIT_L(0); PG8_BAR; PG8_MMA(0, 0, At, B0); PG8_MMA(0, 1, At, B1); PG8_BAR; PG8_SCHED;
            PG8_LDA(At, 0, 1); PG8_STAGE(PG8_SB(0, 0), b2, voffB); PG8_STAGE(PG8_SB(0, 1), b2 + hstepB, voffB); PG8_STAGE(PG8_SA(0, 0), a2, voffA);
            PG8_WAIT_V(8); PG8_WAIT_L(0); PG8_BAR; PG8_MMA(1, 0, At, B0); PG8_MMA(1, 1, At, B1); PG8_BAR; PG8_SCHED;
            PG8_LDB(B0, 1, 0); PG8_LDB(B1, 1, 1); PG8_SCHED; PG8_LDA(At, 1, 0); PG8_STAGE(PG8_SA(0, 1), a2 + hstepA, voffA);
            PG8_WAIT_V(8); PG8_WAIT_L(0); PG8_BAR; PG8_MMA(0, 0, At, B0); PG8_MMA(0, 1, At, B1); PG8_BAR; PG8_SCHED;
            PG8_LDA(At, 1, 1); PG8_STAGE(PG8_SB(1, 0), b3, voffB); PG8_STAGE(PG8_SB(1, 1), b3 + hstepB, voffB); PG8_STAGE(PG8_SA(1, 0), a3, voffA);
            PG8_WAIT_V(8); PG8_WAIT_L(0); PG8_BAR; PG8_MMA(1, 0, At, B0); PG8_MMA(1, 1, At, B1); PG8_BAR; PG8_SCHED;
        }
        if (wr == 0) PG8_BAR;
        E(acc, cur, wr, wc, fr, fq);
        if (!has_next) break;
#pragma unroll
        for (int a = 0; a < 2; ++a)
#pragma unroll
            for (int b = 0; b < 2; ++b)
#pragma unroll
                for (int m = 0; m < 4; ++m)
#pragma unroll
                    for (int n = 0; n < 2; ++n) acc[a][b][m][n] = (f32x4){0.f, 0.f, 0.f, 0.f};
        cur = nxt; cA = nA; cB = nB; ++ui;
        if (wr == 1) PG8_BAR;
    }
    PG8_WAIT_V(0);
    PG8_BAR;
#undef PG8_SA
#undef PG8_SB
#undef PG8_STAGE
#undef PG8_LDA
#undef PG8_LDB
#undef PG8_MMA
#undef PG8_WAIT_V
#undef PG8_WAIT_L
#undef PG8_BAR
#undef PG8_SCHED
#undef PG8_ABASE
#undef PG8_BBASE
}
}

__device__ __forceinline__ v4u pack8(const f32x4& a, const f32x4& b) { v4u w; w.x = cvtpk(a.x, a.y); w.y = cvtpk(a.z, a.w); w.z = cvtpk(b.x, b.y); w.w = cvtpk(b.z, b.w); return w; }
struct EpiInProj {
    bf16 *AQ, *AK, *AVT, *BQ, *BK, *BVT, *CQ, *CK, *CV, *SG; const float *COS, *SIN;
    __device__ __forceinline__ void operator()(const f32x4 (&acc)[2][2][4][2], const pg8::Unit& u, int wr, int wc, int fr, int fq) const {
        asm volatile("" : "+v"(fr), "+v"(fq));
#pragma unroll
        for (int bj = 0; bj < 2; ++bj) {
            const int cblk = u.pn * 256 + bj * 128;
            const int cw = wc * 32 + 8 * fq;
            bf16* dst; int pitch, cbase; int kind;
            int nh = 1, hd = 0;
            if (cblk < 512)       { dst = AQ; pitch = 512; cbase = cblk; kind = 1; }
            else if (cblk < 640)  { dst = AK; pitch = 128; cbase = cblk - 512; kind = 1; }
            else if (cblk < 768)  { dst = AVT; pitch = 128; cbase = cblk - 640; kind = 0; }
            else if (cblk < 1280) { dst = BQ; pitch = 512; cbase = cblk - 768; kind = 0; }
            else if (cblk < 1792) { dst = BK; pitch = 512; cbase = cblk - 1280; kind = 0; }
            else if (cblk < 2304) { dst = BVT; pitch = 512; cbase = cblk - 1792; kind = 0; }
            else if (cblk < 2816) { dst = CQ; pitch = 512; cbase = cblk - 2304; kind = 1; }
            else if (cblk < 3328) { dst = CK; pitch = 512; cbase = cblk - 2816; kind = 1; }
            else if (cblk < 3840) { dst = CV; pitch = 512; cbase = cblk - 3328; kind = 0; }
            else                  { dst = SG; pitch = 3072; cbase = cblk - 3840; kind = 3; }
#pragma unroll
            for (int ai = 0; ai < 2; ++ai)
#pragma unroll
                for (int m = 0; m < 4; ++m) {
                    const int row = u.pm * 256 + ai * 128 + wr * 64 + m * 16 + fr;
                    f32x4 v0 = acc[ai][bj][m][0], v1 = acc[ai][bj][m][1];
                    if (kind == 1) {
                        if (row < T_LAT) {
                            const int t = row & (SEQ - 1), i0 = (cw & 63) >> 1;
                            const f32x4 cs = *(const GAS f32x4*)(COS + t * 32 + i0), sn = *(const GAS f32x4*)(SIN + t * 32 + i0);
                            const f32x4 a = v0, b = v1;
                            v0.x = a.x * cs.x - a.y * sn.x; v0.y = a.y * cs.x + a.x * sn.x; v0.z = a.z * cs.y - a.w * sn.y; v0.w = a.w * cs.y + a.z * sn.y;
                            v1.x = b.x * cs.z - b.y * sn.z; v1.y = b.y * cs.z + b.x * sn.z; v1.z = b.z * cs.w - b.w * sn.w; v1.w = b.w * cs.w + b.z * sn.w;
                        }
                        *(GAS v4u*)(dst + (size_t)row * pitch + cbase + cw) = pack8(v0, v1);
                    } else if (kind == 0) {
                        *(GAS v4u*)(dst + (size_t)row * pitch + cbase + cw) = pack8(v0, v1);
                    } else if (kind == 3) {
                        v0.x = sigmoid_fast(v0.x); v0.y = sigmoid_fast(v0.y); v0.z = sigmoid_fast(v0.z); v0.w = sigmoid_fast(v0.w);
                        v1.x = sigmoid_fast(v1.x); v1.y = sigmoid_fast(v1.y); v1.z = sigmoid_fast(v1.z); v1.w = sigmoid_fast(v1.w);
                        *(GAS v4u*)(dst + (size_t)row * pitch + cbase + cw) = pack8(v0, v1);
                    } else {
                        const int hc = hd + cw, head = hc >> 6, d = hc & 63;
                        const int b = row_batch(row), tok = row_tok(row);
                        bf16* vp = dst + ((size_t)(b * nh + head) * 64 + d) * NTOK + tok;
                        vp[0 * NTOK] = (bf16)f2bf(v0.x); vp[1 * NTOK] = (bf16)f2bf(v0.y); vp[2 * NTOK] = (bf16)f2bf(v0.z); vp[3 * NTOK] = (bf16)f2bf(v0.w);
                        vp[4 * NTOK] = (bf16)f2bf(v1.x); vp[5 * NTOK] = (bf16)f2bf(v1.y); vp[6 * NTOK] = (bf16)f2bf(v1.z); vp[7 * NTOK] = (bf16)f2bf(v1.w);
                    }
                }
        }
    }
};
__device__ __forceinline__ void unpack8(const v4u& w, f32x4& a, f32x4& b) {
    a = (f32x4){bf2f(w.x & 0xffffu), bf2f(w.x >> 16), bf2f(w.y & 0xffffu), bf2f(w.y >> 16)}; b = (f32x4){bf2f(w.z & 0xffffu), bf2f(w.z >> 16), bf2f(w.w & 0xffffu), bf2f(w.w >> 16)};
}
struct EpiBranch {
    const bf16* SG; bf16* MG;
    __device__ __forceinline__ void operator()(const f32x4 (&acc)[2][2][4][2], const pg8::Unit& u, int wr, int wc, int fr, int fq) const {
        asm volatile("" : "+v"(fr), "+v"(fq));
#pragma unroll
        for (int ai = 0; ai < 2; ++ai)
#pragma unroll
            for (int m = 0; m < 4; ++m) {
                const int row = u.pm * 256 + ai * 128 + wr * 64 + m * 16 + fr;
#pragma unroll
                for (int bj = 0; bj < 2; ++bj) {
                    const int col = u.pn * 256 + bj * 128 + wc * 32 + 8 * fq;
                    f32x4 g0, g1; { const v4u wg = *(const GAS v4u*)(SG + (size_t)row * 3072 + u.seg * 1024 + col); unpack8(wg, g0, g1); }
                    f32x4 v0 = g0 * acc[ai][bj][m][0], v1 = g1 * acc[ai][bj][m][1];
                    bf16* mp = MG + (size_t)row * D + col;
                    if (u.seg > 0) { f32x4 p0, p1; const v4u wp = *(const GAS v4u*)mp; unpack8(wp, p0, p1); v0 += p0; v1 += p1; }
                    *(GAS v4u*)mp = pack8(v0, v1);
                }
            }
    }
};
struct EpiOut {
    float* X; const float* gtl; const float* xin; const float* cin;
    __device__ __forceinline__ void operator()(const f32x4 (&acc)[2][2][4][2], const pg8::Unit& u, int wr, int wc, int fr, int fq) const {
        asm volatile("" : "+v"(fr), "+v"(fq));
#pragma unroll
        for (int ai = 0; ai < 2; ++ai)
#pragma unroll
            for (int m = 0; m < 4; ++m) {
                const int row = u.pm * 256 + ai * 128 + wr * 64 + m * 16 + fr;
                const float* gt = gtl + (size_t)row_modidx(row) * 6 * D + 2 * D;
#pragma unroll
                for (int bj = 0; bj < 2; ++bj) {
                    const int col = u.pn * 256 + bj * 128 + wc * 32 + 8 * fq;
                    GAS f32x4* xp = (GAS f32x4*)(X + (size_t)row * D + col);
                    const GAS f32x4* sp = xin ? (const GAS f32x4*)(xin_row(xin, cin, row) + col) : (const GAS f32x4*)xp;
                    const f32x4 g0 = *(const GAS f32x4*)(gt + col), g1 = *(const GAS f32x4*)(gt + col + 4);
                    xp[0] = sp[0] + g0 * acc[ai][bj][m][0]; xp[1] = sp[1] + g1 * acc[ai][bj][m][1];
                }
            }
    }
};
struct EpiStore {
    bf16* O; int ldc;
    __device__ __forceinline__ void operator()(const f32x4 (&acc)[2][2][4][2], const pg8::Unit& u, int wr, int wc, int fr, int fq) const {
        asm volatile("" : "+v"(fr), "+v"(fq));
#pragma unroll
        for (int ai = 0; ai < 2; ++ai)
#pragma unroll
            for (int m = 0; m < 4; ++m) {
                const int row = u.pm * 256 + ai * 128 + wr * 64 + m * 16 + fr;
#pragma unroll
                for (int bj = 0; bj < 2; ++bj) {
                    const int col = u.pn * 256 + bj * 128 + wc * 32 + 8 * fq;
                    *(GAS v4u*)(O + (size_t)row * ldc + col) = pack8(acc[ai][bj][m][0], acc[ai][bj][m][1]);
                }
            }
    }
};

__global__ void __launch_bounds__(NTHREADS, 2) mega_fwd(Args args) {
    extern __shared__ __attribute__((aligned(16))) unsigned char lds[];
    LAS unsigned char* L = (LAS unsigned char*)lds;
    volatile LAS unsigned* MISC = (volatile LAS unsigned*)(L + MISC_OFF);
    const int wave = __builtin_amdgcn_readfirstlane((int)threadIdx.x >> 6);
    const int lane = lane_id_v(), tid = wave * 64 + lane;
    const int fr = lane & 15, fq = lane >> 4;
    const int G = gridDim.x;
    const int vcu = (G % 8 == 0) ? (int)(blockIdx.x % 8) * (G / 8) + (int)(blockIdx.x / 8) : (int)blockIdx.x;
    for (int u = tid; u < (LDS_BYTES - 131072) / 4; u += NTHREADS) ((LAS unsigned*)(L + 131072))[u] = 0u;
    __syncthreads();
    unsigned char* ws = args.ws;
    gu32* ctl = (gu32*)(ws + WS_CTL);
    (void)xcd_barrier_post((unsigned*)(ctl + CW_BAR), MISC + 8);
    if (tid == 0) MISC[12] = xb_add((unsigned*)(ctl + CW_RANK) + 64 * xb_xcc_id(), 1u);
    __syncthreads();
#define GRID_BAR() do { unsigned* bp_ = (unsigned*)(args.ws + WS_CTL) + CW_BAR; asm volatile("" : "+s"(bp_)); XcdBarrier b_; b_.bar = bp_; b_.x = xb_xcc_id(); b_.st = MISC + 8; xcd_barrier(b_, wave == 0 && lane_id_v() == 0); } while (0)
    const int gw = vcu * NWAVES + wave, NGW = G * NWAVES;
    const int NGT = G * NTHREADS;

#define PHASE_PTRS \
    unsigned char* wsq = args.ws; asm volatile("" : "+s"(wsq)); \
    const float* const* IN_ = (const float* const*)__builtin_amdgcn_kernarg_segment_ptr(); asm volatile("" : "+s"(IN_)); \
    float* MODV = (float*)(wsq + WS_MOD); float* COS = (float*)(wsq + WS_COS); float* SIN = (float*)(wsq + WS_SIN); \
    bf16* WIN = (bf16*)(wsq + WS_WIN); bf16* WB = (bf16*)(wsq + WS_WB); bf16* WO = (bf16*)(wsq + WS_WO); bf16* WQ = (bf16*)(wsq + WS_WQ); bf16* KEYS = (bf16*)(wsq + WS_KEYS); \
    float* X = (float*)(wsq + WS_X); bf16* H = (bf16*)(wsq + WS_H); bf16* Y = (bf16*)(wsq + WS_Y); bf16* MG = (bf16*)(wsq + WS_MG); \
    unsigned* EI = (unsigned*)(wsq + WS_EI); float* EG = (float*)(wsq + WS_EG); \
    unsigned char* U8 = wsq + WS_U8; unsigned char* V8 = wsq + WS_V8; float* SCU = (float*)(wsq + WS_SCU); float* SCV = SCU + DEPTH * 16384; \
    bf16* AQ = (bf16*)(wsq + WS_AQ); bf16* AK = (bf16*)(wsq + WS_AK); bf16* AVT = (bf16*)(wsq + WS_AVT); \
    bf16* BQ = (bf16*)(wsq + WS_BQ); bf16* BK = (bf16*)(wsq + WS_BK); bf16* BVT = (bf16*)(wsq + WS_BVT); \
    bf16* CQ = (bf16*)(wsq + WS_CQ); bf16* CK = (bf16*)(wsq + WS_CK); bf16* CVT = (bf16*)(wsq + WS_CVT); \
    bf16* SG = (bf16*)(wsq + WS_SG); bf16* Q2 = (bf16*)(wsq + WS_Q2); float* SC = (float*)(wsq + WS_SC); \
    (void)MODV; (void)COS; (void)SIN; (void)WIN; (void)WB; (void)WO; (void)WQ; (void)KEYS; (void)X; (void)H; (void)Y; (void)MG; (void)EI; (void)EG; (void)U8; (void)V8; (void)SCU; (void)SCV; \
    (void)AQ; (void)AK; (void)AVT; (void)BQ; (void)BK; (void)BVT; (void)CQ; (void)CK; (void)CVT; (void)SG; (void)Q2; (void)SC; (void)IN_;
#define LAYER_PTRS const float* modl = MODV + (size_t)layer * 3 * 6 * D; const bf16* WINl = WIN + (size_t)layer * IN_W * D; (void)modl; (void)WINl;

#ifndef SKIP_P0
        { PHASE_PTRS
        for (int rep_ = 0; rep_ < REP_P0; ++rep_) {
    {
        LAS float* scr = (LAS float*)(L + wave * 16384);
        int gt = vcu * NTHREADS + tid; asm volatile("" : "+v"(gt));
        constexpr int I_IN = (D / 64) * (IN_W / 32), I_BR = (512 / 64) * (D / 32), I_O = (D / 64) * (D / 32), I_Q = (D / 64) * (2048 / 32);
        constexpr int PER_LAYER = I_IN + 3 * I_BR + I_O + I_Q;
        for (int rp_ = 0; rp_ < REP_P0A; ++rp_)
        for (int it = gw; it < DEPTH * PER_LAYER; it += NGW) {
            const int l = it / PER_LAYER; int r = it % PER_LAYER;
            if (r < I_IN) { p0_transpose_item<true>(IN_[I_WIN] + (size_t)l * D * IN_W, D, IN_W, WIN + (size_t)l * IN_W * D, scr, r, lane); continue; } r -= I_IN;
            if (r < I_BR) { p0_transpose_item(IN_[I_WBA] + (size_t)l * 512 * D, 512, D, WB + (size_t)(l * 3 + 0) * D * 512, scr, r, lane); continue; } r -= I_BR;
            if (r < I_BR) { p0_transpose_item(IN_[I_WBB] + (size_t)l * 512 * D, 512, D, WB + (size_t)(l * 3 + 1) * D * 512, scr, r, lane); continue; } r -= I_BR;
            if (r < I_BR) { p0_transpose_item(IN_[I_WBC] + (size_t)l * 512 * D, 512, D, WB + (size_t)(l * 3 + 2) * D * 512, scr, r, lane); continue; } r -= I_BR;
            if (r < I_O) { p0_transpose_item(IN_[I_WOUT] + (size_t)l * D * D, D, D, WO + (size_t)l * D * D, scr, r, lane); continue; } r -= I_O;
            p0_transpose_item(IN_[I_PWQ] + (size_t)l * D * 2048, D, 2048, WQ + (size_t)l * 2048 * D, scr, r, lane);
        }
        for (int i = gt; i < DEPTH * 16 * 128 * 128 / 4; i += NGT) {
            const f32x4 v = *((const GAS f32x4*)IN_[I_PKEYS] + i);
            v2u o; o.x = pk2(v.x, v.y); o.y = pk2(v.z, v.w); *((GAS v2u*)KEYS + i) = o;
        }
        {
            LAS float* red = (LAS float*)(L + 9216);
            for (int rp_ = 0; rp_ < REP_P0D; ++rp_)
            for (int it = vcu; it < DEPTH * 96; it += G) {
                const int l = it / 96, nc = it % 96, n = nc * 64 + lane;
                const float* wm = IN_[I_WMOD] + (size_t)l * D * 6 * D + n;
                float a0 = 0.f, a1 = 0.f, a2 = 0.f;
#pragma unroll 1
                for (int half = 0; half < 2; ++half) {
                    const int kb = wave * 128 + half * 64;
                    const float c0 = IN_[I_C][kb + lane], c1 = IN_[I_C][D + kb + lane], c2 = IN_[I_CCTX][kb + lane];
                    const int s0 = __builtin_bit_cast(int, c0 * sigmoidf_(c0)), s1 = __builtin_bit_cast(int, c1 * sigmoidf_(c1)), s2 = __builtin_bit_cast(int, c2 * sigmoidf_(c2));
#pragma unroll
                    for (int kk = 0; kk < 64; ++kk) {
                        const float w = wm[(size_t)(kb + kk) * 6 * D];
                        a0 += __builtin_bit_cast(float, __builtin_amdgcn_readlane(s0, kk)) * w;
                        a1 += __builtin_bit_cast(float, __builtin_amdgcn_readlane(s1, kk)) * w;
                        a2 += __builtin_bit_cast(float, __builtin_amdgcn_readlane(s2, kk)) * w;
                    }
                }
                red[(wave * 3 + 0) * 64 + lane] = a0; red[(wave * 3 + 1) * 64 + lane] = a1; red[(wave * 3 + 2) * 64 + lane] = a2;
                __syncthreads();
                if (wave < 3) {
                    float sum = IN_[I_BMOD][l * 6 * D + n];
#pragma unroll
                    for (int w = 0; w < 8; ++w) sum += red[(w * 3 + wave) * 64 + lane];
                    MODV[(size_t)(l * 3 + wave) * 6 * D + n] = sum;
                }
                __syncthreads();
            }
        }
        for (int i = gt; i < SEQ * 32; i += NGT) {
            const int t = i >> 5, f = i & 31;
            const float inv = exp2f(-(float)(f & 15) * (13.287712379549449f / 16.0f));
            const float pos = (f < 16) ? (float)(t / GRID_W) : (float)(t % GRID_W);
            float sn, cs; sincosf(pos * inv, &sn, &cs);
            COS[i] = cs; SIN[i] = sn;
        }
    }
        for (int rp_ = 0; rp_ < REP_P0F; ++rp_)
#pragma unroll 4
        for (int rr = gw; rr < 2 * DEPTH * 16384; rr += NGW) {
            const int tab = rr / (DEPTH * 16384), row = rr % (DEPTH * 16384);
            const float* src = (tab == 0 ? IN_[I_PU] : IN_[I_PV]) + (size_t)row * D;
            f32x4 v[4]; float am = 0.f;
#pragma unroll
            for (int j = 0; j < 4; ++j) { v[j] = *((const GAS f32x4*)src + lane + 64 * j); am = fmaxf(am, fmaxf(fmaxf(fabsf(v[j].x), fabsf(v[j].y)), fmaxf(fabsf(v[j].z), fabsf(v[j].w)))); }
            am = wave_max(am);
            const bool as_i8 = (P10_SLICED != 0) && (tab == 0);
            int ex = 0; float scale = 1.0f;
            if (am > 0.f) { (void)frexpf(am * (as_i8 ? (1.0f / 127.0f) : (1.0f / 448.0f)), &ex); scale = ldexpf(1.0f, ex); }
            const float inv = 1.0f / scale;
            v4u o;
#pragma unroll
            for (int j = 0; j < 4; ++j) {
                if (as_i8) {
                    const int q0 = __float2int_rn(v[j].x * inv), q1 = __float2int_rn(v[j].y * inv), q2 = __float2int_rn(v[j].z * inv), q3 = __float2int_rn(v[j].w * inv);
                    o[j] = (unsigned)(q0 & 255) | ((unsigned)(q1 & 255) << 8) | ((unsigned)(q2 & 255) << 16) | ((unsigned)q3 << 24);
                } else {
                    int p = __builtin_amdgcn_cvt_pk_fp8_f32(v[j].x * inv, v[j].y * inv, 0, false);
                    p = __builtin_amdgcn_cvt_pk_fp8_f32(v[j].z * inv, v[j].w * inv, p, true);
                    o[j] = (unsigned)p;
                }
            }
            *((GAS v4u*)((tab == 0 ? U8 : V8) + (size_t)row * D) + lane) = o;
            if (lane == 0) (tab == 0 ? SCU : SCV)[row] = scale;
        }
        }
        }
#endif
    GRID_BAR();

    for (int layer = 0; layer < DEPTH; ++layer) {
        const bool last = (layer == DEPTH - 1);
        const int T_EFF = last ? T_LAT : T_ALL;

#ifndef SKIP_P1
        { PHASE_PTRS LAYER_PTRS
        for (int rep_ = 0; rep_ < REP_P1; ++rep_) {
        { const int ln = lane_id_v();
        if (layer == 0) {
            f32x4 gm[4], shv[4];
            auto prep = [&](int midx) { const float* md = modl + (size_t)midx * 6 * D;
#pragma unroll
                for (int j = 0; j < 4; ++j) { const f32x4 g = *((const GAS f32x4*)(IN_[I_G1] + layer * D) + ln + 64 * j); const f32x4 sc = *((const GAS f32x4*)(md + D) + ln + 64 * j);
                    gm[j] = g * (sc + 1.0f); shv[j] = *((const GAS f32x4*)(md + 0) + ln + 64 * j); } };
            auto row = [&](int r) {
                const GAS f32x4* xr = (const GAS f32x4*)xin_row(IN_[I_X], IN_[I_CTX], r) + ln;
                f32x4 v[4]; float ss = 0.f;
#pragma unroll
                for (int j = 0; j < 4; ++j) { v[j] = xr[64 * j]; ss += (v[j].x * v[j].x + v[j].y * v[j].y) + (v[j].z * v[j].z + v[j].w * v[j].w); }
                const float rs = 1.0f / sqrtf(wave_sum(ss) * (1.f / D) + NORM_EPS);
                GAS v2u* o8 = (GAS v2u*)(H + (size_t)r * D) + ln;
#pragma unroll
                for (int j = 0; j < 4; ++j) { const f32x4 h = v[j] * rs * gm[j] + shv[j]; v2u o; o.x = pk2(h.x, h.y); o.y = pk2(h.z, h.w); o8[64 * j] = o; } };
            wave_row_blocks(T_ALL, gw, NGW, prep, row);
        }
        }
        }
        }
#endif
        if (layer == 0) GRID_BAR();

#ifndef SKIP_P2
        { PHASE_PTRS LAYER_PTRS
        for (int rep_ = 0; rep_ < REP_P2; ++rep_) {
        {
            pg8::Gemm g{H, WINl, D, D, D, 0, 0};
            pg8::SegOrder<1> S; S.T.init(T_ALL, IN_W, G, (int)blockIdx.x);
            EpiInProj E{AQ, AK, AVT, BQ, BK, BVT, CQ, CK, CVT, SG, COS, SIN};
            pg8::gemm_phase(L, g, S, E, wave);
        }
        }
        }
#endif
        GRID_BAR();

#ifndef SKIP_P3
        { PHASE_PTRS LAYER_PTRS
        {
            LAS bf16* Pl = (LAS bf16*)(L + wave * 8192);
            const float lam_init = 0.8f - 0.6f * expf(-0.3f * (float)layer);
            float lam;
            {
                const int ll = lane_id_v();
                const float* cl = IN_[I_LAMBDA] + layer * 256;
                const float s1 = wave_sum(cl[ll] * cl[64 + ll]), s2 = wave_sum(cl[128 + ll] * cl[192 + ll]);
                lam = expf(s1) - expf(s2) + lam_init;
            }
{ const int lo__ = lane_id_v(); { const int lane = lo__; const int fr = lane & 15, fq = lane >> 4, tid = wave * 64 + lane; (void)fr; (void)fq; (void)tid;
            {
                const int r32 = lane & 31, hi = lane >> 5;
                const int n_lat = BATCH * 4 * (SEQ / 256), n_ctx = last ? 0 : BATCH * 4;
                const int NU = (n_lat + G - 1) / G * G + n_ctx;
                for (int rep_ = 0; rep_ < REP_P3C; ++rep_)
                for (int u0 = vcu; u0 < NU; u0 += G) {
                    int b, h, row0, t_lo, t_hi;
                    if (u0 < n_lat) { const int bh = u0 >> 5; b = bh >> 2; h = bh & 3; row0 = b * SEQ + (u0 & 31) * 256; t_lo = 0; t_hi = 132; }
                    else { const int c = u0 - (n_lat + G - 1) / G * G; if (c < 0 || c >= n_ctx) continue; b = c >> 2; h = c & 3; row0 = T_LAT + b * CTX; t_lo = 128; t_hi = 132; }
                    const int qrow = row0 + wave * 32 + r32;
                    LAS unsigned* o1p = (LAS unsigned*)(L + 65536 + wave * 8192) + lane;
                    const int krow_s = tid >> 3, kch_s = tid & 7;
                    const int vrow_s0 = tid >> 4, vch_s = tid & 15;
                    LAS unsigned char* Kb0 = L; LAS unsigned char* Vb0 = L + 2 * CK_SZ;
#pragma unroll 1
                    for (int m = 0; m < 2; ++m) {
                        bf16x8 qf[4];
                        { const bf16* qp = CQ + (size_t)qrow * 512 + (h * 2 + m) * 64 + hi * 8;
#pragma unroll
                          for (int ks = 0; ks < 4; ++ks) qf[ks] = *(const GAS bf16x8*)(qp + ks * 16); }
                        f32x16 o[4];
#pragma unroll
                        for (int d = 0; d < 4; ++d)
#pragma unroll
                            for (int r = 0; r < 16; ++r) o[d][r] = 0.f;
                        float mrun = -1e30f, lpart = 0.f;
                        const bf16* kg = CK + (size_t)krow_s * 512 + (h * 2 + m) * 64 + kch_s * 8;
                        const bf16* vg = CVT + (size_t)vrow_s0 * 512 + h * 128 + vch_s * 8;
                        auto tile_row = [&](int j) { return (j < 128) ? b * SEQ + 64 * j : T_LAT + b * CTX + 64 * (j - 128); };
                        __syncthreads();
                        {
                            const size_t kb = (size_t)tile_row(t_lo) * 512;
                            const v4u kr = *(const GAS v4u*)(kg + kb), v0 = *(const GAS v4u*)(vg + kb), v1 = *(const GAS v4u*)(vg + kb + 32 * 512);
                            *(LAS v4u*)(Kb0 + krow_s * CK_PITCH + kch_s * 16) = kr;
                            *(LAS v4u*)(Vb0 + vrow_s0 * CV_PITCH + vch_s * 16) = v0; *(LAS v4u*)(Vb0 + (vrow_s0 + 32) * CV_PITCH + vch_s * 16) = v1;
                        }
                        __syncthreads();
#pragma unroll 1
                        for (int j = t_lo; j < t_hi; ++j) {
                            const int cur = (j - t_lo) & 1;
                            const LAS unsigned char* Kb = Kb0 + cur * CK_SZ; const LAS unsigned char* Vb = Vb0 + cur * CV_SZ;
                            v4u kr, v0, v1;
                            const bool more = (j + 1 < t_hi);
                            { const size_t kb = (size_t)tile_row(more ? j + 1 : j) * 512; kr = *(const GAS v4u*)(kg + kb); v0 = *(const GAS v4u*)(vg + kb); v1 = *(const GAS v4u*)(vg + kb + 32 * 512); }
                            f32x16 st[2];
#pragma unroll
                            for (int kb = 0; kb < 2; ++kb) {
#pragma unroll
                                for (int r = 0; r < 16; ++r) st[kb][r] = 0.f;
#pragma unroll
                                for (int ks = 0; ks < 4; ++ks) {
                                    const bf16x8 kf = *(const LAS bf16x8*)(Kb + (kb * 32 + r32) * CK_PITCH + ks * 32 + hi * 16);
                                    st[kb] = __builtin_amdgcn_mfma_f32_32x32x16_bf16(kf, qf[ks], st[kb], 0, 0, 0);
                                }
                            }
                            float mx = st[0][0];
#pragma unroll
                            for (int r = 1; r < 16; ++r) mx = fmaxf(mx, st[0][r]);
#pragma unroll
                            for (int r = 0; r < 16; ++r) mx = fmaxf(mx, st[1][r]);
                            mx = xmax32(mx);
                            if (__builtin_amdgcn_ballot_w64(mx > mrun + C_THR_RAW) != 0ull) {
                                const float mn = fmaxf(mrun, mx);
                                const float alpha = __builtin_amdgcn_exp2f((mrun - mn) * SCL2);
#pragma unroll
                                for (int d = 0; d < 4; ++d)
#pragma unroll
                                    for (int r = 0; r < 16; ++r) o[d][r] *= alpha;
                                lpart *= alpha; mrun = mn;
                            }
                            const float nmc = -mrun * SCL2;
                            float ls = 0.f;
#pragma unroll
                            for (int kb = 0; kb < 2; ++kb)
#pragma unroll
                                for (int r = 0; r < 16; ++r) { const float p = __builtin_amdgcn_exp2f(fmaf(st[kb][r], SCL2, nmc)); st[kb][r] = p; ls += p; }
                            lpart += ls;
                            {
                                const int q4 = (lane & 15) >> 2, p4 = lane & 3, grp = (lane >> 4) & 1;
                                const LAS unsigned char* vbase = Vb + (4 * hi + q4) * CV_PITCH + (16 * grp + 4 * p4) * 2;
#pragma unroll
                                for (int kb = 0; kb < 2; ++kb)
#pragma unroll
                                    for (int ss = 0; ss < 2; ++ss) {
                                        v4u pw;
#pragma unroll
                                        for (int i2 = 0; i2 < 4; ++i2) pw[i2] = cvtpk(st[kb][8 * ss + 2 * i2], st[kb][8 * ss + 2 * i2 + 1]);
                                        const bf16x8 pb = __builtin_bit_cast(bf16x8, pw);
#pragma unroll
                                        for (int d = 0; d < 4; ++d) {
                                            const LAS unsigned char* va = vbase + (kb * 32 + 16 * ss) * CV_PITCH + d * 64;
                                            const s16x4 lo = __builtin_bit_cast(s16x4, __builtin_amdgcn_ds_read_tr16_b64_v4i16((LAS s16x4*)va));
                                            const s16x4 hh = __builtin_bit_cast(s16x4, __builtin_amdgcn_ds_read_tr16_b64_v4i16((LAS s16x4*)(va + 8 * CV_PITCH)));
                                            const bf16x8 vf = __builtin_shufflevector(lo, hh, 0, 1, 2, 3, 4, 5, 6, 7);
                                            o[d] = __builtin_amdgcn_mfma_f32_32x32x16_bf16(vf, pb, o[d], 0, 0, 0);
                                        }
                                        if (ss == 1) __builtin_amdgcn_sched_barrier(0);
                                    }
                            }
                            if (more) {
                                LAS unsigned char* Kn = Kb0 + (cur ^ 1) * CK_SZ; LAS unsigned char* Vn = Vb0 + (cur ^ 1) * CV_SZ;
                                *(LAS v4u*)(Kn + krow_s * CK_PITCH + kch_s * 16) = kr;
                                *(LAS v4u*)(Vn + vrow_s0 * CV_PITCH + vch_s * 16) = v0; *(LAS v4u*)(Vn + (vrow_s0 + 32) * CV_PITCH + vch_s * 16) = v1;
                            }
                            __syncthreads();
                        }
                        const float lt = xadd32(lpart);
                        if (m == 0) {
                            const float inv = 1.0f / lt;
#pragma unroll
                            for (int d = 0; d < 4; ++d)
#pragma unroll
                                for (int i2 = 0; i2 < 8; ++i2) o1p[64 * (d * 8 + i2)] = cvtpk(o[d][2 * i2] * inv, o[d][2 * i2 + 1] * inv);
                        } else {
                            const float inv2 = lam / lt;
                            float ssq = 0.f;
#pragma unroll
                            for (int d = 0; d < 4; ++d)
#pragma unroll
                                for (int i2 = 0; i2 < 8; ++i2) {
                                    const unsigned w1 = o1p[64 * (d * 8 + i2)];
                                    const float a0 = bf2f(w1 & 0xffffu) - o[d][2 * i2] * inv2, a1 = bf2f(w1 >> 16) - o[d][2 * i2 + 1] * inv2;
                                    o[d][2 * i2] = a0; o[d][2 * i2 + 1] = a1; ssq += a0 * a0 + a1 * a1;
                                }
                            ssq = xadd32(ssq);
                            const float rn = 1.0f / sqrtf(ssq * (1.f / 128.f) + NORM_EPS) * (1.0f - lam_init);
                            bf16* yp = Y + (size_t)qrow * 1536 + 1024 + h * 128 + 4 * hi;
                            const float* sl = IN_[I_SUBLN] + layer * 512 + h * 128 + 4 * hi;
#pragma unroll
                            for (int d = 0; d < 4; ++d)
#pragma unroll
                                for (int g4 = 0; g4 < 4; ++g4) {
                                    const f32x4 gsl = *(const GAS f32x4*)(sl + d * 32 + 8 * g4);
                                    v2u w; w.x = cvtpk(o[d][4 * g4] * rn * gsl.x, o[d][4 * g4 + 1] * rn * gsl.y); w.y = cvtpk(o[d][4 * g4 + 2] * rn * gsl.z, o[d][4 * g4 + 3] * rn * gsl.w);
                                    *(GAS v2u*)(yp + d * 32 + 8 * g4) = w;
                                }
                        }
                    }
                }
                __syncthreads();
            }
} }
{ const int lo__ = lane_id_v(); { const int lane = lo__; const int tid = wave * 64 + lane, r32 = lane & 31, hi = lane >> 5;
            {
                const int n_lat = BATCH * 2 * (SEQ / 64), n_ctx = last ? 0 : BATCH * 2 * (CTX / 64);
                for (int rep_ = 0; rep_ < REP_P3A; ++rep_)
                for (int u0 = vcu; u0 < n_lat + n_ctx; u0 += G) {
                    const bool isctx = u0 >= n_lat;
                    int b, g, p0, qrow, nl, klo;
                    if (!isctx) { b = u0 >> 8; g = (u0 >> 7) & 1; p0 = (u0 & 127) * 64; qrow = b * SEQ + p0 + (wave & 1) * 32 + r32;
                                  klo = p0 >= 128 ? 0 : (128 - p0) / 64; const int khi = min(4, (SEQ - 1 - (p0 - 128)) / 64); nl = khi - klo + 1; }
                    else { const int c = u0 - n_lat; b = c >> 3; g = (c >> 2) & 1; p0 = (c & 3) * 64; qrow = T_LAT + b * CTX + p0 + (wave & 1) * 32 + r32; nl = 0; klo = 0; }
                    const int hq = g * 4 + (wave >> 1);
                    const int qpos0 = p0 + (wave & 1) * 32;
                    bf16x8 qf[4];
                    { const bf16* qp = AQ + (size_t)qrow * 512 + hq * 64 + hi * 8;
#pragma unroll
                      for (int ks = 0; ks < 4; ++ks) qf[ks] = *(const GAS bf16x8*)(qp + ks * 16); }
                    f32x16 o[2];
#pragma unroll
                    for (int d = 0; d < 2; ++d)
#pragma unroll
                        for (int r = 0; r < 16; ++r) o[d][r] = 0.f;
                    float mrun = IN_[I_SINK][layer * 8 + hq] * 8.0f;
                    float lpart = (hi == 0) ? 1.0f : 0.0f;
                    const bf16* kg = AK + (size_t)(tid >> 3) * 128 + g * 64 + (tid & 7) * 8;
                    const bf16* vg = AVT + (size_t)(tid >> 3) * 128 + g * 64 + (tid & 7) * 8;
                    const int kp0 = p0 - 128 + 64 * klo;
                    auto tile_row = [&](int j) { return (j < nl) ? b * SEQ + kp0 + 64 * j : T_LAT + b * CTX + 64 * (j - nl); };
                    auto use_tile = [&](int j) { if (j >= nl) return true; const int kp = kp0 + 64 * j; return (kp + 63 >= qpos0 - 128) && (kp <= qpos0 + 31 + 128); };
                    auto elem = [&](f32x16 (&st)[2], int j) {
                        if (j < nl) {
                            const int dq0 = (qpos0 + r32) - (kp0 + 64 * j + 4 * hi);
#pragma unroll
                            for (int kb = 0; kb < 2; ++kb)
#pragma unroll
                                for (int r = 0; r < 16; ++r) { const int dq = dq0 - (kb * 32 + (r & 3) + 8 * (r >> 2)); if (dq > 128 || dq < -128) st[kb][r] = -1e30f; }
                        }
                    };
                    attn64_pass<2>(o, mrun, lpart, qf, kg, 128, vg, 128, nl + 4, tile_row, use_tile, elem, L, lane, tid);
                    const float lt = xadd32(lpart);
                    attn64_store(o, 1.0f / lt, Y + (size_t)qrow * 1536 + hq * 64, hi);
                }
            }
} }
{ const int lo__ = lane_id_v(); { const int lane = lo__; const int tid = wave * 64 + lane, r32 = lane & 31, hi = lane >> 5;
            {
                const int n_lat = BATCH * 8 * 32, n_ctx = last ? 0 : BATCH * 8;
                LAS float* rpbL = (LAS float*)(L + 49152);
                for (int rep_ = 0; rep_ < REP_P3B; ++rep_)
                for (int u0 = vcu; u0 < n_lat + n_ctx; u0 += G) {
                    const bool isctx = u0 >= n_lat;
                    int b, h, gr = 0, qc0 = 0, qrow, nl, krlo;
                    if (!isctx) { b = u0 >> 8; h = (u0 >> 5) & 7; const int r0 = (u0 & 31) * 4; gr = r0 + (wave >> 1); qc0 = (wave & 1) * 32; qrow = b * SEQ + gr * GRID_W + qc0 + r32;
                                  krlo = min(max(r0 - 4, 0), 120); nl = min(max(r0 - 1, 0), 120) + 8 - krlo; }
                    else { const int c = u0 - n_lat; b = c >> 3; h = c & 7; qrow = T_LAT + b * CTX + wave * 32 + r32; nl = 0; krlo = 0; }
                    __syncthreads();
                    if (tid < 465) rpbL[tid] = IN_[I_RPB][(size_t)(layer * 8 + h) * 465 + tid] * 8.0f;
                    bf16x8 qf[4];
                    { const bf16* qp = BQ + (size_t)qrow * 512 + h * 64 + hi * 8;
#pragma unroll
                      for (int ks = 0; ks < 4; ++ks) qf[ks] = *(const GAS bf16x8*)(qp + ks * 16); }
                    f32x16 o[2];
#pragma unroll
                    for (int d = 0; d < 2; ++d)
#pragma unroll
                        for (int r = 0; r < 16; ++r) o[d][r] = 0.f;
                    float mrun = -1e30f, lpart = 0.f;
                    const bf16* kg = BK + (size_t)(tid >> 3) * 512 + h * 64 + (tid & 7) * 8;
                    const bf16* vg = BVT + (size_t)(tid >> 3) * 512 + h * 64 + (tid & 7) * 8;
                    const int rs = min(max(gr - 4, 0), 120);
                    auto tile_row = [&](int j) { return (j < nl) ? b * SEQ + (krlo + j) * GRID_W : T_LAT + b * CTX + 64 * (j - nl); };
                    auto use_tile = [&](int j) { if (j >= nl) return true; const int kr = krlo + j; return kr >= rs && kr < rs + 8; };
                    auto elem = [&](f32x16 (&st)[2], int j) {
                        if (j < nl) {
                            const int qc = qc0 + r32, cstart = min(max(qc - 8, 0), 48);
                            const LAS float* brow = rpbL + (krlo + j - gr + 7) * 31 + 15;
#pragma unroll
                            for (int kb = 0; kb < 2; ++kb)
#pragma unroll
                                for (int r = 0; r < 16; ++r) {
                                    const int kc = kb * 32 + (r & 3) + 8 * (r >> 2) + 4 * hi;
                                    const bool valid = (kc >= cstart) && (kc < cstart + 16);
                                    const int dc = min(max(kc - qc, -15), 15);
                                    st[kb][r] = valid ? st[kb][r] + brow[dc] : -1e30f;
                                }
                        }
                    };
                    attn64_pass<2>(o, mrun, lpart, qf, kg, 512, vg, 512, nl + 4, tile_row, use_tile, elem, L, lane, tid);
                    const float lt = xadd32(lpart);
                    attn64_store(o, 1.0f / lt, Y + (size_t)qrow * 1536 + 512 + h * 64, hi);
                }
                __syncthreads();
            }
} }
        }
        }
#endif
        GRID_BAR();

#ifndef SKIP_P4
        { PHASE_PTRS LAYER_PTRS
        for (int rep_ = 0; rep_ < REP_P4; ++rep_) {
        {
            pg8::Gemm g{Y, WB + (size_t)layer * 3 * D * 512, 1536, 512, 512, 512, (size_t)D * 512};
            pg8::SegOrder<3> S; S.T.init(T_LAT, D, G, (int)blockIdx.x);
            EpiBranch E{SG, MG};
            pg8::gemm_phase(L, g, S, E, wave);
        }
        if (!last) { const int lo__ = lane_id_v(); { const int lane = lo__; const int fr = lane & 15, fq = lane >> 4; (void)fr; (void)fq;
            for (int it = gw; it < (T_ALL - T_LAT) / 32 * (D / 32); it += NGW) {
                const int row0 = T_LAT + (it / (D / 32)) * 32, col0 = (it % (D / 32)) * 32;
                f32x4 mg[2][2]; zero_acc22(mg);
#pragma unroll 1
                for (int seg = 0; seg < 3; ++seg) {
                    f32x4 acc[2][2]; zero_acc22(acc);
                    sgemm32<8>(acc, Y + seg * 512, 1536, WB + (size_t)(layer * 3 + seg) * D * 512, 512, 512, row0, col0, lane);
#pragma unroll
                    for (int m = 0; m < 2; ++m)
#pragma unroll
                        for (int r = 0; r < 4; ++r) {
                            const bf16* gp = SG + (size_t)(row0 + 16 * m + 4 * fq + r) * 3072 + seg * 1024 + col0 + fr;
#pragma unroll
                            for (int n = 0; n < 2; ++n) mg[m][n][r] += bf2f(gp[16 * n]) * acc[m][n][r];
                        }
                }
#pragma unroll
                for (int m = 0; m < 2; ++m)
#pragma unroll
                    for (int r = 0; r < 4; ++r) {
                        bf16* rowp = MG + (size_t)(row0 + 16 * m + 4 * fq + r) * D + col0 + fr;
#pragma unroll
                        for (int n = 0; n < 2; ++n) rowp[16 * n] = (bf16)f2bf(mg[m][n][r]);
                    }
            }
} }
        }
        }
#endif
        GRID_BAR();

#ifndef SKIP_P5
        { PHASE_PTRS LAYER_PTRS
        {
            pg8::Gemm g{MG, WO + (size_t)layer * D * D, D, D, D, 0, 0};
            pg8::SegOrder<1> S; S.T.init(T_LAT, D, G, (int)blockIdx.x);
            EpiOut E{X, modl, layer == 0 ? IN_[I_X] : nullptr, IN_[I_CTX]};
            pg8::gemm_phase(L, g, S, E, wave);
        }
        if (!last) { const int lo__ = lane_id_v(); { const int lane = lo__; const int fr = lane & 15, fq = lane >> 4; (void)fr; (void)fq;
            for (int it = gw; it < (T_ALL - T_LAT) / 32 * (D / 32); it += NGW) {
                const int row0 = T_LAT + (it / (D / 32)) * 32, col0 = (it % (D / 32)) * 32;
                f32x4 acc[2][2]; zero_acc22(acc);
                sgemm32<8>(acc, MG, D, WO + (size_t)layer * D * D, D, D, row0, col0, lane);
                const float* gt = modl + (size_t)2 * 6 * D + 2 * D + col0 + fr;
#pragma unroll
                for (int m = 0; m < 2; ++m)
#pragma unroll
                    for (int r = 0; r < 4; ++r) {
                        float* rowp = X + (size_t)(row0 + 16 * m + 4 * fq + r) * D + col0 + fr;
                        const float* srcp = (layer == 0) ? IN_[I_CTX] + (size_t)(row0 - T_LAT + 16 * m + 4 * fq + r) * D + col0 + fr : rowp;
#pragma unroll
                        for (int n = 0; n < 2; ++n) rowp[16 * n] = srcp[16 * n] + gt[16 * n] * acc[m][n][r];
                    }
            }
} }
        }
#endif
        GRID_BAR();

#ifndef SKIP_P6
        { PHASE_PTRS LAYER_PTRS
        for (int rep_ = 0; rep_ < REP_P6; ++rep_) {
        { const int ln = lane_id_v();
        {
            f32x4 gm[4], shv[4];
            auto prep = [&](int midx) { const float* md = modl + (size_t)midx * 6 * D;
#pragma unroll
                for (int j = 0; j < 4; ++j) { const f32x4 g = *((const GAS f32x4*)(IN_[I_G2] + layer * D) + ln + 64 * j); const f32x4 sc = *((const GAS f32x4*)(md + 4 * D) + ln + 64 * j);
                    gm[j] = g * (sc + 1.0f); shv[j] = *((const GAS f32x4*)(md + 3 * D) + ln + 64 * j); } };
            auto row = [&](int r) {
                const GAS f32x4* xr = (const GAS f32x4*)(X + (size_t)r * D) + ln;
                f32x4 v[4]; float ss = 0.f;
#pragma unroll
                for (int j = 0; j < 4; ++j) { v[j] = xr[64 * j]; ss += (v[j].x * v[j].x + v[j].y * v[j].y) + (v[j].z * v[j].z + v[j].w * v[j].w); }
                const float rs = 1.0f / sqrtf(wave_sum(ss) * (1.f / D) + NORM_EPS);
                GAS v2u* o8 = (GAS v2u*)(H + (size_t)r * D) + ln;
#pragma unroll
                for (int j = 0; j < 4; ++j) { const f32x4 h = v[j] * rs * gm[j] + shv[j]; v2u o; o.x = pk2(h.x, h.y); o.y = pk2(h.z, h.w); o8[64 * j] = o; } };
            wave_row_blocks(T_EFF, gw, NGW, prep, row);
        }
        }
        }
        }
#endif
        GRID_BAR();

#ifndef SKIP_P7
        { PHASE_PTRS LAYER_PTRS
        for (int rep_ = 0; rep_ < REP_P7; ++rep_) {
        {
            pg8::Gemm g{H, WQ + (size_t)layer * 2048 * D, D, D, D, 0, 0};
            pg8::SegOrder<1> S; S.T.init(T_LAT, 2048, G, (int)blockIdx.x);
            EpiStore E{Q2, 2048};
            pg8::gemm_phase(L, g, S, E, wave);
        }
        if (!last) { const int lo__ = lane_id_v(); { const int lane = lo__; const int fr = lane & 15, fq = lane >> 4; (void)fr; (void)fq;
            for (int it = gw; it < (T_ALL - T_LAT) / 32 * (2048 / 32); it += NGW) {
                const int row0 = T_LAT + (it / (2048 / 32)) * 32, col0 = (it % (2048 / 32)) * 32;
                f32x4 acc[2][2]; zero_acc22(acc);
                sgemm32<8>(acc, H, D, WQ + (size_t)layer * 2048 * D, D, D, row0, col0, lane);
#pragma unroll
                for (int m = 0; m < 2; ++m)
#pragma unroll
                    for (int r = 0; r < 4; ++r) {
                        bf16* rowp = Q2 + (size_t)(row0 + 16 * m + 4 * fq + r) * 2048 + col0 + fr;
#pragma unroll
                        for (int n = 0; n < 2; ++n) rowp[16 * n] = (bf16)f2bf(acc[m][n][r]);
                    }
            }
} }
        }
        }
#endif
        GRID_BAR();

#ifndef SKIP_P8
        { PHASE_PTRS LAYER_PTRS
        for (int rep_ = 0; rep_ < REP_P8; ++rep_) {
{ const int lo__ = lane_id_v(); { const int lane = lo__; const int fr = lane & 15, fq = lane >> 4, tid = wave * 64 + lane;
        {
            LAS float* S = (LAS float*)L;
            const int wr = wave >> 1, wc = wave & 1;
            const int tl = tid >> 2, qd = tid & 3, ph = qd >> 1, hq = qd & 1;
            for (int it = vcu; it < (T_EFF / 128) * PEER_HEADS; it += G) {
                const int tile = it >> 3, h = it & 7;
                {
                    f32x4 acc[2][8];
#pragma unroll
                    for (int m = 0; m < 2; ++m)
#pragma unroll
                        for (int n = 0; n < 8; ++n) acc[m][n] = (f32x4){0.f, 0.f, 0.f, 0.f};
                    const bf16* ap = Q2 + (size_t)(tile * 128 + wr * 32 + fr) * 2048 + h * 256 + wc * 128 + fq * 8;
                    const bf16* bp = KEYS + ((size_t)(layer * 16 + h * 2 + wc) * 128 + fr) * 128 + fq * 8;
                    bf16x8 af[2][4];
#pragma unroll
                    for (int m = 0; m < 2; ++m)
#pragma unroll
                        for (int ks = 0; ks < 4; ++ks) af[m][ks] = *(const GAS bf16x8*)(ap + (size_t)m * 16 * 2048 + ks * 32);
#pragma unroll
                    for (int n = 0; n < 8; ++n) {
                        bf16x8 bfr[4];
#pragma unroll
                        for (int ks = 0; ks < 4; ++ks) bfr[ks] = *(const GAS bf16x8*)(bp + (size_t)n * 16 * 128 + ks * 32);
#pragma unroll
                        for (int ks = 0; ks < 4; ++ks)
#pragma unroll
                            for (int m = 0; m < 2; ++m) acc[m][n] = __builtin_amdgcn_mfma_f32_16x16x32_bf16(af[m][ks], bfr[ks], acc[m][n], 0, 0, 0);
                    }
#pragma unroll
                    for (int m = 0; m < 2; ++m)
#pragma unroll
                        for (int r = 0; r < 4; ++r) {
                            const int row_ = wr * 32 + 16 * m + 4 * fq + r;
#pragma unroll
                            for (int n = 0; n < 8; ++n) { const int key_ = wc * 128 + 16 * n + fr, c_ = key_ >> 2, pc_ = (c_ & 0x30) | ((c_ & 15) ^ (((row_ & 3) << 2) | (c_ >> 4)));
                                S[row_ * 256 + pc_ * 4 + (key_ & 3)] = acc[m][n][r]; }
                        }
                }
                __syncthreads();
                {
                    const int t = tile * 128 + tl;
                    int a[16];
#define LOAD_CHUNK_L(v, ch) _Pragma("unroll") for (int q = 0; q < 4; ++q) { const int c_ = qd * 16 + (ch) * 4 + q, pc_ = (c_ & 0x30) | ((c_ & 15) ^ (((tl & 3) << 2) | qd)); \
                        const f32x4 x = *(const LAS f32x4*)(S + tl * 256 + pc_ * 4); const int kb_ = hq * 64 + (ch) * 16 + 4 * q; \
                        v[4 * q + 0] = (f2ord(x.x) & ~127) | (kb_ + 0); v[4 * q + 1] = (f2ord(x.y) & ~127) | (kb_ + 1); v[4 * q + 2] = (f2ord(x.z) & ~127) | (kb_ + 2); v[4 * q + 3] = (f2ord(x.w) & ~127) | (kb_ + 3); }
                    LOAD_CHUNK_L(a, 0) sort16_desc(a);
#pragma unroll
                    for (int ch = 1; ch < 4; ++ch) { int v[16]; LOAD_CHUNK_L(v, ch) sort16_desc(v); merge16_desc(a, v); }
#undef LOAD_CHUNK_L
                    { int b[16];
#pragma unroll
                      for (int i = 0; i < 16; ++i) b[i] = __builtin_amdgcn_update_dpp(0, a[i], 0xB1, 0xF, 0xF, true);
                      merge16_desc(a, b); }
                    int a0[16], a1[16];
#pragma unroll
                    for (int i = 0; i < 16; ++i) { const int o2 = __builtin_amdgcn_update_dpp(0, a[i], 0x4E, 0xF, 0xF, true); a0[i] = ph ? o2 : a[i]; a1[i] = ph ? a[i] : o2; }
                    {
            float va[16], vb[16];
#pragma unroll
            for (int i = 0; i < 16; ++i) { va[i] = ord2f(a0[i] & ~127); vb[i] = ord2f(a1[i] & ~127); }
            int c[16];
            {
                int v[16];
                v[0] = (f2ord(va[0] + vb[0]) & ~255) | 0;
                v[1] = (f2ord(va[0] + vb[1]) & ~255) | 1;
                v[2] = (f2ord(va[0] + vb[2]) & ~255) | 2;
                v[3] = (f2ord(va[0] + vb[3]) & ~255) | 3;
                v[4] = (f2ord(va[0] + vb[4]) & ~255) | 4;
                v[5] = (f2ord(va[0] + vb[5]) & ~255) | 5;
                v[6] = (f2ord(va[0] + vb[6]) & ~255) | 6;
                v[7] = (f2ord(va[0] + vb[7]) & ~255) | 7;
                v[8] = (f2ord(va[0] + vb[8]) & ~255) | 8;
                v[9] = (f2ord(va[0] + vb[9]) & ~255) | 9;
                v[10] = (f2ord(va[0] + vb[10]) & ~255) | 10;
                v[11] = (f2ord(va[0] + vb[11]) & ~255) | 11;
                v[12] = (f2ord(va[0] + vb[12]) & ~255) | 12;
                v[13] = (f2ord(va[0] + vb[13]) & ~255) | 13;
                v[14] = (f2ord(va[0] + vb[14]) & ~255) | 14;
                v[15] = (f2ord(va[0] + vb[15]) & ~255) | 15;
                sort16_desc(v);
#pragma unroll
                for (int i = 0; i < 16; ++i) c[i] = v[i];
            }
            {
                int v[16];
                v[0] = (f2ord(va[1] + vb[0]) & ~255) | 16;
                v[1] = (f2ord(va[1] + vb[1]) & ~255) | 17;
                v[2] = (f2ord(va[1] + vb[2]) & ~255) | 18;
                v[3] = (f2ord(va[1] + vb[3]) & ~255) | 19;
                v[4] = (f2ord(va[1] + vb[4]) & ~255) | 20;
                v[5] = (f2ord(va[1] + vb[5]) & ~255) | 21;
                v[6] = (f2ord(va[1] + vb[6]) & ~255) | 22;
                v[7] = (f2ord(va[1] + vb[7]) & ~255) | 23;
                v[8] = (f2ord(va[2] + vb[0]) & ~255) | 32;
                v[9] = (f2ord(va[2] + vb[1]) & ~255) | 33;
                v[10] = (f2ord(va[2] + vb[2]) & ~255) | 34;
                v[11] = (f2ord(va[2] + vb[3]) & ~255) | 35;
                v[12] = (f2ord(va[2] + vb[4]) & ~255) | 36;
                v[13] = (f2ord(va[3] + vb[0]) & ~255) | 48;
                v[14] = (f2ord(va[3] + vb[1]) & ~255) | 49;
                v[15] = (f2ord(va[3] + vb[2]) & ~255) | 50;
                sort16_desc(v);
                merge16_desc(c, v);
            }
            {
                int v[16];
                v[0] = (f2ord(va[3] + vb[3]) & ~255) | 51;
                v[1] = (f2ord(va[4] + vb[0]) & ~255) | 64;
                v[2] = (f2ord(va[4] + vb[1]) & ~255) | 65;
                v[3] = (f2ord(va[4] + vb[2]) & ~255) | 66;
                v[4] = (f2ord(va[5] + vb[0]) & ~255) | 80;
                v[5] = (f2ord(va[5] + vb[1]) & ~255) | 81;
                v[6] = (f2ord(va[6] + vb[0]) & ~255) | 96;
                v[7] = (f2ord(va[6] + vb[1]) & ~255) | 97;
                v[8] = (f2ord(va[7] + vb[0]) & ~255) | 112;
                v[9] = (f2ord(va[7] + vb[1]) & ~255) | 113;
                v[10] = (f2ord(va[8] + vb[0]) & ~255) | 128;
                v[11] = (f2ord(va[9] + vb[0]) & ~255) | 144;
                v[12] = (f2ord(va[10] + vb[0]) & ~255) | 160;
                v[13] = (f2ord(va[11] + vb[0]) & ~255) | 176;
                v[14] = (f2ord(va[12] + vb[0]) & ~255) | 192;
                v[15] = (f2ord(va[13] + vb[0]) & ~255) | 208;
                sort16_desc(v);
                merge16_desc(c, v);
            }
            {
                int v[16];
                v[0] = (f2ord(va[14] + vb[0]) & ~255) | 224;
                v[1] = (f2ord(va[15] + vb[0]) & ~255) | 240;
                v[2] = (int)0x80000000;
                v[3] = (int)0x80000000;
                v[4] = (int)0x80000000;
                v[5] = (int)0x80000000;
                v[6] = (int)0x80000000;
                v[7] = (int)0x80000000;
                v[8] = (int)0x80000000;
                v[9] = (int)0x80000000;
                v[10] = (int)0x80000000;
                v[11] = (int)0x80000000;
                v[12] = (int)0x80000000;
                v[13] = (int)0x80000000;
                v[14] = (int)0x80000000;
                v[15] = (int)0x80000000;
                sort16_desc(v);
                merge16_desc(c, v);
            }
            const float smax = ord2f(c[0] & ~255);
            float pe[16]; float psum = 0.f;
#pragma unroll
            for (int k = 0; k < 16; ++k) { pe[k] = __expf(ord2f(c[k] & ~255) - smax); psum += pe[k]; }
            const float ip = 1.0f / psum;
#pragma unroll
            for (int kk = 0; kk < 4; ++kk) {
                const int ck = (qd == 0) ? c[kk] : (qd == 1) ? c[4 + kk] : (qd == 2) ? c[8 + kk] : c[12 + kk];
                const float pk_ = (qd == 0) ? pe[kk] : (qd == 1) ? pe[4 + kk] : (qd == 2) ? pe[8 + kk] : pe[12 + kk];
                const int ij = ck & 255, ii = ij >> 4, jj = ij & 15;
                int e0 = 0, e1 = 0;
#pragma unroll
                for (int q = 0; q < 16; ++q) { e0 = (ii == q) ? (a0[q] & 127) : e0; e1 = (jj == q) ? (a1[q] & 127) : e1; }
                const int e = e0 * PEER_KEYS + e1;
                const float su = SCU[layer * 16384 + e], sv = SCV[layer * 16384 + e];
                const int k = 4 * qd + kk;
                EI[(size_t)t * NSEL + h * 16 + k] = (unsigned)e | (f2bf(su) << 16);
                EG[(size_t)t * NSEL + h * 16 + k] = pk_ * ip * sv;
            }
                    }
                }
                __syncthreads();
            }
        }
} }
        }
        }
#endif
        GRID_BAR();

#ifndef SKIP_P10
#define P10_CENSUS \
        unsigned myx_, nx_ = 1u, smask_ = 0u; { unsigned cnt_[16]; unsigned* bw_ = (unsigned*)(args.ws + WS_CTL) + CW_BAR; \
            _Pragma("unroll") for (int j = 0; j < 16; ++j) cnt_[j] = (unsigned)__builtin_amdgcn_readfirstlane((int)xb_ld(&bw_[XB_XCNT(j)])); \
            myx_ = xb_xcc_id(); unsigned np_ = 0u; \
            _Pragma("unroll") for (int j = 0; j < 16; ++j) { np_ += (cnt_[j] > 0u) ? 1u : 0u; nx_ = ((unsigned)j == myx_) ? cnt_[j] : nx_; } \
            if (np_ == 0u) np_ = 1u; if (nx_ == 0u) nx_ = 1u; \
            _Pragma("unroll") for (int sl = 0; sl < 8; ++sl) { const unsigned k_ = (unsigned)sl % np_; unsigned seen_ = 0u, srv_ = 0xffu; \
                _Pragma("unroll") for (int j = 0; j < 16; ++j) { if (cnt_[j] > 0u) { srv_ = (seen_ == k_) ? (unsigned)j : srv_; ++seen_; } } \
                smask_ |= (srv_ == myx_) ? (1u << sl) : 0u; } } \
        const int rank_ = (int)__builtin_amdgcn_readfirstlane((int)MISC[12]); const int wstride_ = (int)nx_ * NWAVES; (void)rank_; (void)wstride_;
        { PHASE_PTRS LAYER_PTRS
        { const int ln = lane_id_v(); const int c = ln & 7, tg = ln >> 3;
          P10_CENSUS
          float* PART = (float*)(wsq + WS_PART);
          const unsigned char* U8l = U8 + (size_t)layer * 16384 * D;
          for (int rep_ = 0; rep_ < REP_P10A; ++rep_)
#pragma unroll 1
          for (int sl = 0; sl < 8; ++sl) {
            if (!((smask_ >> sl) & 1u)) continue;
            const int ws0 = (rank_ * NWAVES + wave) * 8, nslot = wstride_ * 8;
            if (ws0 >= T_EFF) continue;
            const int niter = (T_EFF - ws0 + nslot - 1) / nslot, nb = niter * 8;
#define A_TOK(bi) (ws0 + tg + (min((bi), nb - 1) >> 3) * nslot)
#define A_LOAD_PK(pkv, bi) { const GAS v4u* wp_ = (const GAS v4u*)(EI + (size_t)A_TOK(bi) * NSEL + 16 * (min((bi), nb - 1) & 7)); _Pragma("unroll") for (int q = 0; q < 4; ++q) pkv[q] = wp_[q]; }
#define A_ISSUE(rowv, pkv) { _Pragma("unroll") for (int q = 0; q < 16; ++q) rowv[q] = *(const GAS v4u*)(U8l + (size_t)(pkv[q >> 2][q & 3] & 0xffffu) * D + 128 * sl + 16 * c); }
#define A_LOAD_H(hvv, bi) { const int tq_ = A_TOK(bi); _Pragma("unroll") for (int j = 0; j < 4; ++j) hvv[j] = *(const GAS v2u*)(H + (size_t)tq_ * D + 256 * j + 32 * sl + 4 * c); }
#define A_QUANT(hvv) { float hf[16]; float am_ = 0.f; \
                _Pragma("unroll") for (int j = 0; j < 4; ++j) { hf[4 * j] = bf2f(hvv[j].x & 0xffffu); hf[4 * j + 1] = bf2f(hvv[j].x >> 16); hf[4 * j + 2] = bf2f(hvv[j].y & 0xffffu); hf[4 * j + 3] = bf2f(hvv[j].y >> 16); } \
                _Pragma("unroll") for (int i = 0; i < 16; ++i) am_ = fmaxf(am_, fabsf(hf[i])); \
                am_ = fmaxf(am_, dpp_mov<0xB1>(am_)); am_ = fmaxf(am_, dpp_mov<0x4E>(am_)); am_ = fmaxf(am_, dpp_mov<0x141>(am_)); am_ = fmaxf(am_, 1e-20f); \
                sh_ = am_ * (1.0f / 127.0f); const float ih_ = 127.0f / am_; \
                _Pragma("unroll") for (int j = 0; j < 4; ++j) { const int q0 = __float2int_rn(hf[4 * j] * ih_), q1 = __float2int_rn(hf[4 * j + 1] * ih_), q2 = __float2int_rn(hf[4 * j + 2] * ih_), q3 = __float2int_rn(hf[4 * j + 3] * ih_); \
                    hq_[j] = (int)((unsigned)(q0 & 255) | ((unsigned)(q1 & 255) << 8) | ((unsigned)(q2 & 255) << 16) | ((unsigned)q3 << 24)); } }
#define A_COMPUTE(rowv, bi) { int p_[16]; \
                _Pragma("unroll") for (int q = 0; q < 16; ++q) { int ia = 0; _Pragma("unroll") for (int j = 0; j < 4; ++j) ia = __builtin_amdgcn_sdot4((int)rowv[q][j], hq_[j], ia, false); p_[q] = ia; } \
                { const bool up = (c & 4) != 0; _Pragma("unroll") for (int i = 0; i < 8; ++i) { const int send = up ? p_[i] : p_[8 + i], keep = up ? p_[8 + i] : p_[i]; p_[i] = keep + __builtin_amdgcn_update_dpp(0, send, 0x141, 0xF, 0xF, true); } } \
                { const bool up = (c & 2) != 0; _Pragma("unroll") for (int i = 0; i < 4; ++i) { const int send = up ? p_[i] : p_[4 + i], keep = up ? p_[4 + i] : p_[i]; p_[i] = keep + __builtin_amdgcn_update_dpp(0, send, 0x4E, 0xF, 0xF, true); } } \
                { const bool up = (c & 1) != 0; _Pragma("unroll") for (int i = 0; i < 2; ++i) { const int send = up ? p_[i] : p_[2 + i], keep = up ? p_[2 + i] : p_[i]; p_[i] = keep + __builtin_amdgcn_update_dpp(0, send, 0xB1, 0xF, 0xF, true); } } \
                f32x2 r2_; r2_.x = (float)p_[0] * sh_; r2_.y = (float)p_[1] * sh_; \
                *(GAS f32x2*)(PART + ((size_t)sl * T_ALL + (ws0 + tg + ((bi) >> 3) * nslot)) * NSEL + 16 * ((bi) & 7) + 2 * c) = r2_; }
            v4u pkA[4], pkB[4]; v4u rowA[16], rowB[16]; v2u hN[4]; int hq_[4] = {0, 0, 0, 0}; float sh_ = 0.f;
            A_LOAD_PK(pkA, 0) A_LOAD_PK(pkB, 1) A_LOAD_H(hN, 0)
            A_ISSUE(rowA, pkA)
#pragma unroll 1
            for (int bi = 0; bi < nb; bi += 2) {
                if ((bi & 7) == 0) { A_QUANT(hN) A_LOAD_H(hN, bi + 8) }
                A_ISSUE(rowB, pkB) A_LOAD_PK(pkA, bi + 2)
                __builtin_amdgcn_sched_barrier(0);
                A_COMPUTE(rowA, bi)
                __builtin_amdgcn_sched_barrier(0);
                A_ISSUE(rowA, pkA) A_LOAD_PK(pkB, bi + 3)
                __builtin_amdgcn_sched_barrier(0);
                A_COMPUTE(rowB, bi + 1)
                __builtin_amdgcn_sched_barrier(0);
            }
#undef A_TOK
#undef A_LOAD_PK
#undef A_ISSUE
#undef A_LOAD_H
#undef A_QUANT
#undef A_COMPUTE
          }
        } }
        GRID_BAR();
        { PHASE_PTRS LAYER_PTRS
        { const int ln = lane_id_v();
          const float* PART = (const float*)(wsq + WS_PART); float* WGT = (float*)(wsq + WS_WGT);
          for (int rep_ = 0; rep_ < REP_P10B; ++rep_)
          for (int i4 = vcu * NTHREADS + wave * 64 + ln; i4 < T_EFF * NSEL / 4; i4 += NGT) {
              f32x4 dsum = (f32x4){0.f, 0.f, 0.f, 0.f};
#pragma unroll
              for (int sl = 0; sl < 8; ++sl) dsum += *((const GAS f32x4*)(PART + (size_t)sl * T_ALL * NSEL) + i4);
              const v4u esu = *((const GAS v4u*)EI + i4); const f32x4 gv = *((const GAS f32x4*)EG + i4);
              v4u o;
#pragma unroll
              for (int q = 0; q < 4; ++q) {
                  const float dot = dsum[q] * bf2f(esu[q] >> 16);
                  o[q] = (esu[q] & 0xffffu) | (f2bf(0.5f * dot * (1.0f + erff(dot * 0.70710678118654752f)) * gv[q]) << 16);
              }
              *((GAS v4u*)WGT + i4) = o;
          }
        } }
        GRID_BAR();
        { PHASE_PTRS LAYER_PTRS
        { const int ln = lane_id_v(); const int c = ln & 7, tg = ln >> 3;
          P10_CENSUS
          const unsigned* WGT = (const unsigned*)(wsq + WS_WGT); float* XO = (float*)(wsq + WS_XO);
          const unsigned char* V8l = V8 + (size_t)layer * 16384 * D;
          for (int rep_ = 0; rep_ < REP_P10C; ++rep_)
#pragma unroll 1
          for (int sl = 0; sl < 8; ++sl) {
            if (!((smask_ >> sl) & 1u)) continue;
            const int ws0 = (rank_ * NWAVES + wave) * 8, nslot = wstride_ * 8;
            if (ws0 >= T_EFF) continue;
            const int niter = (T_EFF - ws0 + nslot - 1) / nslot, nb = niter * 8;
#define C_TOK(bi) (ws0 + tg + (min((bi), nb - 1) >> 3) * nslot)
#define C_LOAD_PK(pkv, bi) { const GAS v4u* wp_ = (const GAS v4u*)(WGT + (size_t)C_TOK(bi) * NSEL + 16 * (min((bi), nb - 1) & 7)); _Pragma("unroll") for (int q = 0; q < 4; ++q) pkv[q] = wp_[q]; }
#define C_ISSUE(rowv, wv, pkv) { _Pragma("unroll") for (int q = 0; q < 16; ++q) { const unsigned w_ = pkv[q >> 2][q & 3]; rowv[q] = *(const GAS v4u*)(V8l + (size_t)(w_ & 0xffffu) * D + 128 * sl + 16 * c); } \
                _Pragma("unroll") for (int q = 0; q < 8; ++q) wv[q] = (pkv[q >> 1][(2 * q) & 3] >> 16) | (pkv[q >> 1][(2 * q + 1) & 3] & 0xffff0000u); }
#define C_COMPUTE(rowv, wv) { _Pragma("unroll") for (int q = 0; q < 16; ++q) { const float wq_ = (q & 1) ? __builtin_bit_cast(float, wv[q >> 1] & 0xffff0000u) : bf2f(wv[q >> 1] & 0xffffu); const f32x2 w2_ = (f32x2){wq_, wq_}; _Pragma("unroll") for (int j = 0; j < 4; ++j) { \
                    const f32x2 a = __builtin_amdgcn_cvt_pk_f32_fp8((int)rowv[q][j], false), b = __builtin_amdgcn_cvt_pk_f32_fp8((int)rowv[q][j], true); \
                    f32x2 lo_ = (f32x2){o[j].x, o[j].y}, hi_ = (f32x2){o[j].z, o[j].w}; lo_ = __builtin_elementwise_fma(a, w2_, lo_); hi_ = __builtin_elementwise_fma(b, w2_, hi_); \
                    o[j].x = lo_.x; o[j].y = lo_.y; o[j].z = hi_.x; o[j].w = hi_.y; } \
                    asm volatile("" : "+v"(o[0]), "+v"(o[1]), "+v"(o[2]), "+v"(o[3])); } }
            v4u pkA[4], pkB[4]; unsigned wA[8], wB[8]; v4u rowA[16], rowB[16];
            f32x4 o[4];
#pragma unroll
            for (int j = 0; j < 4; ++j) o[j] = (f32x4){0.f, 0.f, 0.f, 0.f};
            C_LOAD_PK(pkA, 0) C_LOAD_PK(pkB, 1)
            C_ISSUE(rowA, wA, pkA)
#pragma unroll 1
            for (int bi = 0; bi < nb; bi += 2) {
                C_ISSUE(rowB, wB, pkB) C_LOAD_PK(pkA, bi + 2)
                __builtin_amdgcn_sched_barrier(0);
                C_COMPUTE(rowA, wA)
                __builtin_amdgcn_sched_barrier(0);
                C_ISSUE(rowA, wA, pkA) C_LOAD_PK(pkB, bi + 3)
                __builtin_amdgcn_sched_barrier(0);
                C_COMPUTE(rowB, wB)
                __builtin_amdgcn_sched_barrier(0);
                if ((bi & 7) == 6) {
                    const int t = ws0 + tg + (bi >> 3) * nslot;
#pragma unroll
                    for (int j = 0; j < 4; ++j) { *(GAS f32x4*)(XO + (size_t)t * D + 256 * j + 32 * sl + 4 * c) = o[j]; o[j] = (f32x4){0.f, 0.f, 0.f, 0.f}; }
                }
            }
#undef C_TOK
#undef C_LOAD_PK
#undef C_ISSUE
#undef C_COMPUTE
          }
        } }
        GRID_BAR();
#undef P10_CENSUS
        { PHASE_PTRS LAYER_PTRS
        { const int ln = lane_id_v();
          const float* XO = (const float*)(wsq + WS_XO);
          f32x4 gt2v[4], gm[4], shv[4];
          auto prep = [&](int midx) {
              const float* md = modl + (size_t)midx * 6 * D; const float* md1 = modl + (size_t)(3 + midx) * 6 * D;
#pragma unroll
              for (int j = 0; j < 4; ++j) {
                  gt2v[j] = *((const GAS f32x4*)(md + 5 * D) + ln + 64 * j);
                  if (!last) { const f32x4 g = *((const GAS f32x4*)(IN_[I_G1] + (layer + 1) * D) + ln + 64 * j); const f32x4 sc = *((const GAS f32x4*)(md1 + D) + ln + 64 * j);
                               gm[j] = g * (sc + 1.0f); shv[j] = *((const GAS f32x4*)(md1 + 0) + ln + 64 * j); }
                  else { gm[j] = *((const GAS f32x4*)IN_[I_GFINAL] + ln + 64 * j); shv[j] = (f32x4){0.f, 0.f, 0.f, 0.f}; }
              } };
          auto row = [&](int t) {
              GAS f32x4* xr = (GAS f32x4*)(X + (size_t)t * D) + ln;
              const GAS f32x4* xo = (const GAS f32x4*)(XO + (size_t)t * D) + ln;
              f32x4 xn[4]; float ss = 0.f;
#pragma unroll
              for (int j = 0; j < 4; ++j) { xn[j] = xr[64 * j] + gt2v[j] * xo[64 * j]; ss += (xn[j].x * xn[j].x + xn[j].y * xn[j].y) + (xn[j].z * xn[j].z + xn[j].w * xn[j].w); }
              const float rs = 1.0f / sqrtf(wave_sum(ss) * (1.f / D) + NORM_EPS);
              if (!last) {
                  GAS v2u* o8 = (GAS v2u*)(H + (size_t)t * D) + ln;
#pragma unroll
                  for (int j = 0; j < 4; ++j) { xr[64 * j] = xn[j]; const f32x4 hh = xn[j] * rs * gm[j] + shv[j]; v2u o; o.x = pk2(hh.x, hh.y); o.y = pk2(hh.z, hh.w); o8[64 * j] = o; }
              } else {
                  GAS f32x4* op = (GAS f32x4*)(((float*)IN_[22]) + (size_t)t * D) + ln;
#pragma unroll
                  for (int j = 0; j < 4; ++j) op[64 * j] = xn[j] * rs * gm[j];
              } };
          wave_row_blocks(T_EFF, gw, NGW, prep, row);
        } }
#endif
        if (!last) GRID_BAR();
    }
}

extern "C" void kernel_launch(void* const* d_in, const int* in_sizes, int n_in, void* d_out, int out_size, void* d_ws, size_t ws_size, hipStream_t stream) {
    static int grid = 0;
    if (grid == 0) {
        if (n_in != 22 || out_size != T_LAT * D || ws_size < WS_END) { fprintf(stderr, "kernel_launch: unexpected shapes: n_in %d out %d ws %zu (need %zu)\n", n_in, out_size, ws_size, (size_t)WS_END); grid = -1; return; }
        int dev = 0, cus = 0, per_cu = 0;
        if (hipGetDevice(&dev) != hipSuccess || hipDeviceGetAttribute(&cus, hipDeviceAttributeMultiprocessorCount, dev) != hipSuccess) { fprintf(stderr, "device query failed\n"); grid = -1; return; }
        if (hipFuncSetAttribute((const void*)mega_fwd, hipFuncAttributeMaxDynamicSharedMemorySize, LDS_BYTES) != hipSuccess) { fprintf(stderr, "hipFuncSetAttribute failed\n"); grid = -1; return; }
        if (hipOccupancyMaxActiveBlocksPerMultiprocessor(&per_cu, (const void*)mega_fwd, NTHREADS, LDS_BYTES) != hipSuccess || per_cu < 1) { fprintf(stderr, "occupancy query: %d\n", per_cu); }
        (void)hipGetLastError();
        grid = cus;
    }
    if (grid < 0) return;
    if (hipMemsetAsync((char*)d_ws + WS_CTL, 0, CTL_ZERO_BYTES, stream) != hipSuccess) { fprintf(stderr, "memset failed\n"); return; }
    Args a{};
    for (int i = 0; i < 22; ++i) a.in[i] = (const float*)d_in[i];
    a.out = (float*)d_out; a.ws = (unsigned char*)d_ws;
    hipLaunchKernelGGL(mega_fwd, dim3(grid), dim3(NTHREADS), LDS_BYTES, stream, a);
}
```

```cpp
#include <hip/hip_runtime.h>
#include <cstdio>
#include <cstdint>

#ifndef REP_P0
#define REP_P0 1
#endif
#ifndef REP_P1
#define REP_P1 1
#endif
#ifndef REP_P2
#define REP_P2 1
#endif
#ifndef REP_P3A
#define REP_P3A 1
#endif
#ifndef REP_P3B
#define REP_P3B 1
#endif
#ifndef REP_P4
#define REP_P4 1
#endif
#ifndef REP_P6
#define REP_P6 1
#endif
#ifndef REP_P7
#define REP_P7 1
#endif
#ifndef REP_P8
#define REP_P8 1
#endif
#ifndef REP_P9
#define REP_P9 1
#endif
#ifndef REP_P10
#define REP_P10 1
#endif
#ifndef REP_P10A
#define REP_P10A 1
#endif
#ifndef REP_P10C
#define REP_P10C 1
#endif
#ifndef REP_P10B
#define REP_P10B 1
#endif
#ifndef REP_P0A
#define REP_P0A 1
#endif
#ifndef REP_P0D
#define REP_P0D 1
#endif
#ifndef REP_P0F
#define REP_P0F 1
#endif
#ifndef REP_P3C
#define REP_P3C 1
#endif
#define GAS __attribute__((address_space(1)))
#define LAS __attribute__((address_space(3)))
typedef unsigned short bf16;
typedef float f32x4 __attribute__((ext_vector_type(4)));
typedef short bf16x8 __attribute__((ext_vector_type(8)));
typedef unsigned v4u __attribute__((ext_vector_type(4)));
typedef unsigned v2u __attribute__((ext_vector_type(2)));
typedef float f32x2 __attribute__((ext_vector_type(2)));
typedef GAS unsigned gu32;

constexpr int NWAVES = 8, NTHREADS = 512;
constexpr int D = 1024, BATCH = 2, SEQ = 8192, DEPTH = 2, GRID_W = 64, CTX = 256;
constexpr int T_LAT = BATCH * SEQ;
constexpr int T_ALL = T_LAT + BATCH * CTX;
constexpr int NTOK = SEQ + CTX;
constexpr int IN_W = 6912;
constexpr int PEER_HEADS = 8, PEER_KEYS = 128, PEER_TOPK = 16, NSEL = PEER_HEADS * PEER_TOPK;
constexpr float NORM_EPS = 1e-6f;
constexpr float LOG2E = 1.4426950408889634f;
constexpr float SCL2 = 0.125f * LOG2E;

constexpr size_t MiB = 1u << 20;
constexpr size_t WS_CTL = 0, CTL_ZERO_BYTES = 1 * MiB;
constexpr int CW_BAR = 4096;
constexpr int CW_RANK = 8192;
#ifndef P10_SLICED
#define P10_SLICED 1
#endif
constexpr size_t WS_MOD = 65536;
constexpr size_t WS_COS = 2 * MiB, WS_SIN = 3 * MiB;
constexpr size_t WS_WIN = 4 * MiB;
constexpr size_t WS_WB = 31 * MiB;
constexpr size_t WS_WO = 37 * MiB;
constexpr size_t WS_WQ = 41 * MiB;
constexpr size_t WS_KEYS = 49 * MiB;
constexpr size_t WS_X = 50 * MiB;
constexpr size_t WS_H = 116 * MiB;
constexpr size_t WS_Y = 149 * MiB;
constexpr size_t WS_MG = WS_H;
constexpr size_t WS_U8 = 199 * MiB;
constexpr size_t WS_SCU = 231 * MiB;
constexpr size_t WS_EI = 232 * MiB;
constexpr size_t WS_EG = 241 * MiB;
constexpr size_t WS_P = 250 * MiB;
constexpr size_t SZ_R512 = (size_t)T_ALL * 512 * 2;
constexpr size_t SZ_R128 = (size_t)T_ALL * 128 * 2;
constexpr size_t WS_AQ = WS_P, WS_AK = WS_AQ + SZ_R512, WS_AVT = WS_AK + SZ_R128, WS_BQ = WS_AVT + SZ_R128, WS_BK = WS_BQ + SZ_R512,
                 WS_BVT = WS_BK + SZ_R512, WS_CQ = WS_BVT + SZ_R512, WS_CK = WS_CQ + SZ_R512, WS_CVT = WS_CK + SZ_R512, WS_SG = WS_CVT + SZ_R512;
constexpr size_t WS_Q2 = WS_P;
constexpr size_t WS_SC = WS_P + 66 * MiB;
constexpr size_t WS_PART = WS_P, WS_XO = WS_P + 66 * MiB, WS_WGT = WS_P + 132 * MiB;
constexpr size_t WS_PEND = WS_SG + (size_t)T_ALL * 3072 * 2;
constexpr size_t WS_V8 = 473 * MiB;
constexpr size_t WS_END = WS_V8 + 32 * MiB;
static_assert(WS_SC + (size_t)T_ALL * 2048 * 4 <= WS_PEND && WS_PEND <= WS_V8, "alias map");
static_assert(WS_END <= 512 * MiB, "ws map");

constexpr int LDS_BYTES = 147456;
constexpr int MISC_OFF = 131072 + 320;

__device__ __forceinline__ int lane_id_v() { int l; asm volatile("v_mbcnt_lo_u32_b32 %0, -1, 0\n\tv_mbcnt_hi_u32_b32 %0, -1, %0" : "=v"(l)); return l; }
#define XB_TMO      128
#define XB_XCNT(j)  (256  + 64 * (j))
#define XB_XSUB(j)  (1280 + 64 * (j))
#define XB_XGEN(j)  (2304 + 64 * (j))
#define XB_TOP      3328
#define XB_TOPGEN   3392
#define XCD_BAR_WORDS 3456
#define XB_SPIN_CAP (1u << 24)

__device__ __forceinline__ unsigned xb_ld(unsigned* p)              { return __hip_atomic_load(p, __ATOMIC_RELAXED, __HIP_MEMORY_SCOPE_AGENT); }
__device__ __forceinline__ unsigned xb_add(unsigned* p, unsigned v) { return __hip_atomic_fetch_add(p, v, __ATOMIC_RELAXED, __HIP_MEMORY_SCOPE_AGENT); }
__device__ __forceinline__ unsigned xb_xcc_id() { return (unsigned)__builtin_amdgcn_s_getreg((3 << 11) | 20) & 0xFu; }
#define XB_SPIN(cond, bar) do { unsigned _sp = 0; while (cond) { __builtin_amdgcn_s_sleep(1); \
    if ((++_sp & 255u) == 0u) { if (xb_ld(&(bar)[XB_TMO])) break; if (_sp > XB_SPIN_CAP) { atomicAdd(&(bar)[XB_TMO], 1u); break; } } } } while (0)

struct XcdBarrier { unsigned* bar; unsigned x; volatile LAS unsigned* st; };

__device__ __forceinline__ XcdBarrier xcd_barrier_post(unsigned* bar, volatile LAS unsigned* st) {
    XcdBarrier b; b.bar = bar; b.x = xb_xcc_id(); b.st = st;
    if (threadIdx.x == 0) (void)xb_add(&bar[XB_XCNT(b.x)], 1u);
    return b;
}
__device__ __forceinline__ void xcd_barrier_complete(unsigned* bar, unsigned x, unsigned& nloc, unsigned& nx) {
    const unsigned G = gridDim.x * gridDim.y * gridDim.z;
    unsigned sum, cnt, mine, sp = 0u;
    for (;;) {
        sum = 0u; cnt = 0u; mine = 0u;
#pragma unroll
        for (unsigned j = 0; j < 16; ++j) { const unsigned c = xb_ld(&bar[XB_XCNT(j)]); sum += c; cnt += (c > 0u) ? 1u : 0u; mine = (j == x) ? c : mine; }
        if (sum == G) break;
        __builtin_amdgcn_s_sleep(1);
        if ((++sp & 255u) == 0u) { if (xb_ld(&bar[XB_TMO])) break; if (sp > XB_SPIN_CAP) { atomicAdd(&bar[XB_TMO], 1u); break; } }
    }
    nloc = mine > 0u ? mine : 1u; nx = cnt > 0u ? cnt : 1u;
}
__device__ __forceinline__ void xcd_barrier(const XcdBarrier& b, bool t0) {
    asm volatile("s_waitcnt vmcnt(0)" ::: "memory");
    __syncthreads();
    if (t0) {
        unsigned* bar = b.bar;
        __builtin_amdgcn_s_waitcnt(0);
        unsigned nloc = b.st[0], nx = b.st[1];
        if (nloc == 0u) { xcd_barrier_complete(bar, b.x, nloc, nx); b.st[0] = nloc; b.st[1] = nx; }
        const unsigned old = xb_add(&bar[XB_XSUB(b.x)], 1u);
        const unsigned gen = old / nloc;
        if (old + 1u == (gen + 1u) * nloc) {
            __builtin_amdgcn_fence(__ATOMIC_RELEASE, "agent");
            asm volatile("s_waitcnt vmcnt(0)" ::: "memory");
            const unsigned og = xb_add(&bar[XB_TOP], 1u);
            const unsigned tg = og / nx;
            if (og + 1u == (tg + 1u) * nx) xb_add(&bar[XB_TOPGEN], 1u);
            else XB_SPIN(xb_ld(&bar[XB_TOPGEN]) == tg, bar);
            __builtin_amdgcn_fence(__ATOMIC_ACQUIRE, "agent");
            xb_add(&bar[XB_XGEN(b.x)], 1u);
            asm volatile("s_waitcnt vmcnt(0)" ::: "memory");
        } else {
            XB_SPIN(xb_ld(&bar[XB_XGEN(b.x)]) == gen, bar);
            __builtin_amdgcn_fence(__ATOMIC_ACQUIRE, "agent");
            asm volatile("s_waitcnt vmcnt(0)" ::: "memory");
        }
    }
    __syncthreads();
}

__device__ __forceinline__ unsigned f2bf(float f) { unsigned u = __builtin_bit_cast(unsigned, f); return (u + 0x7fffu + ((u >> 16) & 1u)) >> 16; }
__device__ __forceinline__ unsigned pk2(float lo, float hi) { return f2bf(lo) | (f2bf(hi) << 16); }
__device__ __forceinline__ float bf2f(unsigned h) { return __builtin_bit_cast(float, h << 16); }
template <int CTRL> __device__ __forceinline__ float dpp_mov(float v) { return __builtin_bit_cast(float, __builtin_amdgcn_update_dpp(0, __builtin_bit_cast(int, v), CTRL, 0xF, 0xF, true)); }
__device__ __forceinline__ float sum8_dpp(float v) { v += dpp_mov<0xB1>(v); v += dpp_mov<0x4E>(v); v += dpp_mov<0x141>(v); return v; }
template <int K> __device__ __forceinline__ float xshfl_l(float v, int lane) { return __builtin_bit_cast(float, __builtin_amdgcn_ds_bpermute((lane ^ K) << 2, __builtin_bit_cast(int, v))); }
template <int K> __device__ __forceinline__ float xshfl(float v) { return xshfl_l<K>(v, lane_id_v()); }
__device__ __forceinline__ float xadd32(float v) { return v + xshfl_l<32>(v, lane_id_v()); }
__device__ __forceinline__ float xmax32(float v) { return fmaxf(v, xshfl_l<32>(v, lane_id_v())); }
__device__ __forceinline__ float wave_sum(float v) { const int l = lane_id_v(); v += xshfl_l<1>(v, l); v += xshfl_l<2>(v, l); v += xshfl_l<4>(v, l); v += xshfl_l<8>(v, l); v += xshfl_l<16>(v, l); v += xshfl_l<32>(v, l); return v; }
__device__ __forceinline__ float wave_max(float v) { const int l = lane_id_v(); v = fmaxf(v, xshfl_l<1>(v, l)); v = fmaxf(v, xshfl_l<2>(v, l)); v = fmaxf(v, xshfl_l<4>(v, l)); v = fmaxf(v, xshfl_l<8>(v, l)); v = fmaxf(v, xshfl_l<16>(v, l)); v = fmaxf(v, xshfl_l<32>(v, l)); return v; }


__device__ __forceinline__ float sigmoidf_(float x) { return 1.0f / (1.0f + __expf(-x)); }
__device__ __forceinline__ float sigmoid_fast(float x) { return __builtin_amdgcn_rcpf(1.0f + __builtin_amdgcn_exp2f(-LOG2E * x)); }
__device__ __forceinline__ int row_modidx(int r) { return r < T_LAT ? (r >> 13) : 2; }
__device__ __forceinline__ int row_batch(int r) { return r < T_LAT ? (r >> 13) : ((r - T_LAT) >> 8); }
__device__ __forceinline__ int row_tok(int r) { return r < T_LAT ? (r & (SEQ - 1)) : SEQ + ((r - T_LAT) & (CTX - 1)); }

__device__ __forceinline__ const float* xin_row(const float* x, const float* ctx, int r) { return r < T_LAT ? x + (size_t)r * D : ctx + (size_t)(r - T_LAT) * D; }
template <class Prep, class Row>
__device__ __forceinline__ void wave_row_blocks(int T_rows, int gw, int NGW, Prep prep, Row row) {
    for (int r0 = gw * 8; r0 < T_LAT; r0 += NGW * 8) {
        prep(r0 >> 13);
#pragma unroll 2
        for (int k = 0; k < 8; ++k) row(r0 + k);
    }
    if (T_rows > T_LAT) for (int r = T_LAT + gw; r < T_rows; r += NGW) { prep(2); row(r); }
}
struct Args { const float* in[22]; float* out; unsigned char* ws; };
enum { I_X = 0, I_C, I_CTX, I_CCTX, I_WMOD, I_BMOD, I_G1, I_G2, I_WIN, I_SINK, I_RPB, I_LAMBDA, I_SUBLN, I_WBA, I_WBB, I_WBC, I_WOUT, I_PWQ, I_PKEYS, I_PU, I_PV, I_GFINAL };

__device__ __forceinline__ int rope_perm(int c) {
    if (c < 640 || (c >= 2304 && c < 3328)) { const int w = c & 63; return (c & ~63) + 2 * (w & 31) + (w >> 5); }
    return c;
}
template <bool PERM = false>
__device__ __forceinline__ void p0_transpose_item(const float* W, int K, int N, bf16* WT, LAS float* scr, int item, int lane) {
    const int nblk = N / 32, kb = item / nblk, nb = item % nblk, k0 = 64 * kb, n0 = 32 * nb;
#pragma unroll 8
    for (int i = 0; i < 32; ++i) { const int kk = 2 * i + (lane >> 5); scr[kk * 33 + (lane & 31)] = W[(size_t)(k0 + kk) * N + n0 + (lane & 31)]; }
    asm volatile("s_waitcnt lgkmcnt(0)" ::: "memory");
    const int c = lane & 7;
#pragma unroll
    for (int j = 0; j < 4; ++j) { const int n = (lane >> 3) + 8 * j; const LAS float* s = scr + (8 * c) * 33 + n;
        v4u o; o.x = pk2(s[0 * 33], s[1 * 33]); o.y = pk2(s[2 * 33], s[3 * 33]); o.z = pk2(s[4 * 33], s[5 * 33]); o.w = pk2(s[6 * 33], s[7 * 33]);
        const int nout = PERM ? rope_perm(n0 + n) : (n0 + n);
        *(GAS v4u*)(WT + (size_t)nout * K + k0 + 8 * c) = o; }
    asm volatile("s_waitcnt lgkmcnt(0)" ::: "memory");
}

template <int UNR = 2, int NN = 4>
__device__ __forceinline__ void sgemm_tile(f32x4 (&acc)[4][NN], const bf16* A, int lda, const bf16* Bt, int ldb, int K, int row0, int col0, int lane) {
    const int fr = lane & 15, fq = lane >> 4;
    const bf16* ap = A + (size_t)(row0 + fr) * lda + fq * 8;
    const bf16* bp = Bt + (size_t)(col0 + fr) * ldb + fq * 8;
#pragma unroll UNR
    for (int k = 0; k < K; k += 32) {
        bf16x8 a[4], b[NN];
#pragma unroll
        for (int m = 0; m < 4; ++m) a[m] = *(const GAS bf16x8*)(ap + (size_t)m * 16 * lda + k);
#pragma unroll
        for (int n = 0; n < NN; ++n) b[n] = *(const GAS bf16x8*)(bp + (size_t)n * 16 * ldb + k);
#pragma unroll
        for (int m = 0; m < 4; ++m)
#pragma unroll
            for (int n = 0; n < NN; ++n) acc[m][n] = __builtin_amdgcn_mfma_f32_16x16x32_bf16(a[m], b[n], acc[m][n], 0, 0, 0);
    }
}
template <int UNR>
__device__ __forceinline__ void sgemm32(f32x4 (&acc)[2][2], const bf16* A, int lda, const bf16* Bt, int ldb, int K, int row0, int col0, int lane) {
    const int fr = lane & 15, fq = lane >> 4;
    const bf16* ap = A + (size_t)(row0 + fr) * lda + fq * 8;
    const bf16* bp = Bt + (size_t)(col0 + fr) * ldb + fq * 8;
#pragma unroll 1
    for (int k0 = 0; k0 < K; k0 += 32 * UNR) {
        bf16x8 a[UNR][2], b[UNR][2];
#pragma unroll
        for (int u = 0; u < UNR; ++u)
#pragma unroll
            for (int m = 0; m < 2; ++m) { a[u][m] = *(const GAS bf16x8*)(ap + (size_t)m * 16 * lda + k0 + 32 * u); b[u][m] = *(const GAS bf16x8*)(bp + (size_t)m * 16 * ldb + k0 + 32 * u); }
#pragma unroll
        for (int u = 0; u < UNR; ++u)
#pragma unroll
            for (int m = 0; m < 2; ++m)
#pragma unroll
                for (int n = 0; n < 2; ++n) acc[m][n] = __builtin_amdgcn_mfma_f32_16x16x32_bf16(a[u][m], b[u][n], acc[m][n], 0, 0, 0);
    }
}
__device__ __forceinline__ void zero_acc22(f32x4 (&acc)[2][2]) { acc[0][0] = acc[0][1] = acc[1][0] = acc[1][1] = (f32x4){0.f, 0.f, 0.f, 0.f}; }
template <int NN>
__device__ __forceinline__ void zero_acc(f32x4 (&acc)[4][NN]) {
#pragma unroll
    for (int m = 0; m < 4; ++m)
#pragma unroll
        for (int n = 0; n < NN; ++n) acc[m][n] = (f32x4){0.f, 0.f, 0.f, 0.f};
}

__device__ __forceinline__ int f2ord(float f) { const int b = __builtin_bit_cast(int, f); return b ^ ((b >> 31) & 0x7fffffff); }
__device__ __forceinline__ float ord2f(int o) { const int b = o ^ ((o >> 31) & 0x7fffffff); return __builtin_bit_cast(float, b); }
__device__ __forceinline__ void top16_insert(int (&top)[16], int key) {
#pragma unroll
    for (int i = 0; i < 16; ++i) { const int hi = max(top[i], key); key = min(top[i], key); top[i] = hi; }
}
#define CE(a, b) { const int t_ = max(a, b); b = min(a, b); a = t_; }
__device__ __forceinline__ void sort16_desc(int (&v)[16]) { CE(v[0], v[1]); CE(v[3], v[2]); CE(v[4], v[5]); CE(v[7], v[6]); CE(v[8], v[9]); CE(v[11], v[10]); CE(v[12], v[13]); CE(v[15], v[14]); CE(v[0], v[2]); CE(v[1], v[3]); CE(v[6], v[4]); CE(v[7], v[5]); CE(v[8], v[10]); CE(v[9], v[11]); CE(v[14], v[12]); CE(v[15], v[13]); CE(v[0], v[1]); CE(v[2], v[3]); CE(v[5], v[4]); CE(v[7], v[6]); CE(v[8], v[9]); CE(v[10], v[11]); CE(v[13], v[12]); CE(v[15], v[14]); CE(v[0], v[4]); CE(v[1], v[5]); CE(v[2], v[6]); CE(v[3], v[7]); CE(v[12], v[8]); CE(v[13], v[9]); CE(v[14], v[10]); CE(v[15], v[11]); CE(v[0], v[2]); CE(v[1], v[3]); CE(v[4], v[6]); CE(v[5], v[7]); CE(v[10], v[8]); CE(v[11], v[9]); CE(v[14], v[12]); CE(v[15], v[13]); CE(v[0], v[1]); CE(v[2], v[3]); CE(v[4], v[5]); CE(v[6], v[7]); CE(v[9], v[8]); CE(v[11], v[10]); CE(v[13], v[12]); CE(v[15], v[14]); CE(v[0], v[8]); CE(v[1], v[9]); CE(v[2], v[10]); CE(v[3], v[11]); CE(v[4], v[12]); CE(v[5], v[13]); CE(v[6], v[14]); CE(v[7], v[15]); CE(v[0], v[4]); CE(v[1], v[5]); CE(v[2], v[6]); CE(v[3], v[7]); CE(v[8], v[12]); CE(v[9], v[13]); CE(v[10], v[14]); CE(v[11], v[15]); CE(v[0], v[2]); CE(v[1], v[3]); CE(v[4], v[6]); CE(v[5], v[7]); CE(v[8], v[10]); CE(v[9], v[11]); CE(v[12], v[14]); CE(v[13], v[15]); CE(v[0], v[1]); CE(v[2], v[3]); CE(v[4], v[5]); CE(v[6], v[7]); CE(v[8], v[9]); CE(v[10], v[11]); CE(v[12], v[13]); CE(v[14], v[15]); }
__device__ __forceinline__ void merge16_desc(int (&a)[16], const int (&b)[16]) {
#pragma unroll
    for (int i = 0; i < 16; ++i) a[i] = max(a[i], b[15 - i]);
    CE(a[0], a[8]); CE(a[1], a[9]); CE(a[2], a[10]); CE(a[3], a[11]); CE(a[4], a[12]); CE(a[5], a[13]); CE(a[6], a[14]); CE(a[7], a[15]); CE(a[0], a[4]); CE(a[1], a[5]); CE(a[2], a[6]); CE(a[3], a[7]); CE(a[8], a[12]); CE(a[9], a[13]); CE(a[10], a[14]); CE(a[11], a[15]); CE(a[0], a[2]); CE(a[1], a[3]); CE(a[4], a[6]); CE(a[5], a[7]); CE(a[8], a[10]); CE(a[9], a[11]); CE(a[12], a[14]); CE(a[13], a[15]); CE(a[0], a[1]); CE(a[2], a[3]); CE(a[4], a[5]); CE(a[6], a[7]); CE(a[8], a[9]); CE(a[10], a[11]); CE(a[12], a[13]); CE(a[14], a[15]); }
#undef CE


typedef float f32x16 __attribute__((ext_vector_type(16)));
typedef short s16x4 __attribute__((ext_vector_type(4)));
typedef __bf16 bf16x2_t __attribute__((ext_vector_type(2)));
__device__ __forceinline__ unsigned cvtpk(float lo, float hi) { f32x2 v = {lo, hi}; bf16x2_t b = __builtin_convertvector(v, bf16x2_t); return __builtin_bit_cast(unsigned, b); }
constexpr int CK_PITCH = 144, CV_PITCH = 320;
constexpr int CK_SZ = 64 * CK_PITCH, CV_SZ = 64 * CV_PITCH;
constexpr float C_THR_RAW = 8.0f / SCL2;

template <int NDV, class RowFn, class UseFn, class ElemFn>
__device__ __forceinline__ void attn64_pass(f32x16 (&o)[NDV], float& mrun, float& lpart, const bf16x8 (&qf)[4], const bf16* kg, int kpitch, const bf16* vg, int vpitch,
                                            int ntiles, RowFn tile_row, UseFn use_tile, ElemFn elem, LAS unsigned char* L, int lane, int tid) {
    constexpr int VP = NDV * 64 + 64, VSZ = 64 * VP, NVP = NDV / 2;
    const int r32 = lane & 31, hi = lane >> 5;
    const int krow_s = tid >> 3, kch_s = tid & 7;
    const int vrow_s = (NDV == 2) ? (tid >> 3) : (tid >> 4), vch_s = (NDV == 2) ? (tid & 7) : (tid & 15);
    LAS unsigned char* Kb0 = L; LAS unsigned char* Vb0 = L + 2 * CK_SZ;
    __syncthreads();
    {
        const int tr = tile_row(0);
        const v4u kr = *(const GAS v4u*)(kg + (size_t)tr * kpitch);
        *(LAS v4u*)(Kb0 + krow_s * CK_PITCH + kch_s * 16) = kr;
#pragma unroll
        for (int i = 0; i < NVP; ++i) { const v4u v = *(const GAS v4u*)(vg + (size_t)(tr + 32 * i) * vpitch); *(LAS v4u*)(Vb0 + (vrow_s + 32 * i) * VP + vch_s * 16) = v; }
    }
    v4u kr, vr[NVP];
    { const int tr = tile_row(ntiles > 1 ? 1 : 0); kr = *(const GAS v4u*)(kg + (size_t)tr * kpitch);
#pragma unroll
      for (int i = 0; i < NVP; ++i) vr[i] = *(const GAS v4u*)(vg + (size_t)(tr + 32 * i) * vpitch); }
    __syncthreads();
#pragma unroll 1
    for (int j = 0; j < ntiles; ++j) {
        const int cur = j & 1;
        const LAS unsigned char* Kb = Kb0 + cur * CK_SZ; const LAS unsigned char* Vb = Vb0 + cur * VSZ;
        const bool more = (j + 1 < ntiles);
        v4u kr2, vr2[NVP];
        { const int tr = tile_row(j + 2 < ntiles ? j + 2 : ntiles - 1); kr2 = *(const GAS v4u*)(kg + (size_t)tr * kpitch);
#pragma unroll
            for (int i = 0; i < NVP; ++i) vr2[i] = *(const GAS v4u*)(vg + (size_t)(tr + 32 * i) * vpitch); }
        if (use_tile(j)) {
            f32x16 st[2];
#pragma unroll
            for (int kb = 0; kb < 2; ++kb) {
#pragma unroll
                for (int r = 0; r < 16; ++r) st[kb][r] = 0.f;
#pragma unroll
                for (int ks = 0; ks < 4; ++ks) {
                    const bf16x8 kf = *(const LAS bf16x8*)(Kb + (kb * 32 + r32) * CK_PITCH + ks * 32 + hi * 16);
                    st[kb] = __builtin_amdgcn_mfma_f32_32x32x16_bf16(kf, qf[ks], st[kb], 0, 0, 0);
                }
            }
            elem(st, j);
            float mx = st[0][0];
#pragma unroll
            for (int r = 1; r < 16; ++r) mx = fmaxf(mx, st[0][r]);
#pragma unroll
            for (int r = 0; r < 16; ++r) mx = fmaxf(mx, st[1][r]);
            mx = xmax32(mx);
            if (__builtin_amdgcn_ballot_w64(mx > mrun + C_THR_RAW) != 0ull) {
                const float mn = fmaxf(mrun, mx);
                const float alpha = __builtin_amdgcn_exp2f((mrun - mn) * SCL2);
#pragma unroll
                for (int d = 0; d < NDV; ++d)
#pragma unroll
                    for (int r = 0; r < 16; ++r) o[d][r] *= alpha;
                lpart *= alpha; mrun = mn;
            }
            const float nmc = -mrun * SCL2;
            float ls = 0.f;
#pragma unroll
            for (int kb = 0; kb < 2; ++kb)
#pragma unroll
                for (int r = 0; r < 16; ++r) { const float p = __builtin_amdgcn_exp2f(fmaf(st[kb][r], SCL2, nmc)); st[kb][r] = p; ls += p; }
            lpart += ls;
            const int q4 = (lane & 15) >> 2, p4 = lane & 3, grp = (lane >> 4) & 1;
            const LAS unsigned char* vbase = Vb + (4 * hi + q4) * VP + (16 * grp + 4 * p4) * 2;
#pragma unroll
            for (int kb = 0; kb < 2; ++kb)
#pragma unroll
                for (int ss = 0; ss < 2; ++ss) {
                    v4u pw;
#pragma unroll
                    for (int i2 = 0; i2 < 4; ++i2) pw[i2] = cvtpk(st[kb][8 * ss + 2 * i2], st[kb][8 * ss + 2 * i2 + 1]);
                    const bf16x8 pb = __builtin_bit_cast(bf16x8, pw);
#pragma unroll
                    for (int d = 0; d < NDV; ++d) {
                        const LAS unsigned char* va = vbase + (kb * 32 + 16 * ss) * VP + d * 64;
                        const s16x4 lo = __builtin_bit_cast(s16x4, __builtin_amdgcn_ds_read_tr16_b64_v4i16((LAS s16x4*)va));
                        const s16x4 hh = __builtin_bit_cast(s16x4, __builtin_amdgcn_ds_read_tr16_b64_v4i16((LAS s16x4*)(va + 8 * VP)));
                        const bf16x8 vf = __builtin_shufflevector(lo, hh, 0, 1, 2, 3, 4, 5, 6, 7);
                        o[d] = __builtin_amdgcn_mfma_f32_32x32x16_bf16(vf, pb, o[d], 0, 0, 0);
                    }
                }
        }
        if (more) {
            LAS unsigned char* Kn = Kb0 + (cur ^ 1) * CK_SZ; LAS unsigned char* Vn = Vb0 + (cur ^ 1) * VSZ;
            *(LAS v4u*)(Kn + krow_s * CK_PITCH + kch_s * 16) = kr;
#pragma unroll
            for (int i = 0; i < NVP; ++i) *(LAS v4u*)(Vn + (vrow_s + 32 * i) * VP + vch_s * 16) = vr[i];
        }
        kr = kr2;
#pragma unroll
        for (int i = 0; i < NVP; ++i) vr[i] = vr2[i];
        __syncthreads();
    }
}
__device__ __forceinline__ void attn64_store(const f32x16 (&o)[2], float inv, bf16* yrow, int hi) {
#pragma unroll
    for (int d = 0; d < 2; ++d)
#pragma unroll
        for (int g4 = 0; g4 < 4; ++g4) {
            v2u w; w.x = cvtpk(o[d][4 * g4] * inv, o[d][4 * g4 + 1] * inv); w.y = cvtpk(o[d][4 * g4 + 2] * inv, o[d][4 * g4 + 3] * inv);
            *(GAS v2u*)(yrow + d * 32 + 8 * g4 + 4 * hi) = w;
        }
}

namespace pg8 {
typedef unsigned short bf16_t;
constexpr int BM = 256, BK = 64, HALF = 128, HTB = HALF * BK * 2, STAGE_BYTES = 8 * HTB, NXCD = 8, WGM = 8;
__host__ __device__ __forceinline__ int lds_byte(int r, int c) { const int st = (r >> 4) * 2 + (c >> 5), rr = r & 15, cc = c & 31, ob = rr * 64 + cc * 2; return st * 1024 + (ob ^ (((ob >> 9) & 1) << 5)); }
__host__ __device__ __forceinline__ void stage_rc(int b, int& R, int& C) { const int st = b / 1024, sb = b % 1024, swz = sb ^ (((sb >> 9) & 1) << 5); R = (st >> 1) * 16 + swz / 64; C = (st & 1) * 32 + (swz % 64) / 2; }
__host__ __device__ __forceinline__ int perm32(int rho) { const int n = rho >> 4, i = rho & 15; return 8 * (i >> 2) + 4 * n + (i & 3); }
struct Unit { int pm, pn, seg; };
struct Gemm { const bf16_t* A; const bf16_t* Bt; int lda, ldb, K; size_t a_seg, b_seg; };
struct TileOrder {
    int nM, nN, nwg, G, c;
    __device__ void init(int M, int N, int G_, int c_) { nM = M / BM; nN = N / BM; nwg = nM * nN; G = G_; c = c_; }
    __device__ bool tile(int i, int& pm, int& pn) const {
        const long L = (long)i * G + c; if (L >= nwg) return false;
        int wgid = (int)L; { const int q = nwg / NXCD, r = nwg % NXCD, xcd = wgid % NXCD, off = wgid / NXCD; wgid = (xcd < r ? xcd * (q + 1) : r * (q + 1) + (xcd - r) * q) + off; }
        const int nig = WGM * nN, gid = wgid / nig, fm = gid * WGM, gsz = (nM - fm) < WGM ? (nM - fm) : WGM;
        pm = fm + ((wgid % nig) % gsz); pn = (wgid % nig) / gsz; return true;
    }
};
template <int NSEG> struct SegOrder {
    TileOrder T;
    __device__ bool next(int i, Unit& u) const { u.seg = i % NSEG; return T.tile(i / NSEG, u.pm, u.pn); }
};
template <class Epi, class Sched>
__device__ __forceinline__ void gemm_phase(LAS unsigned char* lds, const Gemm g, const Sched& S, const Epi& E, int wid) {
    const int lane = lane_id_v(), tid = wid * 64 + lane,
              wr = wid >> 2, wc = wid & 3, fr = lane & 15, fq = lane >> 4;
    const int K = g.K, nt = K / BK;
    unsigned voffA[2], voffB[2];
#pragma unroll
    for (int i = 0; i < 2; ++i) { int R, C; stage_rc(tid * 16 + i * 8192, R, C); const int Rb = (R & ~31) + perm32(R & 31);
        voffA[i] = (unsigned)(R * g.lda + C) * 2u; voffB[i] = (unsigned)(Rb * g.ldb + C) * 2u; }
    const size_t kstep = (size_t)(BK * 2);
    const size_t hstepA = (size_t)HALF * g.lda * 2, hstepB = (size_t)HALF * g.ldb * 2;
    const unsigned ldsw = (unsigned)wid * 1024u;
    const int aoff = lds_byte(wr * 64 + fr, fq * 8), boff = lds_byte(wc * 32 + fr, fq * 8);
#define PG8_SA(b, h) (((b) * 2 + (h)) * HTB)
#define PG8_SB(b, h) ((4 + (b) * 2 + (h)) * HTB)
#define PG8_STAGE(bufoff, gbase, voff) do { _Pragma("unroll") for (int _i = 0; _i < 2; ++_i) \
        __builtin_amdgcn_global_load_lds((const unsigned*)((const char*)(gbase) + (voff)[_i]), (LAS unsigned*)(lds + (bufoff) + ldsw + _i * 8192), 16, 0, 0); } while (0)
#define PG8_LDA(dst, b, h) do { _Pragma("unroll") for (int m = 0; m < 4; ++m) _Pragma("unroll") for (int k = 0; k < 2; ++k) dst[m][k] = *(const LAS bf16x8*)(lds + PG8_SA(b, h) + aoff + m * 2048 + k * 1024); } while (0)
#define PG8_LDB(dst, b, h) do { _Pragma("unroll") for (int n = 0; n < 2; ++n) _Pragma("unroll") for (int k = 0; k < 2; ++k) dst[n][k] = *(const LAS bf16x8*)(lds + PG8_SB(b, h) + boff + n * 2048 + k * 1024); } while (0)
#define PG8_MMA(ai, bj, At, Bt) do { __builtin_amdgcn_s_setprio(1); _Pragma("unroll") for (int m = 0; m < 4; ++m) _Pragma("unroll") for (int n = 0; n < 2; ++n) _Pragma("unroll") for (int k = 0; k < 2; ++k) \
        acc[ai][bj][m][n] = __builtin_amdgcn_mfma_f32_16x16x32_bf16(Bt[n][k], At[m][k], acc[ai][bj][m][n], 0, 0, 0); __builtin_amdgcn_s_setprio(0); } while (0)
#define PG8_WAIT_V(n) asm volatile("s_waitcnt vmcnt(" #n ")" ::: "memory")
#define PG8_WAIT_L(n) asm volatile("s_waitcnt lgkmcnt(" #n ")" ::: "memory")
#define PG8_BAR __builtin_amdgcn_s_barrier()
#define PG8_SCHED __builtin_amdgcn_sched_barrier(0)
#define PG8_ABASE(u) ((const char*)g.A + ((size_t)(u).seg * g.a_seg + (size_t)(u).pm * BM * g.lda) * 2)
#define PG8_BBASE(u) ((const char*)g.Bt + ((size_t)(u).seg * g.b_seg + (size_t)(u).pn * BM * g.ldb) * 2)
    Unit cur, nxt; int ui = 0;
    if (!S.next(0, cur)) return;
    f32x4 acc[2][2][4][2];
#pragma unroll
    for (int a = 0; a < 2; ++a)
#pragma unroll
        for (int b = 0; b < 2; ++b)
#pragma unroll
            for (int m = 0; m < 4; ++m)
#pragma unroll
                for (int n = 0; n < 2; ++n) acc[a][b][m][n] = (f32x4){0.f, 0.f, 0.f, 0.f};
    bf16x8 At[4][2], B0[2][2], B1[2][2];
    const char* cA = PG8_ABASE(cur); const char* cB = PG8_BBASE(cur);
    PG8_STAGE(PG8_SB(0, 0), cB, voffB); PG8_STAGE(PG8_SB(0, 1), cB + hstepB, voffB); PG8_STAGE(PG8_SA(0, 0), cA, voffA); PG8_STAGE(PG8_SA(0, 1), cA + hstepA, voffA);
    if (wr == 1) PG8_BAR;
    PG8_WAIT_V(2); PG8_BAR;
    PG8_STAGE(PG8_SB(1, 0), cB + kstep, voffB); PG8_STAGE(PG8_SA(1, 0), cA + kstep, voffA); PG8_STAGE(PG8_SB(1, 1), cB + hstepB + kstep, voffB);
    PG8_WAIT_V(6); PG8_BAR;
    for (;;) {
        const bool has_next = S.next(ui + 1, nxt);
        const char* nA = has_next ? PG8_ABASE(nxt) : cA; const char* nB = has_next ? PG8_BBASE(nxt) : cB;
        for (int t = 0; t < nt; t += 2) {
            const bool lastk = (t == nt - 2);
            const char* a1 = cA + (size_t)(t + 1) * kstep;
            const char* a2 = lastk ? nA : cA + (size_t)(t + 2) * kstep; const char* b2 = lastk ? nB : cB + (size_t)(t + 2) * kstep;
            const char* a3 = a2 + kstep; const char* b3 = b2 + kstep;
            PG8_LDB(B0, 0, 0); PG8_LDB(B1, 0, 1); PG8_SCHED; PG8_LDA(At, 0, 0); PG8_STAGE(PG8_SA(1, 1), a1 + hstepA, voffA);
            PG8_WAIT_V(8); PG8_WAIT_L(0); PG8_BAR; PG8_MMA(0, 0, At, B0); PG8_MMA(0, 1, At, B1); PG8_BAR; PG8_SCHED;
            PG8_LDA(At, 0, 1); PG8_STAGE(PG8_SB(0, 0), b2, voffB); PG8_STAGE(PG8_SB(0, 1), b2 + hstepB, voffB); PG8_STAGE(PG8_SA(0, 0), a2, voffA);
            PG8_WAIT_V(8); PG8_WAIT_L(0); PG8_BAR; PG8_MMA(1, 0, At, B0); PG8_MMA(1, 1, At, B1); PG8_BAR; PG8_SCHED;
            PG8_LDB(B0, 1, 0); PG8_LDB(B1, 1, 1); PG8_SCHED; PG8_LDA(At, 1, 0); PG8_STAGE(PG8_SA(0, 1), a2 + hstepA, voffA);
            PG8_WAIT_V(8); PG8_WAIT_L(0); PG8_BAR; PG8_MMA(0, 0, At, B0); PG8_MMA(0, 1, At, B1); PG8_BAR; PG8_SCHED;
            PG8_LDA(At, 1, 1); PG8_STAGE(PG8_SB(1, 0), b3, voffB); PG8_STAGE(PG8_SB(1, 1), b3 + hstepB, voffB); PG8_STAGE(PG8_SA(1, 0), a3, voffA);
            PG8_WAIT_V(8); PG8_WAIT_L(0); PG8_BAR; PG8_MMA(1, 0, At, B0); PG8_MMA(1, 1, At, B1); PG8_BAR; PG8_SCHED;
        }
        if (wr == 0) PG8_BAR;
        E(acc, cur, wr, wc, fr, fq);
        if (!has_next) break;
#pragma unroll
        for (int a = 0; a < 2; ++a)
#pragma unroll
            for (int b = 0; b < 2; ++b)
#pragma unroll
                for (int m = 0; m < 4; ++m)
#pragma unroll
                    for (int n = 0; n < 2; ++n) acc[a][b][m][n] = (f32x4){0.f, 0.f, 0.f, 0.f};
        cur = nxt; cA = nA; cB = nB; ++ui;
        if (wr == 1) PG8_BAR;
    }
    PG8_WAIT_V(0);
    PG8_BAR;
#undef PG8_SA
#undef PG8_SB
#undef PG8_STAGE
#undef PG8_LDA
#undef PG8_LDB
#undef PG8_MMA
#undef PG8_WAIT_V
#undef PG8_WAIT_L
#undef PG8_BAR
#undef PG8_SCHED
#undef PG8_ABASE
#undef PG8_BBASE
}
}

__device__ __forceinline__ v4u pack8(const f32x4& a, const f32x4& b) { v4u w; w.x = cvtpk(a.x, a.y); w.y = cvtpk(a.z, a.w); w.z = cvtpk(b.x, b.y); w.w = cvtpk(b.z, b.w); return w; }
struct EpiInProj {
    bf16 *AQ, *AK, *AVT, *BQ, *BK, *BVT, *CQ, *CK, *CV, *SG; const float *COS, *SIN;
    __device__ __forceinline__ void operator()(const f32x4 (&acc)[2][2][4][2], const pg8::Unit& u, int wr, int wc, int fr, int fq) const {
        asm volatile("" : "+v"(fr), "+v"(fq));
#pragma unroll
        for (int bj = 0; bj < 2; ++bj) {
            const int cblk = u.pn * 256 + bj * 128;
            const int cw = wc * 32 + 8 * fq;
            bf16* dst; int pitch, cbase; int kind;
            int nh = 1, hd = 0;
            if (cblk < 512)       { dst = AQ; pitch = 512; cbase = cblk; kind = 1; }
            else if (cblk < 640)  { dst = AK; pitch = 128; cbase = cblk - 512; kind = 1; }
            else if (cblk < 768)  { dst = AVT; pitch = 128; cbase = cblk - 640; kind = 0; }
            else if (cblk < 1280) { dst = BQ; pitch = 512; cbase = cblk - 768; kind = 0; }
            else if (cblk < 1792) { dst = BK; pitch = 512; cbase = cblk - 1280; kind = 0; }
            else if (cblk < 2304) { dst = BVT; pitch = 512; cbase = cblk - 1792; kind = 0; }
            else if (cblk < 2816) { dst = CQ; pitch = 512; cbase = cblk - 2304; kind = 1; }
            else if (cblk < 3328) { dst = CK; pitch = 512; cbase = cblk - 2816; kind = 1; }
            else if (cblk < 3840) { dst = CV; pitch = 512; cbase = cblk - 3328; kind = 0; }
            else                  { dst = SG; pitch = 3072; cbase = cblk - 3840; kind = 3; }
#pragma unroll
            for (int ai = 0; ai < 2; ++ai)
#pragma unroll
                for (int m = 0; m < 4; ++m) {
                    const int row = u.pm * 256 + ai * 128 + wr * 64 + m * 16 + fr;
                    f32x4 v0 = acc[ai][bj][m][0], v1 = acc[ai][bj][m][1];
                    if (kind == 1) {
                        if (row < T_LAT) {
                            const int t = row & (SEQ - 1), i0 = (cw & 63) >> 1;
                            const f32x4 cs = *(const GAS f32x4*)(COS + t * 32 + i0), sn = *(const GAS f32x4*)(SIN + t * 32 + i0);
                            const f32x4 a = v0, b = v1;
                            v0.x = a.x * cs.x - a.y * sn.x; v0.y = a.y * cs.x + a.x * sn.x; v0.z = a.z * cs.y - a.w * sn.y; v0.w = a.w * cs.y + a.z * sn.y;
                            v1.x = b.x * cs.z - b.y * sn.z; v1.y = b.y * cs.z + b.x * sn.z; v1.z = b.z * cs.w - b.w * sn.w; v1.w = b.w * cs.w + b.z * sn.w;
                        }
                        *(GAS v4u*)(dst + (size_t)row * pitch + cbase + cw) = pack8(v0, v1);
                    } else if (kind == 0) {
                        *(GAS v4u*)(dst + (size_t)row * pitch + cbase + cw) = pack8(v0, v1);
                    } else if (kind == 3) {
                        v0.x = sigmoid_fast(v0.x); v0.y = sigmoid_fast(v0.y); v0.z = sigmoid_fast(v0.z); v0.w = sigmoid_fast(v0.w);
                        v1.x = sigmoid_fast(v1.x); v1.y = sigmoid_fast(v1.y); v1.z = sigmoid_fast(v1.z); v1.w = sigmoid_fast(v1.w);
                        *(GAS v4u*)(dst + (size_t)row * pitch + cbase + cw) = pack8(v0, v1);
                    } else {
                        const int hc = hd + cw, head = hc >> 6, d = hc & 63;
                        const int b = row_batch(row), tok = row_tok(row);
                        bf16* vp = dst + ((size_t)(b * nh + head) * 64 + d) * NTOK + tok;
                        vp[0 * NTOK] = (bf16)f2bf(v0.x); vp[1 * NTOK] = (bf16)f2bf(v0.y); vp[2 * NTOK] = (bf16)f2bf(v0.z); vp[3 * NTOK] = (bf16)f2bf(v0.w);
                        vp[4 * NTOK] = (bf16)f2bf(v1.x); vp[5 * NTOK] = (bf16)f2bf(v1.y); vp[6 * NTOK] = (bf16)f2bf(v1.z); vp[7 * NTOK] = (bf16)f2bf(v1.w);
                    }
                }
        }
    }
};
__device__ __forceinline__ void unpack8(const v4u& w, f32x4& a, f32x4& b) {
    a = (f32x4){bf2f(w.x & 0xffffu), bf2f(w.x >> 16), bf2f(w.y & 0xffffu), bf2f(w.y >> 16)}; b = (f32x4){bf2f(w.z & 0xffffu), bf2f(w.z >> 16), bf2f(w.w & 0xffffu), bf2f(w.w >> 16)};
}
struct EpiBranch {
    const bf16* SG; bf16* MG;
    __device__ __forceinline__ void operator()(const f32x4 (&acc)[2][2][4][2], const pg8::Unit& u, int wr, int wc, int fr, int fq) const {
        asm volatile("" : "+v"(fr), "+v"(fq));
#pragma unroll
        for (int ai = 0; ai < 2; ++ai)
#pragma unroll
            for (int m = 0; m < 4; ++m) {
                const int row = u.pm * 256 + ai * 128 + wr * 64 + m * 16 + fr;
#pragma unroll
                for (int bj = 0; bj < 2; ++bj) {
                    const int col = u.pn * 256 + bj * 128 + wc * 32 + 8 * fq;
                    f32x4 g0, g1; { const v4u wg = *(const GAS v4u*)(SG + (size_t)row * 3072 + u.seg * 1024 + col); unpack8(wg, g0, g1); }
                    f32x4 v0 = g0 * acc[ai][bj][m][0], v1 = g1 * acc[ai][bj][m][1];
                    bf16* mp = MG + (size_t)row * D + col;
                    if (u.seg > 0) { f32x4 p0, p1; const v4u wp = *(const GAS v4u*)mp; unpack8(wp, p0, p1); v0 += p0; v1 += p1; }
                    *(GAS v4u*)mp = pack8(v0, v1);
                }
            }
    }
};
struct EpiOut {
    float* X; const float* gtl; const float* xin; const float* cin;
    __device__ __forceinline__ void operator()(const f32x4 (&acc)[2][2][4][2], const pg8::Unit& u, int wr, int wc, int fr, int fq) const {
        asm volatile("" : "+v"(fr), "+v"(fq));
#pragma unroll
        for (int ai = 0; ai < 2; ++ai)
#pragma unroll
            for (int m = 0; m < 4; ++m) {
                const int row = u.pm * 256 + ai * 128 + wr * 64 + m * 16 + fr;
                const float* gt = gtl + (size_t)row_modidx(row) * 6 * D + 2 * D;
#pragma unroll
                for (int bj = 0; bj < 2; ++bj) {
                    const int col = u.pn * 256 + bj * 128 + wc * 32 + 8 * fq;
                    GAS f32x4* xp = (GAS f32x4*)(X + (size_t)row * D + col);
                    const GAS f32x4* sp = xin ? (const GAS f32x4*)(xin_row(xin, cin, row) + col) : (const GAS f32x4*)xp;
                    const f32x4 g0 = *(const GAS f32x4*)(gt + col), g1 = *(const GAS f32x4*)(gt + col + 4);
                    xp[0] = sp[0] + g0 * acc[ai][bj][m][0]; xp[1] = sp[1] + g1 * acc[ai][bj][m][1];
                }
            }
    }
};
struct EpiStore {
    bf16* O; int ldc;
    __device__ __forceinline__ void operator()(const f32x4 (&acc)[2][2][4][2], const pg8::Unit& u, int wr, int wc, int fr, int fq) const {
        asm volatile("" : "+v"(fr), "+v"(fq));
#pragma unroll
        for (int ai = 0; ai < 2; ++ai)
#pragma unroll
            for (int m = 0; m < 4; ++m) {
                const int row = u.pm * 256 + ai * 128 + wr * 64 + m * 16 + fr;
#pragma unroll
                for (int bj = 0; bj < 2; ++bj) {
                    const int col = u.pn * 256 + bj * 128 + wc * 32 + 8 * fq;
                    *(GAS v4u*)(O + (size_t)row * ldc + col) = pack8(acc[ai][bj][m][0], acc[ai][bj][m][1]);
                }
            }
    }
};

__global__ void __launch_bounds__(NTHREADS, 2) mega_fwd(Args args) {
    extern __shared__ __attribute__((aligned(16))) unsigned char lds[];
    LAS unsigned char* L = (LAS unsigned char*)lds;
    volatile LAS unsigned* MISC = (volatile LAS unsigned*)(L + MISC_OFF);
    const int wave = __builtin_amdgcn_readfirstlane((int)threadIdx.x >> 6);
    const int lane = lane_id_v(), tid = wave * 64 + lane;
    const int fr = lane & 15, fq = lane >> 4;
    const int G = gridDim.x;
    const int vcu = (G % 8 == 0) ? (int)(blockIdx.x % 8) * (G / 8) + (int)(blockIdx.x / 8) : (int)blockIdx.x;
    for (int u = tid; u < (LDS_BYTES - 131072) / 4; u += NTHREADS) ((LAS unsigned*)(L + 131072))[u] = 0u;
    __syncthreads();
    unsigned char* ws = args.ws;
    gu32* ctl = (gu32*)(ws + WS_CTL);
    (void)xcd_barrier_post((unsigned*)(ctl + CW_BAR), MISC + 8);
    if (tid == 0) MISC[12] = xb_add((unsigned*)(ctl + CW_RANK) + 64 * xb_xcc_id(), 1u);
    __syncthreads();
#define GRID_BAR() do { unsigned* bp_ = (unsigned*)(args.ws + WS_CTL) + CW_BAR; asm volatile("" : "+s"(bp_)); XcdBarrier b_; b_.bar = bp_; b_.x = xb_xcc_id(); b_.st = MISC + 8; xcd_barrier(b_, wave == 0 && lane_id_v() == 0); } while (0)
    const int gw = vcu * NWAVES + wave, NGW = G * NWAVES;
    const int NGT = G * NTHREADS;

#define PHASE_PTRS \
    unsigned char* wsq = args.ws; asm volatile("" : "+s"(wsq)); \
    const float* const* IN_ = (const float* const*)__builtin_amdgcn_kernarg_segment_ptr(); asm volatile("" : "+s"(IN_)); \
    float* MODV = (float*)(wsq + WS_MOD); float* COS = (float*)(wsq + WS_COS); float* SIN = (float*)(wsq + WS_SIN); \
    bf16* WIN = (bf16*)(wsq + WS_WIN); bf16* WB = (bf16*)(wsq + WS_WB); bf16* WO = (bf16*)(wsq + WS_WO); bf16* WQ = (bf16*)(wsq + WS_WQ); bf16* KEYS = (bf16*)(wsq + WS_KEYS); \
    float* X = (float*)(wsq + WS_X); bf16* H = (bf16*)(wsq + WS_H); bf16* Y = (bf16*)(wsq + WS_Y); bf16* MG = (bf16*)(wsq + WS_MG); \
    unsigned* EI = (unsigned*)(wsq + WS_EI); float* EG = (float*)(wsq + WS_EG); \
    unsigned char* U8 = wsq + WS_U8; unsigned char* V8 = wsq + WS_V8; float* SCU = (float*)(wsq + WS_SCU); float* SCV = SCU + DEPTH * 16384; \
    bf16* AQ = (bf16*)(wsq + WS_AQ); bf16* AK = (bf16*)(wsq + WS_AK); bf16* AVT = (bf16*)(wsq + WS_AVT); \
    bf16* BQ = (bf16*)(wsq + WS_BQ); bf16* BK = (bf16*)(wsq + WS_BK); bf16* BVT = (bf16*)(wsq + WS_BVT); \
    bf16* CQ = (bf16*)(wsq + WS_CQ); bf16* CK = (bf16*)(wsq + WS_CK); bf16* CVT = (bf16*)(wsq + WS_CVT); \
    bf16* SG = (bf16*)(wsq + WS_SG); bf16* Q2 = (bf16*)(wsq + WS_Q2); float* SC = (float*)(wsq + WS_SC); \
    (void)MODV; (void)COS; (void)SIN; (void)WIN; (void)WB; (void)WO; (void)WQ; (void)KEYS; (void)X; (void)H; (void)Y; (void)MG; (void)EI; (void)EG; (void)U8; (void)V8; (void)SCU; (void)SCV; \
    (void)AQ; (void)AK; (void)AVT; (void)BQ; (void)BK; (void)BVT; (void)CQ; (void)CK; (void)CVT; (void)SG; (void)Q2; (void)SC; (void)IN_;
#define LAYER_PTRS const float* modl = MODV + (size_t)layer * 3 * 6 * D; const bf16* WINl = WIN + (size_t)layer * IN_W * D; (void)modl; (void)WINl;

#ifndef SKIP_P0
        { PHASE_PTRS
        for (int rep_ = 0; rep_ < REP_P0; ++rep_) {
    {
        LAS float* scr = (LAS float*)(L + wave * 16384);
        int gt = vcu * NTHREADS + tid; asm volatile("" : "+v"(gt));
        constexpr int I_IN = (D / 64) * (IN_W / 32), I_BR = (512 / 64) * (D / 32), I_O = (D / 64) * (D / 32), I_Q = (D / 64) * (2048 / 32);
        constexpr int PER_LAYER = I_IN + 3 * I_BR + I_O + I_Q;
        for (int rp_ = 0; rp_ < REP_P0A; ++rp_)
        for (int it = gw; it < DEPTH * PER_LAYER; it += NGW) {
            const int l = it / PER_LAYER; int r = it % PER_LAYER;
            if (r < I_IN) { p0_transpose_item<true>(IN_[I_WIN] + (size_t)l * D * IN_W, D, IN_W, WIN + (size_t)l * IN_W * D, scr, r, lane); continue; } r -= I_IN;
            if (r < I_BR) { p0_transpose_item(IN_[I_WBA] + (size_t)l * 512 * D, 512, D, WB + (size_t)(l * 3 + 0) * D * 512, scr, r, lane); continue; } r -= I_BR;
            if (r < I_BR) { p0_transpose_item(IN_[I_WBB] + (size_t)l * 512 * D, 512, D, WB + (size_t)(l * 3 + 1) * D * 512, scr, r, lane); continue; } r -= I_BR;
            if (r < I_BR) { p0_transpose_item(IN_[I_WBC] + (size_t)l * 512 * D, 512, D, WB + (size_t)(l * 3 + 2) * D * 512, scr, r, lane); continue; } r -= I_BR;
            if (r < I_O) { p0_transpose_item(IN_[I_WOUT] + (size_t)l * D * D, D, D, WO + (size_t)l * D * D, scr, r, lane); continue; } r -= I_O;
            p0_transpose_item(IN_[I_PWQ] + (size_t)l * D * 2048, D, 2048, WQ + (size_t)l * 2048 * D, scr, r, lane);
        }
        for (int i = gt; i < DEPTH * 16 * 128 * 128 / 4; i += NGT) {
            const f32x4 v = *((const GAS f32x4*)IN_[I_PKEYS] + i);
            v2u o; o.x = pk2(v.x, v.y); o.y = pk2(v.z, v.w); *((GAS v2u*)KEYS + i) = o;
        }
        {
            LAS float* red = (LAS float*)(L + 9216);
            for (int rp_ = 0; rp_ < REP_P0D; ++rp_)
            for (int it = vcu; it < DEPTH * 96; it += G) {
                const int l = it / 96, nc = it % 96, n = nc * 64 + lane;
                const float* wm = IN_[I_WMOD] + (size_t)l * D * 6 * D + n;
                float a0 = 0.f, a1 = 0.f, a2 = 0.f;
#pragma unroll 1
                for (int half = 0; half < 2; ++half) {
                    const int kb = wave * 128 + half * 64;
                    const float c0 = IN_[I_C][kb + lane], c1 = IN_[I_C][D + kb + lane], c2 = IN_[I_CCTX][kb + lane];
                    const int s0 = __builtin_bit_cast(int, c0 * sigmoidf_(c0)), s1 = __builtin_bit_cast(int, c1 * sigmoidf_(c1)), s2 = __builtin_bit_cast(int, c2 * sigmoidf_(c2));
#pragma unroll
                    for (int kk = 0; kk < 64; ++kk) {
                        const float w = wm[(size_t)(kb + kk) * 6 * D];
                        a0 += __builtin_bit_cast(float, __builtin_amdgcn_readlane(s0, kk)) * w;
                        a1 += __builtin_bit_cast(float, __builtin_amdgcn_readlane(s1, kk)) * w;
                        a2 += __builtin_bit_cast(float, __builtin_amdgcn_readlane(s2, kk)) * w;
                    }
                }
                red[(wave * 3 + 0) * 64 + lane] = a0; red[(wave * 3 + 1) * 64 + lane] = a1; red[(wave * 3 + 2) * 64 + lane] = a2;
                __syncthreads();
                if (wave < 3) {
                    float sum = IN_[I_BMOD][l * 6 * D + n];
#pragma unroll
                    for (int w = 0; w < 8; ++w) sum += red[(w * 3 + wave) * 64 + lane];
                    MODV[(size_t)(l * 3 + wave) * 6 * D + n] = sum;
                }
                __syncthreads();
            }
        }
        for (int i = gt; i < SEQ * 32; i += NGT) {
            const int t = i >> 5, f = i & 31;
            const float inv = exp2f(-(float)(f & 15) * (13.287712379549449f / 16.0f));
            const float pos = (f < 16) ? (float)(t / GRID_W) : (float)(t % GRID_W);
            float sn, cs; sincosf(pos * inv, &sn, &cs);
            COS[i] = cs; SIN[i] = sn;
        }
    }
        for (int rp_ = 0; rp_ < REP_P0F; ++rp_)
#pragma unroll 4
        for (int rr = gw; rr < 2 * DEPTH * 16384; rr += NGW) {
            const int tab = rr / (DEPTH * 16384), row = rr % (DEPTH * 16384);
            const float* src = (tab == 0 ? IN_[I_PU] : IN_[I_PV]) + (size_t)row * D;
            f32x4 v[4]; float am = 0.f;
#pragma unroll
            for (int j = 0; j < 4; ++j) { v[j] = *((const GAS f32x4*)src + lane + 64 * j); am = fmaxf(am, fmaxf(fmaxf(fabsf(v[j].x), fabsf(v[j].y)), fmaxf(fabsf(v[j].z), fabsf(v[j].w)))); }
            am = wave_max(am);
            const bool as_i8 = (P10_SLICED != 0) && (tab == 0);
            int ex = 0; float scale = 1.0f;
            if (am > 0.f) { (void)frexpf(am * (as_i8 ? (1.0f / 127.0f) : (1.0f / 448.0f)), &ex); scale = ldexpf(1.0f, ex); }
            const float inv = 1.0f / scale;
            v4u o;
#pragma unroll
            for (int j = 0; j < 4; ++j) {
                if (as_i8) {
                    const int q0 = __float2int_rn(v[j].x * inv), q1 = __float2int_rn(v[j].y * inv), q2 = __float2int_rn(v[j].z * inv), q3 = __float2int_rn(v[j].w * inv);
                    o[j] = (unsigned)(q0 & 255) | ((unsigned)(q1 & 255) << 8) | ((unsigned)(q2 & 255) << 16) | ((unsigned)q3 << 24);
                } else {
                    int p = __builtin_amdgcn_cvt_pk_fp8_f32(v[j].x * inv, v[j].y * inv, 0, false);
                    p = __builtin_amdgcn_cvt_pk_fp8_f32(v[j].z * inv, v[j].w * inv, p, true);
                    o[j] = (unsigned)p;
                }
            }
            *((GAS v4u*)((tab == 0 ? U8 : V8) + (size_t)row * D) + lane) = o;
            if (lane == 0) (tab == 0 ? SCU : SCV)[row] = scale;
        }
        }
        }
#endif
    GRID_BAR();

    for (int layer = 0; layer < DEPTH; ++layer) {
        const bool last = (layer == DEPTH - 1);
        const int T_EFF = last ? T_LAT : T_ALL;

#ifndef SKIP_P1
        { PHASE_PTRS LAYER_PTRS
        for (int rep_ = 0; rep_ < REP_P1; ++rep_) {
        { const int ln = lane_id_v();
        if (layer == 0) {
            f32x4 gm[4], shv[4];
            auto prep = [&](int midx) { const float* md = modl + (size_t)midx * 6 * D;
#pragma unroll
                for (int j = 0; j < 4; ++j) { const f32x4 g = *((const GAS f32x4*)(IN_[I_G1] + layer * D) + ln + 64 * j); const f32x4 sc = *((const GAS f32x4*)(md + D) + ln + 64 * j);
                    gm[j] = g * (sc + 1.0f); shv[j] = *((const GAS f32x4*)(md + 0) + ln + 64 * j); } };
            auto row = [&](int r) {
                const GAS f32x4* xr = (const GAS f32x4*)xin_row(IN_[I_X], IN_[I_CTX], r) + ln;
                f32x4 v[4]; float ss = 0.f;
#pragma unroll
                for (int j = 0; j < 4; ++j) { v[j] = xr[64 * j]; ss += (v[j].x * v[j].x + v[j].y * v[j].y) + (v[j].z * v[j].z + v[j].w * v[j].w); }
                const float rs = 1.0f / sqrtf(wave_sum(ss) * (1.f / D) + NORM_EPS);
                GAS v2u* o8 = (GAS v2u*)(H + (size_t)r * D) + ln;
#pragma unroll
                for (int j = 0; j < 4; ++j) { const f32x4 h = v[j] * rs * gm[j] + shv[j]; v2u o; o.x = pk2(h.x, h.y); o.y = pk2(h.z, h.w); o8[64 * j] = o; } };
            wave_row_blocks(T_ALL, gw, NGW, prep, row);
        }
        }
        }
        }
#endif
        if (layer == 0) GRID_BAR();

#ifndef SKIP_P2
        { PHASE_PTRS LAYER_PTRS
        for (int rep_ = 0; rep_ < REP_P2; ++rep_) {
        {
            pg8::Gemm g{H, WINl, D, D, D, 0, 0};
            pg8::SegOrder<1> S; S.T.init(T_ALL, IN_W, G, (int)blockIdx.x);
            EpiInProj E{AQ, AK, AVT, BQ, BK, BVT, CQ, CK, CVT, SG, COS, SIN};
            pg8::gemm_phase(L, g, S, E, wave);
        }
        }
        }
#endif
        GRID_BAR();

#ifndef SKIP_P3
        { PHASE_PTRS LAYER_PTRS
        {
            LAS bf16* Pl = (LAS bf16*)(L + wave * 8192);
            const float lam_init = 0.8f - 0.6f * expf(-0.3f * (float)layer);
            float lam;
            {
                const int ll = lane_id_v();
                const float* cl = IN_[I_LAMBDA] + layer * 256;
                const float s1 = wave_sum(cl[ll] * cl[64 + ll]), s2 = wave_sum(cl[128 + ll] * cl[192 + ll]);
                lam = expf(s1) - expf(s2) + lam_init;
            }
{ const int lo__ = lane_id_v(); { const int lane = lo__; const int fr = lane & 15, fq = lane >> 4, tid = wave * 64 + lane; (void)fr; (void)fq; (void)tid;
            {
                const int r32 = lane & 31, hi = lane >> 5;
                const int n_lat = BATCH * 4 * (SEQ / 256), n_ctx = last ? 0 : BATCH * 4;
                const int NU = (n_lat + G - 1) / G * G + n_ctx;
                for (int rep_ = 0; rep_ < REP_P3C; ++rep_)
                for (int u0 = vcu; u0 < NU; u0 += G) {
                    int b, h, row0, t_lo, t_hi;
                    if (u0 < n_lat) { const int bh = u0 >> 5; b = bh >> 2; h = bh & 3; row0 = b * SEQ + (u0 & 31) * 256; t_lo = 0; t_hi = 132; }
                    else { const int c = u0 - (n_lat + G - 1) / G * G; if (c < 0 || c >= n_ctx) continue; b = c >> 2; h = c & 3; row0 = T_LAT + b * CTX; t_lo = 128; t_hi = 132; }
                    const int qrow = row0 + wave * 32 + r32;
                    LAS unsigned* o1p = (LAS unsigned*)(L + 65536 + wave * 8192) + lane;
                    const int krow_s = tid >> 3, kch_s = tid & 7;
                    const int vrow_s0 = tid >> 4, vch_s = tid & 15;
                    LAS unsigned char* Kb0 = L; LAS unsigned char* Vb0 = L + 2 * CK_SZ;
#pragma unroll 1
                    for (int m = 0; m < 2; ++m) {
                        bf16x8 qf[4];
                        { const bf16* qp = CQ + (size_t)qrow * 512 + (h * 2 + m) * 64 + hi * 8;
#pragma unroll
                          for (int ks = 0; ks < 4; ++ks) qf[ks] = *(const GAS bf16x8*)(qp + ks * 16); }
                        f32x16 o[4];
#pragma unroll
                        for (int d = 0; d < 4; ++d)
#pragma unroll
                            for (int r = 0; r < 16; ++r) o[d][r] = 0.f;
                        float mrun, lpart;
                        v4u pp[4];
                        const bf16* kg = CK + (size_t)krow_s * 512 + (h * 2 + m) * 64 + kch_s * 8;
                        const bf16* vg = CVT + (size_t)vrow_s0 * 512 + h * 128 + vch_s * 8;
                        auto tile_row = [&](int j) { return (j < 128) ? b * SEQ + 64 * j : T_LAT + b * CTX + 64 * (j - 128); };
                        const f32x2 scl2v = {SCL2, SCL2};
                        __syncthreads();
                        {
                            const size_t kb = (size_t)tile_row(t_lo) * 512;
                            const v4u kr = *(const GAS v4u*)(kg + kb), v0 = *(const GAS v4u*)(vg + kb), v1 = *(const GAS v4u*)(vg + kb + 32 * 512);
                            *(LAS v4u*)(Kb0 + krow_s * CK_PITCH + kch_s * 16) = kr;
                            *(LAS v4u*)(Vb0 + vrow_s0 * CV_PITCH + vch_s * 16) = v0; *(LAS v4u*)(Vb0 + (vrow_s0 + 32) * CV_PITCH + vch_s * 16) = v1;
                        }
                        __syncthreads();
                        v4u kr, v0, v1;
                        { const size_t kb = (size_t)tile_row(t_lo + 2) * 512, vb = (size_t)tile_row(t_lo + 1) * 512;
                          kr = *(const GAS v4u*)(kg + kb); v0 = *(const GAS v4u*)(vg + vb); v1 = *(const GAS v4u*)(vg + vb + 32 * 512); }
                        {
                            const v4u kr1 = *(const GAS v4u*)(kg + (size_t)tile_row(t_lo + 1) * 512);
                            f32x16 st[2];
#pragma unroll
                            for (int kb = 0; kb < 2; ++kb) {
#pragma unroll
                                for (int r = 0; r < 16; ++r) st[kb][r] = 0.f;
#pragma unroll
                                for (int ks = 0; ks < 4; ++ks) {
                                    const bf16x8 kf = *(const LAS bf16x8*)(Kb0 + (kb * 32 + r32) * CK_PITCH + ks * 32 + hi * 16);
                                    st[kb] = __builtin_amdgcn_mfma_f32_32x32x16_bf16(kf, qf[ks], st[kb], 0, 0, 0);
                                }
                            }
                            float mx = st[0][0];
#pragma unroll
                            for (int r = 1; r < 16; ++r) mx = fmaxf(mx, st[0][r]);
#pragma unroll
                            for (int r = 0; r < 16; ++r) mx = fmaxf(mx, st[1][r]);
                            mx = xmax32(mx);
                            mrun = mx;
                            const float nmc = -mx * SCL2; const f32x2 nmcv = {nmc, nmc};
                            f32x2 ls2 = {0.f, 0.f};
#pragma unroll
                            for (int ks = 0; ks < 4; ++ks)
#pragma unroll
                                for (int i2 = 0; i2 < 4; ++i2) {
                                    f32x2 x = {st[ks >> 1][8 * (ks & 1) + 2 * i2], st[ks >> 1][8 * (ks & 1) + 2 * i2 + 1]};
                                    x = x * scl2v + nmcv;
                                    const f32x2 p = {__builtin_amdgcn_exp2f(x.x), __builtin_amdgcn_exp2f(x.y)};
                                    ls2 += p; pp[ks][i2] = cvtpk(p.x, p.y);
                                }
                            lpart = ls2.x + ls2.y;
                            *(LAS v4u*)(Kb0 + CK_SZ + krow_s * CK_PITCH + kch_s * 16) = kr1;
                            __syncthreads();
                        }
                        const int q4 = (lane & 15) >> 2, p4 = lane & 3, grp = (lane >> 4) & 1;
                        const int voff = (4 * hi + q4) * CV_PITCH + (16 * grp + 4 * p4) * 2;
#pragma unroll 1
                        for (int j = t_lo + 1; j < t_hi; ++j) {
                            const int cur = (j - t_lo) & 1;
                            const LAS unsigned char* Kb = Kb0 + cur * CK_SZ; const LAS unsigned char* vbase = Vb0 + (cur ^ 1) * CV_SZ + voff;
                            const bool more = (j + 1 < t_hi);
                            auto vfrag = [&](int i) -> bf16x8 {
                                const LAS unsigned char* va = vbase + (i >> 2) * 16 * CV_PITCH + (i & 3) * 64;
                                const s16x4 lo = __builtin_bit_cast(s16x4, __builtin_amdgcn_ds_read_tr16_b64_v4i16((LAS s16x4*)va));
                                const s16x4 hh = __builtin_bit_cast(s16x4, __builtin_amdgcn_ds_read_tr16_b64_v4i16((LAS s16x4*)(va + 8 * CV_PITCH)));
                                return __builtin_shufflevector(lo, hh, 0, 1, 2, 3, 4, 5, 6, 7);
                            };
                            f32x16 st[2];
#pragma unroll
                            for (int kb = 0; kb < 2; ++kb) {
#pragma unroll
                                for (int r = 0; r < 16; ++r) st[kb][r] = 0.f;
#pragma unroll
                                for (int ks = 0; ks < 4; ++ks) {
                                    const bf16x8 kf = *(const LAS bf16x8*)(Kb + (kb * 32 + r32) * CK_PITCH + ks * 32 + hi * 16);
                                    st[kb] = __builtin_amdgcn_mfma_f32_32x32x16_bf16(kf, qf[ks], st[kb], 0, 0, 0);
                                }
                            }
                            bf16x8 vfr[3];
                            vfr[0] = vfrag(0); vfr[1] = vfrag(1); vfr[2] = vfrag(2);
                            float mx = st[0][0];
#pragma unroll
                            for (int r = 1; r < 16; ++r) mx = fmaxf(mx, st[0][r]);
#pragma unroll
                            for (int r = 0; r < 16; ++r) mx = fmaxf(mx, st[1][r]);
                            asm volatile("" : "+v"(mx));
                            __builtin_amdgcn_sched_barrier(0);
                            o[0] = __builtin_amdgcn_mfma_f32_32x32x16_bf16(vfr[0], __builtin_bit_cast(bf16x8, pp[0]), o[0], 0, 0, 0); vfr[0] = vfrag(3);
                            o[1] = __builtin_amdgcn_mfma_f32_32x32x16_bf16(vfr[1], __builtin_bit_cast(bf16x8, pp[0]), o[1], 0, 0, 0); vfr[1] = vfrag(4);
                            mx = xmax32(mx);
                            const bool grow = __builtin_amdgcn_ballot_w64(mx > mrun + C_THR_RAW) != 0ull;
                            const float mn = grow ? fmaxf(mrun, mx) : mrun;
                            float nmc = -mn * SCL2;
                            asm volatile("" : "+v"(nmc));
                            __builtin_amdgcn_sched_barrier(0);
                            float ls0 = 0.f, ls1 = 0.f;
#pragma unroll
                            for (int i = 0; i < 16; ++i) {
                                if (i >= 2) { o[i & 3] = __builtin_amdgcn_mfma_f32_32x32x16_bf16(vfr[i % 3], __builtin_bit_cast(bf16x8, pp[i >> 2]), o[i & 3], 0, 0, 0); if (i + 3 < 16) vfr[i % 3] = vfrag(i + 3); }
                                {
                                    const int kb = i >> 3, r = 2 * (i & 7);
                                    float p0 = __builtin_amdgcn_exp2f(fmaf(st[kb][r], SCL2, nmc));
                                    ls0 += p0; asm volatile("" : "+v"(p0), "+v"(ls0));
                                    float p1 = __builtin_amdgcn_exp2f(fmaf(st[kb][r + 1], SCL2, nmc));
                                    ls1 += p1; asm volatile("" : "+v"(p1), "+v"(ls1));
                                    st[kb][r] = p0; st[kb][r + 1] = p1;
                                }
                                if ((i & 3) == 3) {
                                    const int ks = i >> 2;
#pragma unroll
                                    for (int i2 = 0; i2 < 4; ++i2) pp[ks][i2] = cvtpk(st[ks >> 1][8 * (ks & 1) + 2 * i2], st[ks >> 1][8 * (ks & 1) + 2 * i2 + 1]);
                                    asm volatile("" : "+v"(pp[ks]));
                                }
                                if (i == 3) *(LAS v4u*)(Kb0 + (cur ^ 1) * CK_SZ + krow_s * CK_PITCH + kch_s * 16) = kr;
                                if (i == 5) *(LAS v4u*)(Vb0 + cur * CV_SZ + vrow_s0 * CV_PITCH + vch_s * 16) = v0;
                                if (i == 7) *(LAS v4u*)(Vb0 + cur * CV_SZ + (vrow_s0 + 32) * CV_PITCH + vch_s * 16) = v1;
                                if (i == 9) { const size_t kb = (size_t)tile_row(j + 2 < t_hi ? j + 2 : t_hi - 1) * 512, vb = (size_t)tile_row(more ? j + 1 : j) * 512;
                                              kr = *(const GAS v4u*)(kg + kb); v0 = *(const GAS v4u*)(vg + vb); v1 = *(const GAS v4u*)(vg + vb + 32 * 512); }
                                if (i >= 1) __builtin_amdgcn_sched_barrier(0);
                            }
                            if (grow) {
                                const float alpha = __builtin_amdgcn_exp2f((mrun - mn) * SCL2);
#pragma unroll
                                for (int d = 0; d < 4; ++d)
#pragma unroll
                                    for (int r = 0; r < 16; ++r) o[d][r] *= alpha;
                                lpart *= alpha;
                            }
                            mrun = mn; lpart += ls0 + ls1;
                            __syncthreads();
                        }
                        {
                            const LAS unsigned char* vbase = Vb0 + ((t_hi - 1 - t_lo) & 1) * CV_SZ + voff;
#pragma unroll
                            for (int i = 0; i < 16; ++i) {
                                const LAS unsigned char* va = vbase + (i >> 2) * 16 * CV_PITCH + (i & 3) * 64;
                                const s16x4 lo = __builtin_bit_cast(s16x4, __builtin_amdgcn_ds_read_tr16_b64_v4i16((LAS s16x4*)va));
                                const s16x4 hh = __builtin_bit_cast(s16x4, __builtin_amdgcn_ds_read_tr16_b64_v4i16((LAS s16x4*)(va + 8 * CV_PITCH)));
                                const bf16x8 vf = __builtin_shufflevector(lo, hh, 0, 1, 2, 3, 4, 5, 6, 7);
                                o[i & 3] = __builtin_amdgcn_mfma_f32_32x32x16_bf16(vf, __builtin_bit_cast(bf16x8, pp[i >> 2]), o[i & 3], 0, 0, 0);
                                if ((i & 7) == 7) __builtin_amdgcn_sched_barrier(0);
                            }
                        }
                        const float lt = xadd32(lpart);
                        if (m == 0) {
                            const float inv = 1.0f / lt;
#pragma unroll
                            for (int d = 0; d < 4; ++d)
#pragma unroll
                                for (int i2 = 0; i2 < 8; ++i2) o1p[64 * (d * 8 + i2)] = cvtpk(o[d][2 * i2] * inv, o[d][2 * i2 + 1] * inv);
                        } else {
                            const float inv2 = lam / lt;
                            float ssq = 0.f;
#pragma unroll
                            for (int d = 0; d < 4; ++d)
#pragma unroll
                                for (int i2 = 0; i2 < 8; ++i2) {
                                    const unsigned w1 = o1p[64 * (d * 8 + i2)];
                                    const float a0 = bf2f(w1 & 0xffffu) - o[d][2 * i2] * inv2, a1 = bf2f(w1 >> 16) - o[d][2 * i2 + 1] * inv2;
                                    o[d][2 * i2] = a0; o[d][2 * i2 + 1] = a1; ssq += a0 * a0 + a1 * a1;
                                }
                            ssq = xadd32(ssq);
                            const float rn = 1.0f / sqrtf(ssq * (1.f / 128.f) + NORM_EPS) * (1.0f - lam_init);
                            bf16* yp = Y + (size_t)qrow * 1536 + 1024 + h * 128 + 4 * hi;
                            const float* sl = IN_[I_SUBLN] + layer * 512 + h * 128 + 4 * hi;
#pragma unroll
                            for (int d = 0; d < 4; ++d)
#pragma unroll
                                for (int g4 = 0; g4 < 4; ++g4) {
                                    const f32x4 gsl = *(const GAS f32x4*)(sl + d * 32 + 8 * g4);
                                    v2u w; w.x = cvtpk(o[d][4 * g4] * rn * gsl.x, o[d][4 * g4 + 1] * rn * gsl.y); w.y = cvtpk(o[d][4 * g4 + 2] * rn * gsl.z, o[d][4 * g4 + 3] * rn * gsl.w);
                                    *(GAS v2u*)(yp + d * 32 + 8 * g4) = w;
                                }
                        }
                    }
                }
                __syncthreads();
            }
} }
{ const int lo__ = lane_id_v(); { const int lane = lo__; const int tid = wave * 64 + lane, r32 = lane & 31, hi = lane >> 5;
            {
                const int n_lat = BATCH * 2 * (SEQ / 64), n_ctx = last ? 0 : BATCH * 2 * (CTX / 64);
                for (int rep_ = 0; rep_ < REP_P3A; ++rep_)
                for (int u0 = vcu; u0 < n_lat + n_ctx; u0 += G) {
                    const bool isctx = u0 >= n_lat;
                    int b, g, p0, qrow, nl, klo;
                    if (!isctx) { b = u0 >> 8; g = (u0 >> 7) & 1; p0 = (u0 & 127) * 64; qrow = b * SEQ + p0 + (wave & 1) * 32 + r32;
                                  klo = p0 >= 128 ? 0 : (128 - p0) / 64; const int khi = min(4, (SEQ - 1 - (p0 - 128)) / 64); nl = khi - klo + 1; }
                    else { const int c = u0 - n_lat; b = c >> 3; g = (c >> 2) & 1; p0 = (c & 3) * 64; qrow = T_LAT + b * CTX + p0 + (wave & 1) * 32 + r32; nl = 0; klo = 0; }
                    const int hq = g * 4 + (wave >> 1);
                    const int qpos0 = p0 + (wave & 1) * 32;
                    bf16x8 qf[4];
                    { const bf16* qp = AQ + (size_t)qrow * 512 + hq * 64 + hi * 8;
#pragma unroll
                      for (int ks = 0; ks < 4; ++ks) qf[ks] = *(const GAS bf16x8*)(qp + ks * 16); }
                    f32x16 o[2];
#pragma unroll
                    for (int d = 0; d < 2; ++d)
#pragma unroll
                        for (int r = 0; r < 16; ++r) o[d][r] = 0.f;
                    float mrun = IN_[I_SINK][layer * 8 + hq] * 8.0f;
                    float lpart = (hi == 0) ? 1.0f : 0.0f;
                    const bf16* kg = AK + (size_t)(tid >> 3) * 128 + g * 64 + (tid & 7) * 8;
                    const bf16* vg = AVT + (size_t)(tid >> 3) * 128 + g * 64 + (tid & 7) * 8;
                    const int kp0 = p0 - 128 + 64 * klo;
                    auto tile_row = [&](int j) { return (j < nl) ? b * SEQ + kp0 + 64 * j : T_LAT + b * CTX + 64 * (j - nl); };
                    auto use_tile = [&](int j) { if (j >= nl) return true; const int kp = kp0 + 64 * j; return (kp + 63 >= qpos0 - 128) && (kp <= qpos0 + 31 + 128); };
                    auto elem = [&](f32x16 (&st)[2], int j) {
                        if (j < nl) {
                            const int dq0 = (qpos0 + r32) - (kp0 + 64 * j + 4 * hi);
#pragma unroll
                            for (int kb = 0; kb < 2; ++kb)
#pragma unroll
                                for (int r = 0; r < 16; ++r) { const int dq = dq0 - (kb * 32 + (r & 3) + 8 * (r >> 2)); if (dq > 128 || dq < -128) st[kb][r] = -1e30f; }
                        }
                    };
                    attn64_pass<2>(o, mrun, lpart, qf, kg, 128, vg, 128, nl + 4, tile_row, use_tile, elem, L, lane, tid);
                    const float lt = xadd32(lpart);
                    attn64_store(o, 1.0f / lt, Y + (size_t)qrow * 1536 + hq * 64, hi);
                }
            }
} }
{ const int lo__ = lane_id_v(); { const int lane = lo__; const int tid = wave * 64 + lane, r32 = lane & 31, hi = lane >> 5;
            {
                const int n_lat = BATCH * 8 * 32, n_ctx = last ? 0 : BATCH * 8;
                LAS float* rpbL = (LAS float*)(L + 49152);
                for (int rep_ = 0; rep_ < REP_P3B; ++rep_)
                for (int u0 = vcu; u0 < n_lat + n_ctx; u0 += G) {
                    const bool isctx = u0 >= n_lat;
                    int b, h, gr = 0, qc0 = 0, qrow, nl, krlo;
                    if (!isctx) { b = u0 >> 8; h = (u0 >> 5) & 7; const int r0 = (u0 & 31) * 4; gr = r0 + (wave >> 1); qc0 = (wave & 1) * 32; qrow = b * SEQ + gr * GRID_W + qc0 + r32;
                                  krlo = min(max(r0 - 4, 0), 120); nl = min(max(r0 - 1, 0), 120) + 8 - krlo; }
                    else { const int c = u0 - n_lat; b = c >> 3; h = c & 7; qrow = T_LAT + b * CTX + wave * 32 + r32; nl = 0; krlo = 0; }
                    __syncthreads();
                    if (tid < 465) rpbL[tid] = IN_[I_RPB][(size_t)(layer * 8 + h) * 465 + tid] * 8.0f;
                    bf16x8 qf[4];
                    { const bf16* qp = BQ + (size_t)qrow * 512 + h * 64 + hi * 8;
#pragma unroll
                      for (int ks = 0; ks < 4; ++ks) qf[ks] = *(const GAS bf16x8*)(qp + ks * 16); }
                    f32x16 o[2];
#pragma unroll
                    for (int d = 0; d < 2; ++d)
#pragma unroll
                        for (int r = 0; r < 16; ++r) o[d][r] = 0.f;
                    float mrun = -1e30f, lpart = 0.f;
                    const bf16* kg = BK + (size_t)(tid >> 3) * 512 + h * 64 + (tid & 7) * 8;
                    const bf16* vg = BVT + (size_t)(tid >> 3) * 512 + h * 64 + (tid & 7) * 8;
                    const int rs = min(max(gr - 4, 0), 120);
                    auto tile_row = [&](int j) { return (j < nl) ? b * SEQ + (krlo + j) * GRID_W : T_LAT + b * CTX + 64 * (j - nl); };
                    auto use_tile = [&](int j) { if (j >= nl) return true; const int kr = krlo + j; return kr >= rs && kr < rs + 8; };
                    auto elem = [&](f32x16 (&st)[2], int j) {
                        if (j < nl) {
                            const int qc = qc0 + r32, cstart = min(max(qc - 8, 0), 48);
                            const LAS float* brow = rpbL + (krlo + j - gr + 7) * 31 + 15;
#pragma unroll
                            for (int kb = 0; kb < 2; ++kb)
#pragma unroll
                                for (int r = 0; r < 16; ++r) {
                                    const int kc = kb * 32 + (r & 3) + 8 * (r >> 2) + 4 * hi;
                                    const bool valid = (kc >= cstart) && (kc < cstart + 16);
                                    const int dc = min(max(kc - qc, -15), 15);
                                    st[kb][r] = valid ? st[kb][r] + brow[dc] : -1e30f;
                                }
                        }
                    };
                    attn64_pass<2>(o, mrun, lpart, qf, kg, 512, vg, 512, nl + 4, tile_row, use_tile, elem, L, lane, tid);
                    const float lt = xadd32(lpart);
                    attn64_store(o, 1.0f / lt, Y + (size_t)qrow * 1536 + 512 + h * 64, hi);
                }
                __syncthreads();
            }
} }
        }
        }
#endif
        GRID_BAR();

#ifndef SKIP_P4
        { PHASE_PTRS LAYER_PTRS
        for (int rep_ = 0; rep_ < REP_P4; ++rep_) {
        {
            pg8::Gemm g{Y, WB + (size_t)layer * 3 * D * 512, 1536, 512, 512, 512, (size_t)D * 512};
            pg8::SegOrder<3> S; S.T.init(T_LAT, D, G, (int)blockIdx.x);
            EpiBranch E{SG, MG};
            pg8::gemm_phase(L, g, S, E, wave);
        }
        if (!last) { const int lo__ = lane_id_v(); { const int lane = lo__; const int fr = lane & 15, fq = lane >> 4; (void)fr; (void)fq;
            for (int it = gw; it < (T_ALL - T_LAT) / 32 * (D / 32); it += NGW) {
                const int row0 = T_LAT + (it / (D / 32)) * 32, col0 = (it % (D / 32)) * 32;
                f32x4 mg[2][2]; zero_acc22(mg);
#pragma unroll 1
                for (int seg = 0; seg < 3; ++seg) {
                    f32x4 acc[2][2]; zero_acc22(acc);
                    sgemm32<8>(acc, Y + seg * 512, 1536, WB + (size_t)(layer * 3 + seg) * D * 512, 512, 512, row0, col0, lane);
#pragma unroll
                    for (int m = 0; m < 2; ++m)
#pragma unroll
                        for (int r = 0; r < 4; ++r) {
                            const bf16* gp = SG + (size_t)(row0 + 16 * m + 4 * fq + r) * 3072 + seg * 1024 + col0 + fr;
#pragma unroll
                            for (int n = 0; n < 2; ++n) mg[m][n][r] += bf2f(gp[16 * n]) * acc[m][n][r];
                        }
                }
#pragma unroll
                for (int m = 0; m < 2; ++m)
#pragma unroll
                    for (int r = 0; r < 4; ++r) {
                        bf16* rowp = MG + (size_t)(row0 + 16 * m + 4 * fq + r) * D + col0 + fr;
#pragma unroll
                        for (int n = 0; n < 2; ++n) rowp[16 * n] = (bf16)f2bf(mg[m][n][r]);
                    }
            }
} }
        }
        }
#endif
        GRID_BAR();

#ifndef SKIP_P5
        { PHASE_PTRS LAYER_PTRS
        {
            pg8::Gemm g{MG, WO + (size_t)layer * D * D, D, D, D, 0, 0};
            pg8::SegOrder<1> S; S.T.init(T_LAT, D, G, (int)blockIdx.x);
            EpiOut E{X, modl, layer == 0 ? IN_[I_X] : nullptr, IN_[I_CTX]};
            pg8::gemm_phase(L, g, S, E, wave);
        }
        if (!last) { const int lo__ = lane_id_v(); { const int lane = lo__; const int fr = lane & 15, fq = lane >> 4; (void)fr; (void)fq;
            for (int it = gw; it < (T_ALL - T_LAT) / 32 * (D / 32); it += NGW) {
                const int row0 = T_LAT + (it / (D / 32)) * 32, col0 = (it % (D / 32)) * 32;
                f32x4 acc[2][2]; zero_acc22(acc);
                sgemm32<8>(acc, MG, D, WO + (size_t)layer * D * D, D, D, row0, col0, lane);
                const float* gt = modl + (size_t)2 * 6 * D + 2 * D + col0 + fr;
#pragma unroll
                for (int m = 0; m < 2; ++m)
#pragma unroll
                    for (int r = 0; r < 4; ++r) {
                        float* rowp = X + (size_t)(row0 + 16 * m + 4 * fq + r) * D + col0 + fr;
                        const float* srcp = (layer == 0) ? IN_[I_CTX] + (size_t)(row0 - T_LAT + 16 * m + 4 * fq + r) * D + col0 + fr : rowp;
#pragma unroll
                        for (int n = 0; n < 2; ++n) rowp[16 * n] = srcp[16 * n] + gt[16 * n] * acc[m][n][r];
                    }
            }
} }
        }
#endif
        GRID_BAR();

#ifndef SKIP_P6
        { PHASE_PTRS LAYER_PTRS
        for (int rep_ = 0; rep_ < REP_P6; ++rep_) {
        { const int ln = lane_id_v();
        {
            f32x4 gm[4], shv[4];
            auto prep = [&](int midx) { const float* md = modl + (size_t)midx * 6 * D;
#pragma unroll
                for (int j = 0; j < 4; ++j) { const f32x4 g = *((const GAS f32x4*)(IN_[I_G2] + layer * D) + ln + 64 * j); const f32x4 sc = *((const GAS f32x4*)(md + 4 * D) + ln + 64 * j);
                    gm[j] = g * (sc + 1.0f); shv[j] = *((const GAS f32x4*)(md + 3 * D) + ln + 64 * j); } };
            auto row = [&](int r) {
                const GAS f32x4* xr = (const GAS f32x4*)(X + (size_t)r * D) + ln;
                f32x4 v[4]; float ss = 0.f;
#pragma unroll
                for (int j = 0; j < 4; ++j) { v[j] = xr[64 * j]; ss += (v[j].x * v[j].x + v[j].y * v[j].y) + (v[j].z * v[j].z + v[j].w * v[j].w); }
                const float rs = 1.0f / sqrtf(wave_sum(ss) * (1.f / D) + NORM_EPS);
                GAS v2u* o8 = (GAS v2u*)(H + (size_t)r * D) + ln;
#pragma unroll
                for (int j = 0; j < 4; ++j) { const f32x4 h = v[j] * rs * gm[j] + shv[j]; v2u o; o.x = pk2(h.x, h.y); o.y = pk2(h.z, h.w); o8[64 * j] = o; } };
            wave_row_blocks(T_EFF, gw, NGW, prep, row);
        }
        }
        }
        }
#endif
        GRID_BAR();

#ifndef SKIP_P7
        { PHASE_PTRS LAYER_PTRS
        for (int rep_ = 0; rep_ < REP_P7; ++rep_) {
        {
            pg8::Gemm g{H, WQ + (size_t)layer * 2048 * D, D, D, D, 0, 0};
            pg8::SegOrder<1> S; S.T.init(T_LAT, 2048, G, (int)blockIdx.x);
            EpiStore E{Q2, 2048};
            pg8::gemm_phase(L, g, S, E, wave);
        }
        if (!last) { const int lo__ = lane_id_v(); { const int lane = lo__; const int fr = lane & 15, fq = lane >> 4; (void)fr; (void)fq;
            for (int it = gw; it < (T_ALL - T_LAT) / 32 * (2048 / 32); it += NGW) {
                const int row0 = T_LAT + (it / (2048 / 32)) * 32, col0 = (it % (2048 / 32)) * 32;
                f32x4 acc[2][2]; zero_acc22(acc);
                sgemm32<8>(acc, H, D, WQ + (size_t)layer * 2048 * D, D, D, row0, col0, lane);
#pragma unroll
                for (int m = 0; m < 2; ++m)
#pragma unroll
                    for (int r = 0; r < 4; ++r) {
                        bf16* rowp = Q2 + (size_t)(row0 + 16 * m + 4 * fq + r) * 2048 + col0 + fr;
#pragma unroll
                        for (int n = 0; n < 2; ++n) rowp[16 * n] = (bf16)f2bf(acc[m][n][r]);
                    }
            }
} }
        }
        }
#endif
        GRID_BAR();

#ifndef SKIP_P8
        { PHASE_PTRS LAYER_PTRS
        for (int rep_ = 0; rep_ < REP_P8; ++rep_) {
{ const int lo__ = lane_id_v(); { const int lane = lo__; const int fr = lane & 15, fq = lane >> 4, tid = wave * 64 + lane;
        {
            LAS float* S = (LAS float*)L;
            const int wr = wave >> 1, wc = wave & 1;
            const int tl = tid >> 2, qd = tid & 3, ph = qd >> 1, hq = qd & 1;
            for (int it = vcu; it < (T_EFF / 128) * PEER_HEADS; it += G) {
                const int tile = it >> 3, h = it & 7;
                {
                    f32x4 acc[2][8];
#pragma unroll
                    for (int m = 0; m < 2; ++m)
#pragma unroll
                        for (int n = 0; n < 8; ++n) acc[m][n] = (f32x4){0.f, 0.f, 0.f, 0.f};
                    const bf16* ap = Q2 + (size_t)(tile * 128 + wr * 32 + fr) * 2048 + h * 256 + wc * 128 + fq * 8;
                    const bf16* bp = KEYS + ((size_t)(layer * 16 + h * 2 + wc) * 128 + fr) * 128 + fq * 8;
                    bf16x8 af[2][4];
#pragma unroll
                    for (int m = 0; m < 2; ++m)
#pragma unroll
                        for (int ks = 0; ks < 4; ++ks) af[m][ks] = *(const GAS bf16x8*)(ap + (size_t)m * 16 * 2048 + ks * 32);
#pragma unroll
                    for (int n = 0; n < 8; ++n) {
                        bf16x8 bfr[4];
#pragma unroll
                        for (int ks = 0; ks < 4; ++ks) bfr[ks] = *(const GAS bf16x8*)(bp + (size_t)n * 16 * 128 + ks * 32);
#pragma unroll
                        for (int ks = 0; ks < 4; ++ks)
#pragma unroll
                            for (int m = 0; m < 2; ++m) acc[m][n] = __builtin_amdgcn_mfma_f32_16x16x32_bf16(af[m][ks], bfr[ks], acc[m][n], 0, 0, 0);
                    }
#pragma unroll
                    for (int m = 0; m < 2; ++m)
#pragma unroll
                        for (int r = 0; r < 4; ++r) {
                            const int row_ = wr * 32 + 16 * m + 4 * fq + r;
#pragma unroll
                            for (int n = 0; n < 8; ++n) { const int key_ = wc * 128 + 16 * n + fr, c_ = key_ >> 2, pc_ = (c_ & 0x30) | ((c_ & 15) ^ (((row_ & 3) << 2) | (c_ >> 4)));
                                S[row_ * 256 + pc_ * 4 + (key_ & 3)] = acc[m][n][r]; }
                        }
                }
                __syncthreads();
                {
                    const int t = tile * 128 + tl;
                    int a[16];
#define LOAD_CHUNK_L(v, ch) _Pragma("unroll") for (int q = 0; q < 4; ++q) { const int c_ = qd * 16 + (ch) * 4 + q, pc_ = (c_ & 0x30) | ((c_ & 15) ^ (((tl & 3) << 2) | qd)); \
                        const f32x4 x = *(const LAS f32x4*)(S + tl * 256 + pc_ * 4); const int kb_ = hq * 64 + (ch) * 16 + 4 * q; \
                        v[4 * q + 0] = (f2ord(x.x) & ~127) | (kb_ + 0); v[4 * q + 1] = (f2ord(x.y) & ~127) | (kb_ + 1); v[4 * q + 2] = (f2ord(x.z) & ~127) | (kb_ + 2); v[4 * q + 3] = (f2ord(x.w) & ~127) | (kb_ + 3); }
                    LOAD_CHUNK_L(a, 0) sort16_desc(a);
#pragma unroll
                    for (int ch = 1; ch < 4; ++ch) { int v[16]; LOAD_CHUNK_L(v, ch) sort16_desc(v); merge16_desc(a, v); }
#undef LOAD_CHUNK_L
                    { int b[16];
#pragma unroll
                      for (int i = 0; i < 16; ++i) b[i] = __builtin_amdgcn_update_dpp(0, a[i], 0xB1, 0xF, 0xF, true);
                      merge16_desc(a, b); }
                    int a0[16], a1[16];
#pragma unroll
                    for (int i = 0; i < 16; ++i) { const int o2 = __builtin_amdgcn_update_dpp(0, a[i], 0x4E, 0xF, 0xF, true); a0[i] = ph ? o2 : a[i]; a1[i] = ph ? a[i] : o2; }
                    {
            float va[16], vb[16];
#pragma unroll
            for (int i = 0; i < 16; ++i) { va[i] = ord2f(a0[i] & ~127); vb[i] = ord2f(a1[i] & ~127); }
            int c[16];
            {
                int v[16];
                v[0] = (f2ord(va[0] + vb[0]) & ~255) | 0;
                v[1] = (f2ord(va[0] + vb[1]) & ~255) | 1;
                v[2] = (f2ord(va[0] + vb[2]) & ~255) | 2;
                v[3] = (f2ord(va[0] + vb[3]) & ~255) | 3;
                v[4] = (f2ord(va[0] + vb[4]) & ~255) | 4;
                v[5] = (f2ord(va[0] + vb[5]) & ~255) | 5;
                v[6] = (f2ord(va[0] + vb[6]) & ~255) | 6;
                v[7] = (f2ord(va[0] + vb[7]) & ~255) | 7;
                v[8] = (f2ord(va[0] + vb[8]) & ~255) | 8;
                v[9] = (f2ord(va[0] + vb[9]) & ~255) | 9;
                v[10] = (f2ord(va[0] + vb[10]) & ~255) | 10;
                v[11] = (f2ord(va[0] + vb[11]) & ~255) | 11;
                v[12] = (f2ord(va[0] + vb[12]) & ~255) | 12;
                v[13] = (f2ord(va[0] + vb[13]) & ~255) | 13;
                v[14] = (f2ord(va[0] + vb[14]) & ~255) | 14;
                v[15] = (f2ord(va[0] + vb[15]) & ~255) | 15;
                sort16_desc(v);
#pragma unroll
                for (int i = 0; i < 16; ++i) c[i] = v[i];
            }
            {
                int v[16];
                v[0] = (f2ord(va[1] + vb[0]) & ~255) | 16;
                v[1] = (f2ord(va[1] + vb[1]) & ~255) | 17;
                v[2] = (f2ord(va[1] + vb[2]) & ~255) | 18;
                v[3] = (f2ord(va[1] + vb[3]) & ~255) | 19;
                v[4] = (f2ord(va[1] + vb[4]) & ~255) | 20;
                v[5] = (f2ord(va[1] + vb[5]) & ~255) | 21;
                v[6] = (f2ord(va[1] + vb[6]) & ~255) | 22;
                v[7] = (f2ord(va[1] + vb[7]) & ~255) | 23;
                v[8] = (f2ord(va[2] + vb[0]) & ~255) | 32;
                v[9] = (f2ord(va[2] + vb[1]) & ~255) | 33;
                v[10] = (f2ord(va[2] + vb[2]) & ~255) | 34;
                v[11] = (f2ord(va[2] + vb[3]) & ~255) | 35;
                v[12] = (f2ord(va[2] + vb[4]) & ~255) | 36;
                v[13] = (f2ord(va[3] + vb[0]) & ~255) | 48;
                v[14] = (f2ord(va[3] + vb[1]) & ~255) | 49;
                v[15] = (f2ord(va[3] + vb[2]) & ~255) | 50;
                sort16_desc(v);
                merge16_desc(c, v);
            }
            {
                int v[16];
                v[0] = (f2ord(va[3] + vb[3]) & ~255) | 51;
                v[1] = (f2ord(va[4] + vb[0]) & ~255) | 64;
                v[2] = (f2ord(va[4] + vb[1]) & ~255) | 65;
                v[3] = (f2ord(va[4] + vb[2]) & ~255) | 66;
                v[4] = (f2ord(va[5] + vb[0]) & ~255) | 80;
                v[5] = (f2ord(va[5] + vb[1]) & ~255) | 81;
                v[6] = (f2ord(va[6] + vb[0]) & ~255) | 96;
                v[7] = (f2ord(va[6] + vb[1]) & ~255) | 97;
                v[8] = (f2ord(va[7] + vb[0]) & ~255) | 112;
                v[9] = (f2ord(va[7] + vb[1]) & ~255) | 113;
                v[10] = (f2ord(va[8] + vb[0]) & ~255) | 128;
                v[11] = (f2ord(va[9] + vb[0]) & ~255) | 144;
                v[12] = (f2ord(va[10] + vb[0]) & ~255) | 160;
                v[13] = (f2ord(va[11] + vb[0]) & ~255) | 176;
                v[14] = (f2ord(va[12] + vb[0]) & ~255) | 192;
                v[15] = (f2ord(va[13] + vb[0]) & ~255) | 208;
                sort16_desc(v);
                merge16_desc(c, v);
            }
            {
                int v[16];
                v[0] = (f2ord(va[14] + vb[0]) & ~255) | 224;
                v[1] = (f2ord(va[15] + vb[0]) & ~255) | 240;
                v[2] = (int)0x80000000;
                v[3] = (int)0x80000000;
                v[4] = (int)0x80000000;
                v[5] = (int)0x80000000;
                v[6] = (int)0x80000000;
                v[7] = (int)0x80000000;
                v[8] = (int)0x80000000;
                v[9] = (int)0x80000000;
                v[10] = (int)0x80000000;
                v[11] = (int)0x80000000;
                v[12] = (int)0x80000000;
                v[13] = (int)0x80000000;
                v[14] = (int)0x80000000;
                v[15] = (int)0x80000000;
                sort16_desc(v);
                merge16_desc(c, v);
            }
            const float smax = ord2f(c[0] & ~255);
            float pe[16]; float psum = 0.f;
#pragma unroll
            for (int k = 0; k < 16; ++k) { pe[k] = __expf(ord2f(c[k] & ~255) - smax); psum += pe[k]; }
            const float ip = 1.0f / psum;
#pragma unroll
            for (int kk = 0; kk < 4; ++kk) {
                const int ck = (qd == 0) ? c[kk] : (qd == 1) ? c[4 + kk] : (qd == 2) ? c[8 + kk] : c[12 + kk];
                const float pk_ = (qd == 0) ? pe[kk] : (qd == 1) ? pe[4 + kk] : (qd == 2) ? pe[8 + kk] : pe[12 + kk];
                const int ij = ck & 255, ii = ij >> 4, jj = ij & 15;
                int e0 = 0, e1 = 0;
#pragma unroll
                for (int q = 0; q < 16; ++q) { e0 = (ii == q) ? (a0[q] & 127) : e0; e1 = (jj == q) ? (a1[q] & 127) : e1; }
                const int e = e0 * PEER_KEYS + e1;
                const float su = SCU[layer * 16384 + e], sv = SCV[layer * 16384 + e];
                const int k = 4 * qd + kk;
                EI[(size_t)t * NSEL + h * 16 + k] = (unsigned)e | (f2bf(su) << 16);
                EG[(size_t)t * NSEL + h * 16 + k] = pk_ * ip * sv;
            }
                    }
                }
                __syncthreads();
            }
        }
} }
        }
        }
#endif
        GRID_BAR();

#ifndef SKIP_P10
#define P10_CENSUS \
        unsigned myx_, nx_ = 1u, smask_ = 0u; { unsigned cnt_[16]; unsigned* bw_ = (unsigned*)(args.ws + WS_CTL) + CW_BAR; \
            _Pragma("unroll") for (int j = 0; j < 16; ++j) cnt_[j] = (unsigned)__builtin_amdgcn_readfirstlane((int)xb_ld(&bw_[XB_XCNT(j)])); \
            myx_ = xb_xcc_id(); unsigned np_ = 0u; \
            _Pragma("unroll") for (int j = 0; j < 16; ++j) { np_ += (cnt_[j] > 0u) ? 1u : 0u; nx_ = ((unsigned)j == myx_) ? cnt_[j] : nx_; } \
            if (np_ == 0u) np_ = 1u; if (nx_ == 0u) nx_ = 1u; \
            _Pragma("unroll") for (int sl = 0; sl < 8; ++sl) { const unsigned k_ = (unsigned)sl % np_; unsigned seen_ = 0u, srv_ = 0xffu; \
                _Pragma("unroll") for (int j = 0; j < 16; ++j) { if (cnt_[j] > 0u) { srv_ = (seen_ == k_) ? (unsigned)j : srv_; ++seen_; } } \
                smask_ |= (srv_ == myx_) ? (1u << sl) : 0u; } } \
        const int rank_ = (int)__builtin_amdgcn_readfirstlane((int)MISC[12]); const int wstride_ = (int)nx_ * NWAVES; (void)rank_; (void)wstride_;
        { PHASE_PTRS LAYER_PTRS
        { const int ln = lane_id_v(); const int c = ln & 7, tg = ln >> 3;
          P10_CENSUS
          float* PART = (float*)(wsq + WS_PART);
          const unsigned char* U8l = U8 + (size_t)layer * 16384 * D;
          for (int rep_ = 0; rep_ < REP_P10A; ++rep_)
#pragma unroll 1
          for (int sl = 0; sl < 8; ++sl) {
            if (!((smask_ >> sl) & 1u)) continue;
            const int ws0 = (rank_ * NWAVES + wave) * 8, nslot = wstride_ * 8;
            if (ws0 >= T_EFF) continue;
            const int niter = (T_EFF - ws0 + nslot - 1) / nslot, nb = niter * 8;
#define A_TOK(bi) (ws0 + tg + (min((bi), nb - 1) >> 3) * nslot)
#define A_LOAD_PK(pkv, bi) { const GAS v4u* wp_ = (const GAS v4u*)(EI + (size_t)A_TOK(bi) * NSEL + 16 * (min((bi), nb - 1) & 7)); _Pragma("unroll") for (int q = 0; q < 4; ++q) pkv[q] = wp_[q]; }
#define A_ISSUE(rowv, pkv) { _Pragma("unroll") for (int q = 0; q < 16; ++q) rowv[q] = *(const GAS v4u*)(U8l + (size_t)(pkv[q >> 2][q & 3] & 0xffffu) * D + 128 * sl + 16 * c); }
#define A_LOAD_H(hvv, bi) { const int tq_ = A_TOK(bi); _Pragma("unroll") for (int j = 0; j < 4; ++j) hvv[j] = *(const GAS v2u*)(H + (size_t)tq_ * D + 256 * j + 32 * sl + 4 * c); }
#define A_QUANT(hvv) { float hf[16]; float am_ = 0.f; \
                _Pragma("unroll") for (int j = 0; j < 4; ++j) { hf[4 * j] = bf2f(hvv[j].x & 0xffffu); hf[4 * j + 1] = bf2f(hvv[j].x >> 16); hf[4 * j + 2] = bf2f(hvv[j].y & 0xffffu); hf[4 * j + 3] = bf2f(hvv[j].y >> 16); } \
                _Pragma("unroll") for (int i = 0; i < 16; ++i) am_ = fmaxf(am_, fabsf(hf[i])); \
                am_ = fmaxf(am_, dpp_mov<0xB1>(am_)); am_ = fmaxf(am_, dpp_mov<0x4E>(am_)); am_ = fmaxf(am_, dpp_mov<0x141>(am_)); am_ = fmaxf(am_, 1e-20f); \
                sh_ = am_ * (1.0f / 127.0f); const float ih_ = 127.0f / am_; \
                _Pragma("unroll") for (int j = 0; j < 4; ++j) { const int q0 = __float2int_rn(hf[4 * j] * ih_), q1 = __float2int_rn(hf[4 * j + 1] * ih_), q2 = __float2int_rn(hf[4 * j + 2] * ih_), q3 = __float2int_rn(hf[4 * j + 3] * ih_); \
                    hq_[j] = (int)((unsigned)(q0 & 255) | ((unsigned)(q1 & 255) << 8) | ((unsigned)(q2 & 255) << 16) | ((unsigned)q3 << 24)); } }
#define A_COMPUTE(rowv, bi) { int p_[16]; \
                _Pragma("unroll") for (int q = 0; q < 16; ++q) { int ia = 0; _Pragma("unroll") for (int j = 0; j < 4; ++j) ia = __builtin_amdgcn_sdot4((int)rowv[q][j], hq_[j], ia, false); p_[q] = ia; } \
                { const bool up = (c & 4) != 0; _Pragma("unroll") for (int i = 0; i < 8; ++i) { const int send = up ? p_[i] : p_[8 + i], keep = up ? p_[8 + i] : p_[i]; p_[i] = keep + __builtin_amdgcn_update_dpp(0, send, 0x141, 0xF, 0xF, true); } } \
                { const bool up = (c & 2) != 0; _Pragma("unroll") for (int i = 0; i < 4; ++i) { const int send = up ? p_[i] : p_[4 + i], keep = up ? p_[4 + i] : p_[i]; p_[i] = keep + __builtin_amdgcn_update_dpp(0, send, 0x4E, 0xF, 0xF, true); } } \
                { const bool up = (c & 1) != 0; _Pragma("unroll") for (int i = 0; i < 2; ++i) { const int send = up ? p_[i] : p_[2 + i], keep = up ? p_[2 + i] : p_[i]; p_[i] = keep + __builtin_amdgcn_update_dpp(0, send, 0xB1, 0xF, 0xF, true); } } \
                f32x2 r2_; r2_.x = (float)p_[0] * sh_; r2_.y = (float)p_[1] * sh_; \
                *(GAS f32x2*)(PART + ((size_t)sl * T_ALL + (ws0 + tg + ((bi) >> 3) * nslot)) * NSEL + 16 * ((bi) & 7) + 2 * c) = r2_; }
            v4u pkA[4], pkB[4]; v4u rowA[16], rowB[16]; v2u hN[4]; int hq_[4] = {0, 0, 0, 0}; float sh_ = 0.f;
            A_LOAD_PK(pkA, 0) A_LOAD_PK(pkB, 1) A_LOAD_H(hN, 0)
            A_ISSUE(rowA, pkA)
#pragma unroll 1
            for (int bi = 0; bi < nb; bi += 2) {
                if ((bi & 7) == 0) { A_QUANT(hN) A_LOAD_H(hN, bi + 8) }
                A_ISSUE(rowB, pkB) A_LOAD_PK(pkA, bi + 2)
                __builtin_amdgcn_sched_barrier(0);
                A_COMPUTE(rowA, bi)
                __builtin_amdgcn_sched_barrier(0);
                A_ISSUE(rowA, pkA) A_LOAD_PK(pkB, bi + 3)
                __builtin_amdgcn_sched_barrier(0);
                A_COMPUTE(rowB, bi + 1)
                __builtin_amdgcn_sched_barrier(0);
            }
#undef A_TOK
#undef A_LOAD_PK
#undef A_ISSUE
#undef A_LOAD_H
#undef A_QUANT
#undef A_COMPUTE
          }
        } }
        GRID_BAR();
        { PHASE_PTRS LAYER_PTRS
        { const int ln = lane_id_v();
          const float* PART = (const float*)(wsq + WS_PART); float* WGT = (float*)(wsq + WS_WGT);
          for (int rep_ = 0; rep_ < REP_P10B; ++rep_)
          for (int i4 = vcu * NTHREADS + wave * 64 + ln; i4 < T_EFF * NSEL / 4; i4 += NGT) {
              f32x4 dsum = (f32x4){0.f, 0.f, 0.f, 0.f};
#pragma unroll
              for (int sl = 0; sl < 8; ++sl) dsum += *((const GAS f32x4*)(PART + (size_t)sl * T_ALL * NSEL) + i4);
              const v4u esu = *((const GAS v4u*)EI + i4); const f32x4 gv = *((const GAS f32x4*)EG + i4);
              v4u o;
#pragma unroll
              for (int q = 0; q < 4; ++q) {
                  const float dot = dsum[q] * bf2f(esu[q] >> 16);
                  o[q] = (esu[q] & 0xffffu) | (f2bf(0.5f * dot * (1.0f + erff(dot * 0.70710678118654752f)) * gv[q]) << 16);
              }
              *((GAS v4u*)WGT + i4) = o;
          }
        } }
        GRID_BAR();
        { PHASE_PTRS LAYER_PTRS
        { const int ln = lane_id_v(); const int c = ln & 7, tg = ln >> 3;
          P10_CENSUS
          const unsigned* WGT = (const unsigned*)(wsq + WS_WGT); float* XO = (float*)(wsq + WS_XO);
          const unsigned char* V8l = V8 + (size_t)layer * 16384 * D;
          for (int rep_ = 0; rep_ < REP_P10C; ++rep_)
#pragma unroll 1
          for (int sl = 0; sl < 8; ++sl) {
            if (!((smask_ >> sl) & 1u)) continue;
            const int ws0 = (rank_ * NWAVES + wave) * 8, nslot = wstride_ * 8;
            if (ws0 >= T_EFF) continue;
            const int niter = (T_EFF - ws0 + nslot - 1) / nslot, nb = niter * 8;
#define C_TOK(bi) (ws0 + tg + (min((bi), nb - 1) >> 3) * nslot)
#define C_LOAD_PK(pkv, bi) { const GAS v4u* wp_ = (const GAS v4u*)(WGT + (size_t)C_TOK(bi) * NSEL + 16 * (min((bi), nb - 1) & 7)); _Pragma("unroll") for (int q = 0; q < 4; ++q) pkv[q] = wp_[q]; }
#define C_ISSUE(rowv, wv, pkv) { _Pragma("unroll") for (int q = 0; q < 16; ++q) { const unsigned w_ = pkv[q >> 2][q & 3]; rowv[q] = *(const GAS v4u*)(V8l + (size_t)(w_ & 0xffffu) * D + 128 * sl + 16 * c); } \
                _Pragma("unroll") for (int q = 0; q < 8; ++q) wv[q] = (pkv[q >> 1][(2 * q) & 3] >> 16) | (pkv[q >> 1][(2 * q + 1) & 3] & 0xffff0000u); }
#define C_COMPUTE(rowv, wv) { _Pragma("unroll") for (int q = 0; q < 16; ++q) { const float wq_ = (q & 1) ? __builtin_bit_cast(float, wv[q >> 1] & 0xffff0000u) : bf2f(wv[q >> 1] & 0xffffu); const f32x2 w2_ = (f32x2){wq_, wq_}; _Pragma("unroll") for (int j = 0; j < 4; ++j) { \
                    const f32x2 a = __builtin_amdgcn_cvt_pk_f32_fp8((int)rowv[q][j], false), b = __builtin_amdgcn_cvt_pk_f32_fp8((int)rowv[q][j], true); \
                    f32x2 lo_ = (f32x2){o[j].x, o[j].y}, hi_ = (f32x2){o[j].z, o[j].w}; lo_ = __builtin_elementwise_fma(a, w2_, lo_); hi_ = __builtin_elementwise_fma(b, w2_, hi_); \
                    o[j].x = lo_.x; o[j].y = lo_.y; o[j].z = hi_.x; o[j].w = hi_.y; } \
                    asm volatile("" : "+v"(o[0]), "+v"(o[1]), "+v"(o[2]), "+v"(o[3])); } }
            v4u pkA[4], pkB[4]; unsigned wA[8], wB[8]; v4u rowA[16], rowB[16];
            f32x4 o[4];
#pragma unroll
            for (int j = 0; j < 4; ++j) o[j] = (f32x4){0.f, 0.f, 0.f, 0.f};
            C_LOAD_PK(pkA, 0) C_LOAD_PK(pkB, 1)
            C_ISSUE(rowA, wA, pkA)
#pragma unroll 1
            for (int bi = 0; bi < nb; bi += 2) {
                C_ISSUE(rowB, wB, pkB) C_LOAD_PK(pkA, bi + 2)
                __builtin_amdgcn_sched_barrier(0);
                C_COMPUTE(rowA, wA)
                __builtin_amdgcn_sched_barrier(0);
                C_ISSUE(rowA, wA, pkA) C_LOAD_PK(pkB, bi + 3)
                __builtin_amdgcn_sched_barrier(0);
                C_COMPUTE(rowB, wB)
                __builtin_amdgcn_sched_barrier(0);
                if ((bi & 7) == 6) {
                    const int t = ws0 + tg + (bi >> 3) * nslot;
#pragma unroll
                    for (int j = 0; j < 4; ++j) { *(GAS f32x4*)(XO + (size_t)t * D + 256 * j + 32 * sl + 4 * c) = o[j]; o[j] = (f32x4){0.f, 0.f, 0.f, 0.f}; }
                }
            }
#undef C_TOK
#undef C_LOAD_PK
#undef C_ISSUE
#undef C_COMPUTE
          }
        } }
        GRID_BAR();
#undef P10_CENSUS
        { PHASE_PTRS LAYER_PTRS
        { const int ln = lane_id_v();
          const float* XO = (const float*)(wsq + WS_XO);
          f32x4 gt2v[4], gm[4], shv[4];
          auto prep = [&](int midx) {
              const float* md = modl + (size_t)midx * 6 * D; const float* md1 = modl + (size_t)(3 + midx) * 6 * D;
#pragma unroll
              for (int j = 0; j < 4; ++j) {
                  gt2v[j] = *((const GAS f32x4*)(md + 5 * D) + ln + 64 * j);
                  if (!last) { const f32x4 g = *((const GAS f32x4*)(IN_[I_G1] + (layer + 1) * D) + ln + 64 * j); const f32x4 sc = *((const GAS f32x4*)(md1 + D) + ln + 64 * j);
                               gm[j] = g * (sc + 1.0f); shv[j] = *((const GAS f32x4*)(md1 + 0) + ln + 64 * j); }
                  else { gm[j] = *((const GAS f32x4*)IN_[I_GFINAL] + ln + 64 * j); shv[j] = (f32x4){0.f, 0.f, 0.f, 0.f}; }
              } };
          auto row = [&](int t) {
              GAS f32x4* xr = (GAS f32x4*)(X + (size_t)t * D) + ln;
              const GAS f32x4* xo = (const GAS f32x4*)(XO + (size_t)t * D) + ln;
              f32x4 xn[4]; float ss = 0.f;
#pragma unroll
              for (int j = 0; j < 4; ++j) { xn[j] = xr[64 * j] + gt2v[j] * xo[64 * j]; ss += (xn[j].x * xn[j].x + xn[j].y * xn[j].y) + (xn[j].z * xn[j].z + xn[j].w * xn[j].w); }
              const float rs = 1.0f / sqrtf(wave_sum(ss) * (1.f / D) + NORM_EPS);
              if (!last) {
                  GAS v2u* o8 = (GAS v2u*)(H + (size_t)t * D) + ln;
#pragma unroll
                  for (int j = 0; j < 4; ++j) { xr[64 * j] = xn[j]; const f32x4 hh = xn[j] * rs * gm[j] + shv[j]; v2u o; o.x = pk2(hh.x, hh.y); o.y = pk2(hh.z, hh.w); o8[64 * j] = o; }
              } else {
                  GAS f32x4* op = (GAS f32x4*)(((float*)IN_[22]) + (size_t)t * D) + ln;
#pragma unroll
                  for (int j = 0; j < 4; ++j) op[64 * j] = xn[j] * rs * gm[j];
              } };
          wave_row_blocks(T_EFF, gw, NGW, prep, row);
        } }
#endif
        if (!last) GRID_BAR();
    }
}

extern "C" void kernel_launch(void* const* d_in, const int* in_sizes, int n_in, void* d_out, int out_size, void* d_ws, size_t ws_size, hipStream_t stream) {
    static int grid = 0;
    if (grid == 0) {
        if (n_in != 22 || out_size != T_LAT * D || ws_size < WS_END) { fprintf(stderr, "kernel_launch: unexpected shapes: n_in %d out %d ws %zu (need %zu)\n", n_in, out_size, ws_size, (size_t)WS_END); grid = -1; return; }
        int dev = 0, cus = 0, per_cu = 0;
        if (hipGetDevice(&dev) != hipSuccess || hipDeviceGetAttribute(&cus, hipDeviceAttributeMultiprocessorCount, dev) != hipSuccess) { fprintf(stderr, "device query failed\n"); grid = -1; return; }
        if (hipFuncSetAttribute((const void*)mega_fwd, hipFuncAttributeMaxDynamicSharedMemorySize, LDS_BYTES) != hipSuccess) { fprintf(stderr, "hipFuncSetAttribute failed\n"); grid = -1; return; }
        if (hipOccupancyMaxActiveBlocksPerMultiprocessor(&per_cu, (const void*)mega_fwd, NTHREADS, LDS_BYTES) != hipSuccess || per_cu < 1) { fprintf(stderr, "occupancy query: %d\n", per_cu); }
        (void)hipGetLastError();
        grid = cus;
    }
    if (grid < 0) return;
    if (hipMemsetAsync((char*)d_ws + WS_CTL, 0, CTL_ZERO_BYTES, stream) != hipSuccess) { fprintf(stderr, "memset failed\n"); return; }
    Args a{};
    for (int i = 0; i < 22; ++i) a.in[i] = (const float*)d_in[i];
    a.out = (float*)d_out; a.ws = (unsigned char*)d_ws;
    hipLaunchKernelGGL(mega_fwd, dim3(grid), dim3(NTHREADS), LDS_BYTES, stream, a);
}
```

```cpp
#include <hip/hip_runtime.h>
#include <cstdio>
#include <cstdint>

#ifndef REP_P0
#define REP_P0 1
#endif
#ifndef REP_P1
#define REP_P1 1
#endif
#ifndef REP_P2
#define REP_P2 1
#endif
#ifndef REP_P3A
#define REP_P3A 1
#endif
#ifndef REP_P3B
#define REP_P3B 1
#endif
#ifndef REP_P4
#define REP_P4 1
#endif
#ifndef REP_P6
#define REP_P6 1
#endif
#ifndef REP_P7
#define REP_P7 1
#endif
#ifndef REP_P8
#define REP_P8 1
#endif
#ifndef REP_P9
#define REP_P9 1
#endif
#ifndef REP_P10
#define REP_P10 1
#endif
#ifndef REP_P10A
#define REP_P10A 1
#endif
#ifndef REP_P10C
#define REP_P10C 1
#endif
#ifndef REP_P10B
#define REP_P10B 1
#endif
#ifndef REP_P0A
#define REP_P0A 1
#endif
#ifndef REP_P0D
#define REP_P0D 1
#endif
#ifndef REP_P0F
#define REP_P0F 1
#endif
#ifndef REP_P3C
#define REP_P3C 1
#endif
#define GAS __attribute__((address_space(1)))
#define LAS __attribute__((address_space(3)))
typedef unsigned short bf16;
typedef float f32x4 __attribute__((ext_vector_type(4)));
typedef short bf16x8 __attribute__((ext_vector_type(8)));
typedef unsigned v4u __attribute__((ext_vector_type(4)));
typedef unsigned v2u __attribute__((ext_vector_type(2)));
typedef float f32x2 __attribute__((ext_vector_type(2)));
typedef GAS unsigned gu32;

constexpr int NWAVES = 8, NTHREADS = 512;
constexpr int D = 1024, BATCH = 2, SEQ = 8192, DEPTH = 2, GRID_W = 64, CTX = 256;
constexpr int T_LAT = BATCH * SEQ;
constexpr int T_ALL = T_LAT + BATCH * CTX;
constexpr int NTOK = SEQ + CTX;
constexpr int IN_W = 6912;
constexpr int PEER_HEADS = 8, PEER_KEYS = 128, PEER_TOPK = 16, NSEL = PEER_HEADS * PEER_TOPK;
constexpr float NORM_EPS = 1e-6f;
constexpr float LOG2E = 1.4426950408889634f;
constexpr float SCL2 = 0.125f * LOG2E;

constexpr size_t MiB = 1u << 20;
constexpr size_t WS_CTL = 0, CTL_ZERO_BYTES = 1 * MiB;
constexpr int CW_BAR = 4096;
constexpr int CW_RANK = 8192;
#ifndef P10_SLICED
#define P10_SLICED 1
#endif
constexpr size_t WS_MOD = 65536;
constexpr size_t WS_COS = 2 * MiB, WS_SIN = 3 * MiB;
constexpr size_t WS_WIN = 4 * MiB;
constexpr size_t WS_WB = 31 * MiB;
constexpr size_t WS_WO = 37 * MiB;
constexpr size_t WS_WQ = 41 * MiB;
constexpr size_t WS_KEYS = 49 * MiB;
constexpr size_t WS_X = 50 * MiB;
constexpr size_t WS_H = 116 * MiB;
constexpr size_t WS_Y = 149 * MiB;
constexpr size_t WS_MG = WS_H;
constexpr size_t WS_U8 = 199 * MiB;
constexpr size_t WS_SCU = 231 * MiB;
constexpr size_t WS_EI = 232 * MiB;
constexpr size_t WS_EG = 241 * MiB;
constexpr size_t WS_P = 250 * MiB;
constexpr size_t SZ_R512 = (size_t)T_ALL * 512 * 2;
constexpr size_t SZ_R128 = (size_t)T_ALL * 128 * 2;
constexpr size_t WS_AQ = WS_P, WS_AK = WS_AQ + SZ_R512, WS_AVT = WS_AK + SZ_R128, WS_BQ = WS_AVT + SZ_R128, WS_BK = WS_BQ + SZ_R512,
                 WS_BVT = WS_BK + SZ_R512, WS_CQ = WS_BVT + SZ_R512, WS_CK = WS_CQ + SZ_R512, WS_CVT = WS_CK + SZ_R512, WS_SG = WS_CVT + SZ_R512;
constexpr size_t WS_Q2 = WS_P;
constexpr size_t WS_SC = WS_P + 66 * MiB;
constexpr size_t WS_PART = WS_P, WS_XO = WS_P + 66 * MiB, WS_WGT = WS_P + 132 * MiB;
constexpr size_t WS_PEND = WS_SG + (size_t)T_ALL * 3072 * 2;
constexpr size_t WS_V8 = 473 * MiB;
constexpr size_t WS_END = WS_V8 + 32 * MiB;
static_assert(WS_SC + (size_t)T_ALL * 2048 * 4 <= WS_PEND && WS_PEND <= WS_V8, "alias map");
static_assert(WS_END <= 512 * MiB, "ws map");

constexpr int LDS_BYTES = 147456;
constexpr int MISC_OFF = 131072 + 320;

__device__ __forceinline__ int lane_id_v() { int l; asm volatile("v_mbcnt_lo_u32_b32 %0, -1, 0\n\tv_mbcnt_hi_u32_b32 %0, -1, %0" : "=v"(l)); return l; }
#define XB_TMO      128
#define XB_XCNT(j)  (256  + 64 * (j))
#define XB_XSUB(j)  (1280 + 64 * (j))
#define XB_XGEN(j)  (2304 + 64 * (j))
#define XB_TOP      3328
#define XB_TOPGEN   3392
#define XCD_BAR_WORDS 3456
#define XB_SPIN_CAP (1u << 24)

__device__ __forceinline__ unsigned xb_ld(unsigned* p)              { return __hip_atomic_load(p, __ATOMIC_RELAXED, __HIP_MEMORY_SCOPE_AGENT); }
__device__ __forceinline__ unsigned xb_add(unsigned* p, unsigned v) { return __hip_atomic_fetch_add(p, v, __ATOMIC_RELAXED, __HIP_MEMORY_SCOPE_AGENT); }
__device__ __forceinline__ unsigned xb_xcc_id() { return (unsigned)__builtin_amdgcn_s_getreg((3 << 11) | 20) & 0xFu; }
#define XB_SPIN(cond, bar) do { unsigned _sp = 0; while (cond) { __builtin_amdgcn_s_sleep(1); \
    if ((++_sp & 255u) == 0u) { if (xb_ld(&(bar)[XB_TMO])) break; if (_sp > XB_SPIN_CAP) { atomicAdd(&(bar)[XB_TMO], 1u); break; } } } } while (0)

struct XcdBarrier { unsigned* bar; unsigned x; volatile LAS unsigned* st; };

__device__ __forceinline__ XcdBarrier xcd_barrier_post(unsigned* bar, volatile LAS unsigned* st) {
    XcdBarrier b; b.bar = bar; b.x = xb_xcc_id(); b.st = st;
    if (threadIdx.x == 0) (void)xb_add(&bar[XB_XCNT(b.x)], 1u);
    return b;
}
__device__ __forceinline__ void xcd_barrier_complete(unsigned* bar, unsigned x, unsigned& nloc, unsigned& nx) {
    const unsigned G = gridDim.x * gridDim.y * gridDim.z;
    unsigned sum, cnt, mine, sp = 0u;
    for (;;) {
        sum = 0u; cnt = 0u; mine = 0u;
#pragma unroll
        for (unsigned j = 0; j < 16; ++j) { const unsigned c = xb_ld(&bar[XB_XCNT(j)]); sum += c; cnt += (c > 0u) ? 1u : 0u; mine = (j == x) ? c : mine; }
        if (sum == G) break;
        __builtin_amdgcn_s_sleep(1);
        if ((++sp & 255u) == 0u) { if (xb_ld(&bar[XB_TMO])) break; if (sp > XB_SPIN_CAP) { atomicAdd(&bar[XB_TMO], 1u); break; } }
    }
    nloc = mine > 0u ? mine : 1u; nx = cnt > 0u ? cnt : 1u;
}
__device__ __forceinline__ void xcd_barrier(const XcdBarrier& b, bool t0) {
    asm volatile("s_waitcnt vmcnt(0)" ::: "memory");
    __syncthreads();
    if (t0) {
        unsigned* bar = b.bar;
        __builtin_amdgcn_s_waitcnt(0);
        unsigned nloc = b.st[0], nx = b.st[1];
        if (nloc == 0u) { xcd_barrier_complete(bar, b.x, nloc, nx); b.st[0] = nloc; b.st[1] = nx; }
        const unsigned old = xb_add(&bar[XB_XSUB(b.x)], 1u);
        const unsigned gen = old / nloc;
        if (old + 1u == (gen + 1u) * nloc) {
            __builtin_amdgcn_fence(__ATOMIC_RELEASE, "agent");
            asm volatile("s_waitcnt vmcnt(0)" ::: "memory");
            const unsigned og = xb_add(&bar[XB_TOP], 1u);
            const unsigned tg = og / nx;
            if (og + 1u == (tg + 1u) * nx) xb_add(&bar[XB_TOPGEN], 1u);
            else XB_SPIN(xb_ld(&bar[XB_TOPGEN]) == tg, bar);
            __builtin_amdgcn_fence(__ATOMIC_ACQUIRE, "agent");
            xb_add(&bar[XB_XGEN(b.x)], 1u);
            asm volatile("s_waitcnt vmcnt(0)" ::: "memory");
        } else {
            XB_SPIN(xb_ld(&bar[XB_XGEN(b.x)]) == gen, bar);
            __builtin_amdgcn_fence(__ATOMIC_ACQUIRE, "agent");
            asm volatile("s_waitcnt vmcnt(0)" ::: "memory");
        }
    }
    __syncthreads();
}

__device__ __forceinline__ unsigned f2bf(float f) { unsigned u = __builtin_bit_cast(unsigned, f); return (u + 0x7fffu + ((u >> 16) & 1u)) >> 16; }
__device__ __forceinline__ unsigned pk2(float lo, float hi) { return f2bf(lo) | (f2bf(hi) << 16); }
__device__ __forceinline__ float bf2f(unsigned h) { return __builtin_bit_cast(float, h << 16); }
template <int CTRL> __device__ __forceinline__ float dpp_mov(float v) { return __builtin_bit_cast(float, __builtin_amdgcn_update_dpp(0, __builtin_bit_cast(int, v), CTRL, 0xF, 0xF, true)); }
__device__ __forceinline__ float sum8_dpp(float v) { v += dpp_mov<0xB1>(v); v += dpp_mov<0x4E>(v); v += dpp_mov<0x141>(v); return v; }
template <int K> __device__ __forceinline__ float xshfl_l(float v, int lane) { return __builtin_bit_cast(float, __builtin_amdgcn_ds_bpermute((lane ^ K) << 2, __builtin_bit_cast(int, v))); }
template <int K> __device__ __forceinline__ float xshfl(float v) { return xshfl_l<K>(v, lane_id_v()); }
__device__ __forceinline__ float xadd32(float v) { return v + xshfl_l<32>(v, lane_id_v()); }
__device__ __forceinline__ float xmax32(float v) { return fmaxf(v, xshfl_l<32>(v, lane_id_v())); }
__device__ __forceinline__ float wave_sum(float v) { const int l = lane_id_v(); v += xshfl_l<1>(v, l); v += xshfl_l<2>(v, l); v += xshfl_l<4>(v, l); v += xshfl_l<8>(v, l); v += xshfl_l<16>(v, l); v += xshfl_l<32>(v, l); return v; }
__device__ __forceinline__ float wave_max(float v) { const int l = lane_id_v(); v = fmaxf(v, xshfl_l<1>(v, l)); v = fmaxf(v, xshfl_l<2>(v, l)); v = fmaxf(v, xshfl_l<4>(v, l)); v = fmaxf(v, xshfl_l<8>(v, l)); v = fmaxf(v, xshfl_l<16>(v, l)); v = fmaxf(v, xshfl_l<32>(v, l)); return v; }


__device__ __forceinline__ float sigmoidf_(float x) { return 1.0f / (1.0f + __expf(-x)); }
__device__ __forceinline__ float sigmoid_fast(float x) { return __builtin_amdgcn_rcpf(1.0f + __builtin_amdgcn_exp2f(-LOG2E * x)); }
__device__ __forceinline__ int row_modidx(int r) { return r < T_LAT ? (r >> 13) : 2; }
__device__ __forceinline__ int row_batch(int r) { return r < T_LAT ? (r >> 13) : ((r - T_LAT) >> 8); }
__device__ __forceinline__ int row_tok(int r) { return r < T_LAT ? (r & (SEQ - 1)) : SEQ + ((r - T_LAT) & (CTX - 1)); }

__device__ __forceinline__ const float* xin_row(const float* x, const float* ctx, int r) { return r < T_LAT ? x + (size_t)r * D : ctx + (size_t)(r - T_LAT) * D; }
template <class Prep, class Row>
__device__ __forceinline__ void wave_row_blocks(int T_rows, int gw, int NGW, Prep prep, Row row) {
    for (int r0 = gw * 8; r0 < T_LAT; r0 += NGW * 8) {
        prep(r0 >> 13);
#pragma unroll 2
        for (int k = 0; k < 8; ++k) row(r0 + k);
    }
    if (T_rows > T_LAT) for (int r = T_LAT + gw; r < T_rows; r += NGW) { prep(2); row(r); }
}
struct Args { const float* in[22]; float* out; unsigned char* ws; };
enum { I_X = 0, I_C, I_CTX, I_CCTX, I_WMOD, I_BMOD, I_G1, I_G2, I_WIN, I_SINK, I_RPB, I_LAMBDA, I_SUBLN, I_WBA, I_WBB, I_WBC, I_WOUT, I_PWQ, I_PKEYS, I_PU, I_PV, I_GFINAL };

__device__ __forceinline__ int rope_perm(int c) {
    if (c < 640 || (c >= 2304 && c < 3328)) { const int w = c & 63; return (c & ~63) + 2 * (w & 31) + (w >> 5); }
    return c;
}
template <bool PERM = false>
__device__ __forceinline__ void p0_transpose_item(const float* W, int K, int N, bf16* WT, LAS float* scr, int item, int lane) {
    const int nblk = N / 32, kb = item / nblk, nb = item % nblk, k0 = 64 * kb, n0 = 32 * nb;
#pragma unroll 8
    for (int i = 0; i < 32; ++i) { const int kk = 2 * i + (lane >> 5); scr[kk * 33 + (lane & 31)] = W[(size_t)(k0 + kk) * N + n0 + (lane & 31)]; }
    asm volatile("s_waitcnt lgkmcnt(0)" ::: "memory");
    const int c = lane & 7;
#pragma unroll
    for (int j = 0; j < 4; ++j) { const int n = (lane >> 3) + 8 * j; const LAS float* s = scr + (8 * c) * 33 + n;
        v4u o; o.x = pk2(s[0 * 33], s[1 * 33]); o.y = pk2(s[2 * 33], s[3 * 33]); o.z = pk2(s[4 * 33], s[5 * 33]); o.w = pk2(s[6 * 33], s[7 * 33]);
        const int nout = PERM ? rope_perm(n0 + n) : (n0 + n);
        *(GAS v4u*)(WT + (size_t)nout * K + k0 + 8 * c) = o; }
    asm volatile("s_waitcnt lgkmcnt(0)" ::: "memory");
}

template <int UNR = 2, int NN = 4>
__device__ __forceinline__ void sgemm_tile(f32x4 (&acc)[4][NN], const bf16* A, int lda, const bf16* Bt, int ldb, int K, int row0, int col0, int lane) {
    const int fr = lane & 15, fq = lane >> 4;
    const bf16* ap = A + (size_t)(row0 + fr) * lda + fq * 8;
    const bf16* bp = Bt + (size_t)(col0 + fr) * ldb + fq * 8;
#pragma unroll UNR
    for (int k = 0; k < K; k += 32) {
        bf16x8 a[4], b[NN];
#pragma unroll
        for (int m = 0; m < 4; ++m) a[m] = *(const GAS bf16x8*)(ap + (size_t)m * 16 * lda + k);
#pragma unroll
        for (int n = 0; n < NN; ++n) b[n] = *(const GAS bf16x8*)(bp + (size_t)n * 16 * ldb + k);
#pragma unroll
        for (int m = 0; m < 4; ++m)
#pragma unroll
            for (int n = 0; n < NN; ++n) acc[m][n] = __builtin_amdgcn_mfma_f32_16x16x32_bf16(a[m], b[n], acc[m][n], 0, 0, 0);
    }
}
template <int UNR>
__device__ __forceinline__ void sgemm32(f32x4 (&acc)[2][2], const bf16* A, int lda, const bf16* Bt, int ldb, int K, int row0, int col0, int lane) {
    const int fr = lane & 15, fq = lane >> 4;
    const bf16* ap = A + (size_t)(row0 + fr) * lda + fq * 8;
    const bf16* bp = Bt + (size_t)(col0 + fr) * ldb + fq * 8;
#pragma unroll 1
    for (int k0 = 0; k0 < K; k0 += 32 * UNR) {
        bf16x8 a[UNR][2], b[UNR][2];
#pragma unroll
        for (int u = 0; u < UNR; ++u)
#pragma unroll
            for (int m = 0; m < 2; ++m) { a[u][m] = *(const GAS bf16x8*)(ap + (size_t)m * 16 * lda + k0 + 32 * u); b[u][m] = *(const GAS bf16x8*)(bp + (size_t)m * 16 * ldb + k0 + 32 * u); }
#pragma unroll
        for (int u = 0; u < UNR; ++u)
#pragma unroll
            for (int m = 0; m < 2; ++m)
#pragma unroll
                for (int n = 0; n < 2; ++n) acc[m][n] = __builtin_amdgcn_mfma_f32_16x16x32_bf16(a[u][m], b[u][n], acc[m][n], 0, 0, 0);
    }
}
__device__ __forceinline__ void zero_acc22(f32x4 (&acc)[2][2]) { acc[0][0] = acc[0][1] = acc[1][0] = acc[1][1] = (f32x4){0.f, 0.f, 0.f, 0.f}; }
template <int NN>
__device__ __forceinline__ void zero_acc(f32x4 (&acc)[4][NN]) {
#pragma unroll
    for (int m = 0; m < 4; ++m)
#pragma unroll
        for (int n = 0; n < NN; ++n) acc[m][n] = (f32x4){0.f, 0.f, 0.f, 0.f};
}

__device__ __forceinline__ int f2ord(float f) { const int b = __builtin_bit_cast(int, f); return b ^ ((b >> 31) & 0x7fffffff); }
__device__ __forceinline__ float ord2f(int o) { const int b = o ^ ((o >> 31) & 0x7fffffff); return __builtin_bit_cast(float, b); }
__device__ __forceinline__ void top16_insert(int (&top)[16], int key) {
#pragma unroll
    for (int i = 0; i < 16; ++i) { const int hi = max(top[i], key); key = min(top[i], key); top[i] = hi; }
}
#define CE(a, b) { const int t_ = max(a, b); b = min(a, b); a = t_; }
__device__ __forceinline__ void sort16_desc(int (&v)[16]) { CE(v[0], v[1]); CE(v[3], v[2]); CE(v[4], v[5]); CE(v[7], v[6]); CE(v[8], v[9]); CE(v[11], v[10]); CE(v[12], v[13]); CE(v[15], v[14]); CE(v[0], v[2]); CE(v[1], v[3]); CE(v[6], v[4]); CE(v[7], v[5]); CE(v[8], v[10]); CE(v[9], v[11]); CE(v[14], v[12]); CE(v[15], v[13]); CE(v[0], v[1]); CE(v[2], v[3]); CE(v[5], v[4]); CE(v[7], v[6]); CE(v[8], v[9]); CE(v[10], v[11]); CE(v[13], v[12]); CE(v[15], v[14]); CE(v[0], v[4]); CE(v[1], v[5]); CE(v[2], v[6]); CE(v[3], v[7]); CE(v[12], v[8]); CE(v[13], v[9]); CE(v[14], v[10]); CE(v[15], v[11]); CE(v[0], v[2]); CE(v[1], v[3]); CE(v[4], v[6]); CE(v[5], v[7]); CE(v[10], v[8]); CE(v[11], v[9]); CE(v[14], v[12]); CE(v[15], v[13]); CE(v[0], v[1]); CE(v[2], v[3]); CE(v[4], v[5]); CE(v[6], v[7]); CE(v[9], v[8]); CE(v[11], v[10]); CE(v[13], v[12]); CE(v[15], v[14]); CE(v[0], v[8]); CE(v[1], v[9]); CE(v[2], v[10]); CE(v[3], v[11]); CE(v[4], v[12]); CE(v[5], v[13]); CE(v[6], v[14]); CE(v[7], v[15]); CE(v[0], v[4]); CE(v[1], v[5]); CE(v[2], v[6]); CE(v[3], v[7]); CE(v[8], v[12]); CE(v[9], v[13]); CE(v[10], v[14]); CE(v[11], v[15]); CE(v[0], v[2]); CE(v[1], v[3]); CE(v[4], v[6]); CE(v[5], v[7]); CE(v[8], v[10]); CE(v[9], v[11]); CE(v[12], v[14]); CE(v[13], v[15]); CE(v[0], v[1]); CE(v[2], v[3]); CE(v[4], v[5]); CE(v[6], v[7]); CE(v[8], v[9]); CE(v[10], v[11]); CE(v[12], v[13]); CE(v[14], v[15]); }
__device__ __forceinline__ void merge16_desc(int (&a)[16], const int (&b)[16]) {
#pragma unroll
    for (int i = 0; i < 16; ++i) a[i] = max(a[i], b[15 - i]);
    CE(a[0], a[8]); CE(a[1], a[9]); CE(a[2], a[10]); CE(a[3], a[11]); CE(a[4], a[12]); CE(a[5], a[13]); CE(a[6], a[14]); CE(a[7], a[15]); CE(a[0], a[4]); CE(a[1], a[5]); CE(a[2], a[6]); CE(a[3], a[7]); CE(a[8], a[12]); CE(a[9], a[13]); CE(a[10], a[14]); CE(a[11], a[15]); CE(a[0], a[2]); CE(a[1], a[3]); CE(a[4], a[6]); CE(a[5], a[7]); CE(a[8], a[10]); CE(a[9], a[11]); CE(a[12], a[14]); CE(a[13], a[15]); CE(a[0], a[1]); CE(a[2], a[3]); CE(a[4], a[5]); CE(a[6], a[7]); CE(a[8], a[9]); CE(a[10], a[11]); CE(a[12], a[13]); CE(a[14], a[15]); }
#undef CE


typedef float f32x16 __attribute__((ext_vector_type(16)));
typedef short s16x4 __attribute__((ext_vector_type(4)));
typedef __bf16 bf16x2_t __attribute__((ext_vector_type(2)));
__device__ __forceinline__ unsigned cvtpk(float lo, float hi) { f32x2 v = {lo, hi}; bf16x2_t b = __builtin_convertvector(v, bf16x2_t); return __builtin_bit_cast(unsigned, b); }
constexpr int CK_PITCH = 144, CV_PITCH = 320;
constexpr int CK_SZ = 64 * CK_PITCH, CV_SZ = 64 * CV_PITCH;
constexpr float C_THR_RAW = 8.0f / SCL2;

template <int NDV, class RowFn, class UseFn, class ElemFn>
__device__ __forceinline__ void attn64_pass(f32x16 (&o)[NDV], float& mrun, float& lpart, const bf16x8 (&qf)[4], const bf16* kg, int kpitch, const bf16* vg, int vpitch,
                                            int ntiles, RowFn tile_row, UseFn use_tile, ElemFn elem, LAS unsigned char* L, int lane, int tid) {
    constexpr int VP = NDV * 64 + 64, VSZ = 64 * VP, NVP = NDV / 2;
    const int r32 = lane & 31, hi = lane >> 5;
    const int krow_s = tid >> 3, kch_s = tid & 7;
    const int vrow_s = (NDV == 2) ? (tid >> 3) : (tid >> 4), vch_s = (NDV == 2) ? (tid & 7) : (tid & 15);
    LAS unsigned char* Kb0 = L; LAS unsigned char* Vb0 = L + 2 * CK_SZ;
    __syncthreads();
    {
        const int tr = tile_row(0);
        const v4u kr = *(const GAS v4u*)(kg + (size_t)tr * kpitch);
        *(LAS v4u*)(Kb0 + krow_s * CK_PITCH + kch_s * 16) = kr;
#pragma unroll
        for (int i = 0; i < NVP; ++i) { const v4u v = *(const GAS v4u*)(vg + (size_t)(tr + 32 * i) * vpitch); *(LAS v4u*)(Vb0 + (vrow_s + 32 * i) * VP + vch_s * 16) = v; }
    }
    v4u kr, vr[NVP];
    { const int tr = tile_row(ntiles > 1 ? 1 : 0); kr = *(const GAS v4u*)(kg + (size_t)tr * kpitch);
#pragma unroll
      for (int i = 0; i < NVP; ++i) vr[i] = *(const GAS v4u*)(vg + (size_t)(tr + 32 * i) * vpitch); }
    __syncthreads();
#pragma unroll 1
    for (int j = 0; j < ntiles; ++j) {
        const int cur = j & 1;
        const LAS unsigned char* Kb = Kb0 + cur * CK_SZ; const LAS unsigned char* Vb = Vb0 + cur * VSZ;
        const bool more = (j + 1 < ntiles);
        v4u kr2, vr2[NVP];
        { const int tr = tile_row(j + 2 < ntiles ? j + 2 : ntiles - 1); kr2 = *(const GAS v4u*)(kg + (size_t)tr * kpitch);
#pragma unroll
            for (int i = 0; i < NVP; ++i) vr2[i] = *(const GAS v4u*)(vg + (size_t)(tr + 32 * i) * vpitch); }
        if (use_tile(j)) {
            f32x16 st[2];
#pragma unroll
            for (int kb = 0; kb < 2; ++kb) {
#pragma unroll
                for (int r = 0; r < 16; ++r) st[kb][r] = 0.f;
#pragma unroll
                for (int ks = 0; ks < 4; ++ks) {
                    const bf16x8 kf = *(const LAS bf16x8*)(Kb + (kb * 32 + r32) * CK_PITCH + ks * 32 + hi * 16);
                    st[kb] = __builtin_amdgcn_mfma_f32_32x32x16_bf16(kf, qf[ks], st[kb], 0, 0, 0);
                }
            }
            elem(st, j);
            float mx = st[0][0];
#pragma unroll
            for (int r = 1; r < 16; ++r) mx = fmaxf(mx, st[0][r]);
#pragma unroll
            for (int r = 0; r < 16; ++r) mx = fmaxf(mx, st[1][r]);
            mx = xmax32(mx);
            if (__builtin_amdgcn_ballot_w64(mx > mrun + C_THR_RAW) != 0ull) {
                const float mn = fmaxf(mrun, mx);
                const float alpha = __builtin_amdgcn_exp2f((mrun - mn) * SCL2);
#pragma unroll
                for (int d = 0; d < NDV; ++d)
#pragma unroll
                    for (int r = 0; r < 16; ++r) o[d][r] *= alpha;
                lpart *= alpha; mrun = mn;
            }
            const float nmc = -mrun * SCL2;
            float ls = 0.f;
#pragma unroll
            for (int kb = 0; kb < 2; ++kb)
#pragma unroll
                for (int r = 0; r < 16; ++r) { const float p = __builtin_amdgcn_exp2f(fmaf(st[kb][r], SCL2, nmc)); st[kb][r] = p; ls += p; }
            lpart += ls;
            const int q4 = (lane & 15) >> 2, p4 = lane & 3, grp = (lane >> 4) & 1;
            const LAS unsigned char* vbase = Vb + (4 * hi + q4) * VP + (16 * grp + 4 * p4) * 2;
#pragma unroll
            for (int kb = 0; kb < 2; ++kb)
#pragma unroll
                for (int ss = 0; ss < 2; ++ss) {
                    v4u pw;
#pragma unroll
                    for (int i2 = 0; i2 < 4; ++i2) pw[i2] = cvtpk(st[kb][8 * ss + 2 * i2], st[kb][8 * ss + 2 * i2 + 1]);
                    const bf16x8 pb = __builtin_bit_cast(bf16x8, pw);
#pragma unroll
                    for (int d = 0; d < NDV; ++d) {
                        const LAS unsigned char* va = vbase + (kb * 32 + 16 * ss) * VP + d * 64;
                        const s16x4 lo = __builtin_bit_cast(s16x4, __builtin_amdgcn_ds_read_tr16_b64_v4i16((LAS s16x4*)va));
                        const s16x4 hh = __builtin_bit_cast(s16x4, __builtin_amdgcn_ds_read_tr16_b64_v4i16((LAS s16x4*)(va + 8 * VP)));
                        const bf16x8 vf = __builtin_shufflevector(lo, hh, 0, 1, 2, 3, 4, 5, 6, 7);
                        o[d] = __builtin_amdgcn_mfma_f32_32x32x16_bf16(vf, pb, o[d], 0, 0, 0);
                    }
                }
        }
        if (more) {
            LAS unsigned char* Kn = Kb0 + (cur ^ 1) * CK_SZ; LAS unsigned char* Vn = Vb0 + (cur ^ 1) * VSZ;
            *(LAS v4u*)(Kn + krow_s * CK_PITCH + kch_s * 16) = kr;
#pragma unroll
            for (int i = 0; i < NVP; ++i) *(LAS v4u*)(Vn + (vrow_s + 32 * i) * VP + vch_s * 16) = vr[i];
        }
        kr = kr2;
#pragma unroll
        for (int i = 0; i < NVP; ++i) vr[i] = vr2[i];
        __syncthreads();
    }
}
__device__ __forceinline__ void attn64_store(const f32x16 (&o)[2], float inv, bf16* yrow, int hi) {
#pragma unroll
    for (int d = 0; d < 2; ++d)
#pragma unroll
        for (int g4 = 0; g4 < 4; ++g4) {
            v2u w; w.x = cvtpk(o[d][4 * g4] * inv, o[d][4 * g4 + 1] * inv); w.y = cvtpk(o[d][4 * g4 + 2] * inv, o[d][4 * g4 + 3] * inv);
            *(GAS v2u*)(yrow + d * 32 + 8 * g4 + 4 * hi) = w;
        }
}

namespace pg8 {
typedef unsigned short bf16_t;
constexpr int BM = 256, BK = 64, HALF = 128, HTB = HALF * BK * 2, STAGE_BYTES = 8 * HTB, NXCD = 8, WGM = 8;
__host__ __device__ __forceinline__ int lds_byte(int r, int c) { const int st = (r >> 4) * 2 + (c >> 5), rr = r & 15, cc = c & 31, ob = rr * 64 + cc * 2; return st * 1024 + (ob ^ (((ob >> 9) & 1) << 5)); }
__host__ __device__ __forceinline__ void stage_rc(int b, int& R, int& C) { const int st = b / 1024, sb = b % 1024, swz = sb ^ (((sb >> 9) & 1) << 5); R = (st >> 1) * 16 + swz / 64; C = (st & 1) * 32 + (swz % 64) / 2; }
__host__ __device__ __forceinline__ int perm32(int rho) { const int n = rho >> 4, i = rho & 15; return 8 * (i >> 2) + 4 * n + (i & 3); }
struct Unit { int pm, pn, seg; };
struct Gemm { const bf16_t* A; const bf16_t* Bt; int lda, ldb, K; size_t a_seg, b_seg; };
struct TileOrder {
    int nM, nN, nwg, G, c;
    __device__ void init(int M, int N, int G_, int c_) { nM = M / BM; nN = N / BM; nwg = nM * nN; G = G_; c = c_; }
    __device__ bool tile(int i, int& pm, int& pn) const {
        const long L = (long)i * G + c; if (L >= nwg) return false;
        int wgid = (int)L; { const int q = nwg / NXCD, r = nwg % NXCD, xcd = wgid % NXCD, off = wgid / NXCD; wgid = (xcd < r ? xcd * (q + 1) : r * (q + 1) + (xcd - r) * q) + off; }
        const int nig = WGM * nN, gid = wgid / nig, fm = gid * WGM, gsz = (nM - fm) < WGM ? (nM - fm) : WGM;
        pm = fm + ((wgid % nig) % gsz); pn = (wgid % nig) / gsz; return true;
    }
};
template <int NSEG> struct SegOrder {
    TileOrder T;
    __device__ bool next(int i, Unit& u) const { u.seg = i % NSEG; return T.tile(i / NSEG, u.pm, u.pn); }
};
template <class Epi, class Sched>
__device__ __forceinline__ void gemm_phase(LAS unsigned char* lds, const Gemm g, const Sched& S, const Epi& E, int wid) {
    const int lane = lane_id_v(), tid = wid * 64 + lane,
              wr = wid >> 2, wc = wid & 3, fr = lane & 15, fq = lane >> 4;
    const int K = g.K, nt = K / BK;
    unsigned voffA[2], voffB[2];
#pragma unroll
    for (int i = 0; i < 2; ++i) { int R, C; stage_rc(tid * 16 + i * 8192, R, C); const int Rb = (R & ~31) + perm32(R & 31);
        voffA[i] = (unsigned)(R * g.lda + C) * 2u; voffB[i] = (unsigned)(Rb * g.ldb + C) * 2u; }
    const size_t kstep = (size_t)(BK * 2);
    const size_t hstepA = (size_t)HALF * g.lda * 2, hstepB = (size_t)HALF * g.ldb * 2;
    const unsigned ldsw = (unsigned)wid * 1024u;
    const int aoff = lds_byte(wr * 64 + fr, fq * 8), boff = lds_byte(wc * 32 + fr, fq * 8);
#define PG8_SA(b, h) (((b) * 2 + (h)) * HTB)
#define PG8_SB(b, h) ((4 + (b) * 2 + (h)) * HTB)
#define PG8_STAGE(bufoff, gbase, voff) do { _Pragma("unroll") for (int _i = 0; _i < 2; ++_i) \
        __builtin_amdgcn_global_load_lds((const unsigned*)((const char*)(gbase) + (voff)[_i]), (LAS unsigned*)(lds + (bufoff) + ldsw + _i * 8192), 16, 0, 0); } while (0)
#define PG8_LDA(dst, b, h) do { _Pragma("unroll") for (int m = 0; m < 4; ++m) _Pragma("unroll") for (int k = 0; k < 2; ++k) dst[m][k] = *(const LAS bf16x8*)(lds + PG8_SA(b, h) + aoff + m * 2048 + k * 1024); } while (0)
#define PG8_LDB(dst, b, h) do { _Pragma("unroll") for (int n = 0; n < 2; ++n) _Pragma("unroll") for (int k = 0; k < 2; ++k) dst[n][k] = *(const LAS bf16x8*)(lds + PG8_SB(b, h) + boff + n * 2048 + k * 1024); } while (0)
#define PG8_MMA(ai, bj, At, Bt) do { __builtin_amdgcn_s_setprio(1); _Pragma("unroll") for (int m = 0; m < 4; ++m) _Pragma("unroll") for (int n = 0; n < 2; ++n) _Pragma("unroll") for (int k = 0; k < 2; ++k) \
        acc[ai][bj][m][n] = __builtin_amdgcn_mfma_f32_16x16x32_bf16(Bt[n][k], At[m][k], acc[ai][bj][m][n], 0, 0, 0); __builtin_amdgcn_s_setprio(0); } while (0)
#define PG8_WAIT_V(n) asm volatile("s_waitcnt vmcnt(" #n ")" ::: "memory")
#define PG8_WAIT_L(n) asm volatile("s_waitcnt lgkmcnt(" #n ")" ::: "memory")
#define PG8_BAR __builtin_amdgcn_s_barrier()
#define PG8_SCHED __builtin_amdgcn_sched_barrier(0)
#define PG8_ABASE(u) ((const char*)g.A + ((size_t)(u).seg * g.a_seg + (size_t)(u).pm * BM * g.lda) * 2)
#define PG8_BBASE(u) ((const char*)g.Bt + ((size_t)(u).seg * g.b_seg + (size_t)(u).pn * BM * g.ldb) * 2)
    Unit cur, nxt; int ui = 0;
    if (!S.next(0, cur)) return;
    f32x4 acc[2][2][4][2];
#pragma unroll
    for (int a = 0; a < 2; ++a)
#pragma unroll
        for (int b = 0; b < 2; ++b)
#pragma unroll
            for (int m = 0; m < 4; ++m)
#pragma unroll
                for (int n = 0; n < 2; ++n) acc[a][b][m][n] = (f32x4){0.f, 0.f, 0.f, 0.f};
    bf16x8 At[4][2], B0[2][2], B1[2][2];
    const char* cA = PG8_ABASE(cur); const char* cB = PG8_BBASE(cur);
    PG8_STAGE(PG8_SB(0, 0), cB, voffB); PG8_STAGE(PG8_SB(0, 1), cB + hstepB, voffB); PG8_STAGE(PG8_SA(0, 0), cA, voffA); PG8_STAGE(PG8_SA(0, 1), cA + hstepA, voffA);
    if (wr == 1) PG8_BAR;
    PG8_WAIT_V(2); PG8_BAR;
    PG8_STAGE(PG8_SB(1, 0), cB + kstep, voffB); PG8_STAGE(PG8_SA(1, 0), cA + kstep, voffA); PG8_STAGE(PG8_SB(1, 1), cB + hstepB + kstep, voffB);
    PG8_WAIT_V(6); PG8_BAR;
    for (;;) {
        const bool has_next = S.next(ui + 1, nxt);
        const char* nA = has_next ? PG8_ABASE(nxt) : cA; const char* nB = has_next ? PG8_BBASE(nxt) : cB;
        for (int t = 0; t < nt; t += 2) {
            const bool lastk = (t == nt - 2);
            const char* a1 = cA + (size_t)(t + 1) * kstep;
            const char* a2 = lastk ? nA : cA + (size_t)(t + 2) * kstep; const char* b2 = lastk ? nB : cB + (size_t)(t + 2) * kstep;
            const char* a3 = a2 + kstep; const char* b3 = b2 + kstep;
            PG8_LDB(B0, 0, 0); PG8_LDB(B1, 0, 1); PG8_SCHED; PG8_LDA(At, 0, 0); PG8_STAGE(PG8_SA(1, 1), a1 + hstepA, voffA);
            PG8_WAIT_V(8); PG8_WAIT_L(0); PG8_BAR; PG8_MMA(0, 0, At, B0); PG8_MMA(0, 1, At, B1); PG8_BAR; PG8_SCHED;
            PG8_LDA(At, 0, 1); PG8_STAGE(PG8_SB(0, 0), b2, voffB); PG8_STAGE(PG8_SB(0, 1), b2 + hstepB, voffB); PG8_STAGE(PG8_SA(0, 0), a2, voffA);
            PG8_WAIT_V(8); PG8_WAIT_L(0); PG8_BAR; PG8_MMA(1, 0, At, B0); PG8_MMA(1, 1, At, B1); PG8_BAR; PG8_SCHED;
            PG8_LDB(B0, 1, 0); PG8_LDB(B1, 1, 1); PG8_SCHED; PG8_LDA(At, 1, 0); PG8_STAGE(PG8_SA(0, 1), a2 + hstepA, voffA);
            PG8_WAIT_V(8); PG8_WAIT_L(0); PG8_BAR; PG8_MMA(0, 0, At, B0); PG8_MMA(0, 1, At, B1); PG8_BAR; PG8_SCHED;
            PG8_LDA(At, 1, 1); PG8_STAGE(PG8_SB(1, 0), b3, voffB); PG8_STAGE(PG8_SB(1, 1), b3 + hstepB, voffB); PG8_STAGE(PG8_SA(1, 0), a3, voffA);
            PG8_WAIT_V(8); PG8_WAIT_L(0); PG8_BAR; PG8_MMA(1, 0, At, B0); PG8_MMA(1, 1, At, B1); PG8_BAR; PG8_SCHED;
        }
        if (wr == 0) PG8_BAR;
        E(acc, cur, wr, wc, fr, fq);
        if (!has_next) break;
#pragma unroll
        for (int a = 0; a < 2; ++a)
#pragma unroll
            for (int b = 0; b < 2; ++b)
#pragma unroll
                for (int m = 0; m < 4; ++m)
#pragma unroll
                    for (int n = 0; n < 2; ++n) acc[a][b][m][n] = (f32x4){0.f, 0.f, 0.f, 0.f};
        cur = nxt; cA = nA; cB = nB; ++ui;
        if (wr == 1) PG8_BAR;
    }
    PG8_WAIT_V(0);
    PG8_BAR;
#undef PG8_SA
#undef PG8_SB
#undef PG8_STAGE
#undef PG8_LDA
#undef PG8_LDB
#undef PG8_MMA
#undef PG8_WAIT_V
#undef PG8_WAIT_L
#undef PG8_BAR
#undef PG8_SCHED
#undef PG8_ABASE
#undef PG8_BBASE
}
}

__device__ __forceinline__ v4u pack8(const f32x4& a, const f32x4& b) { v4u w; w.x = cvtpk(a.x, a.y); w.y = cvtpk(a.z, a.w); w.z = cvtpk(b.x, b.y); w.w = cvtpk(b.z, b.w); return w; }
struct EpiInProj {
    bf16 *AQ, *AK, *AVT, *BQ, *BK, *BVT, *CQ, *CK, *CV, *SG; const float *COS, *SIN;
    __device__ __forceinline__ void operator()(const f32x4 (&acc)[2][2][4][2], const pg8::Unit& u, int wr, int wc, int fr, int fq) const {
        asm volatile("" : "+v"(fr), "+v"(fq));
#pragma unroll
        for (int bj = 0; bj < 2; ++bj) {
            const int cblk = u.pn * 256 + bj * 128;
            const int cw = wc * 32 + 8 * fq;
            bf16* dst; int pitch, cbase; int kind;
            int nh = 1, hd = 0; float qs = 1.0f;
            if (cblk < 512)       { dst = AQ; pitch = 512; cbase = cblk; kind = 1; }
            else if (cblk < 640)  { dst = AK; pitch = 128; cbase = cblk - 512; kind = 1; }
            else if (cblk < 768)  { dst = AVT; pitch = 128; cbase = cblk - 640; kind = 0; }
            else if (cblk < 1280) { dst = BQ; pitch = 512; cbase = cblk - 768; kind = 0; }
            else if (cblk < 1792) { dst = BK; pitch = 512; cbase = cblk - 1280; kind = 0; }
            else if (cblk < 2304) { dst = BVT; pitch = 512; cbase = cblk - 1792; kind = 0; }
            else if (cblk < 2816) { dst = CQ; pitch = 512; cbase = cblk - 2304; kind = 1; qs = SCL2; }
            else if (cblk < 3328) { dst = CK; pitch = 512; cbase = cblk - 2816; kind = 1; }
            else if (cblk < 3840) { dst = CV; pitch = 512; cbase = cblk - 3328; kind = 0; }
            else                  { dst = SG; pitch = 3072; cbase = cblk - 3840; kind = 3; }
#pragma unroll
            for (int ai = 0; ai < 2; ++ai)
#pragma unroll
                for (int m = 0; m < 4; ++m) {
                    const int row = u.pm * 256 + ai * 128 + wr * 64 + m * 16 + fr;
                    f32x4 v0 = acc[ai][bj][m][0], v1 = acc[ai][bj][m][1];
                    if (kind == 1) {
                        if (row < T_LAT) {
                            const int t = row & (SEQ - 1), i0 = (cw & 63) >> 1;
                            const f32x4 cs = *(const GAS f32x4*)(COS + t * 32 + i0), sn = *(const GAS f32x4*)(SIN + t * 32 + i0);
                            const f32x4 a = v0, b = v1;
                            v0.x = a.x * cs.x - a.y * sn.x; v0.y = a.y * cs.x + a.x * sn.x; v0.z = a.z * cs.y - a.w * sn.y; v0.w = a.w * cs.y + a.z * sn.y;
                            v1.x = b.x * cs.z - b.y * sn.z; v1.y = b.y * cs.z + b.x * sn.z; v1.z = b.z * cs.w - b.w * sn.w; v1.w = b.w * cs.w + b.z * sn.w;
                        }
                        *(GAS v4u*)(dst + (size_t)row * pitch + cbase + cw) = pack8(v0 * qs, v1 * qs);
                    } else if (kind == 0) {
                        *(GAS v4u*)(dst + (size_t)row * pitch + cbase + cw) = pack8(v0, v1);
                    } else if (kind == 3) {
                        v0.x = sigmoid_fast(v0.x); v0.y = sigmoid_fast(v0.y); v0.z = sigmoid_fast(v0.z); v0.w = sigmoid_fast(v0.w);
                        v1.x = sigmoid_fast(v1.x); v1.y = sigmoid_fast(v1.y); v1.z = sigmoid_fast(v1.z); v1.w = sigmoid_fast(v1.w);
                        *(GAS v4u*)(dst + (size_t)row * pitch + cbase + cw) = pack8(v0, v1);
                    } else {
                        const int hc = hd + cw, head = hc >> 6, d = hc & 63;
                        const int b = row_batch(row), tok = row_tok(row);
                        bf16* vp = dst + ((size_t)(b * nh + head) * 64 + d) * NTOK + tok;
                        vp[0 * NTOK] = (bf16)f2bf(v0.x); vp[1 * NTOK] = (bf16)f2bf(v0.y); vp[2 * NTOK] = (bf16)f2bf(v0.z); vp[3 * NTOK] = (bf16)f2bf(v0.w);
                        vp[4 * NTOK] = (bf16)f2bf(v1.x); vp[5 * NTOK] = (bf16)f2bf(v1.y); vp[6 * NTOK] = (bf16)f2bf(v1.z); vp[7 * NTOK] = (bf16)f2bf(v1.w);
                    }
                }
        }
    }
};
__device__ __forceinline__ void unpack8(const v4u& w, f32x4& a, f32x4& b) {
    a = (f32x4){bf2f(w.x & 0xffffu), bf2f(w.x >> 16), bf2f(w.y & 0xffffu), bf2f(w.y >> 16)}; b = (f32x4){bf2f(w.z & 0xffffu), bf2f(w.z >> 16), bf2f(w.w & 0xffffu), bf2f(w.w >> 16)};
}
struct EpiBranch {
    const bf16* SG; bf16* MG;
    __device__ __forceinline__ void operator()(const f32x4 (&acc)[2][2][4][2], const pg8::Unit& u, int wr, int wc, int fr, int fq) const {
        asm volatile("" : "+v"(fr), "+v"(fq));
#pragma unroll
        for (int ai = 0; ai < 2; ++ai)
#pragma unroll
            for (int m = 0; m < 4; ++m) {
                const int row = u.pm * 256 + ai * 128 + wr * 64 + m * 16 + fr;
#pragma unroll
                for (int bj = 0; bj < 2; ++bj) {
                    const int col = u.pn * 256 + bj * 128 + wc * 32 + 8 * fq;
                    f32x4 g0, g1; { const v4u wg = *(const GAS v4u*)(SG + (size_t)row * 3072 + u.seg * 1024 + col); unpack8(wg, g0, g1); }
                    f32x4 v0 = g0 * acc[ai][bj][m][0], v1 = g1 * acc[ai][bj][m][1];
                    bf16* mp = MG + (size_t)row * D + col;
                    if (u.seg > 0) { f32x4 p0, p1; const v4u wp = *(const GAS v4u*)mp; unpack8(wp, p0, p1); v0 += p0; v1 += p1; }
                    *(GAS v4u*)mp = pack8(v0, v1);
                }
            }
    }
};
struct EpiOut {
    float* X; const float* gtl; const float* xin; const float* cin;
    __device__ __forceinline__ void operator()(const f32x4 (&acc)[2][2][4][2], const pg8::Unit& u, int wr, int wc, int fr, int fq) const {
        asm volatile("" : "+v"(fr), "+v"(fq));
#pragma unroll
        for (int ai = 0; ai < 2; ++ai)
#pragma unroll
            for (int m = 0; m < 4; ++m) {
                const int row = u.pm * 256 + ai * 128 + wr * 64 + m * 16 + fr;
                const float* gt = gtl + (size_t)row_modidx(row) * 6 * D + 2 * D;
#pragma unroll
                for (int bj = 0; bj < 2; ++bj) {
                    const int col = u.pn * 256 + bj * 128 + wc * 32 + 8 * fq;
                    GAS f32x4* xp = (GAS f32x4*)(X + (size_t)row * D + col);
                    const GAS f32x4* sp = xin ? (const GAS f32x4*)(xin_row(xin, cin, row) + col) : (const GAS f32x4*)xp;
                    const f32x4 g0 = *(const GAS f32x4*)(gt + col), g1 = *(const GAS f32x4*)(gt + col + 4);
                    xp[0] = sp[0] + g0 * acc[ai][bj][m][0]; xp[1] = sp[1] + g1 * acc[ai][bj][m][1];
                }
            }
    }
};
struct EpiStore {
    bf16* O; int ldc;
    __device__ __forceinline__ void operator()(const f32x4 (&acc)[2][2][4][2], const pg8::Unit& u, int wr, int wc, int fr, int fq) const {
        asm volatile("" : "+v"(fr), "+v"(fq));
#pragma unroll
        for (int ai = 0; ai < 2; ++ai)
#pragma unroll
            for (int m = 0; m < 4; ++m) {
                const int row = u.pm * 256 + ai * 128 + wr * 64 + m * 16 + fr;
#pragma unroll
                for (int bj = 0; bj < 2; ++bj) {
                    const int col = u.pn * 256 + bj * 128 + wc * 32 + 8 * fq;
                    *(GAS v4u*)(O + (size_t)row * ldc + col) = pack8(acc[ai][bj][m][0], acc[ai][bj][m][1]);
                }
            }
    }
};

__global__ void __launch_bounds__(NTHREADS, 2) mega_fwd(Args args) {
    extern __shared__ __attribute__((aligned(16))) unsigned char lds[];
    LAS unsigned char* L = (LAS unsigned char*)lds;
    volatile LAS unsigned* MISC = (volatile LAS unsigned*)(L + MISC_OFF);
    const int wave = __builtin_amdgcn_readfirstlane((int)threadIdx.x >> 6);
    const int lane = lane_id_v(), tid = wave * 64 + lane;
    const int fr = lane & 15, fq = lane >> 4;
    const int G = gridDim.x;
    const int vcu = (G % 8 == 0) ? (int)(blockIdx.x % 8) * (G / 8) + (int)(blockIdx.x / 8) : (int)blockIdx.x;
    for (int u = tid; u < (LDS_BYTES - 131072) / 4; u += NTHREADS) ((LAS unsigned*)(L + 131072))[u] = 0u;
    __syncthreads();
    unsigned char* ws = args.ws;
    gu32* ctl = (gu32*)(ws + WS_CTL);
    (void)xcd_barrier_post((unsigned*)(ctl + CW_BAR), MISC + 8);
    if (tid == 0) MISC[12] = xb_add((unsigned*)(ctl + CW_RANK) + 64 * xb_xcc_id(), 1u);
    __syncthreads();
#define GRID_BAR() do { unsigned* bp_ = (unsigned*)(args.ws + WS_CTL) + CW_BAR; asm volatile("" : "+s"(bp_)); XcdBarrier b_; b_.bar = bp_; b_.x = xb_xcc_id(); b_.st = MISC + 8; xcd_barrier(b_, wave == 0 && lane_id_v() == 0); } while (0)
    const int gw = vcu * NWAVES + wave, NGW = G * NWAVES;
    const int NGT = G * NTHREADS;

#define PHASE_PTRS \
    unsigned char* wsq = args.ws; asm volatile("" : "+s"(wsq)); \
    const float* const* IN_ = (const float* const*)__builtin_amdgcn_kernarg_segment_ptr(); asm volatile("" : "+s"(IN_)); \
    float* MODV = (float*)(wsq + WS_MOD); float* COS = (float*)(wsq + WS_COS); float* SIN = (float*)(wsq + WS_SIN); \
    bf16* WIN = (bf16*)(wsq + WS_WIN); bf16* WB = (bf16*)(wsq + WS_WB); bf16* WO = (bf16*)(wsq + WS_WO); bf16* WQ = (bf16*)(wsq + WS_WQ); bf16* KEYS = (bf16*)(wsq + WS_KEYS); \
    float* X = (float*)(wsq + WS_X); bf16* H = (bf16*)(wsq + WS_H); bf16* Y = (bf16*)(wsq + WS_Y); bf16* MG = (bf16*)(wsq + WS_MG); \
    unsigned* EI = (unsigned*)(wsq + WS_EI); float* EG = (float*)(wsq + WS_EG); \
    unsigned char* U8 = wsq + WS_U8; unsigned char* V8 = wsq + WS_V8; float* SCU = (float*)(wsq + WS_SCU); float* SCV = SCU + DEPTH * 16384; \
    bf16* AQ = (bf16*)(wsq + WS_AQ); bf16* AK = (bf16*)(wsq + WS_AK); bf16* AVT = (bf16*)(wsq + WS_AVT); \
    bf16* BQ = (bf16*)(wsq + WS_BQ); bf16* BK = (bf16*)(wsq + WS_BK); bf16* BVT = (bf16*)(wsq + WS_BVT); \
    bf16* CQ = (bf16*)(wsq + WS_CQ); bf16* CK = (bf16*)(wsq + WS_CK); bf16* CVT = (bf16*)(wsq + WS_CVT); \
    bf16* SG = (bf16*)(wsq + WS_SG); bf16* Q2 = (bf16*)(wsq + WS_Q2); float* SC = (float*)(wsq + WS_SC); \
    (void)MODV; (void)COS; (void)SIN; (void)WIN; (void)WB; (void)WO; (void)WQ; (void)KEYS; (void)X; (void)H; (void)Y; (void)MG; (void)EI; (void)EG; (void)U8; (void)V8; (void)SCU; (void)SCV; \
    (void)AQ; (void)AK; (void)AVT; (void)BQ; (void)BK; (void)BVT; (void)CQ; (void)CK; (void)CVT; (void)SG; (void)Q2; (void)SC; (void)IN_;
#define LAYER_PTRS const float* modl = MODV + (size_t)layer * 3 * 6 * D; const bf16* WINl = WIN + (size_t)layer * IN_W * D; (void)modl; (void)WINl;

#ifndef SKIP_P0
        { PHASE_PTRS
        for (int rep_ = 0; rep_ < REP_P0; ++rep_) {
    {
        LAS float* scr = (LAS float*)(L + wave * 16384);
        int gt = vcu * NTHREADS + tid; asm volatile("" : "+v"(gt));
        constexpr int I_IN = (D / 64) * (IN_W / 32), I_BR = (512 / 64) * (D / 32), I_O = (D / 64) * (D / 32), I_Q = (D / 64) * (2048 / 32);
        constexpr int PER_LAYER = I_IN + 3 * I_BR + I_O + I_Q;
        for (int rp_ = 0; rp_ < REP_P0A; ++rp_)
        for (int it = gw; it < DEPTH * PER_LAYER; it += NGW) {
            const int l = it / PER_LAYER; int r = it % PER_LAYER;
            if (r < I_IN) { p0_transpose_item<true>(IN_[I_WIN] + (size_t)l * D * IN_W, D, IN_W, WIN + (size_t)l * IN_W * D, scr, r, lane); continue; } r -= I_IN;
            if (r < I_BR) { p0_transpose_item(IN_[I_WBA] + (size_t)l * 512 * D, 512, D, WB + (size_t)(l * 3 + 0) * D * 512, scr, r, lane); continue; } r -= I_BR;
            if (r < I_BR) { p0_transpose_item(IN_[I_WBB] + (size_t)l * 512 * D, 512, D, WB + (size_t)(l * 3 + 1) * D * 512, scr, r, lane); continue; } r -= I_BR;
            if (r < I_BR) { p0_transpose_item(IN_[I_WBC] + (size_t)l * 512 * D, 512, D, WB + (size_t)(l * 3 + 2) * D * 512, scr, r, lane); continue; } r -= I_BR;
            if (r < I_O) { p0_transpose_item(IN_[I_WOUT] + (size_t)l * D * D, D, D, WO + (size_t)l * D * D, scr, r, lane); continue; } r -= I_O;
            p0_transpose_item(IN_[I_PWQ] + (size_t)l * D * 2048, D, 2048, WQ + (size_t)l * 2048 * D, scr, r, lane);
        }
        for (int i = gt; i < DEPTH * 16 * 128 * 128 / 4; i += NGT) {
            const f32x4 v = *((const GAS f32x4*)IN_[I_PKEYS] + i);
            v2u o; o.x = pk2(v.x, v.y); o.y = pk2(v.z, v.w); *((GAS v2u*)KEYS + i) = o;
        }
        {
            LAS float* red = (LAS float*)(L + 9216);
            for (int rp_ = 0; rp_ < REP_P0D; ++rp_)
            for (int it = vcu; it < DEPTH * 96; it += G) {
                const int l = it / 96, nc = it % 96, n = nc * 64 + lane;
                const float* wm = IN_[I_WMOD] + (size_t)l * D * 6 * D + n;
                float a0 = 0.f, a1 = 0.f, a2 = 0.f;
#pragma unroll 1
                for (int half = 0; half < 2; ++half) {
                    const int kb = wave * 128 + half * 64;
                    const float c0 = IN_[I_C][kb + lane], c1 = IN_[I_C][D + kb + lane], c2 = IN_[I_CCTX][kb + lane];
                    const int s0 = __builtin_bit_cast(int, c0 * sigmoidf_(c0)), s1 = __builtin_bit_cast(int, c1 * sigmoidf_(c1)), s2 = __builtin_bit_cast(int, c2 * sigmoidf_(c2));
#pragma unroll
                    for (int kk = 0; kk < 64; ++kk) {
                        const float w = wm[(size_t)(kb + kk) * 6 * D];
                        a0 += __builtin_bit_cast(float, __builtin_amdgcn_readlane(s0, kk)) * w;
                        a1 += __builtin_bit_cast(float, __builtin_amdgcn_readlane(s1, kk)) * w;
                        a2 += __builtin_bit_cast(float, __builtin_amdgcn_readlane(s2, kk)) * w;
                    }
                }
                red[(wave * 3 + 0) * 64 + lane] = a0; red[(wave * 3 + 1) * 64 + lane] = a1; red[(wave * 3 + 2) * 64 + lane] = a2;
                __syncthreads();
                if (wave < 3) {
                    float sum = IN_[I_BMOD][l * 6 * D + n];
#pragma unroll
                    for (int w = 0; w < 8; ++w) sum += red[(w * 3 + wave) * 64 + lane];
                    MODV[(size_t)(l * 3 + wave) * 6 * D + n] = sum;
                }
                __syncthreads();
            }
        }
        for (int i = gt; i < SEQ * 32; i += NGT) {
            const int t = i >> 5, f = i & 31;
            const float inv = exp2f(-(float)(f & 15) * (13.287712379549449f / 16.0f));
            const float pos = (f < 16) ? (float)(t / GRID_W) : (float)(t % GRID_W);
            float sn, cs; sincosf(pos * inv, &sn, &cs);
            COS[i] = cs; SIN[i] = sn;
        }
    }
        for (int rp_ = 0; rp_ < REP_P0F; ++rp_)
#pragma unroll 4
        for (int rr = gw; rr < 2 * DEPTH * 16384; rr += NGW) {
            const int tab = rr / (DEPTH * 16384), row = rr % (DEPTH * 16384);
            const float* src = (tab == 0 ? IN_[I_PU] : IN_[I_PV]) + (size_t)row * D;
            f32x4 v[4]; float am = 0.f;
#pragma unroll
            for (int j = 0; j < 4; ++j) { v[j] = *((const GAS f32x4*)src + lane + 64 * j); am = fmaxf(am, fmaxf(fmaxf(fabsf(v[j].x), fabsf(v[j].y)), fmaxf(fabsf(v[j].z), fabsf(v[j].w)))); }
            am = wave_max(am);
            const bool as_i8 = (P10_SLICED != 0) && (tab == 0);
            int ex = 0; float scale = 1.0f;
            if (am > 0.f) { (void)frexpf(am * (as_i8 ? (1.0f / 127.0f) : (1.0f / 448.0f)), &ex); scale = ldexpf(1.0f, ex); }
            const float inv = 1.0f / scale;
            v4u o;
#pragma unroll
            for (int j = 0; j < 4; ++j) {
                if (as_i8) {
                    const int q0 = __float2int_rn(v[j].x * inv), q1 = __float2int_rn(v[j].y * inv), q2 = __float2int_rn(v[j].z * inv), q3 = __float2int_rn(v[j].w * inv);
                    o[j] = (unsigned)(q0 & 255) | ((unsigned)(q1 & 255) << 8) | ((unsigned)(q2 & 255) << 16) | ((unsigned)q3 << 24);
                } else {
                    int p = __builtin_amdgcn_cvt_pk_fp8_f32(v[j].x * inv, v[j].y * inv, 0, false);
                    p = __builtin_amdgcn_cvt_pk_fp8_f32(v[j].z * inv, v[j].w * inv, p, true);
                    o[j] = (unsigned)p;
                }
            }
            *((GAS v4u*)((tab == 0 ? U8 : V8) + (size_t)row * D) + lane) = o;
            if (lane == 0) (tab == 0 ? SCU : SCV)[row] = scale;
        }
        }
        }
#endif
    GRID_BAR();

    for (int layer = 0; layer < DEPTH; ++layer) {
        const bool last = (layer == DEPTH - 1);
        const int T_EFF = last ? T_LAT : T_ALL;

#ifndef SKIP_P1
        { PHASE_PTRS LAYER_PTRS
        for (int rep_ = 0; rep_ < REP_P1; ++rep_) {
        { const int ln = lane_id_v();
        if (layer == 0) {
            f32x4 gm[4], shv[4];
            auto prep = [&](int midx) { const float* md = modl + (size_t)midx * 6 * D;
#pragma unroll
                for (int j = 0; j < 4; ++j) { const f32x4 g = *((const GAS f32x4*)(IN_[I_G1] + layer * D) + ln + 64 * j); const f32x4 sc = *((const GAS f32x4*)(md + D) + ln + 64 * j);
                    gm[j] = g * (sc + 1.0f); shv[j] = *((const GAS f32x4*)(md + 0) + ln + 64 * j); } };
            auto row = [&](int r) {
                const GAS f32x4* xr = (const GAS f32x4*)xin_row(IN_[I_X], IN_[I_CTX], r) + ln;
                f32x4 v[4]; float ss = 0.f;
#pragma unroll
                for (int j = 0; j < 4; ++j) { v[j] = xr[64 * j]; ss += (v[j].x * v[j].x + v[j].y * v[j].y) + (v[j].z * v[j].z + v[j].w * v[j].w); }
                const float rs = 1.0f / sqrtf(wave_sum(ss) * (1.f / D) + NORM_EPS);
                GAS v2u* o8 = (GAS v2u*)(H + (size_t)r * D) + ln;
#pragma unroll
                for (int j = 0; j < 4; ++j) { const f32x4 h = v[j] * rs * gm[j] + shv[j]; v2u o; o.x = pk2(h.x, h.y); o.y = pk2(h.z, h.w); o8[64 * j] = o; } };
            wave_row_blocks(T_ALL, gw, NGW, prep, row);
        }
        }
        }
        }
#endif
        if (layer == 0) GRID_BAR();

#ifndef SKIP_P2
        { PHASE_PTRS LAYER_PTRS
        for (int rep_ = 0; rep_ < REP_P2; ++rep_) {
        {
            pg8::Gemm g{H, WINl, D, D, D, 0, 0};
            pg8::SegOrder<1> S; S.T.init(T_ALL, IN_W, G, (int)blockIdx.x);
            EpiInProj E{AQ, AK, AVT, BQ, BK, BVT, CQ, CK, CVT, SG, COS, SIN};
            pg8::gemm_phase(L, g, S, E, wave);
        }
        }
        }
#endif
        GRID_BAR();

#ifndef SKIP_P3
        { PHASE_PTRS LAYER_PTRS
        {
            LAS bf16* Pl = (LAS bf16*)(L + wave * 8192);
            const float lam_init = 0.8f - 0.6f * expf(-0.3f * (float)layer);
            float lam;
            {
                const int ll = lane_id_v();
                const float* cl = IN_[I_LAMBDA] + layer * 256;
                const float s1 = wave_sum(cl[ll] * cl[64 + ll]), s2 = wave_sum(cl[128 + ll] * cl[192 + ll]);
                lam = expf(s1) - expf(s2) + lam_init;
            }
{ const int lo__ = lane_id_v(); { const int lane = lo__; const int fr = lane & 15, fq = lane >> 4, tid = wave * 64 + lane; (void)fr; (void)fq; (void)tid;
            {
                const int r32 = lane & 31, hi = lane >> 5;
                const int n_lat = BATCH * 4 * (SEQ / 256), n_ctx = last ? 0 : BATCH * 4;
                const int NU = (n_lat + G - 1) / G * G + n_ctx;
                for (int rep_ = 0; rep_ < REP_P3C; ++rep_)
                for (int u0 = vcu; u0 < NU; u0 += G) {
                    int b, h, row0, t_lo, t_hi;
                    if (u0 < n_lat) { const int bh = u0 >> 5; b = bh >> 2; h = bh & 3; row0 = b * SEQ + (u0 & 31) * 256; t_lo = 0; t_hi = 132; }
                    else { const int c = u0 - (n_lat + G - 1) / G * G; if (c < 0 || c >= n_ctx) continue; b = c >> 2; h = c & 3; row0 = T_LAT + b * CTX; t_lo = 128; t_hi = 132; }
                    const int qrow = row0 + wave * 32 + r32;
                    LAS unsigned* o1p = (LAS unsigned*)(L + 65536 + wave * 8192) + lane;
                    const int krow_s = tid >> 3, kch_s = tid & 7;
                    const int vrow_s0 = tid >> 4, vch_s = tid & 15;
                    LAS unsigned char* Kb0 = L; LAS unsigned char* Vb0 = L + 2 * CK_SZ;
#pragma unroll 1
                    for (int m = 0; m < 2; ++m) {
                        bf16x8 qf[4];
                        { const bf16* qp = CQ + (size_t)qrow * 512 + (h * 2 + m) * 64 + hi * 8;
#pragma unroll
                          for (int ks = 0; ks < 4; ++ks) qf[ks] = *(const GAS bf16x8*)(qp + ks * 16); }
                        f32x16 o[4];
#pragma unroll
                        for (int d = 0; d < 4; ++d)
#pragma unroll
                            for (int r = 0; r < 16; ++r) o[d][r] = 0.f;
                        float lpart;
                        f32x16 cb;
                        v4u pp[4];
                        const bf16* kg = CK + (size_t)krow_s * 512 + (h * 2 + m) * 64 + kch_s * 8;
                        const bf16* vg = CVT + (size_t)vrow_s0 * 512 + h * 128 + vch_s * 8;
                        auto tile_row = [&](int j) { return (j < 128) ? b * SEQ + 64 * j : T_LAT + b * CTX + 64 * (j - 128); };
                        __syncthreads();
                        {
                            const size_t kb = (size_t)tile_row(t_lo) * 512;
                            const v4u kr = *(const GAS v4u*)(kg + kb), v0 = *(const GAS v4u*)(vg + kb), v1 = *(const GAS v4u*)(vg + kb + 32 * 512);
                            *(LAS v4u*)(Kb0 + krow_s * CK_PITCH + kch_s * 16) = kr;
                            *(LAS v4u*)(Vb0 + vrow_s0 * CV_PITCH + vch_s * 16) = v0; *(LAS v4u*)(Vb0 + (vrow_s0 + 32) * CV_PITCH + vch_s * 16) = v1;
                        }
                        __syncthreads();
                        v4u kr, v0, v1;
                        { const size_t kb = (size_t)tile_row(t_lo + 2) * 512, vb = (size_t)tile_row(t_lo + 1) * 512;
                          kr = *(const GAS v4u*)(kg + kb); v0 = *(const GAS v4u*)(vg + vb); v1 = *(const GAS v4u*)(vg + vb + 32 * 512); }
                        {
                            const v4u kr1 = *(const GAS v4u*)(kg + (size_t)tile_row(t_lo + 1) * 512);
                            f32x16 st[2];
#pragma unroll
                            for (int kb = 0; kb < 2; ++kb) {
#pragma unroll
                                for (int r = 0; r < 16; ++r) st[kb][r] = 0.f;
#pragma unroll
                                for (int ks = 0; ks < 4; ++ks) {
                                    const bf16x8 kf = *(const LAS bf16x8*)(Kb0 + (kb * 32 + r32) * CK_PITCH + ks * 32 + hi * 16);
                                    st[kb] = __builtin_amdgcn_mfma_f32_32x32x16_bf16(kf, qf[ks], st[kb], 0, 0, 0);
                                }
                            }
                            float mx = st[0][0];
#pragma unroll
                            for (int r = 1; r < 16; ++r) mx = fmaxf(mx, st[0][r]);
#pragma unroll
                            for (int r = 0; r < 16; ++r) mx = fmaxf(mx, st[1][r]);
                            mx = xmax32(mx);
#pragma unroll
                            for (int r = 0; r < 16; ++r) cb[r] = -mx;
                            float ls0 = 0.f, ls1 = 0.f;
#pragma unroll
                            for (int ks = 0; ks < 4; ++ks)
#pragma unroll
                                for (int i2 = 0; i2 < 4; ++i2) {
                                    const float p0 = __builtin_amdgcn_exp2f(st[ks >> 1][8 * (ks & 1) + 2 * i2] - mx), p1 = __builtin_amdgcn_exp2f(st[ks >> 1][8 * (ks & 1) + 2 * i2 + 1] - mx);
                                    ls0 += p0; ls1 += p1; pp[ks][i2] = cvtpk(p0, p1);
                                }
                            lpart = ls0 + ls1;
                            *(LAS v4u*)(Kb0 + CK_SZ + krow_s * CK_PITCH + kch_s * 16) = kr1;
                            __syncthreads();
                        }
                        const int q4 = (lane & 15) >> 2, p4 = lane & 3, grp = (lane >> 4) & 1;
                        const int voff = (4 * hi + q4) * CV_PITCH + (16 * grp + 4 * p4) * 2;
#pragma unroll 1
                        for (int j = t_lo + 1; j < t_hi; ++j) {
                            const int cur = (j - t_lo) & 1;
                            const LAS unsigned char* Kb = Kb0 + cur * CK_SZ; const LAS unsigned char* vbase = Vb0 + (cur ^ 1) * CV_SZ + voff;
                            const bool more = (j + 1 < t_hi);
                            auto vfrag = [&](int i) -> bf16x8 {
                                const LAS unsigned char* va = vbase + (i >> 2) * 16 * CV_PITCH + (i & 3) * 64;
                                const s16x4 lo = __builtin_bit_cast(s16x4, __builtin_amdgcn_ds_read_tr16_b64_v4i16((LAS s16x4*)va));
                                const s16x4 hh = __builtin_bit_cast(s16x4, __builtin_amdgcn_ds_read_tr16_b64_v4i16((LAS s16x4*)(va + 8 * CV_PITCH)));
                                return __builtin_shufflevector(lo, hh, 0, 1, 2, 3, 4, 5, 6, 7);
                            };
                            f32x16 st[2];
#pragma unroll
                            for (int kb = 0; kb < 2; ++kb) {
#pragma unroll
                                for (int ks = 0; ks < 4; ++ks) {
                                    const bf16x8 kf = *(const LAS bf16x8*)(Kb + (kb * 32 + r32) * CK_PITCH + ks * 32 + hi * 16);
                                    st[kb] = __builtin_amdgcn_mfma_f32_32x32x16_bf16(kf, qf[ks], ks == 0 ? cb : st[kb], 0, 0, 0);
                                }
                            }
                            bf16x8 vfr[3];
                            vfr[0] = vfrag(0); vfr[1] = vfrag(1); vfr[2] = vfrag(2);
                            float mx = st[0][0];
#pragma unroll
                            for (int r = 1; r < 16; ++r) mx = fmaxf(mx, st[0][r]);
#pragma unroll
                            for (int r = 0; r < 16; ++r) mx = fmaxf(mx, st[1][r]);
                            asm volatile("" : "+v"(mx));
                            __builtin_amdgcn_sched_barrier(0);
                            o[0] = __builtin_amdgcn_mfma_f32_32x32x16_bf16(vfr[0], __builtin_bit_cast(bf16x8, pp[0]), o[0], 0, 0, 0); vfr[0] = vfrag(3);
                            o[1] = __builtin_amdgcn_mfma_f32_32x32x16_bf16(vfr[1], __builtin_bit_cast(bf16x8, pp[0]), o[1], 0, 0, 0); vfr[1] = vfrag(4);
                            mx = xmax32(mx);
                            const bool grow = __builtin_amdgcn_ballot_w64(mx > 8.0f) != 0ull;
                            float alpha = 1.0f;
                            if (grow) {
                                const float dl = fmaxf(mx, 0.f);
#pragma unroll
                                for (int kb = 0; kb < 2; ++kb)
#pragma unroll
                                    for (int r = 0; r < 16; ++r) st[kb][r] -= dl;
#pragma unroll
                                for (int r = 0; r < 16; ++r) cb[r] -= dl;
                                alpha = __builtin_amdgcn_exp2f(-dl);
                            }
                            __builtin_amdgcn_sched_barrier(0);
                            float ls0 = 0.f, ls1 = 0.f;
#pragma unroll
                            for (int i = 0; i < 16; ++i) {
                                if (i >= 2) { o[i & 3] = __builtin_amdgcn_mfma_f32_32x32x16_bf16(vfr[i % 3], __builtin_bit_cast(bf16x8, pp[i >> 2]), o[i & 3], 0, 0, 0); if (i + 3 < 16) vfr[i % 3] = vfrag(i + 3); }
                                {
                                    const int kb = i >> 3, r = 2 * (i & 7);
                                    float p0 = __builtin_amdgcn_exp2f(st[kb][r]);
                                    ls0 += p0; asm volatile("" : "+v"(p0), "+v"(ls0));
                                    float p1 = __builtin_amdgcn_exp2f(st[kb][r + 1]);
                                    ls1 += p1; asm volatile("" : "+v"(p1), "+v"(ls1));
                                    st[kb][r] = p0; st[kb][r + 1] = p1;
                                }
                                if ((i & 3) == 3) {
                                    const int ks = i >> 2;
#pragma unroll
                                    for (int i2 = 0; i2 < 4; ++i2) pp[ks][i2] = cvtpk(st[ks >> 1][8 * (ks & 1) + 2 * i2], st[ks >> 1][8 * (ks & 1) + 2 * i2 + 1]);
                                    asm volatile("" : "+v"(pp[ks]));
                                }
                                if (i == 3) *(LAS v4u*)(Kb0 + (cur ^ 1) * CK_SZ + krow_s * CK_PITCH + kch_s * 16) = kr;
                                if (i == 5) *(LAS v4u*)(Vb0 + cur * CV_SZ + vrow_s0 * CV_PITCH + vch_s * 16) = v0;
                                if (i == 7) *(LAS v4u*)(Vb0 + cur * CV_SZ + (vrow_s0 + 32) * CV_PITCH + vch_s * 16) = v1;
                                if (i == 9) { const size_t kb = (size_t)tile_row(j + 2 < t_hi ? j + 2 : t_hi - 1) * 512, vb = (size_t)tile_row(more ? j + 1 : j) * 512;
                                              kr = *(const GAS v4u*)(kg + kb); v0 = *(const GAS v4u*)(vg + vb); v1 = *(const GAS v4u*)(vg + vb + 32 * 512); }
                                if (i >= 1) __builtin_amdgcn_sched_barrier(0);
                            }
                            if (grow) {
#pragma unroll
                                for (int d = 0; d < 4; ++d)
#pragma unroll
                                    for (int r = 0; r < 16; ++r) o[d][r] *= alpha;
                                lpart *= alpha;
                            }
                            lpart += ls0 + ls1;
                            __syncthreads();
                        }
                        {
                            const LAS unsigned char* vbase = Vb0 + ((t_hi - 1 - t_lo) & 1) * CV_SZ + voff;
#pragma unroll
                            for (int i = 0; i < 16; ++i) {
                                const LAS unsigned char* va = vbase + (i >> 2) * 16 * CV_PITCH + (i & 3) * 64;
                                const s16x4 lo = __builtin_bit_cast(s16x4, __builtin_amdgcn_ds_read_tr16_b64_v4i16((LAS s16x4*)va));
                                const s16x4 hh = __builtin_bit_cast(s16x4, __builtin_amdgcn_ds_read_tr16_b64_v4i16((LAS s16x4*)(va + 8 * CV_PITCH)));
                                const bf16x8 vf = __builtin_shufflevector(lo, hh, 0, 1, 2, 3, 4, 5, 6, 7);
                                o[i & 3] = __builtin_amdgcn_mfma_f32_32x32x16_bf16(vf, __builtin_bit_cast(bf16x8, pp[i >> 2]), o[i & 3], 0, 0, 0);
                                if ((i & 7) == 7) __builtin_amdgcn_sched_barrier(0);
                            }
                        }
                        const float lt = xadd32(lpart);
                        if (m == 0) {
                            const float inv = 1.0f / lt;
#pragma unroll
                            for (int d = 0; d < 4; ++d)
#pragma unroll
                                for (int i2 = 0; i2 < 8; ++i2) o1p[64 * (d * 8 + i2)] = cvtpk(o[d][2 * i2] * inv, o[d][2 * i2 + 1] * inv);
                        } else {
                            const float inv2 = lam / lt;
                            float ssq = 0.f;
#pragma unroll
                            for (int d = 0; d < 4; ++d)
#pragma unroll
                                for (int i2 = 0; i2 < 8; ++i2) {
                                    const unsigned w1 = o1p[64 * (d * 8 + i2)];
                                    const float a0 = bf2f(w1 & 0xffffu) - o[d][2 * i2] * inv2, a1 = bf2f(w1 >> 16) - o[d][2 * i2 + 1] * inv2;
                                    o[d][2 * i2] = a0; o[d][2 * i2 + 1] = a1; ssq += a0 * a0 + a1 * a1;
                                }
                            ssq = xadd32(ssq);
                            const float rn = 1.0f / sqrtf(ssq * (1.f / 128.f) + NORM_EPS) * (1.0f - lam_init);
                            bf16* yp = Y + (size_t)qrow * 1536 + 1024 + h * 128 + 4 * hi;
                            const float* sl = IN_[I_SUBLN] + layer * 512 + h * 128 + 4 * hi;
#pragma unroll
                            for (int d = 0; d < 4; ++d)
#pragma unroll
                                for (int g4 = 0; g4 < 4; ++g4) {
                                    const f32x4 gsl = *(const GAS f32x4*)(sl + d * 32 + 8 * g4);
                                    v2u w; w.x = cvtpk(o[d][4 * g4] * rn * gsl.x, o[d][4 * g4 + 1] * rn * gsl.y); w.y = cvtpk(o[d][4 * g4 + 2] * rn * gsl.z, o[d][4 * g4 + 3] * rn * gsl.w);
                                    *(GAS v2u*)(yp + d * 32 + 8 * g4) = w;
                                }
                        }
                    }
                }
                __syncthreads();
            }
} }
{ const int lo__ = lane_id_v(); { const int lane = lo__; const int tid = wave * 64 + lane, r32 = lane & 31, hi = lane >> 5;
            {
                const int n_lat = BATCH * 2 * (SEQ / 64), n_ctx = last ? 0 : BATCH * 2 * (CTX / 64);
                for (int rep_ = 0; rep_ < REP_P3A; ++rep_)
                for (int u0 = vcu; u0 < n_lat + n_ctx; u0 += G) {
                    const bool isctx = u0 >= n_lat;
                    int b, g, p0, qrow, nl, klo;
                    if (!isctx) { b = u0 >> 8; g = (u0 >> 7) & 1; p0 = (u0 & 127) * 64; qrow = b * SEQ + p0 + (wave & 1) * 32 + r32;
                                  klo = p0 >= 128 ? 0 : (128 - p0) / 64; const int khi = min(4, (SEQ - 1 - (p0 - 128)) / 64); nl = khi - klo + 1; }
                    else { const int c = u0 - n_lat; b = c >> 3; g = (c >> 2) & 1; p0 = (c & 3) * 64; qrow = T_LAT + b * CTX + p0 + (wave & 1) * 32 + r32; nl = 0; klo = 0; }
                    const int hq = g * 4 + (wave >> 1);
                    const int qpos0 = p0 + (wave & 1) * 32;
                    bf16x8 qf[4];
                    { const bf16* qp = AQ + (size_t)qrow * 512 + hq * 64 + hi * 8;
#pragma unroll
                      for (int ks = 0; ks < 4; ++ks) qf[ks] = *(const GAS bf16x8*)(qp + ks * 16); }
                    f32x16 o[2];
#pragma unroll
                    for (int d = 0; d < 2; ++d)
#pragma unroll
                        for (int r = 0; r < 16; ++r) o[d][r] = 0.f;
                    float mrun = IN_[I_SINK][layer * 8 + hq] * 8.0f;
                    float lpart = (hi == 0) ? 1.0f : 0.0f;
                    const bf16* kg = AK + (size_t)(tid >> 3) * 128 + g * 64 + (tid & 7) * 8;
                    const bf16* vg = AVT + (size_t)(tid >> 3) * 128 + g * 64 + (tid & 7) * 8;
                    const int kp0 = p0 - 128 + 64 * klo;
                    auto tile_row = [&](int j) { return (j < nl) ? b * SEQ + kp0 + 64 * j : T_LAT + b * CTX + 64 * (j - nl); };
                    auto use_tile = [&](int j) { if (j >= nl) return true; const int kp = kp0 + 64 * j; return (kp + 63 >= qpos0 - 128) && (kp <= qpos0 + 31 + 128); };
                    auto elem = [&](f32x16 (&st)[2], int j) {
                        if (j < nl) {
                            const int dq0 = (qpos0 + r32) - (kp0 + 64 * j + 4 * hi);
#pragma unroll
                            for (int kb = 0; kb < 2; ++kb)
#pragma unroll
                                for (int r = 0; r < 16; ++r) { const int dq = dq0 - (kb * 32 + (r & 3) + 8 * (r >> 2)); if (dq > 128 || dq < -128) st[kb][r] = -1e30f; }
                        }
                    };
                    attn64_pass<2>(o, mrun, lpart, qf, kg, 128, vg, 128, nl + 4, tile_row, use_tile, elem, L, lane, tid);
                    const float lt = xadd32(lpart);
                    attn64_store(o, 1.0f / lt, Y + (size_t)qrow * 1536 + hq * 64, hi);
                }
            }
} }
{ const int lo__ = lane_id_v(); { const int lane = lo__; const int tid = wave * 64 + lane, r32 = lane & 31, hi = lane >> 5;
            {
                const int n_lat = BATCH * 8 * 32, n_ctx = last ? 0 : BATCH * 8;
                LAS float* rpbL = (LAS float*)(L + 49152);
                for (int rep_ = 0; rep_ < REP_P3B; ++rep_)
                for (int u0 = vcu; u0 < n_lat + n_ctx; u0 += G) {
                    const bool isctx = u0 >= n_lat;
                    int b, h, gr = 0, qc0 = 0, qrow, nl, krlo;
                    if (!isctx) { b = u0 >> 8; h = (u0 >> 5) & 7; const int r0 = (u0 & 31) * 4; gr = r0 + (wave >> 1); qc0 = (wave & 1) * 32; qrow = b * SEQ + gr * GRID_W + qc0 + r32;
                                  krlo = min(max(r0 - 4, 0), 120); nl = min(max(r0 - 1, 0), 120) + 8 - krlo; }
                    else { const int c = u0 - n_lat; b = c >> 3; h = c & 7; qrow = T_LAT + b * CTX + wave * 32 + r32; nl = 0; krlo = 0; }
                    __syncthreads();
                    if (tid < 465) rpbL[tid] = IN_[I_RPB][(size_t)(layer * 8 + h) * 465 + tid] * 8.0f;
                    bf16x8 qf[4];
                    { const bf16* qp = BQ + (size_t)qrow * 512 + h * 64 + hi * 8;
#pragma unroll
                      for (int ks = 0; ks < 4; ++ks) qf[ks] = *(const GAS bf16x8*)(qp + ks * 16); }
                    f32x16 o[2];
#pragma unroll
                    for (int d = 0; d < 2; ++d)
#pragma unroll
                        for (int r = 0; r < 16; ++r) o[d][r] = 0.f;
                    float mrun = -1e30f, lpart = 0.f;
                    const bf16* kg = BK + (size_t)(tid >> 3) * 512 + h * 64 + (tid & 7) * 8;
                    const bf16* vg = BVT + (size_t)(tid >> 3) * 512 + h * 64 + (tid & 7) * 8;
                    const int rs = min(max(gr - 4, 0), 120);
                    auto tile_row = [&](int j) { return (j < nl) ? b * SEQ + (krlo + j) * GRID_W : T_LAT + b * CTX + 64 * (j - nl); };
                    auto use_tile = [&](int j) { if (j >= nl) return true; const int kr = krlo + j; return kr >= rs && kr < rs + 8; };
                    auto elem = [&](f32x16 (&st)[2], int j) {
                        if (j < nl) {
                            const int qc = qc0 + r32, cstart = min(max(qc - 8, 0), 48);
                            const LAS float* brow = rpbL + (krlo + j - gr + 7) * 31 + 15;
#pragma unroll
                            for (int kb = 0; kb < 2; ++kb)
#pragma unroll
                                for (int r = 0; r < 16; ++r) {
                                    const int kc = kb * 32 + (r & 3) + 8 * (r >> 2) + 4 * hi;
                                    const bool valid = (kc >= cstart) && (kc < cstart + 16);
                                    const int dc = min(max(kc - qc, -15), 15);
                                    st[kb][r] = valid ? st[kb][r] + brow[dc] : -1e30f;
                                }
                        }
                    };
                    attn64_pass<2>(o, mrun, lpart, qf, kg, 512, vg, 512, nl + 4, tile_row, use_tile, elem, L, lane, tid);
                    const float lt = xadd32(lpart);
                    attn64_store(o, 1.0f / lt, Y + (size_t)qrow * 1536 + 512 + h * 64, hi);
                }
                __syncthreads();
            }
} }
        }
        }
#endif
        GRID_BAR();

#ifndef SKIP_P4
        { PHASE_PTRS LAYER_PTRS
        for (int rep_ = 0; rep_ < REP_P4; ++rep_) {
        {
            pg8::Gemm g{Y, WB + (size_t)layer * 3 * D * 512, 1536, 512, 512, 512, (size_t)D * 512};
            pg8::SegOrder<3> S; S.T.init(T_LAT, D, G, (int)blockIdx.x);
            EpiBranch E{SG, MG};
            pg8::gemm_phase(L, g, S, E, wave);
        }
        if (!last) { const int lo__ = lane_id_v(); { const int lane = lo__; const int fr = lane & 15, fq = lane >> 4; (void)fr; (void)fq;
            for (int it = gw; it < (T_ALL - T_LAT) / 32 * (D / 32); it += NGW) {
                const int row0 = T_LAT + (it / (D / 32)) * 32, col0 = (it % (D / 32)) * 32;
                f32x4 mg[2][2]; zero_acc22(mg);
#pragma unroll 1
                for (int seg = 0; seg < 3; ++seg) {
                    f32x4 acc[2][2]; zero_acc22(acc);
                    sgemm32<8>(acc, Y + seg * 512, 1536, WB + (size_t)(layer * 3 + seg) * D * 512, 512, 512, row0, col0, lane);
#pragma unroll
                    for (int m = 0; m < 2; ++m)
#pragma unroll
                        for (int r = 0; r < 4; ++r) {
                            const bf16* gp = SG + (size_t)(row0 + 16 * m + 4 * fq + r) * 3072 + seg * 1024 + col0 + fr;
#pragma unroll
                            for (int n = 0; n < 2; ++n) mg[m][n][r] += bf2f(gp[16 * n]) * acc[m][n][r];
                        }
                }
#pragma unroll
                for (int m = 0; m < 2; ++m)
#pragma unroll
                    for (int r = 0; r < 4; ++r) {
                        bf16* rowp = MG + (size_t)(row0 + 16 * m + 4 * fq + r) * D + col0 + fr;
#pragma unroll
                        for (int n = 0; n < 2; ++n) rowp[16 * n] = (bf16)f2bf(mg[m][n][r]);
                    }
            }
} }
        }
        }
#endif
        GRID_BAR();

#ifndef SKIP_P5
        { PHASE_PTRS LAYER_PTRS
        {
            pg8::Gemm g{MG, WO + (size_t)layer * D * D, D, D, D, 0, 0};
            pg8::SegOrder<1> S; S.T.init(T_LAT, D, G, (int)blockIdx.x);
            EpiOut E{X, modl, layer == 0 ? IN_[I_X] : nullptr, IN_[I_CTX]};
            pg8::gemm_phase(L, g, S, E, wave);
        }
        if (!last) { const int lo__ = lane_id_v(); { const int lane = lo__; const int fr = lane & 15, fq = lane >> 4; (void)fr; (void)fq;
            for (int it = gw; it < (T_ALL - T_LAT) / 32 * (D / 32); it += NGW) {
                const int row0 = T_LAT + (it / (D / 32)) * 32, col0 = (it % (D / 32)) * 32;
                f32x4 acc[2][2]; zero_acc22(acc);
                sgemm32<8>(acc, MG, D, WO + (size_t)layer * D * D, D, D, row0, col0, lane);
                const float* gt = modl + (size_t)2 * 6 * D + 2 * D + col0 + fr;
#pragma unroll
                for (int m = 0; m < 2; ++m)
#pragma unroll
                    for (int r = 0; r < 4; ++r) {
                        float* rowp = X + (size_t)(row0 + 16 * m + 4 * fq + r) * D + col0 + fr;
                        const float* srcp = (layer == 0) ? IN_[I_CTX] + (size_t)(row0 - T_LAT + 16 * m + 4 * fq + r) * D + col0 + fr : rowp;
#pragma unroll
                        for (int n = 0; n < 2; ++n) rowp[16 * n] = srcp[16 * n] + gt[16 * n] * acc[m][n][r];
                    }
            }
} }
        }
#endif
        GRID_BAR();

#ifndef SKIP_P6
        { PHASE_PTRS LAYER_PTRS
        for (int rep_ = 0; rep_ < REP_P6; ++rep_) {
        { const int ln = lane_id_v();
        {
            f32x4 gm[4], shv[4];
            auto prep = [&](int midx) { const float* md = modl + (size_t)midx * 6 * D;
#pragma unroll
                for (int j = 0; j < 4; ++j) { const f32x4 g = *((const GAS f32x4*)(IN_[I_G2] + layer * D) + ln + 64 * j); const f32x4 sc = *((const GAS f32x4*)(md + 4 * D) + ln + 64 * j);
                    gm[j] = g * (sc + 1.0f); shv[j] = *((const GAS f32x4*)(md + 3 * D) + ln + 64 * j); } };
            auto row = [&](int r) {
                const GAS f32x4* xr = (const GAS f32x4*)(X + (size_t)r * D) + ln;
                f32x4 v[4]; float ss = 0.f;
#pragma unroll
                for (int j = 0; j < 4; ++j) { v[j] = xr[64 * j]; ss += (v[j].x * v[j].x + v[j].y * v[j].y) + (v[j].z * v[j].z + v[j].w * v[j].w); }
                const float rs = 1.0f / sqrtf(wave_sum(ss) * (1.f / D) + NORM_EPS);
                GAS v2u* o8 = (GAS v2u*)(H + (size_t)r * D) + ln;
#pragma unroll
                for (int j = 0; j < 4; ++j) { const f32x4 h = v[j] * rs * gm[j] + shv[j]; v2u o; o.x = pk2(h.x, h.y); o.y = pk2(h.z, h.w); o8[64 * j] = o; } };
            wave_row_blocks(T_EFF, gw, NGW, prep, row);
        }
        }
        }
        }
#endif
        GRID_BAR();

#ifndef SKIP_P7
        { PHASE_PTRS LAYER_PTRS
        for (int rep_ = 0; rep_ < REP_P7; ++rep_) {
        {
            pg8::Gemm g{H, WQ + (size_t)layer * 2048 * D, D, D, D, 0, 0};
            pg8::SegOrder<1> S; S.T.init(T_LAT, 2048, G, (int)blockIdx.x);
            EpiStore E{Q2, 2048};
            pg8::gemm_phase(L, g, S, E, wave);
        }
        if (!last) { const int lo__ = lane_id_v(); { const int lane = lo__; const int fr = lane & 15, fq = lane >> 4; (void)fr; (void)fq;
            for (int it = gw; it < (T_ALL - T_LAT) / 32 * (2048 / 32); it += NGW) {
                const int row0 = T_LAT + (it / (2048 / 32)) * 32, col0 = (it % (2048 / 32)) * 32;
                f32x4 acc[2][2]; zero_acc22(acc);
                sgemm32<8>(acc, H, D, WQ + (size_t)layer * 2048 * D, D, D, row0, col0, lane);
#pragma unroll
                for (int m = 0; m < 2; ++m)
#pragma unroll
                    for (int r = 0; r < 4; ++r) {
                        bf16* rowp = Q2 + (size_t)(row0 + 16 * m + 4 * fq + r) * 2048 + col0 + fr;
#pragma unroll
                        for (int n = 0; n < 2; ++n) rowp[16 * n] = (bf16)f2bf(acc[m][n][r]);
                    }
            }
} }
        }
        }
#endif
        GRID_BAR();

#ifndef SKIP_P8
        { PHASE_PTRS LAYER_PTRS
        for (int rep_ = 0; rep_ < REP_P8; ++rep_) {
{ const int lo__ = lane_id_v(); { const int lane = lo__; const int fr = lane & 15, fq = lane >> 4, tid = wave * 64 + lane;
        {
            LAS float* S = (LAS float*)L;
            const int wr = wave >> 1, wc = wave & 1;
            const int tl = tid >> 2, qd = tid & 3, ph = qd >> 1, hq = qd & 1;
            for (int it = vcu; it < (T_EFF / 128) * PEER_HEADS; it += G) {
                const int tile = it >> 3, h = it & 7;
                {
                    f32x4 acc[2][8];
#pragma unroll
                    for (int m = 0; m < 2; ++m)
#pragma unroll
                        for (int n = 0; n < 8; ++n) acc[m][n] = (f32x4){0.f, 0.f, 0.f, 0.f};
                    const bf16* ap = Q2 + (size_t)(tile * 128 + wr * 32 + fr) * 2048 + h * 256 + wc * 128 + fq * 8;
                    const bf16* bp = KEYS + ((size_t)(layer * 16 + h * 2 + wc) * 128 + fr) * 128 + fq * 8;
                    bf16x8 af[2][4];
#pragma unroll
                    for (int m = 0; m < 2; ++m)
#pragma unroll
                        for (int ks = 0; ks < 4; ++ks) af[m][ks] = *(const GAS bf16x8*)(ap + (size_t)m * 16 * 2048 + ks * 32);
#pragma unroll
                    for (int n = 0; n < 8; ++n) {
                        bf16x8 bfr[4];
#pragma unroll
                        for (int ks = 0; ks < 4; ++ks) bfr[ks] = *(const GAS bf16x8*)(bp + (size_t)n * 16 * 128 + ks * 32);
#pragma unroll
                        for (int ks = 0; ks < 4; ++ks)
#pragma unroll
                            for (int m = 0; m < 2; ++m) acc[m][n] = __builtin_amdgcn_mfma_f32_16x16x32_bf16(af[m][ks], bfr[ks], acc[m][n], 0, 0, 0);
                    }
#pragma unroll
                    for (int m = 0; m < 2; ++m)
#pragma unroll
                        for (int r = 0; r < 4; ++r) {
                            const int row_ = wr * 32 + 16 * m + 4 * fq + r;
#pragma unroll
                            for (int n = 0; n < 8; ++n) { const int key_ = wc * 128 + 16 * n + fr, c_ = key_ >> 2, pc_ = (c_ & 0x30) | ((c_ & 15) ^ (((row_ & 3) << 2) | (c_ >> 4)));
                                S[row_ * 256 + pc_ * 4 + (key_ & 3)] = acc[m][n][r]; }
                        }
                }
                __syncthreads();
                {
                    const int t = tile * 128 + tl;
                    int a[16];
#define LOAD_CHUNK_L(v, ch) _Pragma("unroll") for (int q = 0; q < 4; ++q) { const int c_ = qd * 16 + (ch) * 4 + q, pc_ = (c_ & 0x30) | ((c_ & 15) ^ (((tl & 3) << 2) | qd)); \
                        const f32x4 x = *(const LAS f32x4*)(S + tl * 256 + pc_ * 4); const int kb_ = hq * 64 + (ch) * 16 + 4 * q; \
                        v[4 * q + 0] = (f2ord(x.x) & ~127) | (kb_ + 0); v[4 * q + 1] = (f2ord(x.y) & ~127) | (kb_ + 1); v[4 * q + 2] = (f2ord(x.z) & ~127) | (kb_ + 2); v[4 * q + 3] = (f2ord(x.w) & ~127) | (kb_ + 3); }
                    LOAD_CHUNK_L(a, 0) sort16_desc(a);
#pragma unroll
                    for (int ch = 1; ch < 4; ++ch) { int v[16]; LOAD_CHUNK_L(v, ch) sort16_desc(v); merge16_desc(a, v); }
#undef LOAD_CHUNK_L
                    { int b[16];
#pragma unroll
                      for (int i = 0; i < 16; ++i) b[i] = __builtin_amdgcn_update_dpp(0, a[i], 0xB1, 0xF, 0xF, true);
                      merge16_desc(a, b); }
                    int a0[16], a1[16];
#pragma unroll
                    for (int i = 0; i < 16; ++i) { const int o2 = __builtin_amdgcn_update_dpp(0, a[i], 0x4E, 0xF, 0xF, true); a0[i] = ph ? o2 : a[i]; a1[i] = ph ? a[i] : o2; }
                    {
            float va[16], vb[16];
#pragma unroll
            for (int i = 0; i < 16; ++i) { va[i] = ord2f(a0[i] & ~127); vb[i] = ord2f(a1[i] & ~127); }
            int c[16];
            {
                int v[16];
                v[0] = (f2ord(va[0] + vb[0]) & ~255) | 0;
                v[1] = (f2ord(va[0] + vb[1]) & ~255) | 1;
                v[2] = (f2ord(va[0] + vb[2]) & ~255) | 2;
                v[3] = (f2ord(va[0] + vb[3]) & ~255) | 3;
                v[4] = (f2ord(va[0] + vb[4]) & ~255) | 4;
                v[5] = (f2ord(va[0] + vb[5]) & ~255) | 5;
                v[6] = (f2ord(va[0] + vb[6]) & ~255) | 6;
                v[7] = (f2ord(va[0] + vb[7]) & ~255) | 7;
                v[8] = (f2ord(va[0] + vb[8]) & ~255) | 8;
                v[9] = (f2ord(va[0] + vb[9]) & ~255) | 9;
                v[10] = (f2ord(va[0] + vb[10]) & ~255) | 10;
                v[11] = (f2ord(va[0] + vb[11]) & ~255) | 11;
                v[12] = (f2ord(va[0] + vb[12]) & ~255) | 12;
                v[13] = (f2ord(va[0] + vb[13]) & ~255) | 13;
                v[14] = (f2ord(va[0] + vb[14]) & ~255) | 14;
                v[15] = (f2ord(va[0] + vb[15]) & ~255) | 15;
                sort16_desc(v);
#pragma unroll
                for (int i = 0; i < 16; ++i) c[i] = v[i];
            }
            {
                int v[16];
                v[0] = (f2ord(va[1] + vb[0]) & ~255) | 16;
                v[1] = (f2ord(va[1] + vb[1]) & ~255) | 17;
                v[2] = (f2ord(va[1] + vb[2]) & ~255) | 18;
                v[3] = (f2ord(va[1] + vb[3]) & ~255) | 19;
                v[4] = (f2ord(va[1] + vb[4]) & ~255) | 20;
                v[5] = (f2ord(va[1] + vb[5]) & ~255) | 21;
                v[6] = (f2ord(va[1] + vb[6]) & ~255) | 22;
                v[7] = (f2ord(va[1] + vb[7]) & ~255) | 23;
                v[8] = (f2ord(va[2] + vb[0]) & ~255) | 32;
                v[9] = (f2ord(va[2] + vb[1]) & ~255) | 33;
                v[10] = (f2ord(va[2] + vb[2]) & ~255) | 34;
                v[11] = (f2ord(va[2] + vb[3]) & ~255) | 35;
                v[12] = (f2ord(va[2] + vb[4]) & ~255) | 36;
                v[13] = (f2ord(va[3] + vb[0]) & ~255) | 48;
                v[14] = (f2ord(va[3] + vb[1]) & ~255) | 49;
                v[15] = (f2ord(va[3] + vb[2]) & ~255) | 50;
                sort16_desc(v);
                merge16_desc(c, v);
            }
            {
                int v[16];
                v[0] = (f2ord(va[3] + vb[3]) & ~255) | 51;
                v[1] = (f2ord(va[4] + vb[0]) & ~255) | 64;
                v[2] = (f2ord(va[4] + vb[1]) & ~255) | 65;
                v[3] = (f2ord(va[4] + vb[2]) & ~255) | 66;
                v[4] = (f2ord(va[5] + vb[0]) & ~255) | 80;
                v[5] = (f2ord(va[5] + vb[1]) & ~255) | 81;
                v[6] = (f2ord(va[6] + vb[0]) & ~255) | 96;
                v[7] = (f2ord(va[6] + vb[1]) & ~255) | 97;
                v[8] = (f2ord(va[7] + vb[0]) & ~255) | 112;
                v[9] = (f2ord(va[7] + vb[1]) & ~255) | 113;
                v[10] = (f2ord(va[8] + vb[0]) & ~255) | 128;
                v[11] = (f2ord(va[9] + vb[0]) & ~255) | 144;
                v[12] = (f2ord(va[10] + vb[0]) & ~255) | 160;
                v[13] = (f2ord(va[11] + vb[0]) & ~255) | 176;
                v[14] = (f2ord(va[12] + vb[0]) & ~255) | 192;
                v[15] = (f2ord(va[13] + vb[0]) & ~255) | 208;
                sort16_desc(v);
                merge16_desc(c, v);
            }
            {
                int v[16];
                v[0] = (f2ord(va[14] + vb[0]) & ~255) | 224;
                v[1] = (f2ord(va[15] + vb[0]) & ~255) | 240;
                v[2] = (int)0x80000000;
                v[3] = (int)0x80000000;
                v[4] = (int)0x80000000;
                v[5] = (int)0x80000000;
                v[6] = (int)0x80000000;
                v[7] = (int)0x80000000;
                v[8] = (int)0x80000000;
                v[9] = (int)0x80000000;
                v[10] = (int)0x80000000;
                v[11] = (int)0x80000000;
                v[12] = (int)0x80000000;
                v[13] = (int)0x80000000;
                v[14] = (int)0x80000000;
                v[15] = (int)0x80000000;
                sort16_desc(v);
                merge16_desc(c, v);
            }
            const float smax = ord2f(c[0] & ~255);
            float pe[16]; float psum = 0.f;
#pragma unroll
            for (int k = 0; k < 16; ++k) { pe[k] = __expf(ord2f(c[k] & ~255) - smax); psum += pe[k]; }
            const float ip = 1.0f / psum;
#pragma unroll
            for (int kk = 0; kk < 4; ++kk) {
                const int ck = (qd == 0) ? c[kk] : (qd == 1) ? c[4 + kk] : (qd == 2) ? c[8 + kk] : c[12 + kk];
                const float pk_ = (qd == 0) ? pe[kk] : (qd == 1) ? pe[4 + kk] : (qd == 2) ? pe[8 + kk] : pe[12 + kk];
                const int ij = ck & 255, ii = ij >> 4, jj = ij & 15;
                int e0 = 0, e1 = 0;
#pragma unroll
                for (int q = 0; q < 16; ++q) { e0 = (ii == q) ? (a0[q] & 127) : e0; e1 = (jj == q) ? (a1[q] & 127) : e1; }
                const int e = e0 * PEER_KEYS + e1;
                const float su = SCU[layer * 16384 + e], sv = SCV[layer * 16384 + e];
                const int k = 4 * qd + kk;
                EI[(size_t)t * NSEL + h * 16 + k] = (unsigned)e | (f2bf(su) << 16);
                EG[(size_t)t * NSEL + h * 16 + k] = pk_ * ip * sv;
            }
                    }
                }
                __syncthreads();
            }
        }
} }
        }
        }
#endif
        GRID_BAR();

#ifndef SKIP_P10
#define P10_CENSUS \
        unsigned myx_, nx_ = 1u, smask_ = 0u; { unsigned cnt_[16]; unsigned* bw_ = (unsigned*)(args.ws + WS_CTL) + CW_BAR; \
            _Pragma("unroll") for (int j = 0; j < 16; ++j) cnt_[j] = (unsigned)__builtin_amdgcn_readfirstlane((int)xb_ld(&bw_[XB_XCNT(j)])); \
            myx_ = xb_xcc_id(); unsigned np_ = 0u; \
            _Pragma("unroll") for (int j = 0; j < 16; ++j) { np_ += (cnt_[j] > 0u) ? 1u : 0u; nx_ = ((unsigned)j == myx_) ? cnt_[j] : nx_; } \
            if (np_ == 0u) np_ = 1u; if (nx_ == 0u) nx_ = 1u; \
            _Pragma("unroll") for (int sl = 0; sl < 8; ++sl) { const unsigned k_ = (unsigned)sl % np_; unsigned seen_ = 0u, srv_ = 0xffu; \
                _Pragma("unroll") for (int j = 0; j < 16; ++j) { if (cnt_[j] > 0u) { srv_ = (seen_ == k_) ? (unsigned)j : srv_; ++seen_; } } \
                smask_ |= (srv_ == myx_) ? (1u << sl) : 0u; } } \
        const int rank_ = (int)__builtin_amdgcn_readfirstlane((int)MISC[12]); const int wstride_ = (int)nx_ * NWAVES; (void)rank_; (void)wstride_;
        { PHASE_PTRS LAYER_PTRS
        { const int ln = lane_id_v(); const int c = ln & 7, tg = ln >> 3;
          P10_CENSUS
          float* PART = (float*)(wsq + WS_PART);
          const unsigned char* U8l = U8 + (size_t)layer * 16384 * D;
          for (int rep_ = 0; rep_ < REP_P10A; ++rep_)
#pragma unroll 1
          for (int sl = 0; sl < 8; ++sl) {
            if (!((smask_ >> sl) & 1u)) continue;
            const int ws0 = (rank_ * NWAVES + wave) * 8, nslot = wstride_ * 8;
            if (ws0 >= T_EFF) continue;
            const int niter = (T_EFF - ws0 + nslot - 1) / nslot, nb = niter * 8;
#define A_TOK(bi) (ws0 + tg + (min((bi), nb - 1) >> 3) * nslot)
#define A_LOAD_PK(pkv, bi) { const GAS v4u* wp_ = (const GAS v4u*)(EI + (size_t)A_TOK(bi) * NSEL + 16 * (min((bi), nb - 1) & 7)); _Pragma("unroll") for (int q = 0; q < 4; ++q) pkv[q] = wp_[q]; }
#define A_ISSUE(rowv, pkv) { _Pragma("unroll") for (int q = 0; q < 16; ++q) rowv[q] = *(const GAS v4u*)(U8l + (size_t)(pkv[q >> 2][q & 3] & 0xffffu) * D + 128 * sl + 16 * c); }
#define A_LOAD_H(hvv, bi) { const int tq_ = A_TOK(bi); _Pragma("unroll") for (int j = 0; j < 4; ++j) hvv[j] = *(const GAS v2u*)(H + (size_t)tq_ * D + 256 * j + 32 * sl + 4 * c); }
#define A_QUANT(hvv) { float hf[16]; float am_ = 0.f; \
                _Pragma("unroll") for (int j = 0; j < 4; ++j) { hf[4 * j] = bf2f(hvv[j].x & 0xffffu); hf[4 * j + 1] = bf2f(hvv[j].x >> 16); hf[4 * j + 2] = bf2f(hvv[j].y & 0xffffu); hf[4 * j + 3] = bf2f(hvv[j].y >> 16); } \
                _Pragma("unroll") for (int i = 0; i < 16; ++i) am_ = fmaxf(am_, fabsf(hf[i])); \
                am_ = fmaxf(am_, dpp_mov<0xB1>(am_)); am_ = fmaxf(am_, dpp_mov<0x4E>(am_)); am_ = fmaxf(am_, dpp_mov<0x141>(am_)); am_ = fmaxf(am_, 1e-20f); \
                sh_ = am_ * (1.0f / 127.0f); const float ih_ = 127.0f / am_; \
                _Pragma("unroll") for (int j = 0; j < 4; ++j) { const int q0 = __float2int_rn(hf[4 * j] * ih_), q1 = __float2int_rn(hf[4 * j + 1] * ih_), q2 = __float2int_rn(hf[4 * j + 2] * ih_), q3 = __float2int_rn(hf[4 * j + 3] * ih_); \
                    hq_[j] = (int)((unsigned)(q0 & 255) | ((unsigned)(q1 & 255) << 8) | ((unsigned)(q2 & 255) << 16) | ((unsigned)q3 << 24)); } }
#define A_COMPUTE(rowv, bi) { int p_[16]; \
                _Pragma("unroll") for (int q = 0; q < 16; ++q) { int ia = 0; _Pragma("unroll") for (int j = 0; j < 4; ++j) ia = __builtin_amdgcn_sdot4((int)rowv[q][j], hq_[j], ia, false); p_[q] = ia; } \
                { const bool up = (c & 4) != 0; _Pragma("unroll") for (int i = 0; i < 8; ++i) { const int send = up ? p_[i] : p_[8 + i], keep = up ? p_[8 + i] : p_[i]; p_[i] = keep + __builtin_amdgcn_update_dpp(0, send, 0x141, 0xF, 0xF, true); } } \
                { const bool up = (c & 2) != 0; _Pragma("unroll") for (int i = 0; i < 4; ++i) { const int send = up ? p_[i] : p_[4 + i], keep = up ? p_[4 + i] : p_[i]; p_[i] = keep + __builtin_amdgcn_update_dpp(0, send, 0x4E, 0xF, 0xF, true); } } \
                { const bool up = (c & 1) != 0; _Pragma("unroll") for (int i = 0; i < 2; ++i) { const int send = up ? p_[i] : p_[2 + i], keep = up ? p_[2 + i] : p_[i]; p_[i] = keep + __builtin_amdgcn_update_dpp(0, send, 0xB1, 0xF, 0xF, true); } } \
                f32x2 r2_; r2_.x = (float)p_[0] * sh_; r2_.y = (float)p_[1] * sh_; \
                *(GAS f32x2*)(PART + ((size_t)sl * T_ALL + (ws0 + tg + ((bi) >> 3) * nslot)) * NSEL + 16 * ((bi) & 7) + 2 * c) = r2_; }
            v4u pkA[4], pkB[4]; v4u rowA[16], rowB[16]; v2u hN[4]; int hq_[4] = {0, 0, 0, 0}; float sh_ = 0.f;
            A_LOAD_PK(pkA, 0) A_LOAD_PK(pkB, 1) A_LOAD_H(hN, 0)
            A_ISSUE(rowA, pkA)
#pragma unroll 1
            for (int bi = 0; bi < nb; bi += 2) {
                if ((bi & 7) == 0) { A_QUANT(hN) A_LOAD_H(hN, bi + 8) }
                A_ISSUE(rowB, pkB) A_LOAD_PK(pkA, bi + 2)
                __builtin_amdgcn_sched_barrier(0);
                A_COMPUTE(rowA, bi)
                __builtin_amdgcn_sched_barrier(0);
                A_ISSUE(rowA, pkA) A_LOAD_PK(pkB, bi + 3)
                __builtin_amdgcn_sched_barrier(0);
                A_COMPUTE(rowB, bi + 1)
                __builtin_amdgcn_sched_barrier(0);
            }
#undef A_TOK
#undef A_LOAD_PK
#undef A_ISSUE
#undef A_LOAD_H
#undef A_QUANT
#undef A_COMPUTE
          }
        } }
        GRID_BAR();
        { PHASE_PTRS LAYER_PTRS
        { const int ln = lane_id_v();
          const float* PART = (const float*)(wsq + WS_PART); float* WGT = (float*)(wsq + WS_WGT);
          for (int rep_ = 0; rep_ < REP_P10B; ++rep_)
          for (int i4 = vcu * NTHREADS + wave * 64 + ln; i4 < T_EFF * NSEL / 4; i4 += NGT) {
              f32x4 dsum = (f32x4){0.f, 0.f, 0.f, 0.f};
#pragma unroll
              for (int sl = 0; sl < 8; ++sl) dsum += *((const GAS f32x4*)(PART + (size_t)sl * T_ALL * NSEL) + i4);
              const v4u esu = *((const GAS v4u*)EI + i4); const f32x4 gv = *((const GAS f32x4*)EG + i4);
              v4u o;
#pragma unroll
              for (int q = 0; q < 4; ++q) {
                  const float dot = dsum[q] * bf2f(esu[q] >> 16);
                  o[q] = (esu[q] & 0xffffu) | (f2bf(0.5f * dot * (1.0f + erff(dot * 0.70710678118654752f)) * gv[q]) << 16);
              }
              *((GAS v4u*)WGT + i4) = o;
          }
        } }
        GRID_BAR();
        { PHASE_PTRS LAYER_PTRS
        { const int ln = lane_id_v(); const int c = ln & 7, tg = ln >> 3;
          P10_CENSUS
          const unsigned* WGT = (const unsigned*)(wsq + WS_WGT); float* XO = (float*)(wsq + WS_XO);
          const unsigned char* V8l = V8 + (size_t)layer * 16384 * D;
          for (int rep_ = 0; rep_ < REP_P10C; ++rep_)
#pragma unroll 1
          for (int sl = 0; sl < 8; ++sl) {
            if (!((smask_ >> sl) & 1u)) continue;
            const int ws0 = (rank_ * NWAVES + wave) * 8, nslot = wstride_ * 8;
            if (ws0 >= T_EFF) continue;
            const int niter = (T_EFF - ws0 + nslot - 1) / nslot, nb = niter * 8;
#define C_TOK(bi) (ws0 + tg + (min((bi), nb - 1) >> 3) * nslot)
#define C_LOAD_PK(pkv, bi) { const GAS v4u* wp_ = (const GAS v4u*)(WGT + (size_t)C_TOK(bi) * NSEL + 16 * (min((bi), nb - 1) & 7)); _Pragma("unroll") for (int q = 0; q < 4; ++q) pkv[q] = wp_[q]; }
#define C_ISSUE(rowv, wv, pkv) { _Pragma("unroll") for (int q = 0; q < 16; ++q) { const unsigned w_ = pkv[q >> 2][q & 3]; rowv[q] = *(const GAS v4u*)(V8l + (size_t)(w_ & 0xffffu) * D + 128 * sl + 16 * c); } \
                _Pragma("unroll") for (int q = 0; q < 8; ++q) wv[q] = (pkv[q >> 1][(2 * q) & 3] >> 16) | (pkv[q >> 1][(2 * q + 1) & 3] & 0xffff0000u); }
#define C_COMPUTE(rowv, wv) { _Pragma("unroll") for (int q = 0; q < 16; ++q) { const float wq_ = (q & 1) ? __builtin_bit_cast(float, wv[q >> 1] & 0xffff0000u) : bf2f(wv[q >> 1] & 0xffffu); const f32x2 w2_ = (f32x2){wq_, wq_}; _Pragma("unroll") for (int j = 0; j < 4; ++j) { \
                    const f32x2 a = __builtin_amdgcn_cvt_pk_f32_fp8((int)rowv[q][j], false), b = __builtin_amdgcn_cvt_pk_f32_fp8((int)rowv[q][j], true); \
                    f32x2 lo_ = (f32x2){o[j].x, o[j].y}, hi_ = (f32x2){o[j].z, o[j].w}; lo_ = __builtin_elementwise_fma(a, w2_, lo_); hi_ = __builtin_elementwise_fma(b, w2_, hi_); \
                    o[j].x = lo_.x; o[j].y = lo_.y; o[j].z = hi_.x; o[j].w = hi_.y; } \
                    asm volatile("" : "+v"(o[0]), "+v"(o[1]), "+v"(o[2]), "+v"(o[3])); } }
            v4u pkA[4], pkB[4]; unsigned wA[8], wB[8]; v4u rowA[16], rowB[16];
            f32x4 o[4];
#pragma unroll
            for (int j = 0; j < 4; ++j) o[j] = (f32x4){0.f, 0.f, 0.f, 0.f};
            C_LOAD_PK(pkA, 0) C_LOAD_PK(pkB, 1)
            C_ISSUE(rowA, wA, pkA)
#pragma unroll 1
            for (int bi = 0; bi < nb; bi += 2) {
                C_ISSUE(rowB, wB, pkB) C_LOAD_PK(pkA, bi + 2)
                __builtin_amdgcn_sched_barrier(0);
                C_COMPUTE(rowA, wA)
                __builtin_amdgcn_sched_barrier(0);
                C_ISSUE(rowA, wA, pkA) C_LOAD_PK(pkB, bi + 3)
                __builtin_amdgcn_sched_barrier(0);
                C_COMPUTE(rowB, wB)
                __builtin_amdgcn_sched_barrier(0);
                if ((bi & 7) == 6) {
                    const int t = ws0 + tg + (bi >> 3) * nslot;
#pragma unroll
                    for (int j = 0; j < 4; ++j) { *(GAS f32x4*)(XO + (size_t)t * D + 256 * j + 32 * sl + 4 * c) = o[j]; o[j] = (f32x4){0.f, 0.f, 0.f, 0.f}; }
                }
            }
#undef C_TOK
#undef C_LOAD_PK
#undef C_ISSUE
#undef C_COMPUTE
          }
        } }
        GRID_BAR();
#undef P10_CENSUS
        { PHASE_PTRS LAYER_PTRS
        { const int ln = lane_id_v();
          const float* XO = (const float*)(wsq + WS_XO);
          f32x4 gt2v[4], gm[4], shv[4];
          auto prep = [&](int midx) {
              const float* md = modl + (size_t)midx * 6 * D; const float* md1 = modl + (size_t)(3 + midx) * 6 * D;
#pragma unroll
              for (int j = 0; j < 4; ++j) {
                  gt2v[j] = *((const GAS f32x4*)(md + 5 * D) + ln + 64 * j);
                  if (!last) { const f32x4 g = *((const GAS f32x4*)(IN_[I_G1] + (layer + 1) * D) + ln + 64 * j); const f32x4 sc = *((const GAS f32x4*)(md1 + D) + ln + 64 * j);
                               gm[j] = g * (sc + 1.0f); shv[j] = *((const GAS f32x4*)(md1 + 0) + ln + 64 * j); }
                  else { gm[j] = *((const GAS f32x4*)IN_[I_GFINAL] + ln + 64 * j); shv[j] = (f32x4){0.f, 0.f, 0.f, 0.f}; }
              } };
          auto row = [&](int t) {
              GAS f32x4* xr = (GAS f32x4*)(X + (size_t)t * D) + ln;
              const GAS f32x4* xo = (const GAS f32x4*)(XO + (size_t)t * D) + ln;
              f32x4 xn[4]; float ss = 0.f;
#pragma unroll
              for (int j = 0; j < 4; ++j) { xn[j] = xr[64 * j] + gt2v[j] * xo[64 * j]; ss += (xn[j].x * xn[j].x + xn[j].y * xn[j].y) + (xn[j].z * xn[j].z + xn[j].w * xn[j].w); }
              const float rs = 1.0f / sqrtf(wave_sum(ss) * (1.f / D) + NORM_EPS);
              if (!last) {
                  GAS v2u* o8 = (GAS v2u*)(H + (size_t)t * D) + ln;
#pragma unroll
                  for (int j = 0; j < 4; ++j) { xr[64 * j] = xn[j]; const f32x4 hh = xn[j] * rs * gm[j] + shv[j]; v2u o; o.x = pk2(hh.x, hh.y); o.y = pk2(hh.z, hh.w); o8[64 * j] = o; }
              } else {
                  GAS f32x4* op = (GAS f32x4*)(((float*)IN_[22]) + (size_t)t * D) + ln;
#pragma unroll
                  for (int j = 0; j < 4; ++j) op[64 * j] = xn[j] * rs * gm[j];
              } };
          wave_row_blocks(T_EFF, gw, NGW, prep, row);
        } }
#endif
        if (!last) GRID_BAR();
    }
}

extern "C" void kernel_launch(void* const* d_in, const int* in_sizes, int n_in, void* d_out, int out_size, void* d_ws, size_t ws_size, hipStream_t stream) {
    static int grid = 0;
    if (grid == 0) {
        if (n_in != 22 || out_size != T_LAT * D || ws_size < WS_END) { fprintf(stderr, "kernel_launch: unexpected shapes: n_in %d out %d ws %zu (need %zu)\n", n_in, out_size, ws_size, (size_t)WS_END); grid = -1; return; }
        int dev = 0, cus = 0, per_cu = 0;
        if (hipGetDevice(&dev) != hipSuccess || hipDeviceGetAttribute(&cus, hipDeviceAttributeMultiprocessorCount, dev) != hipSuccess) { fprintf(stderr, "device query failed\n"); grid = -1; return; }
        if (hipFuncSetAttribute((const void*)mega_fwd, hipFuncAttributeMaxDynamicSharedMemorySize, LDS_BYTES) != hipSuccess) { fprintf(stderr, "hipFuncSetAttribute failed\n"); grid = -1; return; }
        if (hipOccupancyMaxActiveBlocksPerMultiprocessor(&per_cu, (const void*)mega_fwd, NTHREADS, LDS_BYTES) != hipSuccess || per_cu < 1) { fprintf(stderr, "occupancy query: %d\n", per_cu); }
        (void)hipGetLastError();
        grid = cus;
    }
    if (grid < 0) return;
    if (hipMemsetAsync((char*)d_ws + WS_CTL, 0, CTL_ZERO_BYTES, stream) != hipSuccess) { fprintf(stderr, "memset failed\n"); return; }
    Args a{};
    for (int i = 0; i < 22; ++i) a.in[i] = (const float*)d_in[i];
    a.out = (float*)d_out; a.ws = (unsigned char*)d_ws;
    hipLaunchKernelGGL(mega_fwd, dim3(grid), dim3(NTHREADS), LDS_BYTES, stream, a);
}
```

```cpp
#include <hip/hip_runtime.h>
#include <cstdio>
#include <cstdint>

#ifndef REP_P0
#define REP_P0 1
#endif
#ifndef REP_P1
#define REP_P1 1
#endif
#ifndef REP_P2
#define REP_P2 1
#endif
#ifndef REP_P3A
#define REP_P3A 1
#endif
#ifndef REP_P3B
#define REP_P3B 1
#endif
#ifndef REP_P4
#define REP_P4 1
#endif
#ifndef REP_P6
#define REP_P6 1
#endif
#ifndef REP_P7
#define REP_P7 1
#endif
#ifndef REP_P8
#define REP_P8 1
#endif
#ifndef REP_P9
#define REP_P9 1
#endif
#ifndef REP_P10
#define REP_P10 1
#endif
#ifndef REP_P10A
#define REP_P10A 1
#endif
#ifndef REP_P10C
#define REP_P10C 1
#endif
#ifndef REP_P10B
#define REP_P10B 1
#endif
#ifndef REP_P0A
#define REP_P0A 1
#endif
#ifndef REP_P0D
#define REP_P0D 1
#endif
#ifndef REP_P0F
#define REP_P0F 1
#endif
#ifndef REP_P3C
#define REP_P3C 1
#endif
#define GAS __attribute__((address_space(1)))
#define LAS __attribute__((address_space(3)))
typedef unsigned short bf16;
typedef float f32x4 __attribute__((ext_vector_type(4)));
typedef short bf16x8 __attribute__((ext_vector_type(8)));
typedef unsigned v4u __attribute__((ext_vector_type(4)));
typedef unsigned v2u __attribute__((ext_vector_type(2)));
typedef float f32x2 __attribute__((ext_vector_type(2)));
typedef GAS unsigned gu32;

constexpr int NWAVES = 8, NTHREADS = 512;
constexpr int D = 1024, BATCH = 2, SEQ = 8192, DEPTH = 2, GRID_W = 64, CTX = 256;
constexpr int T_LAT = BATCH * SEQ;
constexpr int T_ALL = T_LAT + BATCH * CTX;
constexpr int NTOK = SEQ + CTX;
constexpr int IN_W = 6912;
constexpr int PEER_HEADS = 8, PEER_KEYS = 128, PEER_TOPK = 16, NSEL = PEER_HEADS * PEER_TOPK;
constexpr float NORM_EPS = 1e-6f;
constexpr float LOG2E = 1.4426950408889634f;
constexpr float SCL2 = 0.125f * LOG2E;

constexpr size_t MiB = 1u << 20;
constexpr size_t WS_CTL = 0, CTL_ZERO_BYTES = 1 * MiB;
constexpr int CW_BAR = 4096;
constexpr int CW_RANK = 8192;
#ifndef P10_SLICED
#define P10_SLICED 1
#endif
constexpr size_t WS_MOD = 65536;
constexpr size_t WS_COS = 2 * MiB, WS_SIN = 3 * MiB;
constexpr size_t WS_WIN = 4 * MiB;
constexpr size_t WS_WB = 31 * MiB;
constexpr size_t WS_WO = 37 * MiB;
constexpr size_t WS_WQ = 41 * MiB;
constexpr size_t WS_KEYS = 49 * MiB;
constexpr size_t WS_X = 50 * MiB;
constexpr size_t WS_H = 116 * MiB;
constexpr size_t WS_Y = 149 * MiB;
constexpr size_t WS_MG = WS_H;
constexpr size_t WS_U8 = 199 * MiB;
constexpr size_t WS_SCU = 231 * MiB;
constexpr size_t WS_EI = 232 * MiB;
constexpr size_t WS_EG = 241 * MiB;
constexpr size_t WS_P = 250 * MiB;
constexpr size_t SZ_R512 = (size_t)T_ALL * 512 * 2;
constexpr size_t SZ_R128 = (size_t)T_ALL * 128 * 2;
constexpr size_t WS_AQ = WS_P, WS_AK = WS_AQ + SZ_R512, WS_AVT = WS_AK + SZ_R128, WS_BQ = WS_AVT + SZ_R128, WS_BK = WS_BQ + SZ_R512,
                 WS_BVT = WS_BK + SZ_R512, WS_CQ = WS_BVT + SZ_R512, WS_CK = WS_CQ + SZ_R512, WS_CVT = WS_CK + SZ_R512, WS_SG = WS_CVT + SZ_R512;
constexpr size_t WS_Q2 = WS_P;
constexpr size_t WS_SC = WS_P + 66 * MiB;
constexpr size_t WS_PART = WS_P, WS_XO = WS_P + 66 * MiB, WS_WGT = WS_P + 132 * MiB;
constexpr size_t WS_PEND = WS_SG + (size_t)T_ALL * 3072 * 2;
constexpr size_t WS_V8 = 473 * MiB;
constexpr size_t WS_END = WS_V8 + 32 * MiB;
static_assert(WS_SC + (size_t)T_ALL * 2048 * 4 <= WS_PEND && WS_PEND <= WS_V8, "alias map");
static_assert(WS_END <= 512 * MiB, "ws map");

constexpr int LDS_BYTES = 147456;
constexpr int MISC_OFF = 131072 + 320;

__device__ __forceinline__ int lane_id_v() { int l; asm volatile("v_mbcnt_lo_u32_b32 %0, -1, 0\n\tv_mbcnt_hi_u32_b32 %0, -1, %0" : "=v"(l)); return l; }
#define XB_TMO      128
#define XB_XCNT(j)  (256  + 64 * (j))
#define XB_XSUB(j)  (1280 + 64 * (j))
#define XB_XGEN(j)  (2304 + 64 * (j))
#define XB_TOP      3328
#define XB_TOPGEN   3392
#define XCD_BAR_WORDS 3456
#define XB_SPIN_CAP (1u << 24)

__device__ __forceinline__ unsigned xb_ld(unsigned* p)              { return __hip_atomic_load(p, __ATOMIC_RELAXED, __HIP_MEMORY_SCOPE_AGENT); }
__device__ __forceinline__ unsigned xb_add(unsigned* p, unsigned v) { return __hip_atomic_fetch_add(p, v, __ATOMIC_RELAXED, __HIP_MEMORY_SCOPE_AGENT); }
__device__ __forceinline__ unsigned xb_xcc_id() { return (unsigned)__builtin_amdgcn_s_getreg((3 << 11) | 20) & 0xFu; }
#define XB_SPIN(cond, bar) do { unsigned _sp = 0; while (cond) { __builtin_amdgcn_s_sleep(1); \
    if ((++_sp & 255u) == 0u) { if (xb_ld(&(bar)[XB_TMO])) break; if (_sp > XB_SPIN_CAP) { atomicAdd(&(bar)[XB_TMO], 1u); break; } } } } while (0)

struct XcdBarrier { unsigned* bar; unsigned x; volatile LAS unsigned* st; };

__device__ __forceinline__ XcdBarrier xcd_barrier_post(unsigned* bar, volatile LAS unsigned* st) {
    XcdBarrier b; b.bar = bar; b.x = xb_xcc_id(); b.st = st;
    if (threadIdx.x == 0) (void)xb_add(&bar[XB_XCNT(b.x)], 1u);
    return b;
}
__device__ __forceinline__ void xcd_barrier_complete(unsigned* bar, unsigned x, unsigned& nloc, unsigned& nx) {
    const unsigned G = gridDim.x * gridDim.y * gridDim.z;
    unsigned sum, cnt, mine, sp = 0u;
    for (;;) {
        sum = 0u; cnt = 0u; mine = 0u;
#pragma unroll
        for (unsigned j = 0; j < 16; ++j) { const unsigned c = xb_ld(&bar[XB_XCNT(j)]); sum += c; cnt += (c > 0u) ? 1u : 0u; mine = (j == x) ? c : mine; }
        if (sum == G) break;
        __builtin_amdgcn_s_sleep(1);
        if ((++sp & 255u) == 0u) { if (xb_ld(&bar[XB_TMO])) break; if (sp > XB_SPIN_CAP) { atomicAdd(&bar[XB_TMO], 1u); break; } }
    }
    nloc = mine > 0u ? mine : 1u; nx = cnt > 0u ? cnt : 1u;
}
__device__ __forceinline__ void xcd_barrier(const XcdBarrier& b, bool t0) {
    asm volatile("s_waitcnt vmcnt(0)" ::: "memory");
    __syncthreads();
    if (t0) {
        unsigned* bar = b.bar;
        __builtin_amdgcn_s_waitcnt(0);
        unsigned nloc = b.st[0], nx = b.st[1];
        if (nloc == 0u) { xcd_barrier_complete(bar, b.x, nloc, nx); b.st[0] = nloc; b.st[1] = nx; }
        const unsigned old = xb_add(&bar[XB_XSUB(b.x)], 1u);
        const unsigned gen = old / nloc;
        if (old + 1u == (gen + 1u) * nloc) {
            __builtin_amdgcn_fence(__ATOMIC_RELEASE, "agent");
            asm volatile("s_waitcnt vmcnt(0)" ::: "memory");
            const unsigned og = xb_add(&bar[XB_TOP], 1u);
            const unsigned tg = og / nx;
            if (og + 1u == (tg + 1u) * nx) xb_add(&bar[XB_TOPGEN], 1u);
            else XB_SPIN(xb_ld(&bar[XB_TOPGEN]) == tg, bar);
            __builtin_amdgcn_fence(__ATOMIC_ACQUIRE, "agent");
            xb_add(&bar[XB_XGEN(b.x)], 1u);
            asm volatile("s_waitcnt vmcnt(0)" ::: "memory");
        } else {
            XB_SPIN(xb_ld(&bar[XB_XGEN(b.x)]) == gen, bar);
            __builtin_amdgcn_fence(__ATOMIC_ACQUIRE, "agent");
            asm volatile("s_waitcnt vmcnt(0)" ::: "memory");
        }
    }
    __syncthreads();
}

__device__ __forceinline__ unsigned f2bf(float f) { unsigned u = __builtin_bit_cast(unsigned, f); return (u + 0x7fffu + ((u >> 16) & 1u)) >> 16; }
__device__ __forceinline__ unsigned pk2(float lo, float hi) { return f2bf(lo) | (f2bf(hi) << 16); }
__device__ __forceinline__ float bf2f(unsigned h) { return __builtin_bit_cast(float, h << 16); }
template <int CTRL> __device__ __forceinline__ float dpp_mov(float v) { return __builtin_bit_cast(float, __builtin_amdgcn_update_dpp(0, __builtin_bit_cast(int, v), CTRL, 0xF, 0xF, true)); }
__device__ __forceinline__ float sum8_dpp(float v) { v += dpp_mov<0xB1>(v); v += dpp_mov<0x4E>(v); v += dpp_mov<0x141>(v); return v; }
template <int K> __device__ __forceinline__ float xshfl_l(float v, int lane) { return __builtin_bit_cast(float, __builtin_amdgcn_ds_bpermute((lane ^ K) << 2, __builtin_bit_cast(int, v))); }
template <int K> __device__ __forceinline__ float xshfl(float v) { return xshfl_l<K>(v, lane_id_v()); }
__device__ __forceinline__ float xadd32(float v) { return v + xshfl_l<32>(v, lane_id_v()); }
__device__ __forceinline__ float xmax32(float v) { return fmaxf(v, xshfl_l<32>(v, lane_id_v())); }
__device__ __forceinline__ float wave_sum(float v) { const int l = lane_id_v(); v += xshfl_l<1>(v, l); v += xshfl_l<2>(v, l); v += xshfl_l<4>(v, l); v += xshfl_l<8>(v, l); v += xshfl_l<16>(v, l); v += xshfl_l<32>(v, l); return v; }
__device__ __forceinline__ float wave_max(float v) { const int l = lane_id_v(); v = fmaxf(v, xshfl_l<1>(v, l)); v = fmaxf(v, xshfl_l<2>(v, l)); v = fmaxf(v, xshfl_l<4>(v, l)); v = fmaxf(v, xshfl_l<8>(v, l)); v = fmaxf(v, xshfl_l<16>(v, l)); v = fmaxf(v, xshfl_l<32>(v, l)); return v; }


__device__ __forceinline__ float sigmoidf_(float x) { return 1.0f / (1.0f + __expf(-x)); }
__device__ __forceinline__ float sigmoid_fast(float x) { return __builtin_amdgcn_rcpf(1.0f + __builtin_amdgcn_exp2f(-LOG2E * x)); }
__device__ __forceinline__ int row_modidx(int r) { return r < T_LAT ? (r >> 13) : 2; }
__device__ __forceinline__ int row_batch(int r) { return r < T_LAT ? (r >> 13) : ((r - T_LAT) >> 8); }
__device__ __forceinline__ int row_tok(int r) { return r < T_LAT ? (r & (SEQ - 1)) : SEQ + ((r - T_LAT) & (CTX - 1)); }

__device__ __forceinline__ const float* xin_row(const float* x, const float* ctx, int r) { return r < T_LAT ? x + (size_t)r * D : ctx + (size_t)(r - T_LAT) * D; }
template <class Prep, class Row>
__device__ __forceinline__ void wave_row_blocks(int T_rows, int gw, int NGW, Prep prep, Row row) {
    for (int r0 = gw * 8; r0 < T_LAT; r0 += NGW * 8) {
        prep(r0 >> 13);
#pragma unroll 2
        for (int k = 0; k < 8; ++k) row(r0 + k);
    }
    if (T_rows > T_LAT) for (int r = T_LAT + gw; r < T_rows; r += NGW) { prep(2); row(r); }
}
struct Args { const float* in[22]; float* out; unsigned char* ws; };
enum { I_X = 0, I_C, I_CTX, I_CCTX, I_WMOD, I_BMOD, I_G1, I_G2, I_WIN, I_SINK, I_RPB, I_LAMBDA, I_SUBLN, I_WBA, I_WBB, I_WBC, I_WOUT, I_PWQ, I_PKEYS, I_PU, I_PV, I_GFINAL };

__device__ __forceinline__ int rope_perm(int c) {
    if (c < 640 || (c >= 2304 && c < 3328)) { const int w = c & 63; return (c & ~63) + 2 * (w & 31) + (w >> 5); }
    return c;
}
template <bool PERM = false>
__device__ __forceinline__ void p0_transpose_item(const float* W, int K, int N, bf16* WT, LAS float* scr, int item, int lane) {
    const int nblk = N / 32, kb = item / nblk, nb = item % nblk, k0 = 64 * kb, n0 = 32 * nb;
    {
        f32x4 w[8];
        const float* src = W + (size_t)(k0 + (lane >> 3)) * N + n0 + 4 * (lane & 7);
#pragma unroll
        for (int i = 0; i < 8; ++i) w[i] = *(const GAS f32x4*)(src + (size_t)(8 * i) * N);
#pragma unroll
        for (int i = 0; i < 8; ++i) { LAS float* d = scr + (8 * i + (lane >> 3)) * 33 + 4 * (lane & 7); d[0] = w[i].x; d[1] = w[i].y; d[2] = w[i].z; d[3] = w[i].w; }
    }
    asm volatile("s_waitcnt lgkmcnt(0)" ::: "memory");
    const int c = lane & 7;
#pragma unroll
    for (int j = 0; j < 4; ++j) { const int n = (lane >> 3) + 8 * j; const LAS float* s = scr + (8 * c) * 33 + n;
        v4u o; o.x = pk2(s[0 * 33], s[1 * 33]); o.y = pk2(s[2 * 33], s[3 * 33]); o.z = pk2(s[4 * 33], s[5 * 33]); o.w = pk2(s[6 * 33], s[7 * 33]);
        const int nout = PERM ? rope_perm(n0 + n) : (n0 + n);
        *(GAS v4u*)(WT + (size_t)nout * K + k0 + 8 * c) = o; }
    asm volatile("s_waitcnt lgkmcnt(0)" ::: "memory");
}

template <int UNR = 2, int NN = 4>
__device__ __forceinline__ void sgemm_tile(f32x4 (&acc)[4][NN], const bf16* A, int lda, const bf16* Bt, int ldb, int K, int row0, int col0, int lane) {
    const int fr = lane & 15, fq = lane >> 4;
    const bf16* ap = A + (size_t)(row0 + fr) * lda + fq * 8;
    const bf16* bp = Bt + (size_t)(col0 + fr) * ldb + fq * 8;
#pragma unroll UNR
    for (int k = 0; k < K; k += 32) {
        bf16x8 a[4], b[NN];
#pragma unroll
        for (int m = 0; m < 4; ++m) a[m] = *(const GAS bf16x8*)(ap + (size_t)m * 16 * lda + k);
#pragma unroll
        for (int n = 0; n < NN; ++n) b[n] = *(const GAS bf16x8*)(bp + (size_t)n * 16 * ldb + k);
#pragma unroll
        for (int m = 0; m < 4; ++m)
#pragma unroll
            for (int n = 0; n < NN; ++n) acc[m][n] = __builtin_amdgcn_mfma_f32_16x16x32_bf16(a[m], b[n], acc[m][n], 0, 0, 0);
    }
}
template <int UNR>
__device__ __forceinline__ void sgemm32(f32x4 (&acc)[2][2], const bf16* A, int lda, const bf16* Bt, int ldb, int K, int row0, int col0, int lane) {
    const int fr = lane & 15, fq = lane >> 4;
    const bf16* ap = A + (size_t)(row0 + fr) * lda + fq * 8;
    const bf16* bp = Bt + (size_t)(col0 + fr) * ldb + fq * 8;
#pragma unroll 1
    for (int k0 = 0; k0 < K; k0 += 32 * UNR) {
        bf16x8 a[UNR][2], b[UNR][2];
#pragma unroll
        for (int u = 0; u < UNR; ++u)
#pragma unroll
            for (int m = 0; m < 2; ++m) { a[u][m] = *(const GAS bf16x8*)(ap + (size_t)m * 16 * lda + k0 + 32 * u); b[u][m] = *(const GAS bf16x8*)(bp + (size_t)m * 16 * ldb + k0 + 32 * u); }
#pragma unroll
        for (int u = 0; u < UNR; ++u)
#pragma unroll
            for (int m = 0; m < 2; ++m)
#pragma unroll
                for (int n = 0; n < 2; ++n) acc[m][n] = __builtin_amdgcn_mfma_f32_16x16x32_bf16(a[u][m], b[u][n], acc[m][n], 0, 0, 0);
    }
}
__device__ __forceinline__ void zero_acc22(f32x4 (&acc)[2][2]) { acc[0][0] = acc[0][1] = acc[1][0] = acc[1][1] = (f32x4){0.f, 0.f, 0.f, 0.f}; }
template <int NN>
__device__ __forceinline__ void zero_acc(f32x4 (&acc)[4][NN]) {
#pragma unroll
    for (int m = 0; m < 4; ++m)
#pragma unroll
        for (int n = 0; n < NN; ++n) acc[m][n] = (f32x4){0.f, 0.f, 0.f, 0.f};
}

__device__ __forceinline__ int f2ord(float f) { const int b = __builtin_bit_cast(int, f); return b ^ ((b >> 31) & 0x7fffffff); }
__device__ __forceinline__ float ord2f(int o) { const int b = o ^ ((o >> 31) & 0x7fffffff); return __builtin_bit_cast(float, b); }
__device__ __forceinline__ void top16_insert(int (&top)[16], int key) {
#pragma unroll
    for (int i = 0; i < 16; ++i) { const int hi = max(top[i], key); key = min(top[i], key); top[i] = hi; }
}
#define CE(a, b) { const int t_ = max(a, b); b = min(a, b); a = t_; }
__device__ __forceinline__ void sort16_desc(int (&v)[16]) { CE(v[0], v[1]); CE(v[3], v[2]); CE(v[4], v[5]); CE(v[7], v[6]); CE(v[8], v[9]); CE(v[11], v[10]); CE(v[12], v[13]); CE(v[15], v[14]); CE(v[0], v[2]); CE(v[1], v[3]); CE(v[6], v[4]); CE(v[7], v[5]); CE(v[8], v[10]); CE(v[9], v[11]); CE(v[14], v[12]); CE(v[15], v[13]); CE(v[0], v[1]); CE(v[2], v[3]); CE(v[5], v[4]); CE(v[7], v[6]); CE(v[8], v[9]); CE(v[10], v[11]); CE(v[13], v[12]); CE(v[15], v[14]); CE(v[0], v[4]); CE(v[1], v[5]); CE(v[2], v[6]); CE(v[3], v[7]); CE(v[12], v[8]); CE(v[13], v[9]); CE(v[14], v[10]); CE(v[15], v[11]); CE(v[0], v[2]); CE(v[1], v[3]); CE(v[4], v[6]); CE(v[5], v[7]); CE(v[10], v[8]); CE(v[11], v[9]); CE(v[14], v[12]); CE(v[15], v[13]); CE(v[0], v[1]); CE(v[2], v[3]); CE(v[4], v[5]); CE(v[6], v[7]); CE(v[9], v[8]); CE(v[11], v[10]); CE(v[13], v[12]); CE(v[15], v[14]); CE(v[0], v[8]); CE(v[1], v[9]); CE(v[2], v[10]); CE(v[3], v[11]); CE(v[4], v[12]); CE(v[5], v[13]); CE(v[6], v[14]); CE(v[7], v[15]); CE(v[0], v[4]); CE(v[1], v[5]); CE(v[2], v[6]); CE(v[3], v[7]); CE(v[8], v[12]); CE(v[9], v[13]); CE(v[10], v[14]); CE(v[11], v[15]); CE(v[0], v[2]); CE(v[1], v[3]); CE(v[4], v[6]); CE(v[5], v[7]); CE(v[8], v[10]); CE(v[9], v[11]); CE(v[12], v[14]); CE(v[13], v[15]); CE(v[0], v[1]); CE(v[2], v[3]); CE(v[4], v[5]); CE(v[6], v[7]); CE(v[8], v[9]); CE(v[10], v[11]); CE(v[12], v[13]); CE(v[14], v[15]); }
__device__ __forceinline__ void merge16_desc(int (&a)[16], const int (&b)[16]) {
#pragma unroll
    for (int i = 0; i < 16; ++i) a[i] = max(a[i], b[15 - i]);
    CE(a[0], a[8]); CE(a[1], a[9]); CE(a[2], a[10]); CE(a[3], a[11]); CE(a[4], a[12]); CE(a[5], a[13]); CE(a[6], a[14]); CE(a[7], a[15]); CE(a[0], a[4]); CE(a[1], a[5]); CE(a[2], a[6]); CE(a[3], a[7]); CE(a[8], a[12]); CE(a[9], a[13]); CE(a[10], a[14]); CE(a[11], a[15]); CE(a[0], a[2]); CE(a[1], a[3]); CE(a[4], a[6]); CE(a[5], a[7]); CE(a[8], a[10]); CE(a[9], a[11]); CE(a[12], a[14]); CE(a[13], a[15]); CE(a[0], a[1]); CE(a[2], a[3]); CE(a[4], a[5]); CE(a[6], a[7]); CE(a[8], a[9]); CE(a[10], a[11]); CE(a[12], a[13]); CE(a[14], a[15]); }
#undef CE


typedef float f32x16 __attribute__((ext_vector_type(16)));
typedef short s16x4 __attribute__((ext_vector_type(4)));
typedef __bf16 bf16x2_t __attribute__((ext_vector_type(2)));
__device__ __forceinline__ unsigned cvtpk(float lo, float hi) { f32x2 v = {lo, hi}; bf16x2_t b = __builtin_convertvector(v, bf16x2_t); return __builtin_bit_cast(unsigned, b); }
constexpr int CK_PITCH = 144, CV_PITCH = 320;
constexpr int CK_SZ = 64 * CK_PITCH, CV_SZ = 64 * CV_PITCH;
constexpr float C_THR_RAW = 8.0f / SCL2;

template <int NDV, class RowFn, class UseFn, class ElemFn>
__device__ __forceinline__ void attn64_pass(f32x16 (&o)[NDV], float& mrun, float& lpart, const bf16x8 (&qf)[4], const bf16* kg, int kpitch, const bf16* vg, int vpitch,
                                            int ntiles, RowFn tile_row, UseFn use_tile, ElemFn elem, LAS unsigned char* L, int lane, int tid) {
    constexpr int VP = NDV * 64 + 64, VSZ = 64 * VP, NVP = NDV / 2;
    const int r32 = lane & 31, hi = lane >> 5;
    const int krow_s = tid >> 3, kch_s = tid & 7;
    const int vrow_s = (NDV == 2) ? (tid >> 3) : (tid >> 4), vch_s = (NDV == 2) ? (tid & 7) : (tid & 15);
    LAS unsigned char* Kb0 = L; LAS unsigned char* Vb0 = L + 2 * CK_SZ;
    __syncthreads();
    {
        const int tr = tile_row(0);
        const v4u kr = *(const GAS v4u*)(kg + (size_t)tr * kpitch);
        *(LAS v4u*)(Kb0 + krow_s * CK_PITCH + kch_s * 16) = kr;
#pragma unroll
        for (int i = 0; i < NVP; ++i) { const v4u v = *(const GAS v4u*)(vg + (size_t)(tr + 32 * i) * vpitch); *(LAS v4u*)(Vb0 + (vrow_s + 32 * i) * VP + vch_s * 16) = v; }
    }
    v4u kr, vr[NVP];
    { const int tr = tile_row(ntiles > 1 ? 1 : 0); kr = *(const GAS v4u*)(kg + (size_t)tr * kpitch);
#pragma unroll
      for (int i = 0; i < NVP; ++i) vr[i] = *(const GAS v4u*)(vg + (size_t)(tr + 32 * i) * vpitch); }
    __syncthreads();
#pragma unroll 1
    for (int j = 0; j < ntiles; ++j) {
        const int cur = j & 1;
        const LAS unsigned char* Kb = Kb0 + cur * CK_SZ; const LAS unsigned char* Vb = Vb0 + cur * VSZ;
        const bool more = (j + 1 < ntiles);
        v4u kr2, vr2[NVP];
        { const int tr = tile_row(j + 2 < ntiles ? j + 2 : ntiles - 1); kr2 = *(const GAS v4u*)(kg + (size_t)tr * kpitch);
#pragma unroll
            for (int i = 0; i < NVP; ++i) vr2[i] = *(const GAS v4u*)(vg + (size_t)(tr + 32 * i) * vpitch); }
        if (use_tile(j)) {
            f32x16 st[2];
#pragma unroll
            for (int kb = 0; kb < 2; ++kb) {
#pragma unroll
                for (int r = 0; r < 16; ++r) st[kb][r] = 0.f;
#pragma unroll
                for (int ks = 0; ks < 4; ++ks) {
                    const bf16x8 kf = *(const LAS bf16x8*)(Kb + (kb * 32 + r32) * CK_PITCH + ks * 32 + hi * 16);
                    st[kb] = __builtin_amdgcn_mfma_f32_32x32x16_bf16(kf, qf[ks], st[kb], 0, 0, 0);
                }
            }
            elem(st, j);
            float mx = st[0][0];
#pragma unroll
            for (int r = 1; r < 16; ++r) mx = fmaxf(mx, st[0][r]);
#pragma unroll
            for (int r = 0; r < 16; ++r) mx = fmaxf(mx, st[1][r]);
            mx = xmax32(mx);
            if (__builtin_amdgcn_ballot_w64(mx > mrun + C_THR_RAW) != 0ull) {
                const float mn = fmaxf(mrun, mx);
                const float alpha = __builtin_amdgcn_exp2f((mrun - mn) * SCL2);
#pragma unroll
                for (int d = 0; d < NDV; ++d)
#pragma unroll
                    for (int r = 0; r < 16; ++r) o[d][r] *= alpha;
                lpart *= alpha; mrun = mn;
            }
            const float nmc = -mrun * SCL2;
            float ls = 0.f;
#pragma unroll
            for (int kb = 0; kb < 2; ++kb)
#pragma unroll
                for (int r = 0; r < 16; ++r) { const float p = __builtin_amdgcn_exp2f(fmaf(st[kb][r], SCL2, nmc)); st[kb][r] = p; ls += p; }
            lpart += ls;
            const int q4 = (lane & 15) >> 2, p4 = lane & 3, grp = (lane >> 4) & 1;
            const LAS unsigned char* vbase = Vb + (4 * hi + q4) * VP + (16 * grp + 4 * p4) * 2;
#pragma unroll
            for (int kb = 0; kb < 2; ++kb)
#pragma unroll
                for (int ss = 0; ss < 2; ++ss) {
                    v4u pw;
#pragma unroll
                    for (int i2 = 0; i2 < 4; ++i2) pw[i2] = cvtpk(st[kb][8 * ss + 2 * i2], st[kb][8 * ss + 2 * i2 + 1]);
                    const bf16x8 pb = __builtin_bit_cast(bf16x8, pw);
#pragma unroll
                    for (int d = 0; d < NDV; ++d) {
                        const LAS unsigned char* va = vbase + (kb * 32 + 16 * ss) * VP + d * 64;
                        const s16x4 lo = __builtin_bit_cast(s16x4, __builtin_amdgcn_ds_read_tr16_b64_v4i16((LAS s16x4*)va));
                        const s16x4 hh = __builtin_bit_cast(s16x4, __builtin_amdgcn_ds_read_tr16_b64_v4i16((LAS s16x4*)(va + 8 * VP)));
                        const bf16x8 vf = __builtin_shufflevector(lo, hh, 0, 1, 2, 3, 4, 5, 6, 7);
                        o[d] = __builtin_amdgcn_mfma_f32_32x32x16_bf16(vf, pb, o[d], 0, 0, 0);
                    }
                }
        }
        if (more) {
            LAS unsigned char* Kn = Kb0 + (cur ^ 1) * CK_SZ; LAS unsigned char* Vn = Vb0 + (cur ^ 1) * VSZ;
            *(LAS v4u*)(Kn + krow_s * CK_PITCH + kch_s * 16) = kr;
#pragma unroll
            for (int i = 0; i < NVP; ++i) *(LAS v4u*)(Vn + (vrow_s + 32 * i) * VP + vch_s * 16) = vr[i];
        }
        kr = kr2;
#pragma unroll
        for (int i = 0; i < NVP; ++i) vr[i] = vr2[i];
        __syncthreads();
    }
}
__device__ __forceinline__ void attn64_store(const f32x16 (&o)[2], float inv, bf16* yrow, int hi) {
#pragma unroll
    for (int d = 0; d < 2; ++d)
#pragma unroll
        for (int g4 = 0; g4 < 4; ++g4) {
            v2u w; w.x = cvtpk(o[d][4 * g4] * inv, o[d][4 * g4 + 1] * inv); w.y = cvtpk(o[d][4 * g4 + 2] * inv, o[d][4 * g4 + 3] * inv);
            *(GAS v2u*)(yrow + d * 32 + 8 * g4 + 4 * hi) = w;
        }
}

namespace pg8 {
typedef unsigned short bf16_t;
constexpr int BM = 256, BK = 64, HALF = 128, HTB = HALF * BK * 2, STAGE_BYTES = 8 * HTB, NXCD = 8, WGM = 8;
__host__ __device__ __forceinline__ int lds_byte(int r, int c) { const int st = (r >> 4) * 2 + (c >> 5), rr = r & 15, cc = c & 31, ob = rr * 64 + cc * 2; return st * 1024 + (ob ^ (((ob >> 9) & 1) << 5)); }
__host__ __device__ __forceinline__ void stage_rc(int b, int& R, int& C) { const int st = b / 1024, sb = b % 1024, swz = sb ^ (((sb >> 9) & 1) << 5); R = (st >> 1) * 16 + swz / 64; C = (st & 1) * 32 + (swz % 64) / 2; }
__host__ __device__ __forceinline__ int perm32(int rho) { const int n = rho >> 4, i = rho & 15; return 8 * (i >> 2) + 4 * n + (i & 3); }
struct Unit { int pm, pn, seg; };
struct Gemm { const bf16_t* A; const bf16_t* Bt; int lda, ldb, K; size_t a_seg, b_seg; };
struct TileOrder {
    int nM, nN, nwg, G, c;
    __device__ void init(int M, int N, int G_, int c_) { nM = M / BM; nN = N / BM; nwg = nM * nN; G = G_; c = c_; }
    __device__ bool tile(int i, int& pm, int& pn) const {
        const long L = (long)i * G + c; if (L >= nwg) return false;
        int wgid = (int)L; { const int q = nwg / NXCD, r = nwg % NXCD, xcd = wgid % NXCD, off = wgid / NXCD; wgid = (xcd < r ? xcd * (q + 1) : r * (q + 1) + (xcd - r) * q) + off; }
        const int nig = WGM * nN, gid = wgid / nig, fm = gid * WGM, gsz = (nM - fm) < WGM ? (nM - fm) : WGM;
        pm = fm + ((wgid % nig) % gsz); pn = (wgid % nig) / gsz; return true;
    }
};
template <int NSEG> struct SegOrder {
    TileOrder T;
    __device__ bool next(int i, Unit& u) const { u.seg = i % NSEG; return T.tile(i / NSEG, u.pm, u.pn); }
};
template <class Epi, class Sched>
__device__ __forceinline__ void gemm_phase(LAS unsigned char* lds, const Gemm g, const Sched& S, const Epi& E, int wid) {
    const int lane = lane_id_v(), tid = wid * 64 + lane,
              wr = wid >> 2, wc = wid & 3, fr = lane & 15, fq = lane >> 4;
    const int K = g.K, nt = K / BK;
    unsigned voffA[2], voffB[2];
#pragma unroll
    for (int i = 0; i < 2; ++i) { int R, C; stage_rc(tid * 16 + i * 8192, R, C); const int Rb = (R & ~31) + perm32(R & 31);
        voffA[i] = (unsigned)(R * g.lda + C) * 2u; voffB[i] = (unsigned)(Rb * g.ldb + C) * 2u; }
    const size_t kstep = (size_t)(BK * 2);
    const size_t hstepA = (size_t)HALF * g.lda * 2, hstepB = (size_t)HALF * g.ldb * 2;
    const unsigned ldsw = (unsigned)wid * 1024u;
    const int aoff = lds_byte(wr * 64 + fr, fq * 8), boff = lds_byte(wc * 32 + fr, fq * 8);
#define PG8_SA(b, h) (((b) * 2 + (h)) * HTB)
#define PG8_SB(b, h) ((4 + (b) * 2 + (h)) * HTB)
#define PG8_STAGE(bufoff, gbase, voff) do { _Pragma("unroll") for (int _i = 0; _i < 2; ++_i) \
        __builtin_amdgcn_global_load_lds((const unsigned*)((const char*)(gbase) + (voff)[_i]), (LAS unsigned*)(lds + (bufoff) + ldsw + _i * 8192), 16, 0, 0); } while (0)
#define PG8_LDA(dst, b, h) do { _Pragma("unroll") for (int m = 0; m < 4; ++m) _Pragma("unroll") for (int k = 0; k < 2; ++k) dst[m][k] = *(const LAS bf16x8*)(lds + PG8_SA(b, h) + aoff + m * 2048 + k * 1024); } while (0)
#define PG8_LDB(dst, b, h) do { _Pragma("unroll") for (int n = 0; n < 2; ++n) _Pragma("unroll") for (int k = 0; k < 2; ++k) dst[n][k] = *(const LAS bf16x8*)(lds + PG8_SB(b, h) + boff + n * 2048 + k * 1024); } while (0)
#define PG8_MMA(ai, bj, At, Bt) do { __builtin_amdgcn_s_setprio(1); _Pragma("unroll") for (int m = 0; m < 4; ++m) _Pragma("unroll") for (int n = 0; n < 2; ++n) _Pragma("unroll") for (int k = 0; k < 2; ++k) \
        acc[ai][bj][m][n] = __builtin_amdgcn_mfma_f32_16x16x32_bf16(Bt[n][k], At[m][k], acc[ai][bj][m][n], 0, 0, 0); __builtin_amdgcn_s_setprio(0); } while (0)
#define PG8_WAIT_V(n) asm volatile("s_waitcnt vmcnt(" #n ")" ::: "memory")
#define PG8_WAIT_L(n) asm volatile("s_waitcnt lgkmcnt(" #n ")" ::: "memory")
#define PG8_BAR __builtin_amdgcn_s_barrier()
#define PG8_SCHED __builtin_amdgcn_sched_barrier(0)
#define PG8_ABASE(u) ((const char*)g.A + ((size_t)(u).seg * g.a_seg + (size_t)(u).pm * BM * g.lda) * 2)
#define PG8_BBASE(u) ((const char*)g.Bt + ((size_t)(u).seg * g.b_seg + (size_t)(u).pn * BM * g.ldb) * 2)
    Unit cur, nxt; int ui = 0;
    if (!S.next(0, cur)) return;
    f32x4 acc[2][2][4][2];
#pragma unroll
    for (int a = 0; a < 2; ++a)
#pragma unroll
        for (int b = 0; b < 2; ++b)
#pragma unroll
            for (int m = 0; m < 4; ++m)
#pragma unroll
                for (int n = 0; n < 2; ++n) acc[a][b][m][n] = (f32x4){0.f, 0.f, 0.f, 0.f};
    bf16x8 At[4][2], B0[2][2], B1[2][2];
    const char* cA = PG8_ABASE(cur); const char* cB = PG8_BBASE(cur);
    PG8_STAGE(PG8_SB(0, 0), cB, voffB); PG8_STAGE(PG8_SB(0, 1), cB + hstepB, voffB); PG8_STAGE(PG8_SA(0, 0), cA, voffA); PG8_STAGE(PG8_SA(0, 1), cA + hstepA, voffA);
    if (wr == 1) PG8_BAR;
    PG8_WAIT_V(2); PG8_BAR;
    PG8_STAGE(PG8_SB(1, 0), cB + kstep, voffB); PG8_STAGE(PG8_SA(1, 0), cA + kstep, voffA); PG8_STAGE(PG8_SB(1, 1), cB + hstepB + kstep, voffB);
    PG8_WAIT_V(6); PG8_BAR;
    for (;;) {
        const bool has_next = S.next(ui + 1, nxt);
        const char* nA = has_next ? PG8_ABASE(nxt) : cA; const char* nB = has_next ? PG8_BBASE(nxt) : cB;
        for (int t = 0; t < nt; t += 2) {
            const bool lastk = (t == nt - 2);
            const char* a1 = cA + (size_t)(t + 1) * kstep;
            const char* a2 = lastk ? nA : cA + (size_t)(t + 2) * kstep; const char* b2 = lastk ? nB : cB + (size_t)(t + 2) * kstep;
            const char* a3 = a2 + kstep; const char* b3 = b2 + kstep;
            PG8_LDB(B0, 0, 0); PG8_LDB(B1, 0, 1); PG8_SCHED; PG8_LDA(At, 0, 0); PG8_STAGE(PG8_SA(1, 1), a1 + hstepA, voffA);
            PG8_WAIT_V(8); PG8_WAIT_L(0); PG8_BAR; PG8_MMA(0, 0, At, B0); PG8_MMA(0, 1, At, B1); PG8_BAR; PG8_SCHED;
            PG8_LDA(At, 0, 1); PG8_STAGE(PG8_SB(0, 0), b2, voffB); PG8_STAGE(PG8_SB(0, 1), b2 + hstepB, voffB); PG8_STAGE(PG8_SA(0, 0), a2, voffA);
            PG8_WAIT_V(8); PG8_WAIT_L(0); PG8_BAR; PG8_MMA(1, 0, At, B0); PG8_MMA(1, 1, At, B1); PG8_BAR; PG8_SCHED;
            PG8_LDB(B0, 1, 0); PG8_LDB(B1, 1, 1); PG8_SCHED; PG8_LDA(At, 1, 0); PG8_STAGE(PG8_SA(0, 1), a2 + hstepA, voffA);
            PG8_WAIT_V(8); PG8_WAIT_L(0); PG8_BAR; PG8_MMA(0, 0, At, B0); PG8_MMA(0, 1, At, B1); PG8_BAR; PG8_SCHED;
            PG8_LDA(At, 1, 1); PG8_STAGE(PG8_SB(1, 0), b3, voffB); PG8_STAGE(PG8_SB(1, 1), b3 + hstepB, voffB); PG8_STAGE(PG8_SA(1, 0), a3, voffA);
            PG8_WAIT_V(8); PG8_WAIT_L(0); PG8_BAR; PG8_MMA(1, 0, At, B0); PG8_MMA(1, 1, At, B1); PG8_BAR; PG8_SCHED;
        }
        if (wr == 0) PG8_BAR;
        E(acc, cur, wr, wc, fr, fq);
        if (!has_next) break;
#pragma unroll
        for (int a = 0; a < 2; ++a)
#pragma unroll
            for (int b = 0; b < 2; ++b)
#pragma unroll
                for (int m = 0; m < 4; ++m)
#pragma unroll
                    for (int n = 0; n < 2; ++n) acc[a][b][m][n] = (f32x4){0.f, 0.f, 0.f, 0.f};
        cur = nxt; cA = nA; cB = nB; ++ui;
        if (wr == 1) PG8_BAR;
    }
    PG8_WAIT_V(0);
    PG8_BAR;
#undef PG8_SA
#undef PG8_SB
#undef PG8_STAGE
#undef PG8_LDA
#undef PG8_LDB
#undef PG8_MMA
#undef PG8_WAIT_V
#undef PG8_WAIT_L
#undef PG8_BAR
#undef PG8_SCHED
#undef PG8_ABASE
#undef PG8_BBASE
}
}

__device__ __forceinline__ v4u pack8(const f32x4& a, const f32x4& b) { v4u w; w.x = cvtpk(a.x, a.y); w.y = cvtpk(a.z, a.w); w.z = cvtpk(b.x, b.y); w.w = cvtpk(b.z, b.w); return w; }
struct EpiInProj {
    bf16 *AQ, *AK, *AVT, *BQ, *BK, *BVT, *CQ, *CK, *CV, *SG; const float *COS, *SIN;
    __device__ __forceinline__ void operator()(const f32x4 (&acc)[2][2][4][2], const pg8::Unit& u, int wr, int wc, int fr, int fq) const {
        asm volatile("" : "+v"(fr), "+v"(fq));
#pragma unroll
        for (int bj = 0; bj < 2; ++bj) {
            const int cblk = u.pn * 256 + bj * 128;
            const int cw = wc * 32 + 8 * fq;
            bf16* dst; int pitch, cbase; int kind;
            int nh = 1, hd = 0; float qs = 1.0f;
            if (cblk < 512)       { dst = AQ; pitch = 512; cbase = cblk; kind = 1; }
            else if (cblk < 640)  { dst = AK; pitch = 128; cbase = cblk - 512; kind = 1; }
            else if (cblk < 768)  { dst = AVT; pitch = 128; cbase = cblk - 640; kind = 0; }
            else if (cblk < 1280) { dst = BQ; pitch = 512; cbase = cblk - 768; kind = 0; }
            else if (cblk < 1792) { dst = BK; pitch = 512; cbase = cblk - 1280; kind = 0; }
            else if (cblk < 2304) { dst = BVT; pitch = 512; cbase = cblk - 1792; kind = 0; }
            else if (cblk < 2816) { dst = CQ; pitch = 512; cbase = cblk - 2304; kind = 1; qs = SCL2; }
            else if (cblk < 3328) { dst = CK; pitch = 512; cbase = cblk - 2816; kind = 1; }
            else if (cblk < 3840) { dst = CV; pitch = 512; cbase = cblk - 3328; kind = 0; }
            else                  { dst = SG; pitch = 3072; cbase = cblk - 3840; kind = 3; }
#pragma unroll
            for (int ai = 0; ai < 2; ++ai)
#pragma unroll
                for (int m = 0; m < 4; ++m) {
                    const int row = u.pm * 256 + ai * 128 + wr * 64 + m * 16 + fr;
                    f32x4 v0 = acc[ai][bj][m][0], v1 = acc[ai][bj][m][1];
                    if (kind == 1) {
                        if (row < T_LAT) {
                            const int t = row & (SEQ - 1), i0 = (cw & 63) >> 1;
                            const f32x4 cs = *(const GAS f32x4*)(COS + t * 32 + i0), sn = *(const GAS f32x4*)(SIN + t * 32 + i0);
                            const f32x4 a = v0, b = v1;
                            v0.x = a.x * cs.x - a.y * sn.x; v0.y = a.y * cs.x + a.x * sn.x; v0.z = a.z * cs.y - a.w * sn.y; v0.w = a.w * cs.y + a.z * sn.y;
                            v1.x = b.x * cs.z - b.y * sn.z; v1.y = b.y * cs.z + b.x * sn.z; v1.z = b.z * cs.w - b.w * sn.w; v1.w = b.w * cs.w + b.z * sn.w;
                        }
                        *(GAS v4u*)(dst + (size_t)row * pitch + cbase + cw) = pack8(v0 * qs, v1 * qs);
                    } else if (kind == 0) {
                        *(GAS v4u*)(dst + (size_t)row * pitch + cbase + cw) = pack8(v0, v1);
                    } else if (kind == 3) {
                        v0.x = sigmoid_fast(v0.x); v0.y = sigmoid_fast(v0.y); v0.z = sigmoid_fast(v0.z); v0.w = sigmoid_fast(v0.w);
                        v1.x = sigmoid_fast(v1.x); v1.y = sigmoid_fast(v1.y); v1.z = sigmoid_fast(v1.z); v1.w = sigmoid_fast(v1.w);
                        *(GAS v4u*)(dst + (size_t)row * pitch + cbase + cw) = pack8(v0, v1);
                    } else {
                        const int hc = hd + cw, head = hc >> 6, d = hc & 63;
                        const int b = row_batch(row), tok = row_tok(row);
                        bf16* vp = dst + ((size_t)(b * nh + head) * 64 + d) * NTOK + tok;
                        vp[0 * NTOK] = (bf16)f2bf(v0.x); vp[1 * NTOK] = (bf16)f2bf(v0.y); vp[2 * NTOK] = (bf16)f2bf(v0.z); vp[3 * NTOK] = (bf16)f2bf(v0.w);
                        vp[4 * NTOK] = (bf16)f2bf(v1.x); vp[5 * NTOK] = (bf16)f2bf(v1.y); vp[6 * NTOK] = (bf16)f2bf(v1.z); vp[7 * NTOK] = (bf16)f2bf(v1.w);
                    }
                }
        }
    }
};
__device__ __forceinline__ void unpack8(const v4u& w, f32x4& a, f32x4& b) {
    a = (f32x4){bf2f(w.x & 0xffffu), bf2f(w.x >> 16), bf2f(w.y & 0xffffu), bf2f(w.y >> 16)}; b = (f32x4){bf2f(w.z & 0xffffu), bf2f(w.z >> 16), bf2f(w.w & 0xffffu), bf2f(w.w >> 16)};
}
struct EpiBranch {
    const bf16* SG; bf16* MG;
    __device__ __forceinline__ void operator()(const f32x4 (&acc)[2][2][4][2], const pg8::Unit& u, int wr, int wc, int fr, int fq) const {
        asm volatile("" : "+v"(fr), "+v"(fq));
#pragma unroll
        for (int ai = 0; ai < 2; ++ai)
#pragma unroll
            for (int m = 0; m < 4; ++m) {
                const int row = u.pm * 256 + ai * 128 + wr * 64 + m * 16 + fr;
#pragma unroll
                for (int bj = 0; bj < 2; ++bj) {
                    const int col = u.pn * 256 + bj * 128 + wc * 32 + 8 * fq;
                    f32x4 g0, g1; { const v4u wg = *(const GAS v4u*)(SG + (size_t)row * 3072 + u.seg * 1024 + col); unpack8(wg, g0, g1); }
                    f32x4 v0 = g0 * acc[ai][bj][m][0], v1 = g1 * acc[ai][bj][m][1];
                    bf16* mp = MG + (size_t)row * D + col;
                    if (u.seg > 0) { f32x4 p0, p1; const v4u wp = *(const GAS v4u*)mp; unpack8(wp, p0, p1); v0 += p0; v1 += p1; }
                    *(GAS v4u*)mp = pack8(v0, v1);
                }
            }
    }
};
struct EpiOut {
    float* X; const float* gtl; const float* xin; const float* cin;
    __device__ __forceinline__ void operator()(const f32x4 (&acc)[2][2][4][2], const pg8::Unit& u, int wr, int wc, int fr, int fq) const {
        asm volatile("" : "+v"(fr), "+v"(fq));
#pragma unroll
        for (int ai = 0; ai < 2; ++ai)
#pragma unroll
            for (int m = 0; m < 4; ++m) {
                const int row = u.pm * 256 + ai * 128 + wr * 64 + m * 16 + fr;
                const float* gt = gtl + (size_t)row_modidx(row) * 6 * D + 2 * D;
#pragma unroll
                for (int bj = 0; bj < 2; ++bj) {
                    const int col = u.pn * 256 + bj * 128 + wc * 32 + 8 * fq;
                    GAS f32x4* xp = (GAS f32x4*)(X + (size_t)row * D + col);
                    const GAS f32x4* sp = xin ? (const GAS f32x4*)(xin_row(xin, cin, row) + col) : (const GAS f32x4*)xp;
                    const f32x4 g0 = *(const GAS f32x4*)(gt + col), g1 = *(const GAS f32x4*)(gt + col + 4);
                    xp[0] = sp[0] + g0 * acc[ai][bj][m][0]; xp[1] = sp[1] + g1 * acc[ai][bj][m][1];
                }
            }
    }
};
struct EpiStore {
    bf16* O; int ldc;
    __device__ __forceinline__ void operator()(const f32x4 (&acc)[2][2][4][2], const pg8::Unit& u, int wr, int wc, int fr, int fq) const {
        asm volatile("" : "+v"(fr), "+v"(fq));
#pragma unroll
        for (int ai = 0; ai < 2; ++ai)
#pragma unroll
            for (int m = 0; m < 4; ++m) {
                const int row = u.pm * 256 + ai * 128 + wr * 64 + m * 16 + fr;
#pragma unroll
                for (int bj = 0; bj < 2; ++bj) {
                    const int col = u.pn * 256 + bj * 128 + wc * 32 + 8 * fq;
                    *(GAS v4u*)(O + (size_t)row * ldc + col) = pack8(acc[ai][bj][m][0], acc[ai][bj][m][1]);
                }
            }
    }
};

__global__ void __launch_bounds__(NTHREADS, 2) mega_fwd(Args args) {
    extern __shared__ __attribute__((aligned(16))) unsigned char lds[];
    LAS unsigned char* L = (LAS unsigned char*)lds;
    volatile LAS unsigned* MISC = (volatile LAS unsigned*)(L + MISC_OFF);
    const int wave = __builtin_amdgcn_readfirstlane((int)threadIdx.x >> 6);
    const int lane = lane_id_v(), tid = wave * 64 + lane;
    const int fr = lane & 15, fq = lane >> 4;
    const int G = gridDim.x;
    const int vcu = (G % 8 == 0) ? (int)(blockIdx.x % 8) * (G / 8) + (int)(blockIdx.x / 8) : (int)blockIdx.x;
    for (int u = tid; u < (LDS_BYTES - 131072) / 4; u += NTHREADS) ((LAS unsigned*)(L + 131072))[u] = 0u;
    __syncthreads();
    unsigned char* ws = args.ws;
    gu32* ctl = (gu32*)(ws + WS_CTL);
    (void)xcd_barrier_post((unsigned*)(ctl + CW_BAR), MISC + 8);
    if (tid == 0) MISC[12] = xb_add((unsigned*)(ctl + CW_RANK) + 64 * xb_xcc_id(), 1u);
    __syncthreads();
#define GRID_BAR() do { unsigned* bp_ = (unsigned*)(args.ws + WS_CTL) + CW_BAR; asm volatile("" : "+s"(bp_)); XcdBarrier b_; b_.bar = bp_; b_.x = xb_xcc_id(); b_.st = MISC + 8; xcd_barrier(b_, wave == 0 && lane_id_v() == 0); } while (0)
    const int gw = vcu * NWAVES + wave, NGW = G * NWAVES;
    const int NGT = G * NTHREADS;

#define PHASE_PTRS \
    unsigned char* wsq = args.ws; asm volatile("" : "+s"(wsq)); \
    const float* const* IN_ = (const float* const*)__builtin_amdgcn_kernarg_segment_ptr(); asm volatile("" : "+s"(IN_)); \
    float* MODV = (float*)(wsq + WS_MOD); float* COS = (float*)(wsq + WS_COS); float* SIN = (float*)(wsq + WS_SIN); \
    bf16* WIN = (bf16*)(wsq + WS_WIN); bf16* WB = (bf16*)(wsq + WS_WB); bf16* WO = (bf16*)(wsq + WS_WO); bf16* WQ = (bf16*)(wsq + WS_WQ); bf16* KEYS = (bf16*)(wsq + WS_KEYS); \
    float* X = (float*)(wsq + WS_X); bf16* H = (bf16*)(wsq + WS_H); bf16* Y = (bf16*)(wsq + WS_Y); bf16* MG = (bf16*)(wsq + WS_MG); \
    unsigned* EI = (unsigned*)(wsq + WS_EI); float* EG = (float*)(wsq + WS_EG); \
    unsigned char* U8 = wsq + WS_U8; unsigned char* V8 = wsq + WS_V8; float* SCU = (float*)(wsq + WS_SCU); float* SCV = SCU + DEPTH * 16384; \
    bf16* AQ = (bf16*)(wsq + WS_AQ); bf16* AK = (bf16*)(wsq + WS_AK); bf16* AVT = (bf16*)(wsq + WS_AVT); \
    bf16* BQ = (bf16*)(wsq + WS_BQ); bf16* BK = (bf16*)(wsq + WS_BK); bf16* BVT = (bf16*)(wsq + WS_BVT); \
    bf16* CQ = (bf16*)(wsq + WS_CQ); bf16* CK = (bf16*)(wsq + WS_CK); bf16* CVT = (bf16*)(wsq + WS_CVT); \
    bf16* SG = (bf16*)(wsq + WS_SG); bf16* Q2 = (bf16*)(wsq + WS_Q2); float* SC = (float*)(wsq + WS_SC); \
    (void)MODV; (void)COS; (void)SIN; (void)WIN; (void)WB; (void)WO; (void)WQ; (void)KEYS; (void)X; (void)H; (void)Y; (void)MG; (void)EI; (void)EG; (void)U8; (void)V8; (void)SCU; (void)SCV; \
    (void)AQ; (void)AK; (void)AVT; (void)BQ; (void)BK; (void)BVT; (void)CQ; (void)CK; (void)CVT; (void)SG; (void)Q2; (void)SC; (void)IN_;
#define LAYER_PTRS const float* modl = MODV + (size_t)layer * 3 * 6 * D; const bf16* WINl = WIN + (size_t)layer * IN_W * D; (void)modl; (void)WINl;

#ifndef SKIP_P0
        { PHASE_PTRS
        for (int rep_ = 0; rep_ < REP_P0; ++rep_) {
    {
        LAS float* scr = (LAS float*)(L + wave * 16384);
        int gt = vcu * NTHREADS + tid; asm volatile("" : "+v"(gt));
        constexpr int I_IN = (D / 64) * (IN_W / 32), I_BR = (512 / 64) * (D / 32), I_O = (D / 64) * (D / 32), I_Q = (D / 64) * (2048 / 32);
        constexpr int PER_LAYER = I_IN + 3 * I_BR + I_O + I_Q;
        for (int rp_ = 0; rp_ < REP_P0A; ++rp_)
        for (int it = gw; it < DEPTH * PER_LAYER; it += NGW) {
            const int l = it / PER_LAYER; int r = it % PER_LAYER;
            if (r < I_IN) { p0_transpose_item<true>(IN_[I_WIN] + (size_t)l * D * IN_W, D, IN_W, WIN + (size_t)l * IN_W * D, scr, r, lane); continue; } r -= I_IN;
            if (r < I_BR) { p0_transpose_item(IN_[I_WBA] + (size_t)l * 512 * D, 512, D, WB + (size_t)(l * 3 + 0) * D * 512, scr, r, lane); continue; } r -= I_BR;
            if (r < I_BR) { p0_transpose_item(IN_[I_WBB] + (size_t)l * 512 * D, 512, D, WB + (size_t)(l * 3 + 1) * D * 512, scr, r, lane); continue; } r -= I_BR;
            if (r < I_BR) { p0_transpose_item(IN_[I_WBC] + (size_t)l * 512 * D, 512, D, WB + (size_t)(l * 3 + 2) * D * 512, scr, r, lane); continue; } r -= I_BR;
            if (r < I_O) { p0_transpose_item(IN_[I_WOUT] + (size_t)l * D * D, D, D, WO + (size_t)l * D * D, scr, r, lane); continue; } r -= I_O;
            p0_transpose_item(IN_[I_PWQ] + (size_t)l * D * 2048, D, 2048, WQ + (size_t)l * 2048 * D, scr, r, lane);
        }
        for (int i = gt; i < DEPTH * 16 * 128 * 128 / 4; i += NGT) {
            const f32x4 v = *((const GAS f32x4*)IN_[I_PKEYS] + i);
            v2u o; o.x = pk2(v.x, v.y); o.y = pk2(v.z, v.w); *((GAS v2u*)KEYS + i) = o;
        }
        {
            LAS float* red = (LAS float*)(L + 9216);
            for (int rp_ = 0; rp_ < REP_P0D; ++rp_)
            for (int it = vcu; it < DEPTH * 96; it += G) {
                const int l = it / 96, nc = it % 96, n = nc * 64 + lane;
                const float* wm = IN_[I_WMOD] + (size_t)l * D * 6 * D + n;
                float a0 = 0.f, a1 = 0.f, a2 = 0.f;
#pragma unroll 1
                for (int half = 0; half < 2; ++half) {
                    const int kb = wave * 128 + half * 64;
                    const float c0 = IN_[I_C][kb + lane], c1 = IN_[I_C][D + kb + lane], c2 = IN_[I_CCTX][kb + lane];
                    const int s0 = __builtin_bit_cast(int, c0 * sigmoidf_(c0)), s1 = __builtin_bit_cast(int, c1 * sigmoidf_(c1)), s2 = __builtin_bit_cast(int, c2 * sigmoidf_(c2));
#pragma unroll
                    for (int kk = 0; kk < 64; ++kk) {
                        const float w = wm[(size_t)(kb + kk) * 6 * D];
                        a0 += __builtin_bit_cast(float, __builtin_amdgcn_readlane(s0, kk)) * w;
                        a1 += __builtin_bit_cast(float, __builtin_amdgcn_readlane(s1, kk)) * w;
                        a2 += __builtin_bit_cast(float, __builtin_amdgcn_readlane(s2, kk)) * w;
                    }
                }
                red[(wave * 3 + 0) * 64 + lane] = a0; red[(wave * 3 + 1) * 64 + lane] = a1; red[(wave * 3 + 2) * 64 + lane] = a2;
                __syncthreads();
                if (wave < 3) {
                    float sum = IN_[I_BMOD][l * 6 * D + n];
#pragma unroll
                    for (int w = 0; w < 8; ++w) sum += red[(w * 3 + wave) * 64 + lane];
                    MODV[(size_t)(l * 3 + wave) * 6 * D + n] = sum;
                }
                __syncthreads();
            }
        }
        for (int i = gt; i < SEQ * 32; i += NGT) {
            const int t = i >> 5, f = i & 31;
            const float inv = exp2f(-(float)(f & 15) * (13.287712379549449f / 16.0f));
            const float pos = (f < 16) ? (float)(t / GRID_W) : (float)(t % GRID_W);
            float sn, cs; sincosf(pos * inv, &sn, &cs);
            COS[i] = cs; SIN[i] = sn;
        }
    }
        for (int rp_ = 0; rp_ < REP_P0F; ++rp_)
#pragma unroll 4
        for (int rr = gw; rr < 2 * DEPTH * 16384; rr += NGW) {
            const int tab = rr / (DEPTH * 16384), row = rr % (DEPTH * 16384);
            const float* src = (tab == 0 ? IN_[I_PU] : IN_[I_PV]) + (size_t)row * D;
            f32x4 v[4]; float am = 0.f;
#pragma unroll
            for (int j = 0; j < 4; ++j) { v[j] = *((const GAS f32x4*)src + lane + 64 * j); am = fmaxf(am, fmaxf(fmaxf(fabsf(v[j].x), fabsf(v[j].y)), fmaxf(fabsf(v[j].z), fabsf(v[j].w)))); }
            am = wave_max(am);
            const bool as_i8 = (P10_SLICED != 0) && (tab == 0);
            int ex = 0; float scale = 1.0f;
            if (am > 0.f) { (void)frexpf(am * (as_i8 ? (1.0f / 127.0f) : (1.0f / 448.0f)), &ex); scale = ldexpf(1.0f, ex); }
            const float inv = 1.0f / scale;
            v4u o;
#pragma unroll
            for (int j = 0; j < 4; ++j) {
                if (as_i8) {
                    const int q0 = __float2int_rn(v[j].x * inv), q1 = __float2int_rn(v[j].y * inv), q2 = __float2int_rn(v[j].z * inv), q3 = __float2int_rn(v[j].w * inv);
                    o[j] = (unsigned)(q0 & 255) | ((unsigned)(q1 & 255) << 8) | ((unsigned)(q2 & 255) << 16) | ((unsigned)q3 << 24);
                } else {
                    int p = __builtin_amdgcn_cvt_pk_fp8_f32(v[j].x * inv, v[j].y * inv, 0, false);
                    p = __builtin_amdgcn_cvt_pk_fp8_f32(v[j].z * inv, v[j].w * inv, p, true);
                    o[j] = (unsigned)p;
                }
            }
            *((GAS v4u*)((tab == 0 ? U8 : V8) + (size_t)row * D) + lane) = o;
            if (lane == 0) (tab == 0 ? SCU : SCV)[row] = scale;
        }
        }
        }
#endif
    GRID_BAR();

    for (int layer = 0; layer < DEPTH; ++layer) {
        const bool last = (layer == DEPTH - 1);
        const int T_EFF = last ? T_LAT : T_ALL;

#ifndef SKIP_P1
        { PHASE_PTRS LAYER_PTRS
        for (int rep_ = 0; rep_ < REP_P1; ++rep_) {
        { const int ln = lane_id_v();
        if (layer == 0) {
            f32x4 gm[4], shv[4];
            auto prep = [&](int midx) { const float* md = modl + (size_t)midx * 6 * D;
#pragma unroll
                for (int j = 0; j < 4; ++j) { const f32x4 g = *((const GAS f32x4*)(IN_[I_G1] + layer * D) + ln + 64 * j); const f32x4 sc = *((const GAS f32x4*)(md + D) + ln + 64 * j);
                    gm[j] = g * (sc + 1.0f); shv[j] = *((const GAS f32x4*)(md + 0) + ln + 64 * j); } };
            auto row = [&](int r) {
                const GAS f32x4* xr = (const GAS f32x4*)xin_row(IN_[I_X], IN_[I_CTX], r) + ln;
                f32x4 v[4]; float ss = 0.f;
#pragma unroll
                for (int j = 0; j < 4; ++j) { v[j] = xr[64 * j]; ss += (v[j].x * v[j].x + v[j].y * v[j].y) + (v[j].z * v[j].z + v[j].w * v[j].w); }
                const float rs = 1.0f / sqrtf(wave_sum(ss) * (1.f / D) + NORM_EPS);
                GAS v2u* o8 = (GAS v2u*)(H + (size_t)r * D) + ln;
#pragma unroll
                for (int j = 0; j < 4; ++j) { const f32x4 h = v[j] * rs * gm[j] + shv[j]; v2u o; o.x = pk2(h.x, h.y); o.y = pk2(h.z, h.w); o8[64 * j] = o; } };
            wave_row_blocks(T_ALL, gw, NGW, prep, row);
        }
        }
        }
        }
#endif
        if (layer == 0) GRID_BAR();

#ifndef SKIP_P2
        { PHASE_PTRS LAYER_PTRS
        for (int rep_ = 0; rep_ < REP_P2; ++rep_) {
        {
            pg8::Gemm g{H, WINl, D, D, D, 0, 0};
            pg8::SegOrder<1> S; S.T.init(T_ALL, IN_W, G, (int)blockIdx.x);
            EpiInProj E{AQ, AK, AVT, BQ, BK, BVT, CQ, CK, CVT, SG, COS, SIN};
            pg8::gemm_phase(L, g, S, E, wave);
        }
        }
        }
#endif
        GRID_BAR();

#ifndef SKIP_P3
        { PHASE_PTRS LAYER_PTRS
        {
            LAS bf16* Pl = (LAS bf16*)(L + wave * 8192);
            const float lam_init = 0.8f - 0.6f * expf(-0.3f * (float)layer);
            float lam;
            {
                const int ll = lane_id_v();
                const float* cl = IN_[I_LAMBDA] + layer * 256;
                const float s1 = wave_sum(cl[ll] * cl[64 + ll]), s2 = wave_sum(cl[128 + ll] * cl[192 + ll]);
                lam = expf(s1) - expf(s2) + lam_init;
            }
{ const int lo__ = lane_id_v(); { const int lane = lo__; const int fr = lane & 15, fq = lane >> 4, tid = wave * 64 + lane; (void)fr; (void)fq; (void)tid;
            {
                const int r32 = lane & 31, hi = lane >> 5;
                const int n_lat = BATCH * 4 * (SEQ / 256), n_ctx = last ? 0 : BATCH * 4;
                const int NU = (n_lat + G - 1) / G * G + n_ctx;
                for (int rep_ = 0; rep_ < REP_P3C; ++rep_)
                for (int u0 = vcu; u0 < NU; u0 += G) {
                    int b, h, row0, t_lo, t_hi;
                    if (u0 < n_lat) { const int bh = u0 >> 5; b = bh >> 2; h = bh & 3; row0 = b * SEQ + (u0 & 31) * 256; t_lo = 0; t_hi = 132; }
                    else { const int c = u0 - (n_lat + G - 1) / G * G; if (c < 0 || c >= n_ctx) continue; b = c >> 2; h = c & 3; row0 = T_LAT + b * CTX; t_lo = 128; t_hi = 132; }
                    const int qrow = row0 + wave * 32 + r32;
                    LAS unsigned* o1p = (LAS unsigned*)(L + 65536 + wave * 8192) + lane;
                    const int krow_s = tid >> 3, kch_s = tid & 7;
                    const int vrow_s0 = tid >> 4, vch_s = tid & 15;
                    LAS unsigned char* Kb0 = L; LAS unsigned char* Vb0 = L + 2 * CK_SZ;
#pragma unroll 1
                    for (int m = 0; m < 2; ++m) {
                        bf16x8 qf[4];
                        { const bf16* qp = CQ + (size_t)qrow * 512 + (h * 2 + m) * 64 + hi * 8;
#pragma unroll
                          for (int ks = 0; ks < 4; ++ks) qf[ks] = *(const GAS bf16x8*)(qp + ks * 16); }
                        f32x16 o[4];
#pragma unroll
                        for (int d = 0; d < 4; ++d)
#pragma unroll
                            for (int r = 0; r < 16; ++r) o[d][r] = 0.f;
                        float lpart;
                        f32x16 cb;
                        v4u pp[4];
                        const bf16* kg = CK + (size_t)krow_s * 512 + (h * 2 + m) * 64 + kch_s * 8;
                        const bf16* vg = CVT + (size_t)vrow_s0 * 512 + h * 128 + vch_s * 8;
                        auto tile_row = [&](int j) { return (j < 128) ? b * SEQ + 64 * j : T_LAT + b * CTX + 64 * (j - 128); };
                        __syncthreads();
                        {
                            const size_t kb = (size_t)tile_row(t_lo) * 512;
                            const v4u kr = *(const GAS v4u*)(kg + kb), v0 = *(const GAS v4u*)(vg + kb), v1 = *(const GAS v4u*)(vg + kb + 32 * 512);
                            *(LAS v4u*)(Kb0 + krow_s * CK_PITCH + kch_s * 16) = kr;
                            *(LAS v4u*)(Vb0 + vrow_s0 * CV_PITCH + vch_s * 16) = v0; *(LAS v4u*)(Vb0 + (vrow_s0 + 32) * CV_PITCH + vch_s * 16) = v1;
                        }
                        __syncthreads();
                        v4u kr, v0, v1;
                        { const size_t kb = (size_t)tile_row(t_lo + 2) * 512, vb = (size_t)tile_row(t_lo + 1) * 512;
                          kr = *(const GAS v4u*)(kg + kb); v0 = *(const GAS v4u*)(vg + vb); v1 = *(const GAS v4u*)(vg + vb + 32 * 512); }
                        {
                            const v4u kr1 = *(const GAS v4u*)(kg + (size_t)tile_row(t_lo + 1) * 512);
                            f32x16 st[2];
#pragma unroll
                            for (int kb = 0; kb < 2; ++kb) {
#pragma unroll
                                for (int r = 0; r < 16; ++r) st[kb][r] = 0.f;
#pragma unroll
                                for (int ks = 0; ks < 4; ++ks) {
                                    const bf16x8 kf = *(const LAS bf16x8*)(Kb0 + (kb * 32 + r32) * CK_PITCH + ks * 32 + hi * 16);
                                    st[kb] = __builtin_amdgcn_mfma_f32_32x32x16_bf16(kf, qf[ks], st[kb], 0, 0, 0);
                                }
                            }
                            float mx = st[0][0];
#pragma unroll
                            for (int r = 1; r < 16; ++r) mx = fmaxf(mx, st[0][r]);
#pragma unroll
                            for (int r = 0; r < 16; ++r) mx = fmaxf(mx, st[1][r]);
                            mx = xmax32(mx);
#pragma unroll
                            for (int r = 0; r < 16; ++r) cb[r] = -mx;
                            float ls0 = 0.f, ls1 = 0.f;
#pragma unroll
                            for (int ks = 0; ks < 4; ++ks)
#pragma unroll
                                for (int i2 = 0; i2 < 4; ++i2) {
                                    const float p0 = __builtin_amdgcn_exp2f(st[ks >> 1][8 * (ks & 1) + 2 * i2] - mx), p1 = __builtin_amdgcn_exp2f(st[ks >> 1][8 * (ks & 1) + 2 * i2 + 1] - mx);
                                    ls0 += p0; ls1 += p1; pp[ks][i2] = cvtpk(p0, p1);
                                }
                            lpart = ls0 + ls1;
                            *(LAS v4u*)(Kb0 + CK_SZ + krow_s * CK_PITCH + kch_s * 16) = kr1;
                            __syncthreads();
                        }
                        const int q4 = (lane & 15) >> 2, p4 = lane & 3, grp = (lane >> 4) & 1;
                        const int voff = (4 * hi + q4) * CV_PITCH + (16 * grp + 4 * p4) * 2;
#pragma unroll 1
                        for (int j = t_lo + 1; j < t_hi; ++j) {
                            const int cur = (j - t_lo) & 1;
                            const LAS unsigned char* Kb = Kb0 + cur * CK_SZ; const LAS unsigned char* vbase = Vb0 + (cur ^ 1) * CV_SZ + voff;
                            const bool more = (j + 1 < t_hi);
                            auto vfrag = [&](int i) -> bf16x8 {
                                const LAS unsigned char* va = vbase + (i >> 2) * 16 * CV_PITCH + (i & 3) * 64;
                                const s16x4 lo = __builtin_bit_cast(s16x4, __builtin_amdgcn_ds_read_tr16_b64_v4i16((LAS s16x4*)va));
                                const s16x4 hh = __builtin_bit_cast(s16x4, __builtin_amdgcn_ds_read_tr16_b64_v4i16((LAS s16x4*)(va + 8 * CV_PITCH)));
                                return __builtin_shufflevector(lo, hh, 0, 1, 2, 3, 4, 5, 6, 7);
                            };
                            f32x16 st[2];
#pragma unroll
                            for (int kb = 0; kb < 2; ++kb) {
#pragma unroll
                                for (int ks = 0; ks < 4; ++ks) {
                                    const bf16x8 kf = *(const LAS bf16x8*)(Kb + (kb * 32 + r32) * CK_PITCH + ks * 32 + hi * 16);
                                    st[kb] = __builtin_amdgcn_mfma_f32_32x32x16_bf16(kf, qf[ks], ks == 0 ? cb : st[kb], 0, 0, 0);
                                }
                            }
                            bf16x8 vfr[3];
                            vfr[0] = vfrag(0); vfr[1] = vfrag(1); vfr[2] = vfrag(2);
                            float mx = st[0][0];
#pragma unroll
                            for (int r = 1; r < 16; ++r) mx = fmaxf(mx, st[0][r]);
#pragma unroll
                            for (int r = 0; r < 16; ++r) mx = fmaxf(mx, st[1][r]);
                            asm volatile("" : "+v"(mx));
                            __builtin_amdgcn_sched_barrier(0);
                            o[0] = __builtin_amdgcn_mfma_f32_32x32x16_bf16(vfr[0], __builtin_bit_cast(bf16x8, pp[0]), o[0], 0, 0, 0); vfr[0] = vfrag(3);
                            o[1] = __builtin_amdgcn_mfma_f32_32x32x16_bf16(vfr[1], __builtin_bit_cast(bf16x8, pp[0]), o[1], 0, 0, 0); vfr[1] = vfrag(4);
                            mx = xmax32(mx);
                            const bool grow = __builtin_amdgcn_ballot_w64(mx > 8.0f) != 0ull;
                            float alpha = 1.0f;
                            if (grow) {
                                const float dl = fmaxf(mx, 0.f);
#pragma unroll
                                for (int kb = 0; kb < 2; ++kb)
#pragma unroll
                                    for (int r = 0; r < 16; ++r) st[kb][r] -= dl;
#pragma unroll
                                for (int r = 0; r < 16; ++r) cb[r] -= dl;
                                alpha = __builtin_amdgcn_exp2f(-dl);
                            }
                            __builtin_amdgcn_sched_barrier(0);
                            float ls0 = 0.f, ls1 = 0.f;
#pragma unroll
                            for (int i = 0; i < 16; ++i) {
                                if (i >= 2) { o[i & 3] = __builtin_amdgcn_mfma_f32_32x32x16_bf16(vfr[i % 3], __builtin_bit_cast(bf16x8, pp[i >> 2]), o[i & 3], 0, 0, 0); if (i + 3 < 16) vfr[i % 3] = vfrag(i + 3); }
                                {
                                    const int kb = i >> 3, r = 2 * (i & 7);
                                    float p0 = __builtin_amdgcn_exp2f(st[kb][r]);
                                    ls0 += p0; asm volatile("" : "+v"(p0), "+v"(ls0));
                                    float p1 = __builtin_amdgcn_exp2f(st[kb][r + 1]);
                                    ls1 += p1; asm volatile("" : "+v"(p1), "+v"(ls1));
                                    st[kb][r] = p0; st[kb][r + 1] = p1;
                                }
                                if ((i & 3) == 3) {
                                    const int ks = i >> 2;
#pragma unroll
                                    for (int i2 = 0; i2 < 4; ++i2) pp[ks][i2] = cvtpk(st[ks >> 1][8 * (ks & 1) + 2 * i2], st[ks >> 1][8 * (ks & 1) + 2 * i2 + 1]);
                                    asm volatile("" : "+v"(pp[ks]));
                                }
                                if (i == 3) *(LAS v4u*)(Kb0 + (cur ^ 1) * CK_SZ + krow_s * CK_PITCH + kch_s * 16) = kr;
                                if (i == 5) *(LAS v4u*)(Vb0 + cur * CV_SZ + vrow_s0 * CV_PITCH + vch_s * 16) = v0;
                                if (i == 7) *(LAS v4u*)(Vb0 + cur * CV_SZ + (vrow_s0 + 32) * CV_PITCH + vch_s * 16) = v1;
                                if (i == 9) { const size_t kb = (size_t)tile_row(j + 2 < t_hi ? j + 2 : t_hi - 1) * 512, vb = (size_t)tile_row(more ? j + 1 : j) * 512;
                                              kr = *(const GAS v4u*)(kg + kb); v0 = *(const GAS v4u*)(vg + vb); v1 = *(const GAS v4u*)(vg + vb + 32 * 512); }
                                if (i >= 1) __builtin_amdgcn_sched_barrier(0);
                            }
                            if (grow) {
#pragma unroll
                                for (int d = 0; d < 4; ++d)
#pragma unroll
                                    for (int r = 0; r < 16; ++r) o[d][r] *= alpha;
                                lpart *= alpha;
                            }
                            lpart += ls0 + ls1;
                            __syncthreads();
                        }
                        {
                            const LAS unsigned char* vbase = Vb0 + ((t_hi - 1 - t_lo) & 1) * CV_SZ + voff;
#pragma unroll
                            for (int i = 0; i < 16; ++i) {
                                const LAS unsigned char* va = vbase + (i >> 2) * 16 * CV_PITCH + (i & 3) * 64;
                                const s16x4 lo = __builtin_bit_cast(s16x4, __builtin_amdgcn_ds_read_tr16_b64_v4i16((LAS s16x4*)va));
                                const s16x4 hh = __builtin_bit_cast(s16x4, __builtin_amdgcn_ds_read_tr16_b64_v4i16((LAS s16x4*)(va + 8 * CV_PITCH)));
                                const bf16x8 vf = __builtin_shufflevector(lo, hh, 0, 1, 2, 3, 4, 5, 6, 7);
                                o[i & 3] = __builtin_amdgcn_mfma_f32_32x32x16_bf16(vf, __builtin_bit_cast(bf16x8, pp[i >> 2]), o[i & 3], 0, 0, 0);
                                if ((i & 7) == 7) __builtin_amdgcn_sched_barrier(0);
                            }
                        }
                        const float lt = xadd32(lpart);
                        if (m == 0) {
                            const float inv = 1.0f / lt;
#pragma unroll
                            for (int d = 0; d < 4; ++d)
#pragma unroll
                                for (int i2 = 0; i2 < 8; ++i2) o1p[64 * (d * 8 + i2)] = cvtpk(o[d][2 * i2] * inv, o[d][2 * i2 + 1] * inv);
                        } else {
                            const float inv2 = lam / lt;
                            float ssq = 0.f;
#pragma unroll
                            for (int d = 0; d < 4; ++d)
#pragma unroll
                                for (int i2 = 0; i2 < 8; ++i2) {
                                    const unsigned w1 = o1p[64 * (d * 8 + i2)];
                                    const float a0 = bf2f(w1 & 0xffffu) - o[d][2 * i2] * inv2, a1 = bf2f(w1 >> 16) - o[d][2 * i2 + 1] * inv2;
                                    o[d][2 * i2] = a0; o[d][2 * i2 + 1] = a1; ssq += a0 * a0 + a1 * a1;
                                }
                            ssq = xadd32(ssq);
                            const float rn = 1.0f / sqrtf(ssq * (1.f / 128.f) + NORM_EPS) * (1.0f - lam_init);
                            bf16* yp = Y + (size_t)qrow * 1536 + 1024 + h * 128 + 4 * hi;
                            const float* sl = IN_[I_SUBLN] + layer * 512 + h * 128 + 4 * hi;
#pragma unroll
                            for (int d = 0; d < 4; ++d)
#pragma unroll
                                for (int g4 = 0; g4 < 4; ++g4) {
                                    const f32x4 gsl = *(const GAS f32x4*)(sl + d * 32 + 8 * g4);
                                    v2u w; w.x = cvtpk(o[d][4 * g4] * rn * gsl.x, o[d][4 * g4 + 1] * rn * gsl.y); w.y = cvtpk(o[d][4 * g4 + 2] * rn * gsl.z, o[d][4 * g4 + 3] * rn * gsl.w);
                                    *(GAS v2u*)(yp + d * 32 + 8 * g4) = w;
                                }
                        }
                    }
                }
                __syncthreads();
            }
} }
{ const int lo__ = lane_id_v(); { const int lane = lo__; const int tid = wave * 64 + lane, r32 = lane & 31, hi = lane >> 5;
            {
                const int n_lat = BATCH * 2 * (SEQ / 64), n_ctx = last ? 0 : BATCH * 2 * (CTX / 64);
                for (int rep_ = 0; rep_ < REP_P3A; ++rep_)
                for (int u0 = vcu; u0 < n_lat + n_ctx; u0 += G) {
                    const bool isctx = u0 >= n_lat;
                    int b, g, p0, qrow, nl, klo;
                    if (!isctx) { b = u0 >> 8; g = (u0 >> 7) & 1; p0 = (u0 & 127) * 64; qrow = b * SEQ + p0 + (wave & 1) * 32 + r32;
                                  klo = p0 >= 128 ? 0 : (128 - p0) / 64; const int khi = min(4, (SEQ - 1 - (p0 - 128)) / 64); nl = khi - klo + 1; }
                    else { const int c = u0 - n_lat; b = c >> 3; g = (c >> 2) & 1; p0 = (c & 3) * 64; qrow = T_LAT + b * CTX + p0 + (wave & 1) * 32 + r32; nl = 0; klo = 0; }
                    const int hq = g * 4 + (wave >> 1);
                    const int qpos0 = p0 + (wave & 1) * 32;
                    bf16x8 qf[4];
                    { const bf16* qp = AQ + (size_t)qrow * 512 + hq * 64 + hi * 8;
#pragma unroll
                      for (int ks = 0; ks < 4; ++ks) qf[ks] = *(const GAS bf16x8*)(qp + ks * 16); }
                    f32x16 o[2];
#pragma unroll
                    for (int d = 0; d < 2; ++d)
#pragma unroll
                        for (int r = 0; r < 16; ++r) o[d][r] = 0.f;
                    float mrun = IN_[I_SINK][layer * 8 + hq] * 8.0f;
                    float lpart = (hi == 0) ? 1.0f : 0.0f;
                    const bf16* kg = AK + (size_t)(tid >> 3) * 128 + g * 64 + (tid & 7) * 8;
                    const bf16* vg = AVT + (size_t)(tid >> 3) * 128 + g * 64 + (tid & 7) * 8;
                    const int kp0 = p0 - 128 + 64 * klo;
                    auto tile_row = [&](int j) { return (j < nl) ? b * SEQ + kp0 + 64 * j : T_LAT + b * CTX + 64 * (j - nl); };
                    auto use_tile = [&](int j) { if (j >= nl) return true; const int kp = kp0 + 64 * j; return (kp + 63 >= qpos0 - 128) && (kp <= qpos0 + 31 + 128); };
                    auto elem = [&](f32x16 (&st)[2], int j) {
                        if (j < nl) {
                            const int dq0 = (qpos0 + r32) - (kp0 + 64 * j + 4 * hi);
#pragma unroll
                            for (int kb = 0; kb < 2; ++kb)
#pragma unroll
                                for (int r = 0; r < 16; ++r) { const int dq = dq0 - (kb * 32 + (r & 3) + 8 * (r >> 2)); if (dq > 128 || dq < -128) st[kb][r] = -1e30f; }
                        }
                    };
                    attn64_pass<2>(o, mrun, lpart, qf, kg, 128, vg, 128, nl + 4, tile_row, use_tile, elem, L, lane, tid);
                    const float lt = xadd32(lpart);
                    attn64_store(o, 1.0f / lt, Y + (size_t)qrow * 1536 + hq * 64, hi);
                }
            }
} }
{ const int lo__ = lane_id_v(); { const int lane = lo__; const int tid = wave * 64 + lane, r32 = lane & 31, hi = lane >> 5;
            {
                const int n_lat = BATCH * 8 * 32, n_ctx = last ? 0 : BATCH * 8;
                LAS float* rpbL = (LAS float*)(L + 49152);
                for (int rep_ = 0; rep_ < REP_P3B; ++rep_)
                for (int u0 = vcu; u0 < n_lat + n_ctx; u0 += G) {
                    const bool isctx = u0 >= n_lat;
                    int b, h, gr = 0, qc0 = 0, qrow, nl, krlo;
                    if (!isctx) { b = u0 >> 8; h = (u0 >> 5) & 7; const int r0 = (u0 & 31) * 4; gr = r0 + (wave >> 1); qc0 = (wave & 1) * 32; qrow = b * SEQ + gr * GRID_W + qc0 + r32;
                                  krlo = min(max(r0 - 4, 0), 120); nl = min(max(r0 - 1, 0), 120) + 8 - krlo; }
                    else { const int c = u0 - n_lat; b = c >> 3; h = c & 7; qrow = T_LAT + b * CTX + wave * 32 + r32; nl = 0; krlo = 0; }
                    __syncthreads();
                    if (tid < 465) rpbL[tid] = IN_[I_RPB][(size_t)(layer * 8 + h) * 465 + tid] * 8.0f;
                    bf16x8 qf[4];
                    { const bf16* qp = BQ + (size_t)qrow * 512 + h * 64 + hi * 8;
#pragma unroll
                      for (int ks = 0; ks < 4; ++ks) qf[ks] = *(const GAS bf16x8*)(qp + ks * 16); }
                    f32x16 o[2];
#pragma unroll
                    for (int d = 0; d < 2; ++d)
#pragma unroll
                        for (int r = 0; r < 16; ++r) o[d][r] = 0.f;
                    float mrun = -1e30f, lpart = 0.f;
                    const bf16* kg = BK + (size_t)(tid >> 3) * 512 + h * 64 + (tid & 7) * 8;
                    const bf16* vg = BVT + (size_t)(tid >> 3) * 512 + h * 64 + (tid & 7) * 8;
                    const int rs = min(max(gr - 4, 0), 120);
                    auto tile_row = [&](int j) { return (j < nl) ? b * SEQ + (krlo + j) * GRID_W : T_LAT + b * CTX + 64 * (j - nl); };
                    auto use_tile = [&](int j) { if (j >= nl) return true; const int kr = krlo + j; return kr >= rs && kr < rs + 8; };
                    auto elem = [&](f32x16 (&st)[2], int j) {
                        if (j < nl) {
                            const int qc = qc0 + r32, cstart = min(max(qc - 8, 0), 48);
                            const LAS float* brow = rpbL + (krlo + j - gr + 7) * 31 + 15;
#pragma unroll
                            for (int kb = 0; kb < 2; ++kb)
#pragma unroll
                                for (int r = 0; r < 16; ++r) {
                                    const int kc = kb * 32 + (r & 3) + 8 * (r >> 2) + 4 * hi;
                                    const bool valid = (kc >= cstart) && (kc < cstart + 16);
                                    const int dc = min(max(kc - qc, -15), 15);
                                    st[kb][r] = valid ? st[kb][r] + brow[dc] : -1e30f;
                                }
                        }
                    };
                    attn64_pass<2>(o, mrun, lpart, qf, kg, 512, vg, 512, nl + 4, tile_row, use_tile, elem, L, lane, tid);
                    const float lt = xadd32(lpart);
                    attn64_store(o, 1.0f / lt, Y + (size_t)qrow * 1536 + 512 + h * 64, hi);
                }
                __syncthreads();
            }
} }
        }
        }
#endif
        GRID_BAR();

#ifndef SKIP_P4
        { PHASE_PTRS LAYER_PTRS
        for (int rep_ = 0; rep_ < REP_P4; ++rep_) {
        {
            pg8::Gemm g{Y, WB + (size_t)layer * 3 * D * 512, 1536, 512, 512, 512, (size_t)D * 512};
            pg8::SegOrder<3> S; S.T.init(T_LAT, D, G, (int)blockIdx.x);
            EpiBranch E{SG, MG};
            pg8::gemm_phase(L, g, S, E, wave);
        }
        if (!last) { const int lo__ = lane_id_v(); { const int lane = lo__; const int fr = lane & 15, fq = lane >> 4; (void)fr; (void)fq;
            for (int it = gw; it < (T_ALL - T_LAT) / 32 * (D / 32); it += NGW) {
                const int row0 = T_LAT + (it / (D / 32)) * 32, col0 = (it % (D / 32)) * 32;
                f32x4 mg[2][2]; zero_acc22(mg);
#pragma unroll 1
                for (int seg = 0; seg < 3; ++seg) {
                    f32x4 acc[2][2]; zero_acc22(acc);
                    sgemm32<8>(acc, Y + seg * 512, 1536, WB + (size_t)(layer * 3 + seg) * D * 512, 512, 512, row0, col0, lane);
#pragma unroll
                    for (int m = 0; m < 2; ++m)
#pragma unroll
                        for (int r = 0; r < 4; ++r) {
                            const bf16* gp = SG + (size_t)(row0 + 16 * m + 4 * fq + r) * 3072 + seg * 1024 + col0 + fr;
#pragma unroll
                            for (int n = 0; n < 2; ++n) mg[m][n][r] += bf2f(gp[16 * n]) * acc[m][n][r];
                        }
                }
#pragma unroll
                for (int m = 0; m < 2; ++m)
#pragma unroll
                    for (int r = 0; r < 4; ++r) {
                        bf16* rowp = MG + (size_t)(row0 + 16 * m + 4 * fq + r) * D + col0 + fr;
#pragma unroll
                        for (int n = 0; n < 2; ++n) rowp[16 * n] = (bf16)f2bf(mg[m][n][r]);
                    }
            }
} }
        }
        }
#endif
        GRID_BAR();

#ifndef SKIP_P5
        { PHASE_PTRS LAYER_PTRS
        {
            pg8::Gemm g{MG, WO + (size_t)layer * D * D, D, D, D, 0, 0};
            pg8::SegOrder<1> S; S.T.init(T_LAT, D, G, (int)blockIdx.x);
            EpiOut E{X, modl, layer == 0 ? IN_[I_X] : nullptr, IN_[I_CTX]};
            pg8::gemm_phase(L, g, S, E, wave);
        }
        if (!last) { const int lo__ = lane_id_v(); { const int lane = lo__; const int fr = lane & 15, fq = lane >> 4; (void)fr; (void)fq;
            for (int it = gw; it < (T_ALL - T_LAT) / 32 * (D / 32); it += NGW) {
                const int row0 = T_LAT + (it / (D / 32)) * 32, col0 = (it % (D / 32)) * 32;
                f32x4 acc[2][2]; zero_acc22(acc);
                sgemm32<8>(acc, MG, D, WO + (size_t)layer * D * D, D, D, row0, col0, lane);
                const float* gt = modl + (size_t)2 * 6 * D + 2 * D + col0 + fr;
#pragma unroll
                for (int m = 0; m < 2; ++m)
#pragma unroll
                    for (int r = 0; r < 4; ++r) {
                        float* rowp = X + (size_t)(row0 + 16 * m + 4 * fq + r) * D + col0 + fr;
                        const float* srcp = (layer == 0) ? IN_[I_CTX] + (size_t)(row0 - T_LAT + 16 * m + 4 * fq + r) * D + col0 + fr : rowp;
#pragma unroll
                        for (int n = 0; n < 2; ++n) rowp[16 * n] = srcp[16 * n] + gt[16 * n] * acc[m][n][r];
                    }
            }
} }
        }
#endif
        GRID_BAR();

#ifndef SKIP_P6
        { PHASE_PTRS LAYER_PTRS
        for (int rep_ = 0; rep_ < REP_P6; ++rep_) {
        { const int ln = lane_id_v();
        {
            f32x4 gm[4], shv[4];
            auto prep = [&](int midx) { const float* md = modl + (size_t)midx * 6 * D;
#pragma unroll
                for (int j = 0; j < 4; ++j) { const f32x4 g = *((const GAS f32x4*)(IN_[I_G2] + layer * D) + ln + 64 * j); const f32x4 sc = *((const GAS f32x4*)(md + 4 * D) + ln + 64 * j);
                    gm[j] = g * (sc + 1.0f); shv[j] = *((const GAS f32x4*)(md + 3 * D) + ln + 64 * j); } };
            auto row = [&](int r) {
                const GAS f32x4* xr = (const GAS f32x4*)(X + (size_t)r * D) + ln;
                f32x4 v[4]; float ss = 0.f;
#pragma unroll
                for (int j = 0; j < 4; ++j) { v[j] = xr[64 * j]; ss += (v[j].x * v[j].x + v[j].y * v[j].y) + (v[j].z * v[j].z + v[j].w * v[j].w); }
                const float rs = 1.0f / sqrtf(wave_sum(ss) * (1.f / D) + NORM_EPS);
                GAS v2u* o8 = (GAS v2u*)(H + (size_t)r * D) + ln;
#pragma unroll
                for (int j = 0; j < 4; ++j) { const f32x4 h = v[j] * rs * gm[j] + shv[j]; v2u o; o.x = pk2(h.x, h.y); o.y = pk2(h.z, h.w); o8[64 * j] = o; } };
            wave_row_blocks(T_EFF, gw, NGW, prep, row);
        }
        }
        }
        }
#endif
        GRID_BAR();

#ifndef SKIP_P7
        { PHASE_PTRS LAYER_PTRS
        for (int rep_ = 0; rep_ < REP_P7; ++rep_) {
        {
            pg8::Gemm g{H, WQ + (size_t)layer * 2048 * D, D, D, D, 0, 0};
            pg8::SegOrder<1> S; S.T.init(T_LAT, 2048, G, (int)blockIdx.x);
            EpiStore E{Q2, 2048};
            pg8::gemm_phase(L, g, S, E, wave);
        }
        if (!last) { const int lo__ = lane_id_v(); { const int lane = lo__; const int fr = lane & 15, fq = lane >> 4; (void)fr; (void)fq;
            for (int it = gw; it < (T_ALL - T_LAT) / 32 * (2048 / 32); it += NGW) {
                const int row0 = T_LAT + (it / (2048 / 32)) * 32, col0 = (it % (2048 / 32)) * 32;
                f32x4 acc[2][2]; zero_acc22(acc);
                sgemm32<8>(acc, H, D, WQ + (size_t)layer * 2048 * D, D, D, row0, col0, lane);
#pragma unroll
                for (int m = 0; m < 2; ++m)
#pragma unroll
                    for (int r = 0; r < 4; ++r) {
                        bf16* rowp = Q2 + (size_t)(row0 + 16 * m + 4 * fq + r) * 2048 + col0 + fr;
#pragma unroll
                        for (int n = 0; n < 2; ++n) rowp[16 * n] = (bf16)f2bf(acc[m][n][r]);
                    }
            }
} }
        }
        }
#endif
        GRID_BAR();

#ifndef SKIP_P8
        { PHASE_PTRS LAYER_PTRS
        for (int rep_ = 0; rep_ < REP_P8; ++rep_) {
{ const int lo__ = lane_id_v(); { const int lane = lo__; const int fr = lane & 15, fq = lane >> 4, tid = wave * 64 + lane;
        {
            LAS float* S = (LAS float*)L;
            const int wr = wave >> 1, wc = wave & 1;
            const int tl = tid >> 2, qd = tid & 3, ph = qd >> 1, hq = qd & 1;
            for (int it = vcu; it < (T_EFF / 128) * PEER_HEADS; it += G) {
                const int tile = it >> 3, h = it & 7;
                {
                    f32x4 acc[2][8];
#pragma unroll
                    for (int m = 0; m < 2; ++m)
#pragma unroll
                        for (int n = 0; n < 8; ++n) acc[m][n] = (f32x4){0.f, 0.f, 0.f, 0.f};
                    const bf16* ap = Q2 + (size_t)(tile * 128 + wr * 32 + fr) * 2048 + h * 256 + wc * 128 + fq * 8;
                    const bf16* bp = KEYS + ((size_t)(layer * 16 + h * 2 + wc) * 128 + fr) * 128 + fq * 8;
                    bf16x8 af[2][4];
#pragma unroll
                    for (int m = 0; m < 2; ++m)
#pragma unroll
                        for (int ks = 0; ks < 4; ++ks) af[m][ks] = *(const GAS bf16x8*)(ap + (size_t)m * 16 * 2048 + ks * 32);
#pragma unroll
                    for (int n = 0; n < 8; ++n) {
                        bf16x8 bfr[4];
#pragma unroll
                        for (int ks = 0; ks < 4; ++ks) bfr[ks] = *(const GAS bf16x8*)(bp + (size_t)n * 16 * 128 + ks * 32);
#pragma unroll
                        for (int ks = 0; ks < 4; ++ks)
#pragma unroll
                            for (int m = 0; m < 2; ++m) acc[m][n] = __builtin_amdgcn_mfma_f32_16x16x32_bf16(af[m][ks], bfr[ks], acc[m][n], 0, 0, 0);
                    }
#pragma unroll
                    for (int m = 0; m < 2; ++m)
#pragma unroll
                        for (int r = 0; r < 4; ++r) {
                            const int row_ = wr * 32 + 16 * m + 4 * fq + r;
#pragma unroll
                            for (int n = 0; n < 8; ++n) { const int key_ = wc * 128 + 16 * n + fr, c_ = key_ >> 2, pc_ = (c_ & 0x30) | ((c_ & 15) ^ (((row_ & 3) << 2) | (c_ >> 4)));
                                S[row_ * 256 + pc_ * 4 + (key_ & 3)] = acc[m][n][r]; }
                        }
                }
                __syncthreads();
                {
                    const int t = tile * 128 + tl;
                    int a[16];
#define LOAD_CHUNK_L(v, ch) _Pragma("unroll") for (int q = 0; q < 4; ++q) { const int c_ = qd * 16 + (ch) * 4 + q, pc_ = (c_ & 0x30) | ((c_ & 15) ^ (((tl & 3) << 2) | qd)); \
                        const f32x4 x = *(const LAS f32x4*)(S + tl * 256 + pc_ * 4); const int kb_ = hq * 64 + (ch) * 16 + 4 * q; \
                        v[4 * q + 0] = (f2ord(x.x) & ~127) | (kb_ + 0); v[4 * q + 1] = (f2ord(x.y) & ~127) | (kb_ + 1); v[4 * q + 2] = (f2ord(x.z) & ~127) | (kb_ + 2); v[4 * q + 3] = (f2ord(x.w) & ~127) | (kb_ + 3); }
                    LOAD_CHUNK_L(a, 0) sort16_desc(a);
#pragma unroll
                    for (int ch = 1; ch < 4; ++ch) { int v[16]; LOAD_CHUNK_L(v, ch) sort16_desc(v); merge16_desc(a, v); }
#undef LOAD_CHUNK_L
                    { int b[16];
#pragma unroll
                      for (int i = 0; i < 16; ++i) b[i] = __builtin_amdgcn_update_dpp(0, a[i], 0xB1, 0xF, 0xF, true);
                      merge16_desc(a, b); }
                    int a0[16], a1[16];
#pragma unroll
                    for (int i = 0; i < 16; ++i) { const int o2 = __builtin_amdgcn_update_dpp(0, a[i], 0x4E, 0xF, 0xF, true); a0[i] = ph ? o2 : a[i]; a1[i] = ph ? a[i] : o2; }
                    {
            float va[16], vb[16];
#pragma unroll
            for (int i = 0; i < 16; ++i) { va[i] = ord2f(a0[i] & ~127); vb[i] = ord2f(a1[i] & ~127); }
            int c[16];
            {
                int v[16];
                v[0] = (f2ord(va[0] + vb[0]) & ~255) | 0;
                v[1] = (f2ord(va[0] + vb[1]) & ~255) | 1;
                v[2] = (f2ord(va[0] + vb[2]) & ~255) | 2;
                v[3] = (f2ord(va[0] + vb[3]) & ~255) | 3;
                v[4] = (f2ord(va[0] + vb[4]) & ~255) | 4;
                v[5] = (f2ord(va[0] + vb[5]) & ~255) | 5;
                v[6] = (f2ord(va[0] + vb[6]) & ~255) | 6;
                v[7] = (f2ord(va[0] + vb[7]) & ~255) | 7;
                v[8] = (f2ord(va[0] + vb[8]) & ~255) | 8;
                v[9] = (f2ord(va[0] + vb[9]) & ~255) | 9;
                v[10] = (f2ord(va[0] + vb[10]) & ~255) | 10;
                v[11] = (f2ord(va[0] + vb[11]) & ~255) | 11;
                v[12] = (f2ord(va[0] + vb[12]) & ~255) | 12;
                v[13] = (f2ord(va[0] + vb[13]) & ~255) | 13;
                v[14] = (f2ord(va[0] + vb[14]) & ~255) | 14;
                v[15] = (f2ord(va[0] + vb[15]) & ~255) | 15;
                sort16_desc(v);
#pragma unroll
                for (int i = 0; i < 16; ++i) c[i] = v[i];
            }
            {
                int v[16];
                v[0] = (f2ord(va[1] + vb[0]) & ~255) | 16;
                v[1] = (f2ord(va[1] + vb[1]) & ~255) | 17;
                v[2] = (f2ord(va[1] + vb[2]) & ~255) | 18;
                v[3] = (f2ord(va[1] + vb[3]) & ~255) | 19;
                v[4] = (f2ord(va[1] + vb[4]) & ~255) | 20;
                v[5] = (f2ord(va[1] + vb[5]) & ~255) | 21;
                v[6] = (f2ord(va[1] + vb[6]) & ~255) | 22;
                v[7] = (f2ord(va[1] + vb[7]) & ~255) | 23;
                v[8] = (f2ord(va[2] + vb[0]) & ~255) | 32;
                v[9] = (f2ord(va[2] + vb[1]) & ~255) | 33;
                v[10] = (f2ord(va[2] + vb[2]) & ~255) | 34;
                v[11] = (f2ord(va[2] + vb[3]) & ~255) | 35;
                v[12] = (f2ord(va[2] + vb[4]) & ~255) | 36;
                v[13] = (f2ord(va[3] + vb[0]) & ~255) | 48;
                v[14] = (f2ord(va[3] + vb[1]) & ~255) | 49;
                v[15] = (f2ord(va[3] + vb[2]) & ~255) | 50;
                sort16_desc(v);
                merge16_desc(c, v);
            }
            {
                int v[16];
                v[0] = (f2ord(va[3] + vb[3]) & ~255) | 51;
                v[1] = (f2ord(va[4] + vb[0]) & ~255) | 64;
                v[2] = (f2ord(va[4] + vb[1]) & ~255) | 65;
                v[3] = (f2ord(va[4] + vb[2]) & ~255) | 66;
                v[4] = (f2ord(va[5] + vb[0]) & ~255) | 80;
                v[5] = (f2ord(va[5] + vb[1]) & ~255) | 81;
                v[6] = (f2ord(va[6] + vb[0]) & ~255) | 96;
                v[7] = (f2ord(va[6] + vb[1]) & ~255) | 97;
                v[8] = (f2ord(va[7] + vb[0]) & ~255) | 112;
                v[9] = (f2ord(va[7] + vb[1]) & ~255) | 113;
                v[10] = (f2ord(va[8] + vb[0]) & ~255) | 128;
                v[11] = (f2ord(va[9] + vb[0]) & ~255) | 144;
                v[12] = (f2ord(va[10] + vb[0]) & ~255) | 160;
                v[13] = (f2ord(va[11] + vb[0]) & ~255) | 176;
                v[14] = (f2ord(va[12] + vb[0]) & ~255) | 192;
                v[15] = (f2ord(va[13] + vb[0]) & ~255) | 208;
                sort16_desc(v);
                merge16_desc(c, v);
            }
            {
                int v[16];
                v[0] = (f2ord(va[14] + vb[0]) & ~255) | 224;
                v[1] = (f2ord(va[15] + vb[0]) & ~255) | 240;
                v[2] = (int)0x80000000;
                v[3] = (int)0x80000000;
                v[4] = (int)0x80000000;
                v[5] = (int)0x80000000;
                v[6] = (int)0x80000000;
                v[7] = (int)0x80000000;
                v[8] = (int)0x80000000;
                v[9] = (int)0x80000000;
                v[10] = (int)0x80000000;
                v[11] = (int)0x80000000;
                v[12] = (int)0x80000000;
                v[13] = (int)0x80000000;
                v[14] = (int)0x80000000;
                v[15] = (int)0x80000000;
                sort16_desc(v);
                merge16_desc(c, v);
            }
            const float smax = ord2f(c[0] & ~255);
            float pe[16]; float psum = 0.f;
#pragma unroll
            for (int k = 0; k < 16; ++k) { pe[k] = __expf(ord2f(c[k] & ~255) - smax); psum += pe[k]; }
            const float ip = 1.0f / psum;
#pragma unroll
            for (int kk = 0; kk < 4; ++kk) {
                const int ck = (qd == 0) ? c[kk] : (qd == 1) ? c[4 + kk] : (qd == 2) ? c[8 + kk] : c[12 + kk];
                const float pk_ = (qd == 0) ? pe[kk] : (qd == 1) ? pe[4 + kk] : (qd == 2) ? pe[8 + kk] : pe[12 + kk];
                const int ij = ck & 255, ii = ij >> 4, jj = ij & 15;
                int e0 = 0, e1 = 0;
#pragma unroll
                for (int q = 0; q < 16; ++q) { e0 = (ii == q) ? (a0[q] & 127) : e0; e1 = (jj == q) ? (a1[q] & 127) : e1; }
                const int e = e0 * PEER_KEYS + e1;
                const float su = SCU[layer * 16384 + e], sv = SCV[layer * 16384 + e];
                const int k = 4 * qd + kk;
                EI[(size_t)t * NSEL + h * 16 + k] = (unsigned)e | (f2bf(su) << 16);
                EG[(size_t)t * NSEL + h * 16 + k] = pk_ * ip * sv;
            }
                    }
                }
                __syncthreads();
            }
        }
} }
        }
        }
#endif
        GRID_BAR();

#ifndef SKIP_P10
#define P10_CENSUS \
        unsigned myx_, nx_ = 1u, smask_ = 0u; { unsigned cnt_[16]; unsigned* bw_ = (unsigned*)(args.ws + WS_CTL) + CW_BAR; \
            _Pragma("unroll") for (int j = 0; j < 16; ++j) cnt_[j] = (unsigned)__builtin_amdgcn_readfirstlane((int)xb_ld(&bw_[XB_XCNT(j)])); \
            myx_ = xb_xcc_id(); unsigned np_ = 0u; \
            _Pragma("unroll") for (int j = 0; j < 16; ++j) { np_ += (cnt_[j] > 0u) ? 1u : 0u; nx_ = ((unsigned)j == myx_) ? cnt_[j] : nx_; } \
            if (np_ == 0u) np_ = 1u; if (nx_ == 0u) nx_ = 1u; \
            _Pragma("unroll") for (int sl = 0; sl < 8; ++sl) { const unsigned k_ = (unsigned)sl % np_; unsigned seen_ = 0u, srv_ = 0xffu; \
                _Pragma("unroll") for (int j = 0; j < 16; ++j) { if (cnt_[j] > 0u) { srv_ = (seen_ == k_) ? (unsigned)j : srv_; ++seen_; } } \
                smask_ |= (srv_ == myx_) ? (1u << sl) : 0u; } } \
        const int rank_ = (int)__builtin_amdgcn_readfirstlane((int)MISC[12]); const int wstride_ = (int)nx_ * NWAVES; (void)rank_; (void)wstride_;
        { PHASE_PTRS LAYER_PTRS
        { const int ln = lane_id_v(); const int c = ln & 7, tg = ln >> 3;
          P10_CENSUS
          float* PART = (float*)(wsq + WS_PART);
          const unsigned char* U8l = U8 + (size_t)layer * 16384 * D;
          for (int rep_ = 0; rep_ < REP_P10A; ++rep_)
#pragma unroll 1
          for (int sl = 0; sl < 8; ++sl) {
            if (!((smask_ >> sl) & 1u)) continue;
            const int ws0 = (rank_ * NWAVES + wave) * 8, nslot = wstride_ * 8;
            if (ws0 >= T_EFF) continue;
            const int niter = (T_EFF - ws0 + nslot - 1) / nslot, nb = niter * 8;
#define A_TOK(bi) (ws0 + tg + (min((bi), nb - 1) >> 3) * nslot)
#define A_LOAD_PK(pkv, bi) { const GAS v4u* wp_ = (const GAS v4u*)(EI + (size_t)A_TOK(bi) * NSEL + 16 * (min((bi), nb - 1) & 7)); _Pragma("unroll") for (int q = 0; q < 4; ++q) pkv[q] = wp_[q]; }
#define A_ISSUE(rowv, pkv) { _Pragma("unroll") for (int q = 0; q < 16; ++q) rowv[q] = *(const GAS v4u*)(U8l + (size_t)(pkv[q >> 2][q & 3] & 0xffffu) * D + 128 * sl + 16 * c); }
#define A_LOAD_H(hvv, bi) { const int tq_ = A_TOK(bi); _Pragma("unroll") for (int j = 0; j < 4; ++j) hvv[j] = *(const GAS v2u*)(H + (size_t)tq_ * D + 256 * j + 32 * sl + 4 * c); }
#define A_QUANT(hvv) { float hf[16]; float am_ = 0.f; \
                _Pragma("unroll") for (int j = 0; j < 4; ++j) { hf[4 * j] = bf2f(hvv[j].x & 0xffffu); hf[4 * j + 1] = bf2f(hvv[j].x >> 16); hf[4 * j + 2] = bf2f(hvv[j].y & 0xffffu); hf[4 * j + 3] = bf2f(hvv[j].y >> 16); } \
                _Pragma("unroll") for (int i = 0; i < 16; ++i) am_ = fmaxf(am_, fabsf(hf[i])); \
                am_ = fmaxf(am_, dpp_mov<0xB1>(am_)); am_ = fmaxf(am_, dpp_mov<0x4E>(am_)); am_ = fmaxf(am_, dpp_mov<0x141>(am_)); am_ = fmaxf(am_, 1e-20f); \
                sh_ = am_ * (1.0f / 127.0f); const float ih_ = 127.0f / am_; \
                _Pragma("unroll") for (int j = 0; j < 4; ++j) { const int q0 = __float2int_rn(hf[4 * j] * ih_), q1 = __float2int_rn(hf[4 * j + 1] * ih_), q2 = __float2int_rn(hf[4 * j + 2] * ih_), q3 = __float2int_rn(hf[4 * j + 3] * ih_); \
                    hq_[j] = (int)((unsigned)(q0 & 255) | ((unsigned)(q1 & 255) << 8) | ((unsigned)(q2 & 255) << 16) | ((unsigned)q3 << 24)); } }
#define A_COMPUTE(rowv, bi) { int p_[16]; \
                _Pragma("unroll") for (int q = 0; q < 16; ++q) { int ia = 0; _Pragma("unroll") for (int j = 0; j < 4; ++j) ia = __builtin_amdgcn_sdot4((int)rowv[q][j], hq_[j], ia, false); p_[q] = ia; } \
                { const bool up = (c & 4) != 0; _Pragma("unroll") for (int i = 0; i < 8; ++i) { const int send = up ? p_[i] : p_[8 + i], keep = up ? p_[8 + i] : p_[i]; p_[i] = keep + __builtin_amdgcn_update_dpp(0, send, 0x141, 0xF, 0xF, true); } } \
                { const bool up = (c & 2) != 0; _Pragma("unroll") for (int i = 0; i < 4; ++i) { const int send = up ? p_[i] : p_[4 + i], keep = up ? p_[4 + i] : p_[i]; p_[i] = keep + __builtin_amdgcn_update_dpp(0, send, 0x4E, 0xF, 0xF, true); } } \
                { const bool up = (c & 1) != 0; _Pragma("unroll") for (int i = 0; i < 2; ++i) { const int send = up ? p_[i] : p_[2 + i], keep = up ? p_[2 + i] : p_[i]; p_[i] = keep + __builtin_amdgcn_update_dpp(0, send, 0xB1, 0xF, 0xF, true); } } \
                f32x2 r2_; r2_.x = (float)p_[0] * sh_; r2_.y = (float)p_[1] * sh_; \
                *(GAS f32x2*)(PART + ((size_t)sl * T_ALL + (ws0 + tg + ((bi) >> 3) * nslot)) * NSEL + 16 * ((bi) & 7) + 2 * c) = r2_; }
            v4u pkA[4], pkB[4]; v4u rowA[16], rowB[16]; v2u hN[4]; int hq_[4] = {0, 0, 0, 0}; float sh_ = 0.f;
            A_LOAD_PK(pkA, 0) A_LOAD_PK(pkB, 1) A_LOAD_H(hN, 0)
            A_ISSUE(rowA, pkA)
#pragma unroll 1
            for (int bi = 0; bi < nb; bi += 2) {
                if ((bi & 7) == 0) { A_QUANT(hN) A_LOAD_H(hN, bi + 8) }
                A_ISSUE(rowB, pkB) A_LOAD_PK(pkA, bi + 2)
                __builtin_amdgcn_sched_barrier(0);
                A_COMPUTE(rowA, bi)
                __builtin_amdgcn_sched_barrier(0);
                A_ISSUE(rowA, pkA) A_LOAD_PK(pkB, bi + 3)
                __builtin_amdgcn_sched_barrier(0);
                A_COMPUTE(rowB, bi + 1)
                __builtin_amdgcn_sched_barrier(0);
            }
#undef A_TOK
#undef A_LOAD_PK
#undef A_ISSUE
#undef A_LOAD_H
#undef A_QUANT
#undef A_COMPUTE
          }
        } }
        GRID_BAR();
        { PHASE_PTRS LAYER_PTRS
        { const int ln = lane_id_v();
          const float* PART = (const float*)(wsq + WS_PART); float* WGT = (float*)(wsq + WS_WGT);
          for (int rep_ = 0; rep_ < REP_P10B; ++rep_)
          for (int i4 = vcu * NTHREADS + wave * 64 + ln; i4 < T_EFF * NSEL / 4; i4 += NGT) {
              f32x4 dsum = (f32x4){0.f, 0.f, 0.f, 0.f};
#pragma unroll
              for (int sl = 0; sl < 8; ++sl) dsum += *((const GAS f32x4*)(PART + (size_t)sl * T_ALL * NSEL) + i4);
              const v4u esu = *((const GAS v4u*)EI + i4); const f32x4 gv = *((const GAS f32x4*)EG + i4);
              v4u o;
#pragma unroll
              for (int q = 0; q < 4; ++q) {
                  const float dot = dsum[q] * bf2f(esu[q] >> 16);
                  o[q] = (esu[q] & 0xffffu) | (f2bf(0.5f * dot * (1.0f + erff(dot * 0.70710678118654752f)) * gv[q]) << 16);
              }
              *((GAS v4u*)WGT + i4) = o;
          }
        } }
        GRID_BAR();
        { PHASE_PTRS LAYER_PTRS
        { const int ln = lane_id_v(); const int c = ln & 7, tg = ln >> 3;
          P10_CENSUS
          const unsigned* WGT = (const unsigned*)(wsq + WS_WGT); float* XO = (float*)(wsq + WS_XO);
          const unsigned char* V8l = V8 + (size_t)layer * 16384 * D;
          for (int rep_ = 0; rep_ < REP_P10C; ++rep_)
#pragma unroll 1
          for (int sl = 0; sl < 8; ++sl) {
            if (!((smask_ >> sl) & 1u)) continue;
            const int ws0 = (rank_ * NWAVES + wave) * 8, nslot = wstride_ * 8;
            if (ws0 >= T_EFF) continue;
            const int niter = (T_EFF - ws0 + nslot - 1) / nslot, nb = niter * 8;
#define C_TOK(bi) (ws0 + tg + (min((bi), nb - 1) >> 3) * nslot)
#define C_LOAD_PK(pkv, bi) { const GAS v4u* wp_ = (const GAS v4u*)(WGT + (size_t)C_TOK(bi) * NSEL + 16 * (min((bi), nb - 1) & 7)); _Pragma("unroll") for (int q = 0; q < 4; ++q) pkv[q] = wp_[q]; }
#define C_ISSUE(rowv, wv, pkv) { _Pragma("unroll") for (int q = 0; q < 16; ++q) { const unsigned w_ = pkv[q >> 2][q & 3]; rowv[q] = *(const GAS v4u*)(V8l + (size_t)(w_ & 0xffffu) * D + 128 * sl + 16 * c); } \
                _Pragma("unroll") for (int q = 0; q < 8; ++q) wv[q] = (pkv[q >> 1][(2 * q) & 3] >> 16) | (pkv[q >> 1][(2 * q + 1) & 3] & 0xffff0000u); }
#define C_COMPUTE(rowv, wv) { _Pragma("unroll") for (int q = 0; q < 16; ++q) { const float wq_ = (q & 1) ? __builtin_bit_cast(float, wv[q >> 1] & 0xffff0000u) : bf2f(wv[q >> 1] & 0xffffu); const f32x2 w2_ = (f32x2){wq_, wq_}; _Pragma("unroll") for (int j = 0; j < 4; ++j) { \
                    const f32x2 a = __builtin_amdgcn_cvt_pk_f32_fp8((int)rowv[q][j], false), b = __builtin_amdgcn_cvt_pk_f32_fp8((int)rowv[q][j], true); \
                    f32x2 lo_ = (f32x2){o[j].x, o[j].y}, hi_ = (f32x2){o[j].z, o[j].w}; lo_ = __builtin_elementwise_fma(a, w2_, lo_); hi_ = __builtin_elementwise_fma(b, w2_, hi_); \
                    o[j].x = lo_.x; o[j].y = lo_.y; o[j].z = hi_.x; o[j].w = hi_.y; } \
                    asm volatile("" : "+v"(o[0]), "+v"(o[1]), "+v"(o[2]), "+v"(o[3])); } }
            v4u pkA[4], pkB[4]; unsigned wA[8], wB[8]; v4u rowA[16], rowB[16];
            f32x4 o[4];
#pragma unroll
            for (int j = 0; j < 4; ++j) o[j] = (f32x4){0.f, 0.f, 0.f, 0.f};
            C_LOAD_PK(pkA, 0) C_LOAD_PK(pkB, 1)
            C_ISSUE(rowA, wA, pkA)
#pragma unroll 1
            for (int bi = 0; bi < nb; bi += 2) {
                C_ISSUE(rowB, wB, pkB) C_LOAD_PK(pkA, bi + 2)
                __builtin_amdgcn_sched_barrier(0);
                C_COMPUTE(rowA, wA)
                __builtin_amdgcn_sched_barrier(0);
                C_ISSUE(rowA, wA, pkA) C_LOAD_PK(pkB, bi + 3)
                __builtin_amdgcn_sched_barrier(0);
                C_COMPUTE(rowB, wB)
                __builtin_amdgcn_sched_barrier(0);
                if ((bi & 7) == 6) {
                    const int t = ws0 + tg + (bi >> 3) * nslot;
#pragma unroll
                    for (int j = 0; j < 4; ++j) { *(GAS f32x4*)(XO + (size_t)t * D + 256 * j + 32 * sl + 4 * c) = o[j]; o[j] = (f32x4){0.f, 0.f, 0.f, 0.f}; }
                }
            }
#undef C_TOK
#undef C_LOAD_PK
#undef C_ISSUE
#undef C_COMPUTE
          }
        } }
        GRID_BAR();
#undef P10_CENSUS
        { PHASE_PTRS LAYER_PTRS
        { const int ln = lane_id_v();
          const float* XO = (const float*)(wsq + WS_XO);
          f32x4 gt2v[4], gm[4], shv[4];
          auto prep = [&](int midx) {
              const float* md = modl + (size_t)midx * 6 * D; const float* md1 = modl + (size_t)(3 + midx) * 6 * D;
#pragma unroll
              for (int j = 0; j < 4; ++j) {
                  gt2v[j] = *((const GAS f32x4*)(md + 5 * D) + ln + 64 * j);
                  if (!last) { const f32x4 g = *((const GAS f32x4*)(IN_[I_G1] + (layer + 1) * D) + ln + 64 * j); const f32x4 sc = *((const GAS f32x4*)(md1 + D) + ln + 64 * j);
                               gm[j] = g * (sc + 1.0f); shv[j] = *((const GAS f32x4*)(md1 + 0) + ln + 64 * j); }
                  else { gm[j] = *((const GAS f32x4*)IN_[I_GFINAL] + ln + 64 * j); shv[j] = (f32x4){0.f, 0.f, 0.f, 0.f}; }
              } };
          auto row = [&](int t) {
              GAS f32x4* xr = (GAS f32x4*)(X + (size_t)t * D) + ln;
              const GAS f32x4* xo = (const GAS f32x4*)(XO + (size_t)t * D) + ln;
              f32x4 xn[4]; float ss = 0.f;
#pragma unroll
              for (int j = 0; j < 4; ++j) { xn[j] = xr[64 * j] + gt2v[j] * xo[64 * j]; ss += (xn[j].x * xn[j].x + xn[j].y * xn[j].y) + (xn[j].z * xn[j].z + xn[j].w * xn[j].w); }
              const float rs = 1.0f / sqrtf(wave_sum(ss) * (1.f / D) + NORM_EPS);
              if (!last) {
                  GAS v2u* o8 = (GAS v2u*)(H + (size_t)t * D) + ln;
#pragma unroll
                  for (int j = 0; j < 4; ++j) { xr[64 * j] = xn[j]; const f32x4 hh = xn[j] * rs * gm[j] + shv[j]; v2u o; o.x = pk2(hh.x, hh.y); o.y = pk2(hh.z, hh.w); o8[64 * j] = o; }
              } else {
                  GAS f32x4* op = (GAS f32x4*)(((float*)IN_[22]) + (size_t)t * D) + ln;
#pragma unroll
                  for (int j = 0; j < 4; ++j) op[64 * j] = xn[j] * rs * gm[j];
              } };
          wave_row_blocks(T_EFF, gw, NGW, prep, row);
        } }
#endif
        if (!last) GRID_BAR();
    }
}

extern "C" void kernel_launch(void* const* d_in, const int* in_sizes, int n_in, void* d_out, int out_size, void* d_ws, size_t ws_size, hipStream_t stream) {
    static int grid = 0;
    if (grid == 0) {
        if (n_in != 22 || out_size != T_LAT * D || ws_size < WS_END) { fprintf(stderr, "kernel_launch: unexpected shapes: n_in %d out %d ws %zu (need %zu)\n", n_in, out_size, ws_size, (size_t)WS_END); grid = -1; return; }
        int dev = 0, cus = 0, per_cu = 0;
        if (hipGetDevice(&dev) != hipSuccess || hipDeviceGetAttribute(&cus, hipDeviceAttributeMultiprocessorCount, dev) != hipSuccess) { fprintf(stderr, "device query failed\n"); grid = -1; return; }
        if (hipFuncSetAttribute((const void*)mega_fwd, hipFuncAttributeMaxDynamicSharedMemorySize, LDS_BYTES) != hipSuccess) { fprintf(stderr, "hipFuncSetAttribute failed\n"); grid = -1; return; }
        if (hipOccupancyMaxActiveBlocksPerMultiprocessor(&per_cu, (const void*)mega_fwd, NTHREADS, LDS_BYTES) != hipSuccess || per_cu < 1) { fprintf(stderr, "occupancy query: %d\n", per_cu); }
        (void)hipGetLastError();
        grid = cus;
    }
    if (grid < 0) return;
    if (hipMemsetAsync((char*)d_ws + WS_CTL, 0, CTL_ZERO_BYTES, stream) != hipSuccess) { fprintf(stderr, "memset failed\n"); return; }
    Args a{};
    for (int i = 0; i < 22; ++i) a.in[i] = (const float*)d_in[i];
    a.out = (float*)d_out; a.ws = (unsigned char*)d_ws;
    hipLaunchKernelGGL(mega_fwd, dim3(grid), dim3(NTHREADS), LDS_BYTES, stream, a);
}
```

```cpp
#include <hip/hip_runtime.h>
#include <cstdio>
#include <cstdint>

#ifndef REP_P0
#define REP_P0 1
#endif
#ifndef REP_P1
#define REP_P1 1
#endif
#ifndef REP_P2
#define REP_P2 1
#endif
#ifndef REP_P3A
#define REP_P3A 1
#endif
#ifndef REP_P3B
#define REP_P3B 1
#endif
#ifndef REP_P4
#define REP_P4 1
#endif
#ifndef REP_P6
#define REP_P6 1
#endif
#ifndef REP_P7
#define REP_P7 1
#endif
#ifndef REP_P8
#define REP_P8 1
#endif
#ifndef REP_P9
#define REP_P9 1
#endif
#ifndef REP_P10
#define REP_P10 1
#endif
#ifndef REP_P10A
#define REP_P10A 1
#endif
#ifndef REP_P10C
#define REP_P10C 1
#endif
#ifndef REP_P10B
#define REP_P10B 1
#endif
#ifndef REP_P0A
#define REP_P0A 1
#endif
#ifndef REP_P0D
#define REP_P0D 1
#endif
#ifndef REP_P0F
#define REP_P0F 1
#endif
#ifndef REP_P3C
#define REP_P3C 1
#endif
#define GAS __attribute__((address_space(1)))
#define LAS __attribute__((address_space(3)))
typedef unsigned short bf16;
typedef float f32x4 __attribute__((ext_vector_type(4)));
typedef short bf16x8 __attribute__((ext_vector_type(8)));
typedef unsigned v4u __attribute__((ext_vector_type(4)));
typedef unsigned v2u __attribute__((ext_vector_type(2)));
typedef float f32x2 __attribute__((ext_vector_type(2)));
typedef GAS unsigned gu32;

constexpr int NWAVES = 8, NTHREADS = 512;
constexpr int D = 1024, BATCH = 2, SEQ = 8192, DEPTH = 2, GRID_W = 64, CTX = 256;
constexpr int T_LAT = BATCH * SEQ;
constexpr int T_ALL = T_LAT + BATCH * CTX;
constexpr int NTOK = SEQ + CTX;
constexpr int IN_W = 6912;
constexpr int PEER_HEADS = 8, PEER_KEYS = 128, PEER_TOPK = 16, NSEL = PEER_HEADS * PEER_TOPK;
constexpr float NORM_EPS = 1e-6f;
constexpr float LOG2E = 1.4426950408889634f;
constexpr float SCL2 = 0.125f * LOG2E;

constexpr size_t MiB = 1u << 20;
constexpr size_t WS_CTL = 0, CTL_ZERO_BYTES = 1 * MiB;
constexpr int CW_BAR = 4096;
constexpr int CW_RANK = 8192;
#ifndef P10_SLICED
#define P10_SLICED 1
#endif
constexpr size_t WS_MOD = 65536;
constexpr size_t WS_COS = 2 * MiB, WS_SIN = 3 * MiB;
constexpr size_t WS_WIN = 4 * MiB;
constexpr size_t WS_WB = 31 * MiB;
constexpr size_t WS_WO = 37 * MiB;
constexpr size_t WS_WQ = 41 * MiB;
constexpr size_t WS_KEYS = 49 * MiB;
constexpr size_t WS_X = 50 * MiB;
constexpr size_t WS_H = 116 * MiB;
constexpr size_t WS_Y = 149 * MiB;
constexpr size_t WS_MG = WS_H;
constexpr size_t WS_U8 = 199 * MiB;
constexpr size_t WS_SCU = 231 * MiB;
constexpr size_t WS_EI = 232 * MiB;
constexpr size_t WS_EG = 241 * MiB;
constexpr size_t WS_P = 250 * MiB;
constexpr size_t SZ_R512 = (size_t)T_ALL * 512 * 2;
constexpr size_t SZ_R128 = (size_t)T_ALL * 128 * 2;
constexpr size_t WS_AQ = WS_P, WS_AK = WS_AQ + SZ_R512, WS_AVT = WS_AK + SZ_R128, WS_BQ = WS_AVT + SZ_R128, WS_BK = WS_BQ + SZ_R512,
                 WS_BVT = WS_BK + SZ_R512, WS_CQ = WS_BVT + SZ_R512, WS_CK = WS_CQ + SZ_R512, WS_CVT = WS_CK + SZ_R512, WS_SG = WS_CVT + SZ_R512;
constexpr size_t WS_Q2 = WS_P;
constexpr size_t WS_SC = WS_P + 66 * MiB;
constexpr size_t WS_PART = WS_P, WS_XO = WS_P + 66 * MiB, WS_WGT = WS_P + 132 * MiB;
constexpr size_t WS_PEND = WS_SG + (size_t)T_ALL * 3072 * 2;
constexpr size_t WS_V8 = 473 * MiB;
constexpr size_t WS_END = WS_V8 + 32 * MiB;
static_assert(WS_SC + (size_t)T_ALL * 2048 * 4 <= WS_PEND && WS_PEND <= WS_V8, "alias map");
static_assert(WS_END <= 512 * MiB, "ws map");

constexpr int LDS_BYTES = 147456;
constexpr int MISC_OFF = 131072 + 320;

__device__ __forceinline__ int lane_id_v() { int l; asm volatile("v_mbcnt_lo_u32_b32 %0, -1, 0\n\tv_mbcnt_hi_u32_b32 %0, -1, %0" : "=v"(l)); return l; }
#define XB_TMO      128
#define XB_XCNT(j)  (256  + 64 * (j))
#define XB_XSUB(j)  (1280 + 64 * (j))
#define XB_XGEN(j)  (2304 + 64 * (j))
#define XB_TOP      3328
#define XB_TOPGEN   3392
#define XCD_BAR_WORDS 3456
#define XB_SPIN_CAP (1u << 24)

__device__ __forceinline__ unsigned xb_ld(unsigned* p)              { return __hip_atomic_load(p, __ATOMIC_RELAXED, __HIP_MEMORY_SCOPE_AGENT); }
__device__ __forceinline__ unsigned xb_add(unsigned* p, unsigned v) { return __hip_atomic_fetch_add(p, v, __ATOMIC_RELAXED, __HIP_MEMORY_SCOPE_AGENT); }
__device__ __forceinline__ unsigned xb_xcc_id() { return (unsigned)__builtin_amdgcn_s_getreg((3 << 11) | 20) & 0xFu; }
#define XB_SPIN(cond, bar) do { unsigned _sp = 0; while (cond) { __builtin_amdgcn_s_sleep(1); \
    if ((++_sp & 255u) == 0u) { if (xb_ld(&(bar)[XB_TMO])) break; if (_sp > XB_SPIN_CAP) { atomicAdd(&(bar)[XB_TMO], 1u); break; } } } } while (0)

struct XcdBarrier { unsigned* bar; unsigned x; volatile LAS unsigned* st; };

__device__ __forceinline__ XcdBarrier xcd_barrier_post(unsigned* bar, volatile LAS unsigned* st) {
    XcdBarrier b; b.bar = bar; b.x = xb_xcc_id(); b.st = st;
    if (threadIdx.x == 0) (void)xb_add(&bar[XB_XCNT(b.x)], 1u);
    return b;
}
__device__ __forceinline__ void xcd_barrier_complete(unsigned* bar, unsigned x, unsigned& nloc, unsigned& nx) {
    const unsigned G = gridDim.x * gridDim.y * gridDim.z;
    unsigned sum, cnt, mine, sp = 0u;
    for (;;) {
        sum = 0u; cnt = 0u; mine = 0u;
#pragma unroll
        for (unsigned j = 0; j < 16; ++j) { const unsigned c = xb_ld(&bar[XB_XCNT(j)]); sum += c; cnt += (c > 0u) ? 1u : 0u; mine = (j == x) ? c : mine; }
        if (sum == G) break;
        __builtin_amdgcn_s_sleep(1);
        if ((++sp & 255u) == 0u) { if (xb_ld(&bar[XB_TMO])) break; if (sp > XB_SPIN_CAP) { atomicAdd(&bar[XB_TMO], 1u); break; } }
    }
    nloc = mine > 0u ? mine : 1u; nx = cnt > 0u ? cnt : 1u;
}
__device__ __forceinline__ void xcd_barrier(const XcdBarrier& b, bool t0) {
    asm volatile("s_waitcnt vmcnt(0)" ::: "memory");
    __syncthreads();
    if (t0) {
        unsigned* bar = b.bar;
        __builtin_amdgcn_s_waitcnt(0);
        unsigned nloc = b.st[0], nx = b.st[1];
        if (nloc == 0u) { xcd_barrier_complete(bar, b.x, nloc, nx); b.st[0] = nloc; b.st[1] = nx; }
        const unsigned old = xb_add(&bar[XB_XSUB(b.x)], 1u);
        const unsigned gen = old / nloc;
        if (old + 1u == (gen + 1u) * nloc) {
            __builtin_amdgcn_fence(__ATOMIC_RELEASE, "agent");
            asm volatile("s_waitcnt vmcnt(0)" ::: "memory");
            const unsigned og = xb_add(&bar[XB_TOP], 1u);
            const unsigned tg = og / nx;
            if (og + 1u == (tg + 1u) * nx) xb_add(&bar[XB_TOPGEN], 1u);
            else XB_SPIN(xb_ld(&bar[XB_TOPGEN]) == tg, bar);
            __builtin_amdgcn_fence(__ATOMIC_ACQUIRE, "agent");
            xb_add(&bar[XB_XGEN(b.x)], 1u);
            asm volatile("s_waitcnt vmcnt(0)" ::: "memory");
        } else {
            XB_SPIN(xb_ld(&bar[XB_XGEN(b.x)]) == gen, bar);
            __builtin_amdgcn_fence(__ATOMIC_ACQUIRE, "agent");
            asm volatile("s_waitcnt vmcnt(0)" ::: "memory");
        }
    }
    __syncthreads();
}

__device__ __forceinline__ unsigned f2bf(float f) { unsigned u = __builtin_bit_cast(unsigned, f); return (u + 0x7fffu + ((u >> 16) & 1u)) >> 16; }
__device__ __forceinline__ unsigned pk2(float lo, float hi) { return f2bf(lo) | (f2bf(hi) << 16); }
__device__ __forceinline__ float bf2f(unsigned h) { return __builtin_bit_cast(float, h << 16); }
template <int CTRL> __device__ __forceinline__ float dpp_mov(float v) { return __builtin_bit_cast(float, __builtin_amdgcn_update_dpp(0, __builtin_bit_cast(int, v), CTRL, 0xF, 0xF, true)); }
__device__ __forceinline__ float sum8_dpp(float v) { v += dpp_mov<0xB1>(v); v += dpp_mov<0x4E>(v); v += dpp_mov<0x141>(v); return v; }
template <int K> __device__ __forceinline__ float xshfl_l(float v, int lane) { return __builtin_bit_cast(float, __builtin_amdgcn_ds_bpermute((lane ^ K) << 2, __builtin_bit_cast(int, v))); }
template <int K> __device__ __forceinline__ float xshfl(float v) { return xshfl_l<K>(v, lane_id_v()); }
__device__ __forceinline__ float xadd32(float v) { return v + xshfl_l<32>(v, lane_id_v()); }
__device__ __forceinline__ float xmax32(float v) { return fmaxf(v, xshfl_l<32>(v, lane_id_v())); }
__device__ __forceinline__ float wave_sum(float v) { const int l = lane_id_v(); v += xshfl_l<1>(v, l); v += xshfl_l<2>(v, l); v += xshfl_l<4>(v, l); v += xshfl_l<8>(v, l); v += xshfl_l<16>(v, l); v += xshfl_l<32>(v, l); return v; }
__device__ __forceinline__ float wave_max(float v) { const int l = lane_id_v(); v = fmaxf(v, xshfl_l<1>(v, l)); v = fmaxf(v, xshfl_l<2>(v, l)); v = fmaxf(v, xshfl_l<4>(v, l)); v = fmaxf(v, xshfl_l<8>(v, l)); v = fmaxf(v, xshfl_l<16>(v, l)); v = fmaxf(v, xshfl_l<32>(v, l)); return v; }


__device__ __forceinline__ float sigmoidf_(float x) { return 1.0f / (1.0f + __expf(-x)); }
__device__ __forceinline__ float sigmoid_fast(float x) { return __builtin_amdgcn_rcpf(1.0f + __builtin_amdgcn_exp2f(-LOG2E * x)); }
__device__ __forceinline__ int row_modidx(int r) { return r < T_LAT ? (r >> 13) : 2; }
__device__ __forceinline__ int row_batch(int r) { return r < T_LAT ? (r >> 13) : ((r - T_LAT) >> 8); }
__device__ __forceinline__ int row_tok(int r) { return r < T_LAT ? (r & (SEQ - 1)) : SEQ + ((r - T_LAT) & (CTX - 1)); }

__device__ __forceinline__ const float* xin_row(const float* x, const float* ctx, int r) { return r < T_LAT ? x + (size_t)r * D : ctx + (size_t)(r - T_LAT) * D; }
template <class Prep, class Row>
__device__ __forceinline__ void wave_row_blocks(int T_rows, int gw, int NGW, Prep prep, Row row) {
    for (int r0 = gw * 8; r0 < T_LAT; r0 += NGW * 8) {
        prep(r0 >> 13);
#pragma unroll 2
        for (int k = 0; k < 8; ++k) row(r0 + k);
    }
    if (T_rows > T_LAT) for (int r = T_LAT + gw; r < T_rows; r += NGW) { prep(2); row(r); }
}
struct Args { const float* in[22]; float* out; unsigned char* ws; };
enum { I_X = 0, I_C, I_CTX, I_CCTX, I_WMOD, I_BMOD, I_G1, I_G2, I_WIN, I_SINK, I_RPB, I_LAMBDA, I_SUBLN, I_WBA, I_WBB, I_WBC, I_WOUT, I_PWQ, I_PKEYS, I_PU, I_PV, I_GFINAL };

__device__ __forceinline__ int rope_perm(int c) {
    if (c < 640 || (c >= 2304 && c < 3328)) { const int w = c & 63; return (c & ~63) + 2 * (w & 31) + (w >> 5); }
    return c;
}
template <bool PERM = false>
__device__ __forceinline__ void p0_transpose_item(const float* W, int K, int N, bf16* WT, LAS float* scr, int item, int lane) {
    const int nblk = N / 32, kb = item / nblk, nb = item % nblk, k0 = 64 * kb, n0 = 32 * nb;
    {
        f32x4 w[8];
        const float* src = W + (size_t)(k0 + (lane >> 3)) * N + n0 + 4 * (lane & 7);
#pragma unroll
        for (int i = 0; i < 8; ++i) w[i] = *(const GAS f32x4*)(src + (size_t)(8 * i) * N);
#pragma unroll
        for (int i = 0; i < 8; ++i) { LAS float* d = scr + (8 * i + (lane >> 3)) * 33 + 4 * (lane & 7); d[0] = w[i].x; d[1] = w[i].y; d[2] = w[i].z; d[3] = w[i].w; }
    }
    asm volatile("s_waitcnt lgkmcnt(0)" ::: "memory");
    const int c = lane & 7;
#pragma unroll
    for (int j = 0; j < 4; ++j) { const int n = (lane >> 3) + 8 * j; const LAS float* s = scr + (8 * c) * 33 + n;
        v4u o; o.x = pk2(s[0 * 33], s[1 * 33]); o.y = pk2(s[2 * 33], s[3 * 33]); o.z = pk2(s[4 * 33], s[5 * 33]); o.w = pk2(s[6 * 33], s[7 * 33]);
        const int nout = PERM ? rope_perm(n0 + n) : (n0 + n);
        *(GAS v4u*)(WT + (size_t)nout * K + k0 + 8 * c) = o; }
    asm volatile("s_waitcnt lgkmcnt(0)" ::: "memory");
}

template <int UNR = 2, int NN = 4>
__device__ __forceinline__ void sgemm_tile(f32x4 (&acc)[4][NN], const bf16* A, int lda, const bf16* Bt, int ldb, int K, int row0, int col0, int lane) {
    const int fr = lane & 15, fq = lane >> 4;
    const bf16* ap = A + (size_t)(row0 + fr) * lda + fq * 8;
    const bf16* bp = Bt + (size_t)(col0 + fr) * ldb + fq * 8;
#pragma unroll UNR
    for (int k = 0; k < K; k += 32) {
        bf16x8 a[4], b[NN];
#pragma unroll
        for (int m = 0; m < 4; ++m) a[m] = *(const GAS bf16x8*)(ap + (size_t)m * 16 * lda + k);
#pragma unroll
        for (int n = 0; n < NN; ++n) b[n] = *(const GAS bf16x8*)(bp + (size_t)n * 16 * ldb + k);
#pragma unroll
        for (int m = 0; m < 4; ++m)
#pragma unroll
            for (int n = 0; n < NN; ++n) acc[m][n] = __builtin_amdgcn_mfma_f32_16x16x32_bf16(a[m], b[n], acc[m][n], 0, 0, 0);
    }
}
template <int UNR>
__device__ __forceinline__ void sgemm32(f32x4 (&acc)[2][2], const bf16* A, int lda, const bf16* Bt, int ldb, int K, int row0, int col0, int lane) {
    const int fr = lane & 15, fq = lane >> 4;
    const bf16* ap = A + (size_t)(row0 + fr) * lda + fq * 8;
    const bf16* bp = Bt + (size_t)(col0 + fr) * ldb + fq * 8;
#pragma unroll 1
    for (int k0 = 0; k0 < K; k0 += 32 * UNR) {
        bf16x8 a[UNR][2], b[UNR][2];
#pragma unroll
        for (int u = 0; u < UNR; ++u)
#pragma unroll
            for (int m = 0; m < 2; ++m) { a[u][m] = *(const GAS bf16x8*)(ap + (size_t)m * 16 * lda + k0 + 32 * u); b[u][m] = *(const GAS bf16x8*)(bp + (size_t)m * 16 * ldb + k0 + 32 * u); }
#pragma unroll
        for (int u = 0; u < UNR; ++u)
#pragma unroll
            for (int m = 0; m < 2; ++m)
#pragma unroll
                for (int n = 0; n < 2; ++n) acc[m][n] = __builtin_amdgcn_mfma_f32_16x16x32_bf16(a[u][m], b[u][n], acc[m][n], 0, 0, 0);
    }
}
__device__ __forceinline__ void zero_acc22(f32x4 (&acc)[2][2]) { acc[0][0] = acc[0][1] = acc[1][0] = acc[1][1] = (f32x4){0.f, 0.f, 0.f, 0.f}; }
template <int NN>
__device__ __forceinline__ void zero_acc(f32x4 (&acc)[4][NN]) {
#pragma unroll
    for (int m = 0; m < 4; ++m)
#pragma unroll
        for (int n = 0; n < NN; ++n) acc[m][n] = (f32x4){0.f, 0.f, 0.f, 0.f};
}

__device__ __forceinline__ int f2ord(float f) { const int b = __builtin_bit_cast(int, f); return b ^ ((b >> 31) & 0x7fffffff); }
__device__ __forceinline__ float ord2f(int o) { const int b = o ^ ((o >> 31) & 0x7fffffff); return __builtin_bit_cast(float, b); }
__device__ __forceinline__ void top16_insert(int (&top)[16], int key) {
#pragma unroll
    for (int i = 0; i < 16; ++i) { const int hi = max(top[i], key); key = min(top[i], key); top[i] = hi; }
}
#define CE(a, b) { const int t_ = max(a, b); b = min(a, b); a = t_; }
__device__ __forceinline__ void sort16_desc(int (&v)[16]) { CE(v[0], v[1]); CE(v[3], v[2]); CE(v[4], v[5]); CE(v[7], v[6]); CE(v[8], v[9]); CE(v[11], v[10]); CE(v[12], v[13]); CE(v[15], v[14]); CE(v[0], v[2]); CE(v[1], v[3]); CE(v[6], v[4]); CE(v[7], v[5]); CE(v[8], v[10]); CE(v[9], v[11]); CE(v[14], v[12]); CE(v[15], v[13]); CE(v[0], v[1]); CE(v[2], v[3]); CE(v[5], v[4]); CE(v[7], v[6]); CE(v[8], v[9]); CE(v[10], v[11]); CE(v[13], v[12]); CE(v[15], v[14]); CE(v[0], v[4]); CE(v[1], v[5]); CE(v[2], v[6]); CE(v[3], v[7]); CE(v[12], v[8]); CE(v[13], v[9]); CE(v[14], v[10]); CE(v[15], v[11]); CE(v[0], v[2]); CE(v[1], v[3]); CE(v[4], v[6]); CE(v[5], v[7]); CE(v[10], v[8]); CE(v[11], v[9]); CE(v[14], v[12]); CE(v[15], v[13]); CE(v[0], v[1]); CE(v[2], v[3]); CE(v[4], v[5]); CE(v[6], v[7]); CE(v[9], v[8]); CE(v[11], v[10]); CE(v[13], v[12]); CE(v[15], v[14]); CE(v[0], v[8]); CE(v[1], v[9]); CE(v[2], v[10]); CE(v[3], v[11]); CE(v[4], v[12]); CE(v[5], v[13]); CE(v[6], v[14]); CE(v[7], v[15]); CE(v[0], v[4]); CE(v[1], v[5]); CE(v[2], v[6]); CE(v[3], v[7]); CE(v[8], v[12]); CE(v[9], v[13]); CE(v[10], v[14]); CE(v[11], v[15]); CE(v[0], v[2]); CE(v[1], v[3]); CE(v[4], v[6]); CE(v[5], v[7]); CE(v[8], v[10]); CE(v[9], v[11]); CE(v[12], v[14]); CE(v[13], v[15]); CE(v[0], v[1]); CE(v[2], v[3]); CE(v[4], v[5]); CE(v[6], v[7]); CE(v[8], v[9]); CE(v[10], v[11]); CE(v[12], v[13]); CE(v[14], v[15]); }
__device__ __forceinline__ void merge16_desc(int (&a)[16], const int (&b)[16]) {
#pragma unroll
    for (int i = 0; i < 16; ++i) a[i] = max(a[i], b[15 - i]);
    CE(a[0], a[8]); CE(a[1], a[9]); CE(a[2], a[10]); CE(a[3], a[11]); CE(a[4], a[12]); CE(a[5], a[13]); CE(a[6], a[14]); CE(a[7], a[15]); CE(a[0], a[4]); CE(a[1], a[5]); CE(a[2], a[6]); CE(a[3], a[7]); CE(a[8], a[12]); CE(a[9], a[13]); CE(a[10], a[14]); CE(a[11], a[15]); CE(a[0], a[2]); CE(a[1], a[3]); CE(a[4], a[6]); CE(a[5], a[7]); CE(a[8], a[10]); CE(a[9], a[11]); CE(a[12], a[14]); CE(a[13], a[15]); CE(a[0], a[1]); CE(a[2], a[3]); CE(a[4], a[5]); CE(a[6], a[7]); CE(a[8], a[9]); CE(a[10], a[11]); CE(a[12], a[13]); CE(a[14], a[15]); }
#undef CE


typedef float f32x16 __attribute__((ext_vector_type(16)));
typedef short s16x4 __attribute__((ext_vector_type(4)));
typedef __bf16 bf16x2_t __attribute__((ext_vector_type(2)));
__device__ __forceinline__ unsigned cvtpk(float lo, float hi) { f32x2 v = {lo, hi}; bf16x2_t b = __builtin_convertvector(v, bf16x2_t); return __builtin_bit_cast(unsigned, b); }
constexpr int CK_PITCH = 144, CV_PITCH = 320;
constexpr int CK_SZ = 64 * CK_PITCH, CV_SZ = 64 * CV_PITCH;
constexpr float C_THR_RAW = 8.0f / SCL2;

template <int NDV, bool HASCM, class RowFn, class UseFn, class ElemFn, class CmFn>
__device__ __forceinline__ void attn64_pass(f32x16 (&o)[NDV], float& mrun, float& lpart, const bf16x8 (&qf)[4], const bf16* kg, int kpitch, const bf16* vg, int vpitch,
                                            int ntiles, RowFn tile_row, UseFn use_tile, ElemFn elem, const f32x16 (&cm)[2], CmFn cm_tile, LAS unsigned char* L, int lane, int tid) {
    constexpr int VP = NDV * 64 + 64, VSZ = 64 * VP, NVP = NDV / 2;
    const int r32 = lane & 31, hi = lane >> 5;
    const int krow_s = tid >> 3, kch_s = tid & 7;
    const int vrow_s = (NDV == 2) ? (tid >> 3) : (tid >> 4), vch_s = (NDV == 2) ? (tid & 7) : (tid & 15);
    LAS unsigned char* Kb0 = L; LAS unsigned char* Vb0 = L + 2 * CK_SZ;
    __syncthreads();
    {
        const int tr = tile_row(0);
        const v4u kr = *(const GAS v4u*)(kg + (size_t)tr * kpitch);
        *(LAS v4u*)(Kb0 + krow_s * CK_PITCH + kch_s * 16) = kr;
#pragma unroll
        for (int i = 0; i < NVP; ++i) { const v4u v = *(const GAS v4u*)(vg + (size_t)(tr + 32 * i) * vpitch); *(LAS v4u*)(Vb0 + (vrow_s + 32 * i) * VP + vch_s * 16) = v; }
    }
    v4u kr, vr[NVP];
    { const int tr = tile_row(ntiles > 1 ? 1 : 0); kr = *(const GAS v4u*)(kg + (size_t)tr * kpitch);
#pragma unroll
      for (int i = 0; i < NVP; ++i) vr[i] = *(const GAS v4u*)(vg + (size_t)(tr + 32 * i) * vpitch); }
    __syncthreads();
#pragma unroll 1
    for (int j = 0; j < ntiles; ++j) {
        const int cur = j & 1;
        const LAS unsigned char* Kb = Kb0 + cur * CK_SZ; const LAS unsigned char* Vb = Vb0 + cur * VSZ;
        const bool more = (j + 1 < ntiles);
        v4u kr2, vr2[NVP];
        { const int tr = tile_row(j + 2 < ntiles ? j + 2 : ntiles - 1); kr2 = *(const GAS v4u*)(kg + (size_t)tr * kpitch);
#pragma unroll
            for (int i = 0; i < NVP; ++i) vr2[i] = *(const GAS v4u*)(vg + (size_t)(tr + 32 * i) * vpitch); }
        if (use_tile(j)) {
            f32x16 st[2];
            if (HASCM && cm_tile(j)) {
#pragma unroll
                for (int kb = 0; kb < 2; ++kb) {
#pragma unroll
                    for (int ks = 0; ks < 4; ++ks) {
                        const bf16x8 kf = *(const LAS bf16x8*)(Kb + (kb * 32 + r32) * CK_PITCH + ks * 32 + hi * 16);
                        st[kb] = __builtin_amdgcn_mfma_f32_32x32x16_bf16(kf, qf[ks], ks == 0 ? cm[kb] : st[kb], 0, 0, 0);
                    }
                }
            } else {
#pragma unroll
                for (int kb = 0; kb < 2; ++kb) {
#pragma unroll
                    for (int r = 0; r < 16; ++r) st[kb][r] = 0.f;
#pragma unroll
                    for (int ks = 0; ks < 4; ++ks) {
                        const bf16x8 kf = *(const LAS bf16x8*)(Kb + (kb * 32 + r32) * CK_PITCH + ks * 32 + hi * 16);
                        st[kb] = __builtin_amdgcn_mfma_f32_32x32x16_bf16(kf, qf[ks], st[kb], 0, 0, 0);
                    }
                }
            }
            elem(st, j);
            float mx = st[0][0];
#pragma unroll
            for (int r = 1; r < 16; ++r) mx = fmaxf(mx, st[0][r]);
#pragma unroll
            for (int r = 0; r < 16; ++r) mx = fmaxf(mx, st[1][r]);
            mx = xmax32(mx);
            if (__builtin_amdgcn_ballot_w64(mx > mrun + C_THR_RAW) != 0ull) {
                const float mn = fmaxf(mrun, mx);
                const float alpha = __builtin_amdgcn_exp2f((mrun - mn) * SCL2);
#pragma unroll
                for (int d = 0; d < NDV; ++d)
#pragma unroll
                    for (int r = 0; r < 16; ++r) o[d][r] *= alpha;
                lpart *= alpha; mrun = mn;
            }
            const float nmc = -mrun * SCL2;
            float ls = 0.f;
#pragma unroll
            for (int kb = 0; kb < 2; ++kb)
#pragma unroll
                for (int r = 0; r < 16; ++r) { const float p = __builtin_amdgcn_exp2f(fmaf(st[kb][r], SCL2, nmc)); st[kb][r] = p; ls += p; }
            lpart += ls;
            const int q4 = (lane & 15) >> 2, p4 = lane & 3, grp = (lane >> 4) & 1;
            const LAS unsigned char* vbase = Vb + (4 * hi + q4) * VP + (16 * grp + 4 * p4) * 2;
#pragma unroll
            for (int kb = 0; kb < 2; ++kb)
#pragma unroll
                for (int ss = 0; ss < 2; ++ss) {
                    v4u pw;
#pragma unroll
                    for (int i2 = 0; i2 < 4; ++i2) pw[i2] = cvtpk(st[kb][8 * ss + 2 * i2], st[kb][8 * ss + 2 * i2 + 1]);
                    const bf16x8 pb = __builtin_bit_cast(bf16x8, pw);
#pragma unroll
                    for (int d = 0; d < NDV; ++d) {
                        const LAS unsigned char* va = vbase + (kb * 32 + 16 * ss) * VP + d * 64;
                        const s16x4 lo = __builtin_bit_cast(s16x4, __builtin_amdgcn_ds_read_tr16_b64_v4i16((LAS s16x4*)va));
                        const s16x4 hh = __builtin_bit_cast(s16x4, __builtin_amdgcn_ds_read_tr16_b64_v4i16((LAS s16x4*)(va + 8 * VP)));
                        const bf16x8 vf = __builtin_shufflevector(lo, hh, 0, 1, 2, 3, 4, 5, 6, 7);
                        o[d] = __builtin_amdgcn_mfma_f32_32x32x16_bf16(vf, pb, o[d], 0, 0, 0);
                    }
                }
        }
        if (more) {
            LAS unsigned char* Kn = Kb0 + (cur ^ 1) * CK_SZ; LAS unsigned char* Vn = Vb0 + (cur ^ 1) * VSZ;
            *(LAS v4u*)(Kn + krow_s * CK_PITCH + kch_s * 16) = kr;
#pragma unroll
            for (int i = 0; i < NVP; ++i) *(LAS v4u*)(Vn + (vrow_s + 32 * i) * VP + vch_s * 16) = vr[i];
        }
        kr = kr2;
#pragma unroll
        for (int i = 0; i < NVP; ++i) vr[i] = vr2[i];
        __syncthreads();
    }
}
__device__ __forceinline__ void attn64_store(const f32x16 (&o)[2], float inv, bf16* yrow, int hi) {
#pragma unroll
    for (int d = 0; d < 2; ++d)
#pragma unroll
        for (int g4 = 0; g4 < 4; ++g4) {
            v2u w; w.x = cvtpk(o[d][4 * g4] * inv, o[d][4 * g4 + 1] * inv); w.y = cvtpk(o[d][4 * g4 + 2] * inv, o[d][4 * g4 + 3] * inv);
            *(GAS v2u*)(yrow + d * 32 + 8 * g4 + 4 * hi) = w;
        }
}

namespace pg8 {
typedef unsigned short bf16_t;
constexpr int BM = 256, BK = 64, HALF = 128, HTB = HALF * BK * 2, STAGE_BYTES = 8 * HTB, NXCD = 8, WGM = 8;
__host__ __device__ __forceinline__ int lds_byte(int r, int c) { const int st = (r >> 4) * 2 + (c >> 5), rr = r & 15, cc = c & 31, ob = rr * 64 + cc * 2; return st * 1024 + (ob ^ (((ob >> 9) & 1) << 5)); }
__host__ __device__ __forceinline__ void stage_rc(int b, int& R, int& C) { const int st = b / 1024, sb = b % 1024, swz = sb ^ (((sb >> 9) & 1) << 5); R = (st >> 1) * 16 + swz / 64; C = (st & 1) * 32 + (swz % 64) / 2; }
__host__ __device__ __forceinline__ int perm32(int rho) { const int n = rho >> 4, i = rho & 15; return 8 * (i >> 2) + 4 * n + (i & 3); }
struct Unit { int pm, pn, seg; };
struct Gemm { const bf16_t* A; const bf16_t* Bt; int lda, ldb, K; size_t a_seg, b_seg; };
struct TileOrder {
    int nM, nN, nwg, G, c;
    __device__ void init(int M, int N, int G_, int c_) { nM = M / BM; nN = N / BM; nwg = nM * nN; G = G_; c = c_; }
    __device__ bool tile(int i, int& pm, int& pn) const {
        const long L = (long)i * G + c; if (L >= nwg) return false;
        int wgid = (int)L; { const int q = nwg / NXCD, r = nwg % NXCD, xcd = wgid % NXCD, off = wgid / NXCD; wgid = (xcd < r ? xcd * (q + 1) : r * (q + 1) + (xcd - r) * q) + off; }
        const int nig = WGM * nN, gid = wgid / nig, fm = gid * WGM, gsz = (nM - fm) < WGM ? (nM - fm) : WGM;
        pm = fm + ((wgid % nig) % gsz); pn = (wgid % nig) / gsz; return true;
    }
};
template <int NSEG> struct SegOrder {
    TileOrder T;
    __device__ bool next(int i, Unit& u) const { u.seg = i % NSEG; return T.tile(i / NSEG, u.pm, u.pn); }
};
template <class Epi, class Sched>
__device__ __forceinline__ void gemm_phase(LAS unsigned char* lds, const Gemm g, const Sched& S, const Epi& E, int wid) {
    const int lane = lane_id_v(), tid = wid * 64 + lane,
              wr = wid >> 2, wc = wid & 3, fr = lane & 15, fq = lane >> 4;
    const int K = g.K, nt = K / BK;
    unsigned voffA[2], voffB[2];
#pragma unroll
    for (int i = 0; i < 2; ++i) { int R, C; stage_rc(tid * 16 + i * 8192, R, C); const int Rb = (R & ~31) + perm32(R & 31);
        voffA[i] = (unsigned)(R * g.lda + C) * 2u; voffB[i] = (unsigned)(Rb * g.ldb + C) * 2u; }
    const size_t kstep = (size_t)(BK * 2);
    const size_t hstepA = (size_t)HALF * g.lda * 2, hstepB = (size_t)HALF * g.ldb * 2;
    const unsigned ldsw = (unsigned)wid * 1024u;
    const int aoff = lds_byte(wr * 64 + fr, fq * 8), boff = lds_byte(wc * 32 + fr, fq * 8);
#define PG8_SA(b, h) (((b) * 2 + (h)) * HTB)
#define PG8_SB(b, h) ((4 + (b) * 2 + (h)) * HTB)
#define PG8_STAGE(bufoff, gbase, voff) do { _Pragma("unroll") for (int _i = 0; _i < 2; ++_i) \
        __builtin_amdgcn_global_load_lds((const unsigned*)((const char*)(gbase) + (voff)[_i]), (LAS unsigned*)(lds + (bufoff) + ldsw + _i * 8192), 16, 0, 0); } while (0)
#define PG8_LDA(dst, b, h) do { _Pragma("unroll") for (int m = 0; m < 4; ++m) _Pragma("unroll") for (int k = 0; k < 2; ++k) dst[m][k] = *(const LAS bf16x8*)(lds + PG8_SA(b, h) + aoff + m * 2048 + k * 1024); } while (0)
#define PG8_LDB(dst, b, h) do { _Pragma("unroll") for (int n = 0; n < 2; ++n) _Pragma("unroll") for (int k = 0; k < 2; ++k) dst[n][k] = *(const LAS bf16x8*)(lds + PG8_SB(b, h) + boff + n * 2048 + k * 1024); } while (0)
#define PG8_MMA(ai, bj, At, Bt) do { __builtin_amdgcn_s_setprio(1); _Pragma("unroll") for (int m = 0; m < 4; ++m) _Pragma("unroll") for (int n = 0; n < 2; ++n) _Pragma("unroll") for (int k = 0; k < 2; ++k) \
        acc[ai][bj][m][n] = __builtin_amdgcn_mfma_f32_16x16x32_bf16(Bt[n][k], At[m][k], acc[ai][bj][m][n], 0, 0, 0); __builtin_amdgcn_s_setprio(0); } while (0)
#define PG8_WAIT_V(n) asm volatile("s_waitcnt vmcnt(" #n ")" ::: "memory")
#define PG8_WAIT_L(n) asm volatile("s_waitcnt lgkmcnt(" #n ")" ::: "memory")
#define PG8_BAR __builtin_amdgcn_s_barrier()
#define PG8_SCHED __builtin_amdgcn_sched_barrier(0)
#define PG8_ABASE(u) ((const char*)g.A + ((size_t)(u).seg * g.a_seg + (size_t)(u).pm * BM * g.lda) * 2)
#define PG8_BBASE(u) ((const char*)g.Bt + ((size_t)(u).seg * g.b_seg + (size_t)(u).pn * BM * g.ldb) * 2)
    Unit cur, nxt; int ui = 0;
    if (!S.next(0, cur)) return;
    f32x4 acc[2][2][4][2];
#pragma unroll
    for (int a = 0; a < 2; ++a)
#pragma unroll
        for (int b = 0; b < 2; ++b)
#pragma unroll
            for (int m = 0; m < 4; ++m)
#pragma unroll
                for (int n = 0; n < 2; ++n) acc[a][b][m][n] = (f32x4){0.f, 0.f, 0.f, 0.f};
    bf16x8 At[4][2], B0[2][2], B1[2][2];
    const char* cA = PG8_ABASE(cur); const char* cB = PG8_BBASE(cur);
    PG8_STAGE(PG8_SB(0, 0), cB, voffB); PG8_STAGE(PG8_SB(0, 1), cB + hstepB, voffB); PG8_STAGE(PG8_SA(0, 0), cA, voffA); PG8_STAGE(PG8_SA(0, 1), cA + hstepA, voffA);
    if (wr == 1) PG8_BAR;
    PG8_WAIT_V(2); PG8_BAR;
    PG8_STAGE(PG8_SB(1, 0), cB + kstep, voffB); PG8_STAGE(PG8_SA(1, 0), cA + kstep, voffA); PG8_STAGE(PG8_SB(1, 1), cB + hstepB + kstep, voffB);
    PG8_WAIT_V(6); PG8_BAR;
    for (;;) {
        const bool has_next = S.next(ui + 1, nxt);
        const char* nA = has_next ? PG8_ABASE(nxt) : cA; const char* nB = has_next ? PG8_BBASE(nxt) : cB;
        for (int t = 0; t < nt; t += 2) {
            const bool lastk = (t == nt - 2);
            const char* a1 = cA + (size_t)(t + 1) * kstep;
            const char* a2 = lastk ? nA : cA + (size_t)(t + 2) * kstep; const char* b2 = lastk ? nB : cB + (size_t)(t + 2) * kstep;
            const char* a3 = a2 + kstep; const char* b3 = b2 + kstep;
            PG8_LDB(B0, 0, 0); PG8_LDB(B1, 0, 1); PG8_SCHED; PG8_LDA(At, 0, 0); PG8_STAGE(PG8_SA(1, 1), a1 + hstepA, voffA);
            PG8_WAIT_V(8); PG8_WAIT_L(0); PG8_BAR; PG8_MMA(0, 0, At, B0); PG8_MMA(0, 1, At, B1); PG8_BAR; PG8_SCHED;
            PG8_LDA(At, 0, 1); PG8_STAGE(PG8_SB(0, 0), b2, voffB); PG8_STAGE(PG8_SB(0, 1), b2 + hstepB, voffB); PG8_STAGE(PG8_SA(0, 0), a2, voffA);
            PG8_WAIT_V(8); PG8_WAIT_L(0); PG8_BAR; PG8_MMA(1, 0, At, B0); PG8_MMA(1, 1, At, B1); PG8_BAR; PG8_SCHED;
            PG8_LDB(B0, 1, 0); PG8_LDB(B1, 1, 1); PG8_SCHED; PG8_LDA(At, 1, 0); PG8_STAGE(PG8_SA(0, 1), a2 + hstepA, voffA);
            PG8_WAIT_V(8); PG8_WAIT_L(0); PG8_BAR; PG8_MMA(0, 0, At, B0); PG8_MMA(0, 1, At, B1); PG8_BAR; PG8_SCHED;
            PG8_LDA(At, 1, 1); PG8_STAGE(PG8_SB(1, 0), b3, voffB); PG8_STAGE(PG8_SB(1, 1), b3 + hstepB, voffB); PG8_STAGE(PG8_SA(1, 0), a3, voffA);
            PG8_WAIT_V(8); PG8_WAIT_L(0); PG8_BAR; PG8_MMA(1, 0, At, B0); PG8_MMA(1, 1, At, B1); PG8_BAR; PG8_SCHED;
        }
        if (wr == 0) PG8_BAR;
        E(acc, cur, wr, wc, fr, fq);
        if (!has_next) break;
#pragma unroll
        for (int a = 0; a < 2; ++a)
#pragma unroll
            for (int b = 0; b < 2; ++b)
#pragma unroll
                for (int m = 0; m < 4; ++m)
#pragma unroll
                    for (int n = 0; n < 2; ++n) acc[a][b][m][n] = (f32x4){0.f, 0.f, 0.f, 0.f};
        cur = nxt; cA = nA; cB = nB; ++ui;
        if (wr == 1) PG8_BAR;
    }
    PG8_WAIT_V(0);
    PG8_BAR;
#undef PG8_SA
#undef PG8_SB
#undef PG8_STAGE
#undef PG8_LDA
#undef PG8_LDB
#undef PG8_MMA
#undef PG8_WAIT_V
#undef PG8_WAIT_L
#undef PG8_BAR
#undef PG8_SCHED
#undef PG8_ABASE
#undef PG8_BBASE
}
}

__device__ __forceinline__ v4u pack8(const f32x4& a, const f32x4& b) { v4u w; w.x = cvtpk(a.x, a.y); w.y = cvtpk(a.z, a.w); w.z = cvtpk(b.x, b.y); w.w = cvtpk(b.z, b.w); return w; }
struct EpiInProj {
    bf16 *AQ, *AK, *AVT, *BQ, *BK, *BVT, *CQ, *CK, *CV, *SG; const float *COS, *SIN;
    __device__ __forceinline__ void operator()(const f32x4 (&acc)[2][2][4][2], const pg8::Unit& u, int wr, int wc, int fr, int fq) const {
        asm volatile("" : "+v"(fr), "+v"(fq));
#pragma unroll
        for (int bj = 0; bj < 2; ++bj) {
            const int cblk = u.pn * 256 + bj * 128;
            const int cw = wc * 32 + 8 * fq;
            bf16* dst; int pitch, cbase; int kind;
            int nh = 1, hd = 0; float qs = 1.0f;
            if (cblk < 512)       { dst = AQ; pitch = 512; cbase = cblk; kind = 1; }
            else if (cblk < 640)  { dst = AK; pitch = 128; cbase = cblk - 512; kind = 1; }
            else if (cblk < 768)  { dst = AVT; pitch = 128; cbase = cblk - 640; kind = 0; }
            else if (cblk < 1280) { dst = BQ; pitch = 512; cbase = cblk - 768; kind = 0; }
            else if (cblk < 1792) { dst = BK; pitch = 512; cbase = cblk - 1280; kind = 0; }
            else if (cblk < 2304) { dst = BVT; pitch = 512; cbase = cblk - 1792; kind = 0; }
            else if (cblk < 2816) { dst = CQ; pitch = 512; cbase = cblk - 2304; kind = 1; qs = SCL2; }
            else if (cblk < 3328) { dst = CK; pitch = 512; cbase = cblk - 2816; kind = 1; }
            else if (cblk < 3840) { dst = CV; pitch = 512; cbase = cblk - 3328; kind = 0; }
            else                  { dst = SG; pitch = 3072; cbase = cblk - 3840; kind = 3; }
#pragma unroll
            for (int ai = 0; ai < 2; ++ai)
#pragma unroll
                for (int m = 0; m < 4; ++m) {
                    const int row = u.pm * 256 + ai * 128 + wr * 64 + m * 16 + fr;
                    f32x4 v0 = acc[ai][bj][m][0], v1 = acc[ai][bj][m][1];
                    if (kind == 1) {
                        if (row < T_LAT) {
                            const int t = row & (SEQ - 1), i0 = (cw & 63) >> 1;
                            const f32x4 cs = *(const GAS f32x4*)(COS + t * 32 + i0), sn = *(const GAS f32x4*)(SIN + t * 32 + i0);
                            const f32x4 a = v0, b = v1;
                            v0.x = a.x * cs.x - a.y * sn.x; v0.y = a.y * cs.x + a.x * sn.x; v0.z = a.z * cs.y - a.w * sn.y; v0.w = a.w * cs.y + a.z * sn.y;
                            v1.x = b.x * cs.z - b.y * sn.z; v1.y = b.y * cs.z + b.x * sn.z; v1.z = b.z * cs.w - b.w * sn.w; v1.w = b.w * cs.w + b.z * sn.w;
                        }
                        *(GAS v4u*)(dst + (size_t)row * pitch + cbase + cw) = pack8(v0 * qs, v1 * qs);
                    } else if (kind == 0) {
                        *(GAS v4u*)(dst + (size_t)row * pitch + cbase + cw) = pack8(v0, v1);
                    } else if (kind == 3) {
                        v0.x = sigmoid_fast(v0.x); v0.y = sigmoid_fast(v0.y); v0.z = sigmoid_fast(v0.z); v0.w = sigmoid_fast(v0.w);
                        v1.x = sigmoid_fast(v1.x); v1.y = sigmoid_fast(v1.y); v1.z = sigmoid_fast(v1.z); v1.w = sigmoid_fast(v1.w);
                        *(GAS v4u*)(dst + (size_t)row * pitch + cbase + cw) = pack8(v0, v1);
                    } else {
                        const int hc = hd + cw, head = hc >> 6, d = hc & 63;
                        const int b = row_batch(row), tok = row_tok(row);
                        bf16* vp = dst + ((size_t)(b * nh + head) * 64 + d) * NTOK + tok;
                        vp[0 * NTOK] = (bf16)f2bf(v0.x); vp[1 * NTOK] = (bf16)f2bf(v0.y); vp[2 * NTOK] = (bf16)f2bf(v0.z); vp[3 * NTOK] = (bf16)f2bf(v0.w);
                        vp[4 * NTOK] = (bf16)f2bf(v1.x); vp[5 * NTOK] = (bf16)f2bf(v1.y); vp[6 * NTOK] = (bf16)f2bf(v1.z); vp[7 * NTOK] = (bf16)f2bf(v1.w);
                    }
                }
        }
    }
};
__device__ __forceinline__ void unpack8(const v4u& w, f32x4& a, f32x4& b) {
    a = (f32x4){bf2f(w.x & 0xffffu), bf2f(w.x >> 16), bf2f(w.y & 0xffffu), bf2f(w.y >> 16)}; b = (f32x4){bf2f(w.z & 0xffffu), bf2f(w.z >> 16), bf2f(w.w & 0xffffu), bf2f(w.w >> 16)};
}
struct EpiBranch {
    const bf16* SG; bf16* MG;
    __device__ __forceinline__ void operator()(const f32x4 (&acc)[2][2][4][2], const pg8::Unit& u, int wr, int wc, int fr, int fq) const {
        asm volatile("" : "+v"(fr), "+v"(fq));
#pragma unroll
        for (int ai = 0; ai < 2; ++ai)
#pragma unroll
            for (int m = 0; m < 4; ++m) {
                const int row = u.pm * 256 + ai * 128 + wr * 64 + m * 16 + fr;
#pragma unroll
                for (int bj = 0; bj < 2; ++bj) {
                    const int col = u.pn * 256 + bj * 128 + wc * 32 + 8 * fq;
                    f32x4 g0, g1; { const v4u wg = *(const GAS v4u*)(SG + (size_t)row * 3072 + u.seg * 1024 + col); unpack8(wg, g0, g1); }
                    f32x4 v0 = g0 * acc[ai][bj][m][0], v1 = g1 * acc[ai][bj][m][1];
                    bf16* mp = MG + (size_t)row * D + col;
                    if (u.seg > 0) { f32x4 p0, p1; const v4u wp = *(const GAS v4u*)mp; unpack8(wp, p0, p1); v0 += p0; v1 += p1; }
                    *(GAS v4u*)mp = pack8(v0, v1);
                }
            }
    }
};
struct EpiOut {
    float* X; const float* gtl; const float* xin; const float* cin;
    __device__ __forceinline__ void operator()(const f32x4 (&acc)[2][2][4][2], const pg8::Unit& u, int wr, int wc, int fr, int fq) const {
        asm volatile("" : "+v"(fr), "+v"(fq));
#pragma unroll
        for (int ai = 0; ai < 2; ++ai)
#pragma unroll
            for (int m = 0; m < 4; ++m) {
                const int row = u.pm * 256 + ai * 128 + wr * 64 + m * 16 + fr;
                const float* gt = gtl + (size_t)row_modidx(row) * 6 * D + 2 * D;
#pragma unroll
                for (int bj = 0; bj < 2; ++bj) {
                    const int col = u.pn * 256 + bj * 128 + wc * 32 + 8 * fq;
                    GAS f32x4* xp = (GAS f32x4*)(X + (size_t)row * D + col);
                    const GAS f32x4* sp = xin ? (const GAS f32x4*)(xin_row(xin, cin, row) + col) : (const GAS f32x4*)xp;
                    const f32x4 g0 = *(const GAS f32x4*)(gt + col), g1 = *(const GAS f32x4*)(gt + col + 4);
                    xp[0] = sp[0] + g0 * acc[ai][bj][m][0]; xp[1] = sp[1] + g1 * acc[ai][bj][m][1];
                }
            }
    }
};
struct EpiStore {
    bf16* O; int ldc;
    __device__ __forceinline__ void operator()(const f32x4 (&acc)[2][2][4][2], const pg8::Unit& u, int wr, int wc, int fr, int fq) const {
        asm volatile("" : "+v"(fr), "+v"(fq));
#pragma unroll
        for (int ai = 0; ai < 2; ++ai)
#pragma unroll
            for (int m = 0; m < 4; ++m) {
                const int row = u.pm * 256 + ai * 128 + wr * 64 + m * 16 + fr;
#pragma unroll
                for (int bj = 0; bj < 2; ++bj) {
                    const int col = u.pn * 256 + bj * 128 + wc * 32 + 8 * fq;
                    *(GAS v4u*)(O + (size_t)row * ldc + col) = pack8(acc[ai][bj][m][0], acc[ai][bj][m][1]);
                }
            }
    }
};

__global__ void __launch_bounds__(NTHREADS, 2) mega_fwd(Args args) {
    extern __shared__ __attribute__((aligned(16))) unsigned char lds[];
    LAS unsigned char* L = (LAS unsigned char*)lds;
    volatile LAS unsigned* MISC = (volatile LAS unsigned*)(L + MISC_OFF);
    const int wave = __builtin_amdgcn_readfirstlane((int)threadIdx.x >> 6);
    const int lane = lane_id_v(), tid = wave * 64 + lane;
    const int fr = lane & 15, fq = lane >> 4;
    const int G = gridDim.x;
    const int vcu = (G % 8 == 0) ? (int)(blockIdx.x % 8) * (G / 8) + (int)(blockIdx.x / 8) : (int)blockIdx.x;
    for (int u = tid; u < (LDS_BYTES - 131072) / 4; u += NTHREADS) ((LAS unsigned*)(L + 131072))[u] = 0u;
    __syncthreads();
    unsigned char* ws = args.ws;
    gu32* ctl = (gu32*)(ws + WS_CTL);
    (void)xcd_barrier_post((unsigned*)(ctl + CW_BAR), MISC + 8);
    if (tid == 0) MISC[12] = xb_add((unsigned*)(ctl + CW_RANK) + 64 * xb_xcc_id(), 1u);
    __syncthreads();
#define GRID_BAR() do { unsigned* bp_ = (unsigned*)(args.ws + WS_CTL) + CW_BAR; asm volatile("" : "+s"(bp_)); XcdBarrier b_; b_.bar = bp_; b_.x = xb_xcc_id(); b_.st = MISC + 8; xcd_barrier(b_, wave == 0 && lane_id_v() == 0); } while (0)
    const int gw = vcu * NWAVES + wave, NGW = G * NWAVES;
    const int NGT = G * NTHREADS;

#define PHASE_PTRS \
    unsigned char* wsq = args.ws; asm volatile("" : "+s"(wsq)); \
    const float* const* IN_ = (const float* const*)__builtin_amdgcn_kernarg_segment_ptr(); asm volatile("" : "+s"(IN_)); \
    float* MODV = (float*)(wsq + WS_MOD); float* COS = (float*)(wsq + WS_COS); float* SIN = (float*)(wsq + WS_SIN); \
    bf16* WIN = (bf16*)(wsq + WS_WIN); bf16* WB = (bf16*)(wsq + WS_WB); bf16* WO = (bf16*)(wsq + WS_WO); bf16* WQ = (bf16*)(wsq + WS_WQ); bf16* KEYS = (bf16*)(wsq + WS_KEYS); \
    float* X = (float*)(wsq + WS_X); bf16* H = (bf16*)(wsq + WS_H); bf16* Y = (bf16*)(wsq + WS_Y); bf16* MG = (bf16*)(wsq + WS_MG); \
    unsigned* EI = (unsigned*)(wsq + WS_EI); float* EG = (float*)(wsq + WS_EG); \
    unsigned char* U8 = wsq + WS_U8; unsigned char* V8 = wsq + WS_V8; float* SCU = (float*)(wsq + WS_SCU); float* SCV = SCU + DEPTH * 16384; \
    bf16* AQ = (bf16*)(wsq + WS_AQ); bf16* AK = (bf16*)(wsq + WS_AK); bf16* AVT = (bf16*)(wsq + WS_AVT); \
    bf16* BQ = (bf16*)(wsq + WS_BQ); bf16* BK = (bf16*)(wsq + WS_BK); bf16* BVT = (bf16*)(wsq + WS_BVT); \
    bf16* CQ = (bf16*)(wsq + WS_CQ); bf16* CK = (bf16*)(wsq + WS_CK); bf16* CVT = (bf16*)(wsq + WS_CVT); \
    bf16* SG = (bf16*)(wsq + WS_SG); bf16* Q2 = (bf16*)(wsq + WS_Q2); float* SC = (float*)(wsq + WS_SC); \
    (void)MODV; (void)COS; (void)SIN; (void)WIN; (void)WB; (void)WO; (void)WQ; (void)KEYS; (void)X; (void)H; (void)Y; (void)MG; (void)EI; (void)EG; (void)U8; (void)V8; (void)SCU; (void)SCV; \
    (void)AQ; (void)AK; (void)AVT; (void)BQ; (void)BK; (void)BVT; (void)CQ; (void)CK; (void)CVT; (void)SG; (void)Q2; (void)SC; (void)IN_;
#define LAYER_PTRS const float* modl = MODV + (size_t)layer * 3 * 6 * D; const bf16* WINl = WIN + (size_t)layer * IN_W * D; (void)modl; (void)WINl;

#ifndef SKIP_P0
        { PHASE_PTRS
        for (int rep_ = 0; rep_ < REP_P0; ++rep_) {
    {
        LAS float* scr = (LAS float*)(L + wave * 16384);
        int gt = vcu * NTHREADS + tid; asm volatile("" : "+v"(gt));
        constexpr int I_IN = (D / 64) * (IN_W / 32), I_BR = (512 / 64) * (D / 32), I_O = (D / 64) * (D / 32), I_Q = (D / 64) * (2048 / 32);
        constexpr int PER_LAYER = I_IN + 3 * I_BR + I_O + I_Q;
        for (int rp_ = 0; rp_ < REP_P0A; ++rp_)
        for (int it = gw; it < DEPTH * PER_LAYER; it += NGW) {
            const int l = it / PER_LAYER; int r = it % PER_LAYER;
            if (r < I_IN) { p0_transpose_item<true>(IN_[I_WIN] + (size_t)l * D * IN_W, D, IN_W, WIN + (size_t)l * IN_W * D, scr, r, lane); continue; } r -= I_IN;
            if (r < I_BR) { p0_transpose_item(IN_[I_WBA] + (size_t)l * 512 * D, 512, D, WB + (size_t)(l * 3 + 0) * D * 512, scr, r, lane); continue; } r -= I_BR;
            if (r < I_BR) { p0_transpose_item(IN_[I_WBB] + (size_t)l * 512 * D, 512, D, WB + (size_t)(l * 3 + 1) * D * 512, scr, r, lane); continue; } r -= I_BR;
            if (r < I_BR) { p0_transpose_item(IN_[I_WBC] + (size_t)l * 512 * D, 512, D, WB + (size_t)(l * 3 + 2) * D * 512, scr, r, lane); continue; } r -= I_BR;
            if (r < I_O) { p0_transpose_item(IN_[I_WOUT] + (size_t)l * D * D, D, D, WO + (size_t)l * D * D, scr, r, lane); continue; } r -= I_O;
            p0_transpose_item(IN_[I_PWQ] + (size_t)l * D * 2048, D, 2048, WQ + (size_t)l * 2048 * D, scr, r, lane);
        }
        for (int i = gt; i < DEPTH * 16 * 128 * 128 / 4; i += NGT) {
            const f32x4 v = *((const GAS f32x4*)IN_[I_PKEYS] + i);
            v2u o; o.x = pk2(v.x, v.y); o.y = pk2(v.z, v.w); *((GAS v2u*)KEYS + i) = o;
        }
        {
            LAS float* red = (LAS float*)(L + 9216);
            for (int rp_ = 0; rp_ < REP_P0D; ++rp_)
            for (int it = vcu; it < DEPTH * 96; it += G) {
                const int l = it / 96, nc = it % 96, n = nc * 64 + lane;
                const float* wm = IN_[I_WMOD] + (size_t)l * D * 6 * D + n;
                float a0 = 0.f, a1 = 0.f, a2 = 0.f;
#pragma unroll 1
                for (int half = 0; half < 2; ++half) {
                    const int kb = wave * 128 + half * 64;
                    const float c0 = IN_[I_C][kb + lane], c1 = IN_[I_C][D + kb + lane], c2 = IN_[I_CCTX][kb + lane];
                    const int s0 = __builtin_bit_cast(int, c0 * sigmoidf_(c0)), s1 = __builtin_bit_cast(int, c1 * sigmoidf_(c1)), s2 = __builtin_bit_cast(int, c2 * sigmoidf_(c2));
#pragma unroll
                    for (int kk = 0; kk < 64; ++kk) {
                        const float w = wm[(size_t)(kb + kk) * 6 * D];
                        a0 += __builtin_bit_cast(float, __builtin_amdgcn_readlane(s0, kk)) * w;
                        a1 += __builtin_bit_cast(float, __builtin_amdgcn_readlane(s1, kk)) * w;
                        a2 += __builtin_bit_cast(float, __builtin_amdgcn_readlane(s2, kk)) * w;
                    }
                }
                red[(wave * 3 + 0) * 64 + lane] = a0; red[(wave * 3 + 1) * 64 + lane] = a1; red[(wave * 3 + 2) * 64 + lane] = a2;
                __syncthreads();
                if (wave < 3) {
                    float sum = IN_[I_BMOD][l * 6 * D + n];
#pragma unroll
                    for (int w = 0; w < 8; ++w) sum += red[(w * 3 + wave) * 64 + lane];
                    MODV[(size_t)(l * 3 + wave) * 6 * D + n] = sum;
                }
                __syncthreads();
            }
        }
        for (int i = gt; i < SEQ * 32; i += NGT) {
            const int t = i >> 5, f = i & 31;
            const float inv = exp2f(-(float)(f & 15) * (13.287712379549449f / 16.0f));
            const float pos = (f < 16) ? (float)(t / GRID_W) : (float)(t % GRID_W);
            float sn, cs; sincosf(pos * inv, &sn, &cs);
            COS[i] = cs; SIN[i] = sn;
        }
    }
        for (int rp_ = 0; rp_ < REP_P0F; ++rp_)
#pragma unroll 4
        for (int rr = gw; rr < 2 * DEPTH * 16384; rr += NGW) {
            const int tab = rr / (DEPTH * 16384), row = rr % (DEPTH * 16384);
            const float* src = (tab == 0 ? IN_[I_PU] : IN_[I_PV]) + (size_t)row * D;
            f32x4 v[4]; float am = 0.f;
#pragma unroll
            for (int j = 0; j < 4; ++j) { v[j] = *((const GAS f32x4*)src + lane + 64 * j); am = fmaxf(am, fmaxf(fmaxf(fabsf(v[j].x), fabsf(v[j].y)), fmaxf(fabsf(v[j].z), fabsf(v[j].w)))); }
            am = wave_max(am);
            const bool as_i8 = (P10_SLICED != 0) && (tab == 0);
            int ex = 0; float scale = 1.0f;
            if (am > 0.f) { (void)frexpf(am * (as_i8 ? (1.0f / 127.0f) : (1.0f / 448.0f)), &ex); scale = ldexpf(1.0f, ex); }
            const float inv = 1.0f / scale;
            v4u o;
#pragma unroll
            for (int j = 0; j < 4; ++j) {
                if (as_i8) {
                    const int q0 = __float2int_rn(v[j].x * inv), q1 = __float2int_rn(v[j].y * inv), q2 = __float2int_rn(v[j].z * inv), q3 = __float2int_rn(v[j].w * inv);
                    o[j] = (unsigned)(q0 & 255) | ((unsigned)(q1 & 255) << 8) | ((unsigned)(q2 & 255) << 16) | ((unsigned)q3 << 24);
                } else {
                    int p = __builtin_amdgcn_cvt_pk_fp8_f32(v[j].x * inv, v[j].y * inv, 0, false);
                    p = __builtin_amdgcn_cvt_pk_fp8_f32(v[j].z * inv, v[j].w * inv, p, true);
                    o[j] = (unsigned)p;
                }
            }
            *((GAS v4u*)((tab == 0 ? U8 : V8) + (size_t)row * D) + lane) = o;
            if (lane == 0) (tab == 0 ? SCU : SCV)[row] = scale;
        }
        }
        }
#endif
    GRID_BAR();

    for (int layer = 0; layer < DEPTH; ++layer) {
        const bool last = (layer == DEPTH - 1);
        const int T_EFF = last ? T_LAT : T_ALL;

#ifndef SKIP_P1
        { PHASE_PTRS LAYER_PTRS
        for (int rep_ = 0; rep_ < REP_P1; ++rep_) {
        { const int ln = lane_id_v();
        if (layer == 0) {
            f32x4 gm[4], shv[4];
            auto prep = [&](int midx) { const float* md = modl + (size_t)midx * 6 * D;
#pragma unroll
                for (int j = 0; j < 4; ++j) { const f32x4 g = *((const GAS f32x4*)(IN_[I_G1] + layer * D) + ln + 64 * j); const f32x4 sc = *((const GAS f32x4*)(md + D) + ln + 64 * j);
                    gm[j] = g * (sc + 1.0f); shv[j] = *((const GAS f32x4*)(md + 0) + ln + 64 * j); } };
            auto row = [&](int r) {
                const GAS f32x4* xr = (const GAS f32x4*)xin_row(IN_[I_X], IN_[I_CTX], r) + ln;
                f32x4 v[4]; float ss = 0.f;
#pragma unroll
                for (int j = 0; j < 4; ++j) { v[j] = xr[64 * j]; ss += (v[j].x * v[j].x + v[j].y * v[j].y) + (v[j].z * v[j].z + v[j].w * v[j].w); }
                const float rs = 1.0f / sqrtf(wave_sum(ss) * (1.f / D) + NORM_EPS);
                GAS v2u* o8 = (GAS v2u*)(H + (size_t)r * D) + ln;
#pragma unroll
                for (int j = 0; j < 4; ++j) { const f32x4 h = v[j] * rs * gm[j] + shv[j]; v2u o; o.x = pk2(h.x, h.y); o.y = pk2(h.z, h.w); o8[64 * j] = o; } };
            wave_row_blocks(T_ALL, gw, NGW, prep, row);
        }
        }
        }
        }
#endif
        if (layer == 0) GRID_BAR();

#ifndef SKIP_P2
        { PHASE_PTRS LAYER_PTRS
        for (int rep_ = 0; rep_ < REP_P2; ++rep_) {
        {
            pg8::Gemm g{H, WINl, D, D, D, 0, 0};
            pg8::SegOrder<1> S; S.T.init(T_ALL, IN_W, G, (int)blockIdx.x);
            EpiInProj E{AQ, AK, AVT, BQ, BK, BVT, CQ, CK, CVT, SG, COS, SIN};
            pg8::gemm_phase(L, g, S, E, wave);
        }
        }
        }
#endif
        GRID_BAR();

#ifndef SKIP_P3
        { PHASE_PTRS LAYER_PTRS
        {
            LAS bf16* Pl = (LAS bf16*)(L + wave * 8192);
            const float lam_init = 0.8f - 0.6f * expf(-0.3f * (float)layer);
            float lam;
            {
                const int ll = lane_id_v();
                const float* cl = IN_[I_LAMBDA] + layer * 256;
                const float s1 = wave_sum(cl[ll] * cl[64 + ll]), s2 = wave_sum(cl[128 + ll] * cl[192 + ll]);
                lam = expf(s1) - expf(s2) + lam_init;
            }
{ const int lo__ = lane_id_v(); { const int lane = lo__; const int fr = lane & 15, fq = lane >> 4, tid = wave * 64 + lane; (void)fr; (void)fq; (void)tid;
            {
                const int r32 = lane & 31, hi = lane >> 5;
                const int n_lat = BATCH * 4 * (SEQ / 256), n_ctx = last ? 0 : BATCH * 4;
                const int NU = (n_lat + G - 1) / G * G + n_ctx;
                for (int rep_ = 0; rep_ < REP_P3C; ++rep_)
                for (int u0 = vcu; u0 < NU; u0 += G) {
                    int b, h, row0, t_lo, t_hi;
                    if (u0 < n_lat) { const int bh = u0 >> 5; b = bh >> 2; h = bh & 3; row0 = b * SEQ + (u0 & 31) * 256; t_lo = 0; t_hi = 132; }
                    else { const int c = u0 - (n_lat + G - 1) / G * G; if (c < 0 || c >= n_ctx) continue; b = c >> 2; h = c & 3; row0 = T_LAT + b * CTX; t_lo = 128; t_hi = 132; }
                    const int qrow = row0 + wave * 32 + r32;
                    LAS unsigned* o1p = (LAS unsigned*)(L + 65536 + wave * 8192) + lane;
                    const int krow_s = tid >> 3, kch_s = tid & 7;
                    const int vrow_s0 = tid >> 4, vch_s = tid & 15;
                    LAS unsigned char* Kb0 = L; LAS unsigned char* Vb0 = L + 2 * CK_SZ;
#pragma unroll 1
                    for (int m = 0; m < 2; ++m) {
                        bf16x8 qf[4];
                        { const bf16* qp = CQ + (size_t)qrow * 512 + (h * 2 + m) * 64 + hi * 8;
#pragma unroll
                          for (int ks = 0; ks < 4; ++ks) qf[ks] = *(const GAS bf16x8*)(qp + ks * 16); }
                        f32x16 o[4];
#pragma unroll
                        for (int d = 0; d < 4; ++d)
#pragma unroll
                            for (int r = 0; r < 16; ++r) o[d][r] = 0.f;
                        float lpart;
                        f32x16 cb;
                        v4u pp[4];
                        const bf16* kg = CK + (size_t)krow_s * 512 + (h * 2 + m) * 64 + kch_s * 8;
                        const bf16* vg = CVT + (size_t)vrow_s0 * 512 + h * 128 + vch_s * 8;
                        auto tile_row = [&](int j) { return (j < 128) ? b * SEQ + 64 * j : T_LAT + b * CTX + 64 * (j - 128); };
                        __syncthreads();
                        {
                            const size_t kb = (size_t)tile_row(t_lo) * 512;
                            const v4u kr = *(const GAS v4u*)(kg + kb), v0 = *(const GAS v4u*)(vg + kb), v1 = *(const GAS v4u*)(vg + kb + 32 * 512);
                            *(LAS v4u*)(Kb0 + krow_s * CK_PITCH + kch_s * 16) = kr;
                            *(LAS v4u*)(Vb0 + vrow_s0 * CV_PITCH + vch_s * 16) = v0; *(LAS v4u*)(Vb0 + (vrow_s0 + 32) * CV_PITCH + vch_s * 16) = v1;
                        }
                        __syncthreads();
                        v4u kr, v0, v1;
                        { const size_t kb = (size_t)tile_row(t_lo + 2) * 512, vb = (size_t)tile_row(t_lo + 1) * 512;
                          kr = *(const GAS v4u*)(kg + kb); v0 = *(const GAS v4u*)(vg + vb); v1 = *(const GAS v4u*)(vg + vb + 32 * 512); }
                        {
                            const v4u kr1 = *(const GAS v4u*)(kg + (size_t)tile_row(t_lo + 1) * 512);
                            f32x16 st[2];
#pragma unroll
                            for (int kb = 0; kb < 2; ++kb) {
#pragma unroll
                                for (int r = 0; r < 16; ++r) st[kb][r] = 0.f;
#pragma unroll
                                for (int ks = 0; ks < 4; ++ks) {
                                    const bf16x8 kf = *(const LAS bf16x8*)(Kb0 + (kb * 32 + r32) * CK_PITCH + ks * 32 + hi * 16);
                                    st[kb] = __builtin_amdgcn_mfma_f32_32x32x16_bf16(kf, qf[ks], st[kb], 0, 0, 0);
                                }
                            }
                            float mx = st[0][0];
#pragma unroll
                            for (int r = 1; r < 16; ++r) mx = fmaxf(mx, st[0][r]);
#pragma unroll
                            for (int r = 0; r < 16; ++r) mx = fmaxf(mx, st[1][r]);
                            mx = xmax32(mx);
#pragma unroll
                            for (int r = 0; r < 16; ++r) cb[r] = -mx;
                            float ls0 = 0.f, ls1 = 0.f;
#pragma unroll
                            for (int ks = 0; ks < 4; ++ks)
#pragma unroll
                                for (int i2 = 0; i2 < 4; ++i2) {
                                    const float p0 = __builtin_amdgcn_exp2f(st[ks >> 1][8 * (ks & 1) + 2 * i2] - mx), p1 = __builtin_amdgcn_exp2f(st[ks >> 1][8 * (ks & 1) + 2 * i2 + 1] - mx);
                                    ls0 += p0; ls1 += p1; pp[ks][i2] = cvtpk(p0, p1);
                                }
                            lpart = ls0 + ls1;
                            *(LAS v4u*)(Kb0 + CK_SZ + krow_s * CK_PITCH + kch_s * 16) = kr1;
                            __syncthreads();
                        }
                        const int q4 = (lane & 15) >> 2, p4 = lane & 3, grp = (lane >> 4) & 1;
                        const int voff = (4 * hi + q4) * CV_PITCH + (16 * grp + 4 * p4) * 2;
#pragma unroll 1
                        for (int j = t_lo + 1; j < t_hi; ++j) {
                            const int cur = (j - t_lo) & 1;
                            const LAS unsigned char* Kb = Kb0 + cur * CK_SZ; const LAS unsigned char* vbase = Vb0 + (cur ^ 1) * CV_SZ + voff;
                            const bool more = (j + 1 < t_hi);
                            auto vfrag = [&](int i) -> bf16x8 {
                                const LAS unsigned char* va = vbase + (i >> 2) * 16 * CV_PITCH + (i & 3) * 64;
                                const s16x4 lo = __builtin_bit_cast(s16x4, __builtin_amdgcn_ds_read_tr16_b64_v4i16((LAS s16x4*)va));
                                const s16x4 hh = __builtin_bit_cast(s16x4, __builtin_amdgcn_ds_read_tr16_b64_v4i16((LAS s16x4*)(va + 8 * CV_PITCH)));
                                return __builtin_shufflevector(lo, hh, 0, 1, 2, 3, 4, 5, 6, 7);
                            };
                            f32x16 st[2];
#pragma unroll
                            for (int kb = 0; kb < 2; ++kb) {
#pragma unroll
                                for (int ks = 0; ks < 4; ++ks) {
                                    const bf16x8 kf = *(const LAS bf16x8*)(Kb + (kb * 32 + r32) * CK_PITCH + ks * 32 + hi * 16);
                                    st[kb] = __builtin_amdgcn_mfma_f32_32x32x16_bf16(kf, qf[ks], ks == 0 ? cb : st[kb], 0, 0, 0);
                                }
                            }
                            bf16x8 vfr[3];
                            vfr[0] = vfrag(0); vfr[1] = vfrag(1); vfr[2] = vfrag(2);
                            float mx = st[0][0];
#pragma unroll
                            for (int r = 1; r < 16; ++r) mx = fmaxf(mx, st[0][r]);
#pragma unroll
                            for (int r = 0; r < 16; ++r) mx = fmaxf(mx, st[1][r]);
                            asm volatile("" : "+v"(mx));
                            __builtin_amdgcn_sched_barrier(0);
                            o[0] = __builtin_amdgcn_mfma_f32_32x32x16_bf16(vfr[0], __builtin_bit_cast(bf16x8, pp[0]), o[0], 0, 0, 0); vfr[0] = vfrag(3);
                            o[1] = __builtin_amdgcn_mfma_f32_32x32x16_bf16(vfr[1], __builtin_bit_cast(bf16x8, pp[0]), o[1], 0, 0, 0); vfr[1] = vfrag(4);
                            mx = xmax32(mx);
                            const bool grow = __builtin_amdgcn_ballot_w64(mx > 8.0f) != 0ull;
                            float alpha = 1.0f;
                            if (grow) {
                                const float dl = fmaxf(mx, 0.f);
#pragma unroll
                                for (int kb = 0; kb < 2; ++kb)
#pragma unroll
                                    for (int r = 0; r < 16; ++r) st[kb][r] -= dl;
#pragma unroll
                                for (int r = 0; r < 16; ++r) cb[r] -= dl;
                                alpha = __builtin_amdgcn_exp2f(-dl);
                            }
                            __builtin_amdgcn_sched_barrier(0);
                            float ls0 = 0.f, ls1 = 0.f;
#pragma unroll
                            for (int i = 0; i < 16; ++i) {
                                if (i >= 2) { o[i & 3] = __builtin_amdgcn_mfma_f32_32x32x16_bf16(vfr[i % 3], __builtin_bit_cast(bf16x8, pp[i >> 2]), o[i & 3], 0, 0, 0); if (i + 3 < 16) vfr[i % 3] = vfrag(i + 3); }
                                {
                                    const int kb = i >> 3, r = 2 * (i & 7);
                                    float p0 = __builtin_amdgcn_exp2f(st[kb][r]);
                                    ls0 += p0; asm volatile("" : "+v"(p0), "+v"(ls0));
                                    float p1 = __builtin_amdgcn_exp2f(st[kb][r + 1]);
                                    ls1 += p1; asm volatile("" : "+v"(p1), "+v"(ls1));
                                    st[kb][r] = p0; st[kb][r + 1] = p1;
                                }
                                if ((i & 3) == 3) {
                                    const int ks = i >> 2;
#pragma unroll
                                    for (int i2 = 0; i2 < 4; ++i2) pp[ks][i2] = cvtpk(st[ks >> 1][8 * (ks & 1) + 2 * i2], st[ks >> 1][8 * (ks & 1) + 2 * i2 + 1]);
                                    asm volatile("" : "+v"(pp[ks]));
                                }
                                if (i == 3) *(LAS v4u*)(Kb0 + (cur ^ 1) * CK_SZ + krow_s * CK_PITCH + kch_s * 16) = kr;
                                if (i == 5) *(LAS v4u*)(Vb0 + cur * CV_SZ + vrow_s0 * CV_PITCH + vch_s * 16) = v0;
                                if (i == 7) *(LAS v4u*)(Vb0 + cur * CV_SZ + (vrow_s0 + 32) * CV_PITCH + vch_s * 16) = v1;
                                if (i == 9) { const size_t kb = (size_t)tile_row(j + 2 < t_hi ? j + 2 : t_hi - 1) * 512, vb = (size_t)tile_row(more ? j + 1 : j) * 512;
                                              kr = *(const GAS v4u*)(kg + kb); v0 = *(const GAS v4u*)(vg + vb); v1 = *(const GAS v4u*)(vg + vb + 32 * 512); }
                                if (i >= 1) __builtin_amdgcn_sched_barrier(0);
                            }
                            if (grow) {
#pragma unroll
                                for (int d = 0; d < 4; ++d)
#pragma unroll
                                    for (int r = 0; r < 16; ++r) o[d][r] *= alpha;
                                lpart *= alpha;
                            }
                            lpart += ls0 + ls1;
                            __syncthreads();
                        }
                        {
                            const LAS unsigned char* vbase = Vb0 + ((t_hi - 1 - t_lo) & 1) * CV_SZ + voff;
#pragma unroll
                            for (int i = 0; i < 16; ++i) {
                                const LAS unsigned char* va = vbase + (i >> 2) * 16 * CV_PITCH + (i & 3) * 64;
                                const s16x4 lo = __builtin_bit_cast(s16x4, __builtin_amdgcn_ds_read_tr16_b64_v4i16((LAS s16x4*)va));
                                const s16x4 hh = __builtin_bit_cast(s16x4, __builtin_amdgcn_ds_read_tr16_b64_v4i16((LAS s16x4*)(va + 8 * CV_PITCH)));
                                const bf16x8 vf = __builtin_shufflevector(lo, hh, 0, 1, 2, 3, 4, 5, 6, 7);
                                o[i & 3] = __builtin_amdgcn_mfma_f32_32x32x16_bf16(vf, __builtin_bit_cast(bf16x8, pp[i >> 2]), o[i & 3], 0, 0, 0);
                                if ((i & 7) == 7) __builtin_amdgcn_sched_barrier(0);
                            }
                        }
                        const float lt = xadd32(lpart);
                        if (m == 0) {
                            const float inv = 1.0f / lt;
#pragma unroll
                            for (int d = 0; d < 4; ++d)
#pragma unroll
                                for (int i2 = 0; i2 < 8; ++i2) o1p[64 * (d * 8 + i2)] = cvtpk(o[d][2 * i2] * inv, o[d][2 * i2 + 1] * inv);
                        } else {
                            const float inv2 = lam / lt;
                            float ssq = 0.f;
#pragma unroll
                            for (int d = 0; d < 4; ++d)
#pragma unroll
                                for (int i2 = 0; i2 < 8; ++i2) {
                                    const unsigned w1 = o1p[64 * (d * 8 + i2)];
                                    const float a0 = bf2f(w1 & 0xffffu) - o[d][2 * i2] * inv2, a1 = bf2f(w1 >> 16) - o[d][2 * i2 + 1] * inv2;
                                    o[d][2 * i2] = a0; o[d][2 * i2 + 1] = a1; ssq += a0 * a0 + a1 * a1;
                                }
                            ssq = xadd32(ssq);
                            const float rn = 1.0f / sqrtf(ssq * (1.f / 128.f) + NORM_EPS) * (1.0f - lam_init);
                            bf16* yp = Y + (size_t)qrow * 1536 + 1024 + h * 128 + 4 * hi;
                            const float* sl = IN_[I_SUBLN] + layer * 512 + h * 128 + 4 * hi;
#pragma unroll
                            for (int d = 0; d < 4; ++d)
#pragma unroll
                                for (int g4 = 0; g4 < 4; ++g4) {
                                    const f32x4 gsl = *(const GAS f32x4*)(sl + d * 32 + 8 * g4);
                                    v2u w; w.x = cvtpk(o[d][4 * g4] * rn * gsl.x, o[d][4 * g4 + 1] * rn * gsl.y); w.y = cvtpk(o[d][4 * g4 + 2] * rn * gsl.z, o[d][4 * g4 + 3] * rn * gsl.w);
                                    *(GAS v2u*)(yp + d * 32 + 8 * g4) = w;
                                }
                        }
                    }
                }
                __syncthreads();
            }
} }
{ const int lo__ = lane_id_v(); { const int lane = lo__; const int tid = wave * 64 + lane, r32 = lane & 31, hi = lane >> 5;
            {
                const int n_lat = BATCH * 2 * (SEQ / 64), n_ctx = last ? 0 : BATCH * 2 * (CTX / 64);
                for (int rep_ = 0; rep_ < REP_P3A; ++rep_)
                for (int u0 = vcu; u0 < n_lat + n_ctx; u0 += G) {
                    const bool isctx = u0 >= n_lat;
                    int b, g, p0, qrow, nl, klo;
                    if (!isctx) { b = u0 >> 8; g = (u0 >> 7) & 1; p0 = (u0 & 127) * 64; qrow = b * SEQ + p0 + (wave & 1) * 32 + r32;
                                  klo = p0 >= 128 ? 0 : (128 - p0) / 64; const int khi = min(4, (SEQ - 1 - (p0 - 128)) / 64); nl = khi - klo + 1; }
                    else { const int c = u0 - n_lat; b = c >> 3; g = (c >> 2) & 1; p0 = (c & 3) * 64; qrow = T_LAT + b * CTX + p0 + (wave & 1) * 32 + r32; nl = 0; klo = 0; }
                    const int hq = g * 4 + (wave >> 1);
                    const int qpos0 = p0 + (wave & 1) * 32;
                    bf16x8 qf[4];
                    { const bf16* qp = AQ + (size_t)qrow * 512 + hq * 64 + hi * 8;
#pragma unroll
                      for (int ks = 0; ks < 4; ++ks) qf[ks] = *(const GAS bf16x8*)(qp + ks * 16); }
                    f32x16 o[2];
#pragma unroll
                    for (int d = 0; d < 2; ++d)
#pragma unroll
                        for (int r = 0; r < 16; ++r) o[d][r] = 0.f;
                    float mrun = IN_[I_SINK][layer * 8 + hq] * 8.0f;
                    float lpart = (hi == 0) ? 1.0f : 0.0f;
                    const bf16* kg = AK + (size_t)(tid >> 3) * 128 + g * 64 + (tid & 7) * 8;
                    const bf16* vg = AVT + (size_t)(tid >> 3) * 128 + g * 64 + (tid & 7) * 8;
                    const int kp0 = p0 - 128 + 64 * klo;
                    auto tile_row = [&](int j) { return (j < nl) ? b * SEQ + kp0 + 64 * j : T_LAT + b * CTX + 64 * (j - nl); };
                    auto use_tile = [&](int j) { if (j >= nl) return true; const int kp = kp0 + 64 * j; return (kp + 63 >= qpos0 - 128) && (kp <= qpos0 + 31 + 128); };
                    auto elem = [&](f32x16 (&st)[2], int j) {
                        if (j < nl) {
                            const int dq0 = (qpos0 + r32) - (kp0 + 64 * j + 4 * hi);
#pragma unroll
                            for (int kb = 0; kb < 2; ++kb)
#pragma unroll
                                for (int r = 0; r < 16; ++r) { const int dq = dq0 - (kb * 32 + (r & 3) + 8 * (r >> 2)); if (dq > 128 || dq < -128) st[kb][r] = -1e30f; }
                        }
                    };
                    attn64_pass<2, false>(o, mrun, lpart, qf, kg, 128, vg, 128, nl + 4, tile_row, use_tile, elem, o, [](int) { return false; }, L, lane, tid);
                    const float lt = xadd32(lpart);
                    attn64_store(o, 1.0f / lt, Y + (size_t)qrow * 1536 + hq * 64, hi);
                }
            }
} }
{ const int lo__ = lane_id_v(); { const int lane = lo__; const int tid = wave * 64 + lane, r32 = lane & 31, hi = lane >> 5;
            {
                const int n_lat = BATCH * 8 * 32, n_ctx = last ? 0 : BATCH * 8;
                LAS float* rpbL = (LAS float*)(L + 49152) + 64;
                f32x16 cm[2];
                {
                    const int qc = (wave & 1) * 32 + r32, cstart = min(max(qc - 8, 0), 48);
#pragma unroll
                    for (int kb = 0; kb < 2; ++kb)
#pragma unroll
                        for (int r = 0; r < 16; ++r) { const int kc = kb * 32 + (r & 3) + 8 * (r >> 2) + 4 * hi; cm[kb][r] = ((kc >= cstart) && (kc < cstart + 16)) ? 0.f : -1e30f; }
                }
                if (tid < 64) { rpbL[tid - 64] = 0.f; rpbL[465 + tid] = 0.f; }
                for (int rep_ = 0; rep_ < REP_P3B; ++rep_)
                for (int u0 = vcu; u0 < n_lat + n_ctx; u0 += G) {
                    const bool isctx = u0 >= n_lat;
                    int b, h, gr = 0, qc0 = 0, qrow, nl, krlo;
                    if (!isctx) { b = u0 >> 8; h = (u0 >> 5) & 7; const int r0 = (u0 & 31) * 4; gr = r0 + (wave >> 1); qc0 = (wave & 1) * 32; qrow = b * SEQ + gr * GRID_W + qc0 + r32;
                                  krlo = min(max(r0 - 4, 0), 120); nl = min(max(r0 - 1, 0), 120) + 8 - krlo; }
                    else { const int c = u0 - n_lat; b = c >> 3; h = c & 7; qrow = T_LAT + b * CTX + wave * 32 + r32; nl = 0; krlo = 0; }
                    __syncthreads();
                    if (tid < 465) rpbL[tid] = IN_[I_RPB][(size_t)(layer * 8 + h) * 465 + tid] * 8.0f;
                    bf16x8 qf[4];
                    { const bf16* qp = BQ + (size_t)qrow * 512 + h * 64 + hi * 8;
#pragma unroll
                      for (int ks = 0; ks < 4; ++ks) qf[ks] = *(const GAS bf16x8*)(qp + ks * 16); }
                    f32x16 o[2];
#pragma unroll
                    for (int d = 0; d < 2; ++d)
#pragma unroll
                        for (int r = 0; r < 16; ++r) o[d][r] = 0.f;
                    float mrun = -1e30f, lpart = 0.f;
                    const bf16* kg = BK + (size_t)(tid >> 3) * 512 + h * 64 + (tid & 7) * 8;
                    const bf16* vg = BVT + (size_t)(tid >> 3) * 512 + h * 64 + (tid & 7) * 8;
                    const int rs = min(max(gr - 4, 0), 120);
                    auto tile_row = [&](int j) { return (j < nl) ? b * SEQ + (krlo + j) * GRID_W : T_LAT + b * CTX + 64 * (j - nl); };
                    auto use_tile = [&](int j) { if (j >= nl) return true; const int kr = krlo + j; return kr >= rs && kr < rs + 8; };
                    auto elem = [&](f32x16 (&st)[2], int j) {
                        if (j < nl) {
                            const LAS float* brow = rpbL + (krlo + j - gr + 7) * 31 + 15 - (qc0 + r32) + 4 * hi;
#pragma unroll
                            for (int kb = 0; kb < 2; ++kb)
#pragma unroll
                                for (int r = 0; r < 16; ++r) st[kb][r] += brow[kb * 32 + (r & 3) + 8 * (r >> 2)];
                        }
                    };
                    attn64_pass<2, true>(o, mrun, lpart, qf, kg, 512, vg, 512, nl + 4, tile_row, use_tile, elem, cm, [&](int j) { return j < nl; }, L, lane, tid);
                    const float lt = xadd32(lpart);
                    attn64_store(o, 1.0f / lt, Y + (size_t)qrow * 1536 + 512 + h * 64, hi);
                }
                __syncthreads();
            }
} }
        }
        }
#endif
        GRID_BAR();

#ifndef SKIP_P4
        { PHASE_PTRS LAYER_PTRS
        for (int rep_ = 0; rep_ < REP_P4; ++rep_) {
        {
            pg8::Gemm g{Y, WB + (size_t)layer * 3 * D * 512, 1536, 512, 512, 512, (size_t)D * 512};
            pg8::SegOrder<3> S; S.T.init(T_LAT, D, G, (int)blockIdx.x);
            EpiBranch E{SG, MG};
            pg8::gemm_phase(L, g, S, E, wave);
        }
        if (!last) { const int lo__ = lane_id_v(); { const int lane = lo__; const int fr = lane & 15, fq = lane >> 4; (void)fr; (void)fq;
            for (int it = gw; it < (T_ALL - T_LAT) / 32 * (D / 32); it += NGW) {
                const int row0 = T_LAT + (it / (D / 32)) * 32, col0 = (it % (D / 32)) * 32;
                f32x4 mg[2][2]; zero_acc22(mg);
#pragma unroll 1
                for (int seg = 0; seg < 3; ++seg) {
                    f32x4 acc[2][2]; zero_acc22(acc);
                    sgemm32<8>(acc, Y + seg * 512, 1536, WB + (size_t)(layer * 3 + seg) * D * 512, 512, 512, row0, col0, lane);
#pragma unroll
                    for (int m = 0; m < 2; ++m)
#pragma unroll
                        for (int r = 0; r < 4; ++r) {
                            const bf16* gp = SG + (size_t)(row0 + 16 * m + 4 * fq + r) * 3072 + seg * 1024 + col0 + fr;
#pragma unroll
                            for (int n = 0; n < 2; ++n) mg[m][n][r] += bf2f(gp[16 * n]) * acc[m][n][r];
                        }
                }
#pragma unroll
                for (int m = 0; m < 2; ++m)
#pragma unroll
                    for (int r = 0; r < 4; ++r) {
                        bf16* rowp = MG + (size_t)(row0 + 16 * m + 4 * fq + r) * D + col0 + fr;
#pragma unroll
                        for (int n = 0; n < 2; ++n) rowp[16 * n] = (bf16)f2bf(mg[m][n][r]);
                    }
            }
} }
        }
        }
#endif
        GRID_BAR();

#ifndef SKIP_P5
        { PHASE_PTRS LAYER_PTRS
        {
            pg8::Gemm g{MG, WO + (size_t)layer * D * D, D, D, D, 0, 0};
            pg8::SegOrder<1> S; S.T.init(T_LAT, D, G, (int)blockIdx.x);
            EpiOut E{X, modl, layer == 0 ? IN_[I_X] : nullptr, IN_[I_CTX]};
            pg8::gemm_phase(L, g, S, E, wave);
        }
        if (!last) { const int lo__ = lane_id_v(); { const int lane = lo__; const int fr = lane & 15, fq = lane >> 4; (void)fr; (void)fq;
            for (int it = gw; it < (T_ALL - T_LAT) / 32 * (D / 32); it += NGW) {
                const int row0 = T_LAT + (it / (D / 32)) * 32, col0 = (it % (D / 32)) * 32;
                f32x4 acc[2][2]; zero_acc22(acc);
                sgemm32<8>(acc, MG, D, WO + (size_t)layer * D * D, D, D, row0, col0, lane);
                const float* gt = modl + (size_t)2 * 6 * D + 2 * D + col0 + fr;
#pragma unroll
                for (int m = 0; m < 2; ++m)
#pragma unroll
                    for (int r = 0; r < 4; ++r) {
                        float* rowp = X + (size_t)(row0 + 16 * m + 4 * fq + r) * D + col0 + fr;
                        const float* srcp = (layer == 0) ? IN_[I_CTX] + (size_t)(row0 - T_LAT + 16 * m + 4 * fq + r) * D + col0 + fr : rowp;
#pragma unroll
                        for (int n = 0; n < 2; ++n) rowp[16 * n] = srcp[16 * n] + gt[16 * n] * acc[m][n][r];
                    }
            }
} }
        }
#endif
        GRID_BAR();

#ifndef SKIP_P6
        { PHASE_PTRS LAYER_PTRS
        for (int rep_ = 0; rep_ < REP_P6; ++rep_) {
        { const int ln = lane_id_v();
        {
            f32x4 gm[4], shv[4];
            auto prep = [&](int midx) { const float* md = modl + (size_t)midx * 6 * D;
#pragma unroll
                for (int j = 0; j < 4; ++j) { const f32x4 g = *((const GAS f32x4*)(IN_[I_G2] + layer * D) + ln + 64 * j); const f32x4 sc = *((const GAS f32x4*)(md + 4 * D) + ln + 64 * j);
                    gm[j] = g * (sc + 1.0f); shv[j] = *((const GAS f32x4*)(md + 3 * D) + ln + 64 * j); } };
            auto row = [&](int r) {
                const GAS f32x4* xr = (const GAS f32x4*)(X + (size_t)r * D) + ln;
                f32x4 v[4]; float ss = 0.f;
#pragma unroll
                for (int j = 0; j < 4; ++j) { v[j] = xr[64 * j]; ss += (v[j].x * v[j].x + v[j].y * v[j].y) + (v[j].z * v[j].z + v[j].w * v[j].w); }
                const float rs = 1.0f / sqrtf(wave_sum(ss) * (1.f / D) + NORM_EPS);
                GAS v2u* o8 = (GAS v2u*)(H + (size_t)r * D) + ln;
#pragma unroll
                for (int j = 0; j < 4; ++j) { const f32x4 h = v[j] * rs * gm[j] + shv[j]; v2u o; o.x = pk2(h.x, h.y); o.y = pk2(h.z, h.w); o8[64 * j] = o; } };
            wave_row_blocks(T_EFF, gw, NGW, prep, row);
        }
        }
        }
        }
#endif
        GRID_BAR();

#ifndef SKIP_P7
        { PHASE_PTRS LAYER_PTRS
        for (int rep_ = 0; rep_ < REP_P7; ++rep_) {
        {
            pg8::Gemm g{H, WQ + (size_t)layer * 2048 * D, D, D, D, 0, 0};
            pg8::SegOrder<1> S; S.T.init(T_LAT, 2048, G, (int)blockIdx.x);
            EpiStore E{Q2, 2048};
            pg8::gemm_phase(L, g, S, E, wave);
        }
        if (!last) { const int lo__ = lane_id_v(); { const int lane = lo__; const int fr = lane & 15, fq = lane >> 4; (void)fr; (void)fq;
            for (int it = gw; it < (T_ALL - T_LAT) / 32 * (2048 / 32); it += NGW) {
                const int row0 = T_LAT + (it / (2048 / 32)) * 32, col0 = (it % (2048 / 32)) * 32;
                f32x4 acc[2][2]; zero_acc22(acc);
                sgemm32<8>(acc, H, D, WQ + (size_t)layer * 2048 * D, D, D, row0, col0, lane);
#pragma unroll
                for (int m = 0; m < 2; ++m)
#pragma unroll
                    for (int r = 0; r < 4; ++r) {
                        bf16* rowp = Q2 + (size_t)(row0 + 16 * m + 4 * fq + r) * 2048 + col0 + fr;
#pragma unroll
                        for (int n = 0; n < 2; ++n) rowp[16 * n] = (bf16)f2bf(acc[m][n][r]);
                    }
            }
} }
        }
        }
#endif
        GRID_BAR();

#ifndef SKIP_P8
        { PHASE_PTRS LAYER_PTRS
        for (int rep_ = 0; rep_ < REP_P8; ++rep_) {
{ const int lo__ = lane_id_v(); { const int lane = lo__; const int fr = lane & 15, fq = lane >> 4, tid = wave * 64 + lane;
        {
            LAS float* S = (LAS float*)L;
            const int wr = wave >> 1, wc = wave & 1;
            const int tl = tid >> 2, qd = tid & 3, ph = qd >> 1, hq = qd & 1;
            for (int it = vcu; it < (T_EFF / 128) * PEER_HEADS; it += G) {
                const int tile = it >> 3, h = it & 7;
                {
                    f32x4 acc[2][8];
#pragma unroll
                    for (int m = 0; m < 2; ++m)
#pragma unroll
                        for (int n = 0; n < 8; ++n) acc[m][n] = (f32x4){0.f, 0.f, 0.f, 0.f};
                    const bf16* ap = Q2 + (size_t)(tile * 128 + wr * 32 + fr) * 2048 + h * 256 + wc * 128 + fq * 8;
                    const bf16* bp = KEYS + ((size_t)(layer * 16 + h * 2 + wc) * 128 + fr) * 128 + fq * 8;
                    bf16x8 af[2][4];
#pragma unroll
                    for (int m = 0; m < 2; ++m)
#pragma unroll
                        for (int ks = 0; ks < 4; ++ks) af[m][ks] = *(const GAS bf16x8*)(ap + (size_t)m * 16 * 2048 + ks * 32);
#pragma unroll
                    for (int n = 0; n < 8; ++n) {
                        bf16x8 bfr[4];
#pragma unroll
                        for (int ks = 0; ks < 4; ++ks) bfr[ks] = *(const GAS bf16x8*)(bp + (size_t)n * 16 * 128 + ks * 32);
#pragma unroll
                        for (int ks = 0; ks < 4; ++ks)
#pragma unroll
                            for (int m = 0; m < 2; ++m) acc[m][n] = __builtin_amdgcn_mfma_f32_16x16x32_bf16(af[m][ks], bfr[ks], acc[m][n], 0, 0, 0);
                    }
#pragma unroll
                    for (int m = 0; m < 2; ++m)
#pragma unroll
                        for (int r = 0; r < 4; ++r) {
                            const int row_ = wr * 32 + 16 * m + 4 * fq + r;
#pragma unroll
                            for (int n = 0; n < 8; ++n) { const int key_ = wc * 128 + 16 * n + fr, c_ = key_ >> 2, pc_ = (c_ & 0x30) | ((c_ & 15) ^ (((row_ & 3) << 2) | (c_ >> 4)));
                                S[row_ * 256 + pc_ * 4 + (key_ & 3)] = acc[m][n][r]; }
                        }
                }
                __syncthreads();
                {
                    const int t = tile * 128 + tl;
                    int a[16];
#define LOAD_CHUNK_L(v, ch) _Pragma("unroll") for (int q = 0; q < 4; ++q) { const int c_ = qd * 16 + (ch) * 4 + q, pc_ = (c_ & 0x30) | ((c_ & 15) ^ (((tl & 3) << 2) | qd)); \
                        const f32x4 x = *(const LAS f32x4*)(S + tl * 256 + pc_ * 4); const int kb_ = hq * 64 + (ch) * 16 + 4 * q; \
                        v[4 * q + 0] = (f2ord(x.x) & ~127) | (kb_ + 0); v[4 * q + 1] = (f2ord(x.y) & ~127) | (kb_ + 1); v[4 * q + 2] = (f2ord(x.z) & ~127) | (kb_ + 2); v[4 * q + 3] = (f2ord(x.w) & ~127) | (kb_ + 3); }
                    LOAD_CHUNK_L(a, 0) sort16_desc(a);
#pragma unroll
                    for (int ch = 1; ch < 4; ++ch) { int v[16]; LOAD_CHUNK_L(v, ch) sort16_desc(v); merge16_desc(a, v); }
#undef LOAD_CHUNK_L
                    { int b[16];
#pragma unroll
                      for (int i = 0; i < 16; ++i) b[i] = __builtin_amdgcn_update_dpp(0, a[i], 0xB1, 0xF, 0xF, true);
                      merge16_desc(a, b); }
                    int a0[16], a1[16];
#pragma unroll
                    for (int i = 0; i < 16; ++i) { const int o2 = __builtin_amdgcn_update_dpp(0, a[i], 0x4E, 0xF, 0xF, true); a0[i] = ph ? o2 : a[i]; a1[i] = ph ? a[i] : o2; }
                    {
            float va[16], vb[16];
#pragma unroll
            for (int i = 0; i < 16; ++i) { va[i] = ord2f(a0[i] & ~127); vb[i] = ord2f(a1[i] & ~127); }
            int c[16];
            {
                int v[16];
                v[0] = (f2ord(va[0] + vb[0]) & ~255) | 0;
                v[1] = (f2ord(va[0] + vb[1]) & ~255) | 1;
                v[2] = (f2ord(va[0] + vb[2]) & ~255) | 2;
                v[3] = (f2ord(va[0] + vb[3]) & ~255) | 3;
                v[4] = (f2ord(va[0] + vb[4]) & ~255) | 4;
                v[5] = (f2ord(va[0] + vb[5]) & ~255) | 5;
                v[6] = (f2ord(va[0] + vb[6]) & ~255) | 6;
                v[7] = (f2ord(va[0] + vb[7]) & ~255) | 7;
                v[8] = (f2ord(va[0] + vb[8]) & ~255) | 8;
                v[9] = (f2ord(va[0] + vb[9]) & ~255) | 9;
                v[10] = (f2ord(va[0] + vb[10]) & ~255) | 10;
                v[11] = (f2ord(va[0] + vb[11]) & ~255) | 11;
                v[12] = (f2ord(va[0] + vb[12]) & ~255) | 12;
                v[13] = (f2ord(va[0] + vb[13]) & ~255) | 13;
                v[14] = (f2ord(va[0] + vb[14]) & ~255) | 14;
                v[15] = (f2ord(va[0] + vb[15]) & ~255) | 15;
                sort16_desc(v);
#pragma unroll
                for (int i = 0; i < 16; ++i) c[i] = v[i];
            }
            {
                int v[16];
                v[0] = (f2ord(va[1] + vb[0]) & ~255) | 16;
                v[1] = (f2ord(va[1] + vb[1]) & ~255) | 17;
                v[2] = (f2ord(va[1] + vb[2]) & ~255) | 18;
                v[3] = (f2ord(va[1] + vb[3]) & ~255) | 19;
                v[4] = (f2ord(va[1] + vb[4]) & ~255) | 20;
                v[5] = (f2ord(va[1] + vb[5]) & ~255) | 21;
                v[6] = (f2ord(va[1] + vb[6]) & ~255) | 22;
                v[7] = (f2ord(va[1] + vb[7]) & ~255) | 23;
                v[8] = (f2ord(va[2] + vb[0]) & ~255) | 32;
                v[9] = (f2ord(va[2] + vb[1]) & ~255) | 33;
                v[10] = (f2ord(va[2] + vb[2]) & ~255) | 34;
                v[11] = (f2ord(va[2] + vb[3]) & ~255) | 35;
                v[12] = (f2ord(va[2] + vb[4]) & ~255) | 36;
                v[13] = (f2ord(va[3] + vb[0]) & ~255) | 48;
                v[14] = (f2ord(va[3] + vb[1]) & ~255) | 49;
                v[15] = (f2ord(va[3] + vb[2]) & ~255) | 50;
                sort16_desc(v);
                merge16_desc(c, v);
            }
            {
                int v[16];
                v[0] = (f2ord(va[3] + vb[3]) & ~255) | 51;
                v[1] = (f2ord(va[4] + vb[0]) & ~255) | 64;
                v[2] = (f2ord(va[4] + vb[1]) & ~255) | 65;
                v[3] = (f2ord(va[4] + vb[2]) & ~255) | 66;
                v[4] = (f2ord(va[5] + vb[0]) & ~255) | 80;
                v[5] = (f2ord(va[5] + vb[1]) & ~255) | 81;
                v[6] = (f2ord(va[6] + vb[0]) & ~255) | 96;
                v[7] = (f2ord(va[6] + vb[1]) & ~255) | 97;
                v[8] = (f2ord(va[7] + vb[0]) & ~255) | 112;
                v[9] = (f2ord(va[7] + vb[1]) & ~255) | 113;
                v[10] = (f2ord(va[8] + vb[0]) & ~255) | 128;
                v[11] = (f2ord(va[9] + vb[0]) & ~255) | 144;
                v[12] = (f2ord(va[10] + vb[0]) & ~255) | 160;
                v[13] = (f2ord(va[11] + vb[0]) & ~255) | 176;
                v[14] = (f2ord(va[12] + vb[0]) & ~255) | 192;
                v[15] = (f2ord(va[13] + vb[0]) & ~255) | 208;
                sort16_desc(v);
                merge16_desc(c, v);
            }
            {
                int v[16];
                v[0] = (f2ord(va[14] + vb[0]) & ~255) | 224;
                v[1] = (f2ord(va[15] + vb[0]) & ~255) | 240;
                v[2] = (int)0x80000000;
                v[3] = (int)0x80000000;
                v[4] = (int)0x80000000;
                v[5] = (int)0x80000000;
                v[6] = (int)0x80000000;
                v[7] = (int)0x80000000;
                v[8] = (int)0x80000000;
                v[9] = (int)0x80000000;
                v[10] = (int)0x80000000;
                v[11] = (int)0x80000000;
                v[12] = (int)0x80000000;
                v[13] = (int)0x80000000;
                v[14] = (int)0x80000000;
                v[15] = (int)0x80000000;
                sort16_desc(v);
                merge16_desc(c, v);
            }
            const float smax = ord2f(c[0] & ~255);
            float pe[16]; float psum = 0.f;
#pragma unroll
            for (int k = 0; k < 16; ++k) { pe[k] = __expf(ord2f(c[k] & ~255) - smax); psum += pe[k]; }
            const float ip = 1.0f / psum;
#pragma unroll
            for (int kk = 0; kk < 4; ++kk) {
                const int ck = (qd == 0) ? c[kk] : (qd == 1) ? c[4 + kk] : (qd == 2) ? c[8 + kk] : c[12 + kk];
                const float pk_ = (qd == 0) ? pe[kk] : (qd == 1) ? pe[4 + kk] : (qd == 2) ? pe[8 + kk] : pe[12 + kk];
                const int ij = ck & 255, ii = ij >> 4, jj = ij & 15;
                int e0 = 0, e1 = 0;
#pragma unroll
                for (int q = 0; q < 16; ++q) { e0 = (ii == q) ? (a0[q] & 127) : e0; e1 = (jj == q) ? (a1[q] & 127) : e1; }
                const int e = e0 * PEER_KEYS + e1;
                const float su = SCU[layer * 16384 + e], sv = SCV[layer * 16384 + e];
                const int k = 4 * qd + kk;
                EI[(size_t)t * NSEL + h * 16 + k] = (unsigned)e | (f2bf(su) << 16);
                EG[(size_t)t * NSEL + h * 16 + k] = pk_ * ip * sv;
            }
                    }
                }
                __syncthreads();
            }
        }
} }
        }
        }
#endif
        GRID_BAR();

#ifndef SKIP_P10
#define P10_CENSUS \
        unsigned myx_, nx_ = 1u, smask_ = 0u; { unsigned cnt_[16]; unsigned* bw_ = (unsigned*)(args.ws + WS_CTL) + CW_BAR; \
            _Pragma("unroll") for (int j = 0; j < 16; ++j) cnt_[j] = (unsigned)__builtin_amdgcn_readfirstlane((int)xb_ld(&bw_[XB_XCNT(j)])); \
            myx_ = xb_xcc_id(); unsigned np_ = 0u; \
            _Pragma("unroll") for (int j = 0; j < 16; ++j) { np_ += (cnt_[j] > 0u) ? 1u : 0u; nx_ = ((unsigned)j == myx_) ? cnt_[j] : nx_; } \
            if (np_ == 0u) np_ = 1u; if (nx_ == 0u) nx_ = 1u; \
            _Pragma("unroll") for (int sl = 0; sl < 8; ++sl) { const unsigned k_ = (unsigned)sl % np_; unsigned seen_ = 0u, srv_ = 0xffu; \
                _Pragma("unroll") for (int j = 0; j < 16; ++j) { if (cnt_[j] > 0u) { srv_ = (seen_ == k_) ? (unsigned)j : srv_; ++seen_; } } \
                smask_ |= (srv_ == myx_) ? (1u << sl) : 0u; } } \
        const int rank_ = (int)__builtin_amdgcn_readfirstlane((int)MISC[12]); const int wstride_ = (int)nx_ * NWAVES; (void)rank_; (void)wstride_;
        { PHASE_PTRS LAYER_PTRS
        { const int ln = lane_id_v(); const int c = ln & 7, tg = ln >> 3;
          P10_CENSUS
          float* PART = (float*)(wsq + WS_PART);
          const unsigned char* U8l = U8 + (size_t)layer * 16384 * D;
          for (int rep_ = 0; rep_ < REP_P10A; ++rep_)
#pragma unroll 1
          for (int sl = 0; sl < 8; ++sl) {
            if (!((smask_ >> sl) & 1u)) continue;
            const int ws0 = (rank_ * NWAVES + wave) * 8, nslot = wstride_ * 8;
            if (ws0 >= T_EFF) continue;
            const int niter = (T_EFF - ws0 + nslot - 1) / nslot, nb = niter * 8;
#define A_TOK(bi) (ws0 + tg + (min((bi), nb - 1) >> 3) * nslot)
#define A_LOAD_PK(pkv, bi) { const GAS v4u* wp_ = (const GAS v4u*)(EI + (size_t)A_TOK(bi) * NSEL + 16 * (min((bi), nb - 1) & 7)); _Pragma("unroll") for (int q = 0; q < 4; ++q) pkv[q] = wp_[q]; }
#define A_ISSUE(rowv, pkv) { _Pragma("unroll") for (int q = 0; q < 16; ++q) rowv[q] = *(const GAS v4u*)(U8l + (size_t)(pkv[q >> 2][q & 3] & 0xffffu) * D + 128 * sl + 16 * c); }
#define A_LOAD_H(hvv, bi) { const int tq_ = A_TOK(bi); _Pragma("unroll") for (int j = 0; j < 4; ++j) hvv[j] = *(const GAS v2u*)(H + (size_t)tq_ * D + 256 * j + 32 * sl + 4 * c); }
#define A_QUANT(hvv) { float hf[16]; float am_ = 0.f; \
                _Pragma("unroll") for (int j = 0; j < 4; ++j) { hf[4 * j] = bf2f(hvv[j].x & 0xffffu); hf[4 * j + 1] = bf2f(hvv[j].x >> 16); hf[4 * j + 2] = bf2f(hvv[j].y & 0xffffu); hf[4 * j + 3] = bf2f(hvv[j].y >> 16); } \
                _Pragma("unroll") for (int i = 0; i < 16; ++i) am_ = fmaxf(am_, fabsf(hf[i])); \
                am_ = fmaxf(am_, dpp_mov<0xB1>(am_)); am_ = fmaxf(am_, dpp_mov<0x4E>(am_)); am_ = fmaxf(am_, dpp_mov<0x141>(am_)); am_ = fmaxf(am_, 1e-20f); \
                sh_ = am_ * (1.0f / 127.0f); const float ih_ = 127.0f / am_; \
                _Pragma("unroll") for (int j = 0; j < 4; ++j) { const int q0 = __float2int_rn(hf[4 * j] * ih_), q1 = __float2int_rn(hf[4 * j + 1] * ih_), q2 = __float2int_rn(hf[4 * j + 2] * ih_), q3 = __float2int_rn(hf[4 * j + 3] * ih_); \
                    hq_[j] = (int)((unsigned)(q0 & 255) | ((unsigned)(q1 & 255) << 8) | ((unsigned)(q2 & 255) << 16) | ((unsigned)q3 << 24)); } }
#define A_COMPUTE(rowv, bi) { int p_[16]; \
                _Pragma("unroll") for (int q = 0; q < 16; ++q) { int ia = 0; _Pragma("unroll") for (int j = 0; j < 4; ++j) ia = __builtin_amdgcn_sdot4((int)rowv[q][j], hq_[j], ia, false); p_[q] = ia; } \
                { const bool up = (c & 4) != 0; _Pragma("unroll") for (int i = 0; i < 8; ++i) { const int send = up ? p_[i] : p_[8 + i], keep = up ? p_[8 + i] : p_[i]; p_[i] = keep + __builtin_amdgcn_update_dpp(0, send, 0x141, 0xF, 0xF, true); } } \
                { const bool up = (c & 2) != 0; _Pragma("unroll") for (int i = 0; i < 4; ++i) { const int send = up ? p_[i] : p_[4 + i], keep = up ? p_[4 + i] : p_[i]; p_[i] = keep + __builtin_amdgcn_update_dpp(0, send, 0x4E, 0xF, 0xF, true); } } \
                { const bool up = (c & 1) != 0; _Pragma("unroll") for (int i = 0; i < 2; ++i) { const int send = up ? p_[i] : p_[2 + i], keep = up ? p_[2 + i] : p_[i]; p_[i] = keep + __builtin_amdgcn_update_dpp(0, send, 0xB1, 0xF, 0xF, true); } } \
                f32x2 r2_; r2_.x = (float)p_[0] * sh_; r2_.y = (float)p_[1] * sh_; \
                *(GAS f32x2*)(PART + ((size_t)sl * T_ALL + (ws0 + tg + ((bi) >> 3) * nslot)) * NSEL + 16 * ((bi) & 7) + 2 * c) = r2_; }
            v4u pkA[4], pkB[4]; v4u rowA[16], rowB[16]; v2u hN[4]; int hq_[4] = {0, 0, 0, 0}; float sh_ = 0.f;
            A_LOAD_PK(pkA, 0) A_LOAD_PK(pkB, 1) A_LOAD_H(hN, 0)
            A_ISSUE(rowA, pkA)
#pragma unroll 1
            for (int bi = 0; bi < nb; bi += 2) {
                if ((bi & 7) == 0) { A_QUANT(hN) A_LOAD_H(hN, bi + 8) }
                A_ISSUE(rowB, pkB) A_LOAD_PK(pkA, bi + 2)
                __builtin_amdgcn_sched_barrier(0);
                A_COMPUTE(rowA, bi)
                __builtin_amdgcn_sched_barrier(0);
                A_ISSUE(rowA, pkA) A_LOAD_PK(pkB, bi + 3)
                __builtin_amdgcn_sched_barrier(0);
                A_COMPUTE(rowB, bi + 1)
                __builtin_amdgcn_sched_barrier(0);
            }
#undef A_TOK
#undef A_LOAD_PK
#undef A_ISSUE
#undef A_LOAD_H
#undef A_QUANT
#undef A_COMPUTE
          }
        } }
        GRID_BAR();
        { PHASE_PTRS LAYER_PTRS
        { const int ln = lane_id_v();
          const float* PART = (const float*)(wsq + WS_PART); float* WGT = (float*)(wsq + WS_WGT);
          for (int rep_ = 0; rep_ < REP_P10B; ++rep_)
          for (int i4 = vcu * NTHREADS + wave * 64 + ln; i4 < T_EFF * NSEL / 4; i4 += NGT) {
              f32x4 dsum = (f32x4){0.f, 0.f, 0.f, 0.f};
#pragma unroll
              for (int sl = 0; sl < 8; ++sl) dsum += *((const GAS f32x4*)(PART + (size_t)sl * T_ALL * NSEL) + i4);
              const v4u esu = *((const GAS v4u*)EI + i4); const f32x4 gv = *((const GAS f32x4*)EG + i4);
              v4u o;
#pragma unroll
              for (int q = 0; q < 4; ++q) {
                  const float dot = dsum[q] * bf2f(esu[q] >> 16);
                  o[q] = (esu[q] & 0xffffu) | (f2bf(0.5f * dot * (1.0f + erff(dot * 0.70710678118654752f)) * gv[q]) << 16);
              }
              *((GAS v4u*)WGT + i4) = o;
          }
        } }
        GRID_BAR();
        { PHASE_PTRS LAYER_PTRS
        { const int ln = lane_id_v(); const int c = ln & 7, tg = ln >> 3;
          P10_CENSUS
          const unsigned* WGT = (const unsigned*)(wsq + WS_WGT); float* XO = (float*)(wsq + WS_XO);
          const unsigned char* V8l = V8 + (size_t)layer * 16384 * D;
          for (int rep_ = 0; rep_ < REP_P10C; ++rep_)
#pragma unroll 1
          for (int sl = 0; sl < 8; ++sl) {
            if (!((smask_ >> sl) & 1u)) continue;
            const int ws0 = (rank_ * NWAVES + wave) * 8, nslot = wstride_ * 8;
            if (ws0 >= T_EFF) continue;
            const int niter = (T_EFF - ws0 + nslot - 1) / nslot, nb = niter * 8;
#define C_TOK(bi) (ws0 + tg + (min((bi), nb - 1) >> 3) * nslot)
#define C_LOAD_PK(pkv, bi) { const GAS v4u* wp_ = (const GAS v4u*)(WGT + (size_t)C_TOK(bi) * NSEL + 16 * (min((bi), nb - 1) & 7)); _Pragma("unroll") for (int q = 0; q < 4; ++q) pkv[q] = wp_[q]; }
#define C_ISSUE(rowv, wv, pkv) { _Pragma("unroll") for (int q = 0; q < 16; ++q) { const unsigned w_ = pkv[q >> 2][q & 3]; rowv[q] = *(const GAS v4u*)(V8l + (size_t)(w_ & 0xffffu) * D + 128 * sl + 16 * c); } \
                _Pragma("unroll") for (int q = 0; q < 8; ++q) wv[q] = (pkv[q >> 1][(2 * q) & 3] >> 16) | (pkv[q >> 1][(2 * q + 1) & 3] & 0xffff0000u); }
#define C_COMPUTE(rowv, wv) { _Pragma("unroll") for (int q = 0; q < 16; ++q) { const float wq_ = (q & 1) ? __builtin_bit_cast(float, wv[q >> 1] & 0xffff0000u) : bf2f(wv[q >> 1] & 0xffffu); const f32x2 w2_ = (f32x2){wq_, wq_}; _Pragma("unroll") for (int j = 0; j < 4; ++j) { \
                    const f32x2 a = __builtin_amdgcn_cvt_pk_f32_fp8((int)rowv[q][j], false), b = __builtin_amdgcn_cvt_pk_f32_fp8((int)rowv[q][j], true); \
                    f32x2 lo_ = (f32x2){o[j].x, o[j].y}, hi_ = (f32x2){o[j].z, o[j].w}; lo_ = __builtin_elementwise_fma(a, w2_, lo_); hi_ = __builtin_elementwise_fma(b, w2_, hi_); \
                    o[j].x = lo_.x; o[j].y = lo_.y; o[j].z = hi_.x; o[j].w = hi_.y; } \
                    asm volatile("" : "+v"(o[0]), "+v"(o[1]), "+v"(o[2]), "+v"(o[3])); } }
            v4u pkA[4], pkB[4]; unsigned wA[8], wB[8]; v4u rowA[16], rowB[16];
            f32x4 o[4];
#pragma unroll
            for (int j = 0; j < 4; ++j) o[j] = (f32x4){0.f, 0.f, 0.f, 0.f};
            C_LOAD_PK(pkA, 0) C_LOAD_PK(pkB, 1)
            C_ISSUE(rowA, wA, pkA)
#pragma unroll 1
            for (int bi = 0; bi < nb; bi += 2) {
                C_ISSUE(rowB, wB, pkB) C_LOAD_PK(pkA, bi + 2)
                __builtin_amdgcn_sched_barrier(0);
                C_COMPUTE(rowA, wA)
                __builtin_amdgcn_sched_barrier(0);
                C_ISSUE(rowA, wA, pkA) C_LOAD_PK(pkB, bi + 3)
                __builtin_amdgcn_sched_barrier(0);
                C_COMPUTE(rowB, wB)
                __builtin_amdgcn_sched_barrier(0);
                if ((bi & 7) == 6) {
                    const int t = ws0 + tg + (bi >> 3) * nslot;
#pragma unroll
                    for (int j = 0; j < 4; ++j) { *(GAS f32x4*)(XO + (size_t)t * D + 256 * j + 32 * sl + 4 * c) = o[j]; o[j] = (f32x4){0.f, 0.f, 0.f, 0.f}; }
                }
            }
#undef C_TOK
#undef C_LOAD_PK
#undef C_ISSUE
#undef C_COMPUTE
          }
        } }
        GRID_BAR();
#undef P10_CENSUS
        { PHASE_PTRS LAYER_PTRS
        { const int ln = lane_id_v();
          const float* XO = (const float*)(wsq + WS_XO);
          f32x4 gt2v[4], gm[4], shv[4];
          auto prep = [&](int midx) {
              const float* md = modl + (size_t)midx * 6 * D; const float* md1 = modl + (size_t)(3 + midx) * 6 * D;
#pragma unroll
              for (int j = 0; j < 4; ++j) {
                  gt2v[j] = *((const GAS f32x4*)(md + 5 * D) + ln + 64 * j);
                  if (!last) { const f32x4 g = *((const GAS f32x4*)(IN_[I_G1] + (layer + 1) * D) + ln + 64 * j); const f32x4 sc = *((const GAS f32x4*)(md1 + D) + ln + 64 * j);
                               gm[j] = g * (sc + 1.0f); shv[j] = *((const GAS f32x4*)(md1 + 0) + ln + 64 * j); }
                  else { gm[j] = *((const GAS f32x4*)IN_[I_GFINAL] + ln + 64 * j); shv[j] = (f32x4){0.f, 0.f, 0.f, 0.f}; }
              } };
          auto row = [&](int t) {
              GAS f32x4* xr = (GAS f32x4*)(X + (size_t)t * D) + ln;
              const GAS f32x4* xo = (const GAS f32x4*)(XO + (size_t)t * D) + ln;
              f32x4 xn[4]; float ss = 0.f;
#pragma unroll
              for (int j = 0; j < 4; ++j) { xn[j] = xr[64 * j] + gt2v[j] * xo[64 * j]; ss += (xn[j].x * xn[j].x + xn[j].y * xn[j].y) + (xn[j].z * xn[j].z + xn[j].w * xn[j].w); }
              const float rs = 1.0f / sqrtf(wave_sum(ss) * (1.f / D) + NORM_EPS);
              if (!last) {
                  GAS v2u* o8 = (GAS v2u*)(H + (size_t)t * D) + ln;
#pragma unroll
                  for (int j = 0; j < 4; ++j) { xr[64 * j] = xn[j]; const f32x4 hh = xn[j] * rs * gm[j] + shv[j]; v2u o; o.x = pk2(hh.x, hh.y); o.y = pk2(hh.z, hh.w); o8[64 * j] = o; }
              } else {
                  GAS f32x4* op = (GAS f32x4*)(((float*)IN_[22]) + (size_t)t * D) + ln;
#pragma unroll
                  for (int j = 0; j < 4; ++j) op[64 * j] = xn[j] * rs * gm[j];
              } };
          wave_row_blocks(T_EFF, gw, NGW, prep, row);
        } }
#endif
        if (!last) GRID_BAR();
    }
}

extern "C" void kernel_launch(void* const* d_in, const int* in_sizes, int n_in, void* d_out, int out_size, void* d_ws, size_t ws_size, hipStream_t stream) {
    static int grid = 0;
    if (grid == 0) {
        if (n_in != 22 || out_size != T_LAT * D || ws_size < WS_END) { fprintf(stderr, "kernel_launch: unexpected shapes: n_in %d out %d ws %zu (need %zu)\n", n_in, out_size, ws_size, (size_t)WS_END); grid = -1; return; }
        int dev = 0, cus = 0, per_cu = 0;
        if (hipGetDevice(&dev) != hipSuccess || hipDeviceGetAttribute(&cus, hipDeviceAttributeMultiprocessorCount, dev) != hipSuccess) { fprintf(stderr, "device query failed\n"); grid = -1; return; }
        if (hipFuncSetAttribute((const void*)mega_fwd, hipFuncAttributeMaxDynamicSharedMemorySize, LDS_BYTES) != hipSuccess) { fprintf(stderr, "hipFuncSetAttribute failed\n"); grid = -1; return; }
        if (hipOccupancyMaxActiveBlocksPerMultiprocessor(&per_cu, (const void*)mega_fwd, NTHREADS, LDS_BYTES) != hipSuccess || per_cu < 1) { fprintf(stderr, "occupancy query: %d\n", per_cu); }
        (void)hipGetLastError();
        grid = cus;
    }
    if (grid < 0) return;
    if (hipMemsetAsync((char*)d_ws + WS_CTL, 0, CTL_ZERO_BYTES, stream) != hipSuccess) { fprintf(stderr, "memset failed\n"); return; }
    Args a{};
    for (int i = 0; i < 22; ++i) a.in[i] = (const float*)d_in[i];
    a.out = (float*)d_out; a.ws = (unsigned char*)d_ws;
    hipLaunchKernelGGL(mega_fwd, dim3(grid), dim3(NTHREADS), LDS_BYTES, stream, a);
}
```

```cpp
#include <hip/hip_runtime.h>
#include <cstdio>
#include <cstdint>

#ifndef REP_P0
#define REP_P0 1
#endif
#ifndef REP_P1
#define REP_P1 1
#endif
#ifndef REP_P2
#define REP_P2 1
#endif
#ifndef REP_P3A
#define REP_P3A 1
#endif
#ifndef REP_P3B
#define REP_P3B 1
#endif
#ifndef REP_P4
#define REP_P4 1
#endif
#ifndef REP_P6
#define REP_P6 1
#endif
#ifndef REP_P7
#define REP_P7 1
#endif
#ifndef REP_P8
#define REP_P8 1
#endif
#ifndef REP_P9
#define REP_P9 1
#endif
#ifndef REP_P10
#define REP_P10 1
#endif
#ifndef REP_P10A
#define REP_P10A 1
#endif
#ifndef REP_P10C
#define REP_P10C 1
#endif
#ifndef REP_P10B
#define REP_P10B 1
#endif
#ifndef REP_P0A
#define REP_P0A 1
#endif
#ifndef REP_P0D
#define REP_P0D 1
#endif
#ifndef REP_P0F
#define REP_P0F 1
#endif
#ifndef REP_P3C
#define REP_P3C 1
#endif
#define GAS __attribute__((address_space(1)))
#define LAS __attribute__((address_space(3)))
typedef unsigned short bf16;
typedef float f32x4 __attribute__((ext_vector_type(4)));
typedef short bf16x8 __attribute__((ext_vector_type(8)));
typedef unsigned v4u __attribute__((ext_vector_type(4)));
typedef unsigned v2u __attribute__((ext_vector_type(2)));
typedef float f32x2 __attribute__((ext_vector_type(2)));
typedef GAS unsigned gu32;

constexpr int NWAVES = 8, NTHREADS = 512;
constexpr int D = 1024, BATCH = 2, SEQ = 8192, DEPTH = 2, GRID_W = 64, CTX = 256;
constexpr int T_LAT = BATCH * SEQ;
constexpr int T_ALL = T_LAT + BATCH * CTX;
constexpr int NTOK = SEQ + CTX;
constexpr int IN_W = 6912;
constexpr int PEER_HEADS = 8, PEER_KEYS = 128, PEER_TOPK = 16, NSEL = PEER_HEADS * PEER_TOPK;
constexpr float NORM_EPS = 1e-6f;
constexpr float LOG2E = 1.4426950408889634f;
constexpr float SCL2 = 0.125f * LOG2E;

constexpr size_t MiB = 1u << 20;
constexpr size_t WS_CTL = 0, CTL_ZERO_BYTES = 1 * MiB;
constexpr int CW_BAR = 4096;
constexpr int CW_RANK = 8192;
#ifndef P10_SLICED
#define P10_SLICED 1
#endif
constexpr size_t WS_MOD = 65536;
constexpr size_t WS_COS = 2 * MiB, WS_SIN = 3 * MiB;
constexpr size_t WS_WIN = 4 * MiB;
constexpr size_t WS_WB = 31 * MiB;
constexpr size_t WS_WO = 37 * MiB;
constexpr size_t WS_WQ = 41 * MiB;
constexpr size_t WS_KEYS = 49 * MiB;
constexpr size_t WS_X = 50 * MiB;
constexpr size_t WS_H = 116 * MiB;
constexpr size_t WS_Y = 149 * MiB;
constexpr size_t WS_MG = WS_H;
constexpr size_t WS_U8 = 199 * MiB;
constexpr size_t WS_SCU = 231 * MiB;
constexpr size_t WS_EI = 232 * MiB;
constexpr size_t WS_EG = 241 * MiB;
constexpr size_t WS_P = 250 * MiB;
constexpr size_t SZ_R512 = (size_t)T_ALL * 512 * 2;
constexpr size_t SZ_R128 = (size_t)T_ALL * 128 * 2;
constexpr size_t WS_AQ = WS_P, WS_AK = WS_AQ + SZ_R512, WS_AVT = WS_AK + SZ_R128, WS_BQ = WS_AVT + SZ_R128, WS_BK = WS_BQ + SZ_R512,
                 WS_BVT = WS_BK + SZ_R512, WS_CQ = WS_BVT + SZ_R512, WS_CK = WS_CQ + SZ_R512, WS_CVT = WS_CK + SZ_R512, WS_SG = WS_CVT + SZ_R512;
constexpr size_t WS_Q2 = WS_P;
constexpr size_t WS_SC = WS_P + 66 * MiB;
constexpr size_t WS_PART = WS_P, WS_XO = WS_P + 66 * MiB, WS_WGT = WS_P + 132 * MiB;
constexpr size_t WS_PEND = WS_SG + (size_t)T_ALL * 3072 * 2;
constexpr size_t WS_V8 = 473 * MiB;
constexpr size_t WS_END = WS_V8 + 32 * MiB;
static_assert(WS_SC + (size_t)T_ALL * 2048 * 4 <= WS_PEND && WS_PEND <= WS_V8, "alias map");
static_assert(WS_END <= 512 * MiB, "ws map");

constexpr int LDS_BYTES = 147456;
constexpr int MISC_OFF = 131072 + 320;

__device__ __forceinline__ int lane_id_v() { int l; asm volatile("v_mbcnt_lo_u32_b32 %0, -1, 0\n\tv_mbcnt_hi_u32_b32 %0, -1, %0" : "=v"(l)); return l; }
#define XB_TMO      128
#define XB_XCNT(j)  (256  + 64 * (j))
#define XB_XSUB(j)  (1280 + 64 * (j))
#define XB_XGEN(j)  (2304 + 64 * (j))
#define XB_TOP      3328
#define XB_TOPGEN   3392
#define XCD_BAR_WORDS 3456
#define XB_SPIN_CAP (1u << 24)

__device__ __forceinline__ unsigned xb_ld(unsigned* p)              { return __hip_atomic_load(p, __ATOMIC_RELAXED, __HIP_MEMORY_SCOPE_AGENT); }
__device__ __forceinline__ unsigned xb_add(unsigned* p, unsigned v) { return __hip_atomic_fetch_add(p, v, __ATOMIC_RELAXED, __HIP_MEMORY_SCOPE_AGENT); }
__device__ __forceinline__ unsigned xb_xcc_id() { return (unsigned)__builtin_amdgcn_s_getreg((3 << 11) | 20) & 0xFu; }
#define XB_SPIN(cond, bar) do { unsigned _sp = 0; while (cond) { __builtin_amdgcn_s_sleep(1); \
    if ((++_sp & 255u) == 0u) { if (xb_ld(&(bar)[XB_TMO])) break; if (_sp > XB_SPIN_CAP) { atomicAdd(&(bar)[XB_TMO], 1u); break; } } } } while (0)

struct XcdBarrier { unsigned* bar; unsigned x; volatile LAS unsigned* st; };

__device__ __forceinline__ XcdBarrier xcd_barrier_post(unsigned* bar, volatile LAS unsigned* st) {
    XcdBarrier b; b.bar = bar; b.x = xb_xcc_id(); b.st = st;
    if (threadIdx.x == 0) (void)xb_add(&bar[XB_XCNT(b.x)], 1u);
    return b;
}
__device__ __forceinline__ void xcd_barrier_complete(unsigned* bar, unsigned x, unsigned& nloc, unsigned& nx) {
    const unsigned G = gridDim.x * gridDim.y * gridDim.z;
    unsigned sum, cnt, mine, sp = 0u;
    for (;;) {
        sum = 0u; cnt = 0u; mine = 0u;
#pragma unroll
        for (unsigned j = 0; j < 16; ++j) { const unsigned c = xb_ld(&bar[XB_XCNT(j)]); sum += c; cnt += (c > 0u) ? 1u : 0u; mine = (j == x) ? c : mine; }
        if (sum == G) break;
        __builtin_amdgcn_s_sleep(1);
        if ((++sp & 255u) == 0u) { if (xb_ld(&bar[XB_TMO])) break; if (sp > XB_SPIN_CAP) { atomicAdd(&bar[XB_TMO], 1u); break; } }
    }
    nloc = mine > 0u ? mine : 1u; nx = cnt > 0u ? cnt : 1u;
}
__device__ __forceinline__ void xcd_barrier(const XcdBarrier& b, bool t0) {
    asm volatile("s_waitcnt vmcnt(0)" ::: "memory");
    __syncthreads();
    if (t0) {
        unsigned* bar = b.bar;
        __builtin_amdgcn_s_waitcnt(0);
        unsigned nloc = b.st[0], nx = b.st[1];
        if (nloc == 0u) { xcd_barrier_complete(bar, b.x, nloc, nx); b.st[0] = nloc; b.st[1] = nx; }
        const unsigned old = xb_add(&bar[XB_XSUB(b.x)], 1u);
        const unsigned gen = old / nloc;
        if (old + 1u == (gen + 1u) * nloc) {
            __builtin_amdgcn_fence(__ATOMIC_RELEASE, "agent");
            asm volatile("s_waitcnt vmcnt(0)" ::: "memory");
            const unsigned og = xb_add(&bar[XB_TOP], 1u);
            const unsigned tg = og / nx;
            if (og + 1u == (tg + 1u) * nx) xb_add(&bar[XB_TOPGEN], 1u);
            else XB_SPIN(xb_ld(&bar[XB_TOPGEN]) == tg, bar);
            __builtin_amdgcn_fence(__ATOMIC_ACQUIRE, "agent");
            xb_add(&bar[XB_XGEN(b.x)], 1u);
            asm volatile("s_waitcnt vmcnt(0)" ::: "memory");
        } else {
            XB_SPIN(xb_ld(&bar[XB_XGEN(b.x)]) == gen, bar);
            __builtin_amdgcn_fence(__ATOMIC_ACQUIRE, "agent");
            asm volatile("s_waitcnt vmcnt(0)" ::: "memory");
        }
    }
    __syncthreads();
}

__device__ __forceinline__ unsigned f2bf(float f) { unsigned u = __builtin_bit_cast(unsigned, f); return (u + 0x7fffu + ((u >> 16) & 1u)) >> 16; }
__device__ __forceinline__ unsigned pk2(float lo, float hi) { return f2bf(lo) | (f2bf(hi) << 16); }
__device__ __forceinline__ float bf2f(unsigned h) { return __builtin_bit_cast(float, h << 16); }
template <int CTRL> __device__ __forceinline__ float dpp_mov(float v) { return __builtin_bit_cast(float, __builtin_amdgcn_update_dpp(0, __builtin_bit_cast(int, v), CTRL, 0xF, 0xF, true)); }
__device__ __forceinline__ float sum8_dpp(float v) { v += dpp_mov<0xB1>(v); v += dpp_mov<0x4E>(v); v += dpp_mov<0x141>(v); return v; }
template <int K> __device__ __forceinline__ float xshfl_l(float v, int lane) { return __builtin_bit_cast(float, __builtin_amdgcn_ds_bpermute((lane ^ K) << 2, __builtin_bit_cast(int, v))); }
template <int K> __device__ __forceinline__ float xshfl(float v) { return xshfl_l<K>(v, lane_id_v()); }
__device__ __forceinline__ float xadd32(float v) { return v + xshfl_l<32>(v, lane_id_v()); }
__device__ __forceinline__ float xmax32(float v) { return fmaxf(v, xshfl_l<32>(v, lane_id_v())); }
__device__ __forceinline__ float wave_sum(float v) { const int l = lane_id_v(); v += xshfl_l<1>(v, l); v += xshfl_l<2>(v, l); v += xshfl_l<4>(v, l); v += xshfl_l<8>(v, l); v += xshfl_l<16>(v, l); v += xshfl_l<32>(v, l); return v; }
__device__ __forceinline__ float wave_max(float v) { const int l = lane_id_v(); v = fmaxf(v, xshfl_l<1>(v, l)); v = fmaxf(v, xshfl_l<2>(v, l)); v = fmaxf(v, xshfl_l<4>(v, l)); v = fmaxf(v, xshfl_l<8>(v, l)); v = fmaxf(v, xshfl_l<16>(v, l)); v = fmaxf(v, xshfl_l<32>(v, l)); return v; }


__device__ __forceinline__ float sigmoidf_(float x) { return 1.0f / (1.0f + __expf(-x)); }
__device__ __forceinline__ float sigmoid_fast(float x) { return __builtin_amdgcn_rcpf(1.0f + __builtin_amdgcn_exp2f(-LOG2E * x)); }
__device__ __forceinline__ int row_modidx(int r) { return r < T_LAT ? (r >> 13) : 2; }
__device__ __forceinline__ int row_batch(int r) { return r < T_LAT ? (r >> 13) : ((r - T_LAT) >> 8); }
__device__ __forceinline__ int row_tok(int r) { return r < T_LAT ? (r & (SEQ - 1)) : SEQ + ((r - T_LAT) & (CTX - 1)); }

__device__ __forceinline__ const float* xin_row(const float* x, const float* ctx, int r) { return r < T_LAT ? x + (size_t)r * D : ctx + (size_t)(r - T_LAT) * D; }
template <class Prep, class Row>
__device__ __forceinline__ void wave_row_blocks(int T_rows, int gw, int NGW, Prep prep, Row row) {
    for (int r0 = gw * 8; r0 < T_LAT; r0 += NGW * 8) {
        prep(r0 >> 13);
#pragma unroll 2
        for (int k = 0; k < 8; ++k) row(r0 + k);
    }
    if (T_rows > T_LAT) for (int r = T_LAT + gw; r < T_rows; r += NGW) { prep(2); row(r); }
}
struct Args { const float* in[22]; float* out; unsigned char* ws; };
enum { I_X = 0, I_C, I_CTX, I_CCTX, I_WMOD, I_BMOD, I_G1, I_G2, I_WIN, I_SINK, I_RPB, I_LAMBDA, I_SUBLN, I_WBA, I_WBB, I_WBC, I_WOUT, I_PWQ, I_PKEYS, I_PU, I_PV, I_GFINAL };

__device__ __forceinline__ int rope_perm(int c) {
    if (c < 640 || (c >= 2304 && c < 3328)) { const int w = c & 63; return (c & ~63) + 2 * (w & 31) + (w >> 5); }
    return c;
}
template <bool PERM = false>
__device__ __forceinline__ void p0_transpose_item(const float* W, int K, int N, bf16* WT, LAS float* scr, int item, int lane) {
    const int nblk = N / 32, kb = item / nblk, nb = item % nblk, k0 = 64 * kb, n0 = 32 * nb;
    {
        f32x4 w[8];
        const float* src = W + (size_t)(k0 + (lane >> 3)) * N + n0 + 4 * (lane & 7);
#pragma unroll
        for (int i = 0; i < 8; ++i) w[i] = *(const GAS f32x4*)(src + (size_t)(8 * i) * N);
#pragma unroll
        for (int i = 0; i < 8; ++i) { LAS float* d = scr + (8 * i + (lane >> 3)) * 33 + 4 * (lane & 7); d[0] = w[i].x; d[1] = w[i].y; d[2] = w[i].z; d[3] = w[i].w; }
    }
    asm volatile("s_waitcnt lgkmcnt(0)" ::: "memory");
    const int c = lane & 7;
#pragma unroll
    for (int j = 0; j < 4; ++j) { const int n = (lane >> 3) + 8 * j; const LAS float* s = scr + (8 * c) * 33 + n;
        v4u o; o.x = pk2(s[0 * 33], s[1 * 33]); o.y = pk2(s[2 * 33], s[3 * 33]); o.z = pk2(s[4 * 33], s[5 * 33]); o.w = pk2(s[6 * 33], s[7 * 33]);
        const int nout = PERM ? rope_perm(n0 + n) : (n0 + n);
        *(GAS v4u*)(WT + (size_t)nout * K + k0 + 8 * c) = o; }
    asm volatile("s_waitcnt lgkmcnt(0)" ::: "memory");
}

template <int UNR = 2, int NN = 4>
__device__ __forceinline__ void sgemm_tile(f32x4 (&acc)[4][NN], const bf16* A, int lda, const bf16* Bt, int ldb, int K, int row0, int col0, int lane) {
    const int fr = lane & 15, fq = lane >> 4;
    const bf16* ap = A + (size_t)(row0 + fr) * lda + fq * 8;
    const bf16* bp = Bt + (size_t)(col0 + fr) * ldb + fq * 8;
#pragma unroll UNR
    for (int k = 0; k < K; k += 32) {
        bf16x8 a[4], b[NN];
#pragma unroll
        for (int m = 0; m < 4; ++m) a[m] = *(const GAS bf16x8*)(ap + (size_t)m * 16 * lda + k);
#pragma unroll
        for (int n = 0; n < NN; ++n) b[n] = *(const GAS bf16x8*)(bp + (size_t)n * 16 * ldb + k);
#pragma unroll
        for (int m = 0; m < 4; ++m)
#pragma unroll
            for (int n = 0; n < NN; ++n) acc[m][n] = __builtin_amdgcn_mfma_f32_16x16x32_bf16(a[m], b[n], acc[m][n], 0, 0, 0);
    }
}
template <int UNR>
__device__ __forceinline__ void sgemm32(f32x4 (&acc)[2][2], const bf16* A, int lda, const bf16* Bt, int ldb, int K, int row0, int col0, int lane) {
    const int fr = lane & 15, fq = lane >> 4;
    const bf16* ap = A + (size_t)(row0 + fr) * lda + fq * 8;
    const bf16* bp = Bt + (size_t)(col0 + fr) * ldb + fq * 8;
#pragma unroll 1
    for (int k0 = 0; k0 < K; k0 += 32 * UNR) {
        bf16x8 a[UNR][2], b[UNR][2];
#pragma unroll
        for (int u = 0; u < UNR; ++u)
#pragma unroll
            for (int m = 0; m < 2; ++m) { a[u][m] = *(const GAS bf16x8*)(ap + (size_t)m * 16 * lda + k0 + 32 * u); b[u][m] = *(const GAS bf16x8*)(bp + (size_t)m * 16 * ldb + k0 + 32 * u); }
#pragma unroll
        for (int u = 0; u < UNR; ++u)
#pragma unroll
            for (int m = 0; m < 2; ++m)
#pragma unroll
                for (int n = 0; n < 2; ++n) acc[m][n] = __builtin_amdgcn_mfma_f32_16x16x32_bf16(a[u][m], b[u][n], acc[m][n], 0, 0, 0);
    }
}
__device__ __forceinline__ void zero_acc22(f32x4 (&acc)[2][2]) { acc[0][0] = acc[0][1] = acc[1][0] = acc[1][1] = (f32x4){0.f, 0.f, 0.f, 0.f}; }
template <int NN>
__device__ __forceinline__ void zero_acc(f32x4 (&acc)[4][NN]) {
#pragma unroll
    for (int m = 0; m < 4; ++m)
#pragma unroll
        for (int n = 0; n < NN; ++n) acc[m][n] = (f32x4){0.f, 0.f, 0.f, 0.f};
}

__device__ __forceinline__ int f2ord(float f) { const int b = __builtin_bit_cast(int, f); return b ^ ((b >> 31) & 0x7fffffff); }
__device__ __forceinline__ float ord2f(int o) { const int b = o ^ ((o >> 31) & 0x7fffffff); return __builtin_bit_cast(float, b); }
__device__ __forceinline__ void top16_insert(int (&top)[16], int key) {
#pragma unroll
    for (int i = 0; i < 16; ++i) { const int hi = max(top[i], key); key = min(top[i], key); top[i] = hi; }
}
#define CE(a, b) { const int t_ = max(a, b); b = min(a, b); a = t_; }
__device__ __forceinline__ void sort16_desc(int (&v)[16]) { CE(v[0], v[1]); CE(v[3], v[2]); CE(v[4], v[5]); CE(v[7], v[6]); CE(v[8], v[9]); CE(v[11], v[10]); CE(v[12], v[13]); CE(v[15], v[14]); CE(v[0], v[2]); CE(v[1], v[3]); CE(v[6], v[4]); CE(v[7], v[5]); CE(v[8], v[10]); CE(v[9], v[11]); CE(v[14], v[12]); CE(v[15], v[13]); CE(v[0], v[1]); CE(v[2], v[3]); CE(v[5], v[4]); CE(v[7], v[6]); CE(v[8], v[9]); CE(v[10], v[11]); CE(v[13], v[12]); CE(v[15], v[14]); CE(v[0], v[4]); CE(v[1], v[5]); CE(v[2], v[6]); CE(v[3], v[7]); CE(v[12], v[8]); CE(v[13], v[9]); CE(v[14], v[10]); CE(v[15], v[11]); CE(v[0], v[2]); CE(v[1], v[3]); CE(v[4], v[6]); CE(v[5], v[7]); CE(v[10], v[8]); CE(v[11], v[9]); CE(v[14], v[12]); CE(v[15], v[13]); CE(v[0], v[1]); CE(v[2], v[3]); CE(v[4], v[5]); CE(v[6], v[7]); CE(v[9], v[8]); CE(v[11], v[10]); CE(v[13], v[12]); CE(v[15], v[14]); CE(v[0], v[8]); CE(v[1], v[9]); CE(v[2], v[10]); CE(v[3], v[11]); CE(v[4], v[12]); CE(v[5], v[13]); CE(v[6], v[14]); CE(v[7], v[15]); CE(v[0], v[4]); CE(v[1], v[5]); CE(v[2], v[6]); CE(v[3], v[7]); CE(v[8], v[12]); CE(v[9], v[13]); CE(v[10], v[14]); CE(v[11], v[15]); CE(v[0], v[2]); CE(v[1], v[3]); CE(v[4], v[6]); CE(v[5], v[7]); CE(v[8], v[10]); CE(v[9], v[11]); CE(v[12], v[14]); CE(v[13], v[15]); CE(v[0], v[1]); CE(v[2], v[3]); CE(v[4], v[5]); CE(v[6], v[7]); CE(v[8], v[9]); CE(v[10], v[11]); CE(v[12], v[13]); CE(v[14], v[15]); }
__device__ __forceinline__ void merge16_desc(int (&a)[16], const int (&b)[16]) {
#pragma unroll
    for (int i = 0; i < 16; ++i) a[i] = max(a[i], b[15 - i]);
    CE(a[0], a[8]); CE(a[1], a[9]); CE(a[2], a[10]); CE(a[3], a[11]); CE(a[4], a[12]); CE(a[5], a[13]); CE(a[6], a[14]); CE(a[7], a[15]); CE(a[0], a[4]); CE(a[1], a[5]); CE(a[2], a[6]); CE(a[3], a[7]); CE(a[8], a[12]); CE(a[9], a[13]); CE(a[10], a[14]); CE(a[11], a[15]); CE(a[0], a[2]); CE(a[1], a[3]); CE(a[4], a[6]); CE(a[5], a[7]); CE(a[8], a[10]); CE(a[9], a[11]); CE(a[12], a[14]); CE(a[13], a[15]); CE(a[0], a[1]); CE(a[2], a[3]); CE(a[4], a[5]); CE(a[6], a[7]); CE(a[8], a[9]); CE(a[10], a[11]); CE(a[12], a[13]); CE(a[14], a[15]); }
#undef CE


typedef float f32x16 __attribute__((ext_vector_type(16)));
typedef short s16x4 __attribute__((ext_vector_type(4)));
typedef __bf16 bf16x2_t __attribute__((ext_vector_type(2)));
__device__ __forceinline__ unsigned cvtpk(float lo, float hi) { f32x2 v = {lo, hi}; bf16x2_t b = __builtin_convertvector(v, bf16x2_t); return __builtin_bit_cast(unsigned, b); }
constexpr int CK_PITCH = 144, CV_PITCH = 320;
constexpr int CK_SZ = 64 * CK_PITCH, CV_SZ = 64 * CV_PITCH;
constexpr float C_THR_RAW = 8.0f / SCL2;

template <int NDV, bool HASCM, class RowFn, class UseFn, class ElemFn, class CmFn>
__device__ __forceinline__ void attn64_pass(f32x16 (&o)[NDV], float& mrun, float& lpart, const bf16x8 (&qf)[4], const bf16* kg, int kpitch, const bf16* vg, int vpitch,
                                            int ntiles, RowFn tile_row, UseFn use_tile, ElemFn elem, const f32x16 (&cm)[2], CmFn cm_tile, LAS unsigned char* L, int lane, int tid) {
    constexpr int VP = NDV * 64 + 64, VSZ = 64 * VP, NVP = NDV / 2;
    const int r32 = lane & 31, hi = lane >> 5;
    const int krow_s = tid >> 3, kch_s = tid & 7;
    const int vrow_s = (NDV == 2) ? (tid >> 3) : (tid >> 4), vch_s = (NDV == 2) ? (tid & 7) : (tid & 15);
    LAS unsigned char* Kb0 = L; LAS unsigned char* Vb0 = L + 2 * CK_SZ;
    __syncthreads();
    {
        const int tr = tile_row(0);
        const v4u kr = *(const GAS v4u*)(kg + (size_t)tr * kpitch);
        *(LAS v4u*)(Kb0 + krow_s * CK_PITCH + kch_s * 16) = kr;
#pragma unroll
        for (int i = 0; i < NVP; ++i) { const v4u v = *(const GAS v4u*)(vg + (size_t)(tr + 32 * i) * vpitch); *(LAS v4u*)(Vb0 + (vrow_s + 32 * i) * VP + vch_s * 16) = v; }
    }
    v4u kr, vr[NVP];
    { const int tr = tile_row(ntiles > 1 ? 1 : 0); kr = *(const GAS v4u*)(kg + (size_t)tr * kpitch);
#pragma unroll
      for (int i = 0; i < NVP; ++i) vr[i] = *(const GAS v4u*)(vg + (size_t)(tr + 32 * i) * vpitch); }
    __syncthreads();
#pragma unroll 1
    for (int j = 0; j < ntiles; ++j) {
        const int cur = j & 1;
        const LAS unsigned char* Kb = Kb0 + cur * CK_SZ; const LAS unsigned char* Vb = Vb0 + cur * VSZ;
        const bool more = (j + 1 < ntiles);
        v4u kr2, vr2[NVP];
        { const int tr = tile_row(j + 2 < ntiles ? j + 2 : ntiles - 1); kr2 = *(const GAS v4u*)(kg + (size_t)tr * kpitch);
#pragma unroll
            for (int i = 0; i < NVP; ++i) vr2[i] = *(const GAS v4u*)(vg + (size_t)(tr + 32 * i) * vpitch); }
        if (use_tile(j)) {
            f32x16 st[2];
            if (HASCM && cm_tile(j)) {
#pragma unroll
                for (int kb = 0; kb < 2; ++kb) {
#pragma unroll
                    for (int ks = 0; ks < 4; ++ks) {
                        const bf16x8 kf = *(const LAS bf16x8*)(Kb + (kb * 32 + r32) * CK_PITCH + ks * 32 + hi * 16);
                        st[kb] = __builtin_amdgcn_mfma_f32_32x32x16_bf16(kf, qf[ks], ks == 0 ? cm[kb] : st[kb], 0, 0, 0);
                    }
                }
            } else {
#pragma unroll
                for (int kb = 0; kb < 2; ++kb) {
#pragma unroll
                    for (int r = 0; r < 16; ++r) st[kb][r] = 0.f;
#pragma unroll
                    for (int ks = 0; ks < 4; ++ks) {
                        const bf16x8 kf = *(const LAS bf16x8*)(Kb + (kb * 32 + r32) * CK_PITCH + ks * 32 + hi * 16);
                        st[kb] = __builtin_amdgcn_mfma_f32_32x32x16_bf16(kf, qf[ks], st[kb], 0, 0, 0);
                    }
                }
            }
            elem(st, j);
            float mx = st[0][0];
#pragma unroll
            for (int r = 1; r < 16; ++r) mx = fmaxf(mx, st[0][r]);
#pragma unroll
            for (int r = 0; r < 16; ++r) mx = fmaxf(mx, st[1][r]);
            mx = xmax32(mx);
            if (__builtin_amdgcn_ballot_w64(mx > mrun + C_THR_RAW) != 0ull) {
                const float mn = fmaxf(mrun, mx);
                const float alpha = __builtin_amdgcn_exp2f((mrun - mn) * SCL2);
#pragma unroll
                for (int d = 0; d < NDV; ++d)
#pragma unroll
                    for (int r = 0; r < 16; ++r) o[d][r] *= alpha;
                lpart *= alpha; mrun = mn;
            }
            const float nmc = -mrun * SCL2;
            float ls = 0.f;
#pragma unroll
            for (int kb = 0; kb < 2; ++kb)
#pragma unroll
                for (int r = 0; r < 16; ++r) { const float p = __builtin_amdgcn_exp2f(fmaf(st[kb][r], SCL2, nmc)); st[kb][r] = p; ls += p; }
            lpart += ls;
            const int q4 = (lane & 15) >> 2, p4 = lane & 3, grp = (lane >> 4) & 1;
            const LAS unsigned char* vbase = Vb + (4 * hi + q4) * VP + (16 * grp + 4 * p4) * 2;
#pragma unroll
            for (int kb = 0; kb < 2; ++kb)
#pragma unroll
                for (int ss = 0; ss < 2; ++ss) {
                    v4u pw;
#pragma unroll
                    for (int i2 = 0; i2 < 4; ++i2) pw[i2] = cvtpk(st[kb][8 * ss + 2 * i2], st[kb][8 * ss + 2 * i2 + 1]);
                    const bf16x8 pb = __builtin_bit_cast(bf16x8, pw);
#pragma unroll
                    for (int d = 0; d < NDV; ++d) {
                        const LAS unsigned char* va = vbase + (kb * 32 + 16 * ss) * VP + d * 64;
                        const s16x4 lo = __builtin_bit_cast(s16x4, __builtin_amdgcn_ds_read_tr16_b64_v4i16((LAS s16x4*)va));
                        const s16x4 hh = __builtin_bit_cast(s16x4, __builtin_amdgcn_ds_read_tr16_b64_v4i16((LAS s16x4*)(va + 8 * VP)));
                        const bf16x8 vf = __builtin_shufflevector(lo, hh, 0, 1, 2, 3, 4, 5, 6, 7);
                        o[d] = __builtin_amdgcn_mfma_f32_32x32x16_bf16(vf, pb, o[d], 0, 0, 0);
                    }
                }
        }
        if (more) {
            LAS unsigned char* Kn = Kb0 + (cur ^ 1) * CK_SZ; LAS unsigned char* Vn = Vb0 + (cur ^ 1) * VSZ;
            *(LAS v4u*)(Kn + krow_s * CK_PITCH + kch_s * 16) = kr;
#pragma unroll
            for (int i = 0; i < NVP; ++i) *(LAS v4u*)(Vn + (vrow_s + 32 * i) * VP + vch_s * 16) = vr[i];
        }
        kr = kr2;
#pragma unroll
        for (int i = 0; i < NVP; ++i) vr[i] = vr2[i];
        __syncthreads();
    }
}
__device__ __forceinline__ void attn64_store(const f32x16 (&o)[2], float inv, bf16* yrow, int hi) {
#pragma unroll
    for (int d = 0; d < 2; ++d)
#pragma unroll
        for (int g4 = 0; g4 < 4; ++g4) {
            v2u w; w.x = cvtpk(o[d][4 * g4] * inv, o[d][4 * g4 + 1] * inv); w.y = cvtpk(o[d][4 * g4 + 2] * inv, o[d][4 * g4 + 3] * inv);
            *(GAS v2u*)(yrow + d * 32 + 8 * g4 + 4 * hi) = w;
        }
}

namespace pg8 {
typedef unsigned short bf16_t;
constexpr int BM = 256, BK = 64, HALF = 128, HTB = HALF * BK * 2, STAGE_BYTES = 8 * HTB, NXCD = 8, WGM = 8;
__host__ __device__ __forceinline__ int lds_byte(int r, int c) { const int st = (r >> 4) * 2 + (c >> 5), rr = r & 15, cc = c & 31, ob = rr * 64 + cc * 2; return st * 1024 + (ob ^ (((ob >> 9) & 1) << 5)); }
__host__ __device__ __forceinline__ void stage_rc(int b, int& R, int& C) { const int st = b / 1024, sb = b % 1024, swz = sb ^ (((sb >> 9) & 1) << 5); R = (st >> 1) * 16 + swz / 64; C = (st & 1) * 32 + (swz % 64) / 2; }
__host__ __device__ __forceinline__ int perm32(int rho) { const int n = rho >> 4, i = rho & 15; return 8 * (i >> 2) + 4 * n + (i & 3); }
struct Unit { int pm, pn, seg; };
struct Gemm { const bf16_t* A; const bf16_t* Bt; int lda, ldb, K; size_t a_seg, b_seg; };
struct TileOrder {
    int nM, nN, nwg, G, c;
    __device__ void init(int M, int N, int G_, int c_) { nM = M / BM; nN = N / BM; nwg = nM * nN; G = G_; c = c_; }
    __device__ bool tile(int i, int& pm, int& pn) const {
        const long L = (long)i * G + c; if (L >= nwg) return false;
        int wgid = (int)L; { const int q = nwg / NXCD, r = nwg % NXCD, xcd = wgid % NXCD, off = wgid / NXCD; wgid = (xcd < r ? xcd * (q + 1) : r * (q + 1) + (xcd - r) * q) + off; }
        const int nig = WGM * nN, gid = wgid / nig, fm = gid * WGM, gsz = (nM - fm) < WGM ? (nM - fm) : WGM;
        pm = fm + ((wgid % nig) % gsz); pn = (wgid % nig) / gsz; return true;
    }
};
template <int NSEG> struct SegOrder {
    TileOrder T;
    __device__ bool next(int i, Unit& u) const { u.seg = i % NSEG; return T.tile(i / NSEG, u.pm, u.pn); }
};
template <class Epi, class Sched>
__device__ __forceinline__ void gemm_phase(LAS unsigned char* lds, const Gemm g, const Sched& S, const Epi& E, int wid) {
    const int lane = lane_id_v(), tid = wid * 64 + lane,
              wr = wid >> 2, wc = wid & 3, fr = lane & 15, fq = lane >> 4;
    const int K = g.K, nt = K / BK;
    unsigned voffA[2], voffB[2];
#pragma unroll
    for (int i = 0; i < 2; ++i) { int R, C; stage_rc(tid * 16 + i * 8192, R, C); const int Rb = (R & ~31) + perm32(R & 31);
        voffA[i] = (unsigned)(R * g.lda + C) * 2u; voffB[i] = (unsigned)(Rb * g.ldb + C) * 2u; }
    const size_t kstep = (size_t)(BK * 2);
    const size_t hstepA = (size_t)HALF * g.lda * 2, hstepB = (size_t)HALF * g.ldb * 2;
    const unsigned ldsw = (unsigned)wid * 1024u;
    const int aoff = lds_byte(wr * 64 + fr, fq * 8), boff = lds_byte(wc * 32 + fr, fq * 8);
#define PG8_SA(b, h) (((b) * 2 + (h)) * HTB)
#define PG8_SB(b, h) ((4 + (b) * 2 + (h)) * HTB)
#define PG8_STAGE(bufoff, gbase, voff) do { _Pragma("unroll") for (int _i = 0; _i < 2; ++_i) \
        __builtin_amdgcn_global_load_lds((const unsigned*)((const char*)(gbase) + (voff)[_i]), (LAS unsigned*)(lds + (bufoff) + ldsw + _i * 8192), 16, 0, 0); } while (0)
#define PG8_LDA(dst, b, h) do { _Pragma("unroll") for (int m = 0; m < 4; ++m) _Pragma("unroll") for (int k = 0; k < 2; ++k) dst[m][k] = *(const LAS bf16x8*)(lds + PG8_SA(b, h) + aoff + m * 2048 + k * 1024); } while (0)
#define PG8_LDB(dst, b, h) do { _Pragma("unroll") for (int n = 0; n < 2; ++n) _Pragma("unroll") for (int k = 0; k < 2; ++k) dst[n][k] = *(const LAS bf16x8*)(lds + PG8_SB(b, h) + boff + n * 2048 + k * 1024); } while (0)
#define PG8_MMA(ai, bj, At, Bt) do { __builtin_amdgcn_s_setprio(1); _Pragma("unroll") for (int m = 0; m < 4; ++m) _Pragma("unroll") for (int n = 0; n < 2; ++n) _Pragma("unroll") for (int k = 0; k < 2; ++k) \
        acc[ai][bj][m][n] = __builtin_amdgcn_mfma_f32_16x16x32_bf16(Bt[n][k], At[m][k], acc[ai][bj][m][n], 0, 0, 0); __builtin_amdgcn_s_setprio(0); } while (0)
#define PG8_WAIT_V(n) asm volatile("s_waitcnt vmcnt(" #n ")" ::: "memory")
#define PG8_WAIT_L(n) asm volatile("s_waitcnt lgkmcnt(" #n ")" ::: "memory")
#define PG8_BAR __builtin_amdgcn_s_barrier()
#define PG8_SCHED __builtin_amdgcn_sched_barrier(0)
#define PG8_ABASE(u) ((const char*)g.A + ((size_t)(u).seg * g.a_seg + (size_t)(u).pm * BM * g.lda) * 2)
#define PG8_BBASE(u) ((const char*)g.Bt + ((size_t)(u).seg * g.b_seg + (size_t)(u).pn * BM * g.ldb) * 2)
    Unit cur, nxt; int ui = 0;
    if (!S.next(0, cur)) return;
    f32x4 acc[2][2][4][2];
#pragma unroll
    for (int a = 0; a < 2; ++a)
#pragma unroll
        for (int b = 0; b < 2; ++b)
#pragma unroll
            for (int m = 0; m < 4; ++m)
#pragma unroll
                for (int n = 0; n < 2; ++n) acc[a][b][m][n] = (f32x4){0.f, 0.f, 0.f, 0.f};
    bf16x8 At[4][2], B0[2][2], B1[2][2];
    const char* cA = PG8_ABASE(cur); const char* cB = PG8_BBASE(cur);
    PG8_STAGE(PG8_SB(0, 0), cB, voffB); PG8_STAGE(PG8_SB(0, 1), cB + hstepB, voffB); PG8_STAGE(PG8_SA(0, 0), cA, voffA); PG8_STAGE(PG8_SA(0, 1), cA + hstepA, voffA);
    if (wr == 1) PG8_BAR;
    PG8_WAIT_V(2); PG8_BAR;
    PG8_STAGE(PG8_SB(1, 0), cB + kstep, voffB); PG8_STAGE(PG8_SA(1, 0), cA + kstep, voffA); PG8_STAGE(PG8_SB(1, 1), cB + hstepB + kstep, voffB);
    PG8_WAIT_V(6); PG8_BAR;
    for (;;) {
        const bool has_next = S.next(ui + 1, nxt);
        const char* nA = has_next ? PG8_ABASE(nxt) : cA; const char* nB = has_next ? PG8_BBASE(nxt) : cB;
        for (int t = 0; t < nt; t += 2) {
            const bool lastk = (t == nt - 2);
            const char* a1 = cA + (size_t)(t + 1) * kstep;
            const char* a2 = lastk ? nA : cA + (size_t)(t + 2) * kstep; const char* b2 = lastk ? nB : cB + (size_t)(t + 2) * kstep;
            const char* a3 = a2 + kstep; const char* b3 = b2 + kstep;
            PG8_LDB(B0, 0, 0); PG8_LDB(B1, 0, 1); PG8_SCHED; PG8_LDA(At, 0, 0); PG8_STAGE(PG8_SA(1, 1), a1 + hstepA, voffA);
            PG8_WAIT_V(8); PG8_WAIT_L(0); PG8_BAR; PG8_MMA(0, 0, At, B0); PG8_MMA(0, 1, At, B1); PG8_BAR; PG8_SCHED;
            PG8_LDA(At, 0, 1); PG8_STAGE(PG8_SB(0, 0), b2, voffB); PG8_STAGE(PG8_SB(0, 1), b2 + hstepB, voffB); PG8_STAGE(PG8_SA(0, 0), a2, voffA);
            PG8_WAIT_V(8); PG8_WAIT_L(0); PG8_BAR; PG8_MMA(1, 0, At, B0); PG8_MMA(1, 1, At, B1); PG8_BAR; PG8_SCHED;
            PG8_LDB(B0, 1, 0); PG8_LDB(B1, 1, 1); PG8_SCHED; PG8_LDA(At, 1, 0); PG8_STAGE(PG8_SA(0, 1), a2 + hstepA, voffA);
            PG8_WAIT_V(8); PG8_WAIT_L(0); PG8_BAR; PG8_MMA(0, 0, At, B0); PG8_MMA(0, 1, At, B1); PG8_BAR; PG8_SCHED;
            PG8_LDA(At, 1, 1); PG8_STAGE(PG8_SB(1, 0), b3, voffB); PG8_STAGE(PG8_SB(1, 1), b3 + hstepB, voffB); PG8_STAGE(PG8_SA(1, 0), a3, voffA);
            PG8_WAIT_V(8); PG8_WAIT_L(0); PG8_BAR; PG8_MMA(1, 0, At, B0); PG8_MMA(1, 1, At, B1); PG8_BAR; PG8_SCHED;
        }
        if (wr == 0) PG8_BAR;
        E(acc, cur, wr, wc, fr, fq);
        if (!has_next) break;
#pragma unroll
        for (int a = 0; a < 2; ++a)
#pragma unroll
            for (int b = 0; b < 2; ++b)
#pragma unroll
                for (int m = 0; m < 4; ++m)
#pragma unroll
                    for (int n = 0; n < 2; ++n) acc[a][b][m][n] = (f32x4){0.f, 0.f, 0.f, 0.f};
        cur = nxt; cA = nA; cB = nB; ++ui;
        if (wr == 1) PG8_BAR;
    }
    PG8_WAIT_V(0);
    PG8_BAR;
#undef PG8_SA
#undef PG8_SB
#undef PG8_STAGE
#undef PG8_LDA
#undef PG8_LDB
#undef PG8_MMA
#undef PG8_WAIT_V
#undef PG8_WAIT_L
#undef PG8_BAR
#undef PG8_SCHED
#undef PG8_ABASE
#undef PG8_BBASE
}
}

__device__ __forceinline__ v4u pack8(const f32x4& a, const f32x4& b) { v4u w; w.x = cvtpk(a.x, a.y); w.y = cvtpk(a.z, a.w); w.z = cvtpk(b.x, b.y); w.w = cvtpk(b.z, b.w); return w; }
struct EpiInProj {
    bf16 *AQ, *AK, *AVT, *BQ, *BK, *BVT, *CQ, *CK, *CV, *SG; const float *COS, *SIN;
    __device__ __forceinline__ void operator()(const f32x4 (&acc)[2][2][4][2], const pg8::Unit& u, int wr, int wc, int fr, int fq) const {
        asm volatile("" : "+v"(fr), "+v"(fq));
#pragma unroll
        for (int bj = 0; bj < 2; ++bj) {
            const int cblk = u.pn * 256 + bj * 128;
            const int cw = wc * 32 + 8 * fq;
            bf16* dst; int pitch, cbase; int kind;
            int nh = 1, hd = 0; float qs = 1.0f;
            if (cblk < 512)       { dst = AQ; pitch = 512; cbase = cblk; kind = 1; }
            else if (cblk < 640)  { dst = AK; pitch = 128; cbase = cblk - 512; kind = 1; }
            else if (cblk < 768)  { dst = AVT; pitch = 128; cbase = cblk - 640; kind = 0; }
            else if (cblk < 1280) { dst = BQ; pitch = 512; cbase = cblk - 768; kind = 0; }
            else if (cblk < 1792) { dst = BK; pitch = 512; cbase = cblk - 1280; kind = 0; }
            else if (cblk < 2304) { dst = BVT; pitch = 512; cbase = cblk - 1792; kind = 0; }
            else if (cblk < 2816) { dst = CQ; pitch = 512; cbase = cblk - 2304; kind = 1; qs = SCL2; }
            else if (cblk < 3328) { dst = CK; pitch = 512; cbase = cblk - 2816; kind = 1; }
            else if (cblk < 3840) { dst = CV; pitch = 512; cbase = cblk - 3328; kind = 0; }
            else                  { dst = SG; pitch = 3072; cbase = cblk - 3840; kind = 3; }
#pragma unroll
            for (int ai = 0; ai < 2; ++ai)
#pragma unroll
                for (int m = 0; m < 4; ++m) {
                    const int row = u.pm * 256 + ai * 128 + wr * 64 + m * 16 + fr;
                    f32x4 v0 = acc[ai][bj][m][0], v1 = acc[ai][bj][m][1];
                    if (kind == 1) {
                        if (row < T_LAT) {
                            const int t = row & (SEQ - 1), i0 = (cw & 63) >> 1;
                            const f32x4 cs = *(const GAS f32x4*)(COS + t * 32 + i0), sn = *(const GAS f32x4*)(SIN + t * 32 + i0);
                            const f32x4 a = v0, b = v1;
                            v0.x = a.x * cs.x - a.y * sn.x; v0.y = a.y * cs.x + a.x * sn.x; v0.z = a.z * cs.y - a.w * sn.y; v0.w = a.w * cs.y + a.z * sn.y;
                            v1.x = b.x * cs.z - b.y * sn.z; v1.y = b.y * cs.z + b.x * sn.z; v1.z = b.z * cs.w - b.w * sn.w; v1.w = b.w * cs.w + b.z * sn.w;
                        }
                        *(GAS v4u*)(dst + (size_t)row * pitch + cbase + cw) = pack8(v0 * qs, v1 * qs);
                    } else if (kind == 0) {
                        *(GAS v4u*)(dst + (size_t)row * pitch + cbase + cw) = pack8(v0, v1);
                    } else if (kind == 3) {
                        v0.x = sigmoid_fast(v0.x); v0.y = sigmoid_fast(v0.y); v0.z = sigmoid_fast(v0.z); v0.w = sigmoid_fast(v0.w);
                        v1.x = sigmoid_fast(v1.x); v1.y = sigmoid_fast(v1.y); v1.z = sigmoid_fast(v1.z); v1.w = sigmoid_fast(v1.w);
                        *(GAS v4u*)(dst + (size_t)row * pitch + cbase + cw) = pack8(v0, v1);
                    } else {
                        const int hc = hd + cw, head = hc >> 6, d = hc & 63;
                        const int b = row_batch(row), tok = row_tok(row);
                        bf16* vp = dst + ((size_t)(b * nh + head) * 64 + d) * NTOK + tok;
                        vp[0 * NTOK] = (bf16)f2bf(v0.x); vp[1 * NTOK] = (bf16)f2bf(v0.y); vp[2 * NTOK] = (bf16)f2bf(v0.z); vp[3 * NTOK] = (bf16)f2bf(v0.w);
                        vp[4 * NTOK] = (bf16)f2bf(v1.x); vp[5 * NTOK] = (bf16)f2bf(v1.y); vp[6 * NTOK] = (bf16)f2bf(v1.z); vp[7 * NTOK] = (bf16)f2bf(v1.w);
                    }
                }
        }
    }
};
__device__ __forceinline__ void unpack8(const v4u& w, f32x4& a, f32x4& b) {
    a = (f32x4){bf2f(w.x & 0xffffu), bf2f(w.x >> 16), bf2f(w.y & 0xffffu), bf2f(w.y >> 16)}; b = (f32x4){bf2f(w.z & 0xffffu), bf2f(w.z >> 16), bf2f(w.w & 0xffffu), bf2f(w.w >> 16)};
}
struct EpiBranch {
    const bf16* SG; bf16* MG;
    __device__ __forceinline__ void operator()(const f32x4 (&acc)[2][2][4][2], const pg8::Unit& u, int wr, int wc, int fr, int fq) const {
        asm volatile("" : "+v"(fr), "+v"(fq));
        const size_t r0 = (size_t)(u.pm * 256 + wr * 64 + fr); const int c0 = u.pn * 256 + wc * 32 + 8 * fq;
        const bf16* gbase = SG + r0 * 3072 + u.seg * 1024 + c0; bf16* mbase = MG + r0 * D + c0;
#pragma unroll
        for (int ai = 0; ai < 2; ++ai) {
            v4u wg[8], wp[8];
#pragma unroll
            for (int c = 0; c < 8; ++c) wg[c] = *(const GAS v4u*)(gbase + (size_t)(ai * 128 + (c >> 1) * 16) * 3072 + (c & 1) * 128);
            if (u.seg > 0) {
#pragma unroll
                for (int c = 0; c < 8; ++c) wp[c] = *(const GAS v4u*)(mbase + (size_t)(ai * 128 + (c >> 1) * 16) * D + (c & 1) * 128);
            }
#pragma unroll
            for (int c = 0; c < 8; ++c) {
                f32x4 g0, g1; unpack8(wg[c], g0, g1);
                f32x4 v0 = g0 * acc[ai][c & 1][c >> 1][0], v1 = g1 * acc[ai][c & 1][c >> 1][1];
                if (u.seg > 0) { f32x4 p0, p1; unpack8(wp[c], p0, p1); v0 += p0; v1 += p1; }
                *(GAS v4u*)(mbase + (size_t)(ai * 128 + (c >> 1) * 16) * D + (c & 1) * 128) = pack8(v0, v1);
            }
        }
    }
};
struct EpiOut {
    float* X; const float* gtl; const float* xin; const float* cin;
    __device__ __forceinline__ void operator()(const f32x4 (&acc)[2][2][4][2], const pg8::Unit& u, int wr, int wc, int fr, int fq) const {
        asm volatile("" : "+v"(fr), "+v"(fq));
#pragma unroll
        for (int ai = 0; ai < 2; ++ai)
#pragma unroll
            for (int m = 0; m < 4; ++m) {
                const int row = u.pm * 256 + ai * 128 + wr * 64 + m * 16 + fr;
                const float* gt = gtl + (size_t)row_modidx(row) * 6 * D + 2 * D;
#pragma unroll
                for (int bj = 0; bj < 2; ++bj) {
                    const int col = u.pn * 256 + bj * 128 + wc * 32 + 8 * fq;
                    GAS f32x4* xp = (GAS f32x4*)(X + (size_t)row * D + col);
                    const GAS f32x4* sp = xin ? (const GAS f32x4*)(xin_row(xin, cin, row) + col) : (const GAS f32x4*)xp;
                    const f32x4 g0 = *(const GAS f32x4*)(gt + col), g1 = *(const GAS f32x4*)(gt + col + 4);
                    xp[0] = sp[0] + g0 * acc[ai][bj][m][0]; xp[1] = sp[1] + g1 * acc[ai][bj][m][1];
                }
            }
    }
};
struct EpiStore {
    bf16* O; int ldc;
    __device__ __forceinline__ void operator()(const f32x4 (&acc)[2][2][4][2], const pg8::Unit& u, int wr, int wc, int fr, int fq) const {
        asm volatile("" : "+v"(fr), "+v"(fq));
#pragma unroll
        for (int ai = 0; ai < 2; ++ai)
#pragma unroll
            for (int m = 0; m < 4; ++m) {
                const int row = u.pm * 256 + ai * 128 + wr * 64 + m * 16 + fr;
#pragma unroll
                for (int bj = 0; bj < 2; ++bj) {
                    const int col = u.pn * 256 + bj * 128 + wc * 32 + 8 * fq;
                    *(GAS v4u*)(O + (size_t)row * ldc + col) = pack8(acc[ai][bj][m][0], acc[ai][bj][m][1]);
                }
            }
    }
};

__global__ void __launch_bounds__(NTHREADS, 2) mega_fwd(Args args) {
    extern __shared__ __attribute__((aligned(16))) unsigned char lds[];
    LAS unsigned char* L = (LAS unsigned char*)lds;
    volatile LAS unsigned* MISC = (volatile LAS unsigned*)(L + MISC_OFF);
    const int wave = __builtin_amdgcn_readfirstlane((int)threadIdx.x >> 6);
    const int lane = lane_id_v(), tid = wave * 64 + lane;
    const int fr = lane & 15, fq = lane >> 4;
    const int G = gridDim.x;
    const int vcu = (G % 8 == 0) ? (int)(blockIdx.x % 8) * (G / 8) + (int)(blockIdx.x / 8) : (int)blockIdx.x;
    for (int u = tid; u < (LDS_BYTES - 131072) / 4; u += NTHREADS) ((LAS unsigned*)(L + 131072))[u] = 0u;
    __syncthreads();
    unsigned char* ws = args.ws;
    gu32* ctl = (gu32*)(ws + WS_CTL);
    (void)xcd_barrier_post((unsigned*)(ctl + CW_BAR), MISC + 8);
    if (tid == 0) MISC[12] = xb_add((unsigned*)(ctl + CW_RANK) + 64 * xb_xcc_id(), 1u);
    __syncthreads();
#define GRID_BAR() do { unsigned* bp_ = (unsigned*)(args.ws + WS_CTL) + CW_BAR; asm volatile("" : "+s"(bp_)); XcdBarrier b_; b_.bar = bp_; b_.x = xb_xcc_id(); b_.st = MISC + 8; xcd_barrier(b_, wave == 0 && lane_id_v() == 0); } while (0)
    const int gw = vcu * NWAVES + wave, NGW = G * NWAVES;
    const int NGT = G * NTHREADS;

#define PHASE_PTRS \
    unsigned char* wsq = args.ws; asm volatile("" : "+s"(wsq)); \
    const float* const* IN_ = (const float* const*)__builtin_amdgcn_kernarg_segment_ptr(); asm volatile("" : "+s"(IN_)); \
    float* MODV = (float*)(wsq + WS_MOD); float* COS = (float*)(wsq + WS_COS); float* SIN = (float*)(wsq + WS_SIN); \
    bf16* WIN = (bf16*)(wsq + WS_WIN); bf16* WB = (bf16*)(wsq + WS_WB); bf16* WO = (bf16*)(wsq + WS_WO); bf16* WQ = (bf16*)(wsq + WS_WQ); bf16* KEYS = (bf16*)(wsq + WS_KEYS); \
    float* X = (float*)(wsq + WS_X); bf16* H = (bf16*)(wsq + WS_H); bf16* Y = (bf16*)(wsq + WS_Y); bf16* MG = (bf16*)(wsq + WS_MG); \
    unsigned* EI = (unsigned*)(wsq + WS_EI); float* EG = (float*)(wsq + WS_EG); \
    unsigned char* U8 = wsq + WS_U8; unsigned char* V8 = wsq + WS_V8; float* SCU = (float*)(wsq + WS_SCU); float* SCV = SCU + DEPTH * 16384; \
    bf16* AQ = (bf16*)(wsq + WS_AQ); bf16* AK = (bf16*)(wsq + WS_AK); bf16* AVT = (bf16*)(wsq + WS_AVT); \
    bf16* BQ = (bf16*)(wsq + WS_BQ); bf16* BK = (bf16*)(wsq + WS_BK); bf16* BVT = (bf16*)(wsq + WS_BVT); \
    bf16* CQ = (bf16*)(wsq + WS_CQ); bf16* CK = (bf16*)(wsq + WS_CK); bf16* CVT = (bf16*)(wsq + WS_CVT); \
    bf16* SG = (bf16*)(wsq + WS_SG); bf16* Q2 = (bf16*)(wsq + WS_Q2); float* SC = (float*)(wsq + WS_SC); \
    (void)MODV; (void)COS; (void)SIN; (void)WIN; (void)WB; (void)WO; (void)WQ; (void)KEYS; (void)X; (void)H; (void)Y; (void)MG; (void)EI; (void)EG; (void)U8; (void)V8; (void)SCU; (void)SCV; \
    (void)AQ; (void)AK; (void)AVT; (void)BQ; (void)BK; (void)BVT; (void)CQ; (void)CK; (void)CVT; (void)SG; (void)Q2; (void)SC; (void)IN_;
#define LAYER_PTRS const float* modl = MODV + (size_t)layer * 3 * 6 * D; const bf16* WINl = WIN + (size_t)layer * IN_W * D; (void)modl; (void)WINl;

#ifndef SKIP_P0
        { PHASE_PTRS
        for (int rep_ = 0; rep_ < REP_P0; ++rep_) {
    {
        LAS float* scr = (LAS float*)(L + wave * 16384);
        int gt = vcu * NTHREADS + tid; asm volatile("" : "+v"(gt));
        constexpr int I_IN = (D / 64) * (IN_W / 32), I_BR = (512 / 64) * (D / 32), I_O = (D / 64) * (D / 32), I_Q = (D / 64) * (2048 / 32);
        constexpr int PER_LAYER = I_IN + 3 * I_BR + I_O + I_Q;
        for (int rp_ = 0; rp_ < REP_P0A; ++rp_)
        for (int it = gw; it < DEPTH * PER_LAYER; it += NGW) {
            const int l = it / PER_LAYER; int r = it % PER_LAYER;
            if (r < I_IN) { p0_transpose_item<true>(IN_[I_WIN] + (size_t)l * D * IN_W, D, IN_W, WIN + (size_t)l * IN_W * D, scr, r, lane); continue; } r -= I_IN;
            if (r < I_BR) { p0_transpose_item(IN_[I_WBA] + (size_t)l * 512 * D, 512, D, WB + (size_t)(l * 3 + 0) * D * 512, scr, r, lane); continue; } r -= I_BR;
            if (r < I_BR) { p0_transpose_item(IN_[I_WBB] + (size_t)l * 512 * D, 512, D, WB + (size_t)(l * 3 + 1) * D * 512, scr, r, lane); continue; } r -= I_BR;
            if (r < I_BR) { p0_transpose_item(IN_[I_WBC] + (size_t)l * 512 * D, 512, D, WB + (size_t)(l * 3 + 2) * D * 512, scr, r, lane); continue; } r -= I_BR;
            if (r < I_O) { p0_transpose_item(IN_[I_WOUT] + (size_t)l * D * D, D, D, WO + (size_t)l * D * D, scr, r, lane); continue; } r -= I_O;
            p0_transpose_item(IN_[I_PWQ] + (size_t)l * D * 2048, D, 2048, WQ + (size_t)l * 2048 * D, scr, r, lane);
        }
        for (int i = gt; i < DEPTH * 16 * 128 * 128 / 4; i += NGT) {
            const f32x4 v = *((const GAS f32x4*)IN_[I_PKEYS] + i);
            v2u o; o.x = pk2(v.x, v.y); o.y = pk2(v.z, v.w); *((GAS v2u*)KEYS + i) = o;
        }
        {
            LAS float* red = (LAS float*)(L + 9216);
            for (int rp_ = 0; rp_ < REP_P0D; ++rp_)
            for (int it = vcu; it < DEPTH * 96; it += G) {
                const int l = it / 96, nc = it % 96, n = nc * 64 + lane;
                const float* wm = IN_[I_WMOD] + (size_t)l * D * 6 * D + n;
                float a0 = 0.f, a1 = 0.f, a2 = 0.f;
#pragma unroll 1
                for (int half = 0; half < 2; ++half) {
                    const int kb = wave * 128 + half * 64;
                    const float c0 = IN_[I_C][kb + lane], c1 = IN_[I_C][D + kb + lane], c2 = IN_[I_CCTX][kb + lane];
                    const int s0 = __builtin_bit_cast(int, c0 * sigmoidf_(c0)), s1 = __builtin_bit_cast(int, c1 * sigmoidf_(c1)), s2 = __builtin_bit_cast(int, c2 * sigmoidf_(c2));
#pragma unroll
                    for (int kk = 0; kk < 64; ++kk) {
                        const float w = wm[(size_t)(kb + kk) * 6 * D];
                        a0 += __builtin_bit_cast(float, __builtin_amdgcn_readlane(s0, kk)) * w;
                        a1 += __builtin_bit_cast(float, __builtin_amdgcn_readlane(s1, kk)) * w;
                        a2 += __builtin_bit_cast(float, __builtin_amdgcn_readlane(s2, kk)) * w;
                    }
                }
                red[(wave * 3 + 0) * 64 + lane] = a0; red[(wave * 3 + 1) * 64 + lane] = a1; red[(wave * 3 + 2) * 64 + lane] = a2;
                __syncthreads();
                if (wave < 3) {
                    float sum = IN_[I_BMOD][l * 6 * D + n];
#pragma unroll
                    for (int w = 0; w < 8; ++w) sum += red[(w * 3 + wave) * 64 + lane];
                    MODV[(size_t)(l * 3 + wave) * 6 * D + n] = sum;
                }
                __syncthreads();
            }
        }
        for (int i = gt; i < SEQ * 32; i += NGT) {
            const int t = i >> 5, f = i & 31;
            const float inv = exp2f(-(float)(f & 15) * (13.287712379549449f / 16.0f));
            const float pos = (f < 16) ? (float)(t / GRID_W) : (float)(t % GRID_W);
            float sn, cs; sincosf(pos * inv, &sn, &cs);
            COS[i] = cs; SIN[i] = sn;
        }
    }
        for (int rp_ = 0; rp_ < REP_P0F; ++rp_)
#pragma unroll 4
        for (int rr = gw; rr < 2 * DEPTH * 16384; rr += NGW) {
            const int tab = rr / (DEPTH * 16384), row = rr % (DEPTH * 16384);
            const float* src = (tab == 0 ? IN_[I_PU] : IN_[I_PV]) + (size_t)row * D;
            f32x4 v[4]; float am = 0.f;
#pragma unroll
            for (int j = 0; j < 4; ++j) { v[j] = *((const GAS f32x4*)src + lane + 64 * j); am = fmaxf(am, fmaxf(fmaxf(fabsf(v[j].x), fabsf(v[j].y)), fmaxf(fabsf(v[j].z), fabsf(v[j].w)))); }
            am = wave_max(am);
            const bool as_i8 = (P10_SLICED != 0) && (tab == 0);
            int ex = 0; float scale = 1.0f;
            if (am > 0.f) { (void)frexpf(am * (as_i8 ? (1.0f / 127.0f) : (1.0f / 448.0f)), &ex); scale = ldexpf(1.0f, ex); }
            const float inv = 1.0f / scale;
            v4u o;
#pragma unroll
            for (int j = 0; j < 4; ++j) {
                if (as_i8) {
                    const int q0 = __float2int_rn(v[j].x * inv), q1 = __float2int_rn(v[j].y * inv), q2 = __float2int_rn(v[j].z * inv), q3 = __float2int_rn(v[j].w * inv);
                    o[j] = (unsigned)(q0 & 255) | ((unsigned)(q1 & 255) << 8) | ((unsigned)(q2 & 255) << 16) | ((unsigned)q3 << 24);
                } else {
                    int p = __builtin_amdgcn_cvt_pk_fp8_f32(v[j].x * inv, v[j].y * inv, 0, false);
                    p = __builtin_amdgcn_cvt_pk_fp8_f32(v[j].z * inv, v[j].w * inv, p, true);
                    o[j] = (unsigned)p;
                }
            }
            *((GAS v4u*)((tab == 0 ? U8 : V8) + (size_t)row * D) + lane) = o;
            if (lane == 0) (tab == 0 ? SCU : SCV)[row] = scale;
        }
        }
        }
#endif
    GRID_BAR();

    for (int layer = 0; layer < DEPTH; ++layer) {
        const bool last = (layer == DEPTH - 1);
        const int T_EFF = last ? T_LAT : T_ALL;

#ifndef SKIP_P1
        { PHASE_PTRS LAYER_PTRS
        for (int rep_ = 0; rep_ < REP_P1; ++rep_) {
        { const int ln = lane_id_v();
        if (layer == 0) {
            f32x4 gm[4], shv[4];
            auto prep = [&](int midx) { const float* md = modl + (size_t)midx * 6 * D;
#pragma unroll
                for (int j = 0; j < 4; ++j) { const f32x4 g = *((const GAS f32x4*)(IN_[I_G1] + layer * D) + ln + 64 * j); const f32x4 sc = *((const GAS f32x4*)(md + D) + ln + 64 * j);
                    gm[j] = g * (sc + 1.0f); shv[j] = *((const GAS f32x4*)(md + 0) + ln + 64 * j); } };
            auto row = [&](int r) {
                const GAS f32x4* xr = (const GAS f32x4*)xin_row(IN_[I_X], IN_[I_CTX], r) + ln;
                f32x4 v[4]; float ss = 0.f;
#pragma unroll
                for (int j = 0; j < 4; ++j) { v[j] = xr[64 * j]; ss += (v[j].x * v[j].x + v[j].y * v[j].y) + (v[j].z * v[j].z + v[j].w * v[j].w); }
                const float rs = 1.0f / sqrtf(wave_sum(ss) * (1.f / D) + NORM_EPS);
                GAS v2u* o8 = (GAS v2u*)(H + (size_t)r * D) + ln;
#pragma unroll
                for (int j = 0; j < 4; ++j) { const f32x4 h = v[j] * rs * gm[j] + shv[j]; v2u o; o.x = pk2(h.x, h.y); o.y = pk2(h.z, h.w); o8[64 * j] = o; } };
            wave_row_blocks(T_ALL, gw, NGW, prep, row);
        }
        }
        }
        }
#endif
        if (layer == 0) GRID_BAR();

#ifndef SKIP_P2
        { PHASE_PTRS LAYER_PTRS
        for (int rep_ = 0; rep_ < REP_P2; ++rep_) {
        {
            pg8::Gemm g{H, WINl, D, D, D, 0, 0};
            pg8::SegOrder<1> S; S.T.init(T_ALL, IN_W, G, (int)blockIdx.x);
            EpiInProj E{AQ, AK, AVT, BQ, BK, BVT, CQ, CK, CVT, SG, COS, SIN};
            pg8::gemm_phase(L, g, S, E, wave);
        }
        }
        }
#endif
        GRID_BAR();

#ifndef SKIP_P3
        { PHASE_PTRS LAYER_PTRS
        {
            LAS bf16* Pl = (LAS bf16*)(L + wave * 8192);
            const float lam_init = 0.8f - 0.6f * expf(-0.3f * (float)layer);
            float lam;
            {
                const int ll = lane_id_v();
                const float* cl = IN_[I_LAMBDA] + layer * 256;
                const float s1 = wave_sum(cl[ll] * cl[64 + ll]), s2 = wave_sum(cl[128 + ll] * cl[192 + ll]);
                lam = expf(s1) - expf(s2) + lam_init;
            }
{ const int lo__ = lane_id_v(); { const int lane = lo__; const int fr = lane & 15, fq = lane >> 4, tid = wave * 64 + lane; (void)fr; (void)fq; (void)tid;
            {
                const int r32 = lane & 31, hi = lane >> 5;
                const int n_lat = BATCH * 4 * (SEQ / 256), n_ctx = last ? 0 : BATCH * 4;
                const int NU = (n_lat + G - 1) / G * G + n_ctx;
                for (int rep_ = 0; rep_ < REP_P3C; ++rep_)
                for (int u0 = vcu; u0 < NU; u0 += G) {
                    int b, h, row0, t_lo, t_hi;
                    if (u0 < n_lat) { const int bh = u0 >> 5; b = bh >> 2; h = bh & 3; row0 = b * SEQ + (u0 & 31) * 256; t_lo = 0; t_hi = 132; }
                    else { const int c = u0 - (n_lat + G - 1) / G * G; if (c < 0 || c >= n_ctx) continue; b = c >> 2; h = c & 3; row0 = T_LAT + b * CTX; t_lo = 128; t_hi = 132; }
                    const int qrow = row0 + wave * 32 + r32;
                    LAS unsigned* o1p = (LAS unsigned*)(L + 65536 + wave * 8192) + lane;
                    const int krow_s = tid >> 3, kch_s = tid & 7;
                    const int vrow_s0 = tid >> 4, vch_s = tid & 15;
                    LAS unsigned char* Kb0 = L; LAS unsigned char* Vb0 = L + 2 * CK_SZ;
#pragma unroll 1
                    for (int m = 0; m < 2; ++m) {
                        bf16x8 qf[4];
                        { const bf16* qp = CQ + (size_t)qrow * 512 + (h * 2 + m) * 64 + hi * 8;
#pragma unroll
                          for (int ks = 0; ks < 4; ++ks) qf[ks] = *(const GAS bf16x8*)(qp + ks * 16); }
                        f32x16 o[4];
#pragma unroll
                        for (int d = 0; d < 4; ++d)
#pragma unroll
                            for (int r = 0; r < 16; ++r) o[d][r] = 0.f;
                        float lpart;
                        f32x16 cb;
                        v4u pp[4];
                        const bf16* kg = CK + (size_t)krow_s * 512 + (h * 2 + m) * 64 + kch_s * 8;
                        const bf16* vg = CVT + (size_t)vrow_s0 * 512 + h * 128 + vch_s * 8;
                        auto tile_row = [&](int j) { return (j < 128) ? b * SEQ + 64 * j : T_LAT + b * CTX + 64 * (j - 128); };
                        __syncthreads();
                        {
                            const size_t kb = (size_t)tile_row(t_lo) * 512;
                            const v4u kr = *(const GAS v4u*)(kg + kb), v0 = *(const GAS v4u*)(vg + kb), v1 = *(const GAS v4u*)(vg + kb + 32 * 512);
                            *(LAS v4u*)(Kb0 + krow_s * CK_PITCH + kch_s * 16) = kr;
                            *(LAS v4u*)(Vb0 + vrow_s0 * CV_PITCH + vch_s * 16) = v0; *(LAS v4u*)(Vb0 + (vrow_s0 + 32) * CV_PITCH + vch_s * 16) = v1;
                        }
                        __syncthreads();
                        v4u kr, v0, v1;
                        { const size_t kb = (size_t)tile_row(t_lo + 2) * 512, vb = (size_t)tile_row(t_lo + 1) * 512;
                          kr = *(const GAS v4u*)(kg + kb); v0 = *(const GAS v4u*)(vg + vb); v1 = *(const GAS v4u*)(vg + vb + 32 * 512); }
                        {
                            const v4u kr1 = *(const GAS v4u*)(kg + (size_t)tile_row(t_lo + 1) * 512);
                            f32x16 st[2];
#pragma unroll
                            for (int kb = 0; kb < 2; ++kb) {
#pragma unroll
                                for (int r = 0; r < 16; ++r) st[kb][r] = 0.f;
#pragma unroll
                                for (int ks = 0; ks < 4; ++ks) {
                                    const bf16x8 kf = *(const LAS bf16x8*)(Kb0 + (kb * 32 + r32) * CK_PITCH + ks * 32 + hi * 16);
                                    st[kb] = __builtin_amdgcn_mfma_f32_32x32x16_bf16(kf, qf[ks], st[kb], 0, 0, 0);
                                }
                            }
                            float mx = st[0][0];
#pragma unroll
                            for (int r = 1; r < 16; ++r) mx = fmaxf(mx, st[0][r]);
#pragma unroll
                            for (int r = 0; r < 16; ++r) mx = fmaxf(mx, st[1][r]);
                            mx = xmax32(mx);
#pragma unroll
                            for (int r = 0; r < 16; ++r) cb[r] = -mx;
                            float ls0 = 0.f, ls1 = 0.f;
#pragma unroll
                            for (int ks = 0; ks < 4; ++ks)
#pragma unroll
                                for (int i2 = 0; i2 < 4; ++i2) {
                                    const float p0 = __builtin_amdgcn_exp2f(st[ks >> 1][8 * (ks & 1) + 2 * i2] - mx), p1 = __builtin_amdgcn_exp2f(st[ks >> 1][8 * (ks & 1) + 2 * i2 + 1] - mx);
                                    ls0 += p0; ls1 += p1; pp[ks][i2] = cvtpk(p0, p1);
                                }
                            lpart = ls0 + ls1;
                            *(LAS v4u*)(Kb0 + CK_SZ + krow_s * CK_PITCH + kch_s * 16) = kr1;
                            __syncthreads();
                        }
                        const int q4 = (lane & 15) >> 2, p4 = lane & 3, grp = (lane >> 4) & 1;
                        const int voff = (4 * hi + q4) * CV_PITCH + (16 * grp + 4 * p4) * 2;
#pragma unroll 1
                        for (int j = t_lo + 1; j < t_hi; ++j) {
                            const int cur = (j - t_lo) & 1;
                            const LAS unsigned char* Kb = Kb0 + cur * CK_SZ; const LAS unsigned char* vbase = Vb0 + (cur ^ 1) * CV_SZ + voff;
                            const bool more = (j + 1 < t_hi);
                            auto vfrag = [&](int i) -> bf16x8 {
                                const LAS unsigned char* va = vbase + (i >> 2) * 16 * CV_PITCH + (i & 3) * 64;
                                const s16x4 lo = __builtin_bit_cast(s16x4, __builtin_amdgcn_ds_read_tr16_b64_v4i16((LAS s16x4*)va));
                                const s16x4 hh = __builtin_bit_cast(s16x4, __builtin_amdgcn_ds_read_tr16_b64_v4i16((LAS s16x4*)(va + 8 * CV_PITCH)));
                                return __builtin_shufflevector(lo, hh, 0, 1, 2, 3, 4, 5, 6, 7);
                            };
                            f32x16 st[2];
#pragma unroll
                            for (int kb = 0; kb < 2; ++kb) {
#pragma unroll
                                for (int ks = 0; ks < 4; ++ks) {
                                    const bf16x8 kf = *(const LAS bf16x8*)(Kb + (kb * 32 + r32) * CK_PITCH + ks * 32 + hi * 16);
                                    st[kb] = __builtin_amdgcn_mfma_f32_32x32x16_bf16(kf, qf[ks], ks == 0 ? cb : st[kb], 0, 0, 0);
                                }
                            }
                            bf16x8 vfr[3];
                            vfr[0] = vfrag(0); vfr[1] = vfrag(1); vfr[2] = vfrag(2);
                            float mx = st[0][0];
#pragma unroll
                            for (int r = 1; r < 16; ++r) mx = fmaxf(mx, st[0][r]);
#pragma unroll
                            for (int r = 0; r < 16; ++r) mx = fmaxf(mx, st[1][r]);
                            asm volatile("" : "+v"(mx));
                            __builtin_amdgcn_sched_barrier(0);
                            o[0] = __builtin_amdgcn_mfma_f32_32x32x16_bf16(vfr[0], __builtin_bit_cast(bf16x8, pp[0]), o[0], 0, 0, 0); vfr[0] = vfrag(3);
                            o[1] = __builtin_amdgcn_mfma_f32_32x32x16_bf16(vfr[1], __builtin_bit_cast(bf16x8, pp[0]), o[1], 0, 0, 0); vfr[1] = vfrag(4);
                            mx = xmax32(mx);
                            const bool grow = __builtin_amdgcn_ballot_w64(mx > 8.0f) != 0ull;
                            float alpha = 1.0f;
                            if (grow) {
                                const float dl = fmaxf(mx, 0.f);
#pragma unroll
                                for (int kb = 0; kb < 2; ++kb)
#pragma unroll
                                    for (int r = 0; r < 16; ++r) st[kb][r] -= dl;
#pragma unroll
                                for (int r = 0; r < 16; ++r) cb[r] -= dl;
                                alpha = __builtin_amdgcn_exp2f(-dl);
                            }
                            __builtin_amdgcn_sched_barrier(0);
                            float ls0 = 0.f, ls1 = 0.f;
#pragma unroll
                            for (int i = 0; i < 16; ++i) {
                                if (i >= 2) { o[i & 3] = __builtin_amdgcn_mfma_f32_32x32x16_bf16(vfr[i % 3], __builtin_bit_cast(bf16x8, pp[i >> 2]), o[i & 3], 0, 0, 0); if (i + 3 < 16) vfr[i % 3] = vfrag(i + 3); }
                                {
                                    const int kb = i >> 3, r = 2 * (i & 7);
                                    float p0 = __builtin_amdgcn_exp2f(st[kb][r]);
                                    ls0 += p0; asm volatile("" : "+v"(p0), "+v"(ls0));
                                    float p1 = __builtin_amdgcn_exp2f(st[kb][r + 1]);
                                    ls1 += p1; asm volatile("" : "+v"(p1), "+v"(ls1));
                                    st[kb][r] = p0; st[kb][r + 1] = p1;
                                }
                                if ((i & 3) == 3) {
                                    const int ks = i >> 2;
#pragma unroll
                                    for (int i2 = 0; i2 < 4; ++i2) pp[ks][i2] = cvtpk(st[ks >> 1][8 * (ks & 1) + 2 * i2], st[ks >> 1][8 * (ks & 1) + 2 * i2 + 1]);
                                    asm volatile("" : "+v"(pp[ks]));
                                }
                                if (i == 3) *(LAS v4u*)(Kb0 + (cur ^ 1) * CK_SZ + krow_s * CK_PITCH + kch_s * 16) = kr;
                                if (i == 5) *(LAS v4u*)(Vb0 + cur * CV_SZ + vrow_s0 * CV_PITCH + vch_s * 16) = v0;
                                if (i == 7) *(LAS v4u*)(Vb0 + cur * CV_SZ + (vrow_s0 + 32) * CV_PITCH + vch_s * 16) = v1;
                                if (i == 9) { const size_t kb = (size_t)tile_row(j + 2 < t_hi ? j + 2 : t_hi - 1) * 512, vb = (size_t)tile_row(more ? j + 1 : j) * 512;
                                              kr = *(const GAS v4u*)(kg + kb); v0 = *(const GAS v4u*)(vg + vb); v1 = *(const GAS v4u*)(vg + vb + 32 * 512); }
                                if (i >= 1) __builtin_amdgcn_sched_barrier(0);
                            }
                            if (grow) {
#pragma unroll
                                for (int d = 0; d < 4; ++d)
#pragma unroll
                                    for (int r = 0; r < 16; ++r) o[d][r] *= alpha;
                                lpart *= alpha;
                            }
                            lpart += ls0 + ls1;
                            __syncthreads();
                        }
                        {
                            const LAS unsigned char* vbase = Vb0 + ((t_hi - 1 - t_lo) & 1) * CV_SZ + voff;
#pragma unroll
                            for (int i = 0; i < 16; ++i) {
                                const LAS unsigned char* va = vbase + (i >> 2) * 16 * CV_PITCH + (i & 3) * 64;
                                const s16x4 lo = __builtin_bit_cast(s16x4, __builtin_amdgcn_ds_read_tr16_b64_v4i16((LAS s16x4*)va));
                                const s16x4 hh = __builtin_bit_cast(s16x4, __builtin_amdgcn_ds_read_tr16_b64_v4i16((LAS s16x4*)(va + 8 * CV_PITCH)));
                                const bf16x8 vf = __builtin_shufflevector(lo, hh, 0, 1, 2, 3, 4, 5, 6, 7);
                                o[i & 3] = __builtin_amdgcn_mfma_f32_32x32x16_bf16(vf, __builtin_bit_cast(bf16x8, pp[i >> 2]), o[i & 3], 0, 0, 0);
                                if ((i & 7) == 7) __builtin_amdgcn_sched_barrier(0);
                            }
                        }
                        const float lt = xadd32(lpart);
                        if (m == 0) {
                            const float inv = 1.0f / lt;
#pragma unroll
                            for (int d = 0; d < 4; ++d)
#pragma unroll
                                for (int i2 = 0; i2 < 8; ++i2) o1p[64 * (d * 8 + i2)] = cvtpk(o[d][2 * i2] * inv, o[d][2 * i2 + 1] * inv);
                        } else {
                            const float inv2 = lam / lt;
                            float ssq = 0.f;
#pragma unroll
                            for (int d = 0; d < 4; ++d)
#pragma unroll
                                for (int i2 = 0; i2 < 8; ++i2) {
                                    const unsigned w1 = o1p[64 * (d * 8 + i2)];
                                    const float a0 = bf2f(w1 & 0xffffu) - o[d][2 * i2] * inv2, a1 = bf2f(w1 >> 16) - o[d][2 * i2 + 1] * inv2;
                                    o[d][2 * i2] = a0; o[d][2 * i2 + 1] = a1; ssq += a0 * a0 + a1 * a1;
                                }
                            ssq = xadd32(ssq);
                            const float rn = 1.0f / sqrtf(ssq * (1.f / 128.f) + NORM_EPS) * (1.0f - lam_init);
                            bf16* yp = Y + (size_t)qrow * 1536 + 1024 + h * 128 + 4 * hi;
                            const float* sl = IN_[I_SUBLN] + layer * 512 + h * 128 + 4 * hi;
#pragma unroll
                            for (int d = 0; d < 4; ++d)
#pragma unroll
                                for (int g4 = 0; g4 < 4; ++g4) {
                                    const f32x4 gsl = *(const GAS f32x4*)(sl + d * 32 + 8 * g4);
                                    v2u w; w.x = cvtpk(o[d][4 * g4] * rn * gsl.x, o[d][4 * g4 + 1] * rn * gsl.y); w.y = cvtpk(o[d][4 * g4 + 2] * rn * gsl.z, o[d][4 * g4 + 3] * rn * gsl.w);
                                    *(GAS v2u*)(yp + d * 32 + 8 * g4) = w;
                                }
                        }
                    }
                }
                __syncthreads();
            }
} }
{ const int lo__ = lane_id_v(); { const int lane = lo__; const int tid = wave * 64 + lane, r32 = lane & 31, hi = lane >> 5;
            {
                const int n_lat = BATCH * 2 * (SEQ / 64), n_ctx = last ? 0 : BATCH * 2 * (CTX / 64);
                for (int rep_ = 0; rep_ < REP_P3A; ++rep_)
                for (int u0 = vcu; u0 < n_lat + n_ctx; u0 += G) {
                    const bool isctx = u0 >= n_lat;
                    int b, g, p0, qrow, nl, klo;
                    if (!isctx) { b = u0 >> 8; g = (u0 >> 7) & 1; p0 = (u0 & 127) * 64; qrow = b * SEQ + p0 + (wave & 1) * 32 + r32;
                                  klo = p0 >= 128 ? 0 : (128 - p0) / 64; const int khi = min(4, (SEQ - 1 - (p0 - 128)) / 64); nl = khi - klo + 1; }
                    else { const int c = u0 - n_lat; b = c >> 3; g = (c >> 2) & 1; p0 = (c & 3) * 64; qrow = T_LAT + b * CTX + p0 + (wave & 1) * 32 + r32; nl = 0; klo = 0; }
                    const int hq = g * 4 + (wave >> 1);
                    const int qpos0 = p0 + (wave & 1) * 32;
                    bf16x8 qf[4];
                    { const bf16* qp = AQ + (size_t)qrow * 512 + hq * 64 + hi * 8;
#pragma unroll
                      for (int ks = 0; ks < 4; ++ks) qf[ks] = *(const GAS bf16x8*)(qp + ks * 16); }
                    f32x16 o[2];
#pragma unroll
                    for (int d = 0; d < 2; ++d)
#pragma unroll
                        for (int r = 0; r < 16; ++r) o[d][r] = 0.f;
                    float mrun = IN_[I_SINK][layer * 8 + hq] * 8.0f;
                    float lpart = (hi == 0) ? 1.0f : 0.0f;
                    const bf16* kg = AK + (size_t)(tid >> 3) * 128 + g * 64 + (tid & 7) * 8;
                    const bf16* vg = AVT + (size_t)(tid >> 3) * 128 + g * 64 + (tid & 7) * 8;
                    const int kp0 = p0 - 128 + 64 * klo;
                    auto tile_row = [&](int j) { return (j < nl) ? b * SEQ + kp0 + 64 * j : T_LAT + b * CTX + 64 * (j - nl); };
                    auto use_tile = [&](int j) { if (j >= nl) return true; const int kp = kp0 + 64 * j; return (kp + 63 >= qpos0 - 128) && (kp <= qpos0 + 31 + 128); };
                    auto elem = [&](f32x16 (&st)[2], int j) {
                        if (j < nl) {
                            const int dq0 = (qpos0 + r32) - (kp0 + 64 * j + 4 * hi);
#pragma unroll
                            for (int kb = 0; kb < 2; ++kb)
#pragma unroll
                                for (int r = 0; r < 16; ++r) { const int dq = dq0 - (kb * 32 + (r & 3) + 8 * (r >> 2)); if (dq > 128 || dq < -128) st[kb][r] = -1e30f; }
                        }
                    };
                    attn64_pass<2, false>(o, mrun, lpart, qf, kg, 128, vg, 128, nl + 4, tile_row, use_tile, elem, o, [](int) { return false; }, L, lane, tid);
                    const float lt = xadd32(lpart);
                    attn64_store(o, 1.0f / lt, Y + (size_t)qrow * 1536 + hq * 64, hi);
                }
            }
} }
{ const int lo__ = lane_id_v(); { const int lane = lo__; const int tid = wave * 64 + lane, r32 = lane & 31, hi = lane >> 5;
            {
                const int n_lat = BATCH * 8 * 32, n_ctx = last ? 0 : BATCH * 8;
                LAS float* rpbL = (LAS float*)(L + 49152) + 64;
                f32x16 cm[2];
                {
                    const int qc = (wave & 1) * 32 + r32, cstart = min(max(qc - 8, 0), 48);
#pragma unroll
                    for (int kb = 0; kb < 2; ++kb)
#pragma unroll
                        for (int r = 0; r < 16; ++r) { const int kc = kb * 32 + (r & 3) + 8 * (r >> 2) + 4 * hi; cm[kb][r] = ((kc >= cstart) && (kc < cstart + 16)) ? 0.f : -1e30f; }
                }
                if (tid < 64) { rpbL[tid - 64] = 0.f; rpbL[465 + tid] = 0.f; }
                for (int rep_ = 0; rep_ < REP_P3B; ++rep_)
                for (int u0 = vcu; u0 < n_lat + n_ctx; u0 += G) {
                    const bool isctx = u0 >= n_lat;
                    int b, h, gr = 0, qc0 = 0, qrow, nl, krlo;
                    if (!isctx) { b = u0 >> 8; h = (u0 >> 5) & 7; const int r0 = (u0 & 31) * 4; gr = r0 + (wave >> 1); qc0 = (wave & 1) * 32; qrow = b * SEQ + gr * GRID_W + qc0 + r32;
                                  krlo = min(max(r0 - 4, 0), 120); nl = min(max(r0 - 1, 0), 120) + 8 - krlo; }
                    else { const int c = u0 - n_lat; b = c >> 3; h = c & 7; qrow = T_LAT + b * CTX + wave * 32 + r32; nl = 0; krlo = 0; }
                    __syncthreads();
                    if (tid < 465) rpbL[tid] = IN_[I_RPB][(size_t)(layer * 8 + h) * 465 + tid] * 8.0f;
                    bf16x8 qf[4];
                    { const bf16* qp = BQ + (size_t)qrow * 512 + h * 64 + hi * 8;
#pragma unroll
                      for (int ks = 0; ks < 4; ++ks) qf[ks] = *(const GAS bf16x8*)(qp + ks * 16); }
                    f32x16 o[2];
#pragma unroll
                    for (int d = 0; d < 2; ++d)
#pragma unroll
                        for (int r = 0; r < 16; ++r) o[d][r] = 0.f;
                    float mrun = -1e30f, lpart = 0.f;
                    const bf16* kg = BK + (size_t)(tid >> 3) * 512 + h * 64 + (tid & 7) * 8;
                    const bf16* vg = BVT + (size_t)(tid >> 3) * 512 + h * 64 + (tid & 7) * 8;
                    const int rs = min(max(gr - 4, 0), 120);
                    auto tile_row = [&](int j) { return (j < nl) ? b * SEQ + (krlo + j) * GRID_W : T_LAT + b * CTX + 64 * (j - nl); };
                    auto use_tile = [&](int j) { if (j >= nl) return true; const int kr = krlo + j; return kr >= rs && kr < rs + 8; };
                    auto elem = [&](f32x16 (&st)[2], int j) {
                        if (j < nl) {
                            const LAS float* brow = rpbL + (krlo + j - gr + 7) * 31 + 15 - (qc0 + r32) + 4 * hi;
#pragma unroll
                            for (int kb = 0; kb < 2; ++kb)
#pragma unroll
                                for (int r = 0; r < 16; ++r) st[kb][r] += brow[kb * 32 + (r & 3) + 8 * (r >> 2)];
                        }
                    };
                    attn64_pass<2, true>(o, mrun, lpart, qf, kg, 512, vg, 512, nl + 4, tile_row, use_tile, elem, cm, [&](int j) { return j < nl; }, L, lane, tid);
                    const float lt = xadd32(lpart);
                    attn64_store(o, 1.0f / lt, Y + (size_t)qrow * 1536 + 512 + h * 64, hi);
                }
                __syncthreads();
            }
} }
        }
        }
#endif
        GRID_BAR();

#ifndef SKIP_P4
        { PHASE_PTRS LAYER_PTRS
        for (int rep_ = 0; rep_ < REP_P4; ++rep_) {
        {
            pg8::Gemm g{Y, WB + (size_t)layer * 3 * D * 512, 1536, 512, 512, 512, (size_t)D * 512};
            pg8::SegOrder<3> S; S.T.init(T_LAT, D, G, (int)blockIdx.x);
            EpiBranch E{SG, MG};
            pg8::gemm_phase(L, g, S, E, wave);
        }
        if (!last) { const int lo__ = lane_id_v(); { const int lane = lo__; const int fr = lane & 15, fq = lane >> 4; (void)fr; (void)fq;
            for (int it = gw; it < (T_ALL - T_LAT) / 32 * (D / 32); it += NGW) {
                const int row0 = T_LAT + (it / (D / 32)) * 32, col0 = (it % (D / 32)) * 32;
                f32x4 mg[2][2]; zero_acc22(mg);
#pragma unroll 1
                for (int seg = 0; seg < 3; ++seg) {
                    f32x4 acc[2][2]; zero_acc22(acc);
                    sgemm32<8>(acc, Y + seg * 512, 1536, WB + (size_t)(layer * 3 + seg) * D * 512, 512, 512, row0, col0, lane);
#pragma unroll
                    for (int m = 0; m < 2; ++m)
#pragma unroll
                        for (int r = 0; r < 4; ++r) {
                            const bf16* gp = SG + (size_t)(row0 + 16 * m + 4 * fq + r) * 3072 + seg * 1024 + col0 + fr;
#pragma unroll
                            for (int n = 0; n < 2; ++n) mg[m][n][r] += bf2f(gp[16 * n]) * acc[m][n][r];
                        }
                }
#pragma unroll
                for (int m = 0; m < 2; ++m)
#pragma unroll
                    for (int r = 0; r < 4; ++r) {
                        bf16* rowp = MG + (size_t)(row0 + 16 * m + 4 * fq + r) * D + col0 + fr;
#pragma unroll
                        for (int n = 0; n < 2; ++n) rowp[16 * n] = (bf16)f2bf(mg[m][n][r]);
                    }
            }
} }
        }
        }
#endif
        GRID_BAR();

#ifndef SKIP_P5
        { PHASE_PTRS LAYER_PTRS
        {
            pg8::Gemm g{MG, WO + (size_t)layer * D * D, D, D, D, 0, 0};
            pg8::SegOrder<1> S; S.T.init(T_LAT, D, G, (int)blockIdx.x);
            EpiOut E{X, modl, layer == 0 ? IN_[I_X] : nullptr, IN_[I_CTX]};
            pg8::gemm_phase(L, g, S, E, wave);
        }
        if (!last) { const int lo__ = lane_id_v(); { const int lane = lo__; const int fr = lane & 15, fq = lane >> 4; (void)fr; (void)fq;
            for (int it = gw; it < (T_ALL - T_LAT) / 32 * (D / 32); it += NGW) {
                const int row0 = T_LAT + (it / (D / 32)) * 32, col0 = (it % (D / 32)) * 32;
                f32x4 acc[2][2]; zero_acc22(acc);
                sgemm32<8>(acc, MG, D, WO + (size_t)layer * D * D, D, D, row0, col0, lane);
                const float* gt = modl + (size_t)2 * 6 * D + 2 * D + col0 + fr;
#pragma unroll
                for (int m = 0; m < 2; ++m)
#pragma unroll
                    for (int r = 0; r < 4; ++r) {
                        float* rowp = X + (size_t)(row0 + 16 * m + 4 * fq + r) * D + col0 + fr;
                        const float* srcp = (layer == 0) ? IN_[I_CTX] + (size_t)(row0 - T_LAT + 16 * m + 4 * fq + r) * D + col0 + fr : rowp;
#pragma unroll
                        for (int n = 0; n < 2; ++n) rowp[16 * n] = srcp[16 * n] + gt[16 * n] * acc[m][n][r];
                    }
            }
} }
        }
#endif
        GRID_BAR();

#ifndef SKIP_P6
        { PHASE_PTRS LAYER_PTRS
        for (int rep_ = 0; rep_ < REP_P6; ++rep_) {
        { const int ln = lane_id_v();
        {
            f32x4 gm[4], shv[4];
            auto prep = [&](int midx) { const float* md = modl + (size_t)midx * 6 * D;
#pragma unroll
                for (int j = 0; j < 4; ++j) { const f32x4 g = *((const GAS f32x4*)(IN_[I_G2] + layer * D) + ln + 64 * j); const f32x4 sc = *((const GAS f32x4*)(md + 4 * D) + ln + 64 * j);
                    gm[j] = g * (sc + 1.0f); shv[j] = *((const GAS f32x4*)(md + 3 * D) + ln + 64 * j); } };
            auto row = [&](int r) {
                const GAS f32x4* xr = (const GAS f32x4*)(X + (size_t)r * D) + ln;
                f32x4 v[4]; float ss = 0.f;
#pragma unroll
                for (int j = 0; j < 4; ++j) { v[j] = xr[64 * j]; ss += (v[j].x * v[j].x + v[j].y * v[j].y) + (v[j].z * v[j].z + v[j].w * v[j].w); }
                const float rs = 1.0f / sqrtf(wave_sum(ss) * (1.f / D) + NORM_EPS);
                GAS v2u* o8 = (GAS v2u*)(H + (size_t)r * D) + ln;
#pragma unroll
                for (int j = 0; j < 4; ++j) { const f32x4 h = v[j] * rs * gm[j] + shv[j]; v2u o; o.x = pk2(h.x, h.y); o.y = pk2(h.z, h.w); o8[64 * j] = o; } };
            wave_row_blocks(T_EFF, gw, NGW, prep, row);
        }
        }
        }
        }
#endif
        GRID_BAR();

#ifndef SKIP_P7
        { PHASE_PTRS LAYER_PTRS
        for (int rep_ = 0; rep_ < REP_P7; ++rep_) {
        {
            pg8::Gemm g{H, WQ + (size_t)layer * 2048 * D, D, D, D, 0, 0};
            pg8::SegOrder<1> S; S.T.init(T_LAT, 2048, G, (int)blockIdx.x);
            EpiStore E{Q2, 2048};
            pg8::gemm_phase(L, g, S, E, wave);
        }
        if (!last) { const int lo__ = lane_id_v(); { const int lane = lo__; const int fr = lane & 15, fq = lane >> 4; (void)fr; (void)fq;
            for (int it = gw; it < (T_ALL - T_LAT) / 32 * (2048 / 32); it += NGW) {
                const int row0 = T_LAT + (it / (2048 / 32)) * 32, col0 = (it % (2048 / 32)) * 32;
                f32x4 acc[2][2]; zero_acc22(acc);
                sgemm32<8>(acc, H, D, WQ + (size_t)layer * 2048 * D, D, D, row0, col0, lane);
#pragma unroll
                for (int m = 0; m < 2; ++m)
#pragma unroll
                    for (int r = 0; r < 4; ++r) {
                        bf16* rowp = Q2 + (size_t)(row0 + 16 * m + 4 * fq + r) * 2048 + col0 + fr;
#pragma unroll
                        for (int n = 0; n < 2; ++n) rowp[16 * n] = (bf16)f2bf(acc[m][n][r]);
                    }
            }
} }
        }
        }
#endif
        GRID_BAR();

#ifndef SKIP_P8
        { PHASE_PTRS LAYER_PTRS
        for (int rep_ = 0; rep_ < REP_P8; ++rep_) {
{ const int lo__ = lane_id_v(); { const int lane = lo__; const int fr = lane & 15, fq = lane >> 4, tid = wave * 64 + lane;
        {
            LAS float* S = (LAS float*)L;
            const int wr = wave >> 1, wc = wave & 1;
            const int tl = tid >> 2, qd = tid & 3, ph = qd >> 1, hq = qd & 1;
            for (int it = vcu; it < (T_EFF / 128) * PEER_HEADS; it += G) {
                const int tile = it >> 3, h = it & 7;
                {
                    f32x4 acc[2][8];
#pragma unroll
                    for (int m = 0; m < 2; ++m)
#pragma unroll
                        for (int n = 0; n < 8; ++n) acc[m][n] = (f32x4){0.f, 0.f, 0.f, 0.f};
                    const bf16* ap = Q2 + (size_t)(tile * 128 + wr * 32 + fr) * 2048 + h * 256 + wc * 128 + fq * 8;
                    const bf16* bp = KEYS + ((size_t)(layer * 16 + h * 2 + wc) * 128 + fr) * 128 + fq * 8;
                    bf16x8 af[2][4];
#pragma unroll
                    for (int m = 0; m < 2; ++m)
#pragma unroll
                        for (int ks = 0; ks < 4; ++ks) af[m][ks] = *(const GAS bf16x8*)(ap + (size_t)m * 16 * 2048 + ks * 32);
#pragma unroll
                    for (int n = 0; n < 8; ++n) {
                        bf16x8 bfr[4];
#pragma unroll
                        for (int ks = 0; ks < 4; ++ks) bfr[ks] = *(const GAS bf16x8*)(bp + (size_t)n * 16 * 128 + ks * 32);
#pragma unroll
                        for (int ks = 0; ks < 4; ++ks)
#pragma unroll
                            for (int m = 0; m < 2; ++m) acc[m][n] = __builtin_amdgcn_mfma_f32_16x16x32_bf16(af[m][ks], bfr[ks], acc[m][n], 0, 0, 0);
                    }
#pragma unroll
                    for (int m = 0; m < 2; ++m)
#pragma unroll
                        for (int r = 0; r < 4; ++r) {
                            const int row_ = wr * 32 + 16 * m + 4 * fq + r;
#pragma unroll
                            for (int n = 0; n < 8; ++n) { const int key_ = wc * 128 + 16 * n + fr, c_ = key_ >> 2, pc_ = (c_ & 0x30) | ((c_ & 15) ^ (((row_ & 3) << 2) | (c_ >> 4)));
                                S[row_ * 256 + pc_ * 4 + (key_ & 3)] = acc[m][n][r]; }
                        }
                }
                __syncthreads();
                {
                    const int t = tile * 128 + tl;
                    int a[16];
#define LOAD_CHUNK_L(v, ch) _Pragma("unroll") for (int q = 0; q < 4; ++q) { const int c_ = qd * 16 + (ch) * 4 + q, pc_ = (c_ & 0x30) | ((c_ & 15) ^ (((tl & 3) << 2) | qd)); \
                        const f32x4 x = *(const LAS f32x4*)(S + tl * 256 + pc_ * 4); const int kb_ = hq * 64 + (ch) * 16 + 4 * q; \
                        v[4 * q + 0] = (f2ord(x.x) & ~127) | (kb_ + 0); v[4 * q + 1] = (f2ord(x.y) & ~127) | (kb_ + 1); v[4 * q + 2] = (f2ord(x.z) & ~127) | (kb_ + 2); v[4 * q + 3] = (f2ord(x.w) & ~127) | (kb_ + 3); }
                    LOAD_CHUNK_L(a, 0) sort16_desc(a);
#pragma unroll
                    for (int ch = 1; ch < 4; ++ch) { int v[16]; LOAD_CHUNK_L(v, ch) sort16_desc(v); merge16_desc(a, v); }
#undef LOAD_CHUNK_L
                    { int b[16];
#pragma unroll
                      for (int i = 0; i < 16; ++i) b[i] = __builtin_amdgcn_update_dpp(0, a[i], 0xB1, 0xF, 0xF, true);
                      merge16_desc(a, b); }
                    int a0[16], a1[16];
#pragma unroll
                    for (int i = 0; i < 16; ++i) { const int o2 = __builtin_amdgcn_update_dpp(0, a[i], 0x4E, 0xF, 0xF, true); a0[i] = ph ? o2 : a[i]; a1[i] = ph ? a[i] : o2; }
                    {
            float va[16], vb[16];
#pragma unroll
            for (int i = 0; i < 16; ++i) { va[i] = ord2f(a0[i] & ~127); vb[i] = ord2f(a1[i] & ~127); }
            int c[16];
            {
                int v[16];
                v[0] = (f2ord(va[0] + vb[0]) & ~255) | 0;
                v[1] = (f2ord(va[0] + vb[1]) & ~255) | 1;
                v[2] = (f2ord(va[0] + vb[2]) & ~255) | 2;
                v[3] = (f2ord(va[0] + vb[3]) & ~255) | 3;
                v[4] = (f2ord(va[0] + vb[4]) & ~255) | 4;
                v[5] = (f2ord(va[0] + vb[5]) & ~255) | 5;
                v[6] = (f2ord(va[0] + vb[6]) & ~255) | 6;
                v[7] = (f2ord(va[0] + vb[7]) & ~255) | 7;
                v[8] = (f2ord(va[0] + vb[8]) & ~255) | 8;
                v[9] = (f2ord(va[0] + vb[9]) & ~255) | 9;
                v[10] = (f2ord(va[0] + vb[10]) & ~255) | 10;
                v[11] = (f2ord(va[0] + vb[11]) & ~255) | 11;
                v[12] = (f2ord(va[0] + vb[12]) & ~255) | 12;
                v[13] = (f2ord(va[0] + vb[13]) & ~255) | 13;
                v[14] = (f2ord(va[0] + vb[14]) & ~255) | 14;
                v[15] = (f2ord(va[0] + vb[15]) & ~255) | 15;
                sort16_desc(v);
#pragma unroll
                for (int i = 0; i < 16; ++i) c[i] = v[i];
            }
            {
                int v[16];
                v[0] = (f2ord(va[1] + vb[0]) & ~255) | 16;
                v[1] = (f2ord(va[1] + vb[1]) & ~255) | 17;
                v[2] = (f2ord(va[1] + vb[2]) & ~255) | 18;
                v[3] = (f2ord(va[1] + vb[3]) & ~255) | 19;
                v[4] = (f2ord(va[1] + vb[4]) & ~255) | 20;
                v[5] = (f2ord(va[1] + vb[5]) & ~255) | 21;
                v[6] = (f2ord(va[1] + vb[6]) & ~255) | 22;
                v[7] = (f2ord(va[1] + vb[7]) & ~255) | 23;
                v[8] = (f2ord(va[2] + vb[0]) & ~255) | 32;
                v[9] = (f2ord(va[2] + vb[1]) & ~255) | 33;
                v[10] = (f2ord(va[2] + vb[2]) & ~255) | 34;
                v[11] = (f2ord(va[2] + vb[3]) & ~255) | 35;
                v[12] = (f2ord(va[2] + vb[4]) & ~255) | 36;
                v[13] = (f2ord(va[3] + vb[0]) & ~255) | 48;
                v[14] = (f2ord(va[3] + vb[1]) & ~255) | 49;
                v[15] = (f2ord(va[3] + vb[2]) & ~255) | 50;
                sort16_desc(v);
                merge16_desc(c, v);
            }
            {
                int v[16];
                v[0] = (f2ord(va[3] + vb[3]) & ~255) | 51;
                v[1] = (f2ord(va[4] + vb[0]) & ~255) | 64;
                v[2] = (f2ord(va[4] + vb[1]) & ~255) | 65;
                v[3] = (f2ord(va[4] + vb[2]) & ~255) | 66;
                v[4] = (f2ord(va[5] + vb[0]) & ~255) | 80;
                v[5] = (f2ord(va[5] + vb[1]) & ~255) | 81;
                v[6] = (f2ord(va[6] + vb[0]) & ~255) | 96;
                v[7] = (f2ord(va[6] + vb[1]) & ~255) | 97;
                v[8] = (f2ord(va[7] + vb[0]) & ~255) | 112;
                v[9] = (f2ord(va[7] + vb[1]) & ~255) | 113;
                v[10] = (f2ord(va[8] + vb[0]) & ~255) | 128;
                v[11] = (f2ord(va[9] + vb[0]) & ~255) | 144;
                v[12] = (f2ord(va[10] + vb[0]) & ~255) | 160;
                v[13] = (f2ord(va[11] + vb[0]) & ~255) | 176;
                v[14] = (f2ord(va[12] + vb[0]) & ~255) | 192;
                v[15] = (f2ord(va[13] + vb[0]) & ~255) | 208;
                sort16_desc(v);
                merge16_desc(c, v);
            }
            {
                int v[16];
                v[0] = (f2ord(va[14] + vb[0]) & ~255) | 224;
                v[1] = (f2ord(va[15] + vb[0]) & ~255) | 240;
                v[2] = (int)0x80000000;
                v[3] = (int)0x80000000;
                v[4] = (int)0x80000000;
                v[5] = (int)0x80000000;
                v[6] = (int)0x80000000;
                v[7] = (int)0x80000000;
                v[8] = (int)0x80000000;
                v[9] = (int)0x80000000;
                v[10] = (int)0x80000000;
                v[11] = (int)0x80000000;
                v[12] = (int)0x80000000;
                v[13] = (int)0x80000000;
                v[14] = (int)0x80000000;
                v[15] = (int)0x80000000;
                sort16_desc(v);
                merge16_desc(c, v);
            }
            const float smax = ord2f(c[0] & ~255);
            float pe[16]; float psum = 0.f;
#pragma unroll
            for (int k = 0; k < 16; ++k) { pe[k] = __expf(ord2f(c[k] & ~255) - smax); psum += pe[k]; }
            const float ip = 1.0f / psum;
#pragma unroll
            for (int kk = 0; kk < 4; ++kk) {
                const int ck = (qd == 0) ? c[kk] : (qd == 1) ? c[4 + kk] : (qd == 2) ? c[8 + kk] : c[12 + kk];
                const float pk_ = (qd == 0) ? pe[kk] : (qd == 1) ? pe[4 + kk] : (qd == 2) ? pe[8 + kk] : pe[12 + kk];
                const int ij = ck & 255, ii = ij >> 4, jj = ij & 15;
                int e0 = 0, e1 = 0;
#pragma unroll
                for (int q = 0; q < 16; ++q) { e0 = (ii == q) ? (a0[q] & 127) : e0; e1 = (jj == q) ? (a1[q] & 127) : e1; }
                const int e = e0 * PEER_KEYS + e1;
                const float su = SCU[layer * 16384 + e], sv = SCV[layer * 16384 + e];
                const int k = 4 * qd + kk;
                EI[(size_t)t * NSEL + h * 16 + k] = (unsigned)e | (f2bf(su) << 16);
                EG[(size_t)t * NSEL + h * 16 + k] = pk_ * ip * sv;
            }
                    }
                }
                __syncthreads();
            }
        }
} }
        }
        }
#endif
        GRID_BAR();

#ifndef SKIP_P10
#define P10_CENSUS \
        unsigned myx_, nx_ = 1u, smask_ = 0u; { unsigned cnt_[16]; unsigned* bw_ = (unsigned*)(args.ws + WS_CTL) + CW_BAR; \
            _Pragma("unroll") for (int j = 0; j < 16; ++j) cnt_[j] = (unsigned)__builtin_amdgcn_readfirstlane((int)xb_ld(&bw_[XB_XCNT(j)])); \
            myx_ = xb_xcc_id(); unsigned np_ = 0u; \
            _Pragma("unroll") for (int j = 0; j < 16; ++j) { np_ += (cnt_[j] > 0u) ? 1u : 0u; nx_ = ((unsigned)j == myx_) ? cnt_[j] : nx_; } \
            if (np_ == 0u) np_ = 1u; if (nx_ == 0u) nx_ = 1u; \
            _Pragma("unroll") for (int sl = 0; sl < 8; ++sl) { const unsigned k_ = (unsigned)sl % np_; unsigned seen_ = 0u, srv_ = 0xffu; \
                _Pragma("unroll") for (int j = 0; j < 16; ++j) { if (cnt_[j] > 0u) { srv_ = (seen_ == k_) ? (unsigned)j : srv_; ++seen_; } } \
                smask_ |= (srv_ == myx_) ? (1u << sl) : 0u; } } \
        const int rank_ = (int)__builtin_amdgcn_readfirstlane((int)MISC[12]); const int wstride_ = (int)nx_ * NWAVES; (void)rank_; (void)wstride_;
        { PHASE_PTRS LAYER_PTRS
        { const int ln = lane_id_v(); const int c = ln & 7, tg = ln >> 3;
          P10_CENSUS
          float* PART = (float*)(wsq + WS_PART);
          const unsigned char* U8l = U8 + (size_t)layer * 16384 * D;
          for (int rep_ = 0; rep_ < REP_P10A; ++rep_)
#pragma unroll 1
          for (int sl = 0; sl < 8; ++sl) {
            if (!((smask_ >> sl) & 1u)) continue;
            const int ws0 = (rank_ * NWAVES + wave) * 8, nslot = wstride_ * 8;
            if (ws0 >= T_EFF) continue;
            const int niter = (T_EFF - ws0 + nslot - 1) / nslot, nb = niter * 8;
#define A_TOK(bi) (ws0 + tg + (min((bi), nb - 1) >> 3) * nslot)
#define A_LOAD_PK(pkv, bi) { const GAS v4u* wp_ = (const GAS v4u*)(EI + (size_t)A_TOK(bi) * NSEL + 16 * (min((bi), nb - 1) & 7)); _Pragma("unroll") for (int q = 0; q < 4; ++q) pkv[q] = wp_[q]; }
#define A_ISSUE(rowv, pkv) { _Pragma("unroll") for (int q = 0; q < 16; ++q) rowv[q] = *(const GAS v4u*)(U8l + (size_t)(pkv[q >> 2][q & 3] & 0xffffu) * D + 128 * sl + 16 * c); }
#define A_LOAD_H(hvv, bi) { const int tq_ = A_TOK(bi); _Pragma("unroll") for (int j = 0; j < 4; ++j) hvv[j] = *(const GAS v2u*)(H + (size_t)tq_ * D + 256 * j + 32 * sl + 4 * c); }
#define A_QUANT(hvv) { float hf[16]; float am_ = 0.f; \
                _Pragma("unroll") for (int j = 0; j < 4; ++j) { hf[4 * j] = bf2f(hvv[j].x & 0xffffu); hf[4 * j + 1] = bf2f(hvv[j].x >> 16); hf[4 * j + 2] = bf2f(hvv[j].y & 0xffffu); hf[4 * j + 3] = bf2f(hvv[j].y >> 16); } \
                _Pragma("unroll") for (int i = 0; i < 16; ++i) am_ = fmaxf(am_, fabsf(hf[i])); \
                am_ = fmaxf(am_, dpp_mov<0xB1>(am_)); am_ = fmaxf(am_, dpp_mov<0x4E>(am_)); am_ = fmaxf(am_, dpp_mov<0x141>(am_)); am_ = fmaxf(am_, 1e-20f); \
                sh_ = am_ * (1.0f / 127.0f); const float ih_ = 127.0f / am_; \
                _Pragma("unroll") for (int j = 0; j < 4; ++j) { const int q0 = __float2int_rn(hf[4 * j] * ih_), q1 = __float2int_rn(hf[4 * j + 1] * ih_), q2 = __float2int_rn(hf[4 * j + 2] * ih_), q3 = __float2int_rn(hf[4 * j + 3] * ih_); \
                    hq_[j] = (int)((unsigned)(q0 & 255) | ((unsigned)(q1 & 255) << 8) | ((unsigned)(q2 & 255) << 16) | ((unsigned)q3 << 24)); } }
#define A_COMPUTE(rowv, bi) { int p_[16]; \
                _Pragma("unroll") for (int q = 0; q < 16; ++q) { int ia = 0; _Pragma("unroll") for (int j = 0; j < 4; ++j) ia = __builtin_amdgcn_sdot4((int)rowv[q][j], hq_[j], ia, false); p_[q] = ia; } \
                { const bool up = (c & 4) != 0; _Pragma("unroll") for (int i = 0; i < 8; ++i) { const int send = up ? p_[i] : p_[8 + i], keep = up ? p_[8 + i] : p_[i]; p_[i] = keep + __builtin_amdgcn_update_dpp(0, send, 0x141, 0xF, 0xF, true); } } \
                { const bool up = (c & 2) != 0; _Pragma("unroll") for (int i = 0; i < 4; ++i) { const int send = up ? p_[i] : p_[4 + i], keep = up ? p_[4 + i] : p_[i]; p_[i] = keep + __builtin_amdgcn_update_dpp(0, send, 0x4E, 0xF, 0xF, true); } } \
                { const bool up = (c & 1) != 0; _Pragma("unroll") for (int i = 0; i < 2; ++i) { const int send = up ? p_[i] : p_[2 + i], keep = up ? p_[2 + i] : p_[i]; p_[i] = keep + __builtin_amdgcn_update_dpp(0, send, 0xB1, 0xF, 0xF, true); } } \
                f32x2 r2_; r2_.x = (float)p_[0] * sh_; r2_.y = (float)p_[1] * sh_; \
                *(GAS f32x2*)(PART + ((size_t)sl * T_ALL + (ws0 + tg + ((bi) >> 3) * nslot)) * NSEL + 16 * ((bi) & 7) + 2 * c) = r2_; }
            v4u pkA[4], pkB[4]; v4u rowA[16], rowB[16]; v2u hN[4]; int hq_[4] = {0, 0, 0, 0}; float sh_ = 0.f;
            A_LOAD_PK(pkA, 0) A_LOAD_PK(pkB, 1) A_LOAD_H(hN, 0)
            A_ISSUE(rowA, pkA)
#pragma unroll 1
            for (int bi = 0; bi < nb; bi += 2) {
                if ((bi & 7) == 0) { A_QUANT(hN) A_LOAD_H(hN, bi + 8) }
                A_ISSUE(rowB, pkB) A_LOAD_PK(pkA, bi + 2)
                __builtin_amdgcn_sched_barrier(0);
                A_COMPUTE(rowA, bi)
                __builtin_amdgcn_sched_barrier(0);
                A_ISSUE(rowA, pkA) A_LOAD_PK(pkB, bi + 3)
                __builtin_amdgcn_sched_barrier(0);
                A_COMPUTE(rowB, bi + 1)
                __builtin_amdgcn_sched_barrier(0);
            }
#undef A_TOK
#undef A_LOAD_PK
#undef A_ISSUE
#undef A_LOAD_H
#undef A_QUANT
#undef A_COMPUTE
          }
        } }
        GRID_BAR();
        { PHASE_PTRS LAYER_PTRS
        { const int ln = lane_id_v();
          const float* PART = (const float*)(wsq + WS_PART); float* WGT = (float*)(wsq + WS_WGT);
          for (int rep_ = 0; rep_ < REP_P10B; ++rep_)
          for (int i4 = vcu * NTHREADS + wave * 64 + ln; i4 < T_EFF * NSEL / 4; i4 += NGT) {
              f32x4 dsum = (f32x4){0.f, 0.f, 0.f, 0.f};
#pragma unroll
              for (int sl = 0; sl < 8; ++sl) dsum += *((const GAS f32x4*)(PART + (size_t)sl * T_ALL * NSEL) + i4);
              const v4u esu = *((const GAS v4u*)EI + i4); const f32x4 gv = *((const GAS f32x4*)EG + i4);
              v4u o;
#pragma unroll
              for (int q = 0; q < 4; ++q) {
                  const float dot = dsum[q] * bf2f(esu[q] >> 16);
                  o[q] = (esu[q] & 0xffffu) | (f2bf(0.5f * dot * (1.0f + erff(dot * 0.70710678118654752f)) * gv[q]) << 16);
              }
              *((GAS v4u*)WGT + i4) = o;
          }
        } }
        GRID_BAR();
        { PHASE_PTRS LAYER_PTRS
        { const int ln = lane_id_v(); const int c = ln & 7, tg = ln >> 3;
          P10_CENSUS
          const unsigned* WGT = (const unsigned*)(wsq + WS_WGT); float* XO = (float*)(wsq + WS_XO);
          const unsigned char* V8l = V8 + (size_t)layer * 16384 * D;
          for (int rep_ = 0; rep_ < REP_P10C; ++rep_)
#pragma unroll 1
          for (int sl = 0; sl < 8; ++sl) {
            if (!((smask_ >> sl) & 1u)) continue;
            const int ws0 = (rank_ * NWAVES + wave) * 8, nslot = wstride_ * 8;
            if (ws0 >= T_EFF) continue;
            const int niter = (T_EFF - ws0 + nslot - 1) / nslot, nb = niter * 8;
#define C_TOK(bi) (ws0 + tg + (min((bi), nb - 1) >> 3) * nslot)
#define C_LOAD_PK(pkv, bi) { const GAS v4u* wp_ = (const GAS v4u*)(WGT + (size_t)C_TOK(bi) * NSEL + 16 * (min((bi), nb - 1) & 7)); _Pragma("unroll") for (int q = 0; q < 4; ++q) pkv[q] = wp_[q]; }
#define C_ISSUE(rowv, wv, pkv) { _Pragma("unroll") for (int q = 0; q < 16; ++q) { const unsigned w_ = pkv[q >> 2][q & 3]; rowv[q] = *(const GAS v4u*)(V8l + (size_t)(w_ & 0xffffu) * D + 128 * sl + 16 * c); } \
                _Pragma("unroll") for (int q = 0; q < 8; ++q) wv[q] = (pkv[q >> 1][(2 * q) & 3] >> 16) | (pkv[q >> 1][(2 * q + 1) & 3] & 0xffff0000u); }
#define C_COMPUTE(rowv, wv) { _Pragma("unroll") for (int q = 0; q < 16; ++q) { const float wq_ = (q & 1) ? __builtin_bit_cast(float, wv[q >> 1] & 0xffff0000u) : bf2f(wv[q >> 1] & 0xffffu); const f32x2 w2_ = (f32x2){wq_, wq_}; _Pragma("unroll") for (int j = 0; j < 4; ++j) { \
                    const f32x2 a = __builtin_amdgcn_cvt_pk_f32_fp8((int)rowv[q][j], false), b = __builtin_amdgcn_cvt_pk_f32_fp8((int)rowv[q][j], true); \
                    f32x2 lo_ = (f32x2){o[j].x, o[j].y}, hi_ = (f32x2){o[j].z, o[j].w}; lo_ = __builtin_elementwise_fma(a, w2_, lo_); hi_ = __builtin_elementwise_fma(b, w2_, hi_); \
                    o[j].x = lo_.x; o[j].y = lo_.y; o[j].z = hi_.x; o[j].w = hi_.y; } \
                    asm volatile("" : "+v"(o[0]), "+v"(o[1]), "+v"(o[2]), "+v"(o[3])); } }
            v4u pkA[4], pkB[4]; unsigned wA[8], wB[8]; v4u rowA[16], rowB[16];
            f32x4 o[4];
#pragma unroll
            for (int j = 0; j < 4; ++j) o[j] = (f32x4){0.f, 0.f, 0.f, 0.f};
            C_LOAD_PK(pkA, 0) C_LOAD_PK(pkB, 1)
            C_ISSUE(rowA, wA, pkA)
#pragma unroll 1
            for (int bi = 0; bi < nb; bi += 2) {
                C_ISSUE(rowB, wB, pkB) C_LOAD_PK(pkA, bi + 2)
                __builtin_amdgcn_sched_barrier(0);
                C_COMPUTE(rowA, wA)
                __builtin_amdgcn_sched_barrier(0);
                C_ISSUE(rowA, wA, pkA) C_LOAD_PK(pkB, bi + 3)
                __builtin_amdgcn_sched_barrier(0);
                C_COMPUTE(rowB, wB)
                __builtin_amdgcn_sched_barrier(0);
                if ((bi & 7) == 6) {
                    const int t = ws0 + tg + (bi >> 3) * nslot;
#pragma unroll
                    for (int j = 0; j < 4; ++j) { *(GAS f32x4*)(XO + (size_t)t * D + 256 * j + 32 * sl + 4 * c) = o[j]; o[j] = (f32x4){0.f, 0.f, 0.f, 0.f}; }
                }
            }
#undef C_TOK
#undef C_LOAD_PK
#undef C_ISSUE
#undef C_COMPUTE
          }
        } }
        GRID_BAR();
#undef P10_CENSUS
        { PHASE_PTRS LAYER_PTRS
        { const int ln = lane_id_v();
          const float* XO = (const float*)(wsq + WS_XO);
          f32x4 gt2v[4], gm[4], shv[4];
          auto prep = [&](int midx) {
              const float* md = modl + (size_t)midx * 6 * D; const float* md1 = modl + (size_t)(3 + midx) * 6 * D;
#pragma unroll
              for (int j = 0; j < 4; ++j) {
                  gt2v[j] = *((const GAS f32x4*)(md + 5 * D) + ln + 64 * j);
                  if (!last) { const f32x4 g = *((const GAS f32x4*)(IN_[I_G1] + (layer + 1) * D) + ln + 64 * j); const f32x4 sc = *((const GAS f32x4*)(md1 + D) + ln + 64 * j);
                               gm[j] = g * (sc + 1.0f); shv[j] = *((const GAS f32x4*)(md1 + 0) + ln + 64 * j); }
                  else { gm[j] = *((const GAS f32x4*)IN_[I_GFINAL] + ln + 64 * j); shv[j] = (f32x4){0.f, 0.f, 0.f, 0.f}; }
              } };
          auto row = [&](int t) {
              GAS f32x4* xr = (GAS f32x4*)(X + (size_t)t * D) + ln;
              const GAS f32x4* xo = (const GAS f32x4*)(XO + (size_t)t * D) + ln;
              f32x4 xn[4]; float ss = 0.f;
#pragma unroll
              for (int j = 0; j < 4; ++j) { xn[j] = xr[64 * j] + gt2v[j] * xo[64 * j]; ss += (xn[j].x * xn[j].x + xn[j].y * xn[j].y) + (xn[j].z * xn[j].z + xn[j].w * xn[j].w); }
              const float rs = 1.0f / sqrtf(wave_sum(ss) * (1.f / D) + NORM_EPS);
              if (!last) {
                  GAS v2u* o8 = (GAS v2u*)(H + (size_t)t * D) + ln;
#pragma unroll
                  for (int j = 0; j < 4; ++j) { xr[64 * j] = xn[j]; const f32x4 hh = xn[j] * rs * gm[j] + shv[j]; v2u o; o.x = pk2(hh.x, hh.y); o.y = pk2(hh.z, hh.w); o8[64 * j] = o; }
              } else {
                  GAS f32x4* op = (GAS f32x4*)(((float*)IN_[22]) + (size_t)t * D) + ln;
#pragma unroll
                  for (int j = 0; j < 4; ++j) op[64 * j] = xn[j] * rs * gm[j];
              } };
          wave_row_blocks(T_EFF, gw, NGW, prep, row);
        } }
#endif
        if (!last) GRID_BAR();
    }
}

extern "C" void kernel_launch(void* const* d_in, const int* in_sizes, int n_in, void* d_out, int out_size, void* d_ws, size_t ws_size, hipStream_t stream) {
    static int grid = 0;
    if (grid == 0) {
        if (n_in != 22 || out_size != T_LAT * D || ws_size < WS_END) { fprintf(stderr, "kernel_launch: unexpected shapes: n_in %d out %d ws %zu (need %zu)\n", n_in, out_size, ws_size, (size_t)WS_END); grid = -1; return; }
        int dev = 0, cus = 0, per_cu = 0;
        if (hipGetDevice(&dev) != hipSuccess || hipDeviceGetAttribute(&cus, hipDeviceAttributeMultiprocessorCount, dev) != hipSuccess) { fprintf(stderr, "device query failed\n"); grid = -1; return; }
        if (hipFuncSetAttribute((const void*)mega_fwd, hipFuncAttributeMaxDynamicSharedMemorySize, LDS_BYTES) != hipSuccess) { fprintf(stderr, "hipFuncSetAttribute failed\n"); grid = -1; return; }
        if (hipOccupancyMaxActiveBlocksPerMultiprocessor(&per_cu, (const void*)mega_fwd, NTHREADS, LDS_BYTES) != hipSuccess || per_cu < 1) { fprintf(stderr, "occupancy query: %d\n", per_cu); }
        (void)hipGetLastError();
        grid = cus;
    }
    if (grid < 0) return;
    if (hipMemsetAsync((char*)d_ws + WS_CTL, 0, CTL_ZERO_BYTES, stream) != hipSuccess) { fprintf(stderr, "memset failed\n"); return; }
    Args a{};
    for (int i = 0; i < 22; ++i) a.in[i] = (const float*)d_in[i];
    a.out = (float*)d_out; a.ws = (unsigned char*)d_ws;
    hipLaunchKernelGGL(mega_fwd, dim3(grid), dim3(NTHREADS), LDS_BYTES, stream, a);
}
```

```cpp
#include <hip/hip_runtime.h>
#include <cstdio>
#include <cstdint>

#ifndef REP_P0
#define REP_P0 1
#endif
#ifndef REP_P1
#define REP_P1 1
#endif
#ifndef REP_P2
#define REP_P2 1
#endif
#ifndef REP_P3A
#define REP_P3A 1
#endif
#ifndef REP_P3B
#define REP_P3B 1
#endif
#ifndef REP_P4
#define REP_P4 1
#endif
#ifndef REP_P6
#define REP_P6 1
#endif
#ifndef REP_P7
#define REP_P7 1
#endif
#ifndef REP_P8
#define REP_P8 1
#endif
#ifndef REP_P9
#define REP_P9 1
#endif
#ifndef REP_P10
#define REP_P10 1
#endif
#ifndef REP_P10A
#define REP_P10A 1
#endif
#ifndef REP_P10C
#define REP_P10C 1
#endif
#ifndef REP_P10B
#define REP_P10B 1
#endif
#ifndef REP_P0A
#define REP_P0A 1
#endif
#ifndef REP_P0D
#define REP_P0D 1
#endif
#ifndef REP_P0F
#define REP_P0F 1
#endif
#ifndef REP_P3C
#define REP_P3C 1
#endif
#define GAS __attribute__((address_space(1)))
#define LAS __attribute__((address_space(3)))
typedef unsigned short bf16;
typedef float f32x4 __attribute__((ext_vector_type(4)));
typedef short bf16x8 __attribute__((ext_vector_type(8)));
typedef unsigned v4u __attribute__((ext_vector_type(4)));
typedef unsigned v2u __attribute__((ext_vector_type(2)));
typedef float f32x2 __attribute__((ext_vector_type(2)));
typedef GAS unsigned gu32;

constexpr int NWAVES = 8, NTHREADS = 512;
constexpr int D = 1024, BATCH = 2, SEQ = 8192, DEPTH = 2, GRID_W = 64, CTX = 256;
constexpr int T_LAT = BATCH * SEQ;
constexpr int T_ALL = T_LAT + BATCH * CTX;
constexpr int NTOK = SEQ + CTX;
constexpr int IN_W = 6912;
constexpr int PEER_HEADS = 8, PEER_KEYS = 128, PEER_TOPK = 16, NSEL = PEER_HEADS * PEER_TOPK;
constexpr float NORM_EPS = 1e-6f;
constexpr float LOG2E = 1.4426950408889634f;
constexpr float SCL2 = 0.125f * LOG2E;

constexpr size_t MiB = 1u << 20;
constexpr size_t WS_CTL = 0, CTL_ZERO_BYTES = 1 * MiB;
constexpr int CW_BAR = 4096;
constexpr int CW_RANK = 8192;
#ifndef P10_SLICED
#define P10_SLICED 1
#endif
constexpr size_t WS_MOD = 65536;
constexpr size_t WS_COS = 2 * MiB, WS_SIN = 3 * MiB;
constexpr size_t WS_WIN = 4 * MiB;
constexpr size_t WS_WB = 31 * MiB;
constexpr size_t WS_WO = 37 * MiB;
constexpr size_t WS_WQ = 41 * MiB;
constexpr size_t WS_KEYS = 49 * MiB;
constexpr size_t WS_X = 50 * MiB;
constexpr size_t WS_H = 116 * MiB;
constexpr size_t WS_Y = 149 * MiB;
constexpr size_t WS_MG = WS_H;
constexpr size_t WS_U8 = 199 * MiB;
constexpr size_t WS_SCU = 231 * MiB;
constexpr size_t WS_EI = 232 * MiB;
constexpr size_t WS_EG = 241 * MiB;
constexpr size_t WS_P = 250 * MiB;
constexpr size_t SZ_R512 = (size_t)T_ALL * 512 * 2;
constexpr size_t SZ_R128 = (size_t)T_ALL * 128 * 2;
constexpr size_t WS_AQ = WS_P, WS_AK = WS_AQ + SZ_R512, WS_AVT = WS_AK + SZ_R128, WS_BQ = WS_AVT + SZ_R128, WS_BK = WS_BQ + SZ_R512,
                 WS_BVT = WS_BK + SZ_R512, WS_CQ = WS_BVT + SZ_R512, WS_CK = WS_CQ + SZ_R512, WS_CVT = WS_CK + SZ_R512, WS_SG = WS_CVT + SZ_R512;
constexpr size_t WS_Q2 = WS_P;
constexpr size_t WS_SC = WS_P + 66 * MiB;
constexpr size_t WS_PART = WS_P, WS_XO = WS_P + 66 * MiB, WS_WGT = WS_P + 132 * MiB;
constexpr size_t WS_PEND = WS_SG + (size_t)T_ALL * 3072 * 2;
constexpr size_t WS_V8 = 473 * MiB;
constexpr size_t WS_END = WS_V8 + 32 * MiB;
static_assert(WS_SC + (size_t)T_ALL * 2048 * 4 <= WS_PEND && WS_PEND <= WS_V8, "alias map");
static_assert(WS_END <= 512 * MiB, "ws map");

constexpr int LDS_BYTES = 147456;
constexpr int MISC_OFF = 131072 + 320;

__device__ __forceinline__ int lane_id_v() { int l; asm volatile("v_mbcnt_lo_u32_b32 %0, -1, 0\n\tv_mbcnt_hi_u32_b32 %0, -1, %0" : "=v"(l)); return l; }
#define XB_TMO      128
#define XB_XCNT(j)  (256  + 64 * (j))
#define XB_XSUB(j)  (1280 + 64 * (j))
#define XB_XGEN(j)  (2304 + 64 * (j))
#define XB_TOP      3328
#define XB_TOPGEN   3392
#define XCD_BAR_WORDS 3456
#define XB_SPIN_CAP (1u << 24)

__device__ __forceinline__ unsigned xb_ld(unsigned* p)              { return __hip_atomic_load(p, __ATOMIC_RELAXED, __HIP_MEMORY_SCOPE_AGENT); }
__device__ __forceinline__ unsigned xb_add(unsigned* p, unsigned v) { return __hip_atomic_fetch_add(p, v, __ATOMIC_RELAXED, __HIP_MEMORY_SCOPE_AGENT); }
__device__ __forceinline__ unsigned xb_xcc_id() { return (unsigned)__builtin_amdgcn_s_getreg((3 << 11) | 20) & 0xFu; }
#define XB_SPIN(cond, bar) do { unsigned _sp = 0; while (cond) { __builtin_amdgcn_s_sleep(1); \
    if ((++_sp & 255u) == 0u) { if (xb_ld(&(bar)[XB_TMO])) break; if (_sp > XB_SPIN_CAP) { atomicAdd(&(bar)[XB_TMO], 1u); break; } } } } while (0)

struct XcdBarrier { unsigned* bar; unsigned x; volatile LAS unsigned* st; };

__device__ __forceinline__ XcdBarrier xcd_barrier_post(unsigned* bar, volatile LAS unsigned* st) {
    XcdBarrier b; b.bar = bar; b.x = xb_xcc_id(); b.st = st;
    if (threadIdx.x == 0) (void)xb_add(&bar[XB_XCNT(b.x)], 1u);
    return b;
}
__device__ __forceinline__ void xcd_barrier_complete(unsigned* bar, unsigned x, unsigned& nloc, unsigned& nx) {
    const unsigned G = gridDim.x * gridDim.y * gridDim.z;
    unsigned sum, cnt, mine, sp = 0u;
    for (;;) {
        sum = 0u; cnt = 0u; mine = 0u;
#pragma unroll
        for (unsigned j = 0; j < 16; ++j) { const unsigned c = xb_ld(&bar[XB_XCNT(j)]); sum += c; cnt += (c > 0u) ? 1u : 0u; mine = (j == x) ? c : mine; }
        if (sum == G) break;
        __builtin_amdgcn_s_sleep(1);
        if ((++sp & 255u) == 0u) { if (xb_ld(&bar[XB_TMO])) break; if (sp > XB_SPIN_CAP) { atomicAdd(&bar[XB_TMO], 1u); break; } }
    }
    nloc = mine > 0u ? mine : 1u; nx = cnt > 0u ? cnt : 1u;
}
__device__ __forceinline__ void xcd_barrier(const XcdBarrier& b, bool t0) {
    asm volatile("s_waitcnt vmcnt(0)" ::: "memory");
    __syncthreads();
    if (t0) {
        unsigned* bar = b.bar;
        __builtin_amdgcn_s_waitcnt(0);
        unsigned nloc = b.st[0], nx = b.st[1];
        if (nloc == 0u) { xcd_barrier_complete(bar, b.x, nloc, nx); b.st[0] = nloc; b.st[1] = nx; }
        const unsigned old = xb_add(&bar[XB_XSUB(b.x)], 1u);
        const unsigned gen = old / nloc;
        if (old + 1u == (gen + 1u) * nloc) {
            __builtin_amdgcn_fence(__ATOMIC_RELEASE, "agent");
            asm volatile("s_waitcnt vmcnt(0)" ::: "memory");
            const unsigned og = xb_add(&bar[XB_TOP], 1u);
            const unsigned tg = og / nx;
            if (og + 1u == (tg + 1u) * nx) xb_add(&bar[XB_TOPGEN], 1u);
            else XB_SPIN(xb_ld(&bar[XB_TOPGEN]) == tg, bar);
            __builtin_amdgcn_fence(__ATOMIC_ACQUIRE, "agent");
            xb_add(&bar[XB_XGEN(b.x)], 1u);
            asm volatile("s_waitcnt vmcnt(0)" ::: "memory");
        } else {
            XB_SPIN(xb_ld(&bar[XB_XGEN(b.x)]) == gen, bar);
            __builtin_amdgcn_fence(__ATOMIC_ACQUIRE, "agent");
            asm volatile("s_waitcnt vmcnt(0)" ::: "memory");
        }
    }
    __syncthreads();
}

__device__ __forceinline__ unsigned f2bf(float f) { unsigned u = __builtin_bit_cast(unsigned, f); return (u + 0x7fffu + ((u >> 16) & 1u)) >> 16; }
__device__ __forceinline__ unsigned pk2(float lo, float hi) { return f2bf(lo) | (f2bf(hi) << 16); }
__device__ __forceinline__ float bf2f(unsigned h) { return __builtin_bit_cast(float, h << 16); }
template <int CTRL> __device__ __forceinline__ float dpp_mov(float v) { return __builtin_bit_cast(float, __builtin_amdgcn_update_dpp(0, __builtin_bit_cast(int, v), CTRL, 0xF, 0xF, true)); }
__device__ __forceinline__ float sum8_dpp(float v) { v += dpp_mov<0xB1>(v); v += dpp_mov<0x4E>(v); v += dpp_mov<0x141>(v); return v; }
template <int K> __device__ __forceinline__ float xshfl_l(float v, int lane) { return __builtin_bit_cast(float, __builtin_amdgcn_ds_bpermute((lane ^ K) << 2, __builtin_bit_cast(int, v))); }
template <int K> __device__ __forceinline__ float xshfl(float v) { return xshfl_l<K>(v, lane_id_v()); }
__device__ __forceinline__ float xadd32(float v) { return v + xshfl_l<32>(v, lane_id_v()); }
__device__ __forceinline__ float xmax32(float v) { return fmaxf(v, xshfl_l<32>(v, lane_id_v())); }
__device__ __forceinline__ float wave_sum(float v) { const int l = lane_id_v(); v += xshfl_l<1>(v, l); v += xshfl_l<2>(v, l); v += xshfl_l<4>(v, l); v += xshfl_l<8>(v, l); v += xshfl_l<16>(v, l); v += xshfl_l<32>(v, l); return v; }
__device__ __forceinline__ float wave_max(float v) { const int l = lane_id_v(); v = fmaxf(v, xshfl_l<1>(v, l)); v = fmaxf(v, xshfl_l<2>(v, l)); v = fmaxf(v, xshfl_l<4>(v, l)); v = fmaxf(v, xshfl_l<8>(v, l)); v = fmaxf(v, xshfl_l<16>(v, l)); v = fmaxf(v, xshfl_l<32>(v, l)); return v; }


__device__ __forceinline__ float sigmoidf_(float x) { return 1.0f / (1.0f + __expf(-x)); }
__device__ __forceinline__ float sigmoid_fast(float x) { return __builtin_amdgcn_rcpf(1.0f + __builtin_amdgcn_exp2f(-LOG2E * x)); }
__device__ __forceinline__ int row_modidx(int r) { return r < T_LAT ? (r >> 13) : 2; }
__device__ __forceinline__ int row_batch(int r) { return r < T_LAT ? (r >> 13) : ((r - T_LAT) >> 8); }
__device__ __forceinline__ int row_tok(int r) { return r < T_LAT ? (r & (SEQ - 1)) : SEQ + ((r - T_LAT) & (CTX - 1)); }

__device__ __forceinline__ const float* xin_row(const float* x, const float* ctx, int r) { return r < T_LAT ? x + (size_t)r * D : ctx + (size_t)(r - T_LAT) * D; }
template <class Prep, class Row>
__device__ __forceinline__ void wave_row_blocks(int T_rows, int gw, int NGW, Prep prep, Row row) {
    for (int r0 = gw * 8; r0 < T_LAT; r0 += NGW * 8) {
        prep(r0 >> 13);
#pragma unroll 2
        for (int k = 0; k < 8; ++k) row(r0 + k);
    }
    if (T_rows > T_LAT) for (int r = T_LAT + gw; r < T_rows; r += NGW) { prep(2); row(r); }
}
struct Args { const float* in[22]; float* out; unsigned char* ws; };
enum { I_X = 0, I_C, I_CTX, I_CCTX, I_WMOD, I_BMOD, I_G1, I_G2, I_WIN, I_SINK, I_RPB, I_LAMBDA, I_SUBLN, I_WBA, I_WBB, I_WBC, I_WOUT, I_PWQ, I_PKEYS, I_PU, I_PV, I_GFINAL };

__device__ __forceinline__ int rope_perm(int c) {
    if (c < 640 || (c >= 2304 && c < 3328)) { const int w = c & 63; return (c & ~63) + 2 * (w & 31) + (w >> 5); }
    return c;
}
template <bool PERM = false>
__device__ __forceinline__ void p0_transpose_item(const float* W, int K, int N, bf16* WT, LAS float* scr, int item, int lane) {
    const int nblk = N / 32, kb = item / nblk, nb = item % nblk, k0 = 64 * kb, n0 = 32 * nb;
    {
        f32x4 w[8];
        const float* src = W + (size_t)(k0 + (lane >> 3)) * N + n0 + 4 * (lane & 7);
#pragma unroll
        for (int i = 0; i < 8; ++i) w[i] = *(const GAS f32x4*)(src + (size_t)(8 * i) * N);
#pragma unroll
        for (int i = 0; i < 8; ++i) { LAS float* d = scr + (8 * i + (lane >> 3)) * 33 + 4 * (lane & 7); d[0] = w[i].x; d[1] = w[i].y; d[2] = w[i].z; d[3] = w[i].w; }
    }
    asm volatile("s_waitcnt lgkmcnt(0)" ::: "memory");
    const int c = lane & 7;
#pragma unroll
    for (int j = 0; j < 4; ++j) { const int n = (lane >> 3) + 8 * j; const LAS float* s = scr + (8 * c) * 33 + n;
        v4u o; o.x = pk2(s[0 * 33], s[1 * 33]); o.y = pk2(s[2 * 33], s[3 * 33]); o.z = pk2(s[4 * 33], s[5 * 33]); o.w = pk2(s[6 * 33], s[7 * 33]);
        const int nout = PERM ? rope_perm(n0 + n) : (n0 + n);
        *(GAS v4u*)(WT + (size_t)nout * K + k0 + 8 * c) = o; }
    asm volatile("s_waitcnt lgkmcnt(0)" ::: "memory");
}

template <int UNR = 2, int NN = 4>
__device__ __forceinline__ void sgemm_tile(f32x4 (&acc)[4][NN], const bf16* A, int lda, const bf16* Bt, int ldb, int K, int row0, int col0, int lane) {
    const int fr = lane & 15, fq = lane >> 4;
    const bf16* ap = A + (size_t)(row0 + fr) * lda + fq * 8;
    const bf16* bp = Bt + (size_t)(col0 + fr) * ldb + fq * 8;
#pragma unroll UNR
    for (int k = 0; k < K; k += 32) {
        bf16x8 a[4], b[NN];
#pragma unroll
        for (int m = 0; m < 4; ++m) a[m] = *(const GAS bf16x8*)(ap + (size_t)m * 16 * lda + k);
#pragma unroll
        for (int n = 0; n < NN; ++n) b[n] = *(const GAS bf16x8*)(bp + (size_t)n * 16 * ldb + k);
#pragma unroll
        for (int m = 0; m < 4; ++m)
#pragma unroll
            for (int n = 0; n < NN; ++n) acc[m][n] = __builtin_amdgcn_mfma_f32_16x16x32_bf16(a[m], b[n], acc[m][n], 0, 0, 0);
    }
}
template <int UNR>
__device__ __forceinline__ void sgemm32(f32x4 (&acc)[2][2], const bf16* A, int lda, const bf16* Bt, int ldb, int K, int row0, int col0, int lane) {
    const int fr = lane & 15, fq = lane >> 4;
    const bf16* ap = A + (size_t)(row0 + fr) * lda + fq * 8;
    const bf16* bp = Bt + (size_t)(col0 + fr) * ldb + fq * 8;
#pragma unroll 1
    for (int k0 = 0; k0 < K; k0 += 32 * UNR) {
        bf16x8 a[UNR][2], b[UNR][2];
#pragma unroll
        for (int u = 0; u < UNR; ++u)
#pragma unroll
            for (int m = 0; m < 2; ++m) { a[u][m] = *(const GAS bf16x8*)(ap + (size_t)m * 16 * lda + k0 + 32 * u); b[u][m] = *(const GAS bf16x8*)(bp + (size_t)m * 16 * ldb + k0 + 32 * u); }
#pragma unroll
        for (int u = 0; u < UNR; ++u)
#pragma unroll
            for (int m = 0; m < 2; ++m)
#pragma unroll
                for (int n = 0; n < 2; ++n) acc[m][n] = __builtin_amdgcn_mfma_f32_16x16x32_bf16(a[u][m], b[u][n], acc[m][n], 0, 0, 0);
    }
}
__device__ __forceinline__ void zero_acc22(f32x4 (&acc)[2][2]) { acc[0][0] = acc[0][1] = acc[1][0] = acc[1][1] = (f32x4){0.f, 0.f, 0.f, 0.f}; }
template <int NN>
__device__ __forceinline__ void zero_acc(f32x4 (&acc)[4][NN]) {
#pragma unroll
    for (int m = 0; m < 4; ++m)
#pragma unroll
        for (int n = 0; n < NN; ++n) acc[m][n] = (f32x4){0.f, 0.f, 0.f, 0.f};
}

__device__ __forceinline__ int f2ord(float f) { const int b = __builtin_bit_cast(int, f); return b ^ ((b >> 31) & 0x7fffffff); }
__device__ __forceinline__ float ord2f(int o) { const int b = o ^ ((o >> 31) & 0x7fffffff); return __builtin_bit_cast(float, b); }
__device__ __forceinline__ void top16_insert(int (&top)[16], int key) {
#pragma unroll
    for (int i = 0; i < 16; ++i) { const int hi = max(top[i], key); key = min(top[i], key); top[i] = hi; }
}
#define CE(a, b) { const int t_ = max(a, b); b = min(a, b); a = t_; }
__device__ __forceinline__ void sort16_desc(int (&v)[16]) { CE(v[0], v[1]); CE(v[3], v[2]); CE(v[4], v[5]); CE(v[7], v[6]); CE(v[8], v[9]); CE(v[11], v[10]); CE(v[12], v[13]); CE(v[15], v[14]); CE(v[0], v[2]); CE(v[1], v[3]); CE(v[6], v[4]); CE(v[7], v[5]); CE(v[8], v[10]); CE(v[9], v[11]); CE(v[14], v[12]); CE(v[15], v[13]); CE(v[0], v[1]); CE(v[2], v[3]); CE(v[5], v[4]); CE(v[7], v[6]); CE(v[8], v[9]); CE(v[10], v[11]); CE(v[13], v[12]); CE(v[15], v[14]); CE(v[0], v[4]); CE(v[1], v[5]); CE(v[2], v[6]); CE(v[3], v[7]); CE(v[12], v[8]); CE(v[13], v[9]); CE(v[14], v[10]); CE(v[15], v[11]); CE(v[0], v[2]); CE(v[1], v[3]); CE(v[4], v[6]); CE(v[5], v[7]); CE(v[10], v[8]); CE(v[11], v[9]); CE(v[14], v[12]); CE(v[15], v[13]); CE(v[0], v[1]); CE(v[2], v[3]); CE(v[4], v[5]); CE(v[6], v[7]); CE(v[9], v[8]); CE(v[11], v[10]); CE(v[13], v[12]); CE(v[15], v[14]); CE(v[0], v[8]); CE(v[1], v[9]); CE(v[2], v[10]); CE(v[3], v[11]); CE(v[4], v[12]); CE(v[5], v[13]); CE(v[6], v[14]); CE(v[7], v[15]); CE(v[0], v[4]); CE(v[1], v[5]); CE(v[2], v[6]); CE(v[3], v[7]); CE(v[8], v[12]); CE(v[9], v[13]); CE(v[10], v[14]); CE(v[11], v[15]); CE(v[0], v[2]); CE(v[1], v[3]); CE(v[4], v[6]); CE(v[5], v[7]); CE(v[8], v[10]); CE(v[9], v[11]); CE(v[12], v[14]); CE(v[13], v[15]); CE(v[0], v[1]); CE(v[2], v[3]); CE(v[4], v[5]); CE(v[6], v[7]); CE(v[8], v[9]); CE(v[10], v[11]); CE(v[12], v[13]); CE(v[14], v[15]); }
__device__ __forceinline__ void merge16_desc(int (&a)[16], const int (&b)[16]) {
#pragma unroll
    for (int i = 0; i < 16; ++i) a[i] = max(a[i], b[15 - i]);
    CE(a[0], a[8]); CE(a[1], a[9]); CE(a[2], a[10]); CE(a[3], a[11]); CE(a[4], a[12]); CE(a[5], a[13]); CE(a[6], a[14]); CE(a[7], a[15]); CE(a[0], a[4]); CE(a[1], a[5]); CE(a[2], a[6]); CE(a[3], a[7]); CE(a[8], a[12]); CE(a[9], a[13]); CE(a[10], a[14]); CE(a[11], a[15]); CE(a[0], a[2]); CE(a[1], a[3]); CE(a[4], a[6]); CE(a[5], a[7]); CE(a[8], a[10]); CE(a[9], a[11]); CE(a[12], a[14]); CE(a[13], a[15]); CE(a[0], a[1]); CE(a[2], a[3]); CE(a[4], a[5]); CE(a[6], a[7]); CE(a[8], a[9]); CE(a[10], a[11]); CE(a[12], a[13]); CE(a[14], a[15]); }
#undef CE


typedef float f32x16 __attribute__((ext_vector_type(16)));
typedef short s16x4 __attribute__((ext_vector_type(4)));
typedef __bf16 bf16x2_t __attribute__((ext_vector_type(2)));
__device__ __forceinline__ unsigned cvtpk(float lo, float hi) { f32x2 v = {lo, hi}; bf16x2_t b = __builtin_convertvector(v, bf16x2_t); return __builtin_bit_cast(unsigned, b); }
constexpr int CK_PITCH = 144, CV_PITCH = 320;
constexpr int CK_SZ = 64 * CK_PITCH, CV_SZ = 64 * CV_PITCH;
constexpr float C_THR_RAW = 8.0f / SCL2;

template <int NDV, bool HASCM, class RowFn, class UseFn, class ElemFn, class CmFn>
__device__ __forceinline__ void attn64_pass(f32x16 (&o)[NDV], float& mrun, float& lpart, const bf16x8 (&qf)[4], const bf16* kg, int kpitch, const bf16* vg, int vpitch,
                                            int ntiles, RowFn tile_row, UseFn use_tile, ElemFn elem, const f32x16 (&cm)[2], CmFn cm_tile, LAS unsigned char* L, int lane, int tid) {
    constexpr int VP = NDV * 64 + 64, VSZ = 64 * VP, NVP = NDV / 2;
    const int r32 = lane & 31, hi = lane >> 5;
    const int krow_s = tid >> 3, kch_s = tid & 7;
    const int vrow_s = (NDV == 2) ? (tid >> 3) : (tid >> 4), vch_s = (NDV == 2) ? (tid & 7) : (tid & 15);
    LAS unsigned char* Kb0 = L; LAS unsigned char* Vb0 = L + 2 * CK_SZ;
    __syncthreads();
    {
        const int tr = tile_row(0);
        const v4u kr = *(const GAS v4u*)(kg + (size_t)tr * kpitch);
        *(LAS v4u*)(Kb0 + krow_s * CK_PITCH + kch_s * 16) = kr;
#pragma unroll
        for (int i = 0; i < NVP; ++i) { const v4u v = *(const GAS v4u*)(vg + (size_t)(tr + 32 * i) * vpitch); *(LAS v4u*)(Vb0 + (vrow_s + 32 * i) * VP + vch_s * 16) = v; }
    }
    v4u kr, vr[NVP];
    { const int tr = tile_row(ntiles > 1 ? 1 : 0); kr = *(const GAS v4u*)(kg + (size_t)tr * kpitch);
#pragma unroll
      for (int i = 0; i < NVP; ++i) vr[i] = *(const GAS v4u*)(vg + (size_t)(tr + 32 * i) * vpitch); }
    __syncthreads();
#pragma unroll 1
    for (int j = 0; j < ntiles; ++j) {
        const int cur = j & 1;
        const LAS unsigned char* Kb = Kb0 + cur * CK_SZ; const LAS unsigned char* Vb = Vb0 + cur * VSZ;
        const bool more = (j + 1 < ntiles);
        v4u kr2, vr2[NVP];
        { const int tr = tile_row(j + 2 < ntiles ? j + 2 : ntiles - 1); kr2 = *(const GAS v4u*)(kg + (size_t)tr * kpitch);
#pragma unroll
            for (int i = 0; i < NVP; ++i) vr2[i] = *(const GAS v4u*)(vg + (size_t)(tr + 32 * i) * vpitch); }
        if (use_tile(j)) {
            f32x16 st[2];
            if (HASCM && cm_tile(j)) {
#pragma unroll
                for (int kb = 0; kb < 2; ++kb) {
#pragma unroll
                    for (int ks = 0; ks < 4; ++ks) {
                        const bf16x8 kf = *(const LAS bf16x8*)(Kb + (kb * 32 + r32) * CK_PITCH + ks * 32 + hi * 16);
                        st[kb] = __builtin_amdgcn_mfma_f32_32x32x16_bf16(kf, qf[ks], ks == 0 ? cm[kb] : st[kb], 0, 0, 0);
                    }
                }
            } else {
#pragma unroll
                for (int kb = 0; kb < 2; ++kb) {
#pragma unroll
                    for (int r = 0; r < 16; ++r) st[kb][r] = 0.f;
#pragma unroll
                    for (int ks = 0; ks < 4; ++ks) {
                        const bf16x8 kf = *(const LAS bf16x8*)(Kb + (kb * 32 + r32) * CK_PITCH + ks * 32 + hi * 16);
                        st[kb] = __builtin_amdgcn_mfma_f32_32x32x16_bf16(kf, qf[ks], st[kb], 0, 0, 0);
                    }
                }
            }
            elem(st, j);
            float mx = st[0][0];
#pragma unroll
            for (int r = 1; r < 16; ++r) mx = fmaxf(mx, st[0][r]);
#pragma unroll
            for (int r = 0; r < 16; ++r) mx = fmaxf(mx, st[1][r]);
            mx = xmax32(mx);
            if (__builtin_amdgcn_ballot_w64(mx > mrun + C_THR_RAW) != 0ull) {
                const float mn = fmaxf(mrun, mx);
                const float alpha = __builtin_amdgcn_exp2f((mrun - mn) * SCL2);
#pragma unroll
                for (int d = 0; d < NDV; ++d)
#pragma unroll
                    for (int r = 0; r < 16; ++r) o[d][r] *= alpha;
                lpart *= alpha; mrun = mn;
            }
            const float nmc = -mrun * SCL2;
            float ls = 0.f;
#pragma unroll
            for (int kb = 0; kb < 2; ++kb)
#pragma unroll
                for (int r = 0; r < 16; ++r) { const float p = __builtin_amdgcn_exp2f(fmaf(st[kb][r], SCL2, nmc)); st[kb][r] = p; ls += p; }
            lpart += ls;
            const int q4 = (lane & 15) >> 2, p4 = lane & 3, grp = (lane >> 4) & 1;
            const LAS unsigned char* vbase = Vb + (4 * hi + q4) * VP + (16 * grp + 4 * p4) * 2;
#pragma unroll
            for (int kb = 0; kb < 2; ++kb)
#pragma unroll
                for (int ss = 0; ss < 2; ++ss) {
                    v4u pw;
#pragma unroll
                    for (int i2 = 0; i2 < 4; ++i2) pw[i2] = cvtpk(st[kb][8 * ss + 2 * i2], st[kb][8 * ss + 2 * i2 + 1]);
                    const bf16x8 pb = __builtin_bit_cast(bf16x8, pw);
#pragma unroll
                    for (int d = 0; d < NDV; ++d) {
                        const LAS unsigned char* va = vbase + (kb * 32 + 16 * ss) * VP + d * 64;
                        const s16x4 lo = __builtin_bit_cast(s16x4, __builtin_amdgcn_ds_read_tr16_b64_v4i16((LAS s16x4*)va));
                        const s16x4 hh = __builtin_bit_cast(s16x4, __builtin_amdgcn_ds_read_tr16_b64_v4i16((LAS s16x4*)(va + 8 * VP)));
                        const bf16x8 vf = __builtin_shufflevector(lo, hh, 0, 1, 2, 3, 4, 5, 6, 7);
                        o[d] = __builtin_amdgcn_mfma_f32_32x32x16_bf16(vf, pb, o[d], 0, 0, 0);
                    }
                }
        }
        if (more) {
            LAS unsigned char* Kn = Kb0 + (cur ^ 1) * CK_SZ; LAS unsigned char* Vn = Vb0 + (cur ^ 1) * VSZ;
            *(LAS v4u*)(Kn + krow_s * CK_PITCH + kch_s * 16) = kr;
#pragma unroll
            for (int i = 0; i < NVP; ++i) *(LAS v4u*)(Vn + (vrow_s + 32 * i) * VP + vch_s * 16) = vr[i];
        }
        kr = kr2;
#pragma unroll
        for (int i = 0; i < NVP; ++i) vr[i] = vr2[i];
        __syncthreads();
    }
}
__device__ __forceinline__ void attn64_store(const f32x16 (&o)[2], float inv, bf16* yrow, int hi) {
#pragma unroll
    for (int d = 0; d < 2; ++d)
#pragma unroll
        for (int g4 = 0; g4 < 4; ++g4) {
            v2u w; w.x = cvtpk(o[d][4 * g4] * inv, o[d][4 * g4 + 1] * inv); w.y = cvtpk(o[d][4 * g4 + 2] * inv, o[d][4 * g4 + 3] * inv);
            *(GAS v2u*)(yrow + d * 32 + 8 * g4 + 4 * hi) = w;
        }
}

namespace pg8 {
typedef unsigned short bf16_t;
constexpr int BM = 256, BK = 64, HALF = 128, HTB = HALF * BK * 2, STAGE_BYTES = 8 * HTB, NXCD = 8, WGM = 8;
__host__ __device__ __forceinline__ int lds_byte(int r, int c) { const int st = (r >> 4) * 2 + (c >> 5), rr = r & 15, cc = c & 31, ob = rr * 64 + cc * 2; return st * 1024 + (ob ^ (((ob >> 9) & 1) << 5)); }
__host__ __device__ __forceinline__ void stage_rc(int b, int& R, int& C) { const int st = b / 1024, sb = b % 1024, swz = sb ^ (((sb >> 9) & 1) << 5); R = (st >> 1) * 16 + swz / 64; C = (st & 1) * 32 + (swz % 64) / 2; }
__host__ __device__ __forceinline__ int perm32(int rho) { const int n = rho >> 4, i = rho & 15; return 8 * (i >> 2) + 4 * n + (i & 3); }
struct Unit { int pm, pn, seg; };
struct Gemm { const bf16_t* A; const bf16_t* Bt; int lda, ldb, K; size_t a_seg, b_seg; };
struct TileOrder {
    int nM, nN, nwg, G, c;
    __device__ void init(int M, int N, int G_, int c_) { nM = M / BM; nN = N / BM; nwg = nM * nN; G = G_; c = c_; }
    __device__ bool tile(int i, int& pm, int& pn) const {
        const long L = (long)i * G + c; if (L >= nwg) return false;
        int wgid = (int)L; { const int q = nwg / NXCD, r = nwg % NXCD, xcd = wgid % NXCD, off = wgid / NXCD; wgid = (xcd < r ? xcd * (q + 1) : r * (q + 1) + (xcd - r) * q) + off; }
        const int nig = WGM * nN, gid = wgid / nig, fm = gid * WGM, gsz = (nM - fm) < WGM ? (nM - fm) : WGM;
        pm = fm + ((wgid % nig) % gsz); pn = (wgid % nig) / gsz; return true;
    }
};
template <int NSEG> struct SegOrder {
    TileOrder T;
    __device__ bool next(int i, Unit& u) const { u.seg = i % NSEG; return T.tile(i / NSEG, u.pm, u.pn); }
};
template <class Epi, class Sched>
__device__ __forceinline__ void gemm_phase(LAS unsigned char* lds, const Gemm g, const Sched& S, const Epi& E, int wid) {
    const int lane = lane_id_v(), tid = wid * 64 + lane,
              wr = wid >> 2, wc = wid & 3, fr = lane & 15, fq = lane >> 4;
    const int K = g.K, nt = K / BK;
    unsigned voffA[2], voffB[2];
#pragma unroll
    for (int i = 0; i < 2; ++i) { int R, C; stage_rc(tid * 16 + i * 8192, R, C); const int Rb = (R & ~31) + perm32(R & 31);
        voffA[i] = (unsigned)(R * g.lda + C) * 2u; voffB[i] = (unsigned)(Rb * g.ldb + C) * 2u; }
    const size_t kstep = (size_t)(BK * 2);
    const size_t hstepA = (size_t)HALF * g.lda * 2, hstepB = (size_t)HALF * g.ldb * 2;
    const unsigned ldsw = (unsigned)wid * 1024u;
    const int aoff = lds_byte(wr * 64 + fr, fq * 8), boff = lds_byte(wc * 32 + fr, fq * 8);
#define PG8_SA(b, h) (((b) * 2 + (h)) * HTB)
#define PG8_SB(b, h) ((4 + (b) * 2 + (h)) * HTB)
#define PG8_STAGE(bufoff, gbase, voff) do { _Pragma("unroll") for (int _i = 0; _i < 2; ++_i) \
        __builtin_amdgcn_global_load_lds((const unsigned*)((const char*)(gbase) + (voff)[_i]), (LAS unsigned*)(lds + (bufoff) + ldsw + _i * 8192), 16, 0, 0); } while (0)
#define PG8_LDA(dst, b, h) do { _Pragma("unroll") for (int m = 0; m < 4; ++m) _Pragma("unroll") for (int k = 0; k < 2; ++k) dst[m][k] = *(const LAS bf16x8*)(lds + PG8_SA(b, h) + aoff + m * 2048 + k * 1024); } while (0)
#define PG8_LDB(dst, b, h) do { _Pragma("unroll") for (int n = 0; n < 2; ++n) _Pragma("unroll") for (int k = 0; k < 2; ++k) dst[n][k] = *(const LAS bf16x8*)(lds + PG8_SB(b, h) + boff + n * 2048 + k * 1024); } while (0)
#define PG8_MMA(ai, bj, At, Bt) do { __builtin_amdgcn_s_setprio(1); _Pragma("unroll") for (int m = 0; m < 4; ++m) _Pragma("unroll") for (int n = 0; n < 2; ++n) _Pragma("unroll") for (int k = 0; k < 2; ++k) \
        acc[ai][bj][m][n] = __builtin_amdgcn_mfma_f32_16x16x32_bf16(Bt[n][k], At[m][k], acc[ai][bj][m][n], 0, 0, 0); __builtin_amdgcn_s_setprio(0); } while (0)
#define PG8_WAIT_V(n) asm volatile("s_waitcnt vmcnt(" #n ")" ::: "memory")
#define PG8_WAIT_L(n) asm volatile("s_waitcnt lgkmcnt(" #n ")" ::: "memory")
#define PG8_BAR __builtin_amdgcn_s_barrier()
#define PG8_SCHED __builtin_amdgcn_sched_barrier(0)
#define PG8_ABASE(u) ((const char*)g.A + ((size_t)(u).seg * g.a_seg + (size_t)(u).pm * BM * g.lda) * 2)
#define PG8_BBASE(u) ((const char*)g.Bt + ((size_t)(u).seg * g.b_seg + (size_t)(u).pn * BM * g.ldb) * 2)
    Unit cur, nxt; int ui = 0;
    if (!S.next(0, cur)) return;
    f32x4 acc[2][2][4][2];
#pragma unroll
    for (int a = 0; a < 2; ++a)
#pragma unroll
        for (int b = 0; b < 2; ++b)
#pragma unroll
            for (int m = 0; m < 4; ++m)
#pragma unroll
                for (int n = 0; n < 2; ++n) acc[a][b][m][n] = (f32x4){0.f, 0.f, 0.f, 0.f};
    bf16x8 At[4][2], B0[2][2], B1[2][2];
    const char* cA = PG8_ABASE(cur); const char* cB = PG8_BBASE(cur);
    PG8_STAGE(PG8_SB(0, 0), cB, voffB); PG8_STAGE(PG8_SB(0, 1), cB + hstepB, voffB); PG8_STAGE(PG8_SA(0, 0), cA, voffA); PG8_STAGE(PG8_SA(0, 1), cA + hstepA, voffA);
    if (wr == 1) PG8_BAR;
    PG8_WAIT_V(2); PG8_BAR;
    PG8_STAGE(PG8_SB(1, 0), cB + kstep, voffB); PG8_STAGE(PG8_SA(1, 0), cA + kstep, voffA); PG8_STAGE(PG8_SB(1, 1), cB + hstepB + kstep, voffB);
    PG8_WAIT_V(6); PG8_BAR;
    for (;;) {
        const bool has_next = S.next(ui + 1, nxt);
        const char* nA = has_next ? PG8_ABASE(nxt) : cA; const char* nB = has_next ? PG8_BBASE(nxt) : cB;
        for (int t = 0; t < nt; t += 2) {
            const bool lastk = (t == nt - 2);
            const char* a1 = cA + (size_t)(t + 1) * kstep;
            const char* a2 = lastk ? nA : cA + (size_t)(t + 2) * kstep; const char* b2 = lastk ? nB : cB + (size_t)(t + 2) * kstep;
            const char* a3 = a2 + kstep; const char* b3 = b2 + kstep;
            PG8_LDB(B0, 0, 0); PG8_LDB(B1, 0, 1); PG8_SCHED; PG8_LDA(At, 0, 0); PG8_STAGE(PG8_SA(1, 1), a1 + hstepA, voffA);
            PG8_WAIT_V(8); PG8_WAIT_L(0); PG8_BAR; PG8_MMA(0, 0, At, B0); PG8_MMA(0, 1, At, B1); PG8_BAR; PG8_SCHED;
            PG8_LDA(At, 0, 1); PG8_STAGE(PG8_SB(0, 0), b2, voffB); PG8_STAGE(PG8_SB(0, 1), b2 + hstepB, voffB); PG8_STAGE(PG8_SA(0, 0), a2, voffA);
            PG8_WAIT_V(8); PG8_WAIT_L(0); PG8_BAR; PG8_MMA(1, 0, At, B0); PG8_MMA(1, 1, At, B1); PG8_BAR; PG8_SCHED;
            PG8_LDB(B0, 1, 0); PG8_LDB(B1, 1, 1); PG8_SCHED; PG8_LDA(At, 1, 0); PG8_STAGE(PG8_SA(0, 1), a2 + hstepA, voffA);
            PG8_WAIT_V(8); PG8_WAIT_L(0); PG8_BAR; PG8_MMA(0, 0, At, B0); PG8_MMA(0, 1, At, B1); PG8_BAR; PG8_SCHED;
            PG8_LDA(At, 1, 1); PG8_STAGE(PG8_SB(1, 0), b3, voffB); PG8_STAGE(PG8_SB(1, 1), b3 + hstepB, voffB); PG8_STAGE(PG8_SA(1, 0), a3, voffA);
            PG8_WAIT_V(8); PG8_WAIT_L(0); PG8_BAR; PG8_MMA(1, 0, At, B0); PG8_MMA(1, 1, At, B1); PG8_BAR; PG8_SCHED;
        }
        if (wr == 0) PG8_BAR;
        E(acc, cur, wr, wc, fr, fq);
        if (!has_next) break;
#pragma unroll
        for (int a = 0; a < 2; ++a)
#pragma unroll
            for (int b = 0; b < 2; ++b)
#pragma unroll
                for (int m = 0; m < 4; ++m)
#pragma unroll
                    for (int n = 0; n < 2; ++n) acc[a][b][m][n] = (f32x4){0.f, 0.f, 0.f, 0.f};
        cur = nxt; cA = nA; cB = nB; ++ui;
        if (wr == 1) PG8_BAR;
    }
    PG8_WAIT_V(0);
    PG8_BAR;
#undef PG8_SA
#undef PG8_SB
#undef PG8_STAGE
#undef PG8_LDA
#undef PG8_LDB
#undef PG8_MMA
#undef PG8_WAIT_V
#undef PG8_WAIT_L
#undef PG8_BAR
#undef PG8_SCHED
#undef PG8_ABASE
#undef PG8_BBASE
}
}

__device__ __forceinline__ v4u pack8(const f32x4& a, const f32x4& b) { v4u w; w.x = cvtpk(a.x, a.y); w.y = cvtpk(a.z, a.w); w.z = cvtpk(b.x, b.y); w.w = cvtpk(b.z, b.w); return w; }
struct EpiInProj {
    bf16 *AQ, *AK, *AVT, *BQ, *BK, *BVT, *CQ, *CK, *CV, *SG; const float *COS, *SIN;
    __device__ __forceinline__ void operator()(const f32x4 (&acc)[2][2][4][2], const pg8::Unit& u, int wr, int wc, int fr, int fq) const {
        asm volatile("" : "+v"(fr), "+v"(fq));
#pragma unroll
        for (int bj = 0; bj < 2; ++bj) {
            const int cblk = u.pn * 256 + bj * 128;
            const int cw = wc * 32 + 8 * fq;
            bf16* dst; int pitch, cbase; int kind;
            int nh = 1, hd = 0; float qs = 1.0f;
            if (cblk < 512)       { dst = AQ; pitch = 512; cbase = cblk; kind = 1; }
            else if (cblk < 640)  { dst = AK; pitch = 128; cbase = cblk - 512; kind = 1; }
            else if (cblk < 768)  { dst = AVT; pitch = 128; cbase = cblk - 640; kind = 0; }
            else if (cblk < 1280) { dst = BQ; pitch = 512; cbase = cblk - 768; kind = 0; }
            else if (cblk < 1792) { dst = BK; pitch = 512; cbase = cblk - 1280; kind = 0; }
            else if (cblk < 2304) { dst = BVT; pitch = 512; cbase = cblk - 1792; kind = 0; }
            else if (cblk < 2816) { dst = CQ; pitch = 512; cbase = cblk - 2304; kind = 1; qs = SCL2; }
            else if (cblk < 3328) { dst = CK; pitch = 512; cbase = cblk - 2816; kind = 1; }
            else if (cblk < 3840) { dst = CV; pitch = 512; cbase = cblk - 3328; kind = 0; }
            else                  { dst = SG; pitch = 3072; cbase = cblk - 3840; kind = 3; }
#pragma unroll
            for (int ai = 0; ai < 2; ++ai)
#pragma unroll
                for (int m = 0; m < 4; ++m) {
                    const int row = u.pm * 256 + ai * 128 + wr * 64 + m * 16 + fr;
                    f32x4 v0 = acc[ai][bj][m][0], v1 = acc[ai][bj][m][1];
                    if (kind == 1) {
                        if (row < T_LAT) {
                            const int t = row & (SEQ - 1), i0 = (cw & 63) >> 1;
                            const f32x4 cs = *(const GAS f32x4*)(COS + t * 32 + i0), sn = *(const GAS f32x4*)(SIN + t * 32 + i0);
                            const f32x4 a = v0, b = v1;
                            v0.x = a.x * cs.x - a.y * sn.x; v0.y = a.y * cs.x + a.x * sn.x; v0.z = a.z * cs.y - a.w * sn.y; v0.w = a.w * cs.y + a.z * sn.y;
                            v1.x = b.x * cs.z - b.y * sn.z; v1.y = b.y * cs.z + b.x * sn.z; v1.z = b.z * cs.w - b.w * sn.w; v1.w = b.w * cs.w + b.z * sn.w;
                        }
                        *(GAS v4u*)(dst + (size_t)row * pitch + cbase + cw) = pack8(v0 * qs, v1 * qs);
                    } else if (kind == 0) {
                        *(GAS v4u*)(dst + (size_t)row * pitch + cbase + cw) = pack8(v0, v1);
                    } else if (kind == 3) {
                        v0.x = sigmoid_fast(v0.x); v0.y = sigmoid_fast(v0.y); v0.z = sigmoid_fast(v0.z); v0.w = sigmoid_fast(v0.w);
                        v1.x = sigmoid_fast(v1.x); v1.y = sigmoid_fast(v1.y); v1.z = sigmoid_fast(v1.z); v1.w = sigmoid_fast(v1.w);
                        *(GAS v4u*)(dst + (size_t)row * pitch + cbase + cw) = pack8(v0, v1);
                    } else {
                        const int hc = hd + cw, head = hc >> 6, d = hc & 63;
                        const int b = row_batch(row), tok = row_tok(row);
                        bf16* vp = dst + ((size_t)(b * nh + head) * 64 + d) * NTOK + tok;
                        vp[0 * NTOK] = (bf16)f2bf(v0.x); vp[1 * NTOK] = (bf16)f2bf(v0.y); vp[2 * NTOK] = (bf16)f2bf(v0.z); vp[3 * NTOK] = (bf16)f2bf(v0.w);
                        vp[4 * NTOK] = (bf16)f2bf(v1.x); vp[5 * NTOK] = (bf16)f2bf(v1.y); vp[6 * NTOK] = (bf16)f2bf(v1.z); vp[7 * NTOK] = (bf16)f2bf(v1.w);
                    }
                }
        }
    }
};
__device__ __forceinline__ void unpack8(const v4u& w, f32x4& a, f32x4& b) {
    a = (f32x4){bf2f(w.x & 0xffffu), bf2f(w.x >> 16), bf2f(w.y & 0xffffu), bf2f(w.y >> 16)}; b = (f32x4){bf2f(w.z & 0xffffu), bf2f(w.z >> 16), bf2f(w.w & 0xffffu), bf2f(w.w >> 16)};
}
struct EpiBranch {
    const bf16* SG; bf16* MG;
    __device__ __forceinline__ void operator()(const f32x4 (&acc)[2][2][4][2], const pg8::Unit& u, int wr, int wc, int fr, int fq) const {
        asm volatile("" : "+v"(fr), "+v"(fq));
        const size_t r0 = (size_t)(u.pm * 256 + wr * 64 + fr); const int c0 = u.pn * 256 + wc * 32 + 8 * fq;
        const bf16* gbase = SG + r0 * 3072 + u.seg * 1024 + c0; bf16* mbase = MG + r0 * D + c0;
#pragma unroll
        for (int ai = 0; ai < 2; ++ai) {
            v4u wg[8], wp[8];
#pragma unroll
            for (int c = 0; c < 8; ++c) wg[c] = *(const GAS v4u*)(gbase + (size_t)(ai * 128 + (c >> 1) * 16) * 3072 + (c & 1) * 128);
            if (u.seg > 0) {
#pragma unroll
                for (int c = 0; c < 8; ++c) wp[c] = *(const GAS v4u*)(mbase + (size_t)(ai * 128 + (c >> 1) * 16) * D + (c & 1) * 128);
            }
#pragma unroll
            for (int c = 0; c < 8; ++c) {
                f32x4 g0, g1; unpack8(wg[c], g0, g1);
                f32x4 v0 = g0 * acc[ai][c & 1][c >> 1][0], v1 = g1 * acc[ai][c & 1][c >> 1][1];
                if (u.seg > 0) { f32x4 p0, p1; unpack8(wp[c], p0, p1); v0 += p0; v1 += p1; }
                *(GAS v4u*)(mbase + (size_t)(ai * 128 + (c >> 1) * 16) * D + (c & 1) * 128) = pack8(v0, v1);
            }
        }
    }
};
struct EpiOut {
    float* X; const float* gtl; const float* xin; const float* cin;
    __device__ __forceinline__ void operator()(const f32x4 (&acc)[2][2][4][2], const pg8::Unit& u, int wr, int wc, int fr, int fq) const {
        asm volatile("" : "+v"(fr), "+v"(fq));
#pragma unroll
        for (int ai = 0; ai < 2; ++ai)
#pragma unroll
            for (int m = 0; m < 4; ++m) {
                const int row = u.pm * 256 + ai * 128 + wr * 64 + m * 16 + fr;
                const float* gt = gtl + (size_t)row_modidx(row) * 6 * D + 2 * D;
#pragma unroll
                for (int bj = 0; bj < 2; ++bj) {
                    const int col = u.pn * 256 + bj * 128 + wc * 32 + 8 * fq;
                    GAS f32x4* xp = (GAS f32x4*)(X + (size_t)row * D + col);
                    const GAS f32x4* sp = xin ? (const GAS f32x4*)(xin_row(xin, cin, row) + col) : (const GAS f32x4*)xp;
                    const f32x4 g0 = *(const GAS f32x4*)(gt + col), g1 = *(const GAS f32x4*)(gt + col + 4);
                    xp[0] = sp[0] + g0 * acc[ai][bj][m][0]; xp[1] = sp[1] + g1 * acc[ai][bj][m][1];
                }
            }
    }
};
struct EpiStore {
    bf16* O; int ldc;
    __device__ __forceinline__ void operator()(const f32x4 (&acc)[2][2][4][2], const pg8::Unit& u, int wr, int wc, int fr, int fq) const {
        asm volatile("" : "+v"(fr), "+v"(fq));
#pragma unroll
        for (int ai = 0; ai < 2; ++ai)
#pragma unroll
            for (int m = 0; m < 4; ++m) {
                const int row = u.pm * 256 + ai * 128 + wr * 64 + m * 16 + fr;
#pragma unroll
                for (int bj = 0; bj < 2; ++bj) {
                    const int col = u.pn * 256 + bj * 128 + wc * 32 + 8 * fq;
                    *(GAS v4u*)(O + (size_t)row * ldc + col) = pack8(acc[ai][bj][m][0], acc[ai][bj][m][1]);
                }
            }
    }
};

__global__ void __launch_bounds__(NTHREADS, 2) mega_fwd(Args args) {
    extern __shared__ __attribute__((aligned(16))) unsigned char lds[];
    LAS unsigned char* L = (LAS unsigned char*)lds;
    volatile LAS unsigned* MISC = (volatile LAS unsigned*)(L + MISC_OFF);
    const int wave = __builtin_amdgcn_readfirstlane((int)threadIdx.x >> 6);
    const int lane = lane_id_v(), tid = wave * 64 + lane;
    const int fr = lane & 15, fq = lane >> 4;
    const int G = gridDim.x;
    const int vcu = (G % 8 == 0) ? (int)(blockIdx.x % 8) * (G / 8) + (int)(blockIdx.x / 8) : (int)blockIdx.x;
    for (int u = tid; u < (LDS_BYTES - 131072) / 4; u += NTHREADS) ((LAS unsigned*)(L + 131072))[u] = 0u;
    __syncthreads();
    unsigned char* ws = args.ws;
    gu32* ctl = (gu32*)(ws + WS_CTL);
    (void)xcd_barrier_post((unsigned*)(ctl + CW_BAR), MISC + 8);
    if (tid == 0) MISC[12] = xb_add((unsigned*)(ctl + CW_RANK) + 64 * xb_xcc_id(), 1u);
    __syncthreads();
#define GRID_BAR() do { unsigned* bp_ = (unsigned*)(args.ws + WS_CTL) + CW_BAR; asm volatile("" : "+s"(bp_)); XcdBarrier b_; b_.bar = bp_; b_.x = xb_xcc_id(); b_.st = MISC + 8; xcd_barrier(b_, wave == 0 && lane_id_v() == 0); } while (0)
    const int gw = vcu * NWAVES + wave, NGW = G * NWAVES;
    const int NGT = G * NTHREADS;

#define PHASE_PTRS \
    unsigned char* wsq = args.ws; asm volatile("" : "+s"(wsq)); \
    const float* const* IN_ = (const float* const*)__builtin_amdgcn_kernarg_segment_ptr(); asm volatile("" : "+s"(IN_)); \
    float* MODV = (float*)(wsq + WS_MOD); float* COS = (float*)(wsq + WS_COS); float* SIN = (float*)(wsq + WS_SIN); \
    bf16* WIN = (bf16*)(wsq + WS_WIN); bf16* WB = (bf16*)(wsq + WS_WB); bf16* WO = (bf16*)(wsq + WS_WO); bf16* WQ = (bf16*)(wsq + WS_WQ); bf16* KEYS = (bf16*)(wsq + WS_KEYS); \
    float* X = (float*)(wsq + WS_X); bf16* H = (bf16*)(wsq + WS_H); bf16* Y = (bf16*)(wsq + WS_Y); bf16* MG = (bf16*)(wsq + WS_MG); \
    unsigned* EI = (unsigned*)(wsq + WS_EI); float* EG = (float*)(wsq + WS_EG); \
    unsigned char* U8 = wsq + WS_U8; unsigned char* V8 = wsq + WS_V8; float* SCU = (float*)(wsq + WS_SCU); float* SCV = SCU + DEPTH * 16384; \
    bf16* AQ = (bf16*)(wsq + WS_AQ); bf16* AK = (bf16*)(wsq + WS_AK); bf16* AVT = (bf16*)(wsq + WS_AVT); \
    bf16* BQ = (bf16*)(wsq + WS_BQ); bf16* BK = (bf16*)(wsq + WS_BK); bf16* BVT = (bf16*)(wsq + WS_BVT); \
    bf16* CQ = (bf16*)(wsq + WS_CQ); bf16* CK = (bf16*)(wsq + WS_CK); bf16* CVT = (bf16*)(wsq + WS_CVT); \
    bf16* SG = (bf16*)(wsq + WS_SG); bf16* Q2 = (bf16*)(wsq + WS_Q2); float* SC = (float*)(wsq + WS_SC); \
    (void)MODV; (void)COS; (void)SIN; (void)WIN; (void)WB; (void)WO; (void)WQ; (void)KEYS; (void)X; (void)H; (void)Y; (void)MG; (void)EI; (void)EG; (void)U8; (void)V8; (void)SCU; (void)SCV; \
    (void)AQ; (void)AK; (void)AVT; (void)BQ; (void)BK; (void)BVT; (void)CQ; (void)CK; (void)CVT; (void)SG; (void)Q2; (void)SC; (void)IN_;
#define LAYER_PTRS const float* modl = MODV + (size_t)layer * 3 * 6 * D; const bf16* WINl = WIN + (size_t)layer * IN_W * D; (void)modl; (void)WINl;

#ifndef SKIP_P0
        { PHASE_PTRS
        for (int rep_ = 0; rep_ < REP_P0; ++rep_) {
    {
        LAS float* scr = (LAS float*)(L + wave * 16384);
        int gt = vcu * NTHREADS + tid; asm volatile("" : "+v"(gt));
        constexpr int I_IN = (D / 64) * (IN_W / 32), I_BR = (512 / 64) * (D / 32), I_O = (D / 64) * (D / 32), I_Q = (D / 64) * (2048 / 32);
        constexpr int PER_LAYER = I_IN + 3 * I_BR + I_O + I_Q;
        for (int rp_ = 0; rp_ < REP_P0A; ++rp_)
        for (int it = gw; it < DEPTH * PER_LAYER; it += NGW) {
            const int l = it / PER_LAYER; int r = it % PER_LAYER;
            if (r < I_IN) { p0_transpose_item<true>(IN_[I_WIN] + (size_t)l * D * IN_W, D, IN_W, WIN + (size_t)l * IN_W * D, scr, r, lane); continue; } r -= I_IN;
            if (r < I_BR) { p0_transpose_item(IN_[I_WBA] + (size_t)l * 512 * D, 512, D, WB + (size_t)(l * 3 + 0) * D * 512, scr, r, lane); continue; } r -= I_BR;
            if (r < I_BR) { p0_transpose_item(IN_[I_WBB] + (size_t)l * 512 * D, 512, D, WB + (size_t)(l * 3 + 1) * D * 512, scr, r, lane); continue; } r -= I_BR;
            if (r < I_BR) { p0_transpose_item(IN_[I_WBC] + (size_t)l * 512 * D, 512, D, WB + (size_t)(l * 3 + 2) * D * 512, scr, r, lane); continue; } r -= I_BR;
            if (r < I_O) { p0_transpose_item(IN_[I_WOUT] + (size_t)l * D * D, D, D, WO + (size_t)l * D * D, scr, r, lane); continue; } r -= I_O;
            p0_transpose_item(IN_[I_PWQ] + (size_t)l * D * 2048, D, 2048, WQ + (size_t)l * 2048 * D, scr, r, lane);
        }
        for (int i = gt; i < DEPTH * 16 * 128 * 128 / 4; i += NGT) {
            const f32x4 v = *((const GAS f32x4*)IN_[I_PKEYS] + i);
            v2u o; o.x = pk2(v.x, v.y); o.y = pk2(v.z, v.w); *((GAS v2u*)KEYS + i) = o;
        }
        {
            LAS float* red = (LAS float*)(L + 9216);
            for (int rp_ = 0; rp_ < REP_P0D; ++rp_)
            for (int it = vcu; it < DEPTH * 96; it += G) {
                const int l = it / 96, nc = it % 96, n = nc * 64 + lane;
                const float* wm = IN_[I_WMOD] + (size_t)l * D * 6 * D + n;
                float a0 = 0.f, a1 = 0.f, a2 = 0.f;
#pragma unroll 1
                for (int half = 0; half < 2; ++half) {
                    const int kb = wave * 128 + half * 64;
                    const float c0 = IN_[I_C][kb + lane], c1 = IN_[I_C][D + kb + lane], c2 = IN_[I_CCTX][kb + lane];
                    const int s0 = __builtin_bit_cast(int, c0 * sigmoidf_(c0)), s1 = __builtin_bit_cast(int, c1 * sigmoidf_(c1)), s2 = __builtin_bit_cast(int, c2 * sigmoidf_(c2));
#pragma unroll
                    for (int kk = 0; kk < 64; ++kk) {
                        const float w = wm[(size_t)(kb + kk) * 6 * D];
                        a0 += __builtin_bit_cast(float, __builtin_amdgcn_readlane(s0, kk)) * w;
                        a1 += __builtin_bit_cast(float, __builtin_amdgcn_readlane(s1, kk)) * w;
                        a2 += __builtin_bit_cast(float, __builtin_amdgcn_readlane(s2, kk)) * w;
                    }
                }
                red[(wave * 3 + 0) * 64 + lane] = a0; red[(wave * 3 + 1) * 64 + lane] = a1; red[(wave * 3 + 2) * 64 + lane] = a2;
                __syncthreads();
                if (wave < 3) {
                    float sum = IN_[I_BMOD][l * 6 * D + n];
#pragma unroll
                    for (int w = 0; w < 8; ++w) sum += red[(w * 3 + wave) * 64 + lane];
                    MODV[(size_t)(l * 3 + wave) * 6 * D + n] = sum;
                }
                __syncthreads();
            }
        }
        for (int i = gt; i < SEQ * 32; i += NGT) {
            const int t = i >> 5, f = i & 31;
            const float inv = exp2f(-(float)(f & 15) * (13.287712379549449f / 16.0f));
            const float pos = (f < 16) ? (float)(t / GRID_W) : (float)(t % GRID_W);
            float sn, cs; sincosf(pos * inv, &sn, &cs);
            COS[i] = cs; SIN[i] = sn;
        }
    }
        for (int rp_ = 0; rp_ < REP_P0F; ++rp_)
#pragma unroll 4
        for (int rr = gw; rr < 2 * DEPTH * 16384; rr += NGW) {
            const int tab = rr / (DEPTH * 16384), row = rr % (DEPTH * 16384);
            const float* src = (tab == 0 ? IN_[I_PU] : IN_[I_PV]) + (size_t)row * D;
            f32x4 v[4]; float am = 0.f;
#pragma unroll
            for (int j = 0; j < 4; ++j) { v[j] = *((const GAS f32x4*)src + lane + 64 * j); am = fmaxf(am, fmaxf(fmaxf(fabsf(v[j].x), fabsf(v[j].y)), fmaxf(fabsf(v[j].z), fabsf(v[j].w)))); }
            am = wave_max(am);
            const bool as_i8 = (P10_SLICED != 0) && (tab == 0);
            int ex = 0; float scale = 1.0f;
            if (am > 0.f) { (void)frexpf(am * (as_i8 ? (1.0f / 127.0f) : (1.0f / 448.0f)), &ex); scale = ldexpf(1.0f, ex); }
            const float inv = 1.0f / scale;
            v4u o;
#pragma unroll
            for (int j = 0; j < 4; ++j) {
                if (as_i8) {
                    const int q0 = __float2int_rn(v[j].x * inv), q1 = __float2int_rn(v[j].y * inv), q2 = __float2int_rn(v[j].z * inv), q3 = __float2int_rn(v[j].w * inv);
                    o[j] = (unsigned)(q0 & 255) | ((unsigned)(q1 & 255) << 8) | ((unsigned)(q2 & 255) << 16) | ((unsigned)q3 << 24);
                } else {
                    int p = __builtin_amdgcn_cvt_pk_fp8_f32(v[j].x * inv, v[j].y * inv, 0, false);
                    p = __builtin_amdgcn_cvt_pk_fp8_f32(v[j].z * inv, v[j].w * inv, p, true);
                    o[j] = (unsigned)p;
                }
            }
            *((GAS v4u*)((tab == 0 ? U8 : V8) + (size_t)row * D) + lane) = o;
            if (lane == 0) (tab == 0 ? SCU : SCV)[row] = scale;
        }
        }
        }
#endif
    GRID_BAR();

    for (int layer = 0; layer < DEPTH; ++layer) {
        const bool last = (layer == DEPTH - 1);
        const int T_EFF = last ? T_LAT : T_ALL;

#ifndef SKIP_P1
        { PHASE_PTRS LAYER_PTRS
        for (int rep_ = 0; rep_ < REP_P1; ++rep_) {
        { const int ln = lane_id_v();
        if (layer == 0) {
            f32x4 gm[4], shv[4];
            auto prep = [&](int midx) { const float* md = modl + (size_t)midx * 6 * D;
#pragma unroll
                for (int j = 0; j < 4; ++j) { const f32x4 g = *((const GAS f32x4*)(IN_[I_G1] + layer * D) + ln + 64 * j); const f32x4 sc = *((const GAS f32x4*)(md + D) + ln + 64 * j);
                    gm[j] = g * (sc + 1.0f); shv[j] = *((const GAS f32x4*)(md + 0) + ln + 64 * j); } };
            auto row = [&](int r) {
                const GAS f32x4* xr = (const GAS f32x4*)xin_row(IN_[I_X], IN_[I_CTX], r) + ln;
                f32x4 v[4]; float ss = 0.f;
#pragma unroll
                for (int j = 0; j < 4; ++j) { v[j] = xr[64 * j]; ss += (v[j].x * v[j].x + v[j].y * v[j].y) + (v[j].z * v[j].z + v[j].w * v[j].w); }
                const float rs = 1.0f / sqrtf(wave_sum(ss) * (1.f / D) + NORM_EPS);
                GAS v2u* o8 = (GAS v2u*)(H + (size_t)r * D) + ln;
#pragma unroll
                for (int j = 0; j < 4; ++j) { const f32x4 h = v[j] * rs * gm[j] + shv[j]; v2u o; o.x = pk2(h.x, h.y); o.y = pk2(h.z, h.w); o8[64 * j] = o; } };
            wave_row_blocks(T_ALL, gw, NGW, prep, row);
        }
        }
        }
        }
#endif
        if (layer == 0) GRID_BAR();

#ifndef SKIP_P2
        { PHASE_PTRS LAYER_PTRS
        for (int rep_ = 0; rep_ < REP_P2; ++rep_) {
        {
            pg8::Gemm g{H, WINl, D, D, D, 0, 0};
            pg8::SegOrder<1> S; S.T.init(T_ALL, IN_W, G, (int)blockIdx.x);
            EpiInProj E{AQ, AK, AVT, BQ, BK, BVT, CQ, CK, CVT, SG, COS, SIN};
            pg8::gemm_phase(L, g, S, E, wave);
        }
        }
        }
#endif
        GRID_BAR();

#ifndef SKIP_P3
        { PHASE_PTRS LAYER_PTRS
        {
            LAS bf16* Pl = (LAS bf16*)(L + wave * 8192);
            const float lam_init = 0.8f - 0.6f * expf(-0.3f * (float)layer);
            float lam;
            {
                const int ll = lane_id_v();
                const float* cl = IN_[I_LAMBDA] + layer * 256;
                const float s1 = wave_sum(cl[ll] * cl[64 + ll]), s2 = wave_sum(cl[128 + ll] * cl[192 + ll]);
                lam = expf(s1) - expf(s2) + lam_init;
            }
{ const int lo__ = lane_id_v(); { const int lane = lo__; const int fr = lane & 15, fq = lane >> 4, tid = wave * 64 + lane; (void)fr; (void)fq; (void)tid;
            {
                const int r32 = lane & 31, hi = lane >> 5;
                const int n_lat = BATCH * 4 * (SEQ / 256), n_ctx = last ? 0 : BATCH * 4;
                const int NU = (n_lat + G - 1) / G * G + n_ctx;
                for (int rep_ = 0; rep_ < REP_P3C; ++rep_)
                for (int u0 = vcu; u0 < NU; u0 += G) {
                    int b, h, row0, t_lo, t_hi;
                    if (u0 < n_lat) { const int bh = u0 >> 5; b = bh >> 2; h = bh & 3; row0 = b * SEQ + (u0 & 31) * 256; t_lo = 0; t_hi = 132; }
                    else { const int c = u0 - (n_lat + G - 1) / G * G; if (c < 0 || c >= n_ctx) continue; b = c >> 2; h = c & 3; row0 = T_LAT + b * CTX; t_lo = 128; t_hi = 132; }
                    const int qrow = row0 + wave * 32 + r32;
                    LAS unsigned* o1p = (LAS unsigned*)(L + 65536 + wave * 8192) + lane;
                    const int krow_s = tid >> 3, kch_s = tid & 7;
                    const int vrow_s0 = tid >> 4, vch_s = tid & 15;
                    LAS unsigned char* Kb0 = L; LAS unsigned char* Vb0 = L + 2 * CK_SZ;
#pragma unroll 1
                    for (int m = 0; m < 2; ++m) {
                        bf16x8 qf[4];
                        { const bf16* qp = CQ + (size_t)qrow * 512 + (h * 2 + m) * 64 + hi * 8;
#pragma unroll
                          for (int ks = 0; ks < 4; ++ks) qf[ks] = *(const GAS bf16x8*)(qp + ks * 16); }
                        f32x16 o[4];
#pragma unroll
                        for (int d = 0; d < 4; ++d)
#pragma unroll
                            for (int r = 0; r < 16; ++r) o[d][r] = 0.f;
                        float lpart;
                        f32x16 cb;
                        v4u pp[4];
                        const bf16* kg = CK + (size_t)krow_s * 512 + (h * 2 + m) * 64 + kch_s * 8;
                        const bf16* vg = CVT + (size_t)vrow_s0 * 512 + h * 128 + vch_s * 8;
                        auto tile_row = [&](int j) { return (j < 128) ? b * SEQ + 64 * j : T_LAT + b * CTX + 64 * (j - 128); };
                        __syncthreads();
                        {
                            const size_t kb = (size_t)tile_row(t_lo) * 512;
                            const v4u kr = *(const GAS v4u*)(kg + kb), v0 = *(const GAS v4u*)(vg + kb), v1 = *(const GAS v4u*)(vg + kb + 32 * 512);
                            *(LAS v4u*)(Kb0 + krow_s * CK_PITCH + kch_s * 16) = kr;
                            *(LAS v4u*)(Vb0 + vrow_s0 * CV_PITCH + vch_s * 16) = v0; *(LAS v4u*)(Vb0 + (vrow_s0 + 32) * CV_PITCH + vch_s * 16) = v1;
                        }
                        __syncthreads();
                        v4u kr, v0, v1;
                        { const size_t kb = (size_t)tile_row(t_lo + 2) * 512, vb = (size_t)tile_row(t_lo + 1) * 512;
                          kr = *(const GAS v4u*)(kg + kb); v0 = *(const GAS v4u*)(vg + vb); v1 = *(const GAS v4u*)(vg + vb + 32 * 512); }
                        {
                            const v4u kr1 = *(const GAS v4u*)(kg + (size_t)tile_row(t_lo + 1) * 512);
                            f32x16 st[2];
#pragma unroll
                            for (int kb = 0; kb < 2; ++kb) {
#pragma unroll
                                for (int r = 0; r < 16; ++r) st[kb][r] = 0.f;
#pragma unroll
                                for (int ks = 0; ks < 4; ++ks) {
                                    const bf16x8 kf = *(const LAS bf16x8*)(Kb0 + (kb * 32 + r32) * CK_PITCH + ks * 32 + hi * 16);
                                    st[kb] = __builtin_amdgcn_mfma_f32_32x32x16_bf16(kf, qf[ks], st[kb], 0, 0, 0);
                                }
                            }
                            float mx = st[0][0];
#pragma unroll
                            for (int r = 1; r < 16; ++r) mx = fmaxf(mx, st[0][r]);
#pragma unroll
                            for (int r = 0; r < 16; ++r) mx = fmaxf(mx, st[1][r]);
                            mx = xmax32(mx);
#pragma unroll
                            for (int r = 0; r < 16; ++r) cb[r] = -mx;
                            float ls0 = 0.f, ls1 = 0.f;
#pragma unroll
                            for (int ks = 0; ks < 4; ++ks)
#pragma unroll
                                for (int i2 = 0; i2 < 4; ++i2) {
                                    const float p0 = __builtin_amdgcn_exp2f(st[ks >> 1][8 * (ks & 1) + 2 * i2] - mx), p1 = __builtin_amdgcn_exp2f(st[ks >> 1][8 * (ks & 1) + 2 * i2 + 1] - mx);
                                    ls0 += p0; ls1 += p1; pp[ks][i2] = cvtpk(p0, p1);
                                }
                            lpart = ls0 + ls1;
                            *(LAS v4u*)(Kb0 + CK_SZ + krow_s * CK_PITCH + kch_s * 16) = kr1;
                            __syncthreads();
                        }
                        const int q4 = (lane & 15) >> 2, p4 = lane & 3, grp = (lane >> 4) & 1;
                        const int voff = (4 * hi + q4) * CV_PITCH + (16 * grp + 4 * p4) * 2;
#pragma unroll 1
                        for (int j = t_lo + 1; j < t_hi; ++j) {
                            const int cur = (j - t_lo) & 1;
                            const LAS unsigned char* Kb = Kb0 + cur * CK_SZ; const LAS unsigned char* vbase = Vb0 + (cur ^ 1) * CV_SZ + voff;
                            const bool more = (j + 1 < t_hi);
                            auto vfrag = [&](int i) -> bf16x8 {
                                const LAS unsigned char* va = vbase + (i >> 2) * 16 * CV_PITCH + (i & 3) * 64;
                                const s16x4 lo = __builtin_bit_cast(s16x4, __builtin_amdgcn_ds_read_tr16_b64_v4i16((LAS s16x4*)va));
                                const s16x4 hh = __builtin_bit_cast(s16x4, __builtin_amdgcn_ds_read_tr16_b64_v4i16((LAS s16x4*)(va + 8 * CV_PITCH)));
                                return __builtin_shufflevector(lo, hh, 0, 1, 2, 3, 4, 5, 6, 7);
                            };
                            f32x16 st[2];
#pragma unroll
                            for (int kb = 0; kb < 2; ++kb) {
#pragma unroll
                                for (int ks = 0; ks < 4; ++ks) {
                                    const bf16x8 kf = *(const LAS bf16x8*)(Kb + (kb * 32 + r32) * CK_PITCH + ks * 32 + hi * 16);
                                    st[kb] = __builtin_amdgcn_mfma_f32_32x32x16_bf16(kf, qf[ks], ks == 0 ? cb : st[kb], 0, 0, 0);
                                }
                            }
                            bf16x8 vfr[2];
                            vfr[0] = vfrag(0); vfr[1] = vfrag(1);
                            float mx = st[0][0];
#pragma unroll
                            for (int r = 1; r < 16; ++r) mx = fmaxf(mx, st[0][r]);
#pragma unroll
                            for (int r = 0; r < 16; ++r) mx = fmaxf(mx, st[1][r]);
                            asm volatile("" : "+v"(mx));
                            __builtin_amdgcn_sched_barrier(0);
                            o[0] = __builtin_amdgcn_mfma_f32_32x32x16_bf16(vfr[0], __builtin_bit_cast(bf16x8, pp[0]), o[0], 0, 0, 0); vfr[0] = vfrag(2);
                            o[1] = __builtin_amdgcn_mfma_f32_32x32x16_bf16(vfr[1], __builtin_bit_cast(bf16x8, pp[0]), o[1], 0, 0, 0); vfr[1] = vfrag(3);
                            mx = xmax32(mx);
                            const bool grow = __builtin_amdgcn_ballot_w64(mx > 8.0f) != 0ull;
                            float alpha = 1.0f;
                            if (grow) {
                                const float dl = fmaxf(mx, 0.f);
#pragma unroll
                                for (int kb = 0; kb < 2; ++kb)
#pragma unroll
                                    for (int r = 0; r < 16; ++r) st[kb][r] -= dl;
#pragma unroll
                                for (int r = 0; r < 16; ++r) cb[r] -= dl;
                                alpha = __builtin_amdgcn_exp2f(-dl);
                            }
                            __builtin_amdgcn_sched_barrier(0);
                            float ls0 = 0.f, ls1 = 0.f;
#pragma unroll
                            for (int i = 0; i < 16; ++i) {
                                if (i >= 2) { o[i & 3] = __builtin_amdgcn_mfma_f32_32x32x16_bf16(vfr[i & 1], __builtin_bit_cast(bf16x8, pp[i >> 2]), o[i & 3], 0, 0, 0); if (i + 2 < 16) vfr[i & 1] = vfrag(i + 2); }
                                {
                                    const int kb = i >> 3, r = 2 * (i & 7);
                                    float p0 = __builtin_amdgcn_exp2f(st[kb][r]);
                                    ls0 += p0; asm volatile("" : "+v"(p0), "+v"(ls0));
                                    float p1 = __builtin_amdgcn_exp2f(st[kb][r + 1]);
                                    ls1 += p1; asm volatile("" : "+v"(p1), "+v"(ls1));
                                    st[kb][r] = p0; st[kb][r + 1] = p1;
                                }
                                if ((i & 3) == 3) {
                                    const int ks = i >> 2;
#pragma unroll
                                    for (int i2 = 0; i2 < 4; ++i2) pp[ks][i2] = cvtpk(st[ks >> 1][8 * (ks & 1) + 2 * i2], st[ks >> 1][8 * (ks & 1) + 2 * i2 + 1]);
                                    asm volatile("" : "+v"(pp[ks]));
                                }
                                if (i == 3) *(LAS v4u*)(Kb0 + (cur ^ 1) * CK_SZ + krow_s * CK_PITCH + kch_s * 16) = kr;
                                if (i == 5) *(LAS v4u*)(Vb0 + cur * CV_SZ + vrow_s0 * CV_PITCH + vch_s * 16) = v0;
                                if (i == 7) *(LAS v4u*)(Vb0 + cur * CV_SZ + (vrow_s0 + 32) * CV_PITCH + vch_s * 16) = v1;
                                if (i == 9) { const size_t kb = (size_t)tile_row(j + 2 < t_hi ? j + 2 : t_hi - 1) * 512, vb = (size_t)tile_row(more ? j + 1 : j) * 512;
                                              kr = *(const GAS v4u*)(kg + kb); v0 = *(const GAS v4u*)(vg + vb); v1 = *(const GAS v4u*)(vg + vb + 32 * 512); }
                                if (i >= 1) __builtin_amdgcn_sched_barrier(0);
                            }
                            if (grow) {
#pragma unroll
                                for (int d = 0; d < 4; ++d)
#pragma unroll
                                    for (int r = 0; r < 16; ++r) o[d][r] *= alpha;
                                lpart *= alpha;
                            }
                            lpart += ls0 + ls1;
                            __syncthreads();
                        }
                        {
                            const LAS unsigned char* vbase = Vb0 + ((t_hi - 1 - t_lo) & 1) * CV_SZ + voff;
#pragma unroll
                            for (int i = 0; i < 16; ++i) {
                                const LAS unsigned char* va = vbase + (i >> 2) * 16 * CV_PITCH + (i & 3) * 64;
                                const s16x4 lo = __builtin_bit_cast(s16x4, __builtin_amdgcn_ds_read_tr16_b64_v4i16((LAS s16x4*)va));
                                const s16x4 hh = __builtin_bit_cast(s16x4, __builtin_amdgcn_ds_read_tr16_b64_v4i16((LAS s16x4*)(va + 8 * CV_PITCH)));
                                const bf16x8 vf = __builtin_shufflevector(lo, hh, 0, 1, 2, 3, 4, 5, 6, 7);
                                o[i & 3] = __builtin_amdgcn_mfma_f32_32x32x16_bf16(vf, __builtin_bit_cast(bf16x8, pp[i >> 2]), o[i & 3], 0, 0, 0);
                                if ((i & 7) == 7) __builtin_amdgcn_sched_barrier(0);
                            }
                        }
                        const float lt = xadd32(lpart);
                        if (m == 0) {
                            const float inv = 1.0f / lt;
#pragma unroll
                            for (int d = 0; d < 4; ++d)
#pragma unroll
                                for (int i2 = 0; i2 < 8; ++i2) o1p[64 * (d * 8 + i2)] = cvtpk(o[d][2 * i2] * inv, o[d][2 * i2 + 1] * inv);
                        } else {
                            const float inv2 = lam / lt;
                            float ssq = 0.f;
#pragma unroll
                            for (int d = 0; d < 4; ++d)
#pragma unroll
                                for (int i2 = 0; i2 < 8; ++i2) {
                                    const unsigned w1 = o1p[64 * (d * 8 + i2)];
                                    const float a0 = bf2f(w1 & 0xffffu) - o[d][2 * i2] * inv2, a1 = bf2f(w1 >> 16) - o[d][2 * i2 + 1] * inv2;
                                    o[d][2 * i2] = a0; o[d][2 * i2 + 1] = a1; ssq += a0 * a0 + a1 * a1;
                                }
                            ssq = xadd32(ssq);
                            const float rn = 1.0f / sqrtf(ssq * (1.f / 128.f) + NORM_EPS) * (1.0f - lam_init);
                            bf16* yp = Y + (size_t)qrow * 1536 + 1024 + h * 128 + 4 * hi;
                            const float* sl = IN_[I_SUBLN] + layer * 512 + h * 128 + 4 * hi;
#pragma unroll
                            for (int d = 0; d < 4; ++d)
#pragma unroll
                                for (int g4 = 0; g4 < 4; ++g4) {
                                    const f32x4 gsl = *(const GAS f32x4*)(sl + d * 32 + 8 * g4);
                                    v2u w; w.x = cvtpk(o[d][4 * g4] * rn * gsl.x, o[d][4 * g4 + 1] * rn * gsl.y); w.y = cvtpk(o[d][4 * g4 + 2] * rn * gsl.z, o[d][4 * g4 + 3] * rn * gsl.w);
                                    *(GAS v2u*)(yp + d * 32 + 8 * g4) = w;
                                }
                        }
                    }
                }
                __syncthreads();
            }
} }
{ const int lo__ = lane_id_v(); { const int lane = lo__; const int tid = wave * 64 + lane, r32 = lane & 31, hi = lane >> 5;
            {
                const int n_lat = BATCH * 2 * (SEQ / 64), n_ctx = last ? 0 : BATCH * 2 * (CTX / 64);
                for (int rep_ = 0; rep_ < REP_P3A; ++rep_)
                for (int u0 = vcu; u0 < n_lat + n_ctx; u0 += G) {
                    const bool isctx = u0 >= n_lat;
                    int b, g, p0, qrow, nl, klo;
                    if (!isctx) { b = u0 >> 8; g = (u0 >> 7) & 1; p0 = (u0 & 127) * 64; qrow = b * SEQ + p0 + (wave & 1) * 32 + r32;
                                  klo = p0 >= 128 ? 0 : (128 - p0) / 64; const int khi = min(4, (SEQ - 1 - (p0 - 128)) / 64); nl = khi - klo + 1; }
                    else { const int c = u0 - n_lat; b = c >> 3; g = (c >> 2) & 1; p0 = (c & 3) * 64; qrow = T_LAT + b * CTX + p0 + (wave & 1) * 32 + r32; nl = 0; klo = 0; }
                    const int hq = g * 4 + (wave >> 1);
                    const int qpos0 = p0 + (wave & 1) * 32;
                    bf16x8 qf[4];
                    { const bf16* qp = AQ + (size_t)qrow * 512 + hq * 64 + hi * 8;
#pragma unroll
                      for (int ks = 0; ks < 4; ++ks) qf[ks] = *(const GAS bf16x8*)(qp + ks * 16); }
                    f32x16 o[2];
#pragma unroll
                    for (int d = 0; d < 2; ++d)
#pragma unroll
                        for (int r = 0; r < 16; ++r) o[d][r] = 0.f;
                    float mrun = IN_[I_SINK][layer * 8 + hq] * 8.0f;
                    float lpart = (hi == 0) ? 1.0f : 0.0f;
                    const bf16* kg = AK + (size_t)(tid >> 3) * 128 + g * 64 + (tid & 7) * 8;
                    const bf16* vg = AVT + (size_t)(tid >> 3) * 128 + g * 64 + (tid & 7) * 8;
                    const int kp0 = p0 - 128 + 64 * klo;
                    auto tile_row = [&](int j) { return (j < nl) ? b * SEQ + kp0 + 64 * j : T_LAT + b * CTX + 64 * (j - nl); };
                    auto use_tile = [&](int j) { if (j >= nl) return true; const int kp = kp0 + 64 * j; return (kp + 63 >= qpos0 - 128) && (kp <= qpos0 + 31 + 128); };
                    auto elem = [&](f32x16 (&st)[2], int j) {
                        if (j < nl) {
                            const int dq0 = (qpos0 + r32) - (kp0 + 64 * j + 4 * hi);
#pragma unroll
                            for (int kb = 0; kb < 2; ++kb)
#pragma unroll
                                for (int r = 0; r < 16; ++r) { const int dq = dq0 - (kb * 32 + (r & 3) + 8 * (r >> 2)); if (dq > 128 || dq < -128) st[kb][r] = -1e30f; }
                        }
                    };
                    attn64_pass<2, false>(o, mrun, lpart, qf, kg, 128, vg, 128, nl + 4, tile_row, use_tile, elem, o, [](int) { return false; }, L, lane, tid);
                    const float lt = xadd32(lpart);
                    attn64_store(o, 1.0f / lt, Y + (size_t)qrow * 1536 + hq * 64, hi);
                }
            }
} }
{ const int lo__ = lane_id_v(); { const int lane = lo__; const int tid = wave * 64 + lane, r32 = lane & 31, hi = lane >> 5;
            {
                const int n_lat = BATCH * 8 * 32, n_ctx = last ? 0 : BATCH * 8;
                LAS float* rpbL = (LAS float*)(L + 49152) + 64;
                f32x16 cm[2];
                {
                    const int qc = (wave & 1) * 32 + r32, cstart = min(max(qc - 8, 0), 48);
#pragma unroll
                    for (int kb = 0; kb < 2; ++kb)
#pragma unroll
                        for (int r = 0; r < 16; ++r) { const int kc = kb * 32 + (r & 3) + 8 * (r >> 2) + 4 * hi; cm[kb][r] = ((kc >= cstart) && (kc < cstart + 16)) ? 0.f : -1e30f; }
                }
                if (tid < 64) { rpbL[tid - 64] = 0.f; rpbL[465 + tid] = 0.f; }
                for (int rep_ = 0; rep_ < REP_P3B; ++rep_)
                for (int u0 = vcu; u0 < n_lat + n_ctx; u0 += G) {
                    const bool isctx = u0 >= n_lat;
                    int b, h, gr = 0, qc0 = 0, qrow, nl, krlo;
                    if (!isctx) { b = u0 >> 8; h = (u0 >> 5) & 7; const int r0 = (u0 & 31) * 4; gr = r0 + (wave >> 1); qc0 = (wave & 1) * 32; qrow = b * SEQ + gr * GRID_W + qc0 + r32;
                                  krlo = min(max(r0 - 4, 0), 120); nl = min(max(r0 - 1, 0), 120) + 8 - krlo; }
                    else { const int c = u0 - n_lat; b = c >> 3; h = c & 7; qrow = T_LAT + b * CTX + wave * 32 + r32; nl = 0; krlo = 0; }
                    __syncthreads();
                    if (tid < 465) rpbL[tid] = IN_[I_RPB][(size_t)(layer * 8 + h) * 465 + tid] * 8.0f;
                    bf16x8 qf[4];
                    { const bf16* qp = BQ + (size_t)qrow * 512 + h * 64 + hi * 8;
#pragma unroll
                      for (int ks = 0; ks < 4; ++ks) qf[ks] = *(const GAS bf16x8*)(qp + ks * 16); }
                    f32x16 o[2];
#pragma unroll
                    for (int d = 0; d < 2; ++d)
#pragma unroll
                        for (int r = 0; r < 16; ++r) o[d][r] = 0.f;
                    float mrun = -1e30f, lpart = 0.f;
                    const bf16* kg = BK + (size_t)(tid >> 3) * 512 + h * 64 + (tid & 7) * 8;
                    const bf16* vg = BVT + (size_t)(tid >> 3) * 512 + h * 64 + (tid & 7) * 8;
                    const int rs = min(max(gr - 4, 0), 120);
                    auto tile_row = [&](int j) { return (j < nl) ? b * SEQ + (krlo + j) * GRID_W : T_LAT + b * CTX + 64 * (j - nl); };
                    auto use_tile = [&](int j) { if (j >= nl) return true; const int kr = krlo + j; return kr >= rs && kr < rs + 8; };
                    auto elem = [&](f32x16 (&st)[2], int j) {
                        if (j < nl) {
                            const LAS float* brow = rpbL + (krlo + j - gr + 7) * 31 + 15 - (qc0 + r32) + 4 * hi;
#pragma unroll
                            for (int kb = 0; kb < 2; ++kb)
#pragma unroll
                                for (int r = 0; r < 16; ++r) st[kb][r] += brow[kb * 32 + (r & 3) + 8 * (r >> 2)];
                        }
                    };
                    attn64_pass<2, true>(o, mrun, lpart, qf, kg, 512, vg, 512, nl + 4, tile_row, use_tile, elem, cm, [&](int j) { return j < nl; }, L, lane, tid);
                    const float lt = xadd32(lpart);
                    attn64_store(o, 1.0f / lt, Y + (size_t)qrow * 1536 + 512 + h * 64, hi);
                }
                __syncthreads();
            }
} }
        }
        }
#endif
        GRID_BAR();

#ifndef SKIP_P4
        { PHASE_PTRS LAYER_PTRS
        for (int rep_ = 0; rep_ < REP_P4; ++rep_) {
        {
            pg8::Gemm g{Y, WB + (size_t)layer * 3 * D * 512, 1536, 512, 512, 512, (size_t)D * 512};
            pg8::SegOrder<3> S; S.T.init(T_LAT, D, G, (int)blockIdx.x);
            EpiBranch E{SG, MG};
            pg8::gemm_phase(L, g, S, E, wave);
        }
        if (!last) { const int lo__ = lane_id_v(); { const int lane = lo__; const int fr = lane & 15, fq = lane >> 4; (void)fr; (void)fq;
            for (int it = gw; it < (T_ALL - T_LAT) / 32 * (D / 32); it += NGW) {
                const int row0 = T_LAT + (it / (D / 32)) * 32, col0 = (it % (D / 32)) * 32;
                f32x4 mg[2][2]; zero_acc22(mg);
#pragma unroll 1
                for (int seg = 0; seg < 3; ++seg) {
                    f32x4 acc[2][2]; zero_acc22(acc);
                    sgemm32<8>(acc, Y + seg * 512, 1536, WB + (size_t)(layer * 3 + seg) * D * 512, 512, 512, row0, col0, lane);
#pragma unroll
                    for (int m = 0; m < 2; ++m)
#pragma unroll
                        for (int r = 0; r < 4; ++r) {
                            const bf16* gp = SG + (size_t)(row0 + 16 * m + 4 * fq + r) * 3072 + seg * 1024 + col0 + fr;
#pragma unroll
                            for (int n = 0; n < 2; ++n) mg[m][n][r] += bf2f(gp[16 * n]) * acc[m][n][r];
                        }
                }
#pragma unroll
                for (int m = 0; m < 2; ++m)
#pragma unroll
                    for (int r = 0; r < 4; ++r) {
                        bf16* rowp = MG + (size_t)(row0 + 16 * m + 4 * fq + r) * D + col0 + fr;
#pragma unroll
                        for (int n = 0; n < 2; ++n) rowp[16 * n] = (bf16)f2bf(mg[m][n][r]);
                    }
            }
} }
        }
        }
#endif
        GRID_BAR();

#ifndef SKIP_P5
        { PHASE_PTRS LAYER_PTRS
        {
            pg8::Gemm g{MG, WO + (size_t)layer * D * D, D, D, D, 0, 0};
            pg8::SegOrder<1> S; S.T.init(T_LAT, D, G, (int)blockIdx.x);
            EpiOut E{X, modl, layer == 0 ? IN_[I_X] : nullptr, IN_[I_CTX]};
            pg8::gemm_phase(L, g, S, E, wave);
        }
        if (!last) { const int lo__ = lane_id_v(); { const int lane = lo__; const int fr = lane & 15, fq = lane >> 4; (void)fr; (void)fq;
            for (int it = gw; it < (T_ALL - T_LAT) / 32 * (D / 32); it += NGW) {
                const int row0 = T_LAT + (it / (D / 32)) * 32, col0 = (it % (D / 32)) * 32;
                f32x4 acc[2][2]; zero_acc22(acc);
                sgemm32<8>(acc, MG, D, WO + (size_t)layer * D * D, D, D, row0, col0, lane);
                const float* gt = modl + (size_t)2 * 6 * D + 2 * D + col0 + fr;
#pragma unroll
                for (int m = 0; m < 2; ++m)
#pragma unroll
                    for (int r = 0; r < 4; ++r) {
                        float* rowp = X + (size_t)(row0 + 16 * m + 4 * fq + r) * D + col0 + fr;
                        const float* srcp = (layer == 0) ? IN_[I_CTX] + (size_t)(row0 - T_LAT + 16 * m + 4 * fq + r) * D + col0 + fr : rowp;
#pragma unroll
                        for (int n = 0; n < 2; ++n) rowp[16 * n] = srcp[16 * n] + gt[16 * n] * acc[m][n][r];
                    }
            }
} }
        }
#endif
        GRID_BAR();

#ifndef SKIP_P6
        { PHASE_PTRS LAYER_PTRS
        for (int rep_ = 0; rep_ < REP_P6; ++rep_) {
        { const int ln = lane_id_v();
        {
            f32x4 gm[4], shv[4];
            auto prep = [&](int midx) { const float* md = modl + (size_t)midx * 6 * D;
#pragma unroll
                for (int j = 0; j < 4; ++j) { const f32x4 g = *((const GAS f32x4*)(IN_[I_G2] + layer * D) + ln + 64 * j); const f32x4 sc = *((const GAS f32x4*)(md + 4 * D) + ln + 64 * j);
                    gm[j] = g * (sc + 1.0f); shv[j] = *((const GAS f32x4*)(md + 3 * D) + ln + 64 * j); } };
            auto row = [&](int r) {
                const GAS f32x4* xr = (const GAS f32x4*)(X + (size_t)r * D) + ln;
                f32x4 v[4]; float ss = 0.f;
#pragma unroll
                for (int j = 0; j < 4; ++j) { v[j] = xr[64 * j]; ss += (v[j].x * v[j].x + v[j].y * v[j].y) + (v[j].z * v[j].z + v[j].w * v[j].w); }
                const float rs = 1.0f / sqrtf(wave_sum(ss) * (1.f / D) + NORM_EPS);
                GAS v2u* o8 = (GAS v2u*)(H + (size_t)r * D) + ln;
#pragma unroll
                for (int j = 0; j < 4; ++j) { const f32x4 h = v[j] * rs * gm[j] + shv[j]; v2u o; o.x = pk2(h.x, h.y); o.y = pk2(h.z, h.w); o8[64 * j] = o; } };
            wave_row_blocks(T_EFF, gw, NGW, prep, row);
        }
        }
        }
        }
#endif
        GRID_BAR();

#ifndef SKIP_P7
        { PHASE_PTRS LAYER_PTRS
        for (int rep_ = 0; rep_ < REP_P7; ++rep_) {
        {
            pg8::Gemm g{H, WQ + (size_t)layer * 2048 * D, D, D, D, 0, 0};
            pg8::SegOrder<1> S; S.T.init(T_LAT, 2048, G, (int)blockIdx.x);
            EpiStore E{Q2, 2048};
            pg8::gemm_phase(L, g, S, E, wave);
        }
        if (!last) { const int lo__ = lane_id_v(); { const int lane = lo__; const int fr = lane & 15, fq = lane >> 4; (void)fr; (void)fq;
            for (int it = gw; it < (T_ALL - T_LAT) / 32 * (2048 / 32); it += NGW) {
                const int row0 = T_LAT + (it / (2048 / 32)) * 32, col0 = (it % (2048 / 32)) * 32;
                f32x4 acc[2][2]; zero_acc22(acc);
                sgemm32<8>(acc, H, D, WQ + (size_t)layer * 2048 * D, D, D, row0, col0, lane);
#pragma unroll
                for (int m = 0; m < 2; ++m)
#pragma unroll
                    for (int r = 0; r < 4; ++r) {
                        bf16* rowp = Q2 + (size_t)(row0 + 16 * m + 4 * fq + r) * 2048 + col0 + fr;
#pragma unroll
                        for (int n = 0; n < 2; ++n) rowp[16 * n] = (bf16)f2bf(acc[m][n][r]);
                    }
            }
} }
        }
        }
#endif
        GRID_BAR();

#ifndef SKIP_P8
        { PHASE_PTRS LAYER_PTRS
        for (int rep_ = 0; rep_ < REP_P8; ++rep_) {
{ const int lo__ = lane_id_v(); { const int lane = lo__; const int fr = lane & 15, fq = lane >> 4, tid = wave * 64 + lane;
        {
            LAS float* S = (LAS float*)L;
            const int wr = wave >> 1, wc = wave & 1;
            const int tl = tid >> 2, qd = tid & 3, ph = qd >> 1, hq = qd & 1;
            for (int it = vcu; it < (T_EFF / 128) * PEER_HEADS; it += G) {
                const int tile = it >> 3, h = it & 7;
                {
                    f32x4 acc[2][8];
#pragma unroll
                    for (int m = 0; m < 2; ++m)
#pragma unroll
                        for (int n = 0; n < 8; ++n) acc[m][n] = (f32x4){0.f, 0.f, 0.f, 0.f};
                    const bf16* ap = Q2 + (size_t)(tile * 128 + wr * 32 + fr) * 2048 + h * 256 + wc * 128 + fq * 8;
                    const bf16* bp = KEYS + ((size_t)(layer * 16 + h * 2 + wc) * 128 + fr) * 128 + fq * 8;
                    bf16x8 af[2][4];
#pragma unroll
                    for (int m = 0; m < 2; ++m)
#pragma unroll
                        for (int ks = 0; ks < 4; ++ks) af[m][ks] = *(const GAS bf16x8*)(ap + (size_t)m * 16 * 2048 + ks * 32);
#pragma unroll
                    for (int n = 0; n < 8; ++n) {
                        bf16x8 bfr[4];
#pragma unroll
                        for (int ks = 0; ks < 4; ++ks) bfr[ks] = *(const GAS bf16x8*)(bp + (size_t)n * 16 * 128 + ks * 32);
#pragma unroll
                        for (int ks = 0; ks < 4; ++ks)
#pragma unroll
                            for (int m = 0; m < 2; ++m) acc[m][n] = __builtin_amdgcn_mfma_f32_16x16x32_bf16(af[m][ks], bfr[ks], acc[m][n], 0, 0, 0);
                    }
#pragma unroll
                    for (int m = 0; m < 2; ++m)
#pragma unroll
                        for (int r = 0; r < 4; ++r) {
                            const int row_ = wr * 32 + 16 * m + 4 * fq + r;
#pragma unroll
                            for (int n = 0; n < 8; ++n) { const int key_ = wc * 128 + 16 * n + fr, c_ = key_ >> 2, pc_ = (c_ & 0x30) | ((c_ & 15) ^ (((row_ & 3) << 2) | (c_ >> 4)));
                                S[row_ * 256 + pc_ * 4 + (key_ & 3)] = acc[m][n][r]; }
                        }
                }
                __syncthreads();
                {
                    const int t = tile * 128 + tl;
                    int a[16];
#define LOAD_CHUNK_L(v, ch) _Pragma("unroll") for (int q = 0; q < 4; ++q) { const int c_ = qd * 16 + (ch) * 4 + q, pc_ = (c_ & 0x30) | ((c_ & 15) ^ (((tl & 3) << 2) | qd)); \
                        const f32x4 x = *(const LAS f32x4*)(S + tl * 256 + pc_ * 4); const int kb_ = hq * 64 + (ch) * 16 + 4 * q; \
                        v[4 * q + 0] = (f2ord(x.x) & ~127) | (kb_ + 0); v[4 * q + 1] = (f2ord(x.y) & ~127) | (kb_ + 1); v[4 * q + 2] = (f2ord(x.z) & ~127) | (kb_ + 2); v[4 * q + 3] = (f2ord(x.w) & ~127) | (kb_ + 3); }
                    LOAD_CHUNK_L(a, 0) sort16_desc(a);
#pragma unroll
                    for (int ch = 1; ch < 4; ++ch) { int v[16]; LOAD_CHUNK_L(v, ch) sort16_desc(v); merge16_desc(a, v); }
#undef LOAD_CHUNK_L
                    { int b[16];
#pragma unroll
                      for (int i = 0; i < 16; ++i) b[i] = __builtin_amdgcn_update_dpp(0, a[i], 0xB1, 0xF, 0xF, true);
                      merge16_desc(a, b); }
                    int a0[16], a1[16];
#pragma unroll
                    for (int i = 0; i < 16; ++i) { const int o2 = __builtin_amdgcn_update_dpp(0, a[i], 0x4E, 0xF, 0xF, true); a0[i] = ph ? o2 : a[i]; a1[i] = ph ? a[i] : o2; }
                    {
            float va[16], vb[16];
#pragma unroll
            for (int i = 0; i < 16; ++i) { va[i] = ord2f(a0[i] & ~127); vb[i] = ord2f(a1[i] & ~127); }
            int c[16];
            {
                int v[16];
                v[0] = (f2ord(va[0] + vb[0]) & ~255) | 0;
                v[1] = (f2ord(va[0] + vb[1]) & ~255) | 1;
                v[2] = (f2ord(va[0] + vb[2]) & ~255) | 2;
                v[3] = (f2ord(va[0] + vb[3]) & ~255) | 3;
                v[4] = (f2ord(va[0] + vb[4]) & ~255) | 4;
                v[5] = (f2ord(va[0] + vb[5]) & ~255) | 5;
                v[6] = (f2ord(va[0] + vb[6]) & ~255) | 6;
                v[7] = (f2ord(va[0] + vb[7]) & ~255) | 7;
                v[8] = (f2ord(va[0] + vb[8]) & ~255) | 8;
                v[9] = (f2ord(va[0] + vb[9]) & ~255) | 9;
                v[10] = (f2ord(va[0] + vb[10]) & ~255) | 10;
                v[11] = (f2ord(va[0] + vb[11]) & ~255) | 11;
                v[12] = (f2ord(va[0] + vb[12]) & ~255) | 12;
                v[13] = (f2ord(va[0] + vb[13]) & ~255) | 13;
                v[14] = (f2ord(va[0] + vb[14]) & ~255) | 14;
                v[15] = (f2ord(va[0] + vb[15]) & ~255) | 15;
                sort16_desc(v);
#pragma unroll
                for (int i = 0; i < 16; ++i) c[i] = v[i];
            }
            {
                int v[16];
                v[0] = (f2ord(va[1] + vb[0]) & ~255) | 16;
                v[1] = (f2ord(va[1] + vb[1]) & ~255) | 17;
                v[2] = (f2ord(va[1] + vb[2]) & ~255) | 18;
                v[3] = (f2ord(va[1] + vb[3]) & ~255) | 19;
                v[4] = (f2ord(va[1] + vb[4]) & ~255) | 20;
                v[5] = (f2ord(va[1] + vb[5]) & ~255) | 21;
                v[6] = (f2ord(va[1] + vb[6]) & ~255) | 22;
                v[7] = (f2ord(va[1] + vb[7]) & ~255) | 23;
                v[8] = (f2ord(va[2] + vb[0]) & ~255) | 32;
                v[9] = (f2ord(va[2] + vb[1]) & ~255) | 33;
                v[10] = (f2ord(va[2] + vb[2]) & ~255) | 34;
                v[11] = (f2ord(va[2] + vb[3]) & ~255) | 35;
                v[12] = (f2ord(va[2] + vb[4]) & ~255) | 36;
                v[13] = (f2ord(va[3] + vb[0]) & ~255) | 48;
                v[14] = (f2ord(va[3] + vb[1]) & ~255) | 49;
                v[15] = (f2ord(va[3] + vb[2]) & ~255) | 50;
                sort16_desc(v);
                merge16_desc(c, v);
            }
            {
                int v[16];
                v[0] = (f2ord(va[3] + vb[3]) & ~255) | 51;
                v[1] = (f2ord(va[4] + vb[0]) & ~255) | 64;
                v[2] = (f2ord(va[4] + vb[1]) & ~255) | 65;
                v[3] = (f2ord(va[4] + vb[2]) & ~255) | 66;
                v[4] = (f2ord(va[5] + vb[0]) & ~255) | 80;
                v[5] = (f2ord(va[5] + vb[1]) & ~255) | 81;
                v[6] = (f2ord(va[6] + vb[0]) & ~255) | 96;
                v[7] = (f2ord(va[6] + vb[1]) & ~255) | 97;
                v[8] = (f2ord(va[7] + vb[0]) & ~255) | 112;
                v[9] = (f2ord(va[7] + vb[1]) & ~255) | 113;
                v[10] = (f2ord(va[8] + vb[0]) & ~255) | 128;
                v[11] = (f2ord(va[9] + vb[0]) & ~255) | 144;
                v[12] = (f2ord(va[10] + vb[0]) & ~255) | 160;
                v[13] = (f2ord(va[11] + vb[0]) & ~255) | 176;
                v[14] = (f2ord(va[12] + vb[0]) & ~255) | 192;
                v[15] = (f2ord(va[13] + vb[0]) & ~255) | 208;
                sort16_desc(v);
                merge16_desc(c, v);
            }
            {
                int v[16];
                v[0] = (f2ord(va[14] + vb[0]) & ~255) | 224;
                v[1] = (f2ord(va[15] + vb[0]) & ~255) | 240;
                v[2] = (int)0x80000000;
                v[3] = (int)0x80000000;
                v[4] = (int)0x80000000;
                v[5] = (int)0x80000000;
                v[6] = (int)0x80000000;
                v[7] = (int)0x80000000;
                v[8] = (int)0x80000000;
                v[9] = (int)0x80000000;
                v[10] = (int)0x80000000;
                v[11] = (int)0x80000000;
                v[12] = (int)0x80000000;
                v[13] = (int)0x80000000;
                v[14] = (int)0x80000000;
                v[15] = (int)0x80000000;
                sort16_desc(v);
                merge16_desc(c, v);
            }
            const float smax = ord2f(c[0] & ~255);
            float pe[16]; float psum = 0.f;
#pragma unroll
            for (int k = 0; k < 16; ++k) { pe[k] = __expf(ord2f(c[k] & ~255) - smax); psum += pe[k]; }
            const float ip = 1.0f / psum;
#pragma unroll
            for (int kk = 0; kk < 4; ++kk) {
                const int ck = (qd == 0) ? c[kk] : (qd == 1) ? c[4 + kk] : (qd == 2) ? c[8 + kk] : c[12 + kk];
                const float pk_ = (qd == 0) ? pe[kk] : (qd == 1) ? pe[4 + kk] : (qd == 2) ? pe[8 + kk] : pe[12 + kk];
                const int ij = ck & 255, ii = ij >> 4, jj = ij & 15;
                int e0 = 0, e1 = 0;
#pragma unroll
                for (int q = 0; q < 16; ++q) { e0 = (ii == q) ? (a0[q] & 127) : e0; e1 = (jj == q) ? (a1[q] & 127) : e1; }
                const int e = e0 * PEER_KEYS + e1;
                const float su = SCU[layer * 16384 + e], sv = SCV[layer * 16384 + e];
                const int k = 4 * qd + kk;
                EI[(size_t)t * NSEL + h * 16 + k] = (unsigned)e | (f2bf(su) << 16);
                EG[(size_t)t * NSEL + h * 16 + k] = pk_ * ip * sv;
            }
                    }
                }
                __syncthreads();
            }
        }
} }
        }
        }
#endif
        GRID_BAR();

#ifndef SKIP_P10
#define P10_CENSUS \
        unsigned myx_, nx_ = 1u, smask_ = 0u; { unsigned cnt_[16]; unsigned* bw_ = (unsigned*)(args.ws + WS_CTL) + CW_BAR; \
            _Pragma("unroll") for (int j = 0; j < 16; ++j) cnt_[j] = (unsigned)__builtin_amdgcn_readfirstlane((int)xb_ld(&bw_[XB_XCNT(j)])); \
            myx_ = xb_xcc_id(); unsigned np_ = 0u; \
            _Pragma("unroll") for (int j = 0; j < 16; ++j) { np_ += (cnt_[j] > 0u) ? 1u : 0u; nx_ = ((unsigned)j == myx_) ? cnt_[j] : nx_; } \
            if (np_ == 0u) np_ = 1u; if (nx_ == 0u) nx_ = 1u; \
            _Pragma("unroll") for (int sl = 0; sl < 8; ++sl) { const unsigned k_ = (unsigned)sl % np_; unsigned seen_ = 0u, srv_ = 0xffu; \
                _Pragma("unroll") for (int j = 0; j < 16; ++j) { if (cnt_[j] > 0u) { srv_ = (seen_ == k_) ? (unsigned)j : srv_; ++seen_; } } \
                smask_ |= (srv_ == myx_) ? (1u << sl) : 0u; } } \
        const int rank_ = (int)__builtin_amdgcn_readfirstlane((int)MISC[12]); const int wstride_ = (int)nx_ * NWAVES; (void)rank_; (void)wstride_;
        { PHASE_PTRS LAYER_PTRS
        { const int ln = lane_id_v(); const int c = ln & 7, tg = ln >> 3;
          P10_CENSUS
          float* PART = (float*)(wsq + WS_PART);
          const unsigned char* U8l = U8 + (size_t)layer * 16384 * D;
          for (int rep_ = 0; rep_ < REP_P10A; ++rep_)
#pragma unroll 1
          for (int sl = 0; sl < 8; ++sl) {
            if (!((smask_ >> sl) & 1u)) continue;
            const int ws0 = (rank_ * NWAVES + wave) * 8, nslot = wstride_ * 8;
            if (ws0 >= T_EFF) continue;
            const int niter = (T_EFF - ws0 + nslot - 1) / nslot, nb = niter * 8;
#define A_TOK(bi) (ws0 + tg + (min((bi), nb - 1) >> 3) * nslot)
#define A_LOAD_PK(pkv, bi) { const GAS v4u* wp_ = (const GAS v4u*)(EI + (size_t)A_TOK(bi) * NSEL + 16 * (min((bi), nb - 1) & 7)); _Pragma("unroll") for (int q = 0; q < 4; ++q) pkv[q] = wp_[q]; }
#define A_ISSUE(rowv, pkv) { _Pragma("unroll") for (int q = 0; q < 16; ++q) rowv[q] = *(const GAS v4u*)(U8l + (size_t)(pkv[q >> 2][q & 3] & 0xffffu) * D + 128 * sl + 16 * c); }
#define A_LOAD_H(hvv, bi) { const int tq_ = A_TOK(bi); _Pragma("unroll") for (int j = 0; j < 4; ++j) hvv[j] = *(const GAS v2u*)(H + (size_t)tq_ * D + 256 * j + 32 * sl + 4 * c); }
#define A_QUANT(hvv) { float hf[16]; float am_ = 0.f; \
                _Pragma("unroll") for (int j = 0; j < 4; ++j) { hf[4 * j] = bf2f(hvv[j].x & 0xffffu); hf[4 * j + 1] = bf2f(hvv[j].x >> 16); hf[4 * j + 2] = bf2f(hvv[j].y & 0xffffu); hf[4 * j + 3] = bf2f(hvv[j].y >> 16); } \
                _Pragma("unroll") for (int i = 0; i < 16; ++i) am_ = fmaxf(am_, fabsf(hf[i])); \
                am_ = fmaxf(am_, dpp_mov<0xB1>(am_)); am_ = fmaxf(am_, dpp_mov<0x4E>(am_)); am_ = fmaxf(am_, dpp_mov<0x141>(am_)); am_ = fmaxf(am_, 1e-20f); \
                sh_ = am_ * (1.0f / 127.0f); const float ih_ = 127.0f / am_; \
                _Pragma("unroll") for (int j = 0; j < 4; ++j) { const int q0 = __float2int_rn(hf[4 * j] * ih_), q1 = __float2int_rn(hf[4 * j + 1] * ih_), q2 = __float2int_rn(hf[4 * j + 2] * ih_), q3 = __float2int_rn(hf[4 * j + 3] * ih_); \
                    hq_[j] = (int)((unsigned)(q0 & 255) | ((unsigned)(q1 & 255) << 8) | ((unsigned)(q2 & 255) << 16) | ((unsigned)q3 << 24)); } }
#define A_COMPUTE(rowv, bi) { int p_[16]; \
                _Pragma("unroll") for (int q = 0; q < 16; ++q) { int ia = 0; _Pragma("unroll") for (int j = 0; j < 4; ++j) ia = __builtin_amdgcn_sdot4((int)rowv[q][j], hq_[j], ia, false); p_[q] = ia; } \
                { const bool up = (c & 4) != 0; _Pragma("unroll") for (int i = 0; i < 8; ++i) { const int send = up ? p_[i] : p_[8 + i], keep = up ? p_[8 + i] : p_[i]; p_[i] = keep + __builtin_amdgcn_update_dpp(0, send, 0x141, 0xF, 0xF, true); } } \
                { const bool up = (c & 2) != 0; _Pragma("unroll") for (int i = 0; i < 4; ++i) { const int send = up ? p_[i] : p_[4 + i], keep = up ? p_[4 + i] : p_[i]; p_[i] = keep + __builtin_amdgcn_update_dpp(0, send, 0x4E, 0xF, 0xF, true); } } \
                { const bool up = (c & 1) != 0; _Pragma("unroll") for (int i = 0; i < 2; ++i) { const int send = up ? p_[i] : p_[2 + i], keep = up ? p_[2 + i] : p_[i]; p_[i] = keep + __builtin_amdgcn_update_dpp(0, send, 0xB1, 0xF, 0xF, true); } } \
                f32x2 r2_; r2_.x = (float)p_[0] * sh_; r2_.y = (float)p_[1] * sh_; \
                *(GAS f32x2*)(PART + ((size_t)sl * T_ALL + (ws0 + tg + ((bi) >> 3) * nslot)) * NSEL + 16 * ((bi) & 7) + 2 * c) = r2_; }
            v4u pkA[4], pkB[4]; v4u rowA[16], rowB[16]; v2u hN[4]; int hq_[4] = {0, 0, 0, 0}; float sh_ = 0.f;
            A_LOAD_PK(pkA, 0) A_LOAD_PK(pkB, 1) A_LOAD_H(hN, 0)
            A_ISSUE(rowA, pkA)
#pragma unroll 1
            for (int bi = 0; bi < nb; bi += 2) {
                if ((bi & 7) == 0) { A_QUANT(hN) A_LOAD_H(hN, bi + 8) }
                A_ISSUE(rowB, pkB) A_LOAD_PK(pkA, bi + 2)
                __builtin_amdgcn_sched_barrier(0);
                A_COMPUTE(rowA, bi)
                __builtin_amdgcn_sched_barrier(0);
                A_ISSUE(rowA, pkA) A_LOAD_PK(pkB, bi + 3)
                __builtin_amdgcn_sched_barrier(0);
                A_COMPUTE(rowB, bi + 1)
                __builtin_amdgcn_sched_barrier(0);
            }
#undef A_TOK
#undef A_LOAD_PK
#undef A_ISSUE
#undef A_LOAD_H
#undef A_QUANT
#undef A_COMPUTE
          }
        } }
        GRID_BAR();
        { PHASE_PTRS LAYER_PTRS
        { const int ln = lane_id_v();
          const float* PART = (const float*)(wsq + WS_PART); float* WGT = (float*)(wsq + WS_WGT);
          for (int rep_ = 0; rep_ < REP_P10B; ++rep_)
          for (int i4 = vcu * NTHREADS + wave * 64 + ln; i4 < T_EFF * NSEL / 4; i4 += NGT) {
              f32x4 dsum = (f32x4){0.f, 0.f, 0.f, 0.f};
#pragma unroll
              for (int sl = 0; sl < 8; ++sl) dsum += *((const GAS f32x4*)(PART + (size_t)sl * T_ALL * NSEL) + i4);
              const v4u esu = *((const GAS v4u*)EI + i4); const f32x4 gv = *((const GAS f32x4*)EG + i4);
              v4u o;
#pragma unroll
              for (int q = 0; q < 4; ++q) {
                  const float dot = dsum[q] * bf2f(esu[q] >> 16);
                  o[q] = (esu[q] & 0xffffu) | (f2bf(0.5f * dot * (1.0f + erff(dot * 0.70710678118654752f)) * gv[q]) << 16);
              }
              *((GAS v4u*)WGT + i4) = o;
          }
        } }
        GRID_BAR();
        { PHASE_PTRS LAYER_PTRS
        { const int ln = lane_id_v(); const int c = ln & 7, tg = ln >> 3;
          P10_CENSUS
          const unsigned* WGT = (const unsigned*)(wsq + WS_WGT); float* XO = (float*)(wsq + WS_XO);
          const unsigned char* V8l = V8 + (size_t)layer * 16384 * D;
          for (int rep_ = 0; rep_ < REP_P10C; ++rep_)
#pragma unroll 1
          for (int sl = 0; sl < 8; ++sl) {
            if (!((smask_ >> sl) & 1u)) continue;
            const int ws0 = (rank_ * NWAVES + wave) * 8, nslot = wstride_ * 8;
            if (ws0 >= T_EFF) continue;
            const int niter = (T_EFF - ws0 + nslot - 1) / nslot, nb = niter * 8;
#define C_TOK(bi) (ws0 + tg + (min((bi), nb - 1) >> 3) * nslot)
#define C_LOAD_PK(pkv, bi) { const GAS v4u* wp_ = (const GAS v4u*)(WGT + (size_t)C_TOK(bi) * NSEL + 16 * (min((bi), nb - 1) & 7)); _Pragma("unroll") for (int q = 0; q < 4; ++q) pkv[q] = wp_[q]; }
#define C_ISSUE(rowv, wv, pkv) { _Pragma("unroll") for (int q = 0; q < 16; ++q) { const unsigned w_ = pkv[q >> 2][q & 3]; rowv[q] = *(const GAS v4u*)(V8l + (size_t)(w_ & 0xffffu) * D + 128 * sl + 16 * c); } \
                _Pragma("unroll") for (int q = 0; q < 8; ++q) wv[q] = (pkv[q >> 1][(2 * q) & 3] >> 16) | (pkv[q >> 1][(2 * q + 1) & 3] & 0xffff0000u); }
#define C_COMPUTE(rowv, wv) { _Pragma("unroll") for (int q = 0; q < 16; ++q) { const float wq_ = (q & 1) ? __builtin_bit_cast(float, wv[q >> 1] & 0xffff0000u) : bf2f(wv[q >> 1] & 0xffffu); const f32x2 w2_ = (f32x2){wq_, wq_}; _Pragma("unroll") for (int j = 0; j < 4; ++j) { \
                    const f32x2 a = __builtin_amdgcn_cvt_pk_f32_fp8((int)rowv[q][j], false), b = __builtin_amdgcn_cvt_pk_f32_fp8((int)rowv[q][j], true); \
                    f32x2 lo_ = (f32x2){o[j].x, o[j].y}, hi_ = (f32x2){o[j].z, o[j].w}; lo_ = __builtin_elementwise_fma(a, w2_, lo_); hi_ = __builtin_elementwise_fma(b, w2_, hi_); \
                    o[j].x = lo_.x; o[j].y = lo_.y; o[j].z = hi_.x; o[j].w = hi_.y; } \
                    asm volatile("" : "+v"(o[0]), "+v"(o[1]), "+v"(o[2]), "+v"(o[3])); } }
            v4u pkA[4], pkB[4]; unsigned wA[8], wB[8]; v4u rowA[16], rowB[16];
            f32x4 o[4];
#pragma unroll
            for (int j = 0; j < 4; ++j) o[j] = (f32x4){0.f, 0.f, 0.f, 0.f};
            C_LOAD_PK(pkA, 0) C_LOAD_PK(pkB, 1)
            C_ISSUE(rowA, wA, pkA)
#pragma unroll 1
            for (int bi = 0; bi < nb; bi += 2) {
                C_ISSUE(rowB, wB, pkB) C_LOAD_PK(pkA, bi + 2)
                __builtin_amdgcn_sched_barrier(0);
                C_COMPUTE(rowA, wA)
                __builtin_amdgcn_sched_barrier(0);
                C_ISSUE(rowA, wA, pkA) C_LOAD_PK(pkB, bi + 3)
                __builtin_amdgcn_sched_barrier(0);
                C_COMPUTE(rowB, wB)
                __builtin_amdgcn_sched_barrier(0);
                if ((bi & 7) == 6) {
                    const int t = ws0 + tg + (bi >> 3) * nslot;
#pragma unroll
                    for (int j = 0; j < 4; ++j) { *(GAS f32x4*)(XO + (size_t)t * D + 256 * j + 32 * sl + 4 * c) = o[j]; o[j] = (f32x4){0.f, 0.f, 0.f, 0.f}; }
                }
            }
#undef C_TOK
#undef C_LOAD_PK
#undef C_ISSUE
#undef C_COMPUTE
          }
        } }
        GRID_BAR();
#undef P10_CENSUS
        { PHASE_PTRS LAYER_PTRS
        { const int ln = lane_id_v();
          const float* XO = (const float*)(wsq + WS_XO);
          f32x4 gt2v[4], gm[4], shv[4];
          auto prep = [&](int midx) {
              const float* md = modl + (size_t)midx * 6 * D; const float* md1 = modl + (size_t)(3 + midx) * 6 * D;
#pragma unroll
              for (int j = 0; j < 4; ++j) {
                  gt2v[j] = *((const GAS f32x4*)(md + 5 * D) + ln + 64 * j);
                  if (!last) { const f32x4 g = *((const GAS f32x4*)(IN_[I_G1] + (layer + 1) * D) + ln + 64 * j); const f32x4 sc = *((const GAS f32x4*)(md1 + D) + ln + 64 * j);
                               gm[j] = g * (sc + 1.0f); shv[j] = *((const GAS f32x4*)(md1 + 0) + ln + 64 * j); }
                  else { gm[j] = *((const GAS f32x4*)IN_[I_GFINAL] + ln + 64 * j); shv[j] = (f32x4){0.f, 0.f, 0.f, 0.f}; }
              } };
          auto row = [&](int t) {
              GAS f32x4* xr = (GAS f32x4*)(X + (size_t)t * D) + ln;
              const GAS f32x4* xo = (const GAS f32x4*)(XO + (size_t)t * D) + ln;
              f32x4 xn[4]; float ss = 0.f;
#pragma unroll
              for (int j = 0; j < 4; ++j) { xn[j] = xr[64 * j] + gt2v[j] * xo[64 * j]; ss += (xn[j].x * xn[j].x + xn[j].y * xn[j].y) + (xn[j].z * xn[j].z + xn[j].w * xn[j].w); }
              const float rs = 1.0f / sqrtf(wave_sum(ss) * (1.f / D) + NORM_EPS);
              if (!last) {
                  GAS v2u* o8 = (GAS v2u*)(H + (size_t)t * D) + ln;
#pragma unroll
                  for (int j = 0; j < 4; ++j) { xr[64 * j] = xn[j]; const f32x4 hh = xn[j] * rs * gm[j] + shv[j]; v2u o; o.x = pk2(hh.x, hh.y); o.y = pk2(hh.z, hh.w); o8[64 * j] = o; }
              } else {
                  GAS f32x4* op = (GAS f32x4*)(((float*)IN_[22]) + (size_t)t * D) + ln;
#pragma unroll
                  for (int j = 0; j < 4; ++j) op[64 * j] = xn[j] * rs * gm[j];
              } };
          wave_row_blocks(T_EFF, gw, NGW, prep, row);
        } }
#endif
        if (!last) GRID_BAR();
    }
}

extern "C" void kernel_launch(void* const* d_in, const int* in_sizes, int n_in, void* d_out, int out_size, void* d_ws, size_t ws_size, hipStream_t stream) {
    static int grid = 0;
    if (grid == 0) {
        if (n_in != 22 || out_size != T_LAT * D || ws_size < WS_END) { fprintf(stderr, "kernel_launch: unexpected shapes: n_in %d out %d ws %zu (need %zu)\n", n_in, out_size, ws_size, (size_t)WS_END); grid = -1; return; }
        int dev = 0, cus = 0, per_cu = 0;
        if (hipGetDevice(&dev) != hipSuccess || hipDeviceGetAttribute(&cus, hipDeviceAttributeMultiprocessorCount, dev) != hipSuccess) { fprintf(stderr, "device query failed\n"); grid = -1; return; }
        if (hipFuncSetAttribute((const void*)mega_fwd, hipFuncAttributeMaxDynamicSharedMemorySize, LDS_BYTES) != hipSuccess) { fprintf(stderr, "hipFuncSetAttribute failed\n"); grid = -1; return; }
        if (hipOccupancyMaxActiveBlocksPerMultiprocessor(&per_cu, (const void*)mega_fwd, NTHREADS, LDS_BYTES) != hipSuccess || per_cu < 1) { fprintf(stderr, "occupancy query: %d\n", per_cu); }
        (void)hipGetLastError();
        grid = cus;
    }
    if (grid < 0) return;
    if (hipMemsetAsync((char*)d_ws + WS_CTL, 0, CTL_ZERO_BYTES, stream) != hipSuccess) { fprintf(stderr, "memset failed\n"); return; }
    Args a{};
    for (int i = 0; i < 22; ++i) a.in[i] = (const float*)d_in[i];
    a.out = (float*)d_out; a.ws = (unsigned char*)d_ws;
    hipLaunchKernelGGL(mega_fwd, dim3(grid), dim3(NTHREADS), LDS_BYTES, stream, a);
}
```

```cpp
#include <hip/hip_runtime.h>
#include <cstdio>
#include <cstdint>

#ifndef REP_P0
#define REP_P0 1
#endif
#ifndef REP_P1
#define REP_P1 1
#endif
#ifndef REP_P2
#define REP_P2 1
#endif
#ifndef REP_P3A
#define REP_P3A 1
#endif
#ifndef REP_P3B
#define REP_P3B 1
#endif
#ifndef REP_P4
#define REP_P4 1
#endif
#ifndef REP_P6
#define REP_P6 1
#endif
#ifndef REP_P7
#define REP_P7 1
#endif
#ifndef REP_P8
#define REP_P8 1
#endif
#ifndef REP_P9
#define REP_P9 1
#endif
#ifndef REP_P10
#define REP_P10 1
#endif
#ifndef REP_P10A
#define REP_P10A 1
#endif
#ifndef REP_P10C
#define REP_P10C 1
#endif
#ifndef REP_P10B
#define REP_P10B 1
#endif
#ifndef REP_P0A
#define REP_P0A 1
#endif
#ifndef REP_P0D
#define REP_P0D 1
#endif
#ifndef REP_P0F
#define REP_P0F 1
#endif
#ifndef REP_P3C
#define REP_P3C 1
#endif
#define GAS __attribute__((address_space(1)))
#define LAS __attribute__((address_space(3)))
typedef unsigned short bf16;
typedef float f32x4 __attribute__((ext_vector_type(4)));
typedef short bf16x8 __attribute__((ext_vector_type(8)));
typedef unsigned v4u __attribute__((ext_vector_type(4)));
typedef unsigned v2u __attribute__((ext_vector_type(2)));
typedef float f32x2 __attribute__((ext_vector_type(2)));
typedef unsigned short u16x2 __attribute__((ext_vector_type(2)));
typedef GAS unsigned gu32;

constexpr int NWAVES = 8, NTHREADS = 512;
constexpr int D = 1024, BATCH = 2, SEQ = 8192, DEPTH = 2, GRID_W = 64, CTX = 256;
constexpr int T_LAT = BATCH * SEQ;
constexpr int T_ALL = T_LAT + BATCH * CTX;
constexpr int NTOK = SEQ + CTX;
constexpr int IN_W = 6912;
constexpr int PEER_HEADS = 8, PEER_KEYS = 128, PEER_TOPK = 16, NSEL = PEER_HEADS * PEER_TOPK;
constexpr float NORM_EPS = 1e-6f;
constexpr float LOG2E = 1.4426950408889634f;
constexpr float SCL2 = 0.125f * LOG2E;

constexpr size_t MiB = 1u << 20;
constexpr size_t WS_CTL = 0, CTL_ZERO_BYTES = 1 * MiB;
constexpr int CW_BAR = 4096;
constexpr int CW_RANK = 8192;
#ifndef P10_SLICED
#define P10_SLICED 1
#endif
constexpr size_t WS_MOD = 65536;
constexpr size_t WS_COS = 2 * MiB, WS_SIN = 3 * MiB;
constexpr size_t WS_WIN = 4 * MiB;
constexpr size_t WS_WB = 31 * MiB;
constexpr size_t WS_WO = 37 * MiB;
constexpr size_t WS_WQ = 41 * MiB;
constexpr size_t WS_KEYS = 49 * MiB;
constexpr size_t WS_X = 50 * MiB;
constexpr size_t WS_H = 116 * MiB;
constexpr size_t WS_Y = 149 * MiB;
constexpr size_t WS_MG = WS_H;
constexpr size_t WS_U8 = 199 * MiB;
constexpr size_t WS_H8 = 215 * MiB;
constexpr size_t WS_HS = WS_KEYS + 512 * 1024;
constexpr size_t WS_WGS = WS_KEYS + 640 * 1024;
constexpr size_t WS_WG8 = WS_Y;
constexpr size_t WS_SCU = WS_KEYS;
constexpr size_t WS_EI = 232 * MiB;
constexpr size_t WS_EG = 241 * MiB;
constexpr size_t WS_P = 250 * MiB;
constexpr size_t SZ_R512 = (size_t)T_ALL * 512 * 2;
constexpr size_t SZ_R128 = (size_t)T_ALL * 128 * 2;
constexpr size_t WS_AQ = WS_P, WS_AK = WS_AQ + SZ_R512, WS_AVT = WS_AK + SZ_R128, WS_BQ = WS_AVT + SZ_R128, WS_BK = WS_BQ + SZ_R512,
                 WS_BVT = WS_BK + SZ_R512, WS_CQ = WS_BVT + SZ_R512, WS_CK = WS_CQ + SZ_R512, WS_CVT = WS_CK + SZ_R512, WS_SG = WS_CVT + SZ_R512;
constexpr size_t WS_Q2 = WS_P;
constexpr size_t WS_SC = WS_P + 66 * MiB;
constexpr size_t WS_PART = WS_P, WS_XO = WS_P + 66 * MiB, WS_WGT = WS_P + 132 * MiB;
constexpr size_t WS_PEND = WS_SG + (size_t)T_ALL * 3072 * 2;
constexpr size_t WS_V8 = 473 * MiB;
constexpr size_t WS_END = WS_V8 + 32 * MiB;
static_assert(WS_SC + (size_t)T_ALL * 2048 * 4 <= WS_PEND && WS_PEND <= WS_V8, "alias map");
static_assert(WS_END <= 512 * MiB, "ws map");

constexpr int LDS_BYTES = 147456;
constexpr int MISC_OFF = 131072 + 320;

__device__ __forceinline__ int lane_id_v() { int l; asm volatile("v_mbcnt_lo_u32_b32 %0, -1, 0\n\tv_mbcnt_hi_u32_b32 %0, -1, %0" : "=v"(l)); return l; }
#define XB_TMO      128
#define XB_XCNT(j)  (256  + 64 * (j))
#define XB_XSUB(j)  (1280 + 64 * (j))
#define XB_XGEN(j)  (2304 + 64 * (j))
#define XB_TOP      3328
#define XB_TOPGEN   3392
#define XCD_BAR_WORDS 3456
#define XB_SPIN_CAP (1u << 24)

__device__ __forceinline__ unsigned xb_ld(unsigned* p)              { return __hip_atomic_load(p, __ATOMIC_RELAXED, __HIP_MEMORY_SCOPE_AGENT); }
__device__ __forceinline__ unsigned xb_add(unsigned* p, unsigned v) { return __hip_atomic_fetch_add(p, v, __ATOMIC_RELAXED, __HIP_MEMORY_SCOPE_AGENT); }
__device__ __forceinline__ unsigned xb_xcc_id() { return (unsigned)__builtin_amdgcn_s_getreg((3 << 11) | 20) & 0xFu; }
#define XB_SPIN(cond, bar) do { unsigned _sp = 0; while (cond) { __builtin_amdgcn_s_sleep(1); \
    if ((++_sp & 255u) == 0u) { if (xb_ld(&(bar)[XB_TMO])) break; if (_sp > XB_SPIN_CAP) { atomicAdd(&(bar)[XB_TMO], 1u); break; } } } } while (0)

struct XcdBarrier { unsigned* bar; unsigned x; volatile LAS unsigned* st; };

__device__ __forceinline__ XcdBarrier xcd_barrier_post(unsigned* bar, volatile LAS unsigned* st) {
    XcdBarrier b; b.bar = bar; b.x = xb_xcc_id(); b.st = st;
    if (threadIdx.x == 0) (void)xb_add(&bar[XB_XCNT(b.x)], 1u);
    return b;
}
__device__ __forceinline__ void xcd_barrier_complete(unsigned* bar, unsigned x, unsigned& nloc, unsigned& nx) {
    const unsigned G = gridDim.x * gridDim.y * gridDim.z;
    unsigned sum, cnt, mine, sp = 0u;
    for (;;) {
        sum = 0u; cnt = 0u; mine = 0u;
#pragma unroll
        for (unsigned j = 0; j < 16; ++j) { const unsigned c = xb_ld(&bar[XB_XCNT(j)]); sum += c; cnt += (c > 0u) ? 1u : 0u; mine = (j == x) ? c : mine; }
        if (sum == G) break;
        __builtin_amdgcn_s_sleep(1);
        if ((++sp & 255u) == 0u) { if (xb_ld(&bar[XB_TMO])) break; if (sp > XB_SPIN_CAP) { atomicAdd(&bar[XB_TMO], 1u); break; } }
    }
    nloc = mine > 0u ? mine : 1u; nx = cnt > 0u ? cnt : 1u;
}
__device__ __forceinline__ void xcd_barrier(const XcdBarrier& b, bool t0) {
    asm volatile("s_waitcnt vmcnt(0)" ::: "memory");
    __syncthreads();
    if (t0) {
        unsigned* bar = b.bar;
        __builtin_amdgcn_s_waitcnt(0);
        unsigned nloc = b.st[0], nx = b.st[1];
        if (nloc == 0u) { xcd_barrier_complete(bar, b.x, nloc, nx); b.st[0] = nloc; b.st[1] = nx; }
        const unsigned old = xb_add(&bar[XB_XSUB(b.x)], 1u);
        const unsigned gen = old / nloc;
        if (old + 1u == (gen + 1u) * nloc) {
            __builtin_amdgcn_fence(__ATOMIC_RELEASE, "agent");
            asm volatile("s_waitcnt vmcnt(0)" ::: "memory");
            const unsigned og = xb_add(&bar[XB_TOP], 1u);
            const unsigned tg = og / nx;
            if (og + 1u == (tg + 1u) * nx) xb_add(&bar[XB_TOPGEN], 1u);
            else XB_SPIN(xb_ld(&bar[XB_TOPGEN]) == tg, bar);
            __builtin_amdgcn_fence(__ATOMIC_ACQUIRE, "agent");
            xb_add(&bar[XB_XGEN(b.x)], 1u);
            asm volatile("s_waitcnt vmcnt(0)" ::: "memory");
        } else {
            XB_SPIN(xb_ld(&bar[XB_XGEN(b.x)]) == gen, bar);
            __builtin_amdgcn_fence(__ATOMIC_ACQUIRE, "agent");
            asm volatile("s_waitcnt vmcnt(0)" ::: "memory");
        }
    }
    __syncthreads();
}

__device__ __forceinline__ unsigned f2bf(float f) { unsigned u = __builtin_bit_cast(unsigned, f); return (u + 0x7fffu + ((u >> 16) & 1u)) >> 16; }
__device__ __forceinline__ unsigned pk2(float lo, float hi) { return f2bf(lo) | (f2bf(hi) << 16); }
__device__ __forceinline__ float bf2f(unsigned h) { return __builtin_bit_cast(float, h << 16); }
template <int CTRL> __device__ __forceinline__ float dpp_mov(float v) { return __builtin_bit_cast(float, __builtin_amdgcn_update_dpp(0, __builtin_bit_cast(int, v), CTRL, 0xF, 0xF, true)); }
__device__ __forceinline__ float sum8_dpp(float v) { v += dpp_mov<0xB1>(v); v += dpp_mov<0x4E>(v); v += dpp_mov<0x141>(v); return v; }
template <int K> __device__ __forceinline__ float xshfl_l(float v, int lane) { return __builtin_bit_cast(float, __builtin_amdgcn_ds_bpermute((lane ^ K) << 2, __builtin_bit_cast(int, v))); }
template <int K> __device__ __forceinline__ float xshfl(float v) { return xshfl_l<K>(v, lane_id_v()); }
__device__ __forceinline__ float xadd32(float v) { return v + xshfl_l<32>(v, lane_id_v()); }
__device__ __forceinline__ float xmax32(float v) { return fmaxf(v, xshfl_l<32>(v, lane_id_v())); }
__device__ __forceinline__ float wave_sum(float v) {
    v += dpp_mov<0xB1>(v); v += dpp_mov<0x4E>(v); v += dpp_mov<0x141>(v); v += dpp_mov<0x140>(v);
    const int b = __builtin_bit_cast(int, v);
    return (__builtin_bit_cast(float, __builtin_amdgcn_readlane(b, 0)) + __builtin_bit_cast(float, __builtin_amdgcn_readlane(b, 16))) + (__builtin_bit_cast(float, __builtin_amdgcn_readlane(b, 32)) + __builtin_bit_cast(float, __builtin_amdgcn_readlane(b, 48)));
}
__device__ __forceinline__ float wave_max(float v) {
    v = fmaxf(v, dpp_mov<0xB1>(v)); v = fmaxf(v, dpp_mov<0x4E>(v)); v = fmaxf(v, dpp_mov<0x141>(v)); v = fmaxf(v, dpp_mov<0x140>(v));
    const int b = __builtin_bit_cast(int, v);
    return fmaxf(fmaxf(__builtin_bit_cast(float, __builtin_amdgcn_readlane(b, 0)), __builtin_bit_cast(float, __builtin_amdgcn_readlane(b, 16))), fmaxf(__builtin_bit_cast(float, __builtin_amdgcn_readlane(b, 32)), __builtin_bit_cast(float, __builtin_amdgcn_readlane(b, 48))));
}


__device__ __forceinline__ float sigmoidf_(float x) { return 1.0f / (1.0f + __expf(-x)); }
__device__ __forceinline__ float sigmoid_fast(float x) { return __builtin_amdgcn_rcpf(1.0f + __builtin_amdgcn_exp2f(-LOG2E * x)); }
__device__ __forceinline__ int row_modidx(int r) { return r < T_LAT ? (r >> 13) : 2; }
__device__ __forceinline__ int row_batch(int r) { return r < T_LAT ? (r >> 13) : ((r - T_LAT) >> 8); }
__device__ __forceinline__ int row_tok(int r) { return r < T_LAT ? (r & (SEQ - 1)) : SEQ + ((r - T_LAT) & (CTX - 1)); }

__device__ __forceinline__ const float* xin_row(const float* x, const float* ctx, int r) { return r < T_LAT ? x + (size_t)r * D : ctx + (size_t)(r - T_LAT) * D; }
template <class Prep, class Row>
__device__ __forceinline__ void wave_row_blocks(int T_rows, int gw, int NGW, Prep prep, Row row) {
    for (int r0 = gw * 8; r0 < T_LAT; r0 += NGW * 8) {
        prep(r0 >> 13);
#pragma unroll 2
        for (int k = 0; k < 8; ++k) row(r0 + k);
    }
    if (T_rows > T_LAT) for (int r = T_LAT + gw; r < T_rows; r += NGW) { prep(2); row(r); }
}
struct Args { const float* in[22]; float* out; unsigned char* ws; };
enum { I_X = 0, I_C, I_CTX, I_CCTX, I_WMOD, I_BMOD, I_G1, I_G2, I_WIN, I_SINK, I_RPB, I_LAMBDA, I_SUBLN, I_WBA, I_WBB, I_WBC, I_WOUT, I_PWQ, I_PKEYS, I_PU, I_PV, I_GFINAL };

__device__ __forceinline__ int rope_perm(int c) {
    if (c < 640 || (c >= 2304 && c < 3328)) { const int w = c & 63; return (c & ~63) + 2 * (w & 31) + (w >> 5); }
    return c;
}
template <bool PERM = false>
__device__ __forceinline__ void p0_transpose_item(const float* W, int K, int N, bf16* WT, LAS float* scr, int item, int lane) {
    const int nblk = N / 32, kb = item / nblk, nb = item % nblk, k0 = 64 * kb, n0 = 32 * nb;
    {
        f32x4 w[8];
        const float* src = W + (size_t)(k0 + (lane >> 3)) * N + n0 + 4 * (lane & 7);
#pragma unroll
        for (int i = 0; i < 8; ++i) w[i] = *(const GAS f32x4*)(src + (size_t)(8 * i) * N);
#pragma unroll
        for (int i = 0; i < 8; ++i) { LAS float* d = scr + (8 * i + (lane >> 3)) * 33 + 4 * (lane & 7); d[0] = w[i].x; d[1] = w[i].y; d[2] = w[i].z; d[3] = w[i].w; }
    }
    asm volatile("s_waitcnt lgkmcnt(0)" ::: "memory");
    const int c = lane & 7;
#pragma unroll
    for (int j = 0; j < 4; ++j) { const int n = (lane >> 3) + 8 * j; const LAS float* s = scr + (8 * c) * 33 + n;
        v4u o; o.x = pk2(s[0 * 33], s[1 * 33]); o.y = pk2(s[2 * 33], s[3 * 33]); o.z = pk2(s[4 * 33], s[5 * 33]); o.w = pk2(s[6 * 33], s[7 * 33]);
        const int nout = PERM ? rope_perm(n0 + n) : (n0 + n);
        *(GAS v4u*)(WT + (size_t)nout * K + k0 + 8 * c) = o; }
    asm volatile("s_waitcnt lgkmcnt(0)" ::: "memory");
}

template <int UNR = 2, int NN = 4>
__device__ __forceinline__ void sgemm_tile(f32x4 (&acc)[4][NN], const bf16* A, int lda, const bf16* Bt, int ldb, int K, int row0, int col0, int lane) {
    const int fr = lane & 15, fq = lane >> 4;
    const bf16* ap = A + (size_t)(row0 + fr) * lda + fq * 8;
    const bf16* bp = Bt + (size_t)(col0 + fr) * ldb + fq * 8;
#pragma unroll UNR
    for (int k = 0; k < K; k += 32) {
        bf16x8 a[4], b[NN];
#pragma unroll
        for (int m = 0; m < 4; ++m) a[m] = *(const GAS bf16x8*)(ap + (size_t)m * 16 * lda + k);
#pragma unroll
        for (int n = 0; n < NN; ++n) b[n] = *(const GAS bf16x8*)(bp + (size_t)n * 16 * ldb + k);
#pragma unroll
        for (int m = 0; m < 4; ++m)
#pragma unroll
            for (int n = 0; n < NN; ++n) acc[m][n] = __builtin_amdgcn_mfma_f32_16x16x32_bf16(a[m], b[n], acc[m][n], 0, 0, 0);
    }
}
template <int UNR>
__device__ __forceinline__ void sgemm32(f32x4 (&acc)[2][2], const bf16* A, int lda, const bf16* Bt, int ldb, int K, int row0, int col0, int lane) {
    const int fr = lane & 15, fq = lane >> 4;
    const bf16* ap = A + (size_t)(row0 + fr) * lda + fq * 8;
    const bf16* bp = Bt + (size_t)(col0 + fr) * ldb + fq * 8;
#pragma unroll 1
    for (int k0 = 0; k0 < K; k0 += 32 * UNR) {
        bf16x8 a[UNR][2], b[UNR][2];
#pragma unroll
        for (int u = 0; u < UNR; ++u)
#pragma unroll
            for (int m = 0; m < 2; ++m) { a[u][m] = *(const GAS bf16x8*)(ap + (size_t)m * 16 * lda + k0 + 32 * u); b[u][m] = *(const GAS bf16x8*)(bp + (size_t)m * 16 * ldb + k0 + 32 * u); }
#pragma unroll
        for (int u = 0; u < UNR; ++u)
#pragma unroll
            for (int m = 0; m < 2; ++m)
#pragma unroll
                for (int n = 0; n < 2; ++n) acc[m][n] = __builtin_amdgcn_mfma_f32_16x16x32_bf16(a[u][m], b[u][n], acc[m][n], 0, 0, 0);
    }
}
__device__ __forceinline__ void zero_acc22(f32x4 (&acc)[2][2]) { acc[0][0] = acc[0][1] = acc[1][0] = acc[1][1] = (f32x4){0.f, 0.f, 0.f, 0.f}; }
template <int NN>
__device__ __forceinline__ void zero_acc(f32x4 (&acc)[4][NN]) {
#pragma unroll
    for (int m = 0; m < 4; ++m)
#pragma unroll
        for (int n = 0; n < NN; ++n) acc[m][n] = (f32x4){0.f, 0.f, 0.f, 0.f};
}

__device__ __forceinline__ void p0_wqk_item(const float* keys_l, const float* wq_l, bf16* WQKl, int item, int lane) {
    const int g = item >> 7, kb = (item >> 5) & 3, cb = item & 31, fr = lane & 15, fq = lane >> 4;
    const float* ap = keys_l + ((size_t)g * 128 + kb * 32 + fr) * 128 + fq * 8;
    const float* bp = wq_l + (size_t)(cb * 32 + fr) * 2048 + g * 128 + fq * 8;
    f32x4 acc[2][2];
#pragma unroll
    for (int m = 0; m < 2; ++m)
#pragma unroll
        for (int n = 0; n < 2; ++n) acc[m][n] = (f32x4){0.f, 0.f, 0.f, 0.f};
#pragma unroll
    for (int ks = 0; ks < 4; ++ks) {
        bf16x8 a[2], b[2];
#pragma unroll
        for (int m = 0; m < 2; ++m) { const f32x4 x0 = *(const GAS f32x4*)(ap + (size_t)m * 16 * 128 + ks * 32), x1 = *(const GAS f32x4*)(ap + (size_t)m * 16 * 128 + ks * 32 + 4);
            v4u w; w.x = pk2(x0.x, x0.y); w.y = pk2(x0.z, x0.w); w.z = pk2(x1.x, x1.y); w.w = pk2(x1.z, x1.w); a[m] = __builtin_bit_cast(bf16x8, w); }
#pragma unroll
        for (int n = 0; n < 2; ++n) { const f32x4 y0 = *(const GAS f32x4*)(bp + (size_t)n * 16 * 2048 + ks * 32), y1 = *(const GAS f32x4*)(bp + (size_t)n * 16 * 2048 + ks * 32 + 4);
            v4u w; w.x = pk2(y0.x, y0.y); w.y = pk2(y0.z, y0.w); w.z = pk2(y1.x, y1.y); w.w = pk2(y1.z, y1.w); b[n] = __builtin_bit_cast(bf16x8, w); }
#pragma unroll
        for (int m = 0; m < 2; ++m)
#pragma unroll
            for (int n = 0; n < 2; ++n) acc[m][n] = __builtin_amdgcn_mfma_f32_16x16x32_bf16(a[m], b[n], acc[m][n], 0, 0, 0);
    }
#pragma unroll
    for (int m = 0; m < 2; ++m)
#pragma unroll
        for (int r = 0; r < 4; ++r) {
            bf16* rowp = WQKl + (size_t)(g * 128 + kb * 32 + 16 * m + 4 * fq + r) * D + cb * 32 + fr;
#pragma unroll
            for (int n = 0; n < 2; ++n) rowp[16 * n] = (bf16)f2bf(acc[m][n][r]);
        }
}

__device__ __forceinline__ void h8_row(const f32x4 (&hv)[4], unsigned char* H8row, float* hs, int ln) {
    float am = 0.f;
#pragma unroll
    for (int j = 0; j < 4; ++j) am = fmaxf(am, fmaxf(fmaxf(fabsf(hv[j].x), fabsf(hv[j].y)), fmaxf(fabsf(hv[j].z), fabsf(hv[j].w))));
    am = fmaxf(wave_max(am), 1e-20f);
    const float iq = 127.0f / am;
#pragma unroll
    for (int j = 0; j < 4; ++j) {
        const int q0 = __float2int_rn(hv[j].x * iq), q1 = __float2int_rn(hv[j].y * iq), q2 = __float2int_rn(hv[j].z * iq), q3 = __float2int_rn(hv[j].w * iq);
        *((GAS unsigned*)(H8row + 256 * j) + ln) = (unsigned)(q0 & 255) | ((unsigned)(q1 & 255) << 8) | ((unsigned)(q2 & 255) << 16) | ((unsigned)q3 << 24);
    }
    if (ln == 0) *hs = am * (1.0f / 127.0f);
}
__device__ __forceinline__ void wg8_rows(const bf16* WINl, unsigned char* WG8, float* wgs, int gw, int NGW, int ln) {
    for (int n = gw; n < IN_W; n += NGW) {
        const GAS v4u* src = (const GAS v4u*)(WINl + (size_t)n * D) + 2 * ln;
        const v4u a = src[0], b = src[1];
        float f[16];
#pragma unroll
        for (int i = 0; i < 4; ++i) { f[2 * i] = bf2f(a[i] & 0xffffu); f[2 * i + 1] = bf2f(a[i] >> 16); f[8 + 2 * i] = bf2f(b[i] & 0xffffu); f[8 + 2 * i + 1] = bf2f(b[i] >> 16); }
        float am = 0.f;
#pragma unroll
        for (int i = 0; i < 16; ++i) am = fmaxf(am, fabsf(f[i]));
        am = fmaxf(wave_max(am), 1e-30f);
        const float iq = 127.0f / am;
        v4u o;
#pragma unroll
        for (int w = 0; w < 4; ++w) {
            const int q0 = __float2int_rn(f[4 * w] * iq), q1 = __float2int_rn(f[4 * w + 1] * iq), q2 = __float2int_rn(f[4 * w + 2] * iq), q3 = __float2int_rn(f[4 * w + 3] * iq);
            o[w] = (unsigned)(q0 & 255) | ((unsigned)(q1 & 255) << 8) | ((unsigned)(q2 & 255) << 16) | ((unsigned)q3 << 24);
        }
        *((GAS v4u*)(WG8 + (size_t)n * D) + ln) = o;
        if (ln == 0) wgs[n] = am * (1.0f / 127.0f);
    }
}

__device__ __forceinline__ int f2ord(float f) { const int b = __builtin_bit_cast(int, f); return b ^ ((b >> 31) & 0x7fffffff); }
__device__ __forceinline__ float ord2f(int o) { const int b = o ^ ((o >> 31) & 0x7fffffff); return __builtin_bit_cast(float, b); }
__device__ __forceinline__ void top16_insert(int (&top)[16], int key) {
#pragma unroll
    for (int i = 0; i < 16; ++i) { const int hi = max(top[i], key); key = min(top[i], key); top[i] = hi; }
}
#define CE(a, b) { const int t_ = max(a, b); b = min(a, b); a = t_; }
__device__ __forceinline__ void sort16_desc(int (&v)[16]) { CE(v[0], v[1]); CE(v[3], v[2]); CE(v[4], v[5]); CE(v[7], v[6]); CE(v[8], v[9]); CE(v[11], v[10]); CE(v[12], v[13]); CE(v[15], v[14]); CE(v[0], v[2]); CE(v[1], v[3]); CE(v[6], v[4]); CE(v[7], v[5]); CE(v[8], v[10]); CE(v[9], v[11]); CE(v[14], v[12]); CE(v[15], v[13]); CE(v[0], v[1]); CE(v[2], v[3]); CE(v[5], v[4]); CE(v[7], v[6]); CE(v[8], v[9]); CE(v[10], v[11]); CE(v[13], v[12]); CE(v[15], v[14]); CE(v[0], v[4]); CE(v[1], v[5]); CE(v[2], v[6]); CE(v[3], v[7]); CE(v[12], v[8]); CE(v[13], v[9]); CE(v[14], v[10]); CE(v[15], v[11]); CE(v[0], v[2]); CE(v[1], v[3]); CE(v[4], v[6]); CE(v[5], v[7]); CE(v[10], v[8]); CE(v[11], v[9]); CE(v[14], v[12]); CE(v[15], v[13]); CE(v[0], v[1]); CE(v[2], v[3]); CE(v[4], v[5]); CE(v[6], v[7]); CE(v[9], v[8]); CE(v[11], v[10]); CE(v[13], v[12]); CE(v[15], v[14]); CE(v[0], v[8]); CE(v[1], v[9]); CE(v[2], v[10]); CE(v[3], v[11]); CE(v[4], v[12]); CE(v[5], v[13]); CE(v[6], v[14]); CE(v[7], v[15]); CE(v[0], v[4]); CE(v[1], v[5]); CE(v[2], v[6]); CE(v[3], v[7]); CE(v[8], v[12]); CE(v[9], v[13]); CE(v[10], v[14]); CE(v[11], v[15]); CE(v[0], v[2]); CE(v[1], v[3]); CE(v[4], v[6]); CE(v[5], v[7]); CE(v[8], v[10]); CE(v[9], v[11]); CE(v[12], v[14]); CE(v[13], v[15]); CE(v[0], v[1]); CE(v[2], v[3]); CE(v[4], v[5]); CE(v[6], v[7]); CE(v[8], v[9]); CE(v[10], v[11]); CE(v[12], v[13]); CE(v[14], v[15]); }
__device__ __forceinline__ void merge16_desc(int (&a)[16], const int (&b)[16]) {
#pragma unroll
    for (int i = 0; i < 16; ++i) a[i] = max(a[i], b[15 - i]);
    CE(a[0], a[8]); CE(a[1], a[9]); CE(a[2], a[10]); CE(a[3], a[11]); CE(a[4], a[12]); CE(a[5], a[13]); CE(a[6], a[14]); CE(a[7], a[15]); CE(a[0], a[4]); CE(a[1], a[5]); CE(a[2], a[6]); CE(a[3], a[7]); CE(a[8], a[12]); CE(a[9], a[13]); CE(a[10], a[14]); CE(a[11], a[15]); CE(a[0], a[2]); CE(a[1], a[3]); CE(a[4], a[6]); CE(a[5], a[7]); CE(a[8], a[10]); CE(a[9], a[11]); CE(a[12], a[14]); CE(a[13], a[15]); CE(a[0], a[1]); CE(a[2], a[3]); CE(a[4], a[5]); CE(a[6], a[7]); CE(a[8], a[9]); CE(a[10], a[11]); CE(a[12], a[13]); CE(a[14], a[15]); }
#undef CE


typedef float f32x16 __attribute__((ext_vector_type(16)));
typedef short s16x4 __attribute__((ext_vector_type(4)));
typedef __bf16 bf16x2_t __attribute__((ext_vector_type(2)));
__device__ __forceinline__ unsigned cvtpk(float lo, float hi) { f32x2 v = {lo, hi}; bf16x2_t b = __builtin_convertvector(v, bf16x2_t); return __builtin_bit_cast(unsigned, b); }
constexpr int CK_PITCH = 144, CV_PITCH = 320;
constexpr int CK_SZ = 64 * CK_PITCH, CV_SZ = 64 * CV_PITCH;
#ifndef VRING
#define VRING 4
#endif
constexpr float C_GROW_SUM = 4096.0f;
constexpr float C_THR_RAW = 8.0f / SCL2;

template <int NDV, bool HASCM, class RowFn, class UseFn, class ElemFn, class CmFn>
__device__ __forceinline__ void attn64_pass(f32x16 (&o)[NDV], float& mrun, float& lpart, const bf16x8 (&qf)[4], const bf16* kg, int kpitch, const bf16* vg, int vpitch,
                                            int ntiles, RowFn tile_row, UseFn use_tile, ElemFn elem, const f32x16 (&cm)[2], CmFn cm_tile, LAS unsigned char* L, int lane, int tid) {
    constexpr int VP = NDV * 64 + 64, VSZ = 64 * VP, NVP = NDV / 2;
    const int r32 = lane & 31, hi = lane >> 5;
    const int krow_s = tid >> 3, kch_s = tid & 7;
    const int vrow_s = (NDV == 2) ? (tid >> 3) : (tid >> 4), vch_s = (NDV == 2) ? (tid & 7) : (tid & 15);
    LAS unsigned char* Kb0 = L; LAS unsigned char* Vb0 = L + 2 * CK_SZ;
    __syncthreads();
    {
        const int tr = tile_row(0);
        const v4u kr = *(const GAS v4u*)(kg + (size_t)tr * kpitch);
        *(LAS v4u*)(Kb0 + krow_s * CK_PITCH + kch_s * 16) = kr;
#pragma unroll
        for (int i = 0; i < NVP; ++i) { const v4u v = *(const GAS v4u*)(vg + (size_t)(tr + 32 * i) * vpitch); *(LAS v4u*)(Vb0 + (vrow_s + 32 * i) * VP + vch_s * 16) = v; }
    }
    v4u kr, vr[NVP];
    { const int tr = tile_row(ntiles > 1 ? 1 : 0); kr = *(const GAS v4u*)(kg + (size_t)tr * kpitch);
#pragma unroll
      for (int i = 0; i < NVP; ++i) vr[i] = *(const GAS v4u*)(vg + (size_t)(tr + 32 * i) * vpitch); }
    __syncthreads();
#pragma unroll 1
    for (int j = 0; j < ntiles; ++j) {
        const int cur = j & 1;
        const LAS unsigned char* Kb = Kb0 + cur * CK_SZ; const LAS unsigned char* Vb = Vb0 + cur * VSZ;
        const bool more = (j + 1 < ntiles);
        v4u kr2, vr2[NVP];
        { const int tr = tile_row(j + 2 < ntiles ? j + 2 : ntiles - 1); kr2 = *(const GAS v4u*)(kg + (size_t)tr * kpitch);
#pragma unroll
            for (int i = 0; i < NVP; ++i) vr2[i] = *(const GAS v4u*)(vg + (size_t)(tr + 32 * i) * vpitch); }
        if (use_tile(j)) {
            f32x16 st[2];
            if (HASCM && cm_tile(j)) {
#pragma unroll
                for (int kb = 0; kb < 2; ++kb) {
#pragma unroll
                    for (int ks = 0; ks < 4; ++ks) {
                        const bf16x8 kf = *(const LAS bf16x8*)(Kb + (kb * 32 + r32) * CK_PITCH + ks * 32 + hi * 16);
                        st[kb] = __builtin_amdgcn_mfma_f32_32x32x16_bf16(kf, qf[ks], ks == 0 ? cm[kb] : st[kb], 0, 0, 0);
                    }
                }
            } else {
#pragma unroll
                for (int kb = 0; kb < 2; ++kb) {
#pragma unroll
                    for (int r = 0; r < 16; ++r) st[kb][r] = 0.f;
#pragma unroll
                    for (int ks = 0; ks < 4; ++ks) {
                        const bf16x8 kf = *(const LAS bf16x8*)(Kb + (kb * 32 + r32) * CK_PITCH + ks * 32 + hi * 16);
                        st[kb] = __builtin_amdgcn_mfma_f32_32x32x16_bf16(kf, qf[ks], st[kb], 0, 0, 0);
                    }
                }
            }
            elem(st, j);
            float mx = st[0][0];
#pragma unroll
            for (int r = 1; r < 16; ++r) mx = fmaxf(mx, st[0][r]);
#pragma unroll
            for (int r = 0; r < 16; ++r) mx = fmaxf(mx, st[1][r]);
            mx = xmax32(mx);
            if (__builtin_amdgcn_ballot_w64(mx > mrun + C_THR_RAW) != 0ull) {
                const float mn = fmaxf(mrun, mx);
                const float alpha = __builtin_amdgcn_exp2f((mrun - mn) * SCL2);
#pragma unroll
                for (int d = 0; d < NDV; ++d)
#pragma unroll
                    for (int r = 0; r < 16; ++r) o[d][r] *= alpha;
                lpart *= alpha; mrun = mn;
            }
            const float nmc = -mrun * SCL2;
            float ls = 0.f;
#pragma unroll
            for (int kb = 0; kb < 2; ++kb)
#pragma unroll
                for (int r = 0; r < 16; ++r) { const float p = __builtin_amdgcn_exp2f(fmaf(st[kb][r], SCL2, nmc)); st[kb][r] = p; ls += p; }
            lpart += ls;
            const int q4 = (lane & 15) >> 2, p4 = lane & 3, grp = (lane >> 4) & 1;
            const LAS unsigned char* vbase = Vb + (4 * hi + q4) * VP + (16 * grp + 4 * p4) * 2;
#pragma unroll
            for (int kb = 0; kb < 2; ++kb)
#pragma unroll
                for (int ss = 0; ss < 2; ++ss) {
                    v4u pw;
#pragma unroll
                    for (int i2 = 0; i2 < 4; ++i2) pw[i2] = cvtpk(st[kb][8 * ss + 2 * i2], st[kb][8 * ss + 2 * i2 + 1]);
                    const bf16x8 pb = __builtin_bit_cast(bf16x8, pw);
#pragma unroll
                    for (int d = 0; d < NDV; ++d) {
                        const LAS unsigned char* va = vbase + (kb * 32 + 16 * ss) * VP + d * 64;
                        const s16x4 lo = __builtin_bit_cast(s16x4, __builtin_amdgcn_ds_read_tr16_b64_v4i16((LAS s16x4*)va));
                        const s16x4 hh = __builtin_bit_cast(s16x4, __builtin_amdgcn_ds_read_tr16_b64_v4i16((LAS s16x4*)(va + 8 * VP)));
                        const bf16x8 vf = __builtin_shufflevector(lo, hh, 0, 1, 2, 3, 4, 5, 6, 7);
                        o[d] = __builtin_amdgcn_mfma_f32_32x32x16_bf16(vf, pb, o[d], 0, 0, 0);
                    }
                }
        }
        if (more) {
            LAS unsigned char* Kn = Kb0 + (cur ^ 1) * CK_SZ; LAS unsigned char* Vn = Vb0 + (cur ^ 1) * VSZ;
            *(LAS v4u*)(Kn + krow_s * CK_PITCH + kch_s * 16) = kr;
#pragma unroll
            for (int i = 0; i < NVP; ++i) *(LAS v4u*)(Vn + (vrow_s + 32 * i) * VP + vch_s * 16) = vr[i];
        }
        kr = kr2;
#pragma unroll
        for (int i = 0; i < NVP; ++i) vr[i] = vr2[i];
        __syncthreads();
    }
}
__device__ __forceinline__ void attn64_store(const f32x16 (&o)[2], float inv, bf16* yrow, int hi) {
#pragma unroll
    for (int d = 0; d < 2; ++d)
#pragma unroll
        for (int g4 = 0; g4 < 4; ++g4) {
            v2u w; w.x = cvtpk(o[d][4 * g4] * inv, o[d][4 * g4 + 1] * inv); w.y = cvtpk(o[d][4 * g4 + 2] * inv, o[d][4 * g4 + 3] * inv);
            *(GAS v2u*)(yrow + d * 32 + 8 * g4 + 4 * hi) = w;
        }
}

namespace pg8 {
typedef unsigned short bf16_t;
constexpr int BM = 256, BK = 64, HALF = 128, HTB = HALF * BK * 2, STAGE_BYTES = 8 * HTB, NXCD = 8, WGM = 8;
__host__ __device__ __forceinline__ int lds_byte(int r, int c) { const int st = (r >> 4) * 2 + (c >> 5), rr = r & 15, cc = c & 31, ob = rr * 64 + cc * 2; return st * 1024 + (ob ^ (((ob >> 9) & 1) << 5)); }
__host__ __device__ __forceinline__ void stage_rc(int b, int& R, int& C) { const int st = b / 1024, sb = b % 1024, swz = sb ^ (((sb >> 9) & 1) << 5); R = (st >> 1) * 16 + swz / 64; C = (st & 1) * 32 + (swz % 64) / 2; }
__host__ __device__ __forceinline__ int perm32(int rho) { const int n = rho >> 4, i = rho & 15; return 8 * (i >> 2) + 4 * n + (i & 3); }
struct Unit { int pm, pn, seg; };
struct Gemm { const bf16_t* A; const bf16_t* Bt; int lda, ldb, K; size_t a_seg, b_seg; };
struct TileOrder {
    int nM, nN, nwg, G, c;
    __device__ void init(int M, int N, int G_, int c_) { nM = M / BM; nN = N / BM; nwg = nM * nN; G = G_; c = c_; }
    __device__ bool tile(int i, int& pm, int& pn) const {
        const long L = (long)i * G + c; if (L >= nwg) return false;
        int wgid = (int)L; { const int q = nwg / NXCD, r = nwg % NXCD, xcd = wgid % NXCD, off = wgid / NXCD; wgid = (xcd < r ? xcd * (q + 1) : r * (q + 1) + (xcd - r) * q) + off; }
        const int nig = WGM * nN, gid = wgid / nig, fm = gid * WGM, gsz = (nM - fm) < WGM ? (nM - fm) : WGM;
        pm = fm + ((wgid % nig) % gsz); pn = (wgid % nig) / gsz; return true;
    }
};
template <int NSEG> struct SegOrder {
    TileOrder T;
    __device__ bool next(int i, Unit& u) const { u.seg = i % NSEG; return T.tile(i / NSEG, u.pm, u.pn); }
};
typedef int i32x4_t __attribute__((ext_vector_type(4)));
template <bool I8 = false, class Epi, class Sched>
__device__ __forceinline__ void gemm_phase(LAS unsigned char* lds, const Gemm g, const Sched& S, const Epi& E, int wid) {
    using acc_t = typename std::conditional<I8, i32x4_t, f32x4>::type;
    const int lane = lane_id_v(), tid = wid * 64 + lane,
              wr = wid >> 2, wc = wid & 3, fr = lane & 15, fq = lane >> 4;
    const int K = g.K, nt = K / BK;
    unsigned voffA[2], voffB[2];
#pragma unroll
    for (int i = 0; i < 2; ++i) { int R, C; stage_rc(tid * 16 + i * 8192, R, C); const int Rb = (R & ~31) + perm32(R & 31);
        voffA[i] = (unsigned)(R * g.lda + C) * 2u; voffB[i] = (unsigned)(Rb * g.ldb + C) * 2u; }
    const size_t kstep = (size_t)(BK * 2);
    const size_t hstepA = (size_t)HALF * g.lda * 2, hstepB = (size_t)HALF * g.ldb * 2;
    const unsigned ldsw = (unsigned)wid * 1024u;
    const int aoff = lds_byte(wr * 64 + fr, fq * 8), boff = lds_byte(wc * 32 + fr, fq * 8);
#define PG8_SA(b, h) (((b) * 2 + (h)) * HTB)
#define PG8_SB(b, h) ((4 + (b) * 2 + (h)) * HTB)
#define PG8_STAGE(bufoff, gbase, voff) do { _Pragma("unroll") for (int _i = 0; _i < 2; ++_i) \
        __builtin_amdgcn_global_load_lds((const unsigned*)((const char*)(gbase) + (voff)[_i]), (LAS unsigned*)(lds + (bufoff) + ldsw + _i * 8192), 16, 0, 0); } while (0)
#define PG8_LDA(dst, b, h) do { _Pragma("unroll") for (int m = 0; m < 4; ++m) _Pragma("unroll") for (int k = 0; k < 2; ++k) dst[m][k] = *(const LAS bf16x8*)(lds + PG8_SA(b, h) + aoff + m * 2048 + k * 1024); } while (0)
#define PG8_LDB(dst, b, h) do { _Pragma("unroll") for (int n = 0; n < 2; ++n) _Pragma("unroll") for (int k = 0; k < 2; ++k) dst[n][k] = *(const LAS bf16x8*)(lds + PG8_SB(b, h) + boff + n * 2048 + k * 1024); } while (0)
#define PG8_MMA(ai, bj, At, Bt) do { __builtin_amdgcn_s_setprio(1); _Pragma("unroll") for (int m = 0; m < 4; ++m) _Pragma("unroll") for (int n = 0; n < 2; ++n) _Pragma("unroll") for (int k = 0; k < 2; ++k) \
        { if constexpr (I8) acc[ai][bj][m][n] = __builtin_amdgcn_mfma_i32_16x16x64_i8(__builtin_bit_cast(i32x4_t, Bt[n][k]), __builtin_bit_cast(i32x4_t, At[m][k]), acc[ai][bj][m][n], 0, 0, 0); \
          else acc[ai][bj][m][n] = __builtin_amdgcn_mfma_f32_16x16x32_bf16(Bt[n][k], At[m][k], acc[ai][bj][m][n], 0, 0, 0); } __builtin_amdgcn_s_setprio(0); } while (0)
#define PG8_WAIT_V(n) asm volatile("s_waitcnt vmcnt(" #n ")" ::: "memory")
#define PG8_WAIT_L(n) asm volatile("s_waitcnt lgkmcnt(" #n ")" ::: "memory")
#define PG8_BAR __builtin_amdgcn_s_barrier()
#define PG8_SCHED __builtin_amdgcn_sched_barrier(0)
#define PG8_ABASE(u) ((const char*)g.A + ((size_t)(u).seg * g.a_seg + (size_t)(u).pm * BM * g.lda) * 2)
#define PG8_BBASE(u) ((const char*)g.Bt + ((size_t)(u).seg * g.b_seg + (size_t)(u).pn * BM * g.ldb) * 2)
    Unit cur, nxt; int ui = 0;
    if (!S.next(0, cur)) return;
    acc_t acc[2][2][4][2];
#pragma unroll
    for (int a = 0; a < 2; ++a)
#pragma unroll
        for (int b = 0; b < 2; ++b)
#pragma unroll
            for (int m = 0; m < 4; ++m)
#pragma unroll
                for (int n = 0; n < 2; ++n) acc[a][b][m][n] = (acc_t){0, 0, 0, 0};
    bf16x8 At[4][2], B0[2][2], B1[2][2];
    const char* cA = PG8_ABASE(cur); const char* cB = PG8_BBASE(cur);
    PG8_STAGE(PG8_SB(0, 0), cB, voffB); PG8_STAGE(PG8_SB(0, 1), cB + hstepB, voffB); PG8_STAGE(PG8_SA(0, 0), cA, voffA); PG8_STAGE(PG8_SA(0, 1), cA + hstepA, voffA);
    if (wr == 1) PG8_BAR;
    PG8_WAIT_V(2); PG8_BAR;
    PG8_STAGE(PG8_SB(1, 0), cB + kstep, voffB); PG8_STAGE(PG8_SA(1, 0), cA + kstep, voffA); PG8_STAGE(PG8_SB(1, 1), cB + hstepB + kstep, voffB);
    PG8_WAIT_V(6); PG8_BAR;
    for (;;) {
        const bool has_next = S.next(ui + 1, nxt);
        const char* nA = has_next ? PG8_ABASE(nxt) : cA; const char* nB = has_next ? PG8_BBASE(nxt) : cB;
        for (int t = 0; t < nt; t += 2) {
            const bool lastk = (t == nt - 2);
            const char* a1 = cA + (size_t)(t + 1) * kstep;
            const char* a2 = lastk ? nA : cA + (size_t)(t + 2) * kstep; const char* b2 = lastk ? nB : cB + (size_t)(t + 2) * kstep;
            const char* a3 = a2 + kstep; const char* b3 = b2 + kstep;
            PG8_LDB(B0, 0, 0); PG8_LDB(B1, 0, 1); PG8_SCHED; PG8_LDA(At, 0, 0); PG8_STAGE(PG8_SA(1, 1), a1 + hstepA, voffA);
            PG8_WAIT_V(8); PG8_WAIT_L(0); PG8_BAR; PG8_MMA(0, 0, At, B0); PG8_MMA(0, 1, At, B1); PG8_BAR; PG8_SCHED;
            PG8_LDA(At, 0, 1); PG8_STAGE(PG8_SB(0, 0), b2, voffB); PG8_STAGE(PG8_SB(0, 1), b2 + hstepB, voffB); PG8_STAGE(PG8_SA(0, 0), a2, voffA);
            PG8_WAIT_V(8); PG8_WAIT_L(0); PG8_BAR; PG8_MMA(1, 0, At, B0); PG8_MMA(1, 1, At, B1); PG8_BAR; PG8_SCHED;
            PG8_LDB(B0, 1, 0); PG8_LDB(B1, 1, 1); PG8_SCHED; PG8_LDA(At, 1, 0); PG8_STAGE(PG8_SA(0, 1), a2 + hstepA, voffA);
            PG8_WAIT_V(8); PG8_WAIT_L(0); PG8_BAR; PG8_MMA(0, 0, At, B0); PG8_MMA(0, 1, At, B1); PG8_BAR; PG8_SCHED;
            PG8_LDA(At, 1, 1); PG8_STAGE(PG8_SB(1, 0), b3, voffB); PG8_STAGE(PG8_SB(1, 1), b3 + hstepB, voffB); PG8_STAGE(PG8_SA(1, 0), a3, voffA);
            PG8_WAIT_V(8); PG8_WAIT_L(0); PG8_BAR; PG8_MMA(1, 0, At, B0); PG8_MMA(1, 1, At, B1); PG8_BAR; PG8_SCHED;
        }
        if (wr == 0) PG8_BAR;
        E(acc, cur, wr, wc, fr, fq);
        if (!has_next) break;
#pragma unroll
        for (int a = 0; a < 2; ++a)
#pragma unroll
            for (int b = 0; b < 2; ++b)
#pragma unroll
                for (int m = 0; m < 4; ++m)
#pragma unroll
                    for (int n = 0; n < 2; ++n) acc[a][b][m][n] = (acc_t){0, 0, 0, 0};
        cur = nxt; cA = nA; cB = nB; ++ui;
        if (wr == 1) PG8_BAR;
    }
    PG8_WAIT_V(0);
    PG8_BAR;
#undef PG8_SA
#undef PG8_SB
#undef PG8_STAGE
#undef PG8_LDA
#undef PG8_LDB
#undef PG8_MMA
#undef PG8_WAIT_V
#undef PG8_WAIT_L
#undef PG8_BAR
#undef PG8_SCHED
#undef PG8_ABASE
#undef PG8_BBASE
}
}

__device__ __forceinline__ v4u pack8(const f32x4& a, const f32x4& b) { v4u w; w.x = cvtpk(a.x, a.y); w.y = cvtpk(a.z, a.w); w.z = cvtpk(b.x, b.y); w.w = cvtpk(b.z, b.w); return w; }
struct EpiInProj {
    bf16 *AQ, *AK, *AVT, *BQ, *BK, *BVT, *CQ, *CK, *CV, *SG; const float *COS, *SIN; const float *hs, *ws;
    __device__ __forceinline__ void operator()(const pg8::i32x4_t (&acc)[2][2][4][2], const pg8::Unit& u, int wr, int wc, int fr, int fq) const {
        asm volatile("" : "+v"(fr), "+v"(fq));
#pragma unroll
        for (int bj = 0; bj < 2; ++bj) {
            const int cblk = u.pn * 256 + bj * 128;
            const int cw = wc * 32 + 8 * fq;
            const f32x4 w0 = *(const GAS f32x4*)(ws + cblk + cw), w1 = *(const GAS f32x4*)(ws + cblk + cw + 4);
            bf16* dst; int pitch, cbase; int kind;
            int nh = 1, hd = 0; float qs = 1.0f;
            if (cblk < 512)       { dst = AQ; pitch = 512; cbase = cblk; kind = 1; }
            else if (cblk < 640)  { dst = AK; pitch = 128; cbase = cblk - 512; kind = 1; }
            else if (cblk < 768)  { dst = AVT; pitch = 128; cbase = cblk - 640; kind = 0; }
            else if (cblk < 1280) { dst = BQ; pitch = 512; cbase = cblk - 768; kind = 0; }
            else if (cblk < 1792) { dst = BK; pitch = 512; cbase = cblk - 1280; kind = 0; }
            else if (cblk < 2304) { dst = BVT; pitch = 512; cbase = cblk - 1792; kind = 0; }
            else if (cblk < 2816) { dst = CQ; pitch = 512; cbase = cblk - 2304; kind = 1; qs = SCL2; }
            else if (cblk < 3328) { dst = CK; pitch = 512; cbase = cblk - 2816; kind = 1; }
            else if (cblk < 3840) { dst = CV; pitch = 512; cbase = cblk - 3328; kind = 0; }
            else                  { dst = SG; pitch = 3072; cbase = cblk - 3840; kind = 3; }
#pragma unroll
            for (int ai = 0; ai < 2; ++ai)
#pragma unroll
                for (int m = 0; m < 4; ++m) {
                    const int row = u.pm * 256 + ai * 128 + wr * 64 + m * 16 + fr;
                    const float hr = hs[row];
                    const pg8::i32x4_t ia = acc[ai][bj][m][0], ib = acc[ai][bj][m][1];
                    f32x4 v0 = (f32x4){(float)ia.x, (float)ia.y, (float)ia.z, (float)ia.w} * (w0 * hr), v1 = (f32x4){(float)ib.x, (float)ib.y, (float)ib.z, (float)ib.w} * (w1 * hr);
                    if (kind == 1) {
                        if (row < T_LAT) {
                            const int t = row & (SEQ - 1), i0 = (cw & 63) >> 1;
                            const f32x4 cs = *(const GAS f32x4*)(COS + t * 32 + i0), sn = *(const GAS f32x4*)(SIN + t * 32 + i0);
                            const f32x4 a = v0, b = v1;
                            v0.x = a.x * cs.x - a.y * sn.x; v0.y = a.y * cs.x + a.x * sn.x; v0.z = a.z * cs.y - a.w * sn.y; v0.w = a.w * cs.y + a.z * sn.y;
                            v1.x = b.x * cs.z - b.y * sn.z; v1.y = b.y * cs.z + b.x * sn.z; v1.z = b.z * cs.w - b.w * sn.w; v1.w = b.w * cs.w + b.z * sn.w;
                        }
                        *(GAS v4u*)(dst + (size_t)row * pitch + cbase + cw) = pack8(v0 * qs, v1 * qs);
                    } else if (kind == 0) {
                        *(GAS v4u*)(dst + (size_t)row * pitch + cbase + cw) = pack8(v0, v1);
                    } else if (kind == 3) {
                        v0.x = sigmoid_fast(v0.x); v0.y = sigmoid_fast(v0.y); v0.z = sigmoid_fast(v0.z); v0.w = sigmoid_fast(v0.w);
                        v1.x = sigmoid_fast(v1.x); v1.y = sigmoid_fast(v1.y); v1.z = sigmoid_fast(v1.z); v1.w = sigmoid_fast(v1.w);
                        v2u gw; v0 = __builtin_elementwise_rint(v0 * 255.0f); v1 = __builtin_elementwise_rint(v1 * 255.0f);
                        gw.x = __builtin_amdgcn_cvt_pk_u8_f32(v0.x, 0, 0u); gw.x = __builtin_amdgcn_cvt_pk_u8_f32(v0.y, 1, gw.x); gw.x = __builtin_amdgcn_cvt_pk_u8_f32(v0.z, 2, gw.x); gw.x = __builtin_amdgcn_cvt_pk_u8_f32(v0.w, 3, gw.x);
                        gw.y = __builtin_amdgcn_cvt_pk_u8_f32(v1.x, 0, 0u); gw.y = __builtin_amdgcn_cvt_pk_u8_f32(v1.y, 1, gw.y); gw.y = __builtin_amdgcn_cvt_pk_u8_f32(v1.z, 2, gw.y); gw.y = __builtin_amdgcn_cvt_pk_u8_f32(v1.w, 3, gw.y);
                        *(GAS v2u*)((GAS unsigned char*)dst + (size_t)row * pitch + cbase + cw) = gw;
                    } else {
                        const int hc = hd + cw, head = hc >> 6, d = hc & 63;
                        const int b = row_batch(row), tok = row_tok(row);
                        bf16* vp = dst + ((size_t)(b * nh + head) * 64 + d) * NTOK + tok;
                        vp[0 * NTOK] = (bf16)f2bf(v0.x); vp[1 * NTOK] = (bf16)f2bf(v0.y); vp[2 * NTOK] = (bf16)f2bf(v0.z); vp[3 * NTOK] = (bf16)f2bf(v0.w);
                        vp[4 * NTOK] = (bf16)f2bf(v1.x); vp[5 * NTOK] = (bf16)f2bf(v1.y); vp[6 * NTOK] = (bf16)f2bf(v1.z); vp[7 * NTOK] = (bf16)f2bf(v1.w);
                    }
                }
        }
    }
};
__device__ __forceinline__ void unpack8(const v4u& w, f32x4& a, f32x4& b) {
    a = (f32x4){bf2f(w.x & 0xffffu), bf2f(w.x >> 16), bf2f(w.y & 0xffffu), bf2f(w.y >> 16)}; b = (f32x4){bf2f(w.z & 0xffffu), bf2f(w.z >> 16), bf2f(w.w & 0xffffu), bf2f(w.w >> 16)};
}
struct EpiBranch {
    const bf16* SG; bf16* MG;
    __device__ __forceinline__ void operator()(const f32x4 (&acc)[2][2][4][2], const pg8::Unit& u, int wr, int wc, int fr, int fq) const {
        asm volatile("" : "+v"(fr), "+v"(fq));
        const size_t r0 = (size_t)(u.pm * 256 + wr * 64 + fr); const int c0 = u.pn * 256 + wc * 32 + 8 * fq;
        const unsigned char* gbase = (const unsigned char*)SG + r0 * 3072 + u.seg * 1024 + c0; bf16* mbase = MG + r0 * D + c0;
#pragma unroll
        for (int ai = 0; ai < 2; ++ai) {
            v2u wg[8]; v4u wp[8];
#pragma unroll
            for (int c = 0; c < 8; ++c) wg[c] = *(const GAS v2u*)(gbase + (size_t)(ai * 128 + (c >> 1) * 16) * 3072 + (c & 1) * 128);
            if (u.seg > 0) {
#pragma unroll
                for (int c = 0; c < 8; ++c) wp[c] = *(const GAS v4u*)(mbase + (size_t)(ai * 128 + (c >> 1) * 16) * D + (c & 1) * 128);
            }
#pragma unroll
            for (int c = 0; c < 8; ++c) {
                const unsigned ga = wg[c].x, gb = wg[c].y;
                const f32x4 g0 = (f32x4){(float)(ga & 255u), (float)((ga >> 8) & 255u), (float)((ga >> 16) & 255u), (float)(ga >> 24)} * (1.0f / 255.0f);
                const f32x4 g1 = (f32x4){(float)(gb & 255u), (float)((gb >> 8) & 255u), (float)((gb >> 16) & 255u), (float)(gb >> 24)} * (1.0f / 255.0f);
                f32x4 v0 = g0 * acc[ai][c & 1][c >> 1][0], v1 = g1 * acc[ai][c & 1][c >> 1][1];
                if (u.seg > 0) { f32x4 p0, p1; unpack8(wp[c], p0, p1); v0 += p0; v1 += p1; }
                *(GAS v4u*)(mbase + (size_t)(ai * 128 + (c >> 1) * 16) * D + (c & 1) * 128) = pack8(v0, v1);
            }
        }
    }
};
struct EpiOut {
    float* X; const float* gtl; const float* xin; const float* cin;
    __device__ __forceinline__ void operator()(const f32x4 (&acc)[2][2][4][2], const pg8::Unit& u, int wr, int wc, int fr, int fq) const {
        asm volatile("" : "+v"(fr), "+v"(fq));
#pragma unroll
        for (int ai = 0; ai < 2; ++ai)
#pragma unroll
            for (int m = 0; m < 4; ++m) {
                const int row = u.pm * 256 + ai * 128 + wr * 64 + m * 16 + fr;
                const float* gt = gtl + (size_t)row_modidx(row) * 6 * D + 2 * D;
#pragma unroll
                for (int bj = 0; bj < 2; ++bj) {
                    const int col = u.pn * 256 + bj * 128 + wc * 32 + 8 * fq;
                    GAS f32x4* xp = (GAS f32x4*)(X + (size_t)row * D + col);
                    const GAS f32x4* sp = xin ? (const GAS f32x4*)(xin_row(xin, cin, row) + col) : (const GAS f32x4*)xp;
                    const f32x4 g0 = *(const GAS f32x4*)(gt + col), g1 = *(const GAS f32x4*)(gt + col + 4);
                    xp[0] = sp[0] + g0 * acc[ai][bj][m][0]; xp[1] = sp[1] + g1 * acc[ai][bj][m][1];
                }
            }
    }
};
struct EpiGate {
    bf16* SG; const float* hs; const float* ws;
    __device__ __forceinline__ void operator()(const pg8::i32x4_t (&acc)[2][2][4][2], const pg8::Unit& u, int wr, int wc, int fr, int fq) const {
        asm volatile("" : "+v"(fr), "+v"(fq));
#pragma unroll
        for (int bj = 0; bj < 2; ++bj) {
            const int col = u.pn * 256 + bj * 128 + wc * 32 + 8 * fq;
            const f32x4 w0 = *(const GAS f32x4*)(ws + col), w1 = *(const GAS f32x4*)(ws + col + 4);
#pragma unroll
            for (int ai = 0; ai < 2; ++ai)
#pragma unroll
                for (int m = 0; m < 4; ++m) {
                    const int row = u.pm * 256 + ai * 128 + wr * 64 + m * 16 + fr;
                    const float hr = hs[row];
                    const pg8::i32x4_t a = acc[ai][bj][m][0], b = acc[ai][bj][m][1];
                    f32x4 v0 = (f32x4){(float)a.x, (float)a.y, (float)a.z, (float)a.w} * hr * w0, v1 = (f32x4){(float)b.x, (float)b.y, (float)b.z, (float)b.w} * hr * w1;
                    v0.x = sigmoid_fast(v0.x); v0.y = sigmoid_fast(v0.y); v0.z = sigmoid_fast(v0.z); v0.w = sigmoid_fast(v0.w);
                    v1.x = sigmoid_fast(v1.x); v1.y = sigmoid_fast(v1.y); v1.z = sigmoid_fast(v1.z); v1.w = sigmoid_fast(v1.w);
                    *(GAS v4u*)(SG + (size_t)row * 3072 + col) = pack8(v0, v1);
                }
        }
    }
};
struct EpiStore {
    bf16* O; int ldc;
    __device__ __forceinline__ void operator()(const f32x4 (&acc)[2][2][4][2], const pg8::Unit& u, int wr, int wc, int fr, int fq) const {
        asm volatile("" : "+v"(fr), "+v"(fq));
#pragma unroll
        for (int ai = 0; ai < 2; ++ai)
#pragma unroll
            for (int m = 0; m < 4; ++m) {
                const int row = u.pm * 256 + ai * 128 + wr * 64 + m * 16 + fr;
#pragma unroll
                for (int bj = 0; bj < 2; ++bj) {
                    const int col = u.pn * 256 + bj * 128 + wc * 32 + 8 * fq;
                    *(GAS v4u*)(O + (size_t)row * ldc + col) = pack8(acc[ai][bj][m][0], acc[ai][bj][m][1]);
                }
            }
    }
};
__device__ __forceinline__ unsigned pkh2(float lo, float hi) { typedef _Float16 h2_t __attribute__((ext_vector_type(2))); h2_t v = {(_Float16)lo, (_Float16)hi}; return __builtin_bit_cast(unsigned, v); }
struct EpiStoreH {
    bf16* O; int ldc;
    __device__ __forceinline__ void operator()(const f32x4 (&acc)[2][2][4][2], const pg8::Unit& u, int wr, int wc, int fr, int fq) const {
        asm volatile("" : "+v"(fr), "+v"(fq));
#pragma unroll
        for (int ai = 0; ai < 2; ++ai)
#pragma unroll
            for (int m = 0; m < 4; ++m) {
                const int row = u.pm * 256 + ai * 128 + wr * 64 + m * 16 + fr;
#pragma unroll
                for (int bj = 0; bj < 2; ++bj) {
                    const int col = u.pn * 256 + bj * 128 + wc * 32 + 8 * fq;
                    const f32x4 a = acc[ai][bj][m][0], b = acc[ai][bj][m][1];
                    v4u w; w.x = pkh2(a.x, a.y); w.y = pkh2(a.z, a.w); w.z = pkh2(b.x, b.y); w.w = pkh2(b.z, b.w);
                    *(GAS v4u*)(O + (size_t)row * ldc + col) = w;
                }
            }
    }
};

__global__ void __launch_bounds__(NTHREADS, 2) mega_fwd(Args args) {
    extern __shared__ __attribute__((aligned(16))) unsigned char lds[];
    LAS unsigned char* L = (LAS unsigned char*)lds;
    volatile LAS unsigned* MISC = (volatile LAS unsigned*)(L + MISC_OFF);
    const int wave = __builtin_amdgcn_readfirstlane((int)threadIdx.x >> 6);
    const int lane = lane_id_v(), tid = wave * 64 + lane;
    const int fr = lane & 15, fq = lane >> 4;
    const int G = gridDim.x;
    const int vcu = (G % 8 == 0) ? (int)(blockIdx.x % 8) * (G / 8) + (int)(blockIdx.x / 8) : (int)blockIdx.x;
    for (int u = tid; u < (LDS_BYTES - 131072) / 4; u += NTHREADS) ((LAS unsigned*)(L + 131072))[u] = 0u;
    __syncthreads();
    unsigned char* ws = args.ws;
    gu32* ctl = (gu32*)(ws + WS_CTL);
    (void)xcd_barrier_post((unsigned*)(ctl + CW_BAR), MISC + 8);
    if (tid == 0) MISC[12] = xb_add((unsigned*)(ctl + CW_RANK) + 64 * xb_xcc_id(), 1u);
    __syncthreads();
#define GRID_BAR() do { unsigned* bp_ = (unsigned*)(args.ws + WS_CTL) + CW_BAR; asm volatile("" : "+s"(bp_)); XcdBarrier b_; b_.bar = bp_; b_.x = xb_xcc_id(); b_.st = MISC + 8; xcd_barrier(b_, wave == 0 && lane_id_v() == 0); } while (0)
    const int gw = vcu * NWAVES + wave, NGW = G * NWAVES;
    const int NGT = G * NTHREADS;

#define PHASE_PTRS \
    unsigned char* wsq = args.ws; asm volatile("" : "+s"(wsq)); \
    const float* const* IN_ = (const float* const*)__builtin_amdgcn_kernarg_segment_ptr(); asm volatile("" : "+s"(IN_)); \
    float* MODV = (float*)(wsq + WS_MOD); float* COS = (float*)(wsq + WS_COS); float* SIN = (float*)(wsq + WS_SIN); \
    bf16* WIN = (bf16*)(wsq + WS_WIN); bf16* WB = (bf16*)(wsq + WS_WB); bf16* WO = (bf16*)(wsq + WS_WO); bf16* WQ = (bf16*)(wsq + WS_WQ); bf16* KEYS = (bf16*)(wsq + WS_KEYS); \
    float* X = (float*)(wsq + WS_X); bf16* H = (bf16*)(wsq + WS_H); bf16* Y = (bf16*)(wsq + WS_Y); bf16* MG = (bf16*)(wsq + WS_MG); \
    unsigned* EI = (unsigned*)(wsq + WS_EI); float* EG = (float*)(wsq + WS_EG); \
    unsigned char* U8 = wsq + WS_U8; unsigned char* V8 = wsq + WS_V8; float* SCU = (float*)(wsq + WS_SCU); float* SCV = SCU + DEPTH * 16384; \
    bf16* AQ = (bf16*)(wsq + WS_AQ); bf16* AK = (bf16*)(wsq + WS_AK); bf16* AVT = (bf16*)(wsq + WS_AVT); \
    bf16* BQ = (bf16*)(wsq + WS_BQ); bf16* BK = (bf16*)(wsq + WS_BK); bf16* BVT = (bf16*)(wsq + WS_BVT); \
    bf16* CQ = (bf16*)(wsq + WS_CQ); bf16* CK = (bf16*)(wsq + WS_CK); bf16* CVT = (bf16*)(wsq + WS_CVT); \
    bf16* SG = (bf16*)(wsq + WS_SG); bf16* Q2 = (bf16*)(wsq + WS_Q2); float* SC = (float*)(wsq + WS_SC); \
    (void)MODV; (void)COS; (void)SIN; (void)WIN; (void)WB; (void)WO; (void)WQ; (void)KEYS; (void)X; (void)H; (void)Y; (void)MG; (void)EI; (void)EG; (void)U8; (void)V8; (void)SCU; (void)SCV; \
    (void)AQ; (void)AK; (void)AVT; (void)BQ; (void)BK; (void)BVT; (void)CQ; (void)CK; (void)CVT; (void)SG; (void)Q2; (void)SC; (void)IN_;
#define LAYER_PTRS const float* modl = MODV + (size_t)layer * 3 * 6 * D; const bf16* WINl = WIN + (size_t)layer * IN_W * D; (void)modl; (void)WINl;

#ifndef SKIP_P0
        { PHASE_PTRS
        for (int rep_ = 0; rep_ < REP_P0; ++rep_) {
    {
        LAS float* scr = (LAS float*)(L + wave * 16384);
        int gt = vcu * NTHREADS + tid; asm volatile("" : "+v"(gt));
        constexpr int I_IN = (D / 64) * (IN_W / 32), I_BR = (512 / 64) * (D / 32), I_O = (D / 64) * (D / 32), I_Q = 16 * 4 * (D / 32);
        constexpr int PER_LAYER = I_IN + 3 * I_BR + I_O + I_Q;
        for (int rp_ = 0; rp_ < REP_P0A; ++rp_)
        for (int it = gw; it < DEPTH * PER_LAYER; it += NGW) {
            const int l = it / PER_LAYER; int r = it % PER_LAYER;
            if (r < I_IN) { p0_transpose_item<true>(IN_[I_WIN] + (size_t)l * D * IN_W, D, IN_W, WIN + (size_t)l * IN_W * D, scr, r, lane); continue; } r -= I_IN;
            if (r < I_BR) { p0_transpose_item(IN_[I_WBA] + (size_t)l * 512 * D, 512, D, WB + (size_t)(l * 3 + 0) * D * 512, scr, r, lane); continue; } r -= I_BR;
            if (r < I_BR) { p0_transpose_item(IN_[I_WBB] + (size_t)l * 512 * D, 512, D, WB + (size_t)(l * 3 + 1) * D * 512, scr, r, lane); continue; } r -= I_BR;
            if (r < I_BR) { p0_transpose_item(IN_[I_WBC] + (size_t)l * 512 * D, 512, D, WB + (size_t)(l * 3 + 2) * D * 512, scr, r, lane); continue; } r -= I_BR;
            if (r < I_O) { p0_transpose_item(IN_[I_WOUT] + (size_t)l * D * D, D, D, WO + (size_t)l * D * D, scr, r, lane); continue; } r -= I_O;
            p0_wqk_item(IN_[I_PKEYS] + (size_t)l * 16 * 128 * 128, IN_[I_PWQ] + (size_t)l * D * 2048, WQ + (size_t)l * 2048 * D, r, lane);
        }
        {
            LAS float* red = (LAS float*)(L + 9216);
            for (int rp_ = 0; rp_ < REP_P0D; ++rp_)
            for (int it = vcu; it < DEPTH * 96; it += G) {
                const int l = it / 96, nc = it % 96, n = nc * 64 + lane;
                const float* wm = IN_[I_WMOD] + (size_t)l * D * 6 * D + n;
                float a0 = 0.f, a1 = 0.f, a2 = 0.f;
#pragma unroll 1
                for (int half = 0; half < 2; ++half) {
                    const int kb = wave * 128 + half * 64;
                    const float c0 = IN_[I_C][kb + lane], c1 = IN_[I_C][D + kb + lane], c2 = IN_[I_CCTX][kb + lane];
                    const int s0 = __builtin_bit_cast(int, c0 * sigmoidf_(c0)), s1 = __builtin_bit_cast(int, c1 * sigmoidf_(c1)), s2 = __builtin_bit_cast(int, c2 * sigmoidf_(c2));
#pragma unroll
                    for (int kk = 0; kk < 64; ++kk) {
                        const float w = wm[(size_t)(kb + kk) * 6 * D];
                        a0 += __builtin_bit_cast(float, __builtin_amdgcn_readlane(s0, kk)) * w;
                        a1 += __builtin_bit_cast(float, __builtin_amdgcn_readlane(s1, kk)) * w;
                        a2 += __builtin_bit_cast(float, __builtin_amdgcn_readlane(s2, kk)) * w;
                    }
                }
                red[(wave * 3 + 0) * 64 + lane] = a0; red[(wave * 3 + 1) * 64 + lane] = a1; red[(wave * 3 + 2) * 64 + lane] = a2;
                __syncthreads();
                if (wave < 3) {
                    float sum = IN_[I_BMOD][l * 6 * D + n];
#pragma unroll
                    for (int w = 0; w < 8; ++w) sum += red[(w * 3 + wave) * 64 + lane];
                    MODV[(size_t)(l * 3 + wave) * 6 * D + n] = sum;
                }
                __syncthreads();
            }
        }
        for (int i = gt; i < SEQ * 32; i += NGT) {
            const int t = i >> 5, f = i & 31;
            const float inv = exp2f(-(float)(f & 15) * (13.287712379549449f / 16.0f));
            const float pos = (f < 16) ? (float)(t / GRID_W) : (float)(t % GRID_W);
            float sn, cs; sincosf(pos * inv, &sn, &cs);
            COS[i] = cs; SIN[i] = sn;
        }
    }
        for (int rp_ = 0; rp_ < REP_P0F; ++rp_)
#pragma unroll 4
        for (int rr = gw; rr < 2 * DEPTH * 16384; rr += NGW) {
            const int tab = rr / (DEPTH * 16384), row = rr % (DEPTH * 16384);
            const float* src = (tab == 0 ? IN_[I_PU] : IN_[I_PV]) + (size_t)row * D;
            f32x4 v[4]; float am = 0.f;
#pragma unroll
            for (int j = 0; j < 4; ++j) { v[j] = *((const GAS f32x4*)src + lane + 64 * j); am = fmaxf(am, fmaxf(fmaxf(fabsf(v[j].x), fabsf(v[j].y)), fmaxf(fabsf(v[j].z), fabsf(v[j].w)))); }
            am = wave_max(am);
            const bool as_i4 = (P10_SLICED != 0) && (tab == 0);
            int ex = 0; float scale = 1.0f;
            if (as_i4) {
                float ss = 0.f;
#pragma unroll
                for (int j = 0; j < 4; ++j) ss += (v[j].x * v[j].x + v[j].y * v[j].y) + (v[j].z * v[j].z + v[j].w * v[j].w);
                ss = wave_sum(ss);
                if (ss > 0.f) scale = sqrtf(ss * (1.0f / D)) * (2.6f / 7.0f);
                const float inv4 = 1.0f / scale;
                v2u o2;
#pragma unroll
                for (int jj = 0; jj < 2; ++jj) {
                    unsigned w = 0u;
#pragma unroll
                    for (int i = 0; i < 4; ++i) {
                        const int qa = min(max(__float2int_rn(v[2 * jj][i] * inv4), -7), 7), qb = min(max(__float2int_rn(v[2 * jj + 1][i] * inv4), -7), 7);
                        w |= ((unsigned)(qa & 15) | ((unsigned)(qb & 15) << 4)) << (8 * i);
                    }
                    o2[jj] = w;
                }
                *((GAS v2u*)(U8 + (size_t)row * (D / 2)) + lane) = o2;
            } else {
            if (am > 0.f) { (void)frexpf(am * (1.0f / 448.0f), &ex); scale = ldexpf(1.0f, ex); }
            const float inv = 1.0f / scale;
            v4u o;
#pragma unroll
            for (int j = 0; j < 4; ++j) {
                int p = __builtin_amdgcn_cvt_pk_fp8_f32(v[j].x * inv, v[j].y * inv, 0, false);
                p = __builtin_amdgcn_cvt_pk_fp8_f32(v[j].z * inv, v[j].w * inv, p, true);
                o[j] = (unsigned)p;
            }
            *((GAS v4u*)((tab == 0 ? U8 : V8) + (size_t)row * D) + lane) = o;
            }
            if (lane == 0) (tab == 0 ? SCU : SCV)[row] = scale;
        }
        }
        }
#endif
    GRID_BAR();

    for (int layer = 0; layer < DEPTH; ++layer) {
        const bool last = (layer == DEPTH - 1);
        const int T_EFF = last ? T_LAT : T_ALL;

#ifndef SKIP_P1
        { PHASE_PTRS LAYER_PTRS
        for (int rep_ = 0; rep_ < REP_P1; ++rep_) {
        { const int ln = lane_id_v();
        if (layer == 0) {
            f32x4 gm[4], shv[4];
            auto prep = [&](int midx) { const float* md = modl + (size_t)midx * 6 * D;
#pragma unroll
                for (int j = 0; j < 4; ++j) { const f32x4 g = *((const GAS f32x4*)(IN_[I_G1] + layer * D) + ln + 64 * j); const f32x4 sc = *((const GAS f32x4*)(md + D) + ln + 64 * j);
                    gm[j] = g * (sc + 1.0f); shv[j] = *((const GAS f32x4*)(md + 0) + ln + 64 * j); } };
            auto row = [&](int r) {
                const GAS f32x4* xr = (const GAS f32x4*)xin_row(IN_[I_X], IN_[I_CTX], r) + ln;
                f32x4 v[4]; float ss = 0.f;
#pragma unroll
                for (int j = 0; j < 4; ++j) { v[j] = xr[64 * j]; ss += (v[j].x * v[j].x + v[j].y * v[j].y) + (v[j].z * v[j].z + v[j].w * v[j].w); }
                const float rs = 1.0f / sqrtf(wave_sum(ss) * (1.f / D) + NORM_EPS);
                f32x4 hv[4];
#pragma unroll
                for (int j = 0; j < 4; ++j) hv[j] = v[j] * rs * gm[j] + shv[j];
                h8_row(hv, wsq + WS_H8 + (size_t)r * D, (float*)(wsq + WS_HS) + r, ln); };
            wave_row_blocks(T_ALL, gw, NGW, prep, row);
            wg8_rows(WINl, wsq + WS_WG8, (float*)(wsq + WS_WGS) + (size_t)layer * IN_W, gw, NGW, ln);
        }
        }
        }
        }
#endif
        if (layer == 0) GRID_BAR();

#ifndef SKIP_P2
        { PHASE_PTRS LAYER_PTRS
        for (int rep_ = 0; rep_ < REP_P2; ++rep_) {
        {
            pg8::Gemm g{(const bf16*)(wsq + WS_H8), (const bf16*)(wsq + WS_WG8), D / 2, D / 2, D / 2, 0, 0};
            pg8::SegOrder<1> S; S.T.init(T_ALL, IN_W, G, (int)blockIdx.x);
            EpiInProj E{AQ, AK, AVT, BQ, BK, BVT, CQ, CK, CVT, SG, COS, SIN, (const float*)(wsq + WS_HS), (const float*)(wsq + WS_WGS) + (size_t)layer * IN_W};
            pg8::gemm_phase<true>(L, g, S, E, wave);
        }
        }
        }
#endif
        GRID_BAR();

#ifndef SKIP_P3
        { PHASE_PTRS LAYER_PTRS
        {
            LAS bf16* Pl = (LAS bf16*)(L + wave * 8192);
            const float lam_init = 0.8f - 0.6f * expf(-0.3f * (float)layer);
            float lam;
            {
                const int ll = lane_id_v();
                const float* cl = IN_[I_LAMBDA] + layer * 256;
                const float s1 = wave_sum(cl[ll] * cl[64 + ll]), s2 = wave_sum(cl[128 + ll] * cl[192 + ll]);
                lam = expf(s1) - expf(s2) + lam_init;
            }
{ const int lo__ = lane_id_v(); { const int lane = lo__; const int fr = lane & 15, fq = lane >> 4, tid = wave * 64 + lane; (void)fr; (void)fq; (void)tid;
            {
                const int r32 = lane & 31, hi = lane >> 5;
                const int n_lat = BATCH * 4 * (SEQ / 256), n_ctx = last ? 0 : BATCH * 4;
                const int NU = (n_lat + G - 1) / G * G + n_ctx;
                for (int rep_ = 0; rep_ < REP_P3C; ++rep_)
                for (int u0 = vcu; u0 < NU; u0 += G) {
                    int b, h, row0, t_lo, t_hi;
                    if (u0 < n_lat) { const int bh = u0 >> 5; b = bh >> 2; h = bh & 3; row0 = b * SEQ + (u0 & 31) * 256; t_lo = 0; t_hi = 132; }
                    else { const int c = u0 - (n_lat + G - 1) / G * G; if (c < 0 || c >= n_ctx) continue; b = c >> 2; h = c & 3; row0 = T_LAT + b * CTX; t_lo = 128; t_hi = 132; }
                    const int qrow = row0 + wave * 32 + r32;
                    LAS unsigned* o1p = (LAS unsigned*)(L + 65536 + wave * 8192) + lane;
                    const int krow_s = tid >> 3, kch_s = tid & 7;
                    const int vrow_s0 = tid >> 4, vch_s = tid & 15;
                    LAS unsigned char* Kb0 = L; LAS unsigned char* Vb0 = L + 2 * CK_SZ;
#pragma unroll 1
                    for (int m = 0; m < 2; ++m) {
                        bf16x8 qf[4];
                        { const bf16* qp = CQ + (size_t)qrow * 512 + (h * 2 + m) * 64 + hi * 8;
#pragma unroll
                          for (int ks = 0; ks < 4; ++ks) qf[ks] = *(const GAS bf16x8*)(qp + ks * 16); }
                        f32x16 o[4];
#pragma unroll
                        for (int d = 0; d < 4; ++d)
#pragma unroll
                            for (int r = 0; r < 16; ++r) o[d][r] = 0.f;
                        float lpart;
                        f32x16 cb;
                        v4u pp[4];
                        const bf16* kg = CK + (size_t)krow_s * 512 + (h * 2 + m) * 64 + kch_s * 8;
                        const bf16* vg = CVT + (size_t)vrow_s0 * 512 + h * 128 + vch_s * 8;
                        auto tile_row = [&](int j) { return (j < 128) ? b * SEQ + 64 * j : T_LAT + b * CTX + 64 * (j - 128); };
                        __syncthreads();
                        {
                            const size_t kb = (size_t)tile_row(t_lo) * 512;
                            const v4u kr = *(const GAS v4u*)(kg + kb), v0 = *(const GAS v4u*)(vg + kb), v1 = *(const GAS v4u*)(vg + kb + 32 * 512);
                            *(LAS v4u*)(Kb0 + krow_s * CK_PITCH + kch_s * 16) = kr;
                            *(LAS v4u*)(Vb0 + vrow_s0 * CV_PITCH + vch_s * 16) = v0; *(LAS v4u*)(Vb0 + (vrow_s0 + 32) * CV_PITCH + vch_s * 16) = v1;
                        }
                        __syncthreads();
                        v4u kr, v0, v1;
                        { const size_t kb = (size_t)tile_row(t_lo + 2) * 512, vb = (size_t)tile_row(t_lo + 1) * 512;
                          kr = *(const GAS v4u*)(kg + kb); v0 = *(const GAS v4u*)(vg + vb); v1 = *(const GAS v4u*)(vg + vb + 32 * 512); }
                        {
                            const v4u kr1 = *(const GAS v4u*)(kg + (size_t)tile_row(t_lo + 1) * 512);
                            f32x16 st[2];
#pragma unroll
                            for (int kb = 0; kb < 2; ++kb) {
#pragma unroll
                                for (int r = 0; r < 16; ++r) st[kb][r] = 0.f;
#pragma unroll
                                for (int ks = 0; ks < 4; ++ks) {
                                    const bf16x8 kf = *(const LAS bf16x8*)(Kb0 + (kb * 32 + r32) * CK_PITCH + ks * 32 + hi * 16);
                                    st[kb] = __builtin_amdgcn_mfma_f32_32x32x16_bf16(kf, qf[ks], st[kb], 0, 0, 0);
                                }
                            }
                            float mx = st[0][0];
#pragma unroll
                            for (int r = 1; r < 16; ++r) mx = fmaxf(mx, st[0][r]);
#pragma unroll
                            for (int r = 0; r < 16; ++r) mx = fmaxf(mx, st[1][r]);
                            mx = xmax32(mx);
#pragma unroll
                            for (int r = 0; r < 16; ++r) cb[r] = -mx;
                            float ls0 = 0.f, ls1 = 0.f;
#pragma unroll
                            for (int ks = 0; ks < 4; ++ks)
#pragma unroll
                                for (int i2 = 0; i2 < 4; ++i2) {
                                    const float p0 = __builtin_amdgcn_exp2f(st[ks >> 1][8 * (ks & 1) + 2 * i2] - mx), p1 = __builtin_amdgcn_exp2f(st[ks >> 1][8 * (ks & 1) + 2 * i2 + 1] - mx);
                                    ls0 += p0; ls1 += p1; pp[ks][i2] = cvtpk(p0, p1);
                                }
                            lpart = ls0 + ls1;
                            *(LAS v4u*)(Kb0 + CK_SZ + krow_s * CK_PITCH + kch_s * 16) = kr1;
                            __syncthreads();
                        }
                        const int q4 = (lane & 15) >> 2, p4 = lane & 3, grp = (lane >> 4) & 1;
                        const int voff = (4 * hi + q4) * CV_PITCH + (16 * grp + 4 * p4) * 2;
                        bool pend = false; float apend = 1.0f;
#pragma unroll 1
                        for (int j = t_lo + 1; j < t_hi; ++j) {
                            const int cur = (j - t_lo) & 1;
                            const LAS unsigned char* Kb = Kb0 + cur * CK_SZ; const LAS unsigned char* vbase = Vb0 + (cur ^ 1) * CV_SZ + voff;
                            const bool more = (j + 1 < t_hi);
                            auto vfrag = [&](int i) -> bf16x8 {
                                const LAS unsigned char* va = vbase + (i >> 2) * 16 * CV_PITCH + (i & 3) * 64;
                                const s16x4 lo = __builtin_bit_cast(s16x4, __builtin_amdgcn_ds_read_tr16_b64_v4i16((LAS s16x4*)va));
                                const s16x4 hh = __builtin_bit_cast(s16x4, __builtin_amdgcn_ds_read_tr16_b64_v4i16((LAS s16x4*)(va + 8 * CV_PITCH)));
                                return __builtin_shufflevector(lo, hh, 0, 1, 2, 3, 4, 5, 6, 7);
                            };
                            f32x16 st[2];
                            bf16x8 kf[8];
#pragma unroll
                            for (int kk = 0; kk < 8; ++kk) kf[kk] = *(const LAS bf16x8*)(Kb + ((kk >> 2) * 32 + r32) * CK_PITCH + (kk & 3) * 32 + hi * 16);
                            __builtin_amdgcn_sched_barrier(0);
#pragma unroll
                            for (int kb = 0; kb < 2; ++kb) {
#pragma unroll
                                for (int ks = 0; ks < 4; ++ks) st[kb] = __builtin_amdgcn_mfma_f32_32x32x16_bf16(kf[kb * 4 + ks], qf[ks], ks == 0 ? cb : st[kb], 0, 0, 0);
                            }
                            bf16x8 vfr[VRING];
#pragma unroll
                            for (int k = 0; k < VRING; ++k) vfr[k] = vfrag(k);
                            __builtin_amdgcn_sched_barrier(0);
                            o[0] = __builtin_amdgcn_mfma_f32_32x32x16_bf16(vfr[0], __builtin_bit_cast(bf16x8, pp[0]), o[0], 0, 0, 0); vfr[0] = vfrag(VRING);
                            o[1] = __builtin_amdgcn_mfma_f32_32x32x16_bf16(vfr[1], __builtin_bit_cast(bf16x8, pp[0]), o[1], 0, 0, 0); vfr[1 % VRING] = vfrag(VRING + 1);
                            __builtin_amdgcn_sched_barrier(0);
                            float ls0 = 0.f, ls1 = 0.f;
#pragma unroll
                            for (int i = 0; i < 16; ++i) {
                                if (i >= 2) { o[i & 3] = __builtin_amdgcn_mfma_f32_32x32x16_bf16(vfr[i % VRING], __builtin_bit_cast(bf16x8, pp[i >> 2]), o[i & 3], 0, 0, 0); if (i + VRING < 16) vfr[i % VRING] = vfrag(i + VRING); }
                                {
                                    const int kb = i >> 3, r = 2 * (i & 7);
                                    float p0 = __builtin_amdgcn_exp2f(st[kb][r]);
                                    ls0 += p0; asm volatile("" : "+v"(p0), "+v"(ls0));
                                    float p1 = __builtin_amdgcn_exp2f(st[kb][r + 1]);
                                    ls1 += p1; asm volatile("" : "+v"(p1), "+v"(ls1));
                                    st[kb][r] = p0; st[kb][r + 1] = p1;
                                }
                                if ((i & 3) == 3) {
                                    const int ks = i >> 2;
#pragma unroll
                                    for (int i2 = 0; i2 < 4; ++i2) pp[ks][i2] = cvtpk(st[ks >> 1][8 * (ks & 1) + 2 * i2], st[ks >> 1][8 * (ks & 1) + 2 * i2 + 1]);
                                    asm volatile("" : "+v"(pp[ks]));
                                }
                                if (i == 3) *(LAS v4u*)(Kb0 + (cur ^ 1) * CK_SZ + krow_s * CK_PITCH + kch_s * 16) = kr;
                                if (i == 5) *(LAS v4u*)(Vb0 + cur * CV_SZ + vrow_s0 * CV_PITCH + vch_s * 16) = v0;
                                if (i == 7) *(LAS v4u*)(Vb0 + cur * CV_SZ + (vrow_s0 + 32) * CV_PITCH + vch_s * 16) = v1;
                                if (i == 9) { const size_t kb = (size_t)tile_row(j + 2 < t_hi ? j + 2 : t_hi - 1) * 512, vb = (size_t)tile_row(more ? j + 1 : j) * 512;
                                              kr = *(const GAS v4u*)(kg + kb); v0 = *(const GAS v4u*)(vg + vb); v1 = *(const GAS v4u*)(vg + vb + 32 * 512); }
                                if (i >= 1) __builtin_amdgcn_sched_barrier(0);
                            }
                            const float lsum = ls0 + ls1;
                            if (pend) {
#pragma unroll
                                for (int d = 0; d < 4; ++d)
#pragma unroll
                                    for (int r = 0; r < 16; ++r) o[d][r] *= apend;
                            }
                            pend = __builtin_amdgcn_ballot_w64(!(lsum <= C_GROW_SUM)) != 0ull;
                            lpart += lsum;
                            if (pend) {
                                u16x2 mw = __builtin_bit_cast(u16x2, pp[0][0]);
#pragma unroll
                                for (int ks = 0; ks < 4; ++ks)
#pragma unroll
                                    for (int i2 = 0; i2 < 4; ++i2) mw = __builtin_elementwise_max(mw, __builtin_bit_cast(u16x2, pp[ks][i2]));
                                const unsigned m16 = mw[0] > mw[1] ? mw[0] : mw[1];
                                const float pm = xmax32(__builtin_bit_cast(float, m16 << 16));
                                int dli = (int)(__builtin_bit_cast(unsigned, pm) >> 23) - 126;
                                dli = pm > 1.0f ? (dli < 126 ? dli : 126) : 0;
                                const float dl = (float)dli;
                                apend = __builtin_bit_cast(float, (unsigned)(127 - dli) << 23);
#pragma unroll
                                for (int r = 0; r < 16; ++r) cb[r] -= dl;
                                lpart *= apend;
                            }
                            __syncthreads();
                        }
                        {
                            const LAS unsigned char* vbase = Vb0 + ((t_hi - 1 - t_lo) & 1) * CV_SZ + voff;
#pragma unroll
                            for (int i = 0; i < 16; ++i) {
                                const LAS unsigned char* va = vbase + (i >> 2) * 16 * CV_PITCH + (i & 3) * 64;
                                const s16x4 lo = __builtin_bit_cast(s16x4, __builtin_amdgcn_ds_read_tr16_b64_v4i16((LAS s16x4*)va));
                                const s16x4 hh = __builtin_bit_cast(s16x4, __builtin_amdgcn_ds_read_tr16_b64_v4i16((LAS s16x4*)(va + 8 * CV_PITCH)));
                                const bf16x8 vf = __builtin_shufflevector(lo, hh, 0, 1, 2, 3, 4, 5, 6, 7);
                                o[i & 3] = __builtin_amdgcn_mfma_f32_32x32x16_bf16(vf, __builtin_bit_cast(bf16x8, pp[i >> 2]), o[i & 3], 0, 0, 0);
                                if ((i & 7) == 7) __builtin_amdgcn_sched_barrier(0);
                            }
                        }
                        if (pend) {
#pragma unroll
                            for (int d = 0; d < 4; ++d)
#pragma unroll
                                for (int r = 0; r < 16; ++r) o[d][r] *= apend;
                        }
                        const float lt = xadd32(lpart);
                        if (m == 0) {
                            const float inv = 1.0f / lt;
#pragma unroll
                            for (int d = 0; d < 4; ++d)
#pragma unroll
                                for (int i2 = 0; i2 < 8; ++i2) o1p[64 * (d * 8 + i2)] = cvtpk(o[d][2 * i2] * inv, o[d][2 * i2 + 1] * inv);
                        } else {
                            const float inv2 = lam / lt;
                            float ssq = 0.f;
#pragma unroll
                            for (int d = 0; d < 4; ++d)
#pragma unroll
                                for (int i2 = 0; i2 < 8; ++i2) {
                                    const unsigned w1 = o1p[64 * (d * 8 + i2)];
                                    const float a0 = bf2f(w1 & 0xffffu) - o[d][2 * i2] * inv2, a1 = bf2f(w1 >> 16) - o[d][2 * i2 + 1] * inv2;
                                    o[d][2 * i2] = a0; o[d][2 * i2 + 1] = a1; ssq += a0 * a0 + a1 * a1;
                                }
                            ssq = xadd32(ssq);
                            const float rn = 1.0f / sqrtf(ssq * (1.f / 128.f) + NORM_EPS) * (1.0f - lam_init);
                            bf16* yp = Y + (size_t)qrow * 1536 + 1024 + h * 128 + 4 * hi;
                            const float* sl = IN_[I_SUBLN] + layer * 512 + h * 128 + 4 * hi;
#pragma unroll
                            for (int d = 0; d < 4; ++d)
#pragma unroll
                                for (int g4 = 0; g4 < 4; ++g4) {
                                    const f32x4 gsl = *(const GAS f32x4*)(sl + d * 32 + 8 * g4);
                                    v2u w; w.x = cvtpk(o[d][4 * g4] * rn * gsl.x, o[d][4 * g4 + 1] * rn * gsl.y); w.y = cvtpk(o[d][4 * g4 + 2] * rn * gsl.z, o[d][4 * g4 + 3] * rn * gsl.w);
                                    *(GAS v2u*)(yp + d * 32 + 8 * g4) = w;
                                }
                        }
                    }
                }
                __syncthreads();
            }
} }
{ const int lo__ = lane_id_v(); { const int lane = lo__; const int tid = wave * 64 + lane, r32 = lane & 31, hi = lane >> 5;
            {
                const int n_lat = BATCH * 2 * (SEQ / 64), n_ctx = last ? 0 : BATCH * 2 * (CTX / 64);
                for (int rep_ = 0; rep_ < REP_P3A; ++rep_)
                for (int u0 = vcu; u0 < n_lat + n_ctx; u0 += G) {
                    const bool isctx = u0 >= n_lat;
                    int b, g, p0, qrow, nl, klo;
                    if (!isctx) { b = u0 >> 8; g = (u0 >> 7) & 1; p0 = (u0 & 127) * 64; qrow = b * SEQ + p0 + (wave & 1) * 32 + r32;
                                  klo = p0 >= 128 ? 0 : (128 - p0) / 64; const int khi = min(4, (SEQ - 1 - (p0 - 128)) / 64); nl = khi - klo + 1; }
                    else { const int c = u0 - n_lat; b = c >> 3; g = (c >> 2) & 1; p0 = (c & 3) * 64; qrow = T_LAT + b * CTX + p0 + (wave & 1) * 32 + r32; nl = 0; klo = 0; }
                    const int hq = g * 4 + (wave >> 1);
                    const int qpos0 = p0 + (wave & 1) * 32;
                    bf16x8 qf[4];
                    { const bf16* qp = AQ + (size_t)qrow * 512 + hq * 64 + hi * 8;
#pragma unroll
                      for (int ks = 0; ks < 4; ++ks) qf[ks] = *(const GAS bf16x8*)(qp + ks * 16); }
                    f32x16 o[2];
#pragma unroll
                    for (int d = 0; d < 2; ++d)
#pragma unroll
                        for (int r = 0; r < 16; ++r) o[d][r] = 0.f;
                    float mrun = IN_[I_SINK][layer * 8 + hq] * 8.0f;
                    float lpart = (hi == 0) ? 1.0f : 0.0f;
                    const bf16* kg = AK + (size_t)(tid >> 3) * 128 + g * 64 + (tid & 7) * 8;
                    const bf16* vg = AVT + (size_t)(tid >> 3) * 128 + g * 64 + (tid & 7) * 8;
                    const int kp0 = p0 - 128 + 64 * klo;
                    auto tile_row = [&](int j) { return (j < nl) ? b * SEQ + kp0 + 64 * j : T_LAT + b * CTX + 64 * (j - nl); };
                    auto use_tile = [&](int j) { if (j >= nl) return true; const int kp = kp0 + 64 * j; return (kp + 63 >= qpos0 - 128) && (kp <= qpos0 + 31 + 128); };
                    auto elem = [&](f32x16 (&st)[2], int j) {
                        if (j < nl) {
                            const int dq0 = (qpos0 + r32) - (kp0 + 64 * j + 4 * hi);
#pragma unroll
                            for (int kb = 0; kb < 2; ++kb)
#pragma unroll
                                for (int r = 0; r < 16; ++r) { const int dq = dq0 - (kb * 32 + (r & 3) + 8 * (r >> 2)); if (dq > 128 || dq < -128) st[kb][r] = -1e30f; }
                        }
                    };
                    attn64_pass<2, false>(o, mrun, lpart, qf, kg, 128, vg, 128, nl + 4, tile_row, use_tile, elem, o, [](int) { return false; }, L, lane, tid);
                    const float lt = xadd32(lpart);
                    attn64_store(o, 1.0f / lt, Y + (size_t)qrow * 1536 + hq * 64, hi);
                }
            }
} }
{ const int lo__ = lane_id_v(); { const int lane = lo__; const int tid = wave * 64 + lane, r32 = lane & 31, hi = lane >> 5;
            {
                const int n_lat = BATCH * 8 * 32, n_ctx = last ? 0 : BATCH * 8;
                LAS float* rpbL = (LAS float*)(L + 49152) + 64;
                f32x16 cm[2];
                {
                    const int qc = (wave & 1) * 32 + r32, cstart = min(max(qc - 8, 0), 48);
#pragma unroll
                    for (int kb = 0; kb < 2; ++kb)
#pragma unroll
                        for (int r = 0; r < 16; ++r) { const int kc = kb * 32 + (r & 3) + 8 * (r >> 2) + 4 * hi; cm[kb][r] = ((kc >= cstart) && (kc < cstart + 16)) ? 0.f : -1e30f; }
                }
                if (tid < 64) { rpbL[tid - 64] = 0.f; rpbL[465 + tid] = 0.f; }
                for (int rep_ = 0; rep_ < REP_P3B; ++rep_)
                for (int u0 = vcu; u0 < n_lat + n_ctx; u0 += G) {
                    const bool isctx = u0 >= n_lat;
                    int b, h, gr = 0, qc0 = 0, qrow, nl, krlo;
                    if (!isctx) { b = u0 >> 8; h = (u0 >> 5) & 7; const int r0 = (u0 & 31) * 4; gr = r0 + (wave >> 1); qc0 = (wave & 1) * 32; qrow = b * SEQ + gr * GRID_W + qc0 + r32;
                                  krlo = min(max(r0 - 4, 0), 120); nl = min(max(r0 - 1, 0), 120) + 8 - krlo; }
                    else { const int c = u0 - n_lat; b = c >> 3; h = c & 7; qrow = T_LAT + b * CTX + wave * 32 + r32; nl = 0; krlo = 0; }
                    __syncthreads();
                    if (tid < 465) rpbL[tid] = IN_[I_RPB][(size_t)(layer * 8 + h) * 465 + tid] * 8.0f;
                    bf16x8 qf[4];
                    { const bf16* qp = BQ + (size_t)qrow * 512 + h * 64 + hi * 8;
#pragma unroll
                      for (int ks = 0; ks < 4; ++ks) qf[ks] = *(const GAS bf16x8*)(qp + ks * 16); }
                    f32x16 o[2];
#pragma unroll
                    for (int d = 0; d < 2; ++d)
#pragma unroll
                        for (int r = 0; r < 16; ++r) o[d][r] = 0.f;
                    float mrun = -1e30f, lpart = 0.f;
                    const bf16* kg = BK + (size_t)(tid >> 3) * 512 + h * 64 + (tid & 7) * 8;
                    const bf16* vg = BVT + (size_t)(tid >> 3) * 512 + h * 64 + (tid & 7) * 8;
                    const int rs = min(max(gr - 4, 0), 120);
                    auto tile_row = [&](int j) { return (j < nl) ? b * SEQ + (krlo + j) * GRID_W : T_LAT + b * CTX + 64 * (j - nl); };
                    auto use_tile = [&](int j) { if (j >= nl) return true; const int kr = krlo + j; return kr >= rs && kr < rs + 8; };
                    auto elem = [&](f32x16 (&st)[2], int j) {
                        if (j < nl) {
                            const LAS float* brow = rpbL + (krlo + j - gr + 7) * 31 + 15 - (qc0 + r32) + 4 * hi;
#pragma unroll
                            for (int kb = 0; kb < 2; ++kb)
#pragma unroll
                                for (int r = 0; r < 16; ++r) st[kb][r] += brow[kb * 32 + (r & 3) + 8 * (r >> 2)];
                        }
                    };
                    attn64_pass<2, true>(o, mrun, lpart, qf, kg, 512, vg, 512, nl + 4, tile_row, use_tile, elem, cm, [&](int j) { return j < nl; }, L, lane, tid);
                    const float lt = xadd32(lpart);
                    attn64_store(o, 1.0f / lt, Y + (size_t)qrow * 1536 + 512 + h * 64, hi);
                }
                __syncthreads();
            }
} }
        }
        }
#endif
        GRID_BAR();

#ifndef SKIP_P4
        { PHASE_PTRS LAYER_PTRS
        for (int rep_ = 0; rep_ < REP_P4; ++rep_) {
        {
            pg8::Gemm g{Y, WB + (size_t)layer * 3 * D * 512, 1536, 512, 512, 512, (size_t)D * 512};
            pg8::SegOrder<3> S; S.T.init(T_LAT, D, G, (int)blockIdx.x);
            EpiBranch E{SG, MG};
            pg8::gemm_phase(L, g, S, E, wave);
        }
        if (!last) { const int lo__ = lane_id_v(); { const int lane = lo__; const int fr = lane & 15, fq = lane >> 4; (void)fr; (void)fq;
            for (int it = gw; it < (T_ALL - T_LAT) / 32 * (D / 32); it += NGW) {
                const int row0 = T_LAT + (it / (D / 32)) * 32, col0 = (it % (D / 32)) * 32;
                f32x4 mg[2][2]; zero_acc22(mg);
#pragma unroll 1
                for (int seg = 0; seg < 3; ++seg) {
                    f32x4 acc[2][2]; zero_acc22(acc);
                    sgemm32<8>(acc, Y + seg * 512, 1536, WB + (size_t)(layer * 3 + seg) * D * 512, 512, 512, row0, col0, lane);
#pragma unroll
                    for (int m = 0; m < 2; ++m)
#pragma unroll
                        for (int r = 0; r < 4; ++r) {
                            const unsigned char* gp = (const unsigned char*)SG + (size_t)(row0 + 16 * m + 4 * fq + r) * 3072 + seg * 1024 + col0 + fr;
#pragma unroll
                            for (int n = 0; n < 2; ++n) mg[m][n][r] += (float)gp[16 * n] * (1.0f / 255.0f) * acc[m][n][r];
                        }
                }
#pragma unroll
                for (int m = 0; m < 2; ++m)
#pragma unroll
                    for (int r = 0; r < 4; ++r) {
                        bf16* rowp = MG + (size_t)(row0 + 16 * m + 4 * fq + r) * D + col0 + fr;
#pragma unroll
                        for (int n = 0; n < 2; ++n) rowp[16 * n] = (bf16)f2bf(mg[m][n][r]);
                    }
            }
} }
        }
        }
#endif
        GRID_BAR();

#ifndef SKIP_P5
        { PHASE_PTRS LAYER_PTRS
        {
            pg8::Gemm g{MG, WO + (size_t)layer * D * D, D, D, D, 0, 0};
            pg8::SegOrder<1> S; S.T.init(T_LAT, D, G, (int)blockIdx.x);
            EpiOut E{X, modl, layer == 0 ? IN_[I_X] : nullptr, IN_[I_CTX]};
            pg8::gemm_phase(L, g, S, E, wave);
        }
        if (!last) { const int lo__ = lane_id_v(); { const int lane = lo__; const int fr = lane & 15, fq = lane >> 4; (void)fr; (void)fq;
            for (int it = gw; it < (T_ALL - T_LAT) / 32 * (D / 32); it += NGW) {
                const int row0 = T_LAT + (it / (D / 32)) * 32, col0 = (it % (D / 32)) * 32;
                f32x4 acc[2][2]; zero_acc22(acc);
                sgemm32<8>(acc, MG, D, WO + (size_t)layer * D * D, D, D, row0, col0, lane);
                const float* gt = modl + (size_t)2 * 6 * D + 2 * D + col0 + fr;
#pragma unroll
                for (int m = 0; m < 2; ++m)
#pragma unroll
                    for (int r = 0; r < 4; ++r) {
                        float* rowp = X + (size_t)(row0 + 16 * m + 4 * fq + r) * D + col0 + fr;
                        const float* srcp = (layer == 0) ? IN_[I_CTX] + (size_t)(row0 - T_LAT + 16 * m + 4 * fq + r) * D + col0 + fr : rowp;
#pragma unroll
                        for (int n = 0; n < 2; ++n) rowp[16 * n] = srcp[16 * n] + gt[16 * n] * acc[m][n][r];
                    }
            }
} }
        }
#endif
        GRID_BAR();

#ifndef SKIP_P6
        { PHASE_PTRS LAYER_PTRS
        for (int rep_ = 0; rep_ < REP_P6; ++rep_) {
        { const int ln = lane_id_v();
        {
            f32x4 gm[4], shv[4];
            auto prep = [&](int midx) { const float* md = modl + (size_t)midx * 6 * D;
#pragma unroll
                for (int j = 0; j < 4; ++j) { const f32x4 g = *((const GAS f32x4*)(IN_[I_G2] + layer * D) + ln + 64 * j); const f32x4 sc = *((const GAS f32x4*)(md + 4 * D) + ln + 64 * j);
                    gm[j] = g * (sc + 1.0f); shv[j] = *((const GAS f32x4*)(md + 3 * D) + ln + 64 * j); } };
            auto row = [&](int r) {
                const GAS f32x4* xr = (const GAS f32x4*)(X + (size_t)r * D) + ln;
                f32x4 v[4]; float ss = 0.f;
#pragma unroll
                for (int j = 0; j < 4; ++j) { v[j] = xr[64 * j]; ss += (v[j].x * v[j].x + v[j].y * v[j].y) + (v[j].z * v[j].z + v[j].w * v[j].w); }
                const float rs = 1.0f / sqrtf(wave_sum(ss) * (1.f / D) + NORM_EPS);
                GAS v2u* o8 = (GAS v2u*)(H + (size_t)r * D) + ln;
#pragma unroll
                for (int j = 0; j < 4; ++j) { const f32x4 h = v[j] * rs * gm[j] + shv[j]; v2u o; o.x = pk2(h.x, h.y); o.y = pk2(h.z, h.w); o8[64 * j] = o; } };
            wave_row_blocks(T_EFF, gw, NGW, prep, row);
        }
        }
        }
        }
#endif
        GRID_BAR();

#ifndef SKIP_P7
        { PHASE_PTRS LAYER_PTRS
        for (int rep_ = 0; rep_ < REP_P7; ++rep_) {
        {
            pg8::Gemm g{H, WQ + (size_t)layer * 2048 * D, D, D, D, 0, 0};
            pg8::SegOrder<1> S; S.T.init(T_LAT, 2048, G, (int)blockIdx.x);
            EpiStoreH E{Q2, 2048};
            pg8::gemm_phase(L, g, S, E, wave);
        }
        if (!last) { const int lo__ = lane_id_v(); { const int lane = lo__; const int fr = lane & 15, fq = lane >> 4; (void)fr; (void)fq;
            for (int it = gw; it < (T_ALL - T_LAT) / 32 * (2048 / 32); it += NGW) {
                const int row0 = T_LAT + (it / (2048 / 32)) * 32, col0 = (it % (2048 / 32)) * 32;
                f32x4 acc[2][2]; zero_acc22(acc);
                sgemm32<8>(acc, H, D, WQ + (size_t)layer * 2048 * D, D, D, row0, col0, lane);
#pragma unroll
                for (int m = 0; m < 2; ++m)
#pragma unroll
                    for (int r = 0; r < 4; ++r) {
                        bf16* rowp = Q2 + (size_t)(row0 + 16 * m + 4 * fq + r) * 2048 + col0 + fr;
#pragma unroll
                        for (int n = 0; n < 2; ++n) rowp[16 * n] = __builtin_bit_cast(unsigned short, (_Float16)acc[m][n][r]);
                    }
            }
} }
        }
        }
#endif
        GRID_BAR();

#ifndef SKIP_P8
        { PHASE_PTRS LAYER_PTRS
        for (int rep_ = 0; rep_ < REP_P8; ++rep_) {
{ const int lo__ = lane_id_v(); { const int lane = lo__; const int fr = lane & 15, fq = lane >> 4, tid = wave * 64 + lane;
        {
            const int tl = tid >> 2, qd = tid & 3, ph = qd >> 1, hq = qd & 1;
            for (int it = vcu; it < (T_EFF / 128) * PEER_HEADS; it += G) {
                const int tile = it >> 3, h = it & 7;
                {
                    const int t = tile * 128 + tl;
                    int a[16];
                    v4u sw[8];
                    { const bf16* sp = Q2 + (size_t)t * 2048 + h * 256 + qd * 64;
#pragma unroll
                      for (int i = 0; i < 8; ++i) sw[i] = *(const GAS v4u*)(sp + 8 * i); }
#define H2F_(x) ((float)__builtin_bit_cast(_Float16, (unsigned short)(x)))
#define LOAD_CHUNK_L(v, ch) _Pragma("unroll") for (int q = 0; q < 4; ++q) { const unsigned w0_ = sw[2 * (ch) + (q >> 1)][2 * (q & 1)], w1_ = sw[2 * (ch) + (q >> 1)][2 * (q & 1) + 1]; const int kb_ = hq * 64 + (ch) * 16 + 4 * q; \
                        v[4 * q + 0] = (f2ord(H2F_(w0_ & 0xffffu)) & ~127) | (kb_ + 0); v[4 * q + 1] = (f2ord(H2F_(w0_ >> 16)) & ~127) | (kb_ + 1); \
                        v[4 * q + 2] = (f2ord(H2F_(w1_ & 0xffffu)) & ~127) | (kb_ + 2); v[4 * q + 3] = (f2ord(H2F_(w1_ >> 16)) & ~127) | (kb_ + 3); }
                    LOAD_CHUNK_L(a, 0) sort16_desc(a);
#pragma unroll
                    for (int ch = 1; ch < 4; ++ch) { int v[16]; LOAD_CHUNK_L(v, ch) sort16_desc(v); merge16_desc(a, v); }
#undef LOAD_CHUNK_L
#undef H2F_
                    { int b[16];
#pragma unroll
                      for (int i = 0; i < 16; ++i) b[i] = __builtin_amdgcn_update_dpp(0, a[i], 0xB1, 0xF, 0xF, true);
                      merge16_desc(a, b); }
                    int a0[16], a1[16];
#pragma unroll
                    for (int i = 0; i < 16; ++i) { const int o2 = __builtin_amdgcn_update_dpp(0, a[i], 0x4E, 0xF, 0xF, true); a0[i] = ph ? o2 : a[i]; a1[i] = ph ? a[i] : o2; }
                    {
            float va[16], vb[16];
#pragma unroll
            for (int i = 0; i < 16; ++i) { va[i] = ord2f(a0[i] & ~127); vb[i] = ord2f(a1[i] & ~127); }
            int c[16];
            {
                constexpr int CI_[4][16] = {{0, 0, 0, 0, 0, 0, 0, 0, 0, 0, 0, 0, 0, 0, 0, 0}, {1, 1, 1, 1, 1, 1, 1, 1, 2, 2, 2, 2, 2, 3, 3, 3}, {3, 4, 4, 4, 5, 5, 6, 6, 7, 7, 8, 9, 10, 11, 12, 13}, {14, 15, 0, 0, 0, 0, 0, 0, 0, 0, 0, 0, 0, 0, 0, 0}};
                constexpr int CJ_[4][16] = {{0, 1, 2, 3, 4, 5, 6, 7, 8, 9, 10, 11, 12, 13, 14, 15}, {0, 1, 2, 3, 4, 5, 6, 7, 0, 1, 2, 3, 4, 0, 1, 2}, {3, 0, 1, 2, 0, 1, 0, 1, 0, 1, 0, 0, 0, 0, 0, 0}, {0, 0, 0, 0, 0, 0, 0, 0, 0, 0, 0, 0, 0, 0, 0, 0}};
                constexpr int CP_[4][16] = {{0, 0, 0, 0, 0, 0, 0, 0, 0, 0, 0, 0, 0, 0, 0, 0}, {0, 0, 0, 0, 0, 0, 0, 0, 0, 0, 0, 0, 0, 0, 0, 0}, {0, 0, 0, 0, 0, 0, 0, 0, 0, 0, 0, 0, 0, 0, 0, 0}, {0, 0, 1, 1, 1, 1, 1, 1, 1, 1, 1, 1, 1, 1, 1, 1}};
                const bool q0_ = (qd == 0), q1_ = (qd == 1), q2_ = (qd == 2);
                int v[16];
#pragma unroll
                for (int k = 0; k < 16; ++k) {
                    const float sa = q0_ ? va[CI_[0][k]] : q1_ ? va[CI_[1][k]] : q2_ ? va[CI_[2][k]] : va[CI_[3][k]];
                    const float sb = q0_ ? vb[CJ_[0][k]] : q1_ ? vb[CJ_[1][k]] : q2_ ? vb[CJ_[2][k]] : vb[CJ_[3][k]];
                    const int id = q0_ ? (CI_[0][k] * 16 + CJ_[0][k]) : q1_ ? (CI_[1][k] * 16 + CJ_[1][k]) : q2_ ? (CI_[2][k] * 16 + CJ_[2][k]) : (CI_[3][k] * 16 + CJ_[3][k]);
                    const bool pad = q0_ ? (CP_[0][k] != 0) : q1_ ? (CP_[1][k] != 0) : q2_ ? (CP_[2][k] != 0) : (CP_[3][k] != 0);
                    v[k] = pad ? (int)0x80000000 : ((f2ord(sa + sb) & ~255) | id);
                }
                sort16_desc(v);
                { int b[16];
#pragma unroll
                  for (int i = 0; i < 16; ++i) b[i] = __builtin_amdgcn_update_dpp(0, v[i], 0xB1, 0xF, 0xF, true);
                  merge16_desc(v, b); }
                { int b[16];
#pragma unroll
                  for (int i = 0; i < 16; ++i) b[i] = __builtin_amdgcn_update_dpp(0, v[i], 0x4E, 0xF, 0xF, true);
                  merge16_desc(v, b); }
#pragma unroll
                for (int i = 0; i < 16; ++i) c[i] = v[i];
            }
            const float smax = ord2f(c[0] & ~255);
            float pe[16]; float psum = 0.f;
#pragma unroll
            for (int k = 0; k < 16; ++k) { pe[k] = __expf(ord2f(c[k] & ~255) - smax); psum += pe[k]; }
            const float ip = 1.0f / psum;
#pragma unroll
            for (int kk = 0; kk < 4; ++kk) {
                const int ck = (qd == 0) ? c[kk] : (qd == 1) ? c[4 + kk] : (qd == 2) ? c[8 + kk] : c[12 + kk];
                const float pk_ = (qd == 0) ? pe[kk] : (qd == 1) ? pe[4 + kk] : (qd == 2) ? pe[8 + kk] : pe[12 + kk];
                const int ij = ck & 255, ii = ij >> 4, jj = ij & 15;
                int e0 = 0, e1 = 0;
#pragma unroll
                for (int q = 0; q < 16; ++q) { e0 = (ii == q) ? (a0[q] & 127) : e0; e1 = (jj == q) ? (a1[q] & 127) : e1; }
                const int e = e0 * PEER_KEYS + e1;
                const float su = SCU[layer * 16384 + e], sv = SCV[layer * 16384 + e];
                const int k = 4 * qd + kk;
                EI[(size_t)t * NSEL + h * 16 + k] = (unsigned)e | (f2bf(su) << 16);
                EG[(size_t)t * NSEL + h * 16 + k] = pk_ * ip * sv;
            }
                    }
                }
            }
        }
} }
        }
        }
#endif
        GRID_BAR();

#ifndef SKIP_P10
#define P10_CENSUS \
        unsigned myx_, nx_ = 1u, smask_ = 0u; { unsigned cnt_[16]; unsigned* bw_ = (unsigned*)(args.ws + WS_CTL) + CW_BAR; \
            _Pragma("unroll") for (int j = 0; j < 16; ++j) cnt_[j] = (unsigned)__builtin_amdgcn_readfirstlane((int)xb_ld(&bw_[XB_XCNT(j)])); \
            myx_ = xb_xcc_id(); unsigned np_ = 0u; \
            _Pragma("unroll") for (int j = 0; j < 16; ++j) { np_ += (cnt_[j] > 0u) ? 1u : 0u; nx_ = ((unsigned)j == myx_) ? cnt_[j] : nx_; } \
            if (np_ == 0u) np_ = 1u; if (nx_ == 0u) nx_ = 1u; \
            _Pragma("unroll") for (int sl = 0; sl < 8; ++sl) { const unsigned k_ = (unsigned)sl % np_; unsigned seen_ = 0u, srv_ = 0xffu; \
                _Pragma("unroll") for (int j = 0; j < 16; ++j) { if (cnt_[j] > 0u) { srv_ = (seen_ == k_) ? (unsigned)j : srv_; ++seen_; } } \
                smask_ |= (srv_ == myx_) ? (1u << sl) : 0u; } } \
        const int rank_ = (int)__builtin_amdgcn_readfirstlane((int)MISC[12]); const int wstride_ = (int)nx_ * NWAVES; (void)rank_; (void)wstride_;
        { PHASE_PTRS LAYER_PTRS
        { const int ln = lane_id_v(); const int c = ln & 7, tg = ln >> 3;
          P10_CENSUS
          float* PART = (float*)(wsq + WS_PART);
          const unsigned char* U8l = U8 + (size_t)layer * 16384 * (D / 2);
          for (int rep_ = 0; rep_ < REP_P10A; ++rep_)
#pragma unroll 1
          for (int s8 = 0; s8 < 8; ++s8) {
            if (!((smask_ >> s8) & 1u)) continue;
            const int sl = s8 & 3, TH = T_EFF / 2, tb = (s8 >> 2) * TH;
            const int ws0 = (rank_ * NWAVES + wave) * 8, nslot = wstride_ * 8;
            const int niter = TH / nslot, nb = niter * 8;
#define A_TOK(bi) (tb + ws0 + tg + (min((bi), nb - 1) >> 3) * nslot)
#define A_LOAD_PK(pkv, bi) { const GAS v4u* wp_ = (const GAS v4u*)(EI + (size_t)A_TOK(bi) * NSEL + 16 * (min((bi), nb - 1) & 7)); _Pragma("unroll") for (int q = 0; q < 4; ++q) pkv[q] = wp_[q]; }
#define A_ISSUE(rowv, pkv) { _Pragma("unroll") for (int q = 0; q < 16; ++q) rowv[q] = *(const GAS v4u*)(U8l + (size_t)(pkv[q >> 2][q & 3] & 0xffffu) * (D / 2) + 128 * sl + 16 * c); }
#define A_LOAD_H(hvv, bi) { const int tq_ = A_TOK(bi); _Pragma("unroll") for (int j = 0; j < 4; ++j) hvv[j] = *(const GAS v4u*)(H + (size_t)tq_ * D + 256 * j + 64 * sl + 8 * c); }
#define A_QUANT(hvv) { float am_ = 0.f; \
                _Pragma("unroll") for (int j = 0; j < 4; ++j) _Pragma("unroll") for (int w = 0; w < 4; ++w) am_ = fmaxf(am_, fmaxf(fabsf(bf2f(hvv[j][w] & 0xffffu)), fabsf(bf2f(hvv[j][w] >> 16)))); \
                am_ = fmaxf(am_, dpp_mov<0xB1>(am_)); am_ = fmaxf(am_, dpp_mov<0x4E>(am_)); am_ = fmaxf(am_, dpp_mov<0x141>(am_)); am_ = fmaxf(am_, 1e-20f); \
                sh_ = am_ * (1.0f / 119.0f); const float ih_ = 119.0f / am_; \
                  \
                _Pragma("unroll") for (int hf = 0; hf < 2; ++hf) _Pragma("unroll") for (int jj = 0; jj < 2; ++jj) { unsigned aw_ = 0u, bw_ = 0u; \
                    _Pragma("unroll") for (int i = 0; i < 4; ++i) _Pragma("unroll") for (int od = 0; od < 2; ++od) { const unsigned hw_ = hvv[2 * jj + od][2 * hf + (i >> 1)]; \
                        const int t_ = __float2int_rn(bf2f((i & 1) ? (hw_ >> 16) : (hw_ & 0xffffu)) * ih_) + 8; \
                        aw_ |= ((unsigned)(t_ >> 4) & 15u) << (4 * (2 * i + od)); bw_ |= (((unsigned)t_ & 15u) ^ 8u) << (4 * (2 * i + od)); } \
                    hq_[2 * hf + jj] = (int)aw_; hq_[4 + 2 * hf + jj] = (int)bw_; } }
#define A_COMPUTE(rowv, bi) { int p_[16]; \
                _Pragma("unroll") for (int q = 0; q < 16; ++q) { int ia = 0, ib = 0; \
                    _Pragma("unroll") for (int w = 0; w < 4; ++w) { ia = __builtin_amdgcn_sdot8((int)rowv[q][w], hq_[w], ia, false); ib = __builtin_amdgcn_sdot8((int)rowv[q][w], hq_[4 + w], ib, false); } \
                    p_[q] = (ia << 4) + ib; } \
                { const bool up = (c & 4) != 0; _Pragma("unroll") for (int i = 0; i < 8; ++i) { const int send = up ? p_[i] : p_[8 + i], keep = up ? p_[8 + i] : p_[i]; p_[i] = keep + __builtin_amdgcn_update_dpp(0, send, 0x141, 0xF, 0xF, true); } } \
                { const bool up = (c & 2) != 0; _Pragma("unroll") for (int i = 0; i < 4; ++i) { const int send = up ? p_[i] : p_[4 + i], keep = up ? p_[4 + i] : p_[i]; p_[i] = keep + __builtin_amdgcn_update_dpp(0, send, 0x4E, 0xF, 0xF, true); } } \
                { const bool up = (c & 1) != 0; _Pragma("unroll") for (int i = 0; i < 2; ++i) { const int send = up ? p_[i] : p_[2 + i], keep = up ? p_[2 + i] : p_[i]; p_[i] = keep + __builtin_amdgcn_update_dpp(0, send, 0xB1, 0xF, 0xF, true); } } \
                  \
                *(GAS unsigned*)((GAS bf16*)PART + ((size_t)sl * T_ALL + (tb + ws0 + tg + ((bi) >> 3) * nslot)) * NSEL + 16 * ((bi) & 7) + 2 * c) = pk2((float)p_[0] * sh_, (float)p_[1] * sh_); }
            v4u pkA[4], pkB[4]; v4u rowA[16], rowB[16]; v4u hN[4]; int hq_[8] = {0, 0, 0, 0, 0, 0, 0, 0}; float sh_ = 0.f;
            if (nb > 0) {
            A_LOAD_PK(pkA, 0) A_LOAD_PK(pkB, 1) A_LOAD_H(hN, 0)
            A_ISSUE(rowA, pkA)
#pragma unroll 1
            for (int bi = 0; bi < nb; bi += 2) {
                if ((bi & 7) == 0) { A_QUANT(hN) A_LOAD_H(hN, bi + 8) }
                A_ISSUE(rowB, pkB) A_LOAD_PK(pkA, bi + 2)
                __builtin_amdgcn_sched_barrier(0);
                A_COMPUTE(rowA, bi)
                __builtin_amdgcn_sched_barrier(0);
                A_ISSUE(rowA, pkA) A_LOAD_PK(pkB, bi + 3)
                __builtin_amdgcn_sched_barrier(0);
                A_COMPUTE(rowB, bi + 1)
                __builtin_amdgcn_sched_barrier(0);
            }
            }
            {
                const int rem0 = niter * nslot, nrem = TH - rem0;
#pragma unroll 1
                for (int un = rank_ * NWAVES + wave; un < nrem; un += wstride_) {
                    const int ws0 = rem0 + (un >> 3) * 8, nb = 8, bi = un & 7;
                    A_LOAD_PK(pkA, bi) A_LOAD_H(hN, bi)
                    A_ISSUE(rowA, pkA)
                    A_QUANT(hN)
                    A_COMPUTE(rowA, bi)
                }
            }
#undef A_TOK
#undef A_LOAD_PK
#undef A_ISSUE
#undef A_LOAD_H
#undef A_QUANT
#undef A_COMPUTE
          }
        } }
        GRID_BAR();
        { PHASE_PTRS LAYER_PTRS
        { const int ln = lane_id_v();
          const float* PART = (const float*)(wsq + WS_PART); float* WGT = (float*)(wsq + WS_WGT);
          for (int rep_ = 0; rep_ < REP_P10B; ++rep_)
          for (int i4 = vcu * NTHREADS + wave * 64 + ln; i4 < T_EFF * NSEL / 4; i4 += NGT) {
              f32x4 dsum = (f32x4){0.f, 0.f, 0.f, 0.f};
#pragma unroll
              for (int sl = 0; sl < 4; ++sl) { const v2u pw_ = *((const GAS v2u*)((const GAS bf16*)PART + (size_t)sl * T_ALL * NSEL) + i4); dsum += (f32x4){bf2f(pw_.x & 0xffffu), bf2f(pw_.x >> 16), bf2f(pw_.y & 0xffffu), bf2f(pw_.y >> 16)}; }
              const v4u esu = *((const GAS v4u*)EI + i4); const f32x4 gv = *((const GAS f32x4*)EG + i4);
              v4u o;
#pragma unroll
              for (int q = 0; q < 4; ++q) {
                  const float dot = dsum[q] * bf2f(esu[q] >> 16);
                  o[q] = (esu[q] & 0xffffu) | (f2bf(0.5f * dot * (1.0f + erff(dot * 0.70710678118654752f)) * gv[q]) << 16);
              }
              *((GAS v4u*)WGT + i4) = o;
          }
        } }
        GRID_BAR();
        { PHASE_PTRS LAYER_PTRS
        { const int ln = lane_id_v(); const int c = ln & 7, tg = ln >> 3;
          P10_CENSUS
          const unsigned* WGT = (const unsigned*)(wsq + WS_WGT); float* XO = (float*)(wsq + WS_XO);
          const unsigned char* V8l = V8 + (size_t)layer * 16384 * D;
          for (int rep_ = 0; rep_ < REP_P10C; ++rep_)
#pragma unroll 1
          for (int sl = 0; sl < 8; ++sl) {
            if (!((smask_ >> sl) & 1u)) continue;
            const int ws0 = (rank_ * NWAVES + wave) * 8, nslot = wstride_ * 8;
            if (ws0 >= T_EFF) continue;
            const int niter = (T_EFF - ws0 + nslot - 1) / nslot, nb = niter * 8;
#define C_TOK(bi) (ws0 + tg + (min((bi), nb - 1) >> 3) * nslot)
#define C_LOAD_PK(pkv, bi) { const GAS v4u* wp_ = (const GAS v4u*)(WGT + (size_t)C_TOK(bi) * NSEL + 16 * (min((bi), nb - 1) & 7)); _Pragma("unroll") for (int q = 0; q < 4; ++q) pkv[q] = wp_[q]; }
#define C_ISSUE(rowv, wv, pkv) { _Pragma("unroll") for (int q = 0; q < 16; ++q) { const unsigned w_ = pkv[q >> 2][q & 3]; rowv[q] = *(const GAS v4u*)(V8l + (size_t)(w_ & 0xffffu) * D + 128 * sl + 16 * c); } \
                _Pragma("unroll") for (int q = 0; q < 8; ++q) wv[q] = (pkv[q >> 1][(2 * q) & 3] >> 16) | (pkv[q >> 1][(2 * q + 1) & 3] & 0xffff0000u); }
#define C_COMPUTE(rowv, wv) { _Pragma("unroll") for (int q = 0; q < 16; ++q) { const float wq_ = (q & 1) ? __builtin_bit_cast(float, wv[q >> 1] & 0xffff0000u) : bf2f(wv[q >> 1] & 0xffffu); const f32x2 w2_ = (f32x2){wq_, wq_}; _Pragma("unroll") for (int j = 0; j < 4; ++j) { \
                    const f32x2 a = __builtin_amdgcn_cvt_pk_f32_fp8((int)rowv[q][j], false), b = __builtin_amdgcn_cvt_pk_f32_fp8((int)rowv[q][j], true); \
                    f32x2 lo_ = (f32x2){o[j].x, o[j].y}, hi_ = (f32x2){o[j].z, o[j].w}; lo_ = __builtin_elementwise_fma(a, w2_, lo_); hi_ = __builtin_elementwise_fma(b, w2_, hi_); \
                    o[j].x = lo_.x; o[j].y = lo_.y; o[j].z = hi_.x; o[j].w = hi_.y; } \
                    asm volatile("" : "+v"(o[0]), "+v"(o[1]), "+v"(o[2]), "+v"(o[3])); } }
            v4u pkA[4], pkB[4]; unsigned wA[8], wB[8]; v4u rowA[16], rowB[16];
            f32x4 o[4];
#pragma unroll
            for (int j = 0; j < 4; ++j) o[j] = (f32x4){0.f, 0.f, 0.f, 0.f};
            C_LOAD_PK(pkA, 0) C_LOAD_PK(pkB, 1)
            C_ISSUE(rowA, wA, pkA)
#pragma unroll 1
            for (int bi = 0; bi < nb; bi += 2) {
                C_ISSUE(rowB, wB, pkB) C_LOAD_PK(pkA, bi + 2)
                __builtin_amdgcn_sched_barrier(0);
                C_COMPUTE(rowA, wA)
                __builtin_amdgcn_sched_barrier(0);
                C_ISSUE(rowA, wA, pkA) C_LOAD_PK(pkB, bi + 3)
                __builtin_amdgcn_sched_barrier(0);
                C_COMPUTE(rowB, wB)
                __builtin_amdgcn_sched_barrier(0);
                if ((bi & 7) == 6) {
                    const int t = ws0 + tg + (bi >> 3) * nslot;
#pragma unroll
                    for (int j = 0; j < 4; ++j) { v2u ow_; ow_.x = pk2(o[j].x, o[j].y); ow_.y = pk2(o[j].z, o[j].w); *(GAS v2u*)((GAS bf16*)XO + (size_t)t * D + 256 * j + 32 * sl + 4 * c) = ow_; o[j] = (f32x4){0.f, 0.f, 0.f, 0.f}; }
                }
            }
#undef C_TOK
#undef C_LOAD_PK
#undef C_ISSUE
#undef C_COMPUTE
          }
        } }
        GRID_BAR();
#undef P10_CENSUS
        { PHASE_PTRS LAYER_PTRS
        { const int ln = lane_id_v();
          const float* XO = (const float*)(wsq + WS_XO);
          f32x4 gt2v[4], gm[4], shv[4];
          auto prep = [&](int midx) {
              const float* md = modl + (size_t)midx * 6 * D; const float* md1 = modl + (size_t)(3 + midx) * 6 * D;
#pragma unroll
              for (int j = 0; j < 4; ++j) {
                  gt2v[j] = *((const GAS f32x4*)(md + 5 * D) + ln + 64 * j);
                  if (!last) { const f32x4 g = *((const GAS f32x4*)(IN_[I_G1] + (layer + 1) * D) + ln + 64 * j); const f32x4 sc = *((const GAS f32x4*)(md1 + D) + ln + 64 * j);
                               gm[j] = g * (sc + 1.0f); shv[j] = *((const GAS f32x4*)(md1 + 0) + ln + 64 * j); }
                  else { gm[j] = *((const GAS f32x4*)IN_[I_GFINAL] + ln + 64 * j); shv[j] = (f32x4){0.f, 0.f, 0.f, 0.f}; }
              } };
          auto row = [&](int t) {
              GAS f32x4* xr = (GAS f32x4*)(X + (size_t)t * D) + ln;
              const GAS v2u* xo = (const GAS v2u*)((const GAS bf16*)XO + (size_t)t * D) + ln;
              f32x4 xn[4]; float ss = 0.f;
#pragma unroll
              for (int j = 0; j < 4; ++j) { const v2u xw_ = xo[64 * j]; xn[j] = xr[64 * j] + gt2v[j] * (f32x4){bf2f(xw_.x & 0xffffu), bf2f(xw_.x >> 16), bf2f(xw_.y & 0xffffu), bf2f(xw_.y >> 16)}; ss += (xn[j].x * xn[j].x + xn[j].y * xn[j].y) + (xn[j].z * xn[j].z + xn[j].w * xn[j].w); }
              const float rs = 1.0f / sqrtf(wave_sum(ss) * (1.f / D) + NORM_EPS);
              if (!last) {
                  f32x4 hv[4];
#pragma unroll
                  for (int j = 0; j < 4; ++j) { xr[64 * j] = xn[j]; hv[j] = xn[j] * rs * gm[j] + shv[j]; }
                  h8_row(hv, wsq + WS_H8 + (size_t)t * D, (float*)(wsq + WS_HS) + t, ln);
              } else {
                  GAS f32x4* op = (GAS f32x4*)(((float*)IN_[22]) + (size_t)t * D) + ln;
#pragma unroll
                  for (int j = 0; j < 4; ++j) op[64 * j] = xn[j] * rs * gm[j];
              } };
          wave_row_blocks(T_EFF, gw, NGW, prep, row);
          if (!last) wg8_rows(WIN + (size_t)(layer + 1) * IN_W * D, wsq + WS_WG8, (float*)(wsq + WS_WGS) + (size_t)(layer + 1) * IN_W, gw, NGW, ln);
        } }
#endif
        if (!last) GRID_BAR();
    }
}

extern "C" void kernel_launch(void* const* d_in, const int* in_sizes, int n_in, void* d_out, int out_size, void* d_ws, size_t ws_size, hipStream_t stream) {
    static int grid = 0;
    if (grid == 0) {
        if (n_in != 22 || out_size != T_LAT * D || ws_size < WS_END) { fprintf(stderr, "kernel_launch: unexpected shapes: n_in %d out %d ws %zu (need %zu)\n", n_in, out_size, ws_size, (size_t)WS_END); grid = -1; return; }
        int dev = 0, cus = 0, per_cu = 0;
        if (hipGetDevice(&dev) != hipSuccess || hipDeviceGetAttribute(&cus, hipDeviceAttributeMultiprocessorCount, dev) != hipSuccess) { fprintf(stderr, "device query failed\n"); grid = -1; return; }
        if (hipFuncSetAttribute((const void*)mega_fwd, hipFuncAttributeMaxDynamicSharedMemorySize, LDS_BYTES) != hipSuccess) { fprintf(stderr, "hipFuncSetAttribute failed\n"); grid = -1; return; }
        if (hipOccupancyMaxActiveBlocksPerMultiprocessor(&per_cu, (const void*)mega_fwd, NTHREADS, LDS_BYTES) != hipSuccess || per_cu < 1) { fprintf(stderr, "occupancy query: %d\n", per_cu); }
        (void)hipGetLastError();
        grid = cus;
    }
    if (grid < 0) return;
    if (hipMemsetAsync((char*)d_ws + WS_CTL, 0, CTL_ZERO_BYTES, stream) != hipSuccess) { fprintf(stderr, "memset failed\n"); return; }
    Args a{};
    for (int i = 0; i < 22; ++i) a.in[i] = (const float*)d_in[i];
    a.out = (float*)d_out; a.ws = (unsigned char*)d_ws;
    hipLaunchKernelGGL(mega_fwd, dim3(grid), dim3(NTHREADS), LDS_BYTES, stream, a);
}
```
